# Optimizing an MI355X kernel written in HIP

```python
import math
import jax, jax.numpy as jnp
from jax import lax
import numpy as np

D_MODEL = 1024
BATCH = 4
SEQ = 8192
DEPTH = 1

ATT_WIDTH = D_MODEL // 2
ATT_HEAD_DIM = 64
ATT_HEADS = ATT_WIDTH // ATT_HEAD_DIM
MOBA_BLOCK = 256
MOBA_TOPK = 3
MOBA_QCHUNK = 64
SSM_WIDTH = D_MODEL // 2
SSM_GROUP = 16
SSM_GROUPS = SSM_WIDTH // SSM_GROUP
SSM_STATE = 64
IN_WIDTH = 3 * ATT_WIDTH + SSM_WIDTH + 2 * D_MODEL
MEM_LEN = 256
XATTN_HEADS = 4
XATTN_HEAD_DIM = D_MODEL // 8
XATTN_WIDTH = XATTN_HEADS * XATTN_HEAD_DIM
N_EXPERTS = 32
EXPERT_TOPK = 4
D_FF = D_MODEL
SWIGLU_LIMIT = 7.0
SWIGLU_ALPHA = 1.702
MOE_BLOCK = 256
RMS_EPS = 1e-6
NEG_INF = -1e30

kernel_name = "hybrid_moba_s5_xattn_moe_layer"


def rmsnorm(x, g):
    xf = x.astype(jnp.float32)
    y = xf * lax.rsqrt(jnp.mean(xf * xf, axis=-1, keepdims=True) + RMS_EPS)
    return (y * g.astype(jnp.float32)).astype(x.dtype)


def moba_attention(q, k, v):
    B, H, S, Dh = q.shape
    nb = -(-S // MOBA_BLOCK)
    sp = nb * MOBA_BLOCK
    pad = ((0, 0), (0, 0), (0, sp - S), (0, 0))
    q, k, v = jnp.pad(q, pad), jnp.pad(k, pad), jnp.pad(v, pad)
    kb = k.reshape(B, H, nb, MOBA_BLOCK, Dh)
    vb = v.reshape(B, H, nb, MOBA_BLOCK, Dh)
    kmean = jnp.mean(kb.astype(jnp.float32), axis=3)
    topk = min(MOBA_TOPK, nb)
    nc = sp // MOBA_QCHUNK
    qc = q.reshape(B, H, nc, MOBA_QCHUNK, Dh).transpose(2, 0, 1, 3, 4)
    scale = Dh ** -0.5
    gather_blocks = jax.vmap(jax.vmap(lambda blocks, idx: blocks[idx]))

    def chunk(args):
        qi, ci = args
        qf = qi.astype(jnp.float32)
        start = ci * MOBA_QCHUNK
        own = start // MOBA_BLOCK
        qpos = start + jnp.arange(MOBA_QCHUNK)
        gate = jnp.einsum('bhqd,bhnd->bhqn', qf, kmean)
        gate = jnp.where(jnp.arange(nb) < own, gate, NEG_INF)
        _, sel = lax.top_k(gate, topk)
        valid = sel < own
        ks = gather_blocks(kb, sel)
        vs = gather_blocks(vb, sel)
        s_sel = jnp.einsum('bhqd,bhqkjd->bhqkj', qf, ks.astype(jnp.float32)) * scale
        s_sel = jnp.where(valid[..., None], s_sel, NEG_INF).reshape(B, H, MOBA_QCHUNK, topk * MOBA_BLOCK)
        k_own = lax.dynamic_index_in_dim(kb, own, axis=2, keepdims=False)
        v_own = lax.dynamic_index_in_dim(vb, own, axis=2, keepdims=False)
        s_own = jnp.einsum('bhqd,bhjd->bhqj', qf, k_own.astype(jnp.float32)) * scale
        kpos = own * MOBA_BLOCK + jnp.arange(MOBA_BLOCK)
        s_own = jnp.where(kpos[None, :] <= qpos[:, None], s_own, NEG_INF)
        p = jax.nn.softmax(jnp.concatenate([s_sel, s_own], axis=-1), axis=-1)
        p_sel = p[..., :topk * MOBA_BLOCK].reshape(B, H, MOBA_QCHUNK, topk, MOBA_BLOCK)
        p_own = p[..., topk * MOBA_BLOCK:]
        out = (jnp.einsum('bhqkj,bhqkjd->bhqd', p_sel, vs.astype(jnp.float32))
               + jnp.einsum('bhqj,bhjd->bhqd', p_own, v_own.astype(jnp.float32)))
        return out.astype(q.dtype)

    outs = lax.map(chunk, (qc, jnp.arange(nc)))
    return outs.transpose(1, 2, 0, 3, 4).reshape(B, H, sp, Dh)[:, :, :S]


def s5_ssm(u, a_re, a_im, log_dt, b_re, b_im, c_re, c_im, d_skip):
    B, S, G, C = u.shape
    uf = u.astype(jnp.float32)
    lam = lax.complex(jnp.minimum(a_re.astype(jnp.float32), -1e-4), a_im.astype(jnp.float32))
    dt = jnp.exp(log_dt.astype(jnp.float32))[:, None]
    lam_bar = jnp.exp(lam * dt)
    b_c = lax.complex(b_re.astype(jnp.float32), b_im.astype(jnp.float32))
    c_c = lax.complex(c_re.astype(jnp.float32), c_im.astype(jnp.float32))
    b_bar = ((lam_bar - 1.0) / lam)[..., None] * b_c
    bu = jnp.einsum('gpc,bsgc->sbgp', b_bar, uf.astype(jnp.complex64))
    a = jnp.broadcast_to(lam_bar[None, None], (S, 1, G, SSM_STATE))

    def combine(left, right):
        a1, b1 = left
        a2, b2 = right
        return a1 * a2, a2 * b1 + b2

    _, xs = lax.associative_scan(combine, (a, bu), axis=0)
    y = jnp.einsum('gcp,sbgp->bsgc', c_c, xs).real + d_skip.astype(jnp.float32) * uf
    return y.astype(u.dtype)


def hybrid_mixer(h, g, w_in, a_re, a_im, log_dt, b_re, b_im, c_re, c_im, d_skip,
                 w_glu, w_proj_a, w_out):
    B, S, _ = h.shape
    n = rmsnorm(h, g)
    z = n @ w_in
    splits = [ATT_WIDTH, 2 * ATT_WIDTH, 3 * ATT_WIDTH, 3 * ATT_WIDTH + SSM_WIDTH,
              3 * ATT_WIDTH + SSM_WIDTH + D_MODEL]
    q, k, v, u, ga, gb = jnp.split(z, splits, axis=-1)
    to_heads = lambda t: t.reshape(B, S, ATT_HEADS, ATT_HEAD_DIM).transpose(0, 2, 1, 3)
    ya = moba_attention(to_heads(q), to_heads(k), to_heads(v))
    ya = ya.transpose(0, 2, 1, 3).reshape(B, S, ATT_WIDTH) @ w_proj_a
    yb = s5_ssm(u.reshape(B, S, SSM_GROUPS, SSM_GROUP), a_re, a_im, log_dt,
                b_re, b_im, c_re, c_im, d_skip).reshape(B, S, SSM_WIDTH)
    zb = jax.nn.gelu(yb) @ w_glu
    yb = zb[..., :D_MODEL] * jax.nn.sigmoid(zb[..., D_MODEL:])
    merged = jax.nn.sigmoid(ga) * ya + jax.nn.sigmoid(gb) * yb
    return merged @ w_out


def cross_attention(h, mem, g, g_mem, w_xq, w_xkv, w_xo):
    B, S, _ = h.shape
    M = mem.shape[1]
    n = rmsnorm(h, g)
    mn = rmsnorm(mem, g_mem)
    q = (n @ w_xq).reshape(B, S, XATTN_HEADS, XATTN_HEAD_DIM)
    kv = mn @ w_xkv
    k = kv[..., :XATTN_WIDTH].reshape(B, M, XATTN_HEADS, XATTN_HEAD_DIM)
    v = kv[..., XATTN_WIDTH:].reshape(B, M, XATTN_HEADS, XATTN_HEAD_DIM)
    s = jnp.einsum('bshd,bmhd->bhsm', q, k).astype(jnp.float32) * (XATTN_HEAD_DIM ** -0.5)
    p = jax.nn.softmax(s, axis=-1).astype(v.dtype)
    o = jnp.einsum('bhsm,bmhd->bshd', p, v).reshape(B, S, XATTN_WIDTH)
    return o @ w_xo


def moe_ffn(x2, w_router, b_router, w_gu, b_gu, w_dn, b_dn):
    T, D = x2.shape
    logits = (x2 @ w_router + b_router).astype(jnp.float32)
    top_v, top_i = lax.top_k(logits, EXPERT_TOPK)
    gates = jax.nn.softmax(top_v, axis=-1)
    N = T * EXPERT_TOPK
    e_flat = top_i.reshape(N)
    order = jnp.argsort(e_flat)
    e_sorted = e_flat[order]
    tok_sorted = order // EXPERT_TOPK
    gate_sorted = gates.reshape(N)[order]
    counts = jnp.bincount(e_flat, length=N_EXPERTS)
    starts = jnp.cumsum(counts) - counts
    padded = ((counts + MOE_BLOCK - 1) // MOE_BLOCK) * MOE_BLOCK
    pends = jnp.cumsum(padded)
    pstarts = pends - padded
    dest = pstarts[e_sorted] + jnp.arange(N) - starts[e_sorted]
    nblk = -(-N // MOE_BLOCK) + N_EXPERTS
    buf = jnp.zeros((nblk * MOE_BLOCK, D), x2.dtype).at[dest].set(x2[tok_sorted])
    blk_expert = jnp.clip(jnp.searchsorted(pends, jnp.arange(nblk) * MOE_BLOCK, side='right'),
                          0, N_EXPERTS - 1)

    def expert_block(args):
        xb, e = args
        gu = xb @ w_gu[e] + b_gu[e]
        gate = jnp.minimum(gu[:, :D_FF], SWIGLU_LIMIT)
        up = jnp.clip(gu[:, D_FF:], -SWIGLU_LIMIT, SWIGLU_LIMIT)
        hid = (up + 1.0) * gate * jax.nn.sigmoid(SWIGLU_ALPHA * gate)
        return hid @ w_dn[e] + b_dn[e]

    out = lax.map(expert_block, (buf.reshape(nblk, MOE_BLOCK, D), blk_expert)).reshape(nblk * MOE_BLOCK, D)
    y = out[dest] * gate_sorted.astype(out.dtype)[:, None]
    return jax.ops.segment_sum(y, tok_sorted, num_segments=T)


def setup_inputs(seed: int = 0) -> dict:
    key = jax.random.key(seed)
    ks = jax.random.split(key, 32)
    L = DEPTH
    f32 = jnp.float32
    nrm = lambda k, shape, scale: jax.random.normal(k, shape, f32) * scale
    gain = lambda k, shape: 1.0 + 0.02 * jax.random.normal(k, shape, f32)
    return {
        "x": nrm(ks[0], (BATCH, SEQ, D_MODEL), 1.0),
        "mem": nrm(ks[1], (BATCH, MEM_LEN, D_MODEL), 1.0),
        "g_mix": gain(ks[2], (L, D_MODEL)),
        "w_in": nrm(ks[3], (L, D_MODEL, IN_WIDTH), D_MODEL ** -0.5),
        "a_re": -0.5 + nrm(ks[4], (L, SSM_GROUPS, SSM_STATE), 0.01),
        "a_im": math.pi * jnp.arange(SSM_STATE, dtype=f32)[None, None, :]
                + nrm(ks[5], (L, SSM_GROUPS, SSM_STATE), 0.01),
        "log_dt": jax.random.uniform(ks[6], (L, SSM_GROUPS), f32, math.log(1e-3), math.log(1e-1)),
        "b_re": nrm(ks[7], (L, SSM_GROUPS, SSM_STATE, SSM_GROUP), (2 * SSM_GROUP) ** -0.5),
        "b_im": nrm(ks[8], (L, SSM_GROUPS, SSM_STATE, SSM_GROUP), (2 * SSM_GROUP) ** -0.5),
        "c_re": nrm(ks[9], (L, SSM_GROUPS, SSM_GROUP, SSM_STATE), (2 * SSM_STATE) ** -0.5),
        "c_im": nrm(ks[10], (L, SSM_GROUPS, SSM_GROUP, SSM_STATE), (2 * SSM_STATE) ** -0.5),
        "d_skip": nrm(ks[11], (L, SSM_GROUPS, SSM_GROUP), 1.0),
        "w_glu": nrm(ks[12], (L, SSM_WIDTH, 2 * D_MODEL), SSM_WIDTH ** -0.5),
        "w_proj_a": nrm(ks[13], (L, ATT_WIDTH, D_MODEL), ATT_WIDTH ** -0.5),
        "w_out": nrm(ks[14], (L, D_MODEL, D_MODEL), D_MODEL ** -0.5),
        "g_xattn": gain(ks[15], (L, D_MODEL)),
        "g_mem": gain(ks[16], (L, D_MODEL)),
        "w_xq": nrm(ks[17], (L, D_MODEL, XATTN_WIDTH), D_MODEL ** -0.5),
        "w_xkv": nrm(ks[18], (L, D_MODEL, 2 * XATTN_WIDTH), D_MODEL ** -0.5),
        "w_xo": nrm(ks[19], (L, XATTN_WIDTH, D_MODEL), XATTN_WIDTH ** -0.5),
        "g_moe": gain(ks[20], (L, D_MODEL)),
        "w_router": nrm(ks[21], (L, D_MODEL, N_EXPERTS), D_MODEL ** -0.5),
        "b_router": nrm(ks[22], (L, N_EXPERTS), 0.01),
        "w_gu": nrm(ks[23], (L, N_EXPERTS, D_MODEL, 2 * D_FF), D_MODEL ** -0.5),
        "b_gu": nrm(ks[24], (L, N_EXPERTS, 2 * D_FF), 0.01),
        "w_dn": nrm(ks[25], (L, N_EXPERTS, D_FF, D_MODEL), D_FF ** -0.5),
        "b_dn": nrm(ks[26], (L, N_EXPERTS, D_MODEL), 0.01),
        "g_final": gain(ks[27], (D_MODEL,)),
    }


def reference(x, mem, g_mix, w_in, a_re, a_im, log_dt, b_re, b_im, c_re, c_im, d_skip,
              w_glu, w_proj_a, w_out, g_xattn, g_mem, w_xq, w_xkv, w_xo,
              g_moe, w_router, b_router, w_gu, b_gu, w_dn, b_dn, g_final):
    h = x
    for l in range(DEPTH):
        h = h + hybrid_mixer(h, g_mix[l], w_in[l], a_re[l], a_im[l], log_dt[l], b_re[l], b_im[l],
                             c_re[l], c_im[l], d_skip[l], w_glu[l], w_proj_a[l], w_out[l])
        h = h + cross_attention(h, mem, g_xattn[l], g_mem[l], w_xq[l], w_xkv[l], w_xo[l])
        n = rmsnorm(h, g_moe[l]).reshape(-1, D_MODEL)
        h = h + moe_ffn(n, w_router[l], b_router[l], w_gu[l], b_gu[l], w_dn[l], b_dn[l]).reshape(h.shape)
    return rmsnorm(h, g_final)
```

```cpp
#include <hip/hip_runtime.h>
#include <cstdio>
#include <cstdint>

#ifndef MK_N_LAUNCHES
#define MK_N_LAUNCHES 0
#endif

#define GAS __attribute__((address_space(1)))
#define LAS __attribute__((address_space(3)))
typedef unsigned short bf16_t;
typedef short bf16x8 __attribute__((ext_vector_type(8)));
typedef float f32x4 __attribute__((ext_vector_type(4)));
typedef float f32x2 __attribute__((ext_vector_type(2)));
typedef unsigned u32x4 __attribute__((ext_vector_type(4)));
typedef unsigned u32x2 __attribute__((ext_vector_type(2)));

constexpr int NB = 4, SEQ = 8192, DM = 1024, T_ = NB * SEQ;
constexpr int AW = 512, NH = 8, HD = 64, MBLK = 256, NBLK = SEQ / MBLK, MTOPK = 3;
constexpr int SW = 512, SGC = 16, NG = 32, SP = 64;
constexpr int INW = 4096;
constexpr int MEML = 256, XH = 4, XD = 128, XW = 512;
constexpr int NE = 32, ETOPK = 4, DFF = 1024;
constexpr float RMS_EPS = 1e-6f;
constexpr float LOG2E = 1.4426950408889634f;
constexpr float QSCALE = 0.125f * LOG2E;
constexpr float XSCALE = 0.08838834764831845f * LOG2E;
constexpr int HID_ROWS = ETOPK * T_ + NE * 256;

constexpr size_t MiB = 1u << 20;
constexpr size_t WS_WIN = 0 * MiB, WS_WGLU = 8 * MiB, WS_WPA = 10 * MiB, WS_WOUT = 11 * MiB, WS_WXQ = 13 * MiB, WS_WXKV = 14 * MiB, WS_WXO = 16 * MiB,
                 WS_WGU = 17 * MiB, WS_WDN = 145 * MiB;
constexpr size_t WS_CTL = 209 * MiB, CTL_ZERO_BYTES = 1 * MiB;
constexpr size_t WS_RSTD0 = 210 * MiB;
constexpr size_t WS_RSTD2 = WS_RSTD0 + 128 * 1024;
constexpr size_t WS_KMEAN = WS_RSTD2 + 128 * 1024;
constexpr size_t WS_TKG = WS_KMEAN + 256 * 1024;
constexpr size_t WS_SSQ1 = 211 * MiB;
constexpr size_t WS_SSQ2 = 213 * MiB;
constexpr size_t WS_ROWLIST = 215 * MiB;
constexpr size_t WS_MN = 219 * MiB;
constexpr size_t WS_MKV = 221 * MiB;
constexpr size_t WS_H = 256 * MiB;
constexpr size_t WS_HB = 384 * MiB;
constexpr size_t WS_HID = 448 * MiB;
constexpr size_t WS_Y = 720 * MiB;
constexpr size_t WS_END = 976 * MiB;
constexpr size_t WS_XB = 448 * MiB, WS_Q = 512 * MiB, WS_K = 544 * MiB, WS_V = 576 * MiB, WS_U = 608 * MiB, WS_ATT = 640 * MiB, WS_YB = 672 * MiB;
constexpr size_t WS_SGA = 720 * MiB, WS_SGB = 784 * MiB, WS_YB2S = 848 * MiB, WS_MERGED = 912 * MiB;
constexpr size_t WS_XQ = 448 * MiB, WS_XO = 480 * MiB;
static_assert(WS_HID + (size_t)HID_ROWS * DFF * 2 <= WS_Y, "HID fits");
constexpr int CW_TMO = 0, CW_CNT = 64  , CW_BAR = 4096;

constexpr int RING_BYTES = 131072;
constexpr int GIDX_OFF = RING_BYTES, GIDX_UNITS = 24;
constexpr int MISC_OFF = GIDX_OFF + GIDX_UNITS * 1024;
constexpr int LDS_BYTES = 163840;

#define RLX_AGENT __ATOMIC_RELAXED, __HIP_MEMORY_SCOPE_AGENT
__device__ __forceinline__ unsigned f2bf(float f) { unsigned u = __builtin_bit_cast(unsigned, f); return (u + 0x7fffu + ((u >> 16) & 1u)) >> 16; }
__device__ __forceinline__ unsigned pk2(float lo, float hi) { return f2bf(lo) | (f2bf(hi) << 16); }
__device__ __forceinline__ float bf2f(unsigned short b) { return __builtin_bit_cast(float, (unsigned)b << 16); }
__device__ __forceinline__ float bflo(unsigned w) { return __builtin_bit_cast(float, w << 16); }
__device__ __forceinline__ float bfhi(unsigned w) { return __builtin_bit_cast(float, w & 0xffff0000u); }
__device__ __forceinline__ float wave_sum(float v) {
#pragma unroll
    for (int o = 1; o < 64; o <<= 1) v += __shfl_xor(v, o);
    return v;
}
__device__ __forceinline__ float fsigmoid(float x) { return __builtin_amdgcn_rcpf(1.0f + __builtin_amdgcn_exp2f(-x * LOG2E)); }
__device__ __forceinline__ float gelu_tanh(float x) {
    const float u = 0.7978845608028654f * (x + 0.044715f * x * x * x);
    return x * fsigmoid(2.0f * u);
}

namespace pg8 {
constexpr int BM = 256, BK = 64, HALF = 128, HTB = HALF * BK * 2, STAGE_BYTES = 8 * HTB;
__host__ __device__ __forceinline__ int lds_byte(int r, int c) { const int st = (r >> 4) * 2 + (c >> 5), rr = r & 15, cc = c & 31, ob = rr * 64 + cc * 2; return st * 1024 + (ob ^ (((ob >> 9) & 1) << 5)); }
__host__ __device__ __forceinline__ void stage_rc(int b, int& R, int& C) { const int st = b / 1024, sb = b % 1024, swz = sb ^ (((sb >> 9) & 1) << 5); R = (st >> 1) * 16 + swz / 64; C = (st & 1) * 32 + (swz % 64) / 2; }
__host__ __device__ __forceinline__ int perm32(int rho) { const int n = rho >> 4, i = rho & 15; return 8 * (i >> 2) + 4 * n + (i & 3); }

struct Unit { int pm, pn, e, mi, ui; };
struct Gemm { const bf16_t* A; const bf16_t* Bt; int K; size_t b_estride; };

struct PatchOrder {
    int nM, nN, PM, PN, x, j, ok;
    __device__ __forceinline__ void init(int nM_, int nN_, int PN_, int G, int c) { nM = nM_; nN = nN_; PN = PN_; PM = (G / 8) / PN_; x = c & 7; j = c >> 3; ok = ((G & 7) == 0) && (PM * PN == G / 8) && (nN % PN == 0); if (!ok) { x = c; j = G; } }
    __device__ __forceinline__ bool next(int i, Unit& u) const {
        if (!ok) { const long L = (long)i * j + x; if (L >= (long)nM * nN) return false; u.pm = (int)(L / nN); u.pn = (int)(L % nN); u.e = 0; u.mi = u.pm; u.ui = i; return true; }
        const int p = 8 * i + x, npn = nN / PN, pmb = p / npn, pnb = p % npn;
        u.pm = pmb * PM + (j % PM); u.pn = pnb * PN + (j / PM); u.e = 0; u.mi = u.pm; u.ui = i;
        return u.pm < nM;
    }
};

__device__ __forceinline__ unsigned cvt_pk_bf16(float lo, float hi) { unsigned r; asm volatile("v_cvt_pk_bf16_f32 %0, %1, %2" : "=v"(r) : "v"(lo), "v"(hi)); return r; }

template <class Epi, class Sched, bool GATHER>
__device__ __forceinline__ void gemm_phase(LAS unsigned char* lds, const Gemm g, const Sched& S, const Epi& E, const LAS int* gidx) {
    const int tid = threadIdx.x, wid = __builtin_amdgcn_readfirstlane(tid >> 6), lane = tid & 63, wr = wid >> 2, wc = wid & 3, fr = lane & 15, fq = lane >> 4;
    const int K = g.K, nt = K / BK;
    int Ra[2], Ca[2]; unsigned voffB[2];
#pragma unroll
    for (int i = 0; i < 2; ++i) { int R, C; stage_rc(tid * 16 + i * 8192, R, C); const int Rb = Epi::PERM ? ((R & ~31) + perm32(R & 31)) : R;
        Ra[i] = R; Ca[i] = C; voffB[i] = (unsigned)(Rb * K + C) * 2u; }
    const size_t kstep = (size_t)(BK * 2);
    const size_t hstep = (size_t)HALF * K * 2;
    const size_t tstep = 2 * hstep;
    const unsigned ldsw = (unsigned)wid * 1024u;
    const int aoff = lds_byte(wr * 64 + fr, fq * 8), boff = lds_byte(wc * 32 + fr, fq * 8);
#define PG8_SA(b, h) (((b) * 2 + (h)) * HTB)
#define PG8_SB(b, h) ((4 + (b) * 2 + (h)) * HTB)
#define PG8_STAGE(bufoff, gbase, voff) do { _Pragma("unroll") for (int _i = 0; _i < 2; ++_i) \
        __builtin_amdgcn_global_load_lds((const unsigned*)((const char*)(gbase) + (voff)[_i]), (LAS unsigned*)(lds + (bufoff) + ldsw + _i * 8192), 16, 0, 0); } while (0)
#define PG8_LDA(dst, b, h) do { _Pragma("unroll") for (int m = 0; m < 4; ++m) _Pragma("unroll") for (int k = 0; k < 2; ++k) dst[m][k] = *(const LAS bf16x8*)(lds + PG8_SA(b, h) + aoff + m * 2048 + k * 1024); } while (0)
#define PG8_LDB(dst, b, h) do { _Pragma("unroll") for (int n = 0; n < 2; ++n) _Pragma("unroll") for (int k = 0; k < 2; ++k) dst[n][k] = *(const LAS bf16x8*)(lds + PG8_SB(b, h) + boff + n * 2048 + k * 1024); } while (0)
#define PG8_MMA(ai, bj, At, Bt) do { __builtin_amdgcn_s_setprio(1); _Pragma("unroll") for (int m = 0; m < 4; ++m) _Pragma("unroll") for (int n = 0; n < 2; ++n) _Pragma("unroll") for (int k = 0; k < 2; ++k) \
        acc[ai][bj][m][n] = __builtin_amdgcn_mfma_f32_16x16x32_bf16(Bt[n][k], At[m][k], acc[ai][bj][m][n], 0, 0, 0); __builtin_amdgcn_s_setprio(0); } while (0)
#define PG8_WAIT_V(n) asm volatile("s_waitcnt vmcnt(" #n ")" ::: "memory")
#define PG8_WAIT_L(n) asm volatile("s_waitcnt lgkmcnt(" #n ")" ::: "memory")
#define PG8_BAR __builtin_amdgcn_s_barrier()
#define PG8_SCHED __builtin_amdgcn_sched_barrier(0)
#define PG8_VOA(dst, u) do { _Pragma("unroll") for (int _h = 0; _h < 2; ++_h) _Pragma("unroll") for (int _i = 0; _i < 2; ++_i) { \
        const int _row = GATHER ? gidx[(u).ui * 256 + _h * HALF + Ra[_i]] : (_h * HALF + Ra[_i]); dst[_h][_i] = (unsigned)(_row * K + Ca[_i]) * 2u; } } while (0)
    Unit cur, nxt; int ui = 0;
    if (!S.next(0, cur)) return;
    f32x4 acc[2][2][4][2];
#pragma unroll
    for (int a = 0; a < 2; ++a)
#pragma unroll
        for (int b = 0; b < 2; ++b)
#pragma unroll
            for (int m = 0; m < 4; ++m)
#pragma unroll
                for (int n = 0; n < 2; ++n) acc[a][b][m][n] = (f32x4){0.f, 0.f, 0.f, 0.f};
    bf16x8 At[4][2], B0[2][2], B1[2][2];
    unsigned voA[2][2], voN[2][2];
    PG8_VOA(voA, cur);
    const char* cA = (const char*)g.A + (GATHER ? (size_t)0 : (size_t)cur.pm * tstep);
    const char* cB = (const char*)g.Bt + ((size_t)cur.e * g.b_estride) * 2 + (size_t)cur.pn * tstep;
    PG8_STAGE(PG8_SB(0, 0), cB, voffB); PG8_STAGE(PG8_SB(0, 1), cB + hstep, voffB); PG8_STAGE(PG8_SA(0, 0), cA, voA[0]); PG8_STAGE(PG8_SA(0, 1), cA, voA[1]);
    if (wr == 1) PG8_BAR;
    PG8_WAIT_V(2); PG8_BAR;
    PG8_STAGE(PG8_SB(1, 0), cB + kstep, voffB); PG8_STAGE(PG8_SA(1, 0), cA + kstep, voA[0]); PG8_STAGE(PG8_SB(1, 1), cB + hstep + kstep, voffB);
    PG8_WAIT_V(6); PG8_BAR;
    for (;;) {
        const bool has_next = S.next(ui + 1, nxt);
        const char* nA = cA; const char* nB = cB;
#pragma unroll
        for (int h = 0; h < 2; ++h)
#pragma unroll
            for (int i = 0; i < 2; ++i) voN[h][i] = voA[h][i];
        if (has_next) { nA = (const char*)g.A + (GATHER ? (size_t)0 : (size_t)nxt.pm * tstep); nB = (const char*)g.Bt + ((size_t)nxt.e * g.b_estride) * 2 + (size_t)nxt.pn * tstep; PG8_VOA(voN, nxt); }
        for (int t = 0; t < nt; t += 2) {
            const bool last = (t == nt - 2);
            const char* a1 = cA + (size_t)(t + 1) * kstep;
            const char* a2 = last ? nA : cA + (size_t)(t + 2) * kstep; const char* b2 = last ? nB : cB + (size_t)(t + 2) * kstep;
            const char* a3 = a2 + kstep; const char* b3 = b2 + kstep;
            unsigned vo2[2][2];
#pragma unroll
            for (int h = 0; h < 2; ++h)
#pragma unroll
                for (int i = 0; i < 2; ++i) vo2[h][i] = last ? voN[h][i] : voA[h][i];
            PG8_LDB(B0, 0, 0); PG8_LDB(B1, 0, 1); PG8_SCHED; PG8_LDA(At, 0, 0); PG8_STAGE(PG8_SA(1, 1), a1, voA[1]);
            PG8_WAIT_V(8); PG8_WAIT_L(0); PG8_BAR; PG8_MMA(0, 0, At, B0); PG8_MMA(0, 1, At, B1); PG8_BAR; PG8_SCHED;
            PG8_LDA(At, 0, 1); PG8_STAGE(PG8_SB(0, 0), b2, voffB); PG8_STAGE(PG8_SB(0, 1), b2 + hstep, voffB); PG8_STAGE(PG8_SA(0, 0), a2, vo2[0]);
            PG8_WAIT_V(8); PG8_WAIT_L(0); PG8_BAR; PG8_MMA(1, 0, At, B0); PG8_MMA(1, 1, At, B1); PG8_BAR; PG8_SCHED;
            PG8_LDB(B0, 1, 0); PG8_LDB(B1, 1, 1); PG8_SCHED; PG8_LDA(At, 1, 0); PG8_STAGE(PG8_SA(0, 1), a2, vo2[1]);
            PG8_WAIT_V(8); PG8_WAIT_L(0); PG8_BAR; PG8_MMA(0, 0, At, B0); PG8_MMA(0, 1, At, B1); PG8_BAR; PG8_SCHED;
            PG8_LDA(At, 1, 1); PG8_STAGE(PG8_SB(1, 0), b3, voffB); PG8_STAGE(PG8_SB(1, 1), b3 + hstep, voffB); PG8_STAGE(PG8_SA(1, 0), a3, vo2[0]);
            PG8_WAIT_V(8); PG8_WAIT_L(0); PG8_BAR; PG8_MMA(1, 0, At, B0); PG8_MMA(1, 1, At, B1); PG8_BAR; PG8_SCHED;
        }
        if (wr == 0) PG8_BAR;
        E(acc, cur, wr, wc, fr, fq);
        if (!has_next) break;
#pragma unroll
        for (int a = 0; a < 2; ++a)
#pragma unroll
            for (int b = 0; b < 2; ++b)
#pragma unroll
                for (int m = 0; m < 4; ++m)
#pragma unroll
                    for (int n = 0; n < 2; ++n) acc[a][b][m][n] = (f32x4){0.f, 0.f, 0.f, 0.f};
        cur = nxt; cA = nA; cB = nB; ++ui;
#pragma unroll
        for (int h = 0; h < 2; ++h)
#pragma unroll
            for (int i = 0; i < 2; ++i) voA[h][i] = voN[h][i];
        if (wr == 1) PG8_BAR;
    }
    PG8_WAIT_V(0);
    PG8_BAR;
#undef PG8_SA
#undef PG8_SB
#undef PG8_STAGE
#undef PG8_LDA
#undef PG8_LDB
#undef PG8_MMA
#undef PG8_WAIT_V
#undef PG8_WAIT_L
#undef PG8_BAR
#undef PG8_SCHED
#undef PG8_VOA
}

typedef const f32x4 (&AccRef)[2][2][4][2];
#define EPI_ROWS for (int ai = 0; ai < 2; ++ai) _Pragma("unroll") for (int m = 0; m < 4; ++m)

struct EpiInProj {
    static constexpr bool PERM = true;
    const float* rstd; bf16_t *Q, *Kb, *V, *U, *SGA, *SGB;
    __device__ __forceinline__ void operator()(AccRef acc, const Unit& u, int wr, int wc, int fr, int fq) const {
        bf16_t* dst; int ld, colt; bool sig = false; float sc = 1.f;
        if (u.pn < 2) { dst = Q; ld = AW; colt = u.pn * 256; sc = QSCALE; }
        else if (u.pn < 4) { dst = Kb; ld = AW; colt = (u.pn - 2) * 256; }
        else if (u.pn < 6) { dst = V; ld = AW; colt = (u.pn - 4) * 256; }
        else if (u.pn < 8) { dst = U; ld = AW; colt = (u.pn - 6) * 256; }
        else if (u.pn < 12) { dst = SGA; ld = DM; colt = (u.pn - 8) * 256; sig = true; }
        else { dst = SGB; ld = DM; colt = (u.pn - 12) * 256; sig = true; }
        const int row0 = u.pm * BM + wr * 64 + fr, col0 = colt + wc * 32 + 8 * fq;
#pragma unroll
        EPI_ROWS { const int row = row0 + ai * HALF + m * 16; const float rs = rstd[row] * sc; bf16_t* rowp = dst + (size_t)row * ld + col0;
#pragma unroll
            for (int bj = 0; bj < 2; ++bj) { f32x4 v0 = acc[ai][bj][m][0] * rs, v1 = acc[ai][bj][m][1] * rs;
                if (sig) {
#pragma unroll
                    for (int e = 0; e < 4; ++e) { v0[e] = fsigmoid(v0[e]); v1[e] = fsigmoid(v1[e]); } }
                u32x4 w; w.x = cvt_pk_bf16(v0[0], v0[1]); w.y = cvt_pk_bf16(v0[2], v0[3]); w.z = cvt_pk_bf16(v1[0], v1[1]); w.w = cvt_pk_bf16(v1[2], v1[3]);
                *(u32x4*)(rowp + bj * HALF) = w; } }
    }
};
struct EpiStore {
    static constexpr bool PERM = true;
    bf16_t* O; int ld;
    __device__ __forceinline__ void operator()(AccRef acc, const Unit& u, int wr, int wc, int fr, int fq) const {
        const int row0 = u.pm * BM + wr * 64 + fr, col0 = u.pn * BM + wc * 32 + 8 * fq;
#pragma unroll
        EPI_ROWS { bf16_t* rowp = O + (size_t)(row0 + ai * HALF + m * 16) * ld + col0;
#pragma unroll
            for (int bj = 0; bj < 2; ++bj) { const f32x4 v0 = acc[ai][bj][m][0], v1 = acc[ai][bj][m][1];
                u32x4 w; w.x = cvt_pk_bf16(v0[0], v0[1]); w.y = cvt_pk_bf16(v0[2], v0[3]); w.z = cvt_pk_bf16(v1[0], v1[1]); w.w = cvt_pk_bf16(v1[2], v1[3]);
                *(u32x4*)(rowp + bj * HALF) = w; } }
    }
};
struct EpiGlu {
    static constexpr bool PERM = true;
    const bf16_t* SGB; bf16_t* O;
    __device__ __forceinline__ void operator()(AccRef acc, const Unit& u, int wr, int wc, int fr, int fq) const {
        const int row0 = u.pm * BM + wr * 64 + fr, col0 = u.pn * HALF + wc * 32 + 8 * fq;
#pragma unroll
        EPI_ROWS { const size_t off = (size_t)(row0 + ai * HALF + m * 16) * DM + col0; const u32x4 s = *(const u32x4*)(SGB + off);
            const f32x4 v0 = acc[ai][0][m][0], v1 = acc[ai][0][m][1], g0 = acc[ai][1][m][0], g1 = acc[ai][1][m][1];
            float o[8];
#pragma unroll
            for (int e = 0; e < 4; ++e) { o[e] = v0[e] * fsigmoid(g0[e]); o[4 + e] = v1[e] * fsigmoid(g1[e]); }
            o[0] *= bflo(s.x); o[1] *= bfhi(s.x); o[2] *= bflo(s.y); o[3] *= bfhi(s.y); o[4] *= bflo(s.z); o[5] *= bfhi(s.z); o[6] *= bflo(s.w); o[7] *= bfhi(s.w);
            u32x4 w; w.x = cvt_pk_bf16(o[0], o[1]); w.y = cvt_pk_bf16(o[2], o[3]); w.z = cvt_pk_bf16(o[4], o[5]); w.w = cvt_pk_bf16(o[6], o[7]);
            *(u32x4*)(O + off) = w; }
    }
};
struct EpiMerge {
    static constexpr bool PERM = true;
    const bf16_t* SGA; const bf16_t* Y2; bf16_t* O;
    __device__ __forceinline__ void operator()(AccRef acc, const Unit& u, int wr, int wc, int fr, int fq) const {
        const int row0 = u.pm * BM + wr * 64 + fr, col0 = u.pn * BM + wc * 32 + 8 * fq;
#pragma unroll
        EPI_ROWS {
#pragma unroll
            for (int bj = 0; bj < 2; ++bj) { const size_t off = (size_t)(row0 + ai * HALF + m * 16) * DM + col0 + bj * HALF;
                const u32x4 s = *(const u32x4*)(SGA + off), y = *(const u32x4*)(Y2 + off); const f32x4 v0 = acc[ai][bj][m][0], v1 = acc[ai][bj][m][1];
                u32x4 w; w.x = cvt_pk_bf16(bflo(s.x) * v0[0] + bflo(y.x), bfhi(s.x) * v0[1] + bfhi(y.x)); w.y = cvt_pk_bf16(bflo(s.y) * v0[2] + bflo(y.y), bfhi(s.y) * v0[3] + bfhi(y.y));
                w.z = cvt_pk_bf16(bflo(s.z) * v1[0] + bflo(y.z), bfhi(s.z) * v1[1] + bfhi(y.z)); w.w = cvt_pk_bf16(bflo(s.w) * v1[2] + bflo(y.w), bfhi(s.w) * v1[3] + bfhi(y.w));
                *(u32x4*)(O + off) = w; } }
    }
};
struct EpiResid {
    static constexpr bool PERM = false;
    const float* base; float* H; bf16_t* HB; float* SSQ;
    __device__ __forceinline__ void operator()(AccRef acc, const Unit& u, int wr, int wc, int fr, int fq) const {
        const int row0 = u.pm * BM + wr * 64 + fr, col0 = u.pn * BM + wc * 32 + 4 * fq;
#pragma unroll
        EPI_ROWS { const int row = row0 + ai * HALF + m * 16; const size_t off = (size_t)row * DM + col0; float ss = 0.f;
#pragma unroll
            for (int bj = 0; bj < 2; ++bj)
#pragma unroll
                for (int n = 0; n < 2; ++n) { const size_t o2 = off + bj * HALF + n * 16; const f32x4 h = *(const f32x4*)(base + o2) + acc[ai][bj][m][n];
                    *(f32x4*)(H + o2) = h; u32x2 w; w.x = cvt_pk_bf16(h[0], h[1]); w.y = cvt_pk_bf16(h[2], h[3]); *(u32x2*)(HB + o2) = w;
                    ss += (h[0] * h[0] + h[1] * h[1]) + (h[2] * h[2] + h[3] * h[3]); }
            ss += __shfl_xor(ss, 16); ss += __shfl_xor(ss, 32);
            if (fq == 0) SSQ[(size_t)row * 16 + u.pn * 4 + wc] = ss; }
    }
};
struct EpiXq {
    static constexpr bool PERM = true;
    const float* SSQ; bf16_t* O;
    __device__ __forceinline__ void operator()(AccRef acc, const Unit& u, int wr, int wc, int fr, int fq) const {
        const int row0 = u.pm * BM + wr * 64 + fr, col0 = u.pn * BM + wc * 32 + 8 * fq;
#pragma unroll
        EPI_ROWS { const int row = row0 + ai * HALF + m * 16; const f32x4* sp = (const f32x4*)(SSQ + (size_t)row * 16);
            const f32x4 a = sp[0] + sp[1] + sp[2] + sp[3]; const float rs = __builtin_amdgcn_rsqf(((a[0] + a[1]) + (a[2] + a[3])) * (1.0f / DM) + RMS_EPS) * XSCALE;
            bf16_t* rowp = O + (size_t)row * XW + col0;
#pragma unroll
            for (int bj = 0; bj < 2; ++bj) { const f32x4 v0 = acc[ai][bj][m][0] * rs, v1 = acc[ai][bj][m][1] * rs;
                u32x4 w; w.x = cvt_pk_bf16(v0[0], v0[1]); w.y = cvt_pk_bf16(v0[2], v0[3]); w.z = cvt_pk_bf16(v1[0], v1[1]); w.w = cvt_pk_bf16(v1[2], v1[3]);
                *(u32x4*)(rowp + bj * HALF) = w; } }
    }
};
struct EpiMoe1 {
    static constexpr bool PERM = true;
    const float* rstd2; const float* bgu; bf16_t* HID; const LAS int* gidx;
    __device__ __forceinline__ void operator()(AccRef acc, const Unit& u, int wr, int wc, int fr, int fq) const {
        const int rl0 = wr * 64 + fr, col0 = u.pn * HALF + wc * 32 + 8 * fq; const float* bg = bgu + (size_t)u.e * (2 * DFF) + col0;
        const f32x4 bg0 = *(const f32x4*)(bg), bg1 = *(const f32x4*)(bg + 4), bu0 = *(const f32x4*)(bg + DFF), bu1 = *(const f32x4*)(bg + DFF + 4);
#pragma unroll
        EPI_ROWS { const int rl = rl0 + ai * HALF + m * 16; const float rs = rstd2[gidx[u.ui * 256 + rl]];
            const f32x4 g0 = acc[ai][0][m][0] * rs + bg0, g1 = acc[ai][0][m][1] * rs + bg1, p0 = acc[ai][1][m][0] * rs + bu0, p1 = acc[ai][1][m][1] * rs + bu1;
            float o[8];
#pragma unroll
            for (int e = 0; e < 4; ++e) { const float ga = fminf(g0[e], 7.0f), gb = fminf(g1[e], 7.0f), ua = fminf(fmaxf(p0[e], -7.0f), 7.0f), ub = fminf(fmaxf(p1[e], -7.0f), 7.0f);
                o[e] = (ua + 1.0f) * ga * fsigmoid(1.702f * ga); o[4 + e] = (ub + 1.0f) * gb * fsigmoid(1.702f * gb); }
            u32x4 w; w.x = cvt_pk_bf16(o[0], o[1]); w.y = cvt_pk_bf16(o[2], o[3]); w.z = cvt_pk_bf16(o[4], o[5]); w.w = cvt_pk_bf16(o[6], o[7]);
            *(u32x4*)(HID + (size_t)(u.pm * BM + rl) * DFF + col0) = w; }
    }
};
struct EpiMoe2 {
    static constexpr bool PERM = true;
    const float* bdn; const float* tkg; const int* rowlist; const unsigned* cnt; bf16_t* Y;
    __device__ __forceinline__ void operator()(AccRef acc, const Unit& u, int wr, int wc, int fr, int fq) const {
        const int rl0 = wr * 64 + fr, col0 = u.pn * BM + wc * 32 + 8 * fq; const float* bd = bdn + (size_t)u.e * DM + col0; const int ce = (int)cnt[u.e];
        f32x4 bv[2][2];
#pragma unroll
        for (int bj = 0; bj < 2; ++bj)
#pragma unroll
            for (int n = 0; n < 2; ++n) bv[bj][n] = *(const f32x4*)(bd + bj * HALF + 4 * n);
#pragma unroll
        EPI_ROWS { const int rank = u.mi * BM + rl0 + ai * HALF + m * 16;
            if (rank < ce) { const int dest = rowlist[(size_t)u.e * T_ + rank]; const float gt = tkg[dest]; bf16_t* rowp = Y + (size_t)dest * DM + col0;
#pragma unroll
                for (int bj = 0; bj < 2; ++bj) { const f32x4 v0 = (acc[ai][bj][m][0] + bv[bj][0]) * gt, v1 = (acc[ai][bj][m][1] + bv[bj][1]) * gt;
                    u32x4 w; w.x = cvt_pk_bf16(v0[0], v0[1]); w.y = cvt_pk_bf16(v0[2], v0[3]); w.z = cvt_pk_bf16(v1[0], v1[1]); w.w = cvt_pk_bf16(v1[2], v1[3]);
                    *(u32x4*)(rowp + bj * HALF) = w; } } }
    }
};
}

struct MoeOrder {
    pg8::PatchOrder P; const LAS int* pref;
    __device__ __forceinline__ bool next(int i, pg8::Unit& u) const {
        if (!P.next(i, u)) return false;
        int e = 0;
#pragma unroll 1
        for (int k = 1; k < NE; ++k) e += (pref[k] <= u.pm) ? 1 : 0;
        u.e = e; u.mi = u.pm - pref[e]; return true;
    }
};

#define XB_TMO      128
#define XB_XCNT(j)  (256  + 64 * (j))
#define XB_XSUB(j)  (1280 + 64 * (j))
#define XB_XGEN(j)  (2304 + 64 * (j))
#define XB_TOP      3328
#define XB_TOPGEN   3392
#define XCD_BAR_WORDS 3456
#define XB_SPIN_CAP (1u << 20)
__device__ __forceinline__ unsigned xb_ld(unsigned* p)              { return __hip_atomic_load(p, __ATOMIC_RELAXED, __HIP_MEMORY_SCOPE_AGENT); }
__device__ __forceinline__ unsigned xb_add(unsigned* p, unsigned v) { return __hip_atomic_fetch_add(p, v, __ATOMIC_RELAXED, __HIP_MEMORY_SCOPE_AGENT); }
__device__ __forceinline__ unsigned xb_xcc_id() { return (unsigned)__builtin_amdgcn_s_getreg((3 << 11) | 20) & 0xFu; }
#define XB_SPIN(cond, bar) do { unsigned _sp = 0; while (cond) { __builtin_amdgcn_s_sleep(1); \
    if ((++_sp & 255u) == 0u) { if (xb_ld(&(bar)[XB_TMO])) break; if (_sp > XB_SPIN_CAP) { atomicAdd(&(bar)[XB_TMO], 1u); break; } } } } while (0)
struct XcdBarrier { unsigned* bar; unsigned x; volatile LAS unsigned* st; };
__device__ __forceinline__ XcdBarrier xcd_barrier_post(unsigned* bar, volatile LAS unsigned* st) {
    XcdBarrier b; b.bar = bar; b.x = xb_xcc_id(); b.st = st;
    if (threadIdx.x == 0) (void)xb_add(&bar[XB_XCNT(b.x)], 1u);
    return b;
}
__device__ __forceinline__ void xcd_barrier_complete(unsigned* bar, unsigned x, unsigned& nloc, unsigned& nx) {
    const unsigned G = gridDim.x * gridDim.y * gridDim.z;
    unsigned sum, cnt, mine, sp = 0u;
    for (;;) {
        sum = 0u; cnt = 0u; mine = 0u;
#pragma unroll
        for (unsigned j = 0; j < 16; ++j) { const unsigned c = xb_ld(&bar[XB_XCNT(j)]); sum += c; cnt += (c > 0u) ? 1u : 0u; mine = (j == x) ? c : mine; }
        if (sum == G) break;
        __builtin_amdgcn_s_sleep(1);
        if ((++sp & 255u) == 0u) { if (xb_ld(&bar[XB_TMO])) break; if (sp > XB_SPIN_CAP) { atomicAdd(&bar[XB_TMO], 1u); break; } }
    }
    nloc = mine > 0u ? mine : 1u; nx = cnt > 0u ? cnt : 1u;
}
__device__ __forceinline__ void xcd_barrier(const XcdBarrier& b) {
    asm volatile("s_waitcnt vmcnt(0)" ::: "memory");
    __syncthreads();
    if (threadIdx.x == 0) {
        unsigned* bar = b.bar;
        __builtin_amdgcn_s_waitcnt(0);
        unsigned nloc = b.st[0], nx = b.st[1];
        if (nloc == 0u) { xcd_barrier_complete(bar, b.x, nloc, nx); b.st[0] = nloc; b.st[1] = nx; }
        const unsigned old = xb_add(&bar[XB_XSUB(b.x)], 1u);
        const unsigned gen = old / nloc;
        if (old + 1u == (gen + 1u) * nloc) {
            __builtin_amdgcn_fence(__ATOMIC_RELEASE, "agent");
            asm volatile("s_waitcnt vmcnt(0)" ::: "memory");
            const unsigned og = xb_add(&bar[XB_TOP], 1u);
            const unsigned tg = og / nx;
            if (og + 1u == (tg + 1u) * nx) xb_add(&bar[XB_TOPGEN], 1u);
            else XB_SPIN(xb_ld(&bar[XB_TOPGEN]) == tg, bar);
            __builtin_amdgcn_fence(__ATOMIC_ACQUIRE, "agent");
            xb_add(&bar[XB_XGEN(b.x)], 1u);
            asm volatile("s_waitcnt vmcnt(0)" ::: "memory");
        } else {
            XB_SPIN(xb_ld(&bar[XB_XGEN(b.x)]) == gen, bar);
            __builtin_amdgcn_fence(__ATOMIC_ACQUIRE, "agent");
            asm volatile("s_waitcnt vmcnt(0)" ::: "memory");
        }
    }
    __syncthreads();
}

struct Args { const float* in[28]; float* out; unsigned char* ws; int ph_lo, ph_hi; };
enum { I_X = 0, I_MEM, I_GMIX, I_WIN, I_ARE, I_AIM, I_LOGDT, I_BRE, I_BIM, I_CRE, I_CIM, I_DSKIP, I_WGLU, I_WPA, I_WOUT, I_GXATTN, I_GMEM, I_WXQ, I_WXKV, I_WXO,
       I_GMOE, I_WROUTER, I_BROUTER, I_WGU, I_BGU, I_WDN, I_BDN, I_GFINAL };

template <int MAP>
__device__ __forceinline__ void p0_transpose_item(const float* W, int K, int N, const float* gain, bf16_t* WT, LAS float* scr, int item, int lane) {
    const int nblk = N / 32, kb = item / nblk, nb = item % nblk, k0 = 64 * kb, n0 = 32 * nb;
#pragma unroll 8
    for (int i = 0; i < 32; ++i) { const int kk = 2 * i + (lane >> 5); float v = W[(size_t)(k0 + kk) * N + n0 + (lane & 31)]; if (gain) v *= gain[k0 + kk]; scr[kk * 33 + (lane & 31)] = v; }
    asm volatile("s_waitcnt lgkmcnt(0)" ::: "memory");
    const int c = lane & 7;
    const int nr0 = (MAP == 1) ? (256 * ((n0 % 1024) / 128) + 128 * (n0 / 1024) + (n0 % 128)) : n0;
#pragma unroll
    for (int j = 0; j < 4; ++j) { const int n = (lane >> 3) + 8 * j; const LAS float* s = scr + (8 * c) * 33 + n;
        u32x4 o; o.x = pk2(s[0 * 33], s[1 * 33]); o.y = pk2(s[2 * 33], s[3 * 33]); o.z = pk2(s[4 * 33], s[5 * 33]); o.w = pk2(s[6 * 33], s[7 * 33]);
        *(u32x4*)(WT + (size_t)(nr0 + n) * K + k0 + 8 * c) = o; }
    asm volatile("s_waitcnt lgkmcnt(0)" ::: "memory");
}
template <int MODE>
__device__ __forceinline__ float rms_row_to_bf16(const float* xrow, const float* gain, bf16_t* orow, int lane) {
    const f32x4* xr = (const f32x4*)xrow + lane;
    f32x4 v[4]; float s = 0.f;
#pragma unroll
    for (int j = 0; j < 4; ++j) { v[j] = xr[64 * j]; s += (v[j][0] * v[j][0] + v[j][1] * v[j][1]) + (v[j][2] * v[j][2] + v[j][3] * v[j][3]); }
    const float rstd = 1.0f / sqrtf(wave_sum(s) * (1.0f / DM) + RMS_EPS);
    u32x2* o8 = (u32x2*)orow + lane;
#pragma unroll
    for (int j = 0; j < 4; ++j) { f32x4 w = v[j];
        if (MODE == 1) { const f32x4 g = ((const f32x4*)gain)[lane + 64 * j]; w = w * rstd * g; }
        u32x2 o; o.x = pk2(w[0], w[1]); o.y = pk2(w[2], w[3]); o8[64 * j] = o; }
    return rstd;
}

struct Frame {
    LAS unsigned char* lds; int tid, lane, wave, G, bid;
    const float* in[28]; float* out; unsigned char* ws; unsigned* ctl;
};
#define WSP(type, off) ((type*)(F.ws + (off)))

__device__ __forceinline__ void phase_prologue(Frame& F) {
    LAS float* scr = (LAS float*)(F.lds + F.wave * 16384);
    const int gw = F.bid * 8 + F.wave, NGW = F.G * 8;
    for (int m = gw; m < T_; m += NGW) { const float r = rms_row_to_bf16<0>(F.in[I_X] + (size_t)m * DM, nullptr, WSP(bf16_t, WS_XB) + (size_t)m * DM, F.lane); if (F.lane == 0) WSP(float, WS_RSTD0)[m] = r; }
    for (int m = gw; m < NB * MEML; m += NGW) (void)rms_row_to_bf16<1>(F.in[I_MEM] + (size_t)m * DM, F.in[I_GMEM], WSP(bf16_t, WS_MN) + (size_t)m * DM, F.lane);
    constexpr int I_IN = (DM / 64) * (INW / 32), I_GLU = (SW / 64) * (2 * DM / 32), I_PA = (AW / 64) * (DM / 32), I_OUT = (DM / 64) * (DM / 32), I_XQ = (DM / 64) * (XW / 32),
                  I_XKV = (DM / 64) * (2 * XW / 32), I_XO = (XW / 64) * (DM / 32), I_GU1 = (DM / 64) * (2 * DFF / 32), I_DN1 = (DFF / 64) * (DM / 32);
    constexpr int NITEMS = I_IN + I_GLU + I_PA + I_OUT + I_XQ + I_XKV + I_XO + NE * (I_GU1 + I_DN1);
    for (int it = gw; it < NITEMS; it += NGW) {
        int r = it;
        if (r < I_IN) { p0_transpose_item<0>(F.in[I_WIN], DM, INW, F.in[I_GMIX], WSP(bf16_t, WS_WIN), scr, r, F.lane); continue; } r -= I_IN;
        if (r < I_GLU) { p0_transpose_item<1>(F.in[I_WGLU], SW, 2 * DM, nullptr, WSP(bf16_t, WS_WGLU), scr, r, F.lane); continue; } r -= I_GLU;
        if (r < I_PA) { p0_transpose_item<0>(F.in[I_WPA], AW, DM, nullptr, WSP(bf16_t, WS_WPA), scr, r, F.lane); continue; } r -= I_PA;
        if (r < I_OUT) { p0_transpose_item<0>(F.in[I_WOUT], DM, DM, nullptr, WSP(bf16_t, WS_WOUT), scr, r, F.lane); continue; } r -= I_OUT;
        if (r < I_XQ) { p0_transpose_item<0>(F.in[I_WXQ], DM, XW, F.in[I_GXATTN], WSP(bf16_t, WS_WXQ), scr, r, F.lane); continue; } r -= I_XQ;
        if (r < I_XKV) { p0_transpose_item<0>(F.in[I_WXKV], DM, 2 * XW, nullptr, WSP(bf16_t, WS_WXKV), scr, r, F.lane); continue; } r -= I_XKV;
        if (r < I_XO) { p0_transpose_item<0>(F.in[I_WXO], XW, DM, nullptr, WSP(bf16_t, WS_WXO), scr, r, F.lane); continue; } r -= I_XO;
        const int e = r / (I_GU1 + I_DN1); r -= e * (I_GU1 + I_DN1);
        if (r < I_GU1) p0_transpose_item<1>(F.in[I_WGU] + (size_t)e * DM * 2 * DFF, DM, 2 * DFF, F.in[I_GMOE], WSP(bf16_t, WS_WGU) + (size_t)e * 2 * DFF * DM, scr, r, F.lane);
        else p0_transpose_item<0>(F.in[I_WDN] + (size_t)e * DFF * DM, DFF, DM, nullptr, WSP(bf16_t, WS_WDN) + (size_t)e * DM * DFF, scr, r - I_GU1, F.lane);
    }
}

__device__ __forceinline__ void phase_kmean(Frame& F) {
    LAS float* red = (LAS float*)F.lds;
    const bf16_t* Kb = WSP(bf16_t, WS_K);
    for (int it = F.bid; it < NB * NH * NBLK; it += F.G) {
        const int j = it % NBLK, h = (it / NBLK) % NH, b = it / (NBLK * NH);
        const int col = F.tid & 63, rg = F.tid >> 6; float s = 0.f;
        const bf16_t* p = Kb + ((size_t)(b * SEQ + j * MBLK + rg * 32)) * AW + h * HD + col;
#pragma unroll 8
        for (int r = 0; r < 32; ++r) s += bf2f(p[(size_t)r * AW]);
        red[rg * 64 + col] = s;
        __syncthreads();
        if (F.tid < 64) { float t = 0.f;
#pragma unroll
            for (int k = 0; k < 8; ++k) t += red[k * 64 + F.tid];
            WSP(float, WS_KMEAN)[(size_t)it * HD + F.tid] = t * (1.0f / MBLK); }
        __syncthreads();
    }
}

__device__ __forceinline__ void phase_moba_simple(Frame& F) {
    LAS unsigned* Ks = (LAS unsigned*)F.lds;
    LAS unsigned* Vs = (LAS unsigned*)(F.lds + 32768);
    LAS float* km = (LAS float*)(F.lds + 65536);
    const bf16_t *Qb = WSP(bf16_t, WS_Q), *Kb = WSP(bf16_t, WS_K), *Vb = WSP(bf16_t, WS_V); bf16_t* Ob = WSP(bf16_t, WS_ATT);
    const int ql = F.tid >> 1, half = F.tid & 1;
    for (int it = F.bid; it < NB * NH * NBLK; it += F.G) {
        const int iblk = (NBLK - 1) - (it % NBLK), h = (it / NBLK) % NH, b = it / (NBLK * NH);
        __syncthreads();
        for (int k = F.tid; k < NBLK * HD; k += 512) km[k] = WSP(float, WS_KMEAN)[(size_t)((b * NH + h) * NBLK) * HD + k];
        float q[32];
        { const u32x4* qp = (const u32x4*)(Qb + (size_t)(b * SEQ + iblk * MBLK + ql) * AW + h * HD + half * 32);
#pragma unroll
          for (int c = 0; c < 4; ++c) { const u32x4 w = qp[c]; q[8 * c + 0] = bflo(w.x); q[8 * c + 1] = bfhi(w.x); q[8 * c + 2] = bflo(w.y); q[8 * c + 3] = bfhi(w.y); q[8 * c + 4] = bflo(w.z); q[8 * c + 5] = bfhi(w.z); q[8 * c + 6] = bflo(w.w); q[8 * c + 7] = bfhi(w.w); } }
        __syncthreads();
        float g0 = -3e38f, g1 = -3e38f, g2 = -3e38f; int s0 = -1, s1 = -1, s2 = -1;
        for (int j = 0; j < iblk; ++j) { float g = 0.f;
#pragma unroll
            for (int d = 0; d < 32; ++d) g += q[d] * km[j * HD + half * 32 + d];
            g += __shfl_xor(g, 1);
            if (g > g0) { g2 = g1; s2 = s1; g1 = g0; s1 = s0; g0 = g; s0 = j; } else if (g > g1) { g2 = g1; s2 = s1; g1 = g; s1 = j; } else if (g > g2) { g2 = g; s2 = j; } }
        float mx = -3e38f, l = 0.f, o[32];
#pragma unroll
        for (int d = 0; d < 32; ++d) o[d] = 0.f;
        for (int jb = 0; jb <= iblk; ++jb) {
            __syncthreads();
            { const size_t rowb = (size_t)(b * SEQ + jb * MBLK);
              for (int c = F.tid; c < 256 * 8; c += 512) { const int r = c >> 3, ch = c & 7;
                  *(LAS u32x4*)(Ks + r * 32 + ch * 4) = *(const u32x4*)(Kb + (rowb + r) * AW + h * HD + ch * 8);
                  *(LAS u32x4*)(Vs + r * 32 + ch * 4) = *(const u32x4*)(Vb + (rowb + r) * AW + h * HD + ch * 8); } }
            __syncthreads();
            const bool need = (jb == iblk) || jb == s0 || jb == s1 || jb == s2;
            if (need) { const int kend = (jb == iblk) ? ql : 255;
                for (int kk = 0; kk <= kend; ++kk) { float s = 0.f;
#pragma unroll
                    for (int c = 0; c < 4; ++c) { const u32x4 w = *(const LAS u32x4*)(Ks + kk * 32 + half * 16 + c * 4);
                        s += q[8 * c + 0] * bflo(w.x) + q[8 * c + 1] * bfhi(w.x) + q[8 * c + 2] * bflo(w.y) + q[8 * c + 3] * bfhi(w.y) + q[8 * c + 4] * bflo(w.z) + q[8 * c + 5] * bfhi(w.z) + q[8 * c + 6] * bflo(w.w) + q[8 * c + 7] * bfhi(w.w); }
                    s += __shfl_xor(s, 1);
                    const float mn = fmaxf(mx, s), corr = __builtin_amdgcn_exp2f(mx - mn), p = __builtin_amdgcn_exp2f(s - mn); mx = mn; l = l * corr + p;
#pragma unroll
                    for (int c = 0; c < 4; ++c) { const u32x4 w = *(const LAS u32x4*)(Vs + kk * 32 + half * 16 + c * 4);
                        o[8 * c + 0] = o[8 * c + 0] * corr + p * bflo(w.x); o[8 * c + 1] = o[8 * c + 1] * corr + p * bfhi(w.x); o[8 * c + 2] = o[8 * c + 2] * corr + p * bflo(w.y); o[8 * c + 3] = o[8 * c + 3] * corr + p * bfhi(w.y);
                        o[8 * c + 4] = o[8 * c + 4] * corr + p * bflo(w.z); o[8 * c + 5] = o[8 * c + 5] * corr + p * bfhi(w.z); o[8 * c + 6] = o[8 * c + 6] * corr + p * bflo(w.w); o[8 * c + 7] = o[8 * c + 7] * corr + p * bfhi(w.w); } } }
        }
        const float il = 1.0f / l;
        u32x4* op = (u32x4*)(Ob + (size_t)(b * SEQ + iblk * MBLK + ql) * AW + h * HD + half * 32);
#pragma unroll
        for (int c = 0; c < 4; ++c) { u32x4 w; w.x = pk2(o[8 * c + 0] * il, o[8 * c + 1] * il); w.y = pk2(o[8 * c + 2] * il, o[8 * c + 3] * il); w.z = pk2(o[8 * c + 4] * il, o[8 * c + 5] * il); w.w = pk2(o[8 * c + 6] * il, o[8 * c + 7] * il); op[c] = w; }
    }
}

__device__ __forceinline__ void phase_ssm_simple(Frame& F) {
    const int gw = F.bid * 8 + F.wave, NGW = F.G * 8, p = F.lane;
    const bf16_t* Ub = WSP(bf16_t, WS_U); bf16_t* Yb = WSP(bf16_t, WS_YB);
    for (int it = gw; it < NB * NG; it += NGW) {
        const int g = it % NG, b = it / NG;
        const float are = fminf(F.in[I_ARE][g * SP + p], -1e-4f), aim = F.in[I_AIM][g * SP + p], dt = expf(F.in[I_LOGDT][g]);
        const float mag = expf(are * dt), ang = aim * dt; const float lr = mag * cosf(ang), li = mag * sinf(ang);
        const float nr = lr - 1.0f, ni = li, den = 1.0f / (are * are + aim * aim); const float fr_ = (nr * are + ni * aim) * den, fi_ = (ni * are - nr * aim) * den;
        float bbr[16], bbi[16], cr[16], ci[16], dsk[16];
#pragma unroll
        for (int c = 0; c < 16; ++c) { const float br = F.in[I_BRE][(size_t)(g * SP + p) * SGC + c], bi = F.in[I_BIM][(size_t)(g * SP + p) * SGC + c];
            bbr[c] = fr_ * br - fi_ * bi; bbi[c] = fr_ * bi + fi_ * br;
            cr[c] = F.in[I_CRE][(size_t)(g * SGC + c) * SP + p]; ci[c] = F.in[I_CIM][(size_t)(g * SGC + c) * SP + p]; dsk[c] = F.in[I_DSKIP][g * SGC + c]; }
        float xr = 0.f, xi = 0.f;
        const int csel = ((p >> 5) & 1) * 8 + ((p >> 4) & 1) * 4 + ((p >> 3) & 1) * 2 + ((p >> 2) & 1);
        float dmine = 0.f;
#pragma unroll
        for (int c = 0; c < 16; ++c) dmine = (c == csel) ? dsk[c] : dmine;
        for (int t = 0; t < SEQ; ++t) {
            const u32x4* up = (const u32x4*)(Ub + (size_t)(b * SEQ + t) * SW + g * SGC); const u32x4 w0 = up[0], w1 = up[1];
            float u[16]; u[0] = bflo(w0.x); u[1] = bfhi(w0.x); u[2] = bflo(w0.y); u[3] = bfhi(w0.y); u[4] = bflo(w0.z); u[5] = bfhi(w0.z); u[6] = bflo(w0.w); u[7] = bfhi(w0.w);
            u[8] = bflo(w1.x); u[9] = bfhi(w1.x); u[10] = bflo(w1.y); u[11] = bfhi(w1.y); u[12] = bflo(w1.z); u[13] = bfhi(w1.z); u[14] = bflo(w1.w); u[15] = bfhi(w1.w);
            float sr = 0.f, si = 0.f;
#pragma unroll
            for (int c = 0; c < 16; ++c) { sr += bbr[c] * u[c]; si += bbi[c] * u[c]; }
            const float nxr = lr * xr - li * xi + sr, nxi = lr * xi + li * xr + si; xr = nxr; xi = nxi;
            float y[16];
#pragma unroll
            for (int c = 0; c < 16; ++c) y[c] = cr[c] * xr - ci[c] * xi;
            float w8[8], w4[4], w2[2], w1_;
            { const bool hi = (p & 32) != 0;
#pragma unroll
              for (int i = 0; i < 8; ++i) { const float keep = hi ? y[i + 8] : y[i], send = hi ? y[i] : y[i + 8]; w8[i] = keep + __shfl_xor(send, 32); } }
            { const bool hi = (p & 16) != 0;
#pragma unroll
              for (int i = 0; i < 4; ++i) { const float keep = hi ? w8[i + 4] : w8[i], send = hi ? w8[i] : w8[i + 4]; w4[i] = keep + __shfl_xor(send, 16); } }
            { const bool hi = (p & 8) != 0;
#pragma unroll
              for (int i = 0; i < 2; ++i) { const float keep = hi ? w4[i + 2] : w4[i], send = hi ? w4[i] : w4[i + 2]; w2[i] = keep + __shfl_xor(send, 8); } }
            { const bool hi = (p & 4) != 0; const float keep = hi ? w2[1] : w2[0], send = hi ? w2[0] : w2[1]; w1_ = keep + __shfl_xor(send, 4); }
            w1_ += __shfl_xor(w1_, 2); w1_ += __shfl_xor(w1_, 1);
            float umine = 0.f;
#pragma unroll
            for (int c = 0; c < 16; ++c) umine = (c == csel) ? u[c] : umine;
            if ((p & 3) == 0) Yb[(size_t)(b * SEQ + t) * SW + g * SGC + csel] = (bf16_t)f2bf(gelu_tanh(w1_ + dmine * umine));
        }
    }
}

__device__ __forceinline__ void phase_xattn_simple(Frame& F) {
    LAS unsigned* Ks = (LAS unsigned*)F.lds;
    LAS unsigned* Vs = (LAS unsigned*)(F.lds + 65536);
    const bf16_t *Qb = WSP(bf16_t, WS_XQ), *KV = WSP(bf16_t, WS_MKV); bf16_t* Ob = WSP(bf16_t, WS_XO);
    const int tl = F.tid >> 2, part = F.tid & 3;
    int lastbh = -1;
    for (int it = F.bid; it < NB * XH * (SEQ / 128); it += F.G) {
        const int bh = it / (SEQ / 128), ch = it % (SEQ / 128), b = bh / XH, h = bh % XH;
        if (bh != lastbh) { __syncthreads();
            for (int c = F.tid; c < 256 * 16; c += 512) { const int r = c >> 4, cc = c & 15;
                *(LAS u32x4*)(Ks + r * 64 + cc * 4) = *(const u32x4*)(KV + (size_t)(b * MEML + r) * (2 * XW) + h * XD + cc * 8);
                *(LAS u32x4*)(Vs + r * 64 + cc * 4) = *(const u32x4*)(KV + (size_t)(b * MEML + r) * (2 * XW) + XW + h * XD + cc * 8); }
            __syncthreads(); lastbh = bh; }
        const size_t row = (size_t)b * SEQ + ch * 128 + tl;
        float q[32];
        { const u32x4* qp = (const u32x4*)(Qb + row * XW + h * XD + part * 32);
#pragma unroll
          for (int c = 0; c < 4; ++c) { const u32x4 w = qp[c]; q[8 * c + 0] = bflo(w.x); q[8 * c + 1] = bfhi(w.x); q[8 * c + 2] = bflo(w.y); q[8 * c + 3] = bfhi(w.y); q[8 * c + 4] = bflo(w.z); q[8 * c + 5] = bfhi(w.z); q[8 * c + 6] = bflo(w.w); q[8 * c + 7] = bfhi(w.w); } }
        float mx = -3e38f, l = 0.f, o[32];
#pragma unroll
        for (int d = 0; d < 32; ++d) o[d] = 0.f;
        for (int kk = 0; kk < MEML; ++kk) { float s = 0.f;
#pragma unroll
            for (int c = 0; c < 4; ++c) { const u32x4 w = *(const LAS u32x4*)(Ks + kk * 64 + part * 16 + c * 4);
                s += q[8 * c + 0] * bflo(w.x) + q[8 * c + 1] * bfhi(w.x) + q[8 * c + 2] * bflo(w.y) + q[8 * c + 3] * bfhi(w.y) + q[8 * c + 4] * bflo(w.z) + q[8 * c + 5] * bfhi(w.z) + q[8 * c + 6] * bflo(w.w) + q[8 * c + 7] * bfhi(w.w); }
            s += __shfl_xor(s, 1); s += __shfl_xor(s, 2);
            const float mn = fmaxf(mx, s), corr = __builtin_amdgcn_exp2f(mx - mn), p = __builtin_amdgcn_exp2f(s - mn); mx = mn; l = l * corr + p;
#pragma unroll
            for (int c = 0; c < 4; ++c) { const u32x4 w = *(const LAS u32x4*)(Vs + kk * 64 + part * 16 + c * 4);
                o[8 * c + 0] = o[8 * c + 0] * corr + p * bflo(w.x); o[8 * c + 1] = o[8 * c + 1] * corr + p * bfhi(w.x); o[8 * c + 2] = o[8 * c + 2] * corr + p * bflo(w.y); o[8 * c + 3] = o[8 * c + 3] * corr + p * bfhi(w.y);
                o[8 * c + 4] = o[8 * c + 4] * corr + p * bflo(w.z); o[8 * c + 5] = o[8 * c + 5] * corr + p * bfhi(w.z); o[8 * c + 6] = o[8 * c + 6] * corr + p * bflo(w.w); o[8 * c + 7] = o[8 * c + 7] * corr + p * bfhi(w.w); } }
        const float il = 1.0f / l;
        u32x4* op = (u32x4*)(Ob + row * XW + h * XD + part * 32);
#pragma unroll
        for (int c = 0; c < 4; ++c) { u32x4 w; w.x = pk2(o[8 * c + 0] * il, o[8 * c + 1] * il); w.y = pk2(o[8 * c + 2] * il, o[8 * c + 3] * il); w.z = pk2(o[8 * c + 4] * il, o[8 * c + 5] * il); w.w = pk2(o[8 * c + 6] * il, o[8 * c + 7] * il); op[c] = w; }
    }
}

__device__ __forceinline__ void phase_router(Frame& F) {
    LAS float* wt = (LAS float*)F.lds;
    for (int c = F.tid; c < NE * DM; c += 512) { const int k = c >> 5, e = c & 31; wt[e * DM + k] = F.in[I_WROUTER][c] * F.in[I_GMOE][k]; }
    __syncthreads();
    const int gw = F.bid * 8 + F.wave, NGW = F.G * 8, lane = F.lane;
    const float* H = WSP(float, WS_H);
    unsigned* cnt = F.ctl + CW_CNT;
    for (int tk = gw; tk < T_; tk += NGW) {
        const f32x4* hp = (const f32x4*)(H + (size_t)tk * DM) + lane; f32x4 hv[4]; float ss = 0.f;
#pragma unroll
        for (int j = 0; j < 4; ++j) { hv[j] = hp[64 * j]; ss += (hv[j][0] * hv[j][0] + hv[j][1] * hv[j][1]) + (hv[j][2] * hv[j][2] + hv[j][3] * hv[j][3]); }
        const float rstd = 1.0f / sqrtf(wave_sum(ss) * (1.0f / DM) + RMS_EPS);
        float mylogit = 0.f;
#pragma unroll 4
        for (int e = 0; e < NE; ++e) { float a = 0.f;
#pragma unroll
            for (int j = 0; j < 4; ++j) { const f32x4 w = *(const LAS f32x4*)(wt + e * DM + 4 * lane + 256 * j); a += (hv[j][0] * w[0] + hv[j][1] * w[1]) + (hv[j][2] * w[2] + hv[j][3] * w[3]); }
            a = wave_sum(a);
            mylogit = (lane == e) ? a : mylogit; }
        mylogit = (lane < NE) ? (mylogit * rstd + F.in[I_BROUTER][lane & 31]) : -3e38f;
        float tv[4]; int ti[4]; float cur = mylogit;
#pragma unroll
        for (int s = 0; s < 4; ++s) { float bv = cur; int bi = lane;
#pragma unroll
            for (int o = 1; o < 64; o <<= 1) { const float ov = __shfl_xor(bv, o); const int oi = __shfl_xor(bi, o); if (ov > bv || (ov == bv && oi < bi)) { bv = ov; bi = oi; } }
            tv[s] = bv; ti[s] = bi; if (lane == bi) cur = -3e38f; }
        const float e1 = __expf(tv[1] - tv[0]), e2 = __expf(tv[2] - tv[0]), e3 = __expf(tv[3] - tv[0]); const float inv = 1.0f / (1.0f + e1 + e2 + e3);
        if (lane == 0) WSP(float, WS_RSTD2)[tk] = rstd;
        if (lane < 4) { const int ex = (lane == 0) ? ti[0] : (lane == 1) ? ti[1] : (lane == 2) ? ti[2] : ti[3]; const float gv = ((lane == 0) ? 1.0f : (lane == 1) ? e1 : (lane == 2) ? e2 : e3) * inv;
            WSP(float, WS_TKG)[(size_t)tk * 4 + lane] = gv;
            const unsigned rank = atomicAdd(&cnt[ex], 1u);
            WSP(int, WS_ROWLIST)[(size_t)ex * T_ + rank] = tk * 4 + lane; }
    }
}

__device__ __forceinline__ void phase_final(Frame& F) {
    const int gw = F.bid * 8 + F.wave, NGW = F.G * 8, lane = F.lane;
    const float* H = WSP(float, WS_H); const bf16_t* Y = WSP(bf16_t, WS_Y);
    for (int tk = gw; tk < T_; tk += NGW) {
        const f32x4* hp = (const f32x4*)(H + (size_t)tk * DM) + lane; f32x4 hv[4];
#pragma unroll
        for (int j = 0; j < 4; ++j) hv[j] = hp[64 * j];
#pragma unroll
        for (int s = 0; s < 4; ++s) { const u32x2* yp = (const u32x2*)(Y + ((size_t)tk * 4 + s) * DM) + lane;
#pragma unroll
            for (int j = 0; j < 4; ++j) { const u32x2 w = yp[64 * j]; hv[j][0] += bflo(w.x); hv[j][1] += bfhi(w.x); hv[j][2] += bflo(w.y); hv[j][3] += bfhi(w.y); } }
        float ss = 0.f;
#pragma unroll
        for (int j = 0; j < 4; ++j) ss += (hv[j][0] * hv[j][0] + hv[j][1] * hv[j][1]) + (hv[j][2] * hv[j][2] + hv[j][3] * hv[j][3]);
        const float rstd = 1.0f / sqrtf(wave_sum(ss) * (1.0f / DM) + RMS_EPS);
        f32x4* op = (f32x4*)(F.out + (size_t)tk * DM) + lane;
#pragma unroll
        for (int j = 0; j < 4; ++j) op[64 * j] = hv[j] * rstd * ((const f32x4*)F.in[I_GFINAL])[lane + 64 * j];
    }
}

constexpr int N_PHASES = 14;
__global__ void __launch_bounds__(512, 2) mega_fwd(Args args) {
    extern __shared__ __attribute__((aligned(16))) unsigned char lds_raw[];
    Frame F;
    F.lds = (LAS unsigned char*)lds_raw; F.tid = threadIdx.x; F.lane = F.tid & 63; F.wave = __builtin_amdgcn_readfirstlane(F.tid >> 6); F.G = gridDim.x; F.bid = blockIdx.x;
#pragma unroll
    for (int i = 0; i < 28; ++i) F.in[i] = args.in[i];
    F.out = args.out; F.ws = args.ws; F.ctl = (unsigned*)(args.ws + WS_CTL);
    volatile LAS unsigned* MISC = (volatile LAS unsigned*)(F.lds + MISC_OFF);
    if (F.tid < 64) MISC[F.tid] = 0u;
    __syncthreads();
    const int lo = args.ph_lo, hi = args.ph_hi;
    XcdBarrier bar; bar.bar = F.ctl + CW_BAR; bar.x = 0; bar.st = nullptr;
    if (hi - lo > 1) bar = xcd_barrier_post(F.ctl + CW_BAR, MISC + 8);
#define IN(k) (lo <= (k) && (k) < hi)
#define SEAM(k) do { if (IN(k) && IN((k) + 1)) xcd_barrier(bar); } while (0)
    LAS unsigned char* ring = F.lds;
    const LAS int* gidx = (const LAS int*)(F.lds + GIDX_OFF);

    if (IN(0)) { phase_prologue(F); } SEAM(0);
    if (IN(1)) {
        { pg8::Gemm g{WSP(bf16_t, WS_XB), WSP(bf16_t, WS_WIN), DM, 0}; pg8::PatchOrder S; S.init(T_ / 256, INW / 256, 8, F.G, F.bid);
          pg8::EpiInProj E{WSP(float, WS_RSTD0), WSP(bf16_t, WS_Q), WSP(bf16_t, WS_K), WSP(bf16_t, WS_V), WSP(bf16_t, WS_U), WSP(bf16_t, WS_SGA), WSP(bf16_t, WS_SGB)};
          pg8::gemm_phase<pg8::EpiInProj, pg8::PatchOrder, false>(ring, g, S, E, gidx); }
        { pg8::Gemm g{WSP(bf16_t, WS_MN), WSP(bf16_t, WS_WXKV), DM, 0}; pg8::PatchOrder S; S.init(NB * MEML / 256, 2 * XW / 256, 4, F.G, F.bid);
          pg8::EpiStore E{WSP(bf16_t, WS_MKV), 2 * XW};
          pg8::gemm_phase<pg8::EpiStore, pg8::PatchOrder, false>(ring, g, S, E, gidx); }
    } SEAM(1);
    if (IN(2)) { phase_kmean(F); } SEAM(2);
    if (IN(3)) { phase_moba_simple(F); phase_ssm_simple(F); } SEAM(3);
    if (IN(4)) {
        pg8::Gemm g{WSP(bf16_t, WS_YB), WSP(bf16_t, WS_WGLU), SW, 0}; pg8::PatchOrder S; S.init(T_ / 256, 2 * DM / 256, 8, F.G, F.bid);
        pg8::EpiGlu E{WSP(bf16_t, WS_SGB), WSP(bf16_t, WS_YB2S)};
        pg8::gemm_phase<pg8::EpiGlu, pg8::PatchOrder, false>(ring, g, S, E, gidx);
    } SEAM(4);
    if (IN(5)) {
        pg8::Gemm g{WSP(bf16_t, WS_ATT), WSP(bf16_t, WS_WPA), AW, 0}; pg8::PatchOrder S; S.init(T_ / 256, DM / 256, 4, F.G, F.bid);
        pg8::EpiMerge E{WSP(bf16_t, WS_SGA), WSP(bf16_t, WS_YB2S), WSP(bf16_t, WS_MERGED)};
        pg8::gemm_phase<pg8::EpiMerge, pg8::PatchOrder, false>(ring, g, S, E, gidx);
    } SEAM(5);
    if (IN(6)) {
        pg8::Gemm g{WSP(bf16_t, WS_MERGED), WSP(bf16_t, WS_WOUT), DM, 0}; pg8::PatchOrder S; S.init(T_ / 256, DM / 256, 4, F.G, F.bid);
        pg8::EpiResid E{F.in[I_X], WSP(float, WS_H), WSP(bf16_t, WS_HB), WSP(float, WS_SSQ1)};
        pg8::gemm_phase<pg8::EpiResid, pg8::PatchOrder, false>(ring, g, S, E, gidx);
    } SEAM(6);
    if (IN(7)) {
        pg8::Gemm g{WSP(bf16_t, WS_HB), WSP(bf16_t, WS_WXQ), DM, 0}; pg8::PatchOrder S; S.init(T_ / 256, XW / 256, 2, F.G, F.bid);
        pg8::EpiXq E{WSP(float, WS_SSQ1), WSP(bf16_t, WS_XQ)};
        pg8::gemm_phase<pg8::EpiXq, pg8::PatchOrder, false>(ring, g, S, E, gidx);
    } SEAM(7);
    if (IN(8)) { phase_xattn_simple(F); } SEAM(8);
    if (IN(9)) {
        pg8::Gemm g{WSP(bf16_t, WS_XO), WSP(bf16_t, WS_WXO), XW, 0}; pg8::PatchOrder S; S.init(T_ / 256, DM / 256, 4, F.G, F.bid);
        pg8::EpiResid E{WSP(float, WS_H), WSP(float, WS_H), WSP(bf16_t, WS_HB), WSP(float, WS_SSQ2)};
        pg8::gemm_phase<pg8::EpiResid, pg8::PatchOrder, false>(ring, g, S, E, gidx);
    } SEAM(9);
    if (IN(10)) { phase_router(F); } SEAM(10);
    if (IN(11) || IN(12)) {
        LAS int* pref = (LAS int*)(F.lds + MISC_OFF + 256);
        const unsigned* cnt = F.ctl + CW_CNT;
        __syncthreads();
        if (F.tid == 0) { int a = 0; for (int e = 0; e < NE; ++e) { pref[e] = a; a += ((int)__hip_atomic_load(cnt + e, RLX_AGENT) + 255) >> 8; } pref[NE] = a; }
        __syncthreads();
        const int MT = pref[NE];
        if (IN(11)) {
            MoeOrder S; S.P.init(MT, 2 * DFF / 256, 8, F.G, F.bid); S.pref = pref;
            { LAS int* gw_ = (LAS int*)(F.lds + GIDX_OFF); pg8::Unit u;
              for (int i = 0; i < GIDX_UNITS && S.next(i, u); ++i) { const int ce = (int)__hip_atomic_load(cnt + u.e, RLX_AGENT);
                  if (F.tid < 256) { const int rank = u.mi * 256 + F.tid; gw_[i * 256 + F.tid] = (rank < ce) ? (WSP(int, WS_ROWLIST)[(size_t)u.e * T_ + rank] >> 2) : 0; } } }
            __syncthreads();
            pg8::Gemm g{WSP(bf16_t, WS_HB), WSP(bf16_t, WS_WGU), DM, (size_t)2 * DFF * DM};
            pg8::EpiMoe1 E{WSP(float, WS_RSTD2), F.in[I_BGU], WSP(bf16_t, WS_HID), gidx};
            pg8::gemm_phase<pg8::EpiMoe1, MoeOrder, true>(ring, g, S, E, gidx);
        }
        SEAM(11);
        if (IN(12)) {
            MoeOrder S; S.P.init(MT, DM / 256, 4, F.G, F.bid); S.pref = pref;
            pg8::Gemm g{WSP(bf16_t, WS_HID), WSP(bf16_t, WS_WDN), DFF, (size_t)DM * DFF};
            pg8::EpiMoe2 E{F.in[I_BDN], WSP(float, WS_TKG), WSP(int, WS_ROWLIST), cnt, WSP(bf16_t, WS_Y)};
            pg8::gemm_phase<pg8::EpiMoe2, MoeOrder, false>(ring, g, S, E, gidx);
        }
    } SEAM(12);
    if (IN(13)) { phase_final(F); }
#undef IN
#undef SEAM
}

extern "C" void kernel_launch(void* const* d_in, const int* in_sizes, int n_in, void* d_out, int out_size, void* d_ws, size_t ws_size, hipStream_t stream) {
    static int grid = 0;
    if (grid == 0) {
        if (n_in != 28 || in_sizes[0] != T_ * DM || out_size != T_ * DM || ws_size < WS_END) { fprintf(stderr, "kernel_launch: unexpected shapes (n_in %d, in0 %d, out %d, ws %zu)\n", n_in, n_in > 0 ? in_sizes[0] : -1, out_size, ws_size); grid = -1; return; }
        int dev = 0, cus = 0;
        if (hipGetDevice(&dev) != hipSuccess || hipDeviceGetAttribute(&cus, hipDeviceAttributeMultiprocessorCount, dev) != hipSuccess) { grid = -1; return; }
        if (hipFuncSetAttribute((const void*)mega_fwd, hipFuncAttributeMaxDynamicSharedMemorySize, LDS_BYTES) != hipSuccess) { fprintf(stderr, "kernel_launch: hipFuncSetAttribute failed\n"); grid = -1; return; }
        (void)hipGetLastError();
        grid = cus;
    }
    if (grid < 0) return;
    (void)hipMemsetAsync((char*)d_ws + WS_CTL, 0, CTL_ZERO_BYTES, stream);
    Args a{};
    for (int i = 0; i < 28; ++i) a.in[i] = (const float*)d_in[i];
    a.out = (float*)d_out; a.ws = (unsigned char*)d_ws;
#if MK_N_LAUNCHES == 1
    a.ph_lo = 0; a.ph_hi = N_PHASES;
    hipLaunchKernelGGL(mega_fwd, dim3(grid), dim3(512), LDS_BYTES, stream, a);
#else
    for (int p = 0; p < N_PHASES; ++p) { a.ph_lo = p; a.ph_hi = p + 1; hipLaunchKernelGGL(mega_fwd, dim3(grid), dim3(512), LDS_BYTES, stream, a); }
#endif
}
```

```cpp
#include <hip/hip_runtime.h>
#include <cstdio>
#include <cstdint>

#ifndef MK_N_LAUNCHES
#define MK_N_LAUNCHES 1
#endif

#define GAS __attribute__((address_space(1)))
#define LAS __attribute__((address_space(3)))
typedef unsigned short bf16_t;
typedef short bf16x8 __attribute__((ext_vector_type(8)));
typedef float f32x4 __attribute__((ext_vector_type(4)));
typedef float f32x2 __attribute__((ext_vector_type(2)));
typedef unsigned u32x4 __attribute__((ext_vector_type(4)));
typedef unsigned u32x2 __attribute__((ext_vector_type(2)));

constexpr int NB = 4, SEQ = 8192, DM = 1024, T_ = NB * SEQ;
constexpr int AW = 512, NH = 8, HD = 64, MBLK = 256, NBLK = SEQ / MBLK, MTOPK = 3;
constexpr int SW = 512, SGC = 16, NG = 32, SP = 64;
constexpr int INW = 4096;
constexpr int MEML = 256, XH = 4, XD = 128, XW = 512;
constexpr int NE = 32, ETOPK = 4, DFF = 1024;
constexpr float RMS_EPS = 1e-6f;
constexpr float LOG2E = 1.4426950408889634f;
constexpr float QSCALE = 0.125f * LOG2E;
constexpr float XSCALE = 0.08838834764831845f * LOG2E;
constexpr int HID_ROWS = ETOPK * T_ + NE * 256;

constexpr size_t MiB = 1u << 20;
constexpr size_t WS_WIN = 0 * MiB, WS_WGLU = 8 * MiB, WS_WPA = 10 * MiB, WS_WOUT = 11 * MiB, WS_WXQ = 13 * MiB, WS_WXKV = 14 * MiB, WS_WXO = 16 * MiB,
                 WS_WGU = 17 * MiB, WS_WDN = 145 * MiB;
constexpr size_t WS_CTL = 209 * MiB, CTL_ZERO_BYTES = 1 * MiB;
constexpr size_t WS_RSTD0 = 210 * MiB;
constexpr size_t WS_RSTD2 = WS_RSTD0 + 128 * 1024;
constexpr size_t WS_KMEAN = WS_RSTD2 + 128 * 1024;
constexpr size_t WS_TKG = WS_KMEAN + 256 * 1024;
constexpr size_t WS_SSQ1 = 211 * MiB;
constexpr size_t WS_SSQ2 = 213 * MiB;
constexpr size_t WS_ROWLIST = 215 * MiB;
constexpr size_t WS_MN = 219 * MiB;
constexpr size_t WS_MKV = 221 * MiB;
constexpr size_t WS_H = 256 * MiB;
constexpr size_t WS_HB = 384 * MiB;
constexpr size_t WS_HID = 448 * MiB;
constexpr size_t WS_Y = 720 * MiB;
constexpr size_t WS_END = 976 * MiB;
constexpr size_t WS_XB = 448 * MiB, WS_Q = 512 * MiB, WS_K = 544 * MiB, WS_V = 576 * MiB, WS_U = 608 * MiB, WS_ATT = 640 * MiB, WS_YB = 672 * MiB;
constexpr size_t WS_SGA = 720 * MiB, WS_SGB = 784 * MiB, WS_YB2S = 848 * MiB, WS_MERGED = 912 * MiB;
constexpr size_t WS_XQ = 448 * MiB, WS_XO = 480 * MiB;
static_assert(WS_HID + (size_t)HID_ROWS * DFF * 2 <= WS_Y, "HID fits");
constexpr int CW_TMO = 0, CW_CNT = 64  , CW_BAR = 4096;

constexpr int RING_BYTES = 131072;
constexpr int GIDX_OFF = RING_BYTES, GIDX_UNITS = 24;
constexpr int MISC_OFF = GIDX_OFF + GIDX_UNITS * 1024;
constexpr int LDS_BYTES = 163840;

#define RLX_AGENT __ATOMIC_RELAXED, __HIP_MEMORY_SCOPE_AGENT
__device__ __forceinline__ unsigned f2bf(float f) { unsigned u = __builtin_bit_cast(unsigned, f); return (u + 0x7fffu + ((u >> 16) & 1u)) >> 16; }
__device__ __forceinline__ unsigned pk2(float lo, float hi) { return f2bf(lo) | (f2bf(hi) << 16); }
__device__ __forceinline__ float bf2f(unsigned short b) { return __builtin_bit_cast(float, (unsigned)b << 16); }
__device__ __forceinline__ float bflo(unsigned w) { return __builtin_bit_cast(float, w << 16); }
__device__ __forceinline__ float bfhi(unsigned w) { return __builtin_bit_cast(float, w & 0xffff0000u); }
__device__ __forceinline__ float wave_sum(float v) {
#pragma unroll
    for (int o = 1; o < 64; o <<= 1) v += __shfl_xor(v, o);
    return v;
}
__device__ __forceinline__ float fsigmoid(float x) { return __builtin_amdgcn_rcpf(1.0f + __builtin_amdgcn_exp2f(-x * LOG2E)); }
__device__ __forceinline__ float gelu_tanh(float x) {
    const float u = 0.7978845608028654f * (x + 0.044715f * x * x * x);
    return x * fsigmoid(2.0f * u);
}

namespace pg8 {
constexpr int BM = 256, BK = 64, HALF = 128, HTB = HALF * BK * 2, STAGE_BYTES = 8 * HTB;
__host__ __device__ __forceinline__ int lds_byte(int r, int c) { const int st = (r >> 4) * 2 + (c >> 5), rr = r & 15, cc = c & 31, ob = rr * 64 + cc * 2; return st * 1024 + (ob ^ (((ob >> 9) & 1) << 5)); }
__host__ __device__ __forceinline__ void stage_rc(int b, int& R, int& C) { const int st = b / 1024, sb = b % 1024, swz = sb ^ (((sb >> 9) & 1) << 5); R = (st >> 1) * 16 + swz / 64; C = (st & 1) * 32 + (swz % 64) / 2; }
__host__ __device__ __forceinline__ int perm32(int rho) { const int n = rho >> 4, i = rho & 15; return 8 * (i >> 2) + 4 * n + (i & 3); }

struct Unit { int pm, pn, e, mi, ui; };
struct Gemm { const bf16_t* A; const bf16_t* Bt; int K; size_t b_estride; };

struct PatchOrder {
    int nM, nN, PM, PN, x, j, ok;
    __device__ __forceinline__ void init(int nM_, int nN_, int PN_, int G, int c) { nM = nM_; nN = nN_; PN = PN_; PM = (G / 8) / PN_; x = c & 7; j = c >> 3; ok = ((G & 7) == 0) && (PM * PN == G / 8) && (nN % PN == 0); if (!ok) { x = c; j = G; } }
    __device__ __forceinline__ bool next(int i, Unit& u) const {
        if (!ok) { const long L = (long)i * j + x; if (L >= (long)nM * nN) return false; u.pm = (int)(L / nN); u.pn = (int)(L % nN); u.e = 0; u.mi = u.pm; u.ui = i; return true; }
        const int p = 8 * i + x, npn = nN / PN, pmb = p / npn, pnb = p % npn;
        u.pm = pmb * PM + (j % PM); u.pn = pnb * PN + (j / PM); u.e = 0; u.mi = u.pm; u.ui = i;
        return u.pm < nM;
    }
};

__device__ __forceinline__ unsigned cvt_pk_bf16(float lo, float hi) { unsigned r; asm volatile("v_cvt_pk_bf16_f32 %0, %1, %2" : "=v"(r) : "v"(lo), "v"(hi)); return r; }

template <class Epi, class Sched, bool GATHER>
__device__ __forceinline__ void gemm_phase(LAS unsigned char* lds, const Gemm g, const Sched& S, const Epi& E, const LAS int* gidx) {
    const int tid = threadIdx.x, wid = __builtin_amdgcn_readfirstlane(tid >> 6), lane = tid & 63, wr = wid >> 2, wc = wid & 3, fr = lane & 15, fq = lane >> 4;
    const int K = g.K, nt = K / BK;
    int Ra[2], Ca[2]; unsigned voffB[2];
#pragma unroll
    for (int i = 0; i < 2; ++i) { int R, C; stage_rc(tid * 16 + i * 8192, R, C); const int Rb = Epi::PERM ? ((R & ~31) + perm32(R & 31)) : R;
        Ra[i] = R; Ca[i] = C; voffB[i] = (unsigned)(Rb * K + C) * 2u; }
    const size_t kstep = (size_t)(BK * 2);
    const size_t hstep = (size_t)HALF * K * 2;
    const size_t tstep = 2 * hstep;
    const unsigned ldsw = (unsigned)wid * 1024u;
    const int aoff = lds_byte(wr * 64 + fr, fq * 8), boff = lds_byte(wc * 32 + fr, fq * 8);
#define PG8_SA(b, h) (((b) * 2 + (h)) * HTB)
#define PG8_SB(b, h) ((4 + (b) * 2 + (h)) * HTB)
#define PG8_STAGE(bufoff, gbase, voff) do { _Pragma("unroll") for (int _i = 0; _i < 2; ++_i) \
        __builtin_amdgcn_global_load_lds((const unsigned*)((const char*)(gbase) + (voff)[_i]), (LAS unsigned*)(lds + (bufoff) + ldsw + _i * 8192), 16, 0, 0); } while (0)
#define PG8_LDA(dst, b, h) do { _Pragma("unroll") for (int m = 0; m < 4; ++m) _Pragma("unroll") for (int k = 0; k < 2; ++k) dst[m][k] = *(const LAS bf16x8*)(lds + PG8_SA(b, h) + aoff + m * 2048 + k * 1024); } while (0)
#define PG8_LDB(dst, b, h) do { _Pragma("unroll") for (int n = 0; n < 2; ++n) _Pragma("unroll") for (int k = 0; k < 2; ++k) dst[n][k] = *(const LAS bf16x8*)(lds + PG8_SB(b, h) + boff + n * 2048 + k * 1024); } while (0)
#define PG8_MMA(ai, bj, At, Bt) do { __builtin_amdgcn_s_setprio(1); _Pragma("unroll") for (int m = 0; m < 4; ++m) _Pragma("unroll") for (int n = 0; n < 2; ++n) _Pragma("unroll") for (int k = 0; k < 2; ++k) \
        acc[ai][bj][m][n] = __builtin_amdgcn_mfma_f32_16x16x32_bf16(Bt[n][k], At[m][k], acc[ai][bj][m][n], 0, 0, 0); __builtin_amdgcn_s_setprio(0); } while (0)
#define PG8_WAIT_V(n) asm volatile("s_waitcnt vmcnt(" #n ")" ::: "memory")
#define PG8_WAIT_L(n) asm volatile("s_waitcnt lgkmcnt(" #n ")" ::: "memory")
#define PG8_BAR __builtin_amdgcn_s_barrier()
#define PG8_SCHED __builtin_amdgcn_sched_barrier(0)
#define PG8_VOA(dst, u) do { _Pragma("unroll") for (int _h = 0; _h < 2; ++_h) _Pragma("unroll") for (int _i = 0; _i < 2; ++_i) { \
        const int _row = GATHER ? gidx[(u).ui * 256 + _h * HALF + Ra[_i]] : (_h * HALF + Ra[_i]); dst[_h][_i] = (unsigned)(_row * K + Ca[_i]) * 2u; } } while (0)
    Unit cur, nxt; int ui = 0;
    if (!S.next(0, cur)) return;
    f32x4 acc[2][2][4][2];
#pragma unroll
    for (int a = 0; a < 2; ++a)
#pragma unroll
        for (int b = 0; b < 2; ++b)
#pragma unroll
            for (int m = 0; m < 4; ++m)
#pragma unroll
                for (int n = 0; n < 2; ++n) acc[a][b][m][n] = (f32x4){0.f, 0.f, 0.f, 0.f};
    bf16x8 At[4][2], B0[2][2], B1[2][2];
    unsigned voA[2][2], voN[2][2];
    PG8_VOA(voA, cur);
    const char* cA = (const char*)g.A + (GATHER ? (size_t)0 : (size_t)cur.pm * tstep);
    const char* cB = (const char*)g.Bt + ((size_t)cur.e * g.b_estride) * 2 + (size_t)cur.pn * tstep;
    PG8_STAGE(PG8_SB(0, 0), cB, voffB); PG8_STAGE(PG8_SB(0, 1), cB + hstep, voffB); PG8_STAGE(PG8_SA(0, 0), cA, voA[0]); PG8_STAGE(PG8_SA(0, 1), cA, voA[1]);
    if (wr == 1) PG8_BAR;
    PG8_WAIT_V(2); PG8_BAR;
    PG8_STAGE(PG8_SB(1, 0), cB + kstep, voffB); PG8_STAGE(PG8_SA(1, 0), cA + kstep, voA[0]); PG8_STAGE(PG8_SB(1, 1), cB + hstep + kstep, voffB);
    PG8_WAIT_V(6); PG8_BAR;
    for (;;) {
        const bool has_next = S.next(ui + 1, nxt);
        const char* nA = cA; const char* nB = cB;
#pragma unroll
        for (int h = 0; h < 2; ++h)
#pragma unroll
            for (int i = 0; i < 2; ++i) voN[h][i] = voA[h][i];
        if (has_next) { nA = (const char*)g.A + (GATHER ? (size_t)0 : (size_t)nxt.pm * tstep); nB = (const char*)g.Bt + ((size_t)nxt.e * g.b_estride) * 2 + (size_t)nxt.pn * tstep; PG8_VOA(voN, nxt); }
        for (int t = 0; t < nt; t += 2) {
            const bool last = (t == nt - 2);
            const char* a1 = cA + (size_t)(t + 1) * kstep;
            const char* a2 = last ? nA : cA + (size_t)(t + 2) * kstep; const char* b2 = last ? nB : cB + (size_t)(t + 2) * kstep;
            const char* a3 = a2 + kstep; const char* b3 = b2 + kstep;
            unsigned vo2[2][2];
#pragma unroll
            for (int h = 0; h < 2; ++h)
#pragma unroll
                for (int i = 0; i < 2; ++i) vo2[h][i] = last ? voN[h][i] : voA[h][i];
            PG8_LDB(B0, 0, 0); PG8_LDB(B1, 0, 1); PG8_SCHED; PG8_LDA(At, 0, 0); PG8_STAGE(PG8_SA(1, 1), a1, voA[1]);
            PG8_WAIT_V(8); PG8_WAIT_L(0); PG8_BAR; PG8_MMA(0, 0, At, B0); PG8_MMA(0, 1, At, B1); PG8_BAR; PG8_SCHED;
            PG8_LDA(At, 0, 1); PG8_STAGE(PG8_SB(0, 0), b2, voffB); PG8_STAGE(PG8_SB(0, 1), b2 + hstep, voffB); PG8_STAGE(PG8_SA(0, 0), a2, vo2[0]);
            PG8_WAIT_V(8); PG8_WAIT_L(0); PG8_BAR; PG8_MMA(1, 0, At, B0); PG8_MMA(1, 1, At, B1); PG8_BAR; PG8_SCHED;
            PG8_LDB(B0, 1, 0); PG8_LDB(B1, 1, 1); PG8_SCHED; PG8_LDA(At, 1, 0); PG8_STAGE(PG8_SA(0, 1), a2, vo2[1]);
            PG8_WAIT_V(8); PG8_WAIT_L(0); PG8_BAR; PG8_MMA(0, 0, At, B0); PG8_MMA(0, 1, At, B1); PG8_BAR; PG8_SCHED;
            PG8_LDA(At, 1, 1); PG8_STAGE(PG8_SB(1, 0), b3, voffB); PG8_STAGE(PG8_SB(1, 1), b3 + hstep, voffB); PG8_STAGE(PG8_SA(1, 0), a3, vo2[0]);
            PG8_WAIT_V(8); PG8_WAIT_L(0); PG8_BAR; PG8_MMA(1, 0, At, B0); PG8_MMA(1, 1, At, B1); PG8_BAR; PG8_SCHED;
        }
        if (wr == 0) PG8_BAR;
        E(acc, cur, wr, wc, fr, fq);
        if (!has_next) break;
#pragma unroll
        for (int a = 0; a < 2; ++a)
#pragma unroll
            for (int b = 0; b < 2; ++b)
#pragma unroll
                for (int m = 0; m < 4; ++m)
#pragma unroll
                    for (int n = 0; n < 2; ++n) acc[a][b][m][n] = (f32x4){0.f, 0.f, 0.f, 0.f};
        cur = nxt; cA = nA; cB = nB; ++ui;
#pragma unroll
        for (int h = 0; h < 2; ++h)
#pragma unroll
            for (int i = 0; i < 2; ++i) voA[h][i] = voN[h][i];
        if (wr == 1) PG8_BAR;
    }
    PG8_WAIT_V(0);
    PG8_BAR;
#undef PG8_SA
#undef PG8_SB
#undef PG8_STAGE
#undef PG8_LDA
#undef PG8_LDB
#undef PG8_MMA
#undef PG8_WAIT_V
#undef PG8_WAIT_L
#undef PG8_BAR
#undef PG8_SCHED
#undef PG8_VOA
}

typedef const f32x4 (&AccRef)[2][2][4][2];
#define EPI_ROWS for (int ai = 0; ai < 2; ++ai) _Pragma("unroll") for (int m = 0; m < 4; ++m)

struct EpiInProj {
    static constexpr bool PERM = true;
    const float* rstd; bf16_t *Q, *Kb, *V, *U, *SGA, *SGB;
    __device__ __forceinline__ void operator()(AccRef acc, const Unit& u, int wr, int wc, int fr, int fq) const {
        bf16_t* dst; int ld, colt; bool sig = false; float sc = 1.f;
        if (u.pn < 2) { dst = Q; ld = AW; colt = u.pn * 256; sc = QSCALE; }
        else if (u.pn < 4) { dst = Kb; ld = AW; colt = (u.pn - 2) * 256; }
        else if (u.pn < 6) { dst = V; ld = AW; colt = (u.pn - 4) * 256; }
        else if (u.pn < 8) { dst = U; ld = AW; colt = (u.pn - 6) * 256; }
        else if (u.pn < 12) { dst = SGA; ld = DM; colt = (u.pn - 8) * 256; sig = true; }
        else { dst = SGB; ld = DM; colt = (u.pn - 12) * 256; sig = true; }
        const int row0 = u.pm * BM + wr * 64 + fr, col0 = colt + wc * 32 + 8 * fq;
#pragma unroll
        EPI_ROWS { const int row = row0 + ai * HALF + m * 16; const float rs = rstd[row] * sc; bf16_t* rowp = dst + (size_t)row * ld + col0;
#pragma unroll
            for (int bj = 0; bj < 2; ++bj) { f32x4 v0 = acc[ai][bj][m][0] * rs, v1 = acc[ai][bj][m][1] * rs;
                if (sig) {
#pragma unroll
                    for (int e = 0; e < 4; ++e) { v0[e] = fsigmoid(v0[e]); v1[e] = fsigmoid(v1[e]); } }
                u32x4 w; w.x = cvt_pk_bf16(v0[0], v0[1]); w.y = cvt_pk_bf16(v0[2], v0[3]); w.z = cvt_pk_bf16(v1[0], v1[1]); w.w = cvt_pk_bf16(v1[2], v1[3]);
                *(u32x4*)(rowp + bj * HALF) = w; } }
    }
};
struct EpiStore {
    static constexpr bool PERM = true;
    bf16_t* O; int ld;
    __device__ __forceinline__ void operator()(AccRef acc, const Unit& u, int wr, int wc, int fr, int fq) const {
        const int row0 = u.pm * BM + wr * 64 + fr, col0 = u.pn * BM + wc * 32 + 8 * fq;
#pragma unroll
        EPI_ROWS { bf16_t* rowp = O + (size_t)(row0 + ai * HALF + m * 16) * ld + col0;
#pragma unroll
            for (int bj = 0; bj < 2; ++bj) { const f32x4 v0 = acc[ai][bj][m][0], v1 = acc[ai][bj][m][1];
                u32x4 w; w.x = cvt_pk_bf16(v0[0], v0[1]); w.y = cvt_pk_bf16(v0[2], v0[3]); w.z = cvt_pk_bf16(v1[0], v1[1]); w.w = cvt_pk_bf16(v1[2], v1[3]);
                *(u32x4*)(rowp + bj * HALF) = w; } }
    }
};
struct EpiGlu {
    static constexpr bool PERM = true;
    const bf16_t* SGB; bf16_t* O;
    __device__ __forceinline__ void operator()(AccRef acc, const Unit& u, int wr, int wc, int fr, int fq) const {
        const int row0 = u.pm * BM + wr * 64 + fr, col0 = u.pn * HALF + wc * 32 + 8 * fq;
#pragma unroll
        EPI_ROWS { const size_t off = (size_t)(row0 + ai * HALF + m * 16) * DM + col0; const u32x4 s = *(const u32x4*)(SGB + off);
            const f32x4 v0 = acc[ai][0][m][0], v1 = acc[ai][0][m][1], g0 = acc[ai][1][m][0], g1 = acc[ai][1][m][1];
            float o[8];
#pragma unroll
            for (int e = 0; e < 4; ++e) { o[e] = v0[e] * fsigmoid(g0[e]); o[4 + e] = v1[e] * fsigmoid(g1[e]); }
            o[0] *= bflo(s.x); o[1] *= bfhi(s.x); o[2] *= bflo(s.y); o[3] *= bfhi(s.y); o[4] *= bflo(s.z); o[5] *= bfhi(s.z); o[6] *= bflo(s.w); o[7] *= bfhi(s.w);
            u32x4 w; w.x = cvt_pk_bf16(o[0], o[1]); w.y = cvt_pk_bf16(o[2], o[3]); w.z = cvt_pk_bf16(o[4], o[5]); w.w = cvt_pk_bf16(o[6], o[7]);
            *(u32x4*)(O + off) = w; }
    }
};
struct EpiMerge {
    static constexpr bool PERM = true;
    const bf16_t* SGA; const bf16_t* Y2; bf16_t* O;
    __device__ __forceinline__ void operator()(AccRef acc, const Unit& u, int wr, int wc, int fr, int fq) const {
        const int row0 = u.pm * BM + wr * 64 + fr, col0 = u.pn * BM + wc * 32 + 8 * fq;
#pragma unroll
        EPI_ROWS {
#pragma unroll
            for (int bj = 0; bj < 2; ++bj) { const size_t off = (size_t)(row0 + ai * HALF + m * 16) * DM + col0 + bj * HALF;
                const u32x4 s = *(const u32x4*)(SGA + off), y = *(const u32x4*)(Y2 + off); const f32x4 v0 = acc[ai][bj][m][0], v1 = acc[ai][bj][m][1];
                u32x4 w; w.x = cvt_pk_bf16(bflo(s.x) * v0[0] + bflo(y.x), bfhi(s.x) * v0[1] + bfhi(y.x)); w.y = cvt_pk_bf16(bflo(s.y) * v0[2] + bflo(y.y), bfhi(s.y) * v0[3] + bfhi(y.y));
                w.z = cvt_pk_bf16(bflo(s.z) * v1[0] + bflo(y.z), bfhi(s.z) * v1[1] + bfhi(y.z)); w.w = cvt_pk_bf16(bflo(s.w) * v1[2] + bflo(y.w), bfhi(s.w) * v1[3] + bfhi(y.w));
                *(u32x4*)(O + off) = w; } }
    }
};
struct EpiResid {
    static constexpr bool PERM = false;
    const float* base; float* H; bf16_t* HB; float* SSQ;
    __device__ __forceinline__ void operator()(AccRef acc, const Unit& u, int wr, int wc, int fr, int fq) const {
        const int row0 = u.pm * BM + wr * 64 + fr, col0 = u.pn * BM + wc * 32 + 4 * fq;
#pragma unroll
        EPI_ROWS { const int row = row0 + ai * HALF + m * 16; const size_t off = (size_t)row * DM + col0; float ss = 0.f;
#pragma unroll
            for (int bj = 0; bj < 2; ++bj)
#pragma unroll
                for (int n = 0; n < 2; ++n) { const size_t o2 = off + bj * HALF + n * 16; const f32x4 h = *(const f32x4*)(base + o2) + acc[ai][bj][m][n];
                    *(f32x4*)(H + o2) = h; u32x2 w; w.x = cvt_pk_bf16(h[0], h[1]); w.y = cvt_pk_bf16(h[2], h[3]); *(u32x2*)(HB + o2) = w;
                    ss += (h[0] * h[0] + h[1] * h[1]) + (h[2] * h[2] + h[3] * h[3]); }
            ss += __shfl_xor(ss, 16); ss += __shfl_xor(ss, 32);
            if (fq == 0) SSQ[(size_t)row * 16 + u.pn * 4 + wc] = ss; }
    }
};
struct EpiXq {
    static constexpr bool PERM = true;
    const float* SSQ; bf16_t* O;
    __device__ __forceinline__ void operator()(AccRef acc, const Unit& u, int wr, int wc, int fr, int fq) const {
        const int row0 = u.pm * BM + wr * 64 + fr, col0 = u.pn * BM + wc * 32 + 8 * fq;
#pragma unroll
        EPI_ROWS { const int row = row0 + ai * HALF + m * 16; const f32x4* sp = (const f32x4*)(SSQ + (size_t)row * 16);
            const f32x4 a = sp[0] + sp[1] + sp[2] + sp[3]; const float rs = __builtin_amdgcn_rsqf(((a[0] + a[1]) + (a[2] + a[3])) * (1.0f / DM) + RMS_EPS) * XSCALE;
            bf16_t* rowp = O + (size_t)row * XW + col0;
#pragma unroll
            for (int bj = 0; bj < 2; ++bj) { const f32x4 v0 = acc[ai][bj][m][0] * rs, v1 = acc[ai][bj][m][1] * rs;
                u32x4 w; w.x = cvt_pk_bf16(v0[0], v0[1]); w.y = cvt_pk_bf16(v0[2], v0[3]); w.z = cvt_pk_bf16(v1[0], v1[1]); w.w = cvt_pk_bf16(v1[2], v1[3]);
                *(u32x4*)(rowp + bj * HALF) = w; } }
    }
};
struct EpiMoe1 {
    static constexpr bool PERM = true;
    const float* rstd2; const float* bgu; bf16_t* HID; const LAS int* gidx;
    __device__ __forceinline__ void operator()(AccRef acc, const Unit& u, int wr, int wc, int fr, int fq) const {
        const int rl0 = wr * 64 + fr, col0 = u.pn * HALF + wc * 32 + 8 * fq; const float* bg = bgu + (size_t)u.e * (2 * DFF) + col0;
        const f32x4 bg0 = *(const f32x4*)(bg), bg1 = *(const f32x4*)(bg + 4), bu0 = *(const f32x4*)(bg + DFF), bu1 = *(const f32x4*)(bg + DFF + 4);
#pragma unroll
        EPI_ROWS { const int rl = rl0 + ai * HALF + m * 16; const float rs = rstd2[gidx[u.ui * 256 + rl]];
            const f32x4 g0 = acc[ai][0][m][0] * rs + bg0, g1 = acc[ai][0][m][1] * rs + bg1, p0 = acc[ai][1][m][0] * rs + bu0, p1 = acc[ai][1][m][1] * rs + bu1;
            float o[8];
#pragma unroll
            for (int e = 0; e < 4; ++e) { const float ga = fminf(g0[e], 7.0f), gb = fminf(g1[e], 7.0f), ua = fminf(fmaxf(p0[e], -7.0f), 7.0f), ub = fminf(fmaxf(p1[e], -7.0f), 7.0f);
                o[e] = (ua + 1.0f) * ga * fsigmoid(1.702f * ga); o[4 + e] = (ub + 1.0f) * gb * fsigmoid(1.702f * gb); }
            u32x4 w; w.x = cvt_pk_bf16(o[0], o[1]); w.y = cvt_pk_bf16(o[2], o[3]); w.z = cvt_pk_bf16(o[4], o[5]); w.w = cvt_pk_bf16(o[6], o[7]);
            *(u32x4*)(HID + (size_t)(u.pm * BM + rl) * DFF + col0) = w; }
    }
};
struct EpiMoe2 {
    static constexpr bool PERM = true;
    const float* bdn; const float* tkg; const int* rowlist; const unsigned* cnt; bf16_t* Y;
    __device__ __forceinline__ void operator()(AccRef acc, const Unit& u, int wr, int wc, int fr, int fq) const {
        const int rl0 = wr * 64 + fr, col0 = u.pn * BM + wc * 32 + 8 * fq; const float* bd = bdn + (size_t)u.e * DM + col0; const int ce = (int)cnt[u.e];
        f32x4 bv[2][2];
#pragma unroll
        for (int bj = 0; bj < 2; ++bj)
#pragma unroll
            for (int n = 0; n < 2; ++n) bv[bj][n] = *(const f32x4*)(bd + bj * HALF + 4 * n);
#pragma unroll
        EPI_ROWS { const int rank = u.mi * BM + rl0 + ai * HALF + m * 16;
            if (rank < ce) { const int dest = rowlist[(size_t)u.e * T_ + rank]; const float gt = tkg[dest]; bf16_t* rowp = Y + (size_t)dest * DM + col0;
#pragma unroll
                for (int bj = 0; bj < 2; ++bj) { const f32x4 v0 = (acc[ai][bj][m][0] + bv[bj][0]) * gt, v1 = (acc[ai][bj][m][1] + bv[bj][1]) * gt;
                    u32x4 w; w.x = cvt_pk_bf16(v0[0], v0[1]); w.y = cvt_pk_bf16(v0[2], v0[3]); w.z = cvt_pk_bf16(v1[0], v1[1]); w.w = cvt_pk_bf16(v1[2], v1[3]);
                    *(u32x4*)(rowp + bj * HALF) = w; } } }
    }
};
}

struct MoeOrder {
    pg8::PatchOrder P; const LAS int* pref;
    __device__ __forceinline__ bool next(int i, pg8::Unit& u) const {
        if (!P.next(i, u)) return false;
        int e = 0;
#pragma unroll 1
        for (int k = 1; k < NE; ++k) e += (pref[k] <= u.pm) ? 1 : 0;
        u.e = e; u.mi = u.pm - pref[e]; return true;
    }
};

#define XB_TMO      128
#define XB_XCNT(j)  (256  + 64 * (j))
#define XB_XSUB(j)  (1280 + 64 * (j))
#define XB_XGEN(j)  (2304 + 64 * (j))
#define XB_TOP      3328
#define XB_TOPGEN   3392
#define XCD_BAR_WORDS 3456
#define XB_SPIN_CAP (1u << 20)
__device__ __forceinline__ unsigned xb_ld(unsigned* p)              { return __hip_atomic_load(p, __ATOMIC_RELAXED, __HIP_MEMORY_SCOPE_AGENT); }
__device__ __forceinline__ unsigned xb_add(unsigned* p, unsigned v) { return __hip_atomic_fetch_add(p, v, __ATOMIC_RELAXED, __HIP_MEMORY_SCOPE_AGENT); }
__device__ __forceinline__ unsigned xb_xcc_id() { return (unsigned)__builtin_amdgcn_s_getreg((3 << 11) | 20) & 0xFu; }
#define XB_SPIN(cond, bar) do { unsigned _sp = 0; while (cond) { __builtin_amdgcn_s_sleep(1); \
    if ((++_sp & 255u) == 0u) { if (xb_ld(&(bar)[XB_TMO])) break; if (_sp > XB_SPIN_CAP) { atomicAdd(&(bar)[XB_TMO], 1u); break; } } } } while (0)
struct XcdBarrier { unsigned* bar; unsigned x; volatile LAS unsigned* st; };
__device__ __forceinline__ XcdBarrier xcd_barrier_post(unsigned* bar, volatile LAS unsigned* st) {
    XcdBarrier b; b.bar = bar; b.x = xb_xcc_id(); b.st = st;
    if (threadIdx.x == 0) (void)xb_add(&bar[XB_XCNT(b.x)], 1u);
    return b;
}
__device__ __forceinline__ void xcd_barrier_complete(unsigned* bar, unsigned x, unsigned& nloc, unsigned& nx) {
    const unsigned G = gridDim.x * gridDim.y * gridDim.z;
    unsigned sum, cnt, mine, sp = 0u;
    for (;;) {
        sum = 0u; cnt = 0u; mine = 0u;
#pragma unroll
        for (unsigned j = 0; j < 16; ++j) { const unsigned c = xb_ld(&bar[XB_XCNT(j)]); sum += c; cnt += (c > 0u) ? 1u : 0u; mine = (j == x) ? c : mine; }
        if (sum == G) break;
        __builtin_amdgcn_s_sleep(1);
        if ((++sp & 255u) == 0u) { if (xb_ld(&bar[XB_TMO])) break; if (sp > XB_SPIN_CAP) { atomicAdd(&bar[XB_TMO], 1u); break; } }
    }
    nloc = mine > 0u ? mine : 1u; nx = cnt > 0u ? cnt : 1u;
}
__device__ __forceinline__ void xcd_barrier(const XcdBarrier& b) {
    asm volatile("s_waitcnt vmcnt(0)" ::: "memory");
    __syncthreads();
    if (threadIdx.x == 0) {
        unsigned* bar = b.bar;
        __builtin_amdgcn_s_waitcnt(0);
        unsigned nloc = b.st[0], nx = b.st[1];
        if (nloc == 0u) { xcd_barrier_complete(bar, b.x, nloc, nx); b.st[0] = nloc; b.st[1] = nx; }
        const unsigned old = xb_add(&bar[XB_XSUB(b.x)], 1u);
        const unsigned gen = old / nloc;
        if (old + 1u == (gen + 1u) * nloc) {
            __builtin_amdgcn_fence(__ATOMIC_RELEASE, "agent");
            asm volatile("s_waitcnt vmcnt(0)" ::: "memory");
            const unsigned og = xb_add(&bar[XB_TOP], 1u);
            const unsigned tg = og / nx;
            if (og + 1u == (tg + 1u) * nx) xb_add(&bar[XB_TOPGEN], 1u);
            else XB_SPIN(xb_ld(&bar[XB_TOPGEN]) == tg, bar);
            __builtin_amdgcn_fence(__ATOMIC_ACQUIRE, "agent");
            xb_add(&bar[XB_XGEN(b.x)], 1u);
            asm volatile("s_waitcnt vmcnt(0)" ::: "memory");
        } else {
            XB_SPIN(xb_ld(&bar[XB_XGEN(b.x)]) == gen, bar);
            __builtin_amdgcn_fence(__ATOMIC_ACQUIRE, "agent");
            asm volatile("s_waitcnt vmcnt(0)" ::: "memory");
        }
    }
    __syncthreads();
}

struct Args { const float* in[28]; float* out; unsigned char* ws; int ph_lo, ph_hi; };
enum { I_X = 0, I_MEM, I_GMIX, I_WIN, I_ARE, I_AIM, I_LOGDT, I_BRE, I_BIM, I_CRE, I_CIM, I_DSKIP, I_WGLU, I_WPA, I_WOUT, I_GXATTN, I_GMEM, I_WXQ, I_WXKV, I_WXO,
       I_GMOE, I_WROUTER, I_BROUTER, I_WGU, I_BGU, I_WDN, I_BDN, I_GFINAL };

template <int MAP>
__device__ __forceinline__ void p0_transpose_item(const float* W, int K, int N, const float* gain, bf16_t* WT, LAS float* scr, int item, int lane) {
    const int nblk = N / 32, kb = item / nblk, nb = item % nblk, k0 = 64 * kb, n0 = 32 * nb;
#pragma unroll 8
    for (int i = 0; i < 32; ++i) { const int kk = 2 * i + (lane >> 5); float v = W[(size_t)(k0 + kk) * N + n0 + (lane & 31)]; if (gain) v *= gain[k0 + kk]; scr[kk * 33 + (lane & 31)] = v; }
    asm volatile("s_waitcnt lgkmcnt(0)" ::: "memory");
    const int c = lane & 7;
    const int nr0 = (MAP == 1) ? (256 * ((n0 % 1024) / 128) + 128 * (n0 / 1024) + (n0 % 128)) : n0;
#pragma unroll
    for (int j = 0; j < 4; ++j) { const int n = (lane >> 3) + 8 * j; const LAS float* s = scr + (8 * c) * 33 + n;
        u32x4 o; o.x = pk2(s[0 * 33], s[1 * 33]); o.y = pk2(s[2 * 33], s[3 * 33]); o.z = pk2(s[4 * 33], s[5 * 33]); o.w = pk2(s[6 * 33], s[7 * 33]);
        *(u32x4*)(WT + (size_t)(nr0 + n) * K + k0 + 8 * c) = o; }
    asm volatile("s_waitcnt lgkmcnt(0)" ::: "memory");
}
template <int MODE>
__device__ __forceinline__ float rms_row_to_bf16(const float* xrow, const float* gain, bf16_t* orow, int lane) {
    const f32x4* xr = (const f32x4*)xrow + lane;
    f32x4 v[4]; float s = 0.f;
#pragma unroll
    for (int j = 0; j < 4; ++j) { v[j] = xr[64 * j]; s += (v[j][0] * v[j][0] + v[j][1] * v[j][1]) + (v[j][2] * v[j][2] + v[j][3] * v[j][3]); }
    const float rstd = 1.0f / sqrtf(wave_sum(s) * (1.0f / DM) + RMS_EPS);
    u32x2* o8 = (u32x2*)orow + lane;
#pragma unroll
    for (int j = 0; j < 4; ++j) { f32x4 w = v[j];
        if (MODE == 1) { const f32x4 g = ((const f32x4*)gain)[lane + 64 * j]; w = w * rstd * g; }
        u32x2 o; o.x = pk2(w[0], w[1]); o.y = pk2(w[2], w[3]); o8[64 * j] = o; }
    return rstd;
}

struct Frame {
    LAS unsigned char* lds; int tid, lane, wave, G, bid;
    const float* in[28]; float* out; unsigned char* ws; unsigned* ctl;
};
#define WSP(type, off) ((type*)(F.ws + (off)))

__device__ __forceinline__ void phase_prologue(Frame& F) {
    LAS float* scr = (LAS float*)(F.lds + F.wave * 16384);
    const int gw = F.bid * 8 + F.wave, NGW = F.G * 8;
    for (int m = gw; m < T_; m += NGW) { const float r = rms_row_to_bf16<0>(F.in[I_X] + (size_t)m * DM, nullptr, WSP(bf16_t, WS_XB) + (size_t)m * DM, F.lane); if (F.lane == 0) WSP(float, WS_RSTD0)[m] = r; }
    for (int m = gw; m < NB * MEML; m += NGW) (void)rms_row_to_bf16<1>(F.in[I_MEM] + (size_t)m * DM, F.in[I_GMEM], WSP(bf16_t, WS_MN) + (size_t)m * DM, F.lane);
    constexpr int I_IN = (DM / 64) * (INW / 32), I_GLU = (SW / 64) * (2 * DM / 32), I_PA = (AW / 64) * (DM / 32), I_OUT = (DM / 64) * (DM / 32), I_XQ = (DM / 64) * (XW / 32),
                  I_XKV = (DM / 64) * (2 * XW / 32), I_XO = (XW / 64) * (DM / 32), I_GU1 = (DM / 64) * (2 * DFF / 32), I_DN1 = (DFF / 64) * (DM / 32);
    constexpr int NITEMS = I_IN + I_GLU + I_PA + I_OUT + I_XQ + I_XKV + I_XO + NE * (I_GU1 + I_DN1);
    for (int it = gw; it < NITEMS; it += NGW) {
        int r = it;
        if (r < I_IN) { p0_transpose_item<0>(F.in[I_WIN], DM, INW, F.in[I_GMIX], WSP(bf16_t, WS_WIN), scr, r, F.lane); continue; } r -= I_IN;
        if (r < I_GLU) { p0_transpose_item<1>(F.in[I_WGLU], SW, 2 * DM, nullptr, WSP(bf16_t, WS_WGLU), scr, r, F.lane); continue; } r -= I_GLU;
        if (r < I_PA) { p0_transpose_item<0>(F.in[I_WPA], AW, DM, nullptr, WSP(bf16_t, WS_WPA), scr, r, F.lane); continue; } r -= I_PA;
        if (r < I_OUT) { p0_transpose_item<0>(F.in[I_WOUT], DM, DM, nullptr, WSP(bf16_t, WS_WOUT), scr, r, F.lane); continue; } r -= I_OUT;
        if (r < I_XQ) { p0_transpose_item<0>(F.in[I_WXQ], DM, XW, F.in[I_GXATTN], WSP(bf16_t, WS_WXQ), scr, r, F.lane); continue; } r -= I_XQ;
        if (r < I_XKV) { p0_transpose_item<0>(F.in[I_WXKV], DM, 2 * XW, nullptr, WSP(bf16_t, WS_WXKV), scr, r, F.lane); continue; } r -= I_XKV;
        if (r < I_XO) { p0_transpose_item<0>(F.in[I_WXO], XW, DM, nullptr, WSP(bf16_t, WS_WXO), scr, r, F.lane); continue; } r -= I_XO;
        const int e = r / (I_GU1 + I_DN1); r -= e * (I_GU1 + I_DN1);
        if (r < I_GU1) p0_transpose_item<1>(F.in[I_WGU] + (size_t)e * DM * 2 * DFF, DM, 2 * DFF, F.in[I_GMOE], WSP(bf16_t, WS_WGU) + (size_t)e * 2 * DFF * DM, scr, r, F.lane);
        else p0_transpose_item<0>(F.in[I_WDN] + (size_t)e * DFF * DM, DFF, DM, nullptr, WSP(bf16_t, WS_WDN) + (size_t)e * DM * DFF, scr, r - I_GU1, F.lane);
    }
}

__device__ __forceinline__ void phase_kmean(Frame& F) {
    LAS float* red = (LAS float*)F.lds;
    const bf16_t* Kb = WSP(bf16_t, WS_K);
    for (int it = F.bid; it < NB * NH * NBLK; it += F.G) {
        const int j = it % NBLK, h = (it / NBLK) % NH, b = it / (NBLK * NH);
        const int col = F.tid & 63, rg = F.tid >> 6; float s = 0.f;
        const bf16_t* p = Kb + ((size_t)(b * SEQ + j * MBLK + rg * 32)) * AW + h * HD + col;
#pragma unroll 8
        for (int r = 0; r < 32; ++r) s += bf2f(p[(size_t)r * AW]);
        red[rg * 64 + col] = s;
        __syncthreads();
        if (F.tid < 64) { float t = 0.f;
#pragma unroll
            for (int k = 0; k < 8; ++k) t += red[k * 64 + F.tid];
            WSP(float, WS_KMEAN)[(size_t)it * HD + F.tid] = t * (1.0f / MBLK); }
        __syncthreads();
    }
}

__device__ __forceinline__ void phase_moba_simple(Frame& F) {
    LAS unsigned* Ks = (LAS unsigned*)F.lds;
    LAS unsigned* Vs = (LAS unsigned*)(F.lds + 32768);
    LAS float* km = (LAS float*)(F.lds + 65536);
    const bf16_t *Qb = WSP(bf16_t, WS_Q), *Kb = WSP(bf16_t, WS_K), *Vb = WSP(bf16_t, WS_V); bf16_t* Ob = WSP(bf16_t, WS_ATT);
    const int ql = F.tid >> 1, half = F.tid & 1;
    for (int it = F.bid; it < NB * NH * NBLK; it += F.G) {
        const int iblk = (NBLK - 1) - (it % NBLK), h = (it / NBLK) % NH, b = it / (NBLK * NH);
        __syncthreads();
        for (int k = F.tid; k < NBLK * HD; k += 512) km[k] = WSP(float, WS_KMEAN)[(size_t)((b * NH + h) * NBLK) * HD + k];
        float q[32];
        { const u32x4* qp = (const u32x4*)(Qb + (size_t)(b * SEQ + iblk * MBLK + ql) * AW + h * HD + half * 32);
#pragma unroll
          for (int c = 0; c < 4; ++c) { const u32x4 w = qp[c]; q[8 * c + 0] = bflo(w.x); q[8 * c + 1] = bfhi(w.x); q[8 * c + 2] = bflo(w.y); q[8 * c + 3] = bfhi(w.y); q[8 * c + 4] = bflo(w.z); q[8 * c + 5] = bfhi(w.z); q[8 * c + 6] = bflo(w.w); q[8 * c + 7] = bfhi(w.w); } }
        __syncthreads();
        float g0 = -3e38f, g1 = -3e38f, g2 = -3e38f; int s0 = -1, s1 = -1, s2 = -1;
        for (int j = 0; j < iblk; ++j) { float g = 0.f;
#pragma unroll
            for (int d = 0; d < 32; ++d) g += q[d] * km[j * HD + half * 32 + d];
            g += __shfl_xor(g, 1);
            if (g > g0) { g2 = g1; s2 = s1; g1 = g0; s1 = s0; g0 = g; s0 = j; } else if (g > g1) { g2 = g1; s2 = s1; g1 = g; s1 = j; } else if (g > g2) { g2 = g; s2 = j; } }
        float mx = -3e38f, l = 0.f, o[32];
#pragma unroll
        for (int d = 0; d < 32; ++d) o[d] = 0.f;
        for (int jb = 0; jb <= iblk; ++jb) {
            __syncthreads();
            { const size_t rowb = (size_t)(b * SEQ + jb * MBLK);
              for (int c = F.tid; c < 256 * 8; c += 512) { const int r = c >> 3, ch = c & 7;
                  *(LAS u32x4*)(Ks + r * 32 + ch * 4) = *(const u32x4*)(Kb + (rowb + r) * AW + h * HD + ch * 8);
                  *(LAS u32x4*)(Vs + r * 32 + ch * 4) = *(const u32x4*)(Vb + (rowb + r) * AW + h * HD + ch * 8); } }
            __syncthreads();
            const bool need = (jb == iblk) || jb == s0 || jb == s1 || jb == s2;
            if (need) { const int kend = (jb == iblk) ? ql : 255;
                for (int kk = 0; kk <= kend; ++kk) { float s = 0.f;
#pragma unroll
                    for (int c = 0; c < 4; ++c) { const u32x4 w = *(const LAS u32x4*)(Ks + kk * 32 + half * 16 + c * 4);
                        s += q[8 * c + 0] * bflo(w.x) + q[8 * c + 1] * bfhi(w.x) + q[8 * c + 2] * bflo(w.y) + q[8 * c + 3] * bfhi(w.y) + q[8 * c + 4] * bflo(w.z) + q[8 * c + 5] * bfhi(w.z) + q[8 * c + 6] * bflo(w.w) + q[8 * c + 7] * bfhi(w.w); }
                    s += __shfl_xor(s, 1);
                    const float mn = fmaxf(mx, s), corr = __builtin_amdgcn_exp2f(mx - mn), p = __builtin_amdgcn_exp2f(s - mn); mx = mn; l = l * corr + p;
#pragma unroll
                    for (int c = 0; c < 4; ++c) { const u32x4 w = *(const LAS u32x4*)(Vs + kk * 32 + half * 16 + c * 4);
                        o[8 * c + 0] = o[8 * c + 0] * corr + p * bflo(w.x); o[8 * c + 1] = o[8 * c + 1] * corr + p * bfhi(w.x); o[8 * c + 2] = o[8 * c + 2] * corr + p * bflo(w.y); o[8 * c + 3] = o[8 * c + 3] * corr + p * bfhi(w.y);
                        o[8 * c + 4] = o[8 * c + 4] * corr + p * bflo(w.z); o[8 * c + 5] = o[8 * c + 5] * corr + p * bfhi(w.z); o[8 * c + 6] = o[8 * c + 6] * corr + p * bflo(w.w); o[8 * c + 7] = o[8 * c + 7] * corr + p * bfhi(w.w); } } }
        }
        const float il = 1.0f / l;
        u32x4* op = (u32x4*)(Ob + (size_t)(b * SEQ + iblk * MBLK + ql) * AW + h * HD + half * 32);
#pragma unroll
        for (int c = 0; c < 4; ++c) { u32x4 w; w.x = pk2(o[8 * c + 0] * il, o[8 * c + 1] * il); w.y = pk2(o[8 * c + 2] * il, o[8 * c + 3] * il); w.z = pk2(o[8 * c + 4] * il, o[8 * c + 5] * il); w.w = pk2(o[8 * c + 6] * il, o[8 * c + 7] * il); op[c] = w; }
    }
}

__device__ __forceinline__ void phase_ssm_simple(Frame& F) {
    const int gw = F.bid * 8 + F.wave, NGW = F.G * 8, p = F.lane;
    const bf16_t* Ub = WSP(bf16_t, WS_U); bf16_t* Yb = WSP(bf16_t, WS_YB);
    for (int it = gw; it < NB * NG; it += NGW) {
        const int g = it % NG, b = it / NG;
        const float are = fminf(F.in[I_ARE][g * SP + p], -1e-4f), aim = F.in[I_AIM][g * SP + p], dt = expf(F.in[I_LOGDT][g]);
        const float mag = expf(are * dt), ang = aim * dt; const float lr = mag * cosf(ang), li = mag * sinf(ang);
        const float nr = lr - 1.0f, ni = li, den = 1.0f / (are * are + aim * aim); const float fr_ = (nr * are + ni * aim) * den, fi_ = (ni * are - nr * aim) * den;
        float bbr[16], bbi[16], cr[16], ci[16], dsk[16];
#pragma unroll
        for (int c = 0; c < 16; ++c) { const float br = F.in[I_BRE][(size_t)(g * SP + p) * SGC + c], bi = F.in[I_BIM][(size_t)(g * SP + p) * SGC + c];
            bbr[c] = fr_ * br - fi_ * bi; bbi[c] = fr_ * bi + fi_ * br;
            cr[c] = F.in[I_CRE][(size_t)(g * SGC + c) * SP + p]; ci[c] = F.in[I_CIM][(size_t)(g * SGC + c) * SP + p]; dsk[c] = F.in[I_DSKIP][g * SGC + c]; }
        float xr = 0.f, xi = 0.f;
        const int csel = ((p >> 5) & 1) * 8 + ((p >> 4) & 1) * 4 + ((p >> 3) & 1) * 2 + ((p >> 2) & 1);
        float dmine = 0.f;
#pragma unroll
        for (int c = 0; c < 16; ++c) dmine = (c == csel) ? dsk[c] : dmine;
        for (int t = 0; t < SEQ; ++t) {
            const u32x4* up = (const u32x4*)(Ub + (size_t)(b * SEQ + t) * SW + g * SGC); const u32x4 w0 = up[0], w1 = up[1];
            float u[16]; u[0] = bflo(w0.x); u[1] = bfhi(w0.x); u[2] = bflo(w0.y); u[3] = bfhi(w0.y); u[4] = bflo(w0.z); u[5] = bfhi(w0.z); u[6] = bflo(w0.w); u[7] = bfhi(w0.w);
            u[8] = bflo(w1.x); u[9] = bfhi(w1.x); u[10] = bflo(w1.y); u[11] = bfhi(w1.y); u[12] = bflo(w1.z); u[13] = bfhi(w1.z); u[14] = bflo(w1.w); u[15] = bfhi(w1.w);
            float sr = 0.f, si = 0.f;
#pragma unroll
            for (int c = 0; c < 16; ++c) { sr += bbr[c] * u[c]; si += bbi[c] * u[c]; }
            const float nxr = lr * xr - li * xi + sr, nxi = lr * xi + li * xr + si; xr = nxr; xi = nxi;
            float y[16];
#pragma unroll
            for (int c = 0; c < 16; ++c) y[c] = cr[c] * xr - ci[c] * xi;
            float w8[8], w4[4], w2[2], w1_;
            { const bool hi = (p & 32) != 0;
#pragma unroll
              for (int i = 0; i < 8; ++i) { const float keep = hi ? y[i + 8] : y[i], send = hi ? y[i] : y[i + 8]; w8[i] = keep + __shfl_xor(send, 32); } }
            { const bool hi = (p & 16) != 0;
#pragma unroll
              for (int i = 0; i < 4; ++i) { const float keep = hi ? w8[i + 4] : w8[i], send = hi ? w8[i] : w8[i + 4]; w4[i] = keep + __shfl_xor(send, 16); } }
            { const bool hi = (p & 8) != 0;
#pragma unroll
              for (int i = 0; i < 2; ++i) { const float keep = hi ? w4[i + 2] : w4[i], send = hi ? w4[i] : w4[i + 2]; w2[i] = keep + __shfl_xor(send, 8); } }
            { const bool hi = (p & 4) != 0; const float keep = hi ? w2[1] : w2[0], send = hi ? w2[0] : w2[1]; w1_ = keep + __shfl_xor(send, 4); }
            w1_ += __shfl_xor(w1_, 2); w1_ += __shfl_xor(w1_, 1);
            float umine = 0.f;
#pragma unroll
            for (int c = 0; c < 16; ++c) umine = (c == csel) ? u[c] : umine;
            if ((p & 3) == 0) Yb[(size_t)(b * SEQ + t) * SW + g * SGC + csel] = (bf16_t)f2bf(gelu_tanh(w1_ + dmine * umine));
        }
    }
}

__device__ __forceinline__ void phase_xattn_simple(Frame& F) {
    LAS unsigned* Ks = (LAS unsigned*)F.lds;
    LAS unsigned* Vs = (LAS unsigned*)(F.lds + 65536);
    const bf16_t *Qb = WSP(bf16_t, WS_XQ), *KV = WSP(bf16_t, WS_MKV); bf16_t* Ob = WSP(bf16_t, WS_XO);
    const int tl = F.tid >> 2, part = F.tid & 3;
    int lastbh = -1;
    for (int it = F.bid; it < NB * XH * (SEQ / 128); it += F.G) {
        const int bh = it / (SEQ / 128), ch = it % (SEQ / 128), b = bh / XH, h = bh % XH;
        if (bh != lastbh) { __syncthreads();
            for (int c = F.tid; c < 256 * 16; c += 512) { const int r = c >> 4, cc = c & 15;
                *(LAS u32x4*)(Ks + r * 64 + cc * 4) = *(const u32x4*)(KV + (size_t)(b * MEML + r) * (2 * XW) + h * XD + cc * 8);
                *(LAS u32x4*)(Vs + r * 64 + cc * 4) = *(const u32x4*)(KV + (size_t)(b * MEML + r) * (2 * XW) + XW + h * XD + cc * 8); }
            __syncthreads(); lastbh = bh; }
        const size_t row = (size_t)b * SEQ + ch * 128 + tl;
        float q[32];
        { const u32x4* qp = (const u32x4*)(Qb + row * XW + h * XD + part * 32);
#pragma unroll
          for (int c = 0; c < 4; ++c) { const u32x4 w = qp[c]; q[8 * c + 0] = bflo(w.x); q[8 * c + 1] = bfhi(w.x); q[8 * c + 2] = bflo(w.y); q[8 * c + 3] = bfhi(w.y); q[8 * c + 4] = bflo(w.z); q[8 * c + 5] = bfhi(w.z); q[8 * c + 6] = bflo(w.w); q[8 * c + 7] = bfhi(w.w); } }
        float mx = -3e38f, l = 0.f, o[32];
#pragma unroll
        for (int d = 0; d < 32; ++d) o[d] = 0.f;
        for (int kk = 0; kk < MEML; ++kk) { float s = 0.f;
#pragma unroll
            for (int c = 0; c < 4; ++c) { const u32x4 w = *(const LAS u32x4*)(Ks + kk * 64 + part * 16 + c * 4);
                s += q[8 * c + 0] * bflo(w.x) + q[8 * c + 1] * bfhi(w.x) + q[8 * c + 2] * bflo(w.y) + q[8 * c + 3] * bfhi(w.y) + q[8 * c + 4] * bflo(w.z) + q[8 * c + 5] * bfhi(w.z) + q[8 * c + 6] * bflo(w.w) + q[8 * c + 7] * bfhi(w.w); }
            s += __shfl_xor(s, 1); s += __shfl_xor(s, 2);
            const float mn = fmaxf(mx, s), corr = __builtin_amdgcn_exp2f(mx - mn), p = __builtin_amdgcn_exp2f(s - mn); mx = mn; l = l * corr + p;
#pragma unroll
            for (int c = 0; c < 4; ++c) { const u32x4 w = *(const LAS u32x4*)(Vs + kk * 64 + part * 16 + c * 4);
                o[8 * c + 0] = o[8 * c + 0] * corr + p * bflo(w.x); o[8 * c + 1] = o[8 * c + 1] * corr + p * bfhi(w.x); o[8 * c + 2] = o[8 * c + 2] * corr + p * bflo(w.y); o[8 * c + 3] = o[8 * c + 3] * corr + p * bfhi(w.y);
                o[8 * c + 4] = o[8 * c + 4] * corr + p * bflo(w.z); o[8 * c + 5] = o[8 * c + 5] * corr + p * bfhi(w.z); o[8 * c + 6] = o[8 * c + 6] * corr + p * bflo(w.w); o[8 * c + 7] = o[8 * c + 7] * corr + p * bfhi(w.w); } }
        const float il = 1.0f / l;
        u32x4* op = (u32x4*)(Ob + row * XW + h * XD + part * 32);
#pragma unroll
        for (int c = 0; c < 4; ++c) { u32x4 w; w.x = pk2(o[8 * c + 0] * il, o[8 * c + 1] * il); w.y = pk2(o[8 * c + 2] * il, o[8 * c + 3] * il); w.z = pk2(o[8 * c + 4] * il, o[8 * c + 5] * il); w.w = pk2(o[8 * c + 6] * il, o[8 * c + 7] * il); op[c] = w; }
    }
}

__device__ __forceinline__ void phase_router(Frame& F) {
    LAS float* wt = (LAS float*)F.lds;
    for (int c = F.tid; c < NE * DM; c += 512) { const int k = c >> 5, e = c & 31; wt[e * DM + k] = F.in[I_WROUTER][c] * F.in[I_GMOE][k]; }
    __syncthreads();
    const int gw = F.bid * 8 + F.wave, NGW = F.G * 8, lane = F.lane;
    const float* H = WSP(float, WS_H);
    unsigned* cnt = F.ctl + CW_CNT;
    for (int tk = gw; tk < T_; tk += NGW) {
        const f32x4* hp = (const f32x4*)(H + (size_t)tk * DM) + lane; f32x4 hv[4]; float ss = 0.f;
#pragma unroll
        for (int j = 0; j < 4; ++j) { hv[j] = hp[64 * j]; ss += (hv[j][0] * hv[j][0] + hv[j][1] * hv[j][1]) + (hv[j][2] * hv[j][2] + hv[j][3] * hv[j][3]); }
        const float rstd = 1.0f / sqrtf(wave_sum(ss) * (1.0f / DM) + RMS_EPS);
        float mylogit = 0.f;
#pragma unroll 4
        for (int e = 0; e < NE; ++e) { float a = 0.f;
#pragma unroll
            for (int j = 0; j < 4; ++j) { const f32x4 w = *(const LAS f32x4*)(wt + e * DM + 4 * lane + 256 * j); a += (hv[j][0] * w[0] + hv[j][1] * w[1]) + (hv[j][2] * w[2] + hv[j][3] * w[3]); }
            a = wave_sum(a);
            mylogit = (lane == e) ? a : mylogit; }
        mylogit = (lane < NE) ? (mylogit * rstd + F.in[I_BROUTER][lane & 31]) : -3e38f;
        float tv[4]; int ti[4]; float cur = mylogit;
#pragma unroll
        for (int s = 0; s < 4; ++s) { float bv = cur; int bi = lane;
#pragma unroll
            for (int o = 1; o < 64; o <<= 1) { const float ov = __shfl_xor(bv, o); const int oi = __shfl_xor(bi, o); if (ov > bv || (ov == bv && oi < bi)) { bv = ov; bi = oi; } }
            tv[s] = bv; ti[s] = bi; if (lane == bi) cur = -3e38f; }
        const float e1 = __expf(tv[1] - tv[0]), e2 = __expf(tv[2] - tv[0]), e3 = __expf(tv[3] - tv[0]); const float inv = 1.0f / (1.0f + e1 + e2 + e3);
        if (lane == 0) WSP(float, WS_RSTD2)[tk] = rstd;
        if (lane < 4) { const int ex = (lane == 0) ? ti[0] : (lane == 1) ? ti[1] : (lane == 2) ? ti[2] : ti[3]; const float gv = ((lane == 0) ? 1.0f : (lane == 1) ? e1 : (lane == 2) ? e2 : e3) * inv;
            WSP(float, WS_TKG)[(size_t)tk * 4 + lane] = gv;
            const unsigned rank = atomicAdd(&cnt[ex], 1u);
            WSP(int, WS_ROWLIST)[(size_t)ex * T_ + rank] = tk * 4 + lane; }
    }
}

__device__ __forceinline__ void phase_final(Frame& F) {
    const int gw = F.bid * 8 + F.wave, NGW = F.G * 8, lane = F.lane;
    const float* H = WSP(float, WS_H); const bf16_t* Y = WSP(bf16_t, WS_Y);
    for (int tk = gw; tk < T_; tk += NGW) {
        const f32x4* hp = (const f32x4*)(H + (size_t)tk * DM) + lane; f32x4 hv[4];
#pragma unroll
        for (int j = 0; j < 4; ++j) hv[j] = hp[64 * j];
#pragma unroll
        for (int s = 0; s < 4; ++s) { const u32x2* yp = (const u32x2*)(Y + ((size_t)tk * 4 + s) * DM) + lane;
#pragma unroll
            for (int j = 0; j < 4; ++j) { const u32x2 w = yp[64 * j]; hv[j][0] += bflo(w.x); hv[j][1] += bfhi(w.x); hv[j][2] += bflo(w.y); hv[j][3] += bfhi(w.y); } }
        float ss = 0.f;
#pragma unroll
        for (int j = 0; j < 4; ++j) ss += (hv[j][0] * hv[j][0] + hv[j][1] * hv[j][1]) + (hv[j][2] * hv[j][2] + hv[j][3] * hv[j][3]);
        const float rstd = 1.0f / sqrtf(wave_sum(ss) * (1.0f / DM) + RMS_EPS);
        f32x4* op = (f32x4*)(F.out + (size_t)tk * DM) + lane;
#pragma unroll
        for (int j = 0; j < 4; ++j) op[64 * j] = hv[j] * rstd * ((const f32x4*)F.in[I_GFINAL])[lane + 64 * j];
    }
}

constexpr int N_PHASES = 14;
__global__ void __launch_bounds__(512, 2) mega_fwd(Args args) {
    extern __shared__ __attribute__((aligned(16))) unsigned char lds_raw[];
    Frame F;
    F.lds = (LAS unsigned char*)lds_raw; F.tid = threadIdx.x; F.lane = F.tid & 63; F.wave = __builtin_amdgcn_readfirstlane(F.tid >> 6); F.G = gridDim.x; F.bid = blockIdx.x;
#pragma unroll
    for (int i = 0; i < 28; ++i) F.in[i] = args.in[i];
    F.out = args.out; F.ws = args.ws; F.ctl = (unsigned*)(args.ws + WS_CTL);
    volatile LAS unsigned* MISC = (volatile LAS unsigned*)(F.lds + MISC_OFF);
    if (F.tid < 64) MISC[F.tid] = 0u;
    __syncthreads();
    const int lo = args.ph_lo, hi = args.ph_hi;
    XcdBarrier bar; bar.bar = F.ctl + CW_BAR; bar.x = 0; bar.st = nullptr;
    if (hi - lo > 1) bar = xcd_barrier_post(F.ctl + CW_BAR, MISC + 8);
#define IN(k) (lo <= (k) && (k) < hi)
#define SEAM(k) do { if (IN(k) && IN((k) + 1)) xcd_barrier(bar); } while (0)
    LAS unsigned char* ring = F.lds;
    const LAS int* gidx = (const LAS int*)(F.lds + GIDX_OFF);

    if (IN(0)) { phase_prologue(F); } SEAM(0);
    if (IN(1)) {
        { pg8::Gemm g{WSP(bf16_t, WS_XB), WSP(bf16_t, WS_WIN), DM, 0}; pg8::PatchOrder S; S.init(T_ / 256, INW / 256, 8, F.G, F.bid);
          pg8::EpiInProj E{WSP(float, WS_RSTD0), WSP(bf16_t, WS_Q), WSP(bf16_t, WS_K), WSP(bf16_t, WS_V), WSP(bf16_t, WS_U), WSP(bf16_t, WS_SGA), WSP(bf16_t, WS_SGB)};
          pg8::gemm_phase<pg8::EpiInProj, pg8::PatchOrder, false>(ring, g, S, E, gidx); }
        { pg8::Gemm g{WSP(bf16_t, WS_MN), WSP(bf16_t, WS_WXKV), DM, 0}; pg8::PatchOrder S; S.init(NB * MEML / 256, 2 * XW / 256, 4, F.G, F.bid);
          pg8::EpiStore E{WSP(bf16_t, WS_MKV), 2 * XW};
          pg8::gemm_phase<pg8::EpiStore, pg8::PatchOrder, false>(ring, g, S, E, gidx); }
    } SEAM(1);
    if (IN(2)) { phase_kmean(F); } SEAM(2);
    if (IN(3)) { phase_moba_simple(F); phase_ssm_simple(F); } SEAM(3);
    if (IN(4)) {
        pg8::Gemm g{WSP(bf16_t, WS_YB), WSP(bf16_t, WS_WGLU), SW, 0}; pg8::PatchOrder S; S.init(T_ / 256, 2 * DM / 256, 8, F.G, F.bid);
        pg8::EpiGlu E{WSP(bf16_t, WS_SGB), WSP(bf16_t, WS_YB2S)};
        pg8::gemm_phase<pg8::EpiGlu, pg8::PatchOrder, false>(ring, g, S, E, gidx);
    } SEAM(4);
    if (IN(5)) {
        pg8::Gemm g{WSP(bf16_t, WS_ATT), WSP(bf16_t, WS_WPA), AW, 0}; pg8::PatchOrder S; S.init(T_ / 256, DM / 256, 4, F.G, F.bid);
        pg8::EpiMerge E{WSP(bf16_t, WS_SGA), WSP(bf16_t, WS_YB2S), WSP(bf16_t, WS_MERGED)};
        pg8::gemm_phase<pg8::EpiMerge, pg8::PatchOrder, false>(ring, g, S, E, gidx);
    } SEAM(5);
    if (IN(6)) {
        pg8::Gemm g{WSP(bf16_t, WS_MERGED), WSP(bf16_t, WS_WOUT), DM, 0}; pg8::PatchOrder S; S.init(T_ / 256, DM / 256, 4, F.G, F.bid);
        pg8::EpiResid E{F.in[I_X], WSP(float, WS_H), WSP(bf16_t, WS_HB), WSP(float, WS_SSQ1)};
        pg8::gemm_phase<pg8::EpiResid, pg8::PatchOrder, false>(ring, g, S, E, gidx);
    } SEAM(6);
    if (IN(7)) {
        pg8::Gemm g{WSP(bf16_t, WS_HB), WSP(bf16_t, WS_WXQ), DM, 0}; pg8::PatchOrder S; S.init(T_ / 256, XW / 256, 2, F.G, F.bid);
        pg8::EpiXq E{WSP(float, WS_SSQ1), WSP(bf16_t, WS_XQ)};
        pg8::gemm_phase<pg8::EpiXq, pg8::PatchOrder, false>(ring, g, S, E, gidx);
    } SEAM(7);
    if (IN(8)) { phase_xattn_simple(F); } SEAM(8);
    if (IN(9)) {
        pg8::Gemm g{WSP(bf16_t, WS_XO), WSP(bf16_t, WS_WXO), XW, 0}; pg8::PatchOrder S; S.init(T_ / 256, DM / 256, 4, F.G, F.bid);
        pg8::EpiResid E{WSP(float, WS_H), WSP(float, WS_H), WSP(bf16_t, WS_HB), WSP(float, WS_SSQ2)};
        pg8::gemm_phase<pg8::EpiResid, pg8::PatchOrder, false>(ring, g, S, E, gidx);
    } SEAM(9);
    if (IN(10)) { phase_router(F); } SEAM(10);
    if (IN(11) || IN(12)) {
        LAS int* pref = (LAS int*)(F.lds + MISC_OFF + 256);
        const unsigned* cnt = F.ctl + CW_CNT;
        __syncthreads();
        if (F.tid == 0) { int a = 0; for (int e = 0; e < NE; ++e) { pref[e] = a; a += ((int)__hip_atomic_load(cnt + e, RLX_AGENT) + 255) >> 8; } pref[NE] = a; }
        __syncthreads();
        const int MT = pref[NE];
        if (IN(11)) {
            MoeOrder S; S.P.init(MT, 2 * DFF / 256, 8, F.G, F.bid); S.pref = pref;
            { LAS int* gw_ = (LAS int*)(F.lds + GIDX_OFF); pg8::Unit u;
              for (int i = 0; i < GIDX_UNITS && S.next(i, u); ++i) { const int ce = (int)__hip_atomic_load(cnt + u.e, RLX_AGENT);
                  if (F.tid < 256) { const int rank = u.mi * 256 + F.tid; gw_[i * 256 + F.tid] = (rank < ce) ? (WSP(int, WS_ROWLIST)[(size_t)u.e * T_ + rank] >> 2) : 0; } } }
            __syncthreads();
            pg8::Gemm g{WSP(bf16_t, WS_HB), WSP(bf16_t, WS_WGU), DM, (size_t)2 * DFF * DM};
            pg8::EpiMoe1 E{WSP(float, WS_RSTD2), F.in[I_BGU], WSP(bf16_t, WS_HID), gidx};
            pg8::gemm_phase<pg8::EpiMoe1, MoeOrder, true>(ring, g, S, E, gidx);
        }
        SEAM(11);
        if (IN(12)) {
            MoeOrder S; S.P.init(MT, DM / 256, 4, F.G, F.bid); S.pref = pref;
            pg8::Gemm g{WSP(bf16_t, WS_HID), WSP(bf16_t, WS_WDN), DFF, (size_t)DM * DFF};
            pg8::EpiMoe2 E{F.in[I_BDN], WSP(float, WS_TKG), WSP(int, WS_ROWLIST), cnt, WSP(bf16_t, WS_Y)};
            pg8::gemm_phase<pg8::EpiMoe2, MoeOrder, false>(ring, g, S, E, gidx);
        }
    } SEAM(12);
    if (IN(13)) { phase_final(F); }
#undef IN
#undef SEAM
}

extern "C" void kernel_launch(void* const* d_in, const int* in_sizes, int n_in, void* d_out, int out_size, void* d_ws, size_t ws_size, hipStream_t stream) {
    static int grid = 0;
    if (grid == 0) {
        if (n_in != 28 || in_sizes[0] != T_ * DM || out_size != T_ * DM || ws_size < WS_END) { fprintf(stderr, "kernel_launch: unexpected shapes (n_in %d, in0 %d, out %d, ws %zu)\n", n_in, n_in > 0 ? in_sizes[0] : -1, out_size, ws_size); grid = -1; return; }
        int dev = 0, cus = 0;
        if (hipGetDevice(&dev) != hipSuccess || hipDeviceGetAttribute(&cus, hipDeviceAttributeMultiprocessorCount, dev) != hipSuccess) { grid = -1; return; }
        if (hipFuncSetAttribute((const void*)mega_fwd, hipFuncAttributeMaxDynamicSharedMemorySize, LDS_BYTES) != hipSuccess) { fprintf(stderr, "kernel_launch: hipFuncSetAttribute failed\n"); grid = -1; return; }
        (void)hipGetLastError();
        grid = cus;
    }
    if (grid < 0) return;
    (void)hipMemsetAsync((char*)d_ws + WS_CTL, 0, CTL_ZERO_BYTES, stream);
    Args a{};
    for (int i = 0; i < 28; ++i) a.in[i] = (const float*)d_in[i];
    a.out = (float*)d_out; a.ws = (unsigned char*)d_ws;
#if MK_N_LAUNCHES == 1
    a.ph_lo = 0; a.ph_hi = N_PHASES;
    hipLaunchKernelGGL(mega_fwd, dim3(grid), dim3(512), LDS_BYTES, stream, a);
#else
    for (int p = 0; p < N_PHASES; ++p) { a.ph_lo = p; a.ph_hi = p + 1; hipLaunchKernelGGL(mega_fwd, dim3(grid), dim3(512), LDS_BYTES, stream, a); }
#endif
}
```

```cpp
#include <hip/hip_runtime.h>
#include <hip/hip_bf16.h>
#include <cmath>
#include <cstdio>
#include <cstdint>

#ifndef MK_N_LAUNCHES
#define MK_N_LAUNCHES 1
#endif

#define GAS __attribute__((address_space(1)))
#define LAS __attribute__((address_space(3)))
typedef unsigned short bf16_t;
typedef short bf16x8 __attribute__((ext_vector_type(8)));
typedef float f32x4 __attribute__((ext_vector_type(4)));
typedef float f32x2 __attribute__((ext_vector_type(2)));
typedef unsigned u32x4 __attribute__((ext_vector_type(4)));
typedef unsigned u32x2 __attribute__((ext_vector_type(2)));

constexpr int NB = 4, SEQ = 8192, DM = 1024, T_ = NB * SEQ;
constexpr int AW = 512, NH = 8, HD = 64, MBLK = 256, NBLK = SEQ / MBLK, MTOPK = 3;
constexpr int SW = 512, SGC = 16, NG = 32, SP = 64;
constexpr int INW = 4096;
constexpr int MEML = 256, XH = 4, XD = 128, XW = 512;
constexpr int NE = 32, ETOPK = 4, DFF = 1024;
constexpr float RMS_EPS = 1e-6f;
constexpr float LOG2E = 1.4426950408889634f;
constexpr float QSCALE = 0.125f * LOG2E;
constexpr float XSCALE = 0.08838834764831845f * LOG2E;
constexpr int HID_ROWS = ETOPK * T_ + NE * 256;

constexpr size_t MiB = 1u << 20;
constexpr size_t WS_WIN = 0 * MiB, WS_WGLU = 8 * MiB, WS_WPA = 10 * MiB, WS_WOUT = 11 * MiB, WS_WXQ = 13 * MiB, WS_WXKV = 14 * MiB, WS_WXO = 16 * MiB,
                 WS_WGU = 17 * MiB, WS_WDN = 145 * MiB;
constexpr size_t WS_CTL = 209 * MiB, CTL_ZERO_BYTES = 1 * MiB;
constexpr size_t WS_RSTD0 = 210 * MiB;
constexpr size_t WS_RSTD2 = WS_RSTD0 + 128 * 1024;
constexpr size_t WS_KMEAN = WS_RSTD2 + 128 * 1024;
constexpr size_t WS_TKG = WS_KMEAN + 256 * 1024;
constexpr size_t WS_SSQ1 = 211 * MiB;
constexpr size_t WS_SSQ2 = 213 * MiB;
constexpr size_t WS_ROWLIST = 215 * MiB;
constexpr size_t WS_MN = 219 * MiB;
constexpr size_t WS_MKV = 221 * MiB;
constexpr size_t WS_WST = 225 * MiB;
constexpr size_t WS_GT = 233 * MiB;
constexpr size_t WS_KT = 241 * MiB;
constexpr size_t WS_LAML = 243 * MiB;
constexpr size_t WS_SST = 244 * MiB;
constexpr size_t WS_H = 256 * MiB;
constexpr size_t WS_HB = 384 * MiB;
constexpr size_t WS_HID = 448 * MiB;
constexpr size_t WS_Y = 720 * MiB;
constexpr size_t WS_END = 976 * MiB;
constexpr size_t WS_XB = 448 * MiB, WS_Q = 512 * MiB, WS_K = 544 * MiB, WS_V = 576 * MiB, WS_U = 608 * MiB, WS_ATT = 640 * MiB, WS_YB = 672 * MiB;
constexpr size_t WS_SGA = 720 * MiB, WS_SGB = 784 * MiB, WS_YB2S = 848 * MiB, WS_MERGED = 912 * MiB;
constexpr size_t WS_XQ = 448 * MiB, WS_XO = 480 * MiB;
static_assert(WS_HID + (size_t)HID_ROWS * DFF * 2 <= WS_Y, "HID fits");
constexpr int CW_TMO = 0, CW_CNT = 64  , CW_BAR = 4096;

constexpr int RING_BYTES = 131072;
constexpr int GIDX_OFF = RING_BYTES, GIDX_UNITS = 24;
constexpr int MISC_OFF = GIDX_OFF + GIDX_UNITS * 1024;
constexpr int LDS_BYTES = 163840;

#define RLX_AGENT __ATOMIC_RELAXED, __HIP_MEMORY_SCOPE_AGENT
__device__ __forceinline__ unsigned f2bf(float f) { unsigned u = __builtin_bit_cast(unsigned, f); return (u + 0x7fffu + ((u >> 16) & 1u)) >> 16; }
__device__ __forceinline__ unsigned pk2(float lo, float hi) { return f2bf(lo) | (f2bf(hi) << 16); }
__device__ __forceinline__ float bf2f(unsigned short b) { return __builtin_bit_cast(float, (unsigned)b << 16); }
__device__ __forceinline__ float bflo(unsigned w) { return __builtin_bit_cast(float, w << 16); }
__device__ __forceinline__ float bfhi(unsigned w) { return __builtin_bit_cast(float, w & 0xffff0000u); }
__device__ __forceinline__ float wave_sum(float v) {
#pragma unroll
    for (int o = 1; o < 64; o <<= 1) v += __shfl_xor(v, o);
    return v;
}
__device__ __forceinline__ float fsigmoid(float x) { return __builtin_amdgcn_rcpf(1.0f + __builtin_amdgcn_exp2f(-x * LOG2E)); }
__device__ __forceinline__ float gelu_tanh(float x) {
    const float u = 0.7978845608028654f * (x + 0.044715f * x * x * x);
    return x * fsigmoid(2.0f * u);
}

namespace pg8 {
constexpr int BM = 256, BK = 64, HALF = 128, HTB = HALF * BK * 2, STAGE_BYTES = 8 * HTB;
__host__ __device__ __forceinline__ int lds_byte(int r, int c) { const int st = (r >> 4) * 2 + (c >> 5), rr = r & 15, cc = c & 31, ob = rr * 64 + cc * 2; return st * 1024 + (ob ^ (((ob >> 9) & 1) << 5)); }
__host__ __device__ __forceinline__ void stage_rc(int b, int& R, int& C) { const int st = b / 1024, sb = b % 1024, swz = sb ^ (((sb >> 9) & 1) << 5); R = (st >> 1) * 16 + swz / 64; C = (st & 1) * 32 + (swz % 64) / 2; }
__host__ __device__ __forceinline__ int perm32(int rho) { const int n = rho >> 4, i = rho & 15; return 8 * (i >> 2) + 4 * n + (i & 3); }

struct Unit { int pm, pn, e, mi, ui; };
struct Gemm { const bf16_t* A; const bf16_t* Bt; int K; size_t b_estride; };

struct PatchOrder {
    int nM, nN, PM, PN, x, j, ok;
    __device__ __forceinline__ void init(int nM_, int nN_, int PN_, int G, int c) { nM = nM_; nN = nN_; PN = PN_; PM = (G / 8) / PN_; x = c & 7; j = c >> 3; ok = ((G & 7) == 0) && (PM * PN == G / 8) && (nN % PN == 0); if (!ok) { x = c; j = G; } }
    __device__ __forceinline__ bool next(int i, Unit& u) const {
        if (!ok) { const long L = (long)i * j + x; if (L >= (long)nM * nN) return false; u.pm = (int)(L / nN); u.pn = (int)(L % nN); u.e = 0; u.mi = u.pm; u.ui = i; return true; }
        const int p = 8 * i + x, npn = nN / PN, pmb = p / npn, pnb = p % npn;
        u.pm = pmb * PM + (j % PM); u.pn = pnb * PN + (j / PM); u.e = 0; u.mi = u.pm; u.ui = i;
        return u.pm < nM;
    }
};

__device__ __forceinline__ unsigned cvt_pk_bf16(float lo, float hi) { unsigned r; asm volatile("v_cvt_pk_bf16_f32 %0, %1, %2" : "=v"(r) : "v"(lo), "v"(hi)); return r; }

template <class Epi, class Sched, bool GATHER>
__device__ __forceinline__ void gemm_phase(LAS unsigned char* lds, const Gemm g, const Sched& S, const Epi& E, const LAS int* gidx) {
    const int tid = threadIdx.x, wid = __builtin_amdgcn_readfirstlane(tid >> 6), lane = tid & 63, wr = wid >> 2, wc = wid & 3, fr = lane & 15, fq = lane >> 4;
    const int K = g.K, nt = K / BK;
    int Ra[2], Ca[2]; unsigned voffB[2];
#pragma unroll
    for (int i = 0; i < 2; ++i) { int R, C; stage_rc(tid * 16 + i * 8192, R, C); const int Rb = Epi::PERM ? ((R & ~31) + perm32(R & 31)) : R;
        Ra[i] = R; Ca[i] = C; voffB[i] = (unsigned)(Rb * K + C) * 2u; }
    const size_t kstep = (size_t)(BK * 2);
    const size_t hstep = (size_t)HALF * K * 2;
    const size_t tstep = 2 * hstep;
    const unsigned ldsw = (unsigned)wid * 1024u;
    const int aoff = lds_byte(wr * 64 + fr, fq * 8), boff = lds_byte(wc * 32 + fr, fq * 8);
#define PG8_SA(b, h) (((b) * 2 + (h)) * HTB)
#define PG8_SB(b, h) ((4 + (b) * 2 + (h)) * HTB)
#define PG8_STAGE(bufoff, gbase, voff) do { _Pragma("unroll") for (int _i = 0; _i < 2; ++_i) \
        __builtin_amdgcn_global_load_lds((const unsigned*)((const char*)(gbase) + (voff)[_i]), (LAS unsigned*)(lds + (bufoff) + ldsw + _i * 8192), 16, 0, 0); } while (0)
#define PG8_LDA(dst, b, h) do { _Pragma("unroll") for (int m = 0; m < 4; ++m) _Pragma("unroll") for (int k = 0; k < 2; ++k) dst[m][k] = *(const LAS bf16x8*)(lds + PG8_SA(b, h) + aoff + m * 2048 + k * 1024); } while (0)
#define PG8_LDB(dst, b, h) do { _Pragma("unroll") for (int n = 0; n < 2; ++n) _Pragma("unroll") for (int k = 0; k < 2; ++k) dst[n][k] = *(const LAS bf16x8*)(lds + PG8_SB(b, h) + boff + n * 2048 + k * 1024); } while (0)
#define PG8_MMA(ai, bj, At, Bt) do { __builtin_amdgcn_s_setprio(1); _Pragma("unroll") for (int m = 0; m < 4; ++m) _Pragma("unroll") for (int n = 0; n < 2; ++n) _Pragma("unroll") for (int k = 0; k < 2; ++k) \
        acc[ai][bj][m][n] = __builtin_amdgcn_mfma_f32_16x16x32_bf16(Bt[n][k], At[m][k], acc[ai][bj][m][n], 0, 0, 0); __builtin_amdgcn_s_setprio(0); } while (0)
#define PG8_WAIT_V(n) asm volatile("s_waitcnt vmcnt(" #n ")" ::: "memory")
#define PG8_WAIT_L(n) asm volatile("s_waitcnt lgkmcnt(" #n ")" ::: "memory")
#define PG8_BAR __builtin_amdgcn_s_barrier()
#define PG8_SCHED __builtin_amdgcn_sched_barrier(0)
#define PG8_VOA(dst, u) do { _Pragma("unroll") for (int _h = 0; _h < 2; ++_h) _Pragma("unroll") for (int _i = 0; _i < 2; ++_i) { \
        const int _row = GATHER ? gidx[(u).ui * 256 + _h * HALF + Ra[_i]] : (_h * HALF + Ra[_i]); dst[_h][_i] = (unsigned)(_row * K + Ca[_i]) * 2u; } } while (0)
    Unit cur, nxt; int ui = 0;
    if (!S.next(0, cur)) return;
    f32x4 acc[2][2][4][2];
#pragma unroll
    for (int a = 0; a < 2; ++a)
#pragma unroll
        for (int b = 0; b < 2; ++b)
#pragma unroll
            for (int m = 0; m < 4; ++m)
#pragma unroll
                for (int n = 0; n < 2; ++n) acc[a][b][m][n] = (f32x4){0.f, 0.f, 0.f, 0.f};
    bf16x8 At[4][2], B0[2][2], B1[2][2];
    unsigned voA[2][2], voN[2][2];
    PG8_VOA(voA, cur);
    const char* cA = (const char*)g.A + (GATHER ? (size_t)0 : (size_t)cur.pm * tstep);
    const char* cB = (const char*)g.Bt + ((size_t)cur.e * g.b_estride) * 2 + (size_t)cur.pn * tstep;
    PG8_STAGE(PG8_SB(0, 0), cB, voffB); PG8_STAGE(PG8_SB(0, 1), cB + hstep, voffB); PG8_STAGE(PG8_SA(0, 0), cA, voA[0]); PG8_STAGE(PG8_SA(0, 1), cA, voA[1]);
    if (wr == 1) PG8_BAR;
    PG8_WAIT_V(2); PG8_BAR;
    PG8_STAGE(PG8_SB(1, 0), cB + kstep, voffB); PG8_STAGE(PG8_SA(1, 0), cA + kstep, voA[0]); PG8_STAGE(PG8_SB(1, 1), cB + hstep + kstep, voffB);
    PG8_WAIT_V(6); PG8_BAR;
    for (;;) {
        const bool has_next = S.next(ui + 1, nxt);
        const char* nA = cA; const char* nB = cB;
#pragma unroll
        for (int h = 0; h < 2; ++h)
#pragma unroll
            for (int i = 0; i < 2; ++i) voN[h][i] = voA[h][i];
        if (has_next) { nA = (const char*)g.A + (GATHER ? (size_t)0 : (size_t)nxt.pm * tstep); nB = (const char*)g.Bt + ((size_t)nxt.e * g.b_estride) * 2 + (size_t)nxt.pn * tstep; PG8_VOA(voN, nxt); }
        for (int t = 0; t < nt; t += 2) {
            const bool last = (t == nt - 2);
            const char* a1 = cA + (size_t)(t + 1) * kstep;
            const char* a2 = last ? nA : cA + (size_t)(t + 2) * kstep; const char* b2 = last ? nB : cB + (size_t)(t + 2) * kstep;
            const char* a3 = a2 + kstep; const char* b3 = b2 + kstep;
            unsigned vo2[2][2];
#pragma unroll
            for (int h = 0; h < 2; ++h)
#pragma unroll
                for (int i = 0; i < 2; ++i) vo2[h][i] = last ? voN[h][i] : voA[h][i];
            PG8_LDB(B0, 0, 0); PG8_LDB(B1, 0, 1); PG8_SCHED; PG8_LDA(At, 0, 0); PG8_STAGE(PG8_SA(1, 1), a1, voA[1]);
            PG8_WAIT_V(8); PG8_WAIT_L(0); PG8_BAR; PG8_MMA(0, 0, At, B0); PG8_MMA(0, 1, At, B1); PG8_BAR; PG8_SCHED;
            PG8_LDA(At, 0, 1); PG8_STAGE(PG8_SB(0, 0), b2, voffB); PG8_STAGE(PG8_SB(0, 1), b2 + hstep, voffB); PG8_STAGE(PG8_SA(0, 0), a2, vo2[0]);
            PG8_WAIT_V(8); PG8_WAIT_L(0); PG8_BAR; PG8_MMA(1, 0, At, B0); PG8_MMA(1, 1, At, B1); PG8_BAR; PG8_SCHED;
            PG8_LDB(B0, 1, 0); PG8_LDB(B1, 1, 1); PG8_SCHED; PG8_LDA(At, 1, 0); PG8_STAGE(PG8_SA(0, 1), a2, vo2[1]);
            PG8_WAIT_V(8); PG8_WAIT_L(0); PG8_BAR; PG8_MMA(0, 0, At, B0); PG8_MMA(0, 1, At, B1); PG8_BAR; PG8_SCHED;
            PG8_LDA(At, 1, 1); PG8_STAGE(PG8_SB(1, 0), b3, voffB); PG8_STAGE(PG8_SB(1, 1), b3 + hstep, voffB); PG8_STAGE(PG8_SA(1, 0), a3, vo2[0]);
            PG8_WAIT_V(8); PG8_WAIT_L(0); PG8_BAR; PG8_MMA(1, 0, At, B0); PG8_MMA(1, 1, At, B1); PG8_BAR; PG8_SCHED;
        }
        if (wr == 0) PG8_BAR;
        E(acc, cur, wr, wc, fr, fq);
        if (!has_next) break;
#pragma unroll
        for (int a = 0; a < 2; ++a)
#pragma unroll
            for (int b = 0; b < 2; ++b)
#pragma unroll
                for (int m = 0; m < 4; ++m)
#pragma unroll
                    for (int n = 0; n < 2; ++n) acc[a][b][m][n] = (f32x4){0.f, 0.f, 0.f, 0.f};
        cur = nxt; cA = nA; cB = nB; ++ui;
#pragma unroll
        for (int h = 0; h < 2; ++h)
#pragma unroll
            for (int i = 0; i < 2; ++i) voA[h][i] = voN[h][i];
        if (wr == 1) PG8_BAR;
    }
    PG8_WAIT_V(0);
    PG8_BAR;
#undef PG8_SA
#undef PG8_SB
#undef PG8_STAGE
#undef PG8_LDA
#undef PG8_LDB
#undef PG8_MMA
#undef PG8_WAIT_V
#undef PG8_WAIT_L
#undef PG8_BAR
#undef PG8_SCHED
#undef PG8_VOA
}

typedef const f32x4 (&AccRef)[2][2][4][2];
#define EPI_ROWS for (int ai = 0; ai < 2; ++ai) _Pragma("unroll") for (int m = 0; m < 4; ++m)

struct EpiInProj {
    static constexpr bool PERM = true;
    const float* rstd; bf16_t *Q, *Kb, *V, *U, *SGA, *SGB;
    __device__ __forceinline__ void operator()(AccRef acc, const Unit& u, int wr, int wc, int fr, int fq) const {
        bf16_t* dst; int ld, colt; bool sig = false; float sc = 1.f;
        if (u.pn < 2) { dst = Q; ld = AW; colt = u.pn * 256; sc = QSCALE; }
        else if (u.pn < 4) { dst = Kb; ld = AW; colt = (u.pn - 2) * 256; }
        else if (u.pn < 6) { dst = V; ld = AW; colt = (u.pn - 4) * 256; }
        else if (u.pn < 8) { dst = U; ld = AW; colt = (u.pn - 6) * 256; }
        else if (u.pn < 12) { dst = SGA; ld = DM; colt = (u.pn - 8) * 256; sig = true; }
        else { dst = SGB; ld = DM; colt = (u.pn - 12) * 256; sig = true; }
        const int row0 = u.pm * BM + wr * 64 + fr, col0 = colt + wc * 32 + 8 * fq;
#pragma unroll
        EPI_ROWS { const int row = row0 + ai * HALF + m * 16; const float rs = rstd[row] * sc; bf16_t* rowp = dst + (size_t)row * ld + col0;
#pragma unroll
            for (int bj = 0; bj < 2; ++bj) { f32x4 v0 = acc[ai][bj][m][0] * rs, v1 = acc[ai][bj][m][1] * rs;
                if (sig) {
#pragma unroll
                    for (int e = 0; e < 4; ++e) { v0[e] = fsigmoid(v0[e]); v1[e] = fsigmoid(v1[e]); } }
                u32x4 w; w.x = cvt_pk_bf16(v0[0], v0[1]); w.y = cvt_pk_bf16(v0[2], v0[3]); w.z = cvt_pk_bf16(v1[0], v1[1]); w.w = cvt_pk_bf16(v1[2], v1[3]);
                *(u32x4*)(rowp + bj * HALF) = w; } }
    }
};
struct EpiStore {
    static constexpr bool PERM = true;
    bf16_t* O; int ld;
    __device__ __forceinline__ void operator()(AccRef acc, const Unit& u, int wr, int wc, int fr, int fq) const {
        const int row0 = u.pm * BM + wr * 64 + fr, col0 = u.pn * BM + wc * 32 + 8 * fq;
#pragma unroll
        EPI_ROWS { bf16_t* rowp = O + (size_t)(row0 + ai * HALF + m * 16) * ld + col0;
#pragma unroll
            for (int bj = 0; bj < 2; ++bj) { const f32x4 v0 = acc[ai][bj][m][0], v1 = acc[ai][bj][m][1];
                u32x4 w; w.x = cvt_pk_bf16(v0[0], v0[1]); w.y = cvt_pk_bf16(v0[2], v0[3]); w.z = cvt_pk_bf16(v1[0], v1[1]); w.w = cvt_pk_bf16(v1[2], v1[3]);
                *(u32x4*)(rowp + bj * HALF) = w; } }
    }
};
struct EpiGlu {
    static constexpr bool PERM = true;
    const bf16_t* SGB; bf16_t* O;
    __device__ __forceinline__ void operator()(AccRef acc, const Unit& u, int wr, int wc, int fr, int fq) const {
        const int row0 = u.pm * BM + wr * 64 + fr, col0 = u.pn * HALF + wc * 32 + 8 * fq;
#pragma unroll
        EPI_ROWS { const size_t off = (size_t)(row0 + ai * HALF + m * 16) * DM + col0; const u32x4 s = *(const u32x4*)(SGB + off);
            const f32x4 v0 = acc[ai][0][m][0], v1 = acc[ai][0][m][1], g0 = acc[ai][1][m][0], g1 = acc[ai][1][m][1];
            float o[8];
#pragma unroll
            for (int e = 0; e < 4; ++e) { o[e] = v0[e] * fsigmoid(g0[e]); o[4 + e] = v1[e] * fsigmoid(g1[e]); }
            o[0] *= bflo(s.x); o[1] *= bfhi(s.x); o[2] *= bflo(s.y); o[3] *= bfhi(s.y); o[4] *= bflo(s.z); o[5] *= bfhi(s.z); o[6] *= bflo(s.w); o[7] *= bfhi(s.w);
            u32x4 w; w.x = cvt_pk_bf16(o[0], o[1]); w.y = cvt_pk_bf16(o[2], o[3]); w.z = cvt_pk_bf16(o[4], o[5]); w.w = cvt_pk_bf16(o[6], o[7]);
            *(u32x4*)(O + off) = w; }
    }
};
struct EpiMerge {
    static constexpr bool PERM = true;
    const bf16_t* SGA; const bf16_t* Y2; bf16_t* O;
    __device__ __forceinline__ void operator()(AccRef acc, const Unit& u, int wr, int wc, int fr, int fq) const {
        const int row0 = u.pm * BM + wr * 64 + fr, col0 = u.pn * BM + wc * 32 + 8 * fq;
#pragma unroll
        EPI_ROWS {
#pragma unroll
            for (int bj = 0; bj < 2; ++bj) { const size_t off = (size_t)(row0 + ai * HALF + m * 16) * DM + col0 + bj * HALF;
                const u32x4 s = *(const u32x4*)(SGA + off), y = *(const u32x4*)(Y2 + off); const f32x4 v0 = acc[ai][bj][m][0], v1 = acc[ai][bj][m][1];
                u32x4 w; w.x = cvt_pk_bf16(bflo(s.x) * v0[0] + bflo(y.x), bfhi(s.x) * v0[1] + bfhi(y.x)); w.y = cvt_pk_bf16(bflo(s.y) * v0[2] + bflo(y.y), bfhi(s.y) * v0[3] + bfhi(y.y));
                w.z = cvt_pk_bf16(bflo(s.z) * v1[0] + bflo(y.z), bfhi(s.z) * v1[1] + bfhi(y.z)); w.w = cvt_pk_bf16(bflo(s.w) * v1[2] + bflo(y.w), bfhi(s.w) * v1[3] + bfhi(y.w));
                *(u32x4*)(O + off) = w; } }
    }
};
struct EpiResid {
    static constexpr bool PERM = false;
    const float* base; float* H; bf16_t* HB; float* SSQ;
    __device__ __forceinline__ void operator()(AccRef acc, const Unit& u, int wr, int wc, int fr, int fq) const {
        const int row0 = u.pm * BM + wr * 64 + fr, col0 = u.pn * BM + wc * 32 + 4 * fq;
#pragma unroll
        EPI_ROWS { const int row = row0 + ai * HALF + m * 16; const size_t off = (size_t)row * DM + col0; float ss = 0.f;
#pragma unroll
            for (int bj = 0; bj < 2; ++bj)
#pragma unroll
                for (int n = 0; n < 2; ++n) { const size_t o2 = off + bj * HALF + n * 16; const f32x4 h = *(const f32x4*)(base + o2) + acc[ai][bj][m][n];
                    *(f32x4*)(H + o2) = h; u32x2 w; w.x = cvt_pk_bf16(h[0], h[1]); w.y = cvt_pk_bf16(h[2], h[3]); *(u32x2*)(HB + o2) = w;
                    ss += (h[0] * h[0] + h[1] * h[1]) + (h[2] * h[2] + h[3] * h[3]); }
            ss += __shfl_xor(ss, 16); ss += __shfl_xor(ss, 32);
            if (fq == 0) SSQ[(size_t)row * 16 + u.pn * 4 + wc] = ss; }
    }
};
struct EpiXq {
    static constexpr bool PERM = true;
    const float* SSQ; bf16_t* O;
    __device__ __forceinline__ void operator()(AccRef acc, const Unit& u, int wr, int wc, int fr, int fq) const {
        const int row0 = u.pm * BM + wr * 64 + fr, col0 = u.pn * BM + wc * 32 + 8 * fq;
#pragma unroll
        EPI_ROWS { const int row = row0 + ai * HALF + m * 16; const f32x4* sp = (const f32x4*)(SSQ + (size_t)row * 16);
            const f32x4 a = sp[0] + sp[1] + sp[2] + sp[3]; const float rs = __builtin_amdgcn_rsqf(((a[0] + a[1]) + (a[2] + a[3])) * (1.0f / DM) + RMS_EPS) * XSCALE;
            bf16_t* rowp = O + (size_t)row * XW + col0;
#pragma unroll
            for (int bj = 0; bj < 2; ++bj) { const f32x4 v0 = acc[ai][bj][m][0] * rs, v1 = acc[ai][bj][m][1] * rs;
                u32x4 w; w.x = cvt_pk_bf16(v0[0], v0[1]); w.y = cvt_pk_bf16(v0[2], v0[3]); w.z = cvt_pk_bf16(v1[0], v1[1]); w.w = cvt_pk_bf16(v1[2], v1[3]);
                *(u32x4*)(rowp + bj * HALF) = w; } }
    }
};
struct EpiMoe1 {
    static constexpr bool PERM = true;
    const float* rstd2; const float* bgu; bf16_t* HID; const LAS int* gidx;
    __device__ __forceinline__ void operator()(AccRef acc, const Unit& u, int wr, int wc, int fr, int fq) const {
        const int rl0 = wr * 64 + fr, col0 = u.pn * HALF + wc * 32 + 8 * fq; const float* bg = bgu + (size_t)u.e * (2 * DFF) + col0;
        const f32x4 bg0 = *(const f32x4*)(bg), bg1 = *(const f32x4*)(bg + 4), bu0 = *(const f32x4*)(bg + DFF), bu1 = *(const f32x4*)(bg + DFF + 4);
#pragma unroll
        EPI_ROWS { const int rl = rl0 + ai * HALF + m * 16; const float rs = rstd2[gidx[u.ui * 256 + rl]];
            const f32x4 g0 = acc[ai][0][m][0] * rs + bg0, g1 = acc[ai][0][m][1] * rs + bg1, p0 = acc[ai][1][m][0] * rs + bu0, p1 = acc[ai][1][m][1] * rs + bu1;
            float o[8];
#pragma unroll
            for (int e = 0; e < 4; ++e) { const float ga = fminf(g0[e], 7.0f), gb = fminf(g1[e], 7.0f), ua = fminf(fmaxf(p0[e], -7.0f), 7.0f), ub = fminf(fmaxf(p1[e], -7.0f), 7.0f);
                o[e] = (ua + 1.0f) * ga * fsigmoid(1.702f * ga); o[4 + e] = (ub + 1.0f) * gb * fsigmoid(1.702f * gb); }
            u32x4 w; w.x = cvt_pk_bf16(o[0], o[1]); w.y = cvt_pk_bf16(o[2], o[3]); w.z = cvt_pk_bf16(o[4], o[5]); w.w = cvt_pk_bf16(o[6], o[7]);
            *(u32x4*)(HID + (size_t)(u.pm * BM + rl) * DFF + col0) = w; }
    }
};
struct EpiMoe2 {
    static constexpr bool PERM = true;
    const float* bdn; const float* tkg; const int* rowlist; const unsigned* cnt; bf16_t* Y;
    __device__ __forceinline__ void operator()(AccRef acc, const Unit& u, int wr, int wc, int fr, int fq) const {
        const int rl0 = wr * 64 + fr, col0 = u.pn * BM + wc * 32 + 8 * fq; const float* bd = bdn + (size_t)u.e * DM + col0; const int ce = (int)cnt[u.e];
        f32x4 bv[2][2];
#pragma unroll
        for (int bj = 0; bj < 2; ++bj)
#pragma unroll
            for (int n = 0; n < 2; ++n) bv[bj][n] = *(const f32x4*)(bd + bj * HALF + 4 * n);
#pragma unroll
        EPI_ROWS { const int rank = u.mi * BM + rl0 + ai * HALF + m * 16;
            if (rank < ce) { const int dest = rowlist[(size_t)u.e * T_ + rank]; const float gt = tkg[dest]; bf16_t* rowp = Y + (size_t)dest * DM + col0;
#pragma unroll
                for (int bj = 0; bj < 2; ++bj) { const f32x4 v0 = (acc[ai][bj][m][0] + bv[bj][0]) * gt, v1 = (acc[ai][bj][m][1] + bv[bj][1]) * gt;
                    u32x4 w; w.x = cvt_pk_bf16(v0[0], v0[1]); w.y = cvt_pk_bf16(v0[2], v0[3]); w.z = cvt_pk_bf16(v1[0], v1[1]); w.w = cvt_pk_bf16(v1[2], v1[3]);
                    *(u32x4*)(rowp + bj * HALF) = w; } } }
    }
};
}

struct MoeOrder {
    pg8::PatchOrder P; const LAS int* pref;
    __device__ __forceinline__ bool next(int i, pg8::Unit& u) const {
        if (!P.next(i, u)) return false;
        int e = 0;
#pragma unroll 1
        for (int k = 1; k < NE; ++k) e += (pref[k] <= u.pm) ? 1 : 0;
        u.e = e; u.mi = u.pm - pref[e]; return true;
    }
};

namespace attn_body {
using bf16=__hip_bfloat16;
using bf16x8=__attribute__((ext_vector_type(8)))short;
using s16x4=__attribute__((ext_vector_type(4)))short;
using f32x16=__attribute__((ext_vector_type(16)))float;
using u32x4=__attribute__((ext_vector_type(4)))unsigned;
constexpr int BATCH=4,NHEAD=8,SEQ=8192,D=64,DM=NHEAD*D;
constexpr int NW=8,QBLK=32,QB=QBLK*NW,KVBLK=64,NQB=SEQ/QB;
constexpr int ATTN_PITCH=DM, ATTN_UNIT_ROWS=QB;
__device__ __forceinline__ int crow(int r,int hi){return (r&3)+8*(r>>2)+4*hi;}
#define SBAR() __builtin_amdgcn_sched_barrier(0)
__device__ __forceinline__ void cmask(f32x16&p0,f32x16&p1,int jb,int qrel,int hi){
  const float NEG=-INFINITY; int kb=64*jb+4*hi;
  #pragma unroll
  for(int r=0;r<16;++r){int kv=kb+(r&3)+8*(r>>2); if(kv>qrel)p0[r]=NEG; if(kv+32>qrel)p1[r]=NEG;}
}

constexpr int NSLOT=3, SLOTB=8192;
constexpr int LDS_K=0, LDS_V=NSLOT*SLOTB, LDS_WS=2*NSLOT*SLOTB, LDS_OST=LDS_WS+NW*64*4, LDS_KM=LDS_OST+NW*4096, LDS_SEL=LDS_KM+32*64*4, LDS_BYTES=LDS_SEL+1024;
constexpr float C2=0.125f*1.4426950408889634f;
__device__ __forceinline__ void glds16(const void*gsrc,unsigned lds_dst){unsigned keep;
  asm volatile("s_mov_b32 %0, m0\n\ts_mov_b32 m0, %2\n\ts_nop 0\n\tglobal_load_lds_dwordx4 %1, off\n\ts_mov_b32 m0, %0":"=&s"(keep):"v"(gsrc),"s"(lds_dst):"memory");}
__device__ __forceinline__ float max3f(float a,float b,float c){float r;asm("v_max3_f32 %0, %1, %2, %3":"=v"(r):"v"(a),"v"(b),"v"(c));return r;}
__device__ __forceinline__ float max2f(float a,float b){float r;asm("v_max_f32_e32 %0, %1, %2":"=v"(r):"v"(a),"v"(b));return r;}
__device__ __forceinline__ float fadd_s(float a,float b){float r;asm("v_add_f32_e32 %0, %1, %2":"=v"(r):"v"(a),"v"(b));return r;}
__device__ __forceinline__ float fsub_s(float a,float b){float r;asm("v_sub_f32_e32 %0, %1, %2":"=v"(r):"v"(a),"v"(b));return r;}
typedef float f32x2_t __attribute__((ext_vector_type(2))); typedef __bf16 bf16x2_t __attribute__((ext_vector_type(2)));
__device__ __forceinline__ unsigned cvtpk_s(float lo,float hi){f32x2_t v={lo,hi};bf16x2_t b=__builtin_convertvector(v,bf16x2_t);return __builtin_bit_cast(unsigned,b);}
#define WAIT_BAR(N) asm volatile("s_waitcnt vmcnt(" #N ") lgkmcnt(0)\n\ts_barrier":::"memory")

__device__ __forceinline__ void qkt(f32x16&p0,f32x16&p1,const char*Kslot,const bf16x8*qr,const f32x16&negm,int r32,int hi){
  const char*kb=Kslot+hi*1024+r32*16;
  #pragma unroll
  for(int d0=0;d0<4;++d0){
    const bf16x8 b0=*reinterpret_cast<const bf16x8*>(kb+d0*2048);
    const bf16x8 b1=*reinterpret_cast<const bf16x8*>(kb+d0*2048+512);
    if(d0==0){p0=__builtin_amdgcn_mfma_f32_32x32x16_bf16(b0,qr[0],negm,0,0,0);p1=__builtin_amdgcn_mfma_f32_32x32x16_bf16(b1,qr[0],negm,0,0,0);}
    else{p0=__builtin_amdgcn_mfma_f32_32x32x16_bf16(b0,qr[d0],p0,0,0,0);p1=__builtin_amdgcn_mfma_f32_32x32x16_bf16(b1,qr[d0],p1,0,0,0);}}
}
typedef __attribute__((address_space(3))) const char* lds_cptr;
typedef short v4i16_t __attribute__((ext_vector_type(4)));
__device__ __forceinline__ void kload8(bf16x8*kf,lds_cptr kp){
  kf[0]=*(const __attribute__((address_space(3))) bf16x8*)(kp);      kf[1]=*(const __attribute__((address_space(3))) bf16x8*)(kp+512);
  kf[2]=*(const __attribute__((address_space(3))) bf16x8*)(kp+2048); kf[3]=*(const __attribute__((address_space(3))) bf16x8*)(kp+2560);
  kf[4]=*(const __attribute__((address_space(3))) bf16x8*)(kp+4096); kf[5]=*(const __attribute__((address_space(3))) bf16x8*)(kp+4608);
  kf[6]=*(const __attribute__((address_space(3))) bf16x8*)(kp+6144); kf[7]=*(const __attribute__((address_space(3))) bf16x8*)(kp+6656);
}
__device__ __forceinline__ void kload2(bf16x8*kf,lds_cptr kp,int j){ kf[2*j]=*(const __attribute__((address_space(3))) bf16x8*)(kp+j*2048); kf[2*j+1]=*(const __attribute__((address_space(3))) bf16x8*)(kp+j*2048+512); }
__device__ __forceinline__ s16x4 vtr(lds_cptr p){ return __builtin_bit_cast(s16x4,__builtin_amdgcn_ds_read_tr16_b64_v4i16((__attribute__((address_space(3))) v4i16_t*)p)); }
__device__ __forceinline__ float rowmax(const f32x16&p0,const f32x16&p1){
  float a=max3f(p0[0],p0[1],p1[0]),b=max3f(p0[2],p0[3],p1[1]);a=max3f(a,p1[2],p1[3]);
  #pragma unroll
  for(int r=4;r<16;r+=4){a=max3f(a,p0[r],p0[r+1]);b=max3f(b,p0[r+2],p0[r+3]);a=max3f(a,p1[r],p1[r+1]);b=max3f(b,p1[r+2],p1[r+3]);}
  const float m=max2f(a,b);
  auto rr=__builtin_amdgcn_permlane32_swap(__float_as_uint(m),__float_as_uint(m),false,false);
  return max2f(__uint_as_float(rr[0]),__uint_as_float(rr[1]));
}
__device__ __forceinline__ void pv(f32x16*o,int vb,bf16x8 pa0,bf16x8 pa1,bf16x8 pa2,bf16x8 pa3){
  #pragma unroll
  for(int d0=0;d0<2;++d0){s16x4 lo[4],hi[4];
    #pragma unroll
    for(int ks=0;ks<4;++ks){
      asm volatile("ds_read_b64_tr_b16 %0,%1 offset:%c2":"=&v"(lo[ks]):"v"(vb),"i"(d0*4096+ks*1024):"memory");
      asm volatile("ds_read_b64_tr_b16 %0,%1 offset:%c2":"=&v"(hi[ks]):"v"(vb),"i"(d0*4096+ks*1024+512):"memory");}
    asm volatile("s_waitcnt lgkmcnt(0)":::"memory");SBAR();
    #define PK(k) (bf16x8){lo[k][0],lo[k][1],lo[k][2],lo[k][3],hi[k][0],hi[k][1],hi[k][2],hi[k][3]}
    o[d0]=__builtin_amdgcn_mfma_f32_32x32x16_bf16(pa0,PK(0),o[d0],0,0,0);
    o[d0]=__builtin_amdgcn_mfma_f32_32x32x16_bf16(pa1,PK(1),o[d0],0,0,0);
    o[d0]=__builtin_amdgcn_mfma_f32_32x32x16_bf16(pa2,PK(2),o[d0],0,0,0);
    o[d0]=__builtin_amdgcn_mfma_f32_32x32x16_bf16(pa3,PK(3),o[d0],0,0,0);
    #undef PK
  }
}

#ifndef ATTN_STORE16
#define ATTN_STORE16(p,v) (*(u32x4*)(p)=(v))
#endif
template<int THRL> __device__ __forceinline__ void attn_unit(int b,int h,int qb,const bf16*Q,const bf16*__restrict__ K,const bf16*__restrict__ V,bf16*O,char*shm){
  const int tid=threadIdx.x,lane=tid&63,r32=lane&31,hi=lane>>5; const int wid=__builtin_amdgcn_readfirstlane(tid>>6);
  const long rowbase=(long)b*SEQ; const int q0=qb*QB;
  const bf16*Qw=Q+(rowbase+q0+wid*QBLK)*DM+h*D;
  const bf16*Kh=K+rowbase*DM+h*D,*Vh=V+rowbase*DM+h*D;
  const unsigned lds0=(unsigned)(uintptr_t)shm;
  float*wsf=(float*)(shm+LDS_WS)+wid*64;
  const bf16*ksrc=Kh+(long)lane*DM+wid*8;
  const bf16*vsrc=Vh+(long)(16*(wid&3)+(lane>>2))*DM+(wid>>2)*32+(lane&3)*8;
  const unsigned kdst=lds0+LDS_K+wid*1024, vdst=lds0+LDS_V+wid*1024;
  #define DMA_K(t,slot) glds16(ksrc+(long)(t)*KVBLK*DM,(unsigned)__builtin_amdgcn_readfirstlane(kdst+(slot)))
  #define DMA_V(t,slot) glds16(vsrc+(long)(t)*KVBLK*DM,(unsigned)__builtin_amdgcn_readfirstlane(vdst+(slot)))
  const int vb0=(int)(lds0+LDS_V)+((lane>>4)&1)*32+(lane&3)*8+(4*hi+((lane&15)>>2))*64;
  const char*Kbase=shm+LDS_K; bf16x8 kf[8];
  const lds_cptr shm3=(lds_cptr)shm; const lds_cptr kp0=shm3+LDS_K+hi*1024+r32*16; const lds_cptr vp0=shm3+LDS_V+((lane>>4)&1)*32+(lane&3)*8+(4*hi+((lane&15)>>2))*64;
  const int NT=(q0+QB)/KVBLK;
  DMA_K(0,0);DMA_V(0,0);DMA_K(1,SLOTB);
  bf16x8 qr[4];
  #pragma unroll
  for(int d0=0;d0<4;++d0)qr[d0]=*reinterpret_cast<const bf16x8*>(&Qw[(long)r32*DM+d0*16+hi*8]);
  { int lp_=lane; asm volatile("":"+v"(lp_)); const int r32p=lp_&31, hip=lp_>>5;
    unsigned sel=0u; const __attribute__((address_space(3))) float*km=(const __attribute__((address_space(3))) float*)((__attribute__((address_space(3))) const char*)shm+LDS_KM); float g0=-3e38f,g1=-3e38f,g2=-3e38f; int s0=-1,s1=-1,s2=-1;
    for(int j=0;j<qb;++j){ float g=0.f;
      #pragma unroll
      for(int d0=0;d0<4;++d0){
        #pragma unroll
        for(int e=0;e<8;++e)g+=__builtin_bit_cast(float,((unsigned)(unsigned short)qr[d0][e])<<16)*km[j*64+16*d0+8*hip+e];}
      g+=__shfl_xor(g,32);
      if(g>g0){g2=g1;s2=s1;g1=g0;s1=s0;g0=g;s0=j;}else if(g>g1){g2=g1;s2=s1;g1=g;s1=j;}else if(g>g2){g2=g;s2=j;} }
    if(s0>=0)sel|=1u<<s0; if(s1>=0)sel|=1u<<s1; if(s2>=0)sel|=1u<<s2;
    if(hip==0)((__attribute__((address_space(3))) unsigned*)((__attribute__((address_space(3))) char*)shm+LDS_SEL))[wid*32+r32p]=sel; asm volatile("s_waitcnt lgkmcnt(0)":::"memory"); }
  float mhat=0.f,l_reg=0.f;f32x16 o[2];o[0]=f32x16{};o[1]=f32x16{};f32x16 negm=f32x16{};asm volatile("":"+v"(negm));
  const int qrel=wid*QBLK+r32;
  #define BMASK(P0,P1,t) do{}while(0)
  #define CMASK(P0,P1,t) do{int jb_=(t)-(NT-4); if(jb_>=0)cmask(P0,P1,jb_,qrel,hi); else BMASK(P0,P1,t);}while(0)
  bool resc=false;
  #define START(P0,P1) do{ const float rm=rowmax(P0,P1); resc=false; \
    { const float dl=__builtin_fmaxf(rm,-64.f); mhat=fadd_s(mhat,dl); \
      _Pragma("unroll") for(int r=0;r<16;++r){P0[r]=fsub_s(P0[r],dl);P1[r]=fsub_s(P1[r],dl);} \
      _Pragma("unroll") for(int r=0;r<16;++r)negm[r]=-mhat; asm volatile("":"+v"(negm)); } \
    _Pragma("unroll") for(int r=0;r<16;++r)P0[r]=__builtin_amdgcn_exp2f(P0[r]); }while(0)
  #define RESC() do{ if(resc){ asm volatile("s_waitcnt lgkmcnt(0)":::"memory"); \
      _Pragma("unroll") for(int d_=0;d_<2;++d_) _Pragma("unroll") for(int r=0;r<16;++r)o[d_][r]*=wsf[crow(r,hi)]; } }while(0)
  f32x16 pA0,pA1,pB0,pB1;
  int sl_prev=0,sl_cur=0,sl_next=SLOTB;
  #define ROT() do{sl_prev=sl_cur;sl_cur=sl_next;sl_next=(sl_next==(NSLOT-1)*SLOTB)?0:sl_next+SLOTB;}while(0)
  DMA_K(2,2*SLOTB);
  WAIT_BAR(3);
  qkt(pA0,pA1,Kbase,qr,negm,r32,hi);asm volatile("s_nop 15\n\ts_nop 7":"+v"(pA0),"+v"(pA1));CMASK(pA0,pA1,0);
  START(pA0,pA1);
  _Pragma("unroll") for(int r=0;r<16;++r)pA1[r]=__builtin_amdgcn_exp2f(pA1[r]);
  WAIT_BAR(0);
  DMA_K(3,0);DMA_V(1,SLOTB);
  ROT();
  kload8(kf,kp0+sl_cur);
  WAIT_BAR(2);
  s16x4 vlo[8],vhi[8]; u32x4 pw0,pw1,pw2,pw3;
  #define PKW(P,B) (keep_?cvtpk_s(P[B],P[B+1]):0u)
  #define PAF(k) __builtin_bit_cast(bf16x8,pw##k)
  #define VFR(i) (bf16x8){vlo[i][0],vlo[i][1],vlo[i][2],vlo[i][3],vhi[i][0],vhi[i][1],vhi[i][2],vhi[i][3]}
  #define PIN(x) asm volatile("":"+v"(x))
  #define MX3(a,b,c) __builtin_fmaxf(__builtin_fmaxf((a),(b)),(c))
  #define GAPA(MF,A0,A1,A2,A3,W0,W1,PW) do{ MF; sacc+=A0; sacc+=A1; sacc+=A2; sacc+=A3; PIN(sacc); W0; W1; PIN(PW); SBAR(); }while(0)
  #define EX(v) __builtin_amdgcn_exp2f(v)
  #define GAPB(MF,X,B) do{ MF; X[B]=EX(X[B]); X[B+1]=EX(X[B+1]); X[B+2]=EX(X[B+2]); X[B+3]=EX(X[B+3]); PIN(X); SBAR(); }while(0)
  #define VRD(i) do{ vlo[i]=vtr(vp_+(((i)>>2)*4096+((i)&3)*1024)); vhi[i]=vtr(vp_+(((i)>>2)*4096+((i)&3)*1024+512)); }while(0)
  #define KRD(G,j) do{ if(G){ kload2(kf,kp0+sl_next,j); SBAR(); } }while(0)
  #define STEP(C0,C1,P0,P1,t,GK,GV,GL) do{ SBAR(); \
    int q_=qrel; asm volatile("":"+v"(q_)); const unsigned selw_=((const volatile __attribute__((address_space(3))) unsigned*)((__attribute__((address_space(3))) const char*)shm+LDS_SEL))[q_]; \
    const bool keep_=((t)-1>=NT-4)||((selw_>>(((t)-1)>>2))&1u); \
    const lds_cptr vp_=vp0+sl_prev; \
    VRD(0); SBAR(); float sacc=(P0[0]+P0[1]); \
    GAPA(C0=__builtin_amdgcn_mfma_f32_32x32x16_bf16(kf[0],qr[0],negm,0,0,0), P0[2],P0[3],P0[4],P0[5],     pw0[0]=PKW(P0,0), pw0[1]=PKW(P0,2), pw0); \
    VRD(4); SBAR(); GAPA(C1=__builtin_amdgcn_mfma_f32_32x32x16_bf16(kf[1],qr[0],negm,0,0,0), P0[6],P0[7],P0[8],P0[9],     pw0[2]=PKW(P0,4), pw0[3]=PKW(P0,6), pw0); \
    VRD(1); SBAR(); GAPA(C0=__builtin_amdgcn_mfma_f32_32x32x16_bf16(kf[2],qr[1],C0,0,0,0),   P0[10],P0[11],P0[12],P0[13], pw1[0]=PKW(P0,8), pw1[1]=PKW(P0,10), pw1); \
    VRD(5); SBAR(); GAPA(C1=__builtin_amdgcn_mfma_f32_32x32x16_bf16(kf[3],qr[1],C1,0,0,0),   P0[14],P0[15],P1[0],P1[1],   pw1[2]=PKW(P0,12),pw1[3]=PKW(P0,14), pw1); \
    VRD(2); SBAR(); GAPA(C0=__builtin_amdgcn_mfma_f32_32x32x16_bf16(kf[4],qr[2],C0,0,0,0),   P1[2],P1[3],P1[4],P1[5],     pw2[0]=PKW(P1,0), pw2[1]=PKW(P1,2), pw2); \
    VRD(6); SBAR(); GAPA(C1=__builtin_amdgcn_mfma_f32_32x32x16_bf16(kf[5],qr[2],C1,0,0,0),   P1[6],P1[7],P1[8],P1[9],     pw2[2]=PKW(P1,4), pw2[3]=PKW(P1,6), pw2); \
    VRD(3); SBAR(); GAPA(C0=__builtin_amdgcn_mfma_f32_32x32x16_bf16(kf[6],qr[3],C0,0,0,0),   P1[10],P1[11],P1[12],P1[13], pw3[0]=PKW(P1,8), pw3[1]=PKW(P1,10), pw3); \
    VRD(7); SBAR(); GAPA(C1=__builtin_amdgcn_mfma_f32_32x32x16_bf16(kf[7],qr[3],C1,0,0,0),   P1[14],P1[15],0.f,0.f,       pw3[2]=PKW(P1,12),pw3[3]=PKW(P1,14), pw3); \
    l_reg+=keep_?sacc:0.f; \
    if(GK){DMA_K((t)+3,sl_cur);} if(GV){DMA_V((t)+1,sl_next);} \
    CMASK(C0,C1,t); \
    { float a=MX3(C0[0],C0[1],C1[0]),b=MX3(C0[2],C0[3],C1[1]); a=MX3(a,C1[2],C1[3]); \
      _Pragma("unroll") for(int r=4;r<16;r+=4){a=MX3(a,C0[r],C0[r+1]);b=MX3(b,C0[r+2],C0[r+3]);a=MX3(a,C1[r],C1[r+1]);b=MX3(b,C1[r+2],C1[r+3]);} \
      float rm=__builtin_fmaxf(a,b); { auto rr=__builtin_amdgcn_permlane32_swap(__float_as_uint(rm),__float_as_uint(rm),false,false); rm=__builtin_fmaxf(__uint_as_float(rr[0]),__uint_as_float(rr[1])); } \
      resc=false; \
      if(__builtin_expect(__any(rm>(float)THRL),0)){ const float dl=__builtin_fmaxf(rm,0.f); mhat+=dl; \
        _Pragma("unroll") for(int r=0;r<16;++r){C0[r]-=dl;C1[r]-=dl;} \
        _Pragma("unroll") for(int r=0;r<16;++r)negm[r]=-mhat; asm volatile("":"+v"(negm)); \
        const float f=__builtin_amdgcn_exp2f(-dl); l_reg*=f; if(hi==0)wsf[r32]=f; resc=true; } } \
    SBAR(); \
    GAPB(o[0]=__builtin_amdgcn_mfma_f32_32x32x16_bf16(PAF(0),VFR(0),o[0],0,0,0), C0,0); \
    GAPB(o[1]=__builtin_amdgcn_mfma_f32_32x32x16_bf16(PAF(0),VFR(4),o[1],0,0,0), C0,4); \
    KRD(GL,0); GAPB(o[0]=__builtin_amdgcn_mfma_f32_32x32x16_bf16(PAF(1),VFR(1),o[0],0,0,0), C0,8); \
    KRD(GL,1); GAPB(o[1]=__builtin_amdgcn_mfma_f32_32x32x16_bf16(PAF(1),VFR(5),o[1],0,0,0), C0,12); \
    KRD(GL,2); GAPB(o[0]=__builtin_amdgcn_mfma_f32_32x32x16_bf16(PAF(2),VFR(2),o[0],0,0,0), C1,0); \
    KRD(GL,3); GAPB(o[1]=__builtin_amdgcn_mfma_f32_32x32x16_bf16(PAF(2),VFR(6),o[1],0,0,0), C1,4); \
    GAPB(o[0]=__builtin_amdgcn_mfma_f32_32x32x16_bf16(PAF(3),VFR(3),o[0],0,0,0), C1,8); \
    GAPB(o[1]=__builtin_amdgcn_mfma_f32_32x32x16_bf16(PAF(3),VFR(7),o[1],0,0,0), C1,12); \
    }while(0)
  int t=1;
  for(;t+5<NT;t+=2){
    STEP(pB0,pB1,pA0,pA1,t,true,true,true);     WAIT_BAR(2); RESC(); ROT();
    STEP(pA0,pA1,pB0,pB1,t+1,true,true,true);   WAIT_BAR(2); RESC(); ROT();
  }
  #define ENDW(tt) do{ if((tt)+3<NT){WAIT_BAR(2);} else if((tt)+2<NT){WAIT_BAR(1);} else {WAIT_BAR(0);} }while(0)
  for(;t+1<NT;t+=2){
    STEP(pB0,pB1,pA0,pA1,t,(t+3<NT),(t+1<NT),(t+1<NT));       ENDW(t);   RESC(); ROT();
    STEP(pA0,pA1,pB0,pB1,t+1,(t+4<NT),(t+2<NT),(t+2<NT));     ENDW(t+1); RESC(); ROT();
  }
  STEP(pB0,pB1,pA0,pA1,NT-1,false,false,false); RESC();
  { const bool keep_=true; float sacc=pB0[0]+pB0[1]; _Pragma("unroll") for(int r=2;r<16;++r)sacc+=pB0[r]; _Pragma("unroll") for(int r=0;r<16;++r)sacc+=pB1[r]; l_reg+=sacc;
    pw0=(u32x4){PKW(pB0,0),PKW(pB0,2),PKW(pB0,4),PKW(pB0,6)};pw1=(u32x4){PKW(pB0,8),PKW(pB0,10),PKW(pB0,12),PKW(pB0,14)};pw2=(u32x4){PKW(pB1,0),PKW(pB1,2),PKW(pB1,4),PKW(pB1,6)};pw3=(u32x4){PKW(pB1,8),PKW(pB1,10),PKW(pB1,12),PKW(pB1,14)};
    SBAR(); pv(o,vb0+sl_cur,PAF(0),PAF(1),PAF(2),PAF(3)); }
  #undef PKW
  #undef PAF
  #undef VFR
  #undef PIN
  #undef MX3
  #undef GAPA
  #undef GAPB
  #undef EX
  #undef VRD
  #undef KRD
  #undef STEP
  #undef ENDW
  {auto rr=__builtin_amdgcn_permlane32_swap(__float_as_uint(l_reg),__float_as_uint(l_reg),false,false);l_reg=__uint_as_float(rr[0])+__uint_as_float(rr[1]);}
  if(hi==0)wsf[32+r32]=l_reg;asm volatile("s_waitcnt lgkmcnt(0)":::"memory");
  float rli[16];
  #pragma unroll
  for(int r=0;r<16;++r)rli[r]=__builtin_amdgcn_rcpf(wsf[32+crow(r,hi)]);
  bf16*Ow=O+(rowbase+q0+wid*QBLK)*DM+h*D;
  { bf16*stg=(bf16*)(shm+LDS_OST)+wid*2048;
    #pragma unroll
    for(int r=0;r<16;++r){const int orow=crow(r,hi);
      #pragma unroll
      for(int d0=0;d0<2;++d0)stg[orow*64+d0*32+r32]=__float2bfloat16(o[d0][r]*rli[r]);}
    asm volatile("s_waitcnt lgkmcnt(0)":::"memory");
    #pragma unroll
    for(int i=0;i<4;++i){const int row=i*8+(lane>>3),ch=lane&7; const u32x4 v=*(const u32x4*)(stg+row*64+ch*8); ATTN_STORE16(Ow+(long)row*DM+ch*8,v);} }
  asm volatile("s_waitcnt lgkmcnt(0)\n\ts_barrier":::"memory");
  #undef DMA_K
  #undef DMA_V
  #undef CMASK
  #undef BMASK
  #undef START
  #undef RESC
  #undef ROT
}
constexpr int ATTN_LDS_BYTES=LDS_BYTES;
struct AttnTensors { const bf16* Q; const bf16* K; const bf16* V; bf16* O; const float* KM; };
struct AttnUnit { int bh; int qb; };
struct StaticOrder {
  int vcu;
  __device__ __forceinline__ explicit StaticOrder(int grid,int block):vcu((block%8)*(grid/8)+block/8){}
  __device__ __forceinline__ bool next(int i,AttnUnit&u)const{ if(i>=4)return false; const int s=vcu&7; u.bh=vcu>>3; u.qb=(i==0)?s:(i==1)?15-s:(i==2)?16+s:31-s; return true; }
  __device__ __forceinline__ void a_ready(const AttnUnit&)const{}
  __device__ __forceinline__ void done(const AttnUnit&)const{}
};
template<class Sched,int THRL=8> __device__ __forceinline__ void attn_phase(char*lds,const AttnTensors&T,const Sched&S){
  AttnUnit u; int lastbh=-1;
  for(int i=0;S.next(i,u);++i){
    if(u.bh!=lastbh){ __syncthreads(); float*km=(float*)(lds+LDS_KM); int tx_=threadIdx.x; asm volatile("":"+v"(tx_)); for(int k=tx_;k<32*64;k+=512)km[k]=T.KM[(long)u.bh*32*64+k]; asm volatile("s_waitcnt vmcnt(0) lgkmcnt(0)":::"memory"); __syncthreads(); lastbh=u.bh; }
    attn_unit<THRL>(u.bh/NHEAD,u.bh%NHEAD,u.qb,T.Q,T.K,T.V,T.O,lds); }
}
#undef SBAR
#undef WAIT_BAR
}

#define XB_TMO      128
#define XB_XCNT(j)  (256  + 64 * (j))
#define XB_XSUB(j)  (1280 + 64 * (j))
#define XB_XGEN(j)  (2304 + 64 * (j))
#define XB_TOP      3328
#define XB_TOPGEN   3392
#define XCD_BAR_WORDS 3456
#define XB_SPIN_CAP (1u << 20)
__device__ __forceinline__ unsigned xb_ld(unsigned* p)              { return __hip_atomic_load(p, __ATOMIC_RELAXED, __HIP_MEMORY_SCOPE_AGENT); }
__device__ __forceinline__ unsigned xb_add(unsigned* p, unsigned v) { return __hip_atomic_fetch_add(p, v, __ATOMIC_RELAXED, __HIP_MEMORY_SCOPE_AGENT); }
__device__ __forceinline__ unsigned xb_xcc_id() { return (unsigned)__builtin_amdgcn_s_getreg((3 << 11) | 20) & 0xFu; }
#define XB_SPIN(cond, bar) do { unsigned _sp = 0; while (cond) { __builtin_amdgcn_s_sleep(1); \
    if ((++_sp & 255u) == 0u) { if (xb_ld(&(bar)[XB_TMO])) break; if (_sp > XB_SPIN_CAP) { atomicAdd(&(bar)[XB_TMO], 1u); break; } } } } while (0)
struct XcdBarrier { unsigned* bar; unsigned x; volatile LAS unsigned* st; };
__device__ __forceinline__ XcdBarrier xcd_barrier_post(unsigned* bar, volatile LAS unsigned* st) {
    XcdBarrier b; b.bar = bar; b.x = xb_xcc_id(); b.st = st;
    if (threadIdx.x == 0) (void)xb_add(&bar[XB_XCNT(b.x)], 1u);
    return b;
}
__device__ __forceinline__ void xcd_barrier_complete(unsigned* bar, unsigned x, unsigned& nloc, unsigned& nx) {
    const unsigned G = gridDim.x * gridDim.y * gridDim.z;
    unsigned sum, cnt, mine, sp = 0u;
    for (;;) {
        sum = 0u; cnt = 0u; mine = 0u;
#pragma unroll
        for (unsigned j = 0; j < 16; ++j) { const unsigned c = xb_ld(&bar[XB_XCNT(j)]); sum += c; cnt += (c > 0u) ? 1u : 0u; mine = (j == x) ? c : mine; }
        if (sum == G) break;
        __builtin_amdgcn_s_sleep(1);
        if ((++sp & 255u) == 0u) { if (xb_ld(&bar[XB_TMO])) break; if (sp > XB_SPIN_CAP) { atomicAdd(&bar[XB_TMO], 1u); break; } }
    }
    nloc = mine > 0u ? mine : 1u; nx = cnt > 0u ? cnt : 1u;
}
__device__ __forceinline__ void xcd_barrier(const XcdBarrier& b) {
    asm volatile("s_waitcnt vmcnt(0)" ::: "memory");
    __syncthreads();
    if (threadIdx.x == 0) {
        unsigned* bar = b.bar;
        __builtin_amdgcn_s_waitcnt(0);
        unsigned nloc = b.st[0], nx = b.st[1];
        if (nloc == 0u) { xcd_barrier_complete(bar, b.x, nloc, nx); b.st[0] = nloc; b.st[1] = nx; }
        const unsigned old = xb_add(&bar[XB_XSUB(b.x)], 1u);
        const unsigned gen = old / nloc;
        if (old + 1u == (gen + 1u) * nloc) {
            __builtin_amdgcn_fence(__ATOMIC_RELEASE, "agent");
            asm volatile("s_waitcnt vmcnt(0)" ::: "memory");
            const unsigned og = xb_add(&bar[XB_TOP], 1u);
            const unsigned tg = og / nx;
            if (og + 1u == (tg + 1u) * nx) xb_add(&bar[XB_TOPGEN], 1u);
            else XB_SPIN(xb_ld(&bar[XB_TOPGEN]) == tg, bar);
            __builtin_amdgcn_fence(__ATOMIC_ACQUIRE, "agent");
            xb_add(&bar[XB_XGEN(b.x)], 1u);
            asm volatile("s_waitcnt vmcnt(0)" ::: "memory");
        } else {
            XB_SPIN(xb_ld(&bar[XB_XGEN(b.x)]) == gen, bar);
            __builtin_amdgcn_fence(__ATOMIC_ACQUIRE, "agent");
            asm volatile("s_waitcnt vmcnt(0)" ::: "memory");
        }
    }
    __syncthreads();
}

struct Args { const float* in[28]; float* out; unsigned char* ws; int ph_lo, ph_hi; };
enum { I_X = 0, I_MEM, I_GMIX, I_WIN, I_ARE, I_AIM, I_LOGDT, I_BRE, I_BIM, I_CRE, I_CIM, I_DSKIP, I_WGLU, I_WPA, I_WOUT, I_GXATTN, I_GMEM, I_WXQ, I_WXKV, I_WXO,
       I_GMOE, I_WROUTER, I_BROUTER, I_WGU, I_BGU, I_WDN, I_BDN, I_GFINAL };

template <int MAP>
__device__ __forceinline__ void p0_transpose_item(const float* W, int K, int N, const float* gain, bf16_t* WT, LAS float* scr, int item, int lane) {
    const int nblk = N / 32, kb = item / nblk, nb = item % nblk, k0 = 64 * kb, n0 = 32 * nb;
#pragma unroll 8
    for (int i = 0; i < 32; ++i) { const int kk = 2 * i + (lane >> 5); float v = W[(size_t)(k0 + kk) * N + n0 + (lane & 31)]; if (gain) v *= gain[k0 + kk]; scr[kk * 33 + (lane & 31)] = v; }
    asm volatile("s_waitcnt lgkmcnt(0)" ::: "memory");
    const int c = lane & 7;
    const int nr0 = (MAP == 1) ? (256 * ((n0 % 1024) / 128) + 128 * (n0 / 1024) + (n0 % 128)) : n0;
#pragma unroll
    for (int j = 0; j < 4; ++j) { const int n = (lane >> 3) + 8 * j; const LAS float* s = scr + (8 * c) * 33 + n;
        u32x4 o; o.x = pk2(s[0 * 33], s[1 * 33]); o.y = pk2(s[2 * 33], s[3 * 33]); o.z = pk2(s[4 * 33], s[5 * 33]); o.w = pk2(s[6 * 33], s[7 * 33]);
        *(u32x4*)(WT + (size_t)(nr0 + n) * K + k0 + 8 * c) = o; }
    asm volatile("s_waitcnt lgkmcnt(0)" ::: "memory");
}
template <int MODE>
__device__ __forceinline__ float rms_row_to_bf16(const float* xrow, const float* gain, bf16_t* orow, int lane) {
    const f32x4* xr = (const f32x4*)xrow + lane;
    f32x4 v[4]; float s = 0.f;
#pragma unroll
    for (int j = 0; j < 4; ++j) { v[j] = xr[64 * j]; s += (v[j][0] * v[j][0] + v[j][1] * v[j][1]) + (v[j][2] * v[j][2] + v[j][3] * v[j][3]); }
    const float rstd = 1.0f / sqrtf(wave_sum(s) * (1.0f / DM) + RMS_EPS);
    u32x2* o8 = (u32x2*)orow + lane;
#pragma unroll
    for (int j = 0; j < 4; ++j) { f32x4 w = v[j];
        if (MODE == 1) { const f32x4 g = ((const f32x4*)gain)[lane + 64 * j]; w = w * rstd * g; }
        u32x2 o; o.x = pk2(w[0], w[1]); o.y = pk2(w[2], w[3]); o8[64 * j] = o; }
    return rstd;
}

struct Frame {
    LAS unsigned char* lds; int tid, lane, wave, G, bid;
    const float* in[28]; float* out; unsigned char* ws; unsigned* ctl;
};
#define WSP(type, off) ((type*)(F.ws + (off)))

__device__ __forceinline__ void phase_prologue(Frame& F) {
    LAS float* scr = (LAS float*)(F.lds + F.wave * 16384);
    const int gw = F.bid * 8 + F.wave, NGW = F.G * 8;
    for (int m = gw; m < T_; m += NGW) { const float r = rms_row_to_bf16<0>(F.in[I_X] + (size_t)m * DM, nullptr, WSP(bf16_t, WS_XB) + (size_t)m * DM, F.lane); if (F.lane == 0) WSP(float, WS_RSTD0)[m] = r; }
    for (int m = gw; m < NB * MEML; m += NGW) (void)rms_row_to_bf16<1>(F.in[I_MEM] + (size_t)m * DM, F.in[I_GMEM], WSP(bf16_t, WS_MN) + (size_t)m * DM, F.lane);
    constexpr int I_IN = (DM / 64) * (INW / 32), I_GLU = (SW / 64) * (2 * DM / 32), I_PA = (AW / 64) * (DM / 32), I_OUT = (DM / 64) * (DM / 32), I_XQ = (DM / 64) * (XW / 32),
                  I_XKV = (DM / 64) * (2 * XW / 32), I_XO = (XW / 64) * (DM / 32), I_GU1 = (DM / 64) * (2 * DFF / 32), I_DN1 = (DFF / 64) * (DM / 32);
    constexpr int NITEMS = I_IN + I_GLU + I_PA + I_OUT + I_XQ + I_XKV + I_XO + NE * (I_GU1 + I_DN1);
    for (int it = gw; it < NITEMS; it += NGW) {
        int r = it;
        if (r < I_IN) { p0_transpose_item<0>(F.in[I_WIN], DM, INW, F.in[I_GMIX], WSP(bf16_t, WS_WIN), scr, r, F.lane); continue; } r -= I_IN;
        if (r < I_GLU) { p0_transpose_item<1>(F.in[I_WGLU], SW, 2 * DM, nullptr, WSP(bf16_t, WS_WGLU), scr, r, F.lane); continue; } r -= I_GLU;
        if (r < I_PA) { p0_transpose_item<0>(F.in[I_WPA], AW, DM, nullptr, WSP(bf16_t, WS_WPA), scr, r, F.lane); continue; } r -= I_PA;
        if (r < I_OUT) { p0_transpose_item<0>(F.in[I_WOUT], DM, DM, nullptr, WSP(bf16_t, WS_WOUT), scr, r, F.lane); continue; } r -= I_OUT;
        if (r < I_XQ) { p0_transpose_item<0>(F.in[I_WXQ], DM, XW, F.in[I_GXATTN], WSP(bf16_t, WS_WXQ), scr, r, F.lane); continue; } r -= I_XQ;
        if (r < I_XKV) { p0_transpose_item<0>(F.in[I_WXKV], DM, 2 * XW, nullptr, WSP(bf16_t, WS_WXKV), scr, r, F.lane); continue; } r -= I_XKV;
        if (r < I_XO) { p0_transpose_item<0>(F.in[I_WXO], XW, DM, nullptr, WSP(bf16_t, WS_WXO), scr, r, F.lane); continue; } r -= I_XO;
        const int e = r / (I_GU1 + I_DN1); r -= e * (I_GU1 + I_DN1);
        if (r < I_GU1) p0_transpose_item<1>(F.in[I_WGU] + (size_t)e * DM * 2 * DFF, DM, 2 * DFF, F.in[I_GMOE], WSP(bf16_t, WS_WGU) + (size_t)e * 2 * DFF * DM, scr, r, F.lane);
        else p0_transpose_item<0>(F.in[I_WDN] + (size_t)e * DFF * DM, DFF, DM, nullptr, WSP(bf16_t, WS_WDN) + (size_t)e * DM * DFF, scr, r - I_GU1, F.lane);
    }
}

__device__ __forceinline__ void phase_kmean(Frame& F) {
    LAS float* red = (LAS float*)F.lds;
    const bf16_t* Kb = WSP(bf16_t, WS_K);
    for (int it = F.bid; it < NB * NH * NBLK; it += F.G) {
        const int j = it % NBLK, h = (it / NBLK) % NH, b = it / (NBLK * NH);
        const int col = F.tid & 63, rg = F.tid >> 6; float s = 0.f;
        const bf16_t* p = Kb + ((size_t)(b * SEQ + j * MBLK + rg * 32)) * AW + h * HD + col;
#pragma unroll 8
        for (int r = 0; r < 32; ++r) s += bf2f(p[(size_t)r * AW]);
        red[rg * 64 + col] = s;
        __syncthreads();
        if (F.tid < 64) { float t = 0.f;
#pragma unroll
            for (int k = 0; k < 8; ++k) t += red[k * 64 + F.tid];
            WSP(float, WS_KMEAN)[(size_t)it * HD + F.tid] = t * (1.0f / MBLK); }
        __syncthreads();
    }
}

__device__ __forceinline__ void phase_moba_simple(Frame& F) {
    LAS unsigned* Ks = (LAS unsigned*)F.lds;
    LAS unsigned* Vs = (LAS unsigned*)(F.lds + 32768);
    LAS float* km = (LAS float*)(F.lds + 65536);
    const bf16_t *Qb = WSP(bf16_t, WS_Q), *Kb = WSP(bf16_t, WS_K), *Vb = WSP(bf16_t, WS_V); bf16_t* Ob = WSP(bf16_t, WS_ATT);
    const int ql = F.tid >> 1, half = F.tid & 1;
    for (int it = F.bid; it < NB * NH * NBLK; it += F.G) {
        const int iblk = (NBLK - 1) - (it % NBLK), h = (it / NBLK) % NH, b = it / (NBLK * NH);
        __syncthreads();
        for (int k = F.tid; k < NBLK * HD; k += 512) km[k] = WSP(float, WS_KMEAN)[(size_t)((b * NH + h) * NBLK) * HD + k];
        float q[32];
        { const u32x4* qp = (const u32x4*)(Qb + (size_t)(b * SEQ + iblk * MBLK + ql) * AW + h * HD + half * 32);
#pragma unroll
          for (int c = 0; c < 4; ++c) { const u32x4 w = qp[c]; q[8 * c + 0] = bflo(w.x); q[8 * c + 1] = bfhi(w.x); q[8 * c + 2] = bflo(w.y); q[8 * c + 3] = bfhi(w.y); q[8 * c + 4] = bflo(w.z); q[8 * c + 5] = bfhi(w.z); q[8 * c + 6] = bflo(w.w); q[8 * c + 7] = bfhi(w.w); } }
        __syncthreads();
        float g0 = -3e38f, g1 = -3e38f, g2 = -3e38f; int s0 = -1, s1 = -1, s2 = -1;
        for (int j = 0; j < iblk; ++j) { float g = 0.f;
#pragma unroll
            for (int d = 0; d < 32; ++d) g += q[d] * km[j * HD + half * 32 + d];
            g += __shfl_xor(g, 1);
            if (g > g0) { g2 = g1; s2 = s1; g1 = g0; s1 = s0; g0 = g; s0 = j; } else if (g > g1) { g2 = g1; s2 = s1; g1 = g; s1 = j; } else if (g > g2) { g2 = g; s2 = j; } }
        float mx = -3e38f, l = 0.f, o[32];
#pragma unroll
        for (int d = 0; d < 32; ++d) o[d] = 0.f;
        for (int jb = 0; jb <= iblk; ++jb) {
            __syncthreads();
            { const size_t rowb = (size_t)(b * SEQ + jb * MBLK);
              for (int c = F.tid; c < 256 * 8; c += 512) { const int r = c >> 3, ch = c & 7;
                  *(LAS u32x4*)(Ks + r * 32 + ch * 4) = *(const u32x4*)(Kb + (rowb + r) * AW + h * HD + ch * 8);
                  *(LAS u32x4*)(Vs + r * 32 + ch * 4) = *(const u32x4*)(Vb + (rowb + r) * AW + h * HD + ch * 8); } }
            __syncthreads();
            const bool need = (jb == iblk) || jb == s0 || jb == s1 || jb == s2;
            if (need) { const int kend = (jb == iblk) ? ql : 255;
                for (int kk = 0; kk <= kend; ++kk) { float s = 0.f;
#pragma unroll
                    for (int c = 0; c < 4; ++c) { const u32x4 w = *(const LAS u32x4*)(Ks + kk * 32 + half * 16 + c * 4);
                        s += q[8 * c + 0] * bflo(w.x) + q[8 * c + 1] * bfhi(w.x) + q[8 * c + 2] * bflo(w.y) + q[8 * c + 3] * bfhi(w.y) + q[8 * c + 4] * bflo(w.z) + q[8 * c + 5] * bfhi(w.z) + q[8 * c + 6] * bflo(w.w) + q[8 * c + 7] * bfhi(w.w); }
                    s += __shfl_xor(s, 1);
                    const float mn = fmaxf(mx, s), corr = __builtin_amdgcn_exp2f(mx - mn), p = __builtin_amdgcn_exp2f(s - mn); mx = mn; l = l * corr + p;
#pragma unroll
                    for (int c = 0; c < 4; ++c) { const u32x4 w = *(const LAS u32x4*)(Vs + kk * 32 + half * 16 + c * 4);
                        o[8 * c + 0] = o[8 * c + 0] * corr + p * bflo(w.x); o[8 * c + 1] = o[8 * c + 1] * corr + p * bfhi(w.x); o[8 * c + 2] = o[8 * c + 2] * corr + p * bflo(w.y); o[8 * c + 3] = o[8 * c + 3] * corr + p * bfhi(w.y);
                        o[8 * c + 4] = o[8 * c + 4] * corr + p * bflo(w.z); o[8 * c + 5] = o[8 * c + 5] * corr + p * bfhi(w.z); o[8 * c + 6] = o[8 * c + 6] * corr + p * bflo(w.w); o[8 * c + 7] = o[8 * c + 7] * corr + p * bfhi(w.w); } } }
        }
        const float il = 1.0f / l;
        u32x4* op = (u32x4*)(Ob + (size_t)(b * SEQ + iblk * MBLK + ql) * AW + h * HD + half * 32);
#pragma unroll
        for (int c = 0; c < 4; ++c) { u32x4 w; w.x = pk2(o[8 * c + 0] * il, o[8 * c + 1] * il); w.y = pk2(o[8 * c + 2] * il, o[8 * c + 3] * il); w.z = pk2(o[8 * c + 4] * il, o[8 * c + 5] * il); w.w = pk2(o[8 * c + 6] * il, o[8 * c + 7] * il); op[c] = w; }
    }
}

__device__ __forceinline__ void phase_ssm_simple(Frame& F) {
    const int gw = F.bid * 8 + F.wave, NGW = F.G * 8, p = F.lane;
    const bf16_t* Ub = WSP(bf16_t, WS_U); bf16_t* Yb = WSP(bf16_t, WS_YB);
    for (int it = gw; it < NB * NG; it += NGW) {
        const int g = it % NG, b = it / NG;
        const float are = fminf(F.in[I_ARE][g * SP + p], -1e-4f), aim = F.in[I_AIM][g * SP + p], dt = expf(F.in[I_LOGDT][g]);
        const float mag = expf(are * dt), ang = aim * dt; const float lr = mag * cosf(ang), li = mag * sinf(ang);
        const float nr = lr - 1.0f, ni = li, den = 1.0f / (are * are + aim * aim); const float fr_ = (nr * are + ni * aim) * den, fi_ = (ni * are - nr * aim) * den;
        float bbr[16], bbi[16], cr[16], ci[16], dsk[16];
#pragma unroll
        for (int c = 0; c < 16; ++c) { const float br = F.in[I_BRE][(size_t)(g * SP + p) * SGC + c], bi = F.in[I_BIM][(size_t)(g * SP + p) * SGC + c];
            bbr[c] = fr_ * br - fi_ * bi; bbi[c] = fr_ * bi + fi_ * br;
            cr[c] = F.in[I_CRE][(size_t)(g * SGC + c) * SP + p]; ci[c] = F.in[I_CIM][(size_t)(g * SGC + c) * SP + p]; dsk[c] = F.in[I_DSKIP][g * SGC + c]; }
        float xr = 0.f, xi = 0.f;
        const int csel = ((p >> 5) & 1) * 8 + ((p >> 4) & 1) * 4 + ((p >> 3) & 1) * 2 + ((p >> 2) & 1);
        float dmine = 0.f;
#pragma unroll
        for (int c = 0; c < 16; ++c) dmine = (c == csel) ? dsk[c] : dmine;
        for (int t = 0; t < SEQ; ++t) {
            const u32x4* up = (const u32x4*)(Ub + (size_t)(b * SEQ + t) * SW + g * SGC); const u32x4 w0 = up[0], w1 = up[1];
            float u[16]; u[0] = bflo(w0.x); u[1] = bfhi(w0.x); u[2] = bflo(w0.y); u[3] = bfhi(w0.y); u[4] = bflo(w0.z); u[5] = bfhi(w0.z); u[6] = bflo(w0.w); u[7] = bfhi(w0.w);
            u[8] = bflo(w1.x); u[9] = bfhi(w1.x); u[10] = bflo(w1.y); u[11] = bfhi(w1.y); u[12] = bflo(w1.z); u[13] = bfhi(w1.z); u[14] = bflo(w1.w); u[15] = bfhi(w1.w);
            float sr = 0.f, si = 0.f;
#pragma unroll
            for (int c = 0; c < 16; ++c) { sr += bbr[c] * u[c]; si += bbi[c] * u[c]; }
            const float nxr = lr * xr - li * xi + sr, nxi = lr * xi + li * xr + si; xr = nxr; xi = nxi;
            float y[16];
#pragma unroll
            for (int c = 0; c < 16; ++c) y[c] = cr[c] * xr - ci[c] * xi;
            float w8[8], w4[4], w2[2], w1_;
            { const bool hi = (p & 32) != 0;
#pragma unroll
              for (int i = 0; i < 8; ++i) { const float keep = hi ? y[i + 8] : y[i], send = hi ? y[i] : y[i + 8]; w8[i] = keep + __shfl_xor(send, 32); } }
            { const bool hi = (p & 16) != 0;
#pragma unroll
              for (int i = 0; i < 4; ++i) { const float keep = hi ? w8[i + 4] : w8[i], send = hi ? w8[i] : w8[i + 4]; w4[i] = keep + __shfl_xor(send, 16); } }
            { const bool hi = (p & 8) != 0;
#pragma unroll
              for (int i = 0; i < 2; ++i) { const float keep = hi ? w4[i + 2] : w4[i], send = hi ? w4[i] : w4[i + 2]; w2[i] = keep + __shfl_xor(send, 8); } }
            { const bool hi = (p & 4) != 0; const float keep = hi ? w2[1] : w2[0], send = hi ? w2[0] : w2[1]; w1_ = keep + __shfl_xor(send, 4); }
            w1_ += __shfl_xor(w1_, 2); w1_ += __shfl_xor(w1_, 1);
            float umine = 0.f;
#pragma unroll
            for (int c = 0; c < 16; ++c) umine = (c == csel) ? u[c] : umine;
            if ((p & 3) == 0) Yb[(size_t)(b * SEQ + t) * SW + g * SGC + csel] = (bf16_t)f2bf(gelu_tanh(w1_ + dmine * umine));
        }
    }
}


__device__ __forceinline__ void p0_ssm_tables(Frame& F, int task) {
    const int g = task >> 3, part = task & 7;
    LAS float* pwr = (LAS float*)F.lds; LAS float* pwi = pwr + 65 * 64; LAS float* bbr = pwi + 65 * 64; LAS float* bbi = bbr + 1024; LAS float* ccr = bbi + 1024; LAS float* cci = ccr + 1024;
    const float dt = expf(F.in[I_LOGDT][g]);
    __syncthreads();
    for (int i = F.tid; i < 65 * 64; i += 512) { const int k = i >> 6, p = i & 63; const float are = fminf(F.in[I_ARE][g * SP + p], -1e-4f), aim = F.in[I_AIM][g * SP + p];
        const float mag = expf(are * dt * (float)k); double a = (double)aim * (double)dt * (double)k; a -= 6.283185307179586 * rint(a * 0.15915494309189535); const float af = (float)a;
        pwr[i] = mag * cosf(af); pwi[i] = mag * sinf(af); }
    for (int i = F.tid; i < 1024; i += 512) { const int p = i >> 4, c = i & 15; const float are = fminf(F.in[I_ARE][g * SP + p], -1e-4f), aim = F.in[I_AIM][g * SP + p];
        const float mag = expf(are * dt); double a = (double)aim * (double)dt; a -= 6.283185307179586 * rint(a * 0.15915494309189535); const float af = (float)a;
        const float lr = mag * cosf(af), li = mag * sinf(af), nr = lr - 1.0f, ni = li, den = 1.0f / (are * are + aim * aim), fr_ = (nr * are + ni * aim) * den, fi_ = (ni * are - nr * aim) * den;
        const float br = F.in[I_BRE][(size_t)(g * SP + p) * SGC + c], bi = F.in[I_BIM][(size_t)(g * SP + p) * SGC + c];
        bbr[i] = fr_ * br - fi_ * bi; bbi[i] = fr_ * bi + fi_ * br; }
    for (int i = F.tid; i < 1024; i += 512) { ccr[i] = F.in[I_CRE][(size_t)g * 1024 + i]; cci[i] = F.in[I_CIM][(size_t)g * 1024 + i]; }
    __syncthreads();
    bf16_t* WST = WSP(bf16_t, WS_WST) + (size_t)g * 128 * 1024; bf16_t* GT = WSP(bf16_t, WS_GT) + (size_t)g * 1024 * 128; bf16_t* KT = WSP(bf16_t, WS_KT) + (size_t)g * 65 * 256;
    for (int j = 0; j < 32; ++j) { const int e = part * 16384 + j * 512 + F.tid; const int pp = e >> 10, k = e & 1023, s = k >> 4, c = k & 15, p = pp & 63;
        const float mr = pwr[(63 - s) * 64 + p], mi = pwi[(63 - s) * 64 + p], br = bbr[p * 16 + c], bi = bbi[p * 16 + c];
        WST[e] = (bf16_t)f2bf(pp < 64 ? (mr * br - mi * bi) : (mr * bi + mi * br)); }
    for (int j = 0; j < 32; ++j) { const int e = part * 16384 + j * 512 + F.tid; const int sc = e >> 7, pp = e & 127, s = sc >> 4, c = sc & 15, p = pp & 63;
        const float mr = pwr[(s + 1) * 64 + p], mi = pwi[(s + 1) * 64 + p], cr = ccr[c * 64 + p], ci = cci[c * 64 + p];
        GT[e] = (bf16_t)f2bf(pp < 64 ? (cr * mr - ci * mi) : -(cr * mi + ci * mr)); }
    for (int e = part * 2080 + F.tid; e < (part + 1) * 2080; e += 512) { const int tt = e >> 8, c = (e >> 4) & 15, c2 = e & 15; float acc = 0.f;
        if (tt > 0) { const int tau = tt - 1;
            for (int p = 0; p < 64; ++p) { const float mr = pwr[tau * 64 + p], mi = pwi[tau * 64 + p], cr = ccr[c * 64 + p], ci = cci[c * 64 + p]; const float zr = cr * mr - ci * mi, zi = cr * mi + ci * mr; acc += zr * bbr[p * 16 + c2] - zi * bbi[p * 16 + c2]; } }
        KT[e] = (bf16_t)f2bf(acc); }
    if (part == 0 && F.tid < 64) { WSP(f32x2, WS_LAML)[g * 64 + F.tid] = (f32x2){pwr[64 * 64 + F.tid], pwi[64 * 64 + F.tid]}; }
    __syncthreads();
}
__device__ __forceinline__ void ssm_state_item(Frame& F, int b, int g) {
    const int w = F.wave, wm = w >> 1, wn = w & 1, row = F.lane & 15, kg = F.lane >> 4;
    f32x4 acc[2][4];
#pragma unroll
    for (int a = 0; a < 2; ++a)
#pragma unroll
        for (int c = 0; c < 4; ++c) acc[a][c] = (f32x4){0.f, 0.f, 0.f, 0.f};
    const bf16_t* Ub = WSP(bf16_t, WS_U) + ((size_t)b * SEQ + (size_t)(32 * wm + row) * 64 + (kg >> 1)) * SW + g * SGC + 8 * (kg & 1);
    const bf16_t* Wb = WSP(bf16_t, WS_WST) + ((size_t)g * 128 + 64 * wn + row) * 1024 + 8 * kg;
#pragma unroll 2
    for (int ks = 0; ks < 32; ++ks) {
        bf16x8 a[2], bq[4];
#pragma unroll
        for (int mt = 0; mt < 2; ++mt) a[mt] = *(const bf16x8*)(Ub + ((size_t)(16 * mt * 64 + 2 * ks)) * SW);
#pragma unroll
        for (int nt = 0; nt < 4; ++nt) bq[nt] = *(const bf16x8*)(Wb + (size_t)nt * 16 * 1024 + 32 * ks);
#pragma unroll
        for (int mt = 0; mt < 2; ++mt)
#pragma unroll
            for (int nt = 0; nt < 4; ++nt) acc[mt][nt] = __builtin_amdgcn_mfma_f32_16x16x32_bf16(a[mt], bq[nt], acc[mt][nt], 0, 0, 0);
    }
    LAS float* X = (LAS float*)F.lds;
    __syncthreads();
#pragma unroll
    for (int mt = 0; mt < 2; ++mt)
#pragma unroll
        for (int nt = 0; nt < 4; ++nt)
#pragma unroll
            for (int r = 0; r < 4; ++r) X[(32 * wm + 16 * mt + 4 * kg + r) * 128 + 64 * wn + 16 * nt + row] = acc[mt][nt][r];
    __syncthreads();
    if (w == 0) { const int p = F.lane; const f32x2 lam = WSP(f32x2, WS_LAML)[g * 64 + p]; float sr = 0.f, si = 0.f;
        bf16_t* SS = WSP(bf16_t, WS_SST) + ((size_t)(b * NG + g) * 128) * 128;
        for (int n = 0; n < 128; ++n) { SS[n * 128 + p] = (bf16_t)f2bf(sr); SS[n * 128 + 64 + p] = (bf16_t)f2bf(si);
            const float xr = X[n * 128 + p], xi = X[n * 128 + 64 + p]; const float nsr = lam.x * sr - lam.y * si + xr, nsi = lam.x * si + lam.y * sr + xi; sr = nsr; si = nsi; } }
    __syncthreads();
}
constexpr int SO_USTR = 2064, SO_KT = 32 * SO_USTR, SO_SS = SO_KT + 65 * 512, SO_SSTR = 272;
__device__ __forceinline__ void ssm_out_item(Frame& F, int b, int g, int rr) {
    LAS unsigned char* L = F.lds;
    __syncthreads();
    { const bf16_t* Ug = WSP(bf16_t, WS_U) + ((size_t)b * SEQ + (size_t)rr * 2048) * SW + g * SGC;
#pragma unroll
      for (int j = 0; j < 8; ++j) { const int c = F.tid + 512 * j, r = c >> 1, half = c & 1; *(LAS u32x4*)(L + (r >> 6) * SO_USTR + (r & 63) * 32 + half * 16) = *(const u32x4*)(Ug + (size_t)r * SW + half * 8); }
      const u32x4* Kg = (const u32x4*)(WSP(bf16_t, WS_KT) + (size_t)g * 65 * 256);
      for (int c = F.tid; c < 2080; c += 512) *(LAS u32x4*)(L + SO_KT + c * 16) = Kg[c];
      { const int c = F.tid, ch = c >> 4, pc = c & 15; *(LAS u32x4*)(L + SO_SS + ch * SO_SSTR + pc * 16) = *(const u32x4*)(WSP(bf16_t, WS_SST) + ((size_t)((b * NG + g) * 128 + rr * 32 + ch)) * 128 + pc * 8); } }
    __syncthreads();
    const int w = F.wave, mt = w >> 2, q = w & 3, row = F.lane & 15, kg = F.lane >> 4;
    f32x4 acc[16];
#pragma unroll
    for (int i = 0; i < 16; ++i) acc[i] = (f32x4){0.f, 0.f, 0.f, 0.f};
    const LAS unsigned char* Ua = L + (16 * mt + row) * SO_USTR + (kg >> 1) * 32 + (kg & 1) * 16;
    const LAS unsigned char* Kb_ = L + SO_KT + (1 - (kg >> 1)) * 512 + row * 32 + (kg & 1) * 16;
#pragma unroll 1
    for (int ks = 0; ks < 32; ++ks) {
        const bf16x8 a = *(const LAS bf16x8*)(Ua + ks * 64);
#pragma unroll
        for (int i = 0; i < 16; ++i) { const int s = 4 * i + q; if (s >= 2 * ks) { const bf16x8 bb = *(const LAS bf16x8*)(Kb_ + (s - 2 * ks) * 512); acc[i] = __builtin_amdgcn_mfma_f32_16x16x32_bf16(a, bb, acc[i], 0, 0, 0); } }
    }
    const bf16_t* Gg = WSP(bf16_t, WS_GT) + ((size_t)g * 1024 + q * 16 + row) * 128 + 8 * kg;
#pragma unroll 1
    for (int k2 = 0; k2 < 4; ++k2) {
        const bf16x8 a = *(const LAS bf16x8*)(L + SO_SS + (16 * mt + row) * SO_SSTR + k2 * 64 + kg * 16);
#pragma unroll
        for (int hh = 0; hh < 2; ++hh) {
            bf16x8 bb[8]; const bf16_t* gp = Gg + (size_t)hh * 8 * 64 * 128 + 32 * k2;
#pragma unroll
            for (int i = 0; i < 8; ++i) { bb[i] = *(const bf16x8*)gp; gp += 64 * 128; }
#pragma unroll
            for (int i = 0; i < 8; ++i) acc[hh * 8 + i] = __builtin_amdgcn_mfma_f32_16x16x32_bf16(a, bb[i], acc[hh * 8 + i], 0, 0, 0);
        }
    }
    __syncthreads();
    const float dsk = F.in[I_DSKIP][g * SGC + row];
    { LAS unsigned short* yb = (LAS unsigned short*)(L + (16 * mt + 4 * kg) * SO_USTR + q * 32 + row * 2);
#pragma unroll
      for (int i = 0; i < 16; ++i)
#pragma unroll
          for (int r = 0; r < 4; ++r) { LAS unsigned short* p = yb + (r * SO_USTR + i * 128) / 2; const float u = bf2f(*p); *p = (unsigned short)f2bf(gelu_tanh(acc[i][r] + dsk * u)); } }
    __syncthreads();
    { bf16_t* Yg = WSP(bf16_t, WS_YB) + ((size_t)b * SEQ + (size_t)rr * 2048) * SW + g * SGC;
#pragma unroll 2
      for (int j = 0; j < 8; ++j) { const int c = F.tid + 512 * j, r = c >> 1, half = c & 1; *(u32x4*)(Yg + (size_t)r * SW + half * 8) = *(const LAS u32x4*)(L + (r >> 6) * SO_USTR + (r & 63) * 32 + half * 16); } }
}
__device__ __forceinline__ void phase_ssm_out(Frame& F) {
    for (int it = F.bid; it < NB * NG * 4; it += F.G) ssm_out_item(F, it >> 7, (it >> 2) & 31, it & 3);
    __syncthreads();
}

__device__ __forceinline__ void phase_xattn_simple(Frame& F) {
    LAS unsigned* Ks = (LAS unsigned*)F.lds;
    LAS unsigned* Vs = (LAS unsigned*)(F.lds + 65536);
    const bf16_t *Qb = WSP(bf16_t, WS_XQ), *KV = WSP(bf16_t, WS_MKV); bf16_t* Ob = WSP(bf16_t, WS_XO);
    const int tl = F.tid >> 2, part = F.tid & 3;
    int lastbh = -1;
    for (int it = F.bid; it < NB * XH * (SEQ / 128); it += F.G) {
        const int bh = it / (SEQ / 128), ch = it % (SEQ / 128), b = bh / XH, h = bh % XH;
        if (bh != lastbh) { __syncthreads();
            for (int c = F.tid; c < 256 * 16; c += 512) { const int r = c >> 4, cc = c & 15;
                *(LAS u32x4*)(Ks + r * 64 + cc * 4) = *(const u32x4*)(KV + (size_t)(b * MEML + r) * (2 * XW) + h * XD + cc * 8);
                *(LAS u32x4*)(Vs + r * 64 + cc * 4) = *(const u32x4*)(KV + (size_t)(b * MEML + r) * (2 * XW) + XW + h * XD + cc * 8); }
            __syncthreads(); lastbh = bh; }
        const size_t row = (size_t)b * SEQ + ch * 128 + tl;
        float q[32];
        { const u32x4* qp = (const u32x4*)(Qb + row * XW + h * XD + part * 32);
#pragma unroll
          for (int c = 0; c < 4; ++c) { const u32x4 w = qp[c]; q[8 * c + 0] = bflo(w.x); q[8 * c + 1] = bfhi(w.x); q[8 * c + 2] = bflo(w.y); q[8 * c + 3] = bfhi(w.y); q[8 * c + 4] = bflo(w.z); q[8 * c + 5] = bfhi(w.z); q[8 * c + 6] = bflo(w.w); q[8 * c + 7] = bfhi(w.w); } }
        float mx = -3e38f, l = 0.f, o[32];
#pragma unroll
        for (int d = 0; d < 32; ++d) o[d] = 0.f;
        for (int kk = 0; kk < MEML; ++kk) { float s = 0.f;
#pragma unroll
            for (int c = 0; c < 4; ++c) { const u32x4 w = *(const LAS u32x4*)(Ks + kk * 64 + part * 16 + c * 4);
                s += q[8 * c + 0] * bflo(w.x) + q[8 * c + 1] * bfhi(w.x) + q[8 * c + 2] * bflo(w.y) + q[8 * c + 3] * bfhi(w.y) + q[8 * c + 4] * bflo(w.z) + q[8 * c + 5] * bfhi(w.z) + q[8 * c + 6] * bflo(w.w) + q[8 * c + 7] * bfhi(w.w); }
            s += __shfl_xor(s, 1); s += __shfl_xor(s, 2);
            const float mn = fmaxf(mx, s), corr = __builtin_amdgcn_exp2f(mx - mn), p = __builtin_amdgcn_exp2f(s - mn); mx = mn; l = l * corr + p;
#pragma unroll
            for (int c = 0; c < 4; ++c) { const u32x4 w = *(const LAS u32x4*)(Vs + kk * 64 + part * 16 + c * 4);
                o[8 * c + 0] = o[8 * c + 0] * corr + p * bflo(w.x); o[8 * c + 1] = o[8 * c + 1] * corr + p * bfhi(w.x); o[8 * c + 2] = o[8 * c + 2] * corr + p * bflo(w.y); o[8 * c + 3] = o[8 * c + 3] * corr + p * bfhi(w.y);
                o[8 * c + 4] = o[8 * c + 4] * corr + p * bflo(w.z); o[8 * c + 5] = o[8 * c + 5] * corr + p * bfhi(w.z); o[8 * c + 6] = o[8 * c + 6] * corr + p * bflo(w.w); o[8 * c + 7] = o[8 * c + 7] * corr + p * bfhi(w.w); } }
        const float il = 1.0f / l;
        u32x4* op = (u32x4*)(Ob + row * XW + h * XD + part * 32);
#pragma unroll
        for (int c = 0; c < 4; ++c) { u32x4 w; w.x = pk2(o[8 * c + 0] * il, o[8 * c + 1] * il); w.y = pk2(o[8 * c + 2] * il, o[8 * c + 3] * il); w.z = pk2(o[8 * c + 4] * il, o[8 * c + 5] * il); w.w = pk2(o[8 * c + 6] * il, o[8 * c + 7] * il); op[c] = w; }
    }
}

__device__ __forceinline__ void phase_router(Frame& F) {
    LAS float* wt = (LAS float*)F.lds;
    for (int c = F.tid; c < NE * DM; c += 512) { const int k = c >> 5, e = c & 31; wt[e * DM + k] = F.in[I_WROUTER][c] * F.in[I_GMOE][k]; }
    __syncthreads();
    const int gw = F.bid * 8 + F.wave, NGW = F.G * 8, lane = F.lane;
    const float* H = WSP(float, WS_H);
    unsigned* cnt = F.ctl + CW_CNT;
    for (int tk = gw; tk < T_; tk += NGW) {
        const f32x4* hp = (const f32x4*)(H + (size_t)tk * DM) + lane; f32x4 hv[4]; float ss = 0.f;
#pragma unroll
        for (int j = 0; j < 4; ++j) { hv[j] = hp[64 * j]; ss += (hv[j][0] * hv[j][0] + hv[j][1] * hv[j][1]) + (hv[j][2] * hv[j][2] + hv[j][3] * hv[j][3]); }
        const float rstd = 1.0f / sqrtf(wave_sum(ss) * (1.0f / DM) + RMS_EPS);
        float mylogit = 0.f;
#pragma unroll 4
        for (int e = 0; e < NE; ++e) { float a = 0.f;
#pragma unroll
            for (int j = 0; j < 4; ++j) { const f32x4 w = *(const LAS f32x4*)(wt + e * DM + 4 * lane + 256 * j); a += (hv[j][0] * w[0] + hv[j][1] * w[1]) + (hv[j][2] * w[2] + hv[j][3] * w[3]); }
            a = wave_sum(a);
            mylogit = (lane == e) ? a : mylogit; }
        mylogit = (lane < NE) ? (mylogit * rstd + F.in[I_BROUTER][lane & 31]) : -3e38f;
        float tv[4]; int ti[4]; float cur = mylogit;
#pragma unroll
        for (int s = 0; s < 4; ++s) { float bv = cur; int bi = lane;
#pragma unroll
            for (int o = 1; o < 64; o <<= 1) { const float ov = __shfl_xor(bv, o); const int oi = __shfl_xor(bi, o); if (ov > bv || (ov == bv && oi < bi)) { bv = ov; bi = oi; } }
            tv[s] = bv; ti[s] = bi; if (lane == bi) cur = -3e38f; }
        const float e1 = __expf(tv[1] - tv[0]), e2 = __expf(tv[2] - tv[0]), e3 = __expf(tv[3] - tv[0]); const float inv = 1.0f / (1.0f + e1 + e2 + e3);
        if (lane == 0) WSP(float, WS_RSTD2)[tk] = rstd;
        if (lane < 4) { const int ex = (lane == 0) ? ti[0] : (lane == 1) ? ti[1] : (lane == 2) ? ti[2] : ti[3]; const float gv = ((lane == 0) ? 1.0f : (lane == 1) ? e1 : (lane == 2) ? e2 : e3) * inv;
            WSP(float, WS_TKG)[(size_t)tk * 4 + lane] = gv;
            const unsigned rank = atomicAdd(&cnt[ex], 1u);
            WSP(int, WS_ROWLIST)[(size_t)ex * T_ + rank] = tk * 4 + lane; }
    }
}

__device__ __forceinline__ void phase_final(Frame& F) {
    const int gw = F.bid * 8 + F.wave, NGW = F.G * 8, lane = F.lane;
    const float* H = WSP(float, WS_H); const bf16_t* Y = WSP(bf16_t, WS_Y);
    for (int tk = gw; tk < T_; tk += NGW) {
        const f32x4* hp = (const f32x4*)(H + (size_t)tk * DM) + lane; f32x4 hv[4];
#pragma unroll
        for (int j = 0; j < 4; ++j) hv[j] = hp[64 * j];
#pragma unroll
        for (int s = 0; s < 4; ++s) { const u32x2* yp = (const u32x2*)(Y + ((size_t)tk * 4 + s) * DM) + lane;
#pragma unroll
            for (int j = 0; j < 4; ++j) { const u32x2 w = yp[64 * j]; hv[j][0] += bflo(w.x); hv[j][1] += bfhi(w.x); hv[j][2] += bflo(w.y); hv[j][3] += bfhi(w.y); } }
        float ss = 0.f;
#pragma unroll
        for (int j = 0; j < 4; ++j) ss += (hv[j][0] * hv[j][0] + hv[j][1] * hv[j][1]) + (hv[j][2] * hv[j][2] + hv[j][3] * hv[j][3]);
        const float rstd = 1.0f / sqrtf(wave_sum(ss) * (1.0f / DM) + RMS_EPS);
        f32x4* op = (f32x4*)(F.out + (size_t)tk * DM) + lane;
#pragma unroll
        for (int j = 0; j < 4; ++j) op[64 * j] = hv[j] * rstd * ((const f32x4*)F.in[I_GFINAL])[lane + 64 * j];
    }
}

constexpr int N_PHASES = 15;
__global__ void __launch_bounds__(512, 2) mega_fwd(Args args) {
    extern __shared__ __attribute__((aligned(16))) unsigned char lds_raw[];
    Frame F;
    F.lds = (LAS unsigned char*)lds_raw; F.tid = threadIdx.x; F.lane = F.tid & 63; F.wave = __builtin_amdgcn_readfirstlane(F.tid >> 6); F.G = gridDim.x; F.bid = blockIdx.x;
#pragma unroll
    for (int i = 0; i < 28; ++i) F.in[i] = args.in[i];
    F.out = args.out; F.ws = args.ws; F.ctl = (unsigned*)(args.ws + WS_CTL);
    volatile LAS unsigned* MISC = (volatile LAS unsigned*)(F.lds + MISC_OFF);
    if (F.tid < 64) MISC[F.tid] = 0u;
    __syncthreads();
    const int lo = args.ph_lo, hi = args.ph_hi;
    XcdBarrier bar; bar.bar = F.ctl + CW_BAR; bar.x = 0; bar.st = nullptr;
    if (hi - lo > 1) bar = xcd_barrier_post(F.ctl + CW_BAR, MISC + 8);
#define IN(k) (lo <= (k) && (k) < hi)
#define SEAM(k) do { if (IN(k) && IN((k) + 1)) xcd_barrier(bar); } while (0)
    LAS unsigned char* ring = F.lds;
    const LAS int* gidx = (const LAS int*)(F.lds + GIDX_OFF);

    if (IN(0)) { for (int tk = F.bid; tk < NG * 8; tk += F.G) p0_ssm_tables(F, tk); phase_prologue(F); } SEAM(0);
    if (IN(1)) {
        { pg8::Gemm g{WSP(bf16_t, WS_XB), WSP(bf16_t, WS_WIN), DM, 0}; pg8::PatchOrder S; S.init(T_ / 256, INW / 256, 8, F.G, F.bid);
          pg8::EpiInProj E{WSP(float, WS_RSTD0), WSP(bf16_t, WS_Q), WSP(bf16_t, WS_K), WSP(bf16_t, WS_V), WSP(bf16_t, WS_U), WSP(bf16_t, WS_SGA), WSP(bf16_t, WS_SGB)};
          pg8::gemm_phase<pg8::EpiInProj, pg8::PatchOrder, false>(ring, g, S, E, gidx); }
        { pg8::Gemm g{WSP(bf16_t, WS_MN), WSP(bf16_t, WS_WXKV), DM, 0}; pg8::PatchOrder S; S.init(NB * MEML / 256, 2 * XW / 256, 4, F.G, F.bid);
          pg8::EpiStore E{WSP(bf16_t, WS_MKV), 2 * XW};
          pg8::gemm_phase<pg8::EpiStore, pg8::PatchOrder, false>(ring, g, S, E, gidx); }
    } SEAM(1);
    if (IN(2)) { phase_kmean(F); } SEAM(2);
    if (IN(3)) {
        for (int it = F.bid; it < NB * NG; it += F.G) ssm_state_item(F, it / NG, it % NG);
        const attn_body::AttnTensors AT{(const attn_body::bf16*)WSP(bf16_t, WS_Q), (const attn_body::bf16*)WSP(bf16_t, WS_K), (const attn_body::bf16*)WSP(bf16_t, WS_V), (attn_body::bf16*)WSP(bf16_t, WS_ATT), WSP(float, WS_KMEAN)};
        const attn_body::StaticOrder SO((int)F.G, (int)F.bid);
        attn_body::attn_phase<attn_body::StaticOrder>((char*)lds_raw, AT, SO);
    } SEAM(3);
    if (IN(4)) { phase_ssm_out(F); } SEAM(4);
    if (IN(5)) {
        pg8::Gemm g{WSP(bf16_t, WS_YB), WSP(bf16_t, WS_WGLU), SW, 0}; pg8::PatchOrder S; S.init(T_ / 256, 2 * DM / 256, 8, F.G, F.bid);
        pg8::EpiGlu E{WSP(bf16_t, WS_SGB), WSP(bf16_t, WS_YB2S)};
        pg8::gemm_phase<pg8::EpiGlu, pg8::PatchOrder, false>(ring, g, S, E, gidx);
    } SEAM(5);
    if (IN(6)) {
        pg8::Gemm g{WSP(bf16_t, WS_ATT), WSP(bf16_t, WS_WPA), AW, 0}; pg8::PatchOrder S; S.init(T_ / 256, DM / 256, 4, F.G, F.bid);
        pg8::EpiMerge E{WSP(bf16_t, WS_SGA), WSP(bf16_t, WS_YB2S), WSP(bf16_t, WS_MERGED)};
        pg8::gemm_phase<pg8::EpiMerge, pg8::PatchOrder, false>(ring, g, S, E, gidx);
    } SEAM(6);
    if (IN(7)) {
        pg8::Gemm g{WSP(bf16_t, WS_MERGED), WSP(bf16_t, WS_WOUT), DM, 0}; pg8::PatchOrder S; S.init(T_ / 256, DM / 256, 4, F.G, F.bid);
        pg8::EpiResid E{F.in[I_X], WSP(float, WS_H), WSP(bf16_t, WS_HB), WSP(float, WS_SSQ1)};
        pg8::gemm_phase<pg8::EpiResid, pg8::PatchOrder, false>(ring, g, S, E, gidx);
    } SEAM(7);
    if (IN(8)) {
        pg8::Gemm g{WSP(bf16_t, WS_HB), WSP(bf16_t, WS_WXQ), DM, 0}; pg8::PatchOrder S; S.init(T_ / 256, XW / 256, 2, F.G, F.bid);
        pg8::EpiXq E{WSP(float, WS_SSQ1), WSP(bf16_t, WS_XQ)};
        pg8::gemm_phase<pg8::EpiXq, pg8::PatchOrder, false>(ring, g, S, E, gidx);
    } SEAM(8);
    if (IN(9)) { phase_xattn_simple(F); } SEAM(9);
    if (IN(10)) {
        pg8::Gemm g{WSP(bf16_t, WS_XO), WSP(bf16_t, WS_WXO), XW, 0}; pg8::PatchOrder S; S.init(T_ / 256, DM / 256, 4, F.G, F.bid);
        pg8::EpiResid E{WSP(float, WS_H), WSP(float, WS_H), WSP(bf16_t, WS_HB), WSP(float, WS_SSQ2)};
        pg8::gemm_phase<pg8::EpiResid, pg8::PatchOrder, false>(ring, g, S, E, gidx);
    } SEAM(10);
    if (IN(11)) { phase_router(F); } SEAM(11);
    if (IN(12) || IN(13)) {
        LAS int* pref = (LAS int*)(F.lds + MISC_OFF + 256);
        const unsigned* cnt = F.ctl + CW_CNT;
        __syncthreads();
        if (F.tid == 0) { int a = 0; for (int e = 0; e < NE; ++e) { pref[e] = a; a += ((int)__hip_atomic_load(cnt + e, RLX_AGENT) + 255) >> 8; } pref[NE] = a; }
        __syncthreads();
        const int MT = pref[NE];
        if (IN(12)) {
            MoeOrder S; S.P.init(MT, 2 * DFF / 256, 8, F.G, F.bid); S.pref = pref;
            { LAS int* gw_ = (LAS int*)(F.lds + GIDX_OFF); pg8::Unit u;
              for (int i = 0; i < GIDX_UNITS && S.next(i, u); ++i) { const int ce = (int)__hip_atomic_load(cnt + u.e, RLX_AGENT);
                  if (F.tid < 256) { const int rank = u.mi * 256 + F.tid; gw_[i * 256 + F.tid] = (rank < ce) ? (WSP(int, WS_ROWLIST)[(size_t)u.e * T_ + rank] >> 2) : 0; } } }
            __syncthreads();
            pg8::Gemm g{WSP(bf16_t, WS_HB), WSP(bf16_t, WS_WGU), DM, (size_t)2 * DFF * DM};
            pg8::EpiMoe1 E{WSP(float, WS_RSTD2), F.in[I_BGU], WSP(bf16_t, WS_HID), gidx};
            pg8::gemm_phase<pg8::EpiMoe1, MoeOrder, true>(ring, g, S, E, gidx);
        }
        SEAM(12);
        if (IN(13)) {
            MoeOrder S; S.P.init(MT, DM / 256, 4, F.G, F.bid); S.pref = pref;
            pg8::Gemm g{WSP(bf16_t, WS_HID), WSP(bf16_t, WS_WDN), DFF, (size_t)DM * DFF};
            pg8::EpiMoe2 E{F.in[I_BDN], WSP(float, WS_TKG), WSP(int, WS_ROWLIST), cnt, WSP(bf16_t, WS_Y)};
            pg8::gemm_phase<pg8::EpiMoe2, MoeOrder, false>(ring, g, S, E, gidx);
        }
    } SEAM(13);
    if (IN(14)) { phase_final(F); }
#undef IN
#undef SEAM
}

extern "C" void kernel_launch(void* const* d_in, const int* in_sizes, int n_in, void* d_out, int out_size, void* d_ws, size_t ws_size, hipStream_t stream) {
    static int grid = 0;
    if (grid == 0) {
        if (n_in != 28 || in_sizes[0] != T_ * DM || out_size != T_ * DM || ws_size < WS_END) { fprintf(stderr, "kernel_launch: unexpected shapes (n_in %d, in0 %d, out %d, ws %zu)\n", n_in, n_in > 0 ? in_sizes[0] : -1, out_size, ws_size); grid = -1; return; }
        int dev = 0, cus = 0;
        if (hipGetDevice(&dev) != hipSuccess || hipDeviceGetAttribute(&cus, hipDeviceAttributeMultiprocessorCount, dev) != hipSuccess) { grid = -1; return; }
        if (hipFuncSetAttribute((const void*)mega_fwd, hipFuncAttributeMaxDynamicSharedMemorySize, LDS_BYTES) != hipSuccess) { fprintf(stderr, "kernel_launch: hipFuncSetAttribute failed\n"); grid = -1; return; }
        (void)hipGetLastError();
        grid = cus;
    }
    if (grid < 0) return;
    (void)hipMemsetAsync((char*)d_ws + WS_CTL, 0, CTL_ZERO_BYTES, stream);
    Args a{};
    for (int i = 0; i < 28; ++i) a.in[i] = (const float*)d_in[i];
    a.out = (float*)d_out; a.ws = (unsigned char*)d_ws;
#if MK_N_LAUNCHES == 1
    a.ph_lo = 0; a.ph_hi = N_PHASES;
    hipLaunchKernelGGL(mega_fwd, dim3(grid), dim3(512), LDS_BYTES, stream, a);
#else
    for (int p = 0; p < N_PHASES; ++p) { a.ph_lo = p; a.ph_hi = p + 1; hipLaunchKernelGGL(mega_fwd, dim3(grid), dim3(512), LDS_BYTES, stream, a); }
#endif
}
```

```cpp
#include <hip/hip_runtime.h>
#include <hip/hip_bf16.h>
#include <cmath>
#include <cstdio>
#include <cstdint>

#ifndef MK_N_LAUNCHES
#define MK_N_LAUNCHES 1
#endif

#ifndef DBG_STAGE
#define DBG_STAGE 0
#endif

#define GAS __attribute__((address_space(1)))
#define LAS __attribute__((address_space(3)))
typedef unsigned short bf16_t;
typedef short bf16x8 __attribute__((ext_vector_type(8)));
typedef float f32x4 __attribute__((ext_vector_type(4)));
typedef float f32x2 __attribute__((ext_vector_type(2)));
typedef unsigned u32x4 __attribute__((ext_vector_type(4)));
typedef unsigned u32x2 __attribute__((ext_vector_type(2)));

constexpr int NB = 4, SEQ = 8192, DM = 1024, T_ = NB * SEQ;
constexpr int AW = 512, NH = 8, HD = 64, MBLK = 256, NBLK = SEQ / MBLK, MTOPK = 3;
constexpr int SW = 512, SGC = 16, NG = 32, SP = 64;
constexpr int INW = 4096;
constexpr int MEML = 256, XH = 4, XD = 128, XW = 512;
constexpr int NE = 32, ETOPK = 4, DFF = 1024;
constexpr float RMS_EPS = 1e-6f;
constexpr float LOG2E = 1.4426950408889634f;
constexpr float QSCALE = 0.125f * LOG2E;
constexpr float XSCALE = 0.08838834764831845f * LOG2E;
constexpr int HID_ROWS = ETOPK * T_ + NE * 256;

constexpr size_t MiB = 1u << 20;
constexpr size_t WS_WIN = 0 * MiB, WS_WGLU = 8 * MiB, WS_WPA = 10 * MiB, WS_WOUT = 11 * MiB, WS_WXQ = 13 * MiB, WS_WXKV = 14 * MiB, WS_WXO = 16 * MiB,
                 WS_WGU = 17 * MiB, WS_WDN = 145 * MiB;
constexpr size_t WS_CTL = 209 * MiB, CTL_ZERO_BYTES = 1 * MiB;
constexpr size_t WS_RSTD0 = 210 * MiB;
constexpr size_t WS_RSTD2 = WS_RSTD0 + 128 * 1024;
constexpr size_t WS_KMEAN = WS_RSTD2 + 128 * 1024;
constexpr size_t WS_TKG = WS_KMEAN + 256 * 1024;
constexpr size_t WS_SSQ1 = 211 * MiB;
constexpr size_t WS_SSQ2 = 213 * MiB;
constexpr size_t WS_ROWLIST = 215 * MiB;
constexpr size_t WS_MN = 219 * MiB;
constexpr size_t WS_MKV = 221 * MiB;
constexpr size_t WS_WST = 225 * MiB;
constexpr size_t WS_GT = 233 * MiB;
constexpr size_t WS_KT = 241 * MiB;
constexpr size_t WS_LAML = 243 * MiB;
constexpr size_t WS_SST = 244 * MiB;
constexpr size_t WS_H = 256 * MiB;
constexpr size_t WS_HB = 384 * MiB;
constexpr size_t WS_HID = 448 * MiB;
constexpr size_t WS_Y = 720 * MiB;
constexpr size_t WS_END = 976 * MiB;
constexpr size_t WS_XB = 448 * MiB, WS_Q = 512 * MiB, WS_K = 544 * MiB, WS_V = 576 * MiB, WS_U = 608 * MiB, WS_ATT = 640 * MiB, WS_YB = 672 * MiB;
constexpr size_t WS_SGA = 720 * MiB, WS_SGB = 784 * MiB, WS_YB2S = 848 * MiB, WS_MERGED = 912 * MiB;
constexpr size_t WS_XQ = 448 * MiB, WS_XO = 480 * MiB;
static_assert(WS_HID + (size_t)HID_ROWS * DFF * 2 <= WS_Y, "HID fits");
constexpr int CW_TMO = 0, CW_CNT = 64  , CW_DBG = 128  , CW_BAR = 4096;

constexpr int RING_BYTES = 131072;
constexpr int GIDX_OFF = RING_BYTES, GIDX_UNITS = 24;
constexpr int MISC_OFF = GIDX_OFF + GIDX_UNITS * 1024;
constexpr int LDS_BYTES = 163840;

#define RLX_AGENT __ATOMIC_RELAXED, __HIP_MEMORY_SCOPE_AGENT
__device__ __forceinline__ unsigned f2bf(float f) { unsigned u = __builtin_bit_cast(unsigned, f); return (u + 0x7fffu + ((u >> 16) & 1u)) >> 16; }
__device__ __forceinline__ unsigned pk2(float lo, float hi) { return f2bf(lo) | (f2bf(hi) << 16); }
__device__ __forceinline__ float bf2f(unsigned short b) { return __builtin_bit_cast(float, (unsigned)b << 16); }
__device__ __forceinline__ float bflo(unsigned w) { return __builtin_bit_cast(float, w << 16); }
__device__ __forceinline__ float bfhi(unsigned w) { return __builtin_bit_cast(float, w & 0xffff0000u); }
__device__ __forceinline__ float wave_sum(float v) {
#pragma unroll
    for (int o = 1; o < 64; o <<= 1) v += __shfl_xor(v, o);
    return v;
}
__device__ __forceinline__ float fsigmoid(float x) { return __builtin_amdgcn_rcpf(1.0f + __builtin_amdgcn_exp2f(-x * LOG2E)); }
__device__ __forceinline__ float gelu_tanh(float x) {
    const float u = 0.7978845608028654f * (x + 0.044715f * x * x * x);
    return x * fsigmoid(2.0f * u);
}

namespace pg8 {
constexpr int BM = 256, BK = 64, HALF = 128, HTB = HALF * BK * 2, STAGE_BYTES = 8 * HTB;
__host__ __device__ __forceinline__ int lds_byte(int r, int c) { const int st = (r >> 4) * 2 + (c >> 5), rr = r & 15, cc = c & 31, ob = rr * 64 + cc * 2; return st * 1024 + (ob ^ (((ob >> 9) & 1) << 5)); }
__host__ __device__ __forceinline__ void stage_rc(int b, int& R, int& C) { const int st = b / 1024, sb = b % 1024, swz = sb ^ (((sb >> 9) & 1) << 5); R = (st >> 1) * 16 + swz / 64; C = (st & 1) * 32 + (swz % 64) / 2; }
__host__ __device__ __forceinline__ int perm32(int rho) { const int n = rho >> 4, i = rho & 15; return 8 * (i >> 2) + 4 * n + (i & 3); }

struct Unit { int pm, pn, e, mi, ui; };
struct Gemm { const bf16_t* A; const bf16_t* Bt; int K; size_t b_estride; };

struct PatchOrder {
    int nM, nN, PM, PN, x, j, ok;
    __device__ __forceinline__ void init(int nM_, int nN_, int PN_, int G, int c) { nM = nM_; nN = nN_; PN = PN_; PM = (G / 8) / PN_; x = c & 7; j = c >> 3; ok = ((G & 7) == 0) && (PM * PN == G / 8) && (nN % PN == 0); if (!ok) { x = c; j = G; } }
    __device__ __forceinline__ bool next(int i, Unit& u) const {
        if (!ok) { const long L = (long)i * j + x; if (L >= (long)nM * nN) return false; u.pm = (int)(L / nN); u.pn = (int)(L % nN); u.e = 0; u.mi = u.pm; u.ui = i; return true; }
        const int p = 8 * i + x, npn = nN / PN, pmb = p / npn, pnb = p % npn;
        u.pm = pmb * PM + (j % PM); u.pn = pnb * PN + (j / PM); u.e = 0; u.mi = u.pm; u.ui = i;
        return u.pm < nM;
    }
};

__device__ __forceinline__ unsigned cvt_pk_bf16(float lo, float hi) { unsigned r; asm volatile("v_cvt_pk_bf16_f32 %0, %1, %2" : "=v"(r) : "v"(lo), "v"(hi)); return r; }

template <class Epi, class Sched, bool GATHER>
__device__ __forceinline__ void gemm_phase(LAS unsigned char* lds, const Gemm g, const Sched& S, const Epi& E, const LAS int* gidx) {
    const int tid = threadIdx.x, wid = __builtin_amdgcn_readfirstlane(tid >> 6), lane = tid & 63, wr = wid >> 2, wc = wid & 3, fr = lane & 15, fq = lane >> 4;
    const int K = g.K, nt = K / BK;
    int Ra[2], Ca[2]; unsigned voffB[2];
#pragma unroll
    for (int i = 0; i < 2; ++i) { int R, C; stage_rc(tid * 16 + i * 8192, R, C); const int Rb = Epi::PERM ? ((R & ~31) + perm32(R & 31)) : R;
        Ra[i] = R; Ca[i] = C; voffB[i] = (unsigned)(Rb * K + C) * 2u; }
    const size_t kstep = (size_t)(BK * 2);
    const size_t hstep = (size_t)HALF * K * 2;
    const size_t tstep = 2 * hstep;
    const unsigned ldsw = (unsigned)wid * 1024u;
    const int aoff = lds_byte(wr * 64 + fr, fq * 8), boff = lds_byte(wc * 32 + fr, fq * 8);
#define PG8_SA(b, h) (((b) * 2 + (h)) * HTB)
#define PG8_SB(b, h) ((4 + (b) * 2 + (h)) * HTB)
#define PG8_STAGE(bufoff, gbase, voff) do { _Pragma("unroll") for (int _i = 0; _i < 2; ++_i) \
        __builtin_amdgcn_global_load_lds((const unsigned*)((const char*)(gbase) + (voff)[_i]), (LAS unsigned*)(lds + (bufoff) + ldsw + _i * 8192), 16, 0, 0); } while (0)
#define PG8_LDA(dst, b, h) do { _Pragma("unroll") for (int m = 0; m < 4; ++m) _Pragma("unroll") for (int k = 0; k < 2; ++k) dst[m][k] = *(const LAS bf16x8*)(lds + PG8_SA(b, h) + aoff + m * 2048 + k * 1024); } while (0)
#define PG8_LDB(dst, b, h) do { _Pragma("unroll") for (int n = 0; n < 2; ++n) _Pragma("unroll") for (int k = 0; k < 2; ++k) dst[n][k] = *(const LAS bf16x8*)(lds + PG8_SB(b, h) + boff + n * 2048 + k * 1024); } while (0)
#define PG8_MMA(ai, bj, At, Bt) do { __builtin_amdgcn_s_setprio(1); _Pragma("unroll") for (int m = 0; m < 4; ++m) _Pragma("unroll") for (int n = 0; n < 2; ++n) _Pragma("unroll") for (int k = 0; k < 2; ++k) \
        acc[ai][bj][m][n] = __builtin_amdgcn_mfma_f32_16x16x32_bf16(Bt[n][k], At[m][k], acc[ai][bj][m][n], 0, 0, 0); __builtin_amdgcn_s_setprio(0); } while (0)
#define PG8_WAIT_V(n) asm volatile("s_waitcnt vmcnt(" #n ")" ::: "memory")
#define PG8_WAIT_L(n) asm volatile("s_waitcnt lgkmcnt(" #n ")" ::: "memory")
#define PG8_BAR __builtin_amdgcn_s_barrier()
#define PG8_SCHED __builtin_amdgcn_sched_barrier(0)
#define PG8_VOA(dst, u) do { _Pragma("unroll") for (int _h = 0; _h < 2; ++_h) _Pragma("unroll") for (int _i = 0; _i < 2; ++_i) { \
        const int _row = GATHER ? gidx[(u).ui * 256 + _h * HALF + Ra[_i]] : (_h * HALF + Ra[_i]); dst[_h][_i] = (unsigned)(_row * K + Ca[_i]) * 2u; } } while (0)
    Unit cur, nxt; int ui = 0;
    if (!S.next(0, cur)) return;
    f32x4 acc[2][2][4][2];
#pragma unroll
    for (int a = 0; a < 2; ++a)
#pragma unroll
        for (int b = 0; b < 2; ++b)
#pragma unroll
            for (int m = 0; m < 4; ++m)
#pragma unroll
                for (int n = 0; n < 2; ++n) acc[a][b][m][n] = (f32x4){0.f, 0.f, 0.f, 0.f};
    bf16x8 At[4][2], B0[2][2], B1[2][2];
    unsigned voA[2][2], voN[2][2];
    PG8_VOA(voA, cur);
    const char* cA = (const char*)g.A + (GATHER ? (size_t)0 : (size_t)cur.pm * tstep);
    const char* cB = (const char*)g.Bt + ((size_t)cur.e * g.b_estride) * 2 + (size_t)cur.pn * tstep;
    PG8_STAGE(PG8_SB(0, 0), cB, voffB); PG8_STAGE(PG8_SB(0, 1), cB + hstep, voffB); PG8_STAGE(PG8_SA(0, 0), cA, voA[0]); PG8_STAGE(PG8_SA(0, 1), cA, voA[1]);
    if (wr == 1) PG8_BAR;
    PG8_WAIT_V(2); PG8_BAR;
    PG8_STAGE(PG8_SB(1, 0), cB + kstep, voffB); PG8_STAGE(PG8_SA(1, 0), cA + kstep, voA[0]); PG8_STAGE(PG8_SB(1, 1), cB + hstep + kstep, voffB);
    PG8_WAIT_V(6); PG8_BAR;
    for (;;) {
        const bool has_next = S.next(ui + 1, nxt);
        const char* nA = cA; const char* nB = cB;
#pragma unroll
        for (int h = 0; h < 2; ++h)
#pragma unroll
            for (int i = 0; i < 2; ++i) voN[h][i] = voA[h][i];
        if (has_next) { nA = (const char*)g.A + (GATHER ? (size_t)0 : (size_t)nxt.pm * tstep); nB = (const char*)g.Bt + ((size_t)nxt.e * g.b_estride) * 2 + (size_t)nxt.pn * tstep; PG8_VOA(voN, nxt); }
        for (int t = 0; t < nt; t += 2) {
            const bool last = (t == nt - 2);
            const char* a1 = cA + (size_t)(t + 1) * kstep;
            const char* a2 = last ? nA : cA + (size_t)(t + 2) * kstep; const char* b2 = last ? nB : cB + (size_t)(t + 2) * kstep;
            const char* a3 = a2 + kstep; const char* b3 = b2 + kstep;
            unsigned vo2[2][2];
#pragma unroll
            for (int h = 0; h < 2; ++h)
#pragma unroll
                for (int i = 0; i < 2; ++i) vo2[h][i] = last ? voN[h][i] : voA[h][i];
            PG8_LDB(B0, 0, 0); PG8_LDB(B1, 0, 1); PG8_SCHED; PG8_LDA(At, 0, 0); PG8_STAGE(PG8_SA(1, 1), a1, voA[1]);
            PG8_WAIT_V(8); PG8_WAIT_L(0); PG8_BAR; PG8_MMA(0, 0, At, B0); PG8_MMA(0, 1, At, B1); PG8_BAR; PG8_SCHED;
            PG8_LDA(At, 0, 1); PG8_STAGE(PG8_SB(0, 0), b2, voffB); PG8_STAGE(PG8_SB(0, 1), b2 + hstep, voffB); PG8_STAGE(PG8_SA(0, 0), a2, vo2[0]);
            PG8_WAIT_V(8); PG8_WAIT_L(0); PG8_BAR; PG8_MMA(1, 0, At, B0); PG8_MMA(1, 1, At, B1); PG8_BAR; PG8_SCHED;
            PG8_LDB(B0, 1, 0); PG8_LDB(B1, 1, 1); PG8_SCHED; PG8_LDA(At, 1, 0); PG8_STAGE(PG8_SA(0, 1), a2, vo2[1]);
            PG8_WAIT_V(8); PG8_WAIT_L(0); PG8_BAR; PG8_MMA(0, 0, At, B0); PG8_MMA(0, 1, At, B1); PG8_BAR; PG8_SCHED;
            PG8_LDA(At, 1, 1); PG8_STAGE(PG8_SB(1, 0), b3, voffB); PG8_STAGE(PG8_SB(1, 1), b3 + hstep, voffB); PG8_STAGE(PG8_SA(1, 0), a3, vo2[0]);
            PG8_WAIT_V(8); PG8_WAIT_L(0); PG8_BAR; PG8_MMA(1, 0, At, B0); PG8_MMA(1, 1, At, B1); PG8_BAR; PG8_SCHED;
        }
        if (wr == 0) PG8_BAR;
        E(acc, cur, wr, wc, fr, fq);
        if (!has_next) break;
#pragma unroll
        for (int a = 0; a < 2; ++a)
#pragma unroll
            for (int b = 0; b < 2; ++b)
#pragma unroll
                for (int m = 0; m < 4; ++m)
#pragma unroll
                    for (int n = 0; n < 2; ++n) acc[a][b][m][n] = (f32x4){0.f, 0.f, 0.f, 0.f};
        cur = nxt; cA = nA; cB = nB; ++ui;
#pragma unroll
        for (int h = 0; h < 2; ++h)
#pragma unroll
            for (int i = 0; i < 2; ++i) voA[h][i] = voN[h][i];
        if (wr == 1) PG8_BAR;
    }
    PG8_WAIT_V(0);
    PG8_BAR;
#undef PG8_SA
#undef PG8_SB
#undef PG8_STAGE
#undef PG8_LDA
#undef PG8_LDB
#undef PG8_MMA
#undef PG8_WAIT_V
#undef PG8_WAIT_L
#undef PG8_BAR
#undef PG8_SCHED
#undef PG8_VOA
}

typedef const f32x4 (&AccRef)[2][2][4][2];
#define EPI_ROWS for (int ai = 0; ai < 2; ++ai) _Pragma("unroll") for (int m = 0; m < 4; ++m)

struct EpiInProj {
    static constexpr bool PERM = true;
    const float* rstd; bf16_t *Q, *Kb, *V, *U, *SGA, *SGB;
    __device__ __forceinline__ void operator()(AccRef acc, const Unit& u, int wr, int wc, int fr, int fq) const {
        bf16_t* dst; int ld, colt; bool sig = false; float sc = 1.f;
        if (u.pn < 2) { dst = Q; ld = AW; colt = u.pn * 256; sc = QSCALE; }
        else if (u.pn < 4) { dst = Kb; ld = AW; colt = (u.pn - 2) * 256; }
        else if (u.pn < 6) { dst = V; ld = AW; colt = (u.pn - 4) * 256; }
        else if (u.pn < 8) { dst = U; ld = AW; colt = (u.pn - 6) * 256; }
        else if (u.pn < 12) { dst = SGA; ld = DM; colt = (u.pn - 8) * 256; sig = true; }
        else { dst = SGB; ld = DM; colt = (u.pn - 12) * 256; sig = true; }
        const int row0 = u.pm * BM + wr * 64 + fr, col0 = colt + wc * 32 + 8 * fq;
#pragma unroll
        EPI_ROWS { const int row = row0 + ai * HALF + m * 16; const float rs = rstd[row] * sc; bf16_t* rowp = dst + (size_t)row * ld + col0;
#pragma unroll
            for (int bj = 0; bj < 2; ++bj) { f32x4 v0 = acc[ai][bj][m][0] * rs, v1 = acc[ai][bj][m][1] * rs;
                if (sig) {
#pragma unroll
                    for (int e = 0; e < 4; ++e) { v0[e] = fsigmoid(v0[e]); v1[e] = fsigmoid(v1[e]); } }
                u32x4 w; w.x = cvt_pk_bf16(v0[0], v0[1]); w.y = cvt_pk_bf16(v0[2], v0[3]); w.z = cvt_pk_bf16(v1[0], v1[1]); w.w = cvt_pk_bf16(v1[2], v1[3]);
                *(u32x4*)(rowp + bj * HALF) = w; } }
    }
};
struct EpiStore {
    static constexpr bool PERM = true;
    bf16_t* O; int ld;
    __device__ __forceinline__ void operator()(AccRef acc, const Unit& u, int wr, int wc, int fr, int fq) const {
        const int row0 = u.pm * BM + wr * 64 + fr, col0 = u.pn * BM + wc * 32 + 8 * fq;
#pragma unroll
        EPI_ROWS { bf16_t* rowp = O + (size_t)(row0 + ai * HALF + m * 16) * ld + col0;
#pragma unroll
            for (int bj = 0; bj < 2; ++bj) { const f32x4 v0 = acc[ai][bj][m][0], v1 = acc[ai][bj][m][1];
                u32x4 w; w.x = cvt_pk_bf16(v0[0], v0[1]); w.y = cvt_pk_bf16(v0[2], v0[3]); w.z = cvt_pk_bf16(v1[0], v1[1]); w.w = cvt_pk_bf16(v1[2], v1[3]);
                *(u32x4*)(rowp + bj * HALF) = w; } }
    }
};
struct EpiGlu {
    static constexpr bool PERM = true;
    const bf16_t* SGB; bf16_t* O;
    __device__ __forceinline__ void operator()(AccRef acc, const Unit& u, int wr, int wc, int fr, int fq) const {
        const int row0 = u.pm * BM + wr * 64 + fr, col0 = u.pn * HALF + wc * 32 + 8 * fq;
#pragma unroll
        EPI_ROWS { const size_t off = (size_t)(row0 + ai * HALF + m * 16) * DM + col0; const u32x4 s = *(const u32x4*)(SGB + off);
            const f32x4 v0 = acc[ai][0][m][0], v1 = acc[ai][0][m][1], g0 = acc[ai][1][m][0], g1 = acc[ai][1][m][1];
            float o[8];
#pragma unroll
            for (int e = 0; e < 4; ++e) { o[e] = v0[e] * fsigmoid(g0[e]); o[4 + e] = v1[e] * fsigmoid(g1[e]); }
            o[0] *= bflo(s.x); o[1] *= bfhi(s.x); o[2] *= bflo(s.y); o[3] *= bfhi(s.y); o[4] *= bflo(s.z); o[5] *= bfhi(s.z); o[6] *= bflo(s.w); o[7] *= bfhi(s.w);
            u32x4 w; w.x = cvt_pk_bf16(o[0], o[1]); w.y = cvt_pk_bf16(o[2], o[3]); w.z = cvt_pk_bf16(o[4], o[5]); w.w = cvt_pk_bf16(o[6], o[7]);
            *(u32x4*)(O + off) = w; }
    }
};
struct EpiMerge {
    static constexpr bool PERM = true;
    const bf16_t* SGA; const bf16_t* Y2; bf16_t* O;
    __device__ __forceinline__ void operator()(AccRef acc, const Unit& u, int wr, int wc, int fr, int fq) const {
        const int row0 = u.pm * BM + wr * 64 + fr, col0 = u.pn * BM + wc * 32 + 8 * fq;
#pragma unroll
        EPI_ROWS {
#pragma unroll
            for (int bj = 0; bj < 2; ++bj) { const size_t off = (size_t)(row0 + ai * HALF + m * 16) * DM + col0 + bj * HALF;
                const u32x4 s = *(const u32x4*)(SGA + off), y = *(const u32x4*)(Y2 + off); const f32x4 v0 = acc[ai][bj][m][0], v1 = acc[ai][bj][m][1];
                u32x4 w; w.x = cvt_pk_bf16(bflo(s.x) * v0[0] + bflo(y.x), bfhi(s.x) * v0[1] + bfhi(y.x)); w.y = cvt_pk_bf16(bflo(s.y) * v0[2] + bflo(y.y), bfhi(s.y) * v0[3] + bfhi(y.y));
                w.z = cvt_pk_bf16(bflo(s.z) * v1[0] + bflo(y.z), bfhi(s.z) * v1[1] + bfhi(y.z)); w.w = cvt_pk_bf16(bflo(s.w) * v1[2] + bflo(y.w), bfhi(s.w) * v1[3] + bfhi(y.w));
                *(u32x4*)(O + off) = w; } }
    }
};
struct EpiResid {
    static constexpr bool PERM = false;
    const float* base; float* H; bf16_t* HB; float* SSQ;
    __device__ __forceinline__ void operator()(AccRef acc, const Unit& u, int wr, int wc, int fr, int fq) const {
        const int row0 = u.pm * BM + wr * 64 + fr, col0 = u.pn * BM + wc * 32 + 4 * fq;
#pragma unroll
        EPI_ROWS { const int row = row0 + ai * HALF + m * 16; const size_t off = (size_t)row * DM + col0; float ss = 0.f;
#pragma unroll
            for (int bj = 0; bj < 2; ++bj)
#pragma unroll
                for (int n = 0; n < 2; ++n) { const size_t o2 = off + bj * HALF + n * 16; const f32x4 h = *(const f32x4*)(base + o2) + acc[ai][bj][m][n];
                    *(f32x4*)(H + o2) = h; u32x2 w; w.x = cvt_pk_bf16(h[0], h[1]); w.y = cvt_pk_bf16(h[2], h[3]); *(u32x2*)(HB + o2) = w;
                    ss += (h[0] * h[0] + h[1] * h[1]) + (h[2] * h[2] + h[3] * h[3]); }
            ss += __shfl_xor(ss, 16); ss += __shfl_xor(ss, 32);
            if (fq == 0) SSQ[(size_t)row * 16 + u.pn * 4 + wc] = ss; }
    }
};
struct EpiXq {
    static constexpr bool PERM = true;
    const float* SSQ; bf16_t* O;
    __device__ __forceinline__ void operator()(AccRef acc, const Unit& u, int wr, int wc, int fr, int fq) const {
        const int row0 = u.pm * BM + wr * 64 + fr, col0 = u.pn * BM + wc * 32 + 8 * fq;
#pragma unroll
        EPI_ROWS { const int row = row0 + ai * HALF + m * 16; const f32x4* sp = (const f32x4*)(SSQ + (size_t)row * 16);
            const f32x4 a = sp[0] + sp[1] + sp[2] + sp[3]; const float rs = __builtin_amdgcn_rsqf(((a[0] + a[1]) + (a[2] + a[3])) * (1.0f / DM) + RMS_EPS) * XSCALE;
            bf16_t* rowp = O + (size_t)row * XW + col0;
#pragma unroll
            for (int bj = 0; bj < 2; ++bj) { const f32x4 v0 = acc[ai][bj][m][0] * rs, v1 = acc[ai][bj][m][1] * rs;
                u32x4 w; w.x = cvt_pk_bf16(v0[0], v0[1]); w.y = cvt_pk_bf16(v0[2], v0[3]); w.z = cvt_pk_bf16(v1[0], v1[1]); w.w = cvt_pk_bf16(v1[2], v1[3]);
                *(u32x4*)(rowp + bj * HALF) = w; } }
    }
};
struct EpiMoe1 {
    static constexpr bool PERM = true;
    const float* rstd2; const float* bgu; bf16_t* HID; const LAS int* gidx;
    __device__ __forceinline__ void operator()(AccRef acc, const Unit& u, int wr, int wc, int fr, int fq) const {
        const int rl0 = wr * 64 + fr, col0 = u.pn * HALF + wc * 32 + 8 * fq; const float* bg = bgu + (size_t)u.e * (2 * DFF) + col0;
        const f32x4 bg0 = *(const f32x4*)(bg), bg1 = *(const f32x4*)(bg + 4), bu0 = *(const f32x4*)(bg + DFF), bu1 = *(const f32x4*)(bg + DFF + 4);
#pragma unroll
        EPI_ROWS { const int rl = rl0 + ai * HALF + m * 16; const float rs = rstd2[gidx[u.ui * 256 + rl]];
            const f32x4 g0 = acc[ai][0][m][0] * rs + bg0, g1 = acc[ai][0][m][1] * rs + bg1, p0 = acc[ai][1][m][0] * rs + bu0, p1 = acc[ai][1][m][1] * rs + bu1;
            float o[8];
#pragma unroll
            for (int e = 0; e < 4; ++e) { const float ga = fminf(g0[e], 7.0f), gb = fminf(g1[e], 7.0f), ua = fminf(fmaxf(p0[e], -7.0f), 7.0f), ub = fminf(fmaxf(p1[e], -7.0f), 7.0f);
                o[e] = (ua + 1.0f) * ga * fsigmoid(1.702f * ga); o[4 + e] = (ub + 1.0f) * gb * fsigmoid(1.702f * gb); }
            u32x4 w; w.x = cvt_pk_bf16(o[0], o[1]); w.y = cvt_pk_bf16(o[2], o[3]); w.z = cvt_pk_bf16(o[4], o[5]); w.w = cvt_pk_bf16(o[6], o[7]);
            *(u32x4*)(HID + (size_t)(u.pm * BM + rl) * DFF + col0) = w; }
    }
};
struct EpiMoe2 {
    static constexpr bool PERM = true;
    const float* bdn; const float* tkg; const int* rowlist; const unsigned* cnt; bf16_t* Y;
    __device__ __forceinline__ void operator()(AccRef acc, const Unit& u, int wr, int wc, int fr, int fq) const {
        const int rl0 = wr * 64 + fr, col0 = u.pn * BM + wc * 32 + 8 * fq; const float* bd = bdn + (size_t)u.e * DM + col0; const int ce = (int)cnt[u.e];
        f32x4 bv[2][2];
#pragma unroll
        for (int bj = 0; bj < 2; ++bj)
#pragma unroll
            for (int n = 0; n < 2; ++n) bv[bj][n] = *(const f32x4*)(bd + bj * HALF + 4 * n);
#pragma unroll
        EPI_ROWS { const int rank = u.mi * BM + rl0 + ai * HALF + m * 16;
            if (rank < ce) { const int dest = rowlist[(size_t)u.e * T_ + rank]; const float gt = tkg[dest]; bf16_t* rowp = Y + (size_t)dest * DM + col0;
#pragma unroll
                for (int bj = 0; bj < 2; ++bj) { const f32x4 v0 = (acc[ai][bj][m][0] + bv[bj][0]) * gt, v1 = (acc[ai][bj][m][1] + bv[bj][1]) * gt;
                    u32x4 w; w.x = cvt_pk_bf16(v0[0], v0[1]); w.y = cvt_pk_bf16(v0[2], v0[3]); w.z = cvt_pk_bf16(v1[0], v1[1]); w.w = cvt_pk_bf16(v1[2], v1[3]);
                    *(u32x4*)(rowp + bj * HALF) = w; } } }
    }
};
}

struct MoeOrder {
    pg8::PatchOrder P; const LAS int* pref;
    __device__ __forceinline__ bool next(int i, pg8::Unit& u) const {
        if (!P.next(i, u)) return false;
        int e = 0;
#pragma unroll 1
        for (int k = 1; k < NE; ++k) e += (pref[k] <= u.pm) ? 1 : 0;
        u.e = e; u.mi = u.pm - pref[e]; return true;
    }
};

namespace attn_body {
using bf16=__hip_bfloat16;
using bf16x8=__attribute__((ext_vector_type(8)))short;
using s16x4=__attribute__((ext_vector_type(4)))short;
using f32x16=__attribute__((ext_vector_type(16)))float;
using u32x4=__attribute__((ext_vector_type(4)))unsigned;
constexpr int BATCH=4,NHEAD=8,SEQ=8192,D=64,DM=NHEAD*D;
constexpr int NW=8,QBLK=32,QB=QBLK*NW,KVBLK=64,NQB=SEQ/QB;
constexpr int ATTN_PITCH=DM, ATTN_UNIT_ROWS=QB;
__device__ __forceinline__ int crow(int r,int hi){return (r&3)+8*(r>>2)+4*hi;}
#define SBAR() __builtin_amdgcn_sched_barrier(0)
__device__ __forceinline__ void cmask(f32x16&p0,f32x16&p1,int jb,int qrel,int hi){
  const float NEG=-INFINITY; int kb=64*jb+4*hi;
  #pragma unroll
  for(int r=0;r<16;++r){int kv=kb+(r&3)+8*(r>>2); if(kv>qrel)p0[r]=NEG; if(kv+32>qrel)p1[r]=NEG;}
}

constexpr int NSLOT=3, SLOTB=8192;
constexpr int LDS_K=0, LDS_V=NSLOT*SLOTB, LDS_WS=2*NSLOT*SLOTB, LDS_OST=LDS_WS+NW*64*4, LDS_KM=LDS_OST+NW*4096, LDS_SEL=LDS_KM+32*64*4, LDS_BYTES=LDS_SEL+1024;
constexpr float C2=0.125f*1.4426950408889634f;
__device__ __forceinline__ void glds16(const void*gsrc,unsigned lds_dst){unsigned keep;
  asm volatile("s_mov_b32 %0, m0\n\ts_mov_b32 m0, %2\n\ts_nop 0\n\tglobal_load_lds_dwordx4 %1, off\n\ts_mov_b32 m0, %0":"=&s"(keep):"v"(gsrc),"s"(lds_dst):"memory");}
__device__ __forceinline__ float max3f(float a,float b,float c){float r;asm("v_max3_f32 %0, %1, %2, %3":"=v"(r):"v"(a),"v"(b),"v"(c));return r;}
__device__ __forceinline__ float max2f(float a,float b){float r;asm("v_max_f32_e32 %0, %1, %2":"=v"(r):"v"(a),"v"(b));return r;}
__device__ __forceinline__ float fadd_s(float a,float b){float r;asm("v_add_f32_e32 %0, %1, %2":"=v"(r):"v"(a),"v"(b));return r;}
__device__ __forceinline__ float fsub_s(float a,float b){float r;asm("v_sub_f32_e32 %0, %1, %2":"=v"(r):"v"(a),"v"(b));return r;}
typedef float f32x2_t __attribute__((ext_vector_type(2))); typedef __bf16 bf16x2_t __attribute__((ext_vector_type(2)));
__device__ __forceinline__ unsigned cvtpk_s(float lo,float hi){f32x2_t v={lo,hi};bf16x2_t b=__builtin_convertvector(v,bf16x2_t);return __builtin_bit_cast(unsigned,b);}
#define WAIT_BAR(N) asm volatile("s_waitcnt vmcnt(" #N ") lgkmcnt(0)\n\ts_barrier":::"memory")

__device__ __forceinline__ void qkt(f32x16&p0,f32x16&p1,const char*Kslot,const bf16x8*qr,const f32x16&negm,int r32,int hi){
  const char*kb=Kslot+hi*1024+r32*16;
  #pragma unroll
  for(int d0=0;d0<4;++d0){
    const bf16x8 b0=*reinterpret_cast<const bf16x8*>(kb+d0*2048);
    const bf16x8 b1=*reinterpret_cast<const bf16x8*>(kb+d0*2048+512);
    if(d0==0){p0=__builtin_amdgcn_mfma_f32_32x32x16_bf16(b0,qr[0],negm,0,0,0);p1=__builtin_amdgcn_mfma_f32_32x32x16_bf16(b1,qr[0],negm,0,0,0);}
    else{p0=__builtin_amdgcn_mfma_f32_32x32x16_bf16(b0,qr[d0],p0,0,0,0);p1=__builtin_amdgcn_mfma_f32_32x32x16_bf16(b1,qr[d0],p1,0,0,0);}}
}
typedef __attribute__((address_space(3))) const char* lds_cptr;
typedef short v4i16_t __attribute__((ext_vector_type(4)));
__device__ __forceinline__ void kload8(bf16x8*kf,lds_cptr kp){
  kf[0]=*(const __attribute__((address_space(3))) bf16x8*)(kp);      kf[1]=*(const __attribute__((address_space(3))) bf16x8*)(kp+512);
  kf[2]=*(const __attribute__((address_space(3))) bf16x8*)(kp+2048); kf[3]=*(const __attribute__((address_space(3))) bf16x8*)(kp+2560);
  kf[4]=*(const __attribute__((address_space(3))) bf16x8*)(kp+4096); kf[5]=*(const __attribute__((address_space(3))) bf16x8*)(kp+4608);
  kf[6]=*(const __attribute__((address_space(3))) bf16x8*)(kp+6144); kf[7]=*(const __attribute__((address_space(3))) bf16x8*)(kp+6656);
}
__device__ __forceinline__ void kload2(bf16x8*kf,lds_cptr kp,int j){ kf[2*j]=*(const __attribute__((address_space(3))) bf16x8*)(kp+j*2048); kf[2*j+1]=*(const __attribute__((address_space(3))) bf16x8*)(kp+j*2048+512); }
__device__ __forceinline__ s16x4 vtr(lds_cptr p){ return __builtin_bit_cast(s16x4,__builtin_amdgcn_ds_read_tr16_b64_v4i16((__attribute__((address_space(3))) v4i16_t*)p)); }
__device__ __forceinline__ float rowmax(const f32x16&p0,const f32x16&p1){
  float a=max3f(p0[0],p0[1],p1[0]),b=max3f(p0[2],p0[3],p1[1]);a=max3f(a,p1[2],p1[3]);
  #pragma unroll
  for(int r=4;r<16;r+=4){a=max3f(a,p0[r],p0[r+1]);b=max3f(b,p0[r+2],p0[r+3]);a=max3f(a,p1[r],p1[r+1]);b=max3f(b,p1[r+2],p1[r+3]);}
  const float m=max2f(a,b);
  auto rr=__builtin_amdgcn_permlane32_swap(__float_as_uint(m),__float_as_uint(m),false,false);
  return max2f(__uint_as_float(rr[0]),__uint_as_float(rr[1]));
}
__device__ __forceinline__ void pv(f32x16*o,int vb,bf16x8 pa0,bf16x8 pa1,bf16x8 pa2,bf16x8 pa3){
  #pragma unroll
  for(int d0=0;d0<2;++d0){s16x4 lo[4],hi[4];
    #pragma unroll
    for(int ks=0;ks<4;++ks){
      asm volatile("ds_read_b64_tr_b16 %0,%1 offset:%c2":"=&v"(lo[ks]):"v"(vb),"i"(d0*4096+ks*1024):"memory");
      asm volatile("ds_read_b64_tr_b16 %0,%1 offset:%c2":"=&v"(hi[ks]):"v"(vb),"i"(d0*4096+ks*1024+512):"memory");}
    asm volatile("s_waitcnt lgkmcnt(0)":::"memory");SBAR();
    #define PK(k) (bf16x8){lo[k][0],lo[k][1],lo[k][2],lo[k][3],hi[k][0],hi[k][1],hi[k][2],hi[k][3]}
    o[d0]=__builtin_amdgcn_mfma_f32_32x32x16_bf16(pa0,PK(0),o[d0],0,0,0);
    o[d0]=__builtin_amdgcn_mfma_f32_32x32x16_bf16(pa1,PK(1),o[d0],0,0,0);
    o[d0]=__builtin_amdgcn_mfma_f32_32x32x16_bf16(pa2,PK(2),o[d0],0,0,0);
    o[d0]=__builtin_amdgcn_mfma_f32_32x32x16_bf16(pa3,PK(3),o[d0],0,0,0);
    #undef PK
  }
}

#ifndef ATTN_STORE16
#define ATTN_STORE16(p,v) (*(u32x4*)(p)=(v))
#endif
template<int THRL> __device__ __forceinline__ void attn_unit(int b,int h,int qb,const bf16*Q,const bf16*__restrict__ K,const bf16*__restrict__ V,bf16*O,char*shm){
  const int tid=threadIdx.x,lane=tid&63,r32=lane&31,hi=lane>>5; const int wid=__builtin_amdgcn_readfirstlane(tid>>6);
  const long rowbase=(long)b*SEQ; const int q0=qb*QB;
  const bf16*Qw=Q+(rowbase+q0+wid*QBLK)*DM+h*D;
  const bf16*Kh=K+rowbase*DM+h*D,*Vh=V+rowbase*DM+h*D;
  const unsigned lds0=(unsigned)(uintptr_t)shm;
  float*wsf=(float*)(shm+LDS_WS)+wid*64;
  const bf16*ksrc=Kh+(long)lane*DM+wid*8;
  const bf16*vsrc=Vh+(long)(16*(wid&3)+(lane>>2))*DM+(wid>>2)*32+(lane&3)*8;
  const unsigned kdst=lds0+LDS_K+wid*1024, vdst=lds0+LDS_V+wid*1024;
  #define DMA_K(t,slot) glds16(ksrc+(long)(t)*KVBLK*DM,(unsigned)__builtin_amdgcn_readfirstlane(kdst+(slot)))
  #define DMA_V(t,slot) glds16(vsrc+(long)(t)*KVBLK*DM,(unsigned)__builtin_amdgcn_readfirstlane(vdst+(slot)))
  const int vb0=(int)(lds0+LDS_V)+((lane>>4)&1)*32+(lane&3)*8+(4*hi+((lane&15)>>2))*64;
  const char*Kbase=shm+LDS_K; bf16x8 kf[8];
  const lds_cptr shm3=(lds_cptr)shm; const lds_cptr kp0=shm3+LDS_K+hi*1024+r32*16; const lds_cptr vp0=shm3+LDS_V+((lane>>4)&1)*32+(lane&3)*8+(4*hi+((lane&15)>>2))*64;
  const int NT=(q0+QB)/KVBLK;
  DMA_K(0,0);DMA_V(0,0);DMA_K(1,SLOTB);
  bf16x8 qr[4];
  #pragma unroll
  for(int d0=0;d0<4;++d0)qr[d0]=*reinterpret_cast<const bf16x8*>(&Qw[(long)r32*DM+d0*16+hi*8]);
  { int lp_=lane; asm volatile("":"+v"(lp_)); const int r32p=lp_&31, hip=lp_>>5;
    unsigned sel=0u; const __attribute__((address_space(3))) float*km=(const __attribute__((address_space(3))) float*)((__attribute__((address_space(3))) const char*)shm+LDS_KM); float g0=-3e38f,g1=-3e38f,g2=-3e38f; int s0=-1,s1=-1,s2=-1;
    for(int j=0;j<qb;++j){ float g=0.f;
      #pragma unroll
      for(int d0=0;d0<4;++d0){
        #pragma unroll
        for(int e=0;e<8;++e)g+=__builtin_bit_cast(float,((unsigned)(unsigned short)qr[d0][e])<<16)*km[j*64+16*d0+8*hip+e];}
      g+=__shfl_xor(g,32);
      if(g>g0){g2=g1;s2=s1;g1=g0;s1=s0;g0=g;s0=j;}else if(g>g1){g2=g1;s2=s1;g1=g;s1=j;}else if(g>g2){g2=g;s2=j;} }
    if(s0>=0)sel|=1u<<s0; if(s1>=0)sel|=1u<<s1; if(s2>=0)sel|=1u<<s2;
    if(hip==0)((__attribute__((address_space(3))) unsigned*)((__attribute__((address_space(3))) char*)shm+LDS_SEL))[wid*32+r32p]=sel; asm volatile("s_waitcnt lgkmcnt(0)":::"memory"); }
  float mhat=0.f,l_reg=0.f;f32x16 o[2];o[0]=f32x16{};o[1]=f32x16{};f32x16 negm=f32x16{};asm volatile("":"+v"(negm));
  const int qrel=wid*QBLK+r32;
  #define BMASK(P0,P1,t) do{}while(0)
  #define CMASK(P0,P1,t) do{int jb_=(t)-(NT-4); if(jb_>=0)cmask(P0,P1,jb_,qrel,hi); else BMASK(P0,P1,t);}while(0)
  bool resc=false;
  #define START(P0,P1) do{ const float rm=rowmax(P0,P1); resc=false; \
    { const float dl=__builtin_fmaxf(rm,-64.f); mhat=fadd_s(mhat,dl); \
      _Pragma("unroll") for(int r=0;r<16;++r){P0[r]=fsub_s(P0[r],dl);P1[r]=fsub_s(P1[r],dl);} \
      _Pragma("unroll") for(int r=0;r<16;++r)negm[r]=-mhat; asm volatile("":"+v"(negm)); } \
    _Pragma("unroll") for(int r=0;r<16;++r)P0[r]=__builtin_amdgcn_exp2f(P0[r]); }while(0)
  #define RESC() do{ if(resc){ asm volatile("s_waitcnt lgkmcnt(0)":::"memory"); \
      _Pragma("unroll") for(int d_=0;d_<2;++d_) _Pragma("unroll") for(int r=0;r<16;++r)o[d_][r]*=wsf[crow(r,hi)]; } }while(0)
  f32x16 pA0,pA1,pB0,pB1;
  int sl_prev=0,sl_cur=0,sl_next=SLOTB;
  #define ROT() do{sl_prev=sl_cur;sl_cur=sl_next;sl_next=(sl_next==(NSLOT-1)*SLOTB)?0:sl_next+SLOTB;}while(0)
  DMA_K(2,2*SLOTB);
  WAIT_BAR(3);
  qkt(pA0,pA1,Kbase,qr,negm,r32,hi);asm volatile("s_nop 15\n\ts_nop 7":"+v"(pA0),"+v"(pA1));CMASK(pA0,pA1,0);
  START(pA0,pA1);
  _Pragma("unroll") for(int r=0;r<16;++r)pA1[r]=__builtin_amdgcn_exp2f(pA1[r]);
  WAIT_BAR(0);
  DMA_K(3,0);DMA_V(1,SLOTB);
  ROT();
  kload8(kf,kp0+sl_cur);
  WAIT_BAR(2);
  s16x4 vlo[8],vhi[8]; u32x4 pw0,pw1,pw2,pw3;
  #define PKW(P,B) (keep_?cvtpk_s(P[B],P[B+1]):0u)
  #define PAF(k) __builtin_bit_cast(bf16x8,pw##k)
  #define VFR(i) (bf16x8){vlo[i][0],vlo[i][1],vlo[i][2],vlo[i][3],vhi[i][0],vhi[i][1],vhi[i][2],vhi[i][3]}
  #define PIN(x) asm volatile("":"+v"(x))
  #define MX3(a,b,c) __builtin_fmaxf(__builtin_fmaxf((a),(b)),(c))
  #define GAPA(MF,A0,A1,A2,A3,W0,W1,PW) do{ MF; sacc+=A0; sacc+=A1; sacc+=A2; sacc+=A3; PIN(sacc); W0; W1; PIN(PW); SBAR(); }while(0)
  #define EX(v) __builtin_amdgcn_exp2f(v)
  #define GAPB(MF,X,B) do{ MF; X[B]=EX(X[B]); X[B+1]=EX(X[B+1]); X[B+2]=EX(X[B+2]); X[B+3]=EX(X[B+3]); PIN(X); SBAR(); }while(0)
  #define VRD(i) do{ vlo[i]=vtr(vp_+(((i)>>2)*4096+((i)&3)*1024)); vhi[i]=vtr(vp_+(((i)>>2)*4096+((i)&3)*1024+512)); }while(0)
  #define KRD(G,j) do{ if(G){ kload2(kf,kp0+sl_next,j); SBAR(); } }while(0)
  #define STEP(C0,C1,P0,P1,t,GK,GV,GL) do{ SBAR(); \
    int q_=qrel; asm volatile("":"+v"(q_)); const unsigned selw_=((const volatile __attribute__((address_space(3))) unsigned*)((__attribute__((address_space(3))) const char*)shm+LDS_SEL))[q_]; \
    const bool keep_=((t)-1>=NT-4)||((selw_>>(((t)-1)>>2))&1u); \
    const lds_cptr vp_=vp0+sl_prev; \
    VRD(0); SBAR(); float sacc=(P0[0]+P0[1]); \
    GAPA(C0=__builtin_amdgcn_mfma_f32_32x32x16_bf16(kf[0],qr[0],negm,0,0,0), P0[2],P0[3],P0[4],P0[5],     pw0[0]=PKW(P0,0), pw0[1]=PKW(P0,2), pw0); \
    VRD(4); SBAR(); GAPA(C1=__builtin_amdgcn_mfma_f32_32x32x16_bf16(kf[1],qr[0],negm,0,0,0), P0[6],P0[7],P0[8],P0[9],     pw0[2]=PKW(P0,4), pw0[3]=PKW(P0,6), pw0); \
    VRD(1); SBAR(); GAPA(C0=__builtin_amdgcn_mfma_f32_32x32x16_bf16(kf[2],qr[1],C0,0,0,0),   P0[10],P0[11],P0[12],P0[13], pw1[0]=PKW(P0,8), pw1[1]=PKW(P0,10), pw1); \
    VRD(5); SBAR(); GAPA(C1=__builtin_amdgcn_mfma_f32_32x32x16_bf16(kf[3],qr[1],C1,0,0,0),   P0[14],P0[15],P1[0],P1[1],   pw1[2]=PKW(P0,12),pw1[3]=PKW(P0,14), pw1); \
    VRD(2); SBAR(); GAPA(C0=__builtin_amdgcn_mfma_f32_32x32x16_bf16(kf[4],qr[2],C0,0,0,0),   P1[2],P1[3],P1[4],P1[5],     pw2[0]=PKW(P1,0), pw2[1]=PKW(P1,2), pw2); \
    VRD(6); SBAR(); GAPA(C1=__builtin_amdgcn_mfma_f32_32x32x16_bf16(kf[5],qr[2],C1,0,0,0),   P1[6],P1[7],P1[8],P1[9],     pw2[2]=PKW(P1,4), pw2[3]=PKW(P1,6), pw2); \
    VRD(3); SBAR(); GAPA(C0=__builtin_amdgcn_mfma_f32_32x32x16_bf16(kf[6],qr[3],C0,0,0,0),   P1[10],P1[11],P1[12],P1[13], pw3[0]=PKW(P1,8), pw3[1]=PKW(P1,10), pw3); \
    VRD(7); SBAR(); GAPA(C1=__builtin_amdgcn_mfma_f32_32x32x16_bf16(kf[7],qr[3],C1,0,0,0),   P1[14],P1[15],0.f,0.f,       pw3[2]=PKW(P1,12),pw3[3]=PKW(P1,14), pw3); \
    l_reg+=keep_?sacc:0.f; \
    if(GK){DMA_K((t)+3,sl_cur);} if(GV){DMA_V((t)+1,sl_next);} \
    CMASK(C0,C1,t); \
    { float a=MX3(C0[0],C0[1],C1[0]),b=MX3(C0[2],C0[3],C1[1]); a=MX3(a,C1[2],C1[3]); \
      _Pragma("unroll") for(int r=4;r<16;r+=4){a=MX3(a,C0[r],C0[r+1]);b=MX3(b,C0[r+2],C0[r+3]);a=MX3(a,C1[r],C1[r+1]);b=MX3(b,C1[r+2],C1[r+3]);} \
      float rm=__builtin_fmaxf(a,b); { auto rr=__builtin_amdgcn_permlane32_swap(__float_as_uint(rm),__float_as_uint(rm),false,false); rm=__builtin_fmaxf(__uint_as_float(rr[0]),__uint_as_float(rr[1])); } \
      resc=false; \
      if(__builtin_expect(__any(rm>(float)THRL),0)){ const float dl=__builtin_fmaxf(rm,0.f); mhat+=dl; \
        _Pragma("unroll") for(int r=0;r<16;++r){C0[r]-=dl;C1[r]-=dl;} \
        _Pragma("unroll") for(int r=0;r<16;++r)negm[r]=-mhat; asm volatile("":"+v"(negm)); \
        const float f=__builtin_amdgcn_exp2f(-dl); l_reg*=f; if(hi==0)wsf[r32]=f; resc=true; } } \
    SBAR(); \
    GAPB(o[0]=__builtin_amdgcn_mfma_f32_32x32x16_bf16(PAF(0),VFR(0),o[0],0,0,0), C0,0); \
    GAPB(o[1]=__builtin_amdgcn_mfma_f32_32x32x16_bf16(PAF(0),VFR(4),o[1],0,0,0), C0,4); \
    KRD(GL,0); GAPB(o[0]=__builtin_amdgcn_mfma_f32_32x32x16_bf16(PAF(1),VFR(1),o[0],0,0,0), C0,8); \
    KRD(GL,1); GAPB(o[1]=__builtin_amdgcn_mfma_f32_32x32x16_bf16(PAF(1),VFR(5),o[1],0,0,0), C0,12); \
    KRD(GL,2); GAPB(o[0]=__builtin_amdgcn_mfma_f32_32x32x16_bf16(PAF(2),VFR(2),o[0],0,0,0), C1,0); \
    KRD(GL,3); GAPB(o[1]=__builtin_amdgcn_mfma_f32_32x32x16_bf16(PAF(2),VFR(6),o[1],0,0,0), C1,4); \
    GAPB(o[0]=__builtin_amdgcn_mfma_f32_32x32x16_bf16(PAF(3),VFR(3),o[0],0,0,0), C1,8); \
    GAPB(o[1]=__builtin_amdgcn_mfma_f32_32x32x16_bf16(PAF(3),VFR(7),o[1],0,0,0), C1,12); \
    }while(0)
  int t=1;
  for(;t+5<NT;t+=2){
    STEP(pB0,pB1,pA0,pA1,t,true,true,true);     WAIT_BAR(2); RESC(); ROT();
    STEP(pA0,pA1,pB0,pB1,t+1,true,true,true);   WAIT_BAR(2); RESC(); ROT();
  }
  #define ENDW(tt) do{ if((tt)+3<NT){WAIT_BAR(2);} else if((tt)+2<NT){WAIT_BAR(1);} else {WAIT_BAR(0);} }while(0)
  for(;t+1<NT;t+=2){
    STEP(pB0,pB1,pA0,pA1,t,(t+3<NT),(t+1<NT),(t+1<NT));       ENDW(t);   RESC(); ROT();
    STEP(pA0,pA1,pB0,pB1,t+1,(t+4<NT),(t+2<NT),(t+2<NT));     ENDW(t+1); RESC(); ROT();
  }
  STEP(pB0,pB1,pA0,pA1,NT-1,false,false,false); RESC();
  { const bool keep_=true; float sacc=pB0[0]+pB0[1]; _Pragma("unroll") for(int r=2;r<16;++r)sacc+=pB0[r]; _Pragma("unroll") for(int r=0;r<16;++r)sacc+=pB1[r]; l_reg+=sacc;
    pw0=(u32x4){PKW(pB0,0),PKW(pB0,2),PKW(pB0,4),PKW(pB0,6)};pw1=(u32x4){PKW(pB0,8),PKW(pB0,10),PKW(pB0,12),PKW(pB0,14)};pw2=(u32x4){PKW(pB1,0),PKW(pB1,2),PKW(pB1,4),PKW(pB1,6)};pw3=(u32x4){PKW(pB1,8),PKW(pB1,10),PKW(pB1,12),PKW(pB1,14)};
    SBAR(); pv(o,vb0+sl_cur,PAF(0),PAF(1),PAF(2),PAF(3)); }
  #undef PKW
  #undef PAF
  #undef VFR
  #undef PIN
  #undef MX3
  #undef GAPA
  #undef GAPB
  #undef EX
  #undef VRD
  #undef KRD
  #undef STEP
  #undef ENDW
  {auto rr=__builtin_amdgcn_permlane32_swap(__float_as_uint(l_reg),__float_as_uint(l_reg),false,false);l_reg=__uint_as_float(rr[0])+__uint_as_float(rr[1]);}
  if(hi==0)wsf[32+r32]=l_reg;asm volatile("s_waitcnt lgkmcnt(0)":::"memory");
  float rli[16];
  #pragma unroll
  for(int r=0;r<16;++r)rli[r]=__builtin_amdgcn_rcpf(wsf[32+crow(r,hi)]);
  bf16*Ow=O+(rowbase+q0+wid*QBLK)*DM+h*D;
  { bf16*stg=(bf16*)(shm+LDS_OST)+wid*2048;
    #pragma unroll
    for(int r=0;r<16;++r){const int orow=crow(r,hi);
      #pragma unroll
      for(int d0=0;d0<2;++d0)stg[orow*64+d0*32+r32]=__float2bfloat16(o[d0][r]*rli[r]);}
    asm volatile("s_waitcnt lgkmcnt(0)":::"memory");
    #pragma unroll
    for(int i=0;i<4;++i){const int row=i*8+(lane>>3),ch=lane&7; const u32x4 v=*(const u32x4*)(stg+row*64+ch*8); ATTN_STORE16(Ow+(long)row*DM+ch*8,v);} }
  asm volatile("s_waitcnt lgkmcnt(0)\n\ts_barrier":::"memory");
  #undef DMA_K
  #undef DMA_V
  #undef CMASK
  #undef BMASK
  #undef START
  #undef RESC
  #undef ROT
}
constexpr int ATTN_LDS_BYTES=LDS_BYTES;
struct AttnTensors { const bf16* Q; const bf16* K; const bf16* V; bf16* O; const float* KM; };
struct AttnUnit { int bh; int qb; };
struct StaticOrder {
  int vcu;
  __device__ __forceinline__ explicit StaticOrder(int grid,int block):vcu((block%8)*(grid/8)+block/8){}
  __device__ __forceinline__ bool next(int i,AttnUnit&u)const{ if(i>=4)return false; const int s=vcu&7; u.bh=vcu>>3; u.qb=(i==0)?s:(i==1)?15-s:(i==2)?16+s:31-s; return true; }
  __device__ __forceinline__ void a_ready(const AttnUnit&)const{}
  __device__ __forceinline__ void done(const AttnUnit&)const{}
};
template<class Sched,int THRL=8> __device__ __forceinline__ void attn_phase(char*lds,const AttnTensors&T,const Sched&S){
  AttnUnit u; int lastbh=-1;
  for(int i=0;S.next(i,u);++i){
    if(u.bh!=lastbh){ __syncthreads(); float*km=(float*)(lds+LDS_KM); int tx_=threadIdx.x; asm volatile("":"+v"(tx_)); for(int k=tx_;k<32*64;k+=512)km[k]=T.KM[(long)u.bh*32*64+k]; asm volatile("s_waitcnt vmcnt(0) lgkmcnt(0)":::"memory"); __syncthreads(); lastbh=u.bh; }
    attn_unit<THRL>(u.bh/NHEAD,u.bh%NHEAD,u.qb,T.Q,T.K,T.V,T.O,lds); }
}
#undef SBAR
#undef WAIT_BAR
}

#define XB_TMO      128
#define XB_XCNT(j)  (256  + 64 * (j))
#define XB_XSUB(j)  (1280 + 64 * (j))
#define XB_XGEN(j)  (2304 + 64 * (j))
#define XB_TOP      3328
#define XB_TOPGEN   3392
#define XCD_BAR_WORDS 3456
#define XB_SPIN_CAP (1u << 20)
__device__ __forceinline__ unsigned xb_ld(unsigned* p)              { return __hip_atomic_load(p, __ATOMIC_RELAXED, __HIP_MEMORY_SCOPE_AGENT); }
__device__ __forceinline__ unsigned xb_add(unsigned* p, unsigned v) { return __hip_atomic_fetch_add(p, v, __ATOMIC_RELAXED, __HIP_MEMORY_SCOPE_AGENT); }
__device__ __forceinline__ unsigned xb_xcc_id() { return (unsigned)__builtin_amdgcn_s_getreg((3 << 11) | 20) & 0xFu; }
#define XB_SPIN(cond, bar) do { unsigned _sp = 0; while (cond) { __builtin_amdgcn_s_sleep(1); \
    if ((++_sp & 255u) == 0u) { if (xb_ld(&(bar)[XB_TMO])) break; if (_sp > XB_SPIN_CAP) { atomicAdd(&(bar)[XB_TMO], 1u); break; } } } } while (0)
struct XcdBarrier { unsigned* bar; unsigned x; volatile LAS unsigned* st; };
__device__ __forceinline__ XcdBarrier xcd_barrier_post(unsigned* bar, volatile LAS unsigned* st) {
    XcdBarrier b; b.bar = bar; b.x = xb_xcc_id(); b.st = st;
    if (threadIdx.x == 0) (void)xb_add(&bar[XB_XCNT(b.x)], 1u);
    return b;
}
__device__ __forceinline__ void xcd_barrier_complete(unsigned* bar, unsigned x, unsigned& nloc, unsigned& nx) {
    const unsigned G = gridDim.x * gridDim.y * gridDim.z;
    unsigned sum, cnt, mine, sp = 0u;
    for (;;) {
        sum = 0u; cnt = 0u; mine = 0u;
#pragma unroll
        for (unsigned j = 0; j < 16; ++j) { const unsigned c = xb_ld(&bar[XB_XCNT(j)]); sum += c; cnt += (c > 0u) ? 1u : 0u; mine = (j == x) ? c : mine; }
        if (sum == G) break;
        __builtin_amdgcn_s_sleep(1);
        if ((++sp & 255u) == 0u) { if (xb_ld(&bar[XB_TMO])) break; if (sp > XB_SPIN_CAP) { atomicAdd(&bar[XB_TMO], 1u); break; } }
    }
    nloc = mine > 0u ? mine : 1u; nx = cnt > 0u ? cnt : 1u;
}
__device__ __forceinline__ void xcd_barrier(const XcdBarrier& b) {
    asm volatile("s_waitcnt vmcnt(0)" ::: "memory");
    __syncthreads();
    if (threadIdx.x == 0) {
        unsigned* bar = b.bar;
        __builtin_amdgcn_s_waitcnt(0);
        unsigned nloc = b.st[0], nx = b.st[1];
        if (nloc == 0u) { xcd_barrier_complete(bar, b.x, nloc, nx); b.st[0] = nloc; b.st[1] = nx; }
        const unsigned old = xb_add(&bar[XB_XSUB(b.x)], 1u);
        const unsigned gen = old / nloc;
        if (old + 1u == (gen + 1u) * nloc) {
            __builtin_amdgcn_fence(__ATOMIC_RELEASE, "agent");
            asm volatile("s_waitcnt vmcnt(0)" ::: "memory");
            const unsigned og = xb_add(&bar[XB_TOP], 1u);
            const unsigned tg = og / nx;
            if (og + 1u == (tg + 1u) * nx) xb_add(&bar[XB_TOPGEN], 1u);
            else XB_SPIN(xb_ld(&bar[XB_TOPGEN]) == tg, bar);
            __builtin_amdgcn_fence(__ATOMIC_ACQUIRE, "agent");
            xb_add(&bar[XB_XGEN(b.x)], 1u);
            asm volatile("s_waitcnt vmcnt(0)" ::: "memory");
        } else {
            XB_SPIN(xb_ld(&bar[XB_XGEN(b.x)]) == gen, bar);
            __builtin_amdgcn_fence(__ATOMIC_ACQUIRE, "agent");
            asm volatile("s_waitcnt vmcnt(0)" ::: "memory");
        }
    }
    __syncthreads();
}

struct Args { const float* in[28]; float* out; unsigned char* ws; int ph_lo, ph_hi; };
enum { I_X = 0, I_MEM, I_GMIX, I_WIN, I_ARE, I_AIM, I_LOGDT, I_BRE, I_BIM, I_CRE, I_CIM, I_DSKIP, I_WGLU, I_WPA, I_WOUT, I_GXATTN, I_GMEM, I_WXQ, I_WXKV, I_WXO,
       I_GMOE, I_WROUTER, I_BROUTER, I_WGU, I_BGU, I_WDN, I_BDN, I_GFINAL };

template <int MAP>
__device__ __forceinline__ void p0_transpose_item(const float* W, int K, int N, const float* gain, bf16_t* WT, LAS float* scr, int item, int lane) {
    const int nblk = N / 32, kb = item / nblk, nb = item % nblk, k0 = 64 * kb, n0 = 32 * nb;
#pragma unroll 8
    for (int i = 0; i < 32; ++i) { const int kk = 2 * i + (lane >> 5); float v = W[(size_t)(k0 + kk) * N + n0 + (lane & 31)]; if (gain) v *= gain[k0 + kk]; scr[kk * 33 + (lane & 31)] = v; }
    asm volatile("s_waitcnt lgkmcnt(0)" ::: "memory");
    const int c = lane & 7;
    const int nr0 = (MAP == 1) ? (256 * ((n0 % 1024) / 128) + 128 * (n0 / 1024) + (n0 % 128)) : n0;
#pragma unroll
    for (int j = 0; j < 4; ++j) { const int n = (lane >> 3) + 8 * j; const LAS float* s = scr + (8 * c) * 33 + n;
        u32x4 o; o.x = pk2(s[0 * 33], s[1 * 33]); o.y = pk2(s[2 * 33], s[3 * 33]); o.z = pk2(s[4 * 33], s[5 * 33]); o.w = pk2(s[6 * 33], s[7 * 33]);
        *(u32x4*)(WT + (size_t)(nr0 + n) * K + k0 + 8 * c) = o; }
    asm volatile("s_waitcnt lgkmcnt(0)" ::: "memory");
}
template <int MODE>
__device__ __forceinline__ float rms_row_to_bf16(const float* xrow, const float* gain, bf16_t* orow, int lane) {
    const f32x4* xr = (const f32x4*)xrow + lane;
    f32x4 v[4]; float s = 0.f;
#pragma unroll
    for (int j = 0; j < 4; ++j) { v[j] = xr[64 * j]; s += (v[j][0] * v[j][0] + v[j][1] * v[j][1]) + (v[j][2] * v[j][2] + v[j][3] * v[j][3]); }
    const float rstd = 1.0f / sqrtf(wave_sum(s) * (1.0f / DM) + RMS_EPS);
    u32x2* o8 = (u32x2*)orow + lane;
#pragma unroll
    for (int j = 0; j < 4; ++j) { f32x4 w = v[j];
        if (MODE == 1) { const f32x4 g = ((const f32x4*)gain)[lane + 64 * j]; w = w * rstd * g; }
        u32x2 o; o.x = pk2(w[0], w[1]); o.y = pk2(w[2], w[3]); o8[64 * j] = o; }
    return rstd;
}

struct Frame {
    LAS unsigned char* lds; int tid, lane, wave, G, bid;
    const float* in[28]; float* out; unsigned char* ws; unsigned* ctl;
};
#define WSP(type, off) ((type*)(F.ws + (off)))

__device__ __forceinline__ void phase_prologue(Frame& F) {
    LAS float* scr = (LAS float*)(F.lds + F.wave * 16384);
    const int gw = F.bid * 8 + F.wave, NGW = F.G * 8;
    for (int m = gw; m < T_; m += NGW) { const float r = rms_row_to_bf16<0>(F.in[I_X] + (size_t)m * DM, nullptr, WSP(bf16_t, WS_XB) + (size_t)m * DM, F.lane); if (F.lane == 0) WSP(float, WS_RSTD0)[m] = r; }
    for (int m = gw; m < NB * MEML; m += NGW) (void)rms_row_to_bf16<1>(F.in[I_MEM] + (size_t)m * DM, F.in[I_GMEM], WSP(bf16_t, WS_MN) + (size_t)m * DM, F.lane);
    constexpr int I_IN = (DM / 64) * (INW / 32), I_GLU = (SW / 64) * (2 * DM / 32), I_PA = (AW / 64) * (DM / 32), I_OUT = (DM / 64) * (DM / 32), I_XQ = (DM / 64) * (XW / 32),
                  I_XKV = (DM / 64) * (2 * XW / 32), I_XO = (XW / 64) * (DM / 32), I_GU1 = (DM / 64) * (2 * DFF / 32), I_DN1 = (DFF / 64) * (DM / 32);
    constexpr int NITEMS = I_IN + I_GLU + I_PA + I_OUT + I_XQ + I_XKV + I_XO + NE * (I_GU1 + I_DN1);
    for (int it = gw; it < NITEMS; it += NGW) {
        int r = it;
        if (r < I_IN) { p0_transpose_item<0>(F.in[I_WIN], DM, INW, F.in[I_GMIX], WSP(bf16_t, WS_WIN), scr, r, F.lane); continue; } r -= I_IN;
        if (r < I_GLU) { p0_transpose_item<1>(F.in[I_WGLU], SW, 2 * DM, nullptr, WSP(bf16_t, WS_WGLU), scr, r, F.lane); continue; } r -= I_GLU;
        if (r < I_PA) { p0_transpose_item<0>(F.in[I_WPA], AW, DM, nullptr, WSP(bf16_t, WS_WPA), scr, r, F.lane); continue; } r -= I_PA;
        if (r < I_OUT) { p0_transpose_item<0>(F.in[I_WOUT], DM, DM, nullptr, WSP(bf16_t, WS_WOUT), scr, r, F.lane); continue; } r -= I_OUT;
        if (r < I_XQ) { p0_transpose_item<0>(F.in[I_WXQ], DM, XW, F.in[I_GXATTN], WSP(bf16_t, WS_WXQ), scr, r, F.lane); continue; } r -= I_XQ;
        if (r < I_XKV) { p0_transpose_item<0>(F.in[I_WXKV], DM, 2 * XW, nullptr, WSP(bf16_t, WS_WXKV), scr, r, F.lane); continue; } r -= I_XKV;
        if (r < I_XO) { p0_transpose_item<0>(F.in[I_WXO], XW, DM, nullptr, WSP(bf16_t, WS_WXO), scr, r, F.lane); continue; } r -= I_XO;
        const int e = r / (I_GU1 + I_DN1); r -= e * (I_GU1 + I_DN1);
        if (r < I_GU1) p0_transpose_item<1>(F.in[I_WGU] + (size_t)e * DM * 2 * DFF, DM, 2 * DFF, F.in[I_GMOE], WSP(bf16_t, WS_WGU) + (size_t)e * 2 * DFF * DM, scr, r, F.lane);
        else p0_transpose_item<0>(F.in[I_WDN] + (size_t)e * DFF * DM, DFF, DM, nullptr, WSP(bf16_t, WS_WDN) + (size_t)e * DM * DFF, scr, r - I_GU1, F.lane);
    }
}

__device__ __forceinline__ void phase_kmean(Frame& F) {
    LAS float* red = (LAS float*)F.lds;
    const bf16_t* Kb = WSP(bf16_t, WS_K);
    for (int it = F.bid; it < NB * NH * NBLK; it += F.G) {
        const int j = it % NBLK, h = (it / NBLK) % NH, b = it / (NBLK * NH);
        const int col = F.tid & 63, rg = F.tid >> 6; float s = 0.f;
        const bf16_t* p = Kb + ((size_t)(b * SEQ + j * MBLK + rg * 32)) * AW + h * HD + col;
#pragma unroll 8
        for (int r = 0; r < 32; ++r) s += bf2f(p[(size_t)r * AW]);
        red[rg * 64 + col] = s;
        __syncthreads();
        if (F.tid < 64) { float t = 0.f;
#pragma unroll
            for (int k = 0; k < 8; ++k) t += red[k * 64 + F.tid];
            WSP(float, WS_KMEAN)[(size_t)it * HD + F.tid] = t * (1.0f / MBLK); }
        __syncthreads();
    }
}

__device__ __forceinline__ void phase_moba_simple(Frame& F, bf16_t* Ob) {
    LAS unsigned* Ks = (LAS unsigned*)F.lds;
    LAS unsigned* Vs = (LAS unsigned*)(F.lds + 32768);
    LAS float* km = (LAS float*)(F.lds + 65536);
    const bf16_t *Qb = WSP(bf16_t, WS_Q), *Kb = WSP(bf16_t, WS_K), *Vb = WSP(bf16_t, WS_V);
    const int ql = F.tid >> 1, half = F.tid & 1;
    for (int it = F.bid; it < NB * NH * NBLK; it += F.G) {
        const int iblk = (NBLK - 1) - (it % NBLK), h = (it / NBLK) % NH, b = it / (NBLK * NH);
        __syncthreads();
        for (int k = F.tid; k < NBLK * HD; k += 512) km[k] = WSP(float, WS_KMEAN)[(size_t)((b * NH + h) * NBLK) * HD + k];
        float q[32];
        { const u32x4* qp = (const u32x4*)(Qb + (size_t)(b * SEQ + iblk * MBLK + ql) * AW + h * HD + half * 32);
#pragma unroll
          for (int c = 0; c < 4; ++c) { const u32x4 w = qp[c]; q[8 * c + 0] = bflo(w.x); q[8 * c + 1] = bfhi(w.x); q[8 * c + 2] = bflo(w.y); q[8 * c + 3] = bfhi(w.y); q[8 * c + 4] = bflo(w.z); q[8 * c + 5] = bfhi(w.z); q[8 * c + 6] = bflo(w.w); q[8 * c + 7] = bfhi(w.w); } }
        __syncthreads();
        float g0 = -3e38f, g1 = -3e38f, g2 = -3e38f; int s0 = -1, s1 = -1, s2 = -1;
        for (int j = 0; j < iblk; ++j) { float g = 0.f;
#pragma unroll
            for (int d = 0; d < 32; ++d) g += q[d] * km[j * HD + half * 32 + d];
            g += __shfl_xor(g, 1);
            if (g > g0) { g2 = g1; s2 = s1; g1 = g0; s1 = s0; g0 = g; s0 = j; } else if (g > g1) { g2 = g1; s2 = s1; g1 = g; s1 = j; } else if (g > g2) { g2 = g; s2 = j; } }
        float mx = -3e38f, l = 0.f, o[32];
#pragma unroll
        for (int d = 0; d < 32; ++d) o[d] = 0.f;
        for (int jb = 0; jb <= iblk; ++jb) {
            __syncthreads();
            { const size_t rowb = (size_t)(b * SEQ + jb * MBLK);
              for (int c = F.tid; c < 256 * 8; c += 512) { const int r = c >> 3, ch = c & 7;
                  *(LAS u32x4*)(Ks + r * 32 + ch * 4) = *(const u32x4*)(Kb + (rowb + r) * AW + h * HD + ch * 8);
                  *(LAS u32x4*)(Vs + r * 32 + ch * 4) = *(const u32x4*)(Vb + (rowb + r) * AW + h * HD + ch * 8); } }
            __syncthreads();
            const bool need = (jb == iblk) || jb == s0 || jb == s1 || jb == s2;
            if (need) { const int kend = (jb == iblk) ? ql : 255;
                for (int kk = 0; kk <= kend; ++kk) { float s = 0.f;
#pragma unroll
                    for (int c = 0; c < 4; ++c) { const u32x4 w = *(const LAS u32x4*)(Ks + kk * 32 + half * 16 + c * 4);
                        s += q[8 * c + 0] * bflo(w.x) + q[8 * c + 1] * bfhi(w.x) + q[8 * c + 2] * bflo(w.y) + q[8 * c + 3] * bfhi(w.y) + q[8 * c + 4] * bflo(w.z) + q[8 * c + 5] * bfhi(w.z) + q[8 * c + 6] * bflo(w.w) + q[8 * c + 7] * bfhi(w.w); }
                    s += __shfl_xor(s, 1);
                    const float mn = fmaxf(mx, s), corr = __builtin_amdgcn_exp2f(mx - mn), p = __builtin_amdgcn_exp2f(s - mn); mx = mn; l = l * corr + p;
#pragma unroll
                    for (int c = 0; c < 4; ++c) { const u32x4 w = *(const LAS u32x4*)(Vs + kk * 32 + half * 16 + c * 4);
                        o[8 * c + 0] = o[8 * c + 0] * corr + p * bflo(w.x); o[8 * c + 1] = o[8 * c + 1] * corr + p * bfhi(w.x); o[8 * c + 2] = o[8 * c + 2] * corr + p * bflo(w.y); o[8 * c + 3] = o[8 * c + 3] * corr + p * bfhi(w.y);
                        o[8 * c + 4] = o[8 * c + 4] * corr + p * bflo(w.z); o[8 * c + 5] = o[8 * c + 5] * corr + p * bfhi(w.z); o[8 * c + 6] = o[8 * c + 6] * corr + p * bflo(w.w); o[8 * c + 7] = o[8 * c + 7] * corr + p * bfhi(w.w); } } }
        }
        const float il = 1.0f / l;
        u32x4* op = (u32x4*)(Ob + (size_t)(b * SEQ + iblk * MBLK + ql) * AW + h * HD + half * 32);
#pragma unroll
        for (int c = 0; c < 4; ++c) { u32x4 w; w.x = pk2(o[8 * c + 0] * il, o[8 * c + 1] * il); w.y = pk2(o[8 * c + 2] * il, o[8 * c + 3] * il); w.z = pk2(o[8 * c + 4] * il, o[8 * c + 5] * il); w.w = pk2(o[8 * c + 6] * il, o[8 * c + 7] * il); op[c] = w; }
    }
}

__device__ __forceinline__ void phase_ssm_simple(Frame& F, bf16_t* Yb) {
    const int gw = F.bid * 8 + F.wave, NGW = F.G * 8, p = F.lane;
    const bf16_t* Ub = WSP(bf16_t, WS_U);
    for (int it = gw; it < NB * NG; it += NGW) {
        const int g = it % NG, b = it / NG;
        const float are = fminf(F.in[I_ARE][g * SP + p], -1e-4f), aim = F.in[I_AIM][g * SP + p], dt = expf(F.in[I_LOGDT][g]);
        const float mag = expf(are * dt), ang = aim * dt; const float lr = mag * cosf(ang), li = mag * sinf(ang);
        const float nr = lr - 1.0f, ni = li, den = 1.0f / (are * are + aim * aim); const float fr_ = (nr * are + ni * aim) * den, fi_ = (ni * are - nr * aim) * den;
        float bbr[16], bbi[16], cr[16], ci[16], dsk[16];
#pragma unroll
        for (int c = 0; c < 16; ++c) { const float br = F.in[I_BRE][(size_t)(g * SP + p) * SGC + c], bi = F.in[I_BIM][(size_t)(g * SP + p) * SGC + c];
            bbr[c] = fr_ * br - fi_ * bi; bbi[c] = fr_ * bi + fi_ * br;
            cr[c] = F.in[I_CRE][(size_t)(g * SGC + c) * SP + p]; ci[c] = F.in[I_CIM][(size_t)(g * SGC + c) * SP + p]; dsk[c] = F.in[I_DSKIP][g * SGC + c]; }
        float xr = 0.f, xi = 0.f;
        const int csel = ((p >> 5) & 1) * 8 + ((p >> 4) & 1) * 4 + ((p >> 3) & 1) * 2 + ((p >> 2) & 1);
        float dmine = 0.f;
#pragma unroll
        for (int c = 0; c < 16; ++c) dmine = (c == csel) ? dsk[c] : dmine;
        for (int t = 0; t < SEQ; ++t) {
            const u32x4* up = (const u32x4*)(Ub + (size_t)(b * SEQ + t) * SW + g * SGC); const u32x4 w0 = up[0], w1 = up[1];
            float u[16]; u[0] = bflo(w0.x); u[1] = bfhi(w0.x); u[2] = bflo(w0.y); u[3] = bfhi(w0.y); u[4] = bflo(w0.z); u[5] = bfhi(w0.z); u[6] = bflo(w0.w); u[7] = bfhi(w0.w);
            u[8] = bflo(w1.x); u[9] = bfhi(w1.x); u[10] = bflo(w1.y); u[11] = bfhi(w1.y); u[12] = bflo(w1.z); u[13] = bfhi(w1.z); u[14] = bflo(w1.w); u[15] = bfhi(w1.w);
            float sr = 0.f, si = 0.f;
#pragma unroll
            for (int c = 0; c < 16; ++c) { sr += bbr[c] * u[c]; si += bbi[c] * u[c]; }
            const float nxr = lr * xr - li * xi + sr, nxi = lr * xi + li * xr + si; xr = nxr; xi = nxi;
            float y[16];
#pragma unroll
            for (int c = 0; c < 16; ++c) y[c] = cr[c] * xr - ci[c] * xi;
            float w8[8], w4[4], w2[2], w1_;
            { const bool hi = (p & 32) != 0;
#pragma unroll
              for (int i = 0; i < 8; ++i) { const float keep = hi ? y[i + 8] : y[i], send = hi ? y[i] : y[i + 8]; w8[i] = keep + __shfl_xor(send, 32); } }
            { const bool hi = (p & 16) != 0;
#pragma unroll
              for (int i = 0; i < 4; ++i) { const float keep = hi ? w8[i + 4] : w8[i], send = hi ? w8[i] : w8[i + 4]; w4[i] = keep + __shfl_xor(send, 16); } }
            { const bool hi = (p & 8) != 0;
#pragma unroll
              for (int i = 0; i < 2; ++i) { const float keep = hi ? w4[i + 2] : w4[i], send = hi ? w4[i] : w4[i + 2]; w2[i] = keep + __shfl_xor(send, 8); } }
            { const bool hi = (p & 4) != 0; const float keep = hi ? w2[1] : w2[0], send = hi ? w2[0] : w2[1]; w1_ = keep + __shfl_xor(send, 4); }
            w1_ += __shfl_xor(w1_, 2); w1_ += __shfl_xor(w1_, 1);
            float umine = 0.f;
#pragma unroll
            for (int c = 0; c < 16; ++c) umine = (c == csel) ? u[c] : umine;
            if ((p & 3) == 0) Yb[(size_t)(b * SEQ + t) * SW + g * SGC + csel] = (bf16_t)f2bf(gelu_tanh(w1_ + dmine * umine));
        }
    }
}


__device__ __forceinline__ void p0_ssm_tables(Frame& F, int task) {
    const int g = task >> 3, part = task & 7;
    LAS float* pwr = (LAS float*)F.lds; LAS float* pwi = pwr + 65 * 64; LAS float* bbr = pwi + 65 * 64; LAS float* bbi = bbr + 1024; LAS float* ccr = bbi + 1024; LAS float* cci = ccr + 1024;
    const float dt = expf(F.in[I_LOGDT][g]);
    __syncthreads();
    for (int i = F.tid; i < 65 * 64; i += 512) { const int k = i >> 6, p = i & 63; const float are = fminf(F.in[I_ARE][g * SP + p], -1e-4f), aim = F.in[I_AIM][g * SP + p];
        const float mag = expf(are * dt * (float)k); double a = (double)aim * (double)dt * (double)k; a -= 6.283185307179586 * rint(a * 0.15915494309189535); const float af = (float)a;
        pwr[i] = mag * cosf(af); pwi[i] = mag * sinf(af); }
    for (int i = F.tid; i < 1024; i += 512) { const int p = i >> 4, c = i & 15; const float are = fminf(F.in[I_ARE][g * SP + p], -1e-4f), aim = F.in[I_AIM][g * SP + p];
        const float mag = expf(are * dt); double a = (double)aim * (double)dt; a -= 6.283185307179586 * rint(a * 0.15915494309189535); const float af = (float)a;
        const float lr = mag * cosf(af), li = mag * sinf(af), nr = lr - 1.0f, ni = li, den = 1.0f / (are * are + aim * aim), fr_ = (nr * are + ni * aim) * den, fi_ = (ni * are - nr * aim) * den;
        const float br = F.in[I_BRE][(size_t)(g * SP + p) * SGC + c], bi = F.in[I_BIM][(size_t)(g * SP + p) * SGC + c];
        bbr[i] = fr_ * br - fi_ * bi; bbi[i] = fr_ * bi + fi_ * br; }
    for (int i = F.tid; i < 1024; i += 512) { ccr[i] = F.in[I_CRE][(size_t)g * 1024 + i]; cci[i] = F.in[I_CIM][(size_t)g * 1024 + i]; }
    __syncthreads();
    bf16_t* WST = WSP(bf16_t, WS_WST) + (size_t)g * 128 * 1024; bf16_t* GT = WSP(bf16_t, WS_GT) + (size_t)g * 1024 * 128; bf16_t* KT = WSP(bf16_t, WS_KT) + (size_t)g * 65 * 256;
    for (int j = 0; j < 32; ++j) { const int e = part * 16384 + j * 512 + F.tid; const int pp = e >> 10, k = e & 1023, s = k >> 4, c = k & 15, p = pp & 63;
        const float mr = pwr[(63 - s) * 64 + p], mi = pwi[(63 - s) * 64 + p], br = bbr[p * 16 + c], bi = bbi[p * 16 + c];
        WST[e] = (bf16_t)f2bf(pp < 64 ? (mr * br - mi * bi) : (mr * bi + mi * br)); }
    for (int j = 0; j < 32; ++j) { const int e = part * 16384 + j * 512 + F.tid; const int sc = e >> 7, pp = e & 127, s = sc >> 4, c = sc & 15, p = pp & 63;
        const float mr = pwr[(s + 1) * 64 + p], mi = pwi[(s + 1) * 64 + p], cr = ccr[c * 64 + p], ci = cci[c * 64 + p];
        GT[e] = (bf16_t)f2bf(pp < 64 ? (cr * mr - ci * mi) : -(cr * mi + ci * mr)); }
    for (int e = part * 2080 + F.tid; e < (part + 1) * 2080; e += 512) { const int tt = e >> 8, c = (e >> 4) & 15, c2 = e & 15; float acc = 0.f;
        if (tt > 0) { const int tau = tt - 1;
            for (int p = 0; p < 64; ++p) { const float mr = pwr[tau * 64 + p], mi = pwi[tau * 64 + p], cr = ccr[c * 64 + p], ci = cci[c * 64 + p]; const float zr = cr * mr - ci * mi, zi = cr * mi + ci * mr; acc += zr * bbr[p * 16 + c2] - zi * bbi[p * 16 + c2]; } }
        KT[e] = (bf16_t)f2bf(acc); }
    if (part == 0 && F.tid < 64) { WSP(f32x2, WS_LAML)[g * 64 + F.tid] = (f32x2){pwr[64 * 64 + F.tid], pwi[64 * 64 + F.tid]}; }
    __syncthreads();
}
__device__ __forceinline__ void ssm_state_item(Frame& F, int b, int g) {
    const int w = F.wave, wm = w >> 1, wn = w & 1, row = F.lane & 15, kg = F.lane >> 4;
    f32x4 acc[2][4];
#pragma unroll
    for (int a = 0; a < 2; ++a)
#pragma unroll
        for (int c = 0; c < 4; ++c) acc[a][c] = (f32x4){0.f, 0.f, 0.f, 0.f};
    const bf16_t* Ub = WSP(bf16_t, WS_U) + ((size_t)b * SEQ + (size_t)(32 * wm + row) * 64 + (kg >> 1)) * SW + g * SGC + 8 * (kg & 1);
    const bf16_t* Wb = WSP(bf16_t, WS_WST) + ((size_t)g * 128 + 64 * wn + row) * 1024 + 8 * kg;
#pragma unroll 2
    for (int ks = 0; ks < 32; ++ks) {
        bf16x8 a[2], bq[4];
#pragma unroll
        for (int mt = 0; mt < 2; ++mt) a[mt] = *(const bf16x8*)(Ub + ((size_t)(16 * mt * 64 + 2 * ks)) * SW);
#pragma unroll
        for (int nt = 0; nt < 4; ++nt) bq[nt] = *(const bf16x8*)(Wb + (size_t)nt * 16 * 1024 + 32 * ks);
#pragma unroll
        for (int mt = 0; mt < 2; ++mt)
#pragma unroll
            for (int nt = 0; nt < 4; ++nt) acc[mt][nt] = __builtin_amdgcn_mfma_f32_16x16x32_bf16(a[mt], bq[nt], acc[mt][nt], 0, 0, 0);
    }
    LAS float* X = (LAS float*)F.lds;
    __syncthreads();
#pragma unroll
    for (int mt = 0; mt < 2; ++mt)
#pragma unroll
        for (int nt = 0; nt < 4; ++nt)
#pragma unroll
            for (int r = 0; r < 4; ++r) X[(32 * wm + 16 * mt + 4 * kg + r) * 128 + 64 * wn + 16 * nt + row] = acc[mt][nt][r];
    __syncthreads();
    if (w == 0) { const int p = F.lane; const f32x2 lam = WSP(f32x2, WS_LAML)[g * 64 + p]; float sr = 0.f, si = 0.f;
        bf16_t* SS = WSP(bf16_t, WS_SST) + ((size_t)(b * NG + g) * 128) * 128;
        for (int n = 0; n < 128; ++n) { SS[n * 128 + p] = (bf16_t)f2bf(sr); SS[n * 128 + 64 + p] = (bf16_t)f2bf(si);
            const float xr = X[n * 128 + p], xi = X[n * 128 + 64 + p]; const float nsr = lam.x * sr - lam.y * si + xr, nsi = lam.x * si + lam.y * sr + xi; sr = nsr; si = nsi; } }
    __syncthreads();
}
constexpr int SO_USTR = 2064, SO_KT = 32 * SO_USTR, SO_SS = SO_KT + 65 * 512, SO_SSTR = 272;
__device__ __forceinline__ void ssm_out_item(Frame& F, int b, int g, int rr) {
    LAS unsigned char* L = F.lds;
    __syncthreads();
    { const bf16_t* Ug = WSP(bf16_t, WS_U) + ((size_t)b * SEQ + (size_t)rr * 2048) * SW + g * SGC;
#pragma unroll
      for (int j = 0; j < 8; ++j) { const int c = F.tid + 512 * j, r = c >> 1, half = c & 1; *(LAS u32x4*)(L + (r >> 6) * SO_USTR + (r & 63) * 32 + half * 16) = *(const u32x4*)(Ug + (size_t)r * SW + half * 8); }
      const u32x4* Kg = (const u32x4*)(WSP(bf16_t, WS_KT) + (size_t)g * 65 * 256);
      for (int c = F.tid; c < 2080; c += 512) *(LAS u32x4*)(L + SO_KT + c * 16) = Kg[c];
      { const int c = F.tid, ch = c >> 4, pc = c & 15; *(LAS u32x4*)(L + SO_SS + ch * SO_SSTR + pc * 16) = *(const u32x4*)(WSP(bf16_t, WS_SST) + ((size_t)((b * NG + g) * 128 + rr * 32 + ch)) * 128 + pc * 8); } }
    __syncthreads();
    const int w = F.wave, mt = w >> 2, q = w & 3, row = F.lane & 15, kg = F.lane >> 4;
    f32x4 acc[16];
#pragma unroll
    for (int i = 0; i < 16; ++i) acc[i] = (f32x4){0.f, 0.f, 0.f, 0.f};
    const LAS unsigned char* Ua = L + (16 * mt + row) * SO_USTR + (kg >> 1) * 32 + (kg & 1) * 16;
    const LAS unsigned char* Kb_ = L + SO_KT + (1 - (kg >> 1)) * 512 + row * 32 + (kg & 1) * 16;
#pragma unroll 1
    for (int ks = 0; ks < 32; ++ks) {
        const bf16x8 a = *(const LAS bf16x8*)(Ua + ks * 64);
#pragma unroll
        for (int i = 0; i < 16; ++i) { const int s = 4 * i + q; if (s >= 2 * ks) { const bf16x8 bb = *(const LAS bf16x8*)(Kb_ + (s - 2 * ks) * 512); acc[i] = __builtin_amdgcn_mfma_f32_16x16x32_bf16(a, bb, acc[i], 0, 0, 0); } }
    }
    const bf16_t* Gg = WSP(bf16_t, WS_GT) + ((size_t)g * 1024 + q * 16 + row) * 128 + 8 * kg;
#pragma unroll 1
    for (int k2 = 0; k2 < 4; ++k2) {
        const bf16x8 a = *(const LAS bf16x8*)(L + SO_SS + (16 * mt + row) * SO_SSTR + k2 * 64 + kg * 16);
#pragma unroll
        for (int hh = 0; hh < 2; ++hh) {
            bf16x8 bb[8]; const bf16_t* gp = Gg + (size_t)hh * 8 * 64 * 128 + 32 * k2;
#pragma unroll
            for (int i = 0; i < 8; ++i) { bb[i] = *(const bf16x8*)gp; gp += 64 * 128; }
#pragma unroll
            for (int i = 0; i < 8; ++i) acc[hh * 8 + i] = __builtin_amdgcn_mfma_f32_16x16x32_bf16(a, bb[i], acc[hh * 8 + i], 0, 0, 0);
        }
    }
    __syncthreads();
    const float dsk = F.in[I_DSKIP][g * SGC + row];
    { LAS unsigned short* yb = (LAS unsigned short*)(L + (16 * mt + 4 * kg) * SO_USTR + q * 32 + row * 2);
#pragma unroll
      for (int i = 0; i < 16; ++i)
#pragma unroll
          for (int r = 0; r < 4; ++r) { LAS unsigned short* p = yb + (r * SO_USTR + i * 128) / 2; const float u = bf2f(*p); *p = (unsigned short)f2bf(gelu_tanh(acc[i][r] + dsk * u)); } }
    __syncthreads();
    { bf16_t* Yg = WSP(bf16_t, WS_YB) + ((size_t)b * SEQ + (size_t)rr * 2048) * SW + g * SGC;
#pragma unroll 2
      for (int j = 0; j < 8; ++j) { const int c = F.tid + 512 * j, r = c >> 1, half = c & 1; *(u32x4*)(Yg + (size_t)r * SW + half * 8) = *(const LAS u32x4*)(L + (r >> 6) * SO_USTR + (r & 63) * 32 + half * 16); } }
}
__device__ __forceinline__ void phase_ssm_out(Frame& F) {
    for (int it = F.bid; it < NB * NG * 4; it += F.G) ssm_out_item(F, it >> 7, (it >> 2) & 31, it & 3);
    __syncthreads();
}

__device__ __forceinline__ void phase_xattn_simple(Frame& F, bf16_t* Ob) {
    LAS unsigned* Ks = (LAS unsigned*)F.lds;
    LAS unsigned* Vs = (LAS unsigned*)(F.lds + 65536);
    const bf16_t *Qb = WSP(bf16_t, WS_XQ), *KV = WSP(bf16_t, WS_MKV);
    const int tl = F.tid >> 2, part = F.tid & 3;
    int lastbh = -1;
    for (int it = F.bid; it < NB * XH * (SEQ / 128); it += F.G) {
        const int bh = it / (SEQ / 128), ch = it % (SEQ / 128), b = bh / XH, h = bh % XH;
        if (bh != lastbh) { __syncthreads();
            for (int c = F.tid; c < 256 * 16; c += 512) { const int r = c >> 4, cc = c & 15;
                *(LAS u32x4*)(Ks + r * 64 + cc * 4) = *(const u32x4*)(KV + (size_t)(b * MEML + r) * (2 * XW) + h * XD + cc * 8);
                *(LAS u32x4*)(Vs + r * 64 + cc * 4) = *(const u32x4*)(KV + (size_t)(b * MEML + r) * (2 * XW) + XW + h * XD + cc * 8); }
            __syncthreads(); lastbh = bh; }
        const size_t row = (size_t)b * SEQ + ch * 128 + tl;
        float q[32];
        { const u32x4* qp = (const u32x4*)(Qb + row * XW + h * XD + part * 32);
#pragma unroll
          for (int c = 0; c < 4; ++c) { const u32x4 w = qp[c]; q[8 * c + 0] = bflo(w.x); q[8 * c + 1] = bfhi(w.x); q[8 * c + 2] = bflo(w.y); q[8 * c + 3] = bfhi(w.y); q[8 * c + 4] = bflo(w.z); q[8 * c + 5] = bfhi(w.z); q[8 * c + 6] = bflo(w.w); q[8 * c + 7] = bfhi(w.w); } }
        float mx = -3e38f, l = 0.f, o[32];
#pragma unroll
        for (int d = 0; d < 32; ++d) o[d] = 0.f;
        for (int kk = 0; kk < MEML; ++kk) { float s = 0.f;
#pragma unroll
            for (int c = 0; c < 4; ++c) { const u32x4 w = *(const LAS u32x4*)(Ks + kk * 64 + part * 16 + c * 4);
                s += q[8 * c + 0] * bflo(w.x) + q[8 * c + 1] * bfhi(w.x) + q[8 * c + 2] * bflo(w.y) + q[8 * c + 3] * bfhi(w.y) + q[8 * c + 4] * bflo(w.z) + q[8 * c + 5] * bfhi(w.z) + q[8 * c + 6] * bflo(w.w) + q[8 * c + 7] * bfhi(w.w); }
            s += __shfl_xor(s, 1); s += __shfl_xor(s, 2);
            const float mn = fmaxf(mx, s), corr = __builtin_amdgcn_exp2f(mx - mn), p = __builtin_amdgcn_exp2f(s - mn); mx = mn; l = l * corr + p;
#pragma unroll
            for (int c = 0; c < 4; ++c) { const u32x4 w = *(const LAS u32x4*)(Vs + kk * 64 + part * 16 + c * 4);
                o[8 * c + 0] = o[8 * c + 0] * corr + p * bflo(w.x); o[8 * c + 1] = o[8 * c + 1] * corr + p * bfhi(w.x); o[8 * c + 2] = o[8 * c + 2] * corr + p * bflo(w.y); o[8 * c + 3] = o[8 * c + 3] * corr + p * bfhi(w.y);
                o[8 * c + 4] = o[8 * c + 4] * corr + p * bflo(w.z); o[8 * c + 5] = o[8 * c + 5] * corr + p * bfhi(w.z); o[8 * c + 6] = o[8 * c + 6] * corr + p * bflo(w.w); o[8 * c + 7] = o[8 * c + 7] * corr + p * bfhi(w.w); } }
        const float il = 1.0f / l;
        u32x4* op = (u32x4*)(Ob + row * XW + h * XD + part * 32);
#pragma unroll
        for (int c = 0; c < 4; ++c) { u32x4 w; w.x = pk2(o[8 * c + 0] * il, o[8 * c + 1] * il); w.y = pk2(o[8 * c + 2] * il, o[8 * c + 3] * il); w.z = pk2(o[8 * c + 4] * il, o[8 * c + 5] * il); w.w = pk2(o[8 * c + 6] * il, o[8 * c + 7] * il); op[c] = w; }
    }
}

__device__ __forceinline__ void phase_router(Frame& F) {
    LAS float* wt = (LAS float*)F.lds;
    for (int c = F.tid; c < NE * DM; c += 512) { const int k = c >> 5, e = c & 31; wt[e * DM + k] = F.in[I_WROUTER][c] * F.in[I_GMOE][k]; }
    __syncthreads();
    const int gw = F.bid * 8 + F.wave, NGW = F.G * 8, lane = F.lane;
    const float* H = WSP(float, WS_H);
    unsigned* cnt = F.ctl + CW_CNT;
    for (int tk = gw; tk < T_; tk += NGW) {
        const f32x4* hp = (const f32x4*)(H + (size_t)tk * DM) + lane; f32x4 hv[4]; float ss = 0.f;
#pragma unroll
        for (int j = 0; j < 4; ++j) { hv[j] = hp[64 * j]; ss += (hv[j][0] * hv[j][0] + hv[j][1] * hv[j][1]) + (hv[j][2] * hv[j][2] + hv[j][3] * hv[j][3]); }
        const float rstd = 1.0f / sqrtf(wave_sum(ss) * (1.0f / DM) + RMS_EPS);
        float mylogit = 0.f;
#pragma unroll 4
        for (int e = 0; e < NE; ++e) { float a = 0.f;
#pragma unroll
            for (int j = 0; j < 4; ++j) { const f32x4 w = *(const LAS f32x4*)(wt + e * DM + 4 * lane + 256 * j); a += (hv[j][0] * w[0] + hv[j][1] * w[1]) + (hv[j][2] * w[2] + hv[j][3] * w[3]); }
            a = wave_sum(a);
            mylogit = (lane == e) ? a : mylogit; }
        mylogit = (lane < NE) ? (mylogit * rstd + F.in[I_BROUTER][lane & 31]) : -3e38f;
        float tv[4]; int ti[4]; float cur = mylogit;
#pragma unroll
        for (int s = 0; s < 4; ++s) { float bv = cur; int bi = lane;
#pragma unroll
            for (int o = 1; o < 64; o <<= 1) { const float ov = __shfl_xor(bv, o); const int oi = __shfl_xor(bi, o); if (ov > bv || (ov == bv && oi < bi)) { bv = ov; bi = oi; } }
            tv[s] = bv; ti[s] = bi; if (lane == bi) cur = -3e38f; }
        const float e1 = __expf(tv[1] - tv[0]), e2 = __expf(tv[2] - tv[0]), e3 = __expf(tv[3] - tv[0]); const float inv = 1.0f / (1.0f + e1 + e2 + e3);
        if (lane == 0) WSP(float, WS_RSTD2)[tk] = rstd;
        if (lane < 4) { const int ex = (lane == 0) ? ti[0] : (lane == 1) ? ti[1] : (lane == 2) ? ti[2] : ti[3]; const float gv = ((lane == 0) ? 1.0f : (lane == 1) ? e1 : (lane == 2) ? e2 : e3) * inv;
            WSP(float, WS_TKG)[(size_t)tk * 4 + lane] = gv;
            const unsigned rank = atomicAdd(&cnt[ex], 1u);
            WSP(int, WS_ROWLIST)[(size_t)ex * T_ + rank] = tk * 4 + lane; }
    }
}


typedef float f32x16 __attribute__((ext_vector_type(16)));
constexpr int XA_VSTR = 520, XA_VT = 65536;
__device__ __forceinline__ bf16x8 pack8(const f32x16& s, int o) {
    u32x4 w; w.x = pg8::cvt_pk_bf16(s[o + 0], s[o + 1]); w.y = pg8::cvt_pk_bf16(s[o + 2], s[o + 3]); w.z = pg8::cvt_pk_bf16(s[o + 4], s[o + 5]); w.w = pg8::cvt_pk_bf16(s[o + 6], s[o + 7]);
    return __builtin_bit_cast(bf16x8, w);
}
__device__ __forceinline__ void phase_xattn(Frame& F) {
    LAS unsigned char* L = F.lds;
    const bf16_t *Qb = WSP(bf16_t, WS_XQ), *KV = WSP(bf16_t, WS_MKV); bf16_t* Ob = WSP(bf16_t, WS_XO);
    const int lane = F.lane, r32 = lane & 31, hi = lane >> 5, wid = F.wave;
    const int NU = NB * XH * (SEQ / 256), UPB = (NU + F.G - 1) / F.G;
    int lastbh = -1;
    for (int u = F.bid * UPB; u < NU && u < (F.bid + 1) * UPB; ++u) {
        const int bh = u >> 5, qb = u & 31, b = bh >> 2, h = bh & 3;
        if (bh != lastbh) {
            __syncthreads();
            for (int c = F.tid; c < 256 * 16; c += 512) { const int m = c >> 4, ch = c & 15; const bf16_t* src = KV + (size_t)(b * MEML + m) * (2 * XW) + h * XD + ch * 8;
                *(LAS u32x4*)(L + m * 256 + ((ch ^ (m & 15)) << 4)) = *(const u32x4*)src;
                const u32x4 v = *(const u32x4*)(src + XW); LAS unsigned short* vt = (LAS unsigned short*)(L + XA_VT + (ch * 8) * XA_VSTR + m * 2);
                vt[0 * (XA_VSTR / 2)] = (unsigned short)(v.x & 0xffff); vt[1 * (XA_VSTR / 2)] = (unsigned short)(v.x >> 16); vt[2 * (XA_VSTR / 2)] = (unsigned short)(v.y & 0xffff); vt[3 * (XA_VSTR / 2)] = (unsigned short)(v.y >> 16);
                vt[4 * (XA_VSTR / 2)] = (unsigned short)(v.z & 0xffff); vt[5 * (XA_VSTR / 2)] = (unsigned short)(v.z >> 16); vt[6 * (XA_VSTR / 2)] = (unsigned short)(v.w & 0xffff); vt[7 * (XA_VSTR / 2)] = (unsigned short)(v.w >> 16); }
            __syncthreads(); lastbh = bh; }
        const size_t row = (size_t)b * SEQ + qb * 256 + wid * 32 + r32;
        bf16x8 qf[8];
#pragma unroll
        for (int kd = 0; kd < 8; ++kd) qf[kd] = *(const bf16x8*)(Qb + row * XW + h * XD + 16 * kd + 8 * hi);
        f32x16 o[4];
#pragma unroll
        for (int dt = 0; dt < 4; ++dt)
#pragma unroll
            for (int r = 0; r < 16; ++r) o[dt][r] = 0.f;
        float mrun = -1e30f, lrun = 0.f;
#pragma unroll 1
        for (int c = 0; c < 4; ++c) {
            f32x16 s0, s1;
#pragma unroll
            for (int r = 0; r < 16; ++r) { s0[r] = 0.f; s1[r] = 0.f; }
            const int kv0 = c * 64 + r32, kv1 = kv0 + 32;
#pragma unroll
            for (int kd = 0; kd < 8; ++kd) { const int ch = 2 * kd + hi;
                const bf16x8 k0 = *(const LAS bf16x8*)(L + kv0 * 256 + ((ch ^ (kv0 & 15)) << 4)), k1 = *(const LAS bf16x8*)(L + kv1 * 256 + ((ch ^ (kv1 & 15)) << 4));
                s0 = __builtin_amdgcn_mfma_f32_32x32x16_bf16(k0, qf[kd], s0, 0, 0, 0); s1 = __builtin_amdgcn_mfma_f32_32x32x16_bf16(k1, qf[kd], s1, 0, 0, 0); }
            float mx = fmaxf(s0[0], s1[0]);
#pragma unroll
            for (int r = 1; r < 16; ++r) mx = fmaxf(mx, fmaxf(s0[r], s1[r]));
            mx = fmaxf(mx, __shfl_xor(mx, 32));
            const float mn = fmaxf(mrun, mx), sc = __builtin_amdgcn_exp2f(mrun - mn); mrun = mn;
            float ls = 0.f;
#pragma unroll
            for (int r = 0; r < 16; ++r) { s0[r] = __builtin_amdgcn_exp2f(s0[r] - mn); s1[r] = __builtin_amdgcn_exp2f(s1[r] - mn); ls += s0[r] + s1[r]; }
            ls += __shfl_xor(ls, 32); lrun = lrun * sc + ls;
#pragma unroll
            for (int dt = 0; dt < 4; ++dt)
#pragma unroll
                for (int r = 0; r < 16; ++r) o[dt][r] *= sc;
            bf16x8 pf[4]; pf[0] = pack8(s0, 0); pf[1] = pack8(s0, 8); pf[2] = pack8(s1, 0); pf[3] = pack8(s1, 8);
#pragma unroll
            for (int dt = 0; dt < 4; ++dt)
#pragma unroll
                for (int ks = 0; ks < 4; ++ks) { const LAS unsigned char* vp = L + XA_VT + (dt * 32 + r32) * XA_VSTR + (c * 64 + 16 * ks + 4 * hi) * 2;
                    const u32x2 lo = *(const LAS u32x2*)vp, hh = *(const LAS u32x2*)(vp + 16); u32x4 w; w.x = lo.x; w.y = lo.y; w.z = hh.x; w.w = hh.y;
                    o[dt] = __builtin_amdgcn_mfma_f32_32x32x16_bf16(__builtin_bit_cast(bf16x8, w), pf[ks], o[dt], 0, 0, 0); }
        }
        const float il = 1.0f / lrun;
        bf16_t* op = Ob + row * XW + h * XD + 4 * hi;
#pragma unroll
        for (int dt = 0; dt < 4; ++dt)
#pragma unroll
            for (int g4 = 0; g4 < 4; ++g4) { u32x2 w; w.x = pg8::cvt_pk_bf16(o[dt][4 * g4] * il, o[dt][4 * g4 + 1] * il); w.y = pg8::cvt_pk_bf16(o[dt][4 * g4 + 2] * il, o[dt][4 * g4 + 3] * il);
                *(u32x2*)(op + dt * 32 + 8 * g4) = w; }
    }
    __syncthreads();
}

constexpr int RT_WSTR = 1028, RT_LG = NE * RT_WSTR * 4  , RT_LCNT = RT_LG + 8 * 16 * 33 * 4  , RT_LBASE = RT_LCNT + 128;
typedef float f32x4v __attribute__((ext_vector_type(4)));
__device__ __forceinline__ void phase_router_mfma(Frame& F) {
    LAS float* wt = (LAS float*)F.lds;
    __syncthreads();
    for (int c = F.tid; c < NE * DM; c += 512) { const int k = c >> 5, e = c & 31; wt[e * RT_WSTR + k] = F.in[I_WROUTER][c] * F.in[I_GMOE][k]; }
    LAS unsigned* lcnt = (LAS unsigned*)(F.lds + RT_LCNT); LAS unsigned* lbase = (LAS unsigned*)(F.lds + RT_LBASE);
    const int lane = F.lane, wid = F.wave, row = lane & 15, kq = lane >> 4;
    LAS float* lg = (LAS float*)(F.lds + RT_LG) + wid * (16 * 33);
    const float* H = WSP(float, WS_H); unsigned* cnt = F.ctl + CW_CNT;
    for (int chunk = F.bid; chunk < T_ / 128; chunk += F.G) {
        if (F.tid < 32) lcnt[F.tid] = 0u;
        __syncthreads();
        const int tok0 = chunk * 128 + wid * 16;
        f32x4 acc0 = {0.f, 0.f, 0.f, 0.f}, acc1 = {0.f, 0.f, 0.f, 0.f}; float ss = 0.f;
        const float* hp = H + (size_t)(tok0 + row) * DM + 4 * kq;
        const LAS float* w0 = wt + row * RT_WSTR + 4 * kq; const LAS float* w1 = w0 + 16 * RT_WSTR;
#pragma unroll 4
        for (int i = 0; i < 64; ++i) { const f32x4 a = *(const f32x4*)(hp + 16 * i); const f32x4 b0 = *(const LAS f32x4*)(w0 + 16 * i), b1 = *(const LAS f32x4*)(w1 + 16 * i);
            ss += (a[0] * a[0] + a[1] * a[1]) + (a[2] * a[2] + a[3] * a[3]);
#pragma unroll
            for (int e = 0; e < 4; ++e) { acc0 = __builtin_amdgcn_mfma_f32_16x16x4f32(a[e], b0[e], acc0, 0, 0, 0); acc1 = __builtin_amdgcn_mfma_f32_16x16x4f32(a[e], b1[e], acc1, 0, 0, 0); } }
        ss += __shfl_xor(ss, 16); ss += __shfl_xor(ss, 32);
        const float rstd = 1.0f / sqrtf(ss * (1.0f / DM) + RMS_EPS);
#pragma unroll
        for (int r = 0; r < 4; ++r) { lg[(4 * kq + r) * 33 + row] = acc0[r]; lg[(4 * kq + r) * 33 + 16 + row] = acc1[r]; }
        asm volatile("s_waitcnt lgkmcnt(0)" ::: "memory");
        int ex[4] = {0, 0, 0, 0}; unsigned lrank[4] = {0u, 0u, 0u, 0u}; const int tk = tok0 + lane;
        if (lane < 16) {
            float v[32];
#pragma unroll
            for (int e = 0; e < 32; ++e) v[e] = lg[lane * 33 + e] * rstd + F.in[I_BROUTER][e];
            float tv[4];
#pragma unroll
            for (int s = 0; s < 4; ++s) { float bv = v[0]; int bi = 0;
#pragma unroll
                for (int e = 1; e < 32; ++e) if (v[e] > bv) { bv = v[e]; bi = e; }
#pragma unroll
                for (int e = 0; e < 32; ++e) v[e] = (e == bi) ? -3e38f : v[e];
                tv[s] = bv; ex[s] = bi; }
            const float e1 = __expf(tv[1] - tv[0]), e2 = __expf(tv[2] - tv[0]), e3 = __expf(tv[3] - tv[0]); const float inv = 1.0f / (1.0f + e1 + e2 + e3);
            WSP(float, WS_RSTD2)[tk] = rstd;
            *(f32x4*)(WSP(float, WS_TKG) + (size_t)tk * 4) = (f32x4){inv, e1 * inv, e2 * inv, e3 * inv};
#pragma unroll
            for (int s = 0; s < 4; ++s) lrank[s] = __hip_atomic_fetch_add(&lcnt[ex[s]], 1u, __ATOMIC_RELAXED, __HIP_MEMORY_SCOPE_WORKGROUP);
        }
        __syncthreads();
        if (F.tid < 32) lbase[F.tid] = atomicAdd(&cnt[F.tid], lcnt[F.tid]);
        __syncthreads();
        if (lane < 16) {
#pragma unroll
            for (int s = 0; s < 4; ++s) WSP(int, WS_ROWLIST)[(size_t)ex[s] * T_ + lbase[ex[s]] + lrank[s]] = tk * 4 + s; }
        __syncthreads();
    }
}

__device__ __forceinline__ void phase_final(Frame& F) {
    const int gw = F.bid * 8 + F.wave, NGW = F.G * 8, lane = F.lane;
    const float* H = WSP(float, WS_H); const bf16_t* Y = WSP(bf16_t, WS_Y);
    for (int tk = gw; tk < T_; tk += NGW) {
        const f32x4* hp = (const f32x4*)(H + (size_t)tk * DM) + lane; f32x4 hv[4];
#pragma unroll
        for (int j = 0; j < 4; ++j) hv[j] = hp[64 * j];
#pragma unroll
        for (int s = 0; s < 4; ++s) { const u32x2* yp = (const u32x2*)(Y + ((size_t)tk * 4 + s) * DM) + lane;
#pragma unroll
            for (int j = 0; j < 4; ++j) { const u32x2 w = yp[64 * j]; hv[j][0] += bflo(w.x); hv[j][1] += bfhi(w.x); hv[j][2] += bflo(w.y); hv[j][3] += bfhi(w.y); } }
        float ss = 0.f;
#pragma unroll
        for (int j = 0; j < 4; ++j) ss += (hv[j][0] * hv[j][0] + hv[j][1] * hv[j][1]) + (hv[j][2] * hv[j][2] + hv[j][3] * hv[j][3]);
        float rstd = 1.0f / sqrtf(wave_sum(ss) * (1.0f / DM) + RMS_EPS);
#if DBG_STAGE
        { const float sd = __hip_atomic_load((float*)(F.ctl + CW_DBG), RLX_AGENT), sr = __hip_atomic_load((float*)(F.ctl + CW_DBG + 1), RLX_AGENT); rstd *= 1.0f + sqrtf(100.0f * sd / fmaxf(sr, 1e-30f)); }
#endif
        f32x4* op = (f32x4*)(F.out + (size_t)tk * DM) + lane;
#pragma unroll
        for (int j = 0; j < 4; ++j) op[64 * j] = hv[j] * rstd * ((const f32x4*)F.in[I_GFINAL])[lane + 64 * j];
    }
}


__device__ __forceinline__ void dbg_compare(Frame& F, const bf16_t* A, const bf16_t* R, size_t n) {
    float sd = 0.f, sr = 0.f;
    for (size_t i = (size_t)F.bid * 512 + F.tid; i < n; i += (size_t)F.G * 512) { const float a = bf2f(A[i]), r = bf2f(R[i]); sd += (a - r) * (a - r); sr += r * r; }
    sd = wave_sum(sd); sr = wave_sum(sr);
    if (F.lane == 0) { atomicAdd((float*)(F.ctl + CW_DBG), sd); atomicAdd((float*)(F.ctl + CW_DBG + 1), sr); }
}
constexpr int N_PHASES = 15;
__global__ void __launch_bounds__(512, 2) mega_fwd(Args args) {
    extern __shared__ __attribute__((aligned(16))) unsigned char lds_raw[];
    Frame F;
    F.lds = (LAS unsigned char*)lds_raw; F.tid = threadIdx.x; F.lane = F.tid & 63; F.wave = __builtin_amdgcn_readfirstlane(F.tid >> 6); F.G = gridDim.x; F.bid = blockIdx.x;
#pragma unroll
    for (int i = 0; i < 28; ++i) F.in[i] = args.in[i];
    F.out = args.out; F.ws = args.ws; F.ctl = (unsigned*)(args.ws + WS_CTL);
    volatile LAS unsigned* MISC = (volatile LAS unsigned*)(F.lds + MISC_OFF);
    if (F.tid < 64) MISC[F.tid] = 0u;
    __syncthreads();
    const int lo = args.ph_lo, hi = args.ph_hi;
    XcdBarrier bar; bar.bar = F.ctl + CW_BAR; bar.x = 0; bar.st = nullptr;
    if (hi - lo > 1) bar = xcd_barrier_post(F.ctl + CW_BAR, MISC + 8);
#define IN(k) (lo <= (k) && (k) < hi)
#define SEAM(k) do { if (IN(k) && IN((k) + 1)) xcd_barrier(bar); } while (0)
    LAS unsigned char* ring = F.lds;
    const LAS int* gidx = (const LAS int*)(F.lds + GIDX_OFF);

    if (IN(0)) { for (int tk = F.bid; tk < NG * 8; tk += F.G) p0_ssm_tables(F, tk); phase_prologue(F); } SEAM(0);
    if (IN(1)) {
        { pg8::Gemm g{WSP(bf16_t, WS_XB), WSP(bf16_t, WS_WIN), DM, 0}; pg8::PatchOrder S; S.init(T_ / 256, INW / 256, 8, F.G, F.bid);
          pg8::EpiInProj E{WSP(float, WS_RSTD0), WSP(bf16_t, WS_Q), WSP(bf16_t, WS_K), WSP(bf16_t, WS_V), WSP(bf16_t, WS_U), WSP(bf16_t, WS_SGA), WSP(bf16_t, WS_SGB)};
          pg8::gemm_phase<pg8::EpiInProj, pg8::PatchOrder, false>(ring, g, S, E, gidx); }
        { pg8::Gemm g{WSP(bf16_t, WS_MN), WSP(bf16_t, WS_WXKV), DM, 0}; pg8::PatchOrder S; S.init(NB * MEML / 256, 2 * XW / 256, 4, F.G, F.bid);
          pg8::EpiStore E{WSP(bf16_t, WS_MKV), 2 * XW};
          pg8::gemm_phase<pg8::EpiStore, pg8::PatchOrder, false>(ring, g, S, E, gidx); }
    } SEAM(1);
    if (IN(2)) { phase_kmean(F); } SEAM(2);
    if (IN(3)) {
        for (int it = F.bid; it < NB * NG; it += F.G) ssm_state_item(F, it / NG, it % NG);
        const attn_body::AttnTensors AT{(const attn_body::bf16*)WSP(bf16_t, WS_Q), (const attn_body::bf16*)WSP(bf16_t, WS_K), (const attn_body::bf16*)WSP(bf16_t, WS_V), (attn_body::bf16*)WSP(bf16_t, WS_ATT), WSP(float, WS_KMEAN)};
        const attn_body::StaticOrder SO((int)F.G, (int)F.bid);
        attn_body::attn_phase<attn_body::StaticOrder>((char*)lds_raw, AT, SO);
    } SEAM(3);
    if (IN(4)) { phase_ssm_out(F); } SEAM(4);
#if DBG_STAGE == 1
    phase_ssm_simple(F, WSP(bf16_t, WS_MERGED)); xcd_barrier(bar); dbg_compare(F, WSP(bf16_t, WS_YB), WSP(bf16_t, WS_MERGED), (size_t)T_ * SW); xcd_barrier(bar);
#elif DBG_STAGE == 2
    phase_moba_simple(F, WSP(bf16_t, WS_MERGED)); xcd_barrier(bar); dbg_compare(F, WSP(bf16_t, WS_ATT), WSP(bf16_t, WS_MERGED), (size_t)T_ * AW); xcd_barrier(bar);
#endif
    if (IN(5)) {
        pg8::Gemm g{WSP(bf16_t, WS_YB), WSP(bf16_t, WS_WGLU), SW, 0}; pg8::PatchOrder S; S.init(T_ / 256, 2 * DM / 256, 8, F.G, F.bid);
        pg8::EpiGlu E{WSP(bf16_t, WS_SGB), WSP(bf16_t, WS_YB2S)};
        pg8::gemm_phase<pg8::EpiGlu, pg8::PatchOrder, false>(ring, g, S, E, gidx);
    } SEAM(5);
    if (IN(6)) {
        pg8::Gemm g{WSP(bf16_t, WS_ATT), WSP(bf16_t, WS_WPA), AW, 0}; pg8::PatchOrder S; S.init(T_ / 256, DM / 256, 4, F.G, F.bid);
        pg8::EpiMerge E{WSP(bf16_t, WS_SGA), WSP(bf16_t, WS_YB2S), WSP(bf16_t, WS_MERGED)};
        pg8::gemm_phase<pg8::EpiMerge, pg8::PatchOrder, false>(ring, g, S, E, gidx);
    } SEAM(6);
    if (IN(7)) {
        pg8::Gemm g{WSP(bf16_t, WS_MERGED), WSP(bf16_t, WS_WOUT), DM, 0}; pg8::PatchOrder S; S.init(T_ / 256, DM / 256, 4, F.G, F.bid);
        pg8::EpiResid E{F.in[I_X], WSP(float, WS_H), WSP(bf16_t, WS_HB), WSP(float, WS_SSQ1)};
        pg8::gemm_phase<pg8::EpiResid, pg8::PatchOrder, false>(ring, g, S, E, gidx);
    } SEAM(7);
    if (IN(8)) {
        pg8::Gemm g{WSP(bf16_t, WS_HB), WSP(bf16_t, WS_WXQ), DM, 0}; pg8::PatchOrder S; S.init(T_ / 256, XW / 256, 2, F.G, F.bid);
        pg8::EpiXq E{WSP(float, WS_SSQ1), WSP(bf16_t, WS_XQ)};
        pg8::gemm_phase<pg8::EpiXq, pg8::PatchOrder, false>(ring, g, S, E, gidx);
    } SEAM(8);
    if (IN(9)) { phase_xattn(F); } SEAM(9);
#if DBG_STAGE == 3
    phase_xattn_simple(F, WSP(bf16_t, WS_MERGED)); xcd_barrier(bar); dbg_compare(F, WSP(bf16_t, WS_XO), WSP(bf16_t, WS_MERGED), (size_t)T_ * XW); xcd_barrier(bar);
#endif
    if (IN(10)) {
        pg8::Gemm g{WSP(bf16_t, WS_XO), WSP(bf16_t, WS_WXO), XW, 0}; pg8::PatchOrder S; S.init(T_ / 256, DM / 256, 4, F.G, F.bid);
        pg8::EpiResid E{WSP(float, WS_H), WSP(float, WS_H), WSP(bf16_t, WS_HB), WSP(float, WS_SSQ2)};
        pg8::gemm_phase<pg8::EpiResid, pg8::PatchOrder, false>(ring, g, S, E, gidx);
    } SEAM(10);
    if (IN(11)) { phase_router_mfma(F); } SEAM(11);
    if (IN(12) || IN(13)) {
        LAS int* pref = (LAS int*)(F.lds + MISC_OFF + 256);
        const unsigned* cnt = F.ctl + CW_CNT;
        __syncthreads();
        if (F.tid == 0) { int a = 0; for (int e = 0; e < NE; ++e) { pref[e] = a; a += ((int)__hip_atomic_load(cnt + e, RLX_AGENT) + 255) >> 8; } pref[NE] = a; }
        __syncthreads();
        const int MT = pref[NE];
        if (IN(12)) {
            MoeOrder S; S.P.init(MT, 2 * DFF / 256, 8, F.G, F.bid); S.pref = pref;
            { LAS int* gw_ = (LAS int*)(F.lds + GIDX_OFF); pg8::Unit u;
              for (int i = 0; i < GIDX_UNITS && S.next(i, u); ++i) { const int ce = (int)__hip_atomic_load(cnt + u.e, RLX_AGENT);
                  if (F.tid < 256) { const int rank = u.mi * 256 + F.tid; gw_[i * 256 + F.tid] = (rank < ce) ? (WSP(int, WS_ROWLIST)[(size_t)u.e * T_ + rank] >> 2) : 0; } } }
            __syncthreads();
            pg8::Gemm g{WSP(bf16_t, WS_HB), WSP(bf16_t, WS_WGU), DM, (size_t)2 * DFF * DM};
            pg8::EpiMoe1 E{WSP(float, WS_RSTD2), F.in[I_BGU], WSP(bf16_t, WS_HID), gidx};
            pg8::gemm_phase<pg8::EpiMoe1, MoeOrder, true>(ring, g, S, E, gidx);
        }
        SEAM(12);
        if (IN(13)) {
            MoeOrder S; S.P.init(MT, DM / 256, 4, F.G, F.bid); S.pref = pref;
            pg8::Gemm g{WSP(bf16_t, WS_HID), WSP(bf16_t, WS_WDN), DFF, (size_t)DM * DFF};
            pg8::EpiMoe2 E{F.in[I_BDN], WSP(float, WS_TKG), WSP(int, WS_ROWLIST), cnt, WSP(bf16_t, WS_Y)};
            pg8::gemm_phase<pg8::EpiMoe2, MoeOrder, false>(ring, g, S, E, gidx);
        }
    } SEAM(13);
    if (IN(14)) { phase_final(F); }
#undef IN
#undef SEAM
}

extern "C" void kernel_launch(void* const* d_in, const int* in_sizes, int n_in, void* d_out, int out_size, void* d_ws, size_t ws_size, hipStream_t stream) {
    static int grid = 0;
    if (grid == 0) {
        if (n_in != 28 || in_sizes[0] != T_ * DM || out_size != T_ * DM || ws_size < WS_END) { fprintf(stderr, "kernel_launch: unexpected shapes (n_in %d, in0 %d, out %d, ws %zu)\n", n_in, n_in > 0 ? in_sizes[0] : -1, out_size, ws_size); grid = -1; return; }
        int dev = 0, cus = 0;
        if (hipGetDevice(&dev) != hipSuccess || hipDeviceGetAttribute(&cus, hipDeviceAttributeMultiprocessorCount, dev) != hipSuccess) { grid = -1; return; }
        if (hipFuncSetAttribute((const void*)mega_fwd, hipFuncAttributeMaxDynamicSharedMemorySize, LDS_BYTES) != hipSuccess) { fprintf(stderr, "kernel_launch: hipFuncSetAttribute failed\n"); grid = -1; return; }
        (void)hipGetLastError();
        grid = cus;
    }
    if (grid < 0) return;
    (void)hipMemsetAsync((char*)d_ws + WS_CTL, 0, CTL_ZERO_BYTES, stream);
    Args a{};
    for (int i = 0; i < 28; ++i) a.in[i] = (const float*)d_in[i];
    a.out = (float*)d_out; a.ws = (unsigned char*)d_ws;
#if MK_N_LAUNCHES == 1
    a.ph_lo = 0; a.ph_hi = N_PHASES;
    hipLaunchKernelGGL(mega_fwd, dim3(grid), dim3(512), LDS_BYTES, stream, a);
#else
    for (int p = 0; p < N_PHASES; ++p) { a.ph_lo = p; a.ph_hi = p + 1; hipLaunchKernelGGL(mega_fwd, dim3(grid), dim3(512), LDS_BYTES, stream, a); }
#endif
}
```

```cpp
#include <hip/hip_runtime.h>
#include <hip/hip_bf16.h>
#include <cmath>
#include <cstdio>
#include <cstdint>

#ifndef MK_N_LAUNCHES
#define MK_N_LAUNCHES 1
#endif

#ifndef REP_MASK
#define REP_MASK 0
#endif
#ifndef DBG_STAGE
#define DBG_STAGE 0
#endif

#define GAS __attribute__((address_space(1)))
#define LAS __attribute__((address_space(3)))
typedef unsigned short bf16_t;
typedef short bf16x8 __attribute__((ext_vector_type(8)));
typedef float f32x4 __attribute__((ext_vector_type(4)));
typedef float f32x2 __attribute__((ext_vector_type(2)));
typedef unsigned u32x4 __attribute__((ext_vector_type(4)));
typedef unsigned u32x2 __attribute__((ext_vector_type(2)));

constexpr int NB = 4, SEQ = 8192, DM = 1024, T_ = NB * SEQ;
constexpr int AW = 512, NH = 8, HD = 64, MBLK = 256, NBLK = SEQ / MBLK, MTOPK = 3;
constexpr int SW = 512, SGC = 16, NG = 32, SP = 64;
constexpr int INW = 4096;
constexpr int MEML = 256, XH = 4, XD = 128, XW = 512;
constexpr int NE = 32, ETOPK = 4, DFF = 1024;
constexpr float RMS_EPS = 1e-6f;
constexpr float LOG2E = 1.4426950408889634f;
constexpr float QSCALE = 0.125f * LOG2E;
constexpr float XSCALE = 0.08838834764831845f * LOG2E;
constexpr int HID_ROWS = ETOPK * T_ + NE * 256;

constexpr size_t MiB = 1u << 20;
constexpr size_t WS_WIN = 0 * MiB, WS_WGLU = 8 * MiB, WS_WPA = 10 * MiB, WS_WOUT = 11 * MiB, WS_WXQ = 13 * MiB, WS_WXKV = 14 * MiB, WS_WXO = 16 * MiB,
                 WS_WGU = 17 * MiB, WS_WDN = 145 * MiB;
constexpr size_t WS_CTL = 209 * MiB, CTL_ZERO_BYTES = 1 * MiB;
constexpr size_t WS_RSTD0 = 210 * MiB;
constexpr size_t WS_RSTD2 = WS_RSTD0 + 128 * 1024;
constexpr size_t WS_KMEAN = WS_RSTD2 + 128 * 1024;
constexpr size_t WS_TKG = WS_KMEAN + 256 * 1024;
constexpr size_t WS_SSQ1 = 211 * MiB;
constexpr size_t WS_SSQ2 = 213 * MiB;
constexpr size_t WS_ROWLIST = 215 * MiB;
constexpr size_t WS_MN = 219 * MiB;
constexpr size_t WS_MKV = 221 * MiB;
constexpr size_t WS_WST = 225 * MiB;
constexpr size_t WS_GT = 233 * MiB;
constexpr size_t WS_KT = 241 * MiB;
constexpr size_t WS_LAML = 243 * MiB;
constexpr size_t WS_SST = 244 * MiB;
constexpr size_t WS_H = 256 * MiB;
constexpr size_t WS_HB = 384 * MiB;
constexpr size_t WS_HID = 448 * MiB;
constexpr size_t WS_Y = 720 * MiB;
constexpr size_t WS_END = 976 * MiB;
constexpr size_t WS_XB = 448 * MiB, WS_Q = 512 * MiB, WS_K = 544 * MiB, WS_V = 576 * MiB, WS_U = 608 * MiB, WS_ATT = 640 * MiB, WS_YB = 672 * MiB;
constexpr size_t WS_SGA = 720 * MiB, WS_SGB = 784 * MiB, WS_YB2S = 848 * MiB, WS_MERGED = 912 * MiB;
constexpr size_t WS_XQ = 448 * MiB, WS_XO = 480 * MiB;
static_assert(WS_HID + (size_t)HID_ROWS * DFF * 2 <= WS_Y, "HID fits");
constexpr int CW_TMO = 0, CW_CNT = 64  , CW_DBG = 128  , CW_BAR = 4096;

constexpr int RING_BYTES = 131072;
constexpr int GIDX_OFF = RING_BYTES, GIDX_UNITS = 24;
constexpr int MISC_OFF = GIDX_OFF + GIDX_UNITS * 1024;
constexpr int LDS_BYTES = 163840;

#define RLX_AGENT __ATOMIC_RELAXED, __HIP_MEMORY_SCOPE_AGENT
__device__ __forceinline__ unsigned f2bf(float f) { unsigned u = __builtin_bit_cast(unsigned, f); return (u + 0x7fffu + ((u >> 16) & 1u)) >> 16; }
__device__ __forceinline__ unsigned pk2(float lo, float hi) { return f2bf(lo) | (f2bf(hi) << 16); }
__device__ __forceinline__ float bf2f(unsigned short b) { return __builtin_bit_cast(float, (unsigned)b << 16); }
__device__ __forceinline__ float bflo(unsigned w) { return __builtin_bit_cast(float, w << 16); }
__device__ __forceinline__ float bfhi(unsigned w) { return __builtin_bit_cast(float, w & 0xffff0000u); }
__device__ __forceinline__ float wave_sum(float v) {
#pragma unroll
    for (int o = 1; o < 64; o <<= 1) v += __shfl_xor(v, o);
    return v;
}
__device__ __forceinline__ float fsigmoid(float x) { return __builtin_amdgcn_rcpf(1.0f + __builtin_amdgcn_exp2f(-x * LOG2E)); }
__device__ __forceinline__ float gelu_tanh(float x) {
    const float u = 0.7978845608028654f * (x + 0.044715f * x * x * x);
    return x * fsigmoid(2.0f * u);
}

namespace pg8 {
constexpr int BM = 256, BK = 64, HALF = 128, HTB = HALF * BK * 2, STAGE_BYTES = 8 * HTB;
__host__ __device__ __forceinline__ int lds_byte(int r, int c) { const int st = (r >> 4) * 2 + (c >> 5), rr = r & 15, cc = c & 31, ob = rr * 64 + cc * 2; return st * 1024 + (ob ^ (((ob >> 9) & 1) << 5)); }
__host__ __device__ __forceinline__ void stage_rc(int b, int& R, int& C) { const int st = b / 1024, sb = b % 1024, swz = sb ^ (((sb >> 9) & 1) << 5); R = (st >> 1) * 16 + swz / 64; C = (st & 1) * 32 + (swz % 64) / 2; }
__host__ __device__ __forceinline__ int perm32(int rho) { const int n = rho >> 4, i = rho & 15; return 8 * (i >> 2) + 4 * n + (i & 3); }

struct Unit { int pm, pn, e, mi, ui; };
struct Gemm { const bf16_t* A; const bf16_t* Bt; int K; size_t b_estride; };

struct PatchOrder {
    int nM, nN, PM, PN, x, j, ok;
    __device__ __forceinline__ void init(int nM_, int nN_, int PN_, int G, int c) { nM = nM_; nN = nN_; PN = PN_; PM = (G / 8) / PN_; x = c & 7; j = c >> 3; ok = ((G & 7) == 0) && (PM * PN == G / 8) && (nN % PN == 0); if (!ok) { x = c; j = G; } }
    __device__ __forceinline__ bool next(int i, Unit& u) const {
        if (!ok) { const long L = (long)i * j + x; if (L >= (long)nM * nN) return false; u.pm = (int)(L / nN); u.pn = (int)(L % nN); u.e = 0; u.mi = u.pm; u.ui = i; return true; }
        const int p = 8 * i + x, npn = nN / PN, pmb = p / npn, pnb = p % npn;
        u.pm = pmb * PM + (j % PM); u.pn = pnb * PN + (j / PM); u.e = 0; u.mi = u.pm; u.ui = i;
        return u.pm < nM;
    }
};

__device__ __forceinline__ unsigned cvt_pk_bf16(float lo, float hi) { unsigned r; asm volatile("v_cvt_pk_bf16_f32 %0, %1, %2" : "=v"(r) : "v"(lo), "v"(hi)); return r; }

template <class Epi, class Sched, bool GATHER>
__device__ __forceinline__ void gemm_phase(LAS unsigned char* lds, const Gemm g, const Sched& S, const Epi& E, const LAS int* gidx) {
    const int tid = threadIdx.x, wid = __builtin_amdgcn_readfirstlane(tid >> 6), lane = tid & 63, wr = wid >> 2, wc = wid & 3, fr = lane & 15, fq = lane >> 4;
    const int K = g.K, nt = K / BK;
    int Ra[2], Ca[2]; unsigned voffB[2];
#pragma unroll
    for (int i = 0; i < 2; ++i) { int R, C; stage_rc(tid * 16 + i * 8192, R, C); const int Rb = Epi::PERM ? ((R & ~31) + perm32(R & 31)) : R;
        Ra[i] = R; Ca[i] = C; voffB[i] = (unsigned)(Rb * K + C) * 2u; }
    const size_t kstep = (size_t)(BK * 2);
    const size_t hstep = (size_t)HALF * K * 2;
    const size_t tstep = 2 * hstep;
    const unsigned ldsw = (unsigned)wid * 1024u;
    const int aoff = lds_byte(wr * 64 + fr, fq * 8), boff = lds_byte(wc * 32 + fr, fq * 8);
#define PG8_SA(b, h) (((b) * 2 + (h)) * HTB)
#define PG8_SB(b, h) ((4 + (b) * 2 + (h)) * HTB)
#define PG8_STAGE(bufoff, gbase, voff) do { _Pragma("unroll") for (int _i = 0; _i < 2; ++_i) \
        __builtin_amdgcn_global_load_lds((const unsigned*)((const char*)(gbase) + (voff)[_i]), (LAS unsigned*)(lds + (bufoff) + ldsw + _i * 8192), 16, 0, 0); } while (0)
#define PG8_LDA(dst, b, h) do { _Pragma("unroll") for (int m = 0; m < 4; ++m) _Pragma("unroll") for (int k = 0; k < 2; ++k) dst[m][k] = *(const LAS bf16x8*)(lds + PG8_SA(b, h) + aoff + m * 2048 + k * 1024); } while (0)
#define PG8_LDB(dst, b, h) do { _Pragma("unroll") for (int n = 0; n < 2; ++n) _Pragma("unroll") for (int k = 0; k < 2; ++k) dst[n][k] = *(const LAS bf16x8*)(lds + PG8_SB(b, h) + boff + n * 2048 + k * 1024); } while (0)
#define PG8_MMA(ai, bj, At, Bt) do { __builtin_amdgcn_s_setprio(1); _Pragma("unroll") for (int m = 0; m < 4; ++m) _Pragma("unroll") for (int n = 0; n < 2; ++n) _Pragma("unroll") for (int k = 0; k < 2; ++k) \
        acc[ai][bj][m][n] = __builtin_amdgcn_mfma_f32_16x16x32_bf16(Bt[n][k], At[m][k], acc[ai][bj][m][n], 0, 0, 0); __builtin_amdgcn_s_setprio(0); } while (0)
#define PG8_WAIT_V(n) asm volatile("s_waitcnt vmcnt(" #n ")" ::: "memory")
#define PG8_WAIT_L(n) asm volatile("s_waitcnt lgkmcnt(" #n ")" ::: "memory")
#define PG8_BAR __builtin_amdgcn_s_barrier()
#define PG8_SCHED __builtin_amdgcn_sched_barrier(0)
#define PG8_VOA(dst, u) do { _Pragma("unroll") for (int _h = 0; _h < 2; ++_h) _Pragma("unroll") for (int _i = 0; _i < 2; ++_i) { \
        const int _row = GATHER ? gidx[(u).ui * 256 + _h * HALF + Ra[_i]] : (_h * HALF + Ra[_i]); dst[_h][_i] = (unsigned)(_row * K + Ca[_i]) * 2u; } } while (0)
    Unit cur, nxt; int ui = 0;
    if (!S.next(0, cur)) return;
    f32x4 acc[2][2][4][2];
#pragma unroll
    for (int a = 0; a < 2; ++a)
#pragma unroll
        for (int b = 0; b < 2; ++b)
#pragma unroll
            for (int m = 0; m < 4; ++m)
#pragma unroll
                for (int n = 0; n < 2; ++n) acc[a][b][m][n] = (f32x4){0.f, 0.f, 0.f, 0.f};
    bf16x8 At[4][2], B0[2][2], B1[2][2];
    unsigned voA[2][2], voN[2][2];
    PG8_VOA(voA, cur);
    const char* cA = (const char*)g.A + (GATHER ? (size_t)0 : (size_t)cur.pm * tstep);
    const char* cB = (const char*)g.Bt + ((size_t)cur.e * g.b_estride) * 2 + (size_t)cur.pn * tstep;
    PG8_STAGE(PG8_SB(0, 0), cB, voffB); PG8_STAGE(PG8_SB(0, 1), cB + hstep, voffB); PG8_STAGE(PG8_SA(0, 0), cA, voA[0]); PG8_STAGE(PG8_SA(0, 1), cA, voA[1]);
    if (wr == 1) PG8_BAR;
    PG8_WAIT_V(2); PG8_BAR;
    PG8_STAGE(PG8_SB(1, 0), cB + kstep, voffB); PG8_STAGE(PG8_SA(1, 0), cA + kstep, voA[0]); PG8_STAGE(PG8_SB(1, 1), cB + hstep + kstep, voffB);
    PG8_WAIT_V(6); PG8_BAR;
    for (;;) {
        const bool has_next = S.next(ui + 1, nxt);
        const char* nA = cA; const char* nB = cB;
#pragma unroll
        for (int h = 0; h < 2; ++h)
#pragma unroll
            for (int i = 0; i < 2; ++i) voN[h][i] = voA[h][i];
        if (has_next) { nA = (const char*)g.A + (GATHER ? (size_t)0 : (size_t)nxt.pm * tstep); nB = (const char*)g.Bt + ((size_t)nxt.e * g.b_estride) * 2 + (size_t)nxt.pn * tstep; PG8_VOA(voN, nxt); }
        for (int t = 0; t < nt; t += 2) {
            const bool last = (t == nt - 2);
            const char* a1 = cA + (size_t)(t + 1) * kstep;
            const char* a2 = last ? nA : cA + (size_t)(t + 2) * kstep; const char* b2 = last ? nB : cB + (size_t)(t + 2) * kstep;
            const char* a3 = a2 + kstep; const char* b3 = b2 + kstep;
            unsigned vo2[2][2];
#pragma unroll
            for (int h = 0; h < 2; ++h)
#pragma unroll
                for (int i = 0; i < 2; ++i) vo2[h][i] = last ? voN[h][i] : voA[h][i];
            PG8_LDB(B0, 0, 0); PG8_LDB(B1, 0, 1); PG8_SCHED; PG8_LDA(At, 0, 0); PG8_STAGE(PG8_SA(1, 1), a1, voA[1]);
            PG8_WAIT_V(8); PG8_WAIT_L(0); PG8_BAR; PG8_MMA(0, 0, At, B0); PG8_MMA(0, 1, At, B1); PG8_BAR; PG8_SCHED;
            PG8_LDA(At, 0, 1); PG8_STAGE(PG8_SB(0, 0), b2, voffB); PG8_STAGE(PG8_SB(0, 1), b2 + hstep, voffB); PG8_STAGE(PG8_SA(0, 0), a2, vo2[0]);
            PG8_WAIT_V(8); PG8_WAIT_L(0); PG8_BAR; PG8_MMA(1, 0, At, B0); PG8_MMA(1, 1, At, B1); PG8_BAR; PG8_SCHED;
            PG8_LDB(B0, 1, 0); PG8_LDB(B1, 1, 1); PG8_SCHED; PG8_LDA(At, 1, 0); PG8_STAGE(PG8_SA(0, 1), a2, vo2[1]);
            PG8_WAIT_V(8); PG8_WAIT_L(0); PG8_BAR; PG8_MMA(0, 0, At, B0); PG8_MMA(0, 1, At, B1); PG8_BAR; PG8_SCHED;
            PG8_LDA(At, 1, 1); PG8_STAGE(PG8_SB(1, 0), b3, voffB); PG8_STAGE(PG8_SB(1, 1), b3 + hstep, voffB); PG8_STAGE(PG8_SA(1, 0), a3, vo2[0]);
            PG8_WAIT_V(8); PG8_WAIT_L(0); PG8_BAR; PG8_MMA(1, 0, At, B0); PG8_MMA(1, 1, At, B1); PG8_BAR; PG8_SCHED;
        }
        if (wr == 0) PG8_BAR;
        E(acc, cur, wr, wc, fr, fq);
        if (!has_next) break;
#pragma unroll
        for (int a = 0; a < 2; ++a)
#pragma unroll
            for (int b = 0; b < 2; ++b)
#pragma unroll
                for (int m = 0; m < 4; ++m)
#pragma unroll
                    for (int n = 0; n < 2; ++n) acc[a][b][m][n] = (f32x4){0.f, 0.f, 0.f, 0.f};
        cur = nxt; cA = nA; cB = nB; ++ui;
#pragma unroll
        for (int h = 0; h < 2; ++h)
#pragma unroll
            for (int i = 0; i < 2; ++i) voA[h][i] = voN[h][i];
        if (wr == 1) PG8_BAR;
    }
    PG8_WAIT_V(0);
    PG8_BAR;
#undef PG8_SA
#undef PG8_SB
#undef PG8_STAGE
#undef PG8_LDA
#undef PG8_LDB
#undef PG8_MMA
#undef PG8_WAIT_V
#undef PG8_WAIT_L
#undef PG8_BAR
#undef PG8_SCHED
#undef PG8_VOA
}

typedef const f32x4 (&AccRef)[2][2][4][2];
#define EPI_ROWS for (int ai = 0; ai < 2; ++ai) _Pragma("unroll") for (int m = 0; m < 4; ++m)

struct EpiInProj {
    static constexpr bool PERM = true;
    const float* rstd; bf16_t *Q, *Kb, *V, *U, *SGA, *SGB;
    __device__ __forceinline__ void operator()(AccRef acc, const Unit& u, int wr, int wc, int fr, int fq) const {
        bf16_t* dst; int ld, colt; bool sig = false; float sc = 1.f;
        if (u.pn < 2) { dst = Q; ld = AW; colt = u.pn * 256; sc = QSCALE; }
        else if (u.pn < 4) { dst = Kb; ld = AW; colt = (u.pn - 2) * 256; }
        else if (u.pn < 6) { dst = V; ld = AW; colt = (u.pn - 4) * 256; }
        else if (u.pn < 8) { dst = U; ld = AW; colt = (u.pn - 6) * 256; }
        else if (u.pn < 12) { dst = SGA; ld = DM; colt = (u.pn - 8) * 256; sig = true; }
        else { dst = SGB; ld = DM; colt = (u.pn - 12) * 256; sig = true; }
        const int row0 = u.pm * BM + wr * 64 + fr, col0 = colt + wc * 32 + 8 * fq;
#pragma unroll
        EPI_ROWS { const int row = row0 + ai * HALF + m * 16; const float rs = rstd[row] * sc; bf16_t* rowp = dst + (size_t)row * ld + col0;
#pragma unroll
            for (int bj = 0; bj < 2; ++bj) { f32x4 v0 = acc[ai][bj][m][0] * rs, v1 = acc[ai][bj][m][1] * rs;
                if (sig) {
#pragma unroll
                    for (int e = 0; e < 4; ++e) { v0[e] = fsigmoid(v0[e]); v1[e] = fsigmoid(v1[e]); } }
                u32x4 w; w.x = cvt_pk_bf16(v0[0], v0[1]); w.y = cvt_pk_bf16(v0[2], v0[3]); w.z = cvt_pk_bf16(v1[0], v1[1]); w.w = cvt_pk_bf16(v1[2], v1[3]);
                *(u32x4*)(rowp + bj * HALF) = w; } }
    }
};
struct EpiStore {
    static constexpr bool PERM = true;
    bf16_t* O; int ld;
    __device__ __forceinline__ void operator()(AccRef acc, const Unit& u, int wr, int wc, int fr, int fq) const {
        const int row0 = u.pm * BM + wr * 64 + fr, col0 = u.pn * BM + wc * 32 + 8 * fq;
#pragma unroll
        EPI_ROWS { bf16_t* rowp = O + (size_t)(row0 + ai * HALF + m * 16) * ld + col0;
#pragma unroll
            for (int bj = 0; bj < 2; ++bj) { const f32x4 v0 = acc[ai][bj][m][0], v1 = acc[ai][bj][m][1];
                u32x4 w; w.x = cvt_pk_bf16(v0[0], v0[1]); w.y = cvt_pk_bf16(v0[2], v0[3]); w.z = cvt_pk_bf16(v1[0], v1[1]); w.w = cvt_pk_bf16(v1[2], v1[3]);
                *(u32x4*)(rowp + bj * HALF) = w; } }
    }
};
struct EpiGlu {
    static constexpr bool PERM = true;
    const bf16_t* SGB; bf16_t* O;
    __device__ __forceinline__ void operator()(AccRef acc, const Unit& u, int wr, int wc, int fr, int fq) const {
        const int row0 = u.pm * BM + wr * 64 + fr, col0 = u.pn * HALF + wc * 32 + 8 * fq;
#pragma unroll
        EPI_ROWS { const size_t off = (size_t)(row0 + ai * HALF + m * 16) * DM + col0; const u32x4 s = *(const u32x4*)(SGB + off);
            const f32x4 v0 = acc[ai][0][m][0], v1 = acc[ai][0][m][1], g0 = acc[ai][1][m][0], g1 = acc[ai][1][m][1];
            float o[8];
#pragma unroll
            for (int e = 0; e < 4; ++e) { o[e] = v0[e] * fsigmoid(g0[e]); o[4 + e] = v1[e] * fsigmoid(g1[e]); }
            o[0] *= bflo(s.x); o[1] *= bfhi(s.x); o[2] *= bflo(s.y); o[3] *= bfhi(s.y); o[4] *= bflo(s.z); o[5] *= bfhi(s.z); o[6] *= bflo(s.w); o[7] *= bfhi(s.w);
            u32x4 w; w.x = cvt_pk_bf16(o[0], o[1]); w.y = cvt_pk_bf16(o[2], o[3]); w.z = cvt_pk_bf16(o[4], o[5]); w.w = cvt_pk_bf16(o[6], o[7]);
            *(u32x4*)(O + off) = w; }
    }
};
struct EpiMerge {
    static constexpr bool PERM = true;
    const bf16_t* SGA; const bf16_t* Y2; bf16_t* O;
    __device__ __forceinline__ void operator()(AccRef acc, const Unit& u, int wr, int wc, int fr, int fq) const {
        const int row0 = u.pm * BM + wr * 64 + fr, col0 = u.pn * BM + wc * 32 + 8 * fq;
#pragma unroll
        EPI_ROWS {
#pragma unroll
            for (int bj = 0; bj < 2; ++bj) { const size_t off = (size_t)(row0 + ai * HALF + m * 16) * DM + col0 + bj * HALF;
                const u32x4 s = *(const u32x4*)(SGA + off), y = *(const u32x4*)(Y2 + off); const f32x4 v0 = acc[ai][bj][m][0], v1 = acc[ai][bj][m][1];
                u32x4 w; w.x = cvt_pk_bf16(bflo(s.x) * v0[0] + bflo(y.x), bfhi(s.x) * v0[1] + bfhi(y.x)); w.y = cvt_pk_bf16(bflo(s.y) * v0[2] + bflo(y.y), bfhi(s.y) * v0[3] + bfhi(y.y));
                w.z = cvt_pk_bf16(bflo(s.z) * v1[0] + bflo(y.z), bfhi(s.z) * v1[1] + bfhi(y.z)); w.w = cvt_pk_bf16(bflo(s.w) * v1[2] + bflo(y.w), bfhi(s.w) * v1[3] + bfhi(y.w));
                *(u32x4*)(O + off) = w; } }
    }
};
struct EpiResid {
    static constexpr bool PERM = false;
    const float* base; float* H; bf16_t* HB; float* SSQ;
    __device__ __forceinline__ void operator()(AccRef acc, const Unit& u, int wr, int wc, int fr, int fq) const {
        const int row0 = u.pm * BM + wr * 64 + fr, col0 = u.pn * BM + wc * 32 + 4 * fq;
#pragma unroll
        EPI_ROWS { const int row = row0 + ai * HALF + m * 16; const size_t off = (size_t)row * DM + col0; float ss = 0.f;
#pragma unroll
            for (int bj = 0; bj < 2; ++bj)
#pragma unroll
                for (int n = 0; n < 2; ++n) { const size_t o2 = off + bj * HALF + n * 16; const f32x4 h = *(const f32x4*)(base + o2) + acc[ai][bj][m][n];
                    *(f32x4*)(H + o2) = h; u32x2 w; w.x = cvt_pk_bf16(h[0], h[1]); w.y = cvt_pk_bf16(h[2], h[3]); *(u32x2*)(HB + o2) = w;
                    ss += (h[0] * h[0] + h[1] * h[1]) + (h[2] * h[2] + h[3] * h[3]); }
            ss += __shfl_xor(ss, 16); ss += __shfl_xor(ss, 32);
            if (fq == 0) SSQ[(size_t)row * 16 + u.pn * 4 + wc] = ss; }
    }
};
struct EpiXq {
    static constexpr bool PERM = true;
    const float* SSQ; bf16_t* O;
    __device__ __forceinline__ void operator()(AccRef acc, const Unit& u, int wr, int wc, int fr, int fq) const {
        const int row0 = u.pm * BM + wr * 64 + fr, col0 = u.pn * BM + wc * 32 + 8 * fq;
#pragma unroll
        EPI_ROWS { const int row = row0 + ai * HALF + m * 16; const f32x4* sp = (const f32x4*)(SSQ + (size_t)row * 16);
            const f32x4 a = sp[0] + sp[1] + sp[2] + sp[3]; const float rs = __builtin_amdgcn_rsqf(((a[0] + a[1]) + (a[2] + a[3])) * (1.0f / DM) + RMS_EPS) * XSCALE;
            bf16_t* rowp = O + (size_t)row * XW + col0;
#pragma unroll
            for (int bj = 0; bj < 2; ++bj) { const f32x4 v0 = acc[ai][bj][m][0] * rs, v1 = acc[ai][bj][m][1] * rs;
                u32x4 w; w.x = cvt_pk_bf16(v0[0], v0[1]); w.y = cvt_pk_bf16(v0[2], v0[3]); w.z = cvt_pk_bf16(v1[0], v1[1]); w.w = cvt_pk_bf16(v1[2], v1[3]);
                *(u32x4*)(rowp + bj * HALF) = w; } }
    }
};
struct EpiMoe1 {
    static constexpr bool PERM = true;
    const float* rstd2; const float* bgu; bf16_t* HID; const LAS int* gidx;
    __device__ __forceinline__ void operator()(AccRef acc, const Unit& u, int wr, int wc, int fr, int fq) const {
        const int rl0 = wr * 64 + fr, col0 = u.pn * HALF + wc * 32 + 8 * fq; const float* bg = bgu + (size_t)u.e * (2 * DFF) + col0;
        const f32x4 bg0 = *(const f32x4*)(bg), bg1 = *(const f32x4*)(bg + 4), bu0 = *(const f32x4*)(bg + DFF), bu1 = *(const f32x4*)(bg + DFF + 4);
#pragma unroll
        EPI_ROWS { const int rl = rl0 + ai * HALF + m * 16; const float rs = rstd2[gidx[u.ui * 256 + rl]];
            const f32x4 g0 = acc[ai][0][m][0] * rs + bg0, g1 = acc[ai][0][m][1] * rs + bg1, p0 = acc[ai][1][m][0] * rs + bu0, p1 = acc[ai][1][m][1] * rs + bu1;
            float o[8];
#pragma unroll
            for (int e = 0; e < 4; ++e) { const float ga = fminf(g0[e], 7.0f), gb = fminf(g1[e], 7.0f), ua = fminf(fmaxf(p0[e], -7.0f), 7.0f), ub = fminf(fmaxf(p1[e], -7.0f), 7.0f);
                o[e] = (ua + 1.0f) * ga * fsigmoid(1.702f * ga); o[4 + e] = (ub + 1.0f) * gb * fsigmoid(1.702f * gb); }
            u32x4 w; w.x = cvt_pk_bf16(o[0], o[1]); w.y = cvt_pk_bf16(o[2], o[3]); w.z = cvt_pk_bf16(o[4], o[5]); w.w = cvt_pk_bf16(o[6], o[7]);
            *(u32x4*)(HID + (size_t)(u.pm * BM + rl) * DFF + col0) = w; }
    }
};
struct EpiMoe2 {
    static constexpr bool PERM = true;
    const float* bdn; const float* tkg; const int* rowlist; const unsigned* cnt; bf16_t* Y;
    __device__ __forceinline__ void operator()(AccRef acc, const Unit& u, int wr, int wc, int fr, int fq) const {
        const int rl0 = wr * 64 + fr, col0 = u.pn * BM + wc * 32 + 8 * fq; const float* bd = bdn + (size_t)u.e * DM + col0; const int ce = (int)cnt[u.e];
        f32x4 bv[2][2];
#pragma unroll
        for (int bj = 0; bj < 2; ++bj)
#pragma unroll
            for (int n = 0; n < 2; ++n) bv[bj][n] = *(const f32x4*)(bd + bj * HALF + 4 * n);
#pragma unroll
        EPI_ROWS { const int rank = u.mi * BM + rl0 + ai * HALF + m * 16;
            if (rank < ce) { const int dest = rowlist[(size_t)u.e * T_ + rank]; const float gt = tkg[dest]; bf16_t* rowp = Y + (size_t)dest * DM + col0;
#pragma unroll
                for (int bj = 0; bj < 2; ++bj) { const f32x4 v0 = (acc[ai][bj][m][0] + bv[bj][0]) * gt, v1 = (acc[ai][bj][m][1] + bv[bj][1]) * gt;
                    u32x4 w; w.x = cvt_pk_bf16(v0[0], v0[1]); w.y = cvt_pk_bf16(v0[2], v0[3]); w.z = cvt_pk_bf16(v1[0], v1[1]); w.w = cvt_pk_bf16(v1[2], v1[3]);
                    *(u32x4*)(rowp + bj * HALF) = w; } } }
    }
};
}

struct MoeOrder {
    pg8::PatchOrder P; const LAS int* pref;
    __device__ __forceinline__ bool next(int i, pg8::Unit& u) const {
        if (!P.next(i, u)) return false;
        int e = 0;
#pragma unroll 1
        for (int k = 1; k < NE; ++k) e += (pref[k] <= u.pm) ? 1 : 0;
        u.e = e; u.mi = u.pm - pref[e]; return true;
    }
};

namespace attn_body {
using bf16=__hip_bfloat16;
using bf16x8=__attribute__((ext_vector_type(8)))short;
using s16x4=__attribute__((ext_vector_type(4)))short;
using f32x16=__attribute__((ext_vector_type(16)))float;
using u32x4=__attribute__((ext_vector_type(4)))unsigned;
constexpr int BATCH=4,NHEAD=8,SEQ=8192,D=64,DM=NHEAD*D;
constexpr int NW=8,QBLK=32,QB=QBLK*NW,KVBLK=64,NQB=SEQ/QB;
constexpr int ATTN_PITCH=DM, ATTN_UNIT_ROWS=QB;
__device__ __forceinline__ int crow(int r,int hi){return (r&3)+8*(r>>2)+4*hi;}
#define SBAR() __builtin_amdgcn_sched_barrier(0)
__device__ __forceinline__ void cmask(f32x16&p0,f32x16&p1,int jb,int qrel,int hi){
  const float NEG=-INFINITY; int kb=64*jb+4*hi;
  #pragma unroll
  for(int r=0;r<16;++r){int kv=kb+(r&3)+8*(r>>2); if(kv>qrel)p0[r]=NEG; if(kv+32>qrel)p1[r]=NEG;}
}

constexpr int NSLOT=3, SLOTB=8192;
constexpr int LDS_K=0, LDS_V=NSLOT*SLOTB, LDS_WS=2*NSLOT*SLOTB, LDS_OST=LDS_WS+NW*64*4, LDS_KM=LDS_OST+NW*4096, LDS_SEL=LDS_KM+32*64*4, LDS_BYTES=LDS_SEL+1024;
constexpr float C2=0.125f*1.4426950408889634f;
__device__ __forceinline__ void glds16(const void*gsrc,unsigned lds_dst){unsigned keep;
  asm volatile("s_mov_b32 %0, m0\n\ts_mov_b32 m0, %2\n\ts_nop 0\n\tglobal_load_lds_dwordx4 %1, off\n\ts_mov_b32 m0, %0":"=&s"(keep):"v"(gsrc),"s"(lds_dst):"memory");}
__device__ __forceinline__ float max3f(float a,float b,float c){float r;asm("v_max3_f32 %0, %1, %2, %3":"=v"(r):"v"(a),"v"(b),"v"(c));return r;}
__device__ __forceinline__ float max2f(float a,float b){float r;asm("v_max_f32_e32 %0, %1, %2":"=v"(r):"v"(a),"v"(b));return r;}
__device__ __forceinline__ float fadd_s(float a,float b){float r;asm("v_add_f32_e32 %0, %1, %2":"=v"(r):"v"(a),"v"(b));return r;}
__device__ __forceinline__ float fsub_s(float a,float b){float r;asm("v_sub_f32_e32 %0, %1, %2":"=v"(r):"v"(a),"v"(b));return r;}
typedef float f32x2_t __attribute__((ext_vector_type(2))); typedef __bf16 bf16x2_t __attribute__((ext_vector_type(2)));
__device__ __forceinline__ unsigned cvtpk_s(float lo,float hi){f32x2_t v={lo,hi};bf16x2_t b=__builtin_convertvector(v,bf16x2_t);return __builtin_bit_cast(unsigned,b);}
#define WAIT_BAR(N) asm volatile("s_waitcnt vmcnt(" #N ") lgkmcnt(0)\n\ts_barrier":::"memory")

__device__ __forceinline__ void qkt(f32x16&p0,f32x16&p1,const char*Kslot,const bf16x8*qr,const f32x16&negm,int r32,int hi){
  const char*kb=Kslot+hi*1024+r32*16;
  #pragma unroll
  for(int d0=0;d0<4;++d0){
    const bf16x8 b0=*reinterpret_cast<const bf16x8*>(kb+d0*2048);
    const bf16x8 b1=*reinterpret_cast<const bf16x8*>(kb+d0*2048+512);
    if(d0==0){p0=__builtin_amdgcn_mfma_f32_32x32x16_bf16(b0,qr[0],negm,0,0,0);p1=__builtin_amdgcn_mfma_f32_32x32x16_bf16(b1,qr[0],negm,0,0,0);}
    else{p0=__builtin_amdgcn_mfma_f32_32x32x16_bf16(b0,qr[d0],p0,0,0,0);p1=__builtin_amdgcn_mfma_f32_32x32x16_bf16(b1,qr[d0],p1,0,0,0);}}
}
typedef __attribute__((address_space(3))) const char* lds_cptr;
typedef short v4i16_t __attribute__((ext_vector_type(4)));
__device__ __forceinline__ void kload8(bf16x8*kf,lds_cptr kp){
  kf[0]=*(const __attribute__((address_space(3))) bf16x8*)(kp);      kf[1]=*(const __attribute__((address_space(3))) bf16x8*)(kp+512);
  kf[2]=*(const __attribute__((address_space(3))) bf16x8*)(kp+2048); kf[3]=*(const __attribute__((address_space(3))) bf16x8*)(kp+2560);
  kf[4]=*(const __attribute__((address_space(3))) bf16x8*)(kp+4096); kf[5]=*(const __attribute__((address_space(3))) bf16x8*)(kp+4608);
  kf[6]=*(const __attribute__((address_space(3))) bf16x8*)(kp+6144); kf[7]=*(const __attribute__((address_space(3))) bf16x8*)(kp+6656);
}
__device__ __forceinline__ void kload2(bf16x8*kf,lds_cptr kp,int j){ kf[2*j]=*(const __attribute__((address_space(3))) bf16x8*)(kp+j*2048); kf[2*j+1]=*(const __attribute__((address_space(3))) bf16x8*)(kp+j*2048+512); }
__device__ __forceinline__ s16x4 vtr(lds_cptr p){ return __builtin_bit_cast(s16x4,__builtin_amdgcn_ds_read_tr16_b64_v4i16((__attribute__((address_space(3))) v4i16_t*)p)); }
__device__ __forceinline__ float rowmax(const f32x16&p0,const f32x16&p1){
  float a=max3f(p0[0],p0[1],p1[0]),b=max3f(p0[2],p0[3],p1[1]);a=max3f(a,p1[2],p1[3]);
  #pragma unroll
  for(int r=4;r<16;r+=4){a=max3f(a,p0[r],p0[r+1]);b=max3f(b,p0[r+2],p0[r+3]);a=max3f(a,p1[r],p1[r+1]);b=max3f(b,p1[r+2],p1[r+3]);}
  const float m=max2f(a,b);
  auto rr=__builtin_amdgcn_permlane32_swap(__float_as_uint(m),__float_as_uint(m),false,false);
  return max2f(__uint_as_float(rr[0]),__uint_as_float(rr[1]));
}
__device__ __forceinline__ void pv(f32x16*o,int vb,bf16x8 pa0,bf16x8 pa1,bf16x8 pa2,bf16x8 pa3){
  #pragma unroll
  for(int d0=0;d0<2;++d0){s16x4 lo[4],hi[4];
    #pragma unroll
    for(int ks=0;ks<4;++ks){
      asm volatile("ds_read_b64_tr_b16 %0,%1 offset:%c2":"=&v"(lo[ks]):"v"(vb),"i"(d0*4096+ks*1024):"memory");
      asm volatile("ds_read_b64_tr_b16 %0,%1 offset:%c2":"=&v"(hi[ks]):"v"(vb),"i"(d0*4096+ks*1024+512):"memory");}
    asm volatile("s_waitcnt lgkmcnt(0)":::"memory");SBAR();
    #define PK(k) (bf16x8){lo[k][0],lo[k][1],lo[k][2],lo[k][3],hi[k][0],hi[k][1],hi[k][2],hi[k][3]}
    o[d0]=__builtin_amdgcn_mfma_f32_32x32x16_bf16(pa0,PK(0),o[d0],0,0,0);
    o[d0]=__builtin_amdgcn_mfma_f32_32x32x16_bf16(pa1,PK(1),o[d0],0,0,0);
    o[d0]=__builtin_amdgcn_mfma_f32_32x32x16_bf16(pa2,PK(2),o[d0],0,0,0);
    o[d0]=__builtin_amdgcn_mfma_f32_32x32x16_bf16(pa3,PK(3),o[d0],0,0,0);
    #undef PK
  }
}

#ifndef ATTN_STORE16
#define ATTN_STORE16(p,v) (*(u32x4*)(p)=(v))
#endif
template<int THRL> __device__ __forceinline__ void attn_unit(int b,int h,int qb,const bf16*Q,const bf16*__restrict__ K,const bf16*__restrict__ V,bf16*O,char*shm){
  const int tid=threadIdx.x,lane=tid&63,r32=lane&31,hi=lane>>5; const int wid=__builtin_amdgcn_readfirstlane(tid>>6);
  const long rowbase=(long)b*SEQ; const int q0=qb*QB;
  const bf16*Qw=Q+(rowbase+q0+wid*QBLK)*DM+h*D;
  const bf16*Kh=K+rowbase*DM+h*D,*Vh=V+rowbase*DM+h*D;
  const unsigned lds0=(unsigned)(uintptr_t)shm;
  float*wsf=(float*)(shm+LDS_WS)+wid*64;
  const bf16*ksrc=Kh+(long)lane*DM+wid*8;
  const bf16*vsrc=Vh+(long)(16*(wid&3)+(lane>>2))*DM+(wid>>2)*32+(lane&3)*8;
  const unsigned kdst=lds0+LDS_K+wid*1024, vdst=lds0+LDS_V+wid*1024;
  #define DMA_K(t,slot) glds16(ksrc+(long)(t)*KVBLK*DM,(unsigned)__builtin_amdgcn_readfirstlane(kdst+(slot)))
  #define DMA_V(t,slot) glds16(vsrc+(long)(t)*KVBLK*DM,(unsigned)__builtin_amdgcn_readfirstlane(vdst+(slot)))
  const int vb0=(int)(lds0+LDS_V)+((lane>>4)&1)*32+(lane&3)*8+(4*hi+((lane&15)>>2))*64;
  const char*Kbase=shm+LDS_K; bf16x8 kf[8];
  const lds_cptr shm3=(lds_cptr)shm; const lds_cptr kp0=shm3+LDS_K+hi*1024+r32*16; const lds_cptr vp0=shm3+LDS_V+((lane>>4)&1)*32+(lane&3)*8+(4*hi+((lane&15)>>2))*64;
  const int NT=(q0+QB)/KVBLK;
  DMA_K(0,0);DMA_V(0,0);DMA_K(1,SLOTB);
  bf16x8 qr[4];
  #pragma unroll
  for(int d0=0;d0<4;++d0)qr[d0]=*reinterpret_cast<const bf16x8*>(&Qw[(long)r32*DM+d0*16+hi*8]);
  { int lp_=lane; asm volatile("":"+v"(lp_)); const int r32p=lp_&31, hip=lp_>>5;
    unsigned sel=0u; const __attribute__((address_space(3))) float*km=(const __attribute__((address_space(3))) float*)((__attribute__((address_space(3))) const char*)shm+LDS_KM); float g0=-3e38f,g1=-3e38f,g2=-3e38f; int s0=-1,s1=-1,s2=-1;
    for(int j=0;j<qb;++j){ float g=0.f;
      #pragma unroll
      for(int d0=0;d0<4;++d0){
        #pragma unroll
        for(int e=0;e<8;++e)g+=__builtin_bit_cast(float,((unsigned)(unsigned short)qr[d0][e])<<16)*km[j*64+16*d0+8*hip+e];}
      g+=__shfl_xor(g,32);
      if(g>g0){g2=g1;s2=s1;g1=g0;s1=s0;g0=g;s0=j;}else if(g>g1){g2=g1;s2=s1;g1=g;s1=j;}else if(g>g2){g2=g;s2=j;} }
    if(s0>=0)sel|=1u<<s0; if(s1>=0)sel|=1u<<s1; if(s2>=0)sel|=1u<<s2;
    if(hip==0)((__attribute__((address_space(3))) unsigned*)((__attribute__((address_space(3))) char*)shm+LDS_SEL))[wid*32+r32p]=sel; asm volatile("s_waitcnt lgkmcnt(0)":::"memory"); }
  float mhat=0.f,l_reg=0.f;f32x16 o[2];o[0]=f32x16{};o[1]=f32x16{};f32x16 negm=f32x16{};asm volatile("":"+v"(negm));
  const int qrel=wid*QBLK+r32;
  #define BMASK(P0,P1,t) do{}while(0)
  #define CMASK(P0,P1,t) do{int jb_=(t)-(NT-4); if(jb_>=0)cmask(P0,P1,jb_,qrel,hi); else BMASK(P0,P1,t);}while(0)
  bool resc=false;
  #define START(P0,P1) do{ const float rm=rowmax(P0,P1); resc=false; \
    { const float dl=__builtin_fmaxf(rm,-64.f); mhat=fadd_s(mhat,dl); \
      _Pragma("unroll") for(int r=0;r<16;++r){P0[r]=fsub_s(P0[r],dl);P1[r]=fsub_s(P1[r],dl);} \
      _Pragma("unroll") for(int r=0;r<16;++r)negm[r]=-mhat; asm volatile("":"+v"(negm)); } \
    _Pragma("unroll") for(int r=0;r<16;++r)P0[r]=__builtin_amdgcn_exp2f(P0[r]); }while(0)
  #define RESC() do{ if(resc){ asm volatile("s_waitcnt lgkmcnt(0)":::"memory"); \
      _Pragma("unroll") for(int d_=0;d_<2;++d_) _Pragma("unroll") for(int r=0;r<16;++r)o[d_][r]*=wsf[crow(r,hi)]; } }while(0)
  f32x16 pA0,pA1,pB0,pB1;
  int sl_prev=0,sl_cur=0,sl_next=SLOTB;
  #define ROT() do{sl_prev=sl_cur;sl_cur=sl_next;sl_next=(sl_next==(NSLOT-1)*SLOTB)?0:sl_next+SLOTB;}while(0)
  DMA_K(2,2*SLOTB);
  WAIT_BAR(3);
  qkt(pA0,pA1,Kbase,qr,negm,r32,hi);asm volatile("s_nop 15\n\ts_nop 7":"+v"(pA0),"+v"(pA1));CMASK(pA0,pA1,0);
  START(pA0,pA1);
  _Pragma("unroll") for(int r=0;r<16;++r)pA1[r]=__builtin_amdgcn_exp2f(pA1[r]);
  WAIT_BAR(0);
  DMA_K(3,0);DMA_V(1,SLOTB);
  ROT();
  kload8(kf,kp0+sl_cur);
  WAIT_BAR(2);
  s16x4 vlo[8],vhi[8]; u32x4 pw0,pw1,pw2,pw3;
  #define PKW(P,B) (keep_?cvtpk_s(P[B],P[B+1]):0u)
  #define PAF(k) __builtin_bit_cast(bf16x8,pw##k)
  #define VFR(i) (bf16x8){vlo[i][0],vlo[i][1],vlo[i][2],vlo[i][3],vhi[i][0],vhi[i][1],vhi[i][2],vhi[i][3]}
  #define PIN(x) asm volatile("":"+v"(x))
  #define MX3(a,b,c) __builtin_fmaxf(__builtin_fmaxf((a),(b)),(c))
  #define GAPA(MF,A0,A1,A2,A3,W0,W1,PW) do{ MF; sacc+=A0; sacc+=A1; sacc+=A2; sacc+=A3; PIN(sacc); W0; W1; PIN(PW); SBAR(); }while(0)
  #define EX(v) __builtin_amdgcn_exp2f(v)
  #define GAPB(MF,X,B) do{ MF; X[B]=EX(X[B]); X[B+1]=EX(X[B+1]); X[B+2]=EX(X[B+2]); X[B+3]=EX(X[B+3]); PIN(X); SBAR(); }while(0)
  #define VRD(i) do{ vlo[i]=vtr(vp_+(((i)>>2)*4096+((i)&3)*1024)); vhi[i]=vtr(vp_+(((i)>>2)*4096+((i)&3)*1024+512)); }while(0)
  #define KRD(G,j) do{ if(G){ kload2(kf,kp0+sl_next,j); SBAR(); } }while(0)
  #define STEP(C0,C1,P0,P1,t,GK,GV,GL) do{ SBAR(); \
    int q_=qrel; asm volatile("":"+v"(q_)); const unsigned selw_=((const volatile __attribute__((address_space(3))) unsigned*)((__attribute__((address_space(3))) const char*)shm+LDS_SEL))[q_]; \
    const bool keep_=((t)-1>=NT-4)||((selw_>>(((t)-1)>>2))&1u); \
    const lds_cptr vp_=vp0+sl_prev; \
    VRD(0); SBAR(); float sacc=(P0[0]+P0[1]); \
    GAPA(C0=__builtin_amdgcn_mfma_f32_32x32x16_bf16(kf[0],qr[0],negm,0,0,0), P0[2],P0[3],P0[4],P0[5],     pw0[0]=PKW(P0,0), pw0[1]=PKW(P0,2), pw0); \
    VRD(4); SBAR(); GAPA(C1=__builtin_amdgcn_mfma_f32_32x32x16_bf16(kf[1],qr[0],negm,0,0,0), P0[6],P0[7],P0[8],P0[9],     pw0[2]=PKW(P0,4), pw0[3]=PKW(P0,6), pw0); \
    VRD(1); SBAR(); GAPA(C0=__builtin_amdgcn_mfma_f32_32x32x16_bf16(kf[2],qr[1],C0,0,0,0),   P0[10],P0[11],P0[12],P0[13], pw1[0]=PKW(P0,8), pw1[1]=PKW(P0,10), pw1); \
    VRD(5); SBAR(); GAPA(C1=__builtin_amdgcn_mfma_f32_32x32x16_bf16(kf[3],qr[1],C1,0,0,0),   P0[14],P0[15],P1[0],P1[1],   pw1[2]=PKW(P0,12),pw1[3]=PKW(P0,14), pw1); \
    VRD(2); SBAR(); GAPA(C0=__builtin_amdgcn_mfma_f32_32x32x16_bf16(kf[4],qr[2],C0,0,0,0),   P1[2],P1[3],P1[4],P1[5],     pw2[0]=PKW(P1,0), pw2[1]=PKW(P1,2), pw2); \
    VRD(6); SBAR(); GAPA(C1=__builtin_amdgcn_mfma_f32_32x32x16_bf16(kf[5],qr[2],C1,0,0,0),   P1[6],P1[7],P1[8],P1[9],     pw2[2]=PKW(P1,4), pw2[3]=PKW(P1,6), pw2); \
    VRD(3); SBAR(); GAPA(C0=__builtin_amdgcn_mfma_f32_32x32x16_bf16(kf[6],qr[3],C0,0,0,0),   P1[10],P1[11],P1[12],P1[13], pw3[0]=PKW(P1,8), pw3[1]=PKW(P1,10), pw3); \
    VRD(7); SBAR(); GAPA(C1=__builtin_amdgcn_mfma_f32_32x32x16_bf16(kf[7],qr[3],C1,0,0,0),   P1[14],P1[15],0.f,0.f,       pw3[2]=PKW(P1,12),pw3[3]=PKW(P1,14), pw3); \
    l_reg+=keep_?sacc:0.f; \
    if(GK){DMA_K((t)+3,sl_cur);} if(GV){DMA_V((t)+1,sl_next);} \
    CMASK(C0,C1,t); \
    { float a=MX3(C0[0],C0[1],C1[0]),b=MX3(C0[2],C0[3],C1[1]); a=MX3(a,C1[2],C1[3]); \
      _Pragma("unroll") for(int r=4;r<16;r+=4){a=MX3(a,C0[r],C0[r+1]);b=MX3(b,C0[r+2],C0[r+3]);a=MX3(a,C1[r],C1[r+1]);b=MX3(b,C1[r+2],C1[r+3]);} \
      float rm=__builtin_fmaxf(a,b); { auto rr=__builtin_amdgcn_permlane32_swap(__float_as_uint(rm),__float_as_uint(rm),false,false); rm=__builtin_fmaxf(__uint_as_float(rr[0]),__uint_as_float(rr[1])); } \
      resc=false; \
      if(__builtin_expect(__any(rm>(float)THRL),0)){ const float dl=__builtin_fmaxf(rm,0.f); mhat+=dl; \
        _Pragma("unroll") for(int r=0;r<16;++r){C0[r]-=dl;C1[r]-=dl;} \
        _Pragma("unroll") for(int r=0;r<16;++r)negm[r]=-mhat; asm volatile("":"+v"(negm)); \
        const float f=__builtin_amdgcn_exp2f(-dl); l_reg*=f; if(hi==0)wsf[r32]=f; resc=true; } } \
    SBAR(); \
    GAPB(o[0]=__builtin_amdgcn_mfma_f32_32x32x16_bf16(PAF(0),VFR(0),o[0],0,0,0), C0,0); \
    GAPB(o[1]=__builtin_amdgcn_mfma_f32_32x32x16_bf16(PAF(0),VFR(4),o[1],0,0,0), C0,4); \
    KRD(GL,0); GAPB(o[0]=__builtin_amdgcn_mfma_f32_32x32x16_bf16(PAF(1),VFR(1),o[0],0,0,0), C0,8); \
    KRD(GL,1); GAPB(o[1]=__builtin_amdgcn_mfma_f32_32x32x16_bf16(PAF(1),VFR(5),o[1],0,0,0), C0,12); \
    KRD(GL,2); GAPB(o[0]=__builtin_amdgcn_mfma_f32_32x32x16_bf16(PAF(2),VFR(2),o[0],0,0,0), C1,0); \
    KRD(GL,3); GAPB(o[1]=__builtin_amdgcn_mfma_f32_32x32x16_bf16(PAF(2),VFR(6),o[1],0,0,0), C1,4); \
    GAPB(o[0]=__builtin_amdgcn_mfma_f32_32x32x16_bf16(PAF(3),VFR(3),o[0],0,0,0), C1,8); \
    GAPB(o[1]=__builtin_amdgcn_mfma_f32_32x32x16_bf16(PAF(3),VFR(7),o[1],0,0,0), C1,12); \
    }while(0)
  int t=1;
  for(;t+5<NT;t+=2){
    STEP(pB0,pB1,pA0,pA1,t,true,true,true);     WAIT_BAR(2); RESC(); ROT();
    STEP(pA0,pA1,pB0,pB1,t+1,true,true,true);   WAIT_BAR(2); RESC(); ROT();
  }
  #define ENDW(tt) do{ if((tt)+3<NT){WAIT_BAR(2);} else if((tt)+2<NT){WAIT_BAR(1);} else {WAIT_BAR(0);} }while(0)
  for(;t+1<NT;t+=2){
    STEP(pB0,pB1,pA0,pA1,t,(t+3<NT),(t+1<NT),(t+1<NT));       ENDW(t);   RESC(); ROT();
    STEP(pA0,pA1,pB0,pB1,t+1,(t+4<NT),(t+2<NT),(t+2<NT));     ENDW(t+1); RESC(); ROT();
  }
  STEP(pB0,pB1,pA0,pA1,NT-1,false,false,false); RESC();
  { const bool keep_=true; float sacc=pB0[0]+pB0[1]; _Pragma("unroll") for(int r=2;r<16;++r)sacc+=pB0[r]; _Pragma("unroll") for(int r=0;r<16;++r)sacc+=pB1[r]; l_reg+=sacc;
    pw0=(u32x4){PKW(pB0,0),PKW(pB0,2),PKW(pB0,4),PKW(pB0,6)};pw1=(u32x4){PKW(pB0,8),PKW(pB0,10),PKW(pB0,12),PKW(pB0,14)};pw2=(u32x4){PKW(pB1,0),PKW(pB1,2),PKW(pB1,4),PKW(pB1,6)};pw3=(u32x4){PKW(pB1,8),PKW(pB1,10),PKW(pB1,12),PKW(pB1,14)};
    SBAR(); pv(o,vb0+sl_cur,PAF(0),PAF(1),PAF(2),PAF(3)); }
  #undef PKW
  #undef PAF
  #undef VFR
  #undef PIN
  #undef MX3
  #undef GAPA
  #undef GAPB
  #undef EX
  #undef VRD
  #undef KRD
  #undef STEP
  #undef ENDW
  {auto rr=__builtin_amdgcn_permlane32_swap(__float_as_uint(l_reg),__float_as_uint(l_reg),false,false);l_reg=__uint_as_float(rr[0])+__uint_as_float(rr[1]);}
  if(hi==0)wsf[32+r32]=l_reg;asm volatile("s_waitcnt lgkmcnt(0)":::"memory");
  float rli[16];
  #pragma unroll
  for(int r=0;r<16;++r)rli[r]=__builtin_amdgcn_rcpf(wsf[32+crow(r,hi)]);
  bf16*Ow=O+(rowbase+q0+wid*QBLK)*DM+h*D;
  { bf16*stg=(bf16*)(shm+LDS_OST)+wid*2048;
    #pragma unroll
    for(int r=0;r<16;++r){const int orow=crow(r,hi);
      #pragma unroll
      for(int d0=0;d0<2;++d0)stg[orow*64+d0*32+r32]=__float2bfloat16(o[d0][r]*rli[r]);}
    asm volatile("s_waitcnt lgkmcnt(0)":::"memory");
    #pragma unroll
    for(int i=0;i<4;++i){const int row=i*8+(lane>>3),ch=lane&7; const u32x4 v=*(const u32x4*)(stg+row*64+ch*8); ATTN_STORE16(Ow+(long)row*DM+ch*8,v);} }
  asm volatile("s_waitcnt lgkmcnt(0)\n\ts_barrier":::"memory");
  #undef DMA_K
  #undef DMA_V
  #undef CMASK
  #undef BMASK
  #undef START
  #undef RESC
  #undef ROT
}
constexpr int ATTN_LDS_BYTES=LDS_BYTES;
struct AttnTensors { const bf16* Q; const bf16* K; const bf16* V; bf16* O; const float* KM; };
struct AttnUnit { int bh; int qb; };
struct StaticOrder {
  int vcu;
  __device__ __forceinline__ explicit StaticOrder(int grid,int block):vcu((block%8)*(grid/8)+block/8){}
  __device__ __forceinline__ bool next(int i,AttnUnit&u)const{ if(i>=4)return false; const int s=vcu&7; u.bh=vcu>>3; u.qb=(i==0)?s:(i==1)?15-s:(i==2)?16+s:31-s; return true; }
  __device__ __forceinline__ void a_ready(const AttnUnit&)const{}
  __device__ __forceinline__ void done(const AttnUnit&)const{}
};
template<class Sched,int THRL=8> __device__ __forceinline__ void attn_phase(char*lds,const AttnTensors&T,const Sched&S){
  AttnUnit u; int lastbh=-1;
  for(int i=0;S.next(i,u);++i){
    if(u.bh!=lastbh){ __syncthreads(); float*km=(float*)(lds+LDS_KM); int tx_=threadIdx.x; asm volatile("":"+v"(tx_)); for(int k=tx_;k<32*64;k+=512)km[k]=T.KM[(long)u.bh*32*64+k]; asm volatile("s_waitcnt vmcnt(0) lgkmcnt(0)":::"memory"); __syncthreads(); lastbh=u.bh; }
    attn_unit<THRL>(u.bh/NHEAD,u.bh%NHEAD,u.qb,T.Q,T.K,T.V,T.O,lds); }
}
#undef SBAR
#undef WAIT_BAR
}

#define XB_TMO      128
#define XB_XCNT(j)  (256  + 64 * (j))
#define XB_XSUB(j)  (1280 + 64 * (j))
#define XB_XGEN(j)  (2304 + 64 * (j))
#define XB_TOP      3328
#define XB_TOPGEN   3392
#define XCD_BAR_WORDS 3456
#define XB_SPIN_CAP (1u << 20)
__device__ __forceinline__ unsigned xb_ld(unsigned* p)              { return __hip_atomic_load(p, __ATOMIC_RELAXED, __HIP_MEMORY_SCOPE_AGENT); }
__device__ __forceinline__ unsigned xb_add(unsigned* p, unsigned v) { return __hip_atomic_fetch_add(p, v, __ATOMIC_RELAXED, __HIP_MEMORY_SCOPE_AGENT); }
__device__ __forceinline__ unsigned xb_xcc_id() { return (unsigned)__builtin_amdgcn_s_getreg((3 << 11) | 20) & 0xFu; }
#define XB_SPIN(cond, bar) do { unsigned _sp = 0; while (cond) { __builtin_amdgcn_s_sleep(1); \
    if ((++_sp & 255u) == 0u) { if (xb_ld(&(bar)[XB_TMO])) break; if (_sp > XB_SPIN_CAP) { atomicAdd(&(bar)[XB_TMO], 1u); break; } } } } while (0)
struct XcdBarrier { unsigned* bar; unsigned x; volatile LAS unsigned* st; };
__device__ __forceinline__ XcdBarrier xcd_barrier_post(unsigned* bar, volatile LAS unsigned* st) {
    XcdBarrier b; b.bar = bar; b.x = xb_xcc_id(); b.st = st;
    if (threadIdx.x == 0) (void)xb_add(&bar[XB_XCNT(b.x)], 1u);
    return b;
}
__device__ __forceinline__ void xcd_barrier_complete(unsigned* bar, unsigned x, unsigned& nloc, unsigned& nx) {
    const unsigned G = gridDim.x * gridDim.y * gridDim.z;
    unsigned sum, cnt, mine, sp = 0u;
    for (;;) {
        sum = 0u; cnt = 0u; mine = 0u;
#pragma unroll
        for (unsigned j = 0; j < 16; ++j) { const unsigned c = xb_ld(&bar[XB_XCNT(j)]); sum += c; cnt += (c > 0u) ? 1u : 0u; mine = (j == x) ? c : mine; }
        if (sum == G) break;
        __builtin_amdgcn_s_sleep(1);
        if ((++sp & 255u) == 0u) { if (xb_ld(&bar[XB_TMO])) break; if (sp > XB_SPIN_CAP) { atomicAdd(&bar[XB_TMO], 1u); break; } }
    }
    nloc = mine > 0u ? mine : 1u; nx = cnt > 0u ? cnt : 1u;
}
__device__ __forceinline__ void xcd_barrier(const XcdBarrier& b) {
    asm volatile("s_waitcnt vmcnt(0)" ::: "memory");
    __syncthreads();
    if (threadIdx.x == 0) {
        unsigned* bar = b.bar;
        __builtin_amdgcn_s_waitcnt(0);
        unsigned nloc = b.st[0], nx = b.st[1];
        if (nloc == 0u) { xcd_barrier_complete(bar, b.x, nloc, nx); b.st[0] = nloc; b.st[1] = nx; }
        const unsigned old = xb_add(&bar[XB_XSUB(b.x)], 1u);
        const unsigned gen = old / nloc;
        if (old + 1u == (gen + 1u) * nloc) {
            __builtin_amdgcn_fence(__ATOMIC_RELEASE, "agent");
            asm volatile("s_waitcnt vmcnt(0)" ::: "memory");
            const unsigned og = xb_add(&bar[XB_TOP], 1u);
            const unsigned tg = og / nx;
            if (og + 1u == (tg + 1u) * nx) xb_add(&bar[XB_TOPGEN], 1u);
            else XB_SPIN(xb_ld(&bar[XB_TOPGEN]) == tg, bar);
            __builtin_amdgcn_fence(__ATOMIC_ACQUIRE, "agent");
            xb_add(&bar[XB_XGEN(b.x)], 1u);
            asm volatile("s_waitcnt vmcnt(0)" ::: "memory");
        } else {
            XB_SPIN(xb_ld(&bar[XB_XGEN(b.x)]) == gen, bar);
            __builtin_amdgcn_fence(__ATOMIC_ACQUIRE, "agent");
            asm volatile("s_waitcnt vmcnt(0)" ::: "memory");
        }
    }
    __syncthreads();
}

struct Args { const float* in[28]; float* out; unsigned char* ws; int ph_lo, ph_hi; };
enum { I_X = 0, I_MEM, I_GMIX, I_WIN, I_ARE, I_AIM, I_LOGDT, I_BRE, I_BIM, I_CRE, I_CIM, I_DSKIP, I_WGLU, I_WPA, I_WOUT, I_GXATTN, I_GMEM, I_WXQ, I_WXKV, I_WXO,
       I_GMOE, I_WROUTER, I_BROUTER, I_WGU, I_BGU, I_WDN, I_BDN, I_GFINAL };

template <int MAP>
__device__ __forceinline__ void p0_transpose_item(const float* W, int K, int N, const float* gain, bf16_t* WT, LAS float* scr, int item, int lane) {
    const int nblk = N / 64, kb = item / nblk, nb = item % nblk, k0 = 64 * kb, n0 = 64 * nb;
    const int q = lane & 15, kr = lane >> 4;
    f32x4 v[16];
    const float* src = W + (size_t)(k0 + kr) * N + n0 + 4 * q;
#pragma unroll
    for (int j = 0; j < 16; ++j) v[j] = *(const f32x4*)(src + (size_t)(4 * j) * N);
    if (gain) {
#pragma unroll
        for (int j = 0; j < 16; ++j) v[j] = v[j] * gain[k0 + kr + 4 * j]; }
#pragma unroll
    for (int j = 0; j < 16; ++j) { const int kk = kr + 4 * j; *(LAS f32x4*)(scr + kk * 64 + 4 * (q ^ ((kk >> 3) & 7))) = v[j]; }
    asm volatile("s_waitcnt lgkmcnt(0)" ::: "memory");
    const int c = lane & 7, nq = lane >> 3;
    const int nr0 = (MAP == 1) ? (256 * ((n0 % 1024) / 128) + 128 * (n0 / 1024) + (n0 % 128)) : n0;
#pragma unroll
    for (int jj = 0; jj < 8; ++jj) { const int n = 8 * jj + nq; const LAS float* sp = scr + (8 * c) * 64 + (n ^ (4 * c));
        u32x4 o; o.x = pk2(sp[0 * 64], sp[1 * 64]); o.y = pk2(sp[2 * 64], sp[3 * 64]); o.z = pk2(sp[4 * 64], sp[5 * 64]); o.w = pk2(sp[6 * 64], sp[7 * 64]);
        *(u32x4*)(WT + (size_t)(nr0 + n) * K + k0 + 8 * c) = o; }
    asm volatile("s_waitcnt lgkmcnt(0)" ::: "memory");
}
template <int MODE>
__device__ __forceinline__ float rms_row_to_bf16(const float* xrow, const float* gain, bf16_t* orow, int lane) {
    const f32x4* xr = (const f32x4*)xrow + lane;
    f32x4 v[4]; float s = 0.f;
#pragma unroll
    for (int j = 0; j < 4; ++j) { v[j] = xr[64 * j]; s += (v[j][0] * v[j][0] + v[j][1] * v[j][1]) + (v[j][2] * v[j][2] + v[j][3] * v[j][3]); }
    const float rstd = 1.0f / sqrtf(wave_sum(s) * (1.0f / DM) + RMS_EPS);
    u32x2* o8 = (u32x2*)orow + lane;
#pragma unroll
    for (int j = 0; j < 4; ++j) { f32x4 w = v[j];
        if (MODE == 1) { const f32x4 g = ((const f32x4*)gain)[lane + 64 * j]; w = w * rstd * g; }
        u32x2 o; o.x = pk2(w[0], w[1]); o.y = pk2(w[2], w[3]); o8[64 * j] = o; }
    return rstd;
}

struct Frame {
    LAS unsigned char* lds; int tid, lane, wave, G, bid;
    const float* in[28]; float* out; unsigned char* ws; unsigned* ctl;
};
#define WSP(type, off) ((type*)(F.ws + (off)))

__device__ __forceinline__ void phase_prologue(Frame& F) {
    LAS float* scr = (LAS float*)(F.lds + F.wave * 16384);
    const int gw = F.bid * 8 + F.wave, NGW = F.G * 8;
    for (int m = gw * 4; m < T_; m += NGW * 4) {
        f32x4 v[4][4]; float ss[4];
#pragma unroll
        for (int r = 0; r < 4; ++r)
#pragma unroll
            for (int j = 0; j < 4; ++j) v[r][j] = ((const f32x4*)(F.in[I_X] + (size_t)(m + r) * DM))[F.lane + 64 * j];
#pragma unroll
        for (int r = 0; r < 4; ++r) { float s = 0.f;
#pragma unroll
            for (int j = 0; j < 4; ++j) s += (v[r][j][0] * v[r][j][0] + v[r][j][1] * v[r][j][1]) + (v[r][j][2] * v[r][j][2] + v[r][j][3] * v[r][j][3]);
            ss[r] = s; }
#pragma unroll
        for (int o = 1; o < 64; o <<= 1) {
#pragma unroll
            for (int r = 0; r < 4; ++r) ss[r] += __shfl_xor(ss[r], o); }
#pragma unroll
        for (int r = 0; r < 4; ++r) { u32x2* o8 = (u32x2*)(WSP(bf16_t, WS_XB) + (size_t)(m + r) * DM) + F.lane;
#pragma unroll
            for (int j = 0; j < 4; ++j) { u32x2 o; o.x = pk2(v[r][j][0], v[r][j][1]); o.y = pk2(v[r][j][2], v[r][j][3]); o8[64 * j] = o; }
            if (F.lane == 0) WSP(float, WS_RSTD0)[m + r] = 1.0f / sqrtf(ss[r] * (1.0f / DM) + RMS_EPS); } }
    for (int m = gw; m < NB * MEML; m += NGW) (void)rms_row_to_bf16<1>(F.in[I_MEM] + (size_t)m * DM, F.in[I_GMEM], WSP(bf16_t, WS_MN) + (size_t)m * DM, F.lane);
    constexpr int I_IN = (DM / 64) * (INW / 64), I_GLU = (SW / 64) * (2 * DM / 64), I_PA = (AW / 64) * (DM / 64), I_OUT = (DM / 64) * (DM / 64), I_XQ = (DM / 64) * (XW / 64),
                  I_XKV = (DM / 64) * (2 * XW / 64), I_XO = (XW / 64) * (DM / 64), I_GU1 = (DM / 64) * (2 * DFF / 64), I_DN1 = (DFF / 64) * (DM / 64);
    constexpr int NITEMS = I_IN + I_GLU + I_PA + I_OUT + I_XQ + I_XKV + I_XO + NE * (I_GU1 + I_DN1);
    for (int it = gw; it < NITEMS; it += NGW) {
        int r = it;
        if (r < I_IN) { p0_transpose_item<0>(F.in[I_WIN], DM, INW, F.in[I_GMIX], WSP(bf16_t, WS_WIN), scr, r, F.lane); continue; } r -= I_IN;
        if (r < I_GLU) { p0_transpose_item<1>(F.in[I_WGLU], SW, 2 * DM, nullptr, WSP(bf16_t, WS_WGLU), scr, r, F.lane); continue; } r -= I_GLU;
        if (r < I_PA) { p0_transpose_item<0>(F.in[I_WPA], AW, DM, nullptr, WSP(bf16_t, WS_WPA), scr, r, F.lane); continue; } r -= I_PA;
        if (r < I_OUT) { p0_transpose_item<0>(F.in[I_WOUT], DM, DM, nullptr, WSP(bf16_t, WS_WOUT), scr, r, F.lane); continue; } r -= I_OUT;
        if (r < I_XQ) { p0_transpose_item<0>(F.in[I_WXQ], DM, XW, F.in[I_GXATTN], WSP(bf16_t, WS_WXQ), scr, r, F.lane); continue; } r -= I_XQ;
        if (r < I_XKV) { p0_transpose_item<0>(F.in[I_WXKV], DM, 2 * XW, nullptr, WSP(bf16_t, WS_WXKV), scr, r, F.lane); continue; } r -= I_XKV;
        if (r < I_XO) { p0_transpose_item<0>(F.in[I_WXO], XW, DM, nullptr, WSP(bf16_t, WS_WXO), scr, r, F.lane); continue; } r -= I_XO;
        const int e = r / (I_GU1 + I_DN1); r -= e * (I_GU1 + I_DN1);
        if (r < I_GU1) p0_transpose_item<1>(F.in[I_WGU] + (size_t)e * DM * 2 * DFF, DM, 2 * DFF, F.in[I_GMOE], WSP(bf16_t, WS_WGU) + (size_t)e * 2 * DFF * DM, scr, r, F.lane);
        else p0_transpose_item<0>(F.in[I_WDN] + (size_t)e * DFF * DM, DFF, DM, nullptr, WSP(bf16_t, WS_WDN) + (size_t)e * DM * DFF, scr, r - I_GU1, F.lane);
    }
}

__device__ __forceinline__ void phase_kmean(Frame& F) {
    LAS float* red = (LAS float*)F.lds;
    const bf16_t* Kb = WSP(bf16_t, WS_K);
    for (int it = F.bid; it < NB * NH * NBLK; it += F.G) {
        const int j = it % NBLK, h = (it / NBLK) % NH, b = it / (NBLK * NH);
        const int col = F.tid & 63, rg = F.tid >> 6; float s = 0.f;
        const bf16_t* p = Kb + ((size_t)(b * SEQ + j * MBLK + rg * 32)) * AW + h * HD + col;
#pragma unroll 8
        for (int r = 0; r < 32; ++r) s += bf2f(p[(size_t)r * AW]);
        red[rg * 64 + col] = s;
        __syncthreads();
        if (F.tid < 64) { float t = 0.f;
#pragma unroll
            for (int k = 0; k < 8; ++k) t += red[k * 64 + F.tid];
            WSP(float, WS_KMEAN)[(size_t)it * HD + F.tid] = t * (1.0f / MBLK); }
        __syncthreads();
    }
}

__device__ __forceinline__ void phase_moba_simple(Frame& F, bf16_t* Ob) {
    LAS unsigned* Ks = (LAS unsigned*)F.lds;
    LAS unsigned* Vs = (LAS unsigned*)(F.lds + 32768);
    LAS float* km = (LAS float*)(F.lds + 65536);
    const bf16_t *Qb = WSP(bf16_t, WS_Q), *Kb = WSP(bf16_t, WS_K), *Vb = WSP(bf16_t, WS_V);
    const int ql = F.tid >> 1, half = F.tid & 1;
    for (int it = F.bid; it < NB * NH * NBLK; it += F.G) {
        const int iblk = (NBLK - 1) - (it % NBLK), h = (it / NBLK) % NH, b = it / (NBLK * NH);
        __syncthreads();
        for (int k = F.tid; k < NBLK * HD; k += 512) km[k] = WSP(float, WS_KMEAN)[(size_t)((b * NH + h) * NBLK) * HD + k];
        float q[32];
        { const u32x4* qp = (const u32x4*)(Qb + (size_t)(b * SEQ + iblk * MBLK + ql) * AW + h * HD + half * 32);
#pragma unroll
          for (int c = 0; c < 4; ++c) { const u32x4 w = qp[c]; q[8 * c + 0] = bflo(w.x); q[8 * c + 1] = bfhi(w.x); q[8 * c + 2] = bflo(w.y); q[8 * c + 3] = bfhi(w.y); q[8 * c + 4] = bflo(w.z); q[8 * c + 5] = bfhi(w.z); q[8 * c + 6] = bflo(w.w); q[8 * c + 7] = bfhi(w.w); } }
        __syncthreads();
        float g0 = -3e38f, g1 = -3e38f, g2 = -3e38f; int s0 = -1, s1 = -1, s2 = -1;
        for (int j = 0; j < iblk; ++j) { float g = 0.f;
#pragma unroll
            for (int d = 0; d < 32; ++d) g += q[d] * km[j * HD + half * 32 + d];
            g += __shfl_xor(g, 1);
            if (g > g0) { g2 = g1; s2 = s1; g1 = g0; s1 = s0; g0 = g; s0 = j; } else if (g > g1) { g2 = g1; s2 = s1; g1 = g; s1 = j; } else if (g > g2) { g2 = g; s2 = j; } }
        float mx = -3e38f, l = 0.f, o[32];
#pragma unroll
        for (int d = 0; d < 32; ++d) o[d] = 0.f;
        for (int jb = 0; jb <= iblk; ++jb) {
            __syncthreads();
            { const size_t rowb = (size_t)(b * SEQ + jb * MBLK);
              for (int c = F.tid; c < 256 * 8; c += 512) { const int r = c >> 3, ch = c & 7;
                  *(LAS u32x4*)(Ks + r * 32 + ch * 4) = *(const u32x4*)(Kb + (rowb + r) * AW + h * HD + ch * 8);
                  *(LAS u32x4*)(Vs + r * 32 + ch * 4) = *(const u32x4*)(Vb + (rowb + r) * AW + h * HD + ch * 8); } }
            __syncthreads();
            const bool need = (jb == iblk) || jb == s0 || jb == s1 || jb == s2;
            if (need) { const int kend = (jb == iblk) ? ql : 255;
                for (int kk = 0; kk <= kend; ++kk) { float s = 0.f;
#pragma unroll
                    for (int c = 0; c < 4; ++c) { const u32x4 w = *(const LAS u32x4*)(Ks + kk * 32 + half * 16 + c * 4);
                        s += q[8 * c + 0] * bflo(w.x) + q[8 * c + 1] * bfhi(w.x) + q[8 * c + 2] * bflo(w.y) + q[8 * c + 3] * bfhi(w.y) + q[8 * c + 4] * bflo(w.z) + q[8 * c + 5] * bfhi(w.z) + q[8 * c + 6] * bflo(w.w) + q[8 * c + 7] * bfhi(w.w); }
                    s += __shfl_xor(s, 1);
                    const float mn = fmaxf(mx, s), corr = __builtin_amdgcn_exp2f(mx - mn), p = __builtin_amdgcn_exp2f(s - mn); mx = mn; l = l * corr + p;
#pragma unroll
                    for (int c = 0; c < 4; ++c) { const u32x4 w = *(const LAS u32x4*)(Vs + kk * 32 + half * 16 + c * 4);
                        o[8 * c + 0] = o[8 * c + 0] * corr + p * bflo(w.x); o[8 * c + 1] = o[8 * c + 1] * corr + p * bfhi(w.x); o[8 * c + 2] = o[8 * c + 2] * corr + p * bflo(w.y); o[8 * c + 3] = o[8 * c + 3] * corr + p * bfhi(w.y);
                        o[8 * c + 4] = o[8 * c + 4] * corr + p * bflo(w.z); o[8 * c + 5] = o[8 * c + 5] * corr + p * bfhi(w.z); o[8 * c + 6] = o[8 * c + 6] * corr + p * bflo(w.w); o[8 * c + 7] = o[8 * c + 7] * corr + p * bfhi(w.w); } } }
        }
        const float il = 1.0f / l;
        u32x4* op = (u32x4*)(Ob + (size_t)(b * SEQ + iblk * MBLK + ql) * AW + h * HD + half * 32);
#pragma unroll
        for (int c = 0; c < 4; ++c) { u32x4 w; w.x = pk2(o[8 * c + 0] * il, o[8 * c + 1] * il); w.y = pk2(o[8 * c + 2] * il, o[8 * c + 3] * il); w.z = pk2(o[8 * c + 4] * il, o[8 * c + 5] * il); w.w = pk2(o[8 * c + 6] * il, o[8 * c + 7] * il); op[c] = w; }
    }
}

__device__ __forceinline__ void phase_ssm_simple(Frame& F, bf16_t* Yb) {
    const int gw = F.bid * 8 + F.wave, NGW = F.G * 8, p = F.lane;
    const bf16_t* Ub = WSP(bf16_t, WS_U);
    for (int it = gw; it < NB * NG; it += NGW) {
        const int g = it % NG, b = it / NG;
        const float are = fminf(F.in[I_ARE][g * SP + p], -1e-4f), aim = F.in[I_AIM][g * SP + p], dt = expf(F.in[I_LOGDT][g]);
        const float mag = expf(are * dt), ang = aim * dt; const float lr = mag * cosf(ang), li = mag * sinf(ang);
        const float nr = lr - 1.0f, ni = li, den = 1.0f / (are * are + aim * aim); const float fr_ = (nr * are + ni * aim) * den, fi_ = (ni * are - nr * aim) * den;
        float bbr[16], bbi[16], cr[16], ci[16], dsk[16];
#pragma unroll
        for (int c = 0; c < 16; ++c) { const float br = F.in[I_BRE][(size_t)(g * SP + p) * SGC + c], bi = F.in[I_BIM][(size_t)(g * SP + p) * SGC + c];
            bbr[c] = fr_ * br - fi_ * bi; bbi[c] = fr_ * bi + fi_ * br;
            cr[c] = F.in[I_CRE][(size_t)(g * SGC + c) * SP + p]; ci[c] = F.in[I_CIM][(size_t)(g * SGC + c) * SP + p]; dsk[c] = F.in[I_DSKIP][g * SGC + c]; }
        float xr = 0.f, xi = 0.f;
        const int csel = ((p >> 5) & 1) * 8 + ((p >> 4) & 1) * 4 + ((p >> 3) & 1) * 2 + ((p >> 2) & 1);
        float dmine = 0.f;
#pragma unroll
        for (int c = 0; c < 16; ++c) dmine = (c == csel) ? dsk[c] : dmine;
        for (int t = 0; t < SEQ; ++t) {
            const u32x4* up = (const u32x4*)(Ub + (size_t)(b * SEQ + t) * SW + g * SGC); const u32x4 w0 = up[0], w1 = up[1];
            float u[16]; u[0] = bflo(w0.x); u[1] = bfhi(w0.x); u[2] = bflo(w0.y); u[3] = bfhi(w0.y); u[4] = bflo(w0.z); u[5] = bfhi(w0.z); u[6] = bflo(w0.w); u[7] = bfhi(w0.w);
            u[8] = bflo(w1.x); u[9] = bfhi(w1.x); u[10] = bflo(w1.y); u[11] = bfhi(w1.y); u[12] = bflo(w1.z); u[13] = bfhi(w1.z); u[14] = bflo(w1.w); u[15] = bfhi(w1.w);
            float sr = 0.f, si = 0.f;
#pragma unroll
            for (int c = 0; c < 16; ++c) { sr += bbr[c] * u[c]; si += bbi[c] * u[c]; }
            const float nxr = lr * xr - li * xi + sr, nxi = lr * xi + li * xr + si; xr = nxr; xi = nxi;
            float y[16];
#pragma unroll
            for (int c = 0; c < 16; ++c) y[c] = cr[c] * xr - ci[c] * xi;
            float w8[8], w4[4], w2[2], w1_;
            { const bool hi = (p & 32) != 0;
#pragma unroll
              for (int i = 0; i < 8; ++i) { const float keep = hi ? y[i + 8] : y[i], send = hi ? y[i] : y[i + 8]; w8[i] = keep + __shfl_xor(send, 32); } }
            { const bool hi = (p & 16) != 0;
#pragma unroll
              for (int i = 0; i < 4; ++i) { const float keep = hi ? w8[i + 4] : w8[i], send = hi ? w8[i] : w8[i + 4]; w4[i] = keep + __shfl_xor(send, 16); } }
            { const bool hi = (p & 8) != 0;
#pragma unroll
              for (int i = 0; i < 2; ++i) { const float keep = hi ? w4[i + 2] : w4[i], send = hi ? w4[i] : w4[i + 2]; w2[i] = keep + __shfl_xor(send, 8); } }
            { const bool hi = (p & 4) != 0; const float keep = hi ? w2[1] : w2[0], send = hi ? w2[0] : w2[1]; w1_ = keep + __shfl_xor(send, 4); }
            w1_ += __shfl_xor(w1_, 2); w1_ += __shfl_xor(w1_, 1);
            float umine = 0.f;
#pragma unroll
            for (int c = 0; c < 16; ++c) umine = (c == csel) ? u[c] : umine;
            if ((p & 3) == 0) Yb[(size_t)(b * SEQ + t) * SW + g * SGC + csel] = (bf16_t)f2bf(gelu_tanh(w1_ + dmine * umine));
        }
    }
}


__device__ __forceinline__ void p0_ssm_tables(Frame& F, int task) {
    const int g = task >> 3, part = task & 7;
    LAS float* pwr = (LAS float*)F.lds; LAS float* pwi = pwr + 65 * 64; LAS float* bbr = pwi + 65 * 64; LAS float* bbi = bbr + 1024; LAS float* ccr = bbi + 1024; LAS float* cci = ccr + 1024;
    const float dt = expf(F.in[I_LOGDT][g]);
    __syncthreads();
    for (int i = F.tid; i < 65 * 64; i += 512) { const int k = i >> 6, p = i & 63; const float are = fminf(F.in[I_ARE][g * SP + p], -1e-4f), aim = F.in[I_AIM][g * SP + p];
        const float mag = expf(are * dt * (float)k); double a = (double)aim * (double)dt * (double)k; a -= 6.283185307179586 * rint(a * 0.15915494309189535); const float af = (float)a;
        pwr[i] = mag * cosf(af); pwi[i] = mag * sinf(af); }
    for (int i = F.tid; i < 1024; i += 512) { const int p = i >> 4, c = i & 15; const float are = fminf(F.in[I_ARE][g * SP + p], -1e-4f), aim = F.in[I_AIM][g * SP + p];
        const float mag = expf(are * dt); double a = (double)aim * (double)dt; a -= 6.283185307179586 * rint(a * 0.15915494309189535); const float af = (float)a;
        const float lr = mag * cosf(af), li = mag * sinf(af), nr = lr - 1.0f, ni = li, den = 1.0f / (are * are + aim * aim), fr_ = (nr * are + ni * aim) * den, fi_ = (ni * are - nr * aim) * den;
        const float br = F.in[I_BRE][(size_t)(g * SP + p) * SGC + c], bi = F.in[I_BIM][(size_t)(g * SP + p) * SGC + c];
        bbr[i] = fr_ * br - fi_ * bi; bbi[i] = fr_ * bi + fi_ * br; }
    for (int i = F.tid; i < 1024; i += 512) { ccr[i] = F.in[I_CRE][(size_t)g * 1024 + i]; cci[i] = F.in[I_CIM][(size_t)g * 1024 + i]; }
    __syncthreads();
    bf16_t* WST = WSP(bf16_t, WS_WST) + (size_t)g * 128 * 1024; bf16_t* GT = WSP(bf16_t, WS_GT) + (size_t)g * 1024 * 128; bf16_t* KT = WSP(bf16_t, WS_KT) + (size_t)g * 65 * 256;
    for (int j = 0; j < 32; ++j) { const int e = part * 16384 + j * 512 + F.tid; const int pp = e >> 10, k = e & 1023, s = k >> 4, c = k & 15, p = pp & 63;
        const float mr = pwr[(63 - s) * 64 + p], mi = pwi[(63 - s) * 64 + p], br = bbr[p * 16 + c], bi = bbi[p * 16 + c];
        WST[e] = (bf16_t)f2bf(pp < 64 ? (mr * br - mi * bi) : (mr * bi + mi * br)); }
    for (int j = 0; j < 32; ++j) { const int e = part * 16384 + j * 512 + F.tid; const int sc = e >> 7, pp = e & 127, s = sc >> 4, c = sc & 15, p = pp & 63;
        const float mr = pwr[(s + 1) * 64 + p], mi = pwi[(s + 1) * 64 + p], cr = ccr[c * 64 + p], ci = cci[c * 64 + p];
        GT[e] = (bf16_t)f2bf(pp < 64 ? (cr * mr - ci * mi) : -(cr * mi + ci * mr)); }
    for (int e = part * 2080 + F.tid; e < (part + 1) * 2080; e += 512) { const int tt = e >> 8, c = (e >> 4) & 15, c2 = e & 15; float acc = 0.f;
        if (tt > 0) { const int tau = tt - 1;
            for (int p = 0; p < 64; ++p) { const float mr = pwr[tau * 64 + p], mi = pwi[tau * 64 + p], cr = ccr[c * 64 + p], ci = cci[c * 64 + p]; const float zr = cr * mr - ci * mi, zi = cr * mi + ci * mr; acc += zr * bbr[p * 16 + c2] - zi * bbi[p * 16 + c2]; } }
        KT[e] = (bf16_t)f2bf(acc); }
    if (part == 0 && F.tid < 64) { WSP(f32x2, WS_LAML)[g * 64 + F.tid] = (f32x2){pwr[64 * 64 + F.tid], pwi[64 * 64 + F.tid]}; }
    __syncthreads();
}
__device__ __forceinline__ void ssm_state_item(Frame& F, int b, int g) {
    const int w = F.wave, wm = w >> 1, wn = w & 1, row = F.lane & 15, kg = F.lane >> 4;
    f32x4 acc[2][4];
#pragma unroll
    for (int a = 0; a < 2; ++a)
#pragma unroll
        for (int c = 0; c < 4; ++c) acc[a][c] = (f32x4){0.f, 0.f, 0.f, 0.f};
    const bf16_t* Ub = WSP(bf16_t, WS_U) + ((size_t)b * SEQ + (size_t)(32 * wm + row) * 64 + (kg >> 1)) * SW + g * SGC + 8 * (kg & 1);
    const bf16_t* Wb = WSP(bf16_t, WS_WST) + ((size_t)g * 128 + 64 * wn + row) * 1024 + 8 * kg;
#pragma unroll 2
    for (int ks = 0; ks < 32; ++ks) {
        bf16x8 a[2], bq[4];
#pragma unroll
        for (int mt = 0; mt < 2; ++mt) a[mt] = *(const bf16x8*)(Ub + ((size_t)(16 * mt * 64 + 2 * ks)) * SW);
#pragma unroll
        for (int nt = 0; nt < 4; ++nt) bq[nt] = *(const bf16x8*)(Wb + (size_t)nt * 16 * 1024 + 32 * ks);
#pragma unroll
        for (int mt = 0; mt < 2; ++mt)
#pragma unroll
            for (int nt = 0; nt < 4; ++nt) acc[mt][nt] = __builtin_amdgcn_mfma_f32_16x16x32_bf16(a[mt], bq[nt], acc[mt][nt], 0, 0, 0);
    }
    LAS float* X = (LAS float*)F.lds;
    __syncthreads();
#pragma unroll
    for (int mt = 0; mt < 2; ++mt)
#pragma unroll
        for (int nt = 0; nt < 4; ++nt)
#pragma unroll
            for (int r = 0; r < 4; ++r) X[(32 * wm + 16 * mt + 4 * kg + r) * 128 + 64 * wn + 16 * nt + row] = acc[mt][nt][r];
    __syncthreads();
    if (w == 0) { const int p = F.lane; const f32x2 lam = WSP(f32x2, WS_LAML)[g * 64 + p]; float sr = 0.f, si = 0.f;
        bf16_t* SS = WSP(bf16_t, WS_SST) + ((size_t)(b * NG + g) * 128) * 128;
        for (int n = 0; n < 128; ++n) { SS[n * 128 + p] = (bf16_t)f2bf(sr); SS[n * 128 + 64 + p] = (bf16_t)f2bf(si);
            const float xr = X[n * 128 + p], xi = X[n * 128 + 64 + p]; const float nsr = lam.x * sr - lam.y * si + xr, nsi = lam.x * si + lam.y * sr + xi; sr = nsr; si = nsi; } }
    __syncthreads();
}
constexpr int SO_USTR = 2064, SO_KT = 32 * SO_USTR, SO_SS = SO_KT + 65 * 512, SO_SSTR = 272;
__device__ __forceinline__ void ssm_out_item(Frame& F, int b, int g, int rr) {
    LAS unsigned char* L = F.lds;
    __syncthreads();
    { const bf16_t* Ug = WSP(bf16_t, WS_U) + ((size_t)b * SEQ + (size_t)rr * 2048) * SW + g * SGC;
#pragma unroll
      for (int j = 0; j < 8; ++j) { const int c = F.tid + 512 * j, r = c >> 1, half = c & 1; *(LAS u32x4*)(L + (r >> 6) * SO_USTR + (r & 63) * 32 + half * 16) = *(const u32x4*)(Ug + (size_t)r * SW + half * 8); }
      const u32x4* Kg = (const u32x4*)(WSP(bf16_t, WS_KT) + (size_t)g * 65 * 256);
      for (int c = F.tid; c < 2080; c += 512) *(LAS u32x4*)(L + SO_KT + c * 16) = Kg[c];
      { const int c = F.tid, ch = c >> 4, pc = c & 15; *(LAS u32x4*)(L + SO_SS + ch * SO_SSTR + pc * 16) = *(const u32x4*)(WSP(bf16_t, WS_SST) + ((size_t)((b * NG + g) * 128 + rr * 32 + ch)) * 128 + pc * 8); } }
    __syncthreads();
    const int w = F.wave, mt = w >> 2, q = w & 3, row = F.lane & 15, kg = F.lane >> 4;
    f32x4 acc[16];
#pragma unroll
    for (int i = 0; i < 16; ++i) acc[i] = (f32x4){0.f, 0.f, 0.f, 0.f};
    const LAS unsigned char* Ua = L + (16 * mt + row) * SO_USTR + (kg >> 1) * 32 + (kg & 1) * 16;
    const LAS unsigned char* Kb_ = L + SO_KT + (1 - (kg >> 1)) * 512 + row * 32 + (kg & 1) * 16;
#pragma unroll 1
    for (int ks = 0; ks < 32; ++ks) {
        const bf16x8 a = *(const LAS bf16x8*)(Ua + ks * 64);
#pragma unroll
        for (int i = 0; i < 16; ++i) { const int s = 4 * i + q; if (s >= 2 * ks) { const bf16x8 bb = *(const LAS bf16x8*)(Kb_ + (s - 2 * ks) * 512); acc[i] = __builtin_amdgcn_mfma_f32_16x16x32_bf16(a, bb, acc[i], 0, 0, 0); } }
    }
    const bf16_t* Gg = WSP(bf16_t, WS_GT) + ((size_t)g * 1024 + q * 16 + row) * 128 + 8 * kg;
#pragma unroll 1
    for (int k2 = 0; k2 < 4; ++k2) {
        const bf16x8 a = *(const LAS bf16x8*)(L + SO_SS + (16 * mt + row) * SO_SSTR + k2 * 64 + kg * 16);
#pragma unroll
        for (int hh = 0; hh < 2; ++hh) {
            bf16x8 bb[8]; const bf16_t* gp = Gg + (size_t)hh * 8 * 64 * 128 + 32 * k2;
#pragma unroll
            for (int i = 0; i < 8; ++i) { bb[i] = *(const bf16x8*)gp; gp += 64 * 128; }
#pragma unroll
            for (int i = 0; i < 8; ++i) acc[hh * 8 + i] = __builtin_amdgcn_mfma_f32_16x16x32_bf16(a, bb[i], acc[hh * 8 + i], 0, 0, 0);
        }
    }
    __syncthreads();
    const float dsk = F.in[I_DSKIP][g * SGC + row];
    { LAS unsigned short* yb = (LAS unsigned short*)(L + (16 * mt + 4 * kg) * SO_USTR + q * 32 + row * 2);
#pragma unroll
      for (int i = 0; i < 16; ++i)
#pragma unroll
          for (int r = 0; r < 4; ++r) { LAS unsigned short* p = yb + (r * SO_USTR + i * 128) / 2; const float u = bf2f(*p); *p = (unsigned short)f2bf(gelu_tanh(acc[i][r] + dsk * u)); } }
    __syncthreads();
    { bf16_t* Yg = WSP(bf16_t, WS_YB) + ((size_t)b * SEQ + (size_t)rr * 2048) * SW + g * SGC;
#pragma unroll 2
      for (int j = 0; j < 8; ++j) { const int c = F.tid + 512 * j, r = c >> 1, half = c & 1; *(u32x4*)(Yg + (size_t)r * SW + half * 8) = *(const LAS u32x4*)(L + (r >> 6) * SO_USTR + (r & 63) * 32 + half * 16); } }
}
__device__ __forceinline__ void phase_ssm_out(Frame& F) {
    for (int it = F.bid; it < NB * NG * 4; it += F.G) ssm_out_item(F, it >> 7, (it >> 2) & 31, it & 3);
    __syncthreads();
}

__device__ __forceinline__ void phase_xattn_simple(Frame& F, bf16_t* Ob) {
    LAS unsigned* Ks = (LAS unsigned*)F.lds;
    LAS unsigned* Vs = (LAS unsigned*)(F.lds + 65536);
    const bf16_t *Qb = WSP(bf16_t, WS_XQ), *KV = WSP(bf16_t, WS_MKV);
    const int tl = F.tid >> 2, part = F.tid & 3;
    int lastbh = -1;
    for (int it = F.bid; it < NB * XH * (SEQ / 128); it += F.G) {
        const int bh = it / (SEQ / 128), ch = it % (SEQ / 128), b = bh / XH, h = bh % XH;
        if (bh != lastbh) { __syncthreads();
            for (int c = F.tid; c < 256 * 16; c += 512) { const int r = c >> 4, cc = c & 15;
                *(LAS u32x4*)(Ks + r * 64 + cc * 4) = *(const u32x4*)(KV + (size_t)(b * MEML + r) * (2 * XW) + h * XD + cc * 8);
                *(LAS u32x4*)(Vs + r * 64 + cc * 4) = *(const u32x4*)(KV + (size_t)(b * MEML + r) * (2 * XW) + XW + h * XD + cc * 8); }
            __syncthreads(); lastbh = bh; }
        const size_t row = (size_t)b * SEQ + ch * 128 + tl;
        float q[32];
        { const u32x4* qp = (const u32x4*)(Qb + row * XW + h * XD + part * 32);
#pragma unroll
          for (int c = 0; c < 4; ++c) { const u32x4 w = qp[c]; q[8 * c + 0] = bflo(w.x); q[8 * c + 1] = bfhi(w.x); q[8 * c + 2] = bflo(w.y); q[8 * c + 3] = bfhi(w.y); q[8 * c + 4] = bflo(w.z); q[8 * c + 5] = bfhi(w.z); q[8 * c + 6] = bflo(w.w); q[8 * c + 7] = bfhi(w.w); } }
        float mx = -3e38f, l = 0.f, o[32];
#pragma unroll
        for (int d = 0; d < 32; ++d) o[d] = 0.f;
        for (int kk = 0; kk < MEML; ++kk) { float s = 0.f;
#pragma unroll
            for (int c = 0; c < 4; ++c) { const u32x4 w = *(const LAS u32x4*)(Ks + kk * 64 + part * 16 + c * 4);
                s += q[8 * c + 0] * bflo(w.x) + q[8 * c + 1] * bfhi(w.x) + q[8 * c + 2] * bflo(w.y) + q[8 * c + 3] * bfhi(w.y) + q[8 * c + 4] * bflo(w.z) + q[8 * c + 5] * bfhi(w.z) + q[8 * c + 6] * bflo(w.w) + q[8 * c + 7] * bfhi(w.w); }
            s += __shfl_xor(s, 1); s += __shfl_xor(s, 2);
            const float mn = fmaxf(mx, s), corr = __builtin_amdgcn_exp2f(mx - mn), p = __builtin_amdgcn_exp2f(s - mn); mx = mn; l = l * corr + p;
#pragma unroll
            for (int c = 0; c < 4; ++c) { const u32x4 w = *(const LAS u32x4*)(Vs + kk * 64 + part * 16 + c * 4);
                o[8 * c + 0] = o[8 * c + 0] * corr + p * bflo(w.x); o[8 * c + 1] = o[8 * c + 1] * corr + p * bfhi(w.x); o[8 * c + 2] = o[8 * c + 2] * corr + p * bflo(w.y); o[8 * c + 3] = o[8 * c + 3] * corr + p * bfhi(w.y);
                o[8 * c + 4] = o[8 * c + 4] * corr + p * bflo(w.z); o[8 * c + 5] = o[8 * c + 5] * corr + p * bfhi(w.z); o[8 * c + 6] = o[8 * c + 6] * corr + p * bflo(w.w); o[8 * c + 7] = o[8 * c + 7] * corr + p * bfhi(w.w); } }
        const float il = 1.0f / l;
        u32x4* op = (u32x4*)(Ob + row * XW + h * XD + part * 32);
#pragma unroll
        for (int c = 0; c < 4; ++c) { u32x4 w; w.x = pk2(o[8 * c + 0] * il, o[8 * c + 1] * il); w.y = pk2(o[8 * c + 2] * il, o[8 * c + 3] * il); w.z = pk2(o[8 * c + 4] * il, o[8 * c + 5] * il); w.w = pk2(o[8 * c + 6] * il, o[8 * c + 7] * il); op[c] = w; }
    }
}

__device__ __forceinline__ void phase_router(Frame& F) {
    LAS float* wt = (LAS float*)F.lds;
    for (int c = F.tid; c < NE * DM; c += 512) { const int k = c >> 5, e = c & 31; wt[e * DM + k] = F.in[I_WROUTER][c] * F.in[I_GMOE][k]; }
    __syncthreads();
    const int gw = F.bid * 8 + F.wave, NGW = F.G * 8, lane = F.lane;
    const float* H = WSP(float, WS_H);
    unsigned* cnt = F.ctl + CW_CNT;
    for (int tk = gw; tk < T_; tk += NGW) {
        const f32x4* hp = (const f32x4*)(H + (size_t)tk * DM) + lane; f32x4 hv[4]; float ss = 0.f;
#pragma unroll
        for (int j = 0; j < 4; ++j) { hv[j] = hp[64 * j]; ss += (hv[j][0] * hv[j][0] + hv[j][1] * hv[j][1]) + (hv[j][2] * hv[j][2] + hv[j][3] * hv[j][3]); }
        const float rstd = 1.0f / sqrtf(wave_sum(ss) * (1.0f / DM) + RMS_EPS);
        float mylogit = 0.f;
#pragma unroll 4
        for (int e = 0; e < NE; ++e) { float a = 0.f;
#pragma unroll
            for (int j = 0; j < 4; ++j) { const f32x4 w = *(const LAS f32x4*)(wt + e * DM + 4 * lane + 256 * j); a += (hv[j][0] * w[0] + hv[j][1] * w[1]) + (hv[j][2] * w[2] + hv[j][3] * w[3]); }
            a = wave_sum(a);
            mylogit = (lane == e) ? a : mylogit; }
        mylogit = (lane < NE) ? (mylogit * rstd + F.in[I_BROUTER][lane & 31]) : -3e38f;
        float tv[4]; int ti[4]; float cur = mylogit;
#pragma unroll
        for (int s = 0; s < 4; ++s) { float bv = cur; int bi = lane;
#pragma unroll
            for (int o = 1; o < 64; o <<= 1) { const float ov = __shfl_xor(bv, o); const int oi = __shfl_xor(bi, o); if (ov > bv || (ov == bv && oi < bi)) { bv = ov; bi = oi; } }
            tv[s] = bv; ti[s] = bi; if (lane == bi) cur = -3e38f; }
        const float e1 = __expf(tv[1] - tv[0]), e2 = __expf(tv[2] - tv[0]), e3 = __expf(tv[3] - tv[0]); const float inv = 1.0f / (1.0f + e1 + e2 + e3);
        if (lane == 0) WSP(float, WS_RSTD2)[tk] = rstd;
        if (lane < 4) { const int ex = (lane == 0) ? ti[0] : (lane == 1) ? ti[1] : (lane == 2) ? ti[2] : ti[3]; const float gv = ((lane == 0) ? 1.0f : (lane == 1) ? e1 : (lane == 2) ? e2 : e3) * inv;
            WSP(float, WS_TKG)[(size_t)tk * 4 + lane] = gv;
            const unsigned rank = atomicAdd(&cnt[ex], 1u);
            WSP(int, WS_ROWLIST)[(size_t)ex * T_ + rank] = tk * 4 + lane; }
    }
}


typedef float f32x16 __attribute__((ext_vector_type(16)));
constexpr int XA_VSTR = 520, XA_VT = 65536;
__device__ __forceinline__ bf16x8 pack8(const f32x16& s, int o) {
    u32x4 w; w.x = pg8::cvt_pk_bf16(s[o + 0], s[o + 1]); w.y = pg8::cvt_pk_bf16(s[o + 2], s[o + 3]); w.z = pg8::cvt_pk_bf16(s[o + 4], s[o + 5]); w.w = pg8::cvt_pk_bf16(s[o + 6], s[o + 7]);
    return __builtin_bit_cast(bf16x8, w);
}
__device__ __forceinline__ void phase_xattn(Frame& F) {
    LAS unsigned char* L = F.lds;
    const bf16_t *Qb = WSP(bf16_t, WS_XQ), *KV = WSP(bf16_t, WS_MKV); bf16_t* Ob = WSP(bf16_t, WS_XO);
    const int lane = F.lane, r32 = lane & 31, hi = lane >> 5, wid = F.wave;
    const int NU = NB * XH * (SEQ / 256), UPB = (NU + F.G - 1) / F.G;
    int lastbh = -1;
    for (int u = F.bid * UPB; u < NU && u < (F.bid + 1) * UPB; ++u) {
        const int bh = u >> 5, qb = u & 31, b = bh >> 2, h = bh & 3;
        if (bh != lastbh) {
            __syncthreads();
            for (int c = F.tid; c < 256 * 16; c += 512) { const int m = c >> 4, ch = c & 15; const bf16_t* src = KV + (size_t)(b * MEML + m) * (2 * XW) + h * XD + ch * 8;
                *(LAS u32x4*)(L + m * 256 + ((ch ^ (m & 15)) << 4)) = *(const u32x4*)src;
                const u32x4 v = *(const u32x4*)(src + XW); LAS unsigned short* vt = (LAS unsigned short*)(L + XA_VT + (ch * 8) * XA_VSTR + m * 2);
                vt[0 * (XA_VSTR / 2)] = (unsigned short)(v.x & 0xffff); vt[1 * (XA_VSTR / 2)] = (unsigned short)(v.x >> 16); vt[2 * (XA_VSTR / 2)] = (unsigned short)(v.y & 0xffff); vt[3 * (XA_VSTR / 2)] = (unsigned short)(v.y >> 16);
                vt[4 * (XA_VSTR / 2)] = (unsigned short)(v.z & 0xffff); vt[5 * (XA_VSTR / 2)] = (unsigned short)(v.z >> 16); vt[6 * (XA_VSTR / 2)] = (unsigned short)(v.w & 0xffff); vt[7 * (XA_VSTR / 2)] = (unsigned short)(v.w >> 16); }
            __syncthreads(); lastbh = bh; }
        const size_t row = (size_t)b * SEQ + qb * 256 + wid * 32 + r32;
        bf16x8 qf[8];
#pragma unroll
        for (int kd = 0; kd < 8; ++kd) qf[kd] = *(const bf16x8*)(Qb + row * XW + h * XD + 16 * kd + 8 * hi);
        f32x16 o[4];
#pragma unroll
        for (int dt = 0; dt < 4; ++dt)
#pragma unroll
            for (int r = 0; r < 16; ++r) o[dt][r] = 0.f;
        float mrun = -1e30f, lrun = 0.f;
#pragma unroll 1
        for (int c = 0; c < 4; ++c) {
            f32x16 s0, s1;
#pragma unroll
            for (int r = 0; r < 16; ++r) { s0[r] = 0.f; s1[r] = 0.f; }
            const int kv0 = c * 64 + r32, kv1 = kv0 + 32;
#pragma unroll
            for (int kd = 0; kd < 8; ++kd) { const int ch = 2 * kd + hi;
                const bf16x8 k0 = *(const LAS bf16x8*)(L + kv0 * 256 + ((ch ^ (kv0 & 15)) << 4)), k1 = *(const LAS bf16x8*)(L + kv1 * 256 + ((ch ^ (kv1 & 15)) << 4));
                s0 = __builtin_amdgcn_mfma_f32_32x32x16_bf16(k0, qf[kd], s0, 0, 0, 0); s1 = __builtin_amdgcn_mfma_f32_32x32x16_bf16(k1, qf[kd], s1, 0, 0, 0); }
            float mx = fmaxf(s0[0], s1[0]);
#pragma unroll
            for (int r = 1; r < 16; ++r) mx = fmaxf(mx, fmaxf(s0[r], s1[r]));
            mx = fmaxf(mx, __shfl_xor(mx, 32));
            const float mn = fmaxf(mrun, mx), sc = __builtin_amdgcn_exp2f(mrun - mn); mrun = mn;
            float ls = 0.f;
#pragma unroll
            for (int r = 0; r < 16; ++r) { s0[r] = __builtin_amdgcn_exp2f(s0[r] - mn); s1[r] = __builtin_amdgcn_exp2f(s1[r] - mn); ls += s0[r] + s1[r]; }
            ls += __shfl_xor(ls, 32); lrun = lrun * sc + ls;
#pragma unroll
            for (int dt = 0; dt < 4; ++dt)
#pragma unroll
                for (int r = 0; r < 16; ++r) o[dt][r] *= sc;
            bf16x8 pf[4]; pf[0] = pack8(s0, 0); pf[1] = pack8(s0, 8); pf[2] = pack8(s1, 0); pf[3] = pack8(s1, 8);
#pragma unroll
            for (int dt = 0; dt < 4; ++dt)
#pragma unroll
                for (int ks = 0; ks < 4; ++ks) { const LAS unsigned char* vp = L + XA_VT + (dt * 32 + r32) * XA_VSTR + (c * 64 + 16 * ks + 4 * hi) * 2;
                    const u32x2 lo = *(const LAS u32x2*)vp, hh = *(const LAS u32x2*)(vp + 16); u32x4 w; w.x = lo.x; w.y = lo.y; w.z = hh.x; w.w = hh.y;
                    o[dt] = __builtin_amdgcn_mfma_f32_32x32x16_bf16(__builtin_bit_cast(bf16x8, w), pf[ks], o[dt], 0, 0, 0); }
        }
        const float il = 1.0f / lrun;
        bf16_t* op = Ob + row * XW + h * XD + 4 * hi;
#pragma unroll
        for (int dt = 0; dt < 4; ++dt)
#pragma unroll
            for (int g4 = 0; g4 < 4; ++g4) { u32x2 w; w.x = pg8::cvt_pk_bf16(o[dt][4 * g4] * il, o[dt][4 * g4 + 1] * il); w.y = pg8::cvt_pk_bf16(o[dt][4 * g4 + 2] * il, o[dt][4 * g4 + 3] * il);
                *(u32x2*)(op + dt * 32 + 8 * g4) = w; }
    }
    __syncthreads();
}

constexpr int RT_WSTR = 1028, RT_LG = NE * RT_WSTR * 4  , RT_LCNT = RT_LG + 8 * 16 * 33 * 4  , RT_LBASE = RT_LCNT + 128;
typedef float f32x4v __attribute__((ext_vector_type(4)));
__device__ __forceinline__ void phase_router_mfma(Frame& F) {
    LAS float* wt = (LAS float*)F.lds;
    __syncthreads();
    for (int c = F.tid; c < NE * DM; c += 512) { const int k = c >> 5, e = c & 31; wt[e * RT_WSTR + k] = F.in[I_WROUTER][c] * F.in[I_GMOE][k]; }
    LAS unsigned* lcnt = (LAS unsigned*)(F.lds + RT_LCNT); LAS unsigned* lbase = (LAS unsigned*)(F.lds + RT_LBASE);
    const int lane = F.lane, wid = F.wave, row = lane & 15, kq = lane >> 4;
    LAS float* lg = (LAS float*)(F.lds + RT_LG) + wid * (16 * 33);
    const float* H = WSP(float, WS_H); unsigned* cnt = F.ctl + CW_CNT;
    for (int chunk = F.bid; chunk < T_ / 128; chunk += F.G) {
        if (F.tid < 32) lcnt[F.tid] = 0u;
        __syncthreads();
        const int tok0 = chunk * 128 + wid * 16;
        f32x4 acc0 = {0.f, 0.f, 0.f, 0.f}, acc1 = {0.f, 0.f, 0.f, 0.f}; float ss = 0.f;
        const float* hp = H + (size_t)(tok0 + row) * DM + 4 * kq;
        const LAS float* w0 = wt + row * RT_WSTR + 4 * kq; const LAS float* w1 = w0 + 16 * RT_WSTR;
#pragma unroll 4
        for (int i = 0; i < 64; ++i) { const f32x4 a = *(const f32x4*)(hp + 16 * i); const f32x4 b0 = *(const LAS f32x4*)(w0 + 16 * i), b1 = *(const LAS f32x4*)(w1 + 16 * i);
            ss += (a[0] * a[0] + a[1] * a[1]) + (a[2] * a[2] + a[3] * a[3]);
#pragma unroll
            for (int e = 0; e < 4; ++e) { acc0 = __builtin_amdgcn_mfma_f32_16x16x4f32(a[e], b0[e], acc0, 0, 0, 0); acc1 = __builtin_amdgcn_mfma_f32_16x16x4f32(a[e], b1[e], acc1, 0, 0, 0); } }
        ss += __shfl_xor(ss, 16); ss += __shfl_xor(ss, 32);
        const float rstd = 1.0f / sqrtf(ss * (1.0f / DM) + RMS_EPS);
#pragma unroll
        for (int r = 0; r < 4; ++r) { lg[(4 * kq + r) * 33 + row] = acc0[r]; lg[(4 * kq + r) * 33 + 16 + row] = acc1[r]; }
        asm volatile("s_waitcnt lgkmcnt(0)" ::: "memory");
        int ex[4] = {0, 0, 0, 0}; unsigned lrank[4] = {0u, 0u, 0u, 0u}; const int tk = tok0 + lane;
        if (lane < 16) {
            float v[32];
#pragma unroll
            for (int e = 0; e < 32; ++e) v[e] = lg[lane * 33 + e] * rstd + F.in[I_BROUTER][e];
            float tv[4];
#pragma unroll
            for (int s = 0; s < 4; ++s) { float bv = v[0]; int bi = 0;
#pragma unroll
                for (int e = 1; e < 32; ++e) if (v[e] > bv) { bv = v[e]; bi = e; }
#pragma unroll
                for (int e = 0; e < 32; ++e) v[e] = (e == bi) ? -3e38f : v[e];
                tv[s] = bv; ex[s] = bi; }
            const float e1 = __expf(tv[1] - tv[0]), e2 = __expf(tv[2] - tv[0]), e3 = __expf(tv[3] - tv[0]); const float inv = 1.0f / (1.0f + e1 + e2 + e3);
            WSP(float, WS_RSTD2)[tk] = rstd;
            *(f32x4*)(WSP(float, WS_TKG) + (size_t)tk * 4) = (f32x4){inv, e1 * inv, e2 * inv, e3 * inv};
#pragma unroll
            for (int s = 0; s < 4; ++s) lrank[s] = __hip_atomic_fetch_add(&lcnt[ex[s]], 1u, __ATOMIC_RELAXED, __HIP_MEMORY_SCOPE_WORKGROUP);
        }
        __syncthreads();
        if (F.tid < 32) lbase[F.tid] = atomicAdd(&cnt[F.tid], lcnt[F.tid]);
        __syncthreads();
        if (lane < 16) {
#pragma unroll
            for (int s = 0; s < 4; ++s) WSP(int, WS_ROWLIST)[(size_t)ex[s] * T_ + lbase[ex[s]] + lrank[s]] = tk * 4 + s; }
        __syncthreads();
    }
}

__device__ __forceinline__ void phase_final(Frame& F) {
    const int gw = F.bid * 8 + F.wave, NGW = F.G * 8, lane = F.lane;
    const float* H = WSP(float, WS_H); const bf16_t* Y = WSP(bf16_t, WS_Y);
    for (int tk = gw; tk < T_; tk += NGW) {
        const f32x4* hp = (const f32x4*)(H + (size_t)tk * DM) + lane; f32x4 hv[4];
#pragma unroll
        for (int j = 0; j < 4; ++j) hv[j] = hp[64 * j];
#pragma unroll
        for (int s = 0; s < 4; ++s) { const u32x2* yp = (const u32x2*)(Y + ((size_t)tk * 4 + s) * DM) + lane;
#pragma unroll
            for (int j = 0; j < 4; ++j) { const u32x2 w = yp[64 * j]; hv[j][0] += bflo(w.x); hv[j][1] += bfhi(w.x); hv[j][2] += bflo(w.y); hv[j][3] += bfhi(w.y); } }
        float ss = 0.f;
#pragma unroll
        for (int j = 0; j < 4; ++j) ss += (hv[j][0] * hv[j][0] + hv[j][1] * hv[j][1]) + (hv[j][2] * hv[j][2] + hv[j][3] * hv[j][3]);
        float rstd = 1.0f / sqrtf(wave_sum(ss) * (1.0f / DM) + RMS_EPS);
#if DBG_STAGE
        { const float sd = __hip_atomic_load((float*)(F.ctl + CW_DBG), RLX_AGENT), sr = __hip_atomic_load((float*)(F.ctl + CW_DBG + 1), RLX_AGENT); rstd *= 1.0f + sqrtf(100.0f * sd / fmaxf(sr, 1e-30f)); }
#endif
        f32x4* op = (f32x4*)(F.out + (size_t)tk * DM) + lane;
#pragma unroll
        for (int j = 0; j < 4; ++j) op[64 * j] = hv[j] * rstd * ((const f32x4*)F.in[I_GFINAL])[lane + 64 * j];
    }
}


__device__ __forceinline__ void dbg_compare(Frame& F, const bf16_t* A, const bf16_t* R, size_t n) {
    float sd = 0.f, sr = 0.f;
    for (size_t i = (size_t)F.bid * 512 + F.tid; i < n; i += (size_t)F.G * 512) { const float a = bf2f(A[i]), r = bf2f(R[i]); sd += (a - r) * (a - r); sr += r * r; }
    sd = wave_sum(sd); sr = wave_sum(sr);
    if (F.lane == 0) { atomicAdd((float*)(F.ctl + CW_DBG), sd); atomicAdd((float*)(F.ctl + CW_DBG + 1), sr); }
}
constexpr int N_PHASES = 15;
__global__ void __launch_bounds__(512, 2) mega_fwd(Args args) {
    extern __shared__ __attribute__((aligned(16))) unsigned char lds_raw[];
    Frame F;
    F.lds = (LAS unsigned char*)lds_raw; F.tid = threadIdx.x; F.lane = F.tid & 63; F.wave = __builtin_amdgcn_readfirstlane(F.tid >> 6); F.G = gridDim.x; F.bid = blockIdx.x;
#pragma unroll
    for (int i = 0; i < 28; ++i) F.in[i] = args.in[i];
    F.out = args.out; F.ws = args.ws; F.ctl = (unsigned*)(args.ws + WS_CTL);
    volatile LAS unsigned* MISC = (volatile LAS unsigned*)(F.lds + MISC_OFF);
    if (F.tid < 64) MISC[F.tid] = 0u;
    __syncthreads();
    const int lo = args.ph_lo, hi = args.ph_hi;
    XcdBarrier bar; bar.bar = F.ctl + CW_BAR; bar.x = 0; bar.st = nullptr;
    if (hi - lo > 1) bar = xcd_barrier_post(F.ctl + CW_BAR, MISC + 8);
#define IN(k) (lo <= (k) && (k) < hi)
#define SEAM(k) do { if (IN(k) && IN((k) + 1)) xcd_barrier(bar); } while (0)
    LAS unsigned char* ring = F.lds;
    const LAS int* gidx = (const LAS int*)(F.lds + GIDX_OFF);

    if (IN(0)) for (int rep_ = 0; rep_ <= ((REP_MASK >> 0) & 1); ++rep_) { if (rep_) xcd_barrier(bar);  for (int tk = F.bid; tk < NG * 8; tk += F.G) p0_ssm_tables(F, tk); phase_prologue(F); } SEAM(0);
    if (IN(1)) for (int rep_ = 0; rep_ <= ((REP_MASK >> 1) & 1); ++rep_) { if (rep_) xcd_barrier(bar);
        { pg8::Gemm g{WSP(bf16_t, WS_XB), WSP(bf16_t, WS_WIN), DM, 0}; pg8::PatchOrder S; S.init(T_ / 256, INW / 256, 8, F.G, F.bid);
          pg8::EpiInProj E{WSP(float, WS_RSTD0), WSP(bf16_t, WS_Q), WSP(bf16_t, WS_K), WSP(bf16_t, WS_V), WSP(bf16_t, WS_U), WSP(bf16_t, WS_SGA), WSP(bf16_t, WS_SGB)};
          pg8::gemm_phase<pg8::EpiInProj, pg8::PatchOrder, false>(ring, g, S, E, gidx); }
        { pg8::Gemm g{WSP(bf16_t, WS_MN), WSP(bf16_t, WS_WXKV), DM, 0}; pg8::PatchOrder S; S.init(NB * MEML / 256, 2 * XW / 256, 4, F.G, F.bid);
          pg8::EpiStore E{WSP(bf16_t, WS_MKV), 2 * XW};
          pg8::gemm_phase<pg8::EpiStore, pg8::PatchOrder, false>(ring, g, S, E, gidx); }
    } SEAM(1);
    if (IN(2)) for (int rep_ = 0; rep_ <= ((REP_MASK >> 2) & 1); ++rep_) { if (rep_) xcd_barrier(bar);  phase_kmean(F); } SEAM(2);
    if (IN(3)) for (int rep_ = 0; rep_ <= ((REP_MASK >> 3) & 1); ++rep_) { if (rep_) xcd_barrier(bar);
        for (int it = F.bid; it < NB * NG; it += F.G) ssm_state_item(F, it / NG, it % NG);
        const attn_body::AttnTensors AT{(const attn_body::bf16*)WSP(bf16_t, WS_Q), (const attn_body::bf16*)WSP(bf16_t, WS_K), (const attn_body::bf16*)WSP(bf16_t, WS_V), (attn_body::bf16*)WSP(bf16_t, WS_ATT), WSP(float, WS_KMEAN)};
        const attn_body::StaticOrder SO((int)F.G, (int)F.bid);
        attn_body::attn_phase<attn_body::StaticOrder>((char*)lds_raw, AT, SO);
    } SEAM(3);
    if (IN(4)) for (int rep_ = 0; rep_ <= ((REP_MASK >> 4) & 1); ++rep_) { if (rep_) xcd_barrier(bar);  phase_ssm_out(F); } SEAM(4);
#if DBG_STAGE == 1
    phase_ssm_simple(F, WSP(bf16_t, WS_MERGED)); xcd_barrier(bar); dbg_compare(F, WSP(bf16_t, WS_YB), WSP(bf16_t, WS_MERGED), (size_t)T_ * SW); xcd_barrier(bar);
#elif DBG_STAGE == 2
    phase_moba_simple(F, WSP(bf16_t, WS_MERGED)); xcd_barrier(bar); dbg_compare(F, WSP(bf16_t, WS_ATT), WSP(bf16_t, WS_MERGED), (size_t)T_ * AW); xcd_barrier(bar);
#endif
    if (IN(5)) for (int rep_ = 0; rep_ <= ((REP_MASK >> 5) & 1); ++rep_) { if (rep_) xcd_barrier(bar);
        pg8::Gemm g{WSP(bf16_t, WS_YB), WSP(bf16_t, WS_WGLU), SW, 0}; pg8::PatchOrder S; S.init(T_ / 256, 2 * DM / 256, 8, F.G, F.bid);
        pg8::EpiGlu E{WSP(bf16_t, WS_SGB), WSP(bf16_t, WS_YB2S)};
        pg8::gemm_phase<pg8::EpiGlu, pg8::PatchOrder, false>(ring, g, S, E, gidx);
    } SEAM(5);
    if (IN(6)) for (int rep_ = 0; rep_ <= ((REP_MASK >> 6) & 1); ++rep_) { if (rep_) xcd_barrier(bar);
        pg8::Gemm g{WSP(bf16_t, WS_ATT), WSP(bf16_t, WS_WPA), AW, 0}; pg8::PatchOrder S; S.init(T_ / 256, DM / 256, 4, F.G, F.bid);
        pg8::EpiMerge E{WSP(bf16_t, WS_SGA), WSP(bf16_t, WS_YB2S), WSP(bf16_t, WS_MERGED)};
        pg8::gemm_phase<pg8::EpiMerge, pg8::PatchOrder, false>(ring, g, S, E, gidx);
    } SEAM(6);
    if (IN(7)) for (int rep_ = 0; rep_ <= ((REP_MASK >> 7) & 1); ++rep_) { if (rep_) xcd_barrier(bar);
        pg8::Gemm g{WSP(bf16_t, WS_MERGED), WSP(bf16_t, WS_WOUT), DM, 0}; pg8::PatchOrder S; S.init(T_ / 256, DM / 256, 4, F.G, F.bid);
        pg8::EpiResid E{F.in[I_X], WSP(float, WS_H), WSP(bf16_t, WS_HB), WSP(float, WS_SSQ1)};
        pg8::gemm_phase<pg8::EpiResid, pg8::PatchOrder, false>(ring, g, S, E, gidx);
    } SEAM(7);
    if (IN(8)) for (int rep_ = 0; rep_ <= ((REP_MASK >> 8) & 1); ++rep_) { if (rep_) xcd_barrier(bar);
        pg8::Gemm g{WSP(bf16_t, WS_HB), WSP(bf16_t, WS_WXQ), DM, 0}; pg8::PatchOrder S; S.init(T_ / 256, XW / 256, 2, F.G, F.bid);
        pg8::EpiXq E{WSP(float, WS_SSQ1), WSP(bf16_t, WS_XQ)};
        pg8::gemm_phase<pg8::EpiXq, pg8::PatchOrder, false>(ring, g, S, E, gidx);
    } SEAM(8);
    if (IN(9)) for (int rep_ = 0; rep_ <= ((REP_MASK >> 9) & 1); ++rep_) { if (rep_) xcd_barrier(bar);  phase_xattn(F); } SEAM(9);
#if DBG_STAGE == 3
    phase_xattn_simple(F, WSP(bf16_t, WS_MERGED)); xcd_barrier(bar); dbg_compare(F, WSP(bf16_t, WS_XO), WSP(bf16_t, WS_MERGED), (size_t)T_ * XW); xcd_barrier(bar);
#endif
    if (IN(10)) for (int rep_ = 0; rep_ <= ((REP_MASK >> 10) & 1); ++rep_) { if (rep_) xcd_barrier(bar);
        pg8::Gemm g{WSP(bf16_t, WS_XO), WSP(bf16_t, WS_WXO), XW, 0}; pg8::PatchOrder S; S.init(T_ / 256, DM / 256, 4, F.G, F.bid);
        pg8::EpiResid E{WSP(float, WS_H), WSP(float, WS_H), WSP(bf16_t, WS_HB), WSP(float, WS_SSQ2)};
        pg8::gemm_phase<pg8::EpiResid, pg8::PatchOrder, false>(ring, g, S, E, gidx);
    } SEAM(10);
    if (IN(11)) for (int rep_ = 0; rep_ <= ((REP_MASK >> 11) & 1); ++rep_) { if (rep_) xcd_barrier(bar);  phase_router_mfma(F); } SEAM(11);
    if (IN(12) || IN(13)) {
        LAS int* pref = (LAS int*)(F.lds + MISC_OFF + 256);
        const unsigned* cnt = F.ctl + CW_CNT;
        __syncthreads();
        if (F.tid == 0) { int a = 0; for (int e = 0; e < NE; ++e) { pref[e] = a; a += ((int)__hip_atomic_load(cnt + e, RLX_AGENT) + 255) >> 8; } pref[NE] = a; }
        __syncthreads();
        const int MT = pref[NE];
        if (IN(12)) for (int rep_ = 0; rep_ <= ((REP_MASK >> 12) & 1); ++rep_) { if (rep_) xcd_barrier(bar);
            MoeOrder S; S.P.init(MT, 2 * DFF / 256, 8, F.G, F.bid); S.pref = pref;
            { LAS int* gw_ = (LAS int*)(F.lds + GIDX_OFF); pg8::Unit u;
              for (int i = 0; i < GIDX_UNITS && S.next(i, u); ++i) { const int ce = (int)__hip_atomic_load(cnt + u.e, RLX_AGENT);
                  if (F.tid < 256) { const int rank = u.mi * 256 + F.tid; gw_[i * 256 + F.tid] = (rank < ce) ? (WSP(int, WS_ROWLIST)[(size_t)u.e * T_ + rank] >> 2) : 0; } } }
            __syncthreads();
            pg8::Gemm g{WSP(bf16_t, WS_HB), WSP(bf16_t, WS_WGU), DM, (size_t)2 * DFF * DM};
            pg8::EpiMoe1 E{WSP(float, WS_RSTD2), F.in[I_BGU], WSP(bf16_t, WS_HID), gidx};
            pg8::gemm_phase<pg8::EpiMoe1, MoeOrder, true>(ring, g, S, E, gidx);
        }
        SEAM(12);
        if (IN(13)) for (int rep_ = 0; rep_ <= ((REP_MASK >> 13) & 1); ++rep_) { if (rep_) xcd_barrier(bar);
            MoeOrder S; S.P.init(MT, DM / 256, 4, F.G, F.bid); S.pref = pref;
            pg8::Gemm g{WSP(bf16_t, WS_HID), WSP(bf16_t, WS_WDN), DFF, (size_t)DM * DFF};
            pg8::EpiMoe2 E{F.in[I_BDN], WSP(float, WS_TKG), WSP(int, WS_ROWLIST), cnt, WSP(bf16_t, WS_Y)};
            pg8::gemm_phase<pg8::EpiMoe2, MoeOrder, false>(ring, g, S, E, gidx);
        }
    } SEAM(13);
    if (IN(14)) for (int rep_ = 0; rep_ <= ((REP_MASK >> 14) & 1); ++rep_) { if (rep_) xcd_barrier(bar);  phase_final(F); }
#undef IN
#undef SEAM
}

extern "C" void kernel_launch(void* const* d_in, const int* in_sizes, int n_in, void* d_out, int out_size, void* d_ws, size_t ws_size, hipStream_t stream) {
    static int grid = 0;
    if (grid == 0) {
        if (n_in != 28 || in_sizes[0] != T_ * DM || out_size != T_ * DM || ws_size < WS_END) { fprintf(stderr, "kernel_launch: unexpected shapes (n_in %d, in0 %d, out %d, ws %zu)\n", n_in, n_in > 0 ? in_sizes[0] : -1, out_size, ws_size); grid = -1; return; }
        int dev = 0, cus = 0;
        if (hipGetDevice(&dev) != hipSuccess || hipDeviceGetAttribute(&cus, hipDeviceAttributeMultiprocessorCount, dev) != hipSuccess) { grid = -1; return; }
        if (hipFuncSetAttribute((const void*)mega_fwd, hipFuncAttributeMaxDynamicSharedMemorySize, LDS_BYTES) != hipSuccess) { fprintf(stderr, "kernel_launch: hipFuncSetAttribute failed\n"); grid = -1; return; }
        (void)hipGetLastError();
        grid = cus;
    }
    if (grid < 0) return;
    (void)hipMemsetAsync((char*)d_ws + WS_CTL, 0, CTL_ZERO_BYTES, stream);
    Args a{};
    for (int i = 0; i < 28; ++i) a.in[i] = (const float*)d_in[i];
    a.out = (float*)d_out; a.ws = (unsigned char*)d_ws;
#if MK_N_LAUNCHES == 1
    a.ph_lo = 0; a.ph_hi = N_PHASES;
    hipLaunchKernelGGL(mega_fwd, dim3(grid), dim3(512), LDS_BYTES, stream, a);
#else
    for (int p = 0; p < N_PHASES; ++p) { a.ph_lo = p; a.ph_hi = p + 1; hipLaunchKernelGGL(mega_fwd, dim3(grid), dim3(512), LDS_BYTES, stream, a); }
#endif
}
```

```cpp
#include <hip/hip_runtime.h>
#include <hip/hip_bf16.h>
#include <cmath>
#include <cstdio>
#include <cstdint>

#ifndef MK_N_LAUNCHES
#define MK_N_LAUNCHES 1
#endif

#ifndef REP_MASK
#define REP_MASK 0
#endif
#ifndef DBG_STAGE
#define DBG_STAGE 0
#endif

#define GAS __attribute__((address_space(1)))
#define LAS __attribute__((address_space(3)))
typedef unsigned short bf16_t;
typedef short bf16x8 __attribute__((ext_vector_type(8)));
typedef float f32x4 __attribute__((ext_vector_type(4)));
typedef float f32x2 __attribute__((ext_vector_type(2)));
typedef unsigned u32x4 __attribute__((ext_vector_type(4)));
typedef unsigned u32x2 __attribute__((ext_vector_type(2)));

constexpr int NB = 4, SEQ = 8192, DM = 1024, T_ = NB * SEQ;
constexpr int AW = 512, NH = 8, HD = 64, MBLK = 256, NBLK = SEQ / MBLK, MTOPK = 3;
constexpr int SW = 512, SGC = 16, NG = 32, SP = 64;
constexpr int INW = 4096;
constexpr int MEML = 256, XH = 4, XD = 128, XW = 512;
constexpr int NE = 32, ETOPK = 4, DFF = 1024;
constexpr float RMS_EPS = 1e-6f;
constexpr float LOG2E = 1.4426950408889634f;
constexpr float QSCALE = 0.125f * LOG2E;
constexpr float XSCALE = 0.08838834764831845f * LOG2E;
constexpr int HID_ROWS = ETOPK * T_ + NE * 256;

constexpr size_t MiB = 1u << 20;
constexpr size_t WS_WIN = 0 * MiB, WS_WGLU = 8 * MiB, WS_WPA = 10 * MiB, WS_WOUT = 11 * MiB, WS_WXQ = 13 * MiB, WS_WXKV = 14 * MiB, WS_WXO = 16 * MiB,
                 WS_WGU = 17 * MiB, WS_WDN = 145 * MiB;
constexpr size_t WS_CTL = 209 * MiB, CTL_ZERO_BYTES = 1 * MiB;
constexpr size_t WS_RSTD0 = 210 * MiB;
constexpr size_t WS_RSTD2 = WS_RSTD0 + 128 * 1024;
constexpr size_t WS_KMEAN = WS_RSTD2 + 128 * 1024;
constexpr size_t WS_KM2 = WS_KMEAN;
constexpr size_t WS_TKG = 224 * MiB;
constexpr size_t WS_SSQ1 = 211 * MiB;
constexpr size_t WS_SSQ2 = 213 * MiB;
constexpr size_t WS_ROWLIST = 215 * MiB;
constexpr size_t WS_MN = 219 * MiB;
constexpr size_t WS_MKV = 221 * MiB;
constexpr size_t WS_MVT = 223 * MiB;
constexpr size_t WS_WST = 225 * MiB;
constexpr size_t WS_GT = 233 * MiB;
constexpr size_t WS_KT = 241 * MiB;
constexpr size_t WS_LAML = 243 * MiB;
constexpr size_t WS_SST = 244 * MiB;
constexpr size_t WS_H = 256 * MiB;
constexpr size_t WS_HB = 384 * MiB;
constexpr size_t WS_HID = 448 * MiB;
constexpr size_t WS_Y = 720 * MiB;
constexpr size_t WS_END = 976 * MiB;
constexpr size_t WS_XB = 448 * MiB, WS_Q = 512 * MiB, WS_K = 544 * MiB, WS_V = 576 * MiB, WS_U = 608 * MiB, WS_ATT = 640 * MiB, WS_YB = 672 * MiB;
constexpr size_t WS_SGA = 720 * MiB, WS_SGB = 784 * MiB, WS_YB2S = 848 * MiB, WS_MERGED = 912 * MiB;
constexpr size_t WS_XQ = 448 * MiB, WS_XO = 480 * MiB;
static_assert(WS_HID + (size_t)HID_ROWS * DFF * 2 <= WS_Y, "HID fits");
constexpr int CW_TMO = 0, CW_CNT = 64  , CW_DBG = 128  , CW_BAR = 4096;

constexpr int RING_BYTES = 131072;
constexpr int GIDX_OFF = RING_BYTES, GIDX_UNITS = 24;
constexpr int MISC_OFF = GIDX_OFF + GIDX_UNITS * 1024;
constexpr int LDS_BYTES = 163840;

#define RLX_AGENT __ATOMIC_RELAXED, __HIP_MEMORY_SCOPE_AGENT
__device__ __forceinline__ unsigned f2bf(float f) { unsigned u = __builtin_bit_cast(unsigned, f); return (u + 0x7fffu + ((u >> 16) & 1u)) >> 16; }
__device__ __forceinline__ unsigned pk2(float lo, float hi) { return f2bf(lo) | (f2bf(hi) << 16); }
__device__ __forceinline__ float bf2f(unsigned short b) { return __builtin_bit_cast(float, (unsigned)b << 16); }
__device__ __forceinline__ float bflo(unsigned w) { return __builtin_bit_cast(float, w << 16); }
__device__ __forceinline__ float bfhi(unsigned w) { return __builtin_bit_cast(float, w & 0xffff0000u); }
__device__ __forceinline__ float wave_sum(float v) {
#pragma unroll
    for (int o = 1; o < 64; o <<= 1) v += __shfl_xor(v, o);
    return v;
}
__device__ __forceinline__ float fsigmoid(float x) { return __builtin_amdgcn_rcpf(1.0f + __builtin_amdgcn_exp2f(-x * LOG2E)); }
__device__ __forceinline__ float gelu_tanh(float x) {
    const float u = 0.7978845608028654f * (x + 0.044715f * x * x * x);
    return x * fsigmoid(2.0f * u);
}

namespace pg8 {
constexpr int BM = 256, BK = 64, HALF = 128, HTB = HALF * BK * 2, STAGE_BYTES = 8 * HTB;
__host__ __device__ __forceinline__ int lds_byte(int r, int c) { const int st = (r >> 4) * 2 + (c >> 5), rr = r & 15, cc = c & 31, ob = rr * 64 + cc * 2; return st * 1024 + (ob ^ (((ob >> 9) & 1) << 5)); }
__host__ __device__ __forceinline__ void stage_rc(int b, int& R, int& C) { const int st = b / 1024, sb = b % 1024, swz = sb ^ (((sb >> 9) & 1) << 5); R = (st >> 1) * 16 + swz / 64; C = (st & 1) * 32 + (swz % 64) / 2; }
__host__ __device__ __forceinline__ int perm32(int rho) { const int n = rho >> 4, i = rho & 15; return 8 * (i >> 2) + 4 * n + (i & 3); }

struct Unit { int pm, pn, e, mi, ui; };
struct Gemm { const bf16_t* A; const bf16_t* Bt; int K; size_t b_estride; };

struct PatchOrder {
    int nM, nN, PM, PN, x, j, ok;
    __device__ __forceinline__ void init(int nM_, int nN_, int PN_, int G, int c) { nM = nM_; nN = nN_; PN = PN_; PM = (G / 8) / PN_; x = c & 7; j = c >> 3; ok = ((G & 7) == 0) && (PM * PN == G / 8) && (nN % PN == 0); if (!ok) { x = c; j = G; } }
    __device__ __forceinline__ bool next(int i, Unit& u) const {
        if (!ok) { const long L = (long)i * j + x; if (L >= (long)nM * nN) return false; u.pm = (int)(L / nN); u.pn = (int)(L % nN); u.e = 0; u.mi = u.pm; u.ui = i; return true; }
        const int p = 8 * i + x, npn = nN / PN, pmb = p / npn, pnb = p % npn;
        u.pm = pmb * PM + (j % PM); u.pn = pnb * PN + (j / PM); u.e = 0; u.mi = u.pm; u.ui = i;
        return u.pm < nM;
    }
};

__device__ __forceinline__ unsigned cvt_pk_bf16(float lo, float hi) { unsigned r; asm volatile("v_cvt_pk_bf16_f32 %0, %1, %2" : "=v"(r) : "v"(lo), "v"(hi)); return r; }

template <class Epi, class Sched, bool GATHER>
__device__ __forceinline__ void gemm_phase(LAS unsigned char* lds, const Gemm g, const Sched& S, const Epi& E, const LAS int* gidx) {
    const int tid = threadIdx.x, wid = __builtin_amdgcn_readfirstlane(tid >> 6), lane = tid & 63, wr = wid >> 2, wc = wid & 3, fr = lane & 15, fq = lane >> 4;
    const int K = g.K, nt = K / BK;
    int Ra[2], Ca[2]; unsigned voffB[2];
#pragma unroll
    for (int i = 0; i < 2; ++i) { int R, C; stage_rc(tid * 16 + i * 8192, R, C); const int Rb = Epi::PERM ? ((R & ~31) + perm32(R & 31)) : R;
        Ra[i] = R; Ca[i] = C; voffB[i] = (unsigned)(Rb * K + C) * 2u; }
    const size_t kstep = (size_t)(BK * 2);
    const size_t hstep = (size_t)HALF * K * 2;
    const size_t tstep = 2 * hstep;
    const unsigned ldsw = (unsigned)wid * 1024u;
    const int aoff = lds_byte(wr * 64 + fr, fq * 8), boff = lds_byte(wc * 32 + fr, fq * 8);
#define PG8_SA(b, h) (((b) * 2 + (h)) * HTB)
#define PG8_SB(b, h) ((4 + (b) * 2 + (h)) * HTB)
#define PG8_STAGE(bufoff, gbase, voff) do { _Pragma("unroll") for (int _i = 0; _i < 2; ++_i) \
        __builtin_amdgcn_global_load_lds((const unsigned*)((const char*)(gbase) + (voff)[_i]), (LAS unsigned*)(lds + (bufoff) + ldsw + _i * 8192), 16, 0, 0); } while (0)
#define PG8_LDA(dst, b, h) do { _Pragma("unroll") for (int m = 0; m < 4; ++m) _Pragma("unroll") for (int k = 0; k < 2; ++k) dst[m][k] = *(const LAS bf16x8*)(lds + PG8_SA(b, h) + aoff + m * 2048 + k * 1024); } while (0)
#define PG8_LDB(dst, b, h) do { _Pragma("unroll") for (int n = 0; n < 2; ++n) _Pragma("unroll") for (int k = 0; k < 2; ++k) dst[n][k] = *(const LAS bf16x8*)(lds + PG8_SB(b, h) + boff + n * 2048 + k * 1024); } while (0)
#define PG8_MMA(ai, bj, At, Bt) do { __builtin_amdgcn_s_setprio(1); _Pragma("unroll") for (int m = 0; m < 4; ++m) _Pragma("unroll") for (int n = 0; n < 2; ++n) _Pragma("unroll") for (int k = 0; k < 2; ++k) \
        acc[ai][bj][m][n] = __builtin_amdgcn_mfma_f32_16x16x32_bf16(Bt[n][k], At[m][k], acc[ai][bj][m][n], 0, 0, 0); __builtin_amdgcn_s_setprio(0); } while (0)
#define PG8_WAIT_V(n) asm volatile("s_waitcnt vmcnt(" #n ")" ::: "memory")
#define PG8_WAIT_L(n) asm volatile("s_waitcnt lgkmcnt(" #n ")" ::: "memory")
#define PG8_BAR __builtin_amdgcn_s_barrier()
#define PG8_SCHED __builtin_amdgcn_sched_barrier(0)
#define PG8_VOA(dst, u) do { _Pragma("unroll") for (int _h = 0; _h < 2; ++_h) _Pragma("unroll") for (int _i = 0; _i < 2; ++_i) { \
        const int _row = GATHER ? gidx[(u).ui * 256 + _h * HALF + Ra[_i]] : (_h * HALF + Ra[_i]); dst[_h][_i] = (unsigned)(_row * K + Ca[_i]) * 2u; } } while (0)
    Unit cur, nxt; int ui = 0;
    if (!S.next(0, cur)) return;
    f32x4 acc[2][2][4][2];
#pragma unroll
    for (int a = 0; a < 2; ++a)
#pragma unroll
        for (int b = 0; b < 2; ++b)
#pragma unroll
            for (int m = 0; m < 4; ++m)
#pragma unroll
                for (int n = 0; n < 2; ++n) acc[a][b][m][n] = (f32x4){0.f, 0.f, 0.f, 0.f};
    bf16x8 At[4][2], B0[2][2], B1[2][2];
    unsigned voA[2][2], voN[2][2];
    PG8_VOA(voA, cur);
    const char* cA = (const char*)g.A + (GATHER ? (size_t)0 : (size_t)cur.pm * tstep);
    const char* cB = (const char*)g.Bt + ((size_t)cur.e * g.b_estride) * 2 + (size_t)cur.pn * tstep;
    PG8_STAGE(PG8_SB(0, 0), cB, voffB); PG8_STAGE(PG8_SB(0, 1), cB + hstep, voffB); PG8_STAGE(PG8_SA(0, 0), cA, voA[0]); PG8_STAGE(PG8_SA(0, 1), cA, voA[1]);
    if (wr == 1) PG8_BAR;
    PG8_WAIT_V(2); PG8_BAR;
    PG8_STAGE(PG8_SB(1, 0), cB + kstep, voffB); PG8_STAGE(PG8_SA(1, 0), cA + kstep, voA[0]); PG8_STAGE(PG8_SB(1, 1), cB + hstep + kstep, voffB);
    PG8_WAIT_V(6); PG8_BAR;
    for (;;) {
        const bool has_next = S.next(ui + 1, nxt);
        const char* nA = cA; const char* nB = cB;
#pragma unroll
        for (int h = 0; h < 2; ++h)
#pragma unroll
            for (int i = 0; i < 2; ++i) voN[h][i] = voA[h][i];
        if (has_next) { nA = (const char*)g.A + (GATHER ? (size_t)0 : (size_t)nxt.pm * tstep); nB = (const char*)g.Bt + ((size_t)nxt.e * g.b_estride) * 2 + (size_t)nxt.pn * tstep; PG8_VOA(voN, nxt); }
        for (int t = 0; t < nt; t += 2) {
            const bool last = (t == nt - 2);
            const char* a1 = cA + (size_t)(t + 1) * kstep;
            const char* a2 = last ? nA : cA + (size_t)(t + 2) * kstep; const char* b2 = last ? nB : cB + (size_t)(t + 2) * kstep;
            const char* a3 = a2 + kstep; const char* b3 = b2 + kstep;
            unsigned vo2[2][2];
#pragma unroll
            for (int h = 0; h < 2; ++h)
#pragma unroll
                for (int i = 0; i < 2; ++i) vo2[h][i] = last ? voN[h][i] : voA[h][i];
            PG8_LDB(B0, 0, 0); PG8_LDB(B1, 0, 1); PG8_SCHED; PG8_LDA(At, 0, 0); PG8_STAGE(PG8_SA(1, 1), a1, voA[1]);
            PG8_WAIT_V(8); PG8_WAIT_L(0); PG8_BAR; PG8_MMA(0, 0, At, B0); PG8_MMA(0, 1, At, B1); PG8_BAR; PG8_SCHED;
            PG8_LDA(At, 0, 1); PG8_STAGE(PG8_SB(0, 0), b2, voffB); PG8_STAGE(PG8_SB(0, 1), b2 + hstep, voffB); PG8_STAGE(PG8_SA(0, 0), a2, vo2[0]);
            PG8_WAIT_V(8); PG8_WAIT_L(0); PG8_BAR; PG8_MMA(1, 0, At, B0); PG8_MMA(1, 1, At, B1); PG8_BAR; PG8_SCHED;
            PG8_LDB(B0, 1, 0); PG8_LDB(B1, 1, 1); PG8_SCHED; PG8_LDA(At, 1, 0); PG8_STAGE(PG8_SA(0, 1), a2, vo2[1]);
            PG8_WAIT_V(8); PG8_WAIT_L(0); PG8_BAR; PG8_MMA(0, 0, At, B0); PG8_MMA(0, 1, At, B1); PG8_BAR; PG8_SCHED;
            PG8_LDA(At, 1, 1); PG8_STAGE(PG8_SB(1, 0), b3, voffB); PG8_STAGE(PG8_SB(1, 1), b3 + hstep, voffB); PG8_STAGE(PG8_SA(1, 0), a3, vo2[0]);
            PG8_WAIT_V(8); PG8_WAIT_L(0); PG8_BAR; PG8_MMA(1, 0, At, B0); PG8_MMA(1, 1, At, B1); PG8_BAR; PG8_SCHED;
        }
        if (wr == 0) PG8_BAR;
        E(acc, cur, wr, wc, fr, fq);
        if (!has_next) break;
#pragma unroll
        for (int a = 0; a < 2; ++a)
#pragma unroll
            for (int b = 0; b < 2; ++b)
#pragma unroll
                for (int m = 0; m < 4; ++m)
#pragma unroll
                    for (int n = 0; n < 2; ++n) acc[a][b][m][n] = (f32x4){0.f, 0.f, 0.f, 0.f};
        cur = nxt; cA = nA; cB = nB; ++ui;
#pragma unroll
        for (int h = 0; h < 2; ++h)
#pragma unroll
            for (int i = 0; i < 2; ++i) voA[h][i] = voN[h][i];
        if (wr == 1) PG8_BAR;
    }
    PG8_WAIT_V(0);
    PG8_BAR;
#undef PG8_SA
#undef PG8_SB
#undef PG8_STAGE
#undef PG8_LDA
#undef PG8_LDB
#undef PG8_MMA
#undef PG8_WAIT_V
#undef PG8_WAIT_L
#undef PG8_BAR
#undef PG8_SCHED
#undef PG8_VOA
}

typedef const f32x4 (&AccRef)[2][2][4][2];
#define EPI_ROWS for (int ai = 0; ai < 2; ++ai) _Pragma("unroll") for (int m = 0; m < 4; ++m)

struct EpiInProj {
    static constexpr bool PERM = true;
    const float* rstd; bf16_t *Q, *Kb, *V, *U, *SGA, *SGB; float* KM2;
    __device__ __forceinline__ void operator()(AccRef acc, const Unit& u, int wr, int wc, int fr, int fq) const {
        bf16_t* dst; int ld, colt; bool sig = false; float sc = 1.f;
        if (u.pn < 2) { dst = Q; ld = AW; colt = u.pn * 256; sc = QSCALE; }
        else if (u.pn < 4) { dst = Kb; ld = AW; colt = (u.pn - 2) * 256; }
        else if (u.pn < 6) { dst = V; ld = AW; colt = (u.pn - 4) * 256; }
        else if (u.pn < 8) { dst = U; ld = AW; colt = (u.pn - 6) * 256; }
        else if (u.pn < 12) { dst = SGA; ld = DM; colt = (u.pn - 8) * 256; sig = true; }
        else { dst = SGB; ld = DM; colt = (u.pn - 12) * 256; sig = true; }
        const int row0 = u.pm * BM + wr * 64 + fr, col0 = colt + wc * 32 + 8 * fq;
        const bool isk = (u.pn == 2 || u.pn == 3); f32x4 cs[2][2];
#pragma unroll
        for (int bj = 0; bj < 2; ++bj)
#pragma unroll
            for (int n = 0; n < 2; ++n) cs[bj][n] = (f32x4){0.f, 0.f, 0.f, 0.f};
#pragma unroll
        EPI_ROWS { const int row = row0 + ai * HALF + m * 16; const float rs = rstd[row] * sc; bf16_t* rowp = dst + (size_t)row * ld + col0;
#pragma unroll
            for (int bj = 0; bj < 2; ++bj) { f32x4 v0 = acc[ai][bj][m][0] * rs, v1 = acc[ai][bj][m][1] * rs;
                cs[bj][0] += v0; cs[bj][1] += v1;
                if (sig) {
#pragma unroll
                    for (int e = 0; e < 4; ++e) { v0[e] = fsigmoid(v0[e]); v1[e] = fsigmoid(v1[e]); } }
                u32x4 w; w.x = cvt_pk_bf16(v0[0], v0[1]); w.y = cvt_pk_bf16(v0[2], v0[3]); w.z = cvt_pk_bf16(v1[0], v1[1]); w.w = cvt_pk_bf16(v1[2], v1[3]);
                *(u32x4*)(rowp + bj * HALF) = w; } }
        if (isk) {
#pragma unroll
            for (int bj = 0; bj < 2; ++bj)
#pragma unroll
                for (int n = 0; n < 2; ++n)
#pragma unroll
                    for (int e = 0; e < 4; ++e) { float v = cs[bj][n][e]; v += __shfl_xor(v, 1); v += __shfl_xor(v, 2); v += __shfl_xor(v, 4); v += __shfl_xor(v, 8); cs[bj][n][e] = v; }
            if (fr == 0) { const int b = u.pm / NBLK, j = u.pm % NBLK;
#pragma unroll
                for (int bj = 0; bj < 2; ++bj) { const int col = colt + bj * HALF + wc * 32 + 8 * fq, h = col >> 6, d = col & 63;
                    float* kp = KM2 + ((((size_t)wr * NB + b) * NH + h) * NBLK + j) * HD + d;
                    *(f32x4*)kp = cs[bj][0] * (1.0f / MBLK); *(f32x4*)(kp + 4) = cs[bj][1] * (1.0f / MBLK); } } }
    }
};
struct EpiStore {
    static constexpr bool PERM = true;
    bf16_t* O; int ld;
    __device__ __forceinline__ void operator()(AccRef acc, const Unit& u, int wr, int wc, int fr, int fq) const {
        const int row0 = u.pm * BM + wr * 64 + fr, col0 = u.pn * BM + wc * 32 + 8 * fq;
#pragma unroll
        EPI_ROWS { bf16_t* rowp = O + (size_t)(row0 + ai * HALF + m * 16) * ld + col0;
#pragma unroll
            for (int bj = 0; bj < 2; ++bj) { const f32x4 v0 = acc[ai][bj][m][0], v1 = acc[ai][bj][m][1];
                u32x4 w; w.x = cvt_pk_bf16(v0[0], v0[1]); w.y = cvt_pk_bf16(v0[2], v0[3]); w.z = cvt_pk_bf16(v1[0], v1[1]); w.w = cvt_pk_bf16(v1[2], v1[3]);
                *(u32x4*)(rowp + bj * HALF) = w; } }
    }
};
struct EpiMemKV {
    static constexpr bool PERM = true;
    bf16_t* O; bf16_t* VT;
    __device__ __forceinline__ void operator()(AccRef acc, const Unit& u, int wr, int wc, int fr, int fq) const {
        const int rl0 = wr * 64 + fr, col0 = u.pn * BM + wc * 32 + 8 * fq;
#pragma unroll
        EPI_ROWS { const int rl = rl0 + ai * HALF + m * 16;
#pragma unroll
            for (int bj = 0; bj < 2; ++bj) { const f32x4 v0 = acc[ai][bj][m][0], v1 = acc[ai][bj][m][1]; const int col = col0 + bj * HALF;
                if (u.pn < 2) { u32x4 w; w.x = cvt_pk_bf16(v0[0], v0[1]); w.y = cvt_pk_bf16(v0[2], v0[3]); w.z = cvt_pk_bf16(v1[0], v1[1]); w.w = cvt_pk_bf16(v1[2], v1[3]);
                    *(u32x4*)(O + (size_t)(u.pm * BM + rl) * (2 * XW) + col) = w; }
                else { bf16_t* vp = VT + ((size_t)u.pm * XW + (col - XW)) * MEML + rl;
#pragma unroll
                    for (int e = 0; e < 4; ++e) { vp[(size_t)e * MEML] = (bf16_t)f2bf(v0[e]); vp[(size_t)(4 + e) * MEML] = (bf16_t)f2bf(v1[e]); } } } }
    }
};
struct EpiGlu {
    static constexpr bool PERM = true;
    const bf16_t* SGB; bf16_t* O;
    __device__ __forceinline__ void operator()(AccRef acc, const Unit& u, int wr, int wc, int fr, int fq) const {
        const int row0 = u.pm * BM + wr * 64 + fr, col0 = u.pn * HALF + wc * 32 + 8 * fq;
#pragma unroll
        EPI_ROWS { const size_t off = (size_t)(row0 + ai * HALF + m * 16) * DM + col0; const u32x4 s = *(const u32x4*)(SGB + off);
            const f32x4 v0 = acc[ai][0][m][0], v1 = acc[ai][0][m][1], g0 = acc[ai][1][m][0], g1 = acc[ai][1][m][1];
            float o[8];
#pragma unroll
            for (int e = 0; e < 4; ++e) { o[e] = v0[e] * fsigmoid(g0[e]); o[4 + e] = v1[e] * fsigmoid(g1[e]); }
            o[0] *= bflo(s.x); o[1] *= bfhi(s.x); o[2] *= bflo(s.y); o[3] *= bfhi(s.y); o[4] *= bflo(s.z); o[5] *= bfhi(s.z); o[6] *= bflo(s.w); o[7] *= bfhi(s.w);
            u32x4 w; w.x = cvt_pk_bf16(o[0], o[1]); w.y = cvt_pk_bf16(o[2], o[3]); w.z = cvt_pk_bf16(o[4], o[5]); w.w = cvt_pk_bf16(o[6], o[7]);
            *(u32x4*)(O + off) = w; }
    }
};
struct EpiMerge {
    static constexpr bool PERM = true;
    const bf16_t* SGA; const bf16_t* Y2; bf16_t* O;
    __device__ __forceinline__ void operator()(AccRef acc, const Unit& u, int wr, int wc, int fr, int fq) const {
        const int row0 = u.pm * BM + wr * 64 + fr, col0 = u.pn * BM + wc * 32 + 8 * fq;
#pragma unroll
        EPI_ROWS {
#pragma unroll
            for (int bj = 0; bj < 2; ++bj) { const size_t off = (size_t)(row0 + ai * HALF + m * 16) * DM + col0 + bj * HALF;
                const u32x4 s = *(const u32x4*)(SGA + off), y = *(const u32x4*)(Y2 + off); const f32x4 v0 = acc[ai][bj][m][0], v1 = acc[ai][bj][m][1];
                u32x4 w; w.x = cvt_pk_bf16(bflo(s.x) * v0[0] + bflo(y.x), bfhi(s.x) * v0[1] + bfhi(y.x)); w.y = cvt_pk_bf16(bflo(s.y) * v0[2] + bflo(y.y), bfhi(s.y) * v0[3] + bfhi(y.y));
                w.z = cvt_pk_bf16(bflo(s.z) * v1[0] + bflo(y.z), bfhi(s.z) * v1[1] + bfhi(y.z)); w.w = cvt_pk_bf16(bflo(s.w) * v1[2] + bflo(y.w), bfhi(s.w) * v1[3] + bfhi(y.w));
                *(u32x4*)(O + off) = w; } }
    }
};
struct EpiResid {
    static constexpr bool PERM = false;
    const float* base; float* H; bf16_t* HB; float* SSQ;
    __device__ __forceinline__ void operator()(AccRef acc, const Unit& u, int wr, int wc, int fr, int fq) const {
        const int row0 = u.pm * BM + wr * 64 + fr, col0 = u.pn * BM + wc * 32 + 4 * fq;
#pragma unroll
        EPI_ROWS { const int row = row0 + ai * HALF + m * 16; const size_t off = (size_t)row * DM + col0; float ss = 0.f;
#pragma unroll
            for (int bj = 0; bj < 2; ++bj)
#pragma unroll
                for (int n = 0; n < 2; ++n) { const size_t o2 = off + bj * HALF + n * 16; const f32x4 h = *(const f32x4*)(base + o2) + acc[ai][bj][m][n];
                    *(f32x4*)(H + o2) = h; u32x2 w; w.x = cvt_pk_bf16(h[0], h[1]); w.y = cvt_pk_bf16(h[2], h[3]); *(u32x2*)(HB + o2) = w;
                    ss += (h[0] * h[0] + h[1] * h[1]) + (h[2] * h[2] + h[3] * h[3]); }
            ss += __shfl_xor(ss, 16); ss += __shfl_xor(ss, 32);
            if (fq == 0) SSQ[(size_t)row * 16 + u.pn * 4 + wc] = ss; }
    }
};
struct EpiXq {
    static constexpr bool PERM = true;
    const float* SSQ; bf16_t* O;
    __device__ __forceinline__ void operator()(AccRef acc, const Unit& u, int wr, int wc, int fr, int fq) const {
        const int row0 = u.pm * BM + wr * 64 + fr, col0 = u.pn * BM + wc * 32 + 8 * fq;
#pragma unroll
        EPI_ROWS { const int row = row0 + ai * HALF + m * 16; const f32x4* sp = (const f32x4*)(SSQ + (size_t)row * 16);
            const f32x4 a = sp[0] + sp[1] + sp[2] + sp[3]; const float rs = __builtin_amdgcn_rsqf(((a[0] + a[1]) + (a[2] + a[3])) * (1.0f / DM) + RMS_EPS) * XSCALE;
            bf16_t* rowp = O + (size_t)row * XW + col0;
#pragma unroll
            for (int bj = 0; bj < 2; ++bj) { const f32x4 v0 = acc[ai][bj][m][0] * rs, v1 = acc[ai][bj][m][1] * rs;
                u32x4 w; w.x = cvt_pk_bf16(v0[0], v0[1]); w.y = cvt_pk_bf16(v0[2], v0[3]); w.z = cvt_pk_bf16(v1[0], v1[1]); w.w = cvt_pk_bf16(v1[2], v1[3]);
                *(u32x4*)(rowp + bj * HALF) = w; } }
    }
};
struct EpiMoe1 {
    static constexpr bool PERM = true;
    const float* rstd2; const float* bgu; bf16_t* HID; const LAS int* gidx;
    __device__ __forceinline__ void operator()(AccRef acc, const Unit& u, int wr, int wc, int fr, int fq) const {
        const int rl0 = wr * 64 + fr, col0 = u.pn * HALF + wc * 32 + 8 * fq; const float* bg = bgu + (size_t)u.e * (2 * DFF) + col0;
        const f32x4 bg0 = *(const f32x4*)(bg), bg1 = *(const f32x4*)(bg + 4), bu0 = *(const f32x4*)(bg + DFF), bu1 = *(const f32x4*)(bg + DFF + 4);
#pragma unroll
        EPI_ROWS { const int rl = rl0 + ai * HALF + m * 16; const float rs = rstd2[gidx[u.ui * 256 + rl]];
            const f32x4 g0 = acc[ai][0][m][0] * rs + bg0, g1 = acc[ai][0][m][1] * rs + bg1, p0 = acc[ai][1][m][0] * rs + bu0, p1 = acc[ai][1][m][1] * rs + bu1;
            float o[8];
#pragma unroll
            for (int e = 0; e < 4; ++e) { const float ga = fminf(g0[e], 7.0f), gb = fminf(g1[e], 7.0f), ua = fminf(fmaxf(p0[e], -7.0f), 7.0f), ub = fminf(fmaxf(p1[e], -7.0f), 7.0f);
                o[e] = (ua + 1.0f) * ga * fsigmoid(1.702f * ga); o[4 + e] = (ub + 1.0f) * gb * fsigmoid(1.702f * gb); }
            u32x4 w; w.x = cvt_pk_bf16(o[0], o[1]); w.y = cvt_pk_bf16(o[2], o[3]); w.z = cvt_pk_bf16(o[4], o[5]); w.w = cvt_pk_bf16(o[6], o[7]);
            *(u32x4*)(HID + (size_t)(u.pm * BM + rl) * DFF + col0) = w; }
    }
};
struct EpiMoe2 {
    static constexpr bool PERM = true;
    const float* bdn; const float* tkg; const int* rowlist; const unsigned* cnt; bf16_t* Y;
    __device__ __forceinline__ void operator()(AccRef acc, const Unit& u, int wr, int wc, int fr, int fq) const {
        const int rl0 = wr * 64 + fr, col0 = u.pn * BM + wc * 32 + 8 * fq; const float* bd = bdn + (size_t)u.e * DM + col0; const int ce = (int)cnt[u.e];
        f32x4 bv[2][2];
#pragma unroll
        for (int bj = 0; bj < 2; ++bj)
#pragma unroll
            for (int n = 0; n < 2; ++n) bv[bj][n] = *(const f32x4*)(bd + bj * HALF + 4 * n);
#pragma unroll
        EPI_ROWS { const int rank = u.mi * BM + rl0 + ai * HALF + m * 16;
            if (rank < ce) { const int dest = rowlist[(size_t)u.e * T_ + rank]; const float gt = tkg[dest]; bf16_t* rowp = Y + (size_t)dest * DM + col0;
#pragma unroll
                for (int bj = 0; bj < 2; ++bj) { const f32x4 v0 = (acc[ai][bj][m][0] + bv[bj][0]) * gt, v1 = (acc[ai][bj][m][1] + bv[bj][1]) * gt;
                    u32x4 w; w.x = cvt_pk_bf16(v0[0], v0[1]); w.y = cvt_pk_bf16(v0[2], v0[3]); w.z = cvt_pk_bf16(v1[0], v1[1]); w.w = cvt_pk_bf16(v1[2], v1[3]);
                    *(u32x4*)(rowp + bj * HALF) = w; } } }
    }
};
}

struct MoeOrder {
    pg8::PatchOrder P; const LAS int* pref;
    __device__ __forceinline__ bool next(int i, pg8::Unit& u) const {
        if (!P.next(i, u)) return false;
        int e = 0;
#pragma unroll 1
        for (int k = 1; k < NE; ++k) e += (pref[k] <= u.pm) ? 1 : 0;
        u.e = e; u.mi = u.pm - pref[e]; return true;
    }
};

namespace attn_body {
using bf16=__hip_bfloat16;
using bf16x8=__attribute__((ext_vector_type(8)))short;
using s16x4=__attribute__((ext_vector_type(4)))short;
using f32x16=__attribute__((ext_vector_type(16)))float;
using u32x4=__attribute__((ext_vector_type(4)))unsigned;
constexpr int BATCH=4,NHEAD=8,SEQ=8192,D=64,DM=NHEAD*D;
constexpr int NW=8,QBLK=32,QB=QBLK*NW,KVBLK=64,NQB=SEQ/QB;
constexpr int ATTN_PITCH=DM, ATTN_UNIT_ROWS=QB;
__device__ __forceinline__ int crow(int r,int hi){return (r&3)+8*(r>>2)+4*hi;}
#define SBAR() __builtin_amdgcn_sched_barrier(0)
__device__ __forceinline__ void cmask(f32x16&p0,f32x16&p1,int jb,int qrel,int hi){
  const float NEG=-INFINITY; int kb=64*jb+4*hi;
  #pragma unroll
  for(int r=0;r<16;++r){int kv=kb+(r&3)+8*(r>>2); if(kv>qrel)p0[r]=NEG; if(kv+32>qrel)p1[r]=NEG;}
}

constexpr int NSLOT=3, SLOTB=8192;
constexpr int LDS_K=0, LDS_V=NSLOT*SLOTB, LDS_WS=2*NSLOT*SLOTB, LDS_OST=LDS_WS+NW*64*4, LDS_KM=LDS_OST+NW*4096, LDS_SEL=LDS_KM+32*64*4, LDS_BYTES=LDS_SEL+1024;
constexpr float C2=0.125f*1.4426950408889634f;
__device__ __forceinline__ void glds16(const void*gsrc,unsigned lds_dst){unsigned keep;
  asm volatile("s_mov_b32 %0, m0\n\ts_mov_b32 m0, %2\n\ts_nop 0\n\tglobal_load_lds_dwordx4 %1, off\n\ts_mov_b32 m0, %0":"=&s"(keep):"v"(gsrc),"s"(lds_dst):"memory");}
__device__ __forceinline__ float max3f(float a,float b,float c){float r;asm("v_max3_f32 %0, %1, %2, %3":"=v"(r):"v"(a),"v"(b),"v"(c));return r;}
__device__ __forceinline__ float max2f(float a,float b){float r;asm("v_max_f32_e32 %0, %1, %2":"=v"(r):"v"(a),"v"(b));return r;}
__device__ __forceinline__ float fadd_s(float a,float b){float r;asm("v_add_f32_e32 %0, %1, %2":"=v"(r):"v"(a),"v"(b));return r;}
__device__ __forceinline__ float fsub_s(float a,float b){float r;asm("v_sub_f32_e32 %0, %1, %2":"=v"(r):"v"(a),"v"(b));return r;}
typedef float f32x2_t __attribute__((ext_vector_type(2))); typedef __bf16 bf16x2_t __attribute__((ext_vector_type(2)));
__device__ __forceinline__ unsigned cvtpk_s(float lo,float hi){f32x2_t v={lo,hi};bf16x2_t b=__builtin_convertvector(v,bf16x2_t);return __builtin_bit_cast(unsigned,b);}
#define WAIT_BAR(N) asm volatile("s_waitcnt vmcnt(" #N ") lgkmcnt(0)\n\ts_barrier":::"memory")

__device__ __forceinline__ void qkt(f32x16&p0,f32x16&p1,const char*Kslot,const bf16x8*qr,const f32x16&negm,int r32,int hi){
  const char*kb=Kslot+hi*1024+r32*16;
  #pragma unroll
  for(int d0=0;d0<4;++d0){
    const bf16x8 b0=*reinterpret_cast<const bf16x8*>(kb+d0*2048);
    const bf16x8 b1=*reinterpret_cast<const bf16x8*>(kb+d0*2048+512);
    if(d0==0){p0=__builtin_amdgcn_mfma_f32_32x32x16_bf16(b0,qr[0],negm,0,0,0);p1=__builtin_amdgcn_mfma_f32_32x32x16_bf16(b1,qr[0],negm,0,0,0);}
    else{p0=__builtin_amdgcn_mfma_f32_32x32x16_bf16(b0,qr[d0],p0,0,0,0);p1=__builtin_amdgcn_mfma_f32_32x32x16_bf16(b1,qr[d0],p1,0,0,0);}}
}
typedef __attribute__((address_space(3))) const char* lds_cptr;
typedef short v4i16_t __attribute__((ext_vector_type(4)));
__device__ __forceinline__ void kload8(bf16x8*kf,lds_cptr kp){
  kf[0]=*(const __attribute__((address_space(3))) bf16x8*)(kp);      kf[1]=*(const __attribute__((address_space(3))) bf16x8*)(kp+512);
  kf[2]=*(const __attribute__((address_space(3))) bf16x8*)(kp+2048); kf[3]=*(const __attribute__((address_space(3))) bf16x8*)(kp+2560);
  kf[4]=*(const __attribute__((address_space(3))) bf16x8*)(kp+4096); kf[5]=*(const __attribute__((address_space(3))) bf16x8*)(kp+4608);
  kf[6]=*(const __attribute__((address_space(3))) bf16x8*)(kp+6144); kf[7]=*(const __attribute__((address_space(3))) bf16x8*)(kp+6656);
}
__device__ __forceinline__ void kload2(bf16x8*kf,lds_cptr kp,int j){ kf[2*j]=*(const __attribute__((address_space(3))) bf16x8*)(kp+j*2048); kf[2*j+1]=*(const __attribute__((address_space(3))) bf16x8*)(kp+j*2048+512); }
__device__ __forceinline__ s16x4 vtr(lds_cptr p){ return __builtin_bit_cast(s16x4,__builtin_amdgcn_ds_read_tr16_b64_v4i16((__attribute__((address_space(3))) v4i16_t*)p)); }
__device__ __forceinline__ float rowmax(const f32x16&p0,const f32x16&p1){
  float a=max3f(p0[0],p0[1],p1[0]),b=max3f(p0[2],p0[3],p1[1]);a=max3f(a,p1[2],p1[3]);
  #pragma unroll
  for(int r=4;r<16;r+=4){a=max3f(a,p0[r],p0[r+1]);b=max3f(b,p0[r+2],p0[r+3]);a=max3f(a,p1[r],p1[r+1]);b=max3f(b,p1[r+2],p1[r+3]);}
  const float m=max2f(a,b);
  auto rr=__builtin_amdgcn_permlane32_swap(__float_as_uint(m),__float_as_uint(m),false,false);
  return max2f(__uint_as_float(rr[0]),__uint_as_float(rr[1]));
}
__device__ __forceinline__ void pv(f32x16*o,int vb,bf16x8 pa0,bf16x8 pa1,bf16x8 pa2,bf16x8 pa3){
  #pragma unroll
  for(int d0=0;d0<2;++d0){s16x4 lo[4],hi[4];
    #pragma unroll
    for(int ks=0;ks<4;++ks){
      asm volatile("ds_read_b64_tr_b16 %0,%1 offset:%c2":"=&v"(lo[ks]):"v"(vb),"i"(d0*4096+ks*1024):"memory");
      asm volatile("ds_read_b64_tr_b16 %0,%1 offset:%c2":"=&v"(hi[ks]):"v"(vb),"i"(d0*4096+ks*1024+512):"memory");}
    asm volatile("s_waitcnt lgkmcnt(0)":::"memory");SBAR();
    #define PK(k) (bf16x8){lo[k][0],lo[k][1],lo[k][2],lo[k][3],hi[k][0],hi[k][1],hi[k][2],hi[k][3]}
    o[d0]=__builtin_amdgcn_mfma_f32_32x32x16_bf16(pa0,PK(0),o[d0],0,0,0);
    o[d0]=__builtin_amdgcn_mfma_f32_32x32x16_bf16(pa1,PK(1),o[d0],0,0,0);
    o[d0]=__builtin_amdgcn_mfma_f32_32x32x16_bf16(pa2,PK(2),o[d0],0,0,0);
    o[d0]=__builtin_amdgcn_mfma_f32_32x32x16_bf16(pa3,PK(3),o[d0],0,0,0);
    #undef PK
  }
}

#ifndef ATTN_STORE16
#define ATTN_STORE16(p,v) (*(u32x4*)(p)=(v))
#endif
template<int THRL> __device__ __forceinline__ void attn_unit(int b,int h,int qb,const bf16*Q,const bf16*__restrict__ K,const bf16*__restrict__ V,bf16*O,char*shm){
  const int tid=threadIdx.x,lane=tid&63,r32=lane&31,hi=lane>>5; const int wid=__builtin_amdgcn_readfirstlane(tid>>6);
  const long rowbase=(long)b*SEQ; const int q0=qb*QB;
  const bf16*Qw=Q+(rowbase+q0+wid*QBLK)*DM+h*D;
  const bf16*Kh=K+rowbase*DM+h*D,*Vh=V+rowbase*DM+h*D;
  const unsigned lds0=(unsigned)(uintptr_t)shm;
  float*wsf=(float*)(shm+LDS_WS)+wid*64;
  const bf16*ksrc=Kh+(long)lane*DM+wid*8;
  const bf16*vsrc=Vh+(long)(16*(wid&3)+(lane>>2))*DM+(wid>>2)*32+(lane&3)*8;
  const unsigned kdst=lds0+LDS_K+wid*1024, vdst=lds0+LDS_V+wid*1024;
  #define DMA_K(t,slot) glds16(ksrc+(long)(t)*KVBLK*DM,(unsigned)__builtin_amdgcn_readfirstlane(kdst+(slot)))
  #define DMA_V(t,slot) glds16(vsrc+(long)(t)*KVBLK*DM,(unsigned)__builtin_amdgcn_readfirstlane(vdst+(slot)))
  const int vb0=(int)(lds0+LDS_V)+((lane>>4)&1)*32+(lane&3)*8+(4*hi+((lane&15)>>2))*64;
  const char*Kbase=shm+LDS_K; bf16x8 kf[8];
  const lds_cptr shm3=(lds_cptr)shm; const lds_cptr kp0=shm3+LDS_K+hi*1024+r32*16; const lds_cptr vp0=shm3+LDS_V+((lane>>4)&1)*32+(lane&3)*8+(4*hi+((lane&15)>>2))*64;
  const int NT=(q0+QB)/KVBLK;
  DMA_K(0,0);DMA_V(0,0);DMA_K(1,SLOTB);
  bf16x8 qr[4];
  #pragma unroll
  for(int d0=0;d0<4;++d0)qr[d0]=*reinterpret_cast<const bf16x8*>(&Qw[(long)r32*DM+d0*16+hi*8]);
  { int lp_=lane; asm volatile("":"+v"(lp_)); const int r32p=lp_&31, hip=lp_>>5;
    unsigned sel=0u; const __attribute__((address_space(3))) float*km=(const __attribute__((address_space(3))) float*)((__attribute__((address_space(3))) const char*)shm+LDS_KM); float g0=-3e38f,g1=-3e38f,g2=-3e38f; int s0=-1,s1=-1,s2=-1;
    for(int j=0;j<qb;++j){ float g=0.f;
      #pragma unroll
      for(int d0=0;d0<4;++d0){
        #pragma unroll
        for(int e=0;e<8;++e)g+=__builtin_bit_cast(float,((unsigned)(unsigned short)qr[d0][e])<<16)*km[j*64+16*d0+8*hip+e];}
      g+=__shfl_xor(g,32);
      if(g>g0){g2=g1;s2=s1;g1=g0;s1=s0;g0=g;s0=j;}else if(g>g1){g2=g1;s2=s1;g1=g;s1=j;}else if(g>g2){g2=g;s2=j;} }
    if(s0>=0)sel|=1u<<s0; if(s1>=0)sel|=1u<<s1; if(s2>=0)sel|=1u<<s2;
    if(hip==0)((__attribute__((address_space(3))) unsigned*)((__attribute__((address_space(3))) char*)shm+LDS_SEL))[wid*32+r32p]=sel; asm volatile("s_waitcnt lgkmcnt(0)":::"memory"); }
  float mhat=0.f,l_reg=0.f;f32x16 o[2];o[0]=f32x16{};o[1]=f32x16{};f32x16 negm=f32x16{};asm volatile("":"+v"(negm));
  const int qrel=wid*QBLK+r32;
  #define BMASK(P0,P1,t) do{}while(0)
  #define CMASK(P0,P1,t) do{int jb_=(t)-(NT-4); if(jb_>=0)cmask(P0,P1,jb_,qrel,hi); else BMASK(P0,P1,t);}while(0)
  bool resc=false;
  #define START(P0,P1) do{ const float rm=rowmax(P0,P1); resc=false; \
    { const float dl=__builtin_fmaxf(rm,-64.f); mhat=fadd_s(mhat,dl); \
      _Pragma("unroll") for(int r=0;r<16;++r){P0[r]=fsub_s(P0[r],dl);P1[r]=fsub_s(P1[r],dl);} \
      _Pragma("unroll") for(int r=0;r<16;++r)negm[r]=-mhat; asm volatile("":"+v"(negm)); } \
    _Pragma("unroll") for(int r=0;r<16;++r)P0[r]=__builtin_amdgcn_exp2f(P0[r]); }while(0)
  #define RESC() do{ if(resc){ asm volatile("s_waitcnt lgkmcnt(0)":::"memory"); \
      _Pragma("unroll") for(int d_=0;d_<2;++d_) _Pragma("unroll") for(int r=0;r<16;++r)o[d_][r]*=wsf[crow(r,hi)]; } }while(0)
  f32x16 pA0,pA1,pB0,pB1;
  int sl_prev=0,sl_cur=0,sl_next=SLOTB;
  #define ROT() do{sl_prev=sl_cur;sl_cur=sl_next;sl_next=(sl_next==(NSLOT-1)*SLOTB)?0:sl_next+SLOTB;}while(0)
  DMA_K(2,2*SLOTB);
  WAIT_BAR(3);
  qkt(pA0,pA1,Kbase,qr,negm,r32,hi);asm volatile("s_nop 15\n\ts_nop 7":"+v"(pA0),"+v"(pA1));CMASK(pA0,pA1,0);
  START(pA0,pA1);
  _Pragma("unroll") for(int r=0;r<16;++r)pA1[r]=__builtin_amdgcn_exp2f(pA1[r]);
  WAIT_BAR(0);
  DMA_K(3,0);DMA_V(1,SLOTB);
  ROT();
  kload8(kf,kp0+sl_cur);
  WAIT_BAR(2);
  s16x4 vlo[8],vhi[8]; u32x4 pw0,pw1,pw2,pw3;
  #define PKW(P,B) (keep_?cvtpk_s(P[B],P[B+1]):0u)
  #define PAF(k) __builtin_bit_cast(bf16x8,pw##k)
  #define VFR(i) (bf16x8){vlo[i][0],vlo[i][1],vlo[i][2],vlo[i][3],vhi[i][0],vhi[i][1],vhi[i][2],vhi[i][3]}
  #define PIN(x) asm volatile("":"+v"(x))
  #define MX3(a,b,c) __builtin_fmaxf(__builtin_fmaxf((a),(b)),(c))
  #define GAPA(MF,A0,A1,A2,A3,W0,W1,PW) do{ MF; sacc+=A0; sacc+=A1; sacc+=A2; sacc+=A3; PIN(sacc); W0; W1; PIN(PW); SBAR(); }while(0)
  #define EX(v) __builtin_amdgcn_exp2f(v)
  #define GAPB(MF,X,B) do{ MF; X[B]=EX(X[B]); X[B+1]=EX(X[B+1]); X[B+2]=EX(X[B+2]); X[B+3]=EX(X[B+3]); PIN(X); SBAR(); }while(0)
  #define VRD(i) do{ vlo[i]=vtr(vp_+(((i)>>2)*4096+((i)&3)*1024)); vhi[i]=vtr(vp_+(((i)>>2)*4096+((i)&3)*1024+512)); }while(0)
  #define KRD(G,j) do{ if(G){ kload2(kf,kp0+sl_next,j); SBAR(); } }while(0)
  #define STEP(C0,C1,P0,P1,t,GK,GV,GL) do{ SBAR(); \
    int q_=qrel; asm volatile("":"+v"(q_)); const unsigned selw_=((const volatile __attribute__((address_space(3))) unsigned*)((__attribute__((address_space(3))) const char*)shm+LDS_SEL))[q_]; \
    const bool keep_=((t)-1>=NT-4)||((selw_>>(((t)-1)>>2))&1u); \
    const lds_cptr vp_=vp0+sl_prev; \
    VRD(0); SBAR(); float sacc=(P0[0]+P0[1]); \
    GAPA(C0=__builtin_amdgcn_mfma_f32_32x32x16_bf16(kf[0],qr[0],negm,0,0,0), P0[2],P0[3],P0[4],P0[5],     pw0[0]=PKW(P0,0), pw0[1]=PKW(P0,2), pw0); \
    VRD(4); SBAR(); GAPA(C1=__builtin_amdgcn_mfma_f32_32x32x16_bf16(kf[1],qr[0],negm,0,0,0), P0[6],P0[7],P0[8],P0[9],     pw0[2]=PKW(P0,4), pw0[3]=PKW(P0,6), pw0); \
    VRD(1); SBAR(); GAPA(C0=__builtin_amdgcn_mfma_f32_32x32x16_bf16(kf[2],qr[1],C0,0,0,0),   P0[10],P0[11],P0[12],P0[13], pw1[0]=PKW(P0,8), pw1[1]=PKW(P0,10), pw1); \
    VRD(5); SBAR(); GAPA(C1=__builtin_amdgcn_mfma_f32_32x32x16_bf16(kf[3],qr[1],C1,0,0,0),   P0[14],P0[15],P1[0],P1[1],   pw1[2]=PKW(P0,12),pw1[3]=PKW(P0,14), pw1); \
    VRD(2); SBAR(); GAPA(C0=__builtin_amdgcn_mfma_f32_32x32x16_bf16(kf[4],qr[2],C0,0,0,0),   P1[2],P1[3],P1[4],P1[5],     pw2[0]=PKW(P1,0), pw2[1]=PKW(P1,2), pw2); \
    VRD(6); SBAR(); GAPA(C1=__builtin_amdgcn_mfma_f32_32x32x16_bf16(kf[5],qr[2],C1,0,0,0),   P1[6],P1[7],P1[8],P1[9],     pw2[2]=PKW(P1,4), pw2[3]=PKW(P1,6), pw2); \
    VRD(3); SBAR(); GAPA(C0=__builtin_amdgcn_mfma_f32_32x32x16_bf16(kf[6],qr[3],C0,0,0,0),   P1[10],P1[11],P1[12],P1[13], pw3[0]=PKW(P1,8), pw3[1]=PKW(P1,10), pw3); \
    VRD(7); SBAR(); GAPA(C1=__builtin_amdgcn_mfma_f32_32x32x16_bf16(kf[7],qr[3],C1,0,0,0),   P1[14],P1[15],0.f,0.f,       pw3[2]=PKW(P1,12),pw3[3]=PKW(P1,14), pw3); \
    l_reg+=keep_?sacc:0.f; \
    if(GK){DMA_K((t)+3,sl_cur);} if(GV){DMA_V((t)+1,sl_next);} \
    CMASK(C0,C1,t); \
    { float a=MX3(C0[0],C0[1],C1[0]),b=MX3(C0[2],C0[3],C1[1]); a=MX3(a,C1[2],C1[3]); \
      _Pragma("unroll") for(int r=4;r<16;r+=4){a=MX3(a,C0[r],C0[r+1]);b=MX3(b,C0[r+2],C0[r+3]);a=MX3(a,C1[r],C1[r+1]);b=MX3(b,C1[r+2],C1[r+3]);} \
      float rm=__builtin_fmaxf(a,b); { auto rr=__builtin_amdgcn_permlane32_swap(__float_as_uint(rm),__float_as_uint(rm),false,false); rm=__builtin_fmaxf(__uint_as_float(rr[0]),__uint_as_float(rr[1])); } \
      resc=false; \
      if(__builtin_expect(__any(rm>(float)THRL),0)){ const float dl=__builtin_fmaxf(rm,0.f); mhat+=dl; \
        _Pragma("unroll") for(int r=0;r<16;++r){C0[r]-=dl;C1[r]-=dl;} \
        _Pragma("unroll") for(int r=0;r<16;++r)negm[r]=-mhat; asm volatile("":"+v"(negm)); \
        const float f=__builtin_amdgcn_exp2f(-dl); l_reg*=f; if(hi==0)wsf[r32]=f; resc=true; } } \
    SBAR(); \
    GAPB(o[0]=__builtin_amdgcn_mfma_f32_32x32x16_bf16(PAF(0),VFR(0),o[0],0,0,0), C0,0); \
    GAPB(o[1]=__builtin_amdgcn_mfma_f32_32x32x16_bf16(PAF(0),VFR(4),o[1],0,0,0), C0,4); \
    KRD(GL,0); GAPB(o[0]=__builtin_amdgcn_mfma_f32_32x32x16_bf16(PAF(1),VFR(1),o[0],0,0,0), C0,8); \
    KRD(GL,1); GAPB(o[1]=__builtin_amdgcn_mfma_f32_32x32x16_bf16(PAF(1),VFR(5),o[1],0,0,0), C0,12); \
    KRD(GL,2); GAPB(o[0]=__builtin_amdgcn_mfma_f32_32x32x16_bf16(PAF(2),VFR(2),o[0],0,0,0), C1,0); \
    KRD(GL,3); GAPB(o[1]=__builtin_amdgcn_mfma_f32_32x32x16_bf16(PAF(2),VFR(6),o[1],0,0,0), C1,4); \
    GAPB(o[0]=__builtin_amdgcn_mfma_f32_32x32x16_bf16(PAF(3),VFR(3),o[0],0,0,0), C1,8); \
    GAPB(o[1]=__builtin_amdgcn_mfma_f32_32x32x16_bf16(PAF(3),VFR(7),o[1],0,0,0), C1,12); \
    }while(0)
  int t=1;
  for(;t+5<NT;t+=2){
    STEP(pB0,pB1,pA0,pA1,t,true,true,true);     WAIT_BAR(2); RESC(); ROT();
    STEP(pA0,pA1,pB0,pB1,t+1,true,true,true);   WAIT_BAR(2); RESC(); ROT();
  }
  #define ENDW(tt) do{ if((tt)+3<NT){WAIT_BAR(2);} else if((tt)+2<NT){WAIT_BAR(1);} else {WAIT_BAR(0);} }while(0)
  for(;t+1<NT;t+=2){
    STEP(pB0,pB1,pA0,pA1,t,(t+3<NT),(t+1<NT),(t+1<NT));       ENDW(t);   RESC(); ROT();
    STEP(pA0,pA1,pB0,pB1,t+1,(t+4<NT),(t+2<NT),(t+2<NT));     ENDW(t+1); RESC(); ROT();
  }
  STEP(pB0,pB1,pA0,pA1,NT-1,false,false,false); RESC();
  { const bool keep_=true; float sacc=pB0[0]+pB0[1]; _Pragma("unroll") for(int r=2;r<16;++r)sacc+=pB0[r]; _Pragma("unroll") for(int r=0;r<16;++r)sacc+=pB1[r]; l_reg+=sacc;
    pw0=(u32x4){PKW(pB0,0),PKW(pB0,2),PKW(pB0,4),PKW(pB0,6)};pw1=(u32x4){PKW(pB0,8),PKW(pB0,10),PKW(pB0,12),PKW(pB0,14)};pw2=(u32x4){PKW(pB1,0),PKW(pB1,2),PKW(pB1,4),PKW(pB1,6)};pw3=(u32x4){PKW(pB1,8),PKW(pB1,10),PKW(pB1,12),PKW(pB1,14)};
    SBAR(); pv(o,vb0+sl_cur,PAF(0),PAF(1),PAF(2),PAF(3)); }
  #undef PKW
  #undef PAF
  #undef VFR
  #undef PIN
  #undef MX3
  #undef GAPA
  #undef GAPB
  #undef EX
  #undef VRD
  #undef KRD
  #undef STEP
  #undef ENDW
  {auto rr=__builtin_amdgcn_permlane32_swap(__float_as_uint(l_reg),__float_as_uint(l_reg),false,false);l_reg=__uint_as_float(rr[0])+__uint_as_float(rr[1]);}
  if(hi==0)wsf[32+r32]=l_reg;asm volatile("s_waitcnt lgkmcnt(0)":::"memory");
  float rli[16];
  #pragma unroll
  for(int r=0;r<16;++r)rli[r]=__builtin_amdgcn_rcpf(wsf[32+crow(r,hi)]);
  bf16*Ow=O+(rowbase+q0+wid*QBLK)*DM+h*D;
  { bf16*stg=(bf16*)(shm+LDS_OST)+wid*2048;
    #pragma unroll
    for(int r=0;r<16;++r){const int orow=crow(r,hi);
      #pragma unroll
      for(int d0=0;d0<2;++d0)stg[orow*64+d0*32+r32]=__float2bfloat16(o[d0][r]*rli[r]);}
    asm volatile("s_waitcnt lgkmcnt(0)":::"memory");
    #pragma unroll
    for(int i=0;i<4;++i){const int row=i*8+(lane>>3),ch=lane&7; const u32x4 v=*(const u32x4*)(stg+row*64+ch*8); ATTN_STORE16(Ow+(long)row*DM+ch*8,v);} }
  asm volatile("s_waitcnt lgkmcnt(0)\n\ts_barrier":::"memory");
  #undef DMA_K
  #undef DMA_V
  #undef CMASK
  #undef BMASK
  #undef START
  #undef RESC
  #undef ROT
}
constexpr int ATTN_LDS_BYTES=LDS_BYTES;
struct AttnTensors { const bf16* Q; const bf16* K; const bf16* V; bf16* O; const float* KM; };
struct AttnUnit { int bh; int qb; };
struct StaticOrder {
  int vcu;
  __device__ __forceinline__ explicit StaticOrder(int grid,int block):vcu((block%8)*(grid/8)+block/8){}
  __device__ __forceinline__ bool next(int i,AttnUnit&u)const{ if(i>=4)return false; const int s=vcu&7; u.bh=vcu>>3; u.qb=(i==0)?s:(i==1)?15-s:(i==2)?16+s:31-s; return true; }
  __device__ __forceinline__ void a_ready(const AttnUnit&)const{}
  __device__ __forceinline__ void done(const AttnUnit&)const{}
};
template<class Sched,int THRL=8> __device__ __forceinline__ void attn_phase(char*lds,const AttnTensors&T,const Sched&S){
  AttnUnit u; int lastbh=-1;
  for(int i=0;S.next(i,u);++i){
    if(u.bh!=lastbh){ __syncthreads(); float*km=(float*)(lds+LDS_KM); int tx_=threadIdx.x; asm volatile("":"+v"(tx_)); for(int k=tx_;k<32*64;k+=512)km[k]=T.KM[(long)u.bh*32*64+k]+T.KM[(long)(BATCH*NHEAD+u.bh)*32*64+k]; asm volatile("s_waitcnt vmcnt(0) lgkmcnt(0)":::"memory"); __syncthreads(); lastbh=u.bh; }
    attn_unit<THRL>(u.bh/NHEAD,u.bh%NHEAD,u.qb,T.Q,T.K,T.V,T.O,lds); }
}
#undef SBAR
#undef WAIT_BAR
}

#define XB_TMO      128
#define XB_XCNT(j)  (256  + 64 * (j))
#define XB_XSUB(j)  (1280 + 64 * (j))
#define XB_XGEN(j)  (2304 + 64 * (j))
#define XB_TOP      3328
#define XB_TOPGEN   3392
#define XCD_BAR_WORDS 3456
#define XB_SPIN_CAP (1u << 20)
__device__ __forceinline__ unsigned xb_ld(unsigned* p)              { return __hip_atomic_load(p, __ATOMIC_RELAXED, __HIP_MEMORY_SCOPE_AGENT); }
__device__ __forceinline__ unsigned xb_add(unsigned* p, unsigned v) { return __hip_atomic_fetch_add(p, v, __ATOMIC_RELAXED, __HIP_MEMORY_SCOPE_AGENT); }
__device__ __forceinline__ unsigned xb_xcc_id() { return (unsigned)__builtin_amdgcn_s_getreg((3 << 11) | 20) & 0xFu; }
#define XB_SPIN(cond, bar) do { unsigned _sp = 0; while (cond) { __builtin_amdgcn_s_sleep(1); \
    if ((++_sp & 255u) == 0u) { if (xb_ld(&(bar)[XB_TMO])) break; if (_sp > XB_SPIN_CAP) { atomicAdd(&(bar)[XB_TMO], 1u); break; } } } } while (0)
struct XcdBarrier { unsigned* bar; unsigned x; volatile LAS unsigned* st; };
__device__ __forceinline__ XcdBarrier xcd_barrier_post(unsigned* bar, volatile LAS unsigned* st) {
    XcdBarrier b; b.bar = bar; b.x = xb_xcc_id(); b.st = st;
    if (threadIdx.x == 0) (void)xb_add(&bar[XB_XCNT(b.x)], 1u);
    return b;
}
__device__ __forceinline__ void xcd_barrier_complete(unsigned* bar, unsigned x, unsigned& nloc, unsigned& nx) {
    const unsigned G = gridDim.x * gridDim.y * gridDim.z;
    unsigned sum, cnt, mine, sp = 0u;
    for (;;) {
        sum = 0u; cnt = 0u; mine = 0u;
#pragma unroll
        for (unsigned j = 0; j < 16; ++j) { const unsigned c = xb_ld(&bar[XB_XCNT(j)]); sum += c; cnt += (c > 0u) ? 1u : 0u; mine = (j == x) ? c : mine; }
        if (sum == G) break;
        __builtin_amdgcn_s_sleep(1);
        if ((++sp & 255u) == 0u) { if (xb_ld(&bar[XB_TMO])) break; if (sp > XB_SPIN_CAP) { atomicAdd(&bar[XB_TMO], 1u); break; } }
    }
    nloc = mine > 0u ? mine : 1u; nx = cnt > 0u ? cnt : 1u;
}
__device__ __forceinline__ void xcd_barrier(const XcdBarrier& b) {
    asm volatile("s_waitcnt vmcnt(0)" ::: "memory");
    __syncthreads();
    if (threadIdx.x == 0) {
        unsigned* bar = b.bar;
        __builtin_amdgcn_s_waitcnt(0);
        unsigned nloc = b.st[0], nx = b.st[1];
        if (nloc == 0u) { xcd_barrier_complete(bar, b.x, nloc, nx); b.st[0] = nloc; b.st[1] = nx; }
        const unsigned old = xb_add(&bar[XB_XSUB(b.x)], 1u);
        const unsigned gen = old / nloc;
        if (old + 1u == (gen + 1u) * nloc) {
            __builtin_amdgcn_fence(__ATOMIC_RELEASE, "agent");
            asm volatile("s_waitcnt vmcnt(0)" ::: "memory");
            const unsigned og = xb_add(&bar[XB_TOP], 1u);
            const unsigned tg = og / nx;
            if (og + 1u == (tg + 1u) * nx) xb_add(&bar[XB_TOPGEN], 1u);
            else XB_SPIN(xb_ld(&bar[XB_TOPGEN]) == tg, bar);
            __builtin_amdgcn_fence(__ATOMIC_ACQUIRE, "agent");
            xb_add(&bar[XB_XGEN(b.x)], 1u);
            asm volatile("s_waitcnt vmcnt(0)" ::: "memory");
        } else {
            XB_SPIN(xb_ld(&bar[XB_XGEN(b.x)]) == gen, bar);
            __builtin_amdgcn_fence(__ATOMIC_ACQUIRE, "agent");
            asm volatile("s_waitcnt vmcnt(0)" ::: "memory");
        }
    }
    __syncthreads();
}

struct Args { const float* in[28]; float* out; unsigned char* ws; int ph_lo, ph_hi; };
enum { I_X = 0, I_MEM, I_GMIX, I_WIN, I_ARE, I_AIM, I_LOGDT, I_BRE, I_BIM, I_CRE, I_CIM, I_DSKIP, I_WGLU, I_WPA, I_WOUT, I_GXATTN, I_GMEM, I_WXQ, I_WXKV, I_WXO,
       I_GMOE, I_WROUTER, I_BROUTER, I_WGU, I_BGU, I_WDN, I_BDN, I_GFINAL };

template <int MAP>
__device__ __forceinline__ void p0_transpose_item(const float* W, int K, int N, const float* gain, bf16_t* WT, LAS float* scr, int item, int lane) {
    const int nblk = N / 64, kb = item / nblk, nb = item % nblk, k0 = 64 * kb, n0 = 64 * nb;
    const int q = lane & 15, kr = lane >> 4;
    f32x4 v[16];
    const float* src = W + (size_t)(k0 + kr) * N + n0 + 4 * q;
#pragma unroll
    for (int j = 0; j < 16; ++j) v[j] = *(const f32x4*)(src + (size_t)(4 * j) * N);
    if (gain) {
#pragma unroll
        for (int j = 0; j < 16; ++j) v[j] = v[j] * gain[k0 + kr + 4 * j]; }
#pragma unroll
    for (int j = 0; j < 16; ++j) { const int kk = kr + 4 * j; *(LAS f32x4*)(scr + kk * 64 + 4 * (q ^ ((kk >> 3) & 7))) = v[j]; }
    asm volatile("s_waitcnt lgkmcnt(0)" ::: "memory");
    const int c = lane & 7, nq = lane >> 3;
    const int nr0 = (MAP == 1) ? (256 * ((n0 % 1024) / 128) + 128 * (n0 / 1024) + (n0 % 128)) : n0;
#pragma unroll
    for (int jj = 0; jj < 8; ++jj) { const int n = 8 * jj + nq; const LAS float* sp = scr + (8 * c) * 64 + (n ^ (4 * c));
        u32x4 o; o.x = pk2(sp[0 * 64], sp[1 * 64]); o.y = pk2(sp[2 * 64], sp[3 * 64]); o.z = pk2(sp[4 * 64], sp[5 * 64]); o.w = pk2(sp[6 * 64], sp[7 * 64]);
        *(u32x4*)(WT + (size_t)(nr0 + n) * K + k0 + 8 * c) = o; }
    asm volatile("s_waitcnt lgkmcnt(0)" ::: "memory");
}
template <int MODE>
__device__ __forceinline__ float rms_row_to_bf16(const float* xrow, const float* gain, bf16_t* orow, int lane) {
    const f32x4* xr = (const f32x4*)xrow + lane;
    f32x4 v[4]; float s = 0.f;
#pragma unroll
    for (int j = 0; j < 4; ++j) { v[j] = xr[64 * j]; s += (v[j][0] * v[j][0] + v[j][1] * v[j][1]) + (v[j][2] * v[j][2] + v[j][3] * v[j][3]); }
    const float rstd = 1.0f / sqrtf(wave_sum(s) * (1.0f / DM) + RMS_EPS);
    u32x2* o8 = (u32x2*)orow + lane;
#pragma unroll
    for (int j = 0; j < 4; ++j) { f32x4 w = v[j];
        if (MODE == 1) { const f32x4 g = ((const f32x4*)gain)[lane + 64 * j]; w = w * rstd * g; }
        u32x2 o; o.x = pk2(w[0], w[1]); o.y = pk2(w[2], w[3]); o8[64 * j] = o; }
    return rstd;
}

struct Frame {
    LAS unsigned char* lds; int tid, lane, wave, G, bid;
    const float* in[28]; float* out; unsigned char* ws; unsigned* ctl;
};
#define WSP(type, off) ((type*)(F.ws + (off)))

__device__ __forceinline__ void phase_prologue(Frame& F) {
    LAS float* scr = (LAS float*)(F.lds + F.wave * 16384);
    const int gw = F.bid * 8 + F.wave, NGW = F.G * 8;
    for (int m = gw * 4; m < T_; m += NGW * 4) {
        f32x4 v[4][4]; float ss[4];
#pragma unroll
        for (int r = 0; r < 4; ++r)
#pragma unroll
            for (int j = 0; j < 4; ++j) v[r][j] = ((const f32x4*)(F.in[I_X] + (size_t)(m + r) * DM))[F.lane + 64 * j];
#pragma unroll
        for (int r = 0; r < 4; ++r) { float s = 0.f;
#pragma unroll
            for (int j = 0; j < 4; ++j) s += (v[r][j][0] * v[r][j][0] + v[r][j][1] * v[r][j][1]) + (v[r][j][2] * v[r][j][2] + v[r][j][3] * v[r][j][3]);
            ss[r] = s; }
#pragma unroll
        for (int o = 1; o < 64; o <<= 1) {
#pragma unroll
            for (int r = 0; r < 4; ++r) ss[r] += __shfl_xor(ss[r], o); }
#pragma unroll
        for (int r = 0; r < 4; ++r) { u32x2* o8 = (u32x2*)(WSP(bf16_t, WS_XB) + (size_t)(m + r) * DM) + F.lane;
#pragma unroll
            for (int j = 0; j < 4; ++j) { u32x2 o; o.x = pk2(v[r][j][0], v[r][j][1]); o.y = pk2(v[r][j][2], v[r][j][3]); o8[64 * j] = o; }
            if (F.lane == 0) WSP(float, WS_RSTD0)[m + r] = 1.0f / sqrtf(ss[r] * (1.0f / DM) + RMS_EPS); } }
    for (int m = gw; m < NB * MEML; m += NGW) (void)rms_row_to_bf16<1>(F.in[I_MEM] + (size_t)m * DM, F.in[I_GMEM], WSP(bf16_t, WS_MN) + (size_t)m * DM, F.lane);
    constexpr int I_IN = (DM / 64) * (INW / 64), I_GLU = (SW / 64) * (2 * DM / 64), I_PA = (AW / 64) * (DM / 64), I_OUT = (DM / 64) * (DM / 64), I_XQ = (DM / 64) * (XW / 64),
                  I_XKV = (DM / 64) * (2 * XW / 64), I_XO = (XW / 64) * (DM / 64), I_GU1 = (DM / 64) * (2 * DFF / 64), I_DN1 = (DFF / 64) * (DM / 64);
    constexpr int NITEMS = I_IN + I_GLU + I_PA + I_OUT + I_XQ + I_XKV + I_XO + NE * (I_GU1 + I_DN1);
    for (int it = gw; it < NITEMS; it += NGW) {
        int r = it;
        if (r < I_IN) { p0_transpose_item<0>(F.in[I_WIN], DM, INW, F.in[I_GMIX], WSP(bf16_t, WS_WIN), scr, r, F.lane); continue; } r -= I_IN;
        if (r < I_GLU) { p0_transpose_item<1>(F.in[I_WGLU], SW, 2 * DM, nullptr, WSP(bf16_t, WS_WGLU), scr, r, F.lane); continue; } r -= I_GLU;
        if (r < I_PA) { p0_transpose_item<0>(F.in[I_WPA], AW, DM, nullptr, WSP(bf16_t, WS_WPA), scr, r, F.lane); continue; } r -= I_PA;
        if (r < I_OUT) { p0_transpose_item<0>(F.in[I_WOUT], DM, DM, nullptr, WSP(bf16_t, WS_WOUT), scr, r, F.lane); continue; } r -= I_OUT;
        if (r < I_XQ) { p0_transpose_item<0>(F.in[I_WXQ], DM, XW, F.in[I_GXATTN], WSP(bf16_t, WS_WXQ), scr, r, F.lane); continue; } r -= I_XQ;
        if (r < I_XKV) { p0_transpose_item<0>(F.in[I_WXKV], DM, 2 * XW, nullptr, WSP(bf16_t, WS_WXKV), scr, r, F.lane); continue; } r -= I_XKV;
        if (r < I_XO) { p0_transpose_item<0>(F.in[I_WXO], XW, DM, nullptr, WSP(bf16_t, WS_WXO), scr, r, F.lane); continue; } r -= I_XO;
        const int e = r / (I_GU1 + I_DN1); r -= e * (I_GU1 + I_DN1);
        if (r < I_GU1) p0_transpose_item<1>(F.in[I_WGU] + (size_t)e * DM * 2 * DFF, DM, 2 * DFF, F.in[I_GMOE], WSP(bf16_t, WS_WGU) + (size_t)e * 2 * DFF * DM, scr, r, F.lane);
        else p0_transpose_item<0>(F.in[I_WDN] + (size_t)e * DFF * DM, DFF, DM, nullptr, WSP(bf16_t, WS_WDN) + (size_t)e * DM * DFF, scr, r - I_GU1, F.lane);
    }
}

__device__ __forceinline__ void phase_kmean(Frame& F) {
    LAS float* red = (LAS float*)F.lds;
    const bf16_t* Kb = WSP(bf16_t, WS_K);
    for (int it = F.bid; it < NB * NH * NBLK; it += F.G) {
        const int j = it % NBLK, h = (it / NBLK) % NH, b = it / (NBLK * NH);
        const int col = F.tid & 63, rg = F.tid >> 6; float s = 0.f;
        const bf16_t* p = Kb + ((size_t)(b * SEQ + j * MBLK + rg * 32)) * AW + h * HD + col;
#pragma unroll 8
        for (int r = 0; r < 32; ++r) s += bf2f(p[(size_t)r * AW]);
        red[rg * 64 + col] = s;
        __syncthreads();
        if (F.tid < 64) { float t = 0.f;
#pragma unroll
            for (int k = 0; k < 8; ++k) t += red[k * 64 + F.tid];
            WSP(float, WS_KMEAN)[(size_t)it * HD + F.tid] = t * (1.0f / MBLK); }
        __syncthreads();
    }
}

__device__ __forceinline__ void phase_moba_simple(Frame& F, bf16_t* Ob) {
    LAS unsigned* Ks = (LAS unsigned*)F.lds;
    LAS unsigned* Vs = (LAS unsigned*)(F.lds + 32768);
    LAS float* km = (LAS float*)(F.lds + 65536);
    const bf16_t *Qb = WSP(bf16_t, WS_Q), *Kb = WSP(bf16_t, WS_K), *Vb = WSP(bf16_t, WS_V);
    const int ql = F.tid >> 1, half = F.tid & 1;
    for (int it = F.bid; it < NB * NH * NBLK; it += F.G) {
        const int iblk = (NBLK - 1) - (it % NBLK), h = (it / NBLK) % NH, b = it / (NBLK * NH);
        __syncthreads();
        for (int k = F.tid; k < NBLK * HD; k += 512) km[k] = WSP(float, WS_KMEAN)[(size_t)((b * NH + h) * NBLK) * HD + k];
        float q[32];
        { const u32x4* qp = (const u32x4*)(Qb + (size_t)(b * SEQ + iblk * MBLK + ql) * AW + h * HD + half * 32);
#pragma unroll
          for (int c = 0; c < 4; ++c) { const u32x4 w = qp[c]; q[8 * c + 0] = bflo(w.x); q[8 * c + 1] = bfhi(w.x); q[8 * c + 2] = bflo(w.y); q[8 * c + 3] = bfhi(w.y); q[8 * c + 4] = bflo(w.z); q[8 * c + 5] = bfhi(w.z); q[8 * c + 6] = bflo(w.w); q[8 * c + 7] = bfhi(w.w); } }
        __syncthreads();
        float g0 = -3e38f, g1 = -3e38f, g2 = -3e38f; int s0 = -1, s1 = -1, s2 = -1;
        for (int j = 0; j < iblk; ++j) { float g = 0.f;
#pragma unroll
            for (int d = 0; d < 32; ++d) g += q[d] * km[j * HD + half * 32 + d];
            g += __shfl_xor(g, 1);
            if (g > g0) { g2 = g1; s2 = s1; g1 = g0; s1 = s0; g0 = g; s0 = j; } else if (g > g1) { g2 = g1; s2 = s1; g1 = g; s1 = j; } else if (g > g2) { g2 = g; s2 = j; } }
        float mx = -3e38f, l = 0.f, o[32];
#pragma unroll
        for (int d = 0; d < 32; ++d) o[d] = 0.f;
        for (int jb = 0; jb <= iblk; ++jb) {
            __syncthreads();
            { const size_t rowb = (size_t)(b * SEQ + jb * MBLK);
              for (int c = F.tid; c < 256 * 8; c += 512) { const int r = c >> 3, ch = c & 7;
                  *(LAS u32x4*)(Ks + r * 32 + ch * 4) = *(const u32x4*)(Kb + (rowb + r) * AW + h * HD + ch * 8);
                  *(LAS u32x4*)(Vs + r * 32 + ch * 4) = *(const u32x4*)(Vb + (rowb + r) * AW + h * HD + ch * 8); } }
            __syncthreads();
            const bool need = (jb == iblk) || jb == s0 || jb == s1 || jb == s2;
            if (need) { const int kend = (jb == iblk) ? ql : 255;
                for (int kk = 0; kk <= kend; ++kk) { float s = 0.f;
#pragma unroll
                    for (int c = 0; c < 4; ++c) { const u32x4 w = *(const LAS u32x4*)(Ks + kk * 32 + half * 16 + c * 4);
                        s += q[8 * c + 0] * bflo(w.x) + q[8 * c + 1] * bfhi(w.x) + q[8 * c + 2] * bflo(w.y) + q[8 * c + 3] * bfhi(w.y) + q[8 * c + 4] * bflo(w.z) + q[8 * c + 5] * bfhi(w.z) + q[8 * c + 6] * bflo(w.w) + q[8 * c + 7] * bfhi(w.w); }
                    s += __shfl_xor(s, 1);
                    const float mn = fmaxf(mx, s), corr = __builtin_amdgcn_exp2f(mx - mn), p = __builtin_amdgcn_exp2f(s - mn); mx = mn; l = l * corr + p;
#pragma unroll
                    for (int c = 0; c < 4; ++c) { const u32x4 w = *(const LAS u32x4*)(Vs + kk * 32 + half * 16 + c * 4);
                        o[8 * c + 0] = o[8 * c + 0] * corr + p * bflo(w.x); o[8 * c + 1] = o[8 * c + 1] * corr + p * bfhi(w.x); o[8 * c + 2] = o[8 * c + 2] * corr + p * bflo(w.y); o[8 * c + 3] = o[8 * c + 3] * corr + p * bfhi(w.y);
                        o[8 * c + 4] = o[8 * c + 4] * corr + p * bflo(w.z); o[8 * c + 5] = o[8 * c + 5] * corr + p * bfhi(w.z); o[8 * c + 6] = o[8 * c + 6] * corr + p * bflo(w.w); o[8 * c + 7] = o[8 * c + 7] * corr + p * bfhi(w.w); } } }
        }
        const float il = 1.0f / l;
        u32x4* op = (u32x4*)(Ob + (size_t)(b * SEQ + iblk * MBLK + ql) * AW + h * HD + half * 32);
#pragma unroll
        for (int c = 0; c < 4; ++c) { u32x4 w; w.x = pk2(o[8 * c + 0] * il, o[8 * c + 1] * il); w.y = pk2(o[8 * c + 2] * il, o[8 * c + 3] * il); w.z = pk2(o[8 * c + 4] * il, o[8 * c + 5] * il); w.w = pk2(o[8 * c + 6] * il, o[8 * c + 7] * il); op[c] = w; }
    }
}

__device__ __forceinline__ void phase_ssm_simple(Frame& F, bf16_t* Yb) {
    const int gw = F.bid * 8 + F.wave, NGW = F.G * 8, p = F.lane;
    const bf16_t* Ub = WSP(bf16_t, WS_U);
    for (int it = gw; it < NB * NG; it += NGW) {
        const int g = it % NG, b = it / NG;
        const float are = fminf(F.in[I_ARE][g * SP + p], -1e-4f), aim = F.in[I_AIM][g * SP + p], dt = expf(F.in[I_LOGDT][g]);
        const float mag = expf(are * dt), ang = aim * dt; const float lr = mag * cosf(ang), li = mag * sinf(ang);
        const float nr = lr - 1.0f, ni = li, den = 1.0f / (are * are + aim * aim); const float fr_ = (nr * are + ni * aim) * den, fi_ = (ni * are - nr * aim) * den;
        float bbr[16], bbi[16], cr[16], ci[16], dsk[16];
#pragma unroll
        for (int c = 0; c < 16; ++c) { const float br = F.in[I_BRE][(size_t)(g * SP + p) * SGC + c], bi = F.in[I_BIM][(size_t)(g * SP + p) * SGC + c];
            bbr[c] = fr_ * br - fi_ * bi; bbi[c] = fr_ * bi + fi_ * br;
            cr[c] = F.in[I_CRE][(size_t)(g * SGC + c) * SP + p]; ci[c] = F.in[I_CIM][(size_t)(g * SGC + c) * SP + p]; dsk[c] = F.in[I_DSKIP][g * SGC + c]; }
        float xr = 0.f, xi = 0.f;
        const int csel = ((p >> 5) & 1) * 8 + ((p >> 4) & 1) * 4 + ((p >> 3) & 1) * 2 + ((p >> 2) & 1);
        float dmine = 0.f;
#pragma unroll
        for (int c = 0; c < 16; ++c) dmine = (c == csel) ? dsk[c] : dmine;
        for (int t = 0; t < SEQ; ++t) {
            const u32x4* up = (const u32x4*)(Ub + (size_t)(b * SEQ + t) * SW + g * SGC); const u32x4 w0 = up[0], w1 = up[1];
            float u[16]; u[0] = bflo(w0.x); u[1] = bfhi(w0.x); u[2] = bflo(w0.y); u[3] = bfhi(w0.y); u[4] = bflo(w0.z); u[5] = bfhi(w0.z); u[6] = bflo(w0.w); u[7] = bfhi(w0.w);
            u[8] = bflo(w1.x); u[9] = bfhi(w1.x); u[10] = bflo(w1.y); u[11] = bfhi(w1.y); u[12] = bflo(w1.z); u[13] = bfhi(w1.z); u[14] = bflo(w1.w); u[15] = bfhi(w1.w);
            float sr = 0.f, si = 0.f;
#pragma unroll
            for (int c = 0; c < 16; ++c) { sr += bbr[c] * u[c]; si += bbi[c] * u[c]; }
            const float nxr = lr * xr - li * xi + sr, nxi = lr * xi + li * xr + si; xr = nxr; xi = nxi;
            float y[16];
#pragma unroll
            for (int c = 0; c < 16; ++c) y[c] = cr[c] * xr - ci[c] * xi;
            float w8[8], w4[4], w2[2], w1_;
            { const bool hi = (p & 32) != 0;
#pragma unroll
              for (int i = 0; i < 8; ++i) { const float keep = hi ? y[i + 8] : y[i], send = hi ? y[i] : y[i + 8]; w8[i] = keep + __shfl_xor(send, 32); } }
            { const bool hi = (p & 16) != 0;
#pragma unroll
              for (int i = 0; i < 4; ++i) { const float keep = hi ? w8[i + 4] : w8[i], send = hi ? w8[i] : w8[i + 4]; w4[i] = keep + __shfl_xor(send, 16); } }
            { const bool hi = (p & 8) != 0;
#pragma unroll
              for (int i = 0; i < 2; ++i) { const float keep = hi ? w4[i + 2] : w4[i], send = hi ? w4[i] : w4[i + 2]; w2[i] = keep + __shfl_xor(send, 8); } }
            { const bool hi = (p & 4) != 0; const float keep = hi ? w2[1] : w2[0], send = hi ? w2[0] : w2[1]; w1_ = keep + __shfl_xor(send, 4); }
            w1_ += __shfl_xor(w1_, 2); w1_ += __shfl_xor(w1_, 1);
            float umine = 0.f;
#pragma unroll
            for (int c = 0; c < 16; ++c) umine = (c == csel) ? u[c] : umine;
            if ((p & 3) == 0) Yb[(size_t)(b * SEQ + t) * SW + g * SGC + csel] = (bf16_t)f2bf(gelu_tanh(w1_ + dmine * umine));
        }
    }
}


__device__ __forceinline__ void p0_ssm_tables(Frame& F, int task) {
    const int g = task >> 3, part = task & 7;
    LAS float* pwr = (LAS float*)F.lds; LAS float* pwi = pwr + 65 * 64; LAS float* bbr = pwi + 65 * 64; LAS float* bbi = bbr + 1024; LAS float* ccr = bbi + 1024; LAS float* cci = ccr + 1024;
    const float dt = expf(F.in[I_LOGDT][g]);
    __syncthreads();
    for (int i = F.tid; i < 65 * 64; i += 512) { const int k = i >> 6, p = i & 63; const float are = fminf(F.in[I_ARE][g * SP + p], -1e-4f), aim = F.in[I_AIM][g * SP + p];
        const float mag = expf(are * dt * (float)k); double a = (double)aim * (double)dt * (double)k; a -= 6.283185307179586 * rint(a * 0.15915494309189535); const float af = (float)a;
        pwr[i] = mag * cosf(af); pwi[i] = mag * sinf(af); }
    for (int i = F.tid; i < 1024; i += 512) { const int p = i >> 4, c = i & 15; const float are = fminf(F.in[I_ARE][g * SP + p], -1e-4f), aim = F.in[I_AIM][g * SP + p];
        const float mag = expf(are * dt); double a = (double)aim * (double)dt; a -= 6.283185307179586 * rint(a * 0.15915494309189535); const float af = (float)a;
        const float lr = mag * cosf(af), li = mag * sinf(af), nr = lr - 1.0f, ni = li, den = 1.0f / (are * are + aim * aim), fr_ = (nr * are + ni * aim) * den, fi_ = (ni * are - nr * aim) * den;
        const float br = F.in[I_BRE][(size_t)(g * SP + p) * SGC + c], bi = F.in[I_BIM][(size_t)(g * SP + p) * SGC + c];
        bbr[i] = fr_ * br - fi_ * bi; bbi[i] = fr_ * bi + fi_ * br; }
    for (int i = F.tid; i < 1024; i += 512) { ccr[i] = F.in[I_CRE][(size_t)g * 1024 + i]; cci[i] = F.in[I_CIM][(size_t)g * 1024 + i]; }
    __syncthreads();
    bf16_t* WST = WSP(bf16_t, WS_WST) + (size_t)g * 128 * 1024; bf16_t* GT = WSP(bf16_t, WS_GT) + (size_t)g * 1024 * 128; bf16_t* KT = WSP(bf16_t, WS_KT) + (size_t)g * 65 * 256;
    for (int j = 0; j < 32; ++j) { const int e = part * 16384 + j * 512 + F.tid; const int pp = e >> 10, k = e & 1023, s = k >> 4, c = k & 15, p = pp & 63;
        const float mr = pwr[(63 - s) * 64 + p], mi = pwi[(63 - s) * 64 + p], br = bbr[p * 16 + c], bi = bbi[p * 16 + c];
        WST[e] = (bf16_t)f2bf(pp < 64 ? (mr * br - mi * bi) : (mr * bi + mi * br)); }
    for (int j = 0; j < 32; ++j) { const int e = part * 16384 + j * 512 + F.tid; const int sc = e >> 7, pp = e & 127, s = sc >> 4, c = sc & 15, p = pp & 63;
        const float mr = pwr[(s + 1) * 64 + p], mi = pwi[(s + 1) * 64 + p], cr = ccr[c * 64 + p], ci = cci[c * 64 + p];
        GT[e] = (bf16_t)f2bf(pp < 64 ? (cr * mr - ci * mi) : -(cr * mi + ci * mr)); }
    for (int e = part * 2080 + F.tid; e < (part + 1) * 2080; e += 512) { const int tt = e >> 8, c = (e >> 4) & 15, c2 = e & 15; float acc = 0.f;
        if (tt > 0) { const int tau = tt - 1;
            for (int p = 0; p < 64; ++p) { const float mr = pwr[tau * 64 + p], mi = pwi[tau * 64 + p], cr = ccr[c * 64 + p], ci = cci[c * 64 + p]; const float zr = cr * mr - ci * mi, zi = cr * mi + ci * mr; acc += zr * bbr[p * 16 + c2] - zi * bbi[p * 16 + c2]; } }
        KT[e] = (bf16_t)f2bf(acc); }
    if (part == 0 && F.tid < 64) { WSP(f32x2, WS_LAML)[g * 64 + F.tid] = (f32x2){pwr[64 * 64 + F.tid], pwi[64 * 64 + F.tid]}; }
    __syncthreads();
}
__device__ __forceinline__ void ssm_state_item(Frame& F, int b, int g) {
    const int w = F.wave, wm = w >> 1, wn = w & 1, row = F.lane & 15, kg = F.lane >> 4;
    f32x4 acc[2][4];
#pragma unroll
    for (int a = 0; a < 2; ++a)
#pragma unroll
        for (int c = 0; c < 4; ++c) acc[a][c] = (f32x4){0.f, 0.f, 0.f, 0.f};
    const bf16_t* Ub = WSP(bf16_t, WS_U) + ((size_t)b * SEQ + (size_t)(32 * wm + row) * 64 + (kg >> 1)) * SW + g * SGC + 8 * (kg & 1);
    const bf16_t* Wb = WSP(bf16_t, WS_WST) + ((size_t)g * 128 + 64 * wn + row) * 1024 + 8 * kg;
#pragma unroll 2
    for (int ks = 0; ks < 32; ++ks) {
        bf16x8 a[2], bq[4];
#pragma unroll
        for (int mt = 0; mt < 2; ++mt) a[mt] = *(const bf16x8*)(Ub + ((size_t)(16 * mt * 64 + 2 * ks)) * SW);
#pragma unroll
        for (int nt = 0; nt < 4; ++nt) bq[nt] = *(const bf16x8*)(Wb + (size_t)nt * 16 * 1024 + 32 * ks);
#pragma unroll
        for (int mt = 0; mt < 2; ++mt)
#pragma unroll
            for (int nt = 0; nt < 4; ++nt) acc[mt][nt] = __builtin_amdgcn_mfma_f32_16x16x32_bf16(a[mt], bq[nt], acc[mt][nt], 0, 0, 0);
    }
    LAS float* X = (LAS float*)F.lds;
    __syncthreads();
#pragma unroll
    for (int mt = 0; mt < 2; ++mt)
#pragma unroll
        for (int nt = 0; nt < 4; ++nt)
#pragma unroll
            for (int r = 0; r < 4; ++r) X[(32 * wm + 16 * mt + 4 * kg + r) * 128 + 64 * wn + 16 * nt + row] = acc[mt][nt][r];
    __syncthreads();
    if (w == 0) { const int p = F.lane; const f32x2 lam = WSP(f32x2, WS_LAML)[g * 64 + p]; float sr = 0.f, si = 0.f;
        bf16_t* SS = WSP(bf16_t, WS_SST) + ((size_t)(b * NG + g) * 128) * 128;
        for (int n = 0; n < 128; ++n) { SS[n * 128 + p] = (bf16_t)f2bf(sr); SS[n * 128 + 64 + p] = (bf16_t)f2bf(si);
            const float xr = X[n * 128 + p], xi = X[n * 128 + 64 + p]; const float nsr = lam.x * sr - lam.y * si + xr, nsi = lam.x * si + lam.y * sr + xi; sr = nsr; si = nsi; } }
    __syncthreads();
}
constexpr int SO_USTR = 2064, SO_KT = 32 * SO_USTR, SO_SS = SO_KT + 65 * 512, SO_SSTR = 272;
__device__ __forceinline__ void ssm_out_item(Frame& F, int b, int g, int rr) {
    LAS unsigned char* L = F.lds;
    __syncthreads();
    { const bf16_t* Ug = WSP(bf16_t, WS_U) + ((size_t)b * SEQ + (size_t)rr * 2048) * SW + g * SGC;
#pragma unroll
      for (int j = 0; j < 8; ++j) { const int c = F.tid + 512 * j, r = c >> 1, half = c & 1; *(LAS u32x4*)(L + (r >> 6) * SO_USTR + (r & 63) * 32 + half * 16) = *(const u32x4*)(Ug + (size_t)r * SW + half * 8); }
      const u32x4* Kg = (const u32x4*)(WSP(bf16_t, WS_KT) + (size_t)g * 65 * 256);
      for (int c = F.tid; c < 2080; c += 512) *(LAS u32x4*)(L + SO_KT + c * 16) = Kg[c];
      { const int c = F.tid, ch = c >> 4, pc = c & 15; *(LAS u32x4*)(L + SO_SS + ch * SO_SSTR + pc * 16) = *(const u32x4*)(WSP(bf16_t, WS_SST) + ((size_t)((b * NG + g) * 128 + rr * 32 + ch)) * 128 + pc * 8); } }
    __syncthreads();
    const int w = F.wave, mt = w >> 2, q = w & 3, row = F.lane & 15, kg = F.lane >> 4;
    f32x4 acc[16];
#pragma unroll
    for (int i = 0; i < 16; ++i) acc[i] = (f32x4){0.f, 0.f, 0.f, 0.f};
    const LAS unsigned char* Ua = L + (16 * mt + row) * SO_USTR + (kg >> 1) * 32 + (kg & 1) * 16;
    const LAS unsigned char* Kb_ = L + SO_KT + (1 - (kg >> 1)) * 512 + row * 32 + (kg & 1) * 16;
#pragma unroll 1
    for (int ks = 0; ks < 32; ++ks) {
        const bf16x8 a = *(const LAS bf16x8*)(Ua + ks * 64);
#pragma unroll
        for (int i = 0; i < 16; ++i) { const int s = 4 * i + q; if (s >= 2 * ks) { const bf16x8 bb = *(const LAS bf16x8*)(Kb_ + (s - 2 * ks) * 512); acc[i] = __builtin_amdgcn_mfma_f32_16x16x32_bf16(a, bb, acc[i], 0, 0, 0); } }
    }
    const bf16_t* Gg = WSP(bf16_t, WS_GT) + ((size_t)g * 1024 + q * 16 + row) * 128 + 8 * kg;
#pragma unroll 1
    for (int k2 = 0; k2 < 4; ++k2) {
        const bf16x8 a = *(const LAS bf16x8*)(L + SO_SS + (16 * mt + row) * SO_SSTR + k2 * 64 + kg * 16);
#pragma unroll
        for (int hh = 0; hh < 2; ++hh) {
            bf16x8 bb[8]; const bf16_t* gp = Gg + (size_t)hh * 8 * 64 * 128 + 32 * k2;
#pragma unroll
            for (int i = 0; i < 8; ++i) { bb[i] = *(const bf16x8*)gp; gp += 64 * 128; }
#pragma unroll
            for (int i = 0; i < 8; ++i) acc[hh * 8 + i] = __builtin_amdgcn_mfma_f32_16x16x32_bf16(a, bb[i], acc[hh * 8 + i], 0, 0, 0);
        }
    }
    __syncthreads();
    const float dsk = F.in[I_DSKIP][g * SGC + row];
    { LAS unsigned short* yb = (LAS unsigned short*)(L + (16 * mt + 4 * kg) * SO_USTR + q * 32 + row * 2);
#pragma unroll
      for (int i = 0; i < 16; ++i)
#pragma unroll
          for (int r = 0; r < 4; ++r) { LAS unsigned short* p = yb + (r * SO_USTR + i * 128) / 2; const float u = bf2f(*p); *p = (unsigned short)f2bf(gelu_tanh(acc[i][r] + dsk * u)); } }
    __syncthreads();
    { bf16_t* Yg = WSP(bf16_t, WS_YB) + ((size_t)b * SEQ + (size_t)rr * 2048) * SW + g * SGC;
#pragma unroll 2
      for (int j = 0; j < 8; ++j) { const int c = F.tid + 512 * j, r = c >> 1, half = c & 1; *(u32x4*)(Yg + (size_t)r * SW + half * 8) = *(const LAS u32x4*)(L + (r >> 6) * SO_USTR + (r & 63) * 32 + half * 16); } }
}
__device__ __forceinline__ void phase_ssm_out(Frame& F) {
    for (int it = F.bid; it < NB * NG * 4; it += F.G) ssm_out_item(F, it >> 7, (it >> 2) & 31, it & 3);
    __syncthreads();
}

__device__ __forceinline__ void phase_xattn_simple(Frame& F, bf16_t* Ob) {
    LAS unsigned* Ks = (LAS unsigned*)F.lds;
    LAS unsigned* Vs = (LAS unsigned*)(F.lds + 65536);
    const bf16_t *Qb = WSP(bf16_t, WS_XQ), *KV = WSP(bf16_t, WS_MKV);
    const int tl = F.tid >> 2, part = F.tid & 3;
    int lastbh = -1;
    for (int it = F.bid; it < NB * XH * (SEQ / 128); it += F.G) {
        const int bh = it / (SEQ / 128), ch = it % (SEQ / 128), b = bh / XH, h = bh % XH;
        if (bh != lastbh) { __syncthreads();
            for (int c = F.tid; c < 256 * 16; c += 512) { const int r = c >> 4, cc = c & 15;
                *(LAS u32x4*)(Ks + r * 64 + cc * 4) = *(const u32x4*)(KV + (size_t)(b * MEML + r) * (2 * XW) + h * XD + cc * 8);
                *(LAS u32x4*)(Vs + r * 64 + cc * 4) = *(const u32x4*)(KV + (size_t)(b * MEML + r) * (2 * XW) + XW + h * XD + cc * 8); }
            __syncthreads(); lastbh = bh; }
        const size_t row = (size_t)b * SEQ + ch * 128 + tl;
        float q[32];
        { const u32x4* qp = (const u32x4*)(Qb + row * XW + h * XD + part * 32);
#pragma unroll
          for (int c = 0; c < 4; ++c) { const u32x4 w = qp[c]; q[8 * c + 0] = bflo(w.x); q[8 * c + 1] = bfhi(w.x); q[8 * c + 2] = bflo(w.y); q[8 * c + 3] = bfhi(w.y); q[8 * c + 4] = bflo(w.z); q[8 * c + 5] = bfhi(w.z); q[8 * c + 6] = bflo(w.w); q[8 * c + 7] = bfhi(w.w); } }
        float mx = -3e38f, l = 0.f, o[32];
#pragma unroll
        for (int d = 0; d < 32; ++d) o[d] = 0.f;
        for (int kk = 0; kk < MEML; ++kk) { float s = 0.f;
#pragma unroll
            for (int c = 0; c < 4; ++c) { const u32x4 w = *(const LAS u32x4*)(Ks + kk * 64 + part * 16 + c * 4);
                s += q[8 * c + 0] * bflo(w.x) + q[8 * c + 1] * bfhi(w.x) + q[8 * c + 2] * bflo(w.y) + q[8 * c + 3] * bfhi(w.y) + q[8 * c + 4] * bflo(w.z) + q[8 * c + 5] * bfhi(w.z) + q[8 * c + 6] * bflo(w.w) + q[8 * c + 7] * bfhi(w.w); }
            s += __shfl_xor(s, 1); s += __shfl_xor(s, 2);
            const float mn = fmaxf(mx, s), corr = __builtin_amdgcn_exp2f(mx - mn), p = __builtin_amdgcn_exp2f(s - mn); mx = mn; l = l * corr + p;
#pragma unroll
            for (int c = 0; c < 4; ++c) { const u32x4 w = *(const LAS u32x4*)(Vs + kk * 64 + part * 16 + c * 4);
                o[8 * c + 0] = o[8 * c + 0] * corr + p * bflo(w.x); o[8 * c + 1] = o[8 * c + 1] * corr + p * bfhi(w.x); o[8 * c + 2] = o[8 * c + 2] * corr + p * bflo(w.y); o[8 * c + 3] = o[8 * c + 3] * corr + p * bfhi(w.y);
                o[8 * c + 4] = o[8 * c + 4] * corr + p * bflo(w.z); o[8 * c + 5] = o[8 * c + 5] * corr + p * bfhi(w.z); o[8 * c + 6] = o[8 * c + 6] * corr + p * bflo(w.w); o[8 * c + 7] = o[8 * c + 7] * corr + p * bfhi(w.w); } }
        const float il = 1.0f / l;
        u32x4* op = (u32x4*)(Ob + row * XW + h * XD + part * 32);
#pragma unroll
        for (int c = 0; c < 4; ++c) { u32x4 w; w.x = pk2(o[8 * c + 0] * il, o[8 * c + 1] * il); w.y = pk2(o[8 * c + 2] * il, o[8 * c + 3] * il); w.z = pk2(o[8 * c + 4] * il, o[8 * c + 5] * il); w.w = pk2(o[8 * c + 6] * il, o[8 * c + 7] * il); op[c] = w; }
    }
}

__device__ __forceinline__ void phase_router(Frame& F) {
    LAS float* wt = (LAS float*)F.lds;
    for (int c = F.tid; c < NE * DM; c += 512) { const int k = c >> 5, e = c & 31; wt[e * DM + k] = F.in[I_WROUTER][c] * F.in[I_GMOE][k]; }
    __syncthreads();
    const int gw = F.bid * 8 + F.wave, NGW = F.G * 8, lane = F.lane;
    const float* H = WSP(float, WS_H);
    unsigned* cnt = F.ctl + CW_CNT;
    for (int tk = gw; tk < T_; tk += NGW) {
        const f32x4* hp = (const f32x4*)(H + (size_t)tk * DM) + lane; f32x4 hv[4]; float ss = 0.f;
#pragma unroll
        for (int j = 0; j < 4; ++j) { hv[j] = hp[64 * j]; ss += (hv[j][0] * hv[j][0] + hv[j][1] * hv[j][1]) + (hv[j][2] * hv[j][2] + hv[j][3] * hv[j][3]); }
        const float rstd = 1.0f / sqrtf(wave_sum(ss) * (1.0f / DM) + RMS_EPS);
        float mylogit = 0.f;
#pragma unroll 4
        for (int e = 0; e < NE; ++e) { float a = 0.f;
#pragma unroll
            for (int j = 0; j < 4; ++j) { const f32x4 w = *(const LAS f32x4*)(wt + e * DM + 4 * lane + 256 * j); a += (hv[j][0] * w[0] + hv[j][1] * w[1]) + (hv[j][2] * w[2] + hv[j][3] * w[3]); }
            a = wave_sum(a);
            mylogit = (lane == e) ? a : mylogit; }
        mylogit = (lane < NE) ? (mylogit * rstd + F.in[I_BROUTER][lane & 31]) : -3e38f;
        float tv[4]; int ti[4]; float cur = mylogit;
#pragma unroll
        for (int s = 0; s < 4; ++s) { float bv = cur; int bi = lane;
#pragma unroll
            for (int o = 1; o < 64; o <<= 1) { const float ov = __shfl_xor(bv, o); const int oi = __shfl_xor(bi, o); if (ov > bv || (ov == bv && oi < bi)) { bv = ov; bi = oi; } }
            tv[s] = bv; ti[s] = bi; if (lane == bi) cur = -3e38f; }
        const float e1 = __expf(tv[1] - tv[0]), e2 = __expf(tv[2] - tv[0]), e3 = __expf(tv[3] - tv[0]); const float inv = 1.0f / (1.0f + e1 + e2 + e3);
        if (lane == 0) WSP(float, WS_RSTD2)[tk] = rstd;
        if (lane < 4) { const int ex = (lane == 0) ? ti[0] : (lane == 1) ? ti[1] : (lane == 2) ? ti[2] : ti[3]; const float gv = ((lane == 0) ? 1.0f : (lane == 1) ? e1 : (lane == 2) ? e2 : e3) * inv;
            WSP(float, WS_TKG)[(size_t)tk * 4 + lane] = gv;
            const unsigned rank = atomicAdd(&cnt[ex], 1u);
            WSP(int, WS_ROWLIST)[(size_t)ex * T_ + rank] = tk * 4 + lane; }
    }
}


typedef float f32x16 __attribute__((ext_vector_type(16)));
constexpr int XA_VSTR = 520, XA_VT = 65536;
__device__ __forceinline__ bf16x8 pack8(const f32x16& s, int o) {
    u32x4 w; w.x = pg8::cvt_pk_bf16(s[o + 0], s[o + 1]); w.y = pg8::cvt_pk_bf16(s[o + 2], s[o + 3]); w.z = pg8::cvt_pk_bf16(s[o + 4], s[o + 5]); w.w = pg8::cvt_pk_bf16(s[o + 6], s[o + 7]);
    return __builtin_bit_cast(bf16x8, w);
}
__device__ __forceinline__ void phase_xattn(Frame& F) {
    LAS unsigned char* L = F.lds;
    const bf16_t *Qb = WSP(bf16_t, WS_XQ), *KV = WSP(bf16_t, WS_MKV); bf16_t* Ob = WSP(bf16_t, WS_XO);
    const int lane = F.lane, r32 = lane & 31, hi = lane >> 5, wid = F.wave;
    const int NU = NB * XH * (SEQ / 256), UPB = (NU + F.G - 1) / F.G;
    int lastbh = -1;
    for (int u = F.bid * UPB; u < NU && u < (F.bid + 1) * UPB; ++u) {
        const int bh = u >> 5, qb = u & 31, b = bh >> 2, h = bh & 3;
        if (bh != lastbh) {
            __syncthreads();
            for (int c = F.tid; c < 256 * 16; c += 512) { const int m = c >> 4, ch = c & 15; *(LAS u32x4*)(L + m * 256 + ((ch ^ (m & 15)) << 4)) = *(const u32x4*)(KV + (size_t)(b * MEML + m) * (2 * XW) + h * XD + ch * 8); }
            { const bf16_t* VTg = WSP(bf16_t, WS_MVT) + ((size_t)b * XW + h * XD) * MEML;
              for (int c = F.tid; c < 128 * 64; c += 512) { const int d = c >> 6, pc = c & 63; *(LAS u32x2*)(L + XA_VT + d * XA_VSTR + pc * 8) = *(const u32x2*)(VTg + (size_t)d * MEML + pc * 4); } }
            __syncthreads(); lastbh = bh; }
        const size_t row = (size_t)b * SEQ + qb * 256 + wid * 32 + r32;
        bf16x8 qf[8];
#pragma unroll
        for (int kd = 0; kd < 8; ++kd) qf[kd] = *(const bf16x8*)(Qb + row * XW + h * XD + 16 * kd + 8 * hi);
        f32x16 o[4];
#pragma unroll
        for (int dt = 0; dt < 4; ++dt)
#pragma unroll
            for (int r = 0; r < 16; ++r) o[dt][r] = 0.f;
        float mrun = -1e30f, lrun = 0.f;
#pragma unroll 1
        for (int c = 0; c < 4; ++c) {
            f32x16 s0, s1;
#pragma unroll
            for (int r = 0; r < 16; ++r) { s0[r] = 0.f; s1[r] = 0.f; }
            const int kv0 = c * 64 + r32, kv1 = kv0 + 32;
#pragma unroll
            for (int kd = 0; kd < 8; ++kd) { const int ch = 2 * kd + hi;
                const bf16x8 k0 = *(const LAS bf16x8*)(L + kv0 * 256 + ((ch ^ (kv0 & 15)) << 4)), k1 = *(const LAS bf16x8*)(L + kv1 * 256 + ((ch ^ (kv1 & 15)) << 4));
                s0 = __builtin_amdgcn_mfma_f32_32x32x16_bf16(k0, qf[kd], s0, 0, 0, 0); s1 = __builtin_amdgcn_mfma_f32_32x32x16_bf16(k1, qf[kd], s1, 0, 0, 0); }
            float mx = fmaxf(s0[0], s1[0]);
#pragma unroll
            for (int r = 1; r < 16; ++r) mx = fmaxf(mx, fmaxf(s0[r], s1[r]));
            mx = fmaxf(mx, __shfl_xor(mx, 32));
            const float mn = fmaxf(mrun, mx), sc = __builtin_amdgcn_exp2f(mrun - mn); mrun = mn;
            float ls = 0.f;
#pragma unroll
            for (int r = 0; r < 16; ++r) { s0[r] = __builtin_amdgcn_exp2f(s0[r] - mn); s1[r] = __builtin_amdgcn_exp2f(s1[r] - mn); ls += s0[r] + s1[r]; }
            ls += __shfl_xor(ls, 32); lrun = lrun * sc + ls;
#pragma unroll
            for (int dt = 0; dt < 4; ++dt)
#pragma unroll
                for (int r = 0; r < 16; ++r) o[dt][r] *= sc;
            bf16x8 pf[4]; pf[0] = pack8(s0, 0); pf[1] = pack8(s0, 8); pf[2] = pack8(s1, 0); pf[3] = pack8(s1, 8);
#pragma unroll
            for (int dt = 0; dt < 4; ++dt)
#pragma unroll
                for (int ks = 0; ks < 4; ++ks) { const LAS unsigned char* vp = L + XA_VT + (dt * 32 + r32) * XA_VSTR + (c * 64 + 16 * ks + 4 * hi) * 2;
                    const u32x2 lo = *(const LAS u32x2*)vp, hh = *(const LAS u32x2*)(vp + 16); u32x4 w; w.x = lo.x; w.y = lo.y; w.z = hh.x; w.w = hh.y;
                    o[dt] = __builtin_amdgcn_mfma_f32_32x32x16_bf16(__builtin_bit_cast(bf16x8, w), pf[ks], o[dt], 0, 0, 0); }
        }
        const float il = 1.0f / lrun;
        bf16_t* op = Ob + row * XW + h * XD + 4 * hi;
#pragma unroll
        for (int dt = 0; dt < 4; ++dt)
#pragma unroll
            for (int g4 = 0; g4 < 4; ++g4) { u32x2 w; w.x = pg8::cvt_pk_bf16(o[dt][4 * g4] * il, o[dt][4 * g4 + 1] * il); w.y = pg8::cvt_pk_bf16(o[dt][4 * g4 + 2] * il, o[dt][4 * g4 + 3] * il);
                *(u32x2*)(op + dt * 32 + 8 * g4) = w; }
    }
    __syncthreads();
}

constexpr int RT_WSTR = 1028, RT_LG = NE * RT_WSTR * 4  , RT_LCNT = RT_LG + 8 * 16 * 33 * 4  , RT_LBASE = RT_LCNT + 128;
typedef float f32x4v __attribute__((ext_vector_type(4)));
__device__ __forceinline__ void phase_router_mfma(Frame& F) {
    LAS float* wt = (LAS float*)F.lds;
    __syncthreads();
    for (int c = F.tid; c < NE * DM; c += 512) { const int k = c >> 5, e = c & 31; wt[e * RT_WSTR + k] = F.in[I_WROUTER][c] * F.in[I_GMOE][k]; }
    LAS unsigned* lcnt = (LAS unsigned*)(F.lds + RT_LCNT); LAS unsigned* lbase = (LAS unsigned*)(F.lds + RT_LBASE);
    const int lane = F.lane, wid = F.wave, row = lane & 15, kq = lane >> 4;
    LAS float* lg = (LAS float*)(F.lds + RT_LG) + wid * (16 * 33);
    const float* H = WSP(float, WS_H); unsigned* cnt = F.ctl + CW_CNT;
    for (int chunk = F.bid; chunk < T_ / 128; chunk += F.G) {
        if (F.tid < 32) lcnt[F.tid] = 0u;
        __syncthreads();
        const int tok0 = chunk * 128 + wid * 16;
        f32x4 acc0 = {0.f, 0.f, 0.f, 0.f}, acc1 = {0.f, 0.f, 0.f, 0.f}; float ss = 0.f;
        const float* hp = H + (size_t)(tok0 + row) * DM + 4 * kq;
        const LAS float* w0 = wt + row * RT_WSTR + 4 * kq; const LAS float* w1 = w0 + 16 * RT_WSTR;
#pragma unroll 4
        for (int i = 0; i < 64; ++i) { const f32x4 a = *(const f32x4*)(hp + 16 * i); const f32x4 b0 = *(const LAS f32x4*)(w0 + 16 * i), b1 = *(const LAS f32x4*)(w1 + 16 * i);
            ss += (a[0] * a[0] + a[1] * a[1]) + (a[2] * a[2] + a[3] * a[3]);
#pragma unroll
            for (int e = 0; e < 4; ++e) { acc0 = __builtin_amdgcn_mfma_f32_16x16x4f32(a[e], b0[e], acc0, 0, 0, 0); acc1 = __builtin_amdgcn_mfma_f32_16x16x4f32(a[e], b1[e], acc1, 0, 0, 0); } }
        ss += __shfl_xor(ss, 16); ss += __shfl_xor(ss, 32);
        const float rstd = 1.0f / sqrtf(ss * (1.0f / DM) + RMS_EPS);
#pragma unroll
        for (int r = 0; r < 4; ++r) { lg[(4 * kq + r) * 33 + row] = acc0[r]; lg[(4 * kq + r) * 33 + 16 + row] = acc1[r]; }
        asm volatile("s_waitcnt lgkmcnt(0)" ::: "memory");
        int ex[4] = {0, 0, 0, 0}; unsigned lrank[4] = {0u, 0u, 0u, 0u}; const int tk = tok0 + lane;
        if (lane < 16) {
            float v[32];
#pragma unroll
            for (int e = 0; e < 32; ++e) v[e] = lg[lane * 33 + e] * rstd + F.in[I_BROUTER][e];
            float tv[4];
#pragma unroll
            for (int s = 0; s < 4; ++s) { float bv = v[0]; int bi = 0;
#pragma unroll
                for (int e = 1; e < 32; ++e) if (v[e] > bv) { bv = v[e]; bi = e; }
#pragma unroll
                for (int e = 0; e < 32; ++e) v[e] = (e == bi) ? -3e38f : v[e];
                tv[s] = bv; ex[s] = bi; }
            const float e1 = __expf(tv[1] - tv[0]), e2 = __expf(tv[2] - tv[0]), e3 = __expf(tv[3] - tv[0]); const float inv = 1.0f / (1.0f + e1 + e2 + e3);
            WSP(float, WS_RSTD2)[tk] = rstd;
            *(f32x4*)(WSP(float, WS_TKG) + (size_t)tk * 4) = (f32x4){inv, e1 * inv, e2 * inv, e3 * inv};
#pragma unroll
            for (int s = 0; s < 4; ++s) lrank[s] = __hip_atomic_fetch_add(&lcnt[ex[s]], 1u, __ATOMIC_RELAXED, __HIP_MEMORY_SCOPE_WORKGROUP);
        }
        __syncthreads();
        if (F.tid < 32) lbase[F.tid] = atomicAdd(&cnt[F.tid], lcnt[F.tid]);
        __syncthreads();
        if (lane < 16) {
#pragma unroll
            for (int s = 0; s < 4; ++s) WSP(int, WS_ROWLIST)[(size_t)ex[s] * T_ + lbase[ex[s]] + lrank[s]] = tk * 4 + s; }
        __syncthreads();
    }
}

__device__ __forceinline__ void phase_final(Frame& F) {
    const int gw = F.bid * 8 + F.wave, NGW = F.G * 8, lane = F.lane;
    const bf16_t* HBf = WSP(bf16_t, WS_HB); const bf16_t* Y = WSP(bf16_t, WS_Y);
    for (int tk = gw; tk < T_; tk += NGW) {
        const u32x2* hp = (const u32x2*)(HBf + (size_t)tk * DM) + lane; f32x4 hv[4];
#pragma unroll
        for (int j = 0; j < 4; ++j) { const u32x2 w = hp[64 * j]; hv[j] = (f32x4){bflo(w.x), bfhi(w.x), bflo(w.y), bfhi(w.y)}; }
#pragma unroll
        for (int s = 0; s < 4; ++s) { const u32x2* yp = (const u32x2*)(Y + ((size_t)tk * 4 + s) * DM) + lane;
#pragma unroll
            for (int j = 0; j < 4; ++j) { const u32x2 w = yp[64 * j]; hv[j][0] += bflo(w.x); hv[j][1] += bfhi(w.x); hv[j][2] += bflo(w.y); hv[j][3] += bfhi(w.y); } }
        float ss = 0.f;
#pragma unroll
        for (int j = 0; j < 4; ++j) ss += (hv[j][0] * hv[j][0] + hv[j][1] * hv[j][1]) + (hv[j][2] * hv[j][2] + hv[j][3] * hv[j][3]);
        float rstd = 1.0f / sqrtf(wave_sum(ss) * (1.0f / DM) + RMS_EPS);
#if DBG_STAGE
        { const float sd = __hip_atomic_load((float*)(F.ctl + CW_DBG), RLX_AGENT), sr = __hip_atomic_load((float*)(F.ctl + CW_DBG + 1), RLX_AGENT); rstd *= 1.0f + sqrtf(100.0f * sd / fmaxf(sr, 1e-30f)); }
#endif
        f32x4* op = (f32x4*)(F.out + (size_t)tk * DM) + lane;
#pragma unroll
        for (int j = 0; j < 4; ++j) op[64 * j] = hv[j] * rstd * ((const f32x4*)F.in[I_GFINAL])[lane + 64 * j];
    }
}


__device__ __forceinline__ void dbg_compare(Frame& F, const bf16_t* A, const bf16_t* R, size_t n) {
    float sd = 0.f, sr = 0.f;
    for (size_t i = (size_t)F.bid * 512 + F.tid; i < n; i += (size_t)F.G * 512) { const float a = bf2f(A[i]), r = bf2f(R[i]); sd += (a - r) * (a - r); sr += r * r; }
    sd = wave_sum(sd); sr = wave_sum(sr);
    if (F.lane == 0) { atomicAdd((float*)(F.ctl + CW_DBG), sd); atomicAdd((float*)(F.ctl + CW_DBG + 1), sr); }
}
constexpr int N_PHASES = 15;
__global__ void __launch_bounds__(512, 2) mega_fwd(Args args) {
    extern __shared__ __attribute__((aligned(16))) unsigned char lds_raw[];
    Frame F;
    F.lds = (LAS unsigned char*)lds_raw; F.tid = threadIdx.x; F.lane = F.tid & 63; F.wave = __builtin_amdgcn_readfirstlane(F.tid >> 6); F.G = gridDim.x; F.bid = blockIdx.x;
#pragma unroll
    for (int i = 0; i < 28; ++i) F.in[i] = args.in[i];
    F.out = args.out; F.ws = args.ws; F.ctl = (unsigned*)(args.ws + WS_CTL);
    volatile LAS unsigned* MISC = (volatile LAS unsigned*)(F.lds + MISC_OFF);
    if (F.tid < 64) MISC[F.tid] = 0u;
    __syncthreads();
    const int lo = args.ph_lo, hi = args.ph_hi;
    XcdBarrier bar; bar.bar = F.ctl + CW_BAR; bar.x = 0; bar.st = nullptr;
    if (hi - lo > 1) bar = xcd_barrier_post(F.ctl + CW_BAR, MISC + 8);
#define IN(k) (lo <= (k) && (k) < hi)
#define SEAM(k) do { if (IN(k) && IN((k) + 1)) xcd_barrier(bar); } while (0)
    LAS unsigned char* ring = F.lds;
    const LAS int* gidx = (const LAS int*)(F.lds + GIDX_OFF);

    if (IN(0)) for (int rep_ = 0; rep_ <= ((REP_MASK >> 0) & 1); ++rep_) { if (rep_) xcd_barrier(bar);  for (int tk = F.bid; tk < NG * 8; tk += F.G) p0_ssm_tables(F, tk); phase_prologue(F); } SEAM(0);
    if (IN(1)) for (int rep_ = 0; rep_ <= ((REP_MASK >> 1) & 1); ++rep_) { if (rep_) xcd_barrier(bar);
        { pg8::Gemm g{WSP(bf16_t, WS_XB), WSP(bf16_t, WS_WIN), DM, 0}; pg8::PatchOrder S; S.init(T_ / 256, INW / 256, 8, F.G, F.bid);
          pg8::EpiInProj E{WSP(float, WS_RSTD0), WSP(bf16_t, WS_Q), WSP(bf16_t, WS_K), WSP(bf16_t, WS_V), WSP(bf16_t, WS_U), WSP(bf16_t, WS_SGA), WSP(bf16_t, WS_SGB), WSP(float, WS_KM2)};
          pg8::gemm_phase<pg8::EpiInProj, pg8::PatchOrder, false>(ring, g, S, E, gidx); }
        { pg8::Gemm g{WSP(bf16_t, WS_MN), WSP(bf16_t, WS_WXKV), DM, 0}; pg8::PatchOrder S; S.init(NB * MEML / 256, 2 * XW / 256, 4, F.G, F.bid);
          pg8::EpiMemKV E{WSP(bf16_t, WS_MKV), WSP(bf16_t, WS_MVT)};
          pg8::gemm_phase<pg8::EpiMemKV, pg8::PatchOrder, false>(ring, g, S, E, gidx); }
    } SEAM(1);
    if (IN(3)) for (int rep_ = 0; rep_ <= ((REP_MASK >> 3) & 1); ++rep_) { if (rep_) xcd_barrier(bar);
        for (int it = F.bid; it < NB * NG; it += F.G) ssm_state_item(F, it / NG, it % NG);
        const attn_body::AttnTensors AT{(const attn_body::bf16*)WSP(bf16_t, WS_Q), (const attn_body::bf16*)WSP(bf16_t, WS_K), (const attn_body::bf16*)WSP(bf16_t, WS_V), (attn_body::bf16*)WSP(bf16_t, WS_ATT), WSP(float, WS_KMEAN)};
        const attn_body::StaticOrder SO((int)F.G, (int)F.bid);
        attn_body::attn_phase<attn_body::StaticOrder>((char*)lds_raw, AT, SO);
    } SEAM(3);
    if (IN(4)) for (int rep_ = 0; rep_ <= ((REP_MASK >> 4) & 1); ++rep_) { if (rep_) xcd_barrier(bar);  phase_ssm_out(F); } SEAM(4);
#if DBG_STAGE == 1
    phase_ssm_simple(F, WSP(bf16_t, WS_MERGED)); xcd_barrier(bar); dbg_compare(F, WSP(bf16_t, WS_YB), WSP(bf16_t, WS_MERGED), (size_t)T_ * SW); xcd_barrier(bar);
#elif DBG_STAGE == 2
    phase_moba_simple(F, WSP(bf16_t, WS_MERGED)); xcd_barrier(bar); dbg_compare(F, WSP(bf16_t, WS_ATT), WSP(bf16_t, WS_MERGED), (size_t)T_ * AW); xcd_barrier(bar);
#endif
    if (IN(5)) for (int rep_ = 0; rep_ <= ((REP_MASK >> 5) & 1); ++rep_) { if (rep_) xcd_barrier(bar);
        pg8::Gemm g{WSP(bf16_t, WS_YB), WSP(bf16_t, WS_WGLU), SW, 0}; pg8::PatchOrder S; S.init(T_ / 256, 2 * DM / 256, 8, F.G, F.bid);
        pg8::EpiGlu E{WSP(bf16_t, WS_SGB), WSP(bf16_t, WS_YB2S)};
        pg8::gemm_phase<pg8::EpiGlu, pg8::PatchOrder, false>(ring, g, S, E, gidx);
    } SEAM(5);
    if (IN(6)) for (int rep_ = 0; rep_ <= ((REP_MASK >> 6) & 1); ++rep_) { if (rep_) xcd_barrier(bar);
        pg8::Gemm g{WSP(bf16_t, WS_ATT), WSP(bf16_t, WS_WPA), AW, 0}; pg8::PatchOrder S; S.init(T_ / 256, DM / 256, 4, F.G, F.bid);
        pg8::EpiMerge E{WSP(bf16_t, WS_SGA), WSP(bf16_t, WS_YB2S), WSP(bf16_t, WS_MERGED)};
        pg8::gemm_phase<pg8::EpiMerge, pg8::PatchOrder, false>(ring, g, S, E, gidx);
    } SEAM(6);
    if (IN(7)) for (int rep_ = 0; rep_ <= ((REP_MASK >> 7) & 1); ++rep_) { if (rep_) xcd_barrier(bar);
        pg8::Gemm g{WSP(bf16_t, WS_MERGED), WSP(bf16_t, WS_WOUT), DM, 0}; pg8::PatchOrder S; S.init(T_ / 256, DM / 256, 4, F.G, F.bid);
        pg8::EpiResid E{F.in[I_X], WSP(float, WS_H), WSP(bf16_t, WS_HB), WSP(float, WS_SSQ1)};
        pg8::gemm_phase<pg8::EpiResid, pg8::PatchOrder, false>(ring, g, S, E, gidx);
    } SEAM(7);
    if (IN(8)) for (int rep_ = 0; rep_ <= ((REP_MASK >> 8) & 1); ++rep_) { if (rep_) xcd_barrier(bar);
        pg8::Gemm g{WSP(bf16_t, WS_HB), WSP(bf16_t, WS_WXQ), DM, 0}; pg8::PatchOrder S; S.init(T_ / 256, XW / 256, 2, F.G, F.bid);
        pg8::EpiXq E{WSP(float, WS_SSQ1), WSP(bf16_t, WS_XQ)};
        pg8::gemm_phase<pg8::EpiXq, pg8::PatchOrder, false>(ring, g, S, E, gidx);
    } SEAM(8);
    if (IN(9)) for (int rep_ = 0; rep_ <= ((REP_MASK >> 9) & 1); ++rep_) { if (rep_) xcd_barrier(bar);  phase_xattn(F); } SEAM(9);
#if DBG_STAGE == 3
    phase_xattn_simple(F, WSP(bf16_t, WS_MERGED)); xcd_barrier(bar); dbg_compare(F, WSP(bf16_t, WS_XO), WSP(bf16_t, WS_MERGED), (size_t)T_ * XW); xcd_barrier(bar);
#endif
    if (IN(10)) for (int rep_ = 0; rep_ <= ((REP_MASK >> 10) & 1); ++rep_) { if (rep_) xcd_barrier(bar);
        pg8::Gemm g{WSP(bf16_t, WS_XO), WSP(bf16_t, WS_WXO), XW, 0}; pg8::PatchOrder S; S.init(T_ / 256, DM / 256, 4, F.G, F.bid);
        pg8::EpiResid E{WSP(float, WS_H), WSP(float, WS_H), WSP(bf16_t, WS_HB), WSP(float, WS_SSQ2)};
        pg8::gemm_phase<pg8::EpiResid, pg8::PatchOrder, false>(ring, g, S, E, gidx);
    } SEAM(10);
    if (IN(11)) for (int rep_ = 0; rep_ <= ((REP_MASK >> 11) & 1); ++rep_) { if (rep_) xcd_barrier(bar);  phase_router_mfma(F); } SEAM(11);
    if (IN(12) || IN(13)) {
        LAS int* pref = (LAS int*)(F.lds + MISC_OFF + 256);
        const unsigned* cnt = F.ctl + CW_CNT;
        __syncthreads();
        if (F.tid == 0) { int a = 0; for (int e = 0; e < NE; ++e) { pref[e] = a; a += ((int)__hip_atomic_load(cnt + e, RLX_AGENT) + 255) >> 8; } pref[NE] = a; }
        __syncthreads();
        const int MT = pref[NE];
        if (IN(12)) for (int rep_ = 0; rep_ <= ((REP_MASK >> 12) & 1); ++rep_) { if (rep_) xcd_barrier(bar);
            MoeOrder S; S.P.init(MT, 2 * DFF / 256, 8, F.G, F.bid); S.pref = pref;
            { LAS int* gw_ = (LAS int*)(F.lds + GIDX_OFF); pg8::Unit u;
              for (int i = 0; i < GIDX_UNITS && S.next(i, u); ++i) { const int ce = (int)__hip_atomic_load(cnt + u.e, RLX_AGENT);
                  if (F.tid < 256) { const int rank = u.mi * 256 + F.tid; gw_[i * 256 + F.tid] = (rank < ce) ? (WSP(int, WS_ROWLIST)[(size_t)u.e * T_ + rank] >> 2) : 0; } } }
            __syncthreads();
            pg8::Gemm g{WSP(bf16_t, WS_HB), WSP(bf16_t, WS_WGU), DM, (size_t)2 * DFF * DM};
            pg8::EpiMoe1 E{WSP(float, WS_RSTD2), F.in[I_BGU], WSP(bf16_t, WS_HID), gidx};
            pg8::gemm_phase<pg8::EpiMoe1, MoeOrder, true>(ring, g, S, E, gidx);
        }
        SEAM(12);
        if (IN(13)) for (int rep_ = 0; rep_ <= ((REP_MASK >> 13) & 1); ++rep_) { if (rep_) xcd_barrier(bar);
            MoeOrder S; S.P.init(MT, DM / 256, 4, F.G, F.bid); S.pref = pref;
            pg8::Gemm g{WSP(bf16_t, WS_HID), WSP(bf16_t, WS_WDN), DFF, (size_t)DM * DFF};
            pg8::EpiMoe2 E{F.in[I_BDN], WSP(float, WS_TKG), WSP(int, WS_ROWLIST), cnt, WSP(bf16_t, WS_Y)};
            pg8::gemm_phase<pg8::EpiMoe2, MoeOrder, false>(ring, g, S, E, gidx);
        }
    } SEAM(13);
    if (IN(14)) for (int rep_ = 0; rep_ <= ((REP_MASK >> 14) & 1); ++rep_) { if (rep_) xcd_barrier(bar);  phase_final(F); }
#undef IN
#undef SEAM
}

extern "C" void kernel_launch(void* const* d_in, const int* in_sizes, int n_in, void* d_out, int out_size, void* d_ws, size_t ws_size, hipStream_t stream) {
    static int grid = 0;
    if (grid == 0) {
        if (n_in != 28 || in_sizes[0] != T_ * DM || out_size != T_ * DM || ws_size < WS_END) { fprintf(stderr, "kernel_launch: unexpected shapes (n_in %d, in0 %d, out %d, ws %zu)\n", n_in, n_in > 0 ? in_sizes[0] : -1, out_size, ws_size); grid = -1; return; }
        int dev = 0, cus = 0;
        if (hipGetDevice(&dev) != hipSuccess || hipDeviceGetAttribute(&cus, hipDeviceAttributeMultiprocessorCount, dev) != hipSuccess) { grid = -1; return; }
        if (hipFuncSetAttribute((const void*)mega_fwd, hipFuncAttributeMaxDynamicSharedMemorySize, LDS_BYTES) != hipSuccess) { fprintf(stderr, "kernel_launch: hipFuncSetAttribute failed\n"); grid = -1; return; }
        (void)hipGetLastError();
        grid = cus;
    }
    if (grid < 0) return;
    (void)hipMemsetAsync((char*)d_ws + WS_CTL, 0, CTL_ZERO_BYTES, stream);
    Args a{};
    for (int i = 0; i < 28; ++i) a.in[i] = (const float*)d_in[i];
    a.out = (float*)d_out; a.ws = (unsigned char*)d_ws;
#if MK_N_LAUNCHES == 1
    a.ph_lo = 0; a.ph_hi = N_PHASES;
    hipLaunchKernelGGL(mega_fwd, dim3(grid), dim3(512), LDS_BYTES, stream, a);
#else
    for (int p = 0; p < N_PHASES; ++p) { a.ph_lo = p; a.ph_hi = p + 1; hipLaunchKernelGGL(mega_fwd, dim3(grid), dim3(512), LDS_BYTES, stream, a); }
#endif
}
```

```cpp
#include <hip/hip_runtime.h>
#include <hip/hip_bf16.h>
#include <cmath>
#include <cstdio>
#include <cstdint>

#ifndef MK_N_LAUNCHES
#define MK_N_LAUNCHES 1
#endif

#ifndef REP_EXTRA
#define REP_EXTRA 1
#endif
#ifndef NULL_EXP
#define NULL_EXP 0
#endif
#ifndef STG_TICKS
#define STG_TICKS 0
#endif
#ifndef MOBA_EXP
#define MOBA_EXP 0
#endif
#ifndef OUT_NT
#define OUT_NT 0
#endif
#ifndef OUT_TOUCH
#define OUT_TOUCH 0
#endif
#ifndef BAR_EXP
#define BAR_EXP 0
#endif
#ifndef FINAL_EXP
#define FINAL_EXP 0
#endif
#ifndef REP_MASK
#define REP_MASK 0
#endif
#ifndef DBG_STAGE
#define DBG_STAGE 0
#endif

#define GAS __attribute__((address_space(1)))
#define LAS __attribute__((address_space(3)))
typedef unsigned short bf16_t;
typedef short bf16x8 __attribute__((ext_vector_type(8)));
typedef float f32x4 __attribute__((ext_vector_type(4)));
typedef float f32x2 __attribute__((ext_vector_type(2)));
typedef float f32x16 __attribute__((ext_vector_type(16)));
typedef unsigned u32x4 __attribute__((ext_vector_type(4)));
typedef unsigned u32x2 __attribute__((ext_vector_type(2)));

constexpr int NB = 4, SEQ = 8192, DM = 1024, T_ = NB * SEQ;
constexpr int AW = 512, NH = 8, HD = 64, MBLK = 256, NBLK = SEQ / MBLK, MTOPK = 3;
constexpr int SW = 512, SGC = 16, NG = 32, SP = 64;
constexpr int INW = 4096;
constexpr int MEML = 256, XH = 4, XD = 128, XW = 512;
constexpr int NE = 32, ETOPK = 4, DFF = 1024;
constexpr float RMS_EPS = 1e-6f;
constexpr float LOG2E = 1.4426950408889634f;
constexpr float QSCALE = 0.125f * LOG2E;
constexpr float XSCALE = 0.08838834764831845f * LOG2E;
constexpr int HID_ROWS = ETOPK * T_ + NE * 256;

constexpr size_t MiB = 1u << 20;
constexpr size_t WS_WIN = 0 * MiB, WS_WGLU = 8 * MiB, WS_WPA = 10 * MiB, WS_WOUT = 11 * MiB, WS_WXQ = 13 * MiB, WS_WXKV = 14 * MiB, WS_WXO = 16 * MiB,
                 WS_WGU = 17 * MiB, WS_WDN = 145 * MiB;
constexpr size_t WS_CTL = 209 * MiB, CTL_ZERO_BYTES = 1 * MiB;
constexpr size_t WS_RSTD0 = 210 * MiB;
constexpr size_t WS_RSTD2 = WS_RSTD0 + 128 * 1024;
constexpr size_t WS_KMEAN = WS_RSTD2 + 128 * 1024;
constexpr size_t WS_KM2 = WS_KMEAN;
constexpr size_t WS_TKG = 224 * MiB;
constexpr size_t WS_SSQ1 = 211 * MiB;
constexpr size_t WS_SSQ2 = 213 * MiB;
constexpr size_t WS_ROWLIST = 215 * MiB;
constexpr size_t WS_MN = 219 * MiB;
constexpr size_t WS_MKV = 221 * MiB;
constexpr size_t WS_MVT = 223 * MiB;
constexpr size_t WS_WST = 225 * MiB;
constexpr size_t WS_GT = 233 * MiB;
constexpr size_t WS_KT = 241 * MiB;
constexpr size_t WS_LAML = 243 * MiB;
constexpr size_t WS_SST = 244 * MiB;
constexpr size_t WS_H = 256 * MiB;
constexpr size_t WS_N2B = 256 * MiB;
constexpr size_t WS_PO = 256 * MiB;
constexpr size_t WS_PML = 384 * MiB;
constexpr size_t WS_MLIST = 392 * MiB;
constexpr size_t WS_HB = 384 * MiB;
constexpr size_t WS_HID = 448 * MiB;
constexpr size_t WS_Y = 720 * MiB;
constexpr size_t WS_END = 976 * MiB;
constexpr size_t WS_XB = 448 * MiB, WS_Q = 512 * MiB, WS_K = 544 * MiB, WS_V = 576 * MiB, WS_U = 608 * MiB, WS_ATT = 640 * MiB, WS_YB = 672 * MiB;
constexpr size_t WS_SGA = 720 * MiB, WS_SGB = 784 * MiB, WS_YB2S = 848 * MiB, WS_MERGED = 912 * MiB;
constexpr size_t WS_XQ = 448 * MiB, WS_XO = 480 * MiB;
static_assert(WS_HID + (size_t)HID_ROWS * DFF * 2 <= WS_Y, "HID fits");
constexpr int CW_TMO = 0, CW_CNT = 64  , CW_DBG = 128  , CW_MCNT = 256  , CW_BAR = 4096;

constexpr int RING_BYTES = 131072;
constexpr int GIDX_OFF = RING_BYTES, GIDX_UNITS = 24;
constexpr int MISC_OFF = GIDX_OFF + GIDX_UNITS * 1024;
constexpr int LDS_BYTES = 163840;

#define RLX_AGENT __ATOMIC_RELAXED, __HIP_MEMORY_SCOPE_AGENT
__device__ __forceinline__ unsigned f2bf(float f) { unsigned u = __builtin_bit_cast(unsigned, f); return (u + 0x7fffu + ((u >> 16) & 1u)) >> 16; }
__device__ __forceinline__ unsigned pk2(float lo, float hi) { return f2bf(lo) | (f2bf(hi) << 16); }
__device__ __forceinline__ float bf2f(unsigned short b) { return __builtin_bit_cast(float, (unsigned)b << 16); }
__device__ __forceinline__ float bflo(unsigned w) { return __builtin_bit_cast(float, w << 16); }
__device__ __forceinline__ float bfhi(unsigned w) { return __builtin_bit_cast(float, w & 0xffff0000u); }
__device__ __forceinline__ float ub0(unsigned w) { return (float)(w & 0xffu) * (1.0f / 255.0f); }
__device__ __forceinline__ float ub1(unsigned w) { return (float)((w >> 8) & 0xffu) * (1.0f / 255.0f); }
__device__ __forceinline__ float ub2(unsigned w) { return (float)((w >> 16) & 0xffu) * (1.0f / 255.0f); }
__device__ __forceinline__ float ub3(unsigned w) { return (float)(w >> 24) * (1.0f / 255.0f); }
__device__ __forceinline__ float wave_sum(float v) {
#pragma unroll
    for (int o = 1; o < 64; o <<= 1) v += __shfl_xor(v, o);
    return v;
}
__device__ __forceinline__ float fsigmoid(float x) { return __builtin_amdgcn_rcpf(1.0f + __builtin_amdgcn_exp2f(-x * LOG2E)); }
__device__ __forceinline__ float gelu_tanh(float x) {
    const float u = 0.7978845608028654f * (x + 0.044715f * x * x * x);
    return x * fsigmoid(2.0f * u);
}

namespace pg8 {
constexpr int BM = 256, BK = 64, HALF = 128, HTB = HALF * BK * 2, STAGE_BYTES = 8 * HTB;
__host__ __device__ __forceinline__ int lds_byte(int r, int c) { const int st = (r >> 4) * 2 + (c >> 5), rr = r & 15, cc = c & 31, ob = rr * 64 + cc * 2; return st * 1024 + (ob ^ (((ob >> 9) & 1) << 5)); }
__host__ __device__ __forceinline__ void stage_rc(int b, int& R, int& C) { const int st = b / 1024, sb = b % 1024, swz = sb ^ (((sb >> 9) & 1) << 5); R = (st >> 1) * 16 + swz / 64; C = (st & 1) * 32 + (swz % 64) / 2; }
__host__ __device__ __forceinline__ int perm32(int rho) { const int n = rho >> 4, i = rho & 15; return 8 * (i >> 2) + 4 * n + (i & 3); }

struct Unit { int pm, pn, e, mi, ui; };
struct Gemm { const bf16_t* A; const bf16_t* Bt; int K; size_t b_estride; };

struct PatchOrder {
    int nM, nN, PM, PN, x, j, ok;
    __device__ __forceinline__ void init(int nM_, int nN_, int PN_, int G, int c) { nM = nM_; nN = nN_; PN = PN_; PM = (G / 8) / PN_; x = c & 7; j = c >> 3; ok = ((G & 7) == 0) && (PM * PN == G / 8) && (nN % PN == 0); if (!ok) { x = c; j = G; } }
    __device__ __forceinline__ bool next(int i, Unit& u) const {
        if (!ok) { const long L = (long)i * j + x; if (L >= (long)nM * nN) return false; u.pm = (int)(L / nN); u.pn = (int)(L % nN); u.e = 0; u.mi = u.pm; u.ui = i; return true; }
        const int p = 8 * i + x, npn = nN / PN, pmb = p / npn, pnb = p % npn;
        u.pm = pmb * PM + (j % PM); u.pn = pnb * PN + (j / PM); u.e = 0; u.mi = u.pm; u.ui = i;
        return u.pm < nM;
    }
};

struct PairOrder {
    int pp, q, mode;
    __device__ __forceinline__ void init(int c, int mode_) { const int x = c & 7, k = c >> 3; q = k & 3; pp = 8 * x + (k >> 2); mode = mode_; }
    __device__ __forceinline__ bool next(int i, Unit& u) const {
        if (mode == 0) { if (i >= 4) return false; u.pm = 2 * pp + (i >> 1); u.pn = 2 * q + (i & 1); }
        else { if (i >= 2) return false; u.pm = 2 * pp + i; u.pn = q; }
        u.e = 0; u.mi = u.pm; u.ui = i; return true;
    }
};
__device__ __forceinline__ unsigned cvt_pk_bf16(float lo, float hi) { unsigned r; asm volatile("v_cvt_pk_bf16_f32 %0, %1, %2" : "=v"(r) : "v"(lo), "v"(hi)); return r; }
#ifndef NT_STORES
#define NT_STORES 0
#endif
#ifndef WT_STORES
#define WT_STORES 0
#endif
__device__ __forceinline__ void st16(void* p, u32x4 v) {
#if WT_STORES
    asm volatile("global_store_dwordx4 %0, %1, off sc1\n\ts_nop 1" :: "v"(p), "v"(v) : "memory");
#elif NT_STORES
    __builtin_nontemporal_store(v, (u32x4*)p);
#else
    *(u32x4*)p = v;
#endif
}

template <class Epi, class Sched, bool GATHER>
__device__ __forceinline__ void gemm_phase(LAS unsigned char* lds, const Gemm g, const Sched& S, const Epi& E, const LAS int* gidx, int stagger_ticks = 0) {
    if (stagger_ticks > 0) {
        const unsigned long long t0 = __builtin_amdgcn_s_memrealtime(); const unsigned long long dl = (unsigned long long)(stagger_ticks * ((blockIdx.x >> 3) & 3));
        while (__builtin_amdgcn_s_memrealtime() - t0 < dl) __builtin_amdgcn_s_sleep(8);
    }
    const int tid = threadIdx.x, wid = __builtin_amdgcn_readfirstlane(tid >> 6), lane = tid & 63, wr = wid >> 2, wc = wid & 3, fr = lane & 15, fq = lane >> 4;
    const int K = g.K, nt = K / BK;
    int Ra[2], Ca[2]; unsigned voffB[2];
#pragma unroll
    for (int i = 0; i < 2; ++i) { int R, C; stage_rc(tid * 16 + i * 8192, R, C); const int Rb = Epi::PERM ? ((R & ~31) + perm32(R & 31)) : R;
        Ra[i] = R; Ca[i] = C; voffB[i] = (unsigned)(Rb * K + C) * 2u; }
    const size_t kstep = (size_t)(BK * 2);
    const size_t hstep = (size_t)HALF * K * 2;
    const size_t tstep = 2 * hstep;
    const unsigned ldsw = (unsigned)wid * 1024u;
    const int aoff = lds_byte(wr * 64 + fr, fq * 8), boff = lds_byte(wc * 32 + fr, fq * 8);
#define PG8_SA(b, h) (((b) * 2 + (h)) * HTB)
#define PG8_SB(b, h) ((4 + (b) * 2 + (h)) * HTB)
#define PG8_STAGE(bufoff, gbase, voff) do { _Pragma("unroll") for (int _i = 0; _i < 2; ++_i) \
        __builtin_amdgcn_global_load_lds((const unsigned*)((const char*)(gbase) + (voff)[_i]), (LAS unsigned*)(lds + (bufoff) + ldsw + _i * 8192), 16, 0, 0); } while (0)
#define PG8_LDA(dst, b, h) do { _Pragma("unroll") for (int m = 0; m < 4; ++m) _Pragma("unroll") for (int k = 0; k < 2; ++k) dst[m][k] = *(const LAS bf16x8*)(lds + PG8_SA(b, h) + aoff + m * 2048 + k * 1024); } while (0)
#define PG8_LDB(dst, b, h) do { _Pragma("unroll") for (int n = 0; n < 2; ++n) _Pragma("unroll") for (int k = 0; k < 2; ++k) dst[n][k] = *(const LAS bf16x8*)(lds + PG8_SB(b, h) + boff + n * 2048 + k * 1024); } while (0)
#define PG8_MMA(ai, bj, At, Bt) do { __builtin_amdgcn_s_setprio(1); _Pragma("unroll") for (int m = 0; m < 4; ++m) _Pragma("unroll") for (int n = 0; n < 2; ++n) _Pragma("unroll") for (int k = 0; k < 2; ++k) \
        acc[ai][bj][m][n] = __builtin_amdgcn_mfma_f32_16x16x32_bf16(Bt[n][k], At[m][k], acc[ai][bj][m][n], 0, 0, 0); __builtin_amdgcn_s_setprio(0); } while (0)
#define PG8_WAIT_V(n) asm volatile("s_waitcnt vmcnt(" #n ")" ::: "memory")
#define PG8_WAIT_L(n) asm volatile("s_waitcnt lgkmcnt(" #n ")" ::: "memory")
#define PG8_BAR __builtin_amdgcn_s_barrier()
#define PG8_SCHED __builtin_amdgcn_sched_barrier(0)
#define PG8_VOA(dst, u) do { _Pragma("unroll") for (int _h = 0; _h < 2; ++_h) _Pragma("unroll") for (int _i = 0; _i < 2; ++_i) { \
        const int _row = GATHER ? gidx[(u).ui * 256 + _h * HALF + Ra[_i]] : (_h * HALF + Ra[_i]); dst[_h][_i] = (unsigned)(_row * K + Ca[_i]) * 2u; } } while (0)
    Unit cur, nxt; int ui = 0;
    if (!S.next(0, cur)) return;
    f32x4 acc[2][2][4][2];
#pragma unroll
    for (int a = 0; a < 2; ++a)
#pragma unroll
        for (int b = 0; b < 2; ++b)
#pragma unroll
            for (int m = 0; m < 4; ++m)
#pragma unroll
                for (int n = 0; n < 2; ++n) acc[a][b][m][n] = (f32x4){0.f, 0.f, 0.f, 0.f};
    bf16x8 At[4][2], B0[2][2], B1[2][2];
    unsigned voA[2][2], voN[2][2];
    PG8_VOA(voA, cur);
    const char* cA = (const char*)g.A + (GATHER ? (size_t)0 : (size_t)cur.pm * tstep);
    const char* cB = (const char*)g.Bt + ((size_t)cur.e * g.b_estride) * 2 + (size_t)cur.pn * tstep;
    PG8_STAGE(PG8_SB(0, 0), cB, voffB); PG8_STAGE(PG8_SB(0, 1), cB + hstep, voffB); PG8_STAGE(PG8_SA(0, 0), cA, voA[0]); PG8_STAGE(PG8_SA(0, 1), cA, voA[1]);
    if (wr == 1) PG8_BAR;
    PG8_WAIT_V(2); PG8_BAR;
    PG8_STAGE(PG8_SB(1, 0), cB + kstep, voffB); PG8_STAGE(PG8_SA(1, 0), cA + kstep, voA[0]); PG8_STAGE(PG8_SB(1, 1), cB + hstep + kstep, voffB);
    PG8_WAIT_V(6); PG8_BAR;
    for (;;) {
        const bool has_next = S.next(ui + 1, nxt);
        const char* nA = cA; const char* nB = cB;
#pragma unroll
        for (int h = 0; h < 2; ++h)
#pragma unroll
            for (int i = 0; i < 2; ++i) voN[h][i] = voA[h][i];
        if (has_next) { nA = (const char*)g.A + (GATHER ? (size_t)0 : (size_t)nxt.pm * tstep); nB = (const char*)g.Bt + ((size_t)nxt.e * g.b_estride) * 2 + (size_t)nxt.pn * tstep; PG8_VOA(voN, nxt); }
        for (int t = 0; t < nt; t += 2) {
            const bool last = (t == nt - 2);
            const char* a1 = cA + (size_t)(t + 1) * kstep;
            const char* a2 = last ? nA : cA + (size_t)(t + 2) * kstep; const char* b2 = last ? nB : cB + (size_t)(t + 2) * kstep;
            const char* a3 = a2 + kstep; const char* b3 = b2 + kstep;
            unsigned vo2[2][2];
#pragma unroll
            for (int h = 0; h < 2; ++h)
#pragma unroll
                for (int i = 0; i < 2; ++i) vo2[h][i] = last ? voN[h][i] : voA[h][i];
            PG8_LDB(B0, 0, 0); PG8_LDB(B1, 0, 1); PG8_SCHED; PG8_LDA(At, 0, 0); PG8_STAGE(PG8_SA(1, 1), a1, voA[1]);
            PG8_WAIT_V(8); PG8_WAIT_L(0); PG8_BAR; PG8_MMA(0, 0, At, B0); PG8_MMA(0, 1, At, B1); PG8_BAR; PG8_SCHED;
            PG8_LDA(At, 0, 1); PG8_STAGE(PG8_SB(0, 0), b2, voffB); PG8_STAGE(PG8_SB(0, 1), b2 + hstep, voffB); PG8_STAGE(PG8_SA(0, 0), a2, vo2[0]);
            PG8_WAIT_V(8); PG8_WAIT_L(0); PG8_BAR; PG8_MMA(1, 0, At, B0); PG8_MMA(1, 1, At, B1); PG8_BAR; PG8_SCHED;
            PG8_LDB(B0, 1, 0); PG8_LDB(B1, 1, 1); PG8_SCHED; PG8_LDA(At, 1, 0); PG8_STAGE(PG8_SA(0, 1), a2, vo2[1]);
            PG8_WAIT_V(8); PG8_WAIT_L(0); PG8_BAR; PG8_MMA(0, 0, At, B0); PG8_MMA(0, 1, At, B1); PG8_BAR; PG8_SCHED;
            PG8_LDA(At, 1, 1); PG8_STAGE(PG8_SB(1, 0), b3, voffB); PG8_STAGE(PG8_SB(1, 1), b3 + hstep, voffB); PG8_STAGE(PG8_SA(1, 0), a3, vo2[0]);
            PG8_WAIT_V(8); PG8_WAIT_L(0); PG8_BAR; PG8_MMA(1, 0, At, B0); PG8_MMA(1, 1, At, B1); PG8_BAR; PG8_SCHED;
        }
        if (wr == 0) PG8_BAR;
        E(acc, cur, wr, wc, fr, fq);
        if (!has_next) break;
#pragma unroll
        for (int a = 0; a < 2; ++a)
#pragma unroll
            for (int b = 0; b < 2; ++b)
#pragma unroll
                for (int m = 0; m < 4; ++m)
#pragma unroll
                    for (int n = 0; n < 2; ++n) acc[a][b][m][n] = (f32x4){0.f, 0.f, 0.f, 0.f};
        cur = nxt; cA = nA; cB = nB; ++ui;
#pragma unroll
        for (int h = 0; h < 2; ++h)
#pragma unroll
            for (int i = 0; i < 2; ++i) voA[h][i] = voN[h][i];
        if (wr == 1) PG8_BAR;
    }
    PG8_WAIT_V(0);
    PG8_BAR;
#undef PG8_SA
#undef PG8_SB
#undef PG8_STAGE
#undef PG8_LDA
#undef PG8_LDB
#undef PG8_MMA
#undef PG8_WAIT_V
#undef PG8_WAIT_L
#undef PG8_BAR
#undef PG8_SCHED
#undef PG8_VOA
}

typedef const f32x4 (&AccRef)[2][2][4][2];
#define EPI_ROWS for (int ai = 0; ai < 2; ++ai) _Pragma("unroll") for (int m = 0; m < 4; ++m)

template <int XMODE> struct EpiInProjT {
    static constexpr bool PERM = true;
    bf16_t *Q, *Kb, *V, *U, *SGA, *SGB; float* KM2;
    __device__ __forceinline__ void operator()(AccRef acc, const Unit& u, int wr, int wc, int fr, int fq) const {
        bf16_t* dst; int ld, colt; bool sig = false; float sc = 1.f;
        if (u.pn < 2) { dst = Q; ld = AW; colt = u.pn * 256; sc = QSCALE; }
        else if (u.pn < 4) { dst = Kb; ld = AW; colt = (u.pn - 2) * 256; }
        else if (u.pn < 6) { dst = V; ld = AW; colt = (u.pn - 4) * 256; }
        else if (u.pn < 8) { dst = U; ld = AW; colt = (u.pn - 6) * 256; }
        else if (u.pn < 12) { dst = SGA; ld = DM; colt = (u.pn - 8) * 256; sig = true; }
        else { dst = SGB; ld = DM; colt = (u.pn - 12) * 256; sig = true; }
        const int row0 = u.pm * BM + wr * 64 + fr, col0 = colt + wc * 32 + 8 * fq;
        const bool isk = (u.pn == 2 || u.pn == 3); f32x4 cs[2][2];
#pragma unroll
        for (int bj = 0; bj < 2; ++bj)
#pragma unroll
            for (int n = 0; n < 2; ++n) cs[bj][n] = (f32x4){0.f, 0.f, 0.f, 0.f};
#pragma unroll
        EPI_ROWS { const int row = row0 + ai * HALF + m * 16; const float rs = sc; bf16_t* rowp = dst + (size_t)row * ld + col0;
#pragma unroll
            for (int bj = 0; bj < 2; ++bj) { f32x4 v0 = acc[ai][bj][m][0] * rs, v1 = acc[ai][bj][m][1] * rs;
                cs[bj][0] += v0; cs[bj][1] += v1;
                if (sig) {
                    unsigned q[8];
#pragma unroll
                    for (int e = 0; e < 4; ++e) { q[e] = (unsigned)(fsigmoid(v0[e]) * 255.0f + 0.5f); q[4 + e] = (unsigned)(fsigmoid(v1[e]) * 255.0f + 0.5f); }
                    const unsigned g0 = q[0] | (q[1] << 8) | (q[2] << 16) | (q[3] << 24), g1 = q[4] | (q[5] << 8) | (q[6] << 16) | (q[7] << 24);
                    if (XMODE != 1) *(u32x2*)((unsigned char*)dst + (size_t)row * ld + col0 + bj * HALF) = (u32x2){g0, g1};
                    continue; }
                u32x4 w; w.x = cvt_pk_bf16(v0[0], v0[1]); w.y = cvt_pk_bf16(v0[2], v0[3]); w.z = cvt_pk_bf16(v1[0], v1[1]); w.w = cvt_pk_bf16(v1[2], v1[3]);
                if (XMODE == 1) { asm volatile("" :: "v"(w)); } else st16(rowp + bj * HALF, w); } }
        if (isk && XMODE == 0) {
#pragma unroll
            for (int bj = 0; bj < 2; ++bj)
#pragma unroll
                for (int n = 0; n < 2; ++n)
#pragma unroll
                    for (int e = 0; e < 4; ++e) { float v = cs[bj][n][e]; v += __shfl_xor(v, 1); v += __shfl_xor(v, 2); v += __shfl_xor(v, 4); v += __shfl_xor(v, 8); cs[bj][n][e] = v; }
            if (fr == 0) { const int b = u.pm / NBLK, j = u.pm % NBLK;
#pragma unroll
                for (int bj = 0; bj < 2; ++bj) { const int col = colt + bj * HALF + wc * 32 + 8 * fq, h = col >> 6, d = col & 63;
                    float* kp = KM2 + ((((size_t)wr * NB + b) * NH + h) * NBLK + j) * HD + d;
                    *(f32x4*)kp = cs[bj][0] * (1.0f / MBLK); *(f32x4*)(kp + 4) = cs[bj][1] * (1.0f / MBLK); } } }
    }
};
struct EpiNull {
    static constexpr bool PERM = true;
    __device__ __forceinline__ void operator()(AccRef acc, const Unit& u, int wr, int wc, int fr, int fq) const {
#pragma unroll
        EPI_ROWS {
#pragma unroll
            for (int bj = 0; bj < 2; ++bj) { asm volatile("" :: "v"(acc[ai][bj][m][0]), "v"(acc[ai][bj][m][1])); } }
    }
};
typedef EpiInProjT<0> EpiInProj;
template <bool FULL> struct EpiStoreExp {
    static constexpr bool PERM = true;
    bf16_t* O;
    __device__ __forceinline__ void operator()(AccRef acc, const Unit& u, int wr, int wc, int fr, int fq) const {
        const int row0 = u.pm * BM + wr * 64 + (FULL ? (fr & 7) : fr), col0 = (u.pn & 3) * BM + (FULL ? (wc * 64 + (fr >> 3) * 32 + 8 * fq) : (wc * 32 + 8 * fq));
#pragma unroll
        EPI_ROWS { bf16_t* rowp = O + (size_t)(row0 + ai * HALF + m * 16) * DM + col0;
#pragma unroll
            for (int bj = 0; bj < 2; ++bj) { const f32x4 v0 = acc[ai][bj][m][0], v1 = acc[ai][bj][m][1];
                u32x4 w; w.x = cvt_pk_bf16(v0[0], v0[1]); w.y = cvt_pk_bf16(v0[2], v0[3]); w.z = cvt_pk_bf16(v1[0], v1[1]); w.w = cvt_pk_bf16(v1[2], v1[3]);
                st16(rowp + (FULL ? (size_t)bj * 8 * DM : (size_t)bj * HALF), w); } }
    }
};
struct EpiStore {
    static constexpr bool PERM = true;
    bf16_t* O; int ld;
    __device__ __forceinline__ void operator()(AccRef acc, const Unit& u, int wr, int wc, int fr, int fq) const {
        const int row0 = u.pm * BM + wr * 64 + fr, col0 = u.pn * BM + wc * 32 + 8 * fq;
#pragma unroll
        EPI_ROWS { bf16_t* rowp = O + (size_t)(row0 + ai * HALF + m * 16) * ld + col0;
#pragma unroll
            for (int bj = 0; bj < 2; ++bj) { const f32x4 v0 = acc[ai][bj][m][0], v1 = acc[ai][bj][m][1];
                u32x4 w; w.x = cvt_pk_bf16(v0[0], v0[1]); w.y = cvt_pk_bf16(v0[2], v0[3]); w.z = cvt_pk_bf16(v1[0], v1[1]); w.w = cvt_pk_bf16(v1[2], v1[3]);
                st16(rowp + bj * HALF, w); } }
    }
};
struct EpiMemKV {
    static constexpr bool PERM = true;
    bf16_t* O; bf16_t* VT;
    __device__ __forceinline__ void operator()(AccRef acc, const Unit& u, int wr, int wc, int fr, int fq) const {
        const int rl0 = wr * 64 + fr, col0 = u.pn * BM + wc * 32 + 8 * fq;
#pragma unroll
        EPI_ROWS { const int rl = rl0 + ai * HALF + m * 16;
#pragma unroll
            for (int bj = 0; bj < 2; ++bj) { const f32x4 v0 = acc[ai][bj][m][0], v1 = acc[ai][bj][m][1]; const int col = col0 + bj * HALF;
                if (u.pn < 2) { u32x4 w; w.x = cvt_pk_bf16(v0[0], v0[1]); w.y = cvt_pk_bf16(v0[2], v0[3]); w.z = cvt_pk_bf16(v1[0], v1[1]); w.w = cvt_pk_bf16(v1[2], v1[3]);
                    st16(O + (size_t)(u.pm * BM + rl) * (2 * XW) + col, w); }
                else { bf16_t* vp = VT + ((size_t)u.pm * XW + (col - XW)) * MEML + rl;
#pragma unroll
                    for (int e = 0; e < 4; ++e) { vp[(size_t)e * MEML] = (bf16_t)f2bf(v0[e]); vp[(size_t)(4 + e) * MEML] = (bf16_t)f2bf(v1[e]); } } } }
    }
};
struct EpiGlu {
    static constexpr bool PERM = true;
    const bf16_t* SGB; bf16_t* O;
    __device__ __forceinline__ void operator()(AccRef acc, const Unit& u, int wr, int wc, int fr, int fq) const {
        const int row0 = u.pm * BM + wr * 64 + fr, col0 = u.pn * HALF + wc * 32 + 8 * fq;
#pragma unroll
        EPI_ROWS { const size_t off = (size_t)(row0 + ai * HALF + m * 16) * DM + col0; const u32x2 s = *(const u32x2*)((const unsigned char*)SGB + off);
            const f32x4 v0 = acc[ai][0][m][0], v1 = acc[ai][0][m][1], g0 = acc[ai][1][m][0], g1 = acc[ai][1][m][1];
            float o[8];
#pragma unroll
            for (int e = 0; e < 4; ++e) { o[e] = v0[e] * fsigmoid(g0[e]); o[4 + e] = v1[e] * fsigmoid(g1[e]); }
            o[0] *= ub0(s.x); o[1] *= ub1(s.x); o[2] *= ub2(s.x); o[3] *= ub3(s.x); o[4] *= ub0(s.y); o[5] *= ub1(s.y); o[6] *= ub2(s.y); o[7] *= ub3(s.y);
            u32x4 w; w.x = cvt_pk_bf16(o[0], o[1]); w.y = cvt_pk_bf16(o[2], o[3]); w.z = cvt_pk_bf16(o[4], o[5]); w.w = cvt_pk_bf16(o[6], o[7]);
            st16(O + off, w); }
    }
};
struct EpiMerge {
    static constexpr bool PERM = true;
    const bf16_t* SGA; const bf16_t* Y2; bf16_t* O;
    __device__ __forceinline__ void operator()(AccRef acc, const Unit& u, int wr, int wc, int fr, int fq) const {
        const int row0 = u.pm * BM + wr * 64 + fr, col0 = u.pn * BM + wc * 32 + 8 * fq;
#pragma unroll
        EPI_ROWS {
#pragma unroll
            for (int bj = 0; bj < 2; ++bj) { const size_t off = (size_t)(row0 + ai * HALF + m * 16) * DM + col0 + bj * HALF;
                const u32x2 s = *(const u32x2*)((const unsigned char*)SGA + off); const u32x4 y = *(const u32x4*)(Y2 + off); const f32x4 v0 = acc[ai][bj][m][0], v1 = acc[ai][bj][m][1];
                u32x4 w; w.x = cvt_pk_bf16(ub0(s.x) * v0[0] + bflo(y.x), ub1(s.x) * v0[1] + bfhi(y.x)); w.y = cvt_pk_bf16(ub2(s.x) * v0[2] + bflo(y.y), ub3(s.x) * v0[3] + bfhi(y.y));
                w.z = cvt_pk_bf16(ub0(s.y) * v1[0] + bflo(y.z), ub1(s.y) * v1[1] + bfhi(y.z)); w.w = cvt_pk_bf16(ub2(s.y) * v1[2] + bflo(y.w), ub3(s.y) * v1[3] + bfhi(y.w));
                st16(O + off, w); } }
    }
};
template <bool XBASE> struct EpiResidT {
    static constexpr bool PERM = true;
    const float* base; bf16_t* HB; float* SSQ;
    __device__ __forceinline__ void operator()(AccRef acc, const Unit& u, int wr, int wc, int fr, int fq) const {
        const int row0 = u.pm * BM + wr * 64 + fr, col0 = u.pn * BM + wc * 32 + 8 * fq;
#pragma unroll
        EPI_ROWS { const int row = row0 + ai * HALF + m * 16; const size_t off = (size_t)row * DM + col0; float ss = 0.f;
#pragma unroll
            for (int bj = 0; bj < 2; ++bj) { const size_t o2 = off + bj * HALF; f32x4 h0, h1;
                if (XBASE) { h0 = *(const f32x4*)(base + o2) + acc[ai][bj][m][0]; h1 = *(const f32x4*)(base + o2 + 4) + acc[ai][bj][m][1]; }
                else { const u32x4 w = *(const u32x4*)(HB + o2); h0 = (f32x4){bflo(w.x), bfhi(w.x), bflo(w.y), bfhi(w.y)} + acc[ai][bj][m][0]; h1 = (f32x4){bflo(w.z), bfhi(w.z), bflo(w.w), bfhi(w.w)} + acc[ai][bj][m][1]; }
                u32x4 o; o.x = cvt_pk_bf16(h0[0], h0[1]); o.y = cvt_pk_bf16(h0[2], h0[3]); o.z = cvt_pk_bf16(h1[0], h1[1]); o.w = cvt_pk_bf16(h1[2], h1[3]); st16(HB + o2, o);
                if (XBASE) ss += ((h0[0] * h0[0] + h0[1] * h0[1]) + (h0[2] * h0[2] + h0[3] * h0[3])) + ((h1[0] * h1[0] + h1[1] * h1[1]) + (h1[2] * h1[2] + h1[3] * h1[3])); }
            if (XBASE) { ss += __shfl_xor(ss, 16); ss += __shfl_xor(ss, 32); if (fq == 0) SSQ[(size_t)row * 16 + u.pn * 4 + wc] = ss; } }
    }
};
struct EpiXq {
    static constexpr bool PERM = true;
    const float* SSQ; bf16_t* O;
    __device__ __forceinline__ void operator()(AccRef acc, const Unit& u, int wr, int wc, int fr, int fq) const {
        const int row0 = u.pm * BM + wr * 64 + fr, col0 = u.pn * BM + wc * 32 + 8 * fq;
#pragma unroll
        EPI_ROWS { const int row = row0 + ai * HALF + m * 16; const f32x4* sp = (const f32x4*)(SSQ + (size_t)row * 16);
            const f32x4 a = sp[0] + sp[1] + sp[2] + sp[3]; const float rs = __builtin_amdgcn_rsqf(((a[0] + a[1]) + (a[2] + a[3])) * (1.0f / DM) + RMS_EPS) * XSCALE;
            bf16_t* rowp = O + (size_t)row * XW + col0;
#pragma unroll
            for (int bj = 0; bj < 2; ++bj) { const f32x4 v0 = acc[ai][bj][m][0] * rs, v1 = acc[ai][bj][m][1] * rs;
                u32x4 w; w.x = cvt_pk_bf16(v0[0], v0[1]); w.y = cvt_pk_bf16(v0[2], v0[3]); w.z = cvt_pk_bf16(v1[0], v1[1]); w.w = cvt_pk_bf16(v1[2], v1[3]);
                st16(rowp + bj * HALF, w); } }
    }
};
struct EpiMoe1 {
    static constexpr bool PERM = true;
    const float* bgu; bf16_t* HID;
    __device__ __forceinline__ void operator()(AccRef acc, const Unit& u, int wr, int wc, int fr, int fq) const {
        const int rl0 = wr * 64 + fr, col0 = u.pn * HALF + wc * 32 + 8 * fq; const float* bg = bgu + (size_t)u.e * (2 * DFF) + col0;
        const f32x4 bg0 = *(const f32x4*)(bg), bg1 = *(const f32x4*)(bg + 4), bu0 = *(const f32x4*)(bg + DFF), bu1 = *(const f32x4*)(bg + DFF + 4);
#pragma unroll
        EPI_ROWS { const int rl = rl0 + ai * HALF + m * 16;
            const f32x4 g0 = acc[ai][0][m][0] + bg0, g1 = acc[ai][0][m][1] + bg1, p0 = acc[ai][1][m][0] + bu0, p1 = acc[ai][1][m][1] + bu1;
            float o[8];
#pragma unroll
            for (int e = 0; e < 4; ++e) { const float ga = fminf(g0[e], 7.0f), gb = fminf(g1[e], 7.0f), ua = fminf(fmaxf(p0[e], -7.0f), 7.0f), ub = fminf(fmaxf(p1[e], -7.0f), 7.0f);
                o[e] = (ua + 1.0f) * ga * fsigmoid(1.702f * ga); o[4 + e] = (ub + 1.0f) * gb * fsigmoid(1.702f * gb); }
            u32x4 w; w.x = cvt_pk_bf16(o[0], o[1]); w.y = cvt_pk_bf16(o[2], o[3]); w.z = cvt_pk_bf16(o[4], o[5]); w.w = cvt_pk_bf16(o[6], o[7]);
            st16(HID + (size_t)(u.pm * BM + rl) * DFF + col0, w); }
    }
};
struct EpiMoe2 {
    static constexpr bool PERM = true;
    const float* bdn; const LAS int* tabD; const LAS float* tabG; bf16_t* Y;
    __device__ __forceinline__ void operator()(AccRef acc, const Unit& u, int wr, int wc, int fr, int fq) const {
        const int rl0 = wr * 64 + fr, col0 = u.pn * BM + wc * 32 + 8 * fq; const float* bd = bdn + (size_t)u.e * DM + col0;
        f32x4 bv[2][2];
#pragma unroll
        for (int bj = 0; bj < 2; ++bj)
#pragma unroll
            for (int n = 0; n < 2; ++n) bv[bj][n] = *(const f32x4*)(bd + bj * HALF + 4 * n);
#pragma unroll
        EPI_ROWS { const int rl = rl0 + ai * HALF + m * 16; const int dest = tabD[u.ui * 256 + rl];
            if (dest >= 0) { const float gt = tabG[u.ui * 256 + rl]; bf16_t* rowp = Y + (size_t)dest * DM + col0;
#pragma unroll
                for (int bj = 0; bj < 2; ++bj) { const f32x4 v0 = (acc[ai][bj][m][0] + bv[bj][0]) * gt, v1 = (acc[ai][bj][m][1] + bv[bj][1]) * gt;
                    u32x4 w; w.x = cvt_pk_bf16(v0[0], v0[1]); w.y = cvt_pk_bf16(v0[2], v0[3]); w.z = cvt_pk_bf16(v1[0], v1[1]); w.w = cvt_pk_bf16(v1[2], v1[3]);
                    st16(rowp + bj * HALF, w); } } }
    }
};
}

struct MoeOrder {
    pg8::PatchOrder P; const LAS int* pref; int rev;
    __device__ __forceinline__ bool next(int i, pg8::Unit& u) const {
        if (!P.next(i, u)) return false;
        if (rev) u.pm = P.nM - 1 - u.pm;
        int e = 0;
#pragma unroll 1
        for (int k = 1; k < NE; ++k) e += (pref[k] <= u.pm) ? 1 : 0;
        u.e = e; u.mi = u.pm - pref[e]; return true;
    }
};

namespace attn_body {
using bf16=__hip_bfloat16;
using bf16x8=__attribute__((ext_vector_type(8)))short;
using s16x4=__attribute__((ext_vector_type(4)))short;
using f32x16=__attribute__((ext_vector_type(16)))float;
using u32x4=__attribute__((ext_vector_type(4)))unsigned;
constexpr int BATCH=4,NHEAD=8,SEQ=8192,D=64,DM=NHEAD*D;
constexpr int NW=8,QBLK=32,QB=QBLK*NW,KVBLK=64,NQB=SEQ/QB;
constexpr int ATTN_PITCH=DM, ATTN_UNIT_ROWS=QB;
__device__ __forceinline__ int crow(int r,int hi){return (r&3)+8*(r>>2)+4*hi;}
#define SBAR() __builtin_amdgcn_sched_barrier(0)
__device__ __forceinline__ void cmask(f32x16&p0,f32x16&p1,int jb,int qrel,int hi){
  const float NEG=-INFINITY; int kb=64*jb+4*hi;
  #pragma unroll
  for(int r=0;r<16;++r){int kv=kb+(r&3)+8*(r>>2); if(kv>qrel)p0[r]=NEG; if(kv+32>qrel)p1[r]=NEG;}
}

constexpr int NSLOT=4, SLOTB=8192;
constexpr int LDS_K=0, LDS_V=NSLOT*SLOTB, LDS_WS=2*NSLOT*SLOTB, LDS_OST=LDS_WS+NW*64*4, LDS_KM=LDS_OST+NW*4096, LDS_SEL=LDS_KM+32*64*4, LDS_DST=LDS_SEL+1024, LDS_BYTES=LDS_DST+1024;
constexpr float C2=0.125f*1.4426950408889634f;
__device__ __forceinline__ void glds16(const void*gsrc,unsigned lds_dst){unsigned keep;
  asm volatile("s_mov_b32 %0, m0\n\ts_mov_b32 m0, %2\n\ts_nop 0\n\tglobal_load_lds_dwordx4 %1, off\n\ts_mov_b32 m0, %0":"=&s"(keep):"v"(gsrc),"s"(lds_dst):"memory");}
__device__ __forceinline__ float max3f(float a,float b,float c){float r;asm("v_max3_f32 %0, %1, %2, %3":"=v"(r):"v"(a),"v"(b),"v"(c));return r;}
__device__ __forceinline__ float max2f(float a,float b){float r;asm("v_max_f32_e32 %0, %1, %2":"=v"(r):"v"(a),"v"(b));return r;}
__device__ __forceinline__ float fadd_s(float a,float b){float r;asm("v_add_f32_e32 %0, %1, %2":"=v"(r):"v"(a),"v"(b));return r;}
__device__ __forceinline__ float fsub_s(float a,float b){float r;asm("v_sub_f32_e32 %0, %1, %2":"=v"(r):"v"(a),"v"(b));return r;}
typedef float f32x2_t __attribute__((ext_vector_type(2))); typedef __bf16 bf16x2_t __attribute__((ext_vector_type(2)));
__device__ __forceinline__ unsigned cvtpk_s(float lo,float hi){f32x2_t v={lo,hi};bf16x2_t b=__builtin_convertvector(v,bf16x2_t);return __builtin_bit_cast(unsigned,b);}
#define WAIT_BAR(N) asm volatile("s_waitcnt vmcnt(" #N ") lgkmcnt(0)\n\ts_barrier":::"memory")

__device__ __forceinline__ void qkt(f32x16&p0,f32x16&p1,const char*Kslot,const bf16x8*qr,const f32x16&negm,int r32,int hi){
  const char*kb=Kslot+hi*1024+r32*16;
  #pragma unroll
  for(int d0=0;d0<4;++d0){
    const bf16x8 b0=*reinterpret_cast<const bf16x8*>(kb+d0*2048);
    const bf16x8 b1=*reinterpret_cast<const bf16x8*>(kb+d0*2048+512);
    if(d0==0){p0=__builtin_amdgcn_mfma_f32_32x32x16_bf16(b0,qr[0],negm,0,0,0);p1=__builtin_amdgcn_mfma_f32_32x32x16_bf16(b1,qr[0],negm,0,0,0);}
    else{p0=__builtin_amdgcn_mfma_f32_32x32x16_bf16(b0,qr[d0],p0,0,0,0);p1=__builtin_amdgcn_mfma_f32_32x32x16_bf16(b1,qr[d0],p1,0,0,0);}}
}
typedef __attribute__((address_space(3))) const char* lds_cptr;
typedef short v4i16_t __attribute__((ext_vector_type(4)));
__device__ __forceinline__ void kload8(bf16x8*kf,lds_cptr kp){
  kf[0]=*(const __attribute__((address_space(3))) bf16x8*)(kp);      kf[1]=*(const __attribute__((address_space(3))) bf16x8*)(kp+512);
  kf[2]=*(const __attribute__((address_space(3))) bf16x8*)(kp+2048); kf[3]=*(const __attribute__((address_space(3))) bf16x8*)(kp+2560);
  kf[4]=*(const __attribute__((address_space(3))) bf16x8*)(kp+4096); kf[5]=*(const __attribute__((address_space(3))) bf16x8*)(kp+4608);
  kf[6]=*(const __attribute__((address_space(3))) bf16x8*)(kp+6144); kf[7]=*(const __attribute__((address_space(3))) bf16x8*)(kp+6656);
}
__device__ __forceinline__ void kload2(bf16x8*kf,lds_cptr kp,int j){ kf[2*j]=*(const __attribute__((address_space(3))) bf16x8*)(kp+j*2048); kf[2*j+1]=*(const __attribute__((address_space(3))) bf16x8*)(kp+j*2048+512); }
__device__ __forceinline__ s16x4 vtr(lds_cptr p){ return __builtin_bit_cast(s16x4,__builtin_amdgcn_ds_read_tr16_b64_v4i16((__attribute__((address_space(3))) v4i16_t*)p)); }
__device__ __forceinline__ float rowmax(const f32x16&p0,const f32x16&p1){
  float a=max3f(p0[0],p0[1],p1[0]),b=max3f(p0[2],p0[3],p1[1]);a=max3f(a,p1[2],p1[3]);
  #pragma unroll
  for(int r=4;r<16;r+=4){a=max3f(a,p0[r],p0[r+1]);b=max3f(b,p0[r+2],p0[r+3]);a=max3f(a,p1[r],p1[r+1]);b=max3f(b,p1[r+2],p1[r+3]);}
  const float m=max2f(a,b);
  auto rr=__builtin_amdgcn_permlane32_swap(__float_as_uint(m),__float_as_uint(m),false,false);
  return max2f(__uint_as_float(rr[0]),__uint_as_float(rr[1]));
}
__device__ __forceinline__ void pv(f32x16*o,int vb,bf16x8 pa0,bf16x8 pa1,bf16x8 pa2,bf16x8 pa3){
  #pragma unroll
  for(int d0=0;d0<2;++d0){s16x4 lo[4],hi[4];
    #pragma unroll
    for(int ks=0;ks<4;++ks){
      asm volatile("ds_read_b64_tr_b16 %0,%1 offset:%c2":"=&v"(lo[ks]):"v"(vb),"i"(d0*4096+ks*1024):"memory");
      asm volatile("ds_read_b64_tr_b16 %0,%1 offset:%c2":"=&v"(hi[ks]):"v"(vb),"i"(d0*4096+ks*1024+512):"memory");}
    asm volatile("s_waitcnt lgkmcnt(0)":::"memory");SBAR();
    #define PK(k) (bf16x8){lo[k][0],lo[k][1],lo[k][2],lo[k][3],hi[k][0],hi[k][1],hi[k][2],hi[k][3]}
    o[d0]=__builtin_amdgcn_mfma_f32_32x32x16_bf16(pa0,PK(0),o[d0],0,0,0);
    o[d0]=__builtin_amdgcn_mfma_f32_32x32x16_bf16(pa1,PK(1),o[d0],0,0,0);
    o[d0]=__builtin_amdgcn_mfma_f32_32x32x16_bf16(pa2,PK(2),o[d0],0,0,0);
    o[d0]=__builtin_amdgcn_mfma_f32_32x32x16_bf16(pa3,PK(3),o[d0],0,0,0);
    #undef PK
  }
}

#ifndef ATTN_STORE16
#define ATTN_STORE16(p,v) (*(u32x4*)(p)=(v))
#endif
template<int THRL> __device__ __forceinline__ void attn_unit(int b,int h,int qb,const bf16*Q,const bf16*__restrict__ K,const bf16*__restrict__ V,bf16*O,char*shm){
  const int tid=threadIdx.x,lane=tid&63,r32=lane&31,hi=lane>>5; const int wid=__builtin_amdgcn_readfirstlane(tid>>6);
  const long rowbase=(long)b*SEQ; const int q0=qb*QB;
  const bf16*Qw=Q+(rowbase+q0+wid*QBLK)*DM+h*D;
  const bf16*Kh=K+rowbase*DM+h*D,*Vh=V+rowbase*DM+h*D;
  const unsigned lds0=(unsigned)(uintptr_t)shm;
  float*wsf=(float*)(shm+LDS_WS)+wid*64;
  const bf16*ksrc=Kh+(long)lane*DM+wid*8;
  const bf16*vsrc=Vh+(long)(16*(wid&3)+(lane>>2))*DM+(wid>>2)*32+(lane&3)*8;
  const unsigned kdst=lds0+LDS_K+wid*1024, vdst=lds0+LDS_V+wid*1024;
  #define DMA_K(t,slot) glds16(ksrc+(long)(t)*KVBLK*DM,(unsigned)__builtin_amdgcn_readfirstlane(kdst+(slot)))
  #define DMA_V(t,slot) glds16(vsrc+(long)(t)*KVBLK*DM,(unsigned)__builtin_amdgcn_readfirstlane(vdst+(slot)))
  const int vb0=(int)(lds0+LDS_V)+((lane>>4)&1)*32+(lane&3)*8+(4*hi+((lane&15)>>2))*64;
  const char*Kbase=shm+LDS_K; bf16x8 kf[8];
  const lds_cptr shm3=(lds_cptr)shm; const lds_cptr kp0=shm3+LDS_K+hi*1024+r32*16; const lds_cptr vp0=shm3+LDS_V+((lane>>4)&1)*32+(lane&3)*8+(4*hi+((lane&15)>>2))*64;
  const int NT=(q0+QB)/KVBLK;
  DMA_K(0,0);DMA_V(0,0);DMA_K(1,SLOTB);
  bf16x8 qr[4];
  #pragma unroll
  for(int d0=0;d0<4;++d0)qr[d0]=*reinterpret_cast<const bf16x8*>(&Qw[(long)r32*DM+d0*16+hi*8]);
  { int lp_=lane; asm volatile("":"+v"(lp_)); const int r32p=lp_&31, hip=lp_>>5;
    unsigned sel=0u; const __attribute__((address_space(3))) float*km=(const __attribute__((address_space(3))) float*)((__attribute__((address_space(3))) const char*)shm+LDS_KM); float g0=-3e38f,g1=-3e38f,g2=-3e38f; int s0=-1,s1=-1,s2=-1;
    for(int j=0;j<qb;++j){ float g=0.f;
      #pragma unroll
      for(int d0=0;d0<4;++d0){
        #pragma unroll
        for(int e=0;e<8;++e)g+=__builtin_bit_cast(float,((unsigned)(unsigned short)qr[d0][e])<<16)*km[j*64+16*d0+8*hip+e];}
      g+=__shfl_xor(g,32);
      if(g>g0){g2=g1;s2=s1;g1=g0;s1=s0;g0=g;s0=j;}else if(g>g1){g2=g1;s2=s1;g1=g;s1=j;}else if(g>g2){g2=g;s2=j;} }
    if(s0>=0)sel|=1u<<s0; if(s1>=0)sel|=1u<<s1; if(s2>=0)sel|=1u<<s2;
    if(hip==0)((__attribute__((address_space(3))) unsigned*)((__attribute__((address_space(3))) char*)shm+LDS_SEL))[wid*32+r32p]=sel; asm volatile("s_waitcnt lgkmcnt(0)":::"memory"); }
  float mhat=0.f,l_reg=0.f;f32x16 o[2];o[0]=f32x16{};o[1]=f32x16{};f32x16 negm=f32x16{};asm volatile("":"+v"(negm));
  const int qrel=wid*QBLK+r32;
  #define BMASK(P0,P1,t) do{}while(0)
  #define CMASK(P0,P1,t) do{int jb_=(t)-(NT-4); if(jb_>=0)cmask(P0,P1,jb_,qrel,hi); else BMASK(P0,P1,t);}while(0)
  bool resc=false;
  #define START(P0,P1) do{ const float rm=rowmax(P0,P1); resc=false; \
    { const float dl=__builtin_fmaxf(rm,-64.f); mhat=fadd_s(mhat,dl); \
      _Pragma("unroll") for(int r=0;r<16;++r){P0[r]=fsub_s(P0[r],dl);P1[r]=fsub_s(P1[r],dl);} \
      _Pragma("unroll") for(int r=0;r<16;++r)negm[r]=-mhat; asm volatile("":"+v"(negm)); } \
    _Pragma("unroll") for(int r=0;r<16;++r)P0[r]=__builtin_amdgcn_exp2f(P0[r]); }while(0)
  #define RESC() do{ if(resc){ asm volatile("s_waitcnt lgkmcnt(0)":::"memory"); \
      _Pragma("unroll") for(int d_=0;d_<2;++d_) _Pragma("unroll") for(int r=0;r<16;++r)o[d_][r]*=wsf[crow(r,hi)]; } }while(0)
  f32x16 pA0,pA1,pB0,pB1;
  int sl_prev=0,sl_cur=0,sl_next=SLOTB;
  #define ROT() do{sl_prev=sl_cur;sl_cur=sl_next;sl_next=(sl_next==(NSLOT-1)*SLOTB)?0:sl_next+SLOTB;}while(0)
  DMA_K(2,2*SLOTB);
  WAIT_BAR(3);
  qkt(pA0,pA1,Kbase,qr,negm,r32,hi);asm volatile("s_nop 15\n\ts_nop 7":"+v"(pA0),"+v"(pA1));CMASK(pA0,pA1,0);
  START(pA0,pA1);
  _Pragma("unroll") for(int r=0;r<16;++r)pA1[r]=__builtin_amdgcn_exp2f(pA1[r]);
  WAIT_BAR(0);
  DMA_K(3,0);DMA_V(1,SLOTB);
  ROT();
  kload8(kf,kp0+sl_cur);
  WAIT_BAR(2);
  s16x4 vlo[8],vhi[8]; u32x4 pw0,pw1,pw2,pw3;
  #define PKW(P,B) (keep_?cvtpk_s(P[B],P[B+1]):0u)
  #define PAF(k) __builtin_bit_cast(bf16x8,pw##k)
  #define VFR(i) (bf16x8){vlo[i][0],vlo[i][1],vlo[i][2],vlo[i][3],vhi[i][0],vhi[i][1],vhi[i][2],vhi[i][3]}
  #define PIN(x) asm volatile("":"+v"(x))
  #define MX3(a,b,c) __builtin_fmaxf(__builtin_fmaxf((a),(b)),(c))
  #define GAPA(MF,A0,A1,A2,A3,W0,W1,PW) do{ MF; sacc+=A0; sacc+=A1; sacc+=A2; sacc+=A3; PIN(sacc); W0; W1; PIN(PW); SBAR(); }while(0)
  #define EX(v) __builtin_amdgcn_exp2f(v)
  #define GAPB(MF,X,B) do{ MF; X[B]=EX(X[B]); X[B+1]=EX(X[B+1]); X[B+2]=EX(X[B+2]); X[B+3]=EX(X[B+3]); PIN(X); SBAR(); }while(0)
  #define VRD(i) do{ vlo[i]=vtr(vp_+(((i)>>2)*4096+((i)&3)*1024)); vhi[i]=vtr(vp_+(((i)>>2)*4096+((i)&3)*1024+512)); }while(0)
  #define KRD(G,j) do{ if(G){ kload2(kf,kp0+sl_next,j); SBAR(); } }while(0)
  #define STEP(C0,C1,P0,P1,t,GK,GV,GL) do{ SBAR(); \
    int q_=qrel; asm volatile("":"+v"(q_)); const unsigned selw_=((const volatile __attribute__((address_space(3))) unsigned*)((__attribute__((address_space(3))) const char*)shm+LDS_SEL))[q_]; \
    const bool keep_=((t)-1>=NT-4)||((selw_>>(((t)-1)>>2))&1u); \
    const lds_cptr vp_=vp0+sl_prev; \
    VRD(0); SBAR(); float sacc=(P0[0]+P0[1]); \
    GAPA(C0=__builtin_amdgcn_mfma_f32_32x32x16_bf16(kf[0],qr[0],negm,0,0,0), P0[2],P0[3],P0[4],P0[5],     pw0[0]=PKW(P0,0), pw0[1]=PKW(P0,2), pw0); \
    VRD(4); SBAR(); GAPA(C1=__builtin_amdgcn_mfma_f32_32x32x16_bf16(kf[1],qr[0],negm,0,0,0), P0[6],P0[7],P0[8],P0[9],     pw0[2]=PKW(P0,4), pw0[3]=PKW(P0,6), pw0); \
    VRD(1); SBAR(); GAPA(C0=__builtin_amdgcn_mfma_f32_32x32x16_bf16(kf[2],qr[1],C0,0,0,0),   P0[10],P0[11],P0[12],P0[13], pw1[0]=PKW(P0,8), pw1[1]=PKW(P0,10), pw1); \
    VRD(5); SBAR(); GAPA(C1=__builtin_amdgcn_mfma_f32_32x32x16_bf16(kf[3],qr[1],C1,0,0,0),   P0[14],P0[15],P1[0],P1[1],   pw1[2]=PKW(P0,12),pw1[3]=PKW(P0,14), pw1); \
    VRD(2); SBAR(); GAPA(C0=__builtin_amdgcn_mfma_f32_32x32x16_bf16(kf[4],qr[2],C0,0,0,0),   P1[2],P1[3],P1[4],P1[5],     pw2[0]=PKW(P1,0), pw2[1]=PKW(P1,2), pw2); \
    VRD(6); SBAR(); GAPA(C1=__builtin_amdgcn_mfma_f32_32x32x16_bf16(kf[5],qr[2],C1,0,0,0),   P1[6],P1[7],P1[8],P1[9],     pw2[2]=PKW(P1,4), pw2[3]=PKW(P1,6), pw2); \
    VRD(3); SBAR(); GAPA(C0=__builtin_amdgcn_mfma_f32_32x32x16_bf16(kf[6],qr[3],C0,0,0,0),   P1[10],P1[11],P1[12],P1[13], pw3[0]=PKW(P1,8), pw3[1]=PKW(P1,10), pw3); \
    VRD(7); SBAR(); GAPA(C1=__builtin_amdgcn_mfma_f32_32x32x16_bf16(kf[7],qr[3],C1,0,0,0),   P1[14],P1[15],0.f,0.f,       pw3[2]=PKW(P1,12),pw3[3]=PKW(P1,14), pw3); \
    l_reg+=keep_?sacc:0.f; \
    if(GK){DMA_K((t)+3,sl_cur);} if(GV){DMA_V((t)+1,sl_next);} \
    CMASK(C0,C1,t); \
    { float a=MX3(C0[0],C0[1],C1[0]),b=MX3(C0[2],C0[3],C1[1]); a=MX3(a,C1[2],C1[3]); \
      _Pragma("unroll") for(int r=4;r<16;r+=4){a=MX3(a,C0[r],C0[r+1]);b=MX3(b,C0[r+2],C0[r+3]);a=MX3(a,C1[r],C1[r+1]);b=MX3(b,C1[r+2],C1[r+3]);} \
      float rm=__builtin_fmaxf(a,b); { auto rr=__builtin_amdgcn_permlane32_swap(__float_as_uint(rm),__float_as_uint(rm),false,false); rm=__builtin_fmaxf(__uint_as_float(rr[0]),__uint_as_float(rr[1])); } \
      resc=false; \
      if(__builtin_expect(__any(rm>(float)THRL),0)){ const float dl=__builtin_fmaxf(rm,0.f); mhat+=dl; \
        _Pragma("unroll") for(int r=0;r<16;++r){C0[r]-=dl;C1[r]-=dl;} \
        _Pragma("unroll") for(int r=0;r<16;++r)negm[r]=-mhat; asm volatile("":"+v"(negm)); \
        const float f=__builtin_amdgcn_exp2f(-dl); l_reg*=f; if(hi==0)wsf[r32]=f; resc=true; } } \
    SBAR(); \
    GAPB(o[0]=__builtin_amdgcn_mfma_f32_32x32x16_bf16(PAF(0),VFR(0),o[0],0,0,0), C0,0); \
    GAPB(o[1]=__builtin_amdgcn_mfma_f32_32x32x16_bf16(PAF(0),VFR(4),o[1],0,0,0), C0,4); \
    KRD(GL,0); GAPB(o[0]=__builtin_amdgcn_mfma_f32_32x32x16_bf16(PAF(1),VFR(1),o[0],0,0,0), C0,8); \
    KRD(GL,1); GAPB(o[1]=__builtin_amdgcn_mfma_f32_32x32x16_bf16(PAF(1),VFR(5),o[1],0,0,0), C0,12); \
    KRD(GL,2); GAPB(o[0]=__builtin_amdgcn_mfma_f32_32x32x16_bf16(PAF(2),VFR(2),o[0],0,0,0), C1,0); \
    KRD(GL,3); GAPB(o[1]=__builtin_amdgcn_mfma_f32_32x32x16_bf16(PAF(2),VFR(6),o[1],0,0,0), C1,4); \
    GAPB(o[0]=__builtin_amdgcn_mfma_f32_32x32x16_bf16(PAF(3),VFR(3),o[0],0,0,0), C1,8); \
    GAPB(o[1]=__builtin_amdgcn_mfma_f32_32x32x16_bf16(PAF(3),VFR(7),o[1],0,0,0), C1,12); \
    }while(0)
  int t=1;
  for(;t+5<NT;t+=2){
    STEP(pB0,pB1,pA0,pA1,t,true,true,true);     WAIT_BAR(2); RESC(); ROT();
    STEP(pA0,pA1,pB0,pB1,t+1,true,true,true);   WAIT_BAR(2); RESC(); ROT();
  }
  #define ENDW(tt) do{ if((tt)+3<NT){WAIT_BAR(2);} else if((tt)+2<NT){WAIT_BAR(1);} else {WAIT_BAR(0);} }while(0)
  for(;t+1<NT;t+=2){
    STEP(pB0,pB1,pA0,pA1,t,(t+3<NT),(t+1<NT),(t+1<NT));       ENDW(t);   RESC(); ROT();
    STEP(pA0,pA1,pB0,pB1,t+1,(t+4<NT),(t+2<NT),(t+2<NT));     ENDW(t+1); RESC(); ROT();
  }
  STEP(pB0,pB1,pA0,pA1,NT-1,false,false,false); RESC();
  { const bool keep_=true; float sacc=pB0[0]+pB0[1]; _Pragma("unroll") for(int r=2;r<16;++r)sacc+=pB0[r]; _Pragma("unroll") for(int r=0;r<16;++r)sacc+=pB1[r]; l_reg+=sacc;
    pw0=(u32x4){PKW(pB0,0),PKW(pB0,2),PKW(pB0,4),PKW(pB0,6)};pw1=(u32x4){PKW(pB0,8),PKW(pB0,10),PKW(pB0,12),PKW(pB0,14)};pw2=(u32x4){PKW(pB1,0),PKW(pB1,2),PKW(pB1,4),PKW(pB1,6)};pw3=(u32x4){PKW(pB1,8),PKW(pB1,10),PKW(pB1,12),PKW(pB1,14)};
    SBAR(); pv(o,vb0+sl_cur,PAF(0),PAF(1),PAF(2),PAF(3)); }
  #undef PKW
  #undef PAF
  #undef VFR
  #undef PIN
  #undef MX3
  #undef GAPA
  #undef GAPB
  #undef EX
  #undef VRD
  #undef KRD
  #undef STEP
  #undef ENDW
  {auto rr=__builtin_amdgcn_permlane32_swap(__float_as_uint(l_reg),__float_as_uint(l_reg),false,false);l_reg=__uint_as_float(rr[0])+__uint_as_float(rr[1]);}
  if(hi==0)wsf[32+r32]=l_reg;asm volatile("s_waitcnt lgkmcnt(0)":::"memory");
  float rli[16];
  #pragma unroll
  for(int r=0;r<16;++r)rli[r]=__builtin_amdgcn_rcpf(wsf[32+crow(r,hi)]);
  bf16*Ow=O+(rowbase+q0+wid*QBLK)*DM+h*D;
  { bf16*stg=(bf16*)(shm+LDS_OST)+wid*2048;
    #pragma unroll
    for(int r=0;r<16;++r){const int orow=crow(r,hi);
      #pragma unroll
      for(int d0=0;d0<2;++d0)stg[orow*64+d0*32+r32]=__float2bfloat16(o[d0][r]*rli[r]);}
    asm volatile("s_waitcnt lgkmcnt(0)":::"memory");
    #pragma unroll
    for(int i=0;i<4;++i){const int row=i*8+(lane>>3),ch=lane&7; const u32x4 v=*(const u32x4*)(stg+row*64+ch*8); ATTN_STORE16(Ow+(long)row*DM+ch*8,v);} }
  asm volatile("s_waitcnt lgkmcnt(0)\n\ts_barrier":::"memory");
  #undef DMA_K
  #undef DMA_V
  #undef CMASK
  #undef BMASK
  #undef START
  #undef RESC
  #undef ROT
}
template<int THRL> __device__ __forceinline__ void moba_unit4(const bf16*Qrow,const bf16*__restrict__ Kh,const bf16*__restrict__ Vh,bool causal,int dest,bf16*PO,float*PML,char*shm){
  int tid_=threadIdx.x; asm volatile("":"+v"(tid_)); const int tid=tid_,lane=tid&63,r32=lane&31,hi=lane>>5; const int wid=__builtin_amdgcn_readfirstlane(tid>>6);
  const unsigned lds0=(unsigned)(uintptr_t)shm;
  float*wsf=(float*)(shm+LDS_WS)+wid*64;
  const bf16*ksrc=Kh+(long)lane*DM+wid*8;
  const bf16*vsrc=Vh+(long)(16*(wid&3)+(lane>>2))*DM+(wid>>2)*32+(lane&3)*8;
  const unsigned kdst=lds0+LDS_K+wid*1024, vdst=lds0+LDS_V+wid*1024;
  #define DMA_K(t,slot) glds16(ksrc+(long)(t)*KVBLK*DM,(unsigned)__builtin_amdgcn_readfirstlane(kdst+(slot)))
  #define DMA_V(t,slot) glds16(vsrc+(long)(t)*KVBLK*DM,(unsigned)__builtin_amdgcn_readfirstlane(vdst+(slot)))
  const int vb0=(int)(lds0+LDS_V)+((lane>>4)&1)*32+(lane&3)*8+(4*hi+((lane&15)>>2))*64;
  const char*Kbase=shm+LDS_K; bf16x8 kf[8];
  const lds_cptr shm3=(lds_cptr)shm; const lds_cptr kp0=shm3+LDS_K+hi*1024+r32*16; const lds_cptr vp0=shm3+LDS_V+((lane>>4)&1)*32+(lane&3)*8+(4*hi+((lane&15)>>2))*64;
  constexpr int NT=4;
  DMA_K(0,0);DMA_V(0,0);DMA_K(1,SLOTB);
  bf16x8 qr[4];
  #pragma unroll
  for(int d0=0;d0<4;++d0)qr[d0]=*reinterpret_cast<const bf16x8*>(Qrow+d0*16+hi*8);
  float mhat=0.f,l_reg=0.f;f32x16 o[2];o[0]=f32x16{};o[1]=f32x16{};f32x16 negm=f32x16{};asm volatile("":"+v"(negm));
  const int qrel=wid*QBLK+r32;
  #define BMASK(P0,P1,t) do{}while(0)
  #define CMASK(P0,P1,t) do{ if(causal)cmask(P0,P1,(t),qrel,hi); }while(0)
  bool resc=false;
  #define START(P0,P1) do{ const float rm=rowmax(P0,P1); resc=false; \
    { const float dl=__builtin_fmaxf(rm,-64.f); mhat=fadd_s(mhat,dl); \
      _Pragma("unroll") for(int r=0;r<16;++r){P0[r]=fsub_s(P0[r],dl);P1[r]=fsub_s(P1[r],dl);} \
      _Pragma("unroll") for(int r=0;r<16;++r)negm[r]=-mhat; asm volatile("":"+v"(negm)); } \
    _Pragma("unroll") for(int r=0;r<16;++r)P0[r]=__builtin_amdgcn_exp2f(P0[r]); }while(0)
  #define RESC() do{ if(resc){ asm volatile("s_waitcnt lgkmcnt(0)":::"memory"); \
      _Pragma("unroll") for(int d_=0;d_<2;++d_) _Pragma("unroll") for(int r=0;r<16;++r)o[d_][r]*=wsf[crow(r,hi)]; } }while(0)
  f32x16 pA0,pA1,pB0,pB1;
  int sl_prev=0,sl_cur=0,sl_next=SLOTB;
  #define ROT() do{sl_prev=sl_cur;sl_cur=sl_next;sl_next=(sl_next==(NSLOT-1)*SLOTB)?0:sl_next+SLOTB;}while(0)
  DMA_K(2,2*SLOTB);
  WAIT_BAR(3);
  qkt(pA0,pA1,Kbase,qr,negm,r32,hi);asm volatile("s_nop 15\n\ts_nop 7":"+v"(pA0),"+v"(pA1));CMASK(pA0,pA1,0);
  START(pA0,pA1);
  _Pragma("unroll") for(int r=0;r<16;++r)pA1[r]=__builtin_amdgcn_exp2f(pA1[r]);
  WAIT_BAR(0);
  DMA_K(3,0);DMA_V(1,SLOTB);
  ROT();
  kload8(kf,kp0+sl_cur);
  WAIT_BAR(2);
  s16x4 vlo[8],vhi[8]; u32x4 pw0,pw1,pw2,pw3;
  #define PKW(P,B) (keep_?cvtpk_s(P[B],P[B+1]):0u)
  #define PAF(k) __builtin_bit_cast(bf16x8,pw##k)
  #define VFR(i) (bf16x8){vlo[i][0],vlo[i][1],vlo[i][2],vlo[i][3],vhi[i][0],vhi[i][1],vhi[i][2],vhi[i][3]}
  #define PIN(x) asm volatile("":"+v"(x))
  #define MX3(a,b,c) __builtin_fmaxf(__builtin_fmaxf((a),(b)),(c))
  #define GAPA(MF,A0,A1,A2,A3,W0,W1,PW) do{ MF; sacc+=A0; sacc+=A1; sacc+=A2; sacc+=A3; PIN(sacc); W0; W1; PIN(PW); SBAR(); }while(0)
  #define EX(v) __builtin_amdgcn_exp2f(v)
  #define GAPB(MF,X,B) do{ MF; X[B]=EX(X[B]); X[B+1]=EX(X[B+1]); X[B+2]=EX(X[B+2]); X[B+3]=EX(X[B+3]); PIN(X); SBAR(); }while(0)
  #define VRD(i) do{ vlo[i]=vtr(vp_+(((i)>>2)*4096+((i)&3)*1024)); vhi[i]=vtr(vp_+(((i)>>2)*4096+((i)&3)*1024+512)); }while(0)
  #define KRD(G,j) do{ if(G){ kload2(kf,kp0+sl_next,j); SBAR(); } }while(0)
  #define STEP(C0,C1,P0,P1,t,GK,GV,GL) do{ SBAR(); \
    const bool keep_=true; \
    const lds_cptr vp_=vp0+sl_prev; \
    VRD(0); SBAR(); float sacc=(P0[0]+P0[1]); \
    GAPA(C0=__builtin_amdgcn_mfma_f32_32x32x16_bf16(kf[0],qr[0],negm,0,0,0), P0[2],P0[3],P0[4],P0[5],     pw0[0]=PKW(P0,0), pw0[1]=PKW(P0,2), pw0); \
    VRD(4); SBAR(); GAPA(C1=__builtin_amdgcn_mfma_f32_32x32x16_bf16(kf[1],qr[0],negm,0,0,0), P0[6],P0[7],P0[8],P0[9],     pw0[2]=PKW(P0,4), pw0[3]=PKW(P0,6), pw0); \
    VRD(1); SBAR(); GAPA(C0=__builtin_amdgcn_mfma_f32_32x32x16_bf16(kf[2],qr[1],C0,0,0,0),   P0[10],P0[11],P0[12],P0[13], pw1[0]=PKW(P0,8), pw1[1]=PKW(P0,10), pw1); \
    VRD(5); SBAR(); GAPA(C1=__builtin_amdgcn_mfma_f32_32x32x16_bf16(kf[3],qr[1],C1,0,0,0),   P0[14],P0[15],P1[0],P1[1],   pw1[2]=PKW(P0,12),pw1[3]=PKW(P0,14), pw1); \
    VRD(2); SBAR(); GAPA(C0=__builtin_amdgcn_mfma_f32_32x32x16_bf16(kf[4],qr[2],C0,0,0,0),   P1[2],P1[3],P1[4],P1[5],     pw2[0]=PKW(P1,0), pw2[1]=PKW(P1,2), pw2); \
    VRD(6); SBAR(); GAPA(C1=__builtin_amdgcn_mfma_f32_32x32x16_bf16(kf[5],qr[2],C1,0,0,0),   P1[6],P1[7],P1[8],P1[9],     pw2[2]=PKW(P1,4), pw2[3]=PKW(P1,6), pw2); \
    VRD(3); SBAR(); GAPA(C0=__builtin_amdgcn_mfma_f32_32x32x16_bf16(kf[6],qr[3],C0,0,0,0),   P1[10],P1[11],P1[12],P1[13], pw3[0]=PKW(P1,8), pw3[1]=PKW(P1,10), pw3); \
    VRD(7); SBAR(); GAPA(C1=__builtin_amdgcn_mfma_f32_32x32x16_bf16(kf[7],qr[3],C1,0,0,0),   P1[14],P1[15],0.f,0.f,       pw3[2]=PKW(P1,12),pw3[3]=PKW(P1,14), pw3); \
    l_reg+=keep_?sacc:0.f; \
    if(GK){DMA_K((t)+3,sl_cur);} if(GV){DMA_V((t)+1,sl_next);} \
    CMASK(C0,C1,t); \
    { float a=MX3(C0[0],C0[1],C1[0]),b=MX3(C0[2],C0[3],C1[1]); a=MX3(a,C1[2],C1[3]); \
      _Pragma("unroll") for(int r=4;r<16;r+=4){a=MX3(a,C0[r],C0[r+1]);b=MX3(b,C0[r+2],C0[r+3]);a=MX3(a,C1[r],C1[r+1]);b=MX3(b,C1[r+2],C1[r+3]);} \
      float rm=__builtin_fmaxf(a,b); { auto rr=__builtin_amdgcn_permlane32_swap(__float_as_uint(rm),__float_as_uint(rm),false,false); rm=__builtin_fmaxf(__uint_as_float(rr[0]),__uint_as_float(rr[1])); } \
      resc=false; \
      if(__builtin_expect(__any(rm>(float)THRL),0)){ const float dl=__builtin_fmaxf(rm,0.f); mhat+=dl; \
        _Pragma("unroll") for(int r=0;r<16;++r){C0[r]-=dl;C1[r]-=dl;} \
        _Pragma("unroll") for(int r=0;r<16;++r)negm[r]=-mhat; asm volatile("":"+v"(negm)); \
        const float f=__builtin_amdgcn_exp2f(-dl); l_reg*=f; if(hi==0)wsf[r32]=f; resc=true; } } \
    SBAR(); \
    GAPB(o[0]=__builtin_amdgcn_mfma_f32_32x32x16_bf16(PAF(0),VFR(0),o[0],0,0,0), C0,0); \
    GAPB(o[1]=__builtin_amdgcn_mfma_f32_32x32x16_bf16(PAF(0),VFR(4),o[1],0,0,0), C0,4); \
    KRD(GL,0); GAPB(o[0]=__builtin_amdgcn_mfma_f32_32x32x16_bf16(PAF(1),VFR(1),o[0],0,0,0), C0,8); \
    KRD(GL,1); GAPB(o[1]=__builtin_amdgcn_mfma_f32_32x32x16_bf16(PAF(1),VFR(5),o[1],0,0,0), C0,12); \
    KRD(GL,2); GAPB(o[0]=__builtin_amdgcn_mfma_f32_32x32x16_bf16(PAF(2),VFR(2),o[0],0,0,0), C1,0); \
    KRD(GL,3); GAPB(o[1]=__builtin_amdgcn_mfma_f32_32x32x16_bf16(PAF(2),VFR(6),o[1],0,0,0), C1,4); \
    GAPB(o[0]=__builtin_amdgcn_mfma_f32_32x32x16_bf16(PAF(3),VFR(3),o[0],0,0,0), C1,8); \
    GAPB(o[1]=__builtin_amdgcn_mfma_f32_32x32x16_bf16(PAF(3),VFR(7),o[1],0,0,0), C1,12); \
    }while(0)
  int t=1;
  for(;t+5<NT;t+=2){
    STEP(pB0,pB1,pA0,pA1,t,true,true,true);     WAIT_BAR(2); RESC(); ROT();
    STEP(pA0,pA1,pB0,pB1,t+1,true,true,true);   WAIT_BAR(2); RESC(); ROT();
  }
  #define ENDW(tt) do{ if((tt)+3<NT){WAIT_BAR(2);} else if((tt)+2<NT){WAIT_BAR(1);} else {WAIT_BAR(0);} }while(0)
  for(;t+1<NT;t+=2){
    STEP(pB0,pB1,pA0,pA1,t,(t+3<NT),(t+1<NT),(t+1<NT));       ENDW(t);   RESC(); ROT();
    STEP(pA0,pA1,pB0,pB1,t+1,(t+4<NT),(t+2<NT),(t+2<NT));     ENDW(t+1); RESC(); ROT();
  }
  STEP(pB0,pB1,pA0,pA1,NT-1,false,false,false); RESC();
  { const bool keep_=true; float sacc=pB0[0]+pB0[1]; _Pragma("unroll") for(int r=2;r<16;++r)sacc+=pB0[r]; _Pragma("unroll") for(int r=0;r<16;++r)sacc+=pB1[r]; l_reg+=sacc;
    pw0=(u32x4){PKW(pB0,0),PKW(pB0,2),PKW(pB0,4),PKW(pB0,6)};pw1=(u32x4){PKW(pB0,8),PKW(pB0,10),PKW(pB0,12),PKW(pB0,14)};pw2=(u32x4){PKW(pB1,0),PKW(pB1,2),PKW(pB1,4),PKW(pB1,6)};pw3=(u32x4){PKW(pB1,8),PKW(pB1,10),PKW(pB1,12),PKW(pB1,14)};
    SBAR(); pv(o,vb0+sl_cur,PAF(0),PAF(1),PAF(2),PAF(3)); }
  #undef PKW
  #undef PAF
  #undef VFR
  #undef PIN
  #undef MX3
  #undef GAPA
  #undef GAPB
  #undef EX
  #undef VRD
  #undef KRD
  #undef STEP
  #undef ENDW
  {auto rr=__builtin_amdgcn_permlane32_swap(__float_as_uint(l_reg),__float_as_uint(l_reg),false,false);l_reg=__uint_as_float(rr[0])+__uint_as_float(rr[1]);}
  if(hi==0)wsf[32+r32]=l_reg;asm volatile("s_waitcnt lgkmcnt(0)":::"memory");
  float rli[16];
  #pragma unroll
  for(int r=0;r<16;++r)rli[r]=__builtin_amdgcn_rcpf(wsf[32+crow(r,hi)]);
  { bf16*stg=(bf16*)(shm+LDS_OST)+wid*2048;
    int*dtab=(int*)(shm+LDS_DST)+wid*32;
    if(hi==0){ dtab[r32]=dest; if(dest>=0){ PML[2*(long)dest]=mhat; PML[2*(long)dest+1]=l_reg; } }
    #pragma unroll
    for(int r=0;r<16;++r){const int orow=crow(r,hi);
      #pragma unroll
      for(int d0=0;d0<2;++d0)stg[orow*64+d0*32+r32]=__float2bfloat16(o[d0][r]*rli[r]);}
    asm volatile("s_waitcnt lgkmcnt(0)":::"memory");
    #pragma unroll
    for(int i=0;i<4;++i){const int row=i*8+(lane>>3),ch=lane&7; const int dr=dtab[row]; const u32x4 v=*(const u32x4*)(stg+row*64+ch*8); if(dr>=0)*(u32x4*)(PO+(long)dr*64+ch*8)=v;} }
  asm volatile("s_waitcnt lgkmcnt(0)\n\ts_barrier":::"memory");
  #undef DMA_K
  #undef DMA_V
  #undef CMASK
  #undef BMASK
  #undef START
  #undef RESC
  #undef ROT
}
template<int THRL> __device__ __forceinline__ void moba_chunk4(const bf16*Qrow,bool causal,int dest,bf16*PO,float*PML,char*shm){
  int tid_=threadIdx.x; asm volatile("":"+v"(tid_)); const int tid=tid_,lane=tid&63,r32=lane&31,hi=lane>>5; const int wid=__builtin_amdgcn_readfirstlane(tid>>6);
  const unsigned lds0=(unsigned)(uintptr_t)shm;
  float*wsf=(float*)(shm+LDS_WS)+wid*64;
  const int vb0=(int)(lds0+LDS_V)+((lane>>4)&1)*32+(lane&3)*8+(4*hi+((lane&15)>>2))*64;
  const char*Kbase=shm+LDS_K; bf16x8 kf[8];
  const lds_cptr shm3=(lds_cptr)shm; const lds_cptr kp0=shm3+LDS_K+hi*1024+r32*16; const lds_cptr vp0=shm3+LDS_V+((lane>>4)&1)*32+(lane&3)*8+(4*hi+((lane&15)>>2))*64;
  constexpr int NT=4;
  bf16x8 qr[4];
  #pragma unroll
  for(int d0=0;d0<4;++d0)qr[d0]=*reinterpret_cast<const bf16x8*>(Qrow+d0*16+hi*8);
  float mhat=0.f,l_reg=0.f;f32x16 o[2];o[0]=f32x16{};o[1]=f32x16{};f32x16 negm=f32x16{};asm volatile("":"+v"(negm));
  const int qrel=wid*QBLK+r32;
  #define BMASK(P0,P1,t) do{}while(0)
  #define CMASK(P0,P1,t) do{ if(causal)cmask(P0,P1,(t),qrel,hi); }while(0)
  bool resc=false;
  #define START(P0,P1) do{ const float rm=rowmax(P0,P1); resc=false; \
    { const float dl=__builtin_fmaxf(rm,-64.f); mhat=fadd_s(mhat,dl); \
      _Pragma("unroll") for(int r=0;r<16;++r){P0[r]=fsub_s(P0[r],dl);P1[r]=fsub_s(P1[r],dl);} \
      _Pragma("unroll") for(int r=0;r<16;++r)negm[r]=-mhat; asm volatile("":"+v"(negm)); } \
    _Pragma("unroll") for(int r=0;r<16;++r)P0[r]=__builtin_amdgcn_exp2f(P0[r]); }while(0)
  #define RESC() do{ if(resc){ asm volatile("s_waitcnt lgkmcnt(0)":::"memory"); \
      _Pragma("unroll") for(int d_=0;d_<2;++d_) _Pragma("unroll") for(int r=0;r<16;++r)o[d_][r]*=wsf[crow(r,hi)]; } }while(0)
  f32x16 pA0,pA1,pB0,pB1;
  int sl_prev=0,sl_cur=0,sl_next=SLOTB;
  #define ROT() do{sl_prev=sl_cur;sl_cur=sl_next;sl_next=(sl_next==(NSLOT-1)*SLOTB)?0:sl_next+SLOTB;}while(0)
  qkt(pA0,pA1,Kbase,qr,negm,r32,hi);asm volatile("s_nop 15\n\ts_nop 7":"+v"(pA0),"+v"(pA1));CMASK(pA0,pA1,0);
  START(pA0,pA1);
  _Pragma("unroll") for(int r=0;r<16;++r)pA1[r]=__builtin_amdgcn_exp2f(pA1[r]);
  ROT();
  kload8(kf,kp0+sl_cur);
  s16x4 vlo[8],vhi[8]; u32x4 pw0,pw1,pw2,pw3;
  #define PKW(P,B) (keep_?cvtpk_s(P[B],P[B+1]):0u)
  #define PAF(k) __builtin_bit_cast(bf16x8,pw##k)
  #define VFR(i) (bf16x8){vlo[i][0],vlo[i][1],vlo[i][2],vlo[i][3],vhi[i][0],vhi[i][1],vhi[i][2],vhi[i][3]}
  #define PIN(x) asm volatile("":"+v"(x))
  #define MX3(a,b,c) __builtin_fmaxf(__builtin_fmaxf((a),(b)),(c))
  #define GAPA(MF,A0,A1,A2,A3,W0,W1,PW) do{ MF; sacc+=A0; sacc+=A1; sacc+=A2; sacc+=A3; PIN(sacc); W0; W1; PIN(PW); SBAR(); }while(0)
  #define EX(v) __builtin_amdgcn_exp2f(v)
  #define GAPB(MF,X,B) do{ MF; X[B]=EX(X[B]); X[B+1]=EX(X[B+1]); X[B+2]=EX(X[B+2]); X[B+3]=EX(X[B+3]); PIN(X); SBAR(); }while(0)
  #define VRD(i) do{ vlo[i]=vtr(vp_+(((i)>>2)*4096+((i)&3)*1024)); vhi[i]=vtr(vp_+(((i)>>2)*4096+((i)&3)*1024+512)); }while(0)
  #define KRD(G,j) do{ if(G){ kload2(kf,kp0+sl_next,j); SBAR(); } }while(0)
  #define STEP(C0,C1,P0,P1,t,GK,GV,GL) do{ SBAR(); \
    const bool keep_=true; \
    const lds_cptr vp_=vp0+sl_prev; \
    VRD(0); SBAR(); float sacc=(P0[0]+P0[1]); \
    GAPA(C0=__builtin_amdgcn_mfma_f32_32x32x16_bf16(kf[0],qr[0],negm,0,0,0), P0[2],P0[3],P0[4],P0[5],     pw0[0]=PKW(P0,0), pw0[1]=PKW(P0,2), pw0); \
    VRD(4); SBAR(); GAPA(C1=__builtin_amdgcn_mfma_f32_32x32x16_bf16(kf[1],qr[0],negm,0,0,0), P0[6],P0[7],P0[8],P0[9],     pw0[2]=PKW(P0,4), pw0[3]=PKW(P0,6), pw0); \
    VRD(1); SBAR(); GAPA(C0=__builtin_amdgcn_mfma_f32_32x32x16_bf16(kf[2],qr[1],C0,0,0,0),   P0[10],P0[11],P0[12],P0[13], pw1[0]=PKW(P0,8), pw1[1]=PKW(P0,10), pw1); \
    VRD(5); SBAR(); GAPA(C1=__builtin_amdgcn_mfma_f32_32x32x16_bf16(kf[3],qr[1],C1,0,0,0),   P0[14],P0[15],P1[0],P1[1],   pw1[2]=PKW(P0,12),pw1[3]=PKW(P0,14), pw1); \
    VRD(2); SBAR(); GAPA(C0=__builtin_amdgcn_mfma_f32_32x32x16_bf16(kf[4],qr[2],C0,0,0,0),   P1[2],P1[3],P1[4],P1[5],     pw2[0]=PKW(P1,0), pw2[1]=PKW(P1,2), pw2); \
    VRD(6); SBAR(); GAPA(C1=__builtin_amdgcn_mfma_f32_32x32x16_bf16(kf[5],qr[2],C1,0,0,0),   P1[6],P1[7],P1[8],P1[9],     pw2[2]=PKW(P1,4), pw2[3]=PKW(P1,6), pw2); \
    VRD(3); SBAR(); GAPA(C0=__builtin_amdgcn_mfma_f32_32x32x16_bf16(kf[6],qr[3],C0,0,0,0),   P1[10],P1[11],P1[12],P1[13], pw3[0]=PKW(P1,8), pw3[1]=PKW(P1,10), pw3); \
    VRD(7); SBAR(); GAPA(C1=__builtin_amdgcn_mfma_f32_32x32x16_bf16(kf[7],qr[3],C1,0,0,0),   P1[14],P1[15],0.f,0.f,       pw3[2]=PKW(P1,12),pw3[3]=PKW(P1,14), pw3); \
    l_reg+=keep_?sacc:0.f; \
    CMASK(C0,C1,t); \
    { float a=MX3(C0[0],C0[1],C1[0]),b=MX3(C0[2],C0[3],C1[1]); a=MX3(a,C1[2],C1[3]); \
      _Pragma("unroll") for(int r=4;r<16;r+=4){a=MX3(a,C0[r],C0[r+1]);b=MX3(b,C0[r+2],C0[r+3]);a=MX3(a,C1[r],C1[r+1]);b=MX3(b,C1[r+2],C1[r+3]);} \
      float rm=__builtin_fmaxf(a,b); { auto rr=__builtin_amdgcn_permlane32_swap(__float_as_uint(rm),__float_as_uint(rm),false,false); rm=__builtin_fmaxf(__uint_as_float(rr[0]),__uint_as_float(rr[1])); } \
      resc=false; \
      if(__builtin_expect(__any(rm>(float)THRL),0)){ const float dl=__builtin_fmaxf(rm,0.f); mhat+=dl; \
        _Pragma("unroll") for(int r=0;r<16;++r){C0[r]-=dl;C1[r]-=dl;} \
        _Pragma("unroll") for(int r=0;r<16;++r)negm[r]=-mhat; asm volatile("":"+v"(negm)); \
        const float f=__builtin_amdgcn_exp2f(-dl); l_reg*=f; if(hi==0)wsf[r32]=f; resc=true; } } \
    SBAR(); \
    GAPB(o[0]=__builtin_amdgcn_mfma_f32_32x32x16_bf16(PAF(0),VFR(0),o[0],0,0,0), C0,0); \
    GAPB(o[1]=__builtin_amdgcn_mfma_f32_32x32x16_bf16(PAF(0),VFR(4),o[1],0,0,0), C0,4); \
    KRD(GL,0); GAPB(o[0]=__builtin_amdgcn_mfma_f32_32x32x16_bf16(PAF(1),VFR(1),o[0],0,0,0), C0,8); \
    KRD(GL,1); GAPB(o[1]=__builtin_amdgcn_mfma_f32_32x32x16_bf16(PAF(1),VFR(5),o[1],0,0,0), C0,12); \
    KRD(GL,2); GAPB(o[0]=__builtin_amdgcn_mfma_f32_32x32x16_bf16(PAF(2),VFR(2),o[0],0,0,0), C1,0); \
    KRD(GL,3); GAPB(o[1]=__builtin_amdgcn_mfma_f32_32x32x16_bf16(PAF(2),VFR(6),o[1],0,0,0), C1,4); \
    GAPB(o[0]=__builtin_amdgcn_mfma_f32_32x32x16_bf16(PAF(3),VFR(3),o[0],0,0,0), C1,8); \
    GAPB(o[1]=__builtin_amdgcn_mfma_f32_32x32x16_bf16(PAF(3),VFR(7),o[1],0,0,0), C1,12); \
    }while(0)
  int t=1;
  for(;t+5<NT;t+=2){
    STEP(pB0,pB1,pA0,pA1,t,true,true,true);      RESC(); ROT();
    STEP(pA0,pA1,pB0,pB1,t+1,true,true,true);    RESC(); ROT();
  }
  #define ENDW(tt) do{ if((tt)+3<NT){} else if((tt)+2<NT){} else {} }while(0)
  for(;t+1<NT;t+=2){
    STEP(pB0,pB1,pA0,pA1,t,(t+3<NT),(t+1<NT),(t+1<NT));       ENDW(t);   RESC(); ROT();
    STEP(pA0,pA1,pB0,pB1,t+1,(t+4<NT),(t+2<NT),(t+2<NT));     ENDW(t+1); RESC(); ROT();
  }
  STEP(pB0,pB1,pA0,pA1,NT-1,false,false,false); RESC();
  { const bool keep_=true; float sacc=pB0[0]+pB0[1]; _Pragma("unroll") for(int r=2;r<16;++r)sacc+=pB0[r]; _Pragma("unroll") for(int r=0;r<16;++r)sacc+=pB1[r]; l_reg+=sacc;
    pw0=(u32x4){PKW(pB0,0),PKW(pB0,2),PKW(pB0,4),PKW(pB0,6)};pw1=(u32x4){PKW(pB0,8),PKW(pB0,10),PKW(pB0,12),PKW(pB0,14)};pw2=(u32x4){PKW(pB1,0),PKW(pB1,2),PKW(pB1,4),PKW(pB1,6)};pw3=(u32x4){PKW(pB1,8),PKW(pB1,10),PKW(pB1,12),PKW(pB1,14)};
    SBAR(); pv(o,vb0+sl_cur,PAF(0),PAF(1),PAF(2),PAF(3)); }
  #undef PKW
  #undef PAF
  #undef VFR
  #undef PIN
  #undef MX3
  #undef GAPA
  #undef GAPB
  #undef EX
  #undef VRD
  #undef KRD
  #undef STEP
  #undef ENDW
  {auto rr=__builtin_amdgcn_permlane32_swap(__float_as_uint(l_reg),__float_as_uint(l_reg),false,false);l_reg=__uint_as_float(rr[0])+__uint_as_float(rr[1]);}
  if(hi==0)wsf[32+r32]=l_reg;asm volatile("s_waitcnt lgkmcnt(0)":::"memory");
  float rli[16];
  #pragma unroll
  for(int r=0;r<16;++r)rli[r]=__builtin_amdgcn_rcpf(wsf[32+crow(r,hi)]);
  { bf16*stg=(bf16*)(shm+LDS_OST)+wid*2048;
    int*dtab=(int*)(shm+LDS_DST)+wid*32;
    if(hi==0){ dtab[r32]=dest; if(dest>=0){ PML[2*(long)dest]=mhat; PML[2*(long)dest+1]=l_reg; } }
    #pragma unroll
    for(int r=0;r<16;++r){const int orow=crow(r,hi);
      #pragma unroll
      for(int d0=0;d0<2;++d0)stg[orow*64+d0*32+r32]=__float2bfloat16(o[d0][r]*rli[r]);}
    asm volatile("s_waitcnt lgkmcnt(0)":::"memory");
    #pragma unroll
    for(int i=0;i<4;++i){const int row=i*8+(lane>>3),ch=lane&7; const int dr=dtab[row]; const u32x4 v=*(const u32x4*)(stg+row*64+ch*8); if(dr>=0)*(u32x4*)(PO+(long)dr*64+ch*8)=v;} }
  asm volatile("s_waitcnt lgkmcnt(0)":::"memory");
  #undef CMASK
  #undef BMASK
  #undef START
  #undef RESC
  #undef ROT
}

__device__ __forceinline__ void moba_load_kv(const bf16*Kh,const bf16*Vh,char*shm){
  int tid_=threadIdx.x; asm volatile("":"+v"(tid_)); const int lane=tid_&63; const int wid=__builtin_amdgcn_readfirstlane(tid_>>6);
  const unsigned lds0=(unsigned)(uintptr_t)shm;
  const bf16*ksrc=Kh+(long)lane*DM+wid*8;
  const bf16*vsrc=Vh+(long)(16*(wid&3)+(lane>>2))*DM+(wid>>2)*32+(lane&3)*8;
  const unsigned kdst=lds0+LDS_K+wid*1024, vdst=lds0+LDS_V+wid*1024;
  #pragma unroll
  for(int t=0;t<4;++t){ glds16(ksrc+(long)t*KVBLK*DM,(unsigned)__builtin_amdgcn_readfirstlane(kdst+t*SLOTB)); glds16(vsrc+(long)t*KVBLK*DM,(unsigned)__builtin_amdgcn_readfirstlane(vdst+t*SLOTB)); }
  asm volatile("s_waitcnt vmcnt(0)":::"memory");
}
constexpr int ATTN_LDS_BYTES=LDS_BYTES;
struct AttnTensors { const bf16* Q; const bf16* K; const bf16* V; bf16* O; const float* KM; };
struct AttnUnit { int bh; int qb; };
struct StaticOrder {
  int vcu;
  __device__ __forceinline__ explicit StaticOrder(int grid,int block):vcu((block%8)*(grid/8)+block/8){}
  __device__ __forceinline__ bool next(int i,AttnUnit&u)const{ if(i>=4)return false; const int s=vcu&7; u.bh=vcu>>3; u.qb=(i==0)?s:(i==1)?15-s:(i==2)?16+s:31-s; return true; }
  __device__ __forceinline__ void a_ready(const AttnUnit&)const{}
  __device__ __forceinline__ void done(const AttnUnit&)const{}
};
template<class Sched,int THRL=8> __device__ __forceinline__ void attn_phase(char*lds,const AttnTensors&T,const Sched&S){
  AttnUnit u; int lastbh=-1;
  for(int i=0;S.next(i,u);++i){
    if(u.bh!=lastbh){ __syncthreads(); float*km=(float*)(lds+LDS_KM); int tx_=threadIdx.x; asm volatile("":"+v"(tx_)); for(int k=tx_;k<32*64;k+=512)km[k]=T.KM[(long)u.bh*32*64+k]+T.KM[(long)(BATCH*NHEAD+u.bh)*32*64+k]; asm volatile("s_waitcnt vmcnt(0) lgkmcnt(0)":::"memory"); __syncthreads(); lastbh=u.bh; }
    attn_unit<THRL>(u.bh/NHEAD,u.bh%NHEAD,u.qb,T.Q,T.K,T.V,T.O,lds); }
}
#undef SBAR
#undef WAIT_BAR
}

#define XB_TMO      128
#define XB_XCNT(j)  (256  + 64 * (j))
#define XB_XSUB(j)  (1280 + 64 * (j))
#define XB_XGEN(j)  (2304 + 64 * (j))
#define XB_TOP      3328
#define XB_TOPGEN   3392
#define XCD_BAR_WORDS 3456
#define XB_SPIN_CAP (1u << 20)
__device__ __forceinline__ unsigned xb_ld(unsigned* p)              { return __hip_atomic_load(p, __ATOMIC_RELAXED, __HIP_MEMORY_SCOPE_AGENT); }
__device__ __forceinline__ unsigned xb_add(unsigned* p, unsigned v) { return __hip_atomic_fetch_add(p, v, __ATOMIC_RELAXED, __HIP_MEMORY_SCOPE_AGENT); }
__device__ __forceinline__ unsigned xb_xcc_id() { return (unsigned)__builtin_amdgcn_s_getreg((3 << 11) | 20) & 0xFu; }
#define XB_SPIN(cond, bar) do { unsigned _sp = 0; while (cond) { __builtin_amdgcn_s_sleep(1); \
    if ((++_sp & 255u) == 0u) { if (xb_ld(&(bar)[XB_TMO])) break; if (_sp > XB_SPIN_CAP) { atomicAdd(&(bar)[XB_TMO], 1u); break; } } } } while (0)
struct XcdBarrier { unsigned* bar; unsigned x; volatile LAS unsigned* st; };
__device__ __forceinline__ XcdBarrier xcd_barrier_post(unsigned* bar, volatile LAS unsigned* st) {
    XcdBarrier b; b.bar = bar; b.x = xb_xcc_id(); b.st = st;
    if (threadIdx.x == 0) (void)xb_add(&bar[XB_XCNT(b.x)], 1u);
    return b;
}
__device__ __forceinline__ void xcd_barrier_complete(unsigned* bar, unsigned x, unsigned& nloc, unsigned& nx) {
    const unsigned G = gridDim.x * gridDim.y * gridDim.z;
    unsigned sum, cnt, mine, sp = 0u;
    for (;;) {
        sum = 0u; cnt = 0u; mine = 0u;
#pragma unroll
        for (unsigned j = 0; j < 16; ++j) { const unsigned c = xb_ld(&bar[XB_XCNT(j)]); sum += c; cnt += (c > 0u) ? 1u : 0u; mine = (j == x) ? c : mine; }
        if (sum == G) break;
        __builtin_amdgcn_s_sleep(1);
        if ((++sp & 255u) == 0u) { if (xb_ld(&bar[XB_TMO])) break; if (sp > XB_SPIN_CAP) { atomicAdd(&bar[XB_TMO], 1u); break; } }
    }
    nloc = mine > 0u ? mine : 1u; nx = cnt > 0u ? cnt : 1u;
}
__device__ __forceinline__ void xcd_barrier(const XcdBarrier& b) {
    asm volatile("s_waitcnt vmcnt(0)" ::: "memory");
    __syncthreads();
    if (threadIdx.x == 0) {
        unsigned* bar = b.bar;
        __builtin_amdgcn_s_waitcnt(0);
        unsigned nloc = b.st[0], nx = b.st[1];
        if (nloc == 0u) { xcd_barrier_complete(bar, b.x, nloc, nx); b.st[0] = nloc; b.st[1] = nx; }
        const unsigned old = xb_add(&bar[XB_XSUB(b.x)], 1u);
        const unsigned gen = old / nloc;
        if (old + 1u == (gen + 1u) * nloc) {
            __builtin_amdgcn_fence(__ATOMIC_RELEASE, "agent");
            asm volatile("s_waitcnt vmcnt(0)" ::: "memory");
            const unsigned og = xb_add(&bar[XB_TOP], 1u);
            const unsigned tg = og / nx;
            if (og + 1u == (tg + 1u) * nx) xb_add(&bar[XB_TOPGEN], 1u);
            else XB_SPIN(xb_ld(&bar[XB_TOPGEN]) == tg, bar);
            __builtin_amdgcn_fence(__ATOMIC_ACQUIRE, "agent");
            xb_add(&bar[XB_XGEN(b.x)], 1u);
            asm volatile("s_waitcnt vmcnt(0)" ::: "memory");
        } else {
            XB_SPIN(xb_ld(&bar[XB_XGEN(b.x)]) == gen, bar);
            __builtin_amdgcn_fence(__ATOMIC_ACQUIRE, "agent");
            asm volatile("s_waitcnt vmcnt(0)" ::: "memory");
        }
    }
    __syncthreads();
}

struct Args { const float* in[28]; float* out; unsigned char* ws; int ph_lo, ph_hi; };
enum { I_X = 0, I_MEM, I_GMIX, I_WIN, I_ARE, I_AIM, I_LOGDT, I_BRE, I_BIM, I_CRE, I_CIM, I_DSKIP, I_WGLU, I_WPA, I_WOUT, I_GXATTN, I_GMEM, I_WXQ, I_WXKV, I_WXO,
       I_GMOE, I_WROUTER, I_BROUTER, I_WGU, I_BGU, I_WDN, I_BDN, I_GFINAL };

struct TrDesc { const float* W; const float* gain; bf16_t* WT; int K, N, map, item; };
__device__ __forceinline__ void tr_load(const TrDesc& d, f32x4 (&v)[16], float (&g)[16], int lane) {
    const int nblk = d.N / 64, kb = d.item / nblk, nb = d.item % nblk, k0 = 64 * kb, n0 = 64 * nb, q = lane & 15, kr = lane >> 4;
    const float* src = d.W + (size_t)(k0 + kr) * d.N + n0 + 4 * q;
#pragma unroll
    for (int j = 0; j < 16; ++j) v[j] = *(const f32x4*)(src + (size_t)(4 * j) * d.N);
#pragma unroll
    for (int j = 0; j < 16; ++j) g[j] = d.gain ? d.gain[k0 + kr + 4 * j] : 1.0f;
}
__device__ __forceinline__ void tr_finish(const TrDesc& d, const f32x4 (&v)[16], const float (&g)[16], LAS float* scr, int lane) {
    const int nblk = d.N / 64, kb = d.item / nblk, nb = d.item % nblk, k0 = 64 * kb, n0 = 64 * nb, q = lane & 15, kr = lane >> 4;
#pragma unroll
    for (int j = 0; j < 16; ++j) { const int kk = kr + 4 * j; *(LAS f32x4*)(scr + kk * 64 + 4 * (q ^ ((kk >> 3) & 7))) = v[j] * g[j]; }
    asm volatile("s_waitcnt lgkmcnt(0)" ::: "memory");
    const int c = lane & 7, nq = lane >> 3;
    const int nr0 = d.map ? (256 * ((n0 % 1024) / 128) + 128 * (n0 / 1024) + (n0 % 128)) : n0;
#pragma unroll
    for (int jj = 0; jj < 8; ++jj) { const int n = 8 * jj + nq; const LAS float* sp = scr + (8 * c) * 64 + (n ^ (4 * c));
        u32x4 o; o.x = pk2(sp[0 * 64], sp[1 * 64]); o.y = pk2(sp[2 * 64], sp[3 * 64]); o.z = pk2(sp[4 * 64], sp[5 * 64]); o.w = pk2(sp[6 * 64], sp[7 * 64]);
        *(u32x4*)(d.WT + (size_t)(nr0 + n) * d.K + k0 + 8 * c) = o; }
    asm volatile("s_waitcnt lgkmcnt(0)" ::: "memory");
}
template <int MODE>
__device__ __forceinline__ float rms_row_to_bf16(const float* xrow, const float* gain, bf16_t* orow, int lane) {
    const f32x4* xr = (const f32x4*)xrow + lane;
    f32x4 v[4]; float s = 0.f;
#pragma unroll
    for (int j = 0; j < 4; ++j) { v[j] = xr[64 * j]; s += (v[j][0] * v[j][0] + v[j][1] * v[j][1]) + (v[j][2] * v[j][2] + v[j][3] * v[j][3]); }
    const float rstd = 1.0f / sqrtf(wave_sum(s) * (1.0f / DM) + RMS_EPS);
    u32x2* o8 = (u32x2*)orow + lane;
#pragma unroll
    for (int j = 0; j < 4; ++j) { f32x4 w = v[j];
        if (MODE == 1) { const f32x4 g = ((const f32x4*)gain)[lane + 64 * j]; w = w * rstd * g; }
        u32x2 o; o.x = pk2(w[0], w[1]); o.y = pk2(w[2], w[3]); o8[64 * j] = o; }
    return rstd;
}

struct Frame {
    LAS unsigned char* lds; int tid, lane, wave, G, bid;
    const float* in[28]; float* out; unsigned char* ws; unsigned* ctl;
};
#define WSP(type, off) ((type*)(F.ws + (off)))

__device__ __forceinline__ TrDesc tr_decode(Frame& F, int it) {
    constexpr int I_IN = (DM / 64) * (INW / 64), I_GLU = (SW / 64) * (2 * DM / 64), I_PA = (AW / 64) * (DM / 64), I_OUT = (DM / 64) * (DM / 64), I_XQ = (DM / 64) * (XW / 64),
                  I_XKV = (DM / 64) * (2 * XW / 64), I_XO = (XW / 64) * (DM / 64), I_GU1 = (DM / 64) * (2 * DFF / 64), I_DN1 = (DFF / 64) * (DM / 64);
    int r = it;
    if (r < I_IN) return TrDesc{F.in[I_WIN], F.in[I_GMIX], WSP(bf16_t, WS_WIN), DM, INW, 0, r}; r -= I_IN;
    if (r < I_GLU) return TrDesc{F.in[I_WGLU], nullptr, WSP(bf16_t, WS_WGLU), SW, 2 * DM, 1, r}; r -= I_GLU;
    if (r < I_PA) return TrDesc{F.in[I_WPA], nullptr, WSP(bf16_t, WS_WPA), AW, DM, 0, r}; r -= I_PA;
    if (r < I_OUT) return TrDesc{F.in[I_WOUT], nullptr, WSP(bf16_t, WS_WOUT), DM, DM, 0, r}; r -= I_OUT;
    if (r < I_XQ) return TrDesc{F.in[I_WXQ], F.in[I_GXATTN], WSP(bf16_t, WS_WXQ), DM, XW, 0, r}; r -= I_XQ;
    if (r < I_XKV) return TrDesc{F.in[I_WXKV], nullptr, WSP(bf16_t, WS_WXKV), DM, 2 * XW, 0, r}; r -= I_XKV;
    if (r < I_XO) return TrDesc{F.in[I_WXO], nullptr, WSP(bf16_t, WS_WXO), XW, DM, 0, r}; r -= I_XO;
    const int e = r / (I_GU1 + I_DN1); r -= e * (I_GU1 + I_DN1);
    if (r < I_GU1) return TrDesc{F.in[I_WGU] + (size_t)e * DM * 2 * DFF, F.in[I_GMOE], WSP(bf16_t, WS_WGU) + (size_t)e * 2 * DFF * DM, DM, 2 * DFF, 1, r};
    return TrDesc{F.in[I_WDN] + (size_t)e * DFF * DM, nullptr, WSP(bf16_t, WS_WDN) + (size_t)e * DM * DFF, DFF, DM, 0, r - I_GU1};
}
__device__ __forceinline__ void xrow_load(const float* X, int m, f32x4 (&v)[4][4], int lane) {
#pragma unroll
    for (int r = 0; r < 4; ++r)
#pragma unroll
        for (int j = 0; j < 4; ++j) v[r][j] = ((const f32x4*)(X + (size_t)(m + r) * DM))[lane + 64 * j];
}
__device__ __forceinline__ void xrow_finish(bf16_t* XBp, int m, const f32x4 (&v)[4][4], int lane) {
    float ss[4];
#pragma unroll
    for (int r = 0; r < 4; ++r) { float s = 0.f;
#pragma unroll
        for (int j = 0; j < 4; ++j) s += (v[r][j][0] * v[r][j][0] + v[r][j][1] * v[r][j][1]) + (v[r][j][2] * v[r][j][2] + v[r][j][3] * v[r][j][3]);
        ss[r] = s; }
#pragma unroll
    for (int o = 1; o < 64; o <<= 1) {
#pragma unroll
        for (int r = 0; r < 4; ++r) ss[r] += __shfl_xor(ss[r], o); }
#pragma unroll
    for (int r = 0; r < 4; ++r) { u32x2* o8 = (u32x2*)(XBp + (size_t)(m + r) * DM) + lane;
        const float rs = 1.0f / sqrtf(ss[r] * (1.0f / DM) + RMS_EPS);
#pragma unroll
        for (int j = 0; j < 4; ++j) { u32x2 o; o.x = pk2(v[r][j][0] * rs, v[r][j][1] * rs); o.y = pk2(v[r][j][2] * rs, v[r][j][3] * rs); o8[64 * j] = o; } }
}
__device__ __forceinline__ void phase_prologue(Frame& F) {
    LAS float* scr = (LAS float*)(F.lds + F.wave * 16384);
    const int gw = F.bid * 8 + F.wave, NGW = F.G * 8;
    { f32x4 va[4][4], vb[4][4]; const int step = NGW * 4, m0 = gw * 4, n = (m0 < T_) ? (T_ - m0 + step - 1) / step : 0;
      if (n > 0) { xrow_load(F.in[I_X], m0, va, F.lane); int i = 0;
          for (; i + 2 <= n; i += 2) {
              xrow_load(F.in[I_X], m0 + (i + 1) * step, vb, F.lane);
              xrow_finish(WSP(bf16_t, WS_XB), m0 + i * step, va, F.lane);
              xrow_load(F.in[I_X], m0 + min(i + 2, n - 1) * step, va, F.lane);
              xrow_finish(WSP(bf16_t, WS_XB), m0 + (i + 1) * step, vb, F.lane); }
          if (i < n) xrow_finish(WSP(bf16_t, WS_XB), m0 + i * step, va, F.lane); } }
    for (int m = gw; m < NB * MEML; m += NGW) (void)rms_row_to_bf16<1>(F.in[I_MEM] + (size_t)m * DM, F.in[I_GMEM], WSP(bf16_t, WS_MN) + (size_t)m * DM, F.lane);
    constexpr int NITEMS = (DM / 64) * (INW / 64) + (SW / 64) * (2 * DM / 64) + (AW / 64) * (DM / 64) + (DM / 64) * (DM / 64) + (DM / 64) * (XW / 64) + (DM / 64) * (2 * XW / 64) + (XW / 64) * (DM / 64)
                         + NE * ((DM / 64) * (2 * DFF / 64) + (DFF / 64) * (DM / 64));
    { f32x4 va[16], vb[16]; float ga[16], gb[16]; TrDesc da, db; const int n = (gw < NITEMS) ? (NITEMS - gw + NGW - 1) / NGW : 0;
      if (n > 0) { da = tr_decode(F, gw); tr_load(da, va, ga, F.lane); int i = 0;
          for (; i + 2 <= n; i += 2) {
              db = tr_decode(F, gw + (i + 1) * NGW); tr_load(db, vb, gb, F.lane);
              tr_finish(da, va, ga, scr, F.lane);
              da = tr_decode(F, gw + min(i + 2, n - 1) * NGW); tr_load(da, va, ga, F.lane);
              tr_finish(db, vb, gb, scr, F.lane); }
          if (i < n) tr_finish(da, va, ga, scr, F.lane); } }
}

__device__ __forceinline__ void phase_kmean(Frame& F) {
    LAS float* red = (LAS float*)F.lds;
    const bf16_t* Kb = WSP(bf16_t, WS_K);
    for (int it = F.bid; it < NB * NH * NBLK; it += F.G) {
        const int j = it % NBLK, h = (it / NBLK) % NH, b = it / (NBLK * NH);
        const int col = F.tid & 63, rg = F.tid >> 6; float s = 0.f;
        const bf16_t* p = Kb + ((size_t)(b * SEQ + j * MBLK + rg * 32)) * AW + h * HD + col;
#pragma unroll 8
        for (int r = 0; r < 32; ++r) s += bf2f(p[(size_t)r * AW]);
        red[rg * 64 + col] = s;
        __syncthreads();
        if (F.tid < 64) { float t = 0.f;
#pragma unroll
            for (int k = 0; k < 8; ++k) t += red[k * 64 + F.tid];
            WSP(float, WS_KMEAN)[(size_t)it * HD + F.tid] = t * (1.0f / MBLK); }
        __syncthreads();
    }
}

__device__ __forceinline__ void phase_moba_simple(Frame& F, bf16_t* Ob) {
    LAS unsigned* Ks = (LAS unsigned*)F.lds;
    LAS unsigned* Vs = (LAS unsigned*)(F.lds + 32768);
    LAS float* km = (LAS float*)(F.lds + 65536);
    const bf16_t *Qb = WSP(bf16_t, WS_Q), *Kb = WSP(bf16_t, WS_K), *Vb = WSP(bf16_t, WS_V);
    const int ql = F.tid >> 1, half = F.tid & 1;
    for (int it = F.bid; it < NB * NH * NBLK; it += F.G) {
        const int iblk = (NBLK - 1) - (it % NBLK), h = (it / NBLK) % NH, b = it / (NBLK * NH);
        __syncthreads();
        for (int k = F.tid; k < NBLK * HD; k += 512) km[k] = WSP(float, WS_KMEAN)[(size_t)((b * NH + h) * NBLK) * HD + k] + WSP(float, WS_KMEAN)[(size_t)((NB * NH + b * NH + h) * NBLK) * HD + k];
        float q[32];
        { const u32x4* qp = (const u32x4*)(Qb + (size_t)(b * SEQ + iblk * MBLK + ql) * AW + h * HD + half * 32);
#pragma unroll
          for (int c = 0; c < 4; ++c) { const u32x4 w = qp[c]; q[8 * c + 0] = bflo(w.x); q[8 * c + 1] = bfhi(w.x); q[8 * c + 2] = bflo(w.y); q[8 * c + 3] = bfhi(w.y); q[8 * c + 4] = bflo(w.z); q[8 * c + 5] = bfhi(w.z); q[8 * c + 6] = bflo(w.w); q[8 * c + 7] = bfhi(w.w); } }
        __syncthreads();
        float g0 = -3e38f, g1 = -3e38f, g2 = -3e38f; int s0 = -1, s1 = -1, s2 = -1;
        for (int j = 0; j < iblk; ++j) { float g = 0.f;
#pragma unroll
            for (int d = 0; d < 32; ++d) g += q[d] * km[j * HD + half * 32 + d];
            g += __shfl_xor(g, 1);
            if (g > g0) { g2 = g1; s2 = s1; g1 = g0; s1 = s0; g0 = g; s0 = j; } else if (g > g1) { g2 = g1; s2 = s1; g1 = g; s1 = j; } else if (g > g2) { g2 = g; s2 = j; } }
        float mx = -3e38f, l = 0.f, o[32];
#pragma unroll
        for (int d = 0; d < 32; ++d) o[d] = 0.f;
        for (int jb = 0; jb <= iblk; ++jb) {
            __syncthreads();
            { const size_t rowb = (size_t)(b * SEQ + jb * MBLK);
              for (int c = F.tid; c < 256 * 8; c += 512) { const int r = c >> 3, ch = c & 7;
                  *(LAS u32x4*)(Ks + r * 32 + ch * 4) = *(const u32x4*)(Kb + (rowb + r) * AW + h * HD + ch * 8);
                  *(LAS u32x4*)(Vs + r * 32 + ch * 4) = *(const u32x4*)(Vb + (rowb + r) * AW + h * HD + ch * 8); } }
            __syncthreads();
            const bool need = (jb == iblk) || jb == s0 || jb == s1 || jb == s2;
            if (need) { const int kend = (jb == iblk) ? ql : 255;
                for (int kk = 0; kk <= kend; ++kk) { float s = 0.f;
#pragma unroll
                    for (int c = 0; c < 4; ++c) { const u32x4 w = *(const LAS u32x4*)(Ks + kk * 32 + half * 16 + c * 4);
                        s += q[8 * c + 0] * bflo(w.x) + q[8 * c + 1] * bfhi(w.x) + q[8 * c + 2] * bflo(w.y) + q[8 * c + 3] * bfhi(w.y) + q[8 * c + 4] * bflo(w.z) + q[8 * c + 5] * bfhi(w.z) + q[8 * c + 6] * bflo(w.w) + q[8 * c + 7] * bfhi(w.w); }
                    s += __shfl_xor(s, 1);
                    const float mn = fmaxf(mx, s), corr = __builtin_amdgcn_exp2f(mx - mn), p = __builtin_amdgcn_exp2f(s - mn); mx = mn; l = l * corr + p;
#pragma unroll
                    for (int c = 0; c < 4; ++c) { const u32x4 w = *(const LAS u32x4*)(Vs + kk * 32 + half * 16 + c * 4);
                        o[8 * c + 0] = o[8 * c + 0] * corr + p * bflo(w.x); o[8 * c + 1] = o[8 * c + 1] * corr + p * bfhi(w.x); o[8 * c + 2] = o[8 * c + 2] * corr + p * bflo(w.y); o[8 * c + 3] = o[8 * c + 3] * corr + p * bfhi(w.y);
                        o[8 * c + 4] = o[8 * c + 4] * corr + p * bflo(w.z); o[8 * c + 5] = o[8 * c + 5] * corr + p * bfhi(w.z); o[8 * c + 6] = o[8 * c + 6] * corr + p * bflo(w.w); o[8 * c + 7] = o[8 * c + 7] * corr + p * bfhi(w.w); } } }
        }
        const float il = 1.0f / l;
        u32x4* op = (u32x4*)(Ob + (size_t)(b * SEQ + iblk * MBLK + ql) * AW + h * HD + half * 32);
#pragma unroll
        for (int c = 0; c < 4; ++c) { u32x4 w; w.x = pk2(o[8 * c + 0] * il, o[8 * c + 1] * il); w.y = pk2(o[8 * c + 2] * il, o[8 * c + 3] * il); w.z = pk2(o[8 * c + 4] * il, o[8 * c + 5] * il); w.w = pk2(o[8 * c + 6] * il, o[8 * c + 7] * il); op[c] = w; }
    }
}

__device__ __forceinline__ void phase_ssm_simple(Frame& F, bf16_t* Yb) {
    const int gw = F.bid * 8 + F.wave, NGW = F.G * 8, p = F.lane;
    const bf16_t* Ub = WSP(bf16_t, WS_U);
    for (int it = gw; it < NB * NG; it += NGW) {
        const int g = it % NG, b = it / NG;
        const float are = fminf(F.in[I_ARE][g * SP + p], -1e-4f), aim = F.in[I_AIM][g * SP + p], dt = expf(F.in[I_LOGDT][g]);
        const float mag = expf(are * dt), ang = aim * dt; const float lr = mag * cosf(ang), li = mag * sinf(ang);
        const float nr = lr - 1.0f, ni = li, den = 1.0f / (are * are + aim * aim); const float fr_ = (nr * are + ni * aim) * den, fi_ = (ni * are - nr * aim) * den;
        float bbr[16], bbi[16], cr[16], ci[16], dsk[16];
#pragma unroll
        for (int c = 0; c < 16; ++c) { const float br = F.in[I_BRE][(size_t)(g * SP + p) * SGC + c], bi = F.in[I_BIM][(size_t)(g * SP + p) * SGC + c];
            bbr[c] = fr_ * br - fi_ * bi; bbi[c] = fr_ * bi + fi_ * br;
            cr[c] = F.in[I_CRE][(size_t)(g * SGC + c) * SP + p]; ci[c] = F.in[I_CIM][(size_t)(g * SGC + c) * SP + p]; dsk[c] = F.in[I_DSKIP][g * SGC + c]; }
        float xr = 0.f, xi = 0.f;
        const int csel = ((p >> 5) & 1) * 8 + ((p >> 4) & 1) * 4 + ((p >> 3) & 1) * 2 + ((p >> 2) & 1);
        float dmine = 0.f;
#pragma unroll
        for (int c = 0; c < 16; ++c) dmine = (c == csel) ? dsk[c] : dmine;
        for (int t = 0; t < SEQ; ++t) {
            const u32x4* up = (const u32x4*)(Ub + (size_t)(b * SEQ + t) * SW + g * SGC); const u32x4 w0 = up[0], w1 = up[1];
            float u[16]; u[0] = bflo(w0.x); u[1] = bfhi(w0.x); u[2] = bflo(w0.y); u[3] = bfhi(w0.y); u[4] = bflo(w0.z); u[5] = bfhi(w0.z); u[6] = bflo(w0.w); u[7] = bfhi(w0.w);
            u[8] = bflo(w1.x); u[9] = bfhi(w1.x); u[10] = bflo(w1.y); u[11] = bfhi(w1.y); u[12] = bflo(w1.z); u[13] = bfhi(w1.z); u[14] = bflo(w1.w); u[15] = bfhi(w1.w);
            float sr = 0.f, si = 0.f;
#pragma unroll
            for (int c = 0; c < 16; ++c) { sr += bbr[c] * u[c]; si += bbi[c] * u[c]; }
            const float nxr = lr * xr - li * xi + sr, nxi = lr * xi + li * xr + si; xr = nxr; xi = nxi;
            float y[16];
#pragma unroll
            for (int c = 0; c < 16; ++c) y[c] = cr[c] * xr - ci[c] * xi;
            float w8[8], w4[4], w2[2], w1_;
            { const bool hi = (p & 32) != 0;
#pragma unroll
              for (int i = 0; i < 8; ++i) { const float keep = hi ? y[i + 8] : y[i], send = hi ? y[i] : y[i + 8]; w8[i] = keep + __shfl_xor(send, 32); } }
            { const bool hi = (p & 16) != 0;
#pragma unroll
              for (int i = 0; i < 4; ++i) { const float keep = hi ? w8[i + 4] : w8[i], send = hi ? w8[i] : w8[i + 4]; w4[i] = keep + __shfl_xor(send, 16); } }
            { const bool hi = (p & 8) != 0;
#pragma unroll
              for (int i = 0; i < 2; ++i) { const float keep = hi ? w4[i + 2] : w4[i], send = hi ? w4[i] : w4[i + 2]; w2[i] = keep + __shfl_xor(send, 8); } }
            { const bool hi = (p & 4) != 0; const float keep = hi ? w2[1] : w2[0], send = hi ? w2[0] : w2[1]; w1_ = keep + __shfl_xor(send, 4); }
            w1_ += __shfl_xor(w1_, 2); w1_ += __shfl_xor(w1_, 1);
            float umine = 0.f;
#pragma unroll
            for (int c = 0; c < 16; ++c) umine = (c == csel) ? u[c] : umine;
            if ((p & 3) == 0) Yb[(size_t)(b * SEQ + t) * SW + g * SGC + csel] = (bf16_t)f2bf(gelu_tanh(w1_ + dmine * umine));
        }
    }
}


__device__ __forceinline__ void p0_ssm_tables(Frame& F, int task) {
    const int g = task >> 3, part = task & 7;
    LAS float* pwr = (LAS float*)F.lds; LAS float* pwi = pwr + 65 * 64; LAS float* bbr = pwi + 65 * 64; LAS float* bbi = bbr + 1024; LAS float* ccr = bbi + 1024; LAS float* cci = ccr + 1024;
    const float dt = expf(F.in[I_LOGDT][g]);
    __syncthreads();
    for (int i = F.tid; i < 65 * 64; i += 512) { const int k = i >> 6, p = i & 63; const float are = fminf(F.in[I_ARE][g * SP + p], -1e-4f), aim = F.in[I_AIM][g * SP + p];
        const float mag = expf(are * dt * (float)k); double a = (double)aim * (double)dt * (double)k; a -= 6.283185307179586 * rint(a * 0.15915494309189535); const float af = (float)a;
        pwr[i] = mag * cosf(af); pwi[i] = mag * sinf(af); }
    for (int i = F.tid; i < 1024; i += 512) { const int p = i >> 4, c = i & 15; const float are = fminf(F.in[I_ARE][g * SP + p], -1e-4f), aim = F.in[I_AIM][g * SP + p];
        const float mag = expf(are * dt); double a = (double)aim * (double)dt; a -= 6.283185307179586 * rint(a * 0.15915494309189535); const float af = (float)a;
        const float lr = mag * cosf(af), li = mag * sinf(af), nr = lr - 1.0f, ni = li, den = 1.0f / (are * are + aim * aim), fr_ = (nr * are + ni * aim) * den, fi_ = (ni * are - nr * aim) * den;
        const float br = F.in[I_BRE][(size_t)(g * SP + p) * SGC + c], bi = F.in[I_BIM][(size_t)(g * SP + p) * SGC + c];
        bbr[i] = fr_ * br - fi_ * bi; bbi[i] = fr_ * bi + fi_ * br; }
    for (int i = F.tid; i < 1024; i += 512) { ccr[i] = F.in[I_CRE][(size_t)g * 1024 + i]; cci[i] = F.in[I_CIM][(size_t)g * 1024 + i]; }
    __syncthreads();
    bf16_t* WST = WSP(bf16_t, WS_WST) + (size_t)g * 128 * 1024; bf16_t* GT = WSP(bf16_t, WS_GT) + (size_t)g * 1024 * 128; bf16_t* KT = WSP(bf16_t, WS_KT) + (size_t)g * 65 * 256;
    for (int j = 0; j < 32; ++j) { const int e = part * 16384 + j * 512 + F.tid; const int pp = e >> 10, k = e & 1023, s = k >> 4, c = k & 15, p = pp & 63;
        const float mr = pwr[(63 - s) * 64 + p], mi = pwi[(63 - s) * 64 + p], br = bbr[p * 16 + c], bi = bbi[p * 16 + c];
        WST[e] = (bf16_t)f2bf(pp < 64 ? (mr * br - mi * bi) : (mr * bi + mi * br)); }
    for (int j = 0; j < 32; ++j) { const int e = part * 16384 + j * 512 + F.tid; const int sc = e >> 7, pp = e & 127, s = sc >> 4, c = sc & 15, p = pp & 63;
        const float mr = pwr[(s + 1) * 64 + p], mi = pwi[(s + 1) * 64 + p], cr = ccr[c * 64 + p], ci = cci[c * 64 + p];
        GT[e] = (bf16_t)f2bf(pp < 64 ? (cr * mr - ci * mi) : -(cr * mi + ci * mr)); }
    for (int e = part * 2080 + F.tid; e < (part + 1) * 2080; e += 512) { const int tt = e >> 8, c = (e >> 4) & 15, c2 = e & 15; float acc = 0.f;
        if (tt > 0) { const int tau = tt - 1;
            for (int p = 0; p < 64; ++p) { const float mr = pwr[tau * 64 + p], mi = pwi[tau * 64 + p], cr = ccr[c * 64 + p], ci = cci[c * 64 + p]; const float zr = cr * mr - ci * mi, zi = cr * mi + ci * mr; acc += zr * bbr[p * 16 + c2] - zi * bbi[p * 16 + c2]; } }
        KT[e] = (bf16_t)f2bf(acc); }
    if (part == 0 && F.tid < 64) { WSP(f32x2, WS_LAML)[g * 64 + F.tid] = (f32x2){pwr[64 * 64 + F.tid], pwi[64 * 64 + F.tid]}; }
    __syncthreads();
}
__device__ __forceinline__ void ssm_state_item(Frame& F, int b, int g, int h) {
    const int w = F.wave, row = F.lane & 15, kg = F.lane >> 4;
    f32x4 acc[4];
#pragma unroll
    for (int c = 0; c < 4; ++c) acc[c] = (f32x4){0.f, 0.f, 0.f, 0.f};
    const bf16_t* Ub = WSP(bf16_t, WS_U) + ((size_t)b * SEQ + (size_t)(16 * w + row) * 64 + (kg >> 1)) * SW + g * SGC + 8 * (kg & 1);
    const bf16_t* Wb = WSP(bf16_t, WS_WST) + ((size_t)g * 128 + 32 * h + row) * 1024 + 8 * kg;
#pragma unroll 4
    for (int ks = 0; ks < 32; ++ks) {
        const bf16x8 a = *(const bf16x8*)(Ub + ((size_t)(2 * ks)) * SW);
        bf16x8 bq[4];
#pragma unroll
        for (int nt = 0; nt < 4; ++nt) bq[nt] = *(const bf16x8*)(Wb + (size_t)((nt & 1) * 16 + (nt >> 1) * 64) * 1024 + 32 * ks);
#pragma unroll
        for (int nt = 0; nt < 4; ++nt) acc[nt] = __builtin_amdgcn_mfma_f32_16x16x32_bf16(a, bq[nt], acc[nt], 0, 0, 0);
    }
    LAS float* X = (LAS float*)F.lds;
    __syncthreads();
#pragma unroll
    for (int nt = 0; nt < 4; ++nt)
#pragma unroll
        for (int r = 0; r < 4; ++r) X[(16 * w + 4 * kg + r) * 64 + (nt >> 1) * 32 + (nt & 1) * 16 + row] = acc[nt][r];
    __syncthreads();
    if (w == 0 && F.lane < 32) { const int p = 32 * h + F.lane; const f32x2 lam = WSP(f32x2, WS_LAML)[g * 64 + p]; float sr = 0.f, si = 0.f;
        bf16_t* SS = WSP(bf16_t, WS_SST) + ((size_t)(b * NG + g) * 128) * 128;
#pragma unroll 4
        for (int n = 0; n < 128; ++n) { SS[n * 128 + p] = (bf16_t)f2bf(sr); SS[n * 128 + 64 + p] = (bf16_t)f2bf(si);
            const float xr = X[n * 64 + F.lane], xi = X[n * 64 + 32 + F.lane]; const float nsr = lam.x * sr - lam.y * si + xr, nsi = lam.x * si + lam.y * sr + xi; sr = nsr; si = nsi; } }
    __syncthreads();
}
constexpr int SO_USTR = 2064, SO_KT = 32 * SO_USTR, SO_SS = SO_KT + 65 * 512, SO_SSTR = 272;
__device__ __forceinline__ void ssm_out_item(Frame& F, int b, int g, int rr) {
    LAS unsigned char* L = F.lds;
    const int w = F.wave, lane = F.lane, r32 = lane & 31, hi = lane >> 5, sp = r32 >> 4, cch = r32 & 15;
    __syncthreads();
    { const bf16_t* Ug = WSP(bf16_t, WS_U) + ((size_t)b * SEQ + (size_t)rr * 2048) * SW + g * SGC;
#pragma unroll
      for (int j = 0; j < 8; ++j) { const int c = F.tid + 512 * j, r = c >> 1, half = c & 1; *(LAS u32x4*)(L + (r >> 6) * SO_USTR + (r & 63) * 32 + half * 16) = *(const u32x4*)(Ug + (size_t)r * SW + half * 8); }
      const u32x4* Kg = (const u32x4*)(WSP(bf16_t, WS_KT) + (size_t)g * 65 * 256);
      for (int c = F.tid; c < 2080; c += 512) *(LAS u32x4*)(L + SO_KT + c * 16) = Kg[c];
      { const int c = F.tid, ch = c >> 4, pc = c & 15; *(LAS u32x4*)(L + SO_SS + ch * SO_SSTR + pc * 16) = *(const u32x4*)(WSP(bf16_t, WS_SST) + ((size_t)((b * NG + g) * 128 + rr * 32 + ch)) * 128 + pc * 8); } }
    const bf16_t* Gg = WSP(bf16_t, WS_GT) + ((size_t)g * 1024 + (2 * w + sp) * 16 + cch) * 128 + 8 * hi;
    bf16x8 gb[2][8];
#pragma unroll
    for (int k2 = 0; k2 < 8; ++k2) gb[0][k2] = *(const bf16x8*)(Gg + 16 * k2);
    __syncthreads();
    f32x16 acc[4];
#pragma unroll
    for (int a = 0; a < 4; ++a)
#pragma unroll
        for (int r = 0; r < 16; ++r) acc[a][r] = 0.f;
    const LAS unsigned char* Ua = L + r32 * SO_USTR + hi * 16;
    const LAS unsigned char* Kb_ = L + SO_KT + (2 * w + sp + 1) * 512 + cch * 32 + hi * 16;
#define SO_SEG(A0, LO, HI) for (int s1 = (LO); s1 < (HI); ++s1) { const bf16x8 av = *(const LAS bf16x8*)(Ua + s1 * 32); \
        _Pragma("unroll") for (int a = (A0); a < 4; ++a) { const bf16x8 bv = *(const LAS bf16x8*)(Kb_ + a * 8192 - s1 * 512); acc[a] = __builtin_amdgcn_mfma_f32_32x32x16_bf16(av, bv, acc[a], 0, 0, 0); } }
    SO_SEG(0, 0, 2 * w + 2)
    SO_SEG(1, 2 * w + 2, 2 * w + 18)
    SO_SEG(2, 2 * w + 18, 2 * w + 34)
    SO_SEG(3, 2 * w + 34, 2 * w + 50)
#undef SO_SEG
    bf16x8 sa[8];
#pragma unroll
    for (int k2 = 0; k2 < 8; ++k2) sa[k2] = *(const LAS bf16x8*)(L + SO_SS + r32 * SO_SSTR + k2 * 32 + hi * 16);
#pragma unroll
    for (int a = 0; a < 4; ++a) {
        if (a < 3) {
#pragma unroll
            for (int k2 = 0; k2 < 8; ++k2) gb[(a + 1) & 1][k2] = *(const bf16x8*)(Gg + (size_t)(a + 1) * (16 * 16 * 128) + 16 * k2); }
#pragma unroll
        for (int k2 = 0; k2 < 8; ++k2) acc[a] = __builtin_amdgcn_mfma_f32_32x32x16_bf16(sa[k2], gb[a & 1][k2], acc[a], 0, 0, 0);
    }
    __syncthreads();
    const float dsk = F.in[I_DSKIP][g * SGC + cch];
    { LAS unsigned char* yb = L + (4 * hi) * SO_USTR + (2 * w + sp) * 32 + cch * 2;
#pragma unroll
      for (int a = 0; a < 4; ++a)
#pragma unroll
          for (int r = 0; r < 16; ++r) { LAS unsigned short* p = (LAS unsigned short*)(yb + ((r & 3) + 8 * (r >> 2)) * SO_USTR + a * 512); const float u = bf2f(*p); *p = (unsigned short)f2bf(gelu_tanh(acc[a][r] + dsk * u)); } }
    __syncthreads();
    { bf16_t* Yg = WSP(bf16_t, WS_YB) + ((size_t)b * SEQ + (size_t)rr * 2048) * SW + g * SGC;
#pragma unroll 2
      for (int j = 0; j < 8; ++j) { const int c = F.tid + 512 * j, r = c >> 1, half = c & 1; *(u32x4*)(Yg + (size_t)r * SW + half * 8) = *(const LAS u32x4*)(L + (r >> 6) * SO_USTR + (r & 63) * 32 + half * 16); } }
}
__device__ __forceinline__ void phase_ssm_out(Frame& F) {
    for (int it = F.bid; it < NB * NG * 4; it += F.G) ssm_out_item(F, it >> 7, (it >> 2) & 31, it & 3);
    __syncthreads();
}


__device__ __forceinline__ void moba_route_item(Frame& F, int bh, int i) {
    LAS float* km = (LAS float*)F.lds;
    LAS unsigned* lc = (LAS unsigned*)(F.lds + 8192); LAS unsigned* lb = lc + 32;
    const int b = bh >> 3, h = bh & 7, ql = F.tid >> 1, half = F.tid & 1;
    __syncthreads();
    { const float* K0 = WSP(float, WS_KM2) + (size_t)bh * NBLK * HD; const float* K1 = K0 + (size_t)NB * NH * NBLK * HD;
      for (int k = F.tid; k < NBLK * HD; k += 512) km[k] = K0[k] + K1[k]; }
    if (F.tid < 32) lc[F.tid] = 0u;
    float q[32];
    { const u32x4* qp = (const u32x4*)(WSP(bf16_t, WS_Q) + (size_t)(b * SEQ + i * MBLK + ql) * AW + h * HD + half * 32);
#pragma unroll
      for (int c = 0; c < 4; ++c) { const u32x4 w = qp[c]; q[8 * c + 0] = bflo(w.x); q[8 * c + 1] = bfhi(w.x); q[8 * c + 2] = bflo(w.y); q[8 * c + 3] = bfhi(w.y); q[8 * c + 4] = bflo(w.z); q[8 * c + 5] = bfhi(w.z); q[8 * c + 6] = bflo(w.w); q[8 * c + 7] = bfhi(w.w); } }
    __syncthreads();
    float g0 = -3e38f, g1 = -3e38f, g2 = -3e38f; int s0 = -1, s1 = -1, s2 = -1;
    for (int j = 0; j < i; ++j) { float g = 0.f;
#pragma unroll
        for (int d = 0; d < 32; ++d) g += q[d] * km[j * HD + half * 32 + d];
        g += __shfl_xor(g, 1);
        if (g > g0) { g2 = g1; s2 = s1; g1 = g0; s1 = s0; g0 = g; s0 = j; } else if (g > g1) { g2 = g1; s2 = s1; g1 = g; s1 = j; } else if (g > g2) { g2 = g; s2 = j; } }
    unsigned r0 = 0u, r1 = 0u, r2 = 0u;
    if (half == 0) { if (s0 >= 0) r0 = __hip_atomic_fetch_add(&lc[s0], 1u, __ATOMIC_RELAXED, __HIP_MEMORY_SCOPE_WORKGROUP); if (s1 >= 0) r1 = __hip_atomic_fetch_add(&lc[s1], 1u, __ATOMIC_RELAXED, __HIP_MEMORY_SCOPE_WORKGROUP);
        if (s2 >= 0) r2 = __hip_atomic_fetch_add(&lc[s2], 1u, __ATOMIC_RELAXED, __HIP_MEMORY_SCOPE_WORKGROUP); }
    __syncthreads();
    if (F.tid < 32) { const unsigned n = lc[F.tid]; lb[F.tid] = n ? atomicAdd(F.ctl + CW_MCNT + bh * NBLK + F.tid, n) : 0u; }
    __syncthreads();
    if (half == 0) { unsigned short* ML = WSP(unsigned short, WS_MLIST) + (size_t)bh * NBLK * 8192; const unsigned e = (unsigned)(i * MBLK + ql) * 4u;
        f32x2* pml = WSP(f32x2, WS_PML) + ((size_t)bh * SEQ + i * MBLK + ql) * 4;
        if (s0 >= 0) ML[(size_t)s0 * 8192 + lb[s0] + r0] = (unsigned short)(e + 0u); else pml[0] = (f32x2){-1e30f, 0.f};
        if (s1 >= 0) ML[(size_t)s1 * 8192 + lb[s1] + r1] = (unsigned short)(e + 1u); else pml[1] = (f32x2){-1e30f, 0.f};
        if (s2 >= 0) ML[(size_t)s2 * 8192 + lb[s2] + r2] = (unsigned short)(e + 2u); else pml[2] = (f32x2){-1e30f, 0.f}; }
}
template <int EXPM> __device__ __forceinline__ void moba_sparse_phase(Frame& F, char* lds_generic) {
    LAS unsigned* cl = (LAS unsigned*)(F.lds + attn_body::LDS_BYTES);
    LAS unsigned* pf = cl + 128;
    const int x = F.bid & 7, slot = F.bid >> 3, nslots = F.G >> 3;
    __syncthreads();
    if (F.tid < 128) cl[F.tid] = __hip_atomic_load(F.ctl + CW_MCNT + (x + 8 * (F.tid >> 5)) * NBLK + (F.tid & 31), RLX_AGENT);
    __syncthreads();
    if (F.tid == 0) { unsigned a = 0; for (int i = 0; i < 128; ++i) { pf[i] = a; a += 1u + ((cl[i] + 255u) >> 8); } pf[128] = a; }
    __syncthreads();
    const int total = (int)pf[128]; int pos = (int)(((long)total * slot) / nslots); const int end = (int)(((long)total * (slot + 1)) / nslots);
    const attn_body::bf16* Qb = (const attn_body::bf16*)WSP(bf16_t, WS_Q); const attn_body::bf16* Kb = (const attn_body::bf16*)WSP(bf16_t, WS_K); const attn_body::bf16* Vb = (const attn_body::bf16*)WSP(bf16_t, WS_V);
    attn_body::bf16* PO = (attn_body::bf16*)WSP(bf16_t, WS_PO); float* PML = WSP(float, WS_PML);
    const int wid = F.wave;
    int L = 0;
    while (pos < end) {
        while ((int)pf[L + 1] <= pos) ++L;
        const int m = L >> 5, j = L & 31, bh = x + 8 * m, b = bh >> 3, h = bh & 7, cnt = (int)cl[L];
        const int c0 = pos - (int)pf[L], c1 = min((int)pf[L + 1], end) - (int)pf[L];
        const size_t kvrow = (size_t)b * SEQ + (size_t)j * MBLK;
        __syncthreads();
        attn_body::moba_load_kv(Kb + kvrow * AW + h * HD, Vb + kvrow * AW + h * HD, lds_generic);
        __syncthreads();
        for (int c = c0; c < c1; ++c) {
            int l_ = F.lane; asm volatile("" : "+v"(l_)); const int r32 = l_ & 31;
            int qg, dest; bool causal;
            if (c == 0) { qg = j * MBLK + wid * 32 + r32; dest = (EXPM == 1) ? -1 : (bh * SEQ + qg) * 4 + 3; causal = true; }
            else { const int base = (c - 1) * 256 + wid * 32; if (base >= cnt) continue;
                const int idx = base + r32; causal = false;
                if (EXPM == 1) { qg = j * MBLK + wid * 32 + r32; dest = -1; }
                else if (idx < cnt) { const unsigned e = WSP(unsigned short, WS_MLIST)[((size_t)bh * NBLK + j) * 8192 + idx]; qg = (int)(e >> 2); dest = (bh * SEQ + qg) * 4 + (int)(e & 3u); }
                else { qg = j * MBLK + r32; dest = -1; } }
            attn_body::moba_chunk4<8>(Qb + ((size_t)b * SEQ + qg) * AW + h * HD, causal, dest, PO, PML, lds_generic);
        }
        pos += c1 - c0;
    }
    __syncthreads();
}
__device__ __forceinline__ void moba_combine_phase(Frame& F) {
    const bf16_t* PO = WSP(bf16_t, WS_PO); const f32x2* PML = WSP(f32x2, WS_PML); bf16_t* ATT = WSP(bf16_t, WS_ATT);
    for (size_t it = (size_t)F.bid * 512 + F.tid; it < (size_t)NB * NH * SEQ * 8; it += (size_t)F.G * 512) {
        const size_t r = it >> 3; const int ch = (int)(it & 7); const int bh = (int)(r / SEQ), qg = (int)(r % SEQ), b = bh >> 3, h = bh & 7;
        const f32x2 a0 = PML[r * 4 + 0], a1 = PML[r * 4 + 1], a2 = PML[r * 4 + 2], a3 = PML[r * 4 + 3];
        const float M = fmaxf(fmaxf(a0.x, a1.x), fmaxf(a2.x, a3.x));
        const float w0 = a0.y * __builtin_amdgcn_exp2f(a0.x - M), w1 = a1.y * __builtin_amdgcn_exp2f(a1.x - M), w2 = a2.y * __builtin_amdgcn_exp2f(a2.x - M), w3 = a3.y * __builtin_amdgcn_exp2f(a3.x - M);
        const float inv = 1.0f / (w0 + w1 + w2 + w3);
        float o[8] = {0.f, 0.f, 0.f, 0.f, 0.f, 0.f, 0.f, 0.f};
#define CMB(k, wk) if (wk > 0.f) { const u32x4 v = *(const u32x4*)(PO + (r * 4 + k) * 64 + ch * 8); o[0] += wk * bflo(v.x); o[1] += wk * bfhi(v.x); o[2] += wk * bflo(v.y); o[3] += wk * bfhi(v.y); o[4] += wk * bflo(v.z); o[5] += wk * bfhi(v.z); o[6] += wk * bflo(v.w); o[7] += wk * bfhi(v.w); }
        CMB(0, w0) CMB(1, w1) CMB(2, w2) CMB(3, w3)
#undef CMB
        u32x4 w; w.x = pk2(o[0] * inv, o[1] * inv); w.y = pk2(o[2] * inv, o[3] * inv); w.z = pk2(o[4] * inv, o[5] * inv); w.w = pk2(o[6] * inv, o[7] * inv);
        *(u32x4*)(ATT + ((size_t)b * SEQ + qg) * AW + h * HD + ch * 8) = w;
    }
}

__device__ __forceinline__ void phase_xattn_simple(Frame& F, bf16_t* Ob) {
    LAS unsigned* Ks = (LAS unsigned*)F.lds;
    LAS unsigned* Vs = (LAS unsigned*)(F.lds + 65536);
    const bf16_t *Qb = WSP(bf16_t, WS_XQ), *KV = WSP(bf16_t, WS_MKV);
    const int tl = F.tid >> 2, part = F.tid & 3;
    int lastbh = -1;
    for (int it = F.bid; it < NB * XH * (SEQ / 128); it += F.G) {
        const int bh = it / (SEQ / 128), ch = it % (SEQ / 128), b = bh / XH, h = bh % XH;
        if (bh != lastbh) { __syncthreads();
            for (int c = F.tid; c < 256 * 16; c += 512) { const int r = c >> 4, cc = c & 15;
                *(LAS u32x4*)(Ks + r * 64 + cc * 4) = *(const u32x4*)(KV + (size_t)(b * MEML + r) * (2 * XW) + h * XD + cc * 8);
                *(LAS u32x4*)(Vs + r * 64 + cc * 4) = *(const u32x4*)(KV + (size_t)(b * MEML + r) * (2 * XW) + XW + h * XD + cc * 8); }
            __syncthreads(); lastbh = bh; }
        const size_t row = (size_t)b * SEQ + ch * 128 + tl;
        float q[32];
        { const u32x4* qp = (const u32x4*)(Qb + row * XW + h * XD + part * 32);
#pragma unroll
          for (int c = 0; c < 4; ++c) { const u32x4 w = qp[c]; q[8 * c + 0] = bflo(w.x); q[8 * c + 1] = bfhi(w.x); q[8 * c + 2] = bflo(w.y); q[8 * c + 3] = bfhi(w.y); q[8 * c + 4] = bflo(w.z); q[8 * c + 5] = bfhi(w.z); q[8 * c + 6] = bflo(w.w); q[8 * c + 7] = bfhi(w.w); } }
        float mx = -3e38f, l = 0.f, o[32];
#pragma unroll
        for (int d = 0; d < 32; ++d) o[d] = 0.f;
        for (int kk = 0; kk < MEML; ++kk) { float s = 0.f;
#pragma unroll
            for (int c = 0; c < 4; ++c) { const u32x4 w = *(const LAS u32x4*)(Ks + kk * 64 + part * 16 + c * 4);
                s += q[8 * c + 0] * bflo(w.x) + q[8 * c + 1] * bfhi(w.x) + q[8 * c + 2] * bflo(w.y) + q[8 * c + 3] * bfhi(w.y) + q[8 * c + 4] * bflo(w.z) + q[8 * c + 5] * bfhi(w.z) + q[8 * c + 6] * bflo(w.w) + q[8 * c + 7] * bfhi(w.w); }
            s += __shfl_xor(s, 1); s += __shfl_xor(s, 2);
            const float mn = fmaxf(mx, s), corr = __builtin_amdgcn_exp2f(mx - mn), p = __builtin_amdgcn_exp2f(s - mn); mx = mn; l = l * corr + p;
#pragma unroll
            for (int c = 0; c < 4; ++c) { const u32x4 w = *(const LAS u32x4*)(Vs + kk * 64 + part * 16 + c * 4);
                o[8 * c + 0] = o[8 * c + 0] * corr + p * bflo(w.x); o[8 * c + 1] = o[8 * c + 1] * corr + p * bfhi(w.x); o[8 * c + 2] = o[8 * c + 2] * corr + p * bflo(w.y); o[8 * c + 3] = o[8 * c + 3] * corr + p * bfhi(w.y);
                o[8 * c + 4] = o[8 * c + 4] * corr + p * bflo(w.z); o[8 * c + 5] = o[8 * c + 5] * corr + p * bfhi(w.z); o[8 * c + 6] = o[8 * c + 6] * corr + p * bflo(w.w); o[8 * c + 7] = o[8 * c + 7] * corr + p * bfhi(w.w); } }
        const float il = 1.0f / l;
        u32x4* op = (u32x4*)(Ob + row * XW + h * XD + part * 32);
#pragma unroll
        for (int c = 0; c < 4; ++c) { u32x4 w; w.x = pk2(o[8 * c + 0] * il, o[8 * c + 1] * il); w.y = pk2(o[8 * c + 2] * il, o[8 * c + 3] * il); w.z = pk2(o[8 * c + 4] * il, o[8 * c + 5] * il); w.w = pk2(o[8 * c + 6] * il, o[8 * c + 7] * il); op[c] = w; }
    }
}

__device__ __forceinline__ void phase_router(Frame& F) {
    LAS float* wt = (LAS float*)F.lds;
    for (int c = F.tid; c < NE * DM; c += 512) { const int k = c >> 5, e = c & 31; wt[e * DM + k] = F.in[I_WROUTER][c] * F.in[I_GMOE][k]; }
    __syncthreads();
    const int gw = F.bid * 8 + F.wave, NGW = F.G * 8, lane = F.lane;
    const float* H = WSP(float, WS_H);
    unsigned* cnt = F.ctl + CW_CNT;
    for (int tk = gw; tk < T_; tk += NGW) {
        const f32x4* hp = (const f32x4*)(H + (size_t)tk * DM) + lane; f32x4 hv[4]; float ss = 0.f;
#pragma unroll
        for (int j = 0; j < 4; ++j) { hv[j] = hp[64 * j]; ss += (hv[j][0] * hv[j][0] + hv[j][1] * hv[j][1]) + (hv[j][2] * hv[j][2] + hv[j][3] * hv[j][3]); }
        const float rstd = 1.0f / sqrtf(wave_sum(ss) * (1.0f / DM) + RMS_EPS);
        float mylogit = 0.f;
#pragma unroll 4
        for (int e = 0; e < NE; ++e) { float a = 0.f;
#pragma unroll
            for (int j = 0; j < 4; ++j) { const f32x4 w = *(const LAS f32x4*)(wt + e * DM + 4 * lane + 256 * j); a += (hv[j][0] * w[0] + hv[j][1] * w[1]) + (hv[j][2] * w[2] + hv[j][3] * w[3]); }
            a = wave_sum(a);
            mylogit = (lane == e) ? a : mylogit; }
        mylogit = (lane < NE) ? (mylogit * rstd + F.in[I_BROUTER][lane & 31]) : -3e38f;
        float tv[4]; int ti[4]; float cur = mylogit;
#pragma unroll
        for (int s = 0; s < 4; ++s) { float bv = cur; int bi = lane;
#pragma unroll
            for (int o = 1; o < 64; o <<= 1) { const float ov = __shfl_xor(bv, o); const int oi = __shfl_xor(bi, o); if (ov > bv || (ov == bv && oi < bi)) { bv = ov; bi = oi; } }
            tv[s] = bv; ti[s] = bi; if (lane == bi) cur = -3e38f; }
        const float e1 = __expf(tv[1] - tv[0]), e2 = __expf(tv[2] - tv[0]), e3 = __expf(tv[3] - tv[0]); const float inv = 1.0f / (1.0f + e1 + e2 + e3);
        if (lane == 0) WSP(float, WS_RSTD2)[tk] = rstd;
        if (lane < 4) { const int ex = (lane == 0) ? ti[0] : (lane == 1) ? ti[1] : (lane == 2) ? ti[2] : ti[3]; const float gv = ((lane == 0) ? 1.0f : (lane == 1) ? e1 : (lane == 2) ? e2 : e3) * inv;
            WSP(float, WS_TKG)[(size_t)tk * 4 + lane] = gv;
            const unsigned rank = atomicAdd(&cnt[ex], 1u);
            WSP(int, WS_ROWLIST)[(size_t)ex * T_ + rank] = tk * 4 + lane; }
    }
}


constexpr int XA_VSTR = 520, XA_VT = 65536;
__device__ __forceinline__ bf16x8 pack8(const f32x16& s, int o) {
    u32x4 w; w.x = pg8::cvt_pk_bf16(s[o + 0], s[o + 1]); w.y = pg8::cvt_pk_bf16(s[o + 2], s[o + 3]); w.z = pg8::cvt_pk_bf16(s[o + 4], s[o + 5]); w.w = pg8::cvt_pk_bf16(s[o + 6], s[o + 7]);
    return __builtin_bit_cast(bf16x8, w);
}
__device__ __forceinline__ void phase_xattn(Frame& F) {
    LAS unsigned char* L = F.lds;
    const bf16_t *Qb = WSP(bf16_t, WS_XQ), *KV = WSP(bf16_t, WS_MKV); bf16_t* Ob = WSP(bf16_t, WS_XO);
    const int lane = F.lane, r32 = lane & 31, hi = lane >> 5, wid = F.wave;
    const int NU = NB * XH * (SEQ / 256), UPB = (NU + F.G - 1) / F.G;
    int lastbh = -1;
    for (int u = F.bid * UPB; u < NU && u < (F.bid + 1) * UPB; ++u) {
        const int bh = u >> 5, qb = u & 31, b = bh >> 2, h = bh & 3;
        if (bh != lastbh) {
            __syncthreads();
            for (int c = F.tid; c < 256 * 16; c += 512) { const int m = c >> 4, ch = c & 15; *(LAS u32x4*)(L + m * 256 + ((ch ^ (m & 15)) << 4)) = *(const u32x4*)(KV + (size_t)(b * MEML + m) * (2 * XW) + h * XD + ch * 8); }
            { const bf16_t* VTg = WSP(bf16_t, WS_MVT) + ((size_t)b * XW + h * XD) * MEML;
              for (int c = F.tid; c < 128 * 64; c += 512) { const int d = c >> 6, pc = c & 63; *(LAS u32x2*)(L + XA_VT + d * XA_VSTR + pc * 8) = *(const u32x2*)(VTg + (size_t)d * MEML + pc * 4); } }
            __syncthreads(); lastbh = bh; }
        const size_t row = (size_t)b * SEQ + qb * 256 + wid * 32 + r32;
        bf16x8 qf[8];
#pragma unroll
        for (int kd = 0; kd < 8; ++kd) qf[kd] = *(const bf16x8*)(Qb + row * XW + h * XD + 16 * kd + 8 * hi);
        f32x16 o[4];
#pragma unroll
        for (int dt = 0; dt < 4; ++dt)
#pragma unroll
            for (int r = 0; r < 16; ++r) o[dt][r] = 0.f;
        float mrun = -1e30f, lrun = 0.f;
#pragma unroll 1
        for (int c = 0; c < 4; ++c) {
            f32x16 s0, s1;
#pragma unroll
            for (int r = 0; r < 16; ++r) { s0[r] = 0.f; s1[r] = 0.f; }
            const int kv0 = c * 64 + r32, kv1 = kv0 + 32;
#pragma unroll
            for (int kd = 0; kd < 8; ++kd) { const int ch = 2 * kd + hi;
                const bf16x8 k0 = *(const LAS bf16x8*)(L + kv0 * 256 + ((ch ^ (kv0 & 15)) << 4)), k1 = *(const LAS bf16x8*)(L + kv1 * 256 + ((ch ^ (kv1 & 15)) << 4));
                s0 = __builtin_amdgcn_mfma_f32_32x32x16_bf16(k0, qf[kd], s0, 0, 0, 0); s1 = __builtin_amdgcn_mfma_f32_32x32x16_bf16(k1, qf[kd], s1, 0, 0, 0); }
            float mx = fmaxf(s0[0], s1[0]);
#pragma unroll
            for (int r = 1; r < 16; ++r) mx = fmaxf(mx, fmaxf(s0[r], s1[r]));
            mx = fmaxf(mx, __shfl_xor(mx, 32));
            const float mn = fmaxf(mrun, mx), sc = __builtin_amdgcn_exp2f(mrun - mn); mrun = mn;
            float ls = 0.f;
#pragma unroll
            for (int r = 0; r < 16; ++r) { s0[r] = __builtin_amdgcn_exp2f(s0[r] - mn); s1[r] = __builtin_amdgcn_exp2f(s1[r] - mn); ls += s0[r] + s1[r]; }
            ls += __shfl_xor(ls, 32); lrun = lrun * sc + ls;
#pragma unroll
            for (int dt = 0; dt < 4; ++dt)
#pragma unroll
                for (int r = 0; r < 16; ++r) o[dt][r] *= sc;
            bf16x8 pf[4]; pf[0] = pack8(s0, 0); pf[1] = pack8(s0, 8); pf[2] = pack8(s1, 0); pf[3] = pack8(s1, 8);
#pragma unroll
            for (int dt = 0; dt < 4; ++dt)
#pragma unroll
                for (int ks = 0; ks < 4; ++ks) { const LAS unsigned char* vp = L + XA_VT + (dt * 32 + r32) * XA_VSTR + (c * 64 + 16 * ks + 4 * hi) * 2;
                    const u32x2 lo = *(const LAS u32x2*)vp, hh = *(const LAS u32x2*)(vp + 16); u32x4 w; w.x = lo.x; w.y = lo.y; w.z = hh.x; w.w = hh.y;
                    o[dt] = __builtin_amdgcn_mfma_f32_32x32x16_bf16(__builtin_bit_cast(bf16x8, w), pf[ks], o[dt], 0, 0, 0); }
        }
        const float il = 1.0f / lrun;
        bf16_t* op = Ob + row * XW + h * XD + 4 * hi;
#pragma unroll
        for (int dt = 0; dt < 4; ++dt)
#pragma unroll
            for (int g4 = 0; g4 < 4; ++g4) { u32x2 w; w.x = pg8::cvt_pk_bf16(o[dt][4 * g4] * il, o[dt][4 * g4 + 1] * il); w.y = pg8::cvt_pk_bf16(o[dt][4 * g4 + 2] * il, o[dt][4 * g4 + 3] * il);
                *(u32x2*)(op + dt * 32 + 8 * g4) = w; }
    }
    __syncthreads();
}

constexpr int RT_WSTR = 1028, RT_LG = NE * RT_WSTR * 4  , RT_LCNT = RT_LG + 8 * 16 * 33 * 4  , RT_LBASE = RT_LCNT + 128, RT_RS = RT_LBASE + 128  ;
__device__ __forceinline__ void phase_router_mfma(Frame& F) {
    LAS float* wt = (LAS float*)F.lds;
    __syncthreads();
    for (int c = F.tid; c < NE * DM; c += 512) { const int k = c >> 5, e = c & 31; wt[e * RT_WSTR + k] = F.in[I_WROUTER][c] * F.in[I_GMOE][k]; }
    LAS unsigned* lcnt = (LAS unsigned*)(F.lds + RT_LCNT); LAS unsigned* lbase = (LAS unsigned*)(F.lds + RT_LBASE);
    const int lane = F.lane, wid = F.wave, row = lane & 15, kq = lane >> 4;
    LAS float* lg = (LAS float*)(F.lds + RT_LG) + wid * (16 * 33); LAS float* rsl = (LAS float*)(F.lds + RT_RS) + wid * 16;
    const bf16_t* HBp = WSP(bf16_t, WS_HB); bf16_t* N2 = WSP(bf16_t, WS_N2B); unsigned* cnt = F.ctl + CW_CNT;
    for (int chunk = F.bid; chunk < T_ / 128; chunk += F.G) {
        if (F.tid < 32) lcnt[F.tid] = 0u;
        __syncthreads();
        const int tok0 = chunk * 128 + wid * 16;
        f32x4 acc0 = {0.f, 0.f, 0.f, 0.f}, acc1 = {0.f, 0.f, 0.f, 0.f}; float ss = 0.f;
        const bf16_t* hp = HBp + (size_t)(tok0 + row) * DM + 8 * kq;
        const LAS float* w0 = wt + row * RT_WSTR + 8 * kq; const LAS float* w1 = w0 + 16 * RT_WSTR;
#pragma unroll 4
        for (int i = 0; i < 32; ++i) { const u32x4 hw = *(const u32x4*)(hp + 32 * i);
            const float a[8] = {bflo(hw.x), bfhi(hw.x), bflo(hw.y), bfhi(hw.y), bflo(hw.z), bfhi(hw.z), bflo(hw.w), bfhi(hw.w)};
            const f32x4 b00 = *(const LAS f32x4*)(w0 + 32 * i), b01 = *(const LAS f32x4*)(w0 + 32 * i + 4), b10 = *(const LAS f32x4*)(w1 + 32 * i), b11 = *(const LAS f32x4*)(w1 + 32 * i + 4);
#pragma unroll
            for (int e = 0; e < 8; ++e) ss += a[e] * a[e];
#pragma unroll
            for (int e = 0; e < 4; ++e) { acc0 = __builtin_amdgcn_mfma_f32_16x16x4f32(a[e], b00[e], acc0, 0, 0, 0); acc1 = __builtin_amdgcn_mfma_f32_16x16x4f32(a[e], b10[e], acc1, 0, 0, 0); }
#pragma unroll
            for (int e = 0; e < 4; ++e) { acc0 = __builtin_amdgcn_mfma_f32_16x16x4f32(a[4 + e], b01[e], acc0, 0, 0, 0); acc1 = __builtin_amdgcn_mfma_f32_16x16x4f32(a[4 + e], b11[e], acc1, 0, 0, 0); } }
        ss += __shfl_xor(ss, 16); ss += __shfl_xor(ss, 32);
        const float rstd = 1.0f / sqrtf(ss * (1.0f / DM) + RMS_EPS);
#pragma unroll
        for (int r = 0; r < 4; ++r) { lg[(4 * kq + r) * 33 + row] = acc0[r]; lg[(4 * kq + r) * 33 + 16 + row] = acc1[r]; }
        if (lane < 16) rsl[lane] = rstd;
        asm volatile("s_waitcnt lgkmcnt(0)" ::: "memory");
#pragma unroll 4
        for (int t = 0; t < 16; ++t) { const float rs = rsl[t]; const u32x4* src = (const u32x4*)(HBp + (size_t)(tok0 + t) * DM) + lane; u32x4* dst = (u32x4*)(N2 + (size_t)(tok0 + t) * DM) + lane;
#pragma unroll
            for (int hh = 0; hh < 2; ++hh) { const u32x4 w = src[64 * hh]; u32x4 o; o.x = pk2(bflo(w.x) * rs, bfhi(w.x) * rs); o.y = pk2(bflo(w.y) * rs, bfhi(w.y) * rs); o.z = pk2(bflo(w.z) * rs, bfhi(w.z) * rs); o.w = pk2(bflo(w.w) * rs, bfhi(w.w) * rs); dst[64 * hh] = o; } }
        int ex[4] = {0, 0, 0, 0}; unsigned lrank[4] = {0u, 0u, 0u, 0u}; const int tk = tok0 + lane;
        if (lane < 16) {
            float v[32];
#pragma unroll
            for (int e = 0; e < 32; ++e) v[e] = lg[lane * 33 + e] * rstd + F.in[I_BROUTER][e];
            float tv[4];
#pragma unroll
            for (int s = 0; s < 4; ++s) { float bv = v[0]; int bi = 0;
#pragma unroll
                for (int e = 1; e < 32; ++e) if (v[e] > bv) { bv = v[e]; bi = e; }
#pragma unroll
                for (int e = 0; e < 32; ++e) v[e] = (e == bi) ? -3e38f : v[e];
                tv[s] = bv; ex[s] = bi; }
            const float e1 = __expf(tv[1] - tv[0]), e2 = __expf(tv[2] - tv[0]), e3 = __expf(tv[3] - tv[0]); const float inv = 1.0f / (1.0f + e1 + e2 + e3);
            *(f32x4*)(WSP(float, WS_TKG) + (size_t)tk * 4) = (f32x4){inv, e1 * inv, e2 * inv, e3 * inv};
#pragma unroll
            for (int s = 0; s < 4; ++s) lrank[s] = __hip_atomic_fetch_add(&lcnt[ex[s]], 1u, __ATOMIC_RELAXED, __HIP_MEMORY_SCOPE_WORKGROUP);
        }
        __syncthreads();
        if (F.tid < 32) lbase[F.tid] = atomicAdd(&cnt[F.tid], lcnt[F.tid]);
        __syncthreads();
        if (lane < 16) {
#pragma unroll
            for (int s = 0; s < 4; ++s) WSP(int, WS_ROWLIST)[(size_t)ex[s] * T_ + lbase[ex[s]] + lrank[s]] = tk * 4 + s; }
        __syncthreads();
    }
}

struct FinRegs { u32x2 hw[2][4]; u32x2 yw[2][4][4]; };
__device__ __forceinline__ void fin_load(const bf16_t* HBf, const bf16_t* Y, int tk, FinRegs& R, int lane) {
#pragma unroll
    for (int t = 0; t < 2; ++t) {
#pragma unroll
        for (int j = 0; j < 4; ++j) { R.hw[t][j] = ((const u32x2*)(HBf + (size_t)(tk + t) * DM))[lane + 64 * j];
#pragma unroll
            for (int s = 0; s < 4; ++s) R.yw[t][s][j] = ((const u32x2*)(Y + ((size_t)(tk + t) * 4 + s) * DM))[lane + 64 * j]; } }
}
template <int FEXP> __device__ __forceinline__ void fin_finish(Frame& F, int tk, const FinRegs& R, const f32x4 (&gf)[4], int lane) {
#pragma unroll
    for (int t = 0; t < 2; ++t) { f32x4 hv[4]; float ss = 0.f;
#pragma unroll
        for (int j = 0; j < 4; ++j) { const u32x2 w = R.hw[t][j]; hv[j] = (f32x4){bflo(w.x), bfhi(w.x), bflo(w.y), bfhi(w.y)};
#pragma unroll
            for (int s = 0; s < 4; ++s) { const u32x2 y = R.yw[t][s][j]; hv[j][0] += bflo(y.x); hv[j][1] += bfhi(y.x); hv[j][2] += bflo(y.y); hv[j][3] += bfhi(y.y); }
            ss += (hv[j][0] * hv[j][0] + hv[j][1] * hv[j][1]) + (hv[j][2] * hv[j][2] + hv[j][3] * hv[j][3]); }
        float rstd = 1.0f / sqrtf(wave_sum(ss) * (1.0f / DM) + RMS_EPS);
#if DBG_STAGE
        { const float sd = __hip_atomic_load((float*)(F.ctl + CW_DBG), RLX_AGENT), sr = __hip_atomic_load((float*)(F.ctl + CW_DBG + 1), RLX_AGENT); rstd *= 1.0f + sqrtf(100.0f * sd / fmaxf(sr, 1e-30f)); }
#endif
        f32x4* op = (f32x4*)(((FEXP == 3) ? WSP(float, WS_PO) : F.out) + (size_t)(tk + t) * DM) + lane;
        if (FEXP == 1) { asm volatile("" :: "v"(hv[0][0] * rstd), "v"(hv[3][3] * rstd)); }
        else {
#pragma unroll
            for (int j = 0; j < 4; ++j) op[64 * j] = hv[j] * rstd * gf[j]; } }
}
template <int FEXP> __device__ __forceinline__ void phase_final_t(Frame& F) {
    const int gw = F.bid * 8 + F.wave, NGW = F.G * 8, lane = F.lane;
    const bf16_t* HBf = WSP(bf16_t, WS_HB); const bf16_t* Y = WSP(bf16_t, WS_Y);
    f32x4 gf[4];
#pragma unroll
    for (int j = 0; j < 4; ++j) gf[j] = ((const f32x4*)F.in[I_GFINAL])[lane + 64 * j];
    FinRegs ra, rb; const int step = NGW * 2, t0 = gw * 2, n = (t0 < T_) ? (T_ - t0 + step - 1) / step : 0;
    if (n > 0) { fin_load(HBf, Y, t0, ra, lane); int i = 0;
        for (; i + 2 <= n; i += 2) {
            fin_load(HBf, Y, t0 + (i + 1) * step, rb, lane);
            fin_finish<FEXP>(F, t0 + i * step, ra, gf, lane);
            fin_load(HBf, Y, t0 + min(i + 2, n - 1) * step, ra, lane);
            fin_finish<FEXP>(F, t0 + (i + 1) * step, rb, gf, lane); }
        if (i < n) fin_finish<FEXP>(F, t0 + i * step, ra, gf, lane); }
}
__device__ __forceinline__ void phase_final(Frame& F) { phase_final_t<0>(F); }

__device__ __forceinline__ void dbg_compare(Frame& F, const bf16_t* A, const bf16_t* R, size_t n) {
    float sd = 0.f, sr = 0.f;
    for (size_t i = (size_t)F.bid * 512 + F.tid; i < n; i += (size_t)F.G * 512) { const float a = bf2f(A[i]), r = bf2f(R[i]); sd += (a - r) * (a - r); sr += r * r; }
    sd = wave_sum(sd); sr = wave_sum(sr);
    if (F.lane == 0) { atomicAdd((float*)(F.ctl + CW_DBG), sd); atomicAdd((float*)(F.ctl + CW_DBG + 1), sr); }
}
constexpr int N_PHASES = 15;
__global__ void __launch_bounds__(512, 2) mega_fwd(Args args) {
    extern __shared__ __attribute__((aligned(16))) unsigned char lds_raw[];
    Frame F;
    F.lds = (LAS unsigned char*)lds_raw; F.tid = threadIdx.x; F.lane = F.tid & 63; F.wave = __builtin_amdgcn_readfirstlane(F.tid >> 6); F.G = gridDim.x; F.bid = blockIdx.x;
#pragma unroll
    for (int i = 0; i < 28; ++i) F.in[i] = args.in[i];
    F.out = args.out; F.ws = args.ws; F.ctl = (unsigned*)(args.ws + WS_CTL);
    volatile LAS unsigned* MISC = (volatile LAS unsigned*)(F.lds + MISC_OFF);
    if (F.tid < 64) MISC[F.tid] = 0u;
    __syncthreads();
    const int lo = args.ph_lo, hi = args.ph_hi;
    XcdBarrier bar; bar.bar = F.ctl + CW_BAR; bar.x = 0; bar.st = nullptr;
    if (hi - lo > 1) bar = xcd_barrier_post(F.ctl + CW_BAR, MISC + 8);
#define IN(k) (lo <= (k) && (k) < hi)
#define SEAM(k) do { if (IN(k) && IN((k) + 1)) xcd_barrier(bar); } while (0)
    LAS unsigned char* ring = F.lds;
    const LAS int* gidx = (const LAS int*)(F.lds + GIDX_OFF);

    if (IN(0)) for (int rep_ = 0; rep_ <= ((REP_MASK >> 0) & 1) * REP_EXTRA; ++rep_) { if (rep_) xcd_barrier(bar);  for (int tk = F.bid; tk < NG * 8; tk += F.G) p0_ssm_tables(F, tk); phase_prologue(F); } SEAM(0);
    if (IN(1)) for (int rep_ = 0; rep_ <= ((REP_MASK >> 1) & 1) * REP_EXTRA; ++rep_) { if (rep_) xcd_barrier(bar);
        { pg8::Gemm g{WSP(bf16_t, WS_XB), WSP(bf16_t, WS_WIN), DM, 0}; pg8::PatchOrder S; S.init(T_ / 256, INW / 256, 8, F.G, F.bid);
          pg8::EpiInProj E{WSP(bf16_t, WS_Q), WSP(bf16_t, WS_K), WSP(bf16_t, WS_V), WSP(bf16_t, WS_U), WSP(bf16_t, WS_SGA), WSP(bf16_t, WS_SGB), WSP(float, WS_KM2)};
          pg8::gemm_phase<pg8::EpiInProj, pg8::PatchOrder, false>(ring, g, S, E, gidx, STG_TICKS);
#if NULL_EXP == 1
          { pg8::EpiNull EN; pg8::gemm_phase<pg8::EpiNull, pg8::PatchOrder, false>(ring, g, S, EN, gidx); pg8::gemm_phase<pg8::EpiNull, pg8::PatchOrder, false>(ring, g, S, EN, gidx); }
#elif NULL_EXP == 5
          { pg8::EpiStoreExp<false> EN{WSP(bf16_t, WS_N2B)}; pg8::gemm_phase<pg8::EpiStoreExp<false>, pg8::PatchOrder, false>(ring, g, S, EN, gidx); pg8::gemm_phase<pg8::EpiStoreExp<false>, pg8::PatchOrder, false>(ring, g, S, EN, gidx); }
#elif NULL_EXP == 6
          { pg8::EpiStoreExp<true> EN{WSP(bf16_t, WS_N2B)}; pg8::gemm_phase<pg8::EpiStoreExp<true>, pg8::PatchOrder, false>(ring, g, S, EN, gidx); pg8::gemm_phase<pg8::EpiStoreExp<true>, pg8::PatchOrder, false>(ring, g, S, EN, gidx); }
#elif NULL_EXP == 3
          { pg8::EpiInProjT<1> EN{E.Q, E.Kb, E.V, E.U, E.SGA, E.SGB, E.KM2}; pg8::gemm_phase<pg8::EpiInProjT<1>, pg8::PatchOrder, false>(ring, g, S, EN, gidx); pg8::gemm_phase<pg8::EpiInProjT<1>, pg8::PatchOrder, false>(ring, g, S, EN, gidx); }
#elif NULL_EXP == 4
          { pg8::EpiInProjT<2> EN{E.Q, E.Kb, E.V, E.U, E.SGA, E.SGB, E.KM2}; pg8::gemm_phase<pg8::EpiInProjT<2>, pg8::PatchOrder, false>(ring, g, S, EN, gidx); pg8::gemm_phase<pg8::EpiInProjT<2>, pg8::PatchOrder, false>(ring, g, S, EN, gidx); }
#endif
          }
        { pg8::Gemm g{WSP(bf16_t, WS_MN), WSP(bf16_t, WS_WXKV), DM, 0}; pg8::PatchOrder S; S.init(NB * MEML / 256, 2 * XW / 256, 4, F.G, F.bid);
          pg8::EpiMemKV E{WSP(bf16_t, WS_MKV), WSP(bf16_t, WS_MVT)};
          pg8::gemm_phase<pg8::EpiMemKV, pg8::PatchOrder, false>(ring, g, S, E, gidx); }
    } SEAM(1);
    if (IN(2)) for (int rep_ = 0; rep_ <= ((REP_MASK >> 2) & 1) * REP_EXTRA; ++rep_) { if (rep_) { xcd_barrier(bar); if (F.tid < 4) { for (int k_ = F.tid; k_ < 1024; k_ += 4) __hip_atomic_store(F.ctl + CW_MCNT + k_, 0u, RLX_AGENT); } __syncthreads(); xcd_barrier(bar); }
        for (int it = F.bid; it < NB * NG * 2; it += F.G) ssm_state_item(F, (it >> 1) / NG, (it >> 1) % NG, it & 1);
        for (int it = F.bid; it < NB * NH * NBLK; it += F.G) moba_route_item(F, it / NBLK, (NBLK - 1) - (it % NBLK));
    } SEAM(2);
    if (IN(3)) for (int rep_ = 0; rep_ <= ((REP_MASK >> 3) & 1) * REP_EXTRA; ++rep_) { if (rep_) xcd_barrier(bar);
        { int t_ = threadIdx.x; asm volatile("" : "+v"(t_)); F.tid = t_; F.lane = t_ & 63; F.wave = __builtin_amdgcn_readfirstlane(t_ >> 6); }
        moba_sparse_phase<0>(F, (char*)lds_raw);
#if MOBA_EXP == 1
        moba_sparse_phase<1>(F, (char*)lds_raw); moba_sparse_phase<1>(F, (char*)lds_raw);
#endif
        { int t_ = threadIdx.x; asm volatile("" : "+v"(t_)); F.tid = t_; F.lane = t_ & 63; F.wave = __builtin_amdgcn_readfirstlane(t_ >> 6); }
        phase_ssm_out(F);
    } SEAM(3);
#if DBG_STAGE == 1 || DBG_STAGE == 2
    moba_combine_phase(F); xcd_barrier(bar);
#endif
#if DBG_STAGE == 1
    phase_ssm_simple(F, WSP(bf16_t, WS_MERGED)); xcd_barrier(bar); dbg_compare(F, WSP(bf16_t, WS_YB), WSP(bf16_t, WS_MERGED), (size_t)T_ * SW); xcd_barrier(bar);
#elif DBG_STAGE == 2
    phase_moba_simple(F, WSP(bf16_t, WS_MERGED)); xcd_barrier(bar); dbg_compare(F, WSP(bf16_t, WS_ATT), WSP(bf16_t, WS_MERGED), (size_t)T_ * AW); xcd_barrier(bar);
#endif
    if (IN(5)) for (int rep_ = 0; rep_ <= ((REP_MASK >> 5) & 1) * REP_EXTRA; ++rep_) { if (rep_) xcd_barrier(bar);
#if !(DBG_STAGE == 1 || DBG_STAGE == 2)
        moba_combine_phase(F);
#endif
        pg8::Gemm g{WSP(bf16_t, WS_YB), WSP(bf16_t, WS_WGLU), SW, 0};
        pg8::EpiGlu E{WSP(bf16_t, WS_SGB), WSP(bf16_t, WS_YB2S)};
        if (F.G == 256) { pg8::PairOrder S; S.init(F.bid, 0); pg8::gemm_phase<pg8::EpiGlu, pg8::PairOrder, false>(ring, g, S, E, gidx); }
        else { pg8::PatchOrder S; S.init(T_ / 256, 2 * DM / 256, 8, F.G, F.bid); pg8::gemm_phase<pg8::EpiGlu, pg8::PatchOrder, false>(ring, g, S, E, gidx); }
    } if (F.G != 256) SEAM(5);
    if (IN(6)) for (int rep_ = 0; rep_ <= ((REP_MASK >> 6) & 1) * REP_EXTRA; ++rep_) { if (rep_) xcd_barrier(bar);
        pg8::Gemm g{WSP(bf16_t, WS_ATT), WSP(bf16_t, WS_WPA), AW, 0};
        pg8::EpiMerge E{WSP(bf16_t, WS_SGA), WSP(bf16_t, WS_YB2S), WSP(bf16_t, WS_MERGED)};
        if (F.G == 256) { pg8::PairOrder S; S.init(F.bid, 1); pg8::gemm_phase<pg8::EpiMerge, pg8::PairOrder, false>(ring, g, S, E, gidx); }
        else { pg8::PatchOrder S; S.init(T_ / 256, DM / 256, 4, F.G, F.bid); pg8::gemm_phase<pg8::EpiMerge, pg8::PatchOrder, false>(ring, g, S, E, gidx); }
    } SEAM(6);
    if (IN(7)) for (int rep_ = 0; rep_ <= ((REP_MASK >> 7) & 1) * REP_EXTRA; ++rep_) { if (rep_) xcd_barrier(bar);
        pg8::Gemm g{WSP(bf16_t, WS_MERGED), WSP(bf16_t, WS_WOUT), DM, 0}; pg8::PatchOrder S; S.init(T_ / 256, DM / 256, 4, F.G, F.bid);
        pg8::EpiResidT<true> E{F.in[I_X], WSP(bf16_t, WS_HB), WSP(float, WS_SSQ1)};
        pg8::gemm_phase<pg8::EpiResidT<true>, pg8::PatchOrder, false>(ring, g, S, E, gidx);
    } SEAM(7);
    if (IN(8)) for (int rep_ = 0; rep_ <= ((REP_MASK >> 8) & 1) * REP_EXTRA; ++rep_) { if (rep_) xcd_barrier(bar);
        pg8::Gemm g{WSP(bf16_t, WS_HB), WSP(bf16_t, WS_WXQ), DM, 0}; pg8::PatchOrder S; S.init(T_ / 256, XW / 256, 2, F.G, F.bid);
        pg8::EpiXq E{WSP(float, WS_SSQ1), WSP(bf16_t, WS_XQ)};
        pg8::gemm_phase<pg8::EpiXq, pg8::PatchOrder, false>(ring, g, S, E, gidx);
    } SEAM(8);
    if (IN(9)) for (int rep_ = 0; rep_ <= ((REP_MASK >> 9) & 1) * REP_EXTRA; ++rep_) { if (rep_) xcd_barrier(bar);  phase_xattn(F); } SEAM(9);
#if DBG_STAGE == 3
    phase_xattn_simple(F, WSP(bf16_t, WS_MERGED)); xcd_barrier(bar); dbg_compare(F, WSP(bf16_t, WS_XO), WSP(bf16_t, WS_MERGED), (size_t)T_ * XW); xcd_barrier(bar);
#endif
    if (IN(10)) for (int rep_ = 0; rep_ <= ((REP_MASK >> 10) & 1) * REP_EXTRA; ++rep_) { if (rep_) xcd_barrier(bar);
        pg8::Gemm g{WSP(bf16_t, WS_XO), WSP(bf16_t, WS_WXO), XW, 0}; pg8::PatchOrder S; S.init(T_ / 256, DM / 256, 4, F.G, F.bid);
        pg8::EpiResidT<false> E{nullptr, WSP(bf16_t, WS_HB), nullptr};
        pg8::gemm_phase<pg8::EpiResidT<false>, pg8::PatchOrder, false>(ring, g, S, E, gidx);
    } SEAM(10);
    if (IN(11)) for (int rep_ = 0; rep_ <= ((REP_MASK >> 11) & 1) * REP_EXTRA; ++rep_) { if (rep_) xcd_barrier(bar);  phase_router_mfma(F);
#if OUT_TOUCH
        { const int gw = F.bid * 8 + F.wave, NGW = F.G * 8;
          for (int tk = gw * 2; tk < T_; tk += NGW * 2) { if (F.lane < 2) { const float v = __builtin_nontemporal_load(F.out + (size_t)(tk + F.lane) * DM); asm volatile("" :: "v"(v)); } } }
#endif
    } SEAM(11);
    if (IN(12) || IN(13)) {
        LAS int* pref = (LAS int*)(F.lds + MISC_OFF + 256);
        const unsigned* cnt = F.ctl + CW_CNT;
        __syncthreads();
        if (F.tid == 0) { int a = 0; for (int e = 0; e < NE; ++e) { pref[e] = a; a += ((int)__hip_atomic_load(cnt + e, RLX_AGENT) + 255) >> 8; } pref[NE] = a; }
        __syncthreads();
        const int MT = pref[NE];
        if (IN(12)) for (int rep_ = 0; rep_ <= ((REP_MASK >> 12) & 1) * REP_EXTRA; ++rep_) { if (rep_) xcd_barrier(bar);
            MoeOrder S; S.P.init(MT, 2 * DFF / 256, 8, F.G, F.bid); S.pref = pref; S.rev = 0;
            { LAS int* gw_ = (LAS int*)(F.lds + GIDX_OFF); pg8::Unit u;
              for (int i = 0; i < GIDX_UNITS && S.next(i, u); ++i) { const int ce = (int)__hip_atomic_load(cnt + u.e, RLX_AGENT);
                  if (F.tid < 256) { const int rank = u.mi * 256 + F.tid; gw_[i * 256 + F.tid] = (rank < ce) ? (WSP(int, WS_ROWLIST)[(size_t)u.e * T_ + rank] >> 2) : 0; } } }
            __syncthreads();
            pg8::Gemm g{WSP(bf16_t, WS_N2B), WSP(bf16_t, WS_WGU), DM, (size_t)2 * DFF * DM};
            pg8::EpiMoe1 E{F.in[I_BGU], WSP(bf16_t, WS_HID)};
            pg8::gemm_phase<pg8::EpiMoe1, MoeOrder, true>(ring, g, S, E, gidx, STG_TICKS);
#if NULL_EXP == 2
            { pg8::EpiNull EN; pg8::gemm_phase<pg8::EpiNull, MoeOrder, true>(ring, g, S, EN, gidx); }
#endif
        }
        SEAM(12);
        if (IN(13)) for (int rep_ = 0; rep_ <= ((REP_MASK >> 13) & 1) * REP_EXTRA; ++rep_) { if (rep_) xcd_barrier(bar);
            MoeOrder S; S.P.init(MT, DM / 256, 4, F.G, F.bid); S.pref = pref; S.rev = 1;
            pg8::Gemm g{WSP(bf16_t, WS_HID), WSP(bf16_t, WS_WDN), DFF, (size_t)DM * DFF};
            { LAS int* tD = (LAS int*)(F.lds + GIDX_OFF); LAS float* tG = (LAS float*)(F.lds + GIDX_OFF + 12 * 1024); pg8::Unit u;
              __syncthreads();
              for (int i = 0; i < 12 && S.next(i, u); ++i) { const int ce = (int)__hip_atomic_load(cnt + u.e, RLX_AGENT);
                  if (F.tid < 256) { const int rank = u.mi * 256 + F.tid; int d = -1; float gv = 0.f; if (rank < ce) { d = WSP(int, WS_ROWLIST)[(size_t)u.e * T_ + rank]; gv = WSP(float, WS_TKG)[d]; } tD[i * 256 + F.tid] = d; tG[i * 256 + F.tid] = gv; } }
              __syncthreads(); }
            pg8::EpiMoe2 E{F.in[I_BDN], (const LAS int*)(F.lds + GIDX_OFF), (const LAS float*)(F.lds + GIDX_OFF + 12 * 1024), WSP(bf16_t, WS_Y)};
            pg8::gemm_phase<pg8::EpiMoe2, MoeOrder, false>(ring, g, S, E, gidx, STG_TICKS);
        }
    } SEAM(13);
#if BAR_EXP
    for (int k_ = 0; k_ < 20; ++k_) xcd_barrier(bar);
#endif
    if (IN(14)) for (int rep_ = 0; rep_ <= ((REP_MASK >> 14) & 1) * REP_EXTRA; ++rep_) { if (rep_) xcd_barrier(bar);  phase_final(F);
#if FINAL_EXP
        phase_final_t<FINAL_EXP>(F); phase_final_t<FINAL_EXP>(F);
#endif
    }
#undef IN
#undef SEAM
}

extern "C" void kernel_launch(void* const* d_in, const int* in_sizes, int n_in, void* d_out, int out_size, void* d_ws, size_t ws_size, hipStream_t stream) {
    static int grid = 0;
    if (grid == 0) {
        if (n_in != 28 || in_sizes[0] != T_ * DM || out_size != T_ * DM || ws_size < WS_END) { fprintf(stderr, "kernel_launch: unexpected shapes (n_in %d, in0 %d, out %d, ws %zu)\n", n_in, n_in > 0 ? in_sizes[0] : -1, out_size, ws_size); grid = -1; return; }
        int dev = 0, cus = 0;
        if (hipGetDevice(&dev) != hipSuccess || hipDeviceGetAttribute(&cus, hipDeviceAttributeMultiprocessorCount, dev) != hipSuccess) { grid = -1; return; }
        if (hipFuncSetAttribute((const void*)mega_fwd, hipFuncAttributeMaxDynamicSharedMemorySize, LDS_BYTES) != hipSuccess) { fprintf(stderr, "kernel_launch: hipFuncSetAttribute failed\n"); grid = -1; return; }
        (void)hipGetLastError();
        grid = cus;
    }
    if (grid < 0) return;
    (void)hipMemsetAsync((char*)d_ws + WS_CTL, 0, CTL_ZERO_BYTES, stream);
    Args a{};
    for (int i = 0; i < 28; ++i) a.in[i] = (const float*)d_in[i];
    a.out = (float*)d_out; a.ws = (unsigned char*)d_ws;
#if MK_N_LAUNCHES == 1
    a.ph_lo = 0; a.ph_hi = N_PHASES;
    hipLaunchKernelGGL(mega_fwd, dim3(grid), dim3(512), LDS_BYTES, stream, a);
#else
    for (int p = 0; p < N_PHASES; ++p) { a.ph_lo = p; a.ph_hi = p + 1; hipLaunchKernelGGL(mega_fwd, dim3(grid), dim3(512), LDS_BYTES, stream, a); }
#endif
}
```

```cpp
#include <hip/hip_runtime.h>
#include <hip/hip_bf16.h>
#include <cmath>
#include <cstdio>
#include <cstdint>

#ifndef MK_N_LAUNCHES
#define MK_N_LAUNCHES 1
#endif

#ifndef REP_EXTRA
#define REP_EXTRA 1
#endif
#ifndef NULL_EXP
#define NULL_EXP 0
#endif
#ifndef STG_TICKS
#define STG_TICKS 0
#endif
#ifndef MOBA_EXP
#define MOBA_EXP 0
#endif
#ifndef OUT_NT
#define OUT_NT 0
#endif
#ifndef OUT_TOUCH
#define OUT_TOUCH 0
#endif
#ifndef BAR_EXP
#define BAR_EXP 0
#endif
#ifndef FINAL_EXP
#define FINAL_EXP 0
#endif
#ifndef REP_MASK
#define REP_MASK 0
#endif
#ifndef DBG_STAGE
#define DBG_STAGE 0
#endif

#define GAS __attribute__((address_space(1)))
#define LAS __attribute__((address_space(3)))
typedef unsigned short bf16_t;
typedef short bf16x8 __attribute__((ext_vector_type(8)));
typedef float f32x4 __attribute__((ext_vector_type(4)));
typedef float f32x2 __attribute__((ext_vector_type(2)));
typedef float f32x16 __attribute__((ext_vector_type(16)));
typedef unsigned u32x4 __attribute__((ext_vector_type(4)));
typedef unsigned u32x2 __attribute__((ext_vector_type(2)));

constexpr int NB = 4, SEQ = 8192, DM = 1024, T_ = NB * SEQ;
constexpr int AW = 512, NH = 8, HD = 64, MBLK = 256, NBLK = SEQ / MBLK, MTOPK = 3;
constexpr int SW = 512, SGC = 16, NG = 32, SP = 64;
constexpr int INW = 4096;
constexpr int MEML = 256, XH = 4, XD = 128, XW = 512;
constexpr int NE = 32, ETOPK = 4, DFF = 1024;
constexpr float RMS_EPS = 1e-6f;
constexpr float LOG2E = 1.4426950408889634f;
constexpr float QSCALE = 0.125f * LOG2E;
constexpr float XSCALE = 0.08838834764831845f * LOG2E;
constexpr int HID_ROWS = ETOPK * T_ + NE * 256;

constexpr size_t MiB = 1u << 20;
constexpr size_t WS_WIN = 0 * MiB, WS_WGLU = 8 * MiB, WS_WPA = 10 * MiB, WS_WOUT = 11 * MiB, WS_WXQ = 13 * MiB, WS_WXKV = 14 * MiB, WS_WXO = 16 * MiB,
                 WS_WGU = 17 * MiB, WS_WDN = 145 * MiB;
constexpr size_t WS_CTL = 209 * MiB, CTL_ZERO_BYTES = 1 * MiB;
constexpr size_t WS_RSTD0 = 210 * MiB;
constexpr size_t WS_RSTD2 = WS_RSTD0 + 128 * 1024;
constexpr size_t WS_KMEAN = WS_RSTD2 + 128 * 1024;
constexpr size_t WS_KM2 = WS_KMEAN;
constexpr size_t WS_TKG = 224 * MiB;
constexpr size_t WS_SSQ1 = 211 * MiB;
constexpr size_t WS_SSQ2 = 213 * MiB;
constexpr size_t WS_ROWLIST = 215 * MiB;
constexpr size_t WS_MN = 219 * MiB;
constexpr size_t WS_MKV = 221 * MiB;
constexpr size_t WS_MVT = 223 * MiB;
constexpr size_t WS_WST = 225 * MiB;
constexpr size_t WS_GT = 233 * MiB;
constexpr size_t WS_KT = 241 * MiB;
constexpr size_t WS_LAML = 243 * MiB;
constexpr size_t WS_SST = 244 * MiB;
constexpr size_t WS_H = 256 * MiB;
constexpr size_t WS_N2B = 256 * MiB;
constexpr size_t WS_PO = 256 * MiB;
constexpr size_t WS_PML = 384 * MiB;
constexpr size_t WS_MLIST = 392 * MiB;
constexpr size_t WS_HB = 384 * MiB;
constexpr size_t WS_HID = 448 * MiB;
constexpr size_t WS_Y = 720 * MiB;
constexpr size_t WS_END = 976 * MiB;
constexpr size_t WS_XB = 448 * MiB, WS_Q = 512 * MiB, WS_K = 544 * MiB, WS_V = 576 * MiB, WS_U = 608 * MiB, WS_ATT = 640 * MiB, WS_YB = 672 * MiB;
constexpr size_t WS_SGA = 720 * MiB, WS_SGB = 784 * MiB, WS_YB2S = 848 * MiB, WS_MERGED = 912 * MiB;
constexpr size_t WS_XQ = 448 * MiB, WS_XO = 480 * MiB;
static_assert(WS_HID + (size_t)HID_ROWS * DFF * 2 <= WS_Y, "HID fits");
constexpr int CW_TMO = 0, CW_CNT = 64  , CW_DBG = 128  , CW_MCNT = 256  , CW_BAR = 4096;

constexpr int RING_BYTES = 131072;
constexpr int GIDX_OFF = RING_BYTES, GIDX_UNITS = 24;
constexpr int MISC_OFF = GIDX_OFF + GIDX_UNITS * 1024;
constexpr int LDS_BYTES = 163840;

#define RLX_AGENT __ATOMIC_RELAXED, __HIP_MEMORY_SCOPE_AGENT
__device__ __forceinline__ unsigned f2bf(float f) { unsigned u = __builtin_bit_cast(unsigned, f); return (u + 0x7fffu + ((u >> 16) & 1u)) >> 16; }
__device__ __forceinline__ unsigned pk2(float lo, float hi) { return f2bf(lo) | (f2bf(hi) << 16); }
__device__ __forceinline__ float bf2f(unsigned short b) { return __builtin_bit_cast(float, (unsigned)b << 16); }
__device__ __forceinline__ float bflo(unsigned w) { return __builtin_bit_cast(float, w << 16); }
__device__ __forceinline__ float bfhi(unsigned w) { return __builtin_bit_cast(float, w & 0xffff0000u); }
__device__ __forceinline__ float ub0(unsigned w) { return (float)(w & 0xffu) * (1.0f / 255.0f); }
__device__ __forceinline__ float ub1(unsigned w) { return (float)((w >> 8) & 0xffu) * (1.0f / 255.0f); }
__device__ __forceinline__ float ub2(unsigned w) { return (float)((w >> 16) & 0xffu) * (1.0f / 255.0f); }
__device__ __forceinline__ float ub3(unsigned w) { return (float)(w >> 24) * (1.0f / 255.0f); }
__device__ __forceinline__ float wave_sum(float v) {
#pragma unroll
    for (int o = 1; o < 64; o <<= 1) v += __shfl_xor(v, o);
    return v;
}
__device__ __forceinline__ float fsigmoid(float x) { return __builtin_amdgcn_rcpf(1.0f + __builtin_amdgcn_exp2f(-x * LOG2E)); }
__device__ __forceinline__ float gelu_tanh(float x) {
    const float u = 0.7978845608028654f * (x + 0.044715f * x * x * x);
    return x * fsigmoid(2.0f * u);
}

namespace pg8 {
constexpr int BM = 256, BK = 64, HALF = 128, HTB = HALF * BK * 2, STAGE_BYTES = 8 * HTB;
__host__ __device__ __forceinline__ int lds_byte(int r, int c) { const int st = (r >> 4) * 2 + (c >> 5), rr = r & 15, cc = c & 31, ob = rr * 64 + cc * 2; return st * 1024 + (ob ^ (((ob >> 9) & 1) << 5)); }
__host__ __device__ __forceinline__ void stage_rc(int b, int& R, int& C) { const int st = b / 1024, sb = b % 1024, swz = sb ^ (((sb >> 9) & 1) << 5); R = (st >> 1) * 16 + swz / 64; C = (st & 1) * 32 + (swz % 64) / 2; }
__host__ __device__ __forceinline__ int perm32(int rho) { const int n = rho >> 4, i = rho & 15; return 8 * (i >> 2) + 4 * n + (i & 3); }

struct Unit { int pm, pn, e, mi, ui; };
struct Gemm { const bf16_t* A; const bf16_t* Bt; int K; size_t b_estride; };

struct PatchOrder {
    int nM, nN, PM, PN, x, j, ok;
    __device__ __forceinline__ void init(int nM_, int nN_, int PN_, int G, int c) { nM = nM_; nN = nN_; PN = PN_; PM = (G / 8) / PN_; x = c & 7; j = c >> 3; ok = ((G & 7) == 0) && (PM * PN == G / 8) && (nN % PN == 0); if (!ok) { x = c; j = G; } }
    __device__ __forceinline__ bool next(int i, Unit& u) const {
        if (!ok) { const long L = (long)i * j + x; if (L >= (long)nM * nN) return false; u.pm = (int)(L / nN); u.pn = (int)(L % nN); u.e = 0; u.mi = u.pm; u.ui = i; return true; }
        const int p = 8 * i + x, npn = nN / PN, pmb = p / npn, pnb = p % npn;
        u.pm = pmb * PM + (j % PM); u.pn = pnb * PN + (j / PM); u.e = 0; u.mi = u.pm; u.ui = i;
        return u.pm < nM;
    }
};

struct PairOrder {
    int pp, q, mode;
    __device__ __forceinline__ void init(int c, int mode_) { const int x = c & 7, k = c >> 3; q = k & 3; pp = 8 * x + (k >> 2); mode = mode_; }
    __device__ __forceinline__ bool next(int i, Unit& u) const {
        if (mode == 0) { if (i >= 4) return false; u.pm = 2 * pp + (i >> 1); u.pn = 2 * q + (i & 1); }
        else { if (i >= 2) return false; u.pm = 2 * pp + i; u.pn = q; }
        u.e = 0; u.mi = u.pm; u.ui = i; return true;
    }
};
__device__ __forceinline__ unsigned cvt_pk_bf16(float lo, float hi) { unsigned r; asm volatile("v_cvt_pk_bf16_f32 %0, %1, %2" : "=v"(r) : "v"(lo), "v"(hi)); return r; }
#ifndef NT_STORES
#define NT_STORES 0
#endif
#ifndef WT_STORES
#define WT_STORES 0
#endif
__device__ __forceinline__ void st16(void* p, u32x4 v) {
#if WT_STORES
    asm volatile("global_store_dwordx4 %0, %1, off sc1\n\ts_nop 1" :: "v"(p), "v"(v) : "memory");
#elif NT_STORES
    __builtin_nontemporal_store(v, (u32x4*)p);
#else
    *(u32x4*)p = v;
#endif
}

template <class Epi, class Sched, bool GATHER>
__device__ __forceinline__ void gemm_phase(LAS unsigned char* lds, const Gemm g, const Sched& S, const Epi& E, const LAS int* gidx, int stagger_ticks = 0) {
    if (stagger_ticks > 0) {
        const unsigned long long t0 = __builtin_amdgcn_s_memrealtime(); const unsigned long long dl = (unsigned long long)(stagger_ticks * ((blockIdx.x >> 3) & 3));
        while (__builtin_amdgcn_s_memrealtime() - t0 < dl) __builtin_amdgcn_s_sleep(8);
    }
    const int tid = threadIdx.x, wid = __builtin_amdgcn_readfirstlane(tid >> 6), lane = tid & 63, wr = wid >> 2, wc = wid & 3, fr = lane & 15, fq = lane >> 4;
    const int K = g.K, nt = K / BK;
    int Ra[2], Ca[2]; unsigned voffB[2];
#pragma unroll
    for (int i = 0; i < 2; ++i) { int R, C; stage_rc(tid * 16 + i * 8192, R, C); const int Rb = Epi::PERM ? ((R & ~31) + perm32(R & 31)) : R;
        Ra[i] = R; Ca[i] = C; voffB[i] = (unsigned)(Rb * K + C) * 2u; }
    const size_t kstep = (size_t)(BK * 2);
    const size_t hstep = (size_t)HALF * K * 2;
    const size_t tstep = 2 * hstep;
    const unsigned ldsw = (unsigned)wid * 1024u;
    const int aoff = lds_byte(wr * 64 + fr, fq * 8), boff = lds_byte(wc * 32 + fr, fq * 8);
#define PG8_SA(b, h) (((b) * 2 + (h)) * HTB)
#define PG8_SB(b, h) ((4 + (b) * 2 + (h)) * HTB)
#define PG8_STAGE(bufoff, gbase, voff) do { _Pragma("unroll") for (int _i = 0; _i < 2; ++_i) \
        __builtin_amdgcn_global_load_lds((const unsigned*)((const char*)(gbase) + (voff)[_i]), (LAS unsigned*)(lds + (bufoff) + ldsw + _i * 8192), 16, 0, 0); } while (0)
#define PG8_LDA(dst, b, h) do { _Pragma("unroll") for (int m = 0; m < 4; ++m) _Pragma("unroll") for (int k = 0; k < 2; ++k) dst[m][k] = *(const LAS bf16x8*)(lds + PG8_SA(b, h) + aoff + m * 2048 + k * 1024); } while (0)
#define PG8_LDB(dst, b, h) do { _Pragma("unroll") for (int n = 0; n < 2; ++n) _Pragma("unroll") for (int k = 0; k < 2; ++k) dst[n][k] = *(const LAS bf16x8*)(lds + PG8_SB(b, h) + boff + n * 2048 + k * 1024); } while (0)
#define PG8_MMA(ai, bj, At, Bt) do { __builtin_amdgcn_s_setprio(1); _Pragma("unroll") for (int m = 0; m < 4; ++m) _Pragma("unroll") for (int n = 0; n < 2; ++n) _Pragma("unroll") for (int k = 0; k < 2; ++k) \
        acc[ai][bj][m][n] = __builtin_amdgcn_mfma_f32_16x16x32_bf16(Bt[n][k], At[m][k], acc[ai][bj][m][n], 0, 0, 0); __builtin_amdgcn_s_setprio(0); } while (0)
#define PG8_WAIT_V(n) asm volatile("s_waitcnt vmcnt(" #n ")" ::: "memory")
#define PG8_WAIT_L(n) asm volatile("s_waitcnt lgkmcnt(" #n ")" ::: "memory")
#define PG8_BAR __builtin_amdgcn_s_barrier()
#define PG8_SCHED __builtin_amdgcn_sched_barrier(0)
#define PG8_VOA(dst, u) do { _Pragma("unroll") for (int _h = 0; _h < 2; ++_h) _Pragma("unroll") for (int _i = 0; _i < 2; ++_i) { \
        const int _row = GATHER ? gidx[(u).ui * 256 + _h * HALF + Ra[_i]] : (_h * HALF + Ra[_i]); dst[_h][_i] = (unsigned)(_row * K + Ca[_i]) * 2u; } } while (0)
    Unit cur, nxt; int ui = 0;
    if (!S.next(0, cur)) return;
    f32x4 acc[2][2][4][2];
#pragma unroll
    for (int a = 0; a < 2; ++a)
#pragma unroll
        for (int b = 0; b < 2; ++b)
#pragma unroll
            for (int m = 0; m < 4; ++m)
#pragma unroll
                for (int n = 0; n < 2; ++n) acc[a][b][m][n] = (f32x4){0.f, 0.f, 0.f, 0.f};
    bf16x8 At[4][2], B0[2][2], B1[2][2];
    unsigned voA[2][2], voN[2][2];
    PG8_VOA(voA, cur);
    const char* cA = (const char*)g.A + (GATHER ? (size_t)0 : (size_t)cur.pm * tstep);
    const char* cB = (const char*)g.Bt + ((size_t)cur.e * g.b_estride) * 2 + (size_t)cur.pn * tstep;
    PG8_STAGE(PG8_SB(0, 0), cB, voffB); PG8_STAGE(PG8_SB(0, 1), cB + hstep, voffB); PG8_STAGE(PG8_SA(0, 0), cA, voA[0]); PG8_STAGE(PG8_SA(0, 1), cA, voA[1]);
    if (wr == 1) PG8_BAR;
    PG8_WAIT_V(2); PG8_BAR;
    PG8_STAGE(PG8_SB(1, 0), cB + kstep, voffB); PG8_STAGE(PG8_SA(1, 0), cA + kstep, voA[0]); PG8_STAGE(PG8_SB(1, 1), cB + hstep + kstep, voffB);
    PG8_WAIT_V(6); PG8_BAR;
    for (;;) {
        const bool has_next = S.next(ui + 1, nxt);
        const char* nA = cA; const char* nB = cB;
#pragma unroll
        for (int h = 0; h < 2; ++h)
#pragma unroll
            for (int i = 0; i < 2; ++i) voN[h][i] = voA[h][i];
        if (has_next) { nA = (const char*)g.A + (GATHER ? (size_t)0 : (size_t)nxt.pm * tstep); nB = (const char*)g.Bt + ((size_t)nxt.e * g.b_estride) * 2 + (size_t)nxt.pn * tstep; PG8_VOA(voN, nxt); }
        for (int t = 0; t < nt; t += 2) {
            const bool last = (t == nt - 2);
            const char* a1 = cA + (size_t)(t + 1) * kstep;
            const char* a2 = last ? nA : cA + (size_t)(t + 2) * kstep; const char* b2 = last ? nB : cB + (size_t)(t + 2) * kstep;
            const char* a3 = a2 + kstep; const char* b3 = b2 + kstep;
            unsigned vo2[2][2];
#pragma unroll
            for (int h = 0; h < 2; ++h)
#pragma unroll
                for (int i = 0; i < 2; ++i) vo2[h][i] = last ? voN[h][i] : voA[h][i];
            PG8_LDB(B0, 0, 0); PG8_LDB(B1, 0, 1); PG8_SCHED; PG8_LDA(At, 0, 0); PG8_STAGE(PG8_SA(1, 1), a1, voA[1]);
            PG8_WAIT_V(8); PG8_WAIT_L(0); PG8_BAR; PG8_MMA(0, 0, At, B0); PG8_MMA(0, 1, At, B1); PG8_BAR; PG8_SCHED;
            PG8_LDA(At, 0, 1); PG8_STAGE(PG8_SB(0, 0), b2, voffB); PG8_STAGE(PG8_SB(0, 1), b2 + hstep, voffB); PG8_STAGE(PG8_SA(0, 0), a2, vo2[0]);
            PG8_WAIT_V(8); PG8_WAIT_L(0); PG8_BAR; PG8_MMA(1, 0, At, B0); PG8_MMA(1, 1, At, B1); PG8_BAR; PG8_SCHED;
            PG8_LDB(B0, 1, 0); PG8_LDB(B1, 1, 1); PG8_SCHED; PG8_LDA(At, 1, 0); PG8_STAGE(PG8_SA(0, 1), a2, vo2[1]);
            PG8_WAIT_V(8); PG8_WAIT_L(0); PG8_BAR; PG8_MMA(0, 0, At, B0); PG8_MMA(0, 1, At, B1); PG8_BAR; PG8_SCHED;
            PG8_LDA(At, 1, 1); PG8_STAGE(PG8_SB(1, 0), b3, voffB); PG8_STAGE(PG8_SB(1, 1), b3 + hstep, voffB); PG8_STAGE(PG8_SA(1, 0), a3, vo2[0]);
            PG8_WAIT_V(8); PG8_WAIT_L(0); PG8_BAR; PG8_MMA(1, 0, At, B0); PG8_MMA(1, 1, At, B1); PG8_BAR; PG8_SCHED;
        }
        if (wr == 0) PG8_BAR;
        E(acc, cur, wr, wc, fr, fq);
        if (!has_next) break;
#pragma unroll
        for (int a = 0; a < 2; ++a)
#pragma unroll
            for (int b = 0; b < 2; ++b)
#pragma unroll
                for (int m = 0; m < 4; ++m)
#pragma unroll
                    for (int n = 0; n < 2; ++n) acc[a][b][m][n] = (f32x4){0.f, 0.f, 0.f, 0.f};
        cur = nxt; cA = nA; cB = nB; ++ui;
#pragma unroll
        for (int h = 0; h < 2; ++h)
#pragma unroll
            for (int i = 0; i < 2; ++i) voA[h][i] = voN[h][i];
        if (wr == 1) PG8_BAR;
    }
    PG8_WAIT_V(0);
    PG8_BAR;
#undef PG8_SA
#undef PG8_SB
#undef PG8_STAGE
#undef PG8_LDA
#undef PG8_LDB
#undef PG8_MMA
#undef PG8_WAIT_V
#undef PG8_WAIT_L
#undef PG8_BAR
#undef PG8_SCHED
#undef PG8_VOA
}

typedef const f32x4 (&AccRef)[2][2][4][2];
#define EPI_ROWS for (int ai = 0; ai < 2; ++ai) _Pragma("unroll") for (int m = 0; m < 4; ++m)

template <int XMODE> struct EpiInProjT {
    static constexpr bool PERM = true;
    bf16_t *Q, *Kb, *V, *U, *SGA, *SGB; float* KM2;
    __device__ __forceinline__ void operator()(AccRef acc, const Unit& u, int wr, int wc, int fr, int fq) const {
        bf16_t* dst; int ld, colt; bool sig = false; float sc = 1.f;
        if (u.pn < 2) { dst = Q; ld = AW; colt = u.pn * 256; sc = QSCALE; }
        else if (u.pn < 4) { dst = Kb; ld = AW; colt = (u.pn - 2) * 256; }
        else if (u.pn < 6) { dst = V; ld = AW; colt = (u.pn - 4) * 256; }
        else if (u.pn < 8) { dst = U; ld = AW; colt = (u.pn - 6) * 256; }
        else if (u.pn < 12) { dst = SGA; ld = DM; colt = (u.pn - 8) * 256; sig = true; }
        else { dst = SGB; ld = DM; colt = (u.pn - 12) * 256; sig = true; }
        const int row0 = u.pm * BM + wr * 64 + fr, col0 = colt + wc * 32 + 8 * fq;
        const bool isk = (u.pn == 2 || u.pn == 3); f32x4 cs[2][2];
#pragma unroll
        for (int bj = 0; bj < 2; ++bj)
#pragma unroll
            for (int n = 0; n < 2; ++n) cs[bj][n] = (f32x4){0.f, 0.f, 0.f, 0.f};
#pragma unroll
        EPI_ROWS { const int row = row0 + ai * HALF + m * 16; const float rs = sc; bf16_t* rowp = dst + (size_t)row * ld + col0;
#pragma unroll
            for (int bj = 0; bj < 2; ++bj) { f32x4 v0 = acc[ai][bj][m][0] * rs, v1 = acc[ai][bj][m][1] * rs;
                cs[bj][0] += v0; cs[bj][1] += v1;
                if (sig) {
                    unsigned q[8];
#pragma unroll
                    for (int e = 0; e < 4; ++e) { q[e] = (unsigned)(fsigmoid(v0[e]) * 255.0f + 0.5f); q[4 + e] = (unsigned)(fsigmoid(v1[e]) * 255.0f + 0.5f); }
                    const unsigned g0 = q[0] | (q[1] << 8) | (q[2] << 16) | (q[3] << 24), g1 = q[4] | (q[5] << 8) | (q[6] << 16) | (q[7] << 24);
                    if (XMODE != 1) *(u32x2*)((unsigned char*)dst + (size_t)row * ld + col0 + bj * HALF) = (u32x2){g0, g1};
                    continue; }
                u32x4 w; w.x = cvt_pk_bf16(v0[0], v0[1]); w.y = cvt_pk_bf16(v0[2], v0[3]); w.z = cvt_pk_bf16(v1[0], v1[1]); w.w = cvt_pk_bf16(v1[2], v1[3]);
                if (XMODE == 1) { asm volatile("" :: "v"(w)); } else st16(rowp + bj * HALF, w); } }
        if (isk && XMODE == 0) {
#pragma unroll
            for (int bj = 0; bj < 2; ++bj)
#pragma unroll
                for (int n = 0; n < 2; ++n)
#pragma unroll
                    for (int e = 0; e < 4; ++e) { float v = cs[bj][n][e]; v += __shfl_xor(v, 1); v += __shfl_xor(v, 2); v += __shfl_xor(v, 4); v += __shfl_xor(v, 8); cs[bj][n][e] = v; }
            if (fr == 0) { const int b = u.pm / NBLK, j = u.pm % NBLK;
#pragma unroll
                for (int bj = 0; bj < 2; ++bj) { const int col = colt + bj * HALF + wc * 32 + 8 * fq, h = col >> 6, d = col & 63;
                    float* kp = KM2 + ((((size_t)wr * NB + b) * NH + h) * NBLK + j) * HD + d;
                    *(f32x4*)kp = cs[bj][0] * (1.0f / MBLK); *(f32x4*)(kp + 4) = cs[bj][1] * (1.0f / MBLK); } } }
    }
};
struct EpiNull {
    static constexpr bool PERM = true;
    __device__ __forceinline__ void operator()(AccRef acc, const Unit& u, int wr, int wc, int fr, int fq) const {
#pragma unroll
        EPI_ROWS {
#pragma unroll
            for (int bj = 0; bj < 2; ++bj) { asm volatile("" :: "v"(acc[ai][bj][m][0]), "v"(acc[ai][bj][m][1])); } }
    }
};
typedef EpiInProjT<0> EpiInProj;
template <bool FULL> struct EpiStoreExp {
    static constexpr bool PERM = true;
    bf16_t* O;
    __device__ __forceinline__ void operator()(AccRef acc, const Unit& u, int wr, int wc, int fr, int fq) const {
        const int row0 = u.pm * BM + wr * 64 + (FULL ? (fr & 7) : fr), col0 = (u.pn & 3) * BM + (FULL ? (wc * 64 + (fr >> 3) * 32 + 8 * fq) : (wc * 32 + 8 * fq));
#pragma unroll
        EPI_ROWS { bf16_t* rowp = O + (size_t)(row0 + ai * HALF + m * 16) * DM + col0;
#pragma unroll
            for (int bj = 0; bj < 2; ++bj) { const f32x4 v0 = acc[ai][bj][m][0], v1 = acc[ai][bj][m][1];
                u32x4 w; w.x = cvt_pk_bf16(v0[0], v0[1]); w.y = cvt_pk_bf16(v0[2], v0[3]); w.z = cvt_pk_bf16(v1[0], v1[1]); w.w = cvt_pk_bf16(v1[2], v1[3]);
                st16(rowp + (FULL ? (size_t)bj * 8 * DM : (size_t)bj * HALF), w); } }
    }
};
struct EpiStore {
    static constexpr bool PERM = true;
    bf16_t* O; int ld;
    __device__ __forceinline__ void operator()(AccRef acc, const Unit& u, int wr, int wc, int fr, int fq) const {
        const int row0 = u.pm * BM + wr * 64 + fr, col0 = u.pn * BM + wc * 32 + 8 * fq;
#pragma unroll
        EPI_ROWS { bf16_t* rowp = O + (size_t)(row0 + ai * HALF + m * 16) * ld + col0;
#pragma unroll
            for (int bj = 0; bj < 2; ++bj) { const f32x4 v0 = acc[ai][bj][m][0], v1 = acc[ai][bj][m][1];
                u32x4 w; w.x = cvt_pk_bf16(v0[0], v0[1]); w.y = cvt_pk_bf16(v0[2], v0[3]); w.z = cvt_pk_bf16(v1[0], v1[1]); w.w = cvt_pk_bf16(v1[2], v1[3]);
                st16(rowp + bj * HALF, w); } }
    }
};
struct EpiMemKV {
    static constexpr bool PERM = true;
    bf16_t* O; bf16_t* VT;
    __device__ __forceinline__ void operator()(AccRef acc, const Unit& u, int wr, int wc, int fr, int fq) const {
        const int rl0 = wr * 64 + fr, col0 = u.pn * BM + wc * 32 + 8 * fq;
#pragma unroll
        EPI_ROWS { const int rl = rl0 + ai * HALF + m * 16;
#pragma unroll
            for (int bj = 0; bj < 2; ++bj) { const f32x4 v0 = acc[ai][bj][m][0], v1 = acc[ai][bj][m][1]; const int col = col0 + bj * HALF;
                if (u.pn < 2) { u32x4 w; w.x = cvt_pk_bf16(v0[0], v0[1]); w.y = cvt_pk_bf16(v0[2], v0[3]); w.z = cvt_pk_bf16(v1[0], v1[1]); w.w = cvt_pk_bf16(v1[2], v1[3]);
                    st16(O + (size_t)(u.pm * BM + rl) * (2 * XW) + col, w); }
                else { bf16_t* vp = VT + ((size_t)u.pm * XW + (col - XW)) * MEML + rl;
#pragma unroll
                    for (int e = 0; e < 4; ++e) { vp[(size_t)e * MEML] = (bf16_t)f2bf(v0[e]); vp[(size_t)(4 + e) * MEML] = (bf16_t)f2bf(v1[e]); } } } }
    }
};
struct EpiGlu {
    static constexpr bool PERM = true;
    const bf16_t* SGB; bf16_t* O;
    __device__ __forceinline__ void operator()(AccRef acc, const Unit& u, int wr, int wc, int fr, int fq) const {
        const int row0 = u.pm * BM + wr * 64 + fr, col0 = u.pn * HALF + wc * 32 + 8 * fq;
#pragma unroll
        EPI_ROWS { const size_t off = (size_t)(row0 + ai * HALF + m * 16) * DM + col0; const u32x2 s = *(const u32x2*)((const unsigned char*)SGB + off);
            const f32x4 v0 = acc[ai][0][m][0], v1 = acc[ai][0][m][1], g0 = acc[ai][1][m][0], g1 = acc[ai][1][m][1];
            float o[8];
#pragma unroll
            for (int e = 0; e < 4; ++e) { o[e] = v0[e] * fsigmoid(g0[e]); o[4 + e] = v1[e] * fsigmoid(g1[e]); }
            o[0] *= ub0(s.x); o[1] *= ub1(s.x); o[2] *= ub2(s.x); o[3] *= ub3(s.x); o[4] *= ub0(s.y); o[5] *= ub1(s.y); o[6] *= ub2(s.y); o[7] *= ub3(s.y);
            u32x4 w; w.x = cvt_pk_bf16(o[0], o[1]); w.y = cvt_pk_bf16(o[2], o[3]); w.z = cvt_pk_bf16(o[4], o[5]); w.w = cvt_pk_bf16(o[6], o[7]);
            st16(O + off, w); }
    }
};
struct EpiMerge {
    static constexpr bool PERM = true;
    const bf16_t* SGA; const bf16_t* Y2; bf16_t* O;
    __device__ __forceinline__ void operator()(AccRef acc, const Unit& u, int wr, int wc, int fr, int fq) const {
        const int row0 = u.pm * BM + wr * 64 + fr, col0 = u.pn * BM + wc * 32 + 8 * fq;
#pragma unroll
        EPI_ROWS {
#pragma unroll
            for (int bj = 0; bj < 2; ++bj) { const size_t off = (size_t)(row0 + ai * HALF + m * 16) * DM + col0 + bj * HALF;
                const u32x2 s = *(const u32x2*)((const unsigned char*)SGA + off); const u32x4 y = *(const u32x4*)(Y2 + off); const f32x4 v0 = acc[ai][bj][m][0], v1 = acc[ai][bj][m][1];
                u32x4 w; w.x = cvt_pk_bf16(ub0(s.x) * v0[0] + bflo(y.x), ub1(s.x) * v0[1] + bfhi(y.x)); w.y = cvt_pk_bf16(ub2(s.x) * v0[2] + bflo(y.y), ub3(s.x) * v0[3] + bfhi(y.y));
                w.z = cvt_pk_bf16(ub0(s.y) * v1[0] + bflo(y.z), ub1(s.y) * v1[1] + bfhi(y.z)); w.w = cvt_pk_bf16(ub2(s.y) * v1[2] + bflo(y.w), ub3(s.y) * v1[3] + bfhi(y.w));
                st16(O + off, w); } }
    }
};
template <bool XBASE> struct EpiResidT {
    static constexpr bool PERM = true;
    const float* base; bf16_t* HB; float* SSQ;
    __device__ __forceinline__ void operator()(AccRef acc, const Unit& u, int wr, int wc, int fr, int fq) const {
        const int row0 = u.pm * BM + wr * 64 + fr, col0 = u.pn * BM + wc * 32 + 8 * fq;
#pragma unroll
        EPI_ROWS { const int row = row0 + ai * HALF + m * 16; const size_t off = (size_t)row * DM + col0; float ss = 0.f;
#pragma unroll
            for (int bj = 0; bj < 2; ++bj) { const size_t o2 = off + bj * HALF; f32x4 h0, h1;
                if (XBASE) { h0 = *(const f32x4*)(base + o2) + acc[ai][bj][m][0]; h1 = *(const f32x4*)(base + o2 + 4) + acc[ai][bj][m][1]; }
                else { const u32x4 w = *(const u32x4*)(HB + o2); h0 = (f32x4){bflo(w.x), bfhi(w.x), bflo(w.y), bfhi(w.y)} + acc[ai][bj][m][0]; h1 = (f32x4){bflo(w.z), bfhi(w.z), bflo(w.w), bfhi(w.w)} + acc[ai][bj][m][1]; }
                u32x4 o; o.x = cvt_pk_bf16(h0[0], h0[1]); o.y = cvt_pk_bf16(h0[2], h0[3]); o.z = cvt_pk_bf16(h1[0], h1[1]); o.w = cvt_pk_bf16(h1[2], h1[3]); st16(HB + o2, o);
                if (XBASE) ss += ((h0[0] * h0[0] + h0[1] * h0[1]) + (h0[2] * h0[2] + h0[3] * h0[3])) + ((h1[0] * h1[0] + h1[1] * h1[1]) + (h1[2] * h1[2] + h1[3] * h1[3])); }
            if (XBASE) { ss += __shfl_xor(ss, 16); ss += __shfl_xor(ss, 32); if (fq == 0) SSQ[(size_t)row * 16 + u.pn * 4 + wc] = ss; } }
    }
};
struct EpiXq {
    static constexpr bool PERM = true;
    const float* SSQ; bf16_t* O;
    __device__ __forceinline__ void operator()(AccRef acc, const Unit& u, int wr, int wc, int fr, int fq) const {
        const int row0 = u.pm * BM + wr * 64 + fr, col0 = u.pn * BM + wc * 32 + 8 * fq;
#pragma unroll
        EPI_ROWS { const int row = row0 + ai * HALF + m * 16; const f32x4* sp = (const f32x4*)(SSQ + (size_t)row * 16);
            const f32x4 a = sp[0] + sp[1] + sp[2] + sp[3]; const float rs = __builtin_amdgcn_rsqf(((a[0] + a[1]) + (a[2] + a[3])) * (1.0f / DM) + RMS_EPS) * XSCALE;
            bf16_t* rowp = O + (size_t)row * XW + col0;
#pragma unroll
            for (int bj = 0; bj < 2; ++bj) { const f32x4 v0 = acc[ai][bj][m][0] * rs, v1 = acc[ai][bj][m][1] * rs;
                u32x4 w; w.x = cvt_pk_bf16(v0[0], v0[1]); w.y = cvt_pk_bf16(v0[2], v0[3]); w.z = cvt_pk_bf16(v1[0], v1[1]); w.w = cvt_pk_bf16(v1[2], v1[3]);
                st16(rowp + bj * HALF, w); } }
    }
};
struct EpiMoe1 {
    static constexpr bool PERM = true;
    const float* bgu; bf16_t* HID;
    __device__ __forceinline__ void operator()(AccRef acc, const Unit& u, int wr, int wc, int fr, int fq) const {
        const int rl0 = wr * 64 + fr, col0 = u.pn * HALF + wc * 32 + 8 * fq; const float* bg = bgu + (size_t)u.e * (2 * DFF) + col0;
        const f32x4 bg0 = *(const f32x4*)(bg), bg1 = *(const f32x4*)(bg + 4), bu0 = *(const f32x4*)(bg + DFF), bu1 = *(const f32x4*)(bg + DFF + 4);
#pragma unroll
        EPI_ROWS { const int rl = rl0 + ai * HALF + m * 16;
            const f32x4 g0 = acc[ai][0][m][0] + bg0, g1 = acc[ai][0][m][1] + bg1, p0 = acc[ai][1][m][0] + bu0, p1 = acc[ai][1][m][1] + bu1;
            float o[8];
#pragma unroll
            for (int e = 0; e < 4; ++e) { const float ga = fminf(g0[e], 7.0f), gb = fminf(g1[e], 7.0f), ua = fminf(fmaxf(p0[e], -7.0f), 7.0f), ub = fminf(fmaxf(p1[e], -7.0f), 7.0f);
                o[e] = (ua + 1.0f) * ga * fsigmoid(1.702f * ga); o[4 + e] = (ub + 1.0f) * gb * fsigmoid(1.702f * gb); }
            u32x4 w; w.x = cvt_pk_bf16(o[0], o[1]); w.y = cvt_pk_bf16(o[2], o[3]); w.z = cvt_pk_bf16(o[4], o[5]); w.w = cvt_pk_bf16(o[6], o[7]);
            st16(HID + (size_t)(u.pm * BM + rl) * DFF + col0, w); }
    }
};
struct EpiMoe2 {
    static constexpr bool PERM = true;
    const float* bdn; const LAS int* tabD; const LAS float* tabG; bf16_t* Y;
    __device__ __forceinline__ void operator()(AccRef acc, const Unit& u, int wr, int wc, int fr, int fq) const {
        const int rl0 = wr * 64 + fr, col0 = u.pn * BM + wc * 32 + 8 * fq; const float* bd = bdn + (size_t)u.e * DM + col0;
        f32x4 bv[2][2];
#pragma unroll
        for (int bj = 0; bj < 2; ++bj)
#pragma unroll
            for (int n = 0; n < 2; ++n) bv[bj][n] = *(const f32x4*)(bd + bj * HALF + 4 * n);
#pragma unroll
        EPI_ROWS { const int rl = rl0 + ai * HALF + m * 16; const int dest = tabD[u.ui * 256 + rl];
            if (dest >= 0) { const float gt = tabG[u.ui * 256 + rl]; bf16_t* rowp = Y + (size_t)dest * DM + col0;
#pragma unroll
                for (int bj = 0; bj < 2; ++bj) { const f32x4 v0 = (acc[ai][bj][m][0] + bv[bj][0]) * gt, v1 = (acc[ai][bj][m][1] + bv[bj][1]) * gt;
                    u32x4 w; w.x = cvt_pk_bf16(v0[0], v0[1]); w.y = cvt_pk_bf16(v0[2], v0[3]); w.z = cvt_pk_bf16(v1[0], v1[1]); w.w = cvt_pk_bf16(v1[2], v1[3]);
                    st16(rowp + bj * HALF, w); } } }
    }
};
}

struct MoeOrder {
    pg8::PatchOrder P; const LAS int* pref; int rev;
    __device__ __forceinline__ bool next(int i, pg8::Unit& u) const {
        if (!P.next(i, u)) return false;
        if (rev) u.pm = P.nM - 1 - u.pm;
        int e = 0;
#pragma unroll 1
        for (int k = 1; k < NE; ++k) e += (pref[k] <= u.pm) ? 1 : 0;
        u.e = e; u.mi = u.pm - pref[e]; return true;
    }
};

namespace attn_body {
using bf16=__hip_bfloat16;
using bf16x8=__attribute__((ext_vector_type(8)))short;
using s16x4=__attribute__((ext_vector_type(4)))short;
using f32x16=__attribute__((ext_vector_type(16)))float;
using u32x4=__attribute__((ext_vector_type(4)))unsigned;
constexpr int BATCH=4,NHEAD=8,SEQ=8192,D=64,DM=NHEAD*D;
constexpr int NW=8,QBLK=32,QB=QBLK*NW,KVBLK=64,NQB=SEQ/QB;
constexpr int ATTN_PITCH=DM, ATTN_UNIT_ROWS=QB;
__device__ __forceinline__ int crow(int r,int hi){return (r&3)+8*(r>>2)+4*hi;}
#define SBAR() __builtin_amdgcn_sched_barrier(0)
__device__ __forceinline__ void cmask(f32x16&p0,f32x16&p1,int jb,int qrel,int hi){
  const float NEG=-INFINITY; int kb=64*jb+4*hi;
  #pragma unroll
  for(int r=0;r<16;++r){int kv=kb+(r&3)+8*(r>>2); if(kv>qrel)p0[r]=NEG; if(kv+32>qrel)p1[r]=NEG;}
}

constexpr int NSLOT=4, SLOTB=8192;
constexpr int LDS_K=0, LDS_V=NSLOT*SLOTB, LDS_WS=2*NSLOT*SLOTB, LDS_OST=LDS_WS+NW*64*4, LDS_KM=LDS_OST+NW*4096, LDS_SEL=LDS_KM+32*64*4, LDS_DST=LDS_SEL+1024, LDS_BYTES=LDS_DST+1024;
constexpr float C2=0.125f*1.4426950408889634f;
__device__ __forceinline__ void glds16(const void*gsrc,unsigned lds_dst){unsigned keep;
  asm volatile("s_mov_b32 %0, m0\n\ts_mov_b32 m0, %2\n\ts_nop 0\n\tglobal_load_lds_dwordx4 %1, off\n\ts_mov_b32 m0, %0":"=&s"(keep):"v"(gsrc),"s"(lds_dst):"memory");}
__device__ __forceinline__ float max3f(float a,float b,float c){float r;asm("v_max3_f32 %0, %1, %2, %3":"=v"(r):"v"(a),"v"(b),"v"(c));return r;}
__device__ __forceinline__ float max2f(float a,float b){float r;asm("v_max_f32_e32 %0, %1, %2":"=v"(r):"v"(a),"v"(b));return r;}
__device__ __forceinline__ float fadd_s(float a,float b){float r;asm("v_add_f32_e32 %0, %1, %2":"=v"(r):"v"(a),"v"(b));return r;}
__device__ __forceinline__ float fsub_s(float a,float b){float r;asm("v_sub_f32_e32 %0, %1, %2":"=v"(r):"v"(a),"v"(b));return r;}
typedef float f32x2_t __attribute__((ext_vector_type(2))); typedef __bf16 bf16x2_t __attribute__((ext_vector_type(2)));
__device__ __forceinline__ unsigned cvtpk_s(float lo,float hi){f32x2_t v={lo,hi};bf16x2_t b=__builtin_convertvector(v,bf16x2_t);return __builtin_bit_cast(unsigned,b);}
#define WAIT_BAR(N) asm volatile("s_waitcnt vmcnt(" #N ") lgkmcnt(0)\n\ts_barrier":::"memory")

__device__ __forceinline__ void qkt(f32x16&p0,f32x16&p1,const char*Kslot,const bf16x8*qr,const f32x16&negm,int r32,int hi){
  const char*kb=Kslot+hi*1024+r32*16;
  #pragma unroll
  for(int d0=0;d0<4;++d0){
    const bf16x8 b0=*reinterpret_cast<const bf16x8*>(kb+d0*2048);
    const bf16x8 b1=*reinterpret_cast<const bf16x8*>(kb+d0*2048+512);
    if(d0==0){p0=__builtin_amdgcn_mfma_f32_32x32x16_bf16(b0,qr[0],negm,0,0,0);p1=__builtin_amdgcn_mfma_f32_32x32x16_bf16(b1,qr[0],negm,0,0,0);}
    else{p0=__builtin_amdgcn_mfma_f32_32x32x16_bf16(b0,qr[d0],p0,0,0,0);p1=__builtin_amdgcn_mfma_f32_32x32x16_bf16(b1,qr[d0],p1,0,0,0);}}
}
typedef __attribute__((address_space(3))) const char* lds_cptr;
typedef short v4i16_t __attribute__((ext_vector_type(4)));
__device__ __forceinline__ void kload8(bf16x8*kf,lds_cptr kp){
  kf[0]=*(const __attribute__((address_space(3))) bf16x8*)(kp);      kf[1]=*(const __attribute__((address_space(3))) bf16x8*)(kp+512);
  kf[2]=*(const __attribute__((address_space(3))) bf16x8*)(kp+2048); kf[3]=*(const __attribute__((address_space(3))) bf16x8*)(kp+2560);
  kf[4]=*(const __attribute__((address_space(3))) bf16x8*)(kp+4096); kf[5]=*(const __attribute__((address_space(3))) bf16x8*)(kp+4608);
  kf[6]=*(const __attribute__((address_space(3))) bf16x8*)(kp+6144); kf[7]=*(const __attribute__((address_space(3))) bf16x8*)(kp+6656);
}
__device__ __forceinline__ void kload2(bf16x8*kf,lds_cptr kp,int j){ kf[2*j]=*(const __attribute__((address_space(3))) bf16x8*)(kp+j*2048); kf[2*j+1]=*(const __attribute__((address_space(3))) bf16x8*)(kp+j*2048+512); }
__device__ __forceinline__ s16x4 vtr(lds_cptr p){ return __builtin_bit_cast(s16x4,__builtin_amdgcn_ds_read_tr16_b64_v4i16((__attribute__((address_space(3))) v4i16_t*)p)); }
__device__ __forceinline__ float rowmax(const f32x16&p0,const f32x16&p1){
  float a=max3f(p0[0],p0[1],p1[0]),b=max3f(p0[2],p0[3],p1[1]);a=max3f(a,p1[2],p1[3]);
  #pragma unroll
  for(int r=4;r<16;r+=4){a=max3f(a,p0[r],p0[r+1]);b=max3f(b,p0[r+2],p0[r+3]);a=max3f(a,p1[r],p1[r+1]);b=max3f(b,p1[r+2],p1[r+3]);}
  const float m=max2f(a,b);
  auto rr=__builtin_amdgcn_permlane32_swap(__float_as_uint(m),__float_as_uint(m),false,false);
  return max2f(__uint_as_float(rr[0]),__uint_as_float(rr[1]));
}
__device__ __forceinline__ void pv(f32x16*o,int vb,bf16x8 pa0,bf16x8 pa1,bf16x8 pa2,bf16x8 pa3){
  #pragma unroll
  for(int d0=0;d0<2;++d0){s16x4 lo[4],hi[4];
    #pragma unroll
    for(int ks=0;ks<4;++ks){
      asm volatile("ds_read_b64_tr_b16 %0,%1 offset:%c2":"=&v"(lo[ks]):"v"(vb),"i"(d0*4096+ks*1024):"memory");
      asm volatile("ds_read_b64_tr_b16 %0,%1 offset:%c2":"=&v"(hi[ks]):"v"(vb),"i"(d0*4096+ks*1024+512):"memory");}
    asm volatile("s_waitcnt lgkmcnt(0)":::"memory");SBAR();
    #define PK(k) (bf16x8){lo[k][0],lo[k][1],lo[k][2],lo[k][3],hi[k][0],hi[k][1],hi[k][2],hi[k][3]}
    o[d0]=__builtin_amdgcn_mfma_f32_32x32x16_bf16(pa0,PK(0),o[d0],0,0,0);
    o[d0]=__builtin_amdgcn_mfma_f32_32x32x16_bf16(pa1,PK(1),o[d0],0,0,0);
    o[d0]=__builtin_amdgcn_mfma_f32_32x32x16_bf16(pa2,PK(2),o[d0],0,0,0);
    o[d0]=__builtin_amdgcn_mfma_f32_32x32x16_bf16(pa3,PK(3),o[d0],0,0,0);
    #undef PK
  }
}

#ifndef ATTN_STORE16
#define ATTN_STORE16(p,v) (*(u32x4*)(p)=(v))
#endif
template<int THRL> __device__ __forceinline__ void attn_unit(int b,int h,int qb,const bf16*Q,const bf16*__restrict__ K,const bf16*__restrict__ V,bf16*O,char*shm){
  const int tid=threadIdx.x,lane=tid&63,r32=lane&31,hi=lane>>5; const int wid=__builtin_amdgcn_readfirstlane(tid>>6);
  const long rowbase=(long)b*SEQ; const int q0=qb*QB;
  const bf16*Qw=Q+(rowbase+q0+wid*QBLK)*DM+h*D;
  const bf16*Kh=K+rowbase*DM+h*D,*Vh=V+rowbase*DM+h*D;
  const unsigned lds0=(unsigned)(uintptr_t)shm;
  float*wsf=(float*)(shm+LDS_WS)+wid*64;
  const bf16*ksrc=Kh+(long)lane*DM+wid*8;
  const bf16*vsrc=Vh+(long)(16*(wid&3)+(lane>>2))*DM+(wid>>2)*32+(lane&3)*8;
  const unsigned kdst=lds0+LDS_K+wid*1024, vdst=lds0+LDS_V+wid*1024;
  #define DMA_K(t,slot) glds16(ksrc+(long)(t)*KVBLK*DM,(unsigned)__builtin_amdgcn_readfirstlane(kdst+(slot)))
  #define DMA_V(t,slot) glds16(vsrc+(long)(t)*KVBLK*DM,(unsigned)__builtin_amdgcn_readfirstlane(vdst+(slot)))
  const int vb0=(int)(lds0+LDS_V)+((lane>>4)&1)*32+(lane&3)*8+(4*hi+((lane&15)>>2))*64;
  const char*Kbase=shm+LDS_K; bf16x8 kf[8];
  const lds_cptr shm3=(lds_cptr)shm; const lds_cptr kp0=shm3+LDS_K+hi*1024+r32*16; const lds_cptr vp0=shm3+LDS_V+((lane>>4)&1)*32+(lane&3)*8+(4*hi+((lane&15)>>2))*64;
  const int NT=(q0+QB)/KVBLK;
  DMA_K(0,0);DMA_V(0,0);DMA_K(1,SLOTB);
  bf16x8 qr[4];
  #pragma unroll
  for(int d0=0;d0<4;++d0)qr[d0]=*reinterpret_cast<const bf16x8*>(&Qw[(long)r32*DM+d0*16+hi*8]);
  { int lp_=lane; asm volatile("":"+v"(lp_)); const int r32p=lp_&31, hip=lp_>>5;
    unsigned sel=0u; const __attribute__((address_space(3))) float*km=(const __attribute__((address_space(3))) float*)((__attribute__((address_space(3))) const char*)shm+LDS_KM); float g0=-3e38f,g1=-3e38f,g2=-3e38f; int s0=-1,s1=-1,s2=-1;
    for(int j=0;j<qb;++j){ float g=0.f;
      #pragma unroll
      for(int d0=0;d0<4;++d0){
        #pragma unroll
        for(int e=0;e<8;++e)g+=__builtin_bit_cast(float,((unsigned)(unsigned short)qr[d0][e])<<16)*km[j*64+16*d0+8*hip+e];}
      g+=__shfl_xor(g,32);
      if(g>g0){g2=g1;s2=s1;g1=g0;s1=s0;g0=g;s0=j;}else if(g>g1){g2=g1;s2=s1;g1=g;s1=j;}else if(g>g2){g2=g;s2=j;} }
    if(s0>=0)sel|=1u<<s0; if(s1>=0)sel|=1u<<s1; if(s2>=0)sel|=1u<<s2;
    if(hip==0)((__attribute__((address_space(3))) unsigned*)((__attribute__((address_space(3))) char*)shm+LDS_SEL))[wid*32+r32p]=sel; asm volatile("s_waitcnt lgkmcnt(0)":::"memory"); }
  float mhat=0.f,l_reg=0.f;f32x16 o[2];o[0]=f32x16{};o[1]=f32x16{};f32x16 negm=f32x16{};asm volatile("":"+v"(negm));
  const int qrel=wid*QBLK+r32;
  #define BMASK(P0,P1,t) do{}while(0)
  #define CMASK(P0,P1,t) do{int jb_=(t)-(NT-4); if(jb_>=0)cmask(P0,P1,jb_,qrel,hi); else BMASK(P0,P1,t);}while(0)
  bool resc=false;
  #define START(P0,P1) do{ const float rm=rowmax(P0,P1); resc=false; \
    { const float dl=__builtin_fmaxf(rm,-64.f); mhat=fadd_s(mhat,dl); \
      _Pragma("unroll") for(int r=0;r<16;++r){P0[r]=fsub_s(P0[r],dl);P1[r]=fsub_s(P1[r],dl);} \
      _Pragma("unroll") for(int r=0;r<16;++r)negm[r]=-mhat; asm volatile("":"+v"(negm)); } \
    _Pragma("unroll") for(int r=0;r<16;++r)P0[r]=__builtin_amdgcn_exp2f(P0[r]); }while(0)
  #define RESC() do{ if(resc){ asm volatile("s_waitcnt lgkmcnt(0)":::"memory"); \
      _Pragma("unroll") for(int d_=0;d_<2;++d_) _Pragma("unroll") for(int r=0;r<16;++r)o[d_][r]*=wsf[crow(r,hi)]; } }while(0)
  f32x16 pA0,pA1,pB0,pB1;
  int sl_prev=0,sl_cur=0,sl_next=SLOTB;
  #define ROT() do{sl_prev=sl_cur;sl_cur=sl_next;sl_next=(sl_next==(NSLOT-1)*SLOTB)?0:sl_next+SLOTB;}while(0)
  DMA_K(2,2*SLOTB);
  WAIT_BAR(3);
  qkt(pA0,pA1,Kbase,qr,negm,r32,hi);asm volatile("s_nop 15\n\ts_nop 7":"+v"(pA0),"+v"(pA1));CMASK(pA0,pA1,0);
  START(pA0,pA1);
  _Pragma("unroll") for(int r=0;r<16;++r)pA1[r]=__builtin_amdgcn_exp2f(pA1[r]);
  WAIT_BAR(0);
  DMA_K(3,0);DMA_V(1,SLOTB);
  ROT();
  kload8(kf,kp0+sl_cur);
  WAIT_BAR(2);
  s16x4 vlo[8],vhi[8]; u32x4 pw0,pw1,pw2,pw3;
  #define PKW(P,B) (keep_?cvtpk_s(P[B],P[B+1]):0u)
  #define PAF(k) __builtin_bit_cast(bf16x8,pw##k)
  #define VFR(i) (bf16x8){vlo[i][0],vlo[i][1],vlo[i][2],vlo[i][3],vhi[i][0],vhi[i][1],vhi[i][2],vhi[i][3]}
  #define PIN(x) asm volatile("":"+v"(x))
  #define MX3(a,b,c) __builtin_fmaxf(__builtin_fmaxf((a),(b)),(c))
  #define GAPA(MF,A0,A1,A2,A3,W0,W1,PW) do{ MF; sacc+=A0; sacc+=A1; sacc+=A2; sacc+=A3; PIN(sacc); W0; W1; PIN(PW); SBAR(); }while(0)
  #define EX(v) __builtin_amdgcn_exp2f(v)
  #define GAPB(MF,X,B) do{ MF; X[B]=EX(X[B]); X[B+1]=EX(X[B+1]); X[B+2]=EX(X[B+2]); X[B+3]=EX(X[B+3]); PIN(X); SBAR(); }while(0)
  #define VRD(i) do{ vlo[i]=vtr(vp_+(((i)>>2)*4096+((i)&3)*1024)); vhi[i]=vtr(vp_+(((i)>>2)*4096+((i)&3)*1024+512)); }while(0)
  #define KRD(G,j) do{ if(G){ kload2(kf,kp0+sl_next,j); SBAR(); } }while(0)
  #define STEP(C0,C1,P0,P1,t,GK,GV,GL) do{ SBAR(); \
    int q_=qrel; asm volatile("":"+v"(q_)); const unsigned selw_=((const volatile __attribute__((address_space(3))) unsigned*)((__attribute__((address_space(3))) const char*)shm+LDS_SEL))[q_]; \
    const bool keep_=((t)-1>=NT-4)||((selw_>>(((t)-1)>>2))&1u); \
    const lds_cptr vp_=vp0+sl_prev; \
    VRD(0); SBAR(); float sacc=(P0[0]+P0[1]); \
    GAPA(C0=__builtin_amdgcn_mfma_f32_32x32x16_bf16(kf[0],qr[0],negm,0,0,0), P0[2],P0[3],P0[4],P0[5],     pw0[0]=PKW(P0,0), pw0[1]=PKW(P0,2), pw0); \
    VRD(4); SBAR(); GAPA(C1=__builtin_amdgcn_mfma_f32_32x32x16_bf16(kf[1],qr[0],negm,0,0,0), P0[6],P0[7],P0[8],P0[9],     pw0[2]=PKW(P0,4), pw0[3]=PKW(P0,6), pw0); \
    VRD(1); SBAR(); GAPA(C0=__builtin_amdgcn_mfma_f32_32x32x16_bf16(kf[2],qr[1],C0,0,0,0),   P0[10],P0[11],P0[12],P0[13], pw1[0]=PKW(P0,8), pw1[1]=PKW(P0,10), pw1); \
    VRD(5); SBAR(); GAPA(C1=__builtin_amdgcn_mfma_f32_32x32x16_bf16(kf[3],qr[1],C1,0,0,0),   P0[14],P0[15],P1[0],P1[1],   pw1[2]=PKW(P0,12),pw1[3]=PKW(P0,14), pw1); \
    VRD(2); SBAR(); GAPA(C0=__builtin_amdgcn_mfma_f32_32x32x16_bf16(kf[4],qr[2],C0,0,0,0),   P1[2],P1[3],P1[4],P1[5],     pw2[0]=PKW(P1,0), pw2[1]=PKW(P1,2), pw2); \
    VRD(6); SBAR(); GAPA(C1=__builtin_amdgcn_mfma_f32_32x32x16_bf16(kf[5],qr[2],C1,0,0,0),   P1[6],P1[7],P1[8],P1[9],     pw2[2]=PKW(P1,4), pw2[3]=PKW(P1,6), pw2); \
    VRD(3); SBAR(); GAPA(C0=__builtin_amdgcn_mfma_f32_32x32x16_bf16(kf[6],qr[3],C0,0,0,0),   P1[10],P1[11],P1[12],P1[13], pw3[0]=PKW(P1,8), pw3[1]=PKW(P1,10), pw3); \
    VRD(7); SBAR(); GAPA(C1=__builtin_amdgcn_mfma_f32_32x32x16_bf16(kf[7],qr[3],C1,0,0,0),   P1[14],P1[15],0.f,0.f,       pw3[2]=PKW(P1,12),pw3[3]=PKW(P1,14), pw3); \
    l_reg+=keep_?sacc:0.f; \
    if(GK){DMA_K((t)+3,sl_cur);} if(GV){DMA_V((t)+1,sl_next);} \
    CMASK(C0,C1,t); \
    { float a=MX3(C0[0],C0[1],C1[0]),b=MX3(C0[2],C0[3],C1[1]); a=MX3(a,C1[2],C1[3]); \
      _Pragma("unroll") for(int r=4;r<16;r+=4){a=MX3(a,C0[r],C0[r+1]);b=MX3(b,C0[r+2],C0[r+3]);a=MX3(a,C1[r],C1[r+1]);b=MX3(b,C1[r+2],C1[r+3]);} \
      float rm=__builtin_fmaxf(a,b); { auto rr=__builtin_amdgcn_permlane32_swap(__float_as_uint(rm),__float_as_uint(rm),false,false); rm=__builtin_fmaxf(__uint_as_float(rr[0]),__uint_as_float(rr[1])); } \
      resc=false; \
      if(__builtin_expect(__any(rm>(float)THRL),0)){ const float dl=__builtin_fmaxf(rm,0.f); mhat+=dl; \
        _Pragma("unroll") for(int r=0;r<16;++r){C0[r]-=dl;C1[r]-=dl;} \
        _Pragma("unroll") for(int r=0;r<16;++r)negm[r]=-mhat; asm volatile("":"+v"(negm)); \
        const float f=__builtin_amdgcn_exp2f(-dl); l_reg*=f; if(hi==0)wsf[r32]=f; resc=true; } } \
    SBAR(); \
    GAPB(o[0]=__builtin_amdgcn_mfma_f32_32x32x16_bf16(PAF(0),VFR(0),o[0],0,0,0), C0,0); \
    GAPB(o[1]=__builtin_amdgcn_mfma_f32_32x32x16_bf16(PAF(0),VFR(4),o[1],0,0,0), C0,4); \
    KRD(GL,0); GAPB(o[0]=__builtin_amdgcn_mfma_f32_32x32x16_bf16(PAF(1),VFR(1),o[0],0,0,0), C0,8); \
    KRD(GL,1); GAPB(o[1]=__builtin_amdgcn_mfma_f32_32x32x16_bf16(PAF(1),VFR(5),o[1],0,0,0), C0,12); \
    KRD(GL,2); GAPB(o[0]=__builtin_amdgcn_mfma_f32_32x32x16_bf16(PAF(2),VFR(2),o[0],0,0,0), C1,0); \
    KRD(GL,3); GAPB(o[1]=__builtin_amdgcn_mfma_f32_32x32x16_bf16(PAF(2),VFR(6),o[1],0,0,0), C1,4); \
    GAPB(o[0]=__builtin_amdgcn_mfma_f32_32x32x16_bf16(PAF(3),VFR(3),o[0],0,0,0), C1,8); \
    GAPB(o[1]=__builtin_amdgcn_mfma_f32_32x32x16_bf16(PAF(3),VFR(7),o[1],0,0,0), C1,12); \
    }while(0)
  int t=1;
  for(;t+5<NT;t+=2){
    STEP(pB0,pB1,pA0,pA1,t,true,true,true);     WAIT_BAR(2); RESC(); ROT();
    STEP(pA0,pA1,pB0,pB1,t+1,true,true,true);   WAIT_BAR(2); RESC(); ROT();
  }
  #define ENDW(tt) do{ if((tt)+3<NT){WAIT_BAR(2);} else if((tt)+2<NT){WAIT_BAR(1);} else {WAIT_BAR(0);} }while(0)
  for(;t+1<NT;t+=2){
    STEP(pB0,pB1,pA0,pA1,t,(t+3<NT),(t+1<NT),(t+1<NT));       ENDW(t);   RESC(); ROT();
    STEP(pA0,pA1,pB0,pB1,t+1,(t+4<NT),(t+2<NT),(t+2<NT));     ENDW(t+1); RESC(); ROT();
  }
  STEP(pB0,pB1,pA0,pA1,NT-1,false,false,false); RESC();
  { const bool keep_=true; float sacc=pB0[0]+pB0[1]; _Pragma("unroll") for(int r=2;r<16;++r)sacc+=pB0[r]; _Pragma("unroll") for(int r=0;r<16;++r)sacc+=pB1[r]; l_reg+=sacc;
    pw0=(u32x4){PKW(pB0,0),PKW(pB0,2),PKW(pB0,4),PKW(pB0,6)};pw1=(u32x4){PKW(pB0,8),PKW(pB0,10),PKW(pB0,12),PKW(pB0,14)};pw2=(u32x4){PKW(pB1,0),PKW(pB1,2),PKW(pB1,4),PKW(pB1,6)};pw3=(u32x4){PKW(pB1,8),PKW(pB1,10),PKW(pB1,12),PKW(pB1,14)};
    SBAR(); pv(o,vb0+sl_cur,PAF(0),PAF(1),PAF(2),PAF(3)); }
  #undef PKW
  #undef PAF
  #undef VFR
  #undef PIN
  #undef MX3
  #undef GAPA
  #undef GAPB
  #undef EX
  #undef VRD
  #undef KRD
  #undef STEP
  #undef ENDW
  {auto rr=__builtin_amdgcn_permlane32_swap(__float_as_uint(l_reg),__float_as_uint(l_reg),false,false);l_reg=__uint_as_float(rr[0])+__uint_as_float(rr[1]);}
  if(hi==0)wsf[32+r32]=l_reg;asm volatile("s_waitcnt lgkmcnt(0)":::"memory");
  float rli[16];
  #pragma unroll
  for(int r=0;r<16;++r)rli[r]=__builtin_amdgcn_rcpf(wsf[32+crow(r,hi)]);
  bf16*Ow=O+(rowbase+q0+wid*QBLK)*DM+h*D;
  { bf16*stg=(bf16*)(shm+LDS_OST)+wid*2048;
    #pragma unroll
    for(int r=0;r<16;++r){const int orow=crow(r,hi);
      #pragma unroll
      for(int d0=0;d0<2;++d0)stg[orow*64+d0*32+r32]=__float2bfloat16(o[d0][r]*rli[r]);}
    asm volatile("s_waitcnt lgkmcnt(0)":::"memory");
    #pragma unroll
    for(int i=0;i<4;++i){const int row=i*8+(lane>>3),ch=lane&7; const u32x4 v=*(const u32x4*)(stg+row*64+ch*8); ATTN_STORE16(Ow+(long)row*DM+ch*8,v);} }
  asm volatile("s_waitcnt lgkmcnt(0)\n\ts_barrier":::"memory");
  #undef DMA_K
  #undef DMA_V
  #undef CMASK
  #undef BMASK
  #undef START
  #undef RESC
  #undef ROT
}
template<int THRL> __device__ __forceinline__ void moba_unit4(const bf16*Qrow,const bf16*__restrict__ Kh,const bf16*__restrict__ Vh,bool causal,int dest,bf16*PO,float*PML,char*shm){
  int tid_=threadIdx.x; asm volatile("":"+v"(tid_)); const int tid=tid_,lane=tid&63,r32=lane&31,hi=lane>>5; const int wid=__builtin_amdgcn_readfirstlane(tid>>6);
  const unsigned lds0=(unsigned)(uintptr_t)shm;
  float*wsf=(float*)(shm+LDS_WS)+wid*64;
  const bf16*ksrc=Kh+(long)lane*DM+wid*8;
  const bf16*vsrc=Vh+(long)(16*(wid&3)+(lane>>2))*DM+(wid>>2)*32+(lane&3)*8;
  const unsigned kdst=lds0+LDS_K+wid*1024, vdst=lds0+LDS_V+wid*1024;
  #define DMA_K(t,slot) glds16(ksrc+(long)(t)*KVBLK*DM,(unsigned)__builtin_amdgcn_readfirstlane(kdst+(slot)))
  #define DMA_V(t,slot) glds16(vsrc+(long)(t)*KVBLK*DM,(unsigned)__builtin_amdgcn_readfirstlane(vdst+(slot)))
  const int vb0=(int)(lds0+LDS_V)+((lane>>4)&1)*32+(lane&3)*8+(4*hi+((lane&15)>>2))*64;
  const char*Kbase=shm+LDS_K; bf16x8 kf[8];
  const lds_cptr shm3=(lds_cptr)shm; const lds_cptr kp0=shm3+LDS_K+hi*1024+r32*16; const lds_cptr vp0=shm3+LDS_V+((lane>>4)&1)*32+(lane&3)*8+(4*hi+((lane&15)>>2))*64;
  constexpr int NT=4;
  DMA_K(0,0);DMA_V(0,0);DMA_K(1,SLOTB);
  bf16x8 qr[4];
  #pragma unroll
  for(int d0=0;d0<4;++d0)qr[d0]=*reinterpret_cast<const bf16x8*>(Qrow+d0*16+hi*8);
  float mhat=0.f,l_reg=0.f;f32x16 o[2];o[0]=f32x16{};o[1]=f32x16{};f32x16 negm=f32x16{};asm volatile("":"+v"(negm));
  const int qrel=wid*QBLK+r32;
  #define BMASK(P0,P1,t) do{}while(0)
  #define CMASK(P0,P1,t) do{ if(causal)cmask(P0,P1,(t),qrel,hi); }while(0)
  bool resc=false;
  #define START(P0,P1) do{ const float rm=rowmax(P0,P1); resc=false; \
    { const float dl=__builtin_fmaxf(rm,-64.f); mhat=fadd_s(mhat,dl); \
      _Pragma("unroll") for(int r=0;r<16;++r){P0[r]=fsub_s(P0[r],dl);P1[r]=fsub_s(P1[r],dl);} \
      _Pragma("unroll") for(int r=0;r<16;++r)negm[r]=-mhat; asm volatile("":"+v"(negm)); } \
    _Pragma("unroll") for(int r=0;r<16;++r)P0[r]=__builtin_amdgcn_exp2f(P0[r]); }while(0)
  #define RESC() do{ if(resc){ asm volatile("s_waitcnt lgkmcnt(0)":::"memory"); \
      _Pragma("unroll") for(int d_=0;d_<2;++d_) _Pragma("unroll") for(int r=0;r<16;++r)o[d_][r]*=wsf[crow(r,hi)]; } }while(0)
  f32x16 pA0,pA1,pB0,pB1;
  int sl_prev=0,sl_cur=0,sl_next=SLOTB;
  #define ROT() do{sl_prev=sl_cur;sl_cur=sl_next;sl_next=(sl_next==(NSLOT-1)*SLOTB)?0:sl_next+SLOTB;}while(0)
  DMA_K(2,2*SLOTB);
  WAIT_BAR(3);
  qkt(pA0,pA1,Kbase,qr,negm,r32,hi);asm volatile("s_nop 15\n\ts_nop 7":"+v"(pA0),"+v"(pA1));CMASK(pA0,pA1,0);
  START(pA0,pA1);
  _Pragma("unroll") for(int r=0;r<16;++r)pA1[r]=__builtin_amdgcn_exp2f(pA1[r]);
  WAIT_BAR(0);
  DMA_K(3,0);DMA_V(1,SLOTB);
  ROT();
  kload8(kf,kp0+sl_cur);
  WAIT_BAR(2);
  s16x4 vlo[8],vhi[8]; u32x4 pw0,pw1,pw2,pw3;
  #define PKW(P,B) (keep_?cvtpk_s(P[B],P[B+1]):0u)
  #define PAF(k) __builtin_bit_cast(bf16x8,pw##k)
  #define VFR(i) (bf16x8){vlo[i][0],vlo[i][1],vlo[i][2],vlo[i][3],vhi[i][0],vhi[i][1],vhi[i][2],vhi[i][3]}
  #define PIN(x) asm volatile("":"+v"(x))
  #define MX3(a,b,c) __builtin_fmaxf(__builtin_fmaxf((a),(b)),(c))
  #define GAPA(MF,A0,A1,A2,A3,W0,W1,PW) do{ MF; sacc+=A0; sacc+=A1; sacc+=A2; sacc+=A3; PIN(sacc); W0; W1; PIN(PW); SBAR(); }while(0)
  #define EX(v) __builtin_amdgcn_exp2f(v)
  #define GAPB(MF,X,B) do{ MF; X[B]=EX(X[B]); X[B+1]=EX(X[B+1]); X[B+2]=EX(X[B+2]); X[B+3]=EX(X[B+3]); PIN(X); SBAR(); }while(0)
  #define VRD(i) do{ vlo[i]=vtr(vp_+(((i)>>2)*4096+((i)&3)*1024)); vhi[i]=vtr(vp_+(((i)>>2)*4096+((i)&3)*1024+512)); }while(0)
  #define KRD(G,j) do{ if(G){ kload2(kf,kp0+sl_next,j); SBAR(); } }while(0)
  #define STEP(C0,C1,P0,P1,t,GK,GV,GL) do{ SBAR(); \
    const bool keep_=true; \
    const lds_cptr vp_=vp0+sl_prev; \
    VRD(0); SBAR(); float sacc=(P0[0]+P0[1]); \
    GAPA(C0=__builtin_amdgcn_mfma_f32_32x32x16_bf16(kf[0],qr[0],negm,0,0,0), P0[2],P0[3],P0[4],P0[5],     pw0[0]=PKW(P0,0), pw0[1]=PKW(P0,2), pw0); \
    VRD(4); SBAR(); GAPA(C1=__builtin_amdgcn_mfma_f32_32x32x16_bf16(kf[1],qr[0],negm,0,0,0), P0[6],P0[7],P0[8],P0[9],     pw0[2]=PKW(P0,4), pw0[3]=PKW(P0,6), pw0); \
    VRD(1); SBAR(); GAPA(C0=__builtin_amdgcn_mfma_f32_32x32x16_bf16(kf[2],qr[1],C0,0,0,0),   P0[10],P0[11],P0[12],P0[13], pw1[0]=PKW(P0,8), pw1[1]=PKW(P0,10), pw1); \
    VRD(5); SBAR(); GAPA(C1=__builtin_amdgcn_mfma_f32_32x32x16_bf16(kf[3],qr[1],C1,0,0,0),   P0[14],P0[15],P1[0],P1[1],   pw1[2]=PKW(P0,12),pw1[3]=PKW(P0,14), pw1); \
    VRD(2); SBAR(); GAPA(C0=__builtin_amdgcn_mfma_f32_32x32x16_bf16(kf[4],qr[2],C0,0,0,0),   P1[2],P1[3],P1[4],P1[5],     pw2[0]=PKW(P1,0), pw2[1]=PKW(P1,2), pw2); \
    VRD(6); SBAR(); GAPA(C1=__builtin_amdgcn_mfma_f32_32x32x16_bf16(kf[5],qr[2],C1,0,0,0),   P1[6],P1[7],P1[8],P1[9],     pw2[2]=PKW(P1,4), pw2[3]=PKW(P1,6), pw2); \
    VRD(3); SBAR(); GAPA(C0=__builtin_amdgcn_mfma_f32_32x32x16_bf16(kf[6],qr[3],C0,0,0,0),   P1[10],P1[11],P1[12],P1[13], pw3[0]=PKW(P1,8), pw3[1]=PKW(P1,10), pw3); \
    VRD(7); SBAR(); GAPA(C1=__builtin_amdgcn_mfma_f32_32x32x16_bf16(kf[7],qr[3],C1,0,0,0),   P1[14],P1[15],0.f,0.f,       pw3[2]=PKW(P1,12),pw3[3]=PKW(P1,14), pw3); \
    l_reg+=keep_?sacc:0.f; \
    if(GK){DMA_K((t)+3,sl_cur);} if(GV){DMA_V((t)+1,sl_next);} \
    CMASK(C0,C1,t); \
    { float a=MX3(C0[0],C0[1],C1[0]),b=MX3(C0[2],C0[3],C1[1]); a=MX3(a,C1[2],C1[3]); \
      _Pragma("unroll") for(int r=4;r<16;r+=4){a=MX3(a,C0[r],C0[r+1]);b=MX3(b,C0[r+2],C0[r+3]);a=MX3(a,C1[r],C1[r+1]);b=MX3(b,C1[r+2],C1[r+3]);} \
      float rm=__builtin_fmaxf(a,b); { auto rr=__builtin_amdgcn_permlane32_swap(__float_as_uint(rm),__float_as_uint(rm),false,false); rm=__builtin_fmaxf(__uint_as_float(rr[0]),__uint_as_float(rr[1])); } \
      resc=false; \
      if(__builtin_expect(__any(rm>(float)THRL),0)){ const float dl=__builtin_fmaxf(rm,0.f); mhat+=dl; \
        _Pragma("unroll") for(int r=0;r<16;++r){C0[r]-=dl;C1[r]-=dl;} \
        _Pragma("unroll") for(int r=0;r<16;++r)negm[r]=-mhat; asm volatile("":"+v"(negm)); \
        const float f=__builtin_amdgcn_exp2f(-dl); l_reg*=f; if(hi==0)wsf[r32]=f; resc=true; } } \
    SBAR(); \
    GAPB(o[0]=__builtin_amdgcn_mfma_f32_32x32x16_bf16(PAF(0),VFR(0),o[0],0,0,0), C0,0); \
    GAPB(o[1]=__builtin_amdgcn_mfma_f32_32x32x16_bf16(PAF(0),VFR(4),o[1],0,0,0), C0,4); \
    KRD(GL,0); GAPB(o[0]=__builtin_amdgcn_mfma_f32_32x32x16_bf16(PAF(1),VFR(1),o[0],0,0,0), C0,8); \
    KRD(GL,1); GAPB(o[1]=__builtin_amdgcn_mfma_f32_32x32x16_bf16(PAF(1),VFR(5),o[1],0,0,0), C0,12); \
    KRD(GL,2); GAPB(o[0]=__builtin_amdgcn_mfma_f32_32x32x16_bf16(PAF(2),VFR(2),o[0],0,0,0), C1,0); \
    KRD(GL,3); GAPB(o[1]=__builtin_amdgcn_mfma_f32_32x32x16_bf16(PAF(2),VFR(6),o[1],0,0,0), C1,4); \
    GAPB(o[0]=__builtin_amdgcn_mfma_f32_32x32x16_bf16(PAF(3),VFR(3),o[0],0,0,0), C1,8); \
    GAPB(o[1]=__builtin_amdgcn_mfma_f32_32x32x16_bf16(PAF(3),VFR(7),o[1],0,0,0), C1,12); \
    }while(0)
  int t=1;
  for(;t+5<NT;t+=2){
    STEP(pB0,pB1,pA0,pA1,t,true,true,true);     WAIT_BAR(2); RESC(); ROT();
    STEP(pA0,pA1,pB0,pB1,t+1,true,true,true);   WAIT_BAR(2); RESC(); ROT();
  }
  #define ENDW(tt) do{ if((tt)+3<NT){WAIT_BAR(2);} else if((tt)+2<NT){WAIT_BAR(1);} else {WAIT_BAR(0);} }while(0)
  for(;t+1<NT;t+=2){
    STEP(pB0,pB1,pA0,pA1,t,(t+3<NT),(t+1<NT),(t+1<NT));       ENDW(t);   RESC(); ROT();
    STEP(pA0,pA1,pB0,pB1,t+1,(t+4<NT),(t+2<NT),(t+2<NT));     ENDW(t+1); RESC(); ROT();
  }
  STEP(pB0,pB1,pA0,pA1,NT-1,false,false,false); RESC();
  { const bool keep_=true; float sacc=pB0[0]+pB0[1]; _Pragma("unroll") for(int r=2;r<16;++r)sacc+=pB0[r]; _Pragma("unroll") for(int r=0;r<16;++r)sacc+=pB1[r]; l_reg+=sacc;
    pw0=(u32x4){PKW(pB0,0),PKW(pB0,2),PKW(pB0,4),PKW(pB0,6)};pw1=(u32x4){PKW(pB0,8),PKW(pB0,10),PKW(pB0,12),PKW(pB0,14)};pw2=(u32x4){PKW(pB1,0),PKW(pB1,2),PKW(pB1,4),PKW(pB1,6)};pw3=(u32x4){PKW(pB1,8),PKW(pB1,10),PKW(pB1,12),PKW(pB1,14)};
    SBAR(); pv(o,vb0+sl_cur,PAF(0),PAF(1),PAF(2),PAF(3)); }
  #undef PKW
  #undef PAF
  #undef VFR
  #undef PIN
  #undef MX3
  #undef GAPA
  #undef GAPB
  #undef EX
  #undef VRD
  #undef KRD
  #undef STEP
  #undef ENDW
  {auto rr=__builtin_amdgcn_permlane32_swap(__float_as_uint(l_reg),__float_as_uint(l_reg),false,false);l_reg=__uint_as_float(rr[0])+__uint_as_float(rr[1]);}
  if(hi==0)wsf[32+r32]=l_reg;asm volatile("s_waitcnt lgkmcnt(0)":::"memory");
  float rli[16];
  #pragma unroll
  for(int r=0;r<16;++r)rli[r]=__builtin_amdgcn_rcpf(wsf[32+crow(r,hi)]);
  { bf16*stg=(bf16*)(shm+LDS_OST)+wid*2048;
    int*dtab=(int*)(shm+LDS_DST)+wid*32;
    if(hi==0){ dtab[r32]=dest; if(dest>=0){ PML[2*(long)dest]=mhat; PML[2*(long)dest+1]=l_reg; } }
    #pragma unroll
    for(int r=0;r<16;++r){const int orow=crow(r,hi);
      #pragma unroll
      for(int d0=0;d0<2;++d0)stg[orow*64+d0*32+r32]=__float2bfloat16(o[d0][r]*rli[r]);}
    asm volatile("s_waitcnt lgkmcnt(0)":::"memory");
    #pragma unroll
    for(int i=0;i<4;++i){const int row=i*8+(lane>>3),ch=lane&7; const int dr=dtab[row]; const u32x4 v=*(const u32x4*)(stg+row*64+ch*8); if(dr>=0)*(u32x4*)(PO+(long)dr*64+ch*8)=v;} }
  asm volatile("s_waitcnt lgkmcnt(0)\n\ts_barrier":::"memory");
  #undef DMA_K
  #undef DMA_V
  #undef CMASK
  #undef BMASK
  #undef START
  #undef RESC
  #undef ROT
}
template<int THRL> __device__ __forceinline__ void moba_chunk4(const bf16*Qrow,bool causal,int dest,bf16*PO,float*PML,char*shm){
  int tid_=threadIdx.x; asm volatile("":"+v"(tid_)); const int tid=tid_,lane=tid&63,r32=lane&31,hi=lane>>5; const int wid=__builtin_amdgcn_readfirstlane(tid>>6);
  const unsigned lds0=(unsigned)(uintptr_t)shm;
  float*wsf=(float*)(shm+LDS_WS)+wid*64;
  const int vb0=(int)(lds0+LDS_V)+((lane>>4)&1)*32+(lane&3)*8+(4*hi+((lane&15)>>2))*64;
  const char*Kbase=shm+LDS_K; bf16x8 kf[8];
  const lds_cptr shm3=(lds_cptr)shm; const lds_cptr kp0=shm3+LDS_K+hi*1024+r32*16; const lds_cptr vp0=shm3+LDS_V+((lane>>4)&1)*32+(lane&3)*8+(4*hi+((lane&15)>>2))*64;
  constexpr int NT=4;
  bf16x8 qr[4];
  #pragma unroll
  for(int d0=0;d0<4;++d0)qr[d0]=*reinterpret_cast<const bf16x8*>(Qrow+d0*16+hi*8);
  float mhat=0.f,l_reg=0.f;f32x16 o[2];o[0]=f32x16{};o[1]=f32x16{};f32x16 negm=f32x16{};asm volatile("":"+v"(negm));
  const int qrel=wid*QBLK+r32;
  #define BMASK(P0,P1,t) do{}while(0)
  #define CMASK(P0,P1,t) do{ if(causal)cmask(P0,P1,(t),qrel,hi); }while(0)
  bool resc=false;
  #define START(P0,P1) do{ const float rm=rowmax(P0,P1); resc=false; \
    { const float dl=__builtin_fmaxf(rm,-64.f); mhat=fadd_s(mhat,dl); \
      _Pragma("unroll") for(int r=0;r<16;++r){P0[r]=fsub_s(P0[r],dl);P1[r]=fsub_s(P1[r],dl);} \
      _Pragma("unroll") for(int r=0;r<16;++r)negm[r]=-mhat; asm volatile("":"+v"(negm)); } \
    _Pragma("unroll") for(int r=0;r<16;++r)P0[r]=__builtin_amdgcn_exp2f(P0[r]); }while(0)
  #define RESC() do{ if(resc){ asm volatile("s_waitcnt lgkmcnt(0)":::"memory"); \
      _Pragma("unroll") for(int d_=0;d_<2;++d_) _Pragma("unroll") for(int r=0;r<16;++r)o[d_][r]*=wsf[crow(r,hi)]; } }while(0)
  f32x16 pA0,pA1,pB0,pB1;
  int sl_prev=0,sl_cur=0,sl_next=SLOTB;
  #define ROT() do{sl_prev=sl_cur;sl_cur=sl_next;sl_next=(sl_next==(NSLOT-1)*SLOTB)?0:sl_next+SLOTB;}while(0)
  qkt(pA0,pA1,Kbase,qr,negm,r32,hi);asm volatile("s_nop 15\n\ts_nop 7":"+v"(pA0),"+v"(pA1));CMASK(pA0,pA1,0);
  START(pA0,pA1);
  _Pragma("unroll") for(int r=0;r<16;++r)pA1[r]=__builtin_amdgcn_exp2f(pA1[r]);
  ROT();
  kload8(kf,kp0+sl_cur);
  s16x4 vlo[8],vhi[8]; u32x4 pw0,pw1,pw2,pw3;
  #define PKW(P,B) (keep_?cvtpk_s(P[B],P[B+1]):0u)
  #define PAF(k) __builtin_bit_cast(bf16x8,pw##k)
  #define VFR(i) (bf16x8){vlo[i][0],vlo[i][1],vlo[i][2],vlo[i][3],vhi[i][0],vhi[i][1],vhi[i][2],vhi[i][3]}
  #define PIN(x) asm volatile("":"+v"(x))
  #define MX3(a,b,c) __builtin_fmaxf(__builtin_fmaxf((a),(b)),(c))
  #define GAPA(MF,A0,A1,A2,A3,W0,W1,PW) do{ MF; sacc+=A0; sacc+=A1; sacc+=A2; sacc+=A3; PIN(sacc); W0; W1; PIN(PW); SBAR(); }while(0)
  #define EX(v) __builtin_amdgcn_exp2f(v)
  #define GAPB(MF,X,B) do{ MF; X[B]=EX(X[B]); X[B+1]=EX(X[B+1]); X[B+2]=EX(X[B+2]); X[B+3]=EX(X[B+3]); PIN(X); SBAR(); }while(0)
  #define VRD(i) do{ vlo[i]=vtr(vp_+(((i)>>2)*4096+((i)&3)*1024)); vhi[i]=vtr(vp_+(((i)>>2)*4096+((i)&3)*1024+512)); }while(0)
  #define KRD(G,j) do{ if(G){ kload2(kf,kp0+sl_next,j); SBAR(); } }while(0)
  #define STEP(C0,C1,P0,P1,t,GK,GV,GL) do{ SBAR(); \
    const bool keep_=true; \
    const lds_cptr vp_=vp0+sl_prev; \
    VRD(0); SBAR(); float sacc=(P0[0]+P0[1]); \
    GAPA(C0=__builtin_amdgcn_mfma_f32_32x32x16_bf16(kf[0],qr[0],negm,0,0,0), P0[2],P0[3],P0[4],P0[5],     pw0[0]=PKW(P0,0), pw0[1]=PKW(P0,2), pw0); \
    VRD(4); SBAR(); GAPA(C1=__builtin_amdgcn_mfma_f32_32x32x16_bf16(kf[1],qr[0],negm,0,0,0), P0[6],P0[7],P0[8],P0[9],     pw0[2]=PKW(P0,4), pw0[3]=PKW(P0,6), pw0); \
    VRD(1); SBAR(); GAPA(C0=__builtin_amdgcn_mfma_f32_32x32x16_bf16(kf[2],qr[1],C0,0,0,0),   P0[10],P0[11],P0[12],P0[13], pw1[0]=PKW(P0,8), pw1[1]=PKW(P0,10), pw1); \
    VRD(5); SBAR(); GAPA(C1=__builtin_amdgcn_mfma_f32_32x32x16_bf16(kf[3],qr[1],C1,0,0,0),   P0[14],P0[15],P1[0],P1[1],   pw1[2]=PKW(P0,12),pw1[3]=PKW(P0,14), pw1); \
    VRD(2); SBAR(); GAPA(C0=__builtin_amdgcn_mfma_f32_32x32x16_bf16(kf[4],qr[2],C0,0,0,0),   P1[2],P1[3],P1[4],P1[5],     pw2[0]=PKW(P1,0), pw2[1]=PKW(P1,2), pw2); \
    VRD(6); SBAR(); GAPA(C1=__builtin_amdgcn_mfma_f32_32x32x16_bf16(kf[5],qr[2],C1,0,0,0),   P1[6],P1[7],P1[8],P1[9],     pw2[2]=PKW(P1,4), pw2[3]=PKW(P1,6), pw2); \
    VRD(3); SBAR(); GAPA(C0=__builtin_amdgcn_mfma_f32_32x32x16_bf16(kf[6],qr[3],C0,0,0,0),   P1[10],P1[11],P1[12],P1[13], pw3[0]=PKW(P1,8), pw3[1]=PKW(P1,10), pw3); \
    VRD(7); SBAR(); GAPA(C1=__builtin_amdgcn_mfma_f32_32x32x16_bf16(kf[7],qr[3],C1,0,0,0),   P1[14],P1[15],0.f,0.f,       pw3[2]=PKW(P1,12),pw3[3]=PKW(P1,14), pw3); \
    l_reg+=keep_?sacc:0.f; \
    CMASK(C0,C1,t); \
    { float a=MX3(C0[0],C0[1],C1[0]),b=MX3(C0[2],C0[3],C1[1]); a=MX3(a,C1[2],C1[3]); \
      _Pragma("unroll") for(int r=4;r<16;r+=4){a=MX3(a,C0[r],C0[r+1]);b=MX3(b,C0[r+2],C0[r+3]);a=MX3(a,C1[r],C1[r+1]);b=MX3(b,C1[r+2],C1[r+3]);} \
      float rm=__builtin_fmaxf(a,b); { auto rr=__builtin_amdgcn_permlane32_swap(__float_as_uint(rm),__float_as_uint(rm),false,false); rm=__builtin_fmaxf(__uint_as_float(rr[0]),__uint_as_float(rr[1])); } \
      resc=false; \
      if(__builtin_expect(__any(rm>(float)THRL),0)){ const float dl=__builtin_fmaxf(rm,0.f); mhat+=dl; \
        _Pragma("unroll") for(int r=0;r<16;++r){C0[r]-=dl;C1[r]-=dl;} \
        _Pragma("unroll") for(int r=0;r<16;++r)negm[r]=-mhat; asm volatile("":"+v"(negm)); \
        const float f=__builtin_amdgcn_exp2f(-dl); l_reg*=f; if(hi==0)wsf[r32]=f; resc=true; } } \
    SBAR(); \
    GAPB(o[0]=__builtin_amdgcn_mfma_f32_32x32x16_bf16(PAF(0),VFR(0),o[0],0,0,0), C0,0); \
    GAPB(o[1]=__builtin_amdgcn_mfma_f32_32x32x16_bf16(PAF(0),VFR(4),o[1],0,0,0), C0,4); \
    KRD(GL,0); GAPB(o[0]=__builtin_amdgcn_mfma_f32_32x32x16_bf16(PAF(1),VFR(1),o[0],0,0,0), C0,8); \
    KRD(GL,1); GAPB(o[1]=__builtin_amdgcn_mfma_f32_32x32x16_bf16(PAF(1),VFR(5),o[1],0,0,0), C0,12); \
    KRD(GL,2); GAPB(o[0]=__builtin_amdgcn_mfma_f32_32x32x16_bf16(PAF(2),VFR(2),o[0],0,0,0), C1,0); \
    KRD(GL,3); GAPB(o[1]=__builtin_amdgcn_mfma_f32_32x32x16_bf16(PAF(2),VFR(6),o[1],0,0,0), C1,4); \
    GAPB(o[0]=__builtin_amdgcn_mfma_f32_32x32x16_bf16(PAF(3),VFR(3),o[0],0,0,0), C1,8); \
    GAPB(o[1]=__builtin_amdgcn_mfma_f32_32x32x16_bf16(PAF(3),VFR(7),o[1],0,0,0), C1,12); \
    }while(0)
  int t=1;
  for(;t+5<NT;t+=2){
    STEP(pB0,pB1,pA0,pA1,t,true,true,true);      RESC(); ROT();
    STEP(pA0,pA1,pB0,pB1,t+1,true,true,true);    RESC(); ROT();
  }
  #define ENDW(tt) do{ if((tt)+3<NT){} else if((tt)+2<NT){} else {} }while(0)
  for(;t+1<NT;t+=2){
    STEP(pB0,pB1,pA0,pA1,t,(t+3<NT),(t+1<NT),(t+1<NT));       ENDW(t);   RESC(); ROT();
    STEP(pA0,pA1,pB0,pB1,t+1,(t+4<NT),(t+2<NT),(t+2<NT));     ENDW(t+1); RESC(); ROT();
  }
  STEP(pB0,pB1,pA0,pA1,NT-1,false,false,false); RESC();
  { const bool keep_=true; float sacc=pB0[0]+pB0[1]; _Pragma("unroll") for(int r=2;r<16;++r)sacc+=pB0[r]; _Pragma("unroll") for(int r=0;r<16;++r)sacc+=pB1[r]; l_reg+=sacc;
    pw0=(u32x4){PKW(pB0,0),PKW(pB0,2),PKW(pB0,4),PKW(pB0,6)};pw1=(u32x4){PKW(pB0,8),PKW(pB0,10),PKW(pB0,12),PKW(pB0,14)};pw2=(u32x4){PKW(pB1,0),PKW(pB1,2),PKW(pB1,4),PKW(pB1,6)};pw3=(u32x4){PKW(pB1,8),PKW(pB1,10),PKW(pB1,12),PKW(pB1,14)};
    SBAR(); pv(o,vb0+sl_cur,PAF(0),PAF(1),PAF(2),PAF(3)); }
  #undef PKW
  #undef PAF
  #undef VFR
  #undef PIN
  #undef MX3
  #undef GAPA
  #undef GAPB
  #undef EX
  #undef VRD
  #undef KRD
  #undef STEP
  #undef ENDW
  {auto rr=__builtin_amdgcn_permlane32_swap(__float_as_uint(l_reg),__float_as_uint(l_reg),false,false);l_reg=__uint_as_float(rr[0])+__uint_as_float(rr[1]);}
  if(hi==0)wsf[32+r32]=l_reg;asm volatile("s_waitcnt lgkmcnt(0)":::"memory");
  float rli[16];
  #pragma unroll
  for(int r=0;r<16;++r)rli[r]=__builtin_amdgcn_rcpf(wsf[32+crow(r,hi)]);
  { bf16*stg=(bf16*)(shm+LDS_OST)+wid*2048;
    int*dtab=(int*)(shm+LDS_DST)+wid*32;
    if(hi==0){ dtab[r32]=dest; if(dest>=0){ PML[2*(long)dest]=mhat; PML[2*(long)dest+1]=l_reg; } }
    #pragma unroll
    for(int r=0;r<16;++r){const int orow=crow(r,hi);
      #pragma unroll
      for(int d0=0;d0<2;++d0)stg[orow*64+d0*32+r32]=__float2bfloat16(o[d0][r]*rli[r]);}
    asm volatile("s_waitcnt lgkmcnt(0)":::"memory");
    #pragma unroll
    for(int i=0;i<4;++i){const int row=i*8+(lane>>3),ch=lane&7; const int dr=dtab[row]; const u32x4 v=*(const u32x4*)(stg+row*64+ch*8); if(dr>=0)*(u32x4*)(PO+(long)dr*64+ch*8)=v;} }
  asm volatile("s_waitcnt lgkmcnt(0)":::"memory");
  #undef CMASK
  #undef BMASK
  #undef START
  #undef RESC
  #undef ROT
}

__device__ __forceinline__ void moba_load_kv(const bf16*Kh,const bf16*Vh,char*shm){
  int tid_=threadIdx.x; asm volatile("":"+v"(tid_)); const int lane=tid_&63; const int wid=__builtin_amdgcn_readfirstlane(tid_>>6);
  const unsigned lds0=(unsigned)(uintptr_t)shm;
  const bf16*ksrc=Kh+(long)lane*DM+wid*8;
  const bf16*vsrc=Vh+(long)(16*(wid&3)+(lane>>2))*DM+(wid>>2)*32+(lane&3)*8;
  const unsigned kdst=lds0+LDS_K+wid*1024, vdst=lds0+LDS_V+wid*1024;
  #pragma unroll
  for(int t=0;t<4;++t){ glds16(ksrc+(long)t*KVBLK*DM,(unsigned)__builtin_amdgcn_readfirstlane(kdst+t*SLOTB)); glds16(vsrc+(long)t*KVBLK*DM,(unsigned)__builtin_amdgcn_readfirstlane(vdst+t*SLOTB)); }
  asm volatile("s_waitcnt vmcnt(0)":::"memory");
}
constexpr int ATTN_LDS_BYTES=LDS_BYTES;
struct AttnTensors { const bf16* Q; const bf16* K; const bf16* V; bf16* O; const float* KM; };
struct AttnUnit { int bh; int qb; };
struct StaticOrder {
  int vcu;
  __device__ __forceinline__ explicit StaticOrder(int grid,int block):vcu((block%8)*(grid/8)+block/8){}
  __device__ __forceinline__ bool next(int i,AttnUnit&u)const{ if(i>=4)return false; const int s=vcu&7; u.bh=vcu>>3; u.qb=(i==0)?s:(i==1)?15-s:(i==2)?16+s:31-s; return true; }
  __device__ __forceinline__ void a_ready(const AttnUnit&)const{}
  __device__ __forceinline__ void done(const AttnUnit&)const{}
};
template<class Sched,int THRL=8> __device__ __forceinline__ void attn_phase(char*lds,const AttnTensors&T,const Sched&S){
  AttnUnit u; int lastbh=-1;
  for(int i=0;S.next(i,u);++i){
    if(u.bh!=lastbh){ __syncthreads(); float*km=(float*)(lds+LDS_KM); int tx_=threadIdx.x; asm volatile("":"+v"(tx_)); for(int k=tx_;k<32*64;k+=512)km[k]=T.KM[(long)u.bh*32*64+k]+T.KM[(long)(BATCH*NHEAD+u.bh)*32*64+k]; asm volatile("s_waitcnt vmcnt(0) lgkmcnt(0)":::"memory"); __syncthreads(); lastbh=u.bh; }
    attn_unit<THRL>(u.bh/NHEAD,u.bh%NHEAD,u.qb,T.Q,T.K,T.V,T.O,lds); }
}
#undef SBAR
#undef WAIT_BAR
}

#define XB_TMO      128
#define XB_XCNT(j)  (256  + 64 * (j))
#define XB_XSUB(j)  (1280 + 64 * (j))
#define XB_XGEN(j)  (2304 + 64 * (j))
#define XB_TOP      3328
#define XB_TOPGEN   3392
#define XCD_BAR_WORDS 3456
#define XB_SPIN_CAP (1u << 20)
__device__ __forceinline__ unsigned xb_ld(unsigned* p)              { return __hip_atomic_load(p, __ATOMIC_RELAXED, __HIP_MEMORY_SCOPE_AGENT); }
__device__ __forceinline__ unsigned xb_add(unsigned* p, unsigned v) { return __hip_atomic_fetch_add(p, v, __ATOMIC_RELAXED, __HIP_MEMORY_SCOPE_AGENT); }
__device__ __forceinline__ unsigned xb_xcc_id() { return (unsigned)__builtin_amdgcn_s_getreg((3 << 11) | 20) & 0xFu; }
#define XB_SPIN(cond, bar) do { unsigned _sp = 0; while (cond) { __builtin_amdgcn_s_sleep(1); \
    if ((++_sp & 255u) == 0u) { if (xb_ld(&(bar)[XB_TMO])) break; if (_sp > XB_SPIN_CAP) { atomicAdd(&(bar)[XB_TMO], 1u); break; } } } } while (0)
struct XcdBarrier { unsigned* bar; unsigned x; volatile LAS unsigned* st; };
__device__ __forceinline__ XcdBarrier xcd_barrier_post(unsigned* bar, volatile LAS unsigned* st) {
    XcdBarrier b; b.bar = bar; b.x = xb_xcc_id(); b.st = st;
    if (threadIdx.x == 0) (void)xb_add(&bar[XB_XCNT(b.x)], 1u);
    return b;
}
__device__ __forceinline__ void xcd_barrier_complete(unsigned* bar, unsigned x, unsigned& nloc, unsigned& nx) {
    const unsigned G = gridDim.x * gridDim.y * gridDim.z;
    unsigned sum, cnt, mine, sp = 0u;
    for (;;) {
        sum = 0u; cnt = 0u; mine = 0u;
#pragma unroll
        for (unsigned j = 0; j < 16; ++j) { const unsigned c = xb_ld(&bar[XB_XCNT(j)]); sum += c; cnt += (c > 0u) ? 1u : 0u; mine = (j == x) ? c : mine; }
        if (sum == G) break;
        __builtin_amdgcn_s_sleep(1);
        if ((++sp & 255u) == 0u) { if (xb_ld(&bar[XB_TMO])) break; if (sp > XB_SPIN_CAP) { atomicAdd(&bar[XB_TMO], 1u); break; } }
    }
    nloc = mine > 0u ? mine : 1u; nx = cnt > 0u ? cnt : 1u;
}
__device__ __forceinline__ void xcd_barrier(const XcdBarrier& b) {
    asm volatile("s_waitcnt vmcnt(0)" ::: "memory");
    __syncthreads();
    if (threadIdx.x == 0) {
        unsigned* bar = b.bar;
        __builtin_amdgcn_s_waitcnt(0);
        unsigned nloc = b.st[0], nx = b.st[1];
        if (nloc == 0u) { xcd_barrier_complete(bar, b.x, nloc, nx); b.st[0] = nloc; b.st[1] = nx; }
        const unsigned old = xb_add(&bar[XB_XSUB(b.x)], 1u);
        const unsigned gen = old / nloc;
        if (old + 1u == (gen + 1u) * nloc) {
            __builtin_amdgcn_fence(__ATOMIC_RELEASE, "agent");
            asm volatile("s_waitcnt vmcnt(0)" ::: "memory");
            const unsigned og = xb_add(&bar[XB_TOP], 1u);
            const unsigned tg = og / nx;
            if (og + 1u == (tg + 1u) * nx) xb_add(&bar[XB_TOPGEN], 1u);
            else XB_SPIN(xb_ld(&bar[XB_TOPGEN]) == tg, bar);
            __builtin_amdgcn_fence(__ATOMIC_ACQUIRE, "agent");
            xb_add(&bar[XB_XGEN(b.x)], 1u);
            asm volatile("s_waitcnt vmcnt(0)" ::: "memory");
        } else {
            XB_SPIN(xb_ld(&bar[XB_XGEN(b.x)]) == gen, bar);
            __builtin_amdgcn_fence(__ATOMIC_ACQUIRE, "agent");
            asm volatile("s_waitcnt vmcnt(0)" ::: "memory");
        }
    }
    __syncthreads();
}

struct Args { const float* in[28]; float* out; unsigned char* ws; int ph_lo, ph_hi; };
enum { I_X = 0, I_MEM, I_GMIX, I_WIN, I_ARE, I_AIM, I_LOGDT, I_BRE, I_BIM, I_CRE, I_CIM, I_DSKIP, I_WGLU, I_WPA, I_WOUT, I_GXATTN, I_GMEM, I_WXQ, I_WXKV, I_WXO,
       I_GMOE, I_WROUTER, I_BROUTER, I_WGU, I_BGU, I_WDN, I_BDN, I_GFINAL };

struct TrDesc { const float* W; const float* gain; bf16_t* WT; int K, N, map, item; };
__device__ __forceinline__ void tr_load(const TrDesc& d, f32x4 (&v)[16], float (&g)[16], int lane) {
    const int nblk = d.N / 64, kb = d.item / nblk, nb = d.item % nblk, k0 = 64 * kb, n0 = 64 * nb, q = lane & 15, kr = lane >> 4;
    const float* src = d.W + (size_t)(k0 + kr) * d.N + n0 + 4 * q;
#pragma unroll
    for (int j = 0; j < 16; ++j) v[j] = *(const f32x4*)(src + (size_t)(4 * j) * d.N);
#pragma unroll
    for (int j = 0; j < 16; ++j) g[j] = d.gain ? d.gain[k0 + kr + 4 * j] : 1.0f;
}
__device__ __forceinline__ void tr_finish(const TrDesc& d, const f32x4 (&v)[16], const float (&g)[16], LAS float* scr, int lane) {
    const int nblk = d.N / 64, kb = d.item / nblk, nb = d.item % nblk, k0 = 64 * kb, n0 = 64 * nb, q = lane & 15, kr = lane >> 4;
#pragma unroll
    for (int j = 0; j < 16; ++j) { const int kk = kr + 4 * j; *(LAS f32x4*)(scr + kk * 64 + 4 * (q ^ ((kk >> 3) & 7))) = v[j] * g[j]; }
    asm volatile("s_waitcnt lgkmcnt(0)" ::: "memory");
    const int c = lane & 7, nq = lane >> 3;
    const int nr0 = d.map ? (256 * ((n0 % 1024) / 128) + 128 * (n0 / 1024) + (n0 % 128)) : n0;
#pragma unroll
    for (int jj = 0; jj < 8; ++jj) { const int n = 8 * jj + nq; const LAS float* sp = scr + (8 * c) * 64 + (n ^ (4 * c));
        u32x4 o; o.x = pk2(sp[0 * 64], sp[1 * 64]); o.y = pk2(sp[2 * 64], sp[3 * 64]); o.z = pk2(sp[4 * 64], sp[5 * 64]); o.w = pk2(sp[6 * 64], sp[7 * 64]);
        *(u32x4*)(d.WT + (size_t)(nr0 + n) * d.K + k0 + 8 * c) = o; }
    asm volatile("s_waitcnt lgkmcnt(0)" ::: "memory");
}
template <int MODE>
__device__ __forceinline__ float rms_row_to_bf16(const float* xrow, const float* gain, bf16_t* orow, int lane) {
    const f32x4* xr = (const f32x4*)xrow + lane;
    f32x4 v[4]; float s = 0.f;
#pragma unroll
    for (int j = 0; j < 4; ++j) { v[j] = xr[64 * j]; s += (v[j][0] * v[j][0] + v[j][1] * v[j][1]) + (v[j][2] * v[j][2] + v[j][3] * v[j][3]); }
    const float rstd = 1.0f / sqrtf(wave_sum(s) * (1.0f / DM) + RMS_EPS);
    u32x2* o8 = (u32x2*)orow + lane;
#pragma unroll
    for (int j = 0; j < 4; ++j) { f32x4 w = v[j];
        if (MODE == 1) { const f32x4 g = ((const f32x4*)gain)[lane + 64 * j]; w = w * rstd * g; }
        u32x2 o; o.x = pk2(w[0], w[1]); o.y = pk2(w[2], w[3]); o8[64 * j] = o; }
    return rstd;
}

struct Frame {
    LAS unsigned char* lds; int tid, lane, wave, G, bid;
    const float* in[28]; float* out; unsigned char* ws; unsigned* ctl;
};
#define WSP(type, off) ((type*)(F.ws + (off)))

__device__ __forceinline__ TrDesc tr_decode(Frame& F, int it) {
    constexpr int I_IN = (DM / 64) * (INW / 64), I_GLU = (SW / 64) * (2 * DM / 64), I_PA = (AW / 64) * (DM / 64), I_OUT = (DM / 64) * (DM / 64), I_XQ = (DM / 64) * (XW / 64),
                  I_XKV = (DM / 64) * (2 * XW / 64), I_XO = (XW / 64) * (DM / 64), I_GU1 = (DM / 64) * (2 * DFF / 64), I_DN1 = (DFF / 64) * (DM / 64);
    int r = it;
    if (r < I_IN) return TrDesc{F.in[I_WIN], F.in[I_GMIX], WSP(bf16_t, WS_WIN), DM, INW, 0, r}; r -= I_IN;
    if (r < I_GLU) return TrDesc{F.in[I_WGLU], nullptr, WSP(bf16_t, WS_WGLU), SW, 2 * DM, 1, r}; r -= I_GLU;
    if (r < I_PA) return TrDesc{F.in[I_WPA], nullptr, WSP(bf16_t, WS_WPA), AW, DM, 0, r}; r -= I_PA;
    if (r < I_OUT) return TrDesc{F.in[I_WOUT], nullptr, WSP(bf16_t, WS_WOUT), DM, DM, 0, r}; r -= I_OUT;
    if (r < I_XQ) return TrDesc{F.in[I_WXQ], F.in[I_GXATTN], WSP(bf16_t, WS_WXQ), DM, XW, 0, r}; r -= I_XQ;
    if (r < I_XKV) return TrDesc{F.in[I_WXKV], nullptr, WSP(bf16_t, WS_WXKV), DM, 2 * XW, 0, r}; r -= I_XKV;
    if (r < I_XO) return TrDesc{F.in[I_WXO], nullptr, WSP(bf16_t, WS_WXO), XW, DM, 0, r}; r -= I_XO;
    const int e = r / (I_GU1 + I_DN1); r -= e * (I_GU1 + I_DN1);
    if (r < I_GU1) return TrDesc{F.in[I_WGU] + (size_t)e * DM * 2 * DFF, F.in[I_GMOE], WSP(bf16_t, WS_WGU) + (size_t)e * 2 * DFF * DM, DM, 2 * DFF, 1, r};
    return TrDesc{F.in[I_WDN] + (size_t)e * DFF * DM, nullptr, WSP(bf16_t, WS_WDN) + (size_t)e * DM * DFF, DFF, DM, 0, r - I_GU1};
}
__device__ __forceinline__ void xrow_load(const float* X, int m, f32x4 (&v)[4][4], int lane) {
#pragma unroll
    for (int r = 0; r < 4; ++r)
#pragma unroll
        for (int j = 0; j < 4; ++j) v[r][j] = ((const f32x4*)(X + (size_t)(m + r) * DM))[lane + 64 * j];
}
__device__ __forceinline__ void xrow_finish(bf16_t* XBp, int m, const f32x4 (&v)[4][4], int lane) {
    float ss[4];
#pragma unroll
    for (int r = 0; r < 4; ++r) { float s = 0.f;
#pragma unroll
        for (int j = 0; j < 4; ++j) s += (v[r][j][0] * v[r][j][0] + v[r][j][1] * v[r][j][1]) + (v[r][j][2] * v[r][j][2] + v[r][j][3] * v[r][j][3]);
        ss[r] = s; }
#pragma unroll
    for (int o = 1; o < 64; o <<= 1) {
#pragma unroll
        for (int r = 0; r < 4; ++r) ss[r] += __shfl_xor(ss[r], o); }
#pragma unroll
    for (int r = 0; r < 4; ++r) { u32x2* o8 = (u32x2*)(XBp + (size_t)(m + r) * DM) + lane;
        const float rs = 1.0f / sqrtf(ss[r] * (1.0f / DM) + RMS_EPS);
#pragma unroll
        for (int j = 0; j < 4; ++j) { u32x2 o; o.x = pk2(v[r][j][0] * rs, v[r][j][1] * rs); o.y = pk2(v[r][j][2] * rs, v[r][j][3] * rs); o8[64 * j] = o; } }
}
__device__ __forceinline__ void phase_prologue(Frame& F) {
    LAS float* scr = (LAS float*)(F.lds + F.wave * 16384);
    const int gw = F.bid * 8 + F.wave, NGW = F.G * 8;
    { f32x4 va[4][4], vb[4][4]; const int step = NGW * 4, m0 = gw * 4, n = (m0 < T_) ? (T_ - m0 + step - 1) / step : 0;
      if (n > 0) { xrow_load(F.in[I_X], m0, va, F.lane); int i = 0;
          for (; i + 2 <= n; i += 2) {
              xrow_load(F.in[I_X], m0 + (i + 1) * step, vb, F.lane);
              xrow_finish(WSP(bf16_t, WS_XB), m0 + i * step, va, F.lane);
              xrow_load(F.in[I_X], m0 + min(i + 2, n - 1) * step, va, F.lane);
              xrow_finish(WSP(bf16_t, WS_XB), m0 + (i + 1) * step, vb, F.lane); }
          if (i < n) xrow_finish(WSP(bf16_t, WS_XB), m0 + i * step, va, F.lane); } }
    for (int m = gw; m < NB * MEML; m += NGW) (void)rms_row_to_bf16<1>(F.in[I_MEM] + (size_t)m * DM, F.in[I_GMEM], WSP(bf16_t, WS_MN) + (size_t)m * DM, F.lane);
    constexpr int NITEMS = (DM / 64) * (INW / 64) + (SW / 64) * (2 * DM / 64) + (AW / 64) * (DM / 64) + (DM / 64) * (DM / 64) + (DM / 64) * (XW / 64) + (DM / 64) * (2 * XW / 64) + (XW / 64) * (DM / 64)
                         + NE * ((DM / 64) * (2 * DFF / 64) + (DFF / 64) * (DM / 64));
    { f32x4 va[16], vb[16]; float ga[16], gb[16]; TrDesc da, db; const int n = (gw < NITEMS) ? (NITEMS - gw + NGW - 1) / NGW : 0;
      if (n > 0) { da = tr_decode(F, gw); tr_load(da, va, ga, F.lane); int i = 0;
          for (; i + 2 <= n; i += 2) {
              db = tr_decode(F, gw + (i + 1) * NGW); tr_load(db, vb, gb, F.lane);
              tr_finish(da, va, ga, scr, F.lane);
              da = tr_decode(F, gw + min(i + 2, n - 1) * NGW); tr_load(da, va, ga, F.lane);
              tr_finish(db, vb, gb, scr, F.lane); }
          if (i < n) tr_finish(da, va, ga, scr, F.lane); } }
}

__device__ __forceinline__ void phase_kmean(Frame& F) {
    LAS float* red = (LAS float*)F.lds;
    const bf16_t* Kb = WSP(bf16_t, WS_K);
    for (int it = F.bid; it < NB * NH * NBLK; it += F.G) {
        const int j = it % NBLK, h = (it / NBLK) % NH, b = it / (NBLK * NH);
        const int col = F.tid & 63, rg = F.tid >> 6; float s = 0.f;
        const bf16_t* p = Kb + ((size_t)(b * SEQ + j * MBLK + rg * 32)) * AW + h * HD + col;
#pragma unroll 8
        for (int r = 0; r < 32; ++r) s += bf2f(p[(size_t)r * AW]);
        red[rg * 64 + col] = s;
        __syncthreads();
        if (F.tid < 64) { float t = 0.f;
#pragma unroll
            for (int k = 0; k < 8; ++k) t += red[k * 64 + F.tid];
            WSP(float, WS_KMEAN)[(size_t)it * HD + F.tid] = t * (1.0f / MBLK); }
        __syncthreads();
    }
}

__device__ __forceinline__ void phase_moba_simple(Frame& F, bf16_t* Ob) {
    LAS unsigned* Ks = (LAS unsigned*)F.lds;
    LAS unsigned* Vs = (LAS unsigned*)(F.lds + 32768);
    LAS float* km = (LAS float*)(F.lds + 65536);
    const bf16_t *Qb = WSP(bf16_t, WS_Q), *Kb = WSP(bf16_t, WS_K), *Vb = WSP(bf16_t, WS_V);
    const int ql = F.tid >> 1, half = F.tid & 1;
    for (int it = F.bid; it < NB * NH * NBLK; it += F.G) {
        const int iblk = (NBLK - 1) - (it % NBLK), h = (it / NBLK) % NH, b = it / (NBLK * NH);
        __syncthreads();
        for (int k = F.tid; k < NBLK * HD; k += 512) km[k] = WSP(float, WS_KMEAN)[(size_t)((b * NH + h) * NBLK) * HD + k] + WSP(float, WS_KMEAN)[(size_t)((NB * NH + b * NH + h) * NBLK) * HD + k];
        float q[32];
        { const u32x4* qp = (const u32x4*)(Qb + (size_t)(b * SEQ + iblk * MBLK + ql) * AW + h * HD + half * 32);
#pragma unroll
          for (int c = 0; c < 4; ++c) { const u32x4 w = qp[c]; q[8 * c + 0] = bflo(w.x); q[8 * c + 1] = bfhi(w.x); q[8 * c + 2] = bflo(w.y); q[8 * c + 3] = bfhi(w.y); q[8 * c + 4] = bflo(w.z); q[8 * c + 5] = bfhi(w.z); q[8 * c + 6] = bflo(w.w); q[8 * c + 7] = bfhi(w.w); } }
        __syncthreads();
        float g0 = -3e38f, g1 = -3e38f, g2 = -3e38f; int s0 = -1, s1 = -1, s2 = -1;
        for (int j = 0; j < iblk; ++j) { float g = 0.f;
#pragma unroll
            for (int d = 0; d < 32; ++d) g += q[d] * km[j * HD + half * 32 + d];
            g += __shfl_xor(g, 1);
            if (g > g0) { g2 = g1; s2 = s1; g1 = g0; s1 = s0; g0 = g; s0 = j; } else if (g > g1) { g2 = g1; s2 = s1; g1 = g; s1 = j; } else if (g > g2) { g2 = g; s2 = j; } }
        float mx = -3e38f, l = 0.f, o[32];
#pragma unroll
        for (int d = 0; d < 32; ++d) o[d] = 0.f;
        for (int jb = 0; jb <= iblk; ++jb) {
            __syncthreads();
            { const size_t rowb = (size_t)(b * SEQ + jb * MBLK);
              for (int c = F.tid; c < 256 * 8; c += 512) { const int r = c >> 3, ch = c & 7;
                  *(LAS u32x4*)(Ks + r * 32 + ch * 4) = *(const u32x4*)(Kb + (rowb + r) * AW + h * HD + ch * 8);
                  *(LAS u32x4*)(Vs + r * 32 + ch * 4) = *(const u32x4*)(Vb + (rowb + r) * AW + h * HD + ch * 8); } }
            __syncthreads();
            const bool need = (jb == iblk) || jb == s0 || jb == s1 || jb == s2;
            if (need) { const int kend = (jb == iblk) ? ql : 255;
                for (int kk = 0; kk <= kend; ++kk) { float s = 0.f;
#pragma unroll
                    for (int c = 0; c < 4; ++c) { const u32x4 w = *(const LAS u32x4*)(Ks + kk * 32 + half * 16 + c * 4);
                        s += q[8 * c + 0] * bflo(w.x) + q[8 * c + 1] * bfhi(w.x) + q[8 * c + 2] * bflo(w.y) + q[8 * c + 3] * bfhi(w.y) + q[8 * c + 4] * bflo(w.z) + q[8 * c + 5] * bfhi(w.z) + q[8 * c + 6] * bflo(w.w) + q[8 * c + 7] * bfhi(w.w); }
                    s += __shfl_xor(s, 1);
                    const float mn = fmaxf(mx, s), corr = __builtin_amdgcn_exp2f(mx - mn), p = __builtin_amdgcn_exp2f(s - mn); mx = mn; l = l * corr + p;
#pragma unroll
                    for (int c = 0; c < 4; ++c) { const u32x4 w = *(const LAS u32x4*)(Vs + kk * 32 + half * 16 + c * 4);
                        o[8 * c + 0] = o[8 * c + 0] * corr + p * bflo(w.x); o[8 * c + 1] = o[8 * c + 1] * corr + p * bfhi(w.x); o[8 * c + 2] = o[8 * c + 2] * corr + p * bflo(w.y); o[8 * c + 3] = o[8 * c + 3] * corr + p * bfhi(w.y);
                        o[8 * c + 4] = o[8 * c + 4] * corr + p * bflo(w.z); o[8 * c + 5] = o[8 * c + 5] * corr + p * bfhi(w.z); o[8 * c + 6] = o[8 * c + 6] * corr + p * bflo(w.w); o[8 * c + 7] = o[8 * c + 7] * corr + p * bfhi(w.w); } } }
        }
        const float il = 1.0f / l;
        u32x4* op = (u32x4*)(Ob + (size_t)(b * SEQ + iblk * MBLK + ql) * AW + h * HD + half * 32);
#pragma unroll
        for (int c = 0; c < 4; ++c) { u32x4 w; w.x = pk2(o[8 * c + 0] * il, o[8 * c + 1] * il); w.y = pk2(o[8 * c + 2] * il, o[8 * c + 3] * il); w.z = pk2(o[8 * c + 4] * il, o[8 * c + 5] * il); w.w = pk2(o[8 * c + 6] * il, o[8 * c + 7] * il); op[c] = w; }
    }
}

__device__ __forceinline__ void phase_ssm_simple(Frame& F, bf16_t* Yb) {
    const int gw = F.bid * 8 + F.wave, NGW = F.G * 8, p = F.lane;
    const bf16_t* Ub = WSP(bf16_t, WS_U);
    for (int it = gw; it < NB * NG; it += NGW) {
        const int g = it % NG, b = it / NG;
        const float are = fminf(F.in[I_ARE][g * SP + p], -1e-4f), aim = F.in[I_AIM][g * SP + p], dt = expf(F.in[I_LOGDT][g]);
        const float mag = expf(are * dt), ang = aim * dt; const float lr = mag * cosf(ang), li = mag * sinf(ang);
        const float nr = lr - 1.0f, ni = li, den = 1.0f / (are * are + aim * aim); const float fr_ = (nr * are + ni * aim) * den, fi_ = (ni * are - nr * aim) * den;
        float bbr[16], bbi[16], cr[16], ci[16], dsk[16];
#pragma unroll
        for (int c = 0; c < 16; ++c) { const float br = F.in[I_BRE][(size_t)(g * SP + p) * SGC + c], bi = F.in[I_BIM][(size_t)(g * SP + p) * SGC + c];
            bbr[c] = fr_ * br - fi_ * bi; bbi[c] = fr_ * bi + fi_ * br;
            cr[c] = F.in[I_CRE][(size_t)(g * SGC + c) * SP + p]; ci[c] = F.in[I_CIM][(size_t)(g * SGC + c) * SP + p]; dsk[c] = F.in[I_DSKIP][g * SGC + c]; }
        float xr = 0.f, xi = 0.f;
        const int csel = ((p >> 5) & 1) * 8 + ((p >> 4) & 1) * 4 + ((p >> 3) & 1) * 2 + ((p >> 2) & 1);
        float dmine = 0.f;
#pragma unroll
        for (int c = 0; c < 16; ++c) dmine = (c == csel) ? dsk[c] : dmine;
        for (int t = 0; t < SEQ; ++t) {
            const u32x4* up = (const u32x4*)(Ub + (size_t)(b * SEQ + t) * SW + g * SGC); const u32x4 w0 = up[0], w1 = up[1];
            float u[16]; u[0] = bflo(w0.x); u[1] = bfhi(w0.x); u[2] = bflo(w0.y); u[3] = bfhi(w0.y); u[4] = bflo(w0.z); u[5] = bfhi(w0.z); u[6] = bflo(w0.w); u[7] = bfhi(w0.w);
            u[8] = bflo(w1.x); u[9] = bfhi(w1.x); u[10] = bflo(w1.y); u[11] = bfhi(w1.y); u[12] = bflo(w1.z); u[13] = bfhi(w1.z); u[14] = bflo(w1.w); u[15] = bfhi(w1.w);
            float sr = 0.f, si = 0.f;
#pragma unroll
            for (int c = 0; c < 16; ++c) { sr += bbr[c] * u[c]; si += bbi[c] * u[c]; }
            const float nxr = lr * xr - li * xi + sr, nxi = lr * xi + li * xr + si; xr = nxr; xi = nxi;
            float y[16];
#pragma unroll
            for (int c = 0; c < 16; ++c) y[c] = cr[c] * xr - ci[c] * xi;
            float w8[8], w4[4], w2[2], w1_;
            { const bool hi = (p & 32) != 0;
#pragma unroll
              for (int i = 0; i < 8; ++i) { const float keep = hi ? y[i + 8] : y[i], send = hi ? y[i] : y[i + 8]; w8[i] = keep + __shfl_xor(send, 32); } }
            { const bool hi = (p & 16) != 0;
#pragma unroll
              for (int i = 0; i < 4; ++i) { const float keep = hi ? w8[i + 4] : w8[i], send = hi ? w8[i] : w8[i + 4]; w4[i] = keep + __shfl_xor(send, 16); } }
            { const bool hi = (p & 8) != 0;
#pragma unroll
              for (int i = 0; i < 2; ++i) { const float keep = hi ? w4[i + 2] : w4[i], send = hi ? w4[i] : w4[i + 2]; w2[i] = keep + __shfl_xor(send, 8); } }
            { const bool hi = (p & 4) != 0; const float keep = hi ? w2[1] : w2[0], send = hi ? w2[0] : w2[1]; w1_ = keep + __shfl_xor(send, 4); }
            w1_ += __shfl_xor(w1_, 2); w1_ += __shfl_xor(w1_, 1);
            float umine = 0.f;
#pragma unroll
            for (int c = 0; c < 16; ++c) umine = (c == csel) ? u[c] : umine;
            if ((p & 3) == 0) Yb[(size_t)(b * SEQ + t) * SW + g * SGC + csel] = (bf16_t)f2bf(gelu_tanh(w1_ + dmine * umine));
        }
    }
}


__device__ __forceinline__ void p0_ssm_tables(Frame& F, int task) {
    const int g = task >> 3, part = task & 7;
    LAS float* pwr = (LAS float*)F.lds; LAS float* pwi = pwr + 65 * 64; LAS float* bbr = pwi + 65 * 64; LAS float* bbi = bbr + 1024; LAS float* ccr = bbi + 1024; LAS float* cci = ccr + 1024;
    const float dt = expf(F.in[I_LOGDT][g]);
    __syncthreads();
    for (int i = F.tid; i < 65 * 64; i += 512) { const int k = i >> 6, p = i & 63; const float are = fminf(F.in[I_ARE][g * SP + p], -1e-4f), aim = F.in[I_AIM][g * SP + p];
        const float mag = expf(are * dt * (float)k); double a = (double)aim * (double)dt * (double)k; a -= 6.283185307179586 * rint(a * 0.15915494309189535); const float af = (float)a;
        pwr[i] = mag * cosf(af); pwi[i] = mag * sinf(af); }
    for (int i = F.tid; i < 1024; i += 512) { const int p = i >> 4, c = i & 15; const float are = fminf(F.in[I_ARE][g * SP + p], -1e-4f), aim = F.in[I_AIM][g * SP + p];
        const float mag = expf(are * dt); double a = (double)aim * (double)dt; a -= 6.283185307179586 * rint(a * 0.15915494309189535); const float af = (float)a;
        const float lr = mag * cosf(af), li = mag * sinf(af), nr = lr - 1.0f, ni = li, den = 1.0f / (are * are + aim * aim), fr_ = (nr * are + ni * aim) * den, fi_ = (ni * are - nr * aim) * den;
        const float br = F.in[I_BRE][(size_t)(g * SP + p) * SGC + c], bi = F.in[I_BIM][(size_t)(g * SP + p) * SGC + c];
        bbr[i] = fr_ * br - fi_ * bi; bbi[i] = fr_ * bi + fi_ * br; }
    for (int i = F.tid; i < 1024; i += 512) { ccr[i] = F.in[I_CRE][(size_t)g * 1024 + i]; cci[i] = F.in[I_CIM][(size_t)g * 1024 + i]; }
    __syncthreads();
    bf16_t* WST = WSP(bf16_t, WS_WST) + (size_t)g * 128 * 1024; bf16_t* GT = WSP(bf16_t, WS_GT) + (size_t)g * 1024 * 128; bf16_t* KT = WSP(bf16_t, WS_KT) + (size_t)g * 65 * 256;
    for (int j = 0; j < 32; ++j) { const int e = part * 16384 + j * 512 + F.tid; const int pp = e >> 10, k = e & 1023, s = k >> 4, c = k & 15, p = pp & 63;
        const float mr = pwr[(63 - s) * 64 + p], mi = pwi[(63 - s) * 64 + p], br = bbr[p * 16 + c], bi = bbi[p * 16 + c];
        WST[e] = (bf16_t)f2bf(pp < 64 ? (mr * br - mi * bi) : (mr * bi + mi * br)); }
    for (int j = 0; j < 32; ++j) { const int e = part * 16384 + j * 512 + F.tid; const int sc = e >> 7, pp = e & 127, s = sc >> 4, c = sc & 15, p = pp & 63;
        const float mr = pwr[(s + 1) * 64 + p], mi = pwi[(s + 1) * 64 + p], cr = ccr[c * 64 + p], ci = cci[c * 64 + p];
        GT[e] = (bf16_t)f2bf(pp < 64 ? (cr * mr - ci * mi) : -(cr * mi + ci * mr)); }
    for (int e = part * 2080 + F.tid; e < (part + 1) * 2080; e += 512) { const int tt = e >> 8, c = (e >> 4) & 15, c2 = e & 15; float acc = 0.f;
        if (tt > 0) { const int tau = tt - 1;
            for (int p = 0; p < 64; ++p) { const float mr = pwr[tau * 64 + p], mi = pwi[tau * 64 + p], cr = ccr[c * 64 + p], ci = cci[c * 64 + p]; const float zr = cr * mr - ci * mi, zi = cr * mi + ci * mr; acc += zr * bbr[p * 16 + c2] - zi * bbi[p * 16 + c2]; } }
        KT[e] = (bf16_t)f2bf(acc); }
    if (part == 0 && F.tid < 64) { WSP(f32x2, WS_LAML)[g * 64 + F.tid] = (f32x2){pwr[64 * 64 + F.tid], pwi[64 * 64 + F.tid]}; }
    __syncthreads();
}
__device__ __forceinline__ void ssm_state_item(Frame& F, int b, int g, int h) {
    const int w = F.wave, row = F.lane & 15, kg = F.lane >> 4;
    f32x4 acc[4];
#pragma unroll
    for (int c = 0; c < 4; ++c) acc[c] = (f32x4){0.f, 0.f, 0.f, 0.f};
    const bf16_t* Ub = WSP(bf16_t, WS_U) + ((size_t)b * SEQ + (size_t)(16 * w + row) * 64 + (kg >> 1)) * SW + g * SGC + 8 * (kg & 1);
    const bf16_t* Wb = WSP(bf16_t, WS_WST) + ((size_t)g * 128 + 32 * h + row) * 1024 + 8 * kg;
#pragma unroll 4
    for (int ks = 0; ks < 32; ++ks) {
        const bf16x8 a = *(const bf16x8*)(Ub + ((size_t)(2 * ks)) * SW);
        bf16x8 bq[4];
#pragma unroll
        for (int nt = 0; nt < 4; ++nt) bq[nt] = *(const bf16x8*)(Wb + (size_t)((nt & 1) * 16 + (nt >> 1) * 64) * 1024 + 32 * ks);
#pragma unroll
        for (int nt = 0; nt < 4; ++nt) acc[nt] = __builtin_amdgcn_mfma_f32_16x16x32_bf16(a, bq[nt], acc[nt], 0, 0, 0);
    }
    LAS float* X = (LAS float*)F.lds;
    __syncthreads();
#pragma unroll
    for (int nt = 0; nt < 4; ++nt)
#pragma unroll
        for (int r = 0; r < 4; ++r) X[(16 * w + 4 * kg + r) * 64 + (nt >> 1) * 32 + (nt & 1) * 16 + row] = acc[nt][r];
    __syncthreads();
    if (w == 0 && F.lane < 32) { const int p = 32 * h + F.lane; const f32x2 lam = WSP(f32x2, WS_LAML)[g * 64 + p]; float sr = 0.f, si = 0.f;
        bf16_t* SS = WSP(bf16_t, WS_SST) + ((size_t)(b * NG + g) * 128) * 128;
#pragma unroll 4
        for (int n = 0; n < 128; ++n) { SS[n * 128 + p] = (bf16_t)f2bf(sr); SS[n * 128 + 64 + p] = (bf16_t)f2bf(si);
            const float xr = X[n * 64 + F.lane], xi = X[n * 64 + 32 + F.lane]; const float nsr = lam.x * sr - lam.y * si + xr, nsi = lam.x * si + lam.y * sr + xi; sr = nsr; si = nsi; } }
    __syncthreads();
}
constexpr int SO_USTR = 2064, SO_KT = 32 * SO_USTR, SO_SS = SO_KT + 65 * 512, SO_SSTR = 272;
__device__ __forceinline__ void ssm_out_item(Frame& F, int b, int g, int rr) {
    LAS unsigned char* L = F.lds;
    const int w = F.wave, lane = F.lane, r32 = lane & 31, hi = lane >> 5, sp = r32 >> 4, cch = r32 & 15;
    __syncthreads();
    { const bf16_t* Ug = WSP(bf16_t, WS_U) + ((size_t)b * SEQ + (size_t)rr * 2048) * SW + g * SGC;
#pragma unroll
      for (int j = 0; j < 8; ++j) { const int c = F.tid + 512 * j, r = c >> 1, half = c & 1; *(LAS u32x4*)(L + (r >> 6) * SO_USTR + (r & 63) * 32 + half * 16) = *(const u32x4*)(Ug + (size_t)r * SW + half * 8); }
      const u32x4* Kg = (const u32x4*)(WSP(bf16_t, WS_KT) + (size_t)g * 65 * 256);
      for (int c = F.tid; c < 2080; c += 512) *(LAS u32x4*)(L + SO_KT + c * 16) = Kg[c];
      { const int c = F.tid, ch = c >> 4, pc = c & 15; *(LAS u32x4*)(L + SO_SS + ch * SO_SSTR + pc * 16) = *(const u32x4*)(WSP(bf16_t, WS_SST) + ((size_t)((b * NG + g) * 128 + rr * 32 + ch)) * 128 + pc * 8); } }
    const bf16_t* Gg = WSP(bf16_t, WS_GT) + ((size_t)g * 1024 + (2 * w + sp) * 16 + cch) * 128 + 8 * hi;
    bf16x8 gb[2][8];
#pragma unroll
    for (int k2 = 0; k2 < 8; ++k2) gb[0][k2] = *(const bf16x8*)(Gg + 16 * k2);
    __syncthreads();
    f32x16 acc[4];
#pragma unroll
    for (int a = 0; a < 4; ++a)
#pragma unroll
        for (int r = 0; r < 16; ++r) acc[a][r] = 0.f;
    const LAS unsigned char* Ua = L + r32 * SO_USTR + hi * 16;
    const LAS unsigned char* Kb_ = L + SO_KT + (2 * w + sp + 1) * 512 + cch * 32 + hi * 16;
#define SO_SEG(A0, LO, HI) for (int s1 = (LO); s1 < (HI); ++s1) { const bf16x8 av = *(const LAS bf16x8*)(Ua + s1 * 32); \
        _Pragma("unroll") for (int a = (A0); a < 4; ++a) { const bf16x8 bv = *(const LAS bf16x8*)(Kb_ + a * 8192 - s1 * 512); acc[a] = __builtin_amdgcn_mfma_f32_32x32x16_bf16(av, bv, acc[a], 0, 0, 0); } }
    SO_SEG(0, 0, 2 * w + 2)
    SO_SEG(1, 2 * w + 2, 2 * w + 18)
    SO_SEG(2, 2 * w + 18, 2 * w + 34)
    SO_SEG(3, 2 * w + 34, 2 * w + 50)
#undef SO_SEG
    bf16x8 sa[8];
#pragma unroll
    for (int k2 = 0; k2 < 8; ++k2) sa[k2] = *(const LAS bf16x8*)(L + SO_SS + r32 * SO_SSTR + k2 * 32 + hi * 16);
#pragma unroll
    for (int a = 0; a < 4; ++a) {
        if (a < 3) {
#pragma unroll
            for (int k2 = 0; k2 < 8; ++k2) gb[(a + 1) & 1][k2] = *(const bf16x8*)(Gg + (size_t)(a + 1) * (16 * 16 * 128) + 16 * k2); }
#pragma unroll
        for (int k2 = 0; k2 < 8; ++k2) acc[a] = __builtin_amdgcn_mfma_f32_32x32x16_bf16(sa[k2], gb[a & 1][k2], acc[a], 0, 0, 0);
    }
    __syncthreads();
    const float dsk = F.in[I_DSKIP][g * SGC + cch];
    { LAS unsigned char* yb = L + (4 * hi) * SO_USTR + (2 * w + sp) * 32 + cch * 2;
#pragma unroll
      for (int a = 0; a < 4; ++a)
#pragma unroll
          for (int r = 0; r < 16; ++r) { LAS unsigned short* p = (LAS unsigned short*)(yb + ((r & 3) + 8 * (r >> 2)) * SO_USTR + a * 512); const float u = bf2f(*p); *p = (unsigned short)f2bf(gelu_tanh(acc[a][r] + dsk * u)); } }
    __syncthreads();
    { bf16_t* Yg = WSP(bf16_t, WS_YB) + ((size_t)b * SEQ + (size_t)rr * 2048) * SW + g * SGC;
#pragma unroll 2
      for (int j = 0; j < 8; ++j) { const int c = F.tid + 512 * j, r = c >> 1, half = c & 1; *(u32x4*)(Yg + (size_t)r * SW + half * 8) = *(const LAS u32x4*)(L + (r >> 6) * SO_USTR + (r & 63) * 32 + half * 16); } }
}
__device__ __forceinline__ void phase_ssm_out(Frame& F) {
    for (int it = F.bid; it < NB * NG * 4; it += F.G) ssm_out_item(F, it >> 7, (it >> 2) & 31, it & 3);
    __syncthreads();
}


__device__ __forceinline__ void moba_route_item(Frame& F, int bh, int i) {
    LAS float* km = (LAS float*)F.lds;
    LAS unsigned* lc = (LAS unsigned*)(F.lds + 8192); LAS unsigned* lb = lc + 32;
    const int b = bh >> 3, h = bh & 7, ql = F.tid >> 1, half = F.tid & 1;
    __syncthreads();
    { const float* K0 = WSP(float, WS_KM2) + (size_t)bh * NBLK * HD; const float* K1 = K0 + (size_t)NB * NH * NBLK * HD;
      for (int k = F.tid; k < NBLK * HD; k += 512) km[k] = K0[k] + K1[k]; }
    if (F.tid < 32) lc[F.tid] = 0u;
    float q[32];
    { const u32x4* qp = (const u32x4*)(WSP(bf16_t, WS_Q) + (size_t)(b * SEQ + i * MBLK + ql) * AW + h * HD + half * 32);
#pragma unroll
      for (int c = 0; c < 4; ++c) { const u32x4 w = qp[c]; q[8 * c + 0] = bflo(w.x); q[8 * c + 1] = bfhi(w.x); q[8 * c + 2] = bflo(w.y); q[8 * c + 3] = bfhi(w.y); q[8 * c + 4] = bflo(w.z); q[8 * c + 5] = bfhi(w.z); q[8 * c + 6] = bflo(w.w); q[8 * c + 7] = bfhi(w.w); } }
    __syncthreads();
    float g0 = -3e38f, g1 = -3e38f, g2 = -3e38f; int s0 = -1, s1 = -1, s2 = -1;
    for (int j = 0; j < i; ++j) { float g = 0.f;
#pragma unroll
        for (int d = 0; d < 32; ++d) g += q[d] * km[j * HD + half * 32 + d];
        g += __shfl_xor(g, 1);
        if (g > g0) { g2 = g1; s2 = s1; g1 = g0; s1 = s0; g0 = g; s0 = j; } else if (g > g1) { g2 = g1; s2 = s1; g1 = g; s1 = j; } else if (g > g2) { g2 = g; s2 = j; } }
    unsigned r0 = 0u, r1 = 0u, r2 = 0u;
    if (half == 0) { if (s0 >= 0) r0 = __hip_atomic_fetch_add(&lc[s0], 1u, __ATOMIC_RELAXED, __HIP_MEMORY_SCOPE_WORKGROUP); if (s1 >= 0) r1 = __hip_atomic_fetch_add(&lc[s1], 1u, __ATOMIC_RELAXED, __HIP_MEMORY_SCOPE_WORKGROUP);
        if (s2 >= 0) r2 = __hip_atomic_fetch_add(&lc[s2], 1u, __ATOMIC_RELAXED, __HIP_MEMORY_SCOPE_WORKGROUP); }
    __syncthreads();
    if (F.tid < 32) { const unsigned n = lc[F.tid]; lb[F.tid] = n ? atomicAdd(F.ctl + CW_MCNT + bh * NBLK + F.tid, n) : 0u; }
    __syncthreads();
    if (half == 0) { unsigned short* ML = WSP(unsigned short, WS_MLIST) + (size_t)bh * NBLK * 8192; const unsigned e = (unsigned)(i * MBLK + ql) * 4u;
        f32x2* pml = WSP(f32x2, WS_PML) + ((size_t)bh * SEQ + i * MBLK + ql) * 4;
        if (s0 >= 0) ML[(size_t)s0 * 8192 + lb[s0] + r0] = (unsigned short)(e + 0u); else pml[0] = (f32x2){-1e30f, 0.f};
        if (s1 >= 0) ML[(size_t)s1 * 8192 + lb[s1] + r1] = (unsigned short)(e + 1u); else pml[1] = (f32x2){-1e30f, 0.f};
        if (s2 >= 0) ML[(size_t)s2 * 8192 + lb[s2] + r2] = (unsigned short)(e + 2u); else pml[2] = (f32x2){-1e30f, 0.f}; }
}
template <int EXPM> __device__ __forceinline__ void moba_sparse_phase(Frame& F, char* lds_generic) {
    LAS unsigned* cl = (LAS unsigned*)(F.lds + attn_body::LDS_BYTES);
    LAS unsigned* pf = cl + 128;
    const int x = F.bid & 7, slot = F.bid >> 3, nslots = F.G >> 3;
    __syncthreads();
    if (F.tid < 128) cl[F.tid] = __hip_atomic_load(F.ctl + CW_MCNT + (x + 8 * (F.tid >> 5)) * NBLK + (F.tid & 31), RLX_AGENT);
    __syncthreads();
    if (F.tid == 0) { unsigned a = 0; for (int i = 0; i < 128; ++i) { pf[i] = a; a += 1u + ((cl[i] + 255u) >> 8); } pf[128] = a; }
    __syncthreads();
    const int total = (int)pf[128]; int pos = (int)(((long)total * slot) / nslots); const int end = (int)(((long)total * (slot + 1)) / nslots);
    const attn_body::bf16* Qb = (const attn_body::bf16*)WSP(bf16_t, WS_Q); const attn_body::bf16* Kb = (const attn_body::bf16*)WSP(bf16_t, WS_K); const attn_body::bf16* Vb = (const attn_body::bf16*)WSP(bf16_t, WS_V);
    attn_body::bf16* PO = (attn_body::bf16*)WSP(bf16_t, WS_PO); float* PML = WSP(float, WS_PML);
    const int wid = F.wave;
    int L = 0;
    while (pos < end) {
        while ((int)pf[L + 1] <= pos) ++L;
        const int m = L >> 5, j = L & 31, bh = x + 8 * m, b = bh >> 3, h = bh & 7, cnt = (int)cl[L];
        const int c0 = pos - (int)pf[L], c1 = min((int)pf[L + 1], end) - (int)pf[L];
        const size_t kvrow = (size_t)b * SEQ + (size_t)j * MBLK;
        __syncthreads();
        attn_body::moba_load_kv(Kb + kvrow * AW + h * HD, Vb + kvrow * AW + h * HD, lds_generic);
        __syncthreads();
        for (int c = c0; c < c1; ++c) {
            int l_ = F.lane; asm volatile("" : "+v"(l_)); const int r32 = l_ & 31;
            int qg, dest; bool causal;
            if (c == 0) { qg = j * MBLK + wid * 32 + r32; dest = (EXPM == 1) ? -1 : (bh * SEQ + qg) * 4 + 3; causal = true; }
            else { const int base = (c - 1) * 256 + wid * 32; if (base >= cnt) continue;
                const int idx = base + r32; causal = false;
                if (EXPM == 1) { qg = j * MBLK + wid * 32 + r32; dest = -1; }
                else if (idx < cnt) { const unsigned e = WSP(unsigned short, WS_MLIST)[((size_t)bh * NBLK + j) * 8192 + idx]; qg = (int)(e >> 2); dest = (bh * SEQ + qg) * 4 + (int)(e & 3u); }
                else { qg = j * MBLK + r32; dest = -1; } }
            attn_body::moba_chunk4<8>(Qb + ((size_t)b * SEQ + qg) * AW + h * HD, causal, dest, PO, PML, lds_generic);
        }
        pos += c1 - c0;
    }
    __syncthreads();
}
__device__ __forceinline__ void moba_combine_phase(Frame& F) {
    const bf16_t* PO = WSP(bf16_t, WS_PO); const f32x2* PML = WSP(f32x2, WS_PML); bf16_t* ATT = WSP(bf16_t, WS_ATT);
    for (size_t it = (size_t)F.bid * 512 + F.tid; it < (size_t)NB * NH * SEQ * 8; it += (size_t)F.G * 512) {
        const size_t r = it >> 3; const int ch = (int)(it & 7); const int bh = (int)(r / SEQ), qg = (int)(r % SEQ), b = bh >> 3, h = bh & 7;
        const f32x2 a0 = PML[r * 4 + 0], a1 = PML[r * 4 + 1], a2 = PML[r * 4 + 2], a3 = PML[r * 4 + 3];
        const float M = fmaxf(fmaxf(a0.x, a1.x), fmaxf(a2.x, a3.x));
        const float w0 = a0.y * __builtin_amdgcn_exp2f(a0.x - M), w1 = a1.y * __builtin_amdgcn_exp2f(a1.x - M), w2 = a2.y * __builtin_amdgcn_exp2f(a2.x - M), w3 = a3.y * __builtin_amdgcn_exp2f(a3.x - M);
        const float inv = 1.0f / (w0 + w1 + w2 + w3);
        float o[8] = {0.f, 0.f, 0.f, 0.f, 0.f, 0.f, 0.f, 0.f};
#define CMB(k, wk) if (wk > 0.f) { const u32x4 v = *(const u32x4*)(PO + (r * 4 + k) * 64 + ch * 8); o[0] += wk * bflo(v.x); o[1] += wk * bfhi(v.x); o[2] += wk * bflo(v.y); o[3] += wk * bfhi(v.y); o[4] += wk * bflo(v.z); o[5] += wk * bfhi(v.z); o[6] += wk * bflo(v.w); o[7] += wk * bfhi(v.w); }
        CMB(0, w0) CMB(1, w1) CMB(2, w2) CMB(3, w3)
#undef CMB
        u32x4 w; w.x = pk2(o[0] * inv, o[1] * inv); w.y = pk2(o[2] * inv, o[3] * inv); w.z = pk2(o[4] * inv, o[5] * inv); w.w = pk2(o[6] * inv, o[7] * inv);
        *(u32x4*)(ATT + ((size_t)b * SEQ + qg) * AW + h * HD + ch * 8) = w;
    }
}

__device__ __forceinline__ void phase_xattn_simple(Frame& F, bf16_t* Ob) {
    LAS unsigned* Ks = (LAS unsigned*)F.lds;
    LAS unsigned* Vs = (LAS unsigned*)(F.lds + 65536);
    const bf16_t *Qb = WSP(bf16_t, WS_XQ), *KV = WSP(bf16_t, WS_MKV);
    const int tl = F.tid >> 2, part = F.tid & 3;
    int lastbh = -1;
    for (int it = F.bid; it < NB * XH * (SEQ / 128); it += F.G) {
        const int bh = it / (SEQ / 128), ch = it % (SEQ / 128), b = bh / XH, h = bh % XH;
        if (bh != lastbh) { __syncthreads();
            for (int c = F.tid; c < 256 * 16; c += 512) { const int r = c >> 4, cc = c & 15;
                *(LAS u32x4*)(Ks + r * 64 + cc * 4) = *(const u32x4*)(KV + (size_t)(b * MEML + r) * (2 * XW) + h * XD + cc * 8);
                *(LAS u32x4*)(Vs + r * 64 + cc * 4) = *(const u32x4*)(KV + (size_t)(b * MEML + r) * (2 * XW) + XW + h * XD + cc * 8); }
            __syncthreads(); lastbh = bh; }
        const size_t row = (size_t)b * SEQ + ch * 128 + tl;
        float q[32];
        { const u32x4* qp = (const u32x4*)(Qb + row * XW + h * XD + part * 32);
#pragma unroll
          for (int c = 0; c < 4; ++c) { const u32x4 w = qp[c]; q[8 * c + 0] = bflo(w.x); q[8 * c + 1] = bfhi(w.x); q[8 * c + 2] = bflo(w.y); q[8 * c + 3] = bfhi(w.y); q[8 * c + 4] = bflo(w.z); q[8 * c + 5] = bfhi(w.z); q[8 * c + 6] = bflo(w.w); q[8 * c + 7] = bfhi(w.w); } }
        float mx = -3e38f, l = 0.f, o[32];
#pragma unroll
        for (int d = 0; d < 32; ++d) o[d] = 0.f;
        for (int kk = 0; kk < MEML; ++kk) { float s = 0.f;
#pragma unroll
            for (int c = 0; c < 4; ++c) { const u32x4 w = *(const LAS u32x4*)(Ks + kk * 64 + part * 16 + c * 4);
                s += q[8 * c + 0] * bflo(w.x) + q[8 * c + 1] * bfhi(w.x) + q[8 * c + 2] * bflo(w.y) + q[8 * c + 3] * bfhi(w.y) + q[8 * c + 4] * bflo(w.z) + q[8 * c + 5] * bfhi(w.z) + q[8 * c + 6] * bflo(w.w) + q[8 * c + 7] * bfhi(w.w); }
            s += __shfl_xor(s, 1); s += __shfl_xor(s, 2);
            const float mn = fmaxf(mx, s), corr = __builtin_amdgcn_exp2f(mx - mn), p = __builtin_amdgcn_exp2f(s - mn); mx = mn; l = l * corr + p;
#pragma unroll
            for (int c = 0; c < 4; ++c) { const u32x4 w = *(const LAS u32x4*)(Vs + kk * 64 + part * 16 + c * 4);
                o[8 * c + 0] = o[8 * c + 0] * corr + p * bflo(w.x); o[8 * c + 1] = o[8 * c + 1] * corr + p * bfhi(w.x); o[8 * c + 2] = o[8 * c + 2] * corr + p * bflo(w.y); o[8 * c + 3] = o[8 * c + 3] * corr + p * bfhi(w.y);
                o[8 * c + 4] = o[8 * c + 4] * corr + p * bflo(w.z); o[8 * c + 5] = o[8 * c + 5] * corr + p * bfhi(w.z); o[8 * c + 6] = o[8 * c + 6] * corr + p * bflo(w.w); o[8 * c + 7] = o[8 * c + 7] * corr + p * bfhi(w.w); } }
        const float il = 1.0f / l;
        u32x4* op = (u32x4*)(Ob + row * XW + h * XD + part * 32);
#pragma unroll
        for (int c = 0; c < 4; ++c) { u32x4 w; w.x = pk2(o[8 * c + 0] * il, o[8 * c + 1] * il); w.y = pk2(o[8 * c + 2] * il, o[8 * c + 3] * il); w.z = pk2(o[8 * c + 4] * il, o[8 * c + 5] * il); w.w = pk2(o[8 * c + 6] * il, o[8 * c + 7] * il); op[c] = w; }
    }
}

__device__ __forceinline__ void phase_router(Frame& F) {
    LAS float* wt = (LAS float*)F.lds;
    for (int c = F.tid; c < NE * DM; c += 512) { const int k = c >> 5, e = c & 31; wt[e * DM + k] = F.in[I_WROUTER][c] * F.in[I_GMOE][k]; }
    __syncthreads();
    const int gw = F.bid * 8 + F.wave, NGW = F.G * 8, lane = F.lane;
    const float* H = WSP(float, WS_H);
    unsigned* cnt = F.ctl + CW_CNT;
    for (int tk = gw; tk < T_; tk += NGW) {
        const f32x4* hp = (const f32x4*)(H + (size_t)tk * DM) + lane; f32x4 hv[4]; float ss = 0.f;
#pragma unroll
        for (int j = 0; j < 4; ++j) { hv[j] = hp[64 * j]; ss += (hv[j][0] * hv[j][0] + hv[j][1] * hv[j][1]) + (hv[j][2] * hv[j][2] + hv[j][3] * hv[j][3]); }
        const float rstd = 1.0f / sqrtf(wave_sum(ss) * (1.0f / DM) + RMS_EPS);
        float mylogit = 0.f;
#pragma unroll 4
        for (int e = 0; e < NE; ++e) { float a = 0.f;
#pragma unroll
            for (int j = 0; j < 4; ++j) { const f32x4 w = *(const LAS f32x4*)(wt + e * DM + 4 * lane + 256 * j); a += (hv[j][0] * w[0] + hv[j][1] * w[1]) + (hv[j][2] * w[2] + hv[j][3] * w[3]); }
            a = wave_sum(a);
            mylogit = (lane == e) ? a : mylogit; }
        mylogit = (lane < NE) ? (mylogit * rstd + F.in[I_BROUTER][lane & 31]) : -3e38f;
        float tv[4]; int ti[4]; float cur = mylogit;
#pragma unroll
        for (int s = 0; s < 4; ++s) { float bv = cur; int bi = lane;
#pragma unroll
            for (int o = 1; o < 64; o <<= 1) { const float ov = __shfl_xor(bv, o); const int oi = __shfl_xor(bi, o); if (ov > bv || (ov == bv && oi < bi)) { bv = ov; bi = oi; } }
            tv[s] = bv; ti[s] = bi; if (lane == bi) cur = -3e38f; }
        const float e1 = __expf(tv[1] - tv[0]), e2 = __expf(tv[2] - tv[0]), e3 = __expf(tv[3] - tv[0]); const float inv = 1.0f / (1.0f + e1 + e2 + e3);
        if (lane == 0) WSP(float, WS_RSTD2)[tk] = rstd;
        if (lane < 4) { const int ex = (lane == 0) ? ti[0] : (lane == 1) ? ti[1] : (lane == 2) ? ti[2] : ti[3]; const float gv = ((lane == 0) ? 1.0f : (lane == 1) ? e1 : (lane == 2) ? e2 : e3) * inv;
            WSP(float, WS_TKG)[(size_t)tk * 4 + lane] = gv;
            const unsigned rank = atomicAdd(&cnt[ex], 1u);
            WSP(int, WS_ROWLIST)[(size_t)ex * T_ + rank] = tk * 4 + lane; }
    }
}


constexpr int XA_VSTR = 520, XA_VT = 65536;
__device__ __forceinline__ bf16x8 pack8(const f32x16& s, int o) {
    u32x4 w; w.x = pg8::cvt_pk_bf16(s[o + 0], s[o + 1]); w.y = pg8::cvt_pk_bf16(s[o + 2], s[o + 3]); w.z = pg8::cvt_pk_bf16(s[o + 4], s[o + 5]); w.w = pg8::cvt_pk_bf16(s[o + 6], s[o + 7]);
    return __builtin_bit_cast(bf16x8, w);
}
__device__ __forceinline__ void phase_xattn(Frame& F) {
    LAS unsigned char* L = F.lds;
    const bf16_t *Qb = WSP(bf16_t, WS_XQ), *KV = WSP(bf16_t, WS_MKV); bf16_t* Ob = WSP(bf16_t, WS_XO);
    const int lane = F.lane, r32 = lane & 31, hi = lane >> 5, wid = F.wave;
    const int NU = NB * XH * (SEQ / 256), UPB = (NU + F.G - 1) / F.G;
    int lastbh = -1;
    for (int u = F.bid * UPB; u < NU && u < (F.bid + 1) * UPB; ++u) {
        const int bh = u >> 5, qb = u & 31, b = bh >> 2, h = bh & 3;
        if (bh != lastbh) {
            __syncthreads();
            for (int c = F.tid; c < 256 * 16; c += 512) { const int m = c >> 4, ch = c & 15; *(LAS u32x4*)(L + m * 256 + ((ch ^ (m & 15)) << 4)) = *(const u32x4*)(KV + (size_t)(b * MEML + m) * (2 * XW) + h * XD + ch * 8); }
            { const bf16_t* VTg = WSP(bf16_t, WS_MVT) + ((size_t)b * XW + h * XD) * MEML;
              for (int c = F.tid; c < 128 * 64; c += 512) { const int d = c >> 6, pc = c & 63; *(LAS u32x2*)(L + XA_VT + d * XA_VSTR + pc * 8) = *(const u32x2*)(VTg + (size_t)d * MEML + pc * 4); } }
            __syncthreads(); lastbh = bh; }
        const size_t row = (size_t)b * SEQ + qb * 256 + wid * 32 + r32;
        bf16x8 qf[8];
#pragma unroll
        for (int kd = 0; kd < 8; ++kd) qf[kd] = *(const bf16x8*)(Qb + row * XW + h * XD + 16 * kd + 8 * hi);
        f32x16 o[4];
#pragma unroll
        for (int dt = 0; dt < 4; ++dt)
#pragma unroll
            for (int r = 0; r < 16; ++r) o[dt][r] = 0.f;
        float mrun = -1e30f, lrun = 0.f;
#pragma unroll 1
        for (int c = 0; c < 4; ++c) {
            f32x16 s0, s1;
#pragma unroll
            for (int r = 0; r < 16; ++r) { s0[r] = 0.f; s1[r] = 0.f; }
            const int kv0 = c * 64 + r32, kv1 = kv0 + 32;
#pragma unroll
            for (int kd = 0; kd < 8; ++kd) { const int ch = 2 * kd + hi;
                const bf16x8 k0 = *(const LAS bf16x8*)(L + kv0 * 256 + ((ch ^ (kv0 & 15)) << 4)), k1 = *(const LAS bf16x8*)(L + kv1 * 256 + ((ch ^ (kv1 & 15)) << 4));
                s0 = __builtin_amdgcn_mfma_f32_32x32x16_bf16(k0, qf[kd], s0, 0, 0, 0); s1 = __builtin_amdgcn_mfma_f32_32x32x16_bf16(k1, qf[kd], s1, 0, 0, 0); }
            float mx = fmaxf(s0[0], s1[0]);
#pragma unroll
            for (int r = 1; r < 16; ++r) mx = fmaxf(mx, fmaxf(s0[r], s1[r]));
            mx = fmaxf(mx, __shfl_xor(mx, 32));
            const float mn = fmaxf(mrun, mx), sc = __builtin_amdgcn_exp2f(mrun - mn); mrun = mn;
            float ls = 0.f;
#pragma unroll
            for (int r = 0; r < 16; ++r) { s0[r] = __builtin_amdgcn_exp2f(s0[r] - mn); s1[r] = __builtin_amdgcn_exp2f(s1[r] - mn); ls += s0[r] + s1[r]; }
            ls += __shfl_xor(ls, 32); lrun = lrun * sc + ls;
#pragma unroll
            for (int dt = 0; dt < 4; ++dt)
#pragma unroll
                for (int r = 0; r < 16; ++r) o[dt][r] *= sc;
            bf16x8 pf[4]; pf[0] = pack8(s0, 0); pf[1] = pack8(s0, 8); pf[2] = pack8(s1, 0); pf[3] = pack8(s1, 8);
#pragma unroll
            for (int dt = 0; dt < 4; ++dt)
#pragma unroll
                for (int ks = 0; ks < 4; ++ks) { const LAS unsigned char* vp = L + XA_VT + (dt * 32 + r32) * XA_VSTR + (c * 64 + 16 * ks + 4 * hi) * 2;
                    const u32x2 lo = *(const LAS u32x2*)vp, hh = *(const LAS u32x2*)(vp + 16); u32x4 w; w.x = lo.x; w.y = lo.y; w.z = hh.x; w.w = hh.y;
                    o[dt] = __builtin_amdgcn_mfma_f32_32x32x16_bf16(__builtin_bit_cast(bf16x8, w), pf[ks], o[dt], 0, 0, 0); }
        }
        const float il = 1.0f / lrun;
        bf16_t* op = Ob + row * XW + h * XD + 4 * hi;
#pragma unroll
        for (int dt = 0; dt < 4; ++dt)
#pragma unroll
            for (int g4 = 0; g4 < 4; ++g4) { u32x2 w; w.x = pg8::cvt_pk_bf16(o[dt][4 * g4] * il, o[dt][4 * g4 + 1] * il); w.y = pg8::cvt_pk_bf16(o[dt][4 * g4 + 2] * il, o[dt][4 * g4 + 3] * il);
                *(u32x2*)(op + dt * 32 + 8 * g4) = w; }
    }
    __syncthreads();
}

constexpr int RT_WSTR = 1028, RT_LG = NE * RT_WSTR * 4  , RT_LCNT = RT_LG + 8 * 16 * 33 * 4  , RT_LBASE = RT_LCNT + 128, RT_RS = RT_LBASE + 128  ;
__device__ __forceinline__ void phase_router_mfma(Frame& F) {
    LAS float* wt = (LAS float*)F.lds;
    __syncthreads();
    for (int c = F.tid; c < NE * DM; c += 512) { const int k = c >> 5, e = c & 31; wt[e * RT_WSTR + k] = F.in[I_WROUTER][c] * F.in[I_GMOE][k]; }
    LAS unsigned* lcnt = (LAS unsigned*)(F.lds + RT_LCNT); LAS unsigned* lbase = (LAS unsigned*)(F.lds + RT_LBASE);
    const int lane = F.lane, wid = F.wave, row = lane & 15, kq = lane >> 4;
    LAS float* lg = (LAS float*)(F.lds + RT_LG) + wid * (16 * 33); LAS float* rsl = (LAS float*)(F.lds + RT_RS) + wid * 16;
    const bf16_t* HBp = WSP(bf16_t, WS_HB); bf16_t* N2 = WSP(bf16_t, WS_N2B); unsigned* cnt = F.ctl + CW_CNT;
    for (int chunk = F.bid; chunk < T_ / 128; chunk += F.G) {
        if (F.tid < 32) lcnt[F.tid] = 0u;
        __syncthreads();
        const int tok0 = chunk * 128 + wid * 16;
        f32x4 acc0 = {0.f, 0.f, 0.f, 0.f}, acc1 = {0.f, 0.f, 0.f, 0.f}; float ss = 0.f;
        const bf16_t* hp = HBp + (size_t)(tok0 + row) * DM + 8 * kq;
        const LAS float* w0 = wt + row * RT_WSTR + 8 * kq; const LAS float* w1 = w0 + 16 * RT_WSTR;
#pragma unroll 4
        for (int i = 0; i < 32; ++i) { const u32x4 hw = *(const u32x4*)(hp + 32 * i);
            const float a[8] = {bflo(hw.x), bfhi(hw.x), bflo(hw.y), bfhi(hw.y), bflo(hw.z), bfhi(hw.z), bflo(hw.w), bfhi(hw.w)};
            const f32x4 b00 = *(const LAS f32x4*)(w0 + 32 * i), b01 = *(const LAS f32x4*)(w0 + 32 * i + 4), b10 = *(const LAS f32x4*)(w1 + 32 * i), b11 = *(const LAS f32x4*)(w1 + 32 * i + 4);
#pragma unroll
            for (int e = 0; e < 8; ++e) ss += a[e] * a[e];
#pragma unroll
            for (int e = 0; e < 4; ++e) { acc0 = __builtin_amdgcn_mfma_f32_16x16x4f32(a[e], b00[e], acc0, 0, 0, 0); acc1 = __builtin_amdgcn_mfma_f32_16x16x4f32(a[e], b10[e], acc1, 0, 0, 0); }
#pragma unroll
            for (int e = 0; e < 4; ++e) { acc0 = __builtin_amdgcn_mfma_f32_16x16x4f32(a[4 + e], b01[e], acc0, 0, 0, 0); acc1 = __builtin_amdgcn_mfma_f32_16x16x4f32(a[4 + e], b11[e], acc1, 0, 0, 0); } }
        ss += __shfl_xor(ss, 16); ss += __shfl_xor(ss, 32);
        const float rstd = 1.0f / sqrtf(ss * (1.0f / DM) + RMS_EPS);
#pragma unroll
        for (int r = 0; r < 4; ++r) { lg[(4 * kq + r) * 33 + row] = acc0[r]; lg[(4 * kq + r) * 33 + 16 + row] = acc1[r]; }
        if (lane < 16) rsl[lane] = rstd;
        asm volatile("s_waitcnt lgkmcnt(0)" ::: "memory");
#pragma unroll 4
        for (int t = 0; t < 16; ++t) { const float rs = rsl[t]; const u32x4* src = (const u32x4*)(HBp + (size_t)(tok0 + t) * DM) + lane; u32x4* dst = (u32x4*)(N2 + (size_t)(tok0 + t) * DM) + lane;
#pragma unroll
            for (int hh = 0; hh < 2; ++hh) { const u32x4 w = src[64 * hh]; u32x4 o; o.x = pk2(bflo(w.x) * rs, bfhi(w.x) * rs); o.y = pk2(bflo(w.y) * rs, bfhi(w.y) * rs); o.z = pk2(bflo(w.z) * rs, bfhi(w.z) * rs); o.w = pk2(bflo(w.w) * rs, bfhi(w.w) * rs); dst[64 * hh] = o; } }
        int ex[4] = {0, 0, 0, 0}; unsigned lrank[4] = {0u, 0u, 0u, 0u}; const int tk = tok0 + lane;
        if (lane < 16) {
            float v[32];
#pragma unroll
            for (int e = 0; e < 32; ++e) v[e] = lg[lane * 33 + e] * rstd + F.in[I_BROUTER][e];
            float tv[4];
#pragma unroll
            for (int s = 0; s < 4; ++s) { float bv = v[0]; int bi = 0;
#pragma unroll
                for (int e = 1; e < 32; ++e) if (v[e] > bv) { bv = v[e]; bi = e; }
#pragma unroll
                for (int e = 0; e < 32; ++e) v[e] = (e == bi) ? -3e38f : v[e];
                tv[s] = bv; ex[s] = bi; }
            const float e1 = __expf(tv[1] - tv[0]), e2 = __expf(tv[2] - tv[0]), e3 = __expf(tv[3] - tv[0]); const float inv = 1.0f / (1.0f + e1 + e2 + e3);
            *(f32x4*)(WSP(float, WS_TKG) + (size_t)tk * 4) = (f32x4){inv, e1 * inv, e2 * inv, e3 * inv};
#pragma unroll
            for (int s = 0; s < 4; ++s) lrank[s] = __hip_atomic_fetch_add(&lcnt[ex[s]], 1u, __ATOMIC_RELAXED, __HIP_MEMORY_SCOPE_WORKGROUP);
        }
        __syncthreads();
        if (F.tid < 32) lbase[F.tid] = atomicAdd(&cnt[F.tid], lcnt[F.tid]);
        __syncthreads();
        if (lane < 16) {
#pragma unroll
            for (int s = 0; s < 4; ++s) WSP(int, WS_ROWLIST)[(size_t)ex[s] * T_ + lbase[ex[s]] + lrank[s]] = tk * 4 + s; }
        __syncthreads();
    }
}

struct FinRegs { u32x2 hw[2][4]; u32x2 yw[2][4][4]; };
__device__ __forceinline__ void fin_load(const bf16_t* HBf, const bf16_t* Y, int tk, FinRegs& R, int lane) {
#pragma unroll
    for (int t = 0; t < 2; ++t) {
#pragma unroll
        for (int j = 0; j < 4; ++j) { R.hw[t][j] = ((const u32x2*)(HBf + (size_t)(tk + t) * DM))[lane + 64 * j];
#pragma unroll
            for (int s = 0; s < 4; ++s) R.yw[t][s][j] = ((const u32x2*)(Y + ((size_t)(tk + t) * 4 + s) * DM))[lane + 64 * j]; } }
}
template <int FEXP> __device__ __forceinline__ void fin_finish(Frame& F, int tk, const FinRegs& R, const f32x4 (&gf)[4], int lane) {
#pragma unroll
    for (int t = 0; t < 2; ++t) { f32x4 hv[4]; float ss = 0.f;
#pragma unroll
        for (int j = 0; j < 4; ++j) { const u32x2 w = R.hw[t][j]; hv[j] = (f32x4){bflo(w.x), bfhi(w.x), bflo(w.y), bfhi(w.y)};
#pragma unroll
            for (int s = 0; s < 4; ++s) { const u32x2 y = R.yw[t][s][j]; hv[j][0] += bflo(y.x); hv[j][1] += bfhi(y.x); hv[j][2] += bflo(y.y); hv[j][3] += bfhi(y.y); }
            ss += (hv[j][0] * hv[j][0] + hv[j][1] * hv[j][1]) + (hv[j][2] * hv[j][2] + hv[j][3] * hv[j][3]); }
        float rstd = 1.0f / sqrtf(wave_sum(ss) * (1.0f / DM) + RMS_EPS);
#if DBG_STAGE
        { const float sd = __hip_atomic_load((float*)(F.ctl + CW_DBG), RLX_AGENT), sr = __hip_atomic_load((float*)(F.ctl + CW_DBG + 1), RLX_AGENT); rstd *= 1.0f + sqrtf(100.0f * sd / fmaxf(sr, 1e-30f)); }
#endif
        f32x4* op = (f32x4*)(((FEXP == 3) ? WSP(float, WS_PO) : F.out) + (size_t)(tk + t) * DM) + lane;
        if (FEXP == 1) { asm volatile("" :: "v"(hv[0][0] * rstd), "v"(hv[3][3] * rstd)); }
        else {
#pragma unroll
            for (int j = 0; j < 4; ++j) op[64 * j] = hv[j] * rstd * gf[j]; } }
}
template <int FEXP> __device__ __forceinline__ void phase_final_t(Frame& F) {
    const int gw = F.bid * 8 + F.wave, NGW = F.G * 8, lane = F.lane;
    const bf16_t* HBf = WSP(bf16_t, WS_HB); const bf16_t* Y = WSP(bf16_t, WS_Y);
    f32x4 gf[4];
#pragma unroll
    for (int j = 0; j < 4; ++j) gf[j] = ((const f32x4*)F.in[I_GFINAL])[lane + 64 * j];
    FinRegs ra, rb; const int step = NGW * 2, t0 = gw * 2, n = (t0 < T_) ? (T_ - t0 + step - 1) / step : 0;
    if (n > 0) { fin_load(HBf, Y, t0, ra, lane); int i = 0;
        for (; i + 2 <= n; i += 2) {
            fin_load(HBf, Y, t0 + (i + 1) * step, rb, lane);
            fin_finish<FEXP>(F, t0 + i * step, ra, gf, lane);
            fin_load(HBf, Y, t0 + min(i + 2, n - 1) * step, ra, lane);
            fin_finish<FEXP>(F, t0 + (i + 1) * step, rb, gf, lane); }
        if (i < n) fin_finish<FEXP>(F, t0 + i * step, ra, gf, lane); }
}
__device__ __forceinline__ void phase_final(Frame& F) { phase_final_t<0>(F); }

__device__ __forceinline__ void dbg_compare(Frame& F, const bf16_t* A, const bf16_t* R, size_t n) {
    float sd = 0.f, sr = 0.f;
    for (size_t i = (size_t)F.bid * 512 + F.tid; i < n; i += (size_t)F.G * 512) { const float a = bf2f(A[i]), r = bf2f(R[i]); sd += (a - r) * (a - r); sr += r * r; }
    sd = wave_sum(sd); sr = wave_sum(sr);
    if (F.lane == 0) { atomicAdd((float*)(F.ctl + CW_DBG), sd); atomicAdd((float*)(F.ctl + CW_DBG + 1), sr); }
}
constexpr int N_PHASES = 15;
__global__ void __launch_bounds__(512, 2) mega_fwd(Args args) {
    extern __shared__ __attribute__((aligned(16))) unsigned char lds_raw[];
    Frame F;
    F.lds = (LAS unsigned char*)lds_raw; F.tid = threadIdx.x; F.lane = F.tid & 63; F.wave = __builtin_amdgcn_readfirstlane(F.tid >> 6); F.G = gridDim.x; F.bid = blockIdx.x;
#pragma unroll
    for (int i = 0; i < 28; ++i) F.in[i] = args.in[i];
    F.out = args.out; F.ws = args.ws; F.ctl = (unsigned*)(args.ws + WS_CTL);
    volatile LAS unsigned* MISC = (volatile LAS unsigned*)(F.lds + MISC_OFF);
    if (F.tid < 64) MISC[F.tid] = 0u;
    __syncthreads();
    const int lo = args.ph_lo, hi = args.ph_hi;
    XcdBarrier bar; bar.bar = F.ctl + CW_BAR; bar.x = 0; bar.st = nullptr;
    if (hi - lo > 1) bar = xcd_barrier_post(F.ctl + CW_BAR, MISC + 8);
#define IN(k) (lo <= (k) && (k) < hi)
#define SEAM(k) do { if (IN(k) && IN((k) + 1)) xcd_barrier(bar); } while (0)
    LAS unsigned char* ring = F.lds;
    const LAS int* gidx = (const LAS int*)(F.lds + GIDX_OFF);

    if (IN(0)) for (int rep_ = 0; rep_ <= ((REP_MASK >> 0) & 1) * REP_EXTRA; ++rep_) { if (rep_) xcd_barrier(bar);  phase_prologue(F); for (int tk = F.bid; tk < NG * 8; tk += F.G) p0_ssm_tables(F, tk); } SEAM(0);
    if (IN(1)) for (int rep_ = 0; rep_ <= ((REP_MASK >> 1) & 1) * REP_EXTRA; ++rep_) { if (rep_) xcd_barrier(bar);
        { pg8::Gemm g{WSP(bf16_t, WS_XB), WSP(bf16_t, WS_WIN), DM, 0}; pg8::PatchOrder S; S.init(T_ / 256, INW / 256, 8, F.G, F.bid);
          pg8::EpiInProj E{WSP(bf16_t, WS_Q), WSP(bf16_t, WS_K), WSP(bf16_t, WS_V), WSP(bf16_t, WS_U), WSP(bf16_t, WS_SGA), WSP(bf16_t, WS_SGB), WSP(float, WS_KM2)};
          pg8::gemm_phase<pg8::EpiInProj, pg8::PatchOrder, false>(ring, g, S, E, gidx, STG_TICKS);
#if NULL_EXP == 1
          { pg8::EpiNull EN; pg8::gemm_phase<pg8::EpiNull, pg8::PatchOrder, false>(ring, g, S, EN, gidx); pg8::gemm_phase<pg8::EpiNull, pg8::PatchOrder, false>(ring, g, S, EN, gidx); }
#elif NULL_EXP == 5
          { pg8::EpiStoreExp<false> EN{WSP(bf16_t, WS_N2B)}; pg8::gemm_phase<pg8::EpiStoreExp<false>, pg8::PatchOrder, false>(ring, g, S, EN, gidx); pg8::gemm_phase<pg8::EpiStoreExp<false>, pg8::PatchOrder, false>(ring, g, S, EN, gidx); }
#elif NULL_EXP == 6
          { pg8::EpiStoreExp<true> EN{WSP(bf16_t, WS_N2B)}; pg8::gemm_phase<pg8::EpiStoreExp<true>, pg8::PatchOrder, false>(ring, g, S, EN, gidx); pg8::gemm_phase<pg8::EpiStoreExp<true>, pg8::PatchOrder, false>(ring, g, S, EN, gidx); }
#elif NULL_EXP == 3
          { pg8::EpiInProjT<1> EN{E.Q, E.Kb, E.V, E.U, E.SGA, E.SGB, E.KM2}; pg8::gemm_phase<pg8::EpiInProjT<1>, pg8::PatchOrder, false>(ring, g, S, EN, gidx); pg8::gemm_phase<pg8::EpiInProjT<1>, pg8::PatchOrder, false>(ring, g, S, EN, gidx); }
#elif NULL_EXP == 4
          { pg8::EpiInProjT<2> EN{E.Q, E.Kb, E.V, E.U, E.SGA, E.SGB, E.KM2}; pg8::gemm_phase<pg8::EpiInProjT<2>, pg8::PatchOrder, false>(ring, g, S, EN, gidx); pg8::gemm_phase<pg8::EpiInProjT<2>, pg8::PatchOrder, false>(ring, g, S, EN, gidx); }
#endif
          }
        { pg8::Gemm g{WSP(bf16_t, WS_MN), WSP(bf16_t, WS_WXKV), DM, 0}; pg8::PatchOrder S; S.init(NB * MEML / 256, 2 * XW / 256, 4, F.G, F.bid);
          pg8::EpiMemKV E{WSP(bf16_t, WS_MKV), WSP(bf16_t, WS_MVT)};
          pg8::gemm_phase<pg8::EpiMemKV, pg8::PatchOrder, false>(ring, g, S, E, gidx); }
    } SEAM(1);
    if (IN(2)) for (int rep_ = 0; rep_ <= ((REP_MASK >> 2) & 1) * REP_EXTRA; ++rep_) { if (rep_) { xcd_barrier(bar); if (F.tid < 4) { for (int k_ = F.tid; k_ < 1024; k_ += 4) __hip_atomic_store(F.ctl + CW_MCNT + k_, 0u, RLX_AGENT); } __syncthreads(); xcd_barrier(bar); }
        for (int it = F.bid; it < NB * NG * 2; it += F.G) ssm_state_item(F, (it >> 1) / NG, (it >> 1) % NG, it & 1);
        for (int it = F.bid; it < NB * NH * NBLK; it += F.G) moba_route_item(F, it / NBLK, (NBLK - 1) - (it % NBLK));
    } SEAM(2);
    if (IN(3)) for (int rep_ = 0; rep_ <= ((REP_MASK >> 3) & 1) * REP_EXTRA; ++rep_) { if (rep_) xcd_barrier(bar);
        { int t_ = threadIdx.x; asm volatile("" : "+v"(t_)); F.tid = t_; F.lane = t_ & 63; F.wave = __builtin_amdgcn_readfirstlane(t_ >> 6); }
        moba_sparse_phase<0>(F, (char*)lds_raw);
#if MOBA_EXP == 1
        moba_sparse_phase<1>(F, (char*)lds_raw); moba_sparse_phase<1>(F, (char*)lds_raw);
#endif
        { int t_ = threadIdx.x; asm volatile("" : "+v"(t_)); F.tid = t_; F.lane = t_ & 63; F.wave = __builtin_amdgcn_readfirstlane(t_ >> 6); }
        phase_ssm_out(F);
    } SEAM(3);
#if DBG_STAGE == 1 || DBG_STAGE == 2
    moba_combine_phase(F); xcd_barrier(bar);
#endif
#if DBG_STAGE == 1
    phase_ssm_simple(F, WSP(bf16_t, WS_MERGED)); xcd_barrier(bar); dbg_compare(F, WSP(bf16_t, WS_YB), WSP(bf16_t, WS_MERGED), (size_t)T_ * SW); xcd_barrier(bar);
#elif DBG_STAGE == 2
    phase_moba_simple(F, WSP(bf16_t, WS_MERGED)); xcd_barrier(bar); dbg_compare(F, WSP(bf16_t, WS_ATT), WSP(bf16_t, WS_MERGED), (size_t)T_ * AW); xcd_barrier(bar);
#endif
    if (IN(5)) for (int rep_ = 0; rep_ <= ((REP_MASK >> 5) & 1) * REP_EXTRA; ++rep_) { if (rep_) xcd_barrier(bar);
#if !(DBG_STAGE == 1 || DBG_STAGE == 2)
        moba_combine_phase(F);
#endif
        pg8::Gemm g{WSP(bf16_t, WS_YB), WSP(bf16_t, WS_WGLU), SW, 0};
        pg8::EpiGlu E{WSP(bf16_t, WS_SGB), WSP(bf16_t, WS_YB2S)};
        if (F.G == 256) { pg8::PairOrder S; S.init(F.bid, 0); pg8::gemm_phase<pg8::EpiGlu, pg8::PairOrder, false>(ring, g, S, E, gidx); }
        else { pg8::PatchOrder S; S.init(T_ / 256, 2 * DM / 256, 8, F.G, F.bid); pg8::gemm_phase<pg8::EpiGlu, pg8::PatchOrder, false>(ring, g, S, E, gidx); }
    } if (F.G != 256) SEAM(5);
    if (IN(6)) for (int rep_ = 0; rep_ <= ((REP_MASK >> 6) & 1) * REP_EXTRA; ++rep_) { if (rep_) xcd_barrier(bar);
        pg8::Gemm g{WSP(bf16_t, WS_ATT), WSP(bf16_t, WS_WPA), AW, 0};
        pg8::EpiMerge E{WSP(bf16_t, WS_SGA), WSP(bf16_t, WS_YB2S), WSP(bf16_t, WS_MERGED)};
        if (F.G == 256) { pg8::PairOrder S; S.init(F.bid, 1); pg8::gemm_phase<pg8::EpiMerge, pg8::PairOrder, false>(ring, g, S, E, gidx); }
        else { pg8::PatchOrder S; S.init(T_ / 256, DM / 256, 4, F.G, F.bid); pg8::gemm_phase<pg8::EpiMerge, pg8::PatchOrder, false>(ring, g, S, E, gidx); }
    } SEAM(6);
    if (IN(7)) for (int rep_ = 0; rep_ <= ((REP_MASK >> 7) & 1) * REP_EXTRA; ++rep_) { if (rep_) xcd_barrier(bar);
        pg8::Gemm g{WSP(bf16_t, WS_MERGED), WSP(bf16_t, WS_WOUT), DM, 0}; pg8::PatchOrder S; S.init(T_ / 256, DM / 256, 4, F.G, F.bid);
        pg8::EpiResidT<true> E{F.in[I_X], WSP(bf16_t, WS_HB), WSP(float, WS_SSQ1)};
        pg8::gemm_phase<pg8::EpiResidT<true>, pg8::PatchOrder, false>(ring, g, S, E, gidx);
    } SEAM(7);
    if (IN(8)) for (int rep_ = 0; rep_ <= ((REP_MASK >> 8) & 1) * REP_EXTRA; ++rep_) { if (rep_) xcd_barrier(bar);
        pg8::Gemm g{WSP(bf16_t, WS_HB), WSP(bf16_t, WS_WXQ), DM, 0}; pg8::PatchOrder S; S.init(T_ / 256, XW / 256, 2, F.G, F.bid);
        pg8::EpiXq E{WSP(float, WS_SSQ1), WSP(bf16_t, WS_XQ)};
        pg8::gemm_phase<pg8::EpiXq, pg8::PatchOrder, false>(ring, g, S, E, gidx);
    } SEAM(8);
    if (IN(9)) for (int rep_ = 0; rep_ <= ((REP_MASK >> 9) & 1) * REP_EXTRA; ++rep_) { if (rep_) xcd_barrier(bar);  phase_xattn(F); } SEAM(9);
#if DBG_STAGE == 3
    phase_xattn_simple(F, WSP(bf16_t, WS_MERGED)); xcd_barrier(bar); dbg_compare(F, WSP(bf16_t, WS_XO), WSP(bf16_t, WS_MERGED), (size_t)T_ * XW); xcd_barrier(bar);
#endif
    if (IN(10)) for (int rep_ = 0; rep_ <= ((REP_MASK >> 10) & 1) * REP_EXTRA; ++rep_) { if (rep_) xcd_barrier(bar);
        pg8::Gemm g{WSP(bf16_t, WS_XO), WSP(bf16_t, WS_WXO), XW, 0}; pg8::PatchOrder S; S.init(T_ / 256, DM / 256, 4, F.G, F.bid);
        pg8::EpiResidT<false> E{nullptr, WSP(bf16_t, WS_HB), nullptr};
        pg8::gemm_phase<pg8::EpiResidT<false>, pg8::PatchOrder, false>(ring, g, S, E, gidx);
    } SEAM(10);
    if (IN(11)) for (int rep_ = 0; rep_ <= ((REP_MASK >> 11) & 1) * REP_EXTRA; ++rep_) { if (rep_) xcd_barrier(bar);  phase_router_mfma(F);
#if OUT_TOUCH
        { const int gw = F.bid * 8 + F.wave, NGW = F.G * 8;
          for (int tk = gw * 2; tk < T_; tk += NGW * 2) { if (F.lane < 2) { const float v = __builtin_nontemporal_load(F.out + (size_t)(tk + F.lane) * DM); asm volatile("" :: "v"(v)); } } }
#endif
    } SEAM(11);
    if (IN(12) || IN(13)) {
        LAS int* pref = (LAS int*)(F.lds + MISC_OFF + 256);
        const unsigned* cnt = F.ctl + CW_CNT;
        __syncthreads();
        if (F.tid == 0) { int a = 0; for (int e = 0; e < NE; ++e) { pref[e] = a; a += ((int)__hip_atomic_load(cnt + e, RLX_AGENT) + 255) >> 8; } pref[NE] = a; }
        __syncthreads();
        const int MT = pref[NE];
        if (IN(12)) for (int rep_ = 0; rep_ <= ((REP_MASK >> 12) & 1) * REP_EXTRA; ++rep_) { if (rep_) xcd_barrier(bar);
            MoeOrder S; S.P.init(MT, 2 * DFF / 256, 8, F.G, F.bid); S.pref = pref; S.rev = 0;
            { LAS int* gw_ = (LAS int*)(F.lds + GIDX_OFF); pg8::Unit u;
              for (int i = 0; i < GIDX_UNITS && S.next(i, u); ++i) { const int ce = (int)__hip_atomic_load(cnt + u.e, RLX_AGENT);
                  if (F.tid < 256) { const int rank = u.mi * 256 + F.tid; gw_[i * 256 + F.tid] = (rank < ce) ? (WSP(int, WS_ROWLIST)[(size_t)u.e * T_ + rank] >> 2) : 0; } } }
            __syncthreads();
            pg8::Gemm g{WSP(bf16_t, WS_N2B), WSP(bf16_t, WS_WGU), DM, (size_t)2 * DFF * DM};
            pg8::EpiMoe1 E{F.in[I_BGU], WSP(bf16_t, WS_HID)};
            pg8::gemm_phase<pg8::EpiMoe1, MoeOrder, true>(ring, g, S, E, gidx, STG_TICKS);
#if NULL_EXP == 2
            { pg8::EpiNull EN; pg8::gemm_phase<pg8::EpiNull, MoeOrder, true>(ring, g, S, EN, gidx); }
#endif
        }
        SEAM(12);
        if (IN(13)) for (int rep_ = 0; rep_ <= ((REP_MASK >> 13) & 1) * REP_EXTRA; ++rep_) { if (rep_) xcd_barrier(bar);
            MoeOrder S; S.P.init(MT, DM / 256, 4, F.G, F.bid); S.pref = pref; S.rev = 1;
            pg8::Gemm g{WSP(bf16_t, WS_HID), WSP(bf16_t, WS_WDN), DFF, (size_t)DM * DFF};
            { LAS int* tD = (LAS int*)(F.lds + GIDX_OFF); LAS float* tG = (LAS float*)(F.lds + GIDX_OFF + 12 * 1024); pg8::Unit u;
              __syncthreads();
              for (int i = 0; i < 12 && S.next(i, u); ++i) { const int ce = (int)__hip_atomic_load(cnt + u.e, RLX_AGENT);
                  if (F.tid < 256) { const int rank = u.mi * 256 + F.tid; int d = -1; float gv = 0.f; if (rank < ce) { d = WSP(int, WS_ROWLIST)[(size_t)u.e * T_ + rank]; gv = WSP(float, WS_TKG)[d]; } tD[i * 256 + F.tid] = d; tG[i * 256 + F.tid] = gv; } }
              __syncthreads(); }
            pg8::EpiMoe2 E{F.in[I_BDN], (const LAS int*)(F.lds + GIDX_OFF), (const LAS float*)(F.lds + GIDX_OFF + 12 * 1024), WSP(bf16_t, WS_Y)};
            pg8::gemm_phase<pg8::EpiMoe2, MoeOrder, false>(ring, g, S, E, gidx, STG_TICKS);
        }
    } SEAM(13);
#if BAR_EXP
    for (int k_ = 0; k_ < 20; ++k_) xcd_barrier(bar);
#endif
    if (IN(14)) for (int rep_ = 0; rep_ <= ((REP_MASK >> 14) & 1) * REP_EXTRA; ++rep_) { if (rep_) xcd_barrier(bar);  phase_final(F);
#if FINAL_EXP
        phase_final_t<FINAL_EXP>(F); phase_final_t<FINAL_EXP>(F);
#endif
    }
#undef IN
#undef SEAM
}

extern "C" void kernel_launch(void* const* d_in, const int* in_sizes, int n_in, void* d_out, int out_size, void* d_ws, size_t ws_size, hipStream_t stream) {
    static int grid = 0;
    if (grid == 0) {
        if (n_in != 28 || in_sizes[0] != T_ * DM || out_size != T_ * DM || ws_size < WS_END) { fprintf(stderr, "kernel_launch: unexpected shapes (n_in %d, in0 %d, out %d, ws %zu)\n", n_in, n_in > 0 ? in_sizes[0] : -1, out_size, ws_size); grid = -1; return; }
        int dev = 0, cus = 0;
        if (hipGetDevice(&dev) != hipSuccess || hipDeviceGetAttribute(&cus, hipDeviceAttributeMultiprocessorCount, dev) != hipSuccess) { grid = -1; return; }
        if (hipFuncSetAttribute((const void*)mega_fwd, hipFuncAttributeMaxDynamicSharedMemorySize, LDS_BYTES) != hipSuccess) { fprintf(stderr, "kernel_launch: hipFuncSetAttribute failed\n"); grid = -1; return; }
        (void)hipGetLastError();
        grid = cus;
    }
    if (grid < 0) return;
    (void)hipMemsetAsync((char*)d_ws + WS_CTL, 0, CTL_ZERO_BYTES, stream);
    Args a{};
    for (int i = 0; i < 28; ++i) a.in[i] = (const float*)d_in[i];
    a.out = (float*)d_out; a.ws = (unsigned char*)d_ws;
#if MK_N_LAUNCHES == 1
    a.ph_lo = 0; a.ph_hi = N_PHASES;
    hipLaunchKernelGGL(mega_fwd, dim3(grid), dim3(512), LDS_BYTES, stream, a);
#else
    for (int p = 0; p < N_PHASES; ++p) { a.ph_lo = p; a.ph_hi = p + 1; hipLaunchKernelGGL(mega_fwd, dim3(grid), dim3(512), LDS_BYTES, stream, a); }
#endif
}
```

```cpp
#include <hip/hip_runtime.h>
#include <hip/hip_bf16.h>
#include <cmath>
#include <cstdio>
#include <cstdint>

#ifndef MK_N_LAUNCHES
#define MK_N_LAUNCHES 1
#endif

#ifndef REP_EXTRA
#define REP_EXTRA 1
#endif
#ifndef NULL_EXP
#define NULL_EXP 0
#endif
#ifndef STG_TICKS
#define STG_TICKS 0
#endif
#ifndef MOBA_EXP
#define MOBA_EXP 0
#endif
#ifndef OUT_NT
#define OUT_NT 0
#endif
#ifndef OUT_TOUCH
#define OUT_TOUCH 0
#endif
#ifndef BAR_EXP
#define BAR_EXP 0
#endif
#ifndef FINAL_EXP
#define FINAL_EXP 0
#endif
#ifndef MOE1_FP8
#define MOE1_FP8 1
#endif
constexpr int FP8_WSHIFT = 7;
#ifndef MOE2_FP8
#define MOE2_FP8 1
#endif
#ifndef REP_MASK
#define REP_MASK 0
#endif
#ifndef DBG_STAGE
#define DBG_STAGE 0
#endif

#define GAS __attribute__((address_space(1)))
#define LAS __attribute__((address_space(3)))
typedef unsigned short bf16_t;
typedef short bf16x8 __attribute__((ext_vector_type(8)));
typedef float f32x4 __attribute__((ext_vector_type(4)));
typedef float f32x2 __attribute__((ext_vector_type(2)));
typedef float f32x16 __attribute__((ext_vector_type(16)));
typedef unsigned u32x4 __attribute__((ext_vector_type(4)));
typedef unsigned u32x2 __attribute__((ext_vector_type(2)));

constexpr int NB = 4, SEQ = 8192, DM = 1024, T_ = NB * SEQ;
constexpr int AW = 512, NH = 8, HD = 64, MBLK = 256, NBLK = SEQ / MBLK, MTOPK = 3;
constexpr int SW = 512, SGC = 16, NG = 32, SP = 64;
constexpr int INW = 4096;
constexpr int MEML = 256, XH = 4, XD = 128, XW = 512;
constexpr int NE = 32, ETOPK = 4, DFF = 1024;
constexpr float RMS_EPS = 1e-6f;
constexpr float LOG2E = 1.4426950408889634f;
constexpr float QSCALE = 0.125f * LOG2E;
constexpr float XSCALE = 0.08838834764831845f * LOG2E;
constexpr int HID_ROWS = ETOPK * T_ + NE * 256;

constexpr size_t MiB = 1u << 20;
constexpr size_t WS_WIN = 0 * MiB, WS_WGLU = 8 * MiB, WS_WPA = 10 * MiB, WS_WOUT = 11 * MiB, WS_WXQ = 13 * MiB, WS_WXKV = 14 * MiB, WS_WXO = 16 * MiB,
                 WS_WGU = 17 * MiB, WS_WDN = 145 * MiB;
constexpr size_t WS_CTL = 209 * MiB, CTL_ZERO_BYTES = 1 * MiB;
constexpr size_t WS_RSTD0 = 210 * MiB;
constexpr size_t WS_RSTD2 = WS_RSTD0 + 128 * 1024;
constexpr size_t WS_KMEAN = WS_RSTD2 + 128 * 1024;
constexpr size_t WS_KM2 = WS_KMEAN;
constexpr size_t WS_TKG = 224 * MiB;
constexpr size_t WS_SSQ1 = 211 * MiB;
constexpr size_t WS_SSQ2 = 213 * MiB;
constexpr size_t WS_ROWLIST = 215 * MiB;
constexpr size_t WS_MN = 219 * MiB;
constexpr size_t WS_MKV = 221 * MiB;
constexpr size_t WS_MVT = 223 * MiB;
constexpr size_t WS_WST = 225 * MiB;
constexpr size_t WS_GT = 233 * MiB;
constexpr size_t WS_KT = 241 * MiB;
constexpr size_t WS_LAML = 243 * MiB;
constexpr size_t WS_SST = 244 * MiB;
constexpr size_t WS_H = 256 * MiB;
constexpr size_t WS_N2B = 256 * MiB;
constexpr size_t WS_PO = 256 * MiB;
constexpr size_t WS_PML = 384 * MiB;
constexpr size_t WS_MLIST = 392 * MiB;
constexpr size_t WS_HB = 384 * MiB;
constexpr size_t WS_HID = 448 * MiB;
constexpr size_t WS_Y = 720 * MiB;
constexpr size_t WS_END = 976 * MiB;
constexpr size_t WS_XB = 448 * MiB, WS_Q = 512 * MiB, WS_K = 544 * MiB, WS_V = 576 * MiB, WS_U = 608 * MiB, WS_ATT = 640 * MiB, WS_YB = 672 * MiB;
constexpr size_t WS_SGA = 720 * MiB, WS_SGB = 784 * MiB, WS_YB2S = 848 * MiB, WS_MERGED = 912 * MiB;
constexpr size_t WS_XQ = 448 * MiB, WS_XO = 480 * MiB;
static_assert(WS_HID + (size_t)HID_ROWS * DFF * 2 <= WS_Y, "HID fits");
constexpr int CW_TMO = 0, CW_CNT = 64  , CW_DBG = 128  , CW_MCNT = 256  , CW_BAR = 4096;

constexpr int RING_BYTES = 131072;
constexpr int GIDX_OFF = RING_BYTES, GIDX_UNITS = 24;
constexpr int MISC_OFF = GIDX_OFF + GIDX_UNITS * 1024;
constexpr int LDS_BYTES = 163840;

#define RLX_AGENT __ATOMIC_RELAXED, __HIP_MEMORY_SCOPE_AGENT
__device__ __forceinline__ unsigned f2bf(float f) { unsigned u = __builtin_bit_cast(unsigned, f); return (u + 0x7fffu + ((u >> 16) & 1u)) >> 16; }
__device__ __forceinline__ unsigned pk2(float lo, float hi) { return f2bf(lo) | (f2bf(hi) << 16); }
__device__ __forceinline__ float bf2f(unsigned short b) { return __builtin_bit_cast(float, (unsigned)b << 16); }
__device__ __forceinline__ float bflo(unsigned w) { return __builtin_bit_cast(float, w << 16); }
__device__ __forceinline__ float bfhi(unsigned w) { return __builtin_bit_cast(float, w & 0xffff0000u); }
__device__ __forceinline__ float ub0(unsigned w) { return (float)(w & 0xffu) * (1.0f / 255.0f); }
__device__ __forceinline__ float ub1(unsigned w) { return (float)((w >> 8) & 0xffu) * (1.0f / 255.0f); }
__device__ __forceinline__ float ub2(unsigned w) { return (float)((w >> 16) & 0xffu) * (1.0f / 255.0f); }
__device__ __forceinline__ float ub3(unsigned w) { return (float)(w >> 24) * (1.0f / 255.0f); }
__device__ __forceinline__ float wave_sum(float v) {
#pragma unroll
    for (int o = 1; o < 64; o <<= 1) v += __shfl_xor(v, o);
    return v;
}
__device__ __forceinline__ float fsigmoid(float x) { return __builtin_amdgcn_rcpf(1.0f + __builtin_amdgcn_exp2f(-x * LOG2E)); }
__device__ __forceinline__ float gelu_tanh(float x) {
    const float u = 0.7978845608028654f * (x + 0.044715f * x * x * x);
    return x * fsigmoid(2.0f * u);
}

namespace pg8 {
constexpr int BM = 256, BK = 64, HALF = 128, HTB = HALF * BK * 2, STAGE_BYTES = 8 * HTB;
__host__ __device__ __forceinline__ int lds_byte(int r, int c) { const int st = (r >> 4) * 2 + (c >> 5), rr = r & 15, cc = c & 31, ob = rr * 64 + cc * 2; return st * 1024 + (ob ^ (((ob >> 9) & 1) << 5)); }
__host__ __device__ __forceinline__ void stage_rc(int b, int& R, int& C) { const int st = b / 1024, sb = b % 1024, swz = sb ^ (((sb >> 9) & 1) << 5); R = (st >> 1) * 16 + swz / 64; C = (st & 1) * 32 + (swz % 64) / 2; }
__host__ __device__ __forceinline__ int perm32(int rho) { const int n = rho >> 4, i = rho & 15; return 8 * (i >> 2) + 4 * n + (i & 3); }

struct Unit { int pm, pn, e, mi, ui; };
struct Gemm { const bf16_t* A; const bf16_t* Bt; int K; size_t b_estride; int scaleA = 0x7f7f7f7f, scaleB = 0x7f7f7f7f; };
typedef int v8i __attribute__((ext_vector_type(8)));

struct PatchOrder {
    int nM, nN, PM, PN, x, j, ok;
    __device__ __forceinline__ void init(int nM_, int nN_, int PN_, int G, int c) { nM = nM_; nN = nN_; PN = PN_; PM = (G / 8) / PN_; x = c & 7; j = c >> 3; ok = ((G & 7) == 0) && (PM * PN == G / 8) && (nN % PN == 0); if (!ok) { x = c; j = G; } }
    __device__ __forceinline__ bool next(int i, Unit& u) const {
        if (!ok) { const long L = (long)i * j + x; if (L >= (long)nM * nN) return false; u.pm = (int)(L / nN); u.pn = (int)(L % nN); u.e = 0; u.mi = u.pm; u.ui = i; return true; }
        const int p = 8 * i + x, npn = nN / PN, pmb = p / npn, pnb = p % npn;
        u.pm = pmb * PM + (j % PM); u.pn = pnb * PN + (j / PM); u.e = 0; u.mi = u.pm; u.ui = i;
        return u.pm < nM;
    }
};

struct PairOrder {
    int pp, q, mode;
    __device__ __forceinline__ void init(int c, int mode_) { const int x = c & 7, k = c >> 3; q = k & 3; pp = 8 * x + (k >> 2); mode = mode_; }
    __device__ __forceinline__ bool next(int i, Unit& u) const {
        if (mode == 0) { if (i >= 4) return false; u.pm = 2 * pp + (i >> 1); u.pn = 2 * q + (i & 1); }
        else { if (i >= 2) return false; u.pm = 2 * pp + i; u.pn = q; }
        u.e = 0; u.mi = u.pm; u.ui = i; return true;
    }
};
__device__ __forceinline__ unsigned cvt_pk_bf16(float lo, float hi) { unsigned r; asm volatile("v_cvt_pk_bf16_f32 %0, %1, %2" : "=v"(r) : "v"(lo), "v"(hi)); return r; }
#ifndef NT_STORES
#define NT_STORES 0
#endif
#ifndef WT_STORES
#define WT_STORES 0
#endif
__device__ __forceinline__ void st16(void* p, u32x4 v) {
#if WT_STORES
    asm volatile("global_store_dwordx4 %0, %1, off sc1\n\ts_nop 1" :: "v"(p), "v"(v) : "memory");
#elif NT_STORES
    __builtin_nontemporal_store(v, (u32x4*)p);
#else
    *(u32x4*)p = v;
#endif
}

template <class Epi, class Sched, bool GATHER, bool FP8 = false>
__device__ __forceinline__ void gemm_phase(LAS unsigned char* lds, const Gemm g, const Sched& S, const Epi& E, const LAS int* gidx, int stagger_ticks = 0) {
    if (stagger_ticks > 0) {
        const unsigned long long t0 = __builtin_amdgcn_s_memrealtime(); const unsigned long long dl = (unsigned long long)(stagger_ticks * ((blockIdx.x >> 3) & 3));
        while (__builtin_amdgcn_s_memrealtime() - t0 < dl) __builtin_amdgcn_s_sleep(8);
    }
    const int tid = threadIdx.x, wid = __builtin_amdgcn_readfirstlane(tid >> 6), lane = tid & 63, wr = wid >> 2, wc = wid & 3, fr = lane & 15, fq = lane >> 4;
    const int K = g.K, nt = K / BK;
    int Ra[2], Ca[2]; unsigned voffB[2];
#pragma unroll
    for (int i = 0; i < 2; ++i) { int R, C; stage_rc(tid * 16 + i * 8192, R, C); const int Rb = Epi::PERM ? ((R & ~31) + perm32(R & 31)) : R;
        Ra[i] = R; Ca[i] = C; voffB[i] = (unsigned)(Rb * K + C) * 2u; }
    const size_t kstep = (size_t)(BK * 2);
    const size_t hstep = (size_t)HALF * K * 2;
    const size_t tstep = 2 * hstep;
    const unsigned ldsw = (unsigned)wid * 1024u;
    const int aoff = lds_byte(wr * 64 + fr, fq * 8), boff = lds_byte(wc * 32 + fr, fq * 8);
#define PG8_SA(b, h) (((b) * 2 + (h)) * HTB)
#define PG8_SB(b, h) ((4 + (b) * 2 + (h)) * HTB)
#define PG8_STAGE(bufoff, gbase, voff) do { _Pragma("unroll") for (int _i = 0; _i < 2; ++_i) \
        __builtin_amdgcn_global_load_lds((const unsigned*)((const char*)(gbase) + (voff)[_i]), (LAS unsigned*)(lds + (bufoff) + ldsw + _i * 8192), 16, 0, 0); } while (0)
#define PG8_LDA_BF(dst, b, h) do { _Pragma("unroll") for (int m = 0; m < 4; ++m) _Pragma("unroll") for (int k = 0; k < 2; ++k) dst[m][k] = *(const LAS bf16x8*)(lds + PG8_SA(b, h) + aoff + m * 2048 + k * 1024); } while (0)
#define PG8_LDB_BF(dst, b, h) do { _Pragma("unroll") for (int n = 0; n < 2; ++n) _Pragma("unroll") for (int k = 0; k < 2; ++k) dst[n][k] = *(const LAS bf16x8*)(lds + PG8_SB(b, h) + boff + n * 2048 + k * 1024); } while (0)
#define PG8_LD8(dst, base_) do { const u32x4 lo_ = *(const LAS u32x4*)(base_), hi_ = *(const LAS u32x4*)((base_) + 1024); dst = (v8i){(int)lo_.x, (int)lo_.y, (int)lo_.z, (int)lo_.w, (int)hi_.x, (int)hi_.y, (int)hi_.z, (int)hi_.w}; } while (0)
#define PG8_LDA8(dst, b, h) do { _Pragma("unroll") for (int m = 0; m < 4; ++m) PG8_LD8(dst[m], lds + PG8_SA(b, h) + aoff + m * 2048); } while (0)
#define PG8_LDB8(dst, b, h) do { _Pragma("unroll") for (int n = 0; n < 2; ++n) PG8_LD8(dst[n], lds + PG8_SB(b, h) + boff + n * 2048); } while (0)
#define PG8_LDA(dst, b, h) do { if constexpr (FP8) PG8_LDA8(dst##8, b, h); else PG8_LDA_BF(dst, b, h); } while (0)
#define PG8_LDB(dst, b, h) do { if constexpr (FP8) PG8_LDB8(dst##8, b, h); else PG8_LDB_BF(dst, b, h); } while (0)
#define PG8_MMA_BF(ai, bj, At, Bt) do { __builtin_amdgcn_s_setprio(1); _Pragma("unroll") for (int m = 0; m < 4; ++m) _Pragma("unroll") for (int n = 0; n < 2; ++n) _Pragma("unroll") for (int k = 0; k < 2; ++k) \
        acc[ai][bj][m][n] = __builtin_amdgcn_mfma_f32_16x16x32_bf16(Bt[n][k], At[m][k], acc[ai][bj][m][n], 0, 0, 0); __builtin_amdgcn_s_setprio(0); } while (0)
#define PG8_MMA_F8(ai, bj, At, Bt) do { __builtin_amdgcn_s_setprio(1); _Pragma("unroll") for (int m = 0; m < 4; ++m) _Pragma("unroll") for (int n = 0; n < 2; ++n) \
        asm volatile("s_nop 1\n\tv_mfma_scale_f32_16x16x128_f8f6f4 %0, %1, %2, %0, %3, %4 op_sel_hi:[0,0,0]" : "+v"(acc[ai][bj][m][n]) : "v"(Bt[n]), "v"(At[m]), "v"(sclB), "v"(sclA)); \
        __builtin_amdgcn_s_setprio(0); } while (0)
#define PG8_MMA(ai, bj, At, Bt) do { if constexpr (FP8) PG8_MMA_F8(ai, bj, At##8, Bt##8); else PG8_MMA_BF(ai, bj, At, Bt); } while (0)
#define PG8_WAIT_V(n) asm volatile("s_waitcnt vmcnt(" #n ")" ::: "memory")
#define PG8_WAIT_L(n) asm volatile("s_waitcnt lgkmcnt(" #n ")" ::: "memory")
#define PG8_BAR __builtin_amdgcn_s_barrier()
#define PG8_SCHED __builtin_amdgcn_sched_barrier(0)
#define PG8_VOA(dst, u) do { _Pragma("unroll") for (int _h = 0; _h < 2; ++_h) _Pragma("unroll") for (int _i = 0; _i < 2; ++_i) { \
        const int _row = GATHER ? gidx[(u).ui * 256 + _h * HALF + Ra[_i]] : (_h * HALF + Ra[_i]); dst[_h][_i] = (unsigned)(_row * K + Ca[_i]) * 2u; } } while (0)
    Unit cur, nxt; int ui = 0;
    if (!S.next(0, cur)) return;
    f32x4 acc[2][2][4][2];
#pragma unroll
    for (int a = 0; a < 2; ++a)
#pragma unroll
        for (int b = 0; b < 2; ++b)
#pragma unroll
            for (int m = 0; m < 4; ++m)
#pragma unroll
                for (int n = 0; n < 2; ++n) acc[a][b][m][n] = (f32x4){0.f, 0.f, 0.f, 0.f};
    bf16x8 At[4][2], B0[2][2], B1[2][2]; v8i At8[4], B08[2], B18[2];
    unsigned voA[2][2];
    const int sclA = g.scaleA, sclB = g.scaleB;
    PG8_VOA(voA, cur);
    const char* cA = (const char*)g.A + (GATHER ? (size_t)0 : (size_t)cur.pm * tstep);
    const char* cB = (const char*)g.Bt + ((size_t)cur.e * g.b_estride) * 2 + (size_t)cur.pn * tstep;
    PG8_STAGE(PG8_SB(0, 0), cB, voffB); PG8_STAGE(PG8_SB(0, 1), cB + hstep, voffB); PG8_STAGE(PG8_SA(0, 0), cA, voA[0]); PG8_STAGE(PG8_SA(0, 1), cA, voA[1]);
    if (wr == 1) PG8_BAR;
    PG8_WAIT_V(2); PG8_BAR;
    PG8_STAGE(PG8_SB(1, 0), cB + kstep, voffB); PG8_STAGE(PG8_SA(1, 0), cA + kstep, voA[0]); PG8_STAGE(PG8_SB(1, 1), cB + hstep + kstep, voffB);
    PG8_WAIT_V(6); PG8_BAR;
    for (;;) {
        const bool has_next = S.next(ui + 1, nxt);
        const char* nA = cA; const char* nB = cB;
        if (has_next) { nA = (const char*)g.A + (GATHER ? (size_t)0 : (size_t)nxt.pm * tstep); nB = (const char*)g.Bt + ((size_t)nxt.e * g.b_estride) * 2 + (size_t)nxt.pn * tstep; }
#pragma unroll 1
        for (int t = 0; t < nt; t += 2) {
            const bool last = (t == nt - 2);
            const char* a1 = cA + (size_t)(t + 1) * kstep;
            const char* a2 = last ? nA : cA + (size_t)(t + 2) * kstep; const char* b2 = last ? nB : cB + (size_t)(t + 2) * kstep;
            const char* a3 = a2 + kstep; const char* b3 = b2 + kstep;
            unsigned vo2[2][2];
#pragma unroll
            for (int h = 0; h < 2; ++h)
#pragma unroll
                for (int i = 0; i < 2; ++i) vo2[h][i] = voA[h][i];
            if (GATHER && last && has_next) { PG8_VOA(vo2, nxt); }
            PG8_LDB(B0, 0, 0); PG8_LDB(B1, 0, 1); PG8_SCHED; PG8_LDA(At, 0, 0); PG8_STAGE(PG8_SA(1, 1), a1, voA[1]);
            PG8_WAIT_V(8); PG8_WAIT_L(0); PG8_BAR; PG8_MMA(0, 0, At, B0); PG8_MMA(0, 1, At, B1); PG8_BAR; PG8_SCHED;
            PG8_LDA(At, 0, 1); PG8_STAGE(PG8_SB(0, 0), b2, voffB); PG8_STAGE(PG8_SB(0, 1), b2 + hstep, voffB); PG8_STAGE(PG8_SA(0, 0), a2, vo2[0]);
            PG8_WAIT_V(8); PG8_WAIT_L(0); PG8_BAR; PG8_MMA(1, 0, At, B0); PG8_MMA(1, 1, At, B1); PG8_BAR; PG8_SCHED;
            PG8_LDB(B0, 1, 0); PG8_LDB(B1, 1, 1); PG8_SCHED; PG8_LDA(At, 1, 0); PG8_STAGE(PG8_SA(0, 1), a2, vo2[1]);
            PG8_WAIT_V(8); PG8_WAIT_L(0); PG8_BAR; PG8_MMA(0, 0, At, B0); PG8_MMA(0, 1, At, B1); PG8_BAR; PG8_SCHED;
            PG8_LDA(At, 1, 1); PG8_STAGE(PG8_SB(1, 0), b3, voffB); PG8_STAGE(PG8_SB(1, 1), b3 + hstep, voffB); PG8_STAGE(PG8_SA(1, 0), a3, vo2[0]);
            PG8_WAIT_V(8); PG8_WAIT_L(0); PG8_BAR; PG8_MMA(1, 0, At, B0); PG8_MMA(1, 1, At, B1); PG8_BAR; PG8_SCHED;
        }
        if (wr == 0) PG8_BAR;
        if constexpr (FP8) asm volatile("s_nop 15\n\ts_nop 15" ::: "memory");
        E(acc, cur, wr, wc, fr, fq);
        if (!has_next) break;
#pragma unroll
        for (int a = 0; a < 2; ++a)
#pragma unroll
            for (int b = 0; b < 2; ++b)
#pragma unroll
                for (int m = 0; m < 4; ++m)
#pragma unroll
                    for (int n = 0; n < 2; ++n) acc[a][b][m][n] = (f32x4){0.f, 0.f, 0.f, 0.f};
        cur = nxt; cA = nA; cB = nB; ++ui;
        if (GATHER) { PG8_VOA(voA, cur); }
        if (wr == 1) PG8_BAR;
    }
    PG8_WAIT_V(0);
    PG8_BAR;
#undef PG8_SA
#undef PG8_SB
#undef PG8_STAGE
#undef PG8_LDA
#undef PG8_LDA_BF
#undef PG8_LDA8
#undef PG8_LD8
#undef PG8_LDB
#undef PG8_LDB_BF
#undef PG8_LDB8
#undef PG8_MMA
#undef PG8_MMA_BF
#undef PG8_MMA_F8
#undef PG8_WAIT_V
#undef PG8_WAIT_L
#undef PG8_BAR
#undef PG8_SCHED
#undef PG8_VOA
}

typedef const f32x4 (&AccRef)[2][2][4][2];
#define EPI_ROWS for (int ai = 0; ai < 2; ++ai) _Pragma("unroll") for (int m = 0; m < 4; ++m)

template <int XMODE> struct EpiInProjT {
    static constexpr bool PERM = true;
    bf16_t *Q, *Kb, *V, *U, *SGA, *SGB; float* KM2;
    __device__ __forceinline__ void operator()(AccRef acc, const Unit& u, int wr, int wc, int fr, int fq) const {
        bf16_t* dst; int ld, colt; bool sig = false; float sc = 1.f;
        if (u.pn < 2) { dst = Q; ld = AW; colt = u.pn * 256; sc = QSCALE; }
        else if (u.pn < 4) { dst = Kb; ld = AW; colt = (u.pn - 2) * 256; }
        else if (u.pn < 6) { dst = V; ld = AW; colt = (u.pn - 4) * 256; }
        else if (u.pn < 8) { dst = U; ld = AW; colt = (u.pn - 6) * 256; }
        else if (u.pn < 12) { dst = SGA; ld = DM; colt = (u.pn - 8) * 256; sig = true; }
        else { dst = SGB; ld = DM; colt = (u.pn - 12) * 256; sig = true; }
        const int row0 = u.pm * BM + wr * 64 + fr, col0 = colt + wc * 32 + 8 * fq;
        const bool isk = (u.pn == 2 || u.pn == 3); f32x4 cs[2][2];
#pragma unroll
        for (int bj = 0; bj < 2; ++bj)
#pragma unroll
            for (int n = 0; n < 2; ++n) cs[bj][n] = (f32x4){0.f, 0.f, 0.f, 0.f};
#pragma unroll
        EPI_ROWS { const int row = row0 + ai * HALF + m * 16; const float rs = sc; bf16_t* rowp = dst + (size_t)row * ld + col0;
#pragma unroll
            for (int bj = 0; bj < 2; ++bj) { f32x4 v0 = acc[ai][bj][m][0] * rs, v1 = acc[ai][bj][m][1] * rs;
                cs[bj][0] += v0; cs[bj][1] += v1;
                if (sig) {
                    unsigned q[8];
#pragma unroll
                    for (int e = 0; e < 4; ++e) { q[e] = (unsigned)(fsigmoid(v0[e]) * 255.0f + 0.5f); q[4 + e] = (unsigned)(fsigmoid(v1[e]) * 255.0f + 0.5f); }
                    const unsigned g0 = q[0] | (q[1] << 8) | (q[2] << 16) | (q[3] << 24), g1 = q[4] | (q[5] << 8) | (q[6] << 16) | (q[7] << 24);
                    if (XMODE != 1) *(u32x2*)((unsigned char*)dst + (size_t)row * ld + col0 + bj * HALF) = (u32x2){g0, g1};
                    continue; }
                u32x4 w; w.x = cvt_pk_bf16(v0[0], v0[1]); w.y = cvt_pk_bf16(v0[2], v0[3]); w.z = cvt_pk_bf16(v1[0], v1[1]); w.w = cvt_pk_bf16(v1[2], v1[3]);
                if (XMODE == 1) { asm volatile("" :: "v"(w)); } else st16(rowp + bj * HALF, w); } }
        if (isk && XMODE == 0) {
#pragma unroll
            for (int bj = 0; bj < 2; ++bj)
#pragma unroll
                for (int n = 0; n < 2; ++n)
#pragma unroll
                    for (int e = 0; e < 4; ++e) { float v = cs[bj][n][e]; v += __shfl_xor(v, 1); v += __shfl_xor(v, 2); v += __shfl_xor(v, 4); v += __shfl_xor(v, 8); cs[bj][n][e] = v; }
            if (fr == 0) { const int b = u.pm / NBLK, j = u.pm % NBLK;
#pragma unroll
                for (int bj = 0; bj < 2; ++bj) { const int col = colt + bj * HALF + wc * 32 + 8 * fq, h = col >> 6, d = col & 63;
                    float* kp = KM2 + ((((size_t)wr * NB + b) * NH + h) * NBLK + j) * HD + d;
                    *(f32x4*)kp = cs[bj][0] * (1.0f / MBLK); *(f32x4*)(kp + 4) = cs[bj][1] * (1.0f / MBLK); } } }
    }
};
struct EpiNull {
    static constexpr bool PERM = true;
    __device__ __forceinline__ void operator()(AccRef acc, const Unit& u, int wr, int wc, int fr, int fq) const {
#pragma unroll
        EPI_ROWS {
#pragma unroll
            for (int bj = 0; bj < 2; ++bj) { asm volatile("" :: "v"(acc[ai][bj][m][0]), "v"(acc[ai][bj][m][1])); } }
    }
};
typedef EpiInProjT<0> EpiInProj;
template <bool FULL> struct EpiStoreExp {
    static constexpr bool PERM = true;
    bf16_t* O;
    __device__ __forceinline__ void operator()(AccRef acc, const Unit& u, int wr, int wc, int fr, int fq) const {
        const int row0 = u.pm * BM + wr * 64 + (FULL ? (fr & 7) : fr), col0 = (u.pn & 3) * BM + (FULL ? (wc * 64 + (fr >> 3) * 32 + 8 * fq) : (wc * 32 + 8 * fq));
#pragma unroll
        EPI_ROWS { bf16_t* rowp = O + (size_t)(row0 + ai * HALF + m * 16) * DM + col0;
#pragma unroll
            for (int bj = 0; bj < 2; ++bj) { const f32x4 v0 = acc[ai][bj][m][0], v1 = acc[ai][bj][m][1];
                u32x4 w; w.x = cvt_pk_bf16(v0[0], v0[1]); w.y = cvt_pk_bf16(v0[2], v0[3]); w.z = cvt_pk_bf16(v1[0], v1[1]); w.w = cvt_pk_bf16(v1[2], v1[3]);
                st16(rowp + (FULL ? (size_t)bj * 8 * DM : (size_t)bj * HALF), w); } }
    }
};
struct EpiStore {
    static constexpr bool PERM = true;
    bf16_t* O; int ld;
    __device__ __forceinline__ void operator()(AccRef acc, const Unit& u, int wr, int wc, int fr, int fq) const {
        const int row0 = u.pm * BM + wr * 64 + fr, col0 = u.pn * BM + wc * 32 + 8 * fq;
#pragma unroll
        EPI_ROWS { bf16_t* rowp = O + (size_t)(row0 + ai * HALF + m * 16) * ld + col0;
#pragma unroll
            for (int bj = 0; bj < 2; ++bj) { const f32x4 v0 = acc[ai][bj][m][0], v1 = acc[ai][bj][m][1];
                u32x4 w; w.x = cvt_pk_bf16(v0[0], v0[1]); w.y = cvt_pk_bf16(v0[2], v0[3]); w.z = cvt_pk_bf16(v1[0], v1[1]); w.w = cvt_pk_bf16(v1[2], v1[3]);
                st16(rowp + bj * HALF, w); } }
    }
};
struct EpiMemKV {
    static constexpr bool PERM = true;
    bf16_t* O; bf16_t* VT;
    __device__ __forceinline__ void operator()(AccRef acc, const Unit& u, int wr, int wc, int fr, int fq) const {
        const int rl0 = wr * 64 + fr, col0 = u.pn * BM + wc * 32 + 8 * fq;
#pragma unroll
        EPI_ROWS { const int rl = rl0 + ai * HALF + m * 16;
#pragma unroll
            for (int bj = 0; bj < 2; ++bj) { const f32x4 v0 = acc[ai][bj][m][0], v1 = acc[ai][bj][m][1]; const int col = col0 + bj * HALF;
                if (u.pn < 2) { u32x4 w; w.x = cvt_pk_bf16(v0[0], v0[1]); w.y = cvt_pk_bf16(v0[2], v0[3]); w.z = cvt_pk_bf16(v1[0], v1[1]); w.w = cvt_pk_bf16(v1[2], v1[3]);
                    st16(O + (size_t)(u.pm * BM + rl) * (2 * XW) + col, w); }
                else { bf16_t* vp = VT + ((size_t)u.pm * XW + (col - XW)) * MEML + rl;
#pragma unroll
                    for (int e = 0; e < 4; ++e) { vp[(size_t)e * MEML] = (bf16_t)f2bf(v0[e]); vp[(size_t)(4 + e) * MEML] = (bf16_t)f2bf(v1[e]); } } } }
    }
};
struct EpiGlu {
    static constexpr bool PERM = true;
    const bf16_t* SGB; bf16_t* O;
    __device__ __forceinline__ void operator()(AccRef acc, const Unit& u, int wr, int wc, int fr, int fq) const {
        const int row0 = u.pm * BM + wr * 64 + fr, col0 = u.pn * HALF + wc * 32 + 8 * fq;
#pragma unroll
        EPI_ROWS { const size_t off = (size_t)(row0 + ai * HALF + m * 16) * DM + col0; const u32x2 s = *(const u32x2*)((const unsigned char*)SGB + off);
            const f32x4 v0 = acc[ai][0][m][0], v1 = acc[ai][0][m][1], g0 = acc[ai][1][m][0], g1 = acc[ai][1][m][1];
            float o[8];
#pragma unroll
            for (int e = 0; e < 4; ++e) { o[e] = v0[e] * fsigmoid(g0[e]); o[4 + e] = v1[e] * fsigmoid(g1[e]); }
            o[0] *= ub0(s.x); o[1] *= ub1(s.x); o[2] *= ub2(s.x); o[3] *= ub3(s.x); o[4] *= ub0(s.y); o[5] *= ub1(s.y); o[6] *= ub2(s.y); o[7] *= ub3(s.y);
            u32x4 w; w.x = cvt_pk_bf16(o[0], o[1]); w.y = cvt_pk_bf16(o[2], o[3]); w.z = cvt_pk_bf16(o[4], o[5]); w.w = cvt_pk_bf16(o[6], o[7]);
            st16(O + off, w); }
    }
};
struct EpiMerge {
    static constexpr bool PERM = true;
    const bf16_t* SGA; const bf16_t* Y2; bf16_t* O;
    __device__ __forceinline__ void operator()(AccRef acc, const Unit& u, int wr, int wc, int fr, int fq) const {
        const int row0 = u.pm * BM + wr * 64 + fr, col0 = u.pn * BM + wc * 32 + 8 * fq;
#pragma unroll
        EPI_ROWS {
#pragma unroll
            for (int bj = 0; bj < 2; ++bj) { const size_t off = (size_t)(row0 + ai * HALF + m * 16) * DM + col0 + bj * HALF;
                const u32x2 s = *(const u32x2*)((const unsigned char*)SGA + off); const u32x4 y = *(const u32x4*)(Y2 + off); const f32x4 v0 = acc[ai][bj][m][0], v1 = acc[ai][bj][m][1];
                u32x4 w; w.x = cvt_pk_bf16(ub0(s.x) * v0[0] + bflo(y.x), ub1(s.x) * v0[1] + bfhi(y.x)); w.y = cvt_pk_bf16(ub2(s.x) * v0[2] + bflo(y.y), ub3(s.x) * v0[3] + bfhi(y.y));
                w.z = cvt_pk_bf16(ub0(s.y) * v1[0] + bflo(y.z), ub1(s.y) * v1[1] + bfhi(y.z)); w.w = cvt_pk_bf16(ub2(s.y) * v1[2] + bflo(y.w), ub3(s.y) * v1[3] + bfhi(y.w));
                st16(O + off, w); } }
    }
};
template <bool XBASE> struct EpiResidT {
    static constexpr bool PERM = true;
    const float* base; bf16_t* HB; float* SSQ;
    __device__ __forceinline__ void operator()(AccRef acc, const Unit& u, int wr, int wc, int fr, int fq) const {
        const int row0 = u.pm * BM + wr * 64 + fr, col0 = u.pn * BM + wc * 32 + 8 * fq;
#pragma unroll
        EPI_ROWS { const int row = row0 + ai * HALF + m * 16; const size_t off = (size_t)row * DM + col0; float ss = 0.f;
#pragma unroll
            for (int bj = 0; bj < 2; ++bj) { const size_t o2 = off + bj * HALF; f32x4 h0, h1;
                if (XBASE) { h0 = *(const f32x4*)(base + o2) + acc[ai][bj][m][0]; h1 = *(const f32x4*)(base + o2 + 4) + acc[ai][bj][m][1]; }
                else { const u32x4 w = *(const u32x4*)(HB + o2); h0 = (f32x4){bflo(w.x), bfhi(w.x), bflo(w.y), bfhi(w.y)} + acc[ai][bj][m][0]; h1 = (f32x4){bflo(w.z), bfhi(w.z), bflo(w.w), bfhi(w.w)} + acc[ai][bj][m][1]; }
                u32x4 o; o.x = cvt_pk_bf16(h0[0], h0[1]); o.y = cvt_pk_bf16(h0[2], h0[3]); o.z = cvt_pk_bf16(h1[0], h1[1]); o.w = cvt_pk_bf16(h1[2], h1[3]); st16(HB + o2, o);
                if (XBASE) ss += ((h0[0] * h0[0] + h0[1] * h0[1]) + (h0[2] * h0[2] + h0[3] * h0[3])) + ((h1[0] * h1[0] + h1[1] * h1[1]) + (h1[2] * h1[2] + h1[3] * h1[3])); }
            if (XBASE) { ss += __shfl_xor(ss, 16); ss += __shfl_xor(ss, 32); if (fq == 0) SSQ[(size_t)row * 16 + u.pn * 4 + wc] = ss; } }
    }
};
struct EpiXq {
    static constexpr bool PERM = true;
    const float* SSQ; bf16_t* O;
    __device__ __forceinline__ void operator()(AccRef acc, const Unit& u, int wr, int wc, int fr, int fq) const {
        const int row0 = u.pm * BM + wr * 64 + fr, col0 = u.pn * BM + wc * 32 + 8 * fq;
#pragma unroll
        EPI_ROWS { const int row = row0 + ai * HALF + m * 16; const f32x4* sp = (const f32x4*)(SSQ + (size_t)row * 16);
            const f32x4 a = sp[0] + sp[1] + sp[2] + sp[3]; const float rs = __builtin_amdgcn_rsqf(((a[0] + a[1]) + (a[2] + a[3])) * (1.0f / DM) + RMS_EPS) * XSCALE;
            bf16_t* rowp = O + (size_t)row * XW + col0;
#pragma unroll
            for (int bj = 0; bj < 2; ++bj) { const f32x4 v0 = acc[ai][bj][m][0] * rs, v1 = acc[ai][bj][m][1] * rs;
                u32x4 w; w.x = cvt_pk_bf16(v0[0], v0[1]); w.y = cvt_pk_bf16(v0[2], v0[3]); w.z = cvt_pk_bf16(v1[0], v1[1]); w.w = cvt_pk_bf16(v1[2], v1[3]);
                st16(rowp + bj * HALF, w); } }
    }
};
struct EpiMoe1 {
    static constexpr bool PERM = true;
    const float* bgu; bf16_t* HID;
    __device__ __forceinline__ void operator()(AccRef acc, const Unit& u, int wr, int wc, int fr, int fq) const {
        const int rl0 = wr * 64 + fr, col0 = u.pn * HALF + wc * 32 + 8 * fq; const float* bg = bgu + (size_t)u.e * (2 * DFF) + col0;
        const f32x4 bg0 = *(const f32x4*)(bg), bg1 = *(const f32x4*)(bg + 4), bu0 = *(const f32x4*)(bg + DFF), bu1 = *(const f32x4*)(bg + DFF + 4);
#pragma unroll
        EPI_ROWS { const int rl = rl0 + ai * HALF + m * 16;
            const f32x4 g0 = acc[ai][0][m][0] + bg0, g1 = acc[ai][0][m][1] + bg1, p0 = acc[ai][1][m][0] + bu0, p1 = acc[ai][1][m][1] + bu1;
            float o[8];
#pragma unroll
            for (int e = 0; e < 4; ++e) { const float ga = fminf(g0[e], 7.0f), gb = fminf(g1[e], 7.0f), ua = fminf(fmaxf(p0[e], -7.0f), 7.0f), ub = fminf(fmaxf(p1[e], -7.0f), 7.0f);
                o[e] = (ua + 1.0f) * ga * fsigmoid(1.702f * ga); o[4 + e] = (ub + 1.0f) * gb * fsigmoid(1.702f * gb); }
            if (MOE2_FP8) { int w0 = 0, w1 = 0;
                w0 = __builtin_amdgcn_cvt_pk_fp8_f32(o[0], o[1], w0, false); w0 = __builtin_amdgcn_cvt_pk_fp8_f32(o[2], o[3], w0, true); w1 = __builtin_amdgcn_cvt_pk_fp8_f32(o[4], o[5], w1, false); w1 = __builtin_amdgcn_cvt_pk_fp8_f32(o[6], o[7], w1, true);
                *(u32x2*)((unsigned char*)HID + (size_t)(u.pm * BM + rl) * DFF + col0) = (u32x2){(unsigned)w0, (unsigned)w1}; }
            else { u32x4 w; w.x = cvt_pk_bf16(o[0], o[1]); w.y = cvt_pk_bf16(o[2], o[3]); w.z = cvt_pk_bf16(o[4], o[5]); w.w = cvt_pk_bf16(o[6], o[7]);
                st16(HID + (size_t)(u.pm * BM + rl) * DFF + col0, w); } }
    }
};
struct EpiMoe2 {
    static constexpr bool PERM = true;
    const float* bdn; const LAS int* tabD; const LAS float* tabG; bf16_t* Y;
    __device__ __forceinline__ void operator()(AccRef acc, const Unit& u, int wr, int wc, int fr, int fq) const {
        const int rl0 = wr * 64 + fr, col0 = u.pn * BM + wc * 32 + 8 * fq; const float* bd = bdn + (size_t)u.e * DM + col0;
        f32x4 bv[2][2];
#pragma unroll
        for (int bj = 0; bj < 2; ++bj)
#pragma unroll
            for (int n = 0; n < 2; ++n) bv[bj][n] = *(const f32x4*)(bd + bj * HALF + 4 * n);
#pragma unroll
        EPI_ROWS { const int rl = rl0 + ai * HALF + m * 16; const int dest = tabD[u.ui * 256 + rl];
            if (dest >= 0) { const float gt = tabG[u.ui * 256 + rl]; bf16_t* rowp = Y + (size_t)dest * DM + col0;
#pragma unroll
                for (int bj = 0; bj < 2; ++bj) { const f32x4 v0 = (acc[ai][bj][m][0] + bv[bj][0]) * gt, v1 = (acc[ai][bj][m][1] + bv[bj][1]) * gt;
                    u32x4 w; w.x = cvt_pk_bf16(v0[0], v0[1]); w.y = cvt_pk_bf16(v0[2], v0[3]); w.z = cvt_pk_bf16(v1[0], v1[1]); w.w = cvt_pk_bf16(v1[2], v1[3]);
                    st16(rowp + bj * HALF, w); } } }
    }
};
}

struct MoeOrder {
    pg8::PatchOrder P; const LAS int* pref; int rev;
    __device__ __forceinline__ bool next(int i, pg8::Unit& u) const {
        if (!P.next(i, u)) return false;
        if (rev) u.pm = P.nM - 1 - u.pm;
        int e = 0;
#pragma unroll 1
        for (int k = 1; k < NE; ++k) e += (pref[k] <= u.pm) ? 1 : 0;
        u.e = e; u.mi = u.pm - pref[e]; return true;
    }
};

namespace attn_body {
using bf16=__hip_bfloat16;
using bf16x8=__attribute__((ext_vector_type(8)))short;
using s16x4=__attribute__((ext_vector_type(4)))short;
using f32x16=__attribute__((ext_vector_type(16)))float;
using u32x4=__attribute__((ext_vector_type(4)))unsigned;
constexpr int BATCH=4,NHEAD=8,SEQ=8192,D=64,DM=NHEAD*D;
constexpr int NW=8,QBLK=32,QB=QBLK*NW,KVBLK=64,NQB=SEQ/QB;
constexpr int ATTN_PITCH=DM, ATTN_UNIT_ROWS=QB;
__device__ __forceinline__ int crow(int r,int hi){return (r&3)+8*(r>>2)+4*hi;}
#define SBAR() __builtin_amdgcn_sched_barrier(0)
__device__ __forceinline__ void cmask(f32x16&p0,f32x16&p1,int jb,int qrel,int hi){
  const float NEG=-INFINITY; int kb=64*jb+4*hi;
  #pragma unroll
  for(int r=0;r<16;++r){int kv=kb+(r&3)+8*(r>>2); if(kv>qrel)p0[r]=NEG; if(kv+32>qrel)p1[r]=NEG;}
}

constexpr int NSLOT=4, SLOTB=8192;
constexpr int LDS_K=0, LDS_V=NSLOT*SLOTB, LDS_WS=2*NSLOT*SLOTB, LDS_OST=LDS_WS+NW*64*4, LDS_KM=LDS_OST+NW*4096, LDS_SEL=LDS_KM+32*64*4, LDS_DST=LDS_SEL+1024, LDS_BYTES=LDS_DST+1024;
constexpr float C2=0.125f*1.4426950408889634f;
__device__ __forceinline__ void glds16(const void*gsrc,unsigned lds_dst){unsigned keep;
  asm volatile("s_mov_b32 %0, m0\n\ts_mov_b32 m0, %2\n\ts_nop 0\n\tglobal_load_lds_dwordx4 %1, off\n\ts_mov_b32 m0, %0":"=&s"(keep):"v"(gsrc),"s"(lds_dst):"memory");}
__device__ __forceinline__ float max3f(float a,float b,float c){float r;asm("v_max3_f32 %0, %1, %2, %3":"=v"(r):"v"(a),"v"(b),"v"(c));return r;}
__device__ __forceinline__ float max2f(float a,float b){float r;asm("v_max_f32_e32 %0, %1, %2":"=v"(r):"v"(a),"v"(b));return r;}
__device__ __forceinline__ float fadd_s(float a,float b){float r;asm("v_add_f32_e32 %0, %1, %2":"=v"(r):"v"(a),"v"(b));return r;}
__device__ __forceinline__ float fsub_s(float a,float b){float r;asm("v_sub_f32_e32 %0, %1, %2":"=v"(r):"v"(a),"v"(b));return r;}
typedef float f32x2_t __attribute__((ext_vector_type(2))); typedef __bf16 bf16x2_t __attribute__((ext_vector_type(2)));
__device__ __forceinline__ unsigned cvtpk_s(float lo,float hi){f32x2_t v={lo,hi};bf16x2_t b=__builtin_convertvector(v,bf16x2_t);return __builtin_bit_cast(unsigned,b);}
#define WAIT_BAR(N) asm volatile("s_waitcnt vmcnt(" #N ") lgkmcnt(0)\n\ts_barrier":::"memory")

__device__ __forceinline__ void qkt(f32x16&p0,f32x16&p1,const char*Kslot,const bf16x8*qr,const f32x16&negm,int r32,int hi){
  const char*kb=Kslot+hi*1024+r32*16;
  #pragma unroll
  for(int d0=0;d0<4;++d0){
    const bf16x8 b0=*reinterpret_cast<const bf16x8*>(kb+d0*2048);
    const bf16x8 b1=*reinterpret_cast<const bf16x8*>(kb+d0*2048+512);
    if(d0==0){p0=__builtin_amdgcn_mfma_f32_32x32x16_bf16(b0,qr[0],negm,0,0,0);p1=__builtin_amdgcn_mfma_f32_32x32x16_bf16(b1,qr[0],negm,0,0,0);}
    else{p0=__builtin_amdgcn_mfma_f32_32x32x16_bf16(b0,qr[d0],p0,0,0,0);p1=__builtin_amdgcn_mfma_f32_32x32x16_bf16(b1,qr[d0],p1,0,0,0);}}
}
typedef __attribute__((address_space(3))) const char* lds_cptr;
typedef short v4i16_t __attribute__((ext_vector_type(4)));
__device__ __forceinline__ void kload8(bf16x8*kf,lds_cptr kp){
  kf[0]=*(const __attribute__((address_space(3))) bf16x8*)(kp);      kf[1]=*(const __attribute__((address_space(3))) bf16x8*)(kp+512);
  kf[2]=*(const __attribute__((address_space(3))) bf16x8*)(kp+2048); kf[3]=*(const __attribute__((address_space(3))) bf16x8*)(kp+2560);
  kf[4]=*(const __attribute__((address_space(3))) bf16x8*)(kp+4096); kf[5]=*(const __attribute__((address_space(3))) bf16x8*)(kp+4608);
  kf[6]=*(const __attribute__((address_space(3))) bf16x8*)(kp+6144); kf[7]=*(const __attribute__((address_space(3))) bf16x8*)(kp+6656);
}
__device__ __forceinline__ void kload2(bf16x8*kf,lds_cptr kp,int j){ kf[2*j]=*(const __attribute__((address_space(3))) bf16x8*)(kp+j*2048); kf[2*j+1]=*(const __attribute__((address_space(3))) bf16x8*)(kp+j*2048+512); }
__device__ __forceinline__ s16x4 vtr(lds_cptr p){ return __builtin_bit_cast(s16x4,__builtin_amdgcn_ds_read_tr16_b64_v4i16((__attribute__((address_space(3))) v4i16_t*)p)); }
__device__ __forceinline__ float rowmax(const f32x16&p0,const f32x16&p1){
  float a=max3f(p0[0],p0[1],p1[0]),b=max3f(p0[2],p0[3],p1[1]);a=max3f(a,p1[2],p1[3]);
  #pragma unroll
  for(int r=4;r<16;r+=4){a=max3f(a,p0[r],p0[r+1]);b=max3f(b,p0[r+2],p0[r+3]);a=max3f(a,p1[r],p1[r+1]);b=max3f(b,p1[r+2],p1[r+3]);}
  const float m=max2f(a,b);
  auto rr=__builtin_amdgcn_permlane32_swap(__float_as_uint(m),__float_as_uint(m),false,false);
  return max2f(__uint_as_float(rr[0]),__uint_as_float(rr[1]));
}
__device__ __forceinline__ void pv(f32x16*o,int vb,bf16x8 pa0,bf16x8 pa1,bf16x8 pa2,bf16x8 pa3){
  #pragma unroll
  for(int d0=0;d0<2;++d0){s16x4 lo[4],hi[4];
    #pragma unroll
    for(int ks=0;ks<4;++ks){
      asm volatile("ds_read_b64_tr_b16 %0,%1 offset:%c2":"=&v"(lo[ks]):"v"(vb),"i"(d0*4096+ks*1024):"memory");
      asm volatile("ds_read_b64_tr_b16 %0,%1 offset:%c2":"=&v"(hi[ks]):"v"(vb),"i"(d0*4096+ks*1024+512):"memory");}
    asm volatile("s_waitcnt lgkmcnt(0)":::"memory");SBAR();
    #define PK(k) (bf16x8){lo[k][0],lo[k][1],lo[k][2],lo[k][3],hi[k][0],hi[k][1],hi[k][2],hi[k][3]}
    o[d0]=__builtin_amdgcn_mfma_f32_32x32x16_bf16(pa0,PK(0),o[d0],0,0,0);
    o[d0]=__builtin_amdgcn_mfma_f32_32x32x16_bf16(pa1,PK(1),o[d0],0,0,0);
    o[d0]=__builtin_amdgcn_mfma_f32_32x32x16_bf16(pa2,PK(2),o[d0],0,0,0);
    o[d0]=__builtin_amdgcn_mfma_f32_32x32x16_bf16(pa3,PK(3),o[d0],0,0,0);
    #undef PK
  }
}

#ifndef ATTN_STORE16
#define ATTN_STORE16(p,v) (*(u32x4*)(p)=(v))
#endif
template<int THRL> __device__ __forceinline__ void attn_unit(int b,int h,int qb,const bf16*Q,const bf16*__restrict__ K,const bf16*__restrict__ V,bf16*O,char*shm){
  const int tid=threadIdx.x,lane=tid&63,r32=lane&31,hi=lane>>5; const int wid=__builtin_amdgcn_readfirstlane(tid>>6);
  const long rowbase=(long)b*SEQ; const int q0=qb*QB;
  const bf16*Qw=Q+(rowbase+q0+wid*QBLK)*DM+h*D;
  const bf16*Kh=K+rowbase*DM+h*D,*Vh=V+rowbase*DM+h*D;
  const unsigned lds0=(unsigned)(uintptr_t)shm;
  float*wsf=(float*)(shm+LDS_WS)+wid*64;
  const bf16*ksrc=Kh+(long)lane*DM+wid*8;
  const bf16*vsrc=Vh+(long)(16*(wid&3)+(lane>>2))*DM+(wid>>2)*32+(lane&3)*8;
  const unsigned kdst=lds0+LDS_K+wid*1024, vdst=lds0+LDS_V+wid*1024;
  #define DMA_K(t,slot) glds16(ksrc+(long)(t)*KVBLK*DM,(unsigned)__builtin_amdgcn_readfirstlane(kdst+(slot)))
  #define DMA_V(t,slot) glds16(vsrc+(long)(t)*KVBLK*DM,(unsigned)__builtin_amdgcn_readfirstlane(vdst+(slot)))
  const int vb0=(int)(lds0+LDS_V)+((lane>>4)&1)*32+(lane&3)*8+(4*hi+((lane&15)>>2))*64;
  const char*Kbase=shm+LDS_K; bf16x8 kf[8];
  const lds_cptr shm3=(lds_cptr)shm; const lds_cptr kp0=shm3+LDS_K+hi*1024+r32*16; const lds_cptr vp0=shm3+LDS_V+((lane>>4)&1)*32+(lane&3)*8+(4*hi+((lane&15)>>2))*64;
  const int NT=(q0+QB)/KVBLK;
  DMA_K(0,0);DMA_V(0,0);DMA_K(1,SLOTB);
  bf16x8 qr[4];
  #pragma unroll
  for(int d0=0;d0<4;++d0)qr[d0]=*reinterpret_cast<const bf16x8*>(&Qw[(long)r32*DM+d0*16+hi*8]);
  { int lp_=lane; asm volatile("":"+v"(lp_)); const int r32p=lp_&31, hip=lp_>>5;
    unsigned sel=0u; const __attribute__((address_space(3))) float*km=(const __attribute__((address_space(3))) float*)((__attribute__((address_space(3))) const char*)shm+LDS_KM); float g0=-3e38f,g1=-3e38f,g2=-3e38f; int s0=-1,s1=-1,s2=-1;
    for(int j=0;j<qb;++j){ float g=0.f;
      #pragma unroll
      for(int d0=0;d0<4;++d0){
        #pragma unroll
        for(int e=0;e<8;++e)g+=__builtin_bit_cast(float,((unsigned)(unsigned short)qr[d0][e])<<16)*km[j*64+16*d0+8*hip+e];}
      g+=__shfl_xor(g,32);
      if(g>g0){g2=g1;s2=s1;g1=g0;s1=s0;g0=g;s0=j;}else if(g>g1){g2=g1;s2=s1;g1=g;s1=j;}else if(g>g2){g2=g;s2=j;} }
    if(s0>=0)sel|=1u<<s0; if(s1>=0)sel|=1u<<s1; if(s2>=0)sel|=1u<<s2;
    if(hip==0)((__attribute__((address_space(3))) unsigned*)((__attribute__((address_space(3))) char*)shm+LDS_SEL))[wid*32+r32p]=sel; asm volatile("s_waitcnt lgkmcnt(0)":::"memory"); }
  float mhat=0.f,l_reg=0.f;f32x16 o[2];o[0]=f32x16{};o[1]=f32x16{};f32x16 negm=f32x16{};asm volatile("":"+v"(negm));
  const int qrel=wid*QBLK+r32;
  #define BMASK(P0,P1,t) do{}while(0)
  #define CMASK(P0,P1,t) do{int jb_=(t)-(NT-4); if(jb_>=0)cmask(P0,P1,jb_,qrel,hi); else BMASK(P0,P1,t);}while(0)
  bool resc=false;
  #define START(P0,P1) do{ const float rm=rowmax(P0,P1); resc=false; \
    { const float dl=__builtin_fmaxf(rm,-64.f); mhat=fadd_s(mhat,dl); \
      _Pragma("unroll") for(int r=0;r<16;++r){P0[r]=fsub_s(P0[r],dl);P1[r]=fsub_s(P1[r],dl);} \
      _Pragma("unroll") for(int r=0;r<16;++r)negm[r]=-mhat; asm volatile("":"+v"(negm)); } \
    _Pragma("unroll") for(int r=0;r<16;++r)P0[r]=__builtin_amdgcn_exp2f(P0[r]); }while(0)
  #define RESC() do{ if(resc){ asm volatile("s_waitcnt lgkmcnt(0)":::"memory"); \
      _Pragma("unroll") for(int d_=0;d_<2;++d_) _Pragma("unroll") for(int r=0;r<16;++r)o[d_][r]*=wsf[crow(r,hi)]; } }while(0)
  f32x16 pA0,pA1,pB0,pB1;
  int sl_prev=0,sl_cur=0,sl_next=SLOTB;
  #define ROT() do{sl_prev=sl_cur;sl_cur=sl_next;sl_next=(sl_next==(NSLOT-1)*SLOTB)?0:sl_next+SLOTB;}while(0)
  DMA_K(2,2*SLOTB);
  WAIT_BAR(3);
  qkt(pA0,pA1,Kbase,qr,negm,r32,hi);asm volatile("s_nop 15\n\ts_nop 7":"+v"(pA0),"+v"(pA1));CMASK(pA0,pA1,0);
  START(pA0,pA1);
  _Pragma("unroll") for(int r=0;r<16;++r)pA1[r]=__builtin_amdgcn_exp2f(pA1[r]);
  WAIT_BAR(0);
  DMA_K(3,0);DMA_V(1,SLOTB);
  ROT();
  kload8(kf,kp0+sl_cur);
  WAIT_BAR(2);
  s16x4 vlo[8],vhi[8]; u32x4 pw0,pw1,pw2,pw3;
  #define PKW(P,B) (keep_?cvtpk_s(P[B],P[B+1]):0u)
  #define PAF(k) __builtin_bit_cast(bf16x8,pw##k)
  #define VFR(i) (bf16x8){vlo[i][0],vlo[i][1],vlo[i][2],vlo[i][3],vhi[i][0],vhi[i][1],vhi[i][2],vhi[i][3]}
  #define PIN(x) asm volatile("":"+v"(x))
  #define MX3(a,b,c) __builtin_fmaxf(__builtin_fmaxf((a),(b)),(c))
  #define GAPA(MF,A0,A1,A2,A3,W0,W1,PW) do{ MF; sacc+=A0; sacc+=A1; sacc+=A2; sacc+=A3; PIN(sacc); W0; W1; PIN(PW); SBAR(); }while(0)
  #define EX(v) __builtin_amdgcn_exp2f(v)
  #define GAPB(MF,X,B) do{ MF; X[B]=EX(X[B]); X[B+1]=EX(X[B+1]); X[B+2]=EX(X[B+2]); X[B+3]=EX(X[B+3]); PIN(X); SBAR(); }while(0)
  #define VRD(i) do{ vlo[i]=vtr(vp_+(((i)>>2)*4096+((i)&3)*1024)); vhi[i]=vtr(vp_+(((i)>>2)*4096+((i)&3)*1024+512)); }while(0)
  #define KRD(G,j) do{ if(G){ kload2(kf,kp0+sl_next,j); SBAR(); } }while(0)
  #define STEP(C0,C1,P0,P1,t,GK,GV,GL) do{ SBAR(); \
    int q_=qrel; asm volatile("":"+v"(q_)); const unsigned selw_=((const volatile __attribute__((address_space(3))) unsigned*)((__attribute__((address_space(3))) const char*)shm+LDS_SEL))[q_]; \
    const bool keep_=((t)-1>=NT-4)||((selw_>>(((t)-1)>>2))&1u); \
    const lds_cptr vp_=vp0+sl_prev; \
    VRD(0); SBAR(); float sacc=(P0[0]+P0[1]); \
    GAPA(C0=__builtin_amdgcn_mfma_f32_32x32x16_bf16(kf[0],qr[0],negm,0,0,0), P0[2],P0[3],P0[4],P0[5],     pw0[0]=PKW(P0,0), pw0[1]=PKW(P0,2), pw0); \
    VRD(4); SBAR(); GAPA(C1=__builtin_amdgcn_mfma_f32_32x32x16_bf16(kf[1],qr[0],negm,0,0,0), P0[6],P0[7],P0[8],P0[9],     pw0[2]=PKW(P0,4), pw0[3]=PKW(P0,6), pw0); \
    VRD(1); SBAR(); GAPA(C0=__builtin_amdgcn_mfma_f32_32x32x16_bf16(kf[2],qr[1],C0,0,0,0),   P0[10],P0[11],P0[12],P0[13], pw1[0]=PKW(P0,8), pw1[1]=PKW(P0,10), pw1); \
    VRD(5); SBAR(); GAPA(C1=__builtin_amdgcn_mfma_f32_32x32x16_bf16(kf[3],qr[1],C1,0,0,0),   P0[14],P0[15],P1[0],P1[1],   pw1[2]=PKW(P0,12),pw1[3]=PKW(P0,14), pw1); \
    VRD(2); SBAR(); GAPA(C0=__builtin_amdgcn_mfma_f32_32x32x16_bf16(kf[4],qr[2],C0,0,0,0),   P1[2],P1[3],P1[4],P1[5],     pw2[0]=PKW(P1,0), pw2[1]=PKW(P1,2), pw2); \
    VRD(6); SBAR(); GAPA(C1=__builtin_amdgcn_mfma_f32_32x32x16_bf16(kf[5],qr[2],C1,0,0,0),   P1[6],P1[7],P1[8],P1[9],     pw2[2]=PKW(P1,4), pw2[3]=PKW(P1,6), pw2); \
    VRD(3); SBAR(); GAPA(C0=__builtin_amdgcn_mfma_f32_32x32x16_bf16(kf[6],qr[3],C0,0,0,0),   P1[10],P1[11],P1[12],P1[13], pw3[0]=PKW(P1,8), pw3[1]=PKW(P1,10), pw3); \
    VRD(7); SBAR(); GAPA(C1=__builtin_amdgcn_mfma_f32_32x32x16_bf16(kf[7],qr[3],C1,0,0,0),   P1[14],P1[15],0.f,0.f,       pw3[2]=PKW(P1,12),pw3[3]=PKW(P1,14), pw3); \
    l_reg+=keep_?sacc:0.f; \
    if(GK){DMA_K((t)+3,sl_cur);} if(GV){DMA_V((t)+1,sl_next);} \
    CMASK(C0,C1,t); \
    { float a=MX3(C0[0],C0[1],C1[0]),b=MX3(C0[2],C0[3],C1[1]); a=MX3(a,C1[2],C1[3]); \
      _Pragma("unroll") for(int r=4;r<16;r+=4){a=MX3(a,C0[r],C0[r+1]);b=MX3(b,C0[r+2],C0[r+3]);a=MX3(a,C1[r],C1[r+1]);b=MX3(b,C1[r+2],C1[r+3]);} \
      float rm=__builtin_fmaxf(a,b); { auto rr=__builtin_amdgcn_permlane32_swap(__float_as_uint(rm),__float_as_uint(rm),false,false); rm=__builtin_fmaxf(__uint_as_float(rr[0]),__uint_as_float(rr[1])); } \
      resc=false; \
      if(__builtin_expect(__any(rm>(float)THRL),0)){ const float dl=__builtin_fmaxf(rm,0.f); mhat+=dl; \
        _Pragma("unroll") for(int r=0;r<16;++r){C0[r]-=dl;C1[r]-=dl;} \
        _Pragma("unroll") for(int r=0;r<16;++r)negm[r]=-mhat; asm volatile("":"+v"(negm)); \
        const float f=__builtin_amdgcn_exp2f(-dl); l_reg*=f; if(hi==0)wsf[r32]=f; resc=true; } } \
    SBAR(); \
    GAPB(o[0]=__builtin_amdgcn_mfma_f32_32x32x16_bf16(PAF(0),VFR(0),o[0],0,0,0), C0,0); \
    GAPB(o[1]=__builtin_amdgcn_mfma_f32_32x32x16_bf16(PAF(0),VFR(4),o[1],0,0,0), C0,4); \
    KRD(GL,0); GAPB(o[0]=__builtin_amdgcn_mfma_f32_32x32x16_bf16(PAF(1),VFR(1),o[0],0,0,0), C0,8); \
    KRD(GL,1); GAPB(o[1]=__builtin_amdgcn_mfma_f32_32x32x16_bf16(PAF(1),VFR(5),o[1],0,0,0), C0,12); \
    KRD(GL,2); GAPB(o[0]=__builtin_amdgcn_mfma_f32_32x32x16_bf16(PAF(2),VFR(2),o[0],0,0,0), C1,0); \
    KRD(GL,3); GAPB(o[1]=__builtin_amdgcn_mfma_f32_32x32x16_bf16(PAF(2),VFR(6),o[1],0,0,0), C1,4); \
    GAPB(o[0]=__builtin_amdgcn_mfma_f32_32x32x16_bf16(PAF(3),VFR(3),o[0],0,0,0), C1,8); \
    GAPB(o[1]=__builtin_amdgcn_mfma_f32_32x32x16_bf16(PAF(3),VFR(7),o[1],0,0,0), C1,12); \
    }while(0)
  int t=1;
  for(;t+5<NT;t+=2){
    STEP(pB0,pB1,pA0,pA1,t,true,true,true);     WAIT_BAR(2); RESC(); ROT();
    STEP(pA0,pA1,pB0,pB1,t+1,true,true,true);   WAIT_BAR(2); RESC(); ROT();
  }
  #define ENDW(tt) do{ if((tt)+3<NT){WAIT_BAR(2);} else if((tt)+2<NT){WAIT_BAR(1);} else {WAIT_BAR(0);} }while(0)
  for(;t+1<NT;t+=2){
    STEP(pB0,pB1,pA0,pA1,t,(t+3<NT),(t+1<NT),(t+1<NT));       ENDW(t);   RESC(); ROT();
    STEP(pA0,pA1,pB0,pB1,t+1,(t+4<NT),(t+2<NT),(t+2<NT));     ENDW(t+1); RESC(); ROT();
  }
  STEP(pB0,pB1,pA0,pA1,NT-1,false,false,false); RESC();
  { const bool keep_=true; float sacc=pB0[0]+pB0[1]; _Pragma("unroll") for(int r=2;r<16;++r)sacc+=pB0[r]; _Pragma("unroll") for(int r=0;r<16;++r)sacc+=pB1[r]; l_reg+=sacc;
    pw0=(u32x4){PKW(pB0,0),PKW(pB0,2),PKW(pB0,4),PKW(pB0,6)};pw1=(u32x4){PKW(pB0,8),PKW(pB0,10),PKW(pB0,12),PKW(pB0,14)};pw2=(u32x4){PKW(pB1,0),PKW(pB1,2),PKW(pB1,4),PKW(pB1,6)};pw3=(u32x4){PKW(pB1,8),PKW(pB1,10),PKW(pB1,12),PKW(pB1,14)};
    SBAR(); pv(o,vb0+sl_cur,PAF(0),PAF(1),PAF(2),PAF(3)); }
  #undef PKW
  #undef PAF
  #undef VFR
  #undef PIN
  #undef MX3
  #undef GAPA
  #undef GAPB
  #undef EX
  #undef VRD
  #undef KRD
  #undef STEP
  #undef ENDW
  {auto rr=__builtin_amdgcn_permlane32_swap(__float_as_uint(l_reg),__float_as_uint(l_reg),false,false);l_reg=__uint_as_float(rr[0])+__uint_as_float(rr[1]);}
  if(hi==0)wsf[32+r32]=l_reg;asm volatile("s_waitcnt lgkmcnt(0)":::"memory");
  float rli[16];
  #pragma unroll
  for(int r=0;r<16;++r)rli[r]=__builtin_amdgcn_rcpf(wsf[32+crow(r,hi)]);
  bf16*Ow=O+(rowbase+q0+wid*QBLK)*DM+h*D;
  { bf16*stg=(bf16*)(shm+LDS_OST)+wid*2048;
    #pragma unroll
    for(int r=0;r<16;++r){const int orow=crow(r,hi);
      #pragma unroll
      for(int d0=0;d0<2;++d0)stg[orow*64+d0*32+r32]=__float2bfloat16(o[d0][r]*rli[r]);}
    asm volatile("s_waitcnt lgkmcnt(0)":::"memory");
    #pragma unroll
    for(int i=0;i<4;++i){const int row=i*8+(lane>>3),ch=lane&7; const u32x4 v=*(const u32x4*)(stg+row*64+ch*8); ATTN_STORE16(Ow+(long)row*DM+ch*8,v);} }
  asm volatile("s_waitcnt lgkmcnt(0)\n\ts_barrier":::"memory");
  #undef DMA_K
  #undef DMA_V
  #undef CMASK
  #undef BMASK
  #undef START
  #undef RESC
  #undef ROT
}
template<int THRL> __device__ __forceinline__ void moba_unit4(const bf16*Qrow,const bf16*__restrict__ Kh,const bf16*__restrict__ Vh,bool causal,int dest,bf16*PO,float*PML,char*shm){
  int tid_=threadIdx.x; asm volatile("":"+v"(tid_)); const int tid=tid_,lane=tid&63,r32=lane&31,hi=lane>>5; const int wid=__builtin_amdgcn_readfirstlane(tid>>6);
  const unsigned lds0=(unsigned)(uintptr_t)shm;
  float*wsf=(float*)(shm+LDS_WS)+wid*64;
  const bf16*ksrc=Kh+(long)lane*DM+wid*8;
  const bf16*vsrc=Vh+(long)(16*(wid&3)+(lane>>2))*DM+(wid>>2)*32+(lane&3)*8;
  const unsigned kdst=lds0+LDS_K+wid*1024, vdst=lds0+LDS_V+wid*1024;
  #define DMA_K(t,slot) glds16(ksrc+(long)(t)*KVBLK*DM,(unsigned)__builtin_amdgcn_readfirstlane(kdst+(slot)))
  #define DMA_V(t,slot) glds16(vsrc+(long)(t)*KVBLK*DM,(unsigned)__builtin_amdgcn_readfirstlane(vdst+(slot)))
  const int vb0=(int)(lds0+LDS_V)+((lane>>4)&1)*32+(lane&3)*8+(4*hi+((lane&15)>>2))*64;
  const char*Kbase=shm+LDS_K; bf16x8 kf[8];
  const lds_cptr shm3=(lds_cptr)shm; const lds_cptr kp0=shm3+LDS_K+hi*1024+r32*16; const lds_cptr vp0=shm3+LDS_V+((lane>>4)&1)*32+(lane&3)*8+(4*hi+((lane&15)>>2))*64;
  constexpr int NT=4;
  DMA_K(0,0);DMA_V(0,0);DMA_K(1,SLOTB);
  bf16x8 qr[4];
  #pragma unroll
  for(int d0=0;d0<4;++d0)qr[d0]=*reinterpret_cast<const bf16x8*>(Qrow+d0*16+hi*8);
  float mhat=0.f,l_reg=0.f;f32x16 o[2];o[0]=f32x16{};o[1]=f32x16{};f32x16 negm=f32x16{};asm volatile("":"+v"(negm));
  const int qrel=wid*QBLK+r32;
  #define BMASK(P0,P1,t) do{}while(0)
  #define CMASK(P0,P1,t) do{ if(causal)cmask(P0,P1,(t),qrel,hi); }while(0)
  bool resc=false;
  #define START(P0,P1) do{ const float rm=rowmax(P0,P1); resc=false; \
    { const float dl=__builtin_fmaxf(rm,-64.f); mhat=fadd_s(mhat,dl); \
      _Pragma("unroll") for(int r=0;r<16;++r){P0[r]=fsub_s(P0[r],dl);P1[r]=fsub_s(P1[r],dl);} \
      _Pragma("unroll") for(int r=0;r<16;++r)negm[r]=-mhat; asm volatile("":"+v"(negm)); } \
    _Pragma("unroll") for(int r=0;r<16;++r)P0[r]=__builtin_amdgcn_exp2f(P0[r]); }while(0)
  #define RESC() do{ if(resc){ asm volatile("s_waitcnt lgkmcnt(0)":::"memory"); \
      _Pragma("unroll") for(int d_=0;d_<2;++d_) _Pragma("unroll") for(int r=0;r<16;++r)o[d_][r]*=wsf[crow(r,hi)]; } }while(0)
  f32x16 pA0,pA1,pB0,pB1;
  int sl_prev=0,sl_cur=0,sl_next=SLOTB;
  #define ROT() do{sl_prev=sl_cur;sl_cur=sl_next;sl_next=(sl_next==(NSLOT-1)*SLOTB)?0:sl_next+SLOTB;}while(0)
  DMA_K(2,2*SLOTB);
  WAIT_BAR(3);
  qkt(pA0,pA1,Kbase,qr,negm,r32,hi);asm volatile("s_nop 15\n\ts_nop 7":"+v"(pA0),"+v"(pA1));CMASK(pA0,pA1,0);
  START(pA0,pA1);
  _Pragma("unroll") for(int r=0;r<16;++r)pA1[r]=__builtin_amdgcn_exp2f(pA1[r]);
  WAIT_BAR(0);
  DMA_K(3,0);DMA_V(1,SLOTB);
  ROT();
  kload8(kf,kp0+sl_cur);
  WAIT_BAR(2);
  s16x4 vlo[8],vhi[8]; u32x4 pw0,pw1,pw2,pw3;
  #define PKW(P,B) (keep_?cvtpk_s(P[B],P[B+1]):0u)
  #define PAF(k) __builtin_bit_cast(bf16x8,pw##k)
  #define VFR(i) (bf16x8){vlo[i][0],vlo[i][1],vlo[i][2],vlo[i][3],vhi[i][0],vhi[i][1],vhi[i][2],vhi[i][3]}
  #define PIN(x) asm volatile("":"+v"(x))
  #define MX3(a,b,c) __builtin_fmaxf(__builtin_fmaxf((a),(b)),(c))
  #define GAPA(MF,A0,A1,A2,A3,W0,W1,PW) do{ MF; sacc+=A0; sacc+=A1; sacc+=A2; sacc+=A3; PIN(sacc); W0; W1; PIN(PW); SBAR(); }while(0)
  #define EX(v) __builtin_amdgcn_exp2f(v)
  #define GAPB(MF,X,B) do{ MF; X[B]=EX(X[B]); X[B+1]=EX(X[B+1]); X[B+2]=EX(X[B+2]); X[B+3]=EX(X[B+3]); PIN(X); SBAR(); }while(0)
  #define VRD(i) do{ vlo[i]=vtr(vp_+(((i)>>2)*4096+((i)&3)*1024)); vhi[i]=vtr(vp_+(((i)>>2)*4096+((i)&3)*1024+512)); }while(0)
  #define KRD(G,j) do{ if(G){ kload2(kf,kp0+sl_next,j); SBAR(); } }while(0)
  #define STEP(C0,C1,P0,P1,t,GK,GV,GL) do{ SBAR(); \
    const bool keep_=true; \
    const lds_cptr vp_=vp0+sl_prev; \
    VRD(0); SBAR(); float sacc=(P0[0]+P0[1]); \
    GAPA(C0=__builtin_amdgcn_mfma_f32_32x32x16_bf16(kf[0],qr[0],negm,0,0,0), P0[2],P0[3],P0[4],P0[5],     pw0[0]=PKW(P0,0), pw0[1]=PKW(P0,2), pw0); \
    VRD(4); SBAR(); GAPA(C1=__builtin_amdgcn_mfma_f32_32x32x16_bf16(kf[1],qr[0],negm,0,0,0), P0[6],P0[7],P0[8],P0[9],     pw0[2]=PKW(P0,4), pw0[3]=PKW(P0,6), pw0); \
    VRD(1); SBAR(); GAPA(C0=__builtin_amdgcn_mfma_f32_32x32x16_bf16(kf[2],qr[1],C0,0,0,0),   P0[10],P0[11],P0[12],P0[13], pw1[0]=PKW(P0,8), pw1[1]=PKW(P0,10), pw1); \
    VRD(5); SBAR(); GAPA(C1=__builtin_amdgcn_mfma_f32_32x32x16_bf16(kf[3],qr[1],C1,0,0,0),   P0[14],P0[15],P1[0],P1[1],   pw1[2]=PKW(P0,12),pw1[3]=PKW(P0,14), pw1); \
    VRD(2); SBAR(); GAPA(C0=__builtin_amdgcn_mfma_f32_32x32x16_bf16(kf[4],qr[2],C0,0,0,0),   P1[2],P1[3],P1[4],P1[5],     pw2[0]=PKW(P1,0), pw2[1]=PKW(P1,2), pw2); \
    VRD(6); SBAR(); GAPA(C1=__builtin_amdgcn_mfma_f32_32x32x16_bf16(kf[5],qr[2],C1,0,0,0),   P1[6],P1[7],P1[8],P1[9],     pw2[2]=PKW(P1,4), pw2[3]=PKW(P1,6), pw2); \
    VRD(3); SBAR(); GAPA(C0=__builtin_amdgcn_mfma_f32_32x32x16_bf16(kf[6],qr[3],C0,0,0,0),   P1[10],P1[11],P1[12],P1[13], pw3[0]=PKW(P1,8), pw3[1]=PKW(P1,10), pw3); \
    VRD(7); SBAR(); GAPA(C1=__builtin_amdgcn_mfma_f32_32x32x16_bf16(kf[7],qr[3],C1,0,0,0),   P1[14],P1[15],0.f,0.f,       pw3[2]=PKW(P1,12),pw3[3]=PKW(P1,14), pw3); \
    l_reg+=keep_?sacc:0.f; \
    if(GK){DMA_K((t)+3,sl_cur);} if(GV){DMA_V((t)+1,sl_next);} \
    CMASK(C0,C1,t); \
    { float a=MX3(C0[0],C0[1],C1[0]),b=MX3(C0[2],C0[3],C1[1]); a=MX3(a,C1[2],C1[3]); \
      _Pragma("unroll") for(int r=4;r<16;r+=4){a=MX3(a,C0[r],C0[r+1]);b=MX3(b,C0[r+2],C0[r+3]);a=MX3(a,C1[r],C1[r+1]);b=MX3(b,C1[r+2],C1[r+3]);} \
      float rm=__builtin_fmaxf(a,b); { auto rr=__builtin_amdgcn_permlane32_swap(__float_as_uint(rm),__float_as_uint(rm),false,false); rm=__builtin_fmaxf(__uint_as_float(rr[0]),__uint_as_float(rr[1])); } \
      resc=false; \
      if(__builtin_expect(__any(rm>(float)THRL),0)){ const float dl=__builtin_fmaxf(rm,0.f); mhat+=dl; \
        _Pragma("unroll") for(int r=0;r<16;++r){C0[r]-=dl;C1[r]-=dl;} \
        _Pragma("unroll") for(int r=0;r<16;++r)negm[r]=-mhat; asm volatile("":"+v"(negm)); \
        const float f=__builtin_amdgcn_exp2f(-dl); l_reg*=f; if(hi==0)wsf[r32]=f; resc=true; } } \
    SBAR(); \
    GAPB(o[0]=__builtin_amdgcn_mfma_f32_32x32x16_bf16(PAF(0),VFR(0),o[0],0,0,0), C0,0); \
    GAPB(o[1]=__builtin_amdgcn_mfma_f32_32x32x16_bf16(PAF(0),VFR(4),o[1],0,0,0), C0,4); \
    KRD(GL,0); GAPB(o[0]=__builtin_amdgcn_mfma_f32_32x32x16_bf16(PAF(1),VFR(1),o[0],0,0,0), C0,8); \
    KRD(GL,1); GAPB(o[1]=__builtin_amdgcn_mfma_f32_32x32x16_bf16(PAF(1),VFR(5),o[1],0,0,0), C0,12); \
    KRD(GL,2); GAPB(o[0]=__builtin_amdgcn_mfma_f32_32x32x16_bf16(PAF(2),VFR(2),o[0],0,0,0), C1,0); \
    KRD(GL,3); GAPB(o[1]=__builtin_amdgcn_mfma_f32_32x32x16_bf16(PAF(2),VFR(6),o[1],0,0,0), C1,4); \
    GAPB(o[0]=__builtin_amdgcn_mfma_f32_32x32x16_bf16(PAF(3),VFR(3),o[0],0,0,0), C1,8); \
    GAPB(o[1]=__builtin_amdgcn_mfma_f32_32x32x16_bf16(PAF(3),VFR(7),o[1],0,0,0), C1,12); \
    }while(0)
  int t=1;
  for(;t+5<NT;t+=2){
    STEP(pB0,pB1,pA0,pA1,t,true,true,true);     WAIT_BAR(2); RESC(); ROT();
    STEP(pA0,pA1,pB0,pB1,t+1,true,true,true);   WAIT_BAR(2); RESC(); ROT();
  }
  #define ENDW(tt) do{ if((tt)+3<NT){WAIT_BAR(2);} else if((tt)+2<NT){WAIT_BAR(1);} else {WAIT_BAR(0);} }while(0)
  for(;t+1<NT;t+=2){
    STEP(pB0,pB1,pA0,pA1,t,(t+3<NT),(t+1<NT),(t+1<NT));       ENDW(t);   RESC(); ROT();
    STEP(pA0,pA1,pB0,pB1,t+1,(t+4<NT),(t+2<NT),(t+2<NT));     ENDW(t+1); RESC(); ROT();
  }
  STEP(pB0,pB1,pA0,pA1,NT-1,false,false,false); RESC();
  { const bool keep_=true; float sacc=pB0[0]+pB0[1]; _Pragma("unroll") for(int r=2;r<16;++r)sacc+=pB0[r]; _Pragma("unroll") for(int r=0;r<16;++r)sacc+=pB1[r]; l_reg+=sacc;
    pw0=(u32x4){PKW(pB0,0),PKW(pB0,2),PKW(pB0,4),PKW(pB0,6)};pw1=(u32x4){PKW(pB0,8),PKW(pB0,10),PKW(pB0,12),PKW(pB0,14)};pw2=(u32x4){PKW(pB1,0),PKW(pB1,2),PKW(pB1,4),PKW(pB1,6)};pw3=(u32x4){PKW(pB1,8),PKW(pB1,10),PKW(pB1,12),PKW(pB1,14)};
    SBAR(); pv(o,vb0+sl_cur,PAF(0),PAF(1),PAF(2),PAF(3)); }
  #undef PKW
  #undef PAF
  #undef VFR
  #undef PIN
  #undef MX3
  #undef GAPA
  #undef GAPB
  #undef EX
  #undef VRD
  #undef KRD
  #undef STEP
  #undef ENDW
  {auto rr=__builtin_amdgcn_permlane32_swap(__float_as_uint(l_reg),__float_as_uint(l_reg),false,false);l_reg=__uint_as_float(rr[0])+__uint_as_float(rr[1]);}
  if(hi==0)wsf[32+r32]=l_reg;asm volatile("s_waitcnt lgkmcnt(0)":::"memory");
  float rli[16];
  #pragma unroll
  for(int r=0;r<16;++r)rli[r]=__builtin_amdgcn_rcpf(wsf[32+crow(r,hi)]);
  { bf16*stg=(bf16*)(shm+LDS_OST)+wid*2048;
    int*dtab=(int*)(shm+LDS_DST)+wid*32;
    if(hi==0){ dtab[r32]=dest; if(dest>=0){ PML[2*(long)dest]=mhat; PML[2*(long)dest+1]=l_reg; } }
    #pragma unroll
    for(int r=0;r<16;++r){const int orow=crow(r,hi);
      #pragma unroll
      for(int d0=0;d0<2;++d0)stg[orow*64+d0*32+r32]=__float2bfloat16(o[d0][r]*rli[r]);}
    asm volatile("s_waitcnt lgkmcnt(0)":::"memory");
    #pragma unroll
    for(int i=0;i<4;++i){const int row=i*8+(lane>>3),ch=lane&7; const int dr=dtab[row]; const u32x4 v=*(const u32x4*)(stg+row*64+ch*8); if(dr>=0)*(u32x4*)(PO+(long)dr*64+ch*8)=v;} }
  asm volatile("s_waitcnt lgkmcnt(0)\n\ts_barrier":::"memory");
  #undef DMA_K
  #undef DMA_V
  #undef CMASK
  #undef BMASK
  #undef START
  #undef RESC
  #undef ROT
}
template<int THRL> __device__ __forceinline__ void moba_chunk4(const bf16*Qrow,bool causal,int dest,bf16*PO,float*PML,char*shm){
  int tid_=threadIdx.x; asm volatile("":"+v"(tid_)); const int tid=tid_,lane=tid&63,r32=lane&31,hi=lane>>5; const int wid=__builtin_amdgcn_readfirstlane(tid>>6);
  const unsigned lds0=(unsigned)(uintptr_t)shm;
  float*wsf=(float*)(shm+LDS_WS)+wid*64;
  const int vb0=(int)(lds0+LDS_V)+((lane>>4)&1)*32+(lane&3)*8+(4*hi+((lane&15)>>2))*64;
  const char*Kbase=shm+LDS_K; bf16x8 kf[8];
  const lds_cptr shm3=(lds_cptr)shm; const lds_cptr kp0=shm3+LDS_K+hi*1024+r32*16; const lds_cptr vp0=shm3+LDS_V+((lane>>4)&1)*32+(lane&3)*8+(4*hi+((lane&15)>>2))*64;
  constexpr int NT=4;
  bf16x8 qr[4];
  #pragma unroll
  for(int d0=0;d0<4;++d0)qr[d0]=*reinterpret_cast<const bf16x8*>(Qrow+d0*16+hi*8);
  float mhat=0.f,l_reg=0.f;f32x16 o[2];o[0]=f32x16{};o[1]=f32x16{};f32x16 negm=f32x16{};asm volatile("":"+v"(negm));
  const int qrel=wid*QBLK+r32;
  #define BMASK(P0,P1,t) do{}while(0)
  #define CMASK(P0,P1,t) do{ if(causal)cmask(P0,P1,(t),qrel,hi); }while(0)
  bool resc=false;
  #define START(P0,P1) do{ const float rm=rowmax(P0,P1); resc=false; \
    { const float dl=__builtin_fmaxf(rm,-64.f); mhat=fadd_s(mhat,dl); \
      _Pragma("unroll") for(int r=0;r<16;++r){P0[r]=fsub_s(P0[r],dl);P1[r]=fsub_s(P1[r],dl);} \
      _Pragma("unroll") for(int r=0;r<16;++r)negm[r]=-mhat; asm volatile("":"+v"(negm)); } \
    _Pragma("unroll") for(int r=0;r<16;++r)P0[r]=__builtin_amdgcn_exp2f(P0[r]); }while(0)
  #define RESC() do{ if(resc){ asm volatile("s_waitcnt lgkmcnt(0)":::"memory"); \
      _Pragma("unroll") for(int d_=0;d_<2;++d_) _Pragma("unroll") for(int r=0;r<16;++r)o[d_][r]*=wsf[crow(r,hi)]; } }while(0)
  f32x16 pA0,pA1,pB0,pB1;
  int sl_prev=0,sl_cur=0,sl_next=SLOTB;
  #define ROT() do{sl_prev=sl_cur;sl_cur=sl_next;sl_next=(sl_next==(NSLOT-1)*SLOTB)?0:sl_next+SLOTB;}while(0)
  qkt(pA0,pA1,Kbase,qr,negm,r32,hi);asm volatile("s_nop 15\n\ts_nop 7":"+v"(pA0),"+v"(pA1));CMASK(pA0,pA1,0);
  START(pA0,pA1);
  _Pragma("unroll") for(int r=0;r<16;++r)pA1[r]=__builtin_amdgcn_exp2f(pA1[r]);
  ROT();
  kload8(kf,kp0+sl_cur);
  s16x4 vlo[8],vhi[8]; u32x4 pw0,pw1,pw2,pw3;
  #define PKW(P,B) (keep_?cvtpk_s(P[B],P[B+1]):0u)
  #define PAF(k) __builtin_bit_cast(bf16x8,pw##k)
  #define VFR(i) (bf16x8){vlo[i][0],vlo[i][1],vlo[i][2],vlo[i][3],vhi[i][0],vhi[i][1],vhi[i][2],vhi[i][3]}
  #define PIN(x) asm volatile("":"+v"(x))
  #define MX3(a,b,c) __builtin_fmaxf(__builtin_fmaxf((a),(b)),(c))
  #define GAPA(MF,A0,A1,A2,A3,W0,W1,PW) do{ MF; sacc+=A0; sacc+=A1; sacc+=A2; sacc+=A3; PIN(sacc); W0; W1; PIN(PW); SBAR(); }while(0)
  #define EX(v) __builtin_amdgcn_exp2f(v)
  #define GAPB(MF,X,B) do{ MF; X[B]=EX(X[B]); X[B+1]=EX(X[B+1]); X[B+2]=EX(X[B+2]); X[B+3]=EX(X[B+3]); PIN(X); SBAR(); }while(0)
  #define VRD(i) do{ vlo[i]=vtr(vp_+(((i)>>2)*4096+((i)&3)*1024)); vhi[i]=vtr(vp_+(((i)>>2)*4096+((i)&3)*1024+512)); }while(0)
  #define KRD(G,j) do{ if(G){ kload2(kf,kp0+sl_next,j); SBAR(); } }while(0)
  #define STEP(C0,C1,P0,P1,t,GK,GV,GL) do{ SBAR(); \
    const bool keep_=true; \
    const lds_cptr vp_=vp0+sl_prev; \
    VRD(0); SBAR(); float sacc=(P0[0]+P0[1]); \
    GAPA(C0=__builtin_amdgcn_mfma_f32_32x32x16_bf16(kf[0],qr[0],negm,0,0,0), P0[2],P0[3],P0[4],P0[5],     pw0[0]=PKW(P0,0), pw0[1]=PKW(P0,2), pw0); \
    VRD(4); SBAR(); GAPA(C1=__builtin_amdgcn_mfma_f32_32x32x16_bf16(kf[1],qr[0],negm,0,0,0), P0[6],P0[7],P0[8],P0[9],     pw0[2]=PKW(P0,4), pw0[3]=PKW(P0,6), pw0); \
    VRD(1); SBAR(); GAPA(C0=__builtin_amdgcn_mfma_f32_32x32x16_bf16(kf[2],qr[1],C0,0,0,0),   P0[10],P0[11],P0[12],P0[13], pw1[0]=PKW(P0,8), pw1[1]=PKW(P0,10), pw1); \
    VRD(5); SBAR(); GAPA(C1=__builtin_amdgcn_mfma_f32_32x32x16_bf16(kf[3],qr[1],C1,0,0,0),   P0[14],P0[15],P1[0],P1[1],   pw1[2]=PKW(P0,12),pw1[3]=PKW(P0,14), pw1); \
    VRD(2); SBAR(); GAPA(C0=__builtin_amdgcn_mfma_f32_32x32x16_bf16(kf[4],qr[2],C0,0,0,0),   P1[2],P1[3],P1[4],P1[5],     pw2[0]=PKW(P1,0), pw2[1]=PKW(P1,2), pw2); \
    VRD(6); SBAR(); GAPA(C1=__builtin_amdgcn_mfma_f32_32x32x16_bf16(kf[5],qr[2],C1,0,0,0),   P1[6],P1[7],P1[8],P1[9],     pw2[2]=PKW(P1,4), pw2[3]=PKW(P1,6), pw2); \
    VRD(3); SBAR(); GAPA(C0=__builtin_amdgcn_mfma_f32_32x32x16_bf16(kf[6],qr[3],C0,0,0,0),   P1[10],P1[11],P1[12],P1[13], pw3[0]=PKW(P1,8), pw3[1]=PKW(P1,10), pw3); \
    VRD(7); SBAR(); GAPA(C1=__builtin_amdgcn_mfma_f32_32x32x16_bf16(kf[7],qr[3],C1,0,0,0),   P1[14],P1[15],0.f,0.f,       pw3[2]=PKW(P1,12),pw3[3]=PKW(P1,14), pw3); \
    l_reg+=keep_?sacc:0.f; \
    CMASK(C0,C1,t); \
    { float a=MX3(C0[0],C0[1],C1[0]),b=MX3(C0[2],C0[3],C1[1]); a=MX3(a,C1[2],C1[3]); \
      _Pragma("unroll") for(int r=4;r<16;r+=4){a=MX3(a,C0[r],C0[r+1]);b=MX3(b,C0[r+2],C0[r+3]);a=MX3(a,C1[r],C1[r+1]);b=MX3(b,C1[r+2],C1[r+3]);} \
      float rm=__builtin_fmaxf(a,b); { auto rr=__builtin_amdgcn_permlane32_swap(__float_as_uint(rm),__float_as_uint(rm),false,false); rm=__builtin_fmaxf(__uint_as_float(rr[0]),__uint_as_float(rr[1])); } \
      resc=false; \
      if(__builtin_expect(__any(rm>(float)THRL),0)){ const float dl=__builtin_fmaxf(rm,0.f); mhat+=dl; \
        _Pragma("unroll") for(int r=0;r<16;++r){C0[r]-=dl;C1[r]-=dl;} \
        _Pragma("unroll") for(int r=0;r<16;++r)negm[r]=-mhat; asm volatile("":"+v"(negm)); \
        const float f=__builtin_amdgcn_exp2f(-dl); l_reg*=f; if(hi==0)wsf[r32]=f; resc=true; } } \
    SBAR(); \
    GAPB(o[0]=__builtin_amdgcn_mfma_f32_32x32x16_bf16(PAF(0),VFR(0),o[0],0,0,0), C0,0); \
    GAPB(o[1]=__builtin_amdgcn_mfma_f32_32x32x16_bf16(PAF(0),VFR(4),o[1],0,0,0), C0,4); \
    KRD(GL,0); GAPB(o[0]=__builtin_amdgcn_mfma_f32_32x32x16_bf16(PAF(1),VFR(1),o[0],0,0,0), C0,8); \
    KRD(GL,1); GAPB(o[1]=__builtin_amdgcn_mfma_f32_32x32x16_bf16(PAF(1),VFR(5),o[1],0,0,0), C0,12); \
    KRD(GL,2); GAPB(o[0]=__builtin_amdgcn_mfma_f32_32x32x16_bf16(PAF(2),VFR(2),o[0],0,0,0), C1,0); \
    KRD(GL,3); GAPB(o[1]=__builtin_amdgcn_mfma_f32_32x32x16_bf16(PAF(2),VFR(6),o[1],0,0,0), C1,4); \
    GAPB(o[0]=__builtin_amdgcn_mfma_f32_32x32x16_bf16(PAF(3),VFR(3),o[0],0,0,0), C1,8); \
    GAPB(o[1]=__builtin_amdgcn_mfma_f32_32x32x16_bf16(PAF(3),VFR(7),o[1],0,0,0), C1,12); \
    }while(0)
  int t=1;
  for(;t+5<NT;t+=2){
    STEP(pB0,pB1,pA0,pA1,t,true,true,true);      RESC(); ROT();
    STEP(pA0,pA1,pB0,pB1,t+1,true,true,true);    RESC(); ROT();
  }
  #define ENDW(tt) do{ if((tt)+3<NT){} else if((tt)+2<NT){} else {} }while(0)
  for(;t+1<NT;t+=2){
    STEP(pB0,pB1,pA0,pA1,t,(t+3<NT),(t+1<NT),(t+1<NT));       ENDW(t);   RESC(); ROT();
    STEP(pA0,pA1,pB0,pB1,t+1,(t+4<NT),(t+2<NT),(t+2<NT));     ENDW(t+1); RESC(); ROT();
  }
  STEP(pB0,pB1,pA0,pA1,NT-1,false,false,false); RESC();
  { const bool keep_=true; float sacc=pB0[0]+pB0[1]; _Pragma("unroll") for(int r=2;r<16;++r)sacc+=pB0[r]; _Pragma("unroll") for(int r=0;r<16;++r)sacc+=pB1[r]; l_reg+=sacc;
    pw0=(u32x4){PKW(pB0,0),PKW(pB0,2),PKW(pB0,4),PKW(pB0,6)};pw1=(u32x4){PKW(pB0,8),PKW(pB0,10),PKW(pB0,12),PKW(pB0,14)};pw2=(u32x4){PKW(pB1,0),PKW(pB1,2),PKW(pB1,4),PKW(pB1,6)};pw3=(u32x4){PKW(pB1,8),PKW(pB1,10),PKW(pB1,12),PKW(pB1,14)};
    SBAR(); pv(o,vb0+sl_cur,PAF(0),PAF(1),PAF(2),PAF(3)); }
  #undef PKW
  #undef PAF
  #undef VFR
  #undef PIN
  #undef MX3
  #undef GAPA
  #undef GAPB
  #undef EX
  #undef VRD
  #undef KRD
  #undef STEP
  #undef ENDW
  {auto rr=__builtin_amdgcn_permlane32_swap(__float_as_uint(l_reg),__float_as_uint(l_reg),false,false);l_reg=__uint_as_float(rr[0])+__uint_as_float(rr[1]);}
  if(hi==0)wsf[32+r32]=l_reg;asm volatile("s_waitcnt lgkmcnt(0)":::"memory");
  float rli[16];
  #pragma unroll
  for(int r=0;r<16;++r)rli[r]=__builtin_amdgcn_rcpf(wsf[32+crow(r,hi)]);
  { bf16*stg=(bf16*)(shm+LDS_OST)+wid*2048;
    int*dtab=(int*)(shm+LDS_DST)+wid*32;
    if(hi==0){ dtab[r32]=dest; if(dest>=0){ PML[2*(long)dest]=mhat; PML[2*(long)dest+1]=l_reg; } }
    #pragma unroll
    for(int r=0;r<16;++r){const int orow=crow(r,hi);
      #pragma unroll
      for(int d0=0;d0<2;++d0)stg[orow*64+d0*32+r32]=__float2bfloat16(o[d0][r]*rli[r]);}
    asm volatile("s_waitcnt lgkmcnt(0)":::"memory");
    #pragma unroll
    for(int i=0;i<4;++i){const int row=i*8+(lane>>3),ch=lane&7; const int dr=dtab[row]; const u32x4 v=*(const u32x4*)(stg+row*64+ch*8); if(dr>=0)*(u32x4*)(PO+(long)dr*64+ch*8)=v;} }
  asm volatile("s_waitcnt lgkmcnt(0)":::"memory");
  #undef CMASK
  #undef BMASK
  #undef START
  #undef RESC
  #undef ROT
}

__device__ __forceinline__ void moba_load_kv(const bf16*Kh,const bf16*Vh,char*shm){
  int tid_=threadIdx.x; asm volatile("":"+v"(tid_)); const int lane=tid_&63; const int wid=__builtin_amdgcn_readfirstlane(tid_>>6);
  const unsigned lds0=(unsigned)(uintptr_t)shm;
  const bf16*ksrc=Kh+(long)lane*DM+wid*8;
  const bf16*vsrc=Vh+(long)(16*(wid&3)+(lane>>2))*DM+(wid>>2)*32+(lane&3)*8;
  const unsigned kdst=lds0+LDS_K+wid*1024, vdst=lds0+LDS_V+wid*1024;
  #pragma unroll
  for(int t=0;t<4;++t){ glds16(ksrc+(long)t*KVBLK*DM,(unsigned)__builtin_amdgcn_readfirstlane(kdst+t*SLOTB)); glds16(vsrc+(long)t*KVBLK*DM,(unsigned)__builtin_amdgcn_readfirstlane(vdst+t*SLOTB)); }
  asm volatile("s_waitcnt vmcnt(0)":::"memory");
}
constexpr int ATTN_LDS_BYTES=LDS_BYTES;
struct AttnTensors { const bf16* Q; const bf16* K; const bf16* V; bf16* O; const float* KM; };
struct AttnUnit { int bh; int qb; };
struct StaticOrder {
  int vcu;
  __device__ __forceinline__ explicit StaticOrder(int grid,int block):vcu((block%8)*(grid/8)+block/8){}
  __device__ __forceinline__ bool next(int i,AttnUnit&u)const{ if(i>=4)return false; const int s=vcu&7; u.bh=vcu>>3; u.qb=(i==0)?s:(i==1)?15-s:(i==2)?16+s:31-s; return true; }
  __device__ __forceinline__ void a_ready(const AttnUnit&)const{}
  __device__ __forceinline__ void done(const AttnUnit&)const{}
};
template<class Sched,int THRL=8> __device__ __forceinline__ void attn_phase(char*lds,const AttnTensors&T,const Sched&S){
  AttnUnit u; int lastbh=-1;
  for(int i=0;S.next(i,u);++i){
    if(u.bh!=lastbh){ __syncthreads(); float*km=(float*)(lds+LDS_KM); int tx_=threadIdx.x; asm volatile("":"+v"(tx_)); for(int k=tx_;k<32*64;k+=512)km[k]=T.KM[(long)u.bh*32*64+k]+T.KM[(long)(BATCH*NHEAD+u.bh)*32*64+k]; asm volatile("s_waitcnt vmcnt(0) lgkmcnt(0)":::"memory"); __syncthreads(); lastbh=u.bh; }
    attn_unit<THRL>(u.bh/NHEAD,u.bh%NHEAD,u.qb,T.Q,T.K,T.V,T.O,lds); }
}
#undef SBAR
#undef WAIT_BAR
}

#define XB_TMO      128
#define XB_XCNT(j)  (256  + 64 * (j))
#define XB_XSUB(j)  (1280 + 64 * (j))
#define XB_XGEN(j)  (2304 + 64 * (j))
#define XB_TOP      3328
#define XB_TOPGEN   3392
#define XCD_BAR_WORDS 3456
#define XB_SPIN_CAP (1u << 20)
__device__ __forceinline__ unsigned xb_ld(unsigned* p)              { return __hip_atomic_load(p, __ATOMIC_RELAXED, __HIP_MEMORY_SCOPE_AGENT); }
__device__ __forceinline__ unsigned xb_add(unsigned* p, unsigned v) { return __hip_atomic_fetch_add(p, v, __ATOMIC_RELAXED, __HIP_MEMORY_SCOPE_AGENT); }
__device__ __forceinline__ unsigned xb_xcc_id() { return (unsigned)__builtin_amdgcn_s_getreg((3 << 11) | 20) & 0xFu; }
#define XB_SPIN(cond, bar) do { unsigned _sp = 0; while (cond) { __builtin_amdgcn_s_sleep(1); \
    if ((++_sp & 255u) == 0u) { if (xb_ld(&(bar)[XB_TMO])) break; if (_sp > XB_SPIN_CAP) { atomicAdd(&(bar)[XB_TMO], 1u); break; } } } } while (0)
struct XcdBarrier { unsigned* bar; unsigned x; volatile LAS unsigned* st; };
__device__ __forceinline__ XcdBarrier xcd_barrier_post(unsigned* bar, volatile LAS unsigned* st) {
    XcdBarrier b; b.bar = bar; b.x = xb_xcc_id(); b.st = st;
    if (threadIdx.x == 0) (void)xb_add(&bar[XB_XCNT(b.x)], 1u);
    return b;
}
__device__ __forceinline__ void xcd_barrier_complete(unsigned* bar, unsigned x, unsigned& nloc, unsigned& nx) {
    const unsigned G = gridDim.x * gridDim.y * gridDim.z;
    unsigned sum, cnt, mine, sp = 0u;
    for (;;) {
        sum = 0u; cnt = 0u; mine = 0u;
#pragma unroll
        for (unsigned j = 0; j < 16; ++j) { const unsigned c = xb_ld(&bar[XB_XCNT(j)]); sum += c; cnt += (c > 0u) ? 1u : 0u; mine = (j == x) ? c : mine; }
        if (sum == G) break;
        __builtin_amdgcn_s_sleep(1);
        if ((++sp & 255u) == 0u) { if (xb_ld(&bar[XB_TMO])) break; if (sp > XB_SPIN_CAP) { atomicAdd(&bar[XB_TMO], 1u); break; } }
    }
    nloc = mine > 0u ? mine : 1u; nx = cnt > 0u ? cnt : 1u;
}
__device__ __forceinline__ void xcd_barrier(const XcdBarrier& b) {
    asm volatile("s_waitcnt vmcnt(0)" ::: "memory");
    __syncthreads();
    if (threadIdx.x == 0) {
        unsigned* bar = b.bar;
        __builtin_amdgcn_s_waitcnt(0);
        unsigned nloc = b.st[0], nx = b.st[1];
        if (nloc == 0u) { xcd_barrier_complete(bar, b.x, nloc, nx); b.st[0] = nloc; b.st[1] = nx; }
        const unsigned old = xb_add(&bar[XB_XSUB(b.x)], 1u);
        const unsigned gen = old / nloc;
        if (old + 1u == (gen + 1u) * nloc) {
            __builtin_amdgcn_fence(__ATOMIC_RELEASE, "agent");
            asm volatile("s_waitcnt vmcnt(0)" ::: "memory");
            const unsigned og = xb_add(&bar[XB_TOP], 1u);
            const unsigned tg = og / nx;
            if (og + 1u == (tg + 1u) * nx) xb_add(&bar[XB_TOPGEN], 1u);
            else XB_SPIN(xb_ld(&bar[XB_TOPGEN]) == tg, bar);
            __builtin_amdgcn_fence(__ATOMIC_ACQUIRE, "agent");
            xb_add(&bar[XB_XGEN(b.x)], 1u);
            asm volatile("s_waitcnt vmcnt(0)" ::: "memory");
        } else {
            XB_SPIN(xb_ld(&bar[XB_XGEN(b.x)]) == gen, bar);
            __builtin_amdgcn_fence(__ATOMIC_ACQUIRE, "agent");
            asm volatile("s_waitcnt vmcnt(0)" ::: "memory");
        }
    }
    __syncthreads();
}

struct Args { const float* in[28]; float* out; unsigned char* ws; int ph_lo, ph_hi; };
enum { I_X = 0, I_MEM, I_GMIX, I_WIN, I_ARE, I_AIM, I_LOGDT, I_BRE, I_BIM, I_CRE, I_CIM, I_DSKIP, I_WGLU, I_WPA, I_WOUT, I_GXATTN, I_GMEM, I_WXQ, I_WXKV, I_WXO,
       I_GMOE, I_WROUTER, I_BROUTER, I_WGU, I_BGU, I_WDN, I_BDN, I_GFINAL };

struct TrDesc { const float* W; const float* gain; bf16_t* WT; int K, N, map, item; int fp8 = 0; };
__device__ __forceinline__ void tr_load(const TrDesc& d, f32x4 (&v)[16], float (&g)[16], int lane) {
    const int nblk = d.N / 64, kb = d.item / nblk, nb = d.item % nblk, k0 = 64 * kb, n0 = 64 * nb, q = lane & 15, kr = lane >> 4;
    const float* src = d.W + (size_t)(k0 + kr) * d.N + n0 + 4 * q;
#pragma unroll
    for (int j = 0; j < 16; ++j) v[j] = *(const f32x4*)(src + (size_t)(4 * j) * d.N);
#pragma unroll
    for (int j = 0; j < 16; ++j) g[j] = d.gain ? d.gain[k0 + kr + 4 * j] : 1.0f;
}
__device__ __forceinline__ void tr_finish(const TrDesc& d, const f32x4 (&v)[16], const float (&g)[16], LAS float* scr, int lane) {
    const int nblk = d.N / 64, kb = d.item / nblk, nb = d.item % nblk, k0 = 64 * kb, n0 = 64 * nb, q = lane & 15, kr = lane >> 4;
#pragma unroll
    for (int j = 0; j < 16; ++j) { const int kk = kr + 4 * j; *(LAS f32x4*)(scr + kk * 64 + 4 * (q ^ ((kk >> 3) & 7))) = v[j] * g[j]; }
    asm volatile("s_waitcnt lgkmcnt(0)" ::: "memory");
    const int c = lane & 7, nq = lane >> 3;
    const int nr0 = d.map ? (256 * ((n0 % 1024) / 128) + 128 * (n0 / 1024) + (n0 % 128)) : n0;
#pragma unroll
    for (int jj = 0; jj < 8; ++jj) { const int n = 8 * jj + nq; const LAS float* sp = scr + (8 * c) * 64 + (n ^ (4 * c));
        if (d.fp8) { const float sc = (float)(1 << FP8_WSHIFT); int w0 = 0, w1 = 0;
            w0 = __builtin_amdgcn_cvt_pk_fp8_f32(sp[0 * 64] * sc, sp[1 * 64] * sc, w0, false); w0 = __builtin_amdgcn_cvt_pk_fp8_f32(sp[2 * 64] * sc, sp[3 * 64] * sc, w0, true);
            w1 = __builtin_amdgcn_cvt_pk_fp8_f32(sp[4 * 64] * sc, sp[5 * 64] * sc, w1, false); w1 = __builtin_amdgcn_cvt_pk_fp8_f32(sp[6 * 64] * sc, sp[7 * 64] * sc, w1, true);
            *(u32x2*)((unsigned char*)d.WT + (size_t)(nr0 + n) * d.K + k0 + 8 * c) = (u32x2){(unsigned)w0, (unsigned)w1}; }
        else { u32x4 o; o.x = pk2(sp[0 * 64], sp[1 * 64]); o.y = pk2(sp[2 * 64], sp[3 * 64]); o.z = pk2(sp[4 * 64], sp[5 * 64]); o.w = pk2(sp[6 * 64], sp[7 * 64]);
            *(u32x4*)(d.WT + (size_t)(nr0 + n) * d.K + k0 + 8 * c) = o; } }
    asm volatile("s_waitcnt lgkmcnt(0)" ::: "memory");
}
template <int MODE>
__device__ __forceinline__ float rms_row_to_bf16(const float* xrow, const float* gain, bf16_t* orow, int lane) {
    const f32x4* xr = (const f32x4*)xrow + lane;
    f32x4 v[4]; float s = 0.f;
#pragma unroll
    for (int j = 0; j < 4; ++j) { v[j] = xr[64 * j]; s += (v[j][0] * v[j][0] + v[j][1] * v[j][1]) + (v[j][2] * v[j][2] + v[j][3] * v[j][3]); }
    const float rstd = 1.0f / sqrtf(wave_sum(s) * (1.0f / DM) + RMS_EPS);
    u32x2* o8 = (u32x2*)orow + lane;
#pragma unroll
    for (int j = 0; j < 4; ++j) { f32x4 w = v[j];
        if (MODE == 1) { const f32x4 g = ((const f32x4*)gain)[lane + 64 * j]; w = w * rstd * g; }
        u32x2 o; o.x = pk2(w[0], w[1]); o.y = pk2(w[2], w[3]); o8[64 * j] = o; }
    return rstd;
}

struct Frame {
    LAS unsigned char* lds; int tid, lane, wave, G, bid;
    const float* in[28]; float* out; unsigned char* ws; unsigned* ctl;
};
#define WSP(type, off) ((type*)(F.ws + (off)))

__device__ __forceinline__ TrDesc tr_decode(Frame& F, int it) {
    constexpr int I_IN = (DM / 64) * (INW / 64), I_GLU = (SW / 64) * (2 * DM / 64), I_PA = (AW / 64) * (DM / 64), I_OUT = (DM / 64) * (DM / 64), I_XQ = (DM / 64) * (XW / 64),
                  I_XKV = (DM / 64) * (2 * XW / 64), I_XO = (XW / 64) * (DM / 64), I_GU1 = (DM / 64) * (2 * DFF / 64), I_DN1 = (DFF / 64) * (DM / 64);
    int r = it;
    if (r < I_IN) return TrDesc{F.in[I_WIN], F.in[I_GMIX], WSP(bf16_t, WS_WIN), DM, INW, 0, r}; r -= I_IN;
    if (r < I_GLU) return TrDesc{F.in[I_WGLU], nullptr, WSP(bf16_t, WS_WGLU), SW, 2 * DM, 1, r}; r -= I_GLU;
    if (r < I_PA) return TrDesc{F.in[I_WPA], nullptr, WSP(bf16_t, WS_WPA), AW, DM, 0, r}; r -= I_PA;
    if (r < I_OUT) return TrDesc{F.in[I_WOUT], nullptr, WSP(bf16_t, WS_WOUT), DM, DM, 0, r}; r -= I_OUT;
    if (r < I_XQ) return TrDesc{F.in[I_WXQ], F.in[I_GXATTN], WSP(bf16_t, WS_WXQ), DM, XW, 0, r}; r -= I_XQ;
    if (r < I_XKV) return TrDesc{F.in[I_WXKV], nullptr, WSP(bf16_t, WS_WXKV), DM, 2 * XW, 0, r}; r -= I_XKV;
    if (r < I_XO) return TrDesc{F.in[I_WXO], nullptr, WSP(bf16_t, WS_WXO), XW, DM, 0, r}; r -= I_XO;
    const int e = r / (I_GU1 + I_DN1); r -= e * (I_GU1 + I_DN1);
    if (r < I_GU1) return TrDesc{F.in[I_WGU] + (size_t)e * DM * 2 * DFF, F.in[I_GMOE], (bf16_t*)(F.ws + WS_WGU + (MOE1_FP8 ? (size_t)e * 2 * DFF * DM : (size_t)e * 2 * DFF * DM * 2)), DM, 2 * DFF, 1, r, MOE1_FP8};
    return TrDesc{F.in[I_WDN] + (size_t)e * DFF * DM, nullptr, (bf16_t*)(F.ws + WS_WDN + (MOE2_FP8 ? (size_t)e * DM * DFF : (size_t)e * DM * DFF * 2)), DFF, DM, 0, r - I_GU1, MOE2_FP8};
}
__device__ __forceinline__ void xrow_load(const float* X, int m, f32x4 (&v)[4][4], int lane) {
#pragma unroll
    for (int r = 0; r < 4; ++r)
#pragma unroll
        for (int j = 0; j < 4; ++j) v[r][j] = ((const f32x4*)(X + (size_t)(m + r) * DM))[lane + 64 * j];
}
__device__ __forceinline__ void xrow_finish(bf16_t* XBp, int m, const f32x4 (&v)[4][4], int lane) {
    float ss[4];
#pragma unroll
    for (int r = 0; r < 4; ++r) { float s = 0.f;
#pragma unroll
        for (int j = 0; j < 4; ++j) s += (v[r][j][0] * v[r][j][0] + v[r][j][1] * v[r][j][1]) + (v[r][j][2] * v[r][j][2] + v[r][j][3] * v[r][j][3]);
        ss[r] = s; }
#pragma unroll
    for (int o = 1; o < 64; o <<= 1) {
#pragma unroll
        for (int r = 0; r < 4; ++r) ss[r] += __shfl_xor(ss[r], o); }
#pragma unroll
    for (int r = 0; r < 4; ++r) { u32x2* o8 = (u32x2*)(XBp + (size_t)(m + r) * DM) + lane;
        const float rs = 1.0f / sqrtf(ss[r] * (1.0f / DM) + RMS_EPS);
#pragma unroll
        for (int j = 0; j < 4; ++j) { u32x2 o; o.x = pk2(v[r][j][0] * rs, v[r][j][1] * rs); o.y = pk2(v[r][j][2] * rs, v[r][j][3] * rs); o8[64 * j] = o; } }
}
__device__ __forceinline__ void phase_prologue(Frame& F) {
    LAS float* scr = (LAS float*)(F.lds + F.wave * 16384);
    const int gw = F.bid * 8 + F.wave, NGW = F.G * 8;
    { f32x4 va[4][4], vb[4][4]; const int step = NGW * 4, m0 = gw * 4, n = (m0 < T_) ? (T_ - m0 + step - 1) / step : 0;
      if (n > 0) { xrow_load(F.in[I_X], m0, va, F.lane); int i = 0;
          for (; i + 2 <= n; i += 2) {
              xrow_load(F.in[I_X], m0 + (i + 1) * step, vb, F.lane);
              xrow_finish(WSP(bf16_t, WS_XB), m0 + i * step, va, F.lane);
              xrow_load(F.in[I_X], m0 + min(i + 2, n - 1) * step, va, F.lane);
              xrow_finish(WSP(bf16_t, WS_XB), m0 + (i + 1) * step, vb, F.lane); }
          if (i < n) xrow_finish(WSP(bf16_t, WS_XB), m0 + i * step, va, F.lane); } }
    for (int m = gw; m < NB * MEML; m += NGW) (void)rms_row_to_bf16<1>(F.in[I_MEM] + (size_t)m * DM, F.in[I_GMEM], WSP(bf16_t, WS_MN) + (size_t)m * DM, F.lane);
    constexpr int NITEMS = (DM / 64) * (INW / 64) + (SW / 64) * (2 * DM / 64) + (AW / 64) * (DM / 64) + (DM / 64) * (DM / 64) + (DM / 64) * (XW / 64) + (DM / 64) * (2 * XW / 64) + (XW / 64) * (DM / 64)
                         + NE * ((DM / 64) * (2 * DFF / 64) + (DFF / 64) * (DM / 64));
    { f32x4 va[16], vb[16]; float ga[16], gb[16]; TrDesc da, db; const int n = (gw < NITEMS) ? (NITEMS - gw + NGW - 1) / NGW : 0;
      if (n > 0) { da = tr_decode(F, gw); tr_load(da, va, ga, F.lane); int i = 0;
          for (; i + 2 <= n; i += 2) {
              db = tr_decode(F, gw + (i + 1) * NGW); tr_load(db, vb, gb, F.lane);
              tr_finish(da, va, ga, scr, F.lane);
              da = tr_decode(F, gw + min(i + 2, n - 1) * NGW); tr_load(da, va, ga, F.lane);
              tr_finish(db, vb, gb, scr, F.lane); }
          if (i < n) tr_finish(da, va, ga, scr, F.lane); } }
}

__device__ __forceinline__ void phase_kmean(Frame& F) {
    LAS float* red = (LAS float*)F.lds;
    const bf16_t* Kb = WSP(bf16_t, WS_K);
    for (int it = F.bid; it < NB * NH * NBLK; it += F.G) {
        const int j = it % NBLK, h = (it / NBLK) % NH, b = it / (NBLK * NH);
        const int col = F.tid & 63, rg = F.tid >> 6; float s = 0.f;
        const bf16_t* p = Kb + ((size_t)(b * SEQ + j * MBLK + rg * 32)) * AW + h * HD + col;
#pragma unroll 8
        for (int r = 0; r < 32; ++r) s += bf2f(p[(size_t)r * AW]);
        red[rg * 64 + col] = s;
        __syncthreads();
        if (F.tid < 64) { float t = 0.f;
#pragma unroll
            for (int k = 0; k < 8; ++k) t += red[k * 64 + F.tid];
            WSP(float, WS_KMEAN)[(size_t)it * HD + F.tid] = t * (1.0f / MBLK); }
        __syncthreads();
    }
}

__device__ __forceinline__ void phase_moba_simple(Frame& F, bf16_t* Ob) {
    LAS unsigned* Ks = (LAS unsigned*)F.lds;
    LAS unsigned* Vs = (LAS unsigned*)(F.lds + 32768);
    LAS float* km = (LAS float*)(F.lds + 65536);
    const bf16_t *Qb = WSP(bf16_t, WS_Q), *Kb = WSP(bf16_t, WS_K), *Vb = WSP(bf16_t, WS_V);
    const int ql = F.tid >> 1, half = F.tid & 1;
    for (int it = F.bid; it < NB * NH * NBLK; it += F.G) {
        const int iblk = (NBLK - 1) - (it % NBLK), h = (it / NBLK) % NH, b = it / (NBLK * NH);
        __syncthreads();
        for (int k = F.tid; k < NBLK * HD; k += 512) km[k] = WSP(float, WS_KMEAN)[(size_t)((b * NH + h) * NBLK) * HD + k] + WSP(float, WS_KMEAN)[(size_t)((NB * NH + b * NH + h) * NBLK) * HD + k];
        float q[32];
        { const u32x4* qp = (const u32x4*)(Qb + (size_t)(b * SEQ + iblk * MBLK + ql) * AW + h * HD + half * 32);
#pragma unroll
          for (int c = 0; c < 4; ++c) { const u32x4 w = qp[c]; q[8 * c + 0] = bflo(w.x); q[8 * c + 1] = bfhi(w.x); q[8 * c + 2] = bflo(w.y); q[8 * c + 3] = bfhi(w.y); q[8 * c + 4] = bflo(w.z); q[8 * c + 5] = bfhi(w.z); q[8 * c + 6] = bflo(w.w); q[8 * c + 7] = bfhi(w.w); } }
        __syncthreads();
        float g0 = -3e38f, g1 = -3e38f, g2 = -3e38f; int s0 = -1, s1 = -1, s2 = -1;
        for (int j = 0; j < iblk; ++j) { float g = 0.f;
#pragma unroll
            for (int d = 0; d < 32; ++d) g += q[d] * km[j * HD + half * 32 + d];
            g += __shfl_xor(g, 1);
            if (g > g0) { g2 = g1; s2 = s1; g1 = g0; s1 = s0; g0 = g; s0 = j; } else if (g > g1) { g2 = g1; s2 = s1; g1 = g; s1 = j; } else if (g > g2) { g2 = g; s2 = j; } }
        float mx = -3e38f, l = 0.f, o[32];
#pragma unroll
        for (int d = 0; d < 32; ++d) o[d] = 0.f;
        for (int jb = 0; jb <= iblk; ++jb) {
            __syncthreads();
            { const size_t rowb = (size_t)(b * SEQ + jb * MBLK);
              for (int c = F.tid; c < 256 * 8; c += 512) { const int r = c >> 3, ch = c & 7;
                  *(LAS u32x4*)(Ks + r * 32 + ch * 4) = *(const u32x4*)(Kb + (rowb + r) * AW + h * HD + ch * 8);
                  *(LAS u32x4*)(Vs + r * 32 + ch * 4) = *(const u32x4*)(Vb + (rowb + r) * AW + h * HD + ch * 8); } }
            __syncthreads();
            const bool need = (jb == iblk) || jb == s0 || jb == s1 || jb == s2;
            if (need) { const int kend = (jb == iblk) ? ql : 255;
                for (int kk = 0; kk <= kend; ++kk) { float s = 0.f;
#pragma unroll
                    for (int c = 0; c < 4; ++c) { const u32x4 w = *(const LAS u32x4*)(Ks + kk * 32 + half * 16 + c * 4);
                        s += q[8 * c + 0] * bflo(w.x) + q[8 * c + 1] * bfhi(w.x) + q[8 * c + 2] * bflo(w.y) + q[8 * c + 3] * bfhi(w.y) + q[8 * c + 4] * bflo(w.z) + q[8 * c + 5] * bfhi(w.z) + q[8 * c + 6] * bflo(w.w) + q[8 * c + 7] * bfhi(w.w); }
                    s += __shfl_xor(s, 1);
                    const float mn = fmaxf(mx, s), corr = __builtin_amdgcn_exp2f(mx - mn), p = __builtin_amdgcn_exp2f(s - mn); mx = mn; l = l * corr + p;
#pragma unroll
                    for (int c = 0; c < 4; ++c) { const u32x4 w = *(const LAS u32x4*)(Vs + kk * 32 + half * 16 + c * 4);
                        o[8 * c + 0] = o[8 * c + 0] * corr + p * bflo(w.x); o[8 * c + 1] = o[8 * c + 1] * corr + p * bfhi(w.x); o[8 * c + 2] = o[8 * c + 2] * corr + p * bflo(w.y); o[8 * c + 3] = o[8 * c + 3] * corr + p * bfhi(w.y);
                        o[8 * c + 4] = o[8 * c + 4] * corr + p * bflo(w.z); o[8 * c + 5] = o[8 * c + 5] * corr + p * bfhi(w.z); o[8 * c + 6] = o[8 * c + 6] * corr + p * bflo(w.w); o[8 * c + 7] = o[8 * c + 7] * corr + p * bfhi(w.w); } } }
        }
        const float il = 1.0f / l;
        u32x4* op = (u32x4*)(Ob + (size_t)(b * SEQ + iblk * MBLK + ql) * AW + h * HD + half * 32);
#pragma unroll
        for (int c = 0; c < 4; ++c) { u32x4 w; w.x = pk2(o[8 * c + 0] * il, o[8 * c + 1] * il); w.y = pk2(o[8 * c + 2] * il, o[8 * c + 3] * il); w.z = pk2(o[8 * c + 4] * il, o[8 * c + 5] * il); w.w = pk2(o[8 * c + 6] * il, o[8 * c + 7] * il); op[c] = w; }
    }
}

__device__ __forceinline__ void phase_ssm_simple(Frame& F, bf16_t* Yb) {
    const int gw = F.bid * 8 + F.wave, NGW = F.G * 8, p = F.lane;
    const bf16_t* Ub = WSP(bf16_t, WS_U);
    for (int it = gw; it < NB * NG; it += NGW) {
        const int g = it % NG, b = it / NG;
        const float are = fminf(F.in[I_ARE][g * SP + p], -1e-4f), aim = F.in[I_AIM][g * SP + p], dt = expf(F.in[I_LOGDT][g]);
        const float mag = expf(are * dt), ang = aim * dt; const float lr = mag * cosf(ang), li = mag * sinf(ang);
        const float nr = lr - 1.0f, ni = li, den = 1.0f / (are * are + aim * aim); const float fr_ = (nr * are + ni * aim) * den, fi_ = (ni * are - nr * aim) * den;
        float bbr[16], bbi[16], cr[16], ci[16], dsk[16];
#pragma unroll
        for (int c = 0; c < 16; ++c) { const float br = F.in[I_BRE][(size_t)(g * SP + p) * SGC + c], bi = F.in[I_BIM][(size_t)(g * SP + p) * SGC + c];
            bbr[c] = fr_ * br - fi_ * bi; bbi[c] = fr_ * bi + fi_ * br;
            cr[c] = F.in[I_CRE][(size_t)(g * SGC + c) * SP + p]; ci[c] = F.in[I_CIM][(size_t)(g * SGC + c) * SP + p]; dsk[c] = F.in[I_DSKIP][g * SGC + c]; }
        float xr = 0.f, xi = 0.f;
        const int csel = ((p >> 5) & 1) * 8 + ((p >> 4) & 1) * 4 + ((p >> 3) & 1) * 2 + ((p >> 2) & 1);
        float dmine = 0.f;
#pragma unroll
        for (int c = 0; c < 16; ++c) dmine = (c == csel) ? dsk[c] : dmine;
        for (int t = 0; t < SEQ; ++t) {
            const u32x4* up = (const u32x4*)(Ub + (size_t)(b * SEQ + t) * SW + g * SGC); const u32x4 w0 = up[0], w1 = up[1];
            float u[16]; u[0] = bflo(w0.x); u[1] = bfhi(w0.x); u[2] = bflo(w0.y); u[3] = bfhi(w0.y); u[4] = bflo(w0.z); u[5] = bfhi(w0.z); u[6] = bflo(w0.w); u[7] = bfhi(w0.w);
            u[8] = bflo(w1.x); u[9] = bfhi(w1.x); u[10] = bflo(w1.y); u[11] = bfhi(w1.y); u[12] = bflo(w1.z); u[13] = bfhi(w1.z); u[14] = bflo(w1.w); u[15] = bfhi(w1.w);
            float sr = 0.f, si = 0.f;
#pragma unroll
            for (int c = 0; c < 16; ++c) { sr += bbr[c] * u[c]; si += bbi[c] * u[c]; }
            const float nxr = lr * xr - li * xi + sr, nxi = lr * xi + li * xr + si; xr = nxr; xi = nxi;
            float y[16];
#pragma unroll
            for (int c = 0; c < 16; ++c) y[c] = cr[c] * xr - ci[c] * xi;
            float w8[8], w4[4], w2[2], w1_;
            { const bool hi = (p & 32) != 0;
#pragma unroll
              for (int i = 0; i < 8; ++i) { const float keep = hi ? y[i + 8] : y[i], send = hi ? y[i] : y[i + 8]; w8[i] = keep + __shfl_xor(send, 32); } }
            { const bool hi = (p & 16) != 0;
#pragma unroll
              for (int i = 0; i < 4; ++i) { const float keep = hi ? w8[i + 4] : w8[i], send = hi ? w8[i] : w8[i + 4]; w4[i] = keep + __shfl_xor(send, 16); } }
            { const bool hi = (p & 8) != 0;
#pragma unroll
              for (int i = 0; i < 2; ++i) { const float keep = hi ? w4[i + 2] : w4[i], send = hi ? w4[i] : w4[i + 2]; w2[i] = keep + __shfl_xor(send, 8); } }
            { const bool hi = (p & 4) != 0; const float keep = hi ? w2[1] : w2[0], send = hi ? w2[0] : w2[1]; w1_ = keep + __shfl_xor(send, 4); }
            w1_ += __shfl_xor(w1_, 2); w1_ += __shfl_xor(w1_, 1);
            float umine = 0.f;
#pragma unroll
            for (int c = 0; c < 16; ++c) umine = (c == csel) ? u[c] : umine;
            if ((p & 3) == 0) Yb[(size_t)(b * SEQ + t) * SW + g * SGC + csel] = (bf16_t)f2bf(gelu_tanh(w1_ + dmine * umine));
        }
    }
}


__device__ __forceinline__ void p0_ssm_tables(Frame& F, int task) {
    const int g = task >> 3, part = task & 7;
    LAS float* pwr = (LAS float*)F.lds; LAS float* pwi = pwr + 65 * 64; LAS float* bbr = pwi + 65 * 64; LAS float* bbi = bbr + 1024; LAS float* ccr = bbi + 1024; LAS float* cci = ccr + 1024;
    const float dt = expf(F.in[I_LOGDT][g]);
    __syncthreads();
    for (int i = F.tid; i < 65 * 64; i += 512) { const int k = i >> 6, p = i & 63; const float are = fminf(F.in[I_ARE][g * SP + p], -1e-4f), aim = F.in[I_AIM][g * SP + p];
        const float mag = expf(are * dt * (float)k); double a = (double)aim * (double)dt * (double)k; a -= 6.283185307179586 * rint(a * 0.15915494309189535); const float af = (float)a;
        pwr[i] = mag * cosf(af); pwi[i] = mag * sinf(af); }
    for (int i = F.tid; i < 1024; i += 512) { const int p = i >> 4, c = i & 15; const float are = fminf(F.in[I_ARE][g * SP + p], -1e-4f), aim = F.in[I_AIM][g * SP + p];
        const float mag = expf(are * dt); double a = (double)aim * (double)dt; a -= 6.283185307179586 * rint(a * 0.15915494309189535); const float af = (float)a;
        const float lr = mag * cosf(af), li = mag * sinf(af), nr = lr - 1.0f, ni = li, den = 1.0f / (are * are + aim * aim), fr_ = (nr * are + ni * aim) * den, fi_ = (ni * are - nr * aim) * den;
        const float br = F.in[I_BRE][(size_t)(g * SP + p) * SGC + c], bi = F.in[I_BIM][(size_t)(g * SP + p) * SGC + c];
        bbr[i] = fr_ * br - fi_ * bi; bbi[i] = fr_ * bi + fi_ * br; }
    for (int i = F.tid; i < 1024; i += 512) { ccr[i] = F.in[I_CRE][(size_t)g * 1024 + i]; cci[i] = F.in[I_CIM][(size_t)g * 1024 + i]; }
    __syncthreads();
    bf16_t* WST = WSP(bf16_t, WS_WST) + (size_t)g * 128 * 1024; bf16_t* GT = WSP(bf16_t, WS_GT) + (size_t)g * 1024 * 128; bf16_t* KT = WSP(bf16_t, WS_KT) + (size_t)g * 65 * 256;
    for (int j = 0; j < 32; ++j) { const int e = part * 16384 + j * 512 + F.tid; const int pp = e >> 10, k = e & 1023, s = k >> 4, c = k & 15, p = pp & 63;
        const float mr = pwr[(63 - s) * 64 + p], mi = pwi[(63 - s) * 64 + p], br = bbr[p * 16 + c], bi = bbi[p * 16 + c];
        WST[e] = (bf16_t)f2bf(pp < 64 ? (mr * br - mi * bi) : (mr * bi + mi * br)); }
    for (int j = 0; j < 32; ++j) { const int e = part * 16384 + j * 512 + F.tid; const int sc = e >> 7, pp = e & 127, s = sc >> 4, c = sc & 15, p = pp & 63;
        const float mr = pwr[(s + 1) * 64 + p], mi = pwi[(s + 1) * 64 + p], cr = ccr[c * 64 + p], ci = cci[c * 64 + p];
        GT[e] = (bf16_t)f2bf(pp < 64 ? (cr * mr - ci * mi) : -(cr * mi + ci * mr)); }
    for (int e = part * 2080 + F.tid; e < (part + 1) * 2080; e += 512) { const int tt = e >> 8, c = (e >> 4) & 15, c2 = e & 15; float acc = 0.f;
        if (tt > 0) { const int tau = tt - 1;
            for (int p = 0; p < 64; ++p) { const float mr = pwr[tau * 64 + p], mi = pwi[tau * 64 + p], cr = ccr[c * 64 + p], ci = cci[c * 64 + p]; const float zr = cr * mr - ci * mi, zi = cr * mi + ci * mr; acc += zr * bbr[p * 16 + c2] - zi * bbi[p * 16 + c2]; } }
        KT[e] = (bf16_t)f2bf(acc); }
    if (part == 0 && F.tid < 64) { WSP(f32x2, WS_LAML)[g * 64 + F.tid] = (f32x2){pwr[64 * 64 + F.tid], pwi[64 * 64 + F.tid]}; }
    __syncthreads();
}
__device__ __forceinline__ void ssm_state_item(Frame& F, int b, int g, int h) {
    const int w = F.wave, row = F.lane & 15, kg = F.lane >> 4;
    f32x4 acc[4];
#pragma unroll
    for (int c = 0; c < 4; ++c) acc[c] = (f32x4){0.f, 0.f, 0.f, 0.f};
    const bf16_t* Ub = WSP(bf16_t, WS_U) + ((size_t)b * SEQ + (size_t)(16 * w + row) * 64 + (kg >> 1)) * SW + g * SGC + 8 * (kg & 1);
    const bf16_t* Wb = WSP(bf16_t, WS_WST) + ((size_t)g * 128 + 32 * h + row) * 1024 + 8 * kg;
#pragma unroll 4
    for (int ks = 0; ks < 32; ++ks) {
        const bf16x8 a = *(const bf16x8*)(Ub + ((size_t)(2 * ks)) * SW);
        bf16x8 bq[4];
#pragma unroll
        for (int nt = 0; nt < 4; ++nt) bq[nt] = *(const bf16x8*)(Wb + (size_t)((nt & 1) * 16 + (nt >> 1) * 64) * 1024 + 32 * ks);
#pragma unroll
        for (int nt = 0; nt < 4; ++nt) acc[nt] = __builtin_amdgcn_mfma_f32_16x16x32_bf16(a, bq[nt], acc[nt], 0, 0, 0);
    }
    LAS float* X = (LAS float*)F.lds;
    __syncthreads();
#pragma unroll
    for (int nt = 0; nt < 4; ++nt)
#pragma unroll
        for (int r = 0; r < 4; ++r) X[(16 * w + 4 * kg + r) * 64 + (nt >> 1) * 32 + (nt & 1) * 16 + row] = acc[nt][r];
    __syncthreads();
    if (w == 0 && F.lane < 32) { const int p = 32 * h + F.lane; const f32x2 lam = WSP(f32x2, WS_LAML)[g * 64 + p]; float sr = 0.f, si = 0.f;
        bf16_t* SS = WSP(bf16_t, WS_SST) + ((size_t)(b * NG + g) * 128) * 128;
#pragma unroll 4
        for (int n = 0; n < 128; ++n) { SS[n * 128 + p] = (bf16_t)f2bf(sr); SS[n * 128 + 64 + p] = (bf16_t)f2bf(si);
            const float xr = X[n * 64 + F.lane], xi = X[n * 64 + 32 + F.lane]; const float nsr = lam.x * sr - lam.y * si + xr, nsi = lam.x * si + lam.y * sr + xi; sr = nsr; si = nsi; } }
    __syncthreads();
}
constexpr int SO_USTR = 2064, SO_KT = 32 * SO_USTR, SO_SS = SO_KT + 65 * 512, SO_SSTR = 272;
__device__ __forceinline__ void ssm_out_item(Frame& F, int b, int g, int rr) {
    LAS unsigned char* L = F.lds;
    const int w = F.wave, lane = F.lane, r32 = lane & 31, hi = lane >> 5, sp = r32 >> 4, cch = r32 & 15;
    __syncthreads();
    { const bf16_t* Ug = WSP(bf16_t, WS_U) + ((size_t)b * SEQ + (size_t)rr * 2048) * SW + g * SGC;
#pragma unroll
      for (int j = 0; j < 8; ++j) { const int c = F.tid + 512 * j, r = c >> 1, half = c & 1; *(LAS u32x4*)(L + (r >> 6) * SO_USTR + (r & 63) * 32 + half * 16) = *(const u32x4*)(Ug + (size_t)r * SW + half * 8); }
      const u32x4* Kg = (const u32x4*)(WSP(bf16_t, WS_KT) + (size_t)g * 65 * 256);
      for (int c = F.tid; c < 2080; c += 512) *(LAS u32x4*)(L + SO_KT + c * 16) = Kg[c];
      { const int c = F.tid, ch = c >> 4, pc = c & 15; *(LAS u32x4*)(L + SO_SS + ch * SO_SSTR + pc * 16) = *(const u32x4*)(WSP(bf16_t, WS_SST) + ((size_t)((b * NG + g) * 128 + rr * 32 + ch)) * 128 + pc * 8); } }
    const bf16_t* Gg = WSP(bf16_t, WS_GT) + ((size_t)g * 1024 + (2 * w + sp) * 16 + cch) * 128 + 8 * hi;
    bf16x8 gb[2][8];
#pragma unroll
    for (int k2 = 0; k2 < 8; ++k2) gb[0][k2] = *(const bf16x8*)(Gg + 16 * k2);
    __syncthreads();
    f32x16 acc[4];
#pragma unroll
    for (int a = 0; a < 4; ++a)
#pragma unroll
        for (int r = 0; r < 16; ++r) acc[a][r] = 0.f;
    const LAS unsigned char* Ua = L + r32 * SO_USTR + hi * 16;
    const LAS unsigned char* Kb_ = L + SO_KT + (2 * w + sp + 1) * 512 + cch * 32 + hi * 16;
#define SO_SEG(A0, LO, HI) for (int s1 = (LO); s1 < (HI); ++s1) { const bf16x8 av = *(const LAS bf16x8*)(Ua + s1 * 32); \
        _Pragma("unroll") for (int a = (A0); a < 4; ++a) { const bf16x8 bv = *(const LAS bf16x8*)(Kb_ + a * 8192 - s1 * 512); acc[a] = __builtin_amdgcn_mfma_f32_32x32x16_bf16(av, bv, acc[a], 0, 0, 0); } }
    SO_SEG(0, 0, 2 * w + 2)
    SO_SEG(1, 2 * w + 2, 2 * w + 18)
    SO_SEG(2, 2 * w + 18, 2 * w + 34)
    SO_SEG(3, 2 * w + 34, 2 * w + 50)
#undef SO_SEG
    bf16x8 sa[8];
#pragma unroll
    for (int k2 = 0; k2 < 8; ++k2) sa[k2] = *(const LAS bf16x8*)(L + SO_SS + r32 * SO_SSTR + k2 * 32 + hi * 16);
#pragma unroll
    for (int a = 0; a < 4; ++a) {
        if (a < 3) {
#pragma unroll
            for (int k2 = 0; k2 < 8; ++k2) gb[(a + 1) & 1][k2] = *(const bf16x8*)(Gg + (size_t)(a + 1) * (16 * 16 * 128) + 16 * k2); }
#pragma unroll
        for (int k2 = 0; k2 < 8; ++k2) acc[a] = __builtin_amdgcn_mfma_f32_32x32x16_bf16(sa[k2], gb[a & 1][k2], acc[a], 0, 0, 0);
    }
    __syncthreads();
    const float dsk = F.in[I_DSKIP][g * SGC + cch];
    { LAS unsigned char* yb = L + (4 * hi) * SO_USTR + (2 * w + sp) * 32 + cch * 2;
#pragma unroll
      for (int a = 0; a < 4; ++a)
#pragma unroll
          for (int r = 0; r < 16; ++r) { LAS unsigned short* p = (LAS unsigned short*)(yb + ((r & 3) + 8 * (r >> 2)) * SO_USTR + a * 512); const float u = bf2f(*p); *p = (unsigned short)f2bf(gelu_tanh(acc[a][r] + dsk * u)); } }
    __syncthreads();
    { bf16_t* Yg = WSP(bf16_t, WS_YB) + ((size_t)b * SEQ + (size_t)rr * 2048) * SW + g * SGC;
#pragma unroll 2
      for (int j = 0; j < 8; ++j) { const int c = F.tid + 512 * j, r = c >> 1, half = c & 1; *(u32x4*)(Yg + (size_t)r * SW + half * 8) = *(const LAS u32x4*)(L + (r >> 6) * SO_USTR + (r & 63) * 32 + half * 16); } }
}
__device__ __forceinline__ void phase_ssm_out(Frame& F) {
    for (int it = F.bid; it < NB * NG * 4; it += F.G) ssm_out_item(F, it >> 7, (it >> 2) & 31, it & 3);
    __syncthreads();
}


__device__ __forceinline__ void moba_route_item(Frame& F, int bh, int i) {
    LAS float* km = (LAS float*)F.lds;
    LAS unsigned* lc = (LAS unsigned*)(F.lds + 8192); LAS unsigned* lb = lc + 32;
    const int b = bh >> 3, h = bh & 7, ql = F.tid >> 1, half = F.tid & 1;
    __syncthreads();
    { const float* K0 = WSP(float, WS_KM2) + (size_t)bh * NBLK * HD; const float* K1 = K0 + (size_t)NB * NH * NBLK * HD;
      for (int k = F.tid; k < NBLK * HD; k += 512) km[k] = K0[k] + K1[k]; }
    if (F.tid < 32) lc[F.tid] = 0u;
    float q[32];
    { const u32x4* qp = (const u32x4*)(WSP(bf16_t, WS_Q) + (size_t)(b * SEQ + i * MBLK + ql) * AW + h * HD + half * 32);
#pragma unroll
      for (int c = 0; c < 4; ++c) { const u32x4 w = qp[c]; q[8 * c + 0] = bflo(w.x); q[8 * c + 1] = bfhi(w.x); q[8 * c + 2] = bflo(w.y); q[8 * c + 3] = bfhi(w.y); q[8 * c + 4] = bflo(w.z); q[8 * c + 5] = bfhi(w.z); q[8 * c + 6] = bflo(w.w); q[8 * c + 7] = bfhi(w.w); } }
    __syncthreads();
    float g0 = -3e38f, g1 = -3e38f, g2 = -3e38f; int s0 = -1, s1 = -1, s2 = -1;
    for (int j = 0; j < i; ++j) { float g = 0.f;
#pragma unroll
        for (int d = 0; d < 32; ++d) g += q[d] * km[j * HD + half * 32 + d];
        g += __shfl_xor(g, 1);
        if (g > g0) { g2 = g1; s2 = s1; g1 = g0; s1 = s0; g0 = g; s0 = j; } else if (g > g1) { g2 = g1; s2 = s1; g1 = g; s1 = j; } else if (g > g2) { g2 = g; s2 = j; } }
    unsigned r0 = 0u, r1 = 0u, r2 = 0u;
    if (half == 0) { if (s0 >= 0) r0 = __hip_atomic_fetch_add(&lc[s0], 1u, __ATOMIC_RELAXED, __HIP_MEMORY_SCOPE_WORKGROUP); if (s1 >= 0) r1 = __hip_atomic_fetch_add(&lc[s1], 1u, __ATOMIC_RELAXED, __HIP_MEMORY_SCOPE_WORKGROUP);
        if (s2 >= 0) r2 = __hip_atomic_fetch_add(&lc[s2], 1u, __ATOMIC_RELAXED, __HIP_MEMORY_SCOPE_WORKGROUP); }
    __syncthreads();
    if (F.tid < 32) { const unsigned n = lc[F.tid]; lb[F.tid] = n ? atomicAdd(F.ctl + CW_MCNT + bh * NBLK + F.tid, n) : 0u; }
    __syncthreads();
    if (half == 0) { unsigned short* ML = WSP(unsigned short, WS_MLIST) + (size_t)bh * NBLK * 8192; const unsigned e = (unsigned)(i * MBLK + ql) * 4u;
        f32x2* pml = WSP(f32x2, WS_PML) + ((size_t)bh * SEQ + i * MBLK + ql) * 4;
        if (s0 >= 0) ML[(size_t)s0 * 8192 + lb[s0] + r0] = (unsigned short)(e + 0u); else pml[0] = (f32x2){-1e30f, 0.f};
        if (s1 >= 0) ML[(size_t)s1 * 8192 + lb[s1] + r1] = (unsigned short)(e + 1u); else pml[1] = (f32x2){-1e30f, 0.f};
        if (s2 >= 0) ML[(size_t)s2 * 8192 + lb[s2] + r2] = (unsigned short)(e + 2u); else pml[2] = (f32x2){-1e30f, 0.f}; }
}
template <int EXPM> __device__ __forceinline__ void moba_sparse_phase(Frame& F, char* lds_generic) {
    LAS unsigned* cl = (LAS unsigned*)(F.lds + attn_body::LDS_BYTES);
    LAS unsigned* pf = cl + 128;
    const int x = F.bid & 7, slot = F.bid >> 3, nslots = F.G >> 3;
    __syncthreads();
    if (F.tid < 128) cl[F.tid] = __hip_atomic_load(F.ctl + CW_MCNT + (x + 8 * (F.tid >> 5)) * NBLK + (F.tid & 31), RLX_AGENT);
    __syncthreads();
    if (F.tid == 0) { unsigned a = 0; for (int i = 0; i < 128; ++i) { pf[i] = a; a += 1u + ((cl[i] + 255u) >> 8); } pf[128] = a; }
    __syncthreads();
    const int total = (int)pf[128]; int pos = (int)(((long)total * slot) / nslots); const int end = (int)(((long)total * (slot + 1)) / nslots);
    const attn_body::bf16* Qb = (const attn_body::bf16*)WSP(bf16_t, WS_Q); const attn_body::bf16* Kb = (const attn_body::bf16*)WSP(bf16_t, WS_K); const attn_body::bf16* Vb = (const attn_body::bf16*)WSP(bf16_t, WS_V);
    attn_body::bf16* PO = (attn_body::bf16*)WSP(bf16_t, WS_PO); float* PML = WSP(float, WS_PML);
    const int wid = F.wave;
    int L = 0;
    while (pos < end) {
        while ((int)pf[L + 1] <= pos) ++L;
        const int m = L >> 5, j = L & 31, bh = x + 8 * m, b = bh >> 3, h = bh & 7, cnt = (int)cl[L];
        const int c0 = pos - (int)pf[L], c1 = min((int)pf[L + 1], end) - (int)pf[L];
        const size_t kvrow = (size_t)b * SEQ + (size_t)j * MBLK;
        __syncthreads();
        attn_body::moba_load_kv(Kb + kvrow * AW + h * HD, Vb + kvrow * AW + h * HD, lds_generic);
        __syncthreads();
        for (int c = c0; c < c1; ++c) {
            int l_ = F.lane; asm volatile("" : "+v"(l_)); const int r32 = l_ & 31;
            int qg, dest; bool causal;
            if (c == 0) { qg = j * MBLK + wid * 32 + r32; dest = (EXPM == 1) ? -1 : (bh * SEQ + qg) * 4 + 3; causal = true; }
            else { const int base = (c - 1) * 256 + wid * 32; if (base >= cnt) continue;
                const int idx = base + r32; causal = false;
                if (EXPM == 1) { qg = j * MBLK + wid * 32 + r32; dest = -1; }
                else if (idx < cnt) { const unsigned e = WSP(unsigned short, WS_MLIST)[((size_t)bh * NBLK + j) * 8192 + idx]; qg = (int)(e >> 2); dest = (bh * SEQ + qg) * 4 + (int)(e & 3u); }
                else { qg = j * MBLK + r32; dest = -1; } }
            attn_body::moba_chunk4<8>(Qb + ((size_t)b * SEQ + qg) * AW + h * HD, causal, dest, PO, PML, lds_generic);
        }
        pos += c1 - c0;
    }
    __syncthreads();
}
__device__ __forceinline__ void moba_combine_phase(Frame& F) {
    const bf16_t* PO = WSP(bf16_t, WS_PO); const f32x2* PML = WSP(f32x2, WS_PML); bf16_t* ATT = WSP(bf16_t, WS_ATT);
    for (size_t it = (size_t)F.bid * 512 + F.tid; it < (size_t)NB * NH * SEQ * 8; it += (size_t)F.G * 512) {
        const size_t r = it >> 3; const int ch = (int)(it & 7); const int bh = (int)(r / SEQ), qg = (int)(r % SEQ), b = bh >> 3, h = bh & 7;
        const f32x2 a0 = PML[r * 4 + 0], a1 = PML[r * 4 + 1], a2 = PML[r * 4 + 2], a3 = PML[r * 4 + 3];
        const float M = fmaxf(fmaxf(a0.x, a1.x), fmaxf(a2.x, a3.x));
        const float w0 = a0.y * __builtin_amdgcn_exp2f(a0.x - M), w1 = a1.y * __builtin_amdgcn_exp2f(a1.x - M), w2 = a2.y * __builtin_amdgcn_exp2f(a2.x - M), w3 = a3.y * __builtin_amdgcn_exp2f(a3.x - M);
        const float inv = 1.0f / (w0 + w1 + w2 + w3);
        float o[8] = {0.f, 0.f, 0.f, 0.f, 0.f, 0.f, 0.f, 0.f};
#define CMB(k, wk) if (wk > 0.f) { const u32x4 v = *(const u32x4*)(PO + (r * 4 + k) * 64 + ch * 8); o[0] += wk * bflo(v.x); o[1] += wk * bfhi(v.x); o[2] += wk * bflo(v.y); o[3] += wk * bfhi(v.y); o[4] += wk * bflo(v.z); o[5] += wk * bfhi(v.z); o[6] += wk * bflo(v.w); o[7] += wk * bfhi(v.w); }
        CMB(0, w0) CMB(1, w1) CMB(2, w2) CMB(3, w3)
#undef CMB
        u32x4 w; w.x = pk2(o[0] * inv, o[1] * inv); w.y = pk2(o[2] * inv, o[3] * inv); w.z = pk2(o[4] * inv, o[5] * inv); w.w = pk2(o[6] * inv, o[7] * inv);
        *(u32x4*)(ATT + ((size_t)b * SEQ + qg) * AW + h * HD + ch * 8) = w;
    }
}

__device__ __forceinline__ void phase_xattn_simple(Frame& F, bf16_t* Ob) {
    LAS unsigned* Ks = (LAS unsigned*)F.lds;
    LAS unsigned* Vs = (LAS unsigned*)(F.lds + 65536);
    const bf16_t *Qb = WSP(bf16_t, WS_XQ), *KV = WSP(bf16_t, WS_MKV);
    const int tl = F.tid >> 2, part = F.tid & 3;
    int lastbh = -1;
    for (int it = F.bid; it < NB * XH * (SEQ / 128); it += F.G) {
        const int bh = it / (SEQ / 128), ch = it % (SEQ / 128), b = bh / XH, h = bh % XH;
        if (bh != lastbh) { __syncthreads();
            for (int c = F.tid; c < 256 * 16; c += 512) { const int r = c >> 4, cc = c & 15;
                *(LAS u32x4*)(Ks + r * 64 + cc * 4) = *(const u32x4*)(KV + (size_t)(b * MEML + r) * (2 * XW) + h * XD + cc * 8);
                *(LAS u32x4*)(Vs + r * 64 + cc * 4) = *(const u32x4*)(KV + (size_t)(b * MEML + r) * (2 * XW) + XW + h * XD + cc * 8); }
            __syncthreads(); lastbh = bh; }
        const size_t row = (size_t)b * SEQ + ch * 128 + tl;
        float q[32];
        { const u32x4* qp = (const u32x4*)(Qb + row * XW + h * XD + part * 32);
#pragma unroll
          for (int c = 0; c < 4; ++c) { const u32x4 w = qp[c]; q[8 * c + 0] = bflo(w.x); q[8 * c + 1] = bfhi(w.x); q[8 * c + 2] = bflo(w.y); q[8 * c + 3] = bfhi(w.y); q[8 * c + 4] = bflo(w.z); q[8 * c + 5] = bfhi(w.z); q[8 * c + 6] = bflo(w.w); q[8 * c + 7] = bfhi(w.w); } }
        float mx = -3e38f, l = 0.f, o[32];
#pragma unroll
        for (int d = 0; d < 32; ++d) o[d] = 0.f;
        for (int kk = 0; kk < MEML; ++kk) { float s = 0.f;
#pragma unroll
            for (int c = 0; c < 4; ++c) { const u32x4 w = *(const LAS u32x4*)(Ks + kk * 64 + part * 16 + c * 4);
                s += q[8 * c + 0] * bflo(w.x) + q[8 * c + 1] * bfhi(w.x) + q[8 * c + 2] * bflo(w.y) + q[8 * c + 3] * bfhi(w.y) + q[8 * c + 4] * bflo(w.z) + q[8 * c + 5] * bfhi(w.z) + q[8 * c + 6] * bflo(w.w) + q[8 * c + 7] * bfhi(w.w); }
            s += __shfl_xor(s, 1); s += __shfl_xor(s, 2);
            const float mn = fmaxf(mx, s), corr = __builtin_amdgcn_exp2f(mx - mn), p = __builtin_amdgcn_exp2f(s - mn); mx = mn; l = l * corr + p;
#pragma unroll
            for (int c = 0; c < 4; ++c) { const u32x4 w = *(const LAS u32x4*)(Vs + kk * 64 + part * 16 + c * 4);
                o[8 * c + 0] = o[8 * c + 0] * corr + p * bflo(w.x); o[8 * c + 1] = o[8 * c + 1] * corr + p * bfhi(w.x); o[8 * c + 2] = o[8 * c + 2] * corr + p * bflo(w.y); o[8 * c + 3] = o[8 * c + 3] * corr + p * bfhi(w.y);
                o[8 * c + 4] = o[8 * c + 4] * corr + p * bflo(w.z); o[8 * c + 5] = o[8 * c + 5] * corr + p * bfhi(w.z); o[8 * c + 6] = o[8 * c + 6] * corr + p * bflo(w.w); o[8 * c + 7] = o[8 * c + 7] * corr + p * bfhi(w.w); } }
        const float il = 1.0f / l;
        u32x4* op = (u32x4*)(Ob + row * XW + h * XD + part * 32);
#pragma unroll
        for (int c = 0; c < 4; ++c) { u32x4 w; w.x = pk2(o[8 * c + 0] * il, o[8 * c + 1] * il); w.y = pk2(o[8 * c + 2] * il, o[8 * c + 3] * il); w.z = pk2(o[8 * c + 4] * il, o[8 * c + 5] * il); w.w = pk2(o[8 * c + 6] * il, o[8 * c + 7] * il); op[c] = w; }
    }
}

__device__ __forceinline__ void phase_router(Frame& F) {
    LAS float* wt = (LAS float*)F.lds;
    for (int c = F.tid; c < NE * DM; c += 512) { const int k = c >> 5, e = c & 31; wt[e * DM + k] = F.in[I_WROUTER][c] * F.in[I_GMOE][k]; }
    __syncthreads();
    const int gw = F.bid * 8 + F.wave, NGW = F.G * 8, lane = F.lane;
    const float* H = WSP(float, WS_H);
    unsigned* cnt = F.ctl + CW_CNT;
    for (int tk = gw; tk < T_; tk += NGW) {
        const f32x4* hp = (const f32x4*)(H + (size_t)tk * DM) + lane; f32x4 hv[4]; float ss = 0.f;
#pragma unroll
        for (int j = 0; j < 4; ++j) { hv[j] = hp[64 * j]; ss += (hv[j][0] * hv[j][0] + hv[j][1] * hv[j][1]) + (hv[j][2] * hv[j][2] + hv[j][3] * hv[j][3]); }
        const float rstd = 1.0f / sqrtf(wave_sum(ss) * (1.0f / DM) + RMS_EPS);
        float mylogit = 0.f;
#pragma unroll 4
        for (int e = 0; e < NE; ++e) { float a = 0.f;
#pragma unroll
            for (int j = 0; j < 4; ++j) { const f32x4 w = *(const LAS f32x4*)(wt + e * DM + 4 * lane + 256 * j); a += (hv[j][0] * w[0] + hv[j][1] * w[1]) + (hv[j][2] * w[2] + hv[j][3] * w[3]); }
            a = wave_sum(a);
            mylogit = (lane == e) ? a : mylogit; }
        mylogit = (lane < NE) ? (mylogit * rstd + F.in[I_BROUTER][lane & 31]) : -3e38f;
        float tv[4]; int ti[4]; float cur = mylogit;
#pragma unroll
        for (int s = 0; s < 4; ++s) { float bv = cur; int bi = lane;
#pragma unroll
            for (int o = 1; o < 64; o <<= 1) { const float ov = __shfl_xor(bv, o); const int oi = __shfl_xor(bi, o); if (ov > bv || (ov == bv && oi < bi)) { bv = ov; bi = oi; } }
            tv[s] = bv; ti[s] = bi; if (lane == bi) cur = -3e38f; }
        const float e1 = __expf(tv[1] - tv[0]), e2 = __expf(tv[2] - tv[0]), e3 = __expf(tv[3] - tv[0]); const float inv = 1.0f / (1.0f + e1 + e2 + e3);
        if (lane == 0) WSP(float, WS_RSTD2)[tk] = rstd;
        if (lane < 4) { const int ex = (lane == 0) ? ti[0] : (lane == 1) ? ti[1] : (lane == 2) ? ti[2] : ti[3]; const float gv = ((lane == 0) ? 1.0f : (lane == 1) ? e1 : (lane == 2) ? e2 : e3) * inv;
            WSP(float, WS_TKG)[(size_t)tk * 4 + lane] = gv;
            const unsigned rank = atomicAdd(&cnt[ex], 1u);
            WSP(int, WS_ROWLIST)[(size_t)ex * T_ + rank] = tk * 4 + lane; }
    }
}


constexpr int XA_VSTR = 520, XA_VT = 65536;
__device__ __forceinline__ bf16x8 pack8(const f32x16& s, int o) {
    u32x4 w; w.x = pg8::cvt_pk_bf16(s[o + 0], s[o + 1]); w.y = pg8::cvt_pk_bf16(s[o + 2], s[o + 3]); w.z = pg8::cvt_pk_bf16(s[o + 4], s[o + 5]); w.w = pg8::cvt_pk_bf16(s[o + 6], s[o + 7]);
    return __builtin_bit_cast(bf16x8, w);
}
__device__ __forceinline__ void phase_xattn(Frame& F) {
    LAS unsigned char* L = F.lds;
    const bf16_t *Qb = WSP(bf16_t, WS_XQ), *KV = WSP(bf16_t, WS_MKV); bf16_t* Ob = WSP(bf16_t, WS_XO);
    const int lane = F.lane, r32 = lane & 31, hi = lane >> 5, wid = F.wave;
    const int NU = NB * XH * (SEQ / 256), UPB = (NU + F.G - 1) / F.G;
    int lastbh = -1;
    for (int u = F.bid * UPB; u < NU && u < (F.bid + 1) * UPB; ++u) {
        const int bh = u >> 5, qb = u & 31, b = bh >> 2, h = bh & 3;
        if (bh != lastbh) {
            __syncthreads();
            for (int c = F.tid; c < 256 * 16; c += 512) { const int m = c >> 4, ch = c & 15; *(LAS u32x4*)(L + m * 256 + ((ch ^ (m & 15)) << 4)) = *(const u32x4*)(KV + (size_t)(b * MEML + m) * (2 * XW) + h * XD + ch * 8); }
            { const bf16_t* VTg = WSP(bf16_t, WS_MVT) + ((size_t)b * XW + h * XD) * MEML;
              for (int c = F.tid; c < 128 * 64; c += 512) { const int d = c >> 6, pc = c & 63; *(LAS u32x2*)(L + XA_VT + d * XA_VSTR + pc * 8) = *(const u32x2*)(VTg + (size_t)d * MEML + pc * 4); } }
            __syncthreads(); lastbh = bh; }
        const size_t row = (size_t)b * SEQ + qb * 256 + wid * 32 + r32;
        bf16x8 qf[8];
#pragma unroll
        for (int kd = 0; kd < 8; ++kd) qf[kd] = *(const bf16x8*)(Qb + row * XW + h * XD + 16 * kd + 8 * hi);
        f32x16 o[4];
#pragma unroll
        for (int dt = 0; dt < 4; ++dt)
#pragma unroll
            for (int r = 0; r < 16; ++r) o[dt][r] = 0.f;
        float mrun = -1e30f, lrun = 0.f;
#pragma unroll 1
        for (int c = 0; c < 4; ++c) {
            f32x16 s0, s1;
#pragma unroll
            for (int r = 0; r < 16; ++r) { s0[r] = 0.f; s1[r] = 0.f; }
            const int kv0 = c * 64 + r32, kv1 = kv0 + 32;
#pragma unroll
            for (int kd = 0; kd < 8; ++kd) { const int ch = 2 * kd + hi;
                const bf16x8 k0 = *(const LAS bf16x8*)(L + kv0 * 256 + ((ch ^ (kv0 & 15)) << 4)), k1 = *(const LAS bf16x8*)(L + kv1 * 256 + ((ch ^ (kv1 & 15)) << 4));
                s0 = __builtin_amdgcn_mfma_f32_32x32x16_bf16(k0, qf[kd], s0, 0, 0, 0); s1 = __builtin_amdgcn_mfma_f32_32x32x16_bf16(k1, qf[kd], s1, 0, 0, 0); }
            float mx = fmaxf(s0[0], s1[0]);
#pragma unroll
            for (int r = 1; r < 16; ++r) mx = fmaxf(mx, fmaxf(s0[r], s1[r]));
            mx = fmaxf(mx, __shfl_xor(mx, 32));
            const float mn = fmaxf(mrun, mx), sc = __builtin_amdgcn_exp2f(mrun - mn); mrun = mn;
            float ls = 0.f;
#pragma unroll
            for (int r = 0; r < 16; ++r) { s0[r] = __builtin_amdgcn_exp2f(s0[r] - mn); s1[r] = __builtin_amdgcn_exp2f(s1[r] - mn); ls += s0[r] + s1[r]; }
            ls += __shfl_xor(ls, 32); lrun = lrun * sc + ls;
#pragma unroll
            for (int dt = 0; dt < 4; ++dt)
#pragma unroll
                for (int r = 0; r < 16; ++r) o[dt][r] *= sc;
            bf16x8 pf[4]; pf[0] = pack8(s0, 0); pf[1] = pack8(s0, 8); pf[2] = pack8(s1, 0); pf[3] = pack8(s1, 8);
#pragma unroll
            for (int dt = 0; dt < 4; ++dt)
#pragma unroll
                for (int ks = 0; ks < 4; ++ks) { const LAS unsigned char* vp = L + XA_VT + (dt * 32 + r32) * XA_VSTR + (c * 64 + 16 * ks + 4 * hi) * 2;
                    const u32x2 lo = *(const LAS u32x2*)vp, hh = *(const LAS u32x2*)(vp + 16); u32x4 w; w.x = lo.x; w.y = lo.y; w.z = hh.x; w.w = hh.y;
                    o[dt] = __builtin_amdgcn_mfma_f32_32x32x16_bf16(__builtin_bit_cast(bf16x8, w), pf[ks], o[dt], 0, 0, 0); }
        }
        const float il = 1.0f / lrun;
        bf16_t* op = Ob + row * XW + h * XD + 4 * hi;
#pragma unroll
        for (int dt = 0; dt < 4; ++dt)
#pragma unroll
            for (int g4 = 0; g4 < 4; ++g4) { u32x2 w; w.x = pg8::cvt_pk_bf16(o[dt][4 * g4] * il, o[dt][4 * g4 + 1] * il); w.y = pg8::cvt_pk_bf16(o[dt][4 * g4 + 2] * il, o[dt][4 * g4 + 3] * il);
                *(u32x2*)(op + dt * 32 + 8 * g4) = w; }
    }
    __syncthreads();
}

constexpr int RT_WSTR = 1028, RT_LG = NE * RT_WSTR * 4  , RT_LCNT = RT_LG + 8 * 16 * 33 * 4  , RT_LBASE = RT_LCNT + 128, RT_RS = RT_LBASE + 128  ;
__device__ __forceinline__ void phase_router_mfma(Frame& F) {
    LAS float* wt = (LAS float*)F.lds;
    __syncthreads();
    for (int c = F.tid; c < NE * DM; c += 512) { const int k = c >> 5, e = c & 31; wt[e * RT_WSTR + k] = F.in[I_WROUTER][c] * F.in[I_GMOE][k]; }
    LAS unsigned* lcnt = (LAS unsigned*)(F.lds + RT_LCNT); LAS unsigned* lbase = (LAS unsigned*)(F.lds + RT_LBASE);
    const int lane = F.lane, wid = F.wave, row = lane & 15, kq = lane >> 4;
    LAS float* lg = (LAS float*)(F.lds + RT_LG) + wid * (16 * 33); LAS float* rsl = (LAS float*)(F.lds + RT_RS) + wid * 16;
    const bf16_t* HBp = WSP(bf16_t, WS_HB); bf16_t* N2 = WSP(bf16_t, WS_N2B); unsigned* cnt = F.ctl + CW_CNT;
    for (int chunk = F.bid; chunk < T_ / 128; chunk += F.G) {
        if (F.tid < 32) lcnt[F.tid] = 0u;
        __syncthreads();
        const int tok0 = chunk * 128 + wid * 16;
        f32x4 acc0 = {0.f, 0.f, 0.f, 0.f}, acc1 = {0.f, 0.f, 0.f, 0.f}; float ss = 0.f;
        const bf16_t* hp = HBp + (size_t)(tok0 + row) * DM + 8 * kq;
        const LAS float* w0 = wt + row * RT_WSTR + 8 * kq; const LAS float* w1 = w0 + 16 * RT_WSTR;
#pragma unroll 4
        for (int i = 0; i < 32; ++i) { const u32x4 hw = *(const u32x4*)(hp + 32 * i);
            const float a[8] = {bflo(hw.x), bfhi(hw.x), bflo(hw.y), bfhi(hw.y), bflo(hw.z), bfhi(hw.z), bflo(hw.w), bfhi(hw.w)};
            const f32x4 b00 = *(const LAS f32x4*)(w0 + 32 * i), b01 = *(const LAS f32x4*)(w0 + 32 * i + 4), b10 = *(const LAS f32x4*)(w1 + 32 * i), b11 = *(const LAS f32x4*)(w1 + 32 * i + 4);
#pragma unroll
            for (int e = 0; e < 8; ++e) ss += a[e] * a[e];
#pragma unroll
            for (int e = 0; e < 4; ++e) { acc0 = __builtin_amdgcn_mfma_f32_16x16x4f32(a[e], b00[e], acc0, 0, 0, 0); acc1 = __builtin_amdgcn_mfma_f32_16x16x4f32(a[e], b10[e], acc1, 0, 0, 0); }
#pragma unroll
            for (int e = 0; e < 4; ++e) { acc0 = __builtin_amdgcn_mfma_f32_16x16x4f32(a[4 + e], b01[e], acc0, 0, 0, 0); acc1 = __builtin_amdgcn_mfma_f32_16x16x4f32(a[4 + e], b11[e], acc1, 0, 0, 0); } }
        ss += __shfl_xor(ss, 16); ss += __shfl_xor(ss, 32);
        const float rstd = 1.0f / sqrtf(ss * (1.0f / DM) + RMS_EPS);
#pragma unroll
        for (int r = 0; r < 4; ++r) { lg[(4 * kq + r) * 33 + row] = acc0[r]; lg[(4 * kq + r) * 33 + 16 + row] = acc1[r]; }
        if (lane < 16) rsl[lane] = rstd;
        asm volatile("s_waitcnt lgkmcnt(0)" ::: "memory");
#pragma unroll 4
        for (int t = 0; t < 16; ++t) { const float rs = rsl[t]; const u32x4* src = (const u32x4*)(HBp + (size_t)(tok0 + t) * DM) + lane; u32x4* dst = (u32x4*)(N2 + (size_t)(tok0 + t) * DM) + lane;
#pragma unroll
            for (int hh = 0; hh < 2; ++hh) { const u32x4 w = src[64 * hh];
                if (MOE1_FP8) { int w0 = 0, w1 = 0;
                    w0 = __builtin_amdgcn_cvt_pk_fp8_f32(bflo(w.x) * rs, bfhi(w.x) * rs, w0, false); w0 = __builtin_amdgcn_cvt_pk_fp8_f32(bflo(w.y) * rs, bfhi(w.y) * rs, w0, true);
                    w1 = __builtin_amdgcn_cvt_pk_fp8_f32(bflo(w.z) * rs, bfhi(w.z) * rs, w1, false); w1 = __builtin_amdgcn_cvt_pk_fp8_f32(bflo(w.w) * rs, bfhi(w.w) * rs, w1, true);
                    ((u32x2*)((unsigned char*)N2 + (size_t)(tok0 + t) * DM))[lane + 64 * hh] = (u32x2){(unsigned)w0, (unsigned)w1}; }
                else { u32x4 o; o.x = pk2(bflo(w.x) * rs, bfhi(w.x) * rs); o.y = pk2(bflo(w.y) * rs, bfhi(w.y) * rs); o.z = pk2(bflo(w.z) * rs, bfhi(w.z) * rs); o.w = pk2(bflo(w.w) * rs, bfhi(w.w) * rs); dst[64 * hh] = o; } } }
        int ex[4] = {0, 0, 0, 0}; unsigned lrank[4] = {0u, 0u, 0u, 0u}; const int tk = tok0 + lane;
        if (lane < 16) {
            float v[32];
#pragma unroll
            for (int e = 0; e < 32; ++e) v[e] = lg[lane * 33 + e] * rstd + F.in[I_BROUTER][e];
            float tv[4];
#pragma unroll
            for (int s = 0; s < 4; ++s) { float bv = v[0]; int bi = 0;
#pragma unroll
                for (int e = 1; e < 32; ++e) if (v[e] > bv) { bv = v[e]; bi = e; }
#pragma unroll
                for (int e = 0; e < 32; ++e) v[e] = (e == bi) ? -3e38f : v[e];
                tv[s] = bv; ex[s] = bi; }
            const float e1 = __expf(tv[1] - tv[0]), e2 = __expf(tv[2] - tv[0]), e3 = __expf(tv[3] - tv[0]); const float inv = 1.0f / (1.0f + e1 + e2 + e3);
            *(f32x4*)(WSP(float, WS_TKG) + (size_t)tk * 4) = (f32x4){inv, e1 * inv, e2 * inv, e3 * inv};
#pragma unroll
            for (int s = 0; s < 4; ++s) lrank[s] = __hip_atomic_fetch_add(&lcnt[ex[s]], 1u, __ATOMIC_RELAXED, __HIP_MEMORY_SCOPE_WORKGROUP);
        }
        __syncthreads();
        if (F.tid < 32) lbase[F.tid] = atomicAdd(&cnt[F.tid], lcnt[F.tid]);
        __syncthreads();
        if (lane < 16) {
#pragma unroll
            for (int s = 0; s < 4; ++s) WSP(int, WS_ROWLIST)[(size_t)ex[s] * T_ + lbase[ex[s]] + lrank[s]] = tk * 4 + s; }
        __syncthreads();
    }
}

struct FinRegs { u32x2 hw[2][4]; u32x2 yw[2][4][4]; };
__device__ __forceinline__ void fin_load(const bf16_t* HBf, const bf16_t* Y, int tk, FinRegs& R, int lane) {
#pragma unroll
    for (int t = 0; t < 2; ++t) {
#pragma unroll
        for (int j = 0; j < 4; ++j) { R.hw[t][j] = ((const u32x2*)(HBf + (size_t)(tk + t) * DM))[lane + 64 * j];
#pragma unroll
            for (int s = 0; s < 4; ++s) R.yw[t][s][j] = ((const u32x2*)(Y + ((size_t)(tk + t) * 4 + s) * DM))[lane + 64 * j]; } }
}
template <int FEXP> __device__ __forceinline__ void fin_finish(Frame& F, int tk, const FinRegs& R, const f32x4 (&gf)[4], int lane) {
#pragma unroll
    for (int t = 0; t < 2; ++t) { f32x4 hv[4]; float ss = 0.f;
#pragma unroll
        for (int j = 0; j < 4; ++j) { const u32x2 w = R.hw[t][j]; hv[j] = (f32x4){bflo(w.x), bfhi(w.x), bflo(w.y), bfhi(w.y)};
#pragma unroll
            for (int s = 0; s < 4; ++s) { const u32x2 y = R.yw[t][s][j]; hv[j][0] += bflo(y.x); hv[j][1] += bfhi(y.x); hv[j][2] += bflo(y.y); hv[j][3] += bfhi(y.y); }
            ss += (hv[j][0] * hv[j][0] + hv[j][1] * hv[j][1]) + (hv[j][2] * hv[j][2] + hv[j][3] * hv[j][3]); }
        float rstd = 1.0f / sqrtf(wave_sum(ss) * (1.0f / DM) + RMS_EPS);
#if DBG_STAGE
        { const float sd = __hip_atomic_load((float*)(F.ctl + CW_DBG), RLX_AGENT), sr = __hip_atomic_load((float*)(F.ctl + CW_DBG + 1), RLX_AGENT); rstd *= 1.0f + sqrtf(100.0f * sd / fmaxf(sr, 1e-30f)); }
#endif
        f32x4* op = (f32x4*)(((FEXP == 3) ? WSP(float, WS_PO) : F.out) + (size_t)(tk + t) * DM) + lane;
        if (FEXP == 1) { asm volatile("" :: "v"(hv[0][0] * rstd), "v"(hv[3][3] * rstd)); }
        else {
#pragma unroll
            for (int j = 0; j < 4; ++j) op[64 * j] = hv[j] * rstd * gf[j]; } }
}
template <int FEXP> __device__ __forceinline__ void phase_final_t(Frame& F) {
    const int gw = F.bid * 8 + F.wave, NGW = F.G * 8, lane = F.lane;
    const bf16_t* HBf = WSP(bf16_t, WS_HB); const bf16_t* Y = WSP(bf16_t, WS_Y);
    f32x4 gf[4];
#pragma unroll
    for (int j = 0; j < 4; ++j) gf[j] = ((const f32x4*)F.in[I_GFINAL])[lane + 64 * j];
    FinRegs ra, rb; const int step = NGW * 2, t0 = gw * 2, n = (t0 < T_) ? (T_ - t0 + step - 1) / step : 0;
    if (n > 0) { fin_load(HBf, Y, t0, ra, lane); int i = 0;
        for (; i + 2 <= n; i += 2) {
            fin_load(HBf, Y, t0 + (i + 1) * step, rb, lane);
            fin_finish<FEXP>(F, t0 + i * step, ra, gf, lane);
            fin_load(HBf, Y, t0 + min(i + 2, n - 1) * step, ra, lane);
            fin_finish<FEXP>(F, t0 + (i + 1) * step, rb, gf, lane); }
        if (i < n) fin_finish<FEXP>(F, t0 + i * step, ra, gf, lane); }
}
__device__ __forceinline__ void phase_final(Frame& F) { phase_final_t<0>(F); }

__device__ __forceinline__ void dbg_compare(Frame& F, const bf16_t* A, const bf16_t* R, size_t n) {
    float sd = 0.f, sr = 0.f;
    for (size_t i = (size_t)F.bid * 512 + F.tid; i < n; i += (size_t)F.G * 512) { const float a = bf2f(A[i]), r = bf2f(R[i]); sd += (a - r) * (a - r); sr += r * r; }
    sd = wave_sum(sd); sr = wave_sum(sr);
    if (F.lane == 0) { atomicAdd((float*)(F.ctl + CW_DBG), sd); atomicAdd((float*)(F.ctl + CW_DBG + 1), sr); }
}
constexpr int N_PHASES = 15;
__global__ void __launch_bounds__(512, 2) mega_fwd(Args args) {
    extern __shared__ __attribute__((aligned(16))) unsigned char lds_raw[];
    Frame F;
    F.lds = (LAS unsigned char*)lds_raw; F.tid = threadIdx.x; F.lane = F.tid & 63; F.wave = __builtin_amdgcn_readfirstlane(F.tid >> 6); F.G = gridDim.x; F.bid = blockIdx.x;
#pragma unroll
    for (int i = 0; i < 28; ++i) F.in[i] = args.in[i];
    F.out = args.out; F.ws = args.ws; F.ctl = (unsigned*)(args.ws + WS_CTL);
    volatile LAS unsigned* MISC = (volatile LAS unsigned*)(F.lds + MISC_OFF);
    if (F.tid < 64) MISC[F.tid] = 0u;
    __syncthreads();
    const int lo = args.ph_lo, hi = args.ph_hi;
    XcdBarrier bar; bar.bar = F.ctl + CW_BAR; bar.x = 0; bar.st = nullptr;
    if (hi - lo > 1) bar = xcd_barrier_post(F.ctl + CW_BAR, MISC + 8);
#define IN(k) (lo <= (k) && (k) < hi)
#define SEAM(k) do { if (IN(k) && IN((k) + 1)) xcd_barrier(bar); } while (0)
    LAS unsigned char* ring = F.lds;
    const LAS int* gidx = (const LAS int*)(F.lds + GIDX_OFF);

    if (IN(0)) for (int rep_ = 0; rep_ <= ((REP_MASK >> 0) & 1) * REP_EXTRA; ++rep_) { if (rep_) xcd_barrier(bar);  phase_prologue(F); for (int tk = F.bid; tk < NG * 8; tk += F.G) p0_ssm_tables(F, tk); } SEAM(0);
    if (IN(1)) for (int rep_ = 0; rep_ <= ((REP_MASK >> 1) & 1) * REP_EXTRA; ++rep_) { if (rep_) xcd_barrier(bar);
        { pg8::Gemm g{WSP(bf16_t, WS_XB), WSP(bf16_t, WS_WIN), DM, 0}; pg8::PatchOrder S; S.init(T_ / 256, INW / 256, 8, F.G, F.bid);
          pg8::EpiInProj E{WSP(bf16_t, WS_Q), WSP(bf16_t, WS_K), WSP(bf16_t, WS_V), WSP(bf16_t, WS_U), WSP(bf16_t, WS_SGA), WSP(bf16_t, WS_SGB), WSP(float, WS_KM2)};
          pg8::gemm_phase<pg8::EpiInProj, pg8::PatchOrder, false>(ring, g, S, E, gidx, STG_TICKS);
#if NULL_EXP == 1
          { pg8::EpiNull EN; pg8::gemm_phase<pg8::EpiNull, pg8::PatchOrder, false>(ring, g, S, EN, gidx); pg8::gemm_phase<pg8::EpiNull, pg8::PatchOrder, false>(ring, g, S, EN, gidx); }
#elif NULL_EXP == 5
          { pg8::EpiStoreExp<false> EN{WSP(bf16_t, WS_N2B)}; pg8::gemm_phase<pg8::EpiStoreExp<false>, pg8::PatchOrder, false>(ring, g, S, EN, gidx); pg8::gemm_phase<pg8::EpiStoreExp<false>, pg8::PatchOrder, false>(ring, g, S, EN, gidx); }
#elif NULL_EXP == 6
          { pg8::EpiStoreExp<true> EN{WSP(bf16_t, WS_N2B)}; pg8::gemm_phase<pg8::EpiStoreExp<true>, pg8::PatchOrder, false>(ring, g, S, EN, gidx); pg8::gemm_phase<pg8::EpiStoreExp<true>, pg8::PatchOrder, false>(ring, g, S, EN, gidx); }
#elif NULL_EXP == 3
          { pg8::EpiInProjT<1> EN{E.Q, E.Kb, E.V, E.U, E.SGA, E.SGB, E.KM2}; pg8::gemm_phase<pg8::EpiInProjT<1>, pg8::PatchOrder, false>(ring, g, S, EN, gidx); pg8::gemm_phase<pg8::EpiInProjT<1>, pg8::PatchOrder, false>(ring, g, S, EN, gidx); }
#elif NULL_EXP == 4
          { pg8::EpiInProjT<2> EN{E.Q, E.Kb, E.V, E.U, E.SGA, E.SGB, E.KM2}; pg8::gemm_phase<pg8::EpiInProjT<2>, pg8::PatchOrder, false>(ring, g, S, EN, gidx); pg8::gemm_phase<pg8::EpiInProjT<2>, pg8::PatchOrder, false>(ring, g, S, EN, gidx); }
#endif
          }
        { pg8::Gemm g{WSP(bf16_t, WS_MN), WSP(bf16_t, WS_WXKV), DM, 0}; pg8::PatchOrder S; S.init(NB * MEML / 256, 2 * XW / 256, 4, F.G, F.bid);
          pg8::EpiMemKV E{WSP(bf16_t, WS_MKV), WSP(bf16_t, WS_MVT)};
          pg8::gemm_phase<pg8::EpiMemKV, pg8::PatchOrder, false>(ring, g, S, E, gidx); }
    } SEAM(1);
    if (IN(2)) for (int rep_ = 0; rep_ <= ((REP_MASK >> 2) & 1) * REP_EXTRA; ++rep_) { if (rep_) { xcd_barrier(bar); if (F.tid < 4) { for (int k_ = F.tid; k_ < 1024; k_ += 4) __hip_atomic_store(F.ctl + CW_MCNT + k_, 0u, RLX_AGENT); } __syncthreads(); xcd_barrier(bar); }
        for (int it = F.bid; it < NB * NG * 2; it += F.G) ssm_state_item(F, (it >> 1) / NG, (it >> 1) % NG, it & 1);
        for (int it = F.bid; it < NB * NH * NBLK; it += F.G) moba_route_item(F, it / NBLK, (NBLK - 1) - (it % NBLK));
    } SEAM(2);
    if (IN(3)) for (int rep_ = 0; rep_ <= ((REP_MASK >> 3) & 1) * REP_EXTRA; ++rep_) { if (rep_) xcd_barrier(bar);
        { int t_ = threadIdx.x; asm volatile("" : "+v"(t_)); F.tid = t_; F.lane = t_ & 63; F.wave = __builtin_amdgcn_readfirstlane(t_ >> 6); }
        moba_sparse_phase<0>(F, (char*)lds_raw);
#if MOBA_EXP == 1
        moba_sparse_phase<1>(F, (char*)lds_raw); moba_sparse_phase<1>(F, (char*)lds_raw);
#endif
        { int t_ = threadIdx.x; asm volatile("" : "+v"(t_)); F.tid = t_; F.lane = t_ & 63; F.wave = __builtin_amdgcn_readfirstlane(t_ >> 6); }
        phase_ssm_out(F);
    } SEAM(3);
#if DBG_STAGE == 1 || DBG_STAGE == 2
    moba_combine_phase(F); xcd_barrier(bar);
#endif
#if DBG_STAGE == 1
    phase_ssm_simple(F, WSP(bf16_t, WS_MERGED)); xcd_barrier(bar); dbg_compare(F, WSP(bf16_t, WS_YB), WSP(bf16_t, WS_MERGED), (size_t)T_ * SW); xcd_barrier(bar);
#elif DBG_STAGE == 2
    phase_moba_simple(F, WSP(bf16_t, WS_MERGED)); xcd_barrier(bar); dbg_compare(F, WSP(bf16_t, WS_ATT), WSP(bf16_t, WS_MERGED), (size_t)T_ * AW); xcd_barrier(bar);
#endif
    if (IN(5)) for (int rep_ = 0; rep_ <= ((REP_MASK >> 5) & 1) * REP_EXTRA; ++rep_) { if (rep_) xcd_barrier(bar);
#if !(DBG_STAGE == 1 || DBG_STAGE == 2)
        moba_combine_phase(F);
#endif
        pg8::Gemm g{WSP(bf16_t, WS_YB), WSP(bf16_t, WS_WGLU), SW, 0};
        pg8::EpiGlu E{WSP(bf16_t, WS_SGB), WSP(bf16_t, WS_YB2S)};
        if (F.G == 256) { pg8::PairOrder S; S.init(F.bid, 0); pg8::gemm_phase<pg8::EpiGlu, pg8::PairOrder, false>(ring, g, S, E, gidx); }
        else { pg8::PatchOrder S; S.init(T_ / 256, 2 * DM / 256, 8, F.G, F.bid); pg8::gemm_phase<pg8::EpiGlu, pg8::PatchOrder, false>(ring, g, S, E, gidx); }
    } if (F.G != 256) SEAM(5);
    if (IN(6)) for (int rep_ = 0; rep_ <= ((REP_MASK >> 6) & 1) * REP_EXTRA; ++rep_) { if (rep_) xcd_barrier(bar);
        pg8::Gemm g{WSP(bf16_t, WS_ATT), WSP(bf16_t, WS_WPA), AW, 0};
        pg8::EpiMerge E{WSP(bf16_t, WS_SGA), WSP(bf16_t, WS_YB2S), WSP(bf16_t, WS_MERGED)};
        if (F.G == 256) { pg8::PairOrder S; S.init(F.bid, 1); pg8::gemm_phase<pg8::EpiMerge, pg8::PairOrder, false>(ring, g, S, E, gidx); }
        else { pg8::PatchOrder S; S.init(T_ / 256, DM / 256, 4, F.G, F.bid); pg8::gemm_phase<pg8::EpiMerge, pg8::PatchOrder, false>(ring, g, S, E, gidx); }
    } SEAM(6);
    if (IN(7)) for (int rep_ = 0; rep_ <= ((REP_MASK >> 7) & 1) * REP_EXTRA; ++rep_) { if (rep_) xcd_barrier(bar);
        pg8::Gemm g{WSP(bf16_t, WS_MERGED), WSP(bf16_t, WS_WOUT), DM, 0}; pg8::PatchOrder S; S.init(T_ / 256, DM / 256, 4, F.G, F.bid);
        pg8::EpiResidT<true> E{F.in[I_X], WSP(bf16_t, WS_HB), WSP(float, WS_SSQ1)};
        pg8::gemm_phase<pg8::EpiResidT<true>, pg8::PatchOrder, false>(ring, g, S, E, gidx);
    } SEAM(7);
    if (IN(8)) for (int rep_ = 0; rep_ <= ((REP_MASK >> 8) & 1) * REP_EXTRA; ++rep_) { if (rep_) xcd_barrier(bar);
        pg8::Gemm g{WSP(bf16_t, WS_HB), WSP(bf16_t, WS_WXQ), DM, 0}; pg8::PatchOrder S; S.init(T_ / 256, XW / 256, 2, F.G, F.bid);
        pg8::EpiXq E{WSP(float, WS_SSQ1), WSP(bf16_t, WS_XQ)};
        pg8::gemm_phase<pg8::EpiXq, pg8::PatchOrder, false>(ring, g, S, E, gidx);
    } SEAM(8);
    if (IN(9)) for (int rep_ = 0; rep_ <= ((REP_MASK >> 9) & 1) * REP_EXTRA; ++rep_) { if (rep_) xcd_barrier(bar);  phase_xattn(F); } SEAM(9);
#if DBG_STAGE == 3
    phase_xattn_simple(F, WSP(bf16_t, WS_MERGED)); xcd_barrier(bar); dbg_compare(F, WSP(bf16_t, WS_XO), WSP(bf16_t, WS_MERGED), (size_t)T_ * XW); xcd_barrier(bar);
#endif
    if (IN(10)) for (int rep_ = 0; rep_ <= ((REP_MASK >> 10) & 1) * REP_EXTRA; ++rep_) { if (rep_) xcd_barrier(bar);
        pg8::Gemm g{WSP(bf16_t, WS_XO), WSP(bf16_t, WS_WXO), XW, 0}; pg8::PatchOrder S; S.init(T_ / 256, DM / 256, 4, F.G, F.bid);
        pg8::EpiResidT<false> E{nullptr, WSP(bf16_t, WS_HB), nullptr};
        pg8::gemm_phase<pg8::EpiResidT<false>, pg8::PatchOrder, false>(ring, g, S, E, gidx);
    } SEAM(10);
    if (IN(11)) for (int rep_ = 0; rep_ <= ((REP_MASK >> 11) & 1) * REP_EXTRA; ++rep_) { if (rep_) xcd_barrier(bar);  phase_router_mfma(F);
#if OUT_TOUCH
        { const int gw = F.bid * 8 + F.wave, NGW = F.G * 8;
          for (int tk = gw * 2; tk < T_; tk += NGW * 2) { if (F.lane < 2) { const float v = __builtin_nontemporal_load(F.out + (size_t)(tk + F.lane) * DM); asm volatile("" :: "v"(v)); } } }
#endif
    } SEAM(11);
    if (IN(12) || IN(13)) {
        LAS int* pref = (LAS int*)(F.lds + MISC_OFF + 256);
        const unsigned* cnt = F.ctl + CW_CNT;
        __syncthreads();
        if (F.tid == 0) { int a = 0; for (int e = 0; e < NE; ++e) { pref[e] = a; a += ((int)__hip_atomic_load(cnt + e, RLX_AGENT) + 255) >> 8; } pref[NE] = a; }
        __syncthreads();
        const int MT = pref[NE];
        if (IN(12)) for (int rep_ = 0; rep_ <= ((REP_MASK >> 12) & 1) * REP_EXTRA; ++rep_) { if (rep_) xcd_barrier(bar);
            MoeOrder S; S.P.init(MT, 2 * DFF / 256, 8, F.G, F.bid); S.pref = pref; S.rev = 0;
            { LAS int* gw_ = (LAS int*)(F.lds + GIDX_OFF); pg8::Unit u;
              for (int i = 0; i < GIDX_UNITS && S.next(i, u); ++i) { const int ce = (int)__hip_atomic_load(cnt + u.e, RLX_AGENT);
                  if (F.tid < 256) { const int rank = u.mi * 256 + F.tid; gw_[i * 256 + F.tid] = (rank < ce) ? (WSP(int, WS_ROWLIST)[(size_t)u.e * T_ + rank] >> 2) : 0; } } }
            __syncthreads();
            pg8::Gemm g{WSP(bf16_t, WS_N2B), WSP(bf16_t, WS_WGU), MOE1_FP8 ? DM / 2 : DM, MOE1_FP8 ? (size_t)2 * DFF * DM / 2 : (size_t)2 * DFF * DM};
            if (MOE1_FP8) g.scaleB = 0x01010101 * (127 - FP8_WSHIFT);
            pg8::EpiMoe1 E{F.in[I_BGU], WSP(bf16_t, WS_HID)};
            pg8::gemm_phase<pg8::EpiMoe1, MoeOrder, true, MOE1_FP8 != 0>(ring, g, S, E, gidx, STG_TICKS);
#if NULL_EXP == 2
            { pg8::EpiNull EN; pg8::gemm_phase<pg8::EpiNull, MoeOrder, true>(ring, g, S, EN, gidx); }
#endif
        }
        SEAM(12);
        if (IN(13)) for (int rep_ = 0; rep_ <= ((REP_MASK >> 13) & 1) * REP_EXTRA; ++rep_) { if (rep_) xcd_barrier(bar);
            MoeOrder S; S.P.init(MT, DM / 256, 4, F.G, F.bid); S.pref = pref; S.rev = 1;
            pg8::Gemm g{WSP(bf16_t, WS_HID), WSP(bf16_t, WS_WDN), MOE2_FP8 ? DFF / 2 : DFF, MOE2_FP8 ? (size_t)DM * DFF / 2 : (size_t)DM * DFF};
            if (MOE2_FP8) g.scaleB = 0x01010101 * (127 - FP8_WSHIFT);
            { LAS int* tD = (LAS int*)(F.lds + GIDX_OFF); LAS float* tG = (LAS float*)(F.lds + GIDX_OFF + 12 * 1024); pg8::Unit u;
              __syncthreads();
              for (int i = 0; i < 12 && S.next(i, u); ++i) { const int ce = (int)__hip_atomic_load(cnt + u.e, RLX_AGENT);
                  if (F.tid < 256) { const int rank = u.mi * 256 + F.tid; int d = -1; float gv = 0.f; if (rank < ce) { d = WSP(int, WS_ROWLIST)[(size_t)u.e * T_ + rank]; gv = WSP(float, WS_TKG)[d]; } tD[i * 256 + F.tid] = d; tG[i * 256 + F.tid] = gv; } }
              __syncthreads(); }
            pg8::EpiMoe2 E{F.in[I_BDN], (const LAS int*)(F.lds + GIDX_OFF), (const LAS float*)(F.lds + GIDX_OFF + 12 * 1024), WSP(bf16_t, WS_Y)};
            pg8::gemm_phase<pg8::EpiMoe2, MoeOrder, false, MOE2_FP8 != 0>(ring, g, S, E, gidx, STG_TICKS);
        }
    } SEAM(13);
#if BAR_EXP
    for (int k_ = 0; k_ < 20; ++k_) xcd_barrier(bar);
#endif
    if (IN(14)) for (int rep_ = 0; rep_ <= ((REP_MASK >> 14) & 1) * REP_EXTRA; ++rep_) { if (rep_) xcd_barrier(bar);  phase_final(F);
#if FINAL_EXP
        phase_final_t<FINAL_EXP>(F); phase_final_t<FINAL_EXP>(F);
#endif
    }
#undef IN
#undef SEAM
}

extern "C" void kernel_launch(void* const* d_in, const int* in_sizes, int n_in, void* d_out, int out_size, void* d_ws, size_t ws_size, hipStream_t stream) {
    static int grid = 0;
    if (grid == 0) {
        if (n_in != 28 || in_sizes[0] != T_ * DM || out_size != T_ * DM || ws_size < WS_END) { fprintf(stderr, "kernel_launch: unexpected shapes (n_in %d, in0 %d, out %d, ws %zu)\n", n_in, n_in > 0 ? in_sizes[0] : -1, out_size, ws_size); grid = -1; return; }
        int dev = 0, cus = 0;
        if (hipGetDevice(&dev) != hipSuccess || hipDeviceGetAttribute(&cus, hipDeviceAttributeMultiprocessorCount, dev) != hipSuccess) { grid = -1; return; }
        if (hipFuncSetAttribute((const void*)mega_fwd, hipFuncAttributeMaxDynamicSharedMemorySize, LDS_BYTES) != hipSuccess) { fprintf(stderr, "kernel_launch: hipFuncSetAttribute failed\n"); grid = -1; return; }
        (void)hipGetLastError();
        grid = cus;
    }
    if (grid < 0) return;
    (void)hipMemsetAsync((char*)d_ws + WS_CTL, 0, CTL_ZERO_BYTES, stream);
    Args a{};
    for (int i = 0; i < 28; ++i) a.in[i] = (const float*)d_in[i];
    a.out = (float*)d_out; a.ws = (unsigned char*)d_ws;
#if MK_N_LAUNCHES == 1
    a.ph_lo = 0; a.ph_hi = N_PHASES;
    hipLaunchKernelGGL(mega_fwd, dim3(grid), dim3(512), LDS_BYTES, stream, a);
#else
    for (int p = 0; p < N_PHASES; ++p) { a.ph_lo = p; a.ph_hi = p + 1; hipLaunchKernelGGL(mega_fwd, dim3(grid), dim3(512), LDS_BYTES, stream, a); }
#endif
}
```

```cpp
#include <hip/hip_runtime.h>
#include <hip/hip_bf16.h>
#include <cmath>
#include <cstdio>
#include <cstdint>

#ifndef MK_N_LAUNCHES
#define MK_N_LAUNCHES 1
#endif

#ifndef REP_EXTRA
#define REP_EXTRA 1
#endif
#ifndef NULL_EXP
#define NULL_EXP 0
#endif
#ifndef STG_TICKS
#define STG_TICKS 0
#endif
#ifndef MOBA_EXP
#define MOBA_EXP 0
#endif
#ifndef OUT_NT
#define OUT_NT 0
#endif
#ifndef OUT_TOUCH
#define OUT_TOUCH 0
#endif
#ifndef BAR_EXP
#define BAR_EXP 0
#endif
#ifndef FINAL_EXP
#define FINAL_EXP 0
#endif
#ifndef MOE1_FP8
#define MOE1_FP8 1
#endif
constexpr int FP8_WSHIFT = 7;
#ifndef MOE2_FP8
#define MOE2_FP8 1
#endif
#ifndef Y_FP8
#define Y_FP8 1
#endif
constexpr int Y_SHIFT = 3;
#ifndef REP_MASK
#define REP_MASK 0
#endif
#ifndef DBG_STAGE
#define DBG_STAGE 0
#endif

#define GAS __attribute__((address_space(1)))
#define LAS __attribute__((address_space(3)))
typedef unsigned short bf16_t;
typedef short bf16x8 __attribute__((ext_vector_type(8)));
typedef float f32x4 __attribute__((ext_vector_type(4)));
typedef float f32x2 __attribute__((ext_vector_type(2)));
typedef float f32x16 __attribute__((ext_vector_type(16)));
typedef unsigned u32x4 __attribute__((ext_vector_type(4)));
typedef unsigned u32x2 __attribute__((ext_vector_type(2)));

constexpr int NB = 4, SEQ = 8192, DM = 1024, T_ = NB * SEQ;
constexpr int AW = 512, NH = 8, HD = 64, MBLK = 256, NBLK = SEQ / MBLK, MTOPK = 3;
constexpr int SW = 512, SGC = 16, NG = 32, SP = 64;
constexpr int INW = 4096;
constexpr int MEML = 256, XH = 4, XD = 128, XW = 512;
constexpr int NE = 32, ETOPK = 4, DFF = 1024;
constexpr float RMS_EPS = 1e-6f;
constexpr float LOG2E = 1.4426950408889634f;
constexpr float QSCALE = 0.125f * LOG2E;
constexpr float XSCALE = 0.08838834764831845f * LOG2E;
constexpr int HID_ROWS = ETOPK * T_ + NE * 256;

constexpr size_t MiB = 1u << 20;
constexpr size_t WS_WIN = 0 * MiB, WS_WGLU = 8 * MiB, WS_WPA = 10 * MiB, WS_WOUT = 11 * MiB, WS_WXQ = 13 * MiB, WS_WXKV = 14 * MiB, WS_WXO = 16 * MiB,
                 WS_WGU = 17 * MiB, WS_WDN = 145 * MiB;
constexpr size_t WS_CTL = 209 * MiB, CTL_ZERO_BYTES = 1 * MiB;
constexpr size_t WS_RSTD0 = 210 * MiB;
constexpr size_t WS_RSTD2 = WS_RSTD0 + 128 * 1024;
constexpr size_t WS_KMEAN = WS_RSTD2 + 128 * 1024;
constexpr size_t WS_KM2 = WS_KMEAN;
constexpr size_t WS_TKG = 224 * MiB;
constexpr size_t WS_SSQ1 = 211 * MiB;
constexpr size_t WS_SSQ2 = 213 * MiB;
constexpr size_t WS_ROWLIST = 215 * MiB;
constexpr size_t WS_MN = 219 * MiB;
constexpr size_t WS_MKV = 221 * MiB;
constexpr size_t WS_MVT = 223 * MiB;
constexpr size_t WS_WST = 225 * MiB;
constexpr size_t WS_GT = 233 * MiB;
constexpr size_t WS_KT = 241 * MiB;
constexpr size_t WS_LAML = 243 * MiB;
constexpr size_t WS_SST = 244 * MiB;
constexpr size_t WS_H = 256 * MiB;
constexpr size_t WS_N2B = 256 * MiB;
constexpr size_t WS_PO = 256 * MiB;
constexpr size_t WS_PML = 384 * MiB;
constexpr size_t WS_MLIST = 392 * MiB;
constexpr size_t WS_HB = 384 * MiB;
constexpr size_t WS_HID = 448 * MiB;
constexpr size_t WS_Y = 720 * MiB;
constexpr size_t WS_END = 992 * MiB;
constexpr size_t WS_INV = 224 * MiB + 512 * 1024;
constexpr size_t WS_XB = 448 * MiB, WS_Q = 512 * MiB, WS_K = 544 * MiB, WS_V = 576 * MiB, WS_U = 608 * MiB, WS_ATT = 640 * MiB, WS_YB = 672 * MiB;
constexpr size_t WS_SGA = 720 * MiB, WS_SGB = 784 * MiB, WS_YB2S = 848 * MiB, WS_MERGED = 912 * MiB;
constexpr size_t WS_XQ = 448 * MiB, WS_XO = 480 * MiB;
static_assert(WS_HID + (size_t)HID_ROWS * DFF * 2 <= WS_Y, "HID fits");
constexpr int CW_TMO = 0, CW_CNT = 64  , CW_DBG = 128  , CW_MCNT = 256  , CW_BAR = 4096;

constexpr int RING_BYTES = 131072;
constexpr int GIDX_OFF = RING_BYTES, GIDX_UNITS = 24;
constexpr int MISC_OFF = GIDX_OFF + GIDX_UNITS * 1024;
constexpr int LDS_BYTES = 163840;

#define RLX_AGENT __ATOMIC_RELAXED, __HIP_MEMORY_SCOPE_AGENT
__device__ __forceinline__ unsigned f2bf(float f) { unsigned u = __builtin_bit_cast(unsigned, f); return (u + 0x7fffu + ((u >> 16) & 1u)) >> 16; }
__device__ __forceinline__ unsigned pk2(float lo, float hi) { return f2bf(lo) | (f2bf(hi) << 16); }
__device__ __forceinline__ float bf2f(unsigned short b) { return __builtin_bit_cast(float, (unsigned)b << 16); }
__device__ __forceinline__ float bflo(unsigned w) { return __builtin_bit_cast(float, w << 16); }
__device__ __forceinline__ float bfhi(unsigned w) { return __builtin_bit_cast(float, w & 0xffff0000u); }
__device__ __forceinline__ float ub0(unsigned w) { return (float)(w & 0xffu) * (1.0f / 255.0f); }
__device__ __forceinline__ float ub1(unsigned w) { return (float)((w >> 8) & 0xffu) * (1.0f / 255.0f); }
__device__ __forceinline__ float ub2(unsigned w) { return (float)((w >> 16) & 0xffu) * (1.0f / 255.0f); }
__device__ __forceinline__ float ub3(unsigned w) { return (float)(w >> 24) * (1.0f / 255.0f); }
__device__ __forceinline__ float wave_sum(float v) {
#pragma unroll
    for (int o = 1; o < 64; o <<= 1) v += __shfl_xor(v, o);
    return v;
}
__device__ __forceinline__ float fsigmoid(float x) { return __builtin_amdgcn_rcpf(1.0f + __builtin_amdgcn_exp2f(-x * LOG2E)); }
__device__ __forceinline__ float gelu_tanh(float x) {
    const float u = 0.7978845608028654f * (x + 0.044715f * x * x * x);
    return x * fsigmoid(2.0f * u);
}

namespace pg8 {
constexpr int BM = 256, BK = 64, HALF = 128, HTB = HALF * BK * 2, STAGE_BYTES = 8 * HTB;
__host__ __device__ __forceinline__ int lds_byte(int r, int c) { const int st = (r >> 4) * 2 + (c >> 5), rr = r & 15, cc = c & 31, ob = rr * 64 + cc * 2; return st * 1024 + (ob ^ (((ob >> 9) & 1) << 5)); }
__host__ __device__ __forceinline__ void stage_rc(int b, int& R, int& C) { const int st = b / 1024, sb = b % 1024, swz = sb ^ (((sb >> 9) & 1) << 5); R = (st >> 1) * 16 + swz / 64; C = (st & 1) * 32 + (swz % 64) / 2; }
__host__ __device__ __forceinline__ int perm32(int rho) { const int n = rho >> 4, i = rho & 15; return 8 * (i >> 2) + 4 * n + (i & 3); }

struct Unit { int pm, pn, e, mi, ui; };
struct Gemm { const bf16_t* A; const bf16_t* Bt; int K; size_t b_estride; int scaleA = 0x7f7f7f7f, scaleB = 0x7f7f7f7f; };
typedef int v8i __attribute__((ext_vector_type(8)));

struct PatchOrder {
    int nM, nN, PM, PN, x, j, ok;
    __device__ __forceinline__ void init(int nM_, int nN_, int PN_, int G, int c) { nM = nM_; nN = nN_; PN = PN_; PM = (G / 8) / PN_; x = c & 7; j = c >> 3; ok = ((G & 7) == 0) && (PM * PN == G / 8) && (nN % PN == 0); if (!ok) { x = c; j = G; } }
    __device__ __forceinline__ bool next(int i, Unit& u) const {
        if (!ok) { const long L = (long)i * j + x; if (L >= (long)nM * nN) return false; u.pm = (int)(L / nN); u.pn = (int)(L % nN); u.e = 0; u.mi = u.pm; u.ui = i; return true; }
        const int p = 8 * i + x, npn = nN / PN, pmb = p / npn, pnb = p % npn;
        u.pm = pmb * PM + (j % PM); u.pn = pnb * PN + (j / PM); u.e = 0; u.mi = u.pm; u.ui = i;
        return u.pm < nM;
    }
};

struct PairOrder {
    int pp, q, mode;
    __device__ __forceinline__ void init(int c, int mode_) { const int x = c & 7, k = c >> 3; q = k & 3; pp = 8 * x + (k >> 2); mode = mode_; }
    __device__ __forceinline__ bool next(int i, Unit& u) const {
        if (mode == 0) { if (i >= 4) return false; u.pm = 2 * pp + (i >> 1); u.pn = 2 * q + (i & 1); }
        else { if (i >= 2) return false; u.pm = 2 * pp + i; u.pn = q; }
        u.e = 0; u.mi = u.pm; u.ui = i; return true;
    }
};
__device__ __forceinline__ unsigned cvt_pk_bf16(float lo, float hi) { unsigned r; asm volatile("v_cvt_pk_bf16_f32 %0, %1, %2" : "=v"(r) : "v"(lo), "v"(hi)); return r; }
#ifndef NT_STORES
#define NT_STORES 0
#endif
#ifndef WT_STORES
#define WT_STORES 0
#endif
__device__ __forceinline__ void st16(void* p, u32x4 v) {
#if WT_STORES
    asm volatile("global_store_dwordx4 %0, %1, off sc1\n\ts_nop 1" :: "v"(p), "v"(v) : "memory");
#elif NT_STORES
    __builtin_nontemporal_store(v, (u32x4*)p);
#else
    *(u32x4*)p = v;
#endif
}

template <class Epi, class Sched, bool GATHER, bool FP8 = false>
__device__ __forceinline__ void gemm_phase(LAS unsigned char* lds, const Gemm g, const Sched& S, const Epi& E, const LAS int* gidx, int stagger_ticks = 0) {
    if (stagger_ticks > 0) {
        const unsigned long long t0 = __builtin_amdgcn_s_memrealtime(); const unsigned long long dl = (unsigned long long)(stagger_ticks * ((blockIdx.x >> 3) & 3));
        while (__builtin_amdgcn_s_memrealtime() - t0 < dl) __builtin_amdgcn_s_sleep(8);
    }
    const int tid = threadIdx.x, wid = __builtin_amdgcn_readfirstlane(tid >> 6), lane = tid & 63, wr = wid >> 2, wc = wid & 3, fr = lane & 15, fq = lane >> 4;
    const int K = g.K, nt = K / BK;
    int Ra[2], Ca[2]; unsigned voffB[2];
#pragma unroll
    for (int i = 0; i < 2; ++i) { int R, C; stage_rc(tid * 16 + i * 8192, R, C); const int Rb = Epi::PERM ? ((R & ~31) + perm32(R & 31)) : R;
        Ra[i] = R; Ca[i] = C; voffB[i] = (unsigned)(Rb * K + C) * 2u; }
    const size_t kstep = (size_t)(BK * 2);
    const size_t hstep = (size_t)HALF * K * 2;
    const size_t tstep = 2 * hstep;
    const unsigned ldsw = (unsigned)wid * 1024u;
    const int aoff = lds_byte(wr * 64 + fr, fq * 8), boff = lds_byte(wc * 32 + fr, fq * 8);
#define PG8_SA(b, h) (((b) * 2 + (h)) * HTB)
#define PG8_SB(b, h) ((4 + (b) * 2 + (h)) * HTB)
#define PG8_STAGE(bufoff, gbase, voff) do { _Pragma("unroll") for (int _i = 0; _i < 2; ++_i) \
        __builtin_amdgcn_global_load_lds((const unsigned*)((const char*)(gbase) + (voff)[_i]), (LAS unsigned*)(lds + (bufoff) + ldsw + _i * 8192), 16, 0, 0); } while (0)
#define PG8_LDA_BF(dst, b, h) do { _Pragma("unroll") for (int m = 0; m < 4; ++m) _Pragma("unroll") for (int k = 0; k < 2; ++k) dst[m][k] = *(const LAS bf16x8*)(lds + PG8_SA(b, h) + aoff + m * 2048 + k * 1024); } while (0)
#define PG8_LDB_BF(dst, b, h) do { _Pragma("unroll") for (int n = 0; n < 2; ++n) _Pragma("unroll") for (int k = 0; k < 2; ++k) dst[n][k] = *(const LAS bf16x8*)(lds + PG8_SB(b, h) + boff + n * 2048 + k * 1024); } while (0)
#define PG8_LD8(dst, base_) do { const u32x4 lo_ = *(const LAS u32x4*)(base_), hi_ = *(const LAS u32x4*)((base_) + 1024); dst = (v8i){(int)lo_.x, (int)lo_.y, (int)lo_.z, (int)lo_.w, (int)hi_.x, (int)hi_.y, (int)hi_.z, (int)hi_.w}; } while (0)
#define PG8_LDA8(dst, b, h) do { _Pragma("unroll") for (int m = 0; m < 4; ++m) PG8_LD8(dst[m], lds + PG8_SA(b, h) + aoff + m * 2048); } while (0)
#define PG8_LDB8(dst, b, h) do { _Pragma("unroll") for (int n = 0; n < 2; ++n) PG8_LD8(dst[n], lds + PG8_SB(b, h) + boff + n * 2048); } while (0)
#define PG8_LDA(dst, b, h) do { if constexpr (FP8) PG8_LDA8(dst##8, b, h); else PG8_LDA_BF(dst, b, h); } while (0)
#define PG8_LDB(dst, b, h) do { if constexpr (FP8) PG8_LDB8(dst##8, b, h); else PG8_LDB_BF(dst, b, h); } while (0)
#define PG8_MMA_BF(ai, bj, At, Bt) do { __builtin_amdgcn_s_setprio(1); _Pragma("unroll") for (int m = 0; m < 4; ++m) _Pragma("unroll") for (int n = 0; n < 2; ++n) _Pragma("unroll") for (int k = 0; k < 2; ++k) \
        acc[ai][bj][m][n] = __builtin_amdgcn_mfma_f32_16x16x32_bf16(Bt[n][k], At[m][k], acc[ai][bj][m][n], 0, 0, 0); __builtin_amdgcn_s_setprio(0); } while (0)
#define PG8_MMA_F8(ai, bj, At, Bt) do { __builtin_amdgcn_s_setprio(1); _Pragma("unroll") for (int m = 0; m < 4; ++m) _Pragma("unroll") for (int n = 0; n < 2; ++n) \
        asm volatile("s_nop 1\n\tv_mfma_scale_f32_16x16x128_f8f6f4 %0, %1, %2, %0, %3, %4 op_sel_hi:[0,0,0]" : "+v"(acc[ai][bj][m][n]) : "v"(Bt[n]), "v"(At[m]), "v"(sclB), "v"(sclA)); \
        __builtin_amdgcn_s_setprio(0); } while (0)
#define PG8_MMA(ai, bj, At, Bt) do { if constexpr (FP8) PG8_MMA_F8(ai, bj, At##8, Bt##8); else PG8_MMA_BF(ai, bj, At, Bt); } while (0)
#define PG8_WAIT_V(n) asm volatile("s_waitcnt vmcnt(" #n ")" ::: "memory")
#define PG8_WAIT_L(n) asm volatile("s_waitcnt lgkmcnt(" #n ")" ::: "memory")
#define PG8_BAR __builtin_amdgcn_s_barrier()
#define PG8_SCHED __builtin_amdgcn_sched_barrier(0)
#define PG8_VOA(dst, u) do { _Pragma("unroll") for (int _h = 0; _h < 2; ++_h) _Pragma("unroll") for (int _i = 0; _i < 2; ++_i) { \
        const int _row = GATHER ? gidx[(u).ui * 256 + _h * HALF + Ra[_i]] : (_h * HALF + Ra[_i]); dst[_h][_i] = (unsigned)(_row * K + Ca[_i]) * 2u; } } while (0)
    Unit cur, nxt; int ui = 0;
    if (!S.next(0, cur)) return;
    f32x4 acc[2][2][4][2];
#pragma unroll
    for (int a = 0; a < 2; ++a)
#pragma unroll
        for (int b = 0; b < 2; ++b)
#pragma unroll
            for (int m = 0; m < 4; ++m)
#pragma unroll
                for (int n = 0; n < 2; ++n) acc[a][b][m][n] = (f32x4){0.f, 0.f, 0.f, 0.f};
    bf16x8 At[4][2], B0[2][2], B1[2][2]; v8i At8[4], B08[2], B18[2];
    unsigned voA[2][2];
    const int sclA = g.scaleA, sclB = g.scaleB;
    PG8_VOA(voA, cur);
    const char* cA = (const char*)g.A + (GATHER ? (size_t)0 : (size_t)cur.pm * tstep);
    const char* cB = (const char*)g.Bt + ((size_t)cur.e * g.b_estride) * 2 + (size_t)cur.pn * tstep;
    PG8_STAGE(PG8_SB(0, 0), cB, voffB); PG8_STAGE(PG8_SB(0, 1), cB + hstep, voffB); PG8_STAGE(PG8_SA(0, 0), cA, voA[0]); PG8_STAGE(PG8_SA(0, 1), cA, voA[1]);
    if (wr == 1) PG8_BAR;
    PG8_WAIT_V(2); PG8_BAR;
    PG8_STAGE(PG8_SB(1, 0), cB + kstep, voffB); PG8_STAGE(PG8_SA(1, 0), cA + kstep, voA[0]); PG8_STAGE(PG8_SB(1, 1), cB + hstep + kstep, voffB);
    PG8_WAIT_V(6); PG8_BAR;
    for (;;) {
        const bool has_next = S.next(ui + 1, nxt);
        const char* nA = cA; const char* nB = cB;
        if (has_next) { nA = (const char*)g.A + (GATHER ? (size_t)0 : (size_t)nxt.pm * tstep); nB = (const char*)g.Bt + ((size_t)nxt.e * g.b_estride) * 2 + (size_t)nxt.pn * tstep; }
#pragma unroll 1
        for (int t = 0; t < nt; t += 2) {
            const bool last = (t == nt - 2);
            const char* a1 = cA + (size_t)(t + 1) * kstep;
            const char* a2 = last ? nA : cA + (size_t)(t + 2) * kstep; const char* b2 = last ? nB : cB + (size_t)(t + 2) * kstep;
            const char* a3 = a2 + kstep; const char* b3 = b2 + kstep;
            unsigned vo2[2][2];
#pragma unroll
            for (int h = 0; h < 2; ++h)
#pragma unroll
                for (int i = 0; i < 2; ++i) vo2[h][i] = voA[h][i];
            if (GATHER && last && has_next) { PG8_VOA(vo2, nxt); }
            PG8_LDB(B0, 0, 0); PG8_LDB(B1, 0, 1); PG8_SCHED; PG8_LDA(At, 0, 0); PG8_STAGE(PG8_SA(1, 1), a1, voA[1]);
            PG8_WAIT_V(8); PG8_WAIT_L(0); PG8_BAR; PG8_MMA(0, 0, At, B0); PG8_MMA(0, 1, At, B1); PG8_BAR; PG8_SCHED;
            PG8_LDA(At, 0, 1); PG8_STAGE(PG8_SB(0, 0), b2, voffB); PG8_STAGE(PG8_SB(0, 1), b2 + hstep, voffB); PG8_STAGE(PG8_SA(0, 0), a2, vo2[0]);
            PG8_WAIT_V(8); PG8_WAIT_L(0); PG8_BAR; PG8_MMA(1, 0, At, B0); PG8_MMA(1, 1, At, B1); PG8_BAR; PG8_SCHED;
            PG8_LDB(B0, 1, 0); PG8_LDB(B1, 1, 1); PG8_SCHED; PG8_LDA(At, 1, 0); PG8_STAGE(PG8_SA(0, 1), a2, vo2[1]);
            PG8_WAIT_V(8); PG8_WAIT_L(0); PG8_BAR; PG8_MMA(0, 0, At, B0); PG8_MMA(0, 1, At, B1); PG8_BAR; PG8_SCHED;
            PG8_LDA(At, 1, 1); PG8_STAGE(PG8_SB(1, 0), b3, voffB); PG8_STAGE(PG8_SB(1, 1), b3 + hstep, voffB); PG8_STAGE(PG8_SA(1, 0), a3, vo2[0]);
            PG8_WAIT_V(8); PG8_WAIT_L(0); PG8_BAR; PG8_MMA(1, 0, At, B0); PG8_MMA(1, 1, At, B1); PG8_BAR; PG8_SCHED;
        }
        if (wr == 0) PG8_BAR;
        if constexpr (FP8) asm volatile("s_nop 15\n\ts_nop 15" ::: "memory");
        E(acc, cur, wr, wc, fr, fq);
        if (!has_next) break;
#pragma unroll
        for (int a = 0; a < 2; ++a)
#pragma unroll
            for (int b = 0; b < 2; ++b)
#pragma unroll
                for (int m = 0; m < 4; ++m)
#pragma unroll
                    for (int n = 0; n < 2; ++n) acc[a][b][m][n] = (f32x4){0.f, 0.f, 0.f, 0.f};
        cur = nxt; cA = nA; cB = nB; ++ui;
        if (GATHER) { PG8_VOA(voA, cur); }
        if (wr == 1) PG8_BAR;
    }
    PG8_WAIT_V(0);
    PG8_BAR;
#undef PG8_SA
#undef PG8_SB
#undef PG8_STAGE
#undef PG8_LDA
#undef PG8_LDA_BF
#undef PG8_LDA8
#undef PG8_LD8
#undef PG8_LDB
#undef PG8_LDB_BF
#undef PG8_LDB8
#undef PG8_MMA
#undef PG8_MMA_BF
#undef PG8_MMA_F8
#undef PG8_WAIT_V
#undef PG8_WAIT_L
#undef PG8_BAR
#undef PG8_SCHED
#undef PG8_VOA
}

typedef const f32x4 (&AccRef)[2][2][4][2];
#define EPI_ROWS for (int ai = 0; ai < 2; ++ai) _Pragma("unroll") for (int m = 0; m < 4; ++m)

template <int XMODE> struct EpiInProjT {
    static constexpr bool PERM = true;
    bf16_t *Q, *Kb, *V, *U, *SGA, *SGB; float* KM2;
    __device__ __forceinline__ void operator()(AccRef acc, const Unit& u, int wr, int wc, int fr, int fq) const {
        bf16_t* dst; int ld, colt; bool sig = false; float sc = 1.f;
        if (u.pn < 2) { dst = Q; ld = AW; colt = u.pn * 256; sc = QSCALE; }
        else if (u.pn < 4) { dst = Kb; ld = AW; colt = (u.pn - 2) * 256; }
        else if (u.pn < 6) { dst = V; ld = AW; colt = (u.pn - 4) * 256; }
        else if (u.pn < 8) { dst = U; ld = AW; colt = (u.pn - 6) * 256; }
        else if (u.pn < 12) { dst = SGA; ld = DM; colt = (u.pn - 8) * 256; sig = true; }
        else { dst = SGB; ld = DM; colt = (u.pn - 12) * 256; sig = true; }
        const int row0 = u.pm * BM + wr * 64 + fr, col0 = colt + wc * 32 + 8 * fq;
        const bool isk = (u.pn == 2 || u.pn == 3); f32x4 cs[2][2];
#pragma unroll
        for (int bj = 0; bj < 2; ++bj)
#pragma unroll
            for (int n = 0; n < 2; ++n) cs[bj][n] = (f32x4){0.f, 0.f, 0.f, 0.f};
#pragma unroll
        EPI_ROWS { const int row = row0 + ai * HALF + m * 16; const float rs = sc; bf16_t* rowp = dst + (size_t)row * ld + col0;
#pragma unroll
            for (int bj = 0; bj < 2; ++bj) { f32x4 v0 = acc[ai][bj][m][0] * rs, v1 = acc[ai][bj][m][1] * rs;
                cs[bj][0] += v0; cs[bj][1] += v1;
                if (sig) {
                    unsigned q[8];
#pragma unroll
                    for (int e = 0; e < 4; ++e) { q[e] = (unsigned)(fsigmoid(v0[e]) * 255.0f + 0.5f); q[4 + e] = (unsigned)(fsigmoid(v1[e]) * 255.0f + 0.5f); }
                    const unsigned g0 = q[0] | (q[1] << 8) | (q[2] << 16) | (q[3] << 24), g1 = q[4] | (q[5] << 8) | (q[6] << 16) | (q[7] << 24);
                    if (XMODE != 1) *(u32x2*)((unsigned char*)dst + (size_t)row * ld + col0 + bj * HALF) = (u32x2){g0, g1};
                    continue; }
                u32x4 w; w.x = cvt_pk_bf16(v0[0], v0[1]); w.y = cvt_pk_bf16(v0[2], v0[3]); w.z = cvt_pk_bf16(v1[0], v1[1]); w.w = cvt_pk_bf16(v1[2], v1[3]);
                if (XMODE == 1) { asm volatile("" :: "v"(w)); } else st16(rowp + bj * HALF, w); } }
        if (isk && XMODE == 0) {
#pragma unroll
            for (int bj = 0; bj < 2; ++bj)
#pragma unroll
                for (int n = 0; n < 2; ++n)
#pragma unroll
                    for (int e = 0; e < 4; ++e) { float v = cs[bj][n][e]; v += __shfl_xor(v, 1); v += __shfl_xor(v, 2); v += __shfl_xor(v, 4); v += __shfl_xor(v, 8); cs[bj][n][e] = v; }
            if (fr == 0) { const int b = u.pm / NBLK, j = u.pm % NBLK;
#pragma unroll
                for (int bj = 0; bj < 2; ++bj) { const int col = colt + bj * HALF + wc * 32 + 8 * fq, h = col >> 6, d = col & 63;
                    float* kp = KM2 + ((((size_t)wr * NB + b) * NH + h) * NBLK + j) * HD + d;
                    *(f32x4*)kp = cs[bj][0] * (1.0f / MBLK); *(f32x4*)(kp + 4) = cs[bj][1] * (1.0f / MBLK); } } }
    }
};
struct EpiNull {
    static constexpr bool PERM = true;
    __device__ __forceinline__ void operator()(AccRef acc, const Unit& u, int wr, int wc, int fr, int fq) const {
#pragma unroll
        EPI_ROWS {
#pragma unroll
            for (int bj = 0; bj < 2; ++bj) { asm volatile("" :: "v"(acc[ai][bj][m][0]), "v"(acc[ai][bj][m][1])); } }
    }
};
typedef EpiInProjT<0> EpiInProj;
template <bool FULL> struct EpiStoreExp {
    static constexpr bool PERM = true;
    bf16_t* O;
    __device__ __forceinline__ void operator()(AccRef acc, const Unit& u, int wr, int wc, int fr, int fq) const {
        const int row0 = u.pm * BM + wr * 64 + (FULL ? (fr & 7) : fr), col0 = (u.pn & 3) * BM + (FULL ? (wc * 64 + (fr >> 3) * 32 + 8 * fq) : (wc * 32 + 8 * fq));
#pragma unroll
        EPI_ROWS { bf16_t* rowp = O + (size_t)(row0 + ai * HALF + m * 16) * DM + col0;
#pragma unroll
            for (int bj = 0; bj < 2; ++bj) { const f32x4 v0 = acc[ai][bj][m][0], v1 = acc[ai][bj][m][1];
                u32x4 w; w.x = cvt_pk_bf16(v0[0], v0[1]); w.y = cvt_pk_bf16(v0[2], v0[3]); w.z = cvt_pk_bf16(v1[0], v1[1]); w.w = cvt_pk_bf16(v1[2], v1[3]);
                st16(rowp + (FULL ? (size_t)bj * 8 * DM : (size_t)bj * HALF), w); } }
    }
};
struct EpiStore {
    static constexpr bool PERM = true;
    bf16_t* O; int ld;
    __device__ __forceinline__ void operator()(AccRef acc, const Unit& u, int wr, int wc, int fr, int fq) const {
        const int row0 = u.pm * BM + wr * 64 + fr, col0 = u.pn * BM + wc * 32 + 8 * fq;
#pragma unroll
        EPI_ROWS { bf16_t* rowp = O + (size_t)(row0 + ai * HALF + m * 16) * ld + col0;
#pragma unroll
            for (int bj = 0; bj < 2; ++bj) { const f32x4 v0 = acc[ai][bj][m][0], v1 = acc[ai][bj][m][1];
                u32x4 w; w.x = cvt_pk_bf16(v0[0], v0[1]); w.y = cvt_pk_bf16(v0[2], v0[3]); w.z = cvt_pk_bf16(v1[0], v1[1]); w.w = cvt_pk_bf16(v1[2], v1[3]);
                st16(rowp + bj * HALF, w); } }
    }
};
struct EpiMemKV {
    static constexpr bool PERM = true;
    bf16_t* O; bf16_t* VT;
    __device__ __forceinline__ void operator()(AccRef acc, const Unit& u, int wr, int wc, int fr, int fq) const {
        const int rl0 = wr * 64 + fr, col0 = u.pn * BM + wc * 32 + 8 * fq;
#pragma unroll
        EPI_ROWS { const int rl = rl0 + ai * HALF + m * 16;
#pragma unroll
            for (int bj = 0; bj < 2; ++bj) { const f32x4 v0 = acc[ai][bj][m][0], v1 = acc[ai][bj][m][1]; const int col = col0 + bj * HALF;
                if (u.pn < 2) { u32x4 w; w.x = cvt_pk_bf16(v0[0], v0[1]); w.y = cvt_pk_bf16(v0[2], v0[3]); w.z = cvt_pk_bf16(v1[0], v1[1]); w.w = cvt_pk_bf16(v1[2], v1[3]);
                    st16(O + (size_t)(u.pm * BM + rl) * (2 * XW) + col, w); }
                else { bf16_t* vp = VT + ((size_t)u.pm * XW + (col - XW)) * MEML + rl;
#pragma unroll
                    for (int e = 0; e < 4; ++e) { vp[(size_t)e * MEML] = (bf16_t)f2bf(v0[e]); vp[(size_t)(4 + e) * MEML] = (bf16_t)f2bf(v1[e]); } } } }
    }
};
struct EpiGlu {
    static constexpr bool PERM = true;
    const bf16_t* SGB; bf16_t* O;
    __device__ __forceinline__ void operator()(AccRef acc, const Unit& u, int wr, int wc, int fr, int fq) const {
        const int row0 = u.pm * BM + wr * 64 + fr, col0 = u.pn * HALF + wc * 32 + 8 * fq;
#pragma unroll
        EPI_ROWS { const size_t off = (size_t)(row0 + ai * HALF + m * 16) * DM + col0; const u32x2 s = *(const u32x2*)((const unsigned char*)SGB + off);
            const f32x4 v0 = acc[ai][0][m][0], v1 = acc[ai][0][m][1], g0 = acc[ai][1][m][0], g1 = acc[ai][1][m][1];
            float o[8];
#pragma unroll
            for (int e = 0; e < 4; ++e) { o[e] = v0[e] * fsigmoid(g0[e]); o[4 + e] = v1[e] * fsigmoid(g1[e]); }
            o[0] *= ub0(s.x); o[1] *= ub1(s.x); o[2] *= ub2(s.x); o[3] *= ub3(s.x); o[4] *= ub0(s.y); o[5] *= ub1(s.y); o[6] *= ub2(s.y); o[7] *= ub3(s.y);
            u32x4 w; w.x = cvt_pk_bf16(o[0], o[1]); w.y = cvt_pk_bf16(o[2], o[3]); w.z = cvt_pk_bf16(o[4], o[5]); w.w = cvt_pk_bf16(o[6], o[7]);
            st16(O + off, w); }
    }
};
struct EpiMerge {
    static constexpr bool PERM = true;
    const bf16_t* SGA; const bf16_t* Y2; bf16_t* O;
    __device__ __forceinline__ void operator()(AccRef acc, const Unit& u, int wr, int wc, int fr, int fq) const {
        const int row0 = u.pm * BM + wr * 64 + fr, col0 = u.pn * BM + wc * 32 + 8 * fq;
#pragma unroll
        EPI_ROWS {
#pragma unroll
            for (int bj = 0; bj < 2; ++bj) { const size_t off = (size_t)(row0 + ai * HALF + m * 16) * DM + col0 + bj * HALF;
                const u32x2 s = *(const u32x2*)((const unsigned char*)SGA + off); const u32x4 y = *(const u32x4*)(Y2 + off); const f32x4 v0 = acc[ai][bj][m][0], v1 = acc[ai][bj][m][1];
                u32x4 w; w.x = cvt_pk_bf16(ub0(s.x) * v0[0] + bflo(y.x), ub1(s.x) * v0[1] + bfhi(y.x)); w.y = cvt_pk_bf16(ub2(s.x) * v0[2] + bflo(y.y), ub3(s.x) * v0[3] + bfhi(y.y));
                w.z = cvt_pk_bf16(ub0(s.y) * v1[0] + bflo(y.z), ub1(s.y) * v1[1] + bfhi(y.z)); w.w = cvt_pk_bf16(ub2(s.y) * v1[2] + bflo(y.w), ub3(s.y) * v1[3] + bfhi(y.w));
                st16(O + off, w); } }
    }
};
template <bool XBASE> struct EpiResidT {
    static constexpr bool PERM = true;
    const float* base; bf16_t* HB; float* SSQ;
    __device__ __forceinline__ void operator()(AccRef acc, const Unit& u, int wr, int wc, int fr, int fq) const {
        const int row0 = u.pm * BM + wr * 64 + fr, col0 = u.pn * BM + wc * 32 + 8 * fq;
#pragma unroll
        EPI_ROWS { const int row = row0 + ai * HALF + m * 16; const size_t off = (size_t)row * DM + col0; float ss = 0.f;
#pragma unroll
            for (int bj = 0; bj < 2; ++bj) { const size_t o2 = off + bj * HALF; f32x4 h0, h1;
                if (XBASE) { h0 = *(const f32x4*)(base + o2) + acc[ai][bj][m][0]; h1 = *(const f32x4*)(base + o2 + 4) + acc[ai][bj][m][1]; }
                else { const u32x4 w = *(const u32x4*)(HB + o2); h0 = (f32x4){bflo(w.x), bfhi(w.x), bflo(w.y), bfhi(w.y)} + acc[ai][bj][m][0]; h1 = (f32x4){bflo(w.z), bfhi(w.z), bflo(w.w), bfhi(w.w)} + acc[ai][bj][m][1]; }
                u32x4 o; o.x = cvt_pk_bf16(h0[0], h0[1]); o.y = cvt_pk_bf16(h0[2], h0[3]); o.z = cvt_pk_bf16(h1[0], h1[1]); o.w = cvt_pk_bf16(h1[2], h1[3]); st16(HB + o2, o);
                if (XBASE) ss += ((h0[0] * h0[0] + h0[1] * h0[1]) + (h0[2] * h0[2] + h0[3] * h0[3])) + ((h1[0] * h1[0] + h1[1] * h1[1]) + (h1[2] * h1[2] + h1[3] * h1[3])); }
            if (XBASE) { ss += __shfl_xor(ss, 16); ss += __shfl_xor(ss, 32); if (fq == 0) SSQ[(size_t)row * 16 + u.pn * 4 + wc] = ss; } }
    }
};
struct EpiXq {
    static constexpr bool PERM = true;
    const float* SSQ; bf16_t* O;
    __device__ __forceinline__ void operator()(AccRef acc, const Unit& u, int wr, int wc, int fr, int fq) const {
        const int row0 = u.pm * BM + wr * 64 + fr, col0 = u.pn * BM + wc * 32 + 8 * fq;
#pragma unroll
        EPI_ROWS { const int row = row0 + ai * HALF + m * 16; const f32x4* sp = (const f32x4*)(SSQ + (size_t)row * 16);
            const f32x4 a = sp[0] + sp[1] + sp[2] + sp[3]; const float rs = __builtin_amdgcn_rsqf(((a[0] + a[1]) + (a[2] + a[3])) * (1.0f / DM) + RMS_EPS) * XSCALE;
            bf16_t* rowp = O + (size_t)row * XW + col0;
#pragma unroll
            for (int bj = 0; bj < 2; ++bj) { const f32x4 v0 = acc[ai][bj][m][0] * rs, v1 = acc[ai][bj][m][1] * rs;
                u32x4 w; w.x = cvt_pk_bf16(v0[0], v0[1]); w.y = cvt_pk_bf16(v0[2], v0[3]); w.z = cvt_pk_bf16(v1[0], v1[1]); w.w = cvt_pk_bf16(v1[2], v1[3]);
                st16(rowp + bj * HALF, w); } }
    }
};
struct EpiMoe1 {
    static constexpr bool PERM = true;
    const float* bgu; bf16_t* HID;
    __device__ __forceinline__ void operator()(AccRef acc, const Unit& u, int wr, int wc, int fr, int fq) const {
        const int rl0 = wr * 64 + fr, col0 = u.pn * HALF + wc * 32 + 8 * fq; const float* bg = bgu + (size_t)u.e * (2 * DFF) + col0;
        const f32x4 bg0 = *(const f32x4*)(bg), bg1 = *(const f32x4*)(bg + 4), bu0 = *(const f32x4*)(bg + DFF), bu1 = *(const f32x4*)(bg + DFF + 4);
#pragma unroll
        EPI_ROWS { const int rl = rl0 + ai * HALF + m * 16;
            const f32x4 g0 = acc[ai][0][m][0] + bg0, g1 = acc[ai][0][m][1] + bg1, p0 = acc[ai][1][m][0] + bu0, p1 = acc[ai][1][m][1] + bu1;
            float o[8];
#pragma unroll
            for (int e = 0; e < 4; ++e) { const float ga = fminf(g0[e], 7.0f), gb = fminf(g1[e], 7.0f), ua = fminf(fmaxf(p0[e], -7.0f), 7.0f), ub = fminf(fmaxf(p1[e], -7.0f), 7.0f);
                o[e] = (ua + 1.0f) * ga * fsigmoid(1.702f * ga); o[4 + e] = (ub + 1.0f) * gb * fsigmoid(1.702f * gb); }
            if (MOE2_FP8) { int w0 = 0, w1 = 0;
                w0 = __builtin_amdgcn_cvt_pk_fp8_f32(o[0], o[1], w0, false); w0 = __builtin_amdgcn_cvt_pk_fp8_f32(o[2], o[3], w0, true); w1 = __builtin_amdgcn_cvt_pk_fp8_f32(o[4], o[5], w1, false); w1 = __builtin_amdgcn_cvt_pk_fp8_f32(o[6], o[7], w1, true);
                *(u32x2*)((unsigned char*)HID + (size_t)(u.pm * BM + rl) * DFF + col0) = (u32x2){(unsigned)w0, (unsigned)w1}; }
            else { u32x4 w; w.x = cvt_pk_bf16(o[0], o[1]); w.y = cvt_pk_bf16(o[2], o[3]); w.z = cvt_pk_bf16(o[4], o[5]); w.w = cvt_pk_bf16(o[6], o[7]);
                st16(HID + (size_t)(u.pm * BM + rl) * DFF + col0, w); } }
    }
};
struct EpiMoe2 {
    static constexpr bool PERM = true;
    const float* bdn; const LAS int* tabD; const LAS float* tabG; bf16_t* Y;
    __device__ __forceinline__ void operator()(AccRef acc, const Unit& u, int wr, int wc, int fr, int fq) const {
        const int rl0 = wr * 64 + fr, col0 = u.pn * BM + wc * 32 + 8 * fq; const float* bd = bdn + (size_t)u.e * DM + col0;
        f32x4 bv[2][2];
#pragma unroll
        for (int bj = 0; bj < 2; ++bj)
#pragma unroll
            for (int n = 0; n < 2; ++n) bv[bj][n] = *(const f32x4*)(bd + bj * HALF + 4 * n);
#pragma unroll
        EPI_ROWS { const int rl = rl0 + ai * HALF + m * 16; const int dest = tabD[u.ui * 256 + rl];
            if (dest >= 0) { const float gt = tabG[u.ui * 256 + rl]; bf16_t* rowp = Y + (size_t)(u.pm * BM + rl) * DM + col0;
#pragma unroll
                for (int bj = 0; bj < 2; ++bj) { const f32x4 v0 = (acc[ai][bj][m][0] + bv[bj][0]) * gt, v1 = (acc[ai][bj][m][1] + bv[bj][1]) * gt;
                    if (Y_FP8) { const float ys = (float)(1 << Y_SHIFT); int w0 = 0, w1 = 0;
                        w0 = __builtin_amdgcn_cvt_pk_fp8_f32(v0[0] * ys, v0[1] * ys, w0, false); w0 = __builtin_amdgcn_cvt_pk_fp8_f32(v0[2] * ys, v0[3] * ys, w0, true);
                        w1 = __builtin_amdgcn_cvt_pk_fp8_f32(v1[0] * ys, v1[1] * ys, w1, false); w1 = __builtin_amdgcn_cvt_pk_fp8_f32(v1[2] * ys, v1[3] * ys, w1, true);
                        *(u32x2*)((unsigned char*)Y + (size_t)(u.pm * BM + rl) * DM + col0 + bj * HALF) = (u32x2){(unsigned)w0, (unsigned)w1}; }
                    else { u32x4 w; w.x = cvt_pk_bf16(v0[0], v0[1]); w.y = cvt_pk_bf16(v0[2], v0[3]); w.z = cvt_pk_bf16(v1[0], v1[1]); w.w = cvt_pk_bf16(v1[2], v1[3]);
                        st16(rowp + bj * HALF, w); } } } }
    }
};
}

struct MoeOrder {
    pg8::PatchOrder P; const LAS int* pref; int rev;
    __device__ __forceinline__ bool next(int i, pg8::Unit& u) const {
        if (!P.next(i, u)) return false;
        if (rev) u.pm = P.nM - 1 - u.pm;
        int e = 0;
#pragma unroll 1
        for (int k = 1; k < NE; ++k) e += (pref[k] <= u.pm) ? 1 : 0;
        u.e = e; u.mi = u.pm - pref[e]; return true;
    }
};

namespace attn_body {
using bf16=__hip_bfloat16;
using bf16x8=__attribute__((ext_vector_type(8)))short;
using s16x4=__attribute__((ext_vector_type(4)))short;
using f32x16=__attribute__((ext_vector_type(16)))float;
using u32x4=__attribute__((ext_vector_type(4)))unsigned;
constexpr int BATCH=4,NHEAD=8,SEQ=8192,D=64,DM=NHEAD*D;
constexpr int NW=8,QBLK=32,QB=QBLK*NW,KVBLK=64,NQB=SEQ/QB;
constexpr int ATTN_PITCH=DM, ATTN_UNIT_ROWS=QB;
__device__ __forceinline__ int crow(int r,int hi){return (r&3)+8*(r>>2)+4*hi;}
#define SBAR() __builtin_amdgcn_sched_barrier(0)
__device__ __forceinline__ void cmask(f32x16&p0,f32x16&p1,int jb,int qrel,int hi){
  const float NEG=-INFINITY; int kb=64*jb+4*hi;
  #pragma unroll
  for(int r=0;r<16;++r){int kv=kb+(r&3)+8*(r>>2); if(kv>qrel)p0[r]=NEG; if(kv+32>qrel)p1[r]=NEG;}
}

constexpr int NSLOT=4, SLOTB=8192;
constexpr int LDS_K=0, LDS_V=NSLOT*SLOTB, LDS_WS=2*NSLOT*SLOTB, LDS_OST=LDS_WS+NW*64*4, LDS_KM=LDS_OST+NW*4096, LDS_SEL=LDS_KM+32*64*4, LDS_DST=LDS_SEL+1024, LDS_BYTES=LDS_DST+1024;
constexpr float C2=0.125f*1.4426950408889634f;
__device__ __forceinline__ void glds16(const void*gsrc,unsigned lds_dst){unsigned keep;
  asm volatile("s_mov_b32 %0, m0\n\ts_mov_b32 m0, %2\n\ts_nop 0\n\tglobal_load_lds_dwordx4 %1, off\n\ts_mov_b32 m0, %0":"=&s"(keep):"v"(gsrc),"s"(lds_dst):"memory");}
__device__ __forceinline__ float max3f(float a,float b,float c){float r;asm("v_max3_f32 %0, %1, %2, %3":"=v"(r):"v"(a),"v"(b),"v"(c));return r;}
__device__ __forceinline__ float max2f(float a,float b){float r;asm("v_max_f32_e32 %0, %1, %2":"=v"(r):"v"(a),"v"(b));return r;}
__device__ __forceinline__ float fadd_s(float a,float b){float r;asm("v_add_f32_e32 %0, %1, %2":"=v"(r):"v"(a),"v"(b));return r;}
__device__ __forceinline__ float fsub_s(float a,float b){float r;asm("v_sub_f32_e32 %0, %1, %2":"=v"(r):"v"(a),"v"(b));return r;}
typedef float f32x2_t __attribute__((ext_vector_type(2))); typedef __bf16 bf16x2_t __attribute__((ext_vector_type(2)));
__device__ __forceinline__ unsigned cvtpk_s(float lo,float hi){f32x2_t v={lo,hi};bf16x2_t b=__builtin_convertvector(v,bf16x2_t);return __builtin_bit_cast(unsigned,b);}
#define WAIT_BAR(N) asm volatile("s_waitcnt vmcnt(" #N ") lgkmcnt(0)\n\ts_barrier":::"memory")

__device__ __forceinline__ void qkt(f32x16&p0,f32x16&p1,const char*Kslot,const bf16x8*qr,const f32x16&negm,int r32,int hi){
  const char*kb=Kslot+hi*1024+r32*16;
  #pragma unroll
  for(int d0=0;d0<4;++d0){
    const bf16x8 b0=*reinterpret_cast<const bf16x8*>(kb+d0*2048);
    const bf16x8 b1=*reinterpret_cast<const bf16x8*>(kb+d0*2048+512);
    if(d0==0){p0=__builtin_amdgcn_mfma_f32_32x32x16_bf16(b0,qr[0],negm,0,0,0);p1=__builtin_amdgcn_mfma_f32_32x32x16_bf16(b1,qr[0],negm,0,0,0);}
    else{p0=__builtin_amdgcn_mfma_f32_32x32x16_bf16(b0,qr[d0],p0,0,0,0);p1=__builtin_amdgcn_mfma_f32_32x32x16_bf16(b1,qr[d0],p1,0,0,0);}}
}
typedef __attribute__((address_space(3))) const char* lds_cptr;
typedef short v4i16_t __attribute__((ext_vector_type(4)));
__device__ __forceinline__ void kload8(bf16x8*kf,lds_cptr kp){
  kf[0]=*(const __attribute__((address_space(3))) bf16x8*)(kp);      kf[1]=*(const __attribute__((address_space(3))) bf16x8*)(kp+512);
  kf[2]=*(const __attribute__((address_space(3))) bf16x8*)(kp+2048); kf[3]=*(const __attribute__((address_space(3))) bf16x8*)(kp+2560);
  kf[4]=*(const __attribute__((address_space(3))) bf16x8*)(kp+4096); kf[5]=*(const __attribute__((address_space(3))) bf16x8*)(kp+4608);
  kf[6]=*(const __attribute__((address_space(3))) bf16x8*)(kp+6144); kf[7]=*(const __attribute__((address_space(3))) bf16x8*)(kp+6656);
}
__device__ __forceinline__ void kload2(bf16x8*kf,lds_cptr kp,int j){ kf[2*j]=*(const __attribute__((address_space(3))) bf16x8*)(kp+j*2048); kf[2*j+1]=*(const __attribute__((address_space(3))) bf16x8*)(kp+j*2048+512); }
__device__ __forceinline__ s16x4 vtr(lds_cptr p){ return __builtin_bit_cast(s16x4,__builtin_amdgcn_ds_read_tr16_b64_v4i16((__attribute__((address_space(3))) v4i16_t*)p)); }
__device__ __forceinline__ float rowmax(const f32x16&p0,const f32x16&p1){
  float a=max3f(p0[0],p0[1],p1[0]),b=max3f(p0[2],p0[3],p1[1]);a=max3f(a,p1[2],p1[3]);
  #pragma unroll
  for(int r=4;r<16;r+=4){a=max3f(a,p0[r],p0[r+1]);b=max3f(b,p0[r+2],p0[r+3]);a=max3f(a,p1[r],p1[r+1]);b=max3f(b,p1[r+2],p1[r+3]);}
  const float m=max2f(a,b);
  auto rr=__builtin_amdgcn_permlane32_swap(__float_as_uint(m),__float_as_uint(m),false,false);
  return max2f(__uint_as_float(rr[0]),__uint_as_float(rr[1]));
}
__device__ __forceinline__ void pv(f32x16*o,int vb,bf16x8 pa0,bf16x8 pa1,bf16x8 pa2,bf16x8 pa3){
  #pragma unroll
  for(int d0=0;d0<2;++d0){s16x4 lo[4],hi[4];
    #pragma unroll
    for(int ks=0;ks<4;++ks){
      asm volatile("ds_read_b64_tr_b16 %0,%1 offset:%c2":"=&v"(lo[ks]):"v"(vb),"i"(d0*4096+ks*1024):"memory");
      asm volatile("ds_read_b64_tr_b16 %0,%1 offset:%c2":"=&v"(hi[ks]):"v"(vb),"i"(d0*4096+ks*1024+512):"memory");}
    asm volatile("s_waitcnt lgkmcnt(0)":::"memory");SBAR();
    #define PK(k) (bf16x8){lo[k][0],lo[k][1],lo[k][2],lo[k][3],hi[k][0],hi[k][1],hi[k][2],hi[k][3]}
    o[d0]=__builtin_amdgcn_mfma_f32_32x32x16_bf16(pa0,PK(0),o[d0],0,0,0);
    o[d0]=__builtin_amdgcn_mfma_f32_32x32x16_bf16(pa1,PK(1),o[d0],0,0,0);
    o[d0]=__builtin_amdgcn_mfma_f32_32x32x16_bf16(pa2,PK(2),o[d0],0,0,0);
    o[d0]=__builtin_amdgcn_mfma_f32_32x32x16_bf16(pa3,PK(3),o[d0],0,0,0);
    #undef PK
  }
}

#ifndef ATTN_STORE16
#define ATTN_STORE16(p,v) (*(u32x4*)(p)=(v))
#endif
template<int THRL> __device__ __forceinline__ void attn_unit(int b,int h,int qb,const bf16*Q,const bf16*__restrict__ K,const bf16*__restrict__ V,bf16*O,char*shm){
  const int tid=threadIdx.x,lane=tid&63,r32=lane&31,hi=lane>>5; const int wid=__builtin_amdgcn_readfirstlane(tid>>6);
  const long rowbase=(long)b*SEQ; const int q0=qb*QB;
  const bf16*Qw=Q+(rowbase+q0+wid*QBLK)*DM+h*D;
  const bf16*Kh=K+rowbase*DM+h*D,*Vh=V+rowbase*DM+h*D;
  const unsigned lds0=(unsigned)(uintptr_t)shm;
  float*wsf=(float*)(shm+LDS_WS)+wid*64;
  const bf16*ksrc=Kh+(long)lane*DM+wid*8;
  const bf16*vsrc=Vh+(long)(16*(wid&3)+(lane>>2))*DM+(wid>>2)*32+(lane&3)*8;
  const unsigned kdst=lds0+LDS_K+wid*1024, vdst=lds0+LDS_V+wid*1024;
  #define DMA_K(t,slot) glds16(ksrc+(long)(t)*KVBLK*DM,(unsigned)__builtin_amdgcn_readfirstlane(kdst+(slot)))
  #define DMA_V(t,slot) glds16(vsrc+(long)(t)*KVBLK*DM,(unsigned)__builtin_amdgcn_readfirstlane(vdst+(slot)))
  const int vb0=(int)(lds0+LDS_V)+((lane>>4)&1)*32+(lane&3)*8+(4*hi+((lane&15)>>2))*64;
  const char*Kbase=shm+LDS_K; bf16x8 kf[8];
  const lds_cptr shm3=(lds_cptr)shm; const lds_cptr kp0=shm3+LDS_K+hi*1024+r32*16; const lds_cptr vp0=shm3+LDS_V+((lane>>4)&1)*32+(lane&3)*8+(4*hi+((lane&15)>>2))*64;
  const int NT=(q0+QB)/KVBLK;
  DMA_K(0,0);DMA_V(0,0);DMA_K(1,SLOTB);
  bf16x8 qr[4];
  #pragma unroll
  for(int d0=0;d0<4;++d0)qr[d0]=*reinterpret_cast<const bf16x8*>(&Qw[(long)r32*DM+d0*16+hi*8]);
  { int lp_=lane; asm volatile("":"+v"(lp_)); const int r32p=lp_&31, hip=lp_>>5;
    unsigned sel=0u; const __attribute__((address_space(3))) float*km=(const __attribute__((address_space(3))) float*)((__attribute__((address_space(3))) const char*)shm+LDS_KM); float g0=-3e38f,g1=-3e38f,g2=-3e38f; int s0=-1,s1=-1,s2=-1;
    for(int j=0;j<qb;++j){ float g=0.f;
      #pragma unroll
      for(int d0=0;d0<4;++d0){
        #pragma unroll
        for(int e=0;e<8;++e)g+=__builtin_bit_cast(float,((unsigned)(unsigned short)qr[d0][e])<<16)*km[j*64+16*d0+8*hip+e];}
      g+=__shfl_xor(g,32);
      if(g>g0){g2=g1;s2=s1;g1=g0;s1=s0;g0=g;s0=j;}else if(g>g1){g2=g1;s2=s1;g1=g;s1=j;}else if(g>g2){g2=g;s2=j;} }
    if(s0>=0)sel|=1u<<s0; if(s1>=0)sel|=1u<<s1; if(s2>=0)sel|=1u<<s2;
    if(hip==0)((__attribute__((address_space(3))) unsigned*)((__attribute__((address_space(3))) char*)shm+LDS_SEL))[wid*32+r32p]=sel; asm volatile("s_waitcnt lgkmcnt(0)":::"memory"); }
  float mhat=0.f,l_reg=0.f;f32x16 o[2];o[0]=f32x16{};o[1]=f32x16{};f32x16 negm=f32x16{};asm volatile("":"+v"(negm));
  const int qrel=wid*QBLK+r32;
  #define BMASK(P0,P1,t) do{}while(0)
  #define CMASK(P0,P1,t) do{int jb_=(t)-(NT-4); if(jb_>=0)cmask(P0,P1,jb_,qrel,hi); else BMASK(P0,P1,t);}while(0)
  bool resc=false;
  #define START(P0,P1) do{ const float rm=rowmax(P0,P1); resc=false; \
    { const float dl=__builtin_fmaxf(rm,-64.f); mhat=fadd_s(mhat,dl); \
      _Pragma("unroll") for(int r=0;r<16;++r){P0[r]=fsub_s(P0[r],dl);P1[r]=fsub_s(P1[r],dl);} \
      _Pragma("unroll") for(int r=0;r<16;++r)negm[r]=-mhat; asm volatile("":"+v"(negm)); } \
    _Pragma("unroll") for(int r=0;r<16;++r)P0[r]=__builtin_amdgcn_exp2f(P0[r]); }while(0)
  #define RESC() do{ if(resc){ asm volatile("s_waitcnt lgkmcnt(0)":::"memory"); \
      _Pragma("unroll") for(int d_=0;d_<2;++d_) _Pragma("unroll") for(int r=0;r<16;++r)o[d_][r]*=wsf[crow(r,hi)]; } }while(0)
  f32x16 pA0,pA1,pB0,pB1;
  int sl_prev=0,sl_cur=0,sl_next=SLOTB;
  #define ROT() do{sl_prev=sl_cur;sl_cur=sl_next;sl_next=(sl_next==(NSLOT-1)*SLOTB)?0:sl_next+SLOTB;}while(0)
  DMA_K(2,2*SLOTB);
  WAIT_BAR(3);
  qkt(pA0,pA1,Kbase,qr,negm,r32,hi);asm volatile("s_nop 15\n\ts_nop 7":"+v"(pA0),"+v"(pA1));CMASK(pA0,pA1,0);
  START(pA0,pA1);
  _Pragma("unroll") for(int r=0;r<16;++r)pA1[r]=__builtin_amdgcn_exp2f(pA1[r]);
  WAIT_BAR(0);
  DMA_K(3,0);DMA_V(1,SLOTB);
  ROT();
  kload8(kf,kp0+sl_cur);
  WAIT_BAR(2);
  s16x4 vlo[8],vhi[8]; u32x4 pw0,pw1,pw2,pw3;
  #define PKW(P,B) (keep_?cvtpk_s(P[B],P[B+1]):0u)
  #define PAF(k) __builtin_bit_cast(bf16x8,pw##k)
  #define VFR(i) (bf16x8){vlo[i][0],vlo[i][1],vlo[i][2],vlo[i][3],vhi[i][0],vhi[i][1],vhi[i][2],vhi[i][3]}
  #define PIN(x) asm volatile("":"+v"(x))
  #define MX3(a,b,c) __builtin_fmaxf(__builtin_fmaxf((a),(b)),(c))
  #define GAPA(MF,A0,A1,A2,A3,W0,W1,PW) do{ MF; sacc+=A0; sacc+=A1; sacc+=A2; sacc+=A3; PIN(sacc); W0; W1; PIN(PW); SBAR(); }while(0)
  #define EX(v) __builtin_amdgcn_exp2f(v)
  #define GAPB(MF,X,B) do{ MF; X[B]=EX(X[B]); X[B+1]=EX(X[B+1]); X[B+2]=EX(X[B+2]); X[B+3]=EX(X[B+3]); PIN(X); SBAR(); }while(0)
  #define VRD(i) do{ vlo[i]=vtr(vp_+(((i)>>2)*4096+((i)&3)*1024)); vhi[i]=vtr(vp_+(((i)>>2)*4096+((i)&3)*1024+512)); }while(0)
  #define KRD(G,j) do{ if(G){ kload2(kf,kp0+sl_next,j); SBAR(); } }while(0)
  #define STEP(C0,C1,P0,P1,t,GK,GV,GL) do{ SBAR(); \
    int q_=qrel; asm volatile("":"+v"(q_)); const unsigned selw_=((const volatile __attribute__((address_space(3))) unsigned*)((__attribute__((address_space(3))) const char*)shm+LDS_SEL))[q_]; \
    const bool keep_=((t)-1>=NT-4)||((selw_>>(((t)-1)>>2))&1u); \
    const lds_cptr vp_=vp0+sl_prev; \
    VRD(0); SBAR(); float sacc=(P0[0]+P0[1]); \
    GAPA(C0=__builtin_amdgcn_mfma_f32_32x32x16_bf16(kf[0],qr[0],negm,0,0,0), P0[2],P0[3],P0[4],P0[5],     pw0[0]=PKW(P0,0), pw0[1]=PKW(P0,2), pw0); \
    VRD(4); SBAR(); GAPA(C1=__builtin_amdgcn_mfma_f32_32x32x16_bf16(kf[1],qr[0],negm,0,0,0), P0[6],P0[7],P0[8],P0[9],     pw0[2]=PKW(P0,4), pw0[3]=PKW(P0,6), pw0); \
    VRD(1); SBAR(); GAPA(C0=__builtin_amdgcn_mfma_f32_32x32x16_bf16(kf[2],qr[1],C0,0,0,0),   P0[10],P0[11],P0[12],P0[13], pw1[0]=PKW(P0,8), pw1[1]=PKW(P0,10), pw1); \
    VRD(5); SBAR(); GAPA(C1=__builtin_amdgcn_mfma_f32_32x32x16_bf16(kf[3],qr[1],C1,0,0,0),   P0[14],P0[15],P1[0],P1[1],   pw1[2]=PKW(P0,12),pw1[3]=PKW(P0,14), pw1); \
    VRD(2); SBAR(); GAPA(C0=__builtin_amdgcn_mfma_f32_32x32x16_bf16(kf[4],qr[2],C0,0,0,0),   P1[2],P1[3],P1[4],P1[5],     pw2[0]=PKW(P1,0), pw2[1]=PKW(P1,2), pw2); \
    VRD(6); SBAR(); GAPA(C1=__builtin_amdgcn_mfma_f32_32x32x16_bf16(kf[5],qr[2],C1,0,0,0),   P1[6],P1[7],P1[8],P1[9],     pw2[2]=PKW(P1,4), pw2[3]=PKW(P1,6), pw2); \
    VRD(3); SBAR(); GAPA(C0=__builtin_amdgcn_mfma_f32_32x32x16_bf16(kf[6],qr[3],C0,0,0,0),   P1[10],P1[11],P1[12],P1[13], pw3[0]=PKW(P1,8), pw3[1]=PKW(P1,10), pw3); \
    VRD(7); SBAR(); GAPA(C1=__builtin_amdgcn_mfma_f32_32x32x16_bf16(kf[7],qr[3],C1,0,0,0),   P1[14],P1[15],0.f,0.f,       pw3[2]=PKW(P1,12),pw3[3]=PKW(P1,14), pw3); \
    l_reg+=keep_?sacc:0.f; \
    if(GK){DMA_K((t)+3,sl_cur);} if(GV){DMA_V((t)+1,sl_next);} \
    CMASK(C0,C1,t); \
    { float a=MX3(C0[0],C0[1],C1[0]),b=MX3(C0[2],C0[3],C1[1]); a=MX3(a,C1[2],C1[3]); \
      _Pragma("unroll") for(int r=4;r<16;r+=4){a=MX3(a,C0[r],C0[r+1]);b=MX3(b,C0[r+2],C0[r+3]);a=MX3(a,C1[r],C1[r+1]);b=MX3(b,C1[r+2],C1[r+3]);} \
      float rm=__builtin_fmaxf(a,b); { auto rr=__builtin_amdgcn_permlane32_swap(__float_as_uint(rm),__float_as_uint(rm),false,false); rm=__builtin_fmaxf(__uint_as_float(rr[0]),__uint_as_float(rr[1])); } \
      resc=false; \
      if(__builtin_expect(__any(rm>(float)THRL),0)){ const float dl=__builtin_fmaxf(rm,0.f); mhat+=dl; \
        _Pragma("unroll") for(int r=0;r<16;++r){C0[r]-=dl;C1[r]-=dl;} \
        _Pragma("unroll") for(int r=0;r<16;++r)negm[r]=-mhat; asm volatile("":"+v"(negm)); \
        const float f=__builtin_amdgcn_exp2f(-dl); l_reg*=f; if(hi==0)wsf[r32]=f; resc=true; } } \
    SBAR(); \
    GAPB(o[0]=__builtin_amdgcn_mfma_f32_32x32x16_bf16(PAF(0),VFR(0),o[0],0,0,0), C0,0); \
    GAPB(o[1]=__builtin_amdgcn_mfma_f32_32x32x16_bf16(PAF(0),VFR(4),o[1],0,0,0), C0,4); \
    KRD(GL,0); GAPB(o[0]=__builtin_amdgcn_mfma_f32_32x32x16_bf16(PAF(1),VFR(1),o[0],0,0,0), C0,8); \
    KRD(GL,1); GAPB(o[1]=__builtin_amdgcn_mfma_f32_32x32x16_bf16(PAF(1),VFR(5),o[1],0,0,0), C0,12); \
    KRD(GL,2); GAPB(o[0]=__builtin_amdgcn_mfma_f32_32x32x16_bf16(PAF(2),VFR(2),o[0],0,0,0), C1,0); \
    KRD(GL,3); GAPB(o[1]=__builtin_amdgcn_mfma_f32_32x32x16_bf16(PAF(2),VFR(6),o[1],0,0,0), C1,4); \
    GAPB(o[0]=__builtin_amdgcn_mfma_f32_32x32x16_bf16(PAF(3),VFR(3),o[0],0,0,0), C1,8); \
    GAPB(o[1]=__builtin_amdgcn_mfma_f32_32x32x16_bf16(PAF(3),VFR(7),o[1],0,0,0), C1,12); \
    }while(0)
  int t=1;
  for(;t+5<NT;t+=2){
    STEP(pB0,pB1,pA0,pA1,t,true,true,true);     WAIT_BAR(2); RESC(); ROT();
    STEP(pA0,pA1,pB0,pB1,t+1,true,true,true);   WAIT_BAR(2); RESC(); ROT();
  }
  #define ENDW(tt) do{ if((tt)+3<NT){WAIT_BAR(2);} else if((tt)+2<NT){WAIT_BAR(1);} else {WAIT_BAR(0);} }while(0)
  for(;t+1<NT;t+=2){
    STEP(pB0,pB1,pA0,pA1,t,(t+3<NT),(t+1<NT),(t+1<NT));       ENDW(t);   RESC(); ROT();
    STEP(pA0,pA1,pB0,pB1,t+1,(t+4<NT),(t+2<NT),(t+2<NT));     ENDW(t+1); RESC(); ROT();
  }
  STEP(pB0,pB1,pA0,pA1,NT-1,false,false,false); RESC();
  { const bool keep_=true; float sacc=pB0[0]+pB0[1]; _Pragma("unroll") for(int r=2;r<16;++r)sacc+=pB0[r]; _Pragma("unroll") for(int r=0;r<16;++r)sacc+=pB1[r]; l_reg+=sacc;
    pw0=(u32x4){PKW(pB0,0),PKW(pB0,2),PKW(pB0,4),PKW(pB0,6)};pw1=(u32x4){PKW(pB0,8),PKW(pB0,10),PKW(pB0,12),PKW(pB0,14)};pw2=(u32x4){PKW(pB1,0),PKW(pB1,2),PKW(pB1,4),PKW(pB1,6)};pw3=(u32x4){PKW(pB1,8),PKW(pB1,10),PKW(pB1,12),PKW(pB1,14)};
    SBAR(); pv(o,vb0+sl_cur,PAF(0),PAF(1),PAF(2),PAF(3)); }
  #undef PKW
  #undef PAF
  #undef VFR
  #undef PIN
  #undef MX3
  #undef GAPA
  #undef GAPB
  #undef EX
  #undef VRD
  #undef KRD
  #undef STEP
  #undef ENDW
  {auto rr=__builtin_amdgcn_permlane32_swap(__float_as_uint(l_reg),__float_as_uint(l_reg),false,false);l_reg=__uint_as_float(rr[0])+__uint_as_float(rr[1]);}
  if(hi==0)wsf[32+r32]=l_reg;asm volatile("s_waitcnt lgkmcnt(0)":::"memory");
  float rli[16];
  #pragma unroll
  for(int r=0;r<16;++r)rli[r]=__builtin_amdgcn_rcpf(wsf[32+crow(r,hi)]);
  bf16*Ow=O+(rowbase+q0+wid*QBLK)*DM+h*D;
  { bf16*stg=(bf16*)(shm+LDS_OST)+wid*2048;
    #pragma unroll
    for(int r=0;r<16;++r){const int orow=crow(r,hi);
      #pragma unroll
      for(int d0=0;d0<2;++d0)stg[orow*64+d0*32+r32]=__float2bfloat16(o[d0][r]*rli[r]);}
    asm volatile("s_waitcnt lgkmcnt(0)":::"memory");
    #pragma unroll
    for(int i=0;i<4;++i){const int row=i*8+(lane>>3),ch=lane&7; const u32x4 v=*(const u32x4*)(stg+row*64+ch*8); ATTN_STORE16(Ow+(long)row*DM+ch*8,v);} }
  asm volatile("s_waitcnt lgkmcnt(0)\n\ts_barrier":::"memory");
  #undef DMA_K
  #undef DMA_V
  #undef CMASK
  #undef BMASK
  #undef START
  #undef RESC
  #undef ROT
}
template<int THRL> __device__ __forceinline__ void moba_unit4(const bf16*Qrow,const bf16*__restrict__ Kh,const bf16*__restrict__ Vh,bool causal,int dest,bf16*PO,float*PML,char*shm){
  int tid_=threadIdx.x; asm volatile("":"+v"(tid_)); const int tid=tid_,lane=tid&63,r32=lane&31,hi=lane>>5; const int wid=__builtin_amdgcn_readfirstlane(tid>>6);
  const unsigned lds0=(unsigned)(uintptr_t)shm;
  float*wsf=(float*)(shm+LDS_WS)+wid*64;
  const bf16*ksrc=Kh+(long)lane*DM+wid*8;
  const bf16*vsrc=Vh+(long)(16*(wid&3)+(lane>>2))*DM+(wid>>2)*32+(lane&3)*8;
  const unsigned kdst=lds0+LDS_K+wid*1024, vdst=lds0+LDS_V+wid*1024;
  #define DMA_K(t,slot) glds16(ksrc+(long)(t)*KVBLK*DM,(unsigned)__builtin_amdgcn_readfirstlane(kdst+(slot)))
  #define DMA_V(t,slot) glds16(vsrc+(long)(t)*KVBLK*DM,(unsigned)__builtin_amdgcn_readfirstlane(vdst+(slot)))
  const int vb0=(int)(lds0+LDS_V)+((lane>>4)&1)*32+(lane&3)*8+(4*hi+((lane&15)>>2))*64;
  const char*Kbase=shm+LDS_K; bf16x8 kf[8];
  const lds_cptr shm3=(lds_cptr)shm; const lds_cptr kp0=shm3+LDS_K+hi*1024+r32*16; const lds_cptr vp0=shm3+LDS_V+((lane>>4)&1)*32+(lane&3)*8+(4*hi+((lane&15)>>2))*64;
  constexpr int NT=4;
  DMA_K(0,0);DMA_V(0,0);DMA_K(1,SLOTB);
  bf16x8 qr[4];
  #pragma unroll
  for(int d0=0;d0<4;++d0)qr[d0]=*reinterpret_cast<const bf16x8*>(Qrow+d0*16+hi*8);
  float mhat=0.f,l_reg=0.f;f32x16 o[2];o[0]=f32x16{};o[1]=f32x16{};f32x16 negm=f32x16{};asm volatile("":"+v"(negm));
  const int qrel=wid*QBLK+r32;
  #define BMASK(P0,P1,t) do{}while(0)
  #define CMASK(P0,P1,t) do{ if(causal)cmask(P0,P1,(t),qrel,hi); }while(0)
  bool resc=false;
  #define START(P0,P1) do{ const float rm=rowmax(P0,P1); resc=false; \
    { const float dl=__builtin_fmaxf(rm,-64.f); mhat=fadd_s(mhat,dl); \
      _Pragma("unroll") for(int r=0;r<16;++r){P0[r]=fsub_s(P0[r],dl);P1[r]=fsub_s(P1[r],dl);} \
      _Pragma("unroll") for(int r=0;r<16;++r)negm[r]=-mhat; asm volatile("":"+v"(negm)); } \
    _Pragma("unroll") for(int r=0;r<16;++r)P0[r]=__builtin_amdgcn_exp2f(P0[r]); }while(0)
  #define RESC() do{ if(resc){ asm volatile("s_waitcnt lgkmcnt(0)":::"memory"); \
      _Pragma("unroll") for(int d_=0;d_<2;++d_) _Pragma("unroll") for(int r=0;r<16;++r)o[d_][r]*=wsf[crow(r,hi)]; } }while(0)
  f32x16 pA0,pA1,pB0,pB1;
  int sl_prev=0,sl_cur=0,sl_next=SLOTB;
  #define ROT() do{sl_prev=sl_cur;sl_cur=sl_next;sl_next=(sl_next==(NSLOT-1)*SLOTB)?0:sl_next+SLOTB;}while(0)
  DMA_K(2,2*SLOTB);
  WAIT_BAR(3);
  qkt(pA0,pA1,Kbase,qr,negm,r32,hi);asm volatile("s_nop 15\n\ts_nop 7":"+v"(pA0),"+v"(pA1));CMASK(pA0,pA1,0);
  START(pA0,pA1);
  _Pragma("unroll") for(int r=0;r<16;++r)pA1[r]=__builtin_amdgcn_exp2f(pA1[r]);
  WAIT_BAR(0);
  DMA_K(3,0);DMA_V(1,SLOTB);
  ROT();
  kload8(kf,kp0+sl_cur);
  WAIT_BAR(2);
  s16x4 vlo[8],vhi[8]; u32x4 pw0,pw1,pw2,pw3;
  #define PKW(P,B) (keep_?cvtpk_s(P[B],P[B+1]):0u)
  #define PAF(k) __builtin_bit_cast(bf16x8,pw##k)
  #define VFR(i) (bf16x8){vlo[i][0],vlo[i][1],vlo[i][2],vlo[i][3],vhi[i][0],vhi[i][1],vhi[i][2],vhi[i][3]}
  #define PIN(x) asm volatile("":"+v"(x))
  #define MX3(a,b,c) __builtin_fmaxf(__builtin_fmaxf((a),(b)),(c))
  #define GAPA(MF,A0,A1,A2,A3,W0,W1,PW) do{ MF; sacc+=A0; sacc+=A1; sacc+=A2; sacc+=A3; PIN(sacc); W0; W1; PIN(PW); SBAR(); }while(0)
  #define EX(v) __builtin_amdgcn_exp2f(v)
  #define GAPB(MF,X,B) do{ MF; X[B]=EX(X[B]); X[B+1]=EX(X[B+1]); X[B+2]=EX(X[B+2]); X[B+3]=EX(X[B+3]); PIN(X); SBAR(); }while(0)
  #define VRD(i) do{ vlo[i]=vtr(vp_+(((i)>>2)*4096+((i)&3)*1024)); vhi[i]=vtr(vp_+(((i)>>2)*4096+((i)&3)*1024+512)); }while(0)
  #define KRD(G,j) do{ if(G){ kload2(kf,kp0+sl_next,j); SBAR(); } }while(0)
  #define STEP(C0,C1,P0,P1,t,GK,GV,GL) do{ SBAR(); \
    const bool keep_=true; \
    const lds_cptr vp_=vp0+sl_prev; \
    VRD(0); SBAR(); float sacc=(P0[0]+P0[1]); \
    GAPA(C0=__builtin_amdgcn_mfma_f32_32x32x16_bf16(kf[0],qr[0],negm,0,0,0), P0[2],P0[3],P0[4],P0[5],     pw0[0]=PKW(P0,0), pw0[1]=PKW(P0,2), pw0); \
    VRD(4); SBAR(); GAPA(C1=__builtin_amdgcn_mfma_f32_32x32x16_bf16(kf[1],qr[0],negm,0,0,0), P0[6],P0[7],P0[8],P0[9],     pw0[2]=PKW(P0,4), pw0[3]=PKW(P0,6), pw0); \
    VRD(1); SBAR(); GAPA(C0=__builtin_amdgcn_mfma_f32_32x32x16_bf16(kf[2],qr[1],C0,0,0,0),   P0[10],P0[11],P0[12],P0[13], pw1[0]=PKW(P0,8), pw1[1]=PKW(P0,10), pw1); \
    VRD(5); SBAR(); GAPA(C1=__builtin_amdgcn_mfma_f32_32x32x16_bf16(kf[3],qr[1],C1,0,0,0),   P0[14],P0[15],P1[0],P1[1],   pw1[2]=PKW(P0,12),pw1[3]=PKW(P0,14), pw1); \
    VRD(2); SBAR(); GAPA(C0=__builtin_amdgcn_mfma_f32_32x32x16_bf16(kf[4],qr[2],C0,0,0,0),   P1[2],P1[3],P1[4],P1[5],     pw2[0]=PKW(P1,0), pw2[1]=PKW(P1,2), pw2); \
    VRD(6); SBAR(); GAPA(C1=__builtin_amdgcn_mfma_f32_32x32x16_bf16(kf[5],qr[2],C1,0,0,0),   P1[6],P1[7],P1[8],P1[9],     pw2[2]=PKW(P1,4), pw2[3]=PKW(P1,6), pw2); \
    VRD(3); SBAR(); GAPA(C0=__builtin_amdgcn_mfma_f32_32x32x16_bf16(kf[6],qr[3],C0,0,0,0),   P1[10],P1[11],P1[12],P1[13], pw3[0]=PKW(P1,8), pw3[1]=PKW(P1,10), pw3); \
    VRD(7); SBAR(); GAPA(C1=__builtin_amdgcn_mfma_f32_32x32x16_bf16(kf[7],qr[3],C1,0,0,0),   P1[14],P1[15],0.f,0.f,       pw3[2]=PKW(P1,12),pw3[3]=PKW(P1,14), pw3); \
    l_reg+=keep_?sacc:0.f; \
    if(GK){DMA_K((t)+3,sl_cur);} if(GV){DMA_V((t)+1,sl_next);} \
    CMASK(C0,C1,t); \
    { float a=MX3(C0[0],C0[1],C1[0]),b=MX3(C0[2],C0[3],C1[1]); a=MX3(a,C1[2],C1[3]); \
      _Pragma("unroll") for(int r=4;r<16;r+=4){a=MX3(a,C0[r],C0[r+1]);b=MX3(b,C0[r+2],C0[r+3]);a=MX3(a,C1[r],C1[r+1]);b=MX3(b,C1[r+2],C1[r+3]);} \
      float rm=__builtin_fmaxf(a,b); { auto rr=__builtin_amdgcn_permlane32_swap(__float_as_uint(rm),__float_as_uint(rm),false,false); rm=__builtin_fmaxf(__uint_as_float(rr[0]),__uint_as_float(rr[1])); } \
      resc=false; \
      if(__builtin_expect(__any(rm>(float)THRL),0)){ const float dl=__builtin_fmaxf(rm,0.f); mhat+=dl; \
        _Pragma("unroll") for(int r=0;r<16;++r){C0[r]-=dl;C1[r]-=dl;} \
        _Pragma("unroll") for(int r=0;r<16;++r)negm[r]=-mhat; asm volatile("":"+v"(negm)); \
        const float f=__builtin_amdgcn_exp2f(-dl); l_reg*=f; if(hi==0)wsf[r32]=f; resc=true; } } \
    SBAR(); \
    GAPB(o[0]=__builtin_amdgcn_mfma_f32_32x32x16_bf16(PAF(0),VFR(0),o[0],0,0,0), C0,0); \
    GAPB(o[1]=__builtin_amdgcn_mfma_f32_32x32x16_bf16(PAF(0),VFR(4),o[1],0,0,0), C0,4); \
    KRD(GL,0); GAPB(o[0]=__builtin_amdgcn_mfma_f32_32x32x16_bf16(PAF(1),VFR(1),o[0],0,0,0), C0,8); \
    KRD(GL,1); GAPB(o[1]=__builtin_amdgcn_mfma_f32_32x32x16_bf16(PAF(1),VFR(5),o[1],0,0,0), C0,12); \
    KRD(GL,2); GAPB(o[0]=__builtin_amdgcn_mfma_f32_32x32x16_bf16(PAF(2),VFR(2),o[0],0,0,0), C1,0); \
    KRD(GL,3); GAPB(o[1]=__builtin_amdgcn_mfma_f32_32x32x16_bf16(PAF(2),VFR(6),o[1],0,0,0), C1,4); \
    GAPB(o[0]=__builtin_amdgcn_mfma_f32_32x32x16_bf16(PAF(3),VFR(3),o[0],0,0,0), C1,8); \
    GAPB(o[1]=__builtin_amdgcn_mfma_f32_32x32x16_bf16(PAF(3),VFR(7),o[1],0,0,0), C1,12); \
    }while(0)
  int t=1;
  for(;t+5<NT;t+=2){
    STEP(pB0,pB1,pA0,pA1,t,true,true,true);     WAIT_BAR(2); RESC(); ROT();
    STEP(pA0,pA1,pB0,pB1,t+1,true,true,true);   WAIT_BAR(2); RESC(); ROT();
  }
  #define ENDW(tt) do{ if((tt)+3<NT){WAIT_BAR(2);} else if((tt)+2<NT){WAIT_BAR(1);} else {WAIT_BAR(0);} }while(0)
  for(;t+1<NT;t+=2){
    STEP(pB0,pB1,pA0,pA1,t,(t+3<NT),(t+1<NT),(t+1<NT));       ENDW(t);   RESC(); ROT();
    STEP(pA0,pA1,pB0,pB1,t+1,(t+4<NT),(t+2<NT),(t+2<NT));     ENDW(t+1); RESC(); ROT();
  }
  STEP(pB0,pB1,pA0,pA1,NT-1,false,false,false); RESC();
  { const bool keep_=true; float sacc=pB0[0]+pB0[1]; _Pragma("unroll") for(int r=2;r<16;++r)sacc+=pB0[r]; _Pragma("unroll") for(int r=0;r<16;++r)sacc+=pB1[r]; l_reg+=sacc;
    pw0=(u32x4){PKW(pB0,0),PKW(pB0,2),PKW(pB0,4),PKW(pB0,6)};pw1=(u32x4){PKW(pB0,8),PKW(pB0,10),PKW(pB0,12),PKW(pB0,14)};pw2=(u32x4){PKW(pB1,0),PKW(pB1,2),PKW(pB1,4),PKW(pB1,6)};pw3=(u32x4){PKW(pB1,8),PKW(pB1,10),PKW(pB1,12),PKW(pB1,14)};
    SBAR(); pv(o,vb0+sl_cur,PAF(0),PAF(1),PAF(2),PAF(3)); }
  #undef PKW
  #undef PAF
  #undef VFR
  #undef PIN
  #undef MX3
  #undef GAPA
  #undef GAPB
  #undef EX
  #undef VRD
  #undef KRD
  #undef STEP
  #undef ENDW
  {auto rr=__builtin_amdgcn_permlane32_swap(__float_as_uint(l_reg),__float_as_uint(l_reg),false,false);l_reg=__uint_as_float(rr[0])+__uint_as_float(rr[1]);}
  if(hi==0)wsf[32+r32]=l_reg;asm volatile("s_waitcnt lgkmcnt(0)":::"memory");
  float rli[16];
  #pragma unroll
  for(int r=0;r<16;++r)rli[r]=__builtin_amdgcn_rcpf(wsf[32+crow(r,hi)]);
  { bf16*stg=(bf16*)(shm+LDS_OST)+wid*2048;
    int*dtab=(int*)(shm+LDS_DST)+wid*32;
    if(hi==0){ dtab[r32]=dest; if(dest>=0){ PML[2*(long)dest]=mhat; PML[2*(long)dest+1]=l_reg; } }
    #pragma unroll
    for(int r=0;r<16;++r){const int orow=crow(r,hi);
      #pragma unroll
      for(int d0=0;d0<2;++d0)stg[orow*64+d0*32+r32]=__float2bfloat16(o[d0][r]*rli[r]);}
    asm volatile("s_waitcnt lgkmcnt(0)":::"memory");
    #pragma unroll
    for(int i=0;i<4;++i){const int row=i*8+(lane>>3),ch=lane&7; const int dr=dtab[row]; const u32x4 v=*(const u32x4*)(stg+row*64+ch*8); if(dr>=0)*(u32x4*)(PO+(long)dr*64+ch*8)=v;} }
  asm volatile("s_waitcnt lgkmcnt(0)\n\ts_barrier":::"memory");
  #undef DMA_K
  #undef DMA_V
  #undef CMASK
  #undef BMASK
  #undef START
  #undef RESC
  #undef ROT
}
template<int THRL> __device__ __forceinline__ void moba_chunk4(const bf16*Qrow,bool causal,int dest,bf16*PO,float*PML,char*shm){
  int tid_=threadIdx.x; asm volatile("":"+v"(tid_)); const int tid=tid_,lane=tid&63,r32=lane&31,hi=lane>>5; const int wid=__builtin_amdgcn_readfirstlane(tid>>6);
  const unsigned lds0=(unsigned)(uintptr_t)shm;
  float*wsf=(float*)(shm+LDS_WS)+wid*64;
  const int vb0=(int)(lds0+LDS_V)+((lane>>4)&1)*32+(lane&3)*8+(4*hi+((lane&15)>>2))*64;
  const char*Kbase=shm+LDS_K; bf16x8 kf[8];
  const lds_cptr shm3=(lds_cptr)shm; const lds_cptr kp0=shm3+LDS_K+hi*1024+r32*16; const lds_cptr vp0=shm3+LDS_V+((lane>>4)&1)*32+(lane&3)*8+(4*hi+((lane&15)>>2))*64;
  constexpr int NT=4;
  bf16x8 qr[4];
  #pragma unroll
  for(int d0=0;d0<4;++d0)qr[d0]=*reinterpret_cast<const bf16x8*>(Qrow+d0*16+hi*8);
  float mhat=0.f,l_reg=0.f;f32x16 o[2];o[0]=f32x16{};o[1]=f32x16{};f32x16 negm=f32x16{};asm volatile("":"+v"(negm));
  const int qrel=wid*QBLK+r32;
  #define BMASK(P0,P1,t) do{}while(0)
  #define CMASK(P0,P1,t) do{ if(causal)cmask(P0,P1,(t),qrel,hi); }while(0)
  bool resc=false;
  #define START(P0,P1) do{ const float rm=rowmax(P0,P1); resc=false; \
    { const float dl=__builtin_fmaxf(rm,-64.f); mhat=fadd_s(mhat,dl); \
      _Pragma("unroll") for(int r=0;r<16;++r){P0[r]=fsub_s(P0[r],dl);P1[r]=fsub_s(P1[r],dl);} \
      _Pragma("unroll") for(int r=0;r<16;++r)negm[r]=-mhat; asm volatile("":"+v"(negm)); } \
    _Pragma("unroll") for(int r=0;r<16;++r)P0[r]=__builtin_amdgcn_exp2f(P0[r]); }while(0)
  #define RESC() do{ if(resc){ asm volatile("s_waitcnt lgkmcnt(0)":::"memory"); \
      _Pragma("unroll") for(int d_=0;d_<2;++d_) _Pragma("unroll") for(int r=0;r<16;++r)o[d_][r]*=wsf[crow(r,hi)]; } }while(0)
  f32x16 pA0,pA1,pB0,pB1;
  int sl_prev=0,sl_cur=0,sl_next=SLOTB;
  #define ROT() do{sl_prev=sl_cur;sl_cur=sl_next;sl_next=(sl_next==(NSLOT-1)*SLOTB)?0:sl_next+SLOTB;}while(0)
  qkt(pA0,pA1,Kbase,qr,negm,r32,hi);asm volatile("s_nop 15\n\ts_nop 7":"+v"(pA0),"+v"(pA1));CMASK(pA0,pA1,0);
  START(pA0,pA1);
  _Pragma("unroll") for(int r=0;r<16;++r)pA1[r]=__builtin_amdgcn_exp2f(pA1[r]);
  ROT();
  kload8(kf,kp0+sl_cur);
  s16x4 vlo[8],vhi[8]; u32x4 pw0,pw1,pw2,pw3;
  #define PKW(P,B) (keep_?cvtpk_s(P[B],P[B+1]):0u)
  #define PAF(k) __builtin_bit_cast(bf16x8,pw##k)
  #define VFR(i) (bf16x8){vlo[i][0],vlo[i][1],vlo[i][2],vlo[i][3],vhi[i][0],vhi[i][1],vhi[i][2],vhi[i][3]}
  #define PIN(x) asm volatile("":"+v"(x))
  #define MX3(a,b,c) __builtin_fmaxf(__builtin_fmaxf((a),(b)),(c))
  #define GAPA(MF,A0,A1,A2,A3,W0,W1,PW) do{ MF; sacc+=A0; sacc+=A1; sacc+=A2; sacc+=A3; PIN(sacc); W0; W1; PIN(PW); SBAR(); }while(0)
  #define EX(v) __builtin_amdgcn_exp2f(v)
  #define GAPB(MF,X,B) do{ MF; X[B]=EX(X[B]); X[B+1]=EX(X[B+1]); X[B+2]=EX(X[B+2]); X[B+3]=EX(X[B+3]); PIN(X); SBAR(); }while(0)
  #define VRD(i) do{ vlo[i]=vtr(vp_+(((i)>>2)*4096+((i)&3)*1024)); vhi[i]=vtr(vp_+(((i)>>2)*4096+((i)&3)*1024+512)); }while(0)
  #define KRD(G,j) do{ if(G){ kload2(kf,kp0+sl_next,j); SBAR(); } }while(0)
  #define STEP(C0,C1,P0,P1,t,GK,GV,GL) do{ SBAR(); \
    const bool keep_=true; \
    const lds_cptr vp_=vp0+sl_prev; \
    VRD(0); SBAR(); float sacc=(P0[0]+P0[1]); \
    GAPA(C0=__builtin_amdgcn_mfma_f32_32x32x16_bf16(kf[0],qr[0],negm,0,0,0), P0[2],P0[3],P0[4],P0[5],     pw0[0]=PKW(P0,0), pw0[1]=PKW(P0,2), pw0); \
    VRD(4); SBAR(); GAPA(C1=__builtin_amdgcn_mfma_f32_32x32x16_bf16(kf[1],qr[0],negm,0,0,0), P0[6],P0[7],P0[8],P0[9],     pw0[2]=PKW(P0,4), pw0[3]=PKW(P0,6), pw0); \
    VRD(1); SBAR(); GAPA(C0=__builtin_amdgcn_mfma_f32_32x32x16_bf16(kf[2],qr[1],C0,0,0,0),   P0[10],P0[11],P0[12],P0[13], pw1[0]=PKW(P0,8), pw1[1]=PKW(P0,10), pw1); \
    VRD(5); SBAR(); GAPA(C1=__builtin_amdgcn_mfma_f32_32x32x16_bf16(kf[3],qr[1],C1,0,0,0),   P0[14],P0[15],P1[0],P1[1],   pw1[2]=PKW(P0,12),pw1[3]=PKW(P0,14), pw1); \
    VRD(2); SBAR(); GAPA(C0=__builtin_amdgcn_mfma_f32_32x32x16_bf16(kf[4],qr[2],C0,0,0,0),   P1[2],P1[3],P1[4],P1[5],     pw2[0]=PKW(P1,0), pw2[1]=PKW(P1,2), pw2); \
    VRD(6); SBAR(); GAPA(C1=__builtin_amdgcn_mfma_f32_32x32x16_bf16(kf[5],qr[2],C1,0,0,0),   P1[6],P1[7],P1[8],P1[9],     pw2[2]=PKW(P1,4), pw2[3]=PKW(P1,6), pw2); \
    VRD(3); SBAR(); GAPA(C0=__builtin_amdgcn_mfma_f32_32x32x16_bf16(kf[6],qr[3],C0,0,0,0),   P1[10],P1[11],P1[12],P1[13], pw3[0]=PKW(P1,8), pw3[1]=PKW(P1,10), pw3); \
    VRD(7); SBAR(); GAPA(C1=__builtin_amdgcn_mfma_f32_32x32x16_bf16(kf[7],qr[3],C1,0,0,0),   P1[14],P1[15],0.f,0.f,       pw3[2]=PKW(P1,12),pw3[3]=PKW(P1,14), pw3); \
    l_reg+=keep_?sacc:0.f; \
    CMASK(C0,C1,t); \
    { float a=MX3(C0[0],C0[1],C1[0]),b=MX3(C0[2],C0[3],C1[1]); a=MX3(a,C1[2],C1[3]); \
      _Pragma("unroll") for(int r=4;r<16;r+=4){a=MX3(a,C0[r],C0[r+1]);b=MX3(b,C0[r+2],C0[r+3]);a=MX3(a,C1[r],C1[r+1]);b=MX3(b,C1[r+2],C1[r+3]);} \
      float rm=__builtin_fmaxf(a,b); { auto rr=__builtin_amdgcn_permlane32_swap(__float_as_uint(rm),__float_as_uint(rm),false,false); rm=__builtin_fmaxf(__uint_as_float(rr[0]),__uint_as_float(rr[1])); } \
      resc=false; \
      if(__builtin_expect(__any(rm>(float)THRL),0)){ const float dl=__builtin_fmaxf(rm,0.f); mhat+=dl; \
        _Pragma("unroll") for(int r=0;r<16;++r){C0[r]-=dl;C1[r]-=dl;} \
        _Pragma("unroll") for(int r=0;r<16;++r)negm[r]=-mhat; asm volatile("":"+v"(negm)); \
        const float f=__builtin_amdgcn_exp2f(-dl); l_reg*=f; if(hi==0)wsf[r32]=f; resc=true; } } \
    SBAR(); \
    GAPB(o[0]=__builtin_amdgcn_mfma_f32_32x32x16_bf16(PAF(0),VFR(0),o[0],0,0,0), C0,0); \
    GAPB(o[1]=__builtin_amdgcn_mfma_f32_32x32x16_bf16(PAF(0),VFR(4),o[1],0,0,0), C0,4); \
    KRD(GL,0); GAPB(o[0]=__builtin_amdgcn_mfma_f32_32x32x16_bf16(PAF(1),VFR(1),o[0],0,0,0), C0,8); \
    KRD(GL,1); GAPB(o[1]=__builtin_amdgcn_mfma_f32_32x32x16_bf16(PAF(1),VFR(5),o[1],0,0,0), C0,12); \
    KRD(GL,2); GAPB(o[0]=__builtin_amdgcn_mfma_f32_32x32x16_bf16(PAF(2),VFR(2),o[0],0,0,0), C1,0); \
    KRD(GL,3); GAPB(o[1]=__builtin_amdgcn_mfma_f32_32x32x16_bf16(PAF(2),VFR(6),o[1],0,0,0), C1,4); \
    GAPB(o[0]=__builtin_amdgcn_mfma_f32_32x32x16_bf16(PAF(3),VFR(3),o[0],0,0,0), C1,8); \
    GAPB(o[1]=__builtin_amdgcn_mfma_f32_32x32x16_bf16(PAF(3),VFR(7),o[1],0,0,0), C1,12); \
    }while(0)
  int t=1;
  for(;t+5<NT;t+=2){
    STEP(pB0,pB1,pA0,pA1,t,true,true,true);      RESC(); ROT();
    STEP(pA0,pA1,pB0,pB1,t+1,true,true,true);    RESC(); ROT();
  }
  #define ENDW(tt) do{ if((tt)+3<NT){} else if((tt)+2<NT){} else {} }while(0)
  for(;t+1<NT;t+=2){
    STEP(pB0,pB1,pA0,pA1,t,(t+3<NT),(t+1<NT),(t+1<NT));       ENDW(t);   RESC(); ROT();
    STEP(pA0,pA1,pB0,pB1,t+1,(t+4<NT),(t+2<NT),(t+2<NT));     ENDW(t+1); RESC(); ROT();
  }
  STEP(pB0,pB1,pA0,pA1,NT-1,false,false,false); RESC();
  { const bool keep_=true; float sacc=pB0[0]+pB0[1]; _Pragma("unroll") for(int r=2;r<16;++r)sacc+=pB0[r]; _Pragma("unroll") for(int r=0;r<16;++r)sacc+=pB1[r]; l_reg+=sacc;
    pw0=(u32x4){PKW(pB0,0),PKW(pB0,2),PKW(pB0,4),PKW(pB0,6)};pw1=(u32x4){PKW(pB0,8),PKW(pB0,10),PKW(pB0,12),PKW(pB0,14)};pw2=(u32x4){PKW(pB1,0),PKW(pB1,2),PKW(pB1,4),PKW(pB1,6)};pw3=(u32x4){PKW(pB1,8),PKW(pB1,10),PKW(pB1,12),PKW(pB1,14)};
    SBAR(); pv(o,vb0+sl_cur,PAF(0),PAF(1),PAF(2),PAF(3)); }
  #undef PKW
  #undef PAF
  #undef VFR
  #undef PIN
  #undef MX3
  #undef GAPA
  #undef GAPB
  #undef EX
  #undef VRD
  #undef KRD
  #undef STEP
  #undef ENDW
  {auto rr=__builtin_amdgcn_permlane32_swap(__float_as_uint(l_reg),__float_as_uint(l_reg),false,false);l_reg=__uint_as_float(rr[0])+__uint_as_float(rr[1]);}
  if(hi==0)wsf[32+r32]=l_reg;asm volatile("s_waitcnt lgkmcnt(0)":::"memory");
  float rli[16];
  #pragma unroll
  for(int r=0;r<16;++r)rli[r]=__builtin_amdgcn_rcpf(wsf[32+crow(r,hi)]);
  { bf16*stg=(bf16*)(shm+LDS_OST)+wid*2048;
    int*dtab=(int*)(shm+LDS_DST)+wid*32;
    if(hi==0){ dtab[r32]=dest; if(dest>=0){ PML[2*(long)dest]=mhat; PML[2*(long)dest+1]=l_reg; } }
    #pragma unroll
    for(int r=0;r<16;++r){const int orow=crow(r,hi);
      #pragma unroll
      for(int d0=0;d0<2;++d0)stg[orow*64+d0*32+r32]=__float2bfloat16(o[d0][r]*rli[r]);}
    asm volatile("s_waitcnt lgkmcnt(0)":::"memory");
    #pragma unroll
    for(int i=0;i<4;++i){const int row=i*8+(lane>>3),ch=lane&7; const int dr=dtab[row]; const u32x4 v=*(const u32x4*)(stg+row*64+ch*8); if(dr>=0)*(u32x4*)(PO+(long)dr*64+ch*8)=v;} }
  asm volatile("s_waitcnt lgkmcnt(0)":::"memory");
  #undef CMASK
  #undef BMASK
  #undef START
  #undef RESC
  #undef ROT
}

__device__ __forceinline__ void moba_load_kv(const bf16*Kh,const bf16*Vh,char*shm){
  int tid_=threadIdx.x; asm volatile("":"+v"(tid_)); const int lane=tid_&63; const int wid=__builtin_amdgcn_readfirstlane(tid_>>6);
  const unsigned lds0=(unsigned)(uintptr_t)shm;
  const bf16*ksrc=Kh+(long)lane*DM+wid*8;
  const bf16*vsrc=Vh+(long)(16*(wid&3)+(lane>>2))*DM+(wid>>2)*32+(lane&3)*8;
  const unsigned kdst=lds0+LDS_K+wid*1024, vdst=lds0+LDS_V+wid*1024;
  #pragma unroll
  for(int t=0;t<4;++t){ glds16(ksrc+(long)t*KVBLK*DM,(unsigned)__builtin_amdgcn_readfirstlane(kdst+t*SLOTB)); glds16(vsrc+(long)t*KVBLK*DM,(unsigned)__builtin_amdgcn_readfirstlane(vdst+t*SLOTB)); }
  asm volatile("s_waitcnt vmcnt(0)":::"memory");
}
constexpr int ATTN_LDS_BYTES=LDS_BYTES;
struct AttnTensors { const bf16* Q; const bf16* K; const bf16* V; bf16* O; const float* KM; };
struct AttnUnit { int bh; int qb; };
struct StaticOrder {
  int vcu;
  __device__ __forceinline__ explicit StaticOrder(int grid,int block):vcu((block%8)*(grid/8)+block/8){}
  __device__ __forceinline__ bool next(int i,AttnUnit&u)const{ if(i>=4)return false; const int s=vcu&7; u.bh=vcu>>3; u.qb=(i==0)?s:(i==1)?15-s:(i==2)?16+s:31-s; return true; }
  __device__ __forceinline__ void a_ready(const AttnUnit&)const{}
  __device__ __forceinline__ void done(const AttnUnit&)const{}
};
template<class Sched,int THRL=8> __device__ __forceinline__ void attn_phase(char*lds,const AttnTensors&T,const Sched&S){
  AttnUnit u; int lastbh=-1;
  for(int i=0;S.next(i,u);++i){
    if(u.bh!=lastbh){ __syncthreads(); float*km=(float*)(lds+LDS_KM); int tx_=threadIdx.x; asm volatile("":"+v"(tx_)); for(int k=tx_;k<32*64;k+=512)km[k]=T.KM[(long)u.bh*32*64+k]+T.KM[(long)(BATCH*NHEAD+u.bh)*32*64+k]; asm volatile("s_waitcnt vmcnt(0) lgkmcnt(0)":::"memory"); __syncthreads(); lastbh=u.bh; }
    attn_unit<THRL>(u.bh/NHEAD,u.bh%NHEAD,u.qb,T.Q,T.K,T.V,T.O,lds); }
}
#undef SBAR
#undef WAIT_BAR
}

#define XB_TMO      128
#define XB_XCNT(j)  (256  + 64 * (j))
#define XB_XSUB(j)  (1280 + 64 * (j))
#define XB_XGEN(j)  (2304 + 64 * (j))
#define XB_TOP      3328
#define XB_TOPGEN   3392
#define XCD_BAR_WORDS 3456
#define XB_SPIN_CAP (1u << 20)
__device__ __forceinline__ unsigned xb_ld(unsigned* p)              { return __hip_atomic_load(p, __ATOMIC_RELAXED, __HIP_MEMORY_SCOPE_AGENT); }
__device__ __forceinline__ unsigned xb_add(unsigned* p, unsigned v) { return __hip_atomic_fetch_add(p, v, __ATOMIC_RELAXED, __HIP_MEMORY_SCOPE_AGENT); }
__device__ __forceinline__ unsigned xb_xcc_id() { return (unsigned)__builtin_amdgcn_s_getreg((3 << 11) | 20) & 0xFu; }
#define XB_SPIN(cond, bar) do { unsigned _sp = 0; while (cond) { __builtin_amdgcn_s_sleep(1); \
    if ((++_sp & 255u) == 0u) { if (xb_ld(&(bar)[XB_TMO])) break; if (_sp > XB_SPIN_CAP) { atomicAdd(&(bar)[XB_TMO], 1u); break; } } } } while (0)
struct XcdBarrier { unsigned* bar; unsigned x; volatile LAS unsigned* st; };
__device__ __forceinline__ XcdBarrier xcd_barrier_post(unsigned* bar, volatile LAS unsigned* st) {
    XcdBarrier b; b.bar = bar; b.x = xb_xcc_id(); b.st = st;
    if (threadIdx.x == 0) (void)xb_add(&bar[XB_XCNT(b.x)], 1u);
    return b;
}
__device__ __forceinline__ void xcd_barrier_complete(unsigned* bar, unsigned x, unsigned& nloc, unsigned& nx) {
    const unsigned G = gridDim.x * gridDim.y * gridDim.z;
    unsigned sum, cnt, mine, sp = 0u;
    for (;;) {
        sum = 0u; cnt = 0u; mine = 0u;
#pragma unroll
        for (unsigned j = 0; j < 16; ++j) { const unsigned c = xb_ld(&bar[XB_XCNT(j)]); sum += c; cnt += (c > 0u) ? 1u : 0u; mine = (j == x) ? c : mine; }
        if (sum == G) break;
        __builtin_amdgcn_s_sleep(1);
        if ((++sp & 255u) == 0u) { if (xb_ld(&bar[XB_TMO])) break; if (sp > XB_SPIN_CAP) { atomicAdd(&bar[XB_TMO], 1u); break; } }
    }
    nloc = mine > 0u ? mine : 1u; nx = cnt > 0u ? cnt : 1u;
}
__device__ __forceinline__ void xcd_barrier(const XcdBarrier& b) {
    asm volatile("s_waitcnt vmcnt(0)" ::: "memory");
    __syncthreads();
    if (threadIdx.x == 0) {
        unsigned* bar = b.bar;
        __builtin_amdgcn_s_waitcnt(0);
        unsigned nloc = b.st[0], nx = b.st[1];
        if (nloc == 0u) { xcd_barrier_complete(bar, b.x, nloc, nx); b.st[0] = nloc; b.st[1] = nx; }
        const unsigned old = xb_add(&bar[XB_XSUB(b.x)], 1u);
        const unsigned gen = old / nloc;
        if (old + 1u == (gen + 1u) * nloc) {
            __builtin_amdgcn_fence(__ATOMIC_RELEASE, "agent");
            asm volatile("s_waitcnt vmcnt(0)" ::: "memory");
            const unsigned og = xb_add(&bar[XB_TOP], 1u);
            const unsigned tg = og / nx;
            if (og + 1u == (tg + 1u) * nx) xb_add(&bar[XB_TOPGEN], 1u);
            else XB_SPIN(xb_ld(&bar[XB_TOPGEN]) == tg, bar);
            __builtin_amdgcn_fence(__ATOMIC_ACQUIRE, "agent");
            xb_add(&bar[XB_XGEN(b.x)], 1u);
            asm volatile("s_waitcnt vmcnt(0)" ::: "memory");
        } else {
            XB_SPIN(xb_ld(&bar[XB_XGEN(b.x)]) == gen, bar);
            __builtin_amdgcn_fence(__ATOMIC_ACQUIRE, "agent");
            asm volatile("s_waitcnt vmcnt(0)" ::: "memory");
        }
    }
    __syncthreads();
}

struct Args { const float* in[28]; float* out; unsigned char* ws; int ph_lo, ph_hi; };
enum { I_X = 0, I_MEM, I_GMIX, I_WIN, I_ARE, I_AIM, I_LOGDT, I_BRE, I_BIM, I_CRE, I_CIM, I_DSKIP, I_WGLU, I_WPA, I_WOUT, I_GXATTN, I_GMEM, I_WXQ, I_WXKV, I_WXO,
       I_GMOE, I_WROUTER, I_BROUTER, I_WGU, I_BGU, I_WDN, I_BDN, I_GFINAL };

struct TrDesc { const float* W; const float* gain; bf16_t* WT; int K, N, map, item; int fp8 = 0; };
__device__ __forceinline__ void tr_load(const TrDesc& d, f32x4 (&v)[16], float (&g)[16], int lane) {
    const int nblk = d.N / 64, kb = d.item / nblk, nb = d.item % nblk, k0 = 64 * kb, n0 = 64 * nb, q = lane & 15, kr = lane >> 4;
    const float* src = d.W + (size_t)(k0 + kr) * d.N + n0 + 4 * q;
#pragma unroll
    for (int j = 0; j < 16; ++j) v[j] = *(const f32x4*)(src + (size_t)(4 * j) * d.N);
#pragma unroll
    for (int j = 0; j < 16; ++j) g[j] = d.gain ? d.gain[k0 + kr + 4 * j] : 1.0f;
}
__device__ __forceinline__ void tr_finish(const TrDesc& d, const f32x4 (&v)[16], const float (&g)[16], LAS float* scr, int lane) {
    const int nblk = d.N / 64, kb = d.item / nblk, nb = d.item % nblk, k0 = 64 * kb, n0 = 64 * nb, q = lane & 15, kr = lane >> 4;
#pragma unroll
    for (int j = 0; j < 16; ++j) { const int kk = kr + 4 * j; *(LAS f32x4*)(scr + kk * 64 + 4 * (q ^ ((kk >> 3) & 7))) = v[j] * g[j]; }
    asm volatile("s_waitcnt lgkmcnt(0)" ::: "memory");
    const int c = lane & 7, nq = lane >> 3;
    const int nr0 = d.map ? (256 * ((n0 % 1024) / 128) + 128 * (n0 / 1024) + (n0 % 128)) : n0;
#pragma unroll
    for (int jj = 0; jj < 8; ++jj) { const int n = 8 * jj + nq; const LAS float* sp = scr + (8 * c) * 64 + (n ^ (4 * c));
        if (d.fp8) { const float sc = (float)(1 << FP8_WSHIFT); int w0 = 0, w1 = 0;
            w0 = __builtin_amdgcn_cvt_pk_fp8_f32(sp[0 * 64] * sc, sp[1 * 64] * sc, w0, false); w0 = __builtin_amdgcn_cvt_pk_fp8_f32(sp[2 * 64] * sc, sp[3 * 64] * sc, w0, true);
            w1 = __builtin_amdgcn_cvt_pk_fp8_f32(sp[4 * 64] * sc, sp[5 * 64] * sc, w1, false); w1 = __builtin_amdgcn_cvt_pk_fp8_f32(sp[6 * 64] * sc, sp[7 * 64] * sc, w1, true);
            *(u32x2*)((unsigned char*)d.WT + (size_t)(nr0 + n) * d.K + k0 + 8 * c) = (u32x2){(unsigned)w0, (unsigned)w1}; }
        else { u32x4 o; o.x = pk2(sp[0 * 64], sp[1 * 64]); o.y = pk2(sp[2 * 64], sp[3 * 64]); o.z = pk2(sp[4 * 64], sp[5 * 64]); o.w = pk2(sp[6 * 64], sp[7 * 64]);
            *(u32x4*)(d.WT + (size_t)(nr0 + n) * d.K + k0 + 8 * c) = o; } }
    asm volatile("s_waitcnt lgkmcnt(0)" ::: "memory");
}
template <int MODE>
__device__ __forceinline__ float rms_row_to_bf16(const float* xrow, const float* gain, bf16_t* orow, int lane) {
    const f32x4* xr = (const f32x4*)xrow + lane;
    f32x4 v[4]; float s = 0.f;
#pragma unroll
    for (int j = 0; j < 4; ++j) { v[j] = xr[64 * j]; s += (v[j][0] * v[j][0] + v[j][1] * v[j][1]) + (v[j][2] * v[j][2] + v[j][3] * v[j][3]); }
    const float rstd = 1.0f / sqrtf(wave_sum(s) * (1.0f / DM) + RMS_EPS);
    u32x2* o8 = (u32x2*)orow + lane;
#pragma unroll
    for (int j = 0; j < 4; ++j) { f32x4 w = v[j];
        if (MODE == 1) { const f32x4 g = ((const f32x4*)gain)[lane + 64 * j]; w = w * rstd * g; }
        u32x2 o; o.x = pk2(w[0], w[1]); o.y = pk2(w[2], w[3]); o8[64 * j] = o; }
    return rstd;
}

struct Frame {
    LAS unsigned char* lds; int tid, lane, wave, G, bid;
    const float* in[28]; float* out; unsigned char* ws; unsigned* ctl;
};
#define WSP(type, off) ((type*)(F.ws + (off)))

__device__ __forceinline__ TrDesc tr_decode(Frame& F, int it) {
    constexpr int I_IN = (DM / 64) * (INW / 64), I_GLU = (SW / 64) * (2 * DM / 64), I_PA = (AW / 64) * (DM / 64), I_OUT = (DM / 64) * (DM / 64), I_XQ = (DM / 64) * (XW / 64),
                  I_XKV = (DM / 64) * (2 * XW / 64), I_XO = (XW / 64) * (DM / 64), I_GU1 = (DM / 64) * (2 * DFF / 64), I_DN1 = (DFF / 64) * (DM / 64);
    int r = it;
    if (r < I_IN) return TrDesc{F.in[I_WIN], F.in[I_GMIX], WSP(bf16_t, WS_WIN), DM, INW, 0, r}; r -= I_IN;
    if (r < I_GLU) return TrDesc{F.in[I_WGLU], nullptr, WSP(bf16_t, WS_WGLU), SW, 2 * DM, 1, r}; r -= I_GLU;
    if (r < I_PA) return TrDesc{F.in[I_WPA], nullptr, WSP(bf16_t, WS_WPA), AW, DM, 0, r}; r -= I_PA;
    if (r < I_OUT) return TrDesc{F.in[I_WOUT], nullptr, WSP(bf16_t, WS_WOUT), DM, DM, 0, r}; r -= I_OUT;
    if (r < I_XQ) return TrDesc{F.in[I_WXQ], F.in[I_GXATTN], WSP(bf16_t, WS_WXQ), DM, XW, 0, r}; r -= I_XQ;
    if (r < I_XKV) return TrDesc{F.in[I_WXKV], nullptr, WSP(bf16_t, WS_WXKV), DM, 2 * XW, 0, r}; r -= I_XKV;
    if (r < I_XO) return TrDesc{F.in[I_WXO], nullptr, WSP(bf16_t, WS_WXO), XW, DM, 0, r}; r -= I_XO;
    const int e = r / (I_GU1 + I_DN1); r -= e * (I_GU1 + I_DN1);
    if (r < I_GU1) return TrDesc{F.in[I_WGU] + (size_t)e * DM * 2 * DFF, F.in[I_GMOE], (bf16_t*)(F.ws + WS_WGU + (MOE1_FP8 ? (size_t)e * 2 * DFF * DM : (size_t)e * 2 * DFF * DM * 2)), DM, 2 * DFF, 1, r, MOE1_FP8};
    return TrDesc{F.in[I_WDN] + (size_t)e * DFF * DM, nullptr, (bf16_t*)(F.ws + WS_WDN + (MOE2_FP8 ? (size_t)e * DM * DFF : (size_t)e * DM * DFF * 2)), DFF, DM, 0, r - I_GU1, MOE2_FP8};
}
__device__ __forceinline__ void xrow_load(const float* X, int m, f32x4 (&v)[4][4], int lane) {
#pragma unroll
    for (int r = 0; r < 4; ++r)
#pragma unroll
        for (int j = 0; j < 4; ++j) v[r][j] = ((const f32x4*)(X + (size_t)(m + r) * DM))[lane + 64 * j];
}
__device__ __forceinline__ void xrow_finish(bf16_t* XBp, int m, const f32x4 (&v)[4][4], int lane) {
    float ss[4];
#pragma unroll
    for (int r = 0; r < 4; ++r) { float s = 0.f;
#pragma unroll
        for (int j = 0; j < 4; ++j) s += (v[r][j][0] * v[r][j][0] + v[r][j][1] * v[r][j][1]) + (v[r][j][2] * v[r][j][2] + v[r][j][3] * v[r][j][3]);
        ss[r] = s; }
#pragma unroll
    for (int o = 1; o < 64; o <<= 1) {
#pragma unroll
        for (int r = 0; r < 4; ++r) ss[r] += __shfl_xor(ss[r], o); }
#pragma unroll
    for (int r = 0; r < 4; ++r) { u32x2* o8 = (u32x2*)(XBp + (size_t)(m + r) * DM) + lane;
        const float rs = 1.0f / sqrtf(ss[r] * (1.0f / DM) + RMS_EPS);
#pragma unroll
        for (int j = 0; j < 4; ++j) { u32x2 o; o.x = pk2(v[r][j][0] * rs, v[r][j][1] * rs); o.y = pk2(v[r][j][2] * rs, v[r][j][3] * rs); o8[64 * j] = o; } }
}
__device__ __forceinline__ void phase_prologue(Frame& F) {
    LAS float* scr = (LAS float*)(F.lds + F.wave * 16384);
    const int gw = F.bid * 8 + F.wave, NGW = F.G * 8;
    { f32x4 va[4][4], vb[4][4]; const int step = NGW * 4, m0 = gw * 4, n = (m0 < T_) ? (T_ - m0 + step - 1) / step : 0;
      if (n > 0) { xrow_load(F.in[I_X], m0, va, F.lane); int i = 0;
          for (; i + 2 <= n; i += 2) {
              xrow_load(F.in[I_X], m0 + (i + 1) * step, vb, F.lane);
              xrow_finish(WSP(bf16_t, WS_XB), m0 + i * step, va, F.lane);
              xrow_load(F.in[I_X], m0 + min(i + 2, n - 1) * step, va, F.lane);
              xrow_finish(WSP(bf16_t, WS_XB), m0 + (i + 1) * step, vb, F.lane); }
          if (i < n) xrow_finish(WSP(bf16_t, WS_XB), m0 + i * step, va, F.lane); } }
    for (int m = gw; m < NB * MEML; m += NGW) (void)rms_row_to_bf16<1>(F.in[I_MEM] + (size_t)m * DM, F.in[I_GMEM], WSP(bf16_t, WS_MN) + (size_t)m * DM, F.lane);
    constexpr int NITEMS = (DM / 64) * (INW / 64) + (SW / 64) * (2 * DM / 64) + (AW / 64) * (DM / 64) + (DM / 64) * (DM / 64) + (DM / 64) * (XW / 64) + (DM / 64) * (2 * XW / 64) + (XW / 64) * (DM / 64)
                         + NE * ((DM / 64) * (2 * DFF / 64) + (DFF / 64) * (DM / 64));
    { f32x4 va[16], vb[16]; float ga[16], gb[16]; TrDesc da, db; const int n = (gw < NITEMS) ? (NITEMS - gw + NGW - 1) / NGW : 0;
      if (n > 0) { da = tr_decode(F, gw); tr_load(da, va, ga, F.lane); int i = 0;
          for (; i + 2 <= n; i += 2) {
              db = tr_decode(F, gw + (i + 1) * NGW); tr_load(db, vb, gb, F.lane);
              tr_finish(da, va, ga, scr, F.lane);
              da = tr_decode(F, gw + min(i + 2, n - 1) * NGW); tr_load(da, va, ga, F.lane);
              tr_finish(db, vb, gb, scr, F.lane); }
          if (i < n) tr_finish(da, va, ga, scr, F.lane); } }
}

__device__ __forceinline__ void phase_kmean(Frame& F) {
    LAS float* red = (LAS float*)F.lds;
    const bf16_t* Kb = WSP(bf16_t, WS_K);
    for (int it = F.bid; it < NB * NH * NBLK; it += F.G) {
        const int j = it % NBLK, h = (it / NBLK) % NH, b = it / (NBLK * NH);
        const int col = F.tid & 63, rg = F.tid >> 6; float s = 0.f;
        const bf16_t* p = Kb + ((size_t)(b * SEQ + j * MBLK + rg * 32)) * AW + h * HD + col;
#pragma unroll 8
        for (int r = 0; r < 32; ++r) s += bf2f(p[(size_t)r * AW]);
        red[rg * 64 + col] = s;
        __syncthreads();
        if (F.tid < 64) { float t = 0.f;
#pragma unroll
            for (int k = 0; k < 8; ++k) t += red[k * 64 + F.tid];
            WSP(float, WS_KMEAN)[(size_t)it * HD + F.tid] = t * (1.0f / MBLK); }
        __syncthreads();
    }
}

__device__ __forceinline__ void phase_moba_simple(Frame& F, bf16_t* Ob) {
    LAS unsigned* Ks = (LAS unsigned*)F.lds;
    LAS unsigned* Vs = (LAS unsigned*)(F.lds + 32768);
    LAS float* km = (LAS float*)(F.lds + 65536);
    const bf16_t *Qb = WSP(bf16_t, WS_Q), *Kb = WSP(bf16_t, WS_K), *Vb = WSP(bf16_t, WS_V);
    const int ql = F.tid >> 1, half = F.tid & 1;
    for (int it = F.bid; it < NB * NH * NBLK; it += F.G) {
        const int iblk = (NBLK - 1) - (it % NBLK), h = (it / NBLK) % NH, b = it / (NBLK * NH);
        __syncthreads();
        for (int k = F.tid; k < NBLK * HD; k += 512) km[k] = WSP(float, WS_KMEAN)[(size_t)((b * NH + h) * NBLK) * HD + k] + WSP(float, WS_KMEAN)[(size_t)((NB * NH + b * NH + h) * NBLK) * HD + k];
        float q[32];
        { const u32x4* qp = (const u32x4*)(Qb + (size_t)(b * SEQ + iblk * MBLK + ql) * AW + h * HD + half * 32);
#pragma unroll
          for (int c = 0; c < 4; ++c) { const u32x4 w = qp[c]; q[8 * c + 0] = bflo(w.x); q[8 * c + 1] = bfhi(w.x); q[8 * c + 2] = bflo(w.y); q[8 * c + 3] = bfhi(w.y); q[8 * c + 4] = bflo(w.z); q[8 * c + 5] = bfhi(w.z); q[8 * c + 6] = bflo(w.w); q[8 * c + 7] = bfhi(w.w); } }
        __syncthreads();
        float g0 = -3e38f, g1 = -3e38f, g2 = -3e38f; int s0 = -1, s1 = -1, s2 = -1;
        for (int j = 0; j < iblk; ++j) { float g = 0.f;
#pragma unroll
            for (int d = 0; d < 32; ++d) g += q[d] * km[j * HD + half * 32 + d];
            g += __shfl_xor(g, 1);
            if (g > g0) { g2 = g1; s2 = s1; g1 = g0; s1 = s0; g0 = g; s0 = j; } else if (g > g1) { g2 = g1; s2 = s1; g1 = g; s1 = j; } else if (g > g2) { g2 = g; s2 = j; } }
        float mx = -3e38f, l = 0.f, o[32];
#pragma unroll
        for (int d = 0; d < 32; ++d) o[d] = 0.f;
        for (int jb = 0; jb <= iblk; ++jb) {
            __syncthreads();
            { const size_t rowb = (size_t)(b * SEQ + jb * MBLK);
              for (int c = F.tid; c < 256 * 8; c += 512) { const int r = c >> 3, ch = c & 7;
                  *(LAS u32x4*)(Ks + r * 32 + ch * 4) = *(const u32x4*)(Kb + (rowb + r) * AW + h * HD + ch * 8);
                  *(LAS u32x4*)(Vs + r * 32 + ch * 4) = *(const u32x4*)(Vb + (rowb + r) * AW + h * HD + ch * 8); } }
            __syncthreads();
            const bool need = (jb == iblk) || jb == s0 || jb == s1 || jb == s2;
            if (need) { const int kend = (jb == iblk) ? ql : 255;
                for (int kk = 0; kk <= kend; ++kk) { float s = 0.f;
#pragma unroll
                    for (int c = 0; c < 4; ++c) { const u32x4 w = *(const LAS u32x4*)(Ks + kk * 32 + half * 16 + c * 4);
                        s += q[8 * c + 0] * bflo(w.x) + q[8 * c + 1] * bfhi(w.x) + q[8 * c + 2] * bflo(w.y) + q[8 * c + 3] * bfhi(w.y) + q[8 * c + 4] * bflo(w.z) + q[8 * c + 5] * bfhi(w.z) + q[8 * c + 6] * bflo(w.w) + q[8 * c + 7] * bfhi(w.w); }
                    s += __shfl_xor(s, 1);
                    const float mn = fmaxf(mx, s), corr = __builtin_amdgcn_exp2f(mx - mn), p = __builtin_amdgcn_exp2f(s - mn); mx = mn; l = l * corr + p;
#pragma unroll
                    for (int c = 0; c < 4; ++c) { const u32x4 w = *(const LAS u32x4*)(Vs + kk * 32 + half * 16 + c * 4);
                        o[8 * c + 0] = o[8 * c + 0] * corr + p * bflo(w.x); o[8 * c + 1] = o[8 * c + 1] * corr + p * bfhi(w.x); o[8 * c + 2] = o[8 * c + 2] * corr + p * bflo(w.y); o[8 * c + 3] = o[8 * c + 3] * corr + p * bfhi(w.y);
                        o[8 * c + 4] = o[8 * c + 4] * corr + p * bflo(w.z); o[8 * c + 5] = o[8 * c + 5] * corr + p * bfhi(w.z); o[8 * c + 6] = o[8 * c + 6] * corr + p * bflo(w.w); o[8 * c + 7] = o[8 * c + 7] * corr + p * bfhi(w.w); } } }
        }
        const float il = 1.0f / l;
        u32x4* op = (u32x4*)(Ob + (size_t)(b * SEQ + iblk * MBLK + ql) * AW + h * HD + half * 32);
#pragma unroll
        for (int c = 0; c < 4; ++c) { u32x4 w; w.x = pk2(o[8 * c + 0] * il, o[8 * c + 1] * il); w.y = pk2(o[8 * c + 2] * il, o[8 * c + 3] * il); w.z = pk2(o[8 * c + 4] * il, o[8 * c + 5] * il); w.w = pk2(o[8 * c + 6] * il, o[8 * c + 7] * il); op[c] = w; }
    }
}

__device__ __forceinline__ void phase_ssm_simple(Frame& F, bf16_t* Yb) {
    const int gw = F.bid * 8 + F.wave, NGW = F.G * 8, p = F.lane;
    const bf16_t* Ub = WSP(bf16_t, WS_U);
    for (int it = gw; it < NB * NG; it += NGW) {
        const int g = it % NG, b = it / NG;
        const float are = fminf(F.in[I_ARE][g * SP + p], -1e-4f), aim = F.in[I_AIM][g * SP + p], dt = expf(F.in[I_LOGDT][g]);
        const float mag = expf(are * dt), ang = aim * dt; const float lr = mag * cosf(ang), li = mag * sinf(ang);
        const float nr = lr - 1.0f, ni = li, den = 1.0f / (are * are + aim * aim); const float fr_ = (nr * are + ni * aim) * den, fi_ = (ni * are - nr * aim) * den;
        float bbr[16], bbi[16], cr[16], ci[16], dsk[16];
#pragma unroll
        for (int c = 0; c < 16; ++c) { const float br = F.in[I_BRE][(size_t)(g * SP + p) * SGC + c], bi = F.in[I_BIM][(size_t)(g * SP + p) * SGC + c];
            bbr[c] = fr_ * br - fi_ * bi; bbi[c] = fr_ * bi + fi_ * br;
            cr[c] = F.in[I_CRE][(size_t)(g * SGC + c) * SP + p]; ci[c] = F.in[I_CIM][(size_t)(g * SGC + c) * SP + p]; dsk[c] = F.in[I_DSKIP][g * SGC + c]; }
        float xr = 0.f, xi = 0.f;
        const int csel = ((p >> 5) & 1) * 8 + ((p >> 4) & 1) * 4 + ((p >> 3) & 1) * 2 + ((p >> 2) & 1);
        float dmine = 0.f;
#pragma unroll
        for (int c = 0; c < 16; ++c) dmine = (c == csel) ? dsk[c] : dmine;
        for (int t = 0; t < SEQ; ++t) {
            const u32x4* up = (const u32x4*)(Ub + (size_t)(b * SEQ + t) * SW + g * SGC); const u32x4 w0 = up[0], w1 = up[1];
            float u[16]; u[0] = bflo(w0.x); u[1] = bfhi(w0.x); u[2] = bflo(w0.y); u[3] = bfhi(w0.y); u[4] = bflo(w0.z); u[5] = bfhi(w0.z); u[6] = bflo(w0.w); u[7] = bfhi(w0.w);
            u[8] = bflo(w1.x); u[9] = bfhi(w1.x); u[10] = bflo(w1.y); u[11] = bfhi(w1.y); u[12] = bflo(w1.z); u[13] = bfhi(w1.z); u[14] = bflo(w1.w); u[15] = bfhi(w1.w);
            float sr = 0.f, si = 0.f;
#pragma unroll
            for (int c = 0; c < 16; ++c) { sr += bbr[c] * u[c]; si += bbi[c] * u[c]; }
            const float nxr = lr * xr - li * xi + sr, nxi = lr * xi + li * xr + si; xr = nxr; xi = nxi;
            float y[16];
#pragma unroll
            for (int c = 0; c < 16; ++c) y[c] = cr[c] * xr - ci[c] * xi;
            float w8[8], w4[4], w2[2], w1_;
            { const bool hi = (p & 32) != 0;
#pragma unroll
              for (int i = 0; i < 8; ++i) { const float keep = hi ? y[i + 8] : y[i], send = hi ? y[i] : y[i + 8]; w8[i] = keep + __shfl_xor(send, 32); } }
            { const bool hi = (p & 16) != 0;
#pragma unroll
              for (int i = 0; i < 4; ++i) { const float keep = hi ? w8[i + 4] : w8[i], send = hi ? w8[i] : w8[i + 4]; w4[i] = keep + __shfl_xor(send, 16); } }
            { const bool hi = (p & 8) != 0;
#pragma unroll
              for (int i = 0; i < 2; ++i) { const float keep = hi ? w4[i + 2] : w4[i], send = hi ? w4[i] : w4[i + 2]; w2[i] = keep + __shfl_xor(send, 8); } }
            { const bool hi = (p & 4) != 0; const float keep = hi ? w2[1] : w2[0], send = hi ? w2[0] : w2[1]; w1_ = keep + __shfl_xor(send, 4); }
            w1_ += __shfl_xor(w1_, 2); w1_ += __shfl_xor(w1_, 1);
            float umine = 0.f;
#pragma unroll
            for (int c = 0; c < 16; ++c) umine = (c == csel) ? u[c] : umine;
            if ((p & 3) == 0) Yb[(size_t)(b * SEQ + t) * SW + g * SGC + csel] = (bf16_t)f2bf(gelu_tanh(w1_ + dmine * umine));
        }
    }
}


__device__ __forceinline__ void p0_ssm_tables(Frame& F, int task) {
    const int g = task >> 3, part = task & 7;
    LAS float* pwr = (LAS float*)F.lds; LAS float* pwi = pwr + 65 * 64; LAS float* bbr = pwi + 65 * 64; LAS float* bbi = bbr + 1024; LAS float* ccr = bbi + 1024; LAS float* cci = ccr + 1024;
    const float dt = expf(F.in[I_LOGDT][g]);
    __syncthreads();
    for (int i = F.tid; i < 65 * 64; i += 512) { const int k = i >> 6, p = i & 63; const float are = fminf(F.in[I_ARE][g * SP + p], -1e-4f), aim = F.in[I_AIM][g * SP + p];
        const float mag = expf(are * dt * (float)k); double a = (double)aim * (double)dt * (double)k; a -= 6.283185307179586 * rint(a * 0.15915494309189535); const float af = (float)a;
        pwr[i] = mag * cosf(af); pwi[i] = mag * sinf(af); }
    for (int i = F.tid; i < 1024; i += 512) { const int p = i >> 4, c = i & 15; const float are = fminf(F.in[I_ARE][g * SP + p], -1e-4f), aim = F.in[I_AIM][g * SP + p];
        const float mag = expf(are * dt); double a = (double)aim * (double)dt; a -= 6.283185307179586 * rint(a * 0.15915494309189535); const float af = (float)a;
        const float lr = mag * cosf(af), li = mag * sinf(af), nr = lr - 1.0f, ni = li, den = 1.0f / (are * are + aim * aim), fr_ = (nr * are + ni * aim) * den, fi_ = (ni * are - nr * aim) * den;
        const float br = F.in[I_BRE][(size_t)(g * SP + p) * SGC + c], bi = F.in[I_BIM][(size_t)(g * SP + p) * SGC + c];
        bbr[i] = fr_ * br - fi_ * bi; bbi[i] = fr_ * bi + fi_ * br; }
    for (int i = F.tid; i < 1024; i += 512) { ccr[i] = F.in[I_CRE][(size_t)g * 1024 + i]; cci[i] = F.in[I_CIM][(size_t)g * 1024 + i]; }
    __syncthreads();
    bf16_t* WST = WSP(bf16_t, WS_WST) + (size_t)g * 128 * 1024; bf16_t* GT = WSP(bf16_t, WS_GT) + (size_t)g * 1024 * 128; bf16_t* KT = WSP(bf16_t, WS_KT) + (size_t)g * 65 * 256;
    for (int j = 0; j < 32; ++j) { const int e = part * 16384 + j * 512 + F.tid; const int pp = e >> 10, k = e & 1023, s = k >> 4, c = k & 15, p = pp & 63;
        const float mr = pwr[(63 - s) * 64 + p], mi = pwi[(63 - s) * 64 + p], br = bbr[p * 16 + c], bi = bbi[p * 16 + c];
        WST[e] = (bf16_t)f2bf(pp < 64 ? (mr * br - mi * bi) : (mr * bi + mi * br)); }
    for (int j = 0; j < 32; ++j) { const int e = part * 16384 + j * 512 + F.tid; const int sc = e >> 7, pp = e & 127, s = sc >> 4, c = sc & 15, p = pp & 63;
        const float mr = pwr[(s + 1) * 64 + p], mi = pwi[(s + 1) * 64 + p], cr = ccr[c * 64 + p], ci = cci[c * 64 + p];
        GT[e] = (bf16_t)f2bf(pp < 64 ? (cr * mr - ci * mi) : -(cr * mi + ci * mr)); }
    for (int e = part * 2080 + F.tid; e < (part + 1) * 2080; e += 512) { const int tt = e >> 8, c = (e >> 4) & 15, c2 = e & 15; float acc = 0.f;
        if (tt > 0) { const int tau = tt - 1;
            for (int p = 0; p < 64; ++p) { const float mr = pwr[tau * 64 + p], mi = pwi[tau * 64 + p], cr = ccr[c * 64 + p], ci = cci[c * 64 + p]; const float zr = cr * mr - ci * mi, zi = cr * mi + ci * mr; acc += zr * bbr[p * 16 + c2] - zi * bbi[p * 16 + c2]; } }
        KT[e] = (bf16_t)f2bf(acc); }
    if (part == 0 && F.tid < 64) { WSP(f32x2, WS_LAML)[g * 64 + F.tid] = (f32x2){pwr[64 * 64 + F.tid], pwi[64 * 64 + F.tid]}; }
    __syncthreads();
}
__device__ __forceinline__ void ssm_state_item(Frame& F, int b, int g, int h) {
    const int w = F.wave, row = F.lane & 15, kg = F.lane >> 4;
    f32x4 acc[4];
#pragma unroll
    for (int c = 0; c < 4; ++c) acc[c] = (f32x4){0.f, 0.f, 0.f, 0.f};
    const bf16_t* Ub = WSP(bf16_t, WS_U) + ((size_t)b * SEQ + (size_t)(16 * w + row) * 64 + (kg >> 1)) * SW + g * SGC + 8 * (kg & 1);
    const bf16_t* Wb = WSP(bf16_t, WS_WST) + ((size_t)g * 128 + 32 * h + row) * 1024 + 8 * kg;
#pragma unroll 4
    for (int ks = 0; ks < 32; ++ks) {
        const bf16x8 a = *(const bf16x8*)(Ub + ((size_t)(2 * ks)) * SW);
        bf16x8 bq[4];
#pragma unroll
        for (int nt = 0; nt < 4; ++nt) bq[nt] = *(const bf16x8*)(Wb + (size_t)((nt & 1) * 16 + (nt >> 1) * 64) * 1024 + 32 * ks);
#pragma unroll
        for (int nt = 0; nt < 4; ++nt) acc[nt] = __builtin_amdgcn_mfma_f32_16x16x32_bf16(a, bq[nt], acc[nt], 0, 0, 0);
    }
    LAS float* X = (LAS float*)F.lds;
    __syncthreads();
#pragma unroll
    for (int nt = 0; nt < 4; ++nt)
#pragma unroll
        for (int r = 0; r < 4; ++r) X[(16 * w + 4 * kg + r) * 64 + (nt >> 1) * 32 + (nt & 1) * 16 + row] = acc[nt][r];
    __syncthreads();
    if (w == 0 && F.lane < 32) { const int p = 32 * h + F.lane; const f32x2 lam = WSP(f32x2, WS_LAML)[g * 64 + p]; float sr = 0.f, si = 0.f;
        bf16_t* SS = WSP(bf16_t, WS_SST) + ((size_t)(b * NG + g) * 128) * 128;
#pragma unroll 4
        for (int n = 0; n < 128; ++n) { SS[n * 128 + p] = (bf16_t)f2bf(sr); SS[n * 128 + 64 + p] = (bf16_t)f2bf(si);
            const float xr = X[n * 64 + F.lane], xi = X[n * 64 + 32 + F.lane]; const float nsr = lam.x * sr - lam.y * si + xr, nsi = lam.x * si + lam.y * sr + xi; sr = nsr; si = nsi; } }
    __syncthreads();
}
constexpr int SO_USTR = 2064, SO_KT = 32 * SO_USTR, SO_SS = SO_KT + 65 * 512, SO_SSTR = 272;
__device__ __forceinline__ void ssm_out_item(Frame& F, int b, int g, int rr) {
    LAS unsigned char* L = F.lds;
    const int w = F.wave, lane = F.lane, r32 = lane & 31, hi = lane >> 5, sp = r32 >> 4, cch = r32 & 15;
    __syncthreads();
    { const bf16_t* Ug = WSP(bf16_t, WS_U) + ((size_t)b * SEQ + (size_t)rr * 2048) * SW + g * SGC;
#pragma unroll
      for (int j = 0; j < 8; ++j) { const int c = F.tid + 512 * j, r = c >> 1, half = c & 1; *(LAS u32x4*)(L + (r >> 6) * SO_USTR + (r & 63) * 32 + half * 16) = *(const u32x4*)(Ug + (size_t)r * SW + half * 8); }
      const u32x4* Kg = (const u32x4*)(WSP(bf16_t, WS_KT) + (size_t)g * 65 * 256);
      for (int c = F.tid; c < 2080; c += 512) *(LAS u32x4*)(L + SO_KT + c * 16) = Kg[c];
      { const int c = F.tid, ch = c >> 4, pc = c & 15; *(LAS u32x4*)(L + SO_SS + ch * SO_SSTR + pc * 16) = *(const u32x4*)(WSP(bf16_t, WS_SST) + ((size_t)((b * NG + g) * 128 + rr * 32 + ch)) * 128 + pc * 8); } }
    const bf16_t* Gg = WSP(bf16_t, WS_GT) + ((size_t)g * 1024 + (2 * w + sp) * 16 + cch) * 128 + 8 * hi;
    bf16x8 gb[2][8];
#pragma unroll
    for (int k2 = 0; k2 < 8; ++k2) gb[0][k2] = *(const bf16x8*)(Gg + 16 * k2);
    __syncthreads();
    f32x16 acc[4];
#pragma unroll
    for (int a = 0; a < 4; ++a)
#pragma unroll
        for (int r = 0; r < 16; ++r) acc[a][r] = 0.f;
    const LAS unsigned char* Ua = L + r32 * SO_USTR + hi * 16;
    const LAS unsigned char* Kb_ = L + SO_KT + (2 * w + sp + 1) * 512 + cch * 32 + hi * 16;
#define SO_SEG(A0, LO, HI) for (int s1 = (LO); s1 < (HI); ++s1) { const bf16x8 av = *(const LAS bf16x8*)(Ua + s1 * 32); \
        _Pragma("unroll") for (int a = (A0); a < 4; ++a) { const bf16x8 bv = *(const LAS bf16x8*)(Kb_ + a * 8192 - s1 * 512); acc[a] = __builtin_amdgcn_mfma_f32_32x32x16_bf16(av, bv, acc[a], 0, 0, 0); } }
    SO_SEG(0, 0, 2 * w + 2)
    SO_SEG(1, 2 * w + 2, 2 * w + 18)
    SO_SEG(2, 2 * w + 18, 2 * w + 34)
    SO_SEG(3, 2 * w + 34, 2 * w + 50)
#undef SO_SEG
    bf16x8 sa[8];
#pragma unroll
    for (int k2 = 0; k2 < 8; ++k2) sa[k2] = *(const LAS bf16x8*)(L + SO_SS + r32 * SO_SSTR + k2 * 32 + hi * 16);
#pragma unroll
    for (int a = 0; a < 4; ++a) {
        if (a < 3) {
#pragma unroll
            for (int k2 = 0; k2 < 8; ++k2) gb[(a + 1) & 1][k2] = *(const bf16x8*)(Gg + (size_t)(a + 1) * (16 * 16 * 128) + 16 * k2); }
#pragma unroll
        for (int k2 = 0; k2 < 8; ++k2) acc[a] = __builtin_amdgcn_mfma_f32_32x32x16_bf16(sa[k2], gb[a & 1][k2], acc[a], 0, 0, 0);
    }
    __syncthreads();
    const float dsk = F.in[I_DSKIP][g * SGC + cch];
    { LAS unsigned char* yb = L + (4 * hi) * SO_USTR + (2 * w + sp) * 32 + cch * 2;
#pragma unroll
      for (int a = 0; a < 4; ++a)
#pragma unroll
          for (int r = 0; r < 16; ++r) { LAS unsigned short* p = (LAS unsigned short*)(yb + ((r & 3) + 8 * (r >> 2)) * SO_USTR + a * 512); const float u = bf2f(*p); *p = (unsigned short)f2bf(gelu_tanh(acc[a][r] + dsk * u)); } }
    __syncthreads();
    { bf16_t* Yg = WSP(bf16_t, WS_YB) + ((size_t)b * SEQ + (size_t)rr * 2048) * SW + g * SGC;
#pragma unroll 2
      for (int j = 0; j < 8; ++j) { const int c = F.tid + 512 * j, r = c >> 1, half = c & 1; *(u32x4*)(Yg + (size_t)r * SW + half * 8) = *(const LAS u32x4*)(L + (r >> 6) * SO_USTR + (r & 63) * 32 + half * 16); } }
}
__device__ __forceinline__ void phase_ssm_out(Frame& F) {
    for (int it = F.bid; it < NB * NG * 4; it += F.G) ssm_out_item(F, it >> 7, (it >> 2) & 31, it & 3);
    __syncthreads();
}


__device__ __forceinline__ void moba_route_item(Frame& F, int bh, int i) {
    LAS float* km = (LAS float*)F.lds;
    LAS unsigned* lc = (LAS unsigned*)(F.lds + 8192); LAS unsigned* lb = lc + 32;
    const int b = bh >> 3, h = bh & 7, ql = F.tid >> 1, half = F.tid & 1;
    __syncthreads();
    { const float* K0 = WSP(float, WS_KM2) + (size_t)bh * NBLK * HD; const float* K1 = K0 + (size_t)NB * NH * NBLK * HD;
      for (int k = F.tid; k < NBLK * HD; k += 512) km[k] = K0[k] + K1[k]; }
    if (F.tid < 32) lc[F.tid] = 0u;
    float q[32];
    { const u32x4* qp = (const u32x4*)(WSP(bf16_t, WS_Q) + (size_t)(b * SEQ + i * MBLK + ql) * AW + h * HD + half * 32);
#pragma unroll
      for (int c = 0; c < 4; ++c) { const u32x4 w = qp[c]; q[8 * c + 0] = bflo(w.x); q[8 * c + 1] = bfhi(w.x); q[8 * c + 2] = bflo(w.y); q[8 * c + 3] = bfhi(w.y); q[8 * c + 4] = bflo(w.z); q[8 * c + 5] = bfhi(w.z); q[8 * c + 6] = bflo(w.w); q[8 * c + 7] = bfhi(w.w); } }
    __syncthreads();
    float g0 = -3e38f, g1 = -3e38f, g2 = -3e38f; int s0 = -1, s1 = -1, s2 = -1;
    for (int j = 0; j < i; ++j) { float g = 0.f;
#pragma unroll
        for (int d = 0; d < 32; ++d) g += q[d] * km[j * HD + half * 32 + d];
        g += __shfl_xor(g, 1);
        if (g > g0) { g2 = g1; s2 = s1; g1 = g0; s1 = s0; g0 = g; s0 = j; } else if (g > g1) { g2 = g1; s2 = s1; g1 = g; s1 = j; } else if (g > g2) { g2 = g; s2 = j; } }
    unsigned r0 = 0u, r1 = 0u, r2 = 0u;
    if (half == 0) { if (s0 >= 0) r0 = __hip_atomic_fetch_add(&lc[s0], 1u, __ATOMIC_RELAXED, __HIP_MEMORY_SCOPE_WORKGROUP); if (s1 >= 0) r1 = __hip_atomic_fetch_add(&lc[s1], 1u, __ATOMIC_RELAXED, __HIP_MEMORY_SCOPE_WORKGROUP);
        if (s2 >= 0) r2 = __hip_atomic_fetch_add(&lc[s2], 1u, __ATOMIC_RELAXED, __HIP_MEMORY_SCOPE_WORKGROUP); }
    __syncthreads();
    if (F.tid < 32) { const unsigned n = lc[F.tid]; lb[F.tid] = n ? atomicAdd(F.ctl + CW_MCNT + bh * NBLK + F.tid, n) : 0u; }
    __syncthreads();
    if (half == 0) { unsigned short* ML = WSP(unsigned short, WS_MLIST) + (size_t)bh * NBLK * 8192; const unsigned e = (unsigned)(i * MBLK + ql) * 4u;
        f32x2* pml = WSP(f32x2, WS_PML) + ((size_t)bh * SEQ + i * MBLK + ql) * 4;
        if (s0 >= 0) ML[(size_t)s0 * 8192 + lb[s0] + r0] = (unsigned short)(e + 0u); else pml[0] = (f32x2){-1e30f, 0.f};
        if (s1 >= 0) ML[(size_t)s1 * 8192 + lb[s1] + r1] = (unsigned short)(e + 1u); else pml[1] = (f32x2){-1e30f, 0.f};
        if (s2 >= 0) ML[(size_t)s2 * 8192 + lb[s2] + r2] = (unsigned short)(e + 2u); else pml[2] = (f32x2){-1e30f, 0.f}; }
}
template <int EXPM> __device__ __forceinline__ void moba_sparse_phase(Frame& F, char* lds_generic) {
    LAS unsigned* cl = (LAS unsigned*)(F.lds + attn_body::LDS_BYTES);
    LAS unsigned* pf = cl + 128;
    const int x = F.bid & 7, slot = F.bid >> 3, nslots = F.G >> 3;
    __syncthreads();
    if (F.tid < 128) cl[F.tid] = __hip_atomic_load(F.ctl + CW_MCNT + (x + 8 * (F.tid >> 5)) * NBLK + (F.tid & 31), RLX_AGENT);
    __syncthreads();
    if (F.tid == 0) { unsigned a = 0; for (int i = 0; i < 128; ++i) { pf[i] = a; a += 1u + ((cl[i] + 255u) >> 8); } pf[128] = a; }
    __syncthreads();
    const int total = (int)pf[128]; int pos = (int)(((long)total * slot) / nslots); const int end = (int)(((long)total * (slot + 1)) / nslots);
    const attn_body::bf16* Qb = (const attn_body::bf16*)WSP(bf16_t, WS_Q); const attn_body::bf16* Kb = (const attn_body::bf16*)WSP(bf16_t, WS_K); const attn_body::bf16* Vb = (const attn_body::bf16*)WSP(bf16_t, WS_V);
    attn_body::bf16* PO = (attn_body::bf16*)WSP(bf16_t, WS_PO); float* PML = WSP(float, WS_PML);
    const int wid = F.wave;
    int L = 0;
    while (pos < end) {
        while ((int)pf[L + 1] <= pos) ++L;
        const int m = L >> 5, j = L & 31, bh = x + 8 * m, b = bh >> 3, h = bh & 7, cnt = (int)cl[L];
        const int c0 = pos - (int)pf[L], c1 = min((int)pf[L + 1], end) - (int)pf[L];
        const size_t kvrow = (size_t)b * SEQ + (size_t)j * MBLK;
        __syncthreads();
        attn_body::moba_load_kv(Kb + kvrow * AW + h * HD, Vb + kvrow * AW + h * HD, lds_generic);
        __syncthreads();
        for (int c = c0; c < c1; ++c) {
            int l_ = F.lane; asm volatile("" : "+v"(l_)); const int r32 = l_ & 31;
            int qg, dest; bool causal;
            if (c == 0) { qg = j * MBLK + wid * 32 + r32; dest = (EXPM == 1) ? -1 : (bh * SEQ + qg) * 4 + 3; causal = true; }
            else { const int base = (c - 1) * 256 + wid * 32; if (base >= cnt) continue;
                const int idx = base + r32; causal = false;
                if (EXPM == 1) { qg = j * MBLK + wid * 32 + r32; dest = -1; }
                else if (idx < cnt) { const unsigned e = WSP(unsigned short, WS_MLIST)[((size_t)bh * NBLK + j) * 8192 + idx]; qg = (int)(e >> 2); dest = (bh * SEQ + qg) * 4 + (int)(e & 3u); }
                else { qg = j * MBLK + r32; dest = -1; } }
            attn_body::moba_chunk4<8>(Qb + ((size_t)b * SEQ + qg) * AW + h * HD, causal, dest, PO, PML, lds_generic);
        }
        pos += c1 - c0;
    }
    __syncthreads();
}
__device__ __forceinline__ void moba_combine_phase(Frame& F) {
    const bf16_t* PO = WSP(bf16_t, WS_PO); const f32x2* PML = WSP(f32x2, WS_PML); bf16_t* ATT = WSP(bf16_t, WS_ATT);
    for (size_t it = (size_t)F.bid * 512 + F.tid; it < (size_t)NB * NH * SEQ * 8; it += (size_t)F.G * 512) {
        const size_t r = it >> 3; const int ch = (int)(it & 7); const int bh = (int)(r / SEQ), qg = (int)(r % SEQ), b = bh >> 3, h = bh & 7;
        const f32x2 a0 = PML[r * 4 + 0], a1 = PML[r * 4 + 1], a2 = PML[r * 4 + 2], a3 = PML[r * 4 + 3];
        const float M = fmaxf(fmaxf(a0.x, a1.x), fmaxf(a2.x, a3.x));
        const float w0 = a0.y * __builtin_amdgcn_exp2f(a0.x - M), w1 = a1.y * __builtin_amdgcn_exp2f(a1.x - M), w2 = a2.y * __builtin_amdgcn_exp2f(a2.x - M), w3 = a3.y * __builtin_amdgcn_exp2f(a3.x - M);
        const float inv = 1.0f / (w0 + w1 + w2 + w3);
        float o[8] = {0.f, 0.f, 0.f, 0.f, 0.f, 0.f, 0.f, 0.f};
#define CMB(k, wk) if (wk > 0.f) { const u32x4 v = *(const u32x4*)(PO + (r * 4 + k) * 64 + ch * 8); o[0] += wk * bflo(v.x); o[1] += wk * bfhi(v.x); o[2] += wk * bflo(v.y); o[3] += wk * bfhi(v.y); o[4] += wk * bflo(v.z); o[5] += wk * bfhi(v.z); o[6] += wk * bflo(v.w); o[7] += wk * bfhi(v.w); }
        CMB(0, w0) CMB(1, w1) CMB(2, w2) CMB(3, w3)
#undef CMB
        u32x4 w; w.x = pk2(o[0] * inv, o[1] * inv); w.y = pk2(o[2] * inv, o[3] * inv); w.z = pk2(o[4] * inv, o[5] * inv); w.w = pk2(o[6] * inv, o[7] * inv);
        *(u32x4*)(ATT + ((size_t)b * SEQ + qg) * AW + h * HD + ch * 8) = w;
    }
}

__device__ __forceinline__ void phase_xattn_simple(Frame& F, bf16_t* Ob) {
    LAS unsigned* Ks = (LAS unsigned*)F.lds;
    LAS unsigned* Vs = (LAS unsigned*)(F.lds + 65536);
    const bf16_t *Qb = WSP(bf16_t, WS_XQ), *KV = WSP(bf16_t, WS_MKV);
    const int tl = F.tid >> 2, part = F.tid & 3;
    int lastbh = -1;
    for (int it = F.bid; it < NB * XH * (SEQ / 128); it += F.G) {
        const int bh = it / (SEQ / 128), ch = it % (SEQ / 128), b = bh / XH, h = bh % XH;
        if (bh != lastbh) { __syncthreads();
            for (int c = F.tid; c < 256 * 16; c += 512) { const int r = c >> 4, cc = c & 15;
                *(LAS u32x4*)(Ks + r * 64 + cc * 4) = *(const u32x4*)(KV + (size_t)(b * MEML + r) * (2 * XW) + h * XD + cc * 8);
                *(LAS u32x4*)(Vs + r * 64 + cc * 4) = *(const u32x4*)(KV + (size_t)(b * MEML + r) * (2 * XW) + XW + h * XD + cc * 8); }
            __syncthreads(); lastbh = bh; }
        const size_t row = (size_t)b * SEQ + ch * 128 + tl;
        float q[32];
        { const u32x4* qp = (const u32x4*)(Qb + row * XW + h * XD + part * 32);
#pragma unroll
          for (int c = 0; c < 4; ++c) { const u32x4 w = qp[c]; q[8 * c + 0] = bflo(w.x); q[8 * c + 1] = bfhi(w.x); q[8 * c + 2] = bflo(w.y); q[8 * c + 3] = bfhi(w.y); q[8 * c + 4] = bflo(w.z); q[8 * c + 5] = bfhi(w.z); q[8 * c + 6] = bflo(w.w); q[8 * c + 7] = bfhi(w.w); } }
        float mx = -3e38f, l = 0.f, o[32];
#pragma unroll
        for (int d = 0; d < 32; ++d) o[d] = 0.f;
        for (int kk = 0; kk < MEML; ++kk) { float s = 0.f;
#pragma unroll
            for (int c = 0; c < 4; ++c) { const u32x4 w = *(const LAS u32x4*)(Ks + kk * 64 + part * 16 + c * 4);
                s += q[8 * c + 0] * bflo(w.x) + q[8 * c + 1] * bfhi(w.x) + q[8 * c + 2] * bflo(w.y) + q[8 * c + 3] * bfhi(w.y) + q[8 * c + 4] * bflo(w.z) + q[8 * c + 5] * bfhi(w.z) + q[8 * c + 6] * bflo(w.w) + q[8 * c + 7] * bfhi(w.w); }
            s += __shfl_xor(s, 1); s += __shfl_xor(s, 2);
            const float mn = fmaxf(mx, s), corr = __builtin_amdgcn_exp2f(mx - mn), p = __builtin_amdgcn_exp2f(s - mn); mx = mn; l = l * corr + p;
#pragma unroll
            for (int c = 0; c < 4; ++c) { const u32x4 w = *(const LAS u32x4*)(Vs + kk * 64 + part * 16 + c * 4);
                o[8 * c + 0] = o[8 * c + 0] * corr + p * bflo(w.x); o[8 * c + 1] = o[8 * c + 1] * corr + p * bfhi(w.x); o[8 * c + 2] = o[8 * c + 2] * corr + p * bflo(w.y); o[8 * c + 3] = o[8 * c + 3] * corr + p * bfhi(w.y);
                o[8 * c + 4] = o[8 * c + 4] * corr + p * bflo(w.z); o[8 * c + 5] = o[8 * c + 5] * corr + p * bfhi(w.z); o[8 * c + 6] = o[8 * c + 6] * corr + p * bflo(w.w); o[8 * c + 7] = o[8 * c + 7] * corr + p * bfhi(w.w); } }
        const float il = 1.0f / l;
        u32x4* op = (u32x4*)(Ob + row * XW + h * XD + part * 32);
#pragma unroll
        for (int c = 0; c < 4; ++c) { u32x4 w; w.x = pk2(o[8 * c + 0] * il, o[8 * c + 1] * il); w.y = pk2(o[8 * c + 2] * il, o[8 * c + 3] * il); w.z = pk2(o[8 * c + 4] * il, o[8 * c + 5] * il); w.w = pk2(o[8 * c + 6] * il, o[8 * c + 7] * il); op[c] = w; }
    }
}

__device__ __forceinline__ void phase_router(Frame& F) {
    LAS float* wt = (LAS float*)F.lds;
    for (int c = F.tid; c < NE * DM; c += 512) { const int k = c >> 5, e = c & 31; wt[e * DM + k] = F.in[I_WROUTER][c] * F.in[I_GMOE][k]; }
    __syncthreads();
    const int gw = F.bid * 8 + F.wave, NGW = F.G * 8, lane = F.lane;
    const float* H = WSP(float, WS_H);
    unsigned* cnt = F.ctl + CW_CNT;
    for (int tk = gw; tk < T_; tk += NGW) {
        const f32x4* hp = (const f32x4*)(H + (size_t)tk * DM) + lane; f32x4 hv[4]; float ss = 0.f;
#pragma unroll
        for (int j = 0; j < 4; ++j) { hv[j] = hp[64 * j]; ss += (hv[j][0] * hv[j][0] + hv[j][1] * hv[j][1]) + (hv[j][2] * hv[j][2] + hv[j][3] * hv[j][3]); }
        const float rstd = 1.0f / sqrtf(wave_sum(ss) * (1.0f / DM) + RMS_EPS);
        float mylogit = 0.f;
#pragma unroll 4
        for (int e = 0; e < NE; ++e) { float a = 0.f;
#pragma unroll
            for (int j = 0; j < 4; ++j) { const f32x4 w = *(const LAS f32x4*)(wt + e * DM + 4 * lane + 256 * j); a += (hv[j][0] * w[0] + hv[j][1] * w[1]) + (hv[j][2] * w[2] + hv[j][3] * w[3]); }
            a = wave_sum(a);
            mylogit = (lane == e) ? a : mylogit; }
        mylogit = (lane < NE) ? (mylogit * rstd + F.in[I_BROUTER][lane & 31]) : -3e38f;
        float tv[4]; int ti[4]; float cur = mylogit;
#pragma unroll
        for (int s = 0; s < 4; ++s) { float bv = cur; int bi = lane;
#pragma unroll
            for (int o = 1; o < 64; o <<= 1) { const float ov = __shfl_xor(bv, o); const int oi = __shfl_xor(bi, o); if (ov > bv || (ov == bv && oi < bi)) { bv = ov; bi = oi; } }
            tv[s] = bv; ti[s] = bi; if (lane == bi) cur = -3e38f; }
        const float e1 = __expf(tv[1] - tv[0]), e2 = __expf(tv[2] - tv[0]), e3 = __expf(tv[3] - tv[0]); const float inv = 1.0f / (1.0f + e1 + e2 + e3);
        if (lane == 0) WSP(float, WS_RSTD2)[tk] = rstd;
        if (lane < 4) { const int ex = (lane == 0) ? ti[0] : (lane == 1) ? ti[1] : (lane == 2) ? ti[2] : ti[3]; const float gv = ((lane == 0) ? 1.0f : (lane == 1) ? e1 : (lane == 2) ? e2 : e3) * inv;
            WSP(float, WS_TKG)[(size_t)tk * 4 + lane] = gv;
            const unsigned rank = atomicAdd(&cnt[ex], 1u);
            WSP(int, WS_ROWLIST)[(size_t)ex * T_ + rank] = tk * 4 + lane; }
    }
}


constexpr int XA_VSTR = 520, XA_VT = 65536;
__device__ __forceinline__ bf16x8 pack8(const f32x16& s, int o) {
    u32x4 w; w.x = pg8::cvt_pk_bf16(s[o + 0], s[o + 1]); w.y = pg8::cvt_pk_bf16(s[o + 2], s[o + 3]); w.z = pg8::cvt_pk_bf16(s[o + 4], s[o + 5]); w.w = pg8::cvt_pk_bf16(s[o + 6], s[o + 7]);
    return __builtin_bit_cast(bf16x8, w);
}
__device__ __forceinline__ void phase_xattn(Frame& F) {
    LAS unsigned char* L = F.lds;
    const bf16_t *Qb = WSP(bf16_t, WS_XQ), *KV = WSP(bf16_t, WS_MKV); bf16_t* Ob = WSP(bf16_t, WS_XO);
    const int lane = F.lane, r32 = lane & 31, hi = lane >> 5, wid = F.wave;
    const int NU = NB * XH * (SEQ / 256), UPB = (NU + F.G - 1) / F.G;
    int lastbh = -1;
    for (int u = F.bid * UPB; u < NU && u < (F.bid + 1) * UPB; ++u) {
        const int bh = u >> 5, qb = u & 31, b = bh >> 2, h = bh & 3;
        if (bh != lastbh) {
            __syncthreads();
            for (int c = F.tid; c < 256 * 16; c += 512) { const int m = c >> 4, ch = c & 15; *(LAS u32x4*)(L + m * 256 + ((ch ^ (m & 15)) << 4)) = *(const u32x4*)(KV + (size_t)(b * MEML + m) * (2 * XW) + h * XD + ch * 8); }
            { const bf16_t* VTg = WSP(bf16_t, WS_MVT) + ((size_t)b * XW + h * XD) * MEML;
              for (int c = F.tid; c < 128 * 64; c += 512) { const int d = c >> 6, pc = c & 63; *(LAS u32x2*)(L + XA_VT + d * XA_VSTR + pc * 8) = *(const u32x2*)(VTg + (size_t)d * MEML + pc * 4); } }
            __syncthreads(); lastbh = bh; }
        const size_t row = (size_t)b * SEQ + qb * 256 + wid * 32 + r32;
        bf16x8 qf[8];
#pragma unroll
        for (int kd = 0; kd < 8; ++kd) qf[kd] = *(const bf16x8*)(Qb + row * XW + h * XD + 16 * kd + 8 * hi);
        f32x16 o[4];
#pragma unroll
        for (int dt = 0; dt < 4; ++dt)
#pragma unroll
            for (int r = 0; r < 16; ++r) o[dt][r] = 0.f;
        float mrun = -1e30f, lrun = 0.f;
#pragma unroll 1
        for (int c = 0; c < 4; ++c) {
            f32x16 s0, s1;
#pragma unroll
            for (int r = 0; r < 16; ++r) { s0[r] = 0.f; s1[r] = 0.f; }
            const int kv0 = c * 64 + r32, kv1 = kv0 + 32;
#pragma unroll
            for (int kd = 0; kd < 8; ++kd) { const int ch = 2 * kd + hi;
                const bf16x8 k0 = *(const LAS bf16x8*)(L + kv0 * 256 + ((ch ^ (kv0 & 15)) << 4)), k1 = *(const LAS bf16x8*)(L + kv1 * 256 + ((ch ^ (kv1 & 15)) << 4));
                s0 = __builtin_amdgcn_mfma_f32_32x32x16_bf16(k0, qf[kd], s0, 0, 0, 0); s1 = __builtin_amdgcn_mfma_f32_32x32x16_bf16(k1, qf[kd], s1, 0, 0, 0); }
            float mx = fmaxf(s0[0], s1[0]);
#pragma unroll
            for (int r = 1; r < 16; ++r) mx = fmaxf(mx, fmaxf(s0[r], s1[r]));
            mx = fmaxf(mx, __shfl_xor(mx, 32));
            const float mn = fmaxf(mrun, mx), sc = __builtin_amdgcn_exp2f(mrun - mn); mrun = mn;
            float ls = 0.f;
#pragma unroll
            for (int r = 0; r < 16; ++r) { s0[r] = __builtin_amdgcn_exp2f(s0[r] - mn); s1[r] = __builtin_amdgcn_exp2f(s1[r] - mn); ls += s0[r] + s1[r]; }
            ls += __shfl_xor(ls, 32); lrun = lrun * sc + ls;
#pragma unroll
            for (int dt = 0; dt < 4; ++dt)
#pragma unroll
                for (int r = 0; r < 16; ++r) o[dt][r] *= sc;
            bf16x8 pf[4]; pf[0] = pack8(s0, 0); pf[1] = pack8(s0, 8); pf[2] = pack8(s1, 0); pf[3] = pack8(s1, 8);
#pragma unroll
            for (int dt = 0; dt < 4; ++dt)
#pragma unroll
                for (int ks = 0; ks < 4; ++ks) { const LAS unsigned char* vp = L + XA_VT + (dt * 32 + r32) * XA_VSTR + (c * 64 + 16 * ks + 4 * hi) * 2;
                    const u32x2 lo = *(const LAS u32x2*)vp, hh = *(const LAS u32x2*)(vp + 16); u32x4 w; w.x = lo.x; w.y = lo.y; w.z = hh.x; w.w = hh.y;
                    o[dt] = __builtin_amdgcn_mfma_f32_32x32x16_bf16(__builtin_bit_cast(bf16x8, w), pf[ks], o[dt], 0, 0, 0); }
        }
        const float il = 1.0f / lrun;
        bf16_t* op = Ob + row * XW + h * XD + 4 * hi;
#pragma unroll
        for (int dt = 0; dt < 4; ++dt)
#pragma unroll
            for (int g4 = 0; g4 < 4; ++g4) { u32x2 w; w.x = pg8::cvt_pk_bf16(o[dt][4 * g4] * il, o[dt][4 * g4 + 1] * il); w.y = pg8::cvt_pk_bf16(o[dt][4 * g4 + 2] * il, o[dt][4 * g4 + 3] * il);
                *(u32x2*)(op + dt * 32 + 8 * g4) = w; }
    }
    __syncthreads();
}

constexpr int RT_WSTR = 1028, RT_LG = NE * RT_WSTR * 4  , RT_LCNT = RT_LG + 8 * 16 * 33 * 4  , RT_LBASE = RT_LCNT + 128, RT_RS = RT_LBASE + 128  ;
__device__ __forceinline__ void phase_router_mfma(Frame& F) {
    LAS float* wt = (LAS float*)F.lds;
    __syncthreads();
    for (int c = F.tid; c < NE * DM; c += 512) { const int k = c >> 5, e = c & 31; wt[e * RT_WSTR + k] = F.in[I_WROUTER][c] * F.in[I_GMOE][k]; }
    LAS unsigned* lcnt = (LAS unsigned*)(F.lds + RT_LCNT); LAS unsigned* lbase = (LAS unsigned*)(F.lds + RT_LBASE);
    const int lane = F.lane, wid = F.wave, row = lane & 15, kq = lane >> 4;
    LAS float* lg = (LAS float*)(F.lds + RT_LG) + wid * (16 * 33); LAS float* rsl = (LAS float*)(F.lds + RT_RS) + wid * 16;
    const bf16_t* HBp = WSP(bf16_t, WS_HB); bf16_t* N2 = WSP(bf16_t, WS_N2B); unsigned* cnt = F.ctl + CW_CNT;
    for (int chunk = F.bid; chunk < T_ / 128; chunk += F.G) {
        if (F.tid < 32) lcnt[F.tid] = 0u;
        __syncthreads();
        const int tok0 = chunk * 128 + wid * 16;
        f32x4 acc0 = {0.f, 0.f, 0.f, 0.f}, acc1 = {0.f, 0.f, 0.f, 0.f}; float ss = 0.f;
        const bf16_t* hp = HBp + (size_t)(tok0 + row) * DM + 8 * kq;
        const LAS float* w0 = wt + row * RT_WSTR + 8 * kq; const LAS float* w1 = w0 + 16 * RT_WSTR;
#pragma unroll 4
        for (int i = 0; i < 32; ++i) { const u32x4 hw = *(const u32x4*)(hp + 32 * i);
            const float a[8] = {bflo(hw.x), bfhi(hw.x), bflo(hw.y), bfhi(hw.y), bflo(hw.z), bfhi(hw.z), bflo(hw.w), bfhi(hw.w)};
            const f32x4 b00 = *(const LAS f32x4*)(w0 + 32 * i), b01 = *(const LAS f32x4*)(w0 + 32 * i + 4), b10 = *(const LAS f32x4*)(w1 + 32 * i), b11 = *(const LAS f32x4*)(w1 + 32 * i + 4);
#pragma unroll
            for (int e = 0; e < 8; ++e) ss += a[e] * a[e];
#pragma unroll
            for (int e = 0; e < 4; ++e) { acc0 = __builtin_amdgcn_mfma_f32_16x16x4f32(a[e], b00[e], acc0, 0, 0, 0); acc1 = __builtin_amdgcn_mfma_f32_16x16x4f32(a[e], b10[e], acc1, 0, 0, 0); }
#pragma unroll
            for (int e = 0; e < 4; ++e) { acc0 = __builtin_amdgcn_mfma_f32_16x16x4f32(a[4 + e], b01[e], acc0, 0, 0, 0); acc1 = __builtin_amdgcn_mfma_f32_16x16x4f32(a[4 + e], b11[e], acc1, 0, 0, 0); } }
        ss += __shfl_xor(ss, 16); ss += __shfl_xor(ss, 32);
        const float rstd = 1.0f / sqrtf(ss * (1.0f / DM) + RMS_EPS);
#pragma unroll
        for (int r = 0; r < 4; ++r) { lg[(4 * kq + r) * 33 + row] = acc0[r]; lg[(4 * kq + r) * 33 + 16 + row] = acc1[r]; }
        if (lane < 16) rsl[lane] = rstd;
        asm volatile("s_waitcnt lgkmcnt(0)" ::: "memory");
#pragma unroll 4
        for (int t = 0; t < 16; ++t) { const float rs = rsl[t]; const u32x4* src = (const u32x4*)(HBp + (size_t)(tok0 + t) * DM) + lane; u32x4* dst = (u32x4*)(N2 + (size_t)(tok0 + t) * DM) + lane;
#pragma unroll
            for (int hh = 0; hh < 2; ++hh) { const u32x4 w = src[64 * hh];
                if (MOE1_FP8) { int w0 = 0, w1 = 0;
                    w0 = __builtin_amdgcn_cvt_pk_fp8_f32(bflo(w.x) * rs, bfhi(w.x) * rs, w0, false); w0 = __builtin_amdgcn_cvt_pk_fp8_f32(bflo(w.y) * rs, bfhi(w.y) * rs, w0, true);
                    w1 = __builtin_amdgcn_cvt_pk_fp8_f32(bflo(w.z) * rs, bfhi(w.z) * rs, w1, false); w1 = __builtin_amdgcn_cvt_pk_fp8_f32(bflo(w.w) * rs, bfhi(w.w) * rs, w1, true);
                    ((u32x2*)((unsigned char*)N2 + (size_t)(tok0 + t) * DM))[lane + 64 * hh] = (u32x2){(unsigned)w0, (unsigned)w1}; }
                else { u32x4 o; o.x = pk2(bflo(w.x) * rs, bfhi(w.x) * rs); o.y = pk2(bflo(w.y) * rs, bfhi(w.y) * rs); o.z = pk2(bflo(w.z) * rs, bfhi(w.z) * rs); o.w = pk2(bflo(w.w) * rs, bfhi(w.w) * rs); dst[64 * hh] = o; } } }
        int ex[4] = {0, 0, 0, 0}; unsigned lrank[4] = {0u, 0u, 0u, 0u}; const int tk = tok0 + lane;
        if (lane < 16) {
            float v[32];
#pragma unroll
            for (int e = 0; e < 32; ++e) v[e] = lg[lane * 33 + e] * rstd + F.in[I_BROUTER][e];
            float tv[4];
#pragma unroll
            for (int s = 0; s < 4; ++s) { float bv = v[0]; int bi = 0;
#pragma unroll
                for (int e = 1; e < 32; ++e) if (v[e] > bv) { bv = v[e]; bi = e; }
#pragma unroll
                for (int e = 0; e < 32; ++e) v[e] = (e == bi) ? -3e38f : v[e];
                tv[s] = bv; ex[s] = bi; }
            const float e1 = __expf(tv[1] - tv[0]), e2 = __expf(tv[2] - tv[0]), e3 = __expf(tv[3] - tv[0]); const float inv = 1.0f / (1.0f + e1 + e2 + e3);
            *(f32x4*)(WSP(float, WS_TKG) + (size_t)tk * 4) = (f32x4){inv, e1 * inv, e2 * inv, e3 * inv};
#pragma unroll
            for (int s = 0; s < 4; ++s) lrank[s] = __hip_atomic_fetch_add(&lcnt[ex[s]], 1u, __ATOMIC_RELAXED, __HIP_MEMORY_SCOPE_WORKGROUP);
        }
        __syncthreads();
        if (F.tid < 32) lbase[F.tid] = atomicAdd(&cnt[F.tid], lcnt[F.tid]);
        __syncthreads();
        if (lane < 16) {
#pragma unroll
            for (int s = 0; s < 4; ++s) WSP(int, WS_ROWLIST)[(size_t)ex[s] * T_ + lbase[ex[s]] + lrank[s]] = tk * 4 + s; }
        __syncthreads();
    }
}

struct FinRegs { u32x2 hw[2][4]; u32x2 yw[2][4][4]; };
__device__ __forceinline__ void fin_load(const bf16_t* HBf, const bf16_t* Y, const int* INV, int tk, FinRegs& R, int lane) {
    int inv[2][4];
#pragma unroll
    for (int t = 0; t < 2; ++t)
#pragma unroll
        for (int s = 0; s < 4; ++s) inv[t][s] = __builtin_amdgcn_readfirstlane(INV[(size_t)(tk + t) * 4 + s]);
#pragma unroll
    for (int t = 0; t < 2; ++t) {
#pragma unroll
        for (int j = 0; j < 4; ++j) { R.hw[t][j] = ((const u32x2*)(HBf + (size_t)(tk + t) * DM))[lane + 64 * j];
#pragma unroll
            for (int s = 0; s < 4; ++s) { if (Y_FP8) { R.yw[t][s][j].x = ((const unsigned*)((const unsigned char*)Y + (size_t)inv[t][s] * DM))[lane + 64 * j]; R.yw[t][s][j].y = 0u; }
                else R.yw[t][s][j] = ((const u32x2*)(Y + (size_t)inv[t][s] * DM))[lane + 64 * j]; } } }
}
template <int FEXP> __device__ __forceinline__ void fin_finish(Frame& F, int tk, const FinRegs& R, const f32x4 (&gf)[4], int lane) {
#pragma unroll
    for (int t = 0; t < 2; ++t) { f32x4 hv[4]; float ss = 0.f;
#pragma unroll
        for (int j = 0; j < 4; ++j) { const u32x2 w = R.hw[t][j]; hv[j] = (f32x4){bflo(w.x), bfhi(w.x), bflo(w.y), bfhi(w.y)};
#pragma unroll
            for (int s = 0; s < 4; ++s) { const u32x2 y = R.yw[t][s][j];
                if (Y_FP8) { const float yi = 1.0f / (float)(1 << Y_SHIFT); hv[j][0] += __builtin_amdgcn_cvt_f32_fp8((int)y.x, 0) * yi; hv[j][1] += __builtin_amdgcn_cvt_f32_fp8((int)y.x, 1) * yi; hv[j][2] += __builtin_amdgcn_cvt_f32_fp8((int)y.x, 2) * yi; hv[j][3] += __builtin_amdgcn_cvt_f32_fp8((int)y.x, 3) * yi; }
                else { hv[j][0] += bflo(y.x); hv[j][1] += bfhi(y.x); hv[j][2] += bflo(y.y); hv[j][3] += bfhi(y.y); } }
            ss += (hv[j][0] * hv[j][0] + hv[j][1] * hv[j][1]) + (hv[j][2] * hv[j][2] + hv[j][3] * hv[j][3]); }
        float rstd = 1.0f / sqrtf(wave_sum(ss) * (1.0f / DM) + RMS_EPS);
#if DBG_STAGE
        { const float sd = __hip_atomic_load((float*)(F.ctl + CW_DBG), RLX_AGENT), sr = __hip_atomic_load((float*)(F.ctl + CW_DBG + 1), RLX_AGENT); rstd *= 1.0f + sqrtf(100.0f * sd / fmaxf(sr, 1e-30f)); }
#endif
        f32x4* op = (f32x4*)(((FEXP == 3) ? WSP(float, WS_PO) : F.out) + (size_t)(tk + t) * DM) + lane;
        if (FEXP == 1) { asm volatile("" :: "v"(hv[0][0] * rstd), "v"(hv[3][3] * rstd)); }
        else {
#pragma unroll
            for (int j = 0; j < 4; ++j) op[64 * j] = hv[j] * rstd * gf[j]; } }
}
template <int FEXP> __device__ __forceinline__ void phase_final_t(Frame& F) {
    const int gw = F.bid * 8 + F.wave, NGW = F.G * 8, lane = F.lane;
    const bf16_t* HBf = WSP(bf16_t, WS_HB); const bf16_t* Y = WSP(bf16_t, WS_Y); const int* INVp = WSP(int, WS_INV);
    f32x4 gf[4];
#pragma unroll
    for (int j = 0; j < 4; ++j) gf[j] = ((const f32x4*)F.in[I_GFINAL])[lane + 64 * j];
    FinRegs ra, rb; const int step = NGW * 2, t0 = gw * 2, n = (t0 < T_) ? (T_ - t0 + step - 1) / step : 0;
    if (n > 0) { fin_load(HBf, Y, INVp, t0, ra, lane); int i = 0;
        for (; i + 2 <= n; i += 2) {
            fin_load(HBf, Y, INVp, t0 + (i + 1) * step, rb, lane);
            fin_finish<FEXP>(F, t0 + i * step, ra, gf, lane);
            fin_load(HBf, Y, INVp, t0 + min(i + 2, n - 1) * step, ra, lane);
            fin_finish<FEXP>(F, t0 + (i + 1) * step, rb, gf, lane); }
        if (i < n) fin_finish<FEXP>(F, t0 + i * step, ra, gf, lane); }
}
__device__ __forceinline__ void phase_final(Frame& F) { phase_final_t<0>(F); }

__device__ __forceinline__ void dbg_compare(Frame& F, const bf16_t* A, const bf16_t* R, size_t n) {
    float sd = 0.f, sr = 0.f;
    for (size_t i = (size_t)F.bid * 512 + F.tid; i < n; i += (size_t)F.G * 512) { const float a = bf2f(A[i]), r = bf2f(R[i]); sd += (a - r) * (a - r); sr += r * r; }
    sd = wave_sum(sd); sr = wave_sum(sr);
    if (F.lane == 0) { atomicAdd((float*)(F.ctl + CW_DBG), sd); atomicAdd((float*)(F.ctl + CW_DBG + 1), sr); }
}
constexpr int N_PHASES = 15;
__global__ void __launch_bounds__(512, 2) mega_fwd(Args args) {
    extern __shared__ __attribute__((aligned(16))) unsigned char lds_raw[];
    Frame F;
    F.lds = (LAS unsigned char*)lds_raw; F.tid = threadIdx.x; F.lane = F.tid & 63; F.wave = __builtin_amdgcn_readfirstlane(F.tid >> 6); F.G = gridDim.x; F.bid = blockIdx.x;
#pragma unroll
    for (int i = 0; i < 28; ++i) F.in[i] = args.in[i];
    F.out = args.out; F.ws = args.ws; F.ctl = (unsigned*)(args.ws + WS_CTL);
    volatile LAS unsigned* MISC = (volatile LAS unsigned*)(F.lds + MISC_OFF);
    if (F.tid < 64) MISC[F.tid] = 0u;
    __syncthreads();
    const int lo = args.ph_lo, hi = args.ph_hi;
    XcdBarrier bar; bar.bar = F.ctl + CW_BAR; bar.x = 0; bar.st = nullptr;
    if (hi - lo > 1) bar = xcd_barrier_post(F.ctl + CW_BAR, MISC + 8);
#define IN(k) (lo <= (k) && (k) < hi)
#define SEAM(k) do { if (IN(k) && IN((k) + 1)) xcd_barrier(bar); } while (0)
    LAS unsigned char* ring = F.lds;
    const LAS int* gidx = (const LAS int*)(F.lds + GIDX_OFF);

    if (IN(0)) for (int rep_ = 0; rep_ <= ((REP_MASK >> 0) & 1) * REP_EXTRA; ++rep_) { if (rep_) xcd_barrier(bar);  phase_prologue(F); for (int tk = F.bid; tk < NG * 8; tk += F.G) p0_ssm_tables(F, tk); } SEAM(0);
    if (IN(1)) for (int rep_ = 0; rep_ <= ((REP_MASK >> 1) & 1) * REP_EXTRA; ++rep_) { if (rep_) xcd_barrier(bar);
        { pg8::Gemm g{WSP(bf16_t, WS_XB), WSP(bf16_t, WS_WIN), DM, 0}; pg8::PatchOrder S; S.init(T_ / 256, INW / 256, 8, F.G, F.bid);
          pg8::EpiInProj E{WSP(bf16_t, WS_Q), WSP(bf16_t, WS_K), WSP(bf16_t, WS_V), WSP(bf16_t, WS_U), WSP(bf16_t, WS_SGA), WSP(bf16_t, WS_SGB), WSP(float, WS_KM2)};
          pg8::gemm_phase<pg8::EpiInProj, pg8::PatchOrder, false>(ring, g, S, E, gidx, STG_TICKS);
#if NULL_EXP == 1
          { pg8::EpiNull EN; pg8::gemm_phase<pg8::EpiNull, pg8::PatchOrder, false>(ring, g, S, EN, gidx); pg8::gemm_phase<pg8::EpiNull, pg8::PatchOrder, false>(ring, g, S, EN, gidx); }
#elif NULL_EXP == 5
          { pg8::EpiStoreExp<false> EN{WSP(bf16_t, WS_N2B)}; pg8::gemm_phase<pg8::EpiStoreExp<false>, pg8::PatchOrder, false>(ring, g, S, EN, gidx); pg8::gemm_phase<pg8::EpiStoreExp<false>, pg8::PatchOrder, false>(ring, g, S, EN, gidx); }
#elif NULL_EXP == 6
          { pg8::EpiStoreExp<true> EN{WSP(bf16_t, WS_N2B)}; pg8::gemm_phase<pg8::EpiStoreExp<true>, pg8::PatchOrder, false>(ring, g, S, EN, gidx); pg8::gemm_phase<pg8::EpiStoreExp<true>, pg8::PatchOrder, false>(ring, g, S, EN, gidx); }
#elif NULL_EXP == 3
          { pg8::EpiInProjT<1> EN{E.Q, E.Kb, E.V, E.U, E.SGA, E.SGB, E.KM2}; pg8::gemm_phase<pg8::EpiInProjT<1>, pg8::PatchOrder, false>(ring, g, S, EN, gidx); pg8::gemm_phase<pg8::EpiInProjT<1>, pg8::PatchOrder, false>(ring, g, S, EN, gidx); }
#elif NULL_EXP == 4
          { pg8::EpiInProjT<2> EN{E.Q, E.Kb, E.V, E.U, E.SGA, E.SGB, E.KM2}; pg8::gemm_phase<pg8::EpiInProjT<2>, pg8::PatchOrder, false>(ring, g, S, EN, gidx); pg8::gemm_phase<pg8::EpiInProjT<2>, pg8::PatchOrder, false>(ring, g, S, EN, gidx); }
#endif
          }
        { pg8::Gemm g{WSP(bf16_t, WS_MN), WSP(bf16_t, WS_WXKV), DM, 0}; pg8::PatchOrder S; S.init(NB * MEML / 256, 2 * XW / 256, 4, F.G, F.bid);
          pg8::EpiMemKV E{WSP(bf16_t, WS_MKV), WSP(bf16_t, WS_MVT)};
          pg8::gemm_phase<pg8::EpiMemKV, pg8::PatchOrder, false>(ring, g, S, E, gidx); }
    } SEAM(1);
    if (IN(2)) for (int rep_ = 0; rep_ <= ((REP_MASK >> 2) & 1) * REP_EXTRA; ++rep_) { if (rep_) { xcd_barrier(bar); if (F.tid < 4) { for (int k_ = F.tid; k_ < 1024; k_ += 4) __hip_atomic_store(F.ctl + CW_MCNT + k_, 0u, RLX_AGENT); } __syncthreads(); xcd_barrier(bar); }
        for (int it = F.bid; it < NB * NG * 2; it += F.G) ssm_state_item(F, (it >> 1) / NG, (it >> 1) % NG, it & 1);
        for (int it = F.bid; it < NB * NH * NBLK; it += F.G) moba_route_item(F, it / NBLK, (NBLK - 1) - (it % NBLK));
    } SEAM(2);
    if (IN(3)) for (int rep_ = 0; rep_ <= ((REP_MASK >> 3) & 1) * REP_EXTRA; ++rep_) { if (rep_) xcd_barrier(bar);
        { int t_ = threadIdx.x; asm volatile("" : "+v"(t_)); F.tid = t_; F.lane = t_ & 63; F.wave = __builtin_amdgcn_readfirstlane(t_ >> 6); }
        moba_sparse_phase<0>(F, (char*)lds_raw);
#if MOBA_EXP == 1
        moba_sparse_phase<1>(F, (char*)lds_raw); moba_sparse_phase<1>(F, (char*)lds_raw);
#endif
        { int t_ = threadIdx.x; asm volatile("" : "+v"(t_)); F.tid = t_; F.lane = t_ & 63; F.wave = __builtin_amdgcn_readfirstlane(t_ >> 6); }
        phase_ssm_out(F);
    } SEAM(3);
#if DBG_STAGE == 1 || DBG_STAGE == 2
    moba_combine_phase(F); xcd_barrier(bar);
#endif
#if DBG_STAGE == 1
    phase_ssm_simple(F, WSP(bf16_t, WS_MERGED)); xcd_barrier(bar); dbg_compare(F, WSP(bf16_t, WS_YB), WSP(bf16_t, WS_MERGED), (size_t)T_ * SW); xcd_barrier(bar);
#elif DBG_STAGE == 2
    phase_moba_simple(F, WSP(bf16_t, WS_MERGED)); xcd_barrier(bar); dbg_compare(F, WSP(bf16_t, WS_ATT), WSP(bf16_t, WS_MERGED), (size_t)T_ * AW); xcd_barrier(bar);
#endif
    if (IN(5)) for (int rep_ = 0; rep_ <= ((REP_MASK >> 5) & 1) * REP_EXTRA; ++rep_) { if (rep_) xcd_barrier(bar);
#if !(DBG_STAGE == 1 || DBG_STAGE == 2)
        moba_combine_phase(F);
#endif
        pg8::Gemm g{WSP(bf16_t, WS_YB), WSP(bf16_t, WS_WGLU), SW, 0};
        pg8::EpiGlu E{WSP(bf16_t, WS_SGB), WSP(bf16_t, WS_YB2S)};
        if (F.G == 256) { pg8::PairOrder S; S.init(F.bid, 0); pg8::gemm_phase<pg8::EpiGlu, pg8::PairOrder, false>(ring, g, S, E, gidx); }
        else { pg8::PatchOrder S; S.init(T_ / 256, 2 * DM / 256, 8, F.G, F.bid); pg8::gemm_phase<pg8::EpiGlu, pg8::PatchOrder, false>(ring, g, S, E, gidx); }
    } if (F.G != 256) SEAM(5);
    if (IN(6)) for (int rep_ = 0; rep_ <= ((REP_MASK >> 6) & 1) * REP_EXTRA; ++rep_) { if (rep_) xcd_barrier(bar);
        pg8::Gemm g{WSP(bf16_t, WS_ATT), WSP(bf16_t, WS_WPA), AW, 0};
        pg8::EpiMerge E{WSP(bf16_t, WS_SGA), WSP(bf16_t, WS_YB2S), WSP(bf16_t, WS_MERGED)};
        if (F.G == 256) { pg8::PairOrder S; S.init(F.bid, 1); pg8::gemm_phase<pg8::EpiMerge, pg8::PairOrder, false>(ring, g, S, E, gidx); }
        else { pg8::PatchOrder S; S.init(T_ / 256, DM / 256, 4, F.G, F.bid); pg8::gemm_phase<pg8::EpiMerge, pg8::PatchOrder, false>(ring, g, S, E, gidx); }
    } SEAM(6);
    if (IN(7)) for (int rep_ = 0; rep_ <= ((REP_MASK >> 7) & 1) * REP_EXTRA; ++rep_) { if (rep_) xcd_barrier(bar);
        pg8::Gemm g{WSP(bf16_t, WS_MERGED), WSP(bf16_t, WS_WOUT), DM, 0}; pg8::PatchOrder S; S.init(T_ / 256, DM / 256, 4, F.G, F.bid);
        pg8::EpiResidT<true> E{F.in[I_X], WSP(bf16_t, WS_HB), WSP(float, WS_SSQ1)};
        pg8::gemm_phase<pg8::EpiResidT<true>, pg8::PatchOrder, false>(ring, g, S, E, gidx);
    } SEAM(7);
    if (IN(8)) for (int rep_ = 0; rep_ <= ((REP_MASK >> 8) & 1) * REP_EXTRA; ++rep_) { if (rep_) xcd_barrier(bar);
        pg8::Gemm g{WSP(bf16_t, WS_HB), WSP(bf16_t, WS_WXQ), DM, 0}; pg8::PatchOrder S; S.init(T_ / 256, XW / 256, 2, F.G, F.bid);
        pg8::EpiXq E{WSP(float, WS_SSQ1), WSP(bf16_t, WS_XQ)};
        pg8::gemm_phase<pg8::EpiXq, pg8::PatchOrder, false>(ring, g, S, E, gidx);
    } SEAM(8);
    if (IN(9)) for (int rep_ = 0; rep_ <= ((REP_MASK >> 9) & 1) * REP_EXTRA; ++rep_) { if (rep_) xcd_barrier(bar);  phase_xattn(F); } SEAM(9);
#if DBG_STAGE == 3
    phase_xattn_simple(F, WSP(bf16_t, WS_MERGED)); xcd_barrier(bar); dbg_compare(F, WSP(bf16_t, WS_XO), WSP(bf16_t, WS_MERGED), (size_t)T_ * XW); xcd_barrier(bar);
#endif
    if (IN(10)) for (int rep_ = 0; rep_ <= ((REP_MASK >> 10) & 1) * REP_EXTRA; ++rep_) { if (rep_) xcd_barrier(bar);
        pg8::Gemm g{WSP(bf16_t, WS_XO), WSP(bf16_t, WS_WXO), XW, 0}; pg8::PatchOrder S; S.init(T_ / 256, DM / 256, 4, F.G, F.bid);
        pg8::EpiResidT<false> E{nullptr, WSP(bf16_t, WS_HB), nullptr};
        pg8::gemm_phase<pg8::EpiResidT<false>, pg8::PatchOrder, false>(ring, g, S, E, gidx);
    } SEAM(10);
    if (IN(11)) for (int rep_ = 0; rep_ <= ((REP_MASK >> 11) & 1) * REP_EXTRA; ++rep_) { if (rep_) xcd_barrier(bar);  phase_router_mfma(F);
#if OUT_TOUCH
        { const int gw = F.bid * 8 + F.wave, NGW = F.G * 8;
          for (int tk = gw * 2; tk < T_; tk += NGW * 2) { if (F.lane < 2) { const float v = __builtin_nontemporal_load(F.out + (size_t)(tk + F.lane) * DM); asm volatile("" :: "v"(v)); } } }
#endif
    } SEAM(11);
    if (IN(12) || IN(13)) {
        LAS int* pref = (LAS int*)(F.lds + MISC_OFF + 256);
        const unsigned* cnt = F.ctl + CW_CNT;
        __syncthreads();
        if (F.tid == 0) { int a = 0; for (int e = 0; e < NE; ++e) { pref[e] = a; a += ((int)__hip_atomic_load(cnt + e, RLX_AGENT) + 255) >> 8; } pref[NE] = a; }
        __syncthreads();
        const int MT = pref[NE];
        if (IN(12)) for (int rep_ = 0; rep_ <= ((REP_MASK >> 12) & 1) * REP_EXTRA; ++rep_) { if (rep_) xcd_barrier(bar);
            MoeOrder S; S.P.init(MT, 2 * DFF / 256, 8, F.G, F.bid); S.pref = pref; S.rev = 0;
            { LAS int* gw_ = (LAS int*)(F.lds + GIDX_OFF); pg8::Unit u;
              for (int i = 0; i < GIDX_UNITS && S.next(i, u); ++i) { const int ce = (int)__hip_atomic_load(cnt + u.e, RLX_AGENT);
                  if (F.tid < 256) { const int rank = u.mi * 256 + F.tid; int tokslot = 0; if (rank < ce) { tokslot = WSP(int, WS_ROWLIST)[(size_t)u.e * T_ + rank]; if (u.pn == 0) WSP(int, WS_INV)[tokslot] = u.pm * 256 + F.tid; }
                      gw_[i * 256 + F.tid] = tokslot >> 2; } } }
            __syncthreads();
            pg8::Gemm g{WSP(bf16_t, WS_N2B), WSP(bf16_t, WS_WGU), MOE1_FP8 ? DM / 2 : DM, MOE1_FP8 ? (size_t)2 * DFF * DM / 2 : (size_t)2 * DFF * DM};
            if (MOE1_FP8) g.scaleB = 0x01010101 * (127 - FP8_WSHIFT);
            pg8::EpiMoe1 E{F.in[I_BGU], WSP(bf16_t, WS_HID)};
            pg8::gemm_phase<pg8::EpiMoe1, MoeOrder, true, MOE1_FP8 != 0>(ring, g, S, E, gidx, STG_TICKS);
#if NULL_EXP == 2
            { pg8::EpiNull EN; pg8::gemm_phase<pg8::EpiNull, MoeOrder, true>(ring, g, S, EN, gidx); }
#endif
        }
        SEAM(12);
        if (IN(13)) for (int rep_ = 0; rep_ <= ((REP_MASK >> 13) & 1) * REP_EXTRA; ++rep_) { if (rep_) xcd_barrier(bar);
            MoeOrder S; S.P.init(MT, DM / 256, 4, F.G, F.bid); S.pref = pref; S.rev = 1;
            pg8::Gemm g{WSP(bf16_t, WS_HID), WSP(bf16_t, WS_WDN), MOE2_FP8 ? DFF / 2 : DFF, MOE2_FP8 ? (size_t)DM * DFF / 2 : (size_t)DM * DFF};
            if (MOE2_FP8) g.scaleB = 0x01010101 * (127 - FP8_WSHIFT);
            { LAS int* tD = (LAS int*)(F.lds + GIDX_OFF); LAS float* tG = (LAS float*)(F.lds + GIDX_OFF + 12 * 1024); pg8::Unit u;
              __syncthreads();
              for (int i = 0; i < 12 && S.next(i, u); ++i) { const int ce = (int)__hip_atomic_load(cnt + u.e, RLX_AGENT);
                  if (F.tid < 256) { const int rank = u.mi * 256 + F.tid; int d = -1; float gv = 0.f; if (rank < ce) { d = WSP(int, WS_ROWLIST)[(size_t)u.e * T_ + rank]; gv = WSP(float, WS_TKG)[d]; } tD[i * 256 + F.tid] = d; tG[i * 256 + F.tid] = gv; } }
              __syncthreads(); }
            pg8::EpiMoe2 E{F.in[I_BDN], (const LAS int*)(F.lds + GIDX_OFF), (const LAS float*)(F.lds + GIDX_OFF + 12 * 1024), WSP(bf16_t, WS_Y)};
            pg8::gemm_phase<pg8::EpiMoe2, MoeOrder, false, MOE2_FP8 != 0>(ring, g, S, E, gidx, STG_TICKS);
        }
    } SEAM(13);
#if BAR_EXP
    for (int k_ = 0; k_ < 20; ++k_) xcd_barrier(bar);
#endif
    if (IN(14)) for (int rep_ = 0; rep_ <= ((REP_MASK >> 14) & 1) * REP_EXTRA; ++rep_) { if (rep_) xcd_barrier(bar);  phase_final(F);
#if FINAL_EXP
        phase_final_t<FINAL_EXP>(F); phase_final_t<FINAL_EXP>(F);
#endif
    }
#undef IN
#undef SEAM
}

extern "C" void kernel_launch(void* const* d_in, const int* in_sizes, int n_in, void* d_out, int out_size, void* d_ws, size_t ws_size, hipStream_t stream) {
    static int grid = 0;
    if (grid == 0) {
        if (n_in != 28 || in_sizes[0] != T_ * DM || out_size != T_ * DM || ws_size < WS_END) { fprintf(stderr, "kernel_launch: unexpected shapes (n_in %d, in0 %d, out %d, ws %zu)\n", n_in, n_in > 0 ? in_sizes[0] : -1, out_size, ws_size); grid = -1; return; }
        int dev = 0, cus = 0;
        if (hipGetDevice(&dev) != hipSuccess || hipDeviceGetAttribute(&cus, hipDeviceAttributeMultiprocessorCount, dev) != hipSuccess) { grid = -1; return; }
        if (hipFuncSetAttribute((const void*)mega_fwd, hipFuncAttributeMaxDynamicSharedMemorySize, LDS_BYTES) != hipSuccess) { fprintf(stderr, "kernel_launch: hipFuncSetAttribute failed\n"); grid = -1; return; }
        (void)hipGetLastError();
        grid = cus;
    }
    if (grid < 0) return;
    (void)hipMemsetAsync((char*)d_ws + WS_CTL, 0, CTL_ZERO_BYTES, stream);
    Args a{};
    for (int i = 0; i < 28; ++i) a.in[i] = (const float*)d_in[i];
    a.out = (float*)d_out; a.ws = (unsigned char*)d_ws;
#if MK_N_LAUNCHES == 1
    a.ph_lo = 0; a.ph_hi = N_PHASES;
    hipLaunchKernelGGL(mega_fwd, dim3(grid), dim3(512), LDS_BYTES, stream, a);
#else
    for (int p = 0; p < N_PHASES; ++p) { a.ph_lo = p; a.ph_hi = p + 1; hipLaunchKernelGGL(mega_fwd, dim3(grid), dim3(512), LDS_BYTES, stream, a); }
#endif
}
```

```cpp
#include <hip/hip_runtime.h>
#include <hip/hip_bf16.h>
#include <cmath>
#include <cstdio>
#include <cstdint>

#ifndef MK_N_LAUNCHES
#define MK_N_LAUNCHES 1
#endif

#ifndef REP_EXTRA
#define REP_EXTRA 1
#endif
#ifndef NULL_EXP
#define NULL_EXP 0
#endif
#ifndef STG_TICKS
#define STG_TICKS 0
#endif
#ifndef MOBA_EXP
#define MOBA_EXP 0
#endif
#ifndef OUT_NT
#define OUT_NT 0
#endif
#ifndef OUT_TOUCH
#define OUT_TOUCH 0
#endif
#ifndef BAR_EXP
#define BAR_EXP 0
#endif
#ifndef FINAL_EXP
#define FINAL_EXP 0
#endif
#ifndef MOE1_FP8
#define MOE1_FP8 1
#endif
constexpr int FP8_WSHIFT = 7;
#ifndef MOE2_FP8
#define MOE2_FP8 1
#endif
#ifndef Y_FP8
#define Y_FP8 1
#endif
constexpr int Y_SHIFT = 3;
#ifndef CONV_SLOTS
#define CONV_SLOTS 14
#endif
#ifndef REP_MASK
#define REP_MASK 0
#endif
#ifndef DBG_STAGE
#define DBG_STAGE 0
#endif

#define GAS __attribute__((address_space(1)))
#define LAS __attribute__((address_space(3)))
typedef unsigned short bf16_t;
typedef short bf16x8 __attribute__((ext_vector_type(8)));
typedef float f32x4 __attribute__((ext_vector_type(4)));
typedef float f32x2 __attribute__((ext_vector_type(2)));
typedef float f32x16 __attribute__((ext_vector_type(16)));
typedef unsigned u32x4 __attribute__((ext_vector_type(4)));
typedef unsigned u32x2 __attribute__((ext_vector_type(2)));

constexpr int NB = 4, SEQ = 8192, DM = 1024, T_ = NB * SEQ;
constexpr int AW = 512, NH = 8, HD = 64, MBLK = 256, NBLK = SEQ / MBLK, MTOPK = 3;
constexpr int SW = 512, SGC = 16, NG = 32, SP = 64;
constexpr int INW = 4096;
constexpr int MEML = 256, XH = 4, XD = 128, XW = 512;
constexpr int NE = 32, ETOPK = 4, DFF = 1024;
constexpr float RMS_EPS = 1e-6f;
constexpr float LOG2E = 1.4426950408889634f;
constexpr float QSCALE = 0.125f * LOG2E;
constexpr float XSCALE = 0.08838834764831845f * LOG2E;
constexpr int HID_ROWS = ETOPK * T_ + NE * 256;

constexpr size_t MiB = 1u << 20;
constexpr size_t WS_WIN = 0 * MiB, WS_WGLU = 8 * MiB, WS_WPA = 10 * MiB, WS_WOUT = 11 * MiB, WS_WXQ = 13 * MiB, WS_WXKV = 14 * MiB, WS_WXO = 16 * MiB,
                 WS_WGU = 17 * MiB, WS_WDN = 145 * MiB;
constexpr size_t WS_CTL = 209 * MiB, CTL_ZERO_BYTES = 1 * MiB;
constexpr size_t WS_RSTD0 = 210 * MiB;
constexpr size_t WS_RSTD2 = WS_RSTD0 + 128 * 1024;
constexpr size_t WS_KMEAN = WS_RSTD2 + 128 * 1024;
constexpr size_t WS_KM2 = WS_KMEAN;
constexpr size_t WS_TKG = 224 * MiB;
constexpr size_t WS_SSQ1 = 211 * MiB;
constexpr size_t WS_SSQ2 = 213 * MiB;
constexpr size_t WS_ROWLIST = 215 * MiB;
constexpr size_t WS_MN = 219 * MiB;
constexpr size_t WS_MKV = 221 * MiB;
constexpr size_t WS_MVT = 223 * MiB;
constexpr size_t WS_WST = 225 * MiB;
constexpr size_t WS_GT = 233 * MiB;
constexpr size_t WS_KT = 241 * MiB;
constexpr size_t WS_LAML = 243 * MiB;
constexpr size_t WS_SST = 244 * MiB;
constexpr size_t WS_H = 256 * MiB;
constexpr size_t WS_N2B = 256 * MiB;
constexpr size_t WS_PO = 256 * MiB;
constexpr size_t WS_PML = 384 * MiB;
constexpr size_t WS_MLIST = 392 * MiB;
constexpr size_t WS_HB = 384 * MiB;
constexpr size_t WS_HID = 448 * MiB;
constexpr size_t WS_Y = 720 * MiB;
constexpr size_t WS_END = 992 * MiB;
constexpr size_t WS_INV = 224 * MiB + 512 * 1024;
constexpr size_t WS_XB = 448 * MiB, WS_Q = 512 * MiB, WS_K = 544 * MiB, WS_V = 576 * MiB, WS_U = 608 * MiB, WS_ATT = 640 * MiB, WS_YB = 672 * MiB;
constexpr size_t WS_SGA = 720 * MiB, WS_SGB = 784 * MiB, WS_YB2S = 848 * MiB, WS_MERGED = 912 * MiB;
constexpr size_t WS_XQ = 448 * MiB, WS_XO = 480 * MiB;
static_assert(WS_HID + (size_t)HID_ROWS * DFF * 2 <= WS_Y, "HID fits");
constexpr int CW_TMO = 0, CW_CNT = 64  , CW_DBG = 128  , CW_MCNT = 256  , CW_ACNT = 1536  , CW_BAR = 4096;

constexpr int RING_BYTES = 131072;
constexpr int GIDX_OFF = RING_BYTES, GIDX_UNITS = 24;
constexpr int MISC_OFF = GIDX_OFF + GIDX_UNITS * 1024;
constexpr int LDS_BYTES = 163840;

#define RLX_AGENT __ATOMIC_RELAXED, __HIP_MEMORY_SCOPE_AGENT
__device__ __forceinline__ unsigned f2bf(float f) { unsigned u = __builtin_bit_cast(unsigned, f); return (u + 0x7fffu + ((u >> 16) & 1u)) >> 16; }
__device__ __forceinline__ unsigned pk2(float lo, float hi) { return f2bf(lo) | (f2bf(hi) << 16); }
__device__ __forceinline__ float bf2f(unsigned short b) { return __builtin_bit_cast(float, (unsigned)b << 16); }
__device__ __forceinline__ float bflo(unsigned w) { return __builtin_bit_cast(float, w << 16); }
__device__ __forceinline__ float bfhi(unsigned w) { return __builtin_bit_cast(float, w & 0xffff0000u); }
__device__ __forceinline__ float ub0(unsigned w) { return (float)(w & 0xffu) * (1.0f / 255.0f); }
__device__ __forceinline__ float ub1(unsigned w) { return (float)((w >> 8) & 0xffu) * (1.0f / 255.0f); }
__device__ __forceinline__ float ub2(unsigned w) { return (float)((w >> 16) & 0xffu) * (1.0f / 255.0f); }
__device__ __forceinline__ float ub3(unsigned w) { return (float)(w >> 24) * (1.0f / 255.0f); }
__device__ __forceinline__ float wave_sum(float v) {
#pragma unroll
    for (int o = 1; o < 64; o <<= 1) v += __shfl_xor(v, o);
    return v;
}
__device__ __forceinline__ float fsigmoid(float x) { return __builtin_amdgcn_rcpf(1.0f + __builtin_amdgcn_exp2f(-x * LOG2E)); }
__device__ __forceinline__ float gelu_tanh(float x) {
    const float u = 0.7978845608028654f * (x + 0.044715f * x * x * x);
    return x * fsigmoid(2.0f * u);
}

namespace pg8 {
constexpr int BM = 256, BK = 64, HALF = 128, HTB = HALF * BK * 2, STAGE_BYTES = 8 * HTB;
__host__ __device__ __forceinline__ int lds_byte(int r, int c) { const int st = (r >> 4) * 2 + (c >> 5), rr = r & 15, cc = c & 31, ob = rr * 64 + cc * 2; return st * 1024 + (ob ^ (((ob >> 9) & 1) << 5)); }
__host__ __device__ __forceinline__ void stage_rc(int b, int& R, int& C) { const int st = b / 1024, sb = b % 1024, swz = sb ^ (((sb >> 9) & 1) << 5); R = (st >> 1) * 16 + swz / 64; C = (st & 1) * 32 + (swz % 64) / 2; }
__host__ __device__ __forceinline__ int perm32(int rho) { const int n = rho >> 4, i = rho & 15; return 8 * (i >> 2) + 4 * n + (i & 3); }

struct Unit { int pm, pn, e, mi, ui; };
struct Gemm { const bf16_t* A; const bf16_t* Bt; int K; size_t b_estride; int scaleA = 0x7f7f7f7f, scaleB = 0x7f7f7f7f; };
typedef int v8i __attribute__((ext_vector_type(8)));

struct PatchOrder {
    int nM, nN, PM, PN, x, j, ok;
    __device__ __forceinline__ void init(int nM_, int nN_, int PN_, int G, int c) { nM = nM_; nN = nN_; PN = PN_; PM = (G / 8) / PN_; x = c & 7; j = c >> 3; ok = ((G & 7) == 0) && (PM * PN == G / 8) && (nN % PN == 0); if (!ok) { x = c; j = G; } }
    __device__ __forceinline__ bool next(int i, Unit& u) const {
        if (!ok) { const long L = (long)i * j + x; if (L >= (long)nM * nN) return false; u.pm = (int)(L / nN); u.pn = (int)(L % nN); u.e = 0; u.mi = u.pm; u.ui = i; return true; }
        const int p = 8 * i + x, npn = nN / PN, pmb = p / npn, pnb = p % npn;
        u.pm = pmb * PM + (j % PM); u.pn = pnb * PN + (j / PM); u.e = 0; u.mi = u.pm; u.ui = i;
        return u.pm < nM;
    }
};

struct PairOrder {
    int pp, q, mode;
    __device__ __forceinline__ void init(int c, int mode_) { const int x = c & 7, k = c >> 3; q = k & 3; pp = 8 * x + (k >> 2); mode = mode_; }
    __device__ __forceinline__ bool next(int i, Unit& u) const {
        if (mode == 0) { if (i >= 4) return false; u.pm = 2 * pp + (i >> 1); u.pn = 2 * q + (i & 1); }
        else { if (i >= 2) return false; u.pm = 2 * pp + i; u.pn = q; }
        u.e = 0; u.mi = u.pm; u.ui = i; return true;
    }
};
__device__ __forceinline__ unsigned cvt_pk_bf16(float lo, float hi) { unsigned r; asm volatile("v_cvt_pk_bf16_f32 %0, %1, %2" : "=v"(r) : "v"(lo), "v"(hi)); return r; }
#ifndef NT_STORES
#define NT_STORES 0
#endif
#ifndef WT_STORES
#define WT_STORES 0
#endif
__device__ __forceinline__ void st16(void* p, u32x4 v) {
#if WT_STORES
    asm volatile("global_store_dwordx4 %0, %1, off sc1\n\ts_nop 1" :: "v"(p), "v"(v) : "memory");
#elif NT_STORES
    __builtin_nontemporal_store(v, (u32x4*)p);
#else
    *(u32x4*)p = v;
#endif
}

template <class Epi, class Sched, bool GATHER, bool FP8 = false>
__device__ __forceinline__ void gemm_phase(LAS unsigned char* lds, const Gemm g, const Sched& S, const Epi& E, const LAS int* gidx, int stagger_ticks = 0) {
    if (stagger_ticks > 0) {
        const unsigned long long t0 = __builtin_amdgcn_s_memrealtime(); const unsigned long long dl = (unsigned long long)(stagger_ticks * ((blockIdx.x >> 3) & 3));
        while (__builtin_amdgcn_s_memrealtime() - t0 < dl) __builtin_amdgcn_s_sleep(8);
    }
    const int tid = threadIdx.x, wid = __builtin_amdgcn_readfirstlane(tid >> 6), lane = tid & 63, wr = wid >> 2, wc = wid & 3, fr = lane & 15, fq = lane >> 4;
    const int K = g.K, nt = K / BK;
    int Ra[2], Ca[2]; unsigned voffB[2];
#pragma unroll
    for (int i = 0; i < 2; ++i) { int R, C; stage_rc(tid * 16 + i * 8192, R, C); const int Rb = Epi::PERM ? ((R & ~31) + perm32(R & 31)) : R;
        Ra[i] = R; Ca[i] = C; voffB[i] = (unsigned)(Rb * K + C) * 2u; }
    const size_t kstep = (size_t)(BK * 2);
    const size_t hstep = (size_t)HALF * K * 2;
    const size_t tstep = 2 * hstep;
    const unsigned ldsw = (unsigned)wid * 1024u;
    const int aoff = lds_byte(wr * 64 + fr, fq * 8), boff = lds_byte(wc * 32 + fr, fq * 8);
#define PG8_SA(b, h) (((b) * 2 + (h)) * HTB)
#define PG8_SB(b, h) ((4 + (b) * 2 + (h)) * HTB)
#define PG8_STAGE(bufoff, gbase, voff) do { _Pragma("unroll") for (int _i = 0; _i < 2; ++_i) \
        __builtin_amdgcn_global_load_lds((const unsigned*)((const char*)(gbase) + (voff)[_i]), (LAS unsigned*)(lds + (bufoff) + ldsw + _i * 8192), 16, 0, 0); } while (0)
#define PG8_LDA_BF(dst, b, h) do { _Pragma("unroll") for (int m = 0; m < 4; ++m) _Pragma("unroll") for (int k = 0; k < 2; ++k) dst[m][k] = *(const LAS bf16x8*)(lds + PG8_SA(b, h) + aoff + m * 2048 + k * 1024); } while (0)
#define PG8_LDB_BF(dst, b, h) do { _Pragma("unroll") for (int n = 0; n < 2; ++n) _Pragma("unroll") for (int k = 0; k < 2; ++k) dst[n][k] = *(const LAS bf16x8*)(lds + PG8_SB(b, h) + boff + n * 2048 + k * 1024); } while (0)
#define PG8_LD8(dst, base_) do { const u32x4 lo_ = *(const LAS u32x4*)(base_), hi_ = *(const LAS u32x4*)((base_) + 1024); dst = (v8i){(int)lo_.x, (int)lo_.y, (int)lo_.z, (int)lo_.w, (int)hi_.x, (int)hi_.y, (int)hi_.z, (int)hi_.w}; } while (0)
#define PG8_LDA8(dst, b, h) do { _Pragma("unroll") for (int m = 0; m < 4; ++m) PG8_LD8(dst[m], lds + PG8_SA(b, h) + aoff + m * 2048); } while (0)
#define PG8_LDB8(dst, b, h) do { _Pragma("unroll") for (int n = 0; n < 2; ++n) PG8_LD8(dst[n], lds + PG8_SB(b, h) + boff + n * 2048); } while (0)
#define PG8_LDA(dst, b, h) do { if constexpr (FP8) PG8_LDA8(dst##8, b, h); else PG8_LDA_BF(dst, b, h); } while (0)
#define PG8_LDB(dst, b, h) do { if constexpr (FP8) PG8_LDB8(dst##8, b, h); else PG8_LDB_BF(dst, b, h); } while (0)
#define PG8_MMA_BF(ai, bj, At, Bt) do { __builtin_amdgcn_s_setprio(1); _Pragma("unroll") for (int m = 0; m < 4; ++m) _Pragma("unroll") for (int n = 0; n < 2; ++n) _Pragma("unroll") for (int k = 0; k < 2; ++k) \
        acc[ai][bj][m][n] = __builtin_amdgcn_mfma_f32_16x16x32_bf16(Bt[n][k], At[m][k], acc[ai][bj][m][n], 0, 0, 0); __builtin_amdgcn_s_setprio(0); } while (0)
#define PG8_MMA_F8(ai, bj, At, Bt) do { __builtin_amdgcn_s_setprio(1); _Pragma("unroll") for (int m = 0; m < 4; ++m) _Pragma("unroll") for (int n = 0; n < 2; ++n) \
        asm volatile("s_nop 1\n\tv_mfma_scale_f32_16x16x128_f8f6f4 %0, %1, %2, %0, %3, %4 op_sel_hi:[0,0,0]" : "+v"(acc[ai][bj][m][n]) : "v"(Bt[n]), "v"(At[m]), "v"(sclB), "v"(sclA)); \
        __builtin_amdgcn_s_setprio(0); } while (0)
#define PG8_MMA(ai, bj, At, Bt) do { if constexpr (FP8) PG8_MMA_F8(ai, bj, At##8, Bt##8); else PG8_MMA_BF(ai, bj, At, Bt); } while (0)
#define PG8_WAIT_V(n) asm volatile("s_waitcnt vmcnt(" #n ")" ::: "memory")
#define PG8_WAIT_L(n) asm volatile("s_waitcnt lgkmcnt(" #n ")" ::: "memory")
#define PG8_BAR __builtin_amdgcn_s_barrier()
#define PG8_SCHED __builtin_amdgcn_sched_barrier(0)
#define PG8_VOA(dst, u) do { _Pragma("unroll") for (int _h = 0; _h < 2; ++_h) _Pragma("unroll") for (int _i = 0; _i < 2; ++_i) { \
        const int _row = GATHER ? gidx[(u).ui * 256 + _h * HALF + Ra[_i]] : (_h * HALF + Ra[_i]); dst[_h][_i] = (unsigned)(_row * K + Ca[_i]) * 2u; } } while (0)
    Unit cur, nxt; int ui = 0;
    if (!S.next(0, cur)) return;
    f32x4 acc[2][2][4][2];
#pragma unroll
    for (int a = 0; a < 2; ++a)
#pragma unroll
        for (int b = 0; b < 2; ++b)
#pragma unroll
            for (int m = 0; m < 4; ++m)
#pragma unroll
                for (int n = 0; n < 2; ++n) acc[a][b][m][n] = (f32x4){0.f, 0.f, 0.f, 0.f};
    bf16x8 At[4][2], B0[2][2], B1[2][2]; v8i At8[4], B08[2], B18[2];
    unsigned voA[2][2];
    const int sclA = g.scaleA, sclB = g.scaleB;
    PG8_VOA(voA, cur);
    const char* cA = (const char*)g.A + (GATHER ? (size_t)0 : (size_t)cur.pm * tstep);
    const char* cB = (const char*)g.Bt + ((size_t)cur.e * g.b_estride) * 2 + (size_t)cur.pn * tstep;
    PG8_STAGE(PG8_SB(0, 0), cB, voffB); PG8_STAGE(PG8_SB(0, 1), cB + hstep, voffB); PG8_STAGE(PG8_SA(0, 0), cA, voA[0]); PG8_STAGE(PG8_SA(0, 1), cA, voA[1]);
    if (wr == 1) PG8_BAR;
    PG8_WAIT_V(2); PG8_BAR;
    PG8_STAGE(PG8_SB(1, 0), cB + kstep, voffB); PG8_STAGE(PG8_SA(1, 0), cA + kstep, voA[0]); PG8_STAGE(PG8_SB(1, 1), cB + hstep + kstep, voffB);
    PG8_WAIT_V(6); PG8_BAR;
    for (;;) {
        const bool has_next = S.next(ui + 1, nxt);
        const char* nA = cA; const char* nB = cB;
        if (has_next) { nA = (const char*)g.A + (GATHER ? (size_t)0 : (size_t)nxt.pm * tstep); nB = (const char*)g.Bt + ((size_t)nxt.e * g.b_estride) * 2 + (size_t)nxt.pn * tstep; }
#pragma unroll 1
        for (int t = 0; t < nt; t += 2) {
            const bool last = (t == nt - 2);
            const char* a1 = cA + (size_t)(t + 1) * kstep;
            const char* a2 = last ? nA : cA + (size_t)(t + 2) * kstep; const char* b2 = last ? nB : cB + (size_t)(t + 2) * kstep;
            const char* a3 = a2 + kstep; const char* b3 = b2 + kstep;
            unsigned vo2[2][2];
#pragma unroll
            for (int h = 0; h < 2; ++h)
#pragma unroll
                for (int i = 0; i < 2; ++i) vo2[h][i] = voA[h][i];
            if (GATHER && last && has_next) { PG8_VOA(vo2, nxt); }
            PG8_LDB(B0, 0, 0); PG8_LDB(B1, 0, 1); PG8_SCHED; PG8_LDA(At, 0, 0); PG8_STAGE(PG8_SA(1, 1), a1, voA[1]);
            PG8_WAIT_V(8); PG8_WAIT_L(0); PG8_BAR; PG8_MMA(0, 0, At, B0); PG8_MMA(0, 1, At, B1); PG8_BAR; PG8_SCHED;
            PG8_LDA(At, 0, 1); PG8_STAGE(PG8_SB(0, 0), b2, voffB); PG8_STAGE(PG8_SB(0, 1), b2 + hstep, voffB); PG8_STAGE(PG8_SA(0, 0), a2, vo2[0]);
            PG8_WAIT_V(8); PG8_WAIT_L(0); PG8_BAR; PG8_MMA(1, 0, At, B0); PG8_MMA(1, 1, At, B1); PG8_BAR; PG8_SCHED;
            PG8_LDB(B0, 1, 0); PG8_LDB(B1, 1, 1); PG8_SCHED; PG8_LDA(At, 1, 0); PG8_STAGE(PG8_SA(0, 1), a2, vo2[1]);
            PG8_WAIT_V(8); PG8_WAIT_L(0); PG8_BAR; PG8_MMA(0, 0, At, B0); PG8_MMA(0, 1, At, B1); PG8_BAR; PG8_SCHED;
            PG8_LDA(At, 1, 1); PG8_STAGE(PG8_SB(1, 0), b3, voffB); PG8_STAGE(PG8_SB(1, 1), b3 + hstep, voffB); PG8_STAGE(PG8_SA(1, 0), a3, vo2[0]);
            PG8_WAIT_V(8); PG8_WAIT_L(0); PG8_BAR; PG8_MMA(1, 0, At, B0); PG8_MMA(1, 1, At, B1); PG8_BAR; PG8_SCHED;
        }
        if (wr == 0) PG8_BAR;
        if constexpr (FP8) asm volatile("s_nop 15\n\ts_nop 15" ::: "memory");
        E(acc, cur, wr, wc, fr, fq);
        if (!has_next) break;
#pragma unroll
        for (int a = 0; a < 2; ++a)
#pragma unroll
            for (int b = 0; b < 2; ++b)
#pragma unroll
                for (int m = 0; m < 4; ++m)
#pragma unroll
                    for (int n = 0; n < 2; ++n) acc[a][b][m][n] = (f32x4){0.f, 0.f, 0.f, 0.f};
        cur = nxt; cA = nA; cB = nB; ++ui;
        if (GATHER) { PG8_VOA(voA, cur); }
        if (wr == 1) PG8_BAR;
    }
    PG8_WAIT_V(0);
    PG8_BAR;
#undef PG8_SA
#undef PG8_SB
#undef PG8_STAGE
#undef PG8_LDA
#undef PG8_LDA_BF
#undef PG8_LDA8
#undef PG8_LD8
#undef PG8_LDB
#undef PG8_LDB_BF
#undef PG8_LDB8
#undef PG8_MMA
#undef PG8_MMA_BF
#undef PG8_MMA_F8
#undef PG8_WAIT_V
#undef PG8_WAIT_L
#undef PG8_BAR
#undef PG8_SCHED
#undef PG8_VOA
}

typedef const f32x4 (&AccRef)[2][2][4][2];
#define EPI_ROWS for (int ai = 0; ai < 2; ++ai) _Pragma("unroll") for (int m = 0; m < 4; ++m)

template <int XMODE> struct EpiInProjT {
    static constexpr bool PERM = true;
    bf16_t *Q, *Kb, *V, *U, *SGA, *SGB; float* KM2;
    __device__ __forceinline__ void operator()(AccRef acc, const Unit& u, int wr, int wc, int fr, int fq) const {
        bf16_t* dst; int ld, colt; bool sig = false; float sc = 1.f;
        if (u.pn < 2) { dst = Q; ld = AW; colt = u.pn * 256; sc = QSCALE; }
        else if (u.pn < 4) { dst = Kb; ld = AW; colt = (u.pn - 2) * 256; }
        else if (u.pn < 6) { dst = V; ld = AW; colt = (u.pn - 4) * 256; }
        else if (u.pn < 8) { dst = U; ld = AW; colt = (u.pn - 6) * 256; }
        else if (u.pn < 12) { dst = SGA; ld = DM; colt = (u.pn - 8) * 256; sig = true; }
        else { dst = SGB; ld = DM; colt = (u.pn - 12) * 256; sig = true; }
        const int row0 = u.pm * BM + wr * 64 + fr, col0 = colt + wc * 32 + 8 * fq;
        const bool isk = (u.pn == 2 || u.pn == 3); f32x4 cs[2][2];
#pragma unroll
        for (int bj = 0; bj < 2; ++bj)
#pragma unroll
            for (int n = 0; n < 2; ++n) cs[bj][n] = (f32x4){0.f, 0.f, 0.f, 0.f};
#pragma unroll
        EPI_ROWS { const int row = row0 + ai * HALF + m * 16; const float rs = sc; bf16_t* rowp = dst + (size_t)row * ld + col0;
#pragma unroll
            for (int bj = 0; bj < 2; ++bj) { f32x4 v0 = acc[ai][bj][m][0] * rs, v1 = acc[ai][bj][m][1] * rs;
                cs[bj][0] += v0; cs[bj][1] += v1;
                if (sig) {
                    unsigned q[8];
#pragma unroll
                    for (int e = 0; e < 4; ++e) { q[e] = (unsigned)(fsigmoid(v0[e]) * 255.0f + 0.5f); q[4 + e] = (unsigned)(fsigmoid(v1[e]) * 255.0f + 0.5f); }
                    const unsigned g0 = q[0] | (q[1] << 8) | (q[2] << 16) | (q[3] << 24), g1 = q[4] | (q[5] << 8) | (q[6] << 16) | (q[7] << 24);
                    if (XMODE != 1) *(u32x2*)((unsigned char*)dst + (size_t)row * ld + col0 + bj * HALF) = (u32x2){g0, g1};
                    continue; }
                u32x4 w; w.x = cvt_pk_bf16(v0[0], v0[1]); w.y = cvt_pk_bf16(v0[2], v0[3]); w.z = cvt_pk_bf16(v1[0], v1[1]); w.w = cvt_pk_bf16(v1[2], v1[3]);
                if (XMODE == 1) { asm volatile("" :: "v"(w)); } else st16(rowp + bj * HALF, w); } }
        if (isk && XMODE == 0) {
#pragma unroll
            for (int bj = 0; bj < 2; ++bj)
#pragma unroll
                for (int n = 0; n < 2; ++n)
#pragma unroll
                    for (int e = 0; e < 4; ++e) { float v = cs[bj][n][e]; v += __shfl_xor(v, 1); v += __shfl_xor(v, 2); v += __shfl_xor(v, 4); v += __shfl_xor(v, 8); cs[bj][n][e] = v; }
            if (fr == 0) { const int b = u.pm / NBLK, j = u.pm % NBLK;
#pragma unroll
                for (int bj = 0; bj < 2; ++bj) { const int col = colt + bj * HALF + wc * 32 + 8 * fq, h = col >> 6, d = col & 63;
                    float* kp = KM2 + ((((size_t)wr * NB + b) * NH + h) * NBLK + j) * HD + d;
                    *(f32x4*)kp = cs[bj][0] * (1.0f / MBLK); *(f32x4*)(kp + 4) = cs[bj][1] * (1.0f / MBLK); } } }
    }
};
struct EpiNull {
    static constexpr bool PERM = true;
    __device__ __forceinline__ void operator()(AccRef acc, const Unit& u, int wr, int wc, int fr, int fq) const {
#pragma unroll
        EPI_ROWS {
#pragma unroll
            for (int bj = 0; bj < 2; ++bj) { asm volatile("" :: "v"(acc[ai][bj][m][0]), "v"(acc[ai][bj][m][1])); } }
    }
};
typedef EpiInProjT<0> EpiInProj;
template <bool FULL> struct EpiStoreExp {
    static constexpr bool PERM = true;
    bf16_t* O;
    __device__ __forceinline__ void operator()(AccRef acc, const Unit& u, int wr, int wc, int fr, int fq) const {
        const int row0 = u.pm * BM + wr * 64 + (FULL ? (fr & 7) : fr), col0 = (u.pn & 3) * BM + (FULL ? (wc * 64 + (fr >> 3) * 32 + 8 * fq) : (wc * 32 + 8 * fq));
#pragma unroll
        EPI_ROWS { bf16_t* rowp = O + (size_t)(row0 + ai * HALF + m * 16) * DM + col0;
#pragma unroll
            for (int bj = 0; bj < 2; ++bj) { const f32x4 v0 = acc[ai][bj][m][0], v1 = acc[ai][bj][m][1];
                u32x4 w; w.x = cvt_pk_bf16(v0[0], v0[1]); w.y = cvt_pk_bf16(v0[2], v0[3]); w.z = cvt_pk_bf16(v1[0], v1[1]); w.w = cvt_pk_bf16(v1[2], v1[3]);
                st16(rowp + (FULL ? (size_t)bj * 8 * DM : (size_t)bj * HALF), w); } }
    }
};
struct EpiStore {
    static constexpr bool PERM = true;
    bf16_t* O; int ld;
    __device__ __forceinline__ void operator()(AccRef acc, const Unit& u, int wr, int wc, int fr, int fq) const {
        const int row0 = u.pm * BM + wr * 64 + fr, col0 = u.pn * BM + wc * 32 + 8 * fq;
#pragma unroll
        EPI_ROWS { bf16_t* rowp = O + (size_t)(row0 + ai * HALF + m * 16) * ld + col0;
#pragma unroll
            for (int bj = 0; bj < 2; ++bj) { const f32x4 v0 = acc[ai][bj][m][0], v1 = acc[ai][bj][m][1];
                u32x4 w; w.x = cvt_pk_bf16(v0[0], v0[1]); w.y = cvt_pk_bf16(v0[2], v0[3]); w.z = cvt_pk_bf16(v1[0], v1[1]); w.w = cvt_pk_bf16(v1[2], v1[3]);
                st16(rowp + bj * HALF, w); } }
    }
};
struct EpiMemKV {
    static constexpr bool PERM = true;
    bf16_t* O; bf16_t* VT;
    __device__ __forceinline__ void operator()(AccRef acc, const Unit& u, int wr, int wc, int fr, int fq) const {
        const int rl0 = wr * 64 + fr, col0 = u.pn * BM + wc * 32 + 8 * fq;
#pragma unroll
        EPI_ROWS { const int rl = rl0 + ai * HALF + m * 16;
#pragma unroll
            for (int bj = 0; bj < 2; ++bj) { const f32x4 v0 = acc[ai][bj][m][0], v1 = acc[ai][bj][m][1]; const int col = col0 + bj * HALF;
                if (u.pn < 2) { u32x4 w; w.x = cvt_pk_bf16(v0[0], v0[1]); w.y = cvt_pk_bf16(v0[2], v0[3]); w.z = cvt_pk_bf16(v1[0], v1[1]); w.w = cvt_pk_bf16(v1[2], v1[3]);
                    st16(O + (size_t)(u.pm * BM + rl) * (2 * XW) + col, w); }
                else { bf16_t* vp = VT + ((size_t)u.pm * XW + (col - XW)) * MEML + rl;
#pragma unroll
                    for (int e = 0; e < 4; ++e) { vp[(size_t)e * MEML] = (bf16_t)f2bf(v0[e]); vp[(size_t)(4 + e) * MEML] = (bf16_t)f2bf(v1[e]); } } } }
    }
};
struct EpiGlu {
    static constexpr bool PERM = true;
    const bf16_t* SGB; bf16_t* O;
    __device__ __forceinline__ void operator()(AccRef acc, const Unit& u, int wr, int wc, int fr, int fq) const {
        const int row0 = u.pm * BM + wr * 64 + fr, col0 = u.pn * HALF + wc * 32 + 8 * fq;
#pragma unroll
        EPI_ROWS { const size_t off = (size_t)(row0 + ai * HALF + m * 16) * DM + col0; const u32x2 s = *(const u32x2*)((const unsigned char*)SGB + off);
            const f32x4 v0 = acc[ai][0][m][0], v1 = acc[ai][0][m][1], g0 = acc[ai][1][m][0], g1 = acc[ai][1][m][1];
            float o[8];
#pragma unroll
            for (int e = 0; e < 4; ++e) { o[e] = v0[e] * fsigmoid(g0[e]); o[4 + e] = v1[e] * fsigmoid(g1[e]); }
            o[0] *= ub0(s.x); o[1] *= ub1(s.x); o[2] *= ub2(s.x); o[3] *= ub3(s.x); o[4] *= ub0(s.y); o[5] *= ub1(s.y); o[6] *= ub2(s.y); o[7] *= ub3(s.y);
            u32x4 w; w.x = cvt_pk_bf16(o[0], o[1]); w.y = cvt_pk_bf16(o[2], o[3]); w.z = cvt_pk_bf16(o[4], o[5]); w.w = cvt_pk_bf16(o[6], o[7]);
            st16(O + off, w); }
    }
};
struct EpiMerge {
    static constexpr bool PERM = true;
    const bf16_t* SGA; const bf16_t* Y2; bf16_t* O;
    __device__ __forceinline__ void operator()(AccRef acc, const Unit& u, int wr, int wc, int fr, int fq) const {
        const int row0 = u.pm * BM + wr * 64 + fr, col0 = u.pn * BM + wc * 32 + 8 * fq;
#pragma unroll
        EPI_ROWS {
#pragma unroll
            for (int bj = 0; bj < 2; ++bj) { const size_t off = (size_t)(row0 + ai * HALF + m * 16) * DM + col0 + bj * HALF;
                const u32x2 s = *(const u32x2*)((const unsigned char*)SGA + off); const u32x4 y = *(const u32x4*)(Y2 + off); const f32x4 v0 = acc[ai][bj][m][0], v1 = acc[ai][bj][m][1];
                u32x4 w; w.x = cvt_pk_bf16(ub0(s.x) * v0[0] + bflo(y.x), ub1(s.x) * v0[1] + bfhi(y.x)); w.y = cvt_pk_bf16(ub2(s.x) * v0[2] + bflo(y.y), ub3(s.x) * v0[3] + bfhi(y.y));
                w.z = cvt_pk_bf16(ub0(s.y) * v1[0] + bflo(y.z), ub1(s.y) * v1[1] + bfhi(y.z)); w.w = cvt_pk_bf16(ub2(s.y) * v1[2] + bflo(y.w), ub3(s.y) * v1[3] + bfhi(y.w));
                st16(O + off, w); } }
    }
};
template <bool XBASE> struct EpiResidT {
    static constexpr bool PERM = true;
    const float* base; bf16_t* HB; float* SSQ;
    __device__ __forceinline__ void operator()(AccRef acc, const Unit& u, int wr, int wc, int fr, int fq) const {
        const int row0 = u.pm * BM + wr * 64 + fr, col0 = u.pn * BM + wc * 32 + 8 * fq;
#pragma unroll
        EPI_ROWS { const int row = row0 + ai * HALF + m * 16; const size_t off = (size_t)row * DM + col0; float ss = 0.f;
#pragma unroll
            for (int bj = 0; bj < 2; ++bj) { const size_t o2 = off + bj * HALF; f32x4 h0, h1;
                if (XBASE) { h0 = *(const f32x4*)(base + o2) + acc[ai][bj][m][0]; h1 = *(const f32x4*)(base + o2 + 4) + acc[ai][bj][m][1]; }
                else { const u32x4 w = *(const u32x4*)(HB + o2); h0 = (f32x4){bflo(w.x), bfhi(w.x), bflo(w.y), bfhi(w.y)} + acc[ai][bj][m][0]; h1 = (f32x4){bflo(w.z), bfhi(w.z), bflo(w.w), bfhi(w.w)} + acc[ai][bj][m][1]; }
                u32x4 o; o.x = cvt_pk_bf16(h0[0], h0[1]); o.y = cvt_pk_bf16(h0[2], h0[3]); o.z = cvt_pk_bf16(h1[0], h1[1]); o.w = cvt_pk_bf16(h1[2], h1[3]); st16(HB + o2, o);
                if (XBASE) ss += ((h0[0] * h0[0] + h0[1] * h0[1]) + (h0[2] * h0[2] + h0[3] * h0[3])) + ((h1[0] * h1[0] + h1[1] * h1[1]) + (h1[2] * h1[2] + h1[3] * h1[3])); }
            if (XBASE) { ss += __shfl_xor(ss, 16); ss += __shfl_xor(ss, 32); if (fq == 0) SSQ[(size_t)row * 16 + u.pn * 4 + wc] = ss; } }
    }
};
struct EpiXq {
    static constexpr bool PERM = true;
    const float* SSQ; bf16_t* O;
    __device__ __forceinline__ void operator()(AccRef acc, const Unit& u, int wr, int wc, int fr, int fq) const {
        const int row0 = u.pm * BM + wr * 64 + fr, col0 = u.pn * BM + wc * 32 + 8 * fq;
#pragma unroll
        EPI_ROWS { const int row = row0 + ai * HALF + m * 16; const f32x4* sp = (const f32x4*)(SSQ + (size_t)row * 16);
            const f32x4 a = sp[0] + sp[1] + sp[2] + sp[3]; const float rs = __builtin_amdgcn_rsqf(((a[0] + a[1]) + (a[2] + a[3])) * (1.0f / DM) + RMS_EPS) * XSCALE;
            bf16_t* rowp = O + (size_t)row * XW + col0;
#pragma unroll
            for (int bj = 0; bj < 2; ++bj) { const f32x4 v0 = acc[ai][bj][m][0] * rs, v1 = acc[ai][bj][m][1] * rs;
                u32x4 w; w.x = cvt_pk_bf16(v0[0], v0[1]); w.y = cvt_pk_bf16(v0[2], v0[3]); w.z = cvt_pk_bf16(v1[0], v1[1]); w.w = cvt_pk_bf16(v1[2], v1[3]);
                st16(rowp + bj * HALF, w); } }
    }
};
struct EpiMoe1 {
    static constexpr bool PERM = true;
    const float* bgu; bf16_t* HID;
    __device__ __forceinline__ void operator()(AccRef acc, const Unit& u, int wr, int wc, int fr, int fq) const {
        const int rl0 = wr * 64 + fr, col0 = u.pn * HALF + wc * 32 + 8 * fq; const float* bg = bgu + (size_t)u.e * (2 * DFF) + col0;
        const f32x4 bg0 = *(const f32x4*)(bg), bg1 = *(const f32x4*)(bg + 4), bu0 = *(const f32x4*)(bg + DFF), bu1 = *(const f32x4*)(bg + DFF + 4);
#pragma unroll
        EPI_ROWS { const int rl = rl0 + ai * HALF + m * 16;
            const f32x4 g0 = acc[ai][0][m][0] + bg0, g1 = acc[ai][0][m][1] + bg1, p0 = acc[ai][1][m][0] + bu0, p1 = acc[ai][1][m][1] + bu1;
            float o[8];
#pragma unroll
            for (int e = 0; e < 4; ++e) { const float ga = fminf(g0[e], 7.0f), gb = fminf(g1[e], 7.0f), ua = fminf(fmaxf(p0[e], -7.0f), 7.0f), ub = fminf(fmaxf(p1[e], -7.0f), 7.0f);
                o[e] = (ua + 1.0f) * ga * fsigmoid(1.702f * ga); o[4 + e] = (ub + 1.0f) * gb * fsigmoid(1.702f * gb); }
            if (MOE2_FP8) { int w0 = 0, w1 = 0;
                w0 = __builtin_amdgcn_cvt_pk_fp8_f32(o[0], o[1], w0, false); w0 = __builtin_amdgcn_cvt_pk_fp8_f32(o[2], o[3], w0, true); w1 = __builtin_amdgcn_cvt_pk_fp8_f32(o[4], o[5], w1, false); w1 = __builtin_amdgcn_cvt_pk_fp8_f32(o[6], o[7], w1, true);
                *(u32x2*)((unsigned char*)HID + (size_t)(u.pm * BM + rl) * DFF + col0) = (u32x2){(unsigned)w0, (unsigned)w1}; }
            else { u32x4 w; w.x = cvt_pk_bf16(o[0], o[1]); w.y = cvt_pk_bf16(o[2], o[3]); w.z = cvt_pk_bf16(o[4], o[5]); w.w = cvt_pk_bf16(o[6], o[7]);
                st16(HID + (size_t)(u.pm * BM + rl) * DFF + col0, w); } }
    }
};
struct EpiMoe2 {
    static constexpr bool PERM = true;
    const float* bdn; const LAS int* tabD; const LAS float* tabG; bf16_t* Y;
    __device__ __forceinline__ void operator()(AccRef acc, const Unit& u, int wr, int wc, int fr, int fq) const {
        const int rl0 = wr * 64 + fr, col0 = u.pn * BM + wc * 32 + 8 * fq; const float* bd = bdn + (size_t)u.e * DM + col0;
        f32x4 bv[2][2];
#pragma unroll
        for (int bj = 0; bj < 2; ++bj)
#pragma unroll
            for (int n = 0; n < 2; ++n) bv[bj][n] = *(const f32x4*)(bd + bj * HALF + 4 * n);
#pragma unroll
        EPI_ROWS { const int rl = rl0 + ai * HALF + m * 16; const int dest = tabD[u.ui * 256 + rl];
            if (dest >= 0) { const float gt = tabG[u.ui * 256 + rl]; bf16_t* rowp = Y + (size_t)(u.pm * BM + rl) * DM + col0;
#pragma unroll
                for (int bj = 0; bj < 2; ++bj) { const f32x4 v0 = (acc[ai][bj][m][0] + bv[bj][0]) * gt, v1 = (acc[ai][bj][m][1] + bv[bj][1]) * gt;
                    if (Y_FP8) { const float ys = (float)(1 << Y_SHIFT); int w0 = 0, w1 = 0;
                        w0 = __builtin_amdgcn_cvt_pk_fp8_f32(v0[0] * ys, v0[1] * ys, w0, false); w0 = __builtin_amdgcn_cvt_pk_fp8_f32(v0[2] * ys, v0[3] * ys, w0, true);
                        w1 = __builtin_amdgcn_cvt_pk_fp8_f32(v1[0] * ys, v1[1] * ys, w1, false); w1 = __builtin_amdgcn_cvt_pk_fp8_f32(v1[2] * ys, v1[3] * ys, w1, true);
                        *(u32x2*)((unsigned char*)Y + (size_t)(u.pm * BM + rl) * DM + col0 + bj * HALF) = (u32x2){(unsigned)w0, (unsigned)w1}; }
                    else { u32x4 w; w.x = cvt_pk_bf16(v0[0], v0[1]); w.y = cvt_pk_bf16(v0[2], v0[3]); w.z = cvt_pk_bf16(v1[0], v1[1]); w.w = cvt_pk_bf16(v1[2], v1[3]);
                        st16(rowp + bj * HALF, w); } } } }
    }
};
}

struct MoeOrder {
    pg8::PatchOrder P; const LAS int* pref; int rev;
    __device__ __forceinline__ bool next(int i, pg8::Unit& u) const {
        if (!P.next(i, u)) return false;
        if (rev) u.pm = P.nM - 1 - u.pm;
        int e = 0;
#pragma unroll 1
        for (int k = 1; k < NE; ++k) e += (pref[k] <= u.pm) ? 1 : 0;
        u.e = e; u.mi = u.pm - pref[e]; return true;
    }
};

namespace attn_body {
using bf16=__hip_bfloat16;
using bf16x8=__attribute__((ext_vector_type(8)))short;
using s16x4=__attribute__((ext_vector_type(4)))short;
using f32x16=__attribute__((ext_vector_type(16)))float;
using u32x4=__attribute__((ext_vector_type(4)))unsigned;
constexpr int BATCH=4,NHEAD=8,SEQ=8192,D=64,DM=NHEAD*D;
constexpr int NW=8,QBLK=32,QB=QBLK*NW,KVBLK=64,NQB=SEQ/QB;
constexpr int ATTN_PITCH=DM, ATTN_UNIT_ROWS=QB;
__device__ __forceinline__ int crow(int r,int hi){return (r&3)+8*(r>>2)+4*hi;}
#define SBAR() __builtin_amdgcn_sched_barrier(0)
__device__ __forceinline__ void cmask(f32x16&p0,f32x16&p1,int jb,int qrel,int hi){
  const float NEG=-INFINITY; int kb=64*jb+4*hi;
  #pragma unroll
  for(int r=0;r<16;++r){int kv=kb+(r&3)+8*(r>>2); if(kv>qrel)p0[r]=NEG; if(kv+32>qrel)p1[r]=NEG;}
}

constexpr int NSLOT=4, SLOTB=8192;
constexpr int LDS_K=0, LDS_V=NSLOT*SLOTB, LDS_WS=2*NSLOT*SLOTB, LDS_OST=LDS_WS+NW*64*4, LDS_KM=LDS_OST+NW*4096, LDS_SEL=LDS_KM+32*64*4, LDS_DST=LDS_SEL+1024, LDS_BYTES=LDS_DST+1024;
constexpr float C2=0.125f*1.4426950408889634f;
__device__ __forceinline__ void glds16(const void*gsrc,unsigned lds_dst){unsigned keep;
  asm volatile("s_mov_b32 %0, m0\n\ts_mov_b32 m0, %2\n\ts_nop 0\n\tglobal_load_lds_dwordx4 %1, off\n\ts_mov_b32 m0, %0":"=&s"(keep):"v"(gsrc),"s"(lds_dst):"memory");}
__device__ __forceinline__ float max3f(float a,float b,float c){float r;asm("v_max3_f32 %0, %1, %2, %3":"=v"(r):"v"(a),"v"(b),"v"(c));return r;}
__device__ __forceinline__ float max2f(float a,float b){float r;asm("v_max_f32_e32 %0, %1, %2":"=v"(r):"v"(a),"v"(b));return r;}
__device__ __forceinline__ float fadd_s(float a,float b){float r;asm("v_add_f32_e32 %0, %1, %2":"=v"(r):"v"(a),"v"(b));return r;}
__device__ __forceinline__ float fsub_s(float a,float b){float r;asm("v_sub_f32_e32 %0, %1, %2":"=v"(r):"v"(a),"v"(b));return r;}
typedef float f32x2_t __attribute__((ext_vector_type(2))); typedef __bf16 bf16x2_t __attribute__((ext_vector_type(2)));
__device__ __forceinline__ unsigned cvtpk_s(float lo,float hi){f32x2_t v={lo,hi};bf16x2_t b=__builtin_convertvector(v,bf16x2_t);return __builtin_bit_cast(unsigned,b);}
#define WAIT_BAR(N) asm volatile("s_waitcnt vmcnt(" #N ") lgkmcnt(0)\n\ts_barrier":::"memory")

__device__ __forceinline__ void qkt(f32x16&p0,f32x16&p1,const char*Kslot,const bf16x8*qr,const f32x16&negm,int r32,int hi){
  const char*kb=Kslot+hi*1024+r32*16;
  #pragma unroll
  for(int d0=0;d0<4;++d0){
    const bf16x8 b0=*reinterpret_cast<const bf16x8*>(kb+d0*2048);
    const bf16x8 b1=*reinterpret_cast<const bf16x8*>(kb+d0*2048+512);
    if(d0==0){p0=__builtin_amdgcn_mfma_f32_32x32x16_bf16(b0,qr[0],negm,0,0,0);p1=__builtin_amdgcn_mfma_f32_32x32x16_bf16(b1,qr[0],negm,0,0,0);}
    else{p0=__builtin_amdgcn_mfma_f32_32x32x16_bf16(b0,qr[d0],p0,0,0,0);p1=__builtin_amdgcn_mfma_f32_32x32x16_bf16(b1,qr[d0],p1,0,0,0);}}
}
typedef __attribute__((address_space(3))) const char* lds_cptr;
typedef short v4i16_t __attribute__((ext_vector_type(4)));
__device__ __forceinline__ void kload8(bf16x8*kf,lds_cptr kp){
  kf[0]=*(const __attribute__((address_space(3))) bf16x8*)(kp);      kf[1]=*(const __attribute__((address_space(3))) bf16x8*)(kp+512);
  kf[2]=*(const __attribute__((address_space(3))) bf16x8*)(kp+2048); kf[3]=*(const __attribute__((address_space(3))) bf16x8*)(kp+2560);
  kf[4]=*(const __attribute__((address_space(3))) bf16x8*)(kp+4096); kf[5]=*(const __attribute__((address_space(3))) bf16x8*)(kp+4608);
  kf[6]=*(const __attribute__((address_space(3))) bf16x8*)(kp+6144); kf[7]=*(const __attribute__((address_space(3))) bf16x8*)(kp+6656);
}
__device__ __forceinline__ void kload2(bf16x8*kf,lds_cptr kp,int j){ kf[2*j]=*(const __attribute__((address_space(3))) bf16x8*)(kp+j*2048); kf[2*j+1]=*(const __attribute__((address_space(3))) bf16x8*)(kp+j*2048+512); }
__device__ __forceinline__ s16x4 vtr(lds_cptr p){ return __builtin_bit_cast(s16x4,__builtin_amdgcn_ds_read_tr16_b64_v4i16((__attribute__((address_space(3))) v4i16_t*)p)); }
__device__ __forceinline__ float rowmax(const f32x16&p0,const f32x16&p1){
  float a=max3f(p0[0],p0[1],p1[0]),b=max3f(p0[2],p0[3],p1[1]);a=max3f(a,p1[2],p1[3]);
  #pragma unroll
  for(int r=4;r<16;r+=4){a=max3f(a,p0[r],p0[r+1]);b=max3f(b,p0[r+2],p0[r+3]);a=max3f(a,p1[r],p1[r+1]);b=max3f(b,p1[r+2],p1[r+3]);}
  const float m=max2f(a,b);
  auto rr=__builtin_amdgcn_permlane32_swap(__float_as_uint(m),__float_as_uint(m),false,false);
  return max2f(__uint_as_float(rr[0]),__uint_as_float(rr[1]));
}
__device__ __forceinline__ void pv(f32x16*o,int vb,bf16x8 pa0,bf16x8 pa1,bf16x8 pa2,bf16x8 pa3){
  #pragma unroll
  for(int d0=0;d0<2;++d0){s16x4 lo[4],hi[4];
    #pragma unroll
    for(int ks=0;ks<4;++ks){
      asm volatile("ds_read_b64_tr_b16 %0,%1 offset:%c2":"=&v"(lo[ks]):"v"(vb),"i"(d0*4096+ks*1024):"memory");
      asm volatile("ds_read_b64_tr_b16 %0,%1 offset:%c2":"=&v"(hi[ks]):"v"(vb),"i"(d0*4096+ks*1024+512):"memory");}
    asm volatile("s_waitcnt lgkmcnt(0)":::"memory");SBAR();
    #define PK(k) (bf16x8){lo[k][0],lo[k][1],lo[k][2],lo[k][3],hi[k][0],hi[k][1],hi[k][2],hi[k][3]}
    o[d0]=__builtin_amdgcn_mfma_f32_32x32x16_bf16(pa0,PK(0),o[d0],0,0,0);
    o[d0]=__builtin_amdgcn_mfma_f32_32x32x16_bf16(pa1,PK(1),o[d0],0,0,0);
    o[d0]=__builtin_amdgcn_mfma_f32_32x32x16_bf16(pa2,PK(2),o[d0],0,0,0);
    o[d0]=__builtin_amdgcn_mfma_f32_32x32x16_bf16(pa3,PK(3),o[d0],0,0,0);
    #undef PK
  }
}

#ifndef ATTN_STORE16
#define ATTN_STORE16(p,v) (*(u32x4*)(p)=(v))
#endif
template<int THRL> __device__ __forceinline__ void attn_unit(int b,int h,int qb,const bf16*Q,const bf16*__restrict__ K,const bf16*__restrict__ V,bf16*O,char*shm){
  const int tid=threadIdx.x,lane=tid&63,r32=lane&31,hi=lane>>5; const int wid=__builtin_amdgcn_readfirstlane(tid>>6);
  const long rowbase=(long)b*SEQ; const int q0=qb*QB;
  const bf16*Qw=Q+(rowbase+q0+wid*QBLK)*DM+h*D;
  const bf16*Kh=K+rowbase*DM+h*D,*Vh=V+rowbase*DM+h*D;
  const unsigned lds0=(unsigned)(uintptr_t)shm;
  float*wsf=(float*)(shm+LDS_WS)+wid*64;
  const bf16*ksrc=Kh+(long)lane*DM+wid*8;
  const bf16*vsrc=Vh+(long)(16*(wid&3)+(lane>>2))*DM+(wid>>2)*32+(lane&3)*8;
  const unsigned kdst=lds0+LDS_K+wid*1024, vdst=lds0+LDS_V+wid*1024;
  #define DMA_K(t,slot) glds16(ksrc+(long)(t)*KVBLK*DM,(unsigned)__builtin_amdgcn_readfirstlane(kdst+(slot)))
  #define DMA_V(t,slot) glds16(vsrc+(long)(t)*KVBLK*DM,(unsigned)__builtin_amdgcn_readfirstlane(vdst+(slot)))
  const int vb0=(int)(lds0+LDS_V)+((lane>>4)&1)*32+(lane&3)*8+(4*hi+((lane&15)>>2))*64;
  const char*Kbase=shm+LDS_K; bf16x8 kf[8];
  const lds_cptr shm3=(lds_cptr)shm; const lds_cptr kp0=shm3+LDS_K+hi*1024+r32*16; const lds_cptr vp0=shm3+LDS_V+((lane>>4)&1)*32+(lane&3)*8+(4*hi+((lane&15)>>2))*64;
  const int NT=(q0+QB)/KVBLK;
  DMA_K(0,0);DMA_V(0,0);DMA_K(1,SLOTB);
  bf16x8 qr[4];
  #pragma unroll
  for(int d0=0;d0<4;++d0)qr[d0]=*reinterpret_cast<const bf16x8*>(&Qw[(long)r32*DM+d0*16+hi*8]);
  { int lp_=lane; asm volatile("":"+v"(lp_)); const int r32p=lp_&31, hip=lp_>>5;
    unsigned sel=0u; const __attribute__((address_space(3))) float*km=(const __attribute__((address_space(3))) float*)((__attribute__((address_space(3))) const char*)shm+LDS_KM); float g0=-3e38f,g1=-3e38f,g2=-3e38f; int s0=-1,s1=-1,s2=-1;
    for(int j=0;j<qb;++j){ float g=0.f;
      #pragma unroll
      for(int d0=0;d0<4;++d0){
        #pragma unroll
        for(int e=0;e<8;++e)g+=__builtin_bit_cast(float,((unsigned)(unsigned short)qr[d0][e])<<16)*km[j*64+16*d0+8*hip+e];}
      g+=__shfl_xor(g,32);
      if(g>g0){g2=g1;s2=s1;g1=g0;s1=s0;g0=g;s0=j;}else if(g>g1){g2=g1;s2=s1;g1=g;s1=j;}else if(g>g2){g2=g;s2=j;} }
    if(s0>=0)sel|=1u<<s0; if(s1>=0)sel|=1u<<s1; if(s2>=0)sel|=1u<<s2;
    if(hip==0)((__attribute__((address_space(3))) unsigned*)((__attribute__((address_space(3))) char*)shm+LDS_SEL))[wid*32+r32p]=sel; asm volatile("s_waitcnt lgkmcnt(0)":::"memory"); }
  float mhat=0.f,l_reg=0.f;f32x16 o[2];o[0]=f32x16{};o[1]=f32x16{};f32x16 negm=f32x16{};asm volatile("":"+v"(negm));
  const int qrel=wid*QBLK+r32;
  #define BMASK(P0,P1,t) do{}while(0)
  #define CMASK(P0,P1,t) do{int jb_=(t)-(NT-4); if(jb_>=0)cmask(P0,P1,jb_,qrel,hi); else BMASK(P0,P1,t);}while(0)
  bool resc=false;
  #define START(P0,P1) do{ const float rm=rowmax(P0,P1); resc=false; \
    { const float dl=__builtin_fmaxf(rm,-64.f); mhat=fadd_s(mhat,dl); \
      _Pragma("unroll") for(int r=0;r<16;++r){P0[r]=fsub_s(P0[r],dl);P1[r]=fsub_s(P1[r],dl);} \
      _Pragma("unroll") for(int r=0;r<16;++r)negm[r]=-mhat; asm volatile("":"+v"(negm)); } \
    _Pragma("unroll") for(int r=0;r<16;++r)P0[r]=__builtin_amdgcn_exp2f(P0[r]); }while(0)
  #define RESC() do{ if(resc){ asm volatile("s_waitcnt lgkmcnt(0)":::"memory"); \
      _Pragma("unroll") for(int d_=0;d_<2;++d_) _Pragma("unroll") for(int r=0;r<16;++r)o[d_][r]*=wsf[crow(r,hi)]; } }while(0)
  f32x16 pA0,pA1,pB0,pB1;
  int sl_prev=0,sl_cur=0,sl_next=SLOTB;
  #define ROT() do{sl_prev=sl_cur;sl_cur=sl_next;sl_next=(sl_next==(NSLOT-1)*SLOTB)?0:sl_next+SLOTB;}while(0)
  DMA_K(2,2*SLOTB);
  WAIT_BAR(3);
  qkt(pA0,pA1,Kbase,qr,negm,r32,hi);asm volatile("s_nop 15\n\ts_nop 7":"+v"(pA0),"+v"(pA1));CMASK(pA0,pA1,0);
  START(pA0,pA1);
  _Pragma("unroll") for(int r=0;r<16;++r)pA1[r]=__builtin_amdgcn_exp2f(pA1[r]);
  WAIT_BAR(0);
  DMA_K(3,0);DMA_V(1,SLOTB);
  ROT();
  kload8(kf,kp0+sl_cur);
  WAIT_BAR(2);
  s16x4 vlo[8],vhi[8]; u32x4 pw0,pw1,pw2,pw3;
  #define PKW(P,B) (keep_?cvtpk_s(P[B],P[B+1]):0u)
  #define PAF(k) __builtin_bit_cast(bf16x8,pw##k)
  #define VFR(i) (bf16x8){vlo[i][0],vlo[i][1],vlo[i][2],vlo[i][3],vhi[i][0],vhi[i][1],vhi[i][2],vhi[i][3]}
  #define PIN(x) asm volatile("":"+v"(x))
  #define MX3(a,b,c) __builtin_fmaxf(__builtin_fmaxf((a),(b)),(c))
  #define GAPA(MF,A0,A1,A2,A3,W0,W1,PW) do{ MF; sacc+=A0; sacc+=A1; sacc+=A2; sacc+=A3; PIN(sacc); W0; W1; PIN(PW); SBAR(); }while(0)
  #define EX(v) __builtin_amdgcn_exp2f(v)
  #define GAPB(MF,X,B) do{ MF; X[B]=EX(X[B]); X[B+1]=EX(X[B+1]); X[B+2]=EX(X[B+2]); X[B+3]=EX(X[B+3]); PIN(X); SBAR(); }while(0)
  #define VRD(i) do{ vlo[i]=vtr(vp_+(((i)>>2)*4096+((i)&3)*1024)); vhi[i]=vtr(vp_+(((i)>>2)*4096+((i)&3)*1024+512)); }while(0)
  #define KRD(G,j) do{ if(G){ kload2(kf,kp0+sl_next,j); SBAR(); } }while(0)
  #define STEP(C0,C1,P0,P1,t,GK,GV,GL) do{ SBAR(); \
    int q_=qrel; asm volatile("":"+v"(q_)); const unsigned selw_=((const volatile __attribute__((address_space(3))) unsigned*)((__attribute__((address_space(3))) const char*)shm+LDS_SEL))[q_]; \
    const bool keep_=((t)-1>=NT-4)||((selw_>>(((t)-1)>>2))&1u); \
    const lds_cptr vp_=vp0+sl_prev; \
    VRD(0); SBAR(); float sacc=(P0[0]+P0[1]); \
    GAPA(C0=__builtin_amdgcn_mfma_f32_32x32x16_bf16(kf[0],qr[0],negm,0,0,0), P0[2],P0[3],P0[4],P0[5],     pw0[0]=PKW(P0,0), pw0[1]=PKW(P0,2), pw0); \
    VRD(4); SBAR(); GAPA(C1=__builtin_amdgcn_mfma_f32_32x32x16_bf16(kf[1],qr[0],negm,0,0,0), P0[6],P0[7],P0[8],P0[9],     pw0[2]=PKW(P0,4), pw0[3]=PKW(P0,6), pw0); \
    VRD(1); SBAR(); GAPA(C0=__builtin_amdgcn_mfma_f32_32x32x16_bf16(kf[2],qr[1],C0,0,0,0),   P0[10],P0[11],P0[12],P0[13], pw1[0]=PKW(P0,8), pw1[1]=PKW(P0,10), pw1); \
    VRD(5); SBAR(); GAPA(C1=__builtin_amdgcn_mfma_f32_32x32x16_bf16(kf[3],qr[1],C1,0,0,0),   P0[14],P0[15],P1[0],P1[1],   pw1[2]=PKW(P0,12),pw1[3]=PKW(P0,14), pw1); \
    VRD(2); SBAR(); GAPA(C0=__builtin_amdgcn_mfma_f32_32x32x16_bf16(kf[4],qr[2],C0,0,0,0),   P1[2],P1[3],P1[4],P1[5],     pw2[0]=PKW(P1,0), pw2[1]=PKW(P1,2), pw2); \
    VRD(6); SBAR(); GAPA(C1=__builtin_amdgcn_mfma_f32_32x32x16_bf16(kf[5],qr[2],C1,0,0,0),   P1[6],P1[7],P1[8],P1[9],     pw2[2]=PKW(P1,4), pw2[3]=PKW(P1,6), pw2); \
    VRD(3); SBAR(); GAPA(C0=__builtin_amdgcn_mfma_f32_32x32x16_bf16(kf[6],qr[3],C0,0,0,0),   P1[10],P1[11],P1[12],P1[13], pw3[0]=PKW(P1,8), pw3[1]=PKW(P1,10), pw3); \
    VRD(7); SBAR(); GAPA(C1=__builtin_amdgcn_mfma_f32_32x32x16_bf16(kf[7],qr[3],C1,0,0,0),   P1[14],P1[15],0.f,0.f,       pw3[2]=PKW(P1,12),pw3[3]=PKW(P1,14), pw3); \
    l_reg+=keep_?sacc:0.f; \
    if(GK){DMA_K((t)+3,sl_cur);} if(GV){DMA_V((t)+1,sl_next);} \
    CMASK(C0,C1,t); \
    { float a=MX3(C0[0],C0[1],C1[0]),b=MX3(C0[2],C0[3],C1[1]); a=MX3(a,C1[2],C1[3]); \
      _Pragma("unroll") for(int r=4;r<16;r+=4){a=MX3(a,C0[r],C0[r+1]);b=MX3(b,C0[r+2],C0[r+3]);a=MX3(a,C1[r],C1[r+1]);b=MX3(b,C1[r+2],C1[r+3]);} \
      float rm=__builtin_fmaxf(a,b); { auto rr=__builtin_amdgcn_permlane32_swap(__float_as_uint(rm),__float_as_uint(rm),false,false); rm=__builtin_fmaxf(__uint_as_float(rr[0]),__uint_as_float(rr[1])); } \
      resc=false; \
      if(__builtin_expect(__any(rm>(float)THRL),0)){ const float dl=__builtin_fmaxf(rm,0.f); mhat+=dl; \
        _Pragma("unroll") for(int r=0;r<16;++r){C0[r]-=dl;C1[r]-=dl;} \
        _Pragma("unroll") for(int r=0;r<16;++r)negm[r]=-mhat; asm volatile("":"+v"(negm)); \
        const float f=__builtin_amdgcn_exp2f(-dl); l_reg*=f; if(hi==0)wsf[r32]=f; resc=true; } } \
    SBAR(); \
    GAPB(o[0]=__builtin_amdgcn_mfma_f32_32x32x16_bf16(PAF(0),VFR(0),o[0],0,0,0), C0,0); \
    GAPB(o[1]=__builtin_amdgcn_mfma_f32_32x32x16_bf16(PAF(0),VFR(4),o[1],0,0,0), C0,4); \
    KRD(GL,0); GAPB(o[0]=__builtin_amdgcn_mfma_f32_32x32x16_bf16(PAF(1),VFR(1),o[0],0,0,0), C0,8); \
    KRD(GL,1); GAPB(o[1]=__builtin_amdgcn_mfma_f32_32x32x16_bf16(PAF(1),VFR(5),o[1],0,0,0), C0,12); \
    KRD(GL,2); GAPB(o[0]=__builtin_amdgcn_mfma_f32_32x32x16_bf16(PAF(2),VFR(2),o[0],0,0,0), C1,0); \
    KRD(GL,3); GAPB(o[1]=__builtin_amdgcn_mfma_f32_32x32x16_bf16(PAF(2),VFR(6),o[1],0,0,0), C1,4); \
    GAPB(o[0]=__builtin_amdgcn_mfma_f32_32x32x16_bf16(PAF(3),VFR(3),o[0],0,0,0), C1,8); \
    GAPB(o[1]=__builtin_amdgcn_mfma_f32_32x32x16_bf16(PAF(3),VFR(7),o[1],0,0,0), C1,12); \
    }while(0)
  int t=1;
  for(;t+5<NT;t+=2){
    STEP(pB0,pB1,pA0,pA1,t,true,true,true);     WAIT_BAR(2); RESC(); ROT();
    STEP(pA0,pA1,pB0,pB1,t+1,true,true,true);   WAIT_BAR(2); RESC(); ROT();
  }
  #define ENDW(tt) do{ if((tt)+3<NT){WAIT_BAR(2);} else if((tt)+2<NT){WAIT_BAR(1);} else {WAIT_BAR(0);} }while(0)
  for(;t+1<NT;t+=2){
    STEP(pB0,pB1,pA0,pA1,t,(t+3<NT),(t+1<NT),(t+1<NT));       ENDW(t);   RESC(); ROT();
    STEP(pA0,pA1,pB0,pB1,t+1,(t+4<NT),(t+2<NT),(t+2<NT));     ENDW(t+1); RESC(); ROT();
  }
  STEP(pB0,pB1,pA0,pA1,NT-1,false,false,false); RESC();
  { const bool keep_=true; float sacc=pB0[0]+pB0[1]; _Pragma("unroll") for(int r=2;r<16;++r)sacc+=pB0[r]; _Pragma("unroll") for(int r=0;r<16;++r)sacc+=pB1[r]; l_reg+=sacc;
    pw0=(u32x4){PKW(pB0,0),PKW(pB0,2),PKW(pB0,4),PKW(pB0,6)};pw1=(u32x4){PKW(pB0,8),PKW(pB0,10),PKW(pB0,12),PKW(pB0,14)};pw2=(u32x4){PKW(pB1,0),PKW(pB1,2),PKW(pB1,4),PKW(pB1,6)};pw3=(u32x4){PKW(pB1,8),PKW(pB1,10),PKW(pB1,12),PKW(pB1,14)};
    SBAR(); pv(o,vb0+sl_cur,PAF(0),PAF(1),PAF(2),PAF(3)); }
  #undef PKW
  #undef PAF
  #undef VFR
  #undef PIN
  #undef MX3
  #undef GAPA
  #undef GAPB
  #undef EX
  #undef VRD
  #undef KRD
  #undef STEP
  #undef ENDW
  {auto rr=__builtin_amdgcn_permlane32_swap(__float_as_uint(l_reg),__float_as_uint(l_reg),false,false);l_reg=__uint_as_float(rr[0])+__uint_as_float(rr[1]);}
  if(hi==0)wsf[32+r32]=l_reg;asm volatile("s_waitcnt lgkmcnt(0)":::"memory");
  float rli[16];
  #pragma unroll
  for(int r=0;r<16;++r)rli[r]=__builtin_amdgcn_rcpf(wsf[32+crow(r,hi)]);
  bf16*Ow=O+(rowbase+q0+wid*QBLK)*DM+h*D;
  { bf16*stg=(bf16*)(shm+LDS_OST)+wid*2048;
    #pragma unroll
    for(int r=0;r<16;++r){const int orow=crow(r,hi);
      #pragma unroll
      for(int d0=0;d0<2;++d0)stg[orow*64+d0*32+r32]=__float2bfloat16(o[d0][r]*rli[r]);}
    asm volatile("s_waitcnt lgkmcnt(0)":::"memory");
    #pragma unroll
    for(int i=0;i<4;++i){const int row=i*8+(lane>>3),ch=lane&7; const u32x4 v=*(const u32x4*)(stg+row*64+ch*8); ATTN_STORE16(Ow+(long)row*DM+ch*8,v);} }
  asm volatile("s_waitcnt lgkmcnt(0)\n\ts_barrier":::"memory");
  #undef DMA_K
  #undef DMA_V
  #undef CMASK
  #undef BMASK
  #undef START
  #undef RESC
  #undef ROT
}
template<int THRL> __device__ __forceinline__ void moba_unit4(const bf16*Qrow,const bf16*__restrict__ Kh,const bf16*__restrict__ Vh,bool causal,int dest,bf16*PO,float*PML,char*shm){
  int tid_=threadIdx.x; asm volatile("":"+v"(tid_)); const int tid=tid_,lane=tid&63,r32=lane&31,hi=lane>>5; const int wid=__builtin_amdgcn_readfirstlane(tid>>6);
  const unsigned lds0=(unsigned)(uintptr_t)shm;
  float*wsf=(float*)(shm+LDS_WS)+wid*64;
  const bf16*ksrc=Kh+(long)lane*DM+wid*8;
  const bf16*vsrc=Vh+(long)(16*(wid&3)+(lane>>2))*DM+(wid>>2)*32+(lane&3)*8;
  const unsigned kdst=lds0+LDS_K+wid*1024, vdst=lds0+LDS_V+wid*1024;
  #define DMA_K(t,slot) glds16(ksrc+(long)(t)*KVBLK*DM,(unsigned)__builtin_amdgcn_readfirstlane(kdst+(slot)))
  #define DMA_V(t,slot) glds16(vsrc+(long)(t)*KVBLK*DM,(unsigned)__builtin_amdgcn_readfirstlane(vdst+(slot)))
  const int vb0=(int)(lds0+LDS_V)+((lane>>4)&1)*32+(lane&3)*8+(4*hi+((lane&15)>>2))*64;
  const char*Kbase=shm+LDS_K; bf16x8 kf[8];
  const lds_cptr shm3=(lds_cptr)shm; const lds_cptr kp0=shm3+LDS_K+hi*1024+r32*16; const lds_cptr vp0=shm3+LDS_V+((lane>>4)&1)*32+(lane&3)*8+(4*hi+((lane&15)>>2))*64;
  constexpr int NT=4;
  DMA_K(0,0);DMA_V(0,0);DMA_K(1,SLOTB);
  bf16x8 qr[4];
  #pragma unroll
  for(int d0=0;d0<4;++d0)qr[d0]=*reinterpret_cast<const bf16x8*>(Qrow+d0*16+hi*8);
  float mhat=0.f,l_reg=0.f;f32x16 o[2];o[0]=f32x16{};o[1]=f32x16{};f32x16 negm=f32x16{};asm volatile("":"+v"(negm));
  const int qrel=wid*QBLK+r32;
  #define BMASK(P0,P1,t) do{}while(0)
  #define CMASK(P0,P1,t) do{ if(causal)cmask(P0,P1,(t),qrel,hi); }while(0)
  bool resc=false;
  #define START(P0,P1) do{ const float rm=rowmax(P0,P1); resc=false; \
    { const float dl=__builtin_fmaxf(rm,-64.f); mhat=fadd_s(mhat,dl); \
      _Pragma("unroll") for(int r=0;r<16;++r){P0[r]=fsub_s(P0[r],dl);P1[r]=fsub_s(P1[r],dl);} \
      _Pragma("unroll") for(int r=0;r<16;++r)negm[r]=-mhat; asm volatile("":"+v"(negm)); } \
    _Pragma("unroll") for(int r=0;r<16;++r)P0[r]=__builtin_amdgcn_exp2f(P0[r]); }while(0)
  #define RESC() do{ if(resc){ asm volatile("s_waitcnt lgkmcnt(0)":::"memory"); \
      _Pragma("unroll") for(int d_=0;d_<2;++d_) _Pragma("unroll") for(int r=0;r<16;++r)o[d_][r]*=wsf[crow(r,hi)]; } }while(0)
  f32x16 pA0,pA1,pB0,pB1;
  int sl_prev=0,sl_cur=0,sl_next=SLOTB;
  #define ROT() do{sl_prev=sl_cur;sl_cur=sl_next;sl_next=(sl_next==(NSLOT-1)*SLOTB)?0:sl_next+SLOTB;}while(0)
  DMA_K(2,2*SLOTB);
  WAIT_BAR(3);
  qkt(pA0,pA1,Kbase,qr,negm,r32,hi);asm volatile("s_nop 15\n\ts_nop 7":"+v"(pA0),"+v"(pA1));CMASK(pA0,pA1,0);
  START(pA0,pA1);
  _Pragma("unroll") for(int r=0;r<16;++r)pA1[r]=__builtin_amdgcn_exp2f(pA1[r]);
  WAIT_BAR(0);
  DMA_K(3,0);DMA_V(1,SLOTB);
  ROT();
  kload8(kf,kp0+sl_cur);
  WAIT_BAR(2);
  s16x4 vlo[8],vhi[8]; u32x4 pw0,pw1,pw2,pw3;
  #define PKW(P,B) (keep_?cvtpk_s(P[B],P[B+1]):0u)
  #define PAF(k) __builtin_bit_cast(bf16x8,pw##k)
  #define VFR(i) (bf16x8){vlo[i][0],vlo[i][1],vlo[i][2],vlo[i][3],vhi[i][0],vhi[i][1],vhi[i][2],vhi[i][3]}
  #define PIN(x) asm volatile("":"+v"(x))
  #define MX3(a,b,c) __builtin_fmaxf(__builtin_fmaxf((a),(b)),(c))
  #define GAPA(MF,A0,A1,A2,A3,W0,W1,PW) do{ MF; sacc+=A0; sacc+=A1; sacc+=A2; sacc+=A3; PIN(sacc); W0; W1; PIN(PW); SBAR(); }while(0)
  #define EX(v) __builtin_amdgcn_exp2f(v)
  #define GAPB(MF,X,B) do{ MF; X[B]=EX(X[B]); X[B+1]=EX(X[B+1]); X[B+2]=EX(X[B+2]); X[B+3]=EX(X[B+3]); PIN(X); SBAR(); }while(0)
  #define VRD(i) do{ vlo[i]=vtr(vp_+(((i)>>2)*4096+((i)&3)*1024)); vhi[i]=vtr(vp_+(((i)>>2)*4096+((i)&3)*1024+512)); }while(0)
  #define KRD(G,j) do{ if(G){ kload2(kf,kp0+sl_next,j); SBAR(); } }while(0)
  #define STEP(C0,C1,P0,P1,t,GK,GV,GL) do{ SBAR(); \
    const bool keep_=true; \
    const lds_cptr vp_=vp0+sl_prev; \
    VRD(0); SBAR(); float sacc=(P0[0]+P0[1]); \
    GAPA(C0=__builtin_amdgcn_mfma_f32_32x32x16_bf16(kf[0],qr[0],negm,0,0,0), P0[2],P0[3],P0[4],P0[5],     pw0[0]=PKW(P0,0), pw0[1]=PKW(P0,2), pw0); \
    VRD(4); SBAR(); GAPA(C1=__builtin_amdgcn_mfma_f32_32x32x16_bf16(kf[1],qr[0],negm,0,0,0), P0[6],P0[7],P0[8],P0[9],     pw0[2]=PKW(P0,4), pw0[3]=PKW(P0,6), pw0); \
    VRD(1); SBAR(); GAPA(C0=__builtin_amdgcn_mfma_f32_32x32x16_bf16(kf[2],qr[1],C0,0,0,0),   P0[10],P0[11],P0[12],P0[13], pw1[0]=PKW(P0,8), pw1[1]=PKW(P0,10), pw1); \
    VRD(5); SBAR(); GAPA(C1=__builtin_amdgcn_mfma_f32_32x32x16_bf16(kf[3],qr[1],C1,0,0,0),   P0[14],P0[15],P1[0],P1[1],   pw1[2]=PKW(P0,12),pw1[3]=PKW(P0,14), pw1); \
    VRD(2); SBAR(); GAPA(C0=__builtin_amdgcn_mfma_f32_32x32x16_bf16(kf[4],qr[2],C0,0,0,0),   P1[2],P1[3],P1[4],P1[5],     pw2[0]=PKW(P1,0), pw2[1]=PKW(P1,2), pw2); \
    VRD(6); SBAR(); GAPA(C1=__builtin_amdgcn_mfma_f32_32x32x16_bf16(kf[5],qr[2],C1,0,0,0),   P1[6],P1[7],P1[8],P1[9],     pw2[2]=PKW(P1,4), pw2[3]=PKW(P1,6), pw2); \
    VRD(3); SBAR(); GAPA(C0=__builtin_amdgcn_mfma_f32_32x32x16_bf16(kf[6],qr[3],C0,0,0,0),   P1[10],P1[11],P1[12],P1[13], pw3[0]=PKW(P1,8), pw3[1]=PKW(P1,10), pw3); \
    VRD(7); SBAR(); GAPA(C1=__builtin_amdgcn_mfma_f32_32x32x16_bf16(kf[7],qr[3],C1,0,0,0),   P1[14],P1[15],0.f,0.f,       pw3[2]=PKW(P1,12),pw3[3]=PKW(P1,14), pw3); \
    l_reg+=keep_?sacc:0.f; \
    if(GK){DMA_K((t)+3,sl_cur);} if(GV){DMA_V((t)+1,sl_next);} \
    CMASK(C0,C1,t); \
    { float a=MX3(C0[0],C0[1],C1[0]),b=MX3(C0[2],C0[3],C1[1]); a=MX3(a,C1[2],C1[3]); \
      _Pragma("unroll") for(int r=4;r<16;r+=4){a=MX3(a,C0[r],C0[r+1]);b=MX3(b,C0[r+2],C0[r+3]);a=MX3(a,C1[r],C1[r+1]);b=MX3(b,C1[r+2],C1[r+3]);} \
      float rm=__builtin_fmaxf(a,b); { auto rr=__builtin_amdgcn_permlane32_swap(__float_as_uint(rm),__float_as_uint(rm),false,false); rm=__builtin_fmaxf(__uint_as_float(rr[0]),__uint_as_float(rr[1])); } \
      resc=false; \
      if(__builtin_expect(__any(rm>(float)THRL),0)){ const float dl=__builtin_fmaxf(rm,0.f); mhat+=dl; \
        _Pragma("unroll") for(int r=0;r<16;++r){C0[r]-=dl;C1[r]-=dl;} \
        _Pragma("unroll") for(int r=0;r<16;++r)negm[r]=-mhat; asm volatile("":"+v"(negm)); \
        const float f=__builtin_amdgcn_exp2f(-dl); l_reg*=f; if(hi==0)wsf[r32]=f; resc=true; } } \
    SBAR(); \
    GAPB(o[0]=__builtin_amdgcn_mfma_f32_32x32x16_bf16(PAF(0),VFR(0),o[0],0,0,0), C0,0); \
    GAPB(o[1]=__builtin_amdgcn_mfma_f32_32x32x16_bf16(PAF(0),VFR(4),o[1],0,0,0), C0,4); \
    KRD(GL,0); GAPB(o[0]=__builtin_amdgcn_mfma_f32_32x32x16_bf16(PAF(1),VFR(1),o[0],0,0,0), C0,8); \
    KRD(GL,1); GAPB(o[1]=__builtin_amdgcn_mfma_f32_32x32x16_bf16(PAF(1),VFR(5),o[1],0,0,0), C0,12); \
    KRD(GL,2); GAPB(o[0]=__builtin_amdgcn_mfma_f32_32x32x16_bf16(PAF(2),VFR(2),o[0],0,0,0), C1,0); \
    KRD(GL,3); GAPB(o[1]=__builtin_amdgcn_mfma_f32_32x32x16_bf16(PAF(2),VFR(6),o[1],0,0,0), C1,4); \
    GAPB(o[0]=__builtin_amdgcn_mfma_f32_32x32x16_bf16(PAF(3),VFR(3),o[0],0,0,0), C1,8); \
    GAPB(o[1]=__builtin_amdgcn_mfma_f32_32x32x16_bf16(PAF(3),VFR(7),o[1],0,0,0), C1,12); \
    }while(0)
  int t=1;
  for(;t+5<NT;t+=2){
    STEP(pB0,pB1,pA0,pA1,t,true,true,true);     WAIT_BAR(2); RESC(); ROT();
    STEP(pA0,pA1,pB0,pB1,t+1,true,true,true);   WAIT_BAR(2); RESC(); ROT();
  }
  #define ENDW(tt) do{ if((tt)+3<NT){WAIT_BAR(2);} else if((tt)+2<NT){WAIT_BAR(1);} else {WAIT_BAR(0);} }while(0)
  for(;t+1<NT;t+=2){
    STEP(pB0,pB1,pA0,pA1,t,(t+3<NT),(t+1<NT),(t+1<NT));       ENDW(t);   RESC(); ROT();
    STEP(pA0,pA1,pB0,pB1,t+1,(t+4<NT),(t+2<NT),(t+2<NT));     ENDW(t+1); RESC(); ROT();
  }
  STEP(pB0,pB1,pA0,pA1,NT-1,false,false,false); RESC();
  { const bool keep_=true; float sacc=pB0[0]+pB0[1]; _Pragma("unroll") for(int r=2;r<16;++r)sacc+=pB0[r]; _Pragma("unroll") for(int r=0;r<16;++r)sacc+=pB1[r]; l_reg+=sacc;
    pw0=(u32x4){PKW(pB0,0),PKW(pB0,2),PKW(pB0,4),PKW(pB0,6)};pw1=(u32x4){PKW(pB0,8),PKW(pB0,10),PKW(pB0,12),PKW(pB0,14)};pw2=(u32x4){PKW(pB1,0),PKW(pB1,2),PKW(pB1,4),PKW(pB1,6)};pw3=(u32x4){PKW(pB1,8),PKW(pB1,10),PKW(pB1,12),PKW(pB1,14)};
    SBAR(); pv(o,vb0+sl_cur,PAF(0),PAF(1),PAF(2),PAF(3)); }
  #undef PKW
  #undef PAF
  #undef VFR
  #undef PIN
  #undef MX3
  #undef GAPA
  #undef GAPB
  #undef EX
  #undef VRD
  #undef KRD
  #undef STEP
  #undef ENDW
  {auto rr=__builtin_amdgcn_permlane32_swap(__float_as_uint(l_reg),__float_as_uint(l_reg),false,false);l_reg=__uint_as_float(rr[0])+__uint_as_float(rr[1]);}
  if(hi==0)wsf[32+r32]=l_reg;asm volatile("s_waitcnt lgkmcnt(0)":::"memory");
  float rli[16];
  #pragma unroll
  for(int r=0;r<16;++r)rli[r]=__builtin_amdgcn_rcpf(wsf[32+crow(r,hi)]);
  { bf16*stg=(bf16*)(shm+LDS_OST)+wid*2048;
    int*dtab=(int*)(shm+LDS_DST)+wid*32;
    if(hi==0){ dtab[r32]=dest; if(dest>=0){ PML[2*(long)dest]=mhat; PML[2*(long)dest+1]=l_reg; } }
    #pragma unroll
    for(int r=0;r<16;++r){const int orow=crow(r,hi);
      #pragma unroll
      for(int d0=0;d0<2;++d0)stg[orow*64+d0*32+r32]=__float2bfloat16(o[d0][r]*rli[r]);}
    asm volatile("s_waitcnt lgkmcnt(0)":::"memory");
    #pragma unroll
    for(int i=0;i<4;++i){const int row=i*8+(lane>>3),ch=lane&7; const int dr=dtab[row]; const u32x4 v=*(const u32x4*)(stg+row*64+ch*8); if(dr>=0)*(u32x4*)(PO+(long)dr*64+ch*8)=v;} }
  asm volatile("s_waitcnt lgkmcnt(0)\n\ts_barrier":::"memory");
  #undef DMA_K
  #undef DMA_V
  #undef CMASK
  #undef BMASK
  #undef START
  #undef RESC
  #undef ROT
}
template<int THRL> __device__ __forceinline__ void moba_chunk4(const bf16*Qrow,bool causal,int dest,bf16*PO,float*PML,char*shm){
  int tid_=threadIdx.x; asm volatile("":"+v"(tid_)); const int tid=tid_,lane=tid&63,r32=lane&31,hi=lane>>5; const int wid=__builtin_amdgcn_readfirstlane(tid>>6);
  const unsigned lds0=(unsigned)(uintptr_t)shm;
  float*wsf=(float*)(shm+LDS_WS)+wid*64;
  const int vb0=(int)(lds0+LDS_V)+((lane>>4)&1)*32+(lane&3)*8+(4*hi+((lane&15)>>2))*64;
  const char*Kbase=shm+LDS_K; bf16x8 kf[8];
  const lds_cptr shm3=(lds_cptr)shm; const lds_cptr kp0=shm3+LDS_K+hi*1024+r32*16; const lds_cptr vp0=shm3+LDS_V+((lane>>4)&1)*32+(lane&3)*8+(4*hi+((lane&15)>>2))*64;
  constexpr int NT=4;
  bf16x8 qr[4];
  #pragma unroll
  for(int d0=0;d0<4;++d0)qr[d0]=*reinterpret_cast<const bf16x8*>(Qrow+d0*16+hi*8);
  float mhat=0.f,l_reg=0.f;f32x16 o[2];o[0]=f32x16{};o[1]=f32x16{};f32x16 negm=f32x16{};asm volatile("":"+v"(negm));
  const int qrel=wid*QBLK+r32;
  #define BMASK(P0,P1,t) do{}while(0)
  #define CMASK(P0,P1,t) do{ if(causal)cmask(P0,P1,(t),qrel,hi); }while(0)
  bool resc=false;
  #define START(P0,P1) do{ const float rm=rowmax(P0,P1); resc=false; \
    { const float dl=__builtin_fmaxf(rm,-64.f); mhat=fadd_s(mhat,dl); \
      _Pragma("unroll") for(int r=0;r<16;++r){P0[r]=fsub_s(P0[r],dl);P1[r]=fsub_s(P1[r],dl);} \
      _Pragma("unroll") for(int r=0;r<16;++r)negm[r]=-mhat; asm volatile("":"+v"(negm)); } \
    _Pragma("unroll") for(int r=0;r<16;++r)P0[r]=__builtin_amdgcn_exp2f(P0[r]); }while(0)
  #define RESC() do{ if(resc){ asm volatile("s_waitcnt lgkmcnt(0)":::"memory"); \
      _Pragma("unroll") for(int d_=0;d_<2;++d_) _Pragma("unroll") for(int r=0;r<16;++r)o[d_][r]*=wsf[crow(r,hi)]; } }while(0)
  f32x16 pA0,pA1,pB0,pB1;
  int sl_prev=0,sl_cur=0,sl_next=SLOTB;
  #define ROT() do{sl_prev=sl_cur;sl_cur=sl_next;sl_next=(sl_next==(NSLOT-1)*SLOTB)?0:sl_next+SLOTB;}while(0)
  qkt(pA0,pA1,Kbase,qr,negm,r32,hi);asm volatile("s_nop 15\n\ts_nop 7":"+v"(pA0),"+v"(pA1));CMASK(pA0,pA1,0);
  START(pA0,pA1);
  _Pragma("unroll") for(int r=0;r<16;++r)pA1[r]=__builtin_amdgcn_exp2f(pA1[r]);
  ROT();
  kload8(kf,kp0+sl_cur);
  s16x4 vlo[8],vhi[8]; u32x4 pw0,pw1,pw2,pw3;
  #define PKW(P,B) (keep_?cvtpk_s(P[B],P[B+1]):0u)
  #define PAF(k) __builtin_bit_cast(bf16x8,pw##k)
  #define VFR(i) (bf16x8){vlo[i][0],vlo[i][1],vlo[i][2],vlo[i][3],vhi[i][0],vhi[i][1],vhi[i][2],vhi[i][3]}
  #define PIN(x) asm volatile("":"+v"(x))
  #define MX3(a,b,c) __builtin_fmaxf(__builtin_fmaxf((a),(b)),(c))
  #define GAPA(MF,A0,A1,A2,A3,W0,W1,PW) do{ MF; sacc+=A0; sacc+=A1; sacc+=A2; sacc+=A3; PIN(sacc); W0; W1; PIN(PW); SBAR(); }while(0)
  #define EX(v) __builtin_amdgcn_exp2f(v)
  #define GAPB(MF,X,B) do{ MF; X[B]=EX(X[B]); X[B+1]=EX(X[B+1]); X[B+2]=EX(X[B+2]); X[B+3]=EX(X[B+3]); PIN(X); SBAR(); }while(0)
  #define VRD(i) do{ vlo[i]=vtr(vp_+(((i)>>2)*4096+((i)&3)*1024)); vhi[i]=vtr(vp_+(((i)>>2)*4096+((i)&3)*1024+512)); }while(0)
  #define KRD(G,j) do{ if(G){ kload2(kf,kp0+sl_next,j); SBAR(); } }while(0)
  #define STEP(C0,C1,P0,P1,t,GK,GV,GL) do{ SBAR(); \
    const bool keep_=true; \
    const lds_cptr vp_=vp0+sl_prev; \
    VRD(0); SBAR(); float sacc=(P0[0]+P0[1]); \
    GAPA(C0=__builtin_amdgcn_mfma_f32_32x32x16_bf16(kf[0],qr[0],negm,0,0,0), P0[2],P0[3],P0[4],P0[5],     pw0[0]=PKW(P0,0), pw0[1]=PKW(P0,2), pw0); \
    VRD(4); SBAR(); GAPA(C1=__builtin_amdgcn_mfma_f32_32x32x16_bf16(kf[1],qr[0],negm,0,0,0), P0[6],P0[7],P0[8],P0[9],     pw0[2]=PKW(P0,4), pw0[3]=PKW(P0,6), pw0); \
    VRD(1); SBAR(); GAPA(C0=__builtin_amdgcn_mfma_f32_32x32x16_bf16(kf[2],qr[1],C0,0,0,0),   P0[10],P0[11],P0[12],P0[13], pw1[0]=PKW(P0,8), pw1[1]=PKW(P0,10), pw1); \
    VRD(5); SBAR(); GAPA(C1=__builtin_amdgcn_mfma_f32_32x32x16_bf16(kf[3],qr[1],C1,0,0,0),   P0[14],P0[15],P1[0],P1[1],   pw1[2]=PKW(P0,12),pw1[3]=PKW(P0,14), pw1); \
    VRD(2); SBAR(); GAPA(C0=__builtin_amdgcn_mfma_f32_32x32x16_bf16(kf[4],qr[2],C0,0,0,0),   P1[2],P1[3],P1[4],P1[5],     pw2[0]=PKW(P1,0), pw2[1]=PKW(P1,2), pw2); \
    VRD(6); SBAR(); GAPA(C1=__builtin_amdgcn_mfma_f32_32x32x16_bf16(kf[5],qr[2],C1,0,0,0),   P1[6],P1[7],P1[8],P1[9],     pw2[2]=PKW(P1,4), pw2[3]=PKW(P1,6), pw2); \
    VRD(3); SBAR(); GAPA(C0=__builtin_amdgcn_mfma_f32_32x32x16_bf16(kf[6],qr[3],C0,0,0,0),   P1[10],P1[11],P1[12],P1[13], pw3[0]=PKW(P1,8), pw3[1]=PKW(P1,10), pw3); \
    VRD(7); SBAR(); GAPA(C1=__builtin_amdgcn_mfma_f32_32x32x16_bf16(kf[7],qr[3],C1,0,0,0),   P1[14],P1[15],0.f,0.f,       pw3[2]=PKW(P1,12),pw3[3]=PKW(P1,14), pw3); \
    l_reg+=keep_?sacc:0.f; \
    CMASK(C0,C1,t); \
    { float a=MX3(C0[0],C0[1],C1[0]),b=MX3(C0[2],C0[3],C1[1]); a=MX3(a,C1[2],C1[3]); \
      _Pragma("unroll") for(int r=4;r<16;r+=4){a=MX3(a,C0[r],C0[r+1]);b=MX3(b,C0[r+2],C0[r+3]);a=MX3(a,C1[r],C1[r+1]);b=MX3(b,C1[r+2],C1[r+3]);} \
      float rm=__builtin_fmaxf(a,b); { auto rr=__builtin_amdgcn_permlane32_swap(__float_as_uint(rm),__float_as_uint(rm),false,false); rm=__builtin_fmaxf(__uint_as_float(rr[0]),__uint_as_float(rr[1])); } \
      resc=false; \
      if(__builtin_expect(__any(rm>(float)THRL),0)){ const float dl=__builtin_fmaxf(rm,0.f); mhat+=dl; \
        _Pragma("unroll") for(int r=0;r<16;++r){C0[r]-=dl;C1[r]-=dl;} \
        _Pragma("unroll") for(int r=0;r<16;++r)negm[r]=-mhat; asm volatile("":"+v"(negm)); \
        const float f=__builtin_amdgcn_exp2f(-dl); l_reg*=f; if(hi==0)wsf[r32]=f; resc=true; } } \
    SBAR(); \
    GAPB(o[0]=__builtin_amdgcn_mfma_f32_32x32x16_bf16(PAF(0),VFR(0),o[0],0,0,0), C0,0); \
    GAPB(o[1]=__builtin_amdgcn_mfma_f32_32x32x16_bf16(PAF(0),VFR(4),o[1],0,0,0), C0,4); \
    KRD(GL,0); GAPB(o[0]=__builtin_amdgcn_mfma_f32_32x32x16_bf16(PAF(1),VFR(1),o[0],0,0,0), C0,8); \
    KRD(GL,1); GAPB(o[1]=__builtin_amdgcn_mfma_f32_32x32x16_bf16(PAF(1),VFR(5),o[1],0,0,0), C0,12); \
    KRD(GL,2); GAPB(o[0]=__builtin_amdgcn_mfma_f32_32x32x16_bf16(PAF(2),VFR(2),o[0],0,0,0), C1,0); \
    KRD(GL,3); GAPB(o[1]=__builtin_amdgcn_mfma_f32_32x32x16_bf16(PAF(2),VFR(6),o[1],0,0,0), C1,4); \
    GAPB(o[0]=__builtin_amdgcn_mfma_f32_32x32x16_bf16(PAF(3),VFR(3),o[0],0,0,0), C1,8); \
    GAPB(o[1]=__builtin_amdgcn_mfma_f32_32x32x16_bf16(PAF(3),VFR(7),o[1],0,0,0), C1,12); \
    }while(0)
  int t=1;
  for(;t+5<NT;t+=2){
    STEP(pB0,pB1,pA0,pA1,t,true,true,true);      RESC(); ROT();
    STEP(pA0,pA1,pB0,pB1,t+1,true,true,true);    RESC(); ROT();
  }
  #define ENDW(tt) do{ if((tt)+3<NT){} else if((tt)+2<NT){} else {} }while(0)
  for(;t+1<NT;t+=2){
    STEP(pB0,pB1,pA0,pA1,t,(t+3<NT),(t+1<NT),(t+1<NT));       ENDW(t);   RESC(); ROT();
    STEP(pA0,pA1,pB0,pB1,t+1,(t+4<NT),(t+2<NT),(t+2<NT));     ENDW(t+1); RESC(); ROT();
  }
  STEP(pB0,pB1,pA0,pA1,NT-1,false,false,false); RESC();
  { const bool keep_=true; float sacc=pB0[0]+pB0[1]; _Pragma("unroll") for(int r=2;r<16;++r)sacc+=pB0[r]; _Pragma("unroll") for(int r=0;r<16;++r)sacc+=pB1[r]; l_reg+=sacc;
    pw0=(u32x4){PKW(pB0,0),PKW(pB0,2),PKW(pB0,4),PKW(pB0,6)};pw1=(u32x4){PKW(pB0,8),PKW(pB0,10),PKW(pB0,12),PKW(pB0,14)};pw2=(u32x4){PKW(pB1,0),PKW(pB1,2),PKW(pB1,4),PKW(pB1,6)};pw3=(u32x4){PKW(pB1,8),PKW(pB1,10),PKW(pB1,12),PKW(pB1,14)};
    SBAR(); pv(o,vb0+sl_cur,PAF(0),PAF(1),PAF(2),PAF(3)); }
  #undef PKW
  #undef PAF
  #undef VFR
  #undef PIN
  #undef MX3
  #undef GAPA
  #undef GAPB
  #undef EX
  #undef VRD
  #undef KRD
  #undef STEP
  #undef ENDW
  {auto rr=__builtin_amdgcn_permlane32_swap(__float_as_uint(l_reg),__float_as_uint(l_reg),false,false);l_reg=__uint_as_float(rr[0])+__uint_as_float(rr[1]);}
  if(hi==0)wsf[32+r32]=l_reg;asm volatile("s_waitcnt lgkmcnt(0)":::"memory");
  float rli[16];
  #pragma unroll
  for(int r=0;r<16;++r)rli[r]=__builtin_amdgcn_rcpf(wsf[32+crow(r,hi)]);
  { bf16*stg=(bf16*)(shm+LDS_OST)+wid*2048;
    int*dtab=(int*)(shm+LDS_DST)+wid*32;
    if(hi==0){ dtab[r32]=dest; if(dest>=0){ PML[2*(long)dest]=mhat; PML[2*(long)dest+1]=l_reg; } }
    #pragma unroll
    for(int r=0;r<16;++r){const int orow=crow(r,hi);
      #pragma unroll
      for(int d0=0;d0<2;++d0)stg[orow*64+d0*32+r32]=__float2bfloat16(o[d0][r]*rli[r]);}
    asm volatile("s_waitcnt lgkmcnt(0)":::"memory");
    #pragma unroll
    for(int i=0;i<4;++i){const int row=i*8+(lane>>3),ch=lane&7; const int dr=dtab[row]; const u32x4 v=*(const u32x4*)(stg+row*64+ch*8); if(dr>=0)*(u32x4*)(PO+(long)dr*64+ch*8)=v;} }
  asm volatile("s_waitcnt lgkmcnt(0)":::"memory");
  #undef CMASK
  #undef BMASK
  #undef START
  #undef RESC
  #undef ROT
}

__device__ __forceinline__ void moba_load_kv(const bf16*Kh,const bf16*Vh,char*shm){
  int tid_=threadIdx.x; asm volatile("":"+v"(tid_)); const int lane=tid_&63; const int wid=__builtin_amdgcn_readfirstlane(tid_>>6);
  const unsigned lds0=(unsigned)(uintptr_t)shm;
  const bf16*ksrc=Kh+(long)lane*DM+wid*8;
  const bf16*vsrc=Vh+(long)(16*(wid&3)+(lane>>2))*DM+(wid>>2)*32+(lane&3)*8;
  const unsigned kdst=lds0+LDS_K+wid*1024, vdst=lds0+LDS_V+wid*1024;
  #pragma unroll
  for(int t=0;t<4;++t){ glds16(ksrc+(long)t*KVBLK*DM,(unsigned)__builtin_amdgcn_readfirstlane(kdst+t*SLOTB)); glds16(vsrc+(long)t*KVBLK*DM,(unsigned)__builtin_amdgcn_readfirstlane(vdst+t*SLOTB)); }
  asm volatile("s_waitcnt vmcnt(0)":::"memory");
}
constexpr int ATTN_LDS_BYTES=LDS_BYTES;
struct AttnTensors { const bf16* Q; const bf16* K; const bf16* V; bf16* O; const float* KM; };
struct AttnUnit { int bh; int qb; };
struct StaticOrder {
  int vcu;
  __device__ __forceinline__ explicit StaticOrder(int grid,int block):vcu((block%8)*(grid/8)+block/8){}
  __device__ __forceinline__ bool next(int i,AttnUnit&u)const{ if(i>=4)return false; const int s=vcu&7; u.bh=vcu>>3; u.qb=(i==0)?s:(i==1)?15-s:(i==2)?16+s:31-s; return true; }
  __device__ __forceinline__ void a_ready(const AttnUnit&)const{}
  __device__ __forceinline__ void done(const AttnUnit&)const{}
};
template<class Sched,int THRL=8> __device__ __forceinline__ void attn_phase(char*lds,const AttnTensors&T,const Sched&S){
  AttnUnit u; int lastbh=-1;
  for(int i=0;S.next(i,u);++i){
    if(u.bh!=lastbh){ __syncthreads(); float*km=(float*)(lds+LDS_KM); int tx_=threadIdx.x; asm volatile("":"+v"(tx_)); for(int k=tx_;k<32*64;k+=512)km[k]=T.KM[(long)u.bh*32*64+k]+T.KM[(long)(BATCH*NHEAD+u.bh)*32*64+k]; asm volatile("s_waitcnt vmcnt(0) lgkmcnt(0)":::"memory"); __syncthreads(); lastbh=u.bh; }
    attn_unit<THRL>(u.bh/NHEAD,u.bh%NHEAD,u.qb,T.Q,T.K,T.V,T.O,lds); }
}
#undef SBAR
#undef WAIT_BAR
}

#define XB_TMO      128
#define XB_XCNT(j)  (256  + 64 * (j))
#define XB_XSUB(j)  (1280 + 64 * (j))
#define XB_XGEN(j)  (2304 + 64 * (j))
#define XB_TOP      3328
#define XB_TOPGEN   3392
#define XCD_BAR_WORDS 3456
#define XB_SPIN_CAP (1u << 20)
__device__ __forceinline__ unsigned xb_ld(unsigned* p)              { return __hip_atomic_load(p, __ATOMIC_RELAXED, __HIP_MEMORY_SCOPE_AGENT); }
__device__ __forceinline__ unsigned xb_add(unsigned* p, unsigned v) { return __hip_atomic_fetch_add(p, v, __ATOMIC_RELAXED, __HIP_MEMORY_SCOPE_AGENT); }
__device__ __forceinline__ unsigned xb_xcc_id() { return (unsigned)__builtin_amdgcn_s_getreg((3 << 11) | 20) & 0xFu; }
#define XB_SPIN(cond, bar) do { unsigned _sp = 0; while (cond) { __builtin_amdgcn_s_sleep(1); \
    if ((++_sp & 255u) == 0u) { if (xb_ld(&(bar)[XB_TMO])) break; if (_sp > XB_SPIN_CAP) { atomicAdd(&(bar)[XB_TMO], 1u); break; } } } } while (0)
struct XcdBarrier { unsigned* bar; unsigned x; volatile LAS unsigned* st; };
__device__ __forceinline__ XcdBarrier xcd_barrier_post(unsigned* bar, volatile LAS unsigned* st) {
    XcdBarrier b; b.bar = bar; b.x = xb_xcc_id(); b.st = st;
    if (threadIdx.x == 0) (void)xb_add(&bar[XB_XCNT(b.x)], 1u);
    return b;
}
__device__ __forceinline__ void xcd_barrier_complete(unsigned* bar, unsigned x, unsigned& nloc, unsigned& nx) {
    const unsigned G = gridDim.x * gridDim.y * gridDim.z;
    unsigned sum, cnt, mine, sp = 0u;
    for (;;) {
        sum = 0u; cnt = 0u; mine = 0u;
#pragma unroll
        for (unsigned j = 0; j < 16; ++j) { const unsigned c = xb_ld(&bar[XB_XCNT(j)]); sum += c; cnt += (c > 0u) ? 1u : 0u; mine = (j == x) ? c : mine; }
        if (sum == G) break;
        __builtin_amdgcn_s_sleep(1);
        if ((++sp & 255u) == 0u) { if (xb_ld(&bar[XB_TMO])) break; if (sp > XB_SPIN_CAP) { atomicAdd(&bar[XB_TMO], 1u); break; } }
    }
    nloc = mine > 0u ? mine : 1u; nx = cnt > 0u ? cnt : 1u;
}
__device__ __forceinline__ void xcd_barrier(const XcdBarrier& b) {
    asm volatile("s_waitcnt vmcnt(0)" ::: "memory");
    __syncthreads();
    if (threadIdx.x == 0) {
        unsigned* bar = b.bar;
        __builtin_amdgcn_s_waitcnt(0);
        unsigned nloc = b.st[0], nx = b.st[1];
        if (nloc == 0u) { xcd_barrier_complete(bar, b.x, nloc, nx); b.st[0] = nloc; b.st[1] = nx; }
        const unsigned old = xb_add(&bar[XB_XSUB(b.x)], 1u);
        const unsigned gen = old / nloc;
        if (old + 1u == (gen + 1u) * nloc) {
            __builtin_amdgcn_fence(__ATOMIC_RELEASE, "agent");
            asm volatile("s_waitcnt vmcnt(0)" ::: "memory");
            const unsigned og = xb_add(&bar[XB_TOP], 1u);
            const unsigned tg = og / nx;
            if (og + 1u == (tg + 1u) * nx) xb_add(&bar[XB_TOPGEN], 1u);
            else XB_SPIN(xb_ld(&bar[XB_TOPGEN]) == tg, bar);
            __builtin_amdgcn_fence(__ATOMIC_ACQUIRE, "agent");
            xb_add(&bar[XB_XGEN(b.x)], 1u);
            asm volatile("s_waitcnt vmcnt(0)" ::: "memory");
        } else {
            XB_SPIN(xb_ld(&bar[XB_XGEN(b.x)]) == gen, bar);
            __builtin_amdgcn_fence(__ATOMIC_ACQUIRE, "agent");
            asm volatile("s_waitcnt vmcnt(0)" ::: "memory");
        }
    }
    __syncthreads();
}

struct Args { const float* in[28]; float* out; unsigned char* ws; int ph_lo, ph_hi; };
enum { I_X = 0, I_MEM, I_GMIX, I_WIN, I_ARE, I_AIM, I_LOGDT, I_BRE, I_BIM, I_CRE, I_CIM, I_DSKIP, I_WGLU, I_WPA, I_WOUT, I_GXATTN, I_GMEM, I_WXQ, I_WXKV, I_WXO,
       I_GMOE, I_WROUTER, I_BROUTER, I_WGU, I_BGU, I_WDN, I_BDN, I_GFINAL };

struct TrDesc { const float* W; const float* gain; bf16_t* WT; int K, N, map, item; int fp8 = 0; };
__device__ __forceinline__ void tr_load(const TrDesc& d, f32x4 (&v)[16], float (&g)[16], int lane) {
    const int nblk = d.N / 64, kb = d.item / nblk, nb = d.item % nblk, k0 = 64 * kb, n0 = 64 * nb, q = lane & 15, kr = lane >> 4;
    const float* src = d.W + (size_t)(k0 + kr) * d.N + n0 + 4 * q;
#pragma unroll
    for (int j = 0; j < 16; ++j) v[j] = *(const f32x4*)(src + (size_t)(4 * j) * d.N);
#pragma unroll
    for (int j = 0; j < 16; ++j) g[j] = d.gain ? d.gain[k0 + kr + 4 * j] : 1.0f;
}
__device__ __forceinline__ void tr_finish(const TrDesc& d, const f32x4 (&v)[16], const float (&g)[16], LAS float* scr, int lane) {
    const int nblk = d.N / 64, kb = d.item / nblk, nb = d.item % nblk, k0 = 64 * kb, n0 = 64 * nb, q = lane & 15, kr = lane >> 4;
#pragma unroll
    for (int j = 0; j < 16; ++j) { const int kk = kr + 4 * j; *(LAS f32x4*)(scr + kk * 64 + 4 * (q ^ ((kk >> 3) & 7))) = v[j] * g[j]; }
    asm volatile("s_waitcnt lgkmcnt(0)" ::: "memory");
    const int c = lane & 7, nq = lane >> 3;
    const int nr0 = d.map ? (256 * ((n0 % 1024) / 128) + 128 * (n0 / 1024) + (n0 % 128)) : n0;
#pragma unroll
    for (int jj = 0; jj < 8; ++jj) { const int n = 8 * jj + nq; const LAS float* sp = scr + (8 * c) * 64 + (n ^ (4 * c));
        if (d.fp8) { const float sc = (float)(1 << FP8_WSHIFT); int w0 = 0, w1 = 0;
            w0 = __builtin_amdgcn_cvt_pk_fp8_f32(sp[0 * 64] * sc, sp[1 * 64] * sc, w0, false); w0 = __builtin_amdgcn_cvt_pk_fp8_f32(sp[2 * 64] * sc, sp[3 * 64] * sc, w0, true);
            w1 = __builtin_amdgcn_cvt_pk_fp8_f32(sp[4 * 64] * sc, sp[5 * 64] * sc, w1, false); w1 = __builtin_amdgcn_cvt_pk_fp8_f32(sp[6 * 64] * sc, sp[7 * 64] * sc, w1, true);
            *(u32x2*)((unsigned char*)d.WT + (size_t)(nr0 + n) * d.K + k0 + 8 * c) = (u32x2){(unsigned)w0, (unsigned)w1}; }
        else { u32x4 o; o.x = pk2(sp[0 * 64], sp[1 * 64]); o.y = pk2(sp[2 * 64], sp[3 * 64]); o.z = pk2(sp[4 * 64], sp[5 * 64]); o.w = pk2(sp[6 * 64], sp[7 * 64]);
            *(u32x4*)(d.WT + (size_t)(nr0 + n) * d.K + k0 + 8 * c) = o; } }
    asm volatile("s_waitcnt lgkmcnt(0)" ::: "memory");
}
template <int MODE>
__device__ __forceinline__ float rms_row_to_bf16(const float* xrow, const float* gain, bf16_t* orow, int lane) {
    const f32x4* xr = (const f32x4*)xrow + lane;
    f32x4 v[4]; float s = 0.f;
#pragma unroll
    for (int j = 0; j < 4; ++j) { v[j] = xr[64 * j]; s += (v[j][0] * v[j][0] + v[j][1] * v[j][1]) + (v[j][2] * v[j][2] + v[j][3] * v[j][3]); }
    const float rstd = 1.0f / sqrtf(wave_sum(s) * (1.0f / DM) + RMS_EPS);
    u32x2* o8 = (u32x2*)orow + lane;
#pragma unroll
    for (int j = 0; j < 4; ++j) { f32x4 w = v[j];
        if (MODE == 1) { const f32x4 g = ((const f32x4*)gain)[lane + 64 * j]; w = w * rstd * g; }
        u32x2 o; o.x = pk2(w[0], w[1]); o.y = pk2(w[2], w[3]); o8[64 * j] = o; }
    return rstd;
}

struct Frame {
    LAS unsigned char* lds; int tid, lane, wave, G, bid;
    const float* in[28]; float* out; unsigned char* ws; unsigned* ctl;
};
#define WSP(type, off) ((type*)(F.ws + (off)))

__device__ __forceinline__ TrDesc tr_decode(Frame& F, int it) {
    constexpr int I_IN = (DM / 64) * (INW / 64), I_GLU = (SW / 64) * (2 * DM / 64), I_PA = (AW / 64) * (DM / 64), I_OUT = (DM / 64) * (DM / 64), I_XQ = (DM / 64) * (XW / 64),
                  I_XKV = (DM / 64) * (2 * XW / 64), I_XO = (XW / 64) * (DM / 64), I_GU1 = (DM / 64) * (2 * DFF / 64), I_DN1 = (DFF / 64) * (DM / 64);
    int r = it;
    if (r < I_IN) return TrDesc{F.in[I_WIN], F.in[I_GMIX], WSP(bf16_t, WS_WIN), DM, INW, 0, r}; r -= I_IN;
    if (r < I_GLU) return TrDesc{F.in[I_WGLU], nullptr, WSP(bf16_t, WS_WGLU), SW, 2 * DM, 1, r}; r -= I_GLU;
    if (r < I_PA) return TrDesc{F.in[I_WPA], nullptr, WSP(bf16_t, WS_WPA), AW, DM, 0, r}; r -= I_PA;
    if (r < I_OUT) return TrDesc{F.in[I_WOUT], nullptr, WSP(bf16_t, WS_WOUT), DM, DM, 0, r}; r -= I_OUT;
    if (r < I_XQ) return TrDesc{F.in[I_WXQ], F.in[I_GXATTN], WSP(bf16_t, WS_WXQ), DM, XW, 0, r}; r -= I_XQ;
    if (r < I_XKV) return TrDesc{F.in[I_WXKV], nullptr, WSP(bf16_t, WS_WXKV), DM, 2 * XW, 0, r}; r -= I_XKV;
    if (r < I_XO) return TrDesc{F.in[I_WXO], nullptr, WSP(bf16_t, WS_WXO), XW, DM, 0, r}; r -= I_XO;
    const int e = r / (I_GU1 + I_DN1); r -= e * (I_GU1 + I_DN1);
    if (r < I_GU1) return TrDesc{F.in[I_WGU] + (size_t)e * DM * 2 * DFF, F.in[I_GMOE], (bf16_t*)(F.ws + WS_WGU + (MOE1_FP8 ? (size_t)e * 2 * DFF * DM : (size_t)e * 2 * DFF * DM * 2)), DM, 2 * DFF, 1, r, MOE1_FP8};
    return TrDesc{F.in[I_WDN] + (size_t)e * DFF * DM, nullptr, (bf16_t*)(F.ws + WS_WDN + (MOE2_FP8 ? (size_t)e * DM * DFF : (size_t)e * DM * DFF * 2)), DFF, DM, 0, r - I_GU1, MOE2_FP8};
}
__device__ __forceinline__ void xrow_load(const float* X, int m, f32x4 (&v)[4][4], int lane) {
#pragma unroll
    for (int r = 0; r < 4; ++r)
#pragma unroll
        for (int j = 0; j < 4; ++j) v[r][j] = ((const f32x4*)(X + (size_t)(m + r) * DM))[lane + 64 * j];
}
__device__ __forceinline__ void xrow_finish(bf16_t* XBp, int m, const f32x4 (&v)[4][4], int lane) {
    float ss[4];
#pragma unroll
    for (int r = 0; r < 4; ++r) { float s = 0.f;
#pragma unroll
        for (int j = 0; j < 4; ++j) s += (v[r][j][0] * v[r][j][0] + v[r][j][1] * v[r][j][1]) + (v[r][j][2] * v[r][j][2] + v[r][j][3] * v[r][j][3]);
        ss[r] = s; }
#pragma unroll
    for (int o = 1; o < 64; o <<= 1) {
#pragma unroll
        for (int r = 0; r < 4; ++r) ss[r] += __shfl_xor(ss[r], o); }
#pragma unroll
    for (int r = 0; r < 4; ++r) { u32x2* o8 = (u32x2*)(XBp + (size_t)(m + r) * DM) + lane;
        const float rs = 1.0f / sqrtf(ss[r] * (1.0f / DM) + RMS_EPS);
#pragma unroll
        for (int j = 0; j < 4; ++j) { u32x2 o; o.x = pk2(v[r][j][0] * rs, v[r][j][1] * rs); o.y = pk2(v[r][j][2] * rs, v[r][j][3] * rs); o8[64 * j] = o; } }
}
constexpr int TR_SMALL = (DM / 64) * (INW / 64) + (SW / 64) * (2 * DM / 64) + (AW / 64) * (DM / 64) + (DM / 64) * (DM / 64) + (DM / 64) * (XW / 64) + (DM / 64) * (2 * XW / 64) + (XW / 64) * (DM / 64);
constexpr int TR_ALL = TR_SMALL + NE * ((DM / 64) * (2 * DFF / 64) + (DFF / 64) * (DM / 64));
__device__ __forceinline__ void convert_weights(Frame& F, int which, int gw, int NGW) {
    LAS float* scr = (LAS float*)(F.lds + F.wave * 16384);
    const int lo = (which == 1) ? TR_SMALL : 0, hi = (which == 0) ? TR_SMALL : TR_ALL, first = lo + gw;
    f32x4 va[16], vb[16]; float ga[16], gb[16]; TrDesc da, db; const int n = (first < hi) ? (hi - first + NGW - 1) / NGW : 0;
    if (n > 0) { da = tr_decode(F, first); tr_load(da, va, ga, F.lane); int i = 0;
        for (; i + 2 <= n; i += 2) {
            db = tr_decode(F, first + (i + 1) * NGW); tr_load(db, vb, gb, F.lane);
            tr_finish(da, va, ga, scr, F.lane);
            da = tr_decode(F, first + min(i + 2, n - 1) * NGW); tr_load(da, va, ga, F.lane);
            tr_finish(db, vb, gb, scr, F.lane); }
        if (i < n) tr_finish(da, va, ga, scr, F.lane); }
}
__device__ __forceinline__ void phase_prologue(Frame& F) {
    LAS float* scr = (LAS float*)(F.lds + F.wave * 16384);
    const int gw = F.bid * 8 + F.wave, NGW = F.G * 8;
    { f32x4 va[4][4], vb[4][4]; const int step = NGW * 4, m0 = gw * 4, n = (m0 < T_) ? (T_ - m0 + step - 1) / step : 0;
      if (n > 0) { xrow_load(F.in[I_X], m0, va, F.lane); int i = 0;
          for (; i + 2 <= n; i += 2) {
              xrow_load(F.in[I_X], m0 + (i + 1) * step, vb, F.lane);
              xrow_finish(WSP(bf16_t, WS_XB), m0 + i * step, va, F.lane);
              xrow_load(F.in[I_X], m0 + min(i + 2, n - 1) * step, va, F.lane);
              xrow_finish(WSP(bf16_t, WS_XB), m0 + (i + 1) * step, vb, F.lane); }
          if (i < n) xrow_finish(WSP(bf16_t, WS_XB), m0 + i * step, va, F.lane); } }
    for (int m = gw; m < NB * MEML; m += NGW) (void)rms_row_to_bf16<1>(F.in[I_MEM] + (size_t)m * DM, F.in[I_GMEM], WSP(bf16_t, WS_MN) + (size_t)m * DM, F.lane);
    convert_weights(F, (CONV_SLOTS > 0 && (F.G >> 3) > CONV_SLOTS && (F.G & 7) == 0) ? 0 : 2, gw, NGW);
}

__device__ __forceinline__ void phase_kmean(Frame& F) {
    LAS float* red = (LAS float*)F.lds;
    const bf16_t* Kb = WSP(bf16_t, WS_K);
    for (int it = F.bid; it < NB * NH * NBLK; it += F.G) {
        const int j = it % NBLK, h = (it / NBLK) % NH, b = it / (NBLK * NH);
        const int col = F.tid & 63, rg = F.tid >> 6; float s = 0.f;
        const bf16_t* p = Kb + ((size_t)(b * SEQ + j * MBLK + rg * 32)) * AW + h * HD + col;
#pragma unroll 8
        for (int r = 0; r < 32; ++r) s += bf2f(p[(size_t)r * AW]);
        red[rg * 64 + col] = s;
        __syncthreads();
        if (F.tid < 64) { float t = 0.f;
#pragma unroll
            for (int k = 0; k < 8; ++k) t += red[k * 64 + F.tid];
            WSP(float, WS_KMEAN)[(size_t)it * HD + F.tid] = t * (1.0f / MBLK); }
        __syncthreads();
    }
}

__device__ __forceinline__ void phase_moba_simple(Frame& F, bf16_t* Ob) {
    LAS unsigned* Ks = (LAS unsigned*)F.lds;
    LAS unsigned* Vs = (LAS unsigned*)(F.lds + 32768);
    LAS float* km = (LAS float*)(F.lds + 65536);
    const bf16_t *Qb = WSP(bf16_t, WS_Q), *Kb = WSP(bf16_t, WS_K), *Vb = WSP(bf16_t, WS_V);
    const int ql = F.tid >> 1, half = F.tid & 1;
    for (int it = F.bid; it < NB * NH * NBLK; it += F.G) {
        const int iblk = (NBLK - 1) - (it % NBLK), h = (it / NBLK) % NH, b = it / (NBLK * NH);
        __syncthreads();
        for (int k = F.tid; k < NBLK * HD; k += 512) km[k] = WSP(float, WS_KMEAN)[(size_t)((b * NH + h) * NBLK) * HD + k] + WSP(float, WS_KMEAN)[(size_t)((NB * NH + b * NH + h) * NBLK) * HD + k];
        float q[32];
        { const u32x4* qp = (const u32x4*)(Qb + (size_t)(b * SEQ + iblk * MBLK + ql) * AW + h * HD + half * 32);
#pragma unroll
          for (int c = 0; c < 4; ++c) { const u32x4 w = qp[c]; q[8 * c + 0] = bflo(w.x); q[8 * c + 1] = bfhi(w.x); q[8 * c + 2] = bflo(w.y); q[8 * c + 3] = bfhi(w.y); q[8 * c + 4] = bflo(w.z); q[8 * c + 5] = bfhi(w.z); q[8 * c + 6] = bflo(w.w); q[8 * c + 7] = bfhi(w.w); } }
        __syncthreads();
        float g0 = -3e38f, g1 = -3e38f, g2 = -3e38f; int s0 = -1, s1 = -1, s2 = -1;
        for (int j = 0; j < iblk; ++j) { float g = 0.f;
#pragma unroll
            for (int d = 0; d < 32; ++d) g += q[d] * km[j * HD + half * 32 + d];
            g += __shfl_xor(g, 1);
            if (g > g0) { g2 = g1; s2 = s1; g1 = g0; s1 = s0; g0 = g; s0 = j; } else if (g > g1) { g2 = g1; s2 = s1; g1 = g; s1 = j; } else if (g > g2) { g2 = g; s2 = j; } }
        float mx = -3e38f, l = 0.f, o[32];
#pragma unroll
        for (int d = 0; d < 32; ++d) o[d] = 0.f;
        for (int jb = 0; jb <= iblk; ++jb) {
            __syncthreads();
            { const size_t rowb = (size_t)(b * SEQ + jb * MBLK);
              for (int c = F.tid; c < 256 * 8; c += 512) { const int r = c >> 3, ch = c & 7;
                  *(LAS u32x4*)(Ks + r * 32 + ch * 4) = *(const u32x4*)(Kb + (rowb + r) * AW + h * HD + ch * 8);
                  *(LAS u32x4*)(Vs + r * 32 + ch * 4) = *(const u32x4*)(Vb + (rowb + r) * AW + h * HD + ch * 8); } }
            __syncthreads();
            const bool need = (jb == iblk) || jb == s0 || jb == s1 || jb == s2;
            if (need) { const int kend = (jb == iblk) ? ql : 255;
                for (int kk = 0; kk <= kend; ++kk) { float s = 0.f;
#pragma unroll
                    for (int c = 0; c < 4; ++c) { const u32x4 w = *(const LAS u32x4*)(Ks + kk * 32 + half * 16 + c * 4);
                        s += q[8 * c + 0] * bflo(w.x) + q[8 * c + 1] * bfhi(w.x) + q[8 * c + 2] * bflo(w.y) + q[8 * c + 3] * bfhi(w.y) + q[8 * c + 4] * bflo(w.z) + q[8 * c + 5] * bfhi(w.z) + q[8 * c + 6] * bflo(w.w) + q[8 * c + 7] * bfhi(w.w); }
                    s += __shfl_xor(s, 1);
                    const float mn = fmaxf(mx, s), corr = __builtin_amdgcn_exp2f(mx - mn), p = __builtin_amdgcn_exp2f(s - mn); mx = mn; l = l * corr + p;
#pragma unroll
                    for (int c = 0; c < 4; ++c) { const u32x4 w = *(const LAS u32x4*)(Vs + kk * 32 + half * 16 + c * 4);
                        o[8 * c + 0] = o[8 * c + 0] * corr + p * bflo(w.x); o[8 * c + 1] = o[8 * c + 1] * corr + p * bfhi(w.x); o[8 * c + 2] = o[8 * c + 2] * corr + p * bflo(w.y); o[8 * c + 3] = o[8 * c + 3] * corr + p * bfhi(w.y);
                        o[8 * c + 4] = o[8 * c + 4] * corr + p * bflo(w.z); o[8 * c + 5] = o[8 * c + 5] * corr + p * bfhi(w.z); o[8 * c + 6] = o[8 * c + 6] * corr + p * bflo(w.w); o[8 * c + 7] = o[8 * c + 7] * corr + p * bfhi(w.w); } } }
        }
        const float il = 1.0f / l;
        u32x4* op = (u32x4*)(Ob + (size_t)(b * SEQ + iblk * MBLK + ql) * AW + h * HD + half * 32);
#pragma unroll
        for (int c = 0; c < 4; ++c) { u32x4 w; w.x = pk2(o[8 * c + 0] * il, o[8 * c + 1] * il); w.y = pk2(o[8 * c + 2] * il, o[8 * c + 3] * il); w.z = pk2(o[8 * c + 4] * il, o[8 * c + 5] * il); w.w = pk2(o[8 * c + 6] * il, o[8 * c + 7] * il); op[c] = w; }
    }
}

__device__ __forceinline__ void phase_ssm_simple(Frame& F, bf16_t* Yb) {
    const int gw = F.bid * 8 + F.wave, NGW = F.G * 8, p = F.lane;
    const bf16_t* Ub = WSP(bf16_t, WS_U);
    for (int it = gw; it < NB * NG; it += NGW) {
        const int g = it % NG, b = it / NG;
        const float are = fminf(F.in[I_ARE][g * SP + p], -1e-4f), aim = F.in[I_AIM][g * SP + p], dt = expf(F.in[I_LOGDT][g]);
        const float mag = expf(are * dt), ang = aim * dt; const float lr = mag * cosf(ang), li = mag * sinf(ang);
        const float nr = lr - 1.0f, ni = li, den = 1.0f / (are * are + aim * aim); const float fr_ = (nr * are + ni * aim) * den, fi_ = (ni * are - nr * aim) * den;
        float bbr[16], bbi[16], cr[16], ci[16], dsk[16];
#pragma unroll
        for (int c = 0; c < 16; ++c) { const float br = F.in[I_BRE][(size_t)(g * SP + p) * SGC + c], bi = F.in[I_BIM][(size_t)(g * SP + p) * SGC + c];
            bbr[c] = fr_ * br - fi_ * bi; bbi[c] = fr_ * bi + fi_ * br;
            cr[c] = F.in[I_CRE][(size_t)(g * SGC + c) * SP + p]; ci[c] = F.in[I_CIM][(size_t)(g * SGC + c) * SP + p]; dsk[c] = F.in[I_DSKIP][g * SGC + c]; }
        float xr = 0.f, xi = 0.f;
        const int csel = ((p >> 5) & 1) * 8 + ((p >> 4) & 1) * 4 + ((p >> 3) & 1) * 2 + ((p >> 2) & 1);
        float dmine = 0.f;
#pragma unroll
        for (int c = 0; c < 16; ++c) dmine = (c == csel) ? dsk[c] : dmine;
        for (int t = 0; t < SEQ; ++t) {
            const u32x4* up = (const u32x4*)(Ub + (size_t)(b * SEQ + t) * SW + g * SGC); const u32x4 w0 = up[0], w1 = up[1];
            float u[16]; u[0] = bflo(w0.x); u[1] = bfhi(w0.x); u[2] = bflo(w0.y); u[3] = bfhi(w0.y); u[4] = bflo(w0.z); u[5] = bfhi(w0.z); u[6] = bflo(w0.w); u[7] = bfhi(w0.w);
            u[8] = bflo(w1.x); u[9] = bfhi(w1.x); u[10] = bflo(w1.y); u[11] = bfhi(w1.y); u[12] = bflo(w1.z); u[13] = bfhi(w1.z); u[14] = bflo(w1.w); u[15] = bfhi(w1.w);
            float sr = 0.f, si = 0.f;
#pragma unroll
            for (int c = 0; c < 16; ++c) { sr += bbr[c] * u[c]; si += bbi[c] * u[c]; }
            const float nxr = lr * xr - li * xi + sr, nxi = lr * xi + li * xr + si; xr = nxr; xi = nxi;
            float y[16];
#pragma unroll
            for (int c = 0; c < 16; ++c) y[c] = cr[c] * xr - ci[c] * xi;
            float w8[8], w4[4], w2[2], w1_;
            { const bool hi = (p & 32) != 0;
#pragma unroll
              for (int i = 0; i < 8; ++i) { const float keep = hi ? y[i + 8] : y[i], send = hi ? y[i] : y[i + 8]; w8[i] = keep + __shfl_xor(send, 32); } }
            { const bool hi = (p & 16) != 0;
#pragma unroll
              for (int i = 0; i < 4; ++i) { const float keep = hi ? w8[i + 4] : w8[i], send = hi ? w8[i] : w8[i + 4]; w4[i] = keep + __shfl_xor(send, 16); } }
            { const bool hi = (p & 8) != 0;
#pragma unroll
              for (int i = 0; i < 2; ++i) { const float keep = hi ? w4[i + 2] : w4[i], send = hi ? w4[i] : w4[i + 2]; w2[i] = keep + __shfl_xor(send, 8); } }
            { const bool hi = (p & 4) != 0; const float keep = hi ? w2[1] : w2[0], send = hi ? w2[0] : w2[1]; w1_ = keep + __shfl_xor(send, 4); }
            w1_ += __shfl_xor(w1_, 2); w1_ += __shfl_xor(w1_, 1);
            float umine = 0.f;
#pragma unroll
            for (int c = 0; c < 16; ++c) umine = (c == csel) ? u[c] : umine;
            if ((p & 3) == 0) Yb[(size_t)(b * SEQ + t) * SW + g * SGC + csel] = (bf16_t)f2bf(gelu_tanh(w1_ + dmine * umine));
        }
    }
}


__device__ __forceinline__ void p0_ssm_tables(Frame& F, int task) {
    const int g = task >> 3, part = task & 7;
    LAS float* pwr = (LAS float*)F.lds; LAS float* pwi = pwr + 65 * 64; LAS float* bbr = pwi + 65 * 64; LAS float* bbi = bbr + 1024; LAS float* ccr = bbi + 1024; LAS float* cci = ccr + 1024;
    const float dt = expf(F.in[I_LOGDT][g]);
    __syncthreads();
    for (int i = F.tid; i < 65 * 64; i += 512) { const int k = i >> 6, p = i & 63; const float are = fminf(F.in[I_ARE][g * SP + p], -1e-4f), aim = F.in[I_AIM][g * SP + p];
        const float mag = expf(are * dt * (float)k); double a = (double)aim * (double)dt * (double)k; a -= 6.283185307179586 * rint(a * 0.15915494309189535); const float af = (float)a;
        pwr[i] = mag * cosf(af); pwi[i] = mag * sinf(af); }
    for (int i = F.tid; i < 1024; i += 512) { const int p = i >> 4, c = i & 15; const float are = fminf(F.in[I_ARE][g * SP + p], -1e-4f), aim = F.in[I_AIM][g * SP + p];
        const float mag = expf(are * dt); double a = (double)aim * (double)dt; a -= 6.283185307179586 * rint(a * 0.15915494309189535); const float af = (float)a;
        const float lr = mag * cosf(af), li = mag * sinf(af), nr = lr - 1.0f, ni = li, den = 1.0f / (are * are + aim * aim), fr_ = (nr * are + ni * aim) * den, fi_ = (ni * are - nr * aim) * den;
        const float br = F.in[I_BRE][(size_t)(g * SP + p) * SGC + c], bi = F.in[I_BIM][(size_t)(g * SP + p) * SGC + c];
        bbr[i] = fr_ * br - fi_ * bi; bbi[i] = fr_ * bi + fi_ * br; }
    for (int i = F.tid; i < 1024; i += 512) { ccr[i] = F.in[I_CRE][(size_t)g * 1024 + i]; cci[i] = F.in[I_CIM][(size_t)g * 1024 + i]; }
    __syncthreads();
    bf16_t* WST = WSP(bf16_t, WS_WST) + (size_t)g * 128 * 1024; bf16_t* GT = WSP(bf16_t, WS_GT) + (size_t)g * 1024 * 128; bf16_t* KT = WSP(bf16_t, WS_KT) + (size_t)g * 65 * 256;
    for (int j = 0; j < 32; ++j) { const int e = part * 16384 + j * 512 + F.tid; const int pp = e >> 10, k = e & 1023, s = k >> 4, c = k & 15, p = pp & 63;
        const float mr = pwr[(63 - s) * 64 + p], mi = pwi[(63 - s) * 64 + p], br = bbr[p * 16 + c], bi = bbi[p * 16 + c];
        WST[e] = (bf16_t)f2bf(pp < 64 ? (mr * br - mi * bi) : (mr * bi + mi * br)); }
    for (int j = 0; j < 32; ++j) { const int e = part * 16384 + j * 512 + F.tid; const int sc = e >> 7, pp = e & 127, s = sc >> 4, c = sc & 15, p = pp & 63;
        const float mr = pwr[(s + 1) * 64 + p], mi = pwi[(s + 1) * 64 + p], cr = ccr[c * 64 + p], ci = cci[c * 64 + p];
        GT[e] = (bf16_t)f2bf(pp < 64 ? (cr * mr - ci * mi) : -(cr * mi + ci * mr)); }
    for (int e = part * 2080 + F.tid; e < (part + 1) * 2080; e += 512) { const int tt = e >> 8, c = (e >> 4) & 15, c2 = e & 15; float acc = 0.f;
        if (tt > 0) { const int tau = tt - 1;
            for (int p = 0; p < 64; ++p) { const float mr = pwr[tau * 64 + p], mi = pwi[tau * 64 + p], cr = ccr[c * 64 + p], ci = cci[c * 64 + p]; const float zr = cr * mr - ci * mi, zi = cr * mi + ci * mr; acc += zr * bbr[p * 16 + c2] - zi * bbi[p * 16 + c2]; } }
        KT[e] = (bf16_t)f2bf(acc); }
    if (part == 0 && F.tid < 64) { WSP(f32x2, WS_LAML)[g * 64 + F.tid] = (f32x2){pwr[64 * 64 + F.tid], pwi[64 * 64 + F.tid]}; }
    __syncthreads();
}
__device__ __forceinline__ void ssm_state_item(Frame& F, int b, int g, int h) {
    const int w = F.wave, row = F.lane & 15, kg = F.lane >> 4;
    f32x4 acc[4];
#pragma unroll
    for (int c = 0; c < 4; ++c) acc[c] = (f32x4){0.f, 0.f, 0.f, 0.f};
    const bf16_t* Ub = WSP(bf16_t, WS_U) + ((size_t)b * SEQ + (size_t)(16 * w + row) * 64 + (kg >> 1)) * SW + g * SGC + 8 * (kg & 1);
    const bf16_t* Wb = WSP(bf16_t, WS_WST) + ((size_t)g * 128 + 32 * h + row) * 1024 + 8 * kg;
#pragma unroll 4
    for (int ks = 0; ks < 32; ++ks) {
        const bf16x8 a = *(const bf16x8*)(Ub + ((size_t)(2 * ks)) * SW);
        bf16x8 bq[4];
#pragma unroll
        for (int nt = 0; nt < 4; ++nt) bq[nt] = *(const bf16x8*)(Wb + (size_t)((nt & 1) * 16 + (nt >> 1) * 64) * 1024 + 32 * ks);
#pragma unroll
        for (int nt = 0; nt < 4; ++nt) acc[nt] = __builtin_amdgcn_mfma_f32_16x16x32_bf16(a, bq[nt], acc[nt], 0, 0, 0);
    }
    LAS float* X = (LAS float*)F.lds;
    __syncthreads();
#pragma unroll
    for (int nt = 0; nt < 4; ++nt)
#pragma unroll
        for (int r = 0; r < 4; ++r) X[(16 * w + 4 * kg + r) * 64 + (nt >> 1) * 32 + (nt & 1) * 16 + row] = acc[nt][r];
    __syncthreads();
    if (w == 0 && F.lane < 32) { const int p = 32 * h + F.lane; const f32x2 lam = WSP(f32x2, WS_LAML)[g * 64 + p]; float sr = 0.f, si = 0.f;
        bf16_t* SS = WSP(bf16_t, WS_SST) + ((size_t)(b * NG + g) * 128) * 128;
#pragma unroll 4
        for (int n = 0; n < 128; ++n) { SS[n * 128 + p] = (bf16_t)f2bf(sr); SS[n * 128 + 64 + p] = (bf16_t)f2bf(si);
            const float xr = X[n * 64 + F.lane], xi = X[n * 64 + 32 + F.lane]; const float nsr = lam.x * sr - lam.y * si + xr, nsi = lam.x * si + lam.y * sr + xi; sr = nsr; si = nsi; } }
    __syncthreads();
}
constexpr int SO_USTR = 2064, SO_KT = 32 * SO_USTR, SO_SS = SO_KT + 65 * 512, SO_SSTR = 272;
__device__ __forceinline__ void ssm_out_item(Frame& F, int b, int g, int rr) {
    LAS unsigned char* L = F.lds;
    const int w = F.wave, lane = F.lane, r32 = lane & 31, hi = lane >> 5, sp = r32 >> 4, cch = r32 & 15;
    __syncthreads();
    { const bf16_t* Ug = WSP(bf16_t, WS_U) + ((size_t)b * SEQ + (size_t)rr * 2048) * SW + g * SGC;
#pragma unroll
      for (int j = 0; j < 8; ++j) { const int c = F.tid + 512 * j, r = c >> 1, half = c & 1; *(LAS u32x4*)(L + (r >> 6) * SO_USTR + (r & 63) * 32 + half * 16) = *(const u32x4*)(Ug + (size_t)r * SW + half * 8); }
      const u32x4* Kg = (const u32x4*)(WSP(bf16_t, WS_KT) + (size_t)g * 65 * 256);
      for (int c = F.tid; c < 2080; c += 512) *(LAS u32x4*)(L + SO_KT + c * 16) = Kg[c];
      { const int c = F.tid, ch = c >> 4, pc = c & 15; *(LAS u32x4*)(L + SO_SS + ch * SO_SSTR + pc * 16) = *(const u32x4*)(WSP(bf16_t, WS_SST) + ((size_t)((b * NG + g) * 128 + rr * 32 + ch)) * 128 + pc * 8); } }
    const bf16_t* Gg = WSP(bf16_t, WS_GT) + ((size_t)g * 1024 + (2 * w + sp) * 16 + cch) * 128 + 8 * hi;
    bf16x8 gb[2][8];
#pragma unroll
    for (int k2 = 0; k2 < 8; ++k2) gb[0][k2] = *(const bf16x8*)(Gg + 16 * k2);
    __syncthreads();
    f32x16 acc[4];
#pragma unroll
    for (int a = 0; a < 4; ++a)
#pragma unroll
        for (int r = 0; r < 16; ++r) acc[a][r] = 0.f;
    const LAS unsigned char* Ua = L + r32 * SO_USTR + hi * 16;
    const LAS unsigned char* Kb_ = L + SO_KT + (2 * w + sp + 1) * 512 + cch * 32 + hi * 16;
#define SO_SEG(A0, LO, HI) for (int s1 = (LO); s1 < (HI); ++s1) { const bf16x8 av = *(const LAS bf16x8*)(Ua + s1 * 32); \
        _Pragma("unroll") for (int a = (A0); a < 4; ++a) { const bf16x8 bv = *(const LAS bf16x8*)(Kb_ + a * 8192 - s1 * 512); acc[a] = __builtin_amdgcn_mfma_f32_32x32x16_bf16(av, bv, acc[a], 0, 0, 0); } }
    SO_SEG(0, 0, 2 * w + 2)
    SO_SEG(1, 2 * w + 2, 2 * w + 18)
    SO_SEG(2, 2 * w + 18, 2 * w + 34)
    SO_SEG(3, 2 * w + 34, 2 * w + 50)
#undef SO_SEG
    bf16x8 sa[8];
#pragma unroll
    for (int k2 = 0; k2 < 8; ++k2) sa[k2] = *(const LAS bf16x8*)(L + SO_SS + r32 * SO_SSTR + k2 * 32 + hi * 16);
#pragma unroll
    for (int a = 0; a < 4; ++a) {
        if (a < 3) {
#pragma unroll
            for (int k2 = 0; k2 < 8; ++k2) gb[(a + 1) & 1][k2] = *(const bf16x8*)(Gg + (size_t)(a + 1) * (16 * 16 * 128) + 16 * k2); }
#pragma unroll
        for (int k2 = 0; k2 < 8; ++k2) acc[a] = __builtin_amdgcn_mfma_f32_32x32x16_bf16(sa[k2], gb[a & 1][k2], acc[a], 0, 0, 0);
    }
    __syncthreads();
    const float dsk = F.in[I_DSKIP][g * SGC + cch];
    { LAS unsigned char* yb = L + (4 * hi) * SO_USTR + (2 * w + sp) * 32 + cch * 2;
#pragma unroll
      for (int a = 0; a < 4; ++a)
#pragma unroll
          for (int r = 0; r < 16; ++r) { LAS unsigned short* p = (LAS unsigned short*)(yb + ((r & 3) + 8 * (r >> 2)) * SO_USTR + a * 512); const float u = bf2f(*p); *p = (unsigned short)f2bf(gelu_tanh(acc[a][r] + dsk * u)); } }
    __syncthreads();
    { bf16_t* Yg = WSP(bf16_t, WS_YB) + ((size_t)b * SEQ + (size_t)rr * 2048) * SW + g * SGC;
#pragma unroll 2
      for (int j = 0; j < 8; ++j) { const int c = F.tid + 512 * j, r = c >> 1, half = c & 1; *(u32x4*)(Yg + (size_t)r * SW + half * 8) = *(const LAS u32x4*)(L + (r >> 6) * SO_USTR + (r & 63) * 32 + half * 16); } }
}
__device__ __forceinline__ void phase_ssm_out(Frame& F) {
    for (int it = F.bid; it < NB * NG * 4; it += F.G) ssm_out_item(F, it >> 7, (it >> 2) & 31, it & 3);
    __syncthreads();
}


__device__ __forceinline__ void moba_route_item(Frame& F, int bh, int i) {
    LAS float* km = (LAS float*)F.lds;
    LAS unsigned* lc = (LAS unsigned*)(F.lds + 8192); LAS unsigned* lb = lc + 32;
    const int b = bh >> 3, h = bh & 7, ql = F.tid >> 1, half = F.tid & 1;
    __syncthreads();
    { const float* K0 = WSP(float, WS_KM2) + (size_t)bh * NBLK * HD; const float* K1 = K0 + (size_t)NB * NH * NBLK * HD;
      for (int k = F.tid; k < NBLK * HD; k += 512) km[k] = K0[k] + K1[k]; }
    if (F.tid < 32) lc[F.tid] = 0u;
    float q[32];
    { const u32x4* qp = (const u32x4*)(WSP(bf16_t, WS_Q) + (size_t)(b * SEQ + i * MBLK + ql) * AW + h * HD + half * 32);
#pragma unroll
      for (int c = 0; c < 4; ++c) { const u32x4 w = qp[c]; q[8 * c + 0] = bflo(w.x); q[8 * c + 1] = bfhi(w.x); q[8 * c + 2] = bflo(w.y); q[8 * c + 3] = bfhi(w.y); q[8 * c + 4] = bflo(w.z); q[8 * c + 5] = bfhi(w.z); q[8 * c + 6] = bflo(w.w); q[8 * c + 7] = bfhi(w.w); } }
    __syncthreads();
    float g0 = -3e38f, g1 = -3e38f, g2 = -3e38f; int s0 = -1, s1 = -1, s2 = -1;
    for (int j = 0; j < i; ++j) { float g = 0.f;
#pragma unroll
        for (int d = 0; d < 32; ++d) g += q[d] * km[j * HD + half * 32 + d];
        g += __shfl_xor(g, 1);
        if (g > g0) { g2 = g1; s2 = s1; g1 = g0; s1 = s0; g0 = g; s0 = j; } else if (g > g1) { g2 = g1; s2 = s1; g1 = g; s1 = j; } else if (g > g2) { g2 = g; s2 = j; } }
    unsigned r0 = 0u, r1 = 0u, r2 = 0u;
    if (half == 0) { if (s0 >= 0) r0 = __hip_atomic_fetch_add(&lc[s0], 1u, __ATOMIC_RELAXED, __HIP_MEMORY_SCOPE_WORKGROUP); if (s1 >= 0) r1 = __hip_atomic_fetch_add(&lc[s1], 1u, __ATOMIC_RELAXED, __HIP_MEMORY_SCOPE_WORKGROUP);
        if (s2 >= 0) r2 = __hip_atomic_fetch_add(&lc[s2], 1u, __ATOMIC_RELAXED, __HIP_MEMORY_SCOPE_WORKGROUP); }
    __syncthreads();
    if (F.tid < 32) { const unsigned n = lc[F.tid]; lb[F.tid] = n ? atomicAdd(F.ctl + CW_MCNT + bh * NBLK + F.tid, n) : 0u; }
    __syncthreads();
    if (half == 0) { unsigned short* ML = WSP(unsigned short, WS_MLIST) + (size_t)bh * NBLK * 8192; const unsigned e = (unsigned)(i * MBLK + ql) * 4u;
        f32x2* pml = WSP(f32x2, WS_PML) + ((size_t)bh * SEQ + i * MBLK + ql) * 4;
        if (s0 >= 0) ML[(size_t)s0 * 8192 + lb[s0] + r0] = (unsigned short)(e + 0u); else pml[0] = (f32x2){-1e30f, 0.f};
        if (s1 >= 0) ML[(size_t)s1 * 8192 + lb[s1] + r1] = (unsigned short)(e + 1u); else pml[1] = (f32x2){-1e30f, 0.f};
        if (s2 >= 0) ML[(size_t)s2 * 8192 + lb[s2] + r2] = (unsigned short)(e + 2u); else pml[2] = (f32x2){-1e30f, 0.f}; }
}
template <int EXPM> __device__ __forceinline__ void moba_sparse_phase(Frame& F, char* lds_generic, int nslots) {
    LAS unsigned* cl = (LAS unsigned*)(F.lds + attn_body::LDS_BYTES);
    LAS unsigned* pf = cl + 128;
    const int x = F.bid & 7;
    __syncthreads();
    if (F.tid < 128) cl[F.tid] = __hip_atomic_load(F.ctl + CW_MCNT + (x + 8 * (F.tid >> 5)) * NBLK + (F.tid & 31), RLX_AGENT);
    __syncthreads();
    if (F.tid == 0) { unsigned a = 0; for (int i = 0; i < 128; ++i) { pf[i] = a; a += 1u + ((cl[i] + 255u) >> 8); } pf[128] = a; }
    __syncthreads();
    const int total = (int)pf[128];
    LAS int* grab = (LAS int*)(pf + 132); unsigned* gctr = F.ctl + CW_ACNT + 64 * x;
    const attn_body::bf16* Qb = (const attn_body::bf16*)WSP(bf16_t, WS_Q); const attn_body::bf16* Kb = (const attn_body::bf16*)WSP(bf16_t, WS_K); const attn_body::bf16* Vb = (const attn_body::bf16*)WSP(bf16_t, WS_V);
    attn_body::bf16* PO = (attn_body::bf16*)WSP(bf16_t, WS_PO); float* PML = WSP(float, WS_PML);
    const int wid = F.wave;
    int L = 0;
    for (;;) {
    __syncthreads();
    if (F.tid == 0) { const int cur = (int)__hip_atomic_load(gctr, RLX_AGENT); int g = (total - cur) / (2 * nslots); g = g < 2 ? 2 : g; const int p = (int)__hip_atomic_fetch_add(gctr, (unsigned)g, RLX_AGENT); grab[0] = p; grab[1] = min(p + g, total); }
    __syncthreads();
    int pos = grab[0]; const int end = grab[1];
    if (pos >= total) break;
    while (pos < end) {
        while ((int)pf[L + 1] <= pos) ++L;
        const int m = L >> 5, j = L & 31, bh = x + 8 * m, b = bh >> 3, h = bh & 7, cnt = (int)cl[L];
        const int c0 = pos - (int)pf[L], c1 = min((int)pf[L + 1], end) - (int)pf[L];
        const size_t kvrow = (size_t)b * SEQ + (size_t)j * MBLK;
        __syncthreads();
        attn_body::moba_load_kv(Kb + kvrow * AW + h * HD, Vb + kvrow * AW + h * HD, lds_generic);
        __syncthreads();
        for (int c = c0; c < c1; ++c) {
            int l_ = F.lane; asm volatile("" : "+v"(l_)); const int r32 = l_ & 31;
            int qg, dest; bool causal;
            if (c == 0) { qg = j * MBLK + wid * 32 + r32; dest = (EXPM == 1) ? -1 : (bh * SEQ + qg) * 4 + 3; causal = true; }
            else { const int base = (c - 1) * 256 + wid * 32; if (base >= cnt) continue;
                const int idx = base + r32; causal = false;
                if (EXPM == 1) { qg = j * MBLK + wid * 32 + r32; dest = -1; }
                else if (idx < cnt) { const unsigned e = WSP(unsigned short, WS_MLIST)[((size_t)bh * NBLK + j) * 8192 + idx]; qg = (int)(e >> 2); dest = (bh * SEQ + qg) * 4 + (int)(e & 3u); }
                else { qg = j * MBLK + r32; dest = -1; } }
            attn_body::moba_chunk4<8>(Qb + ((size_t)b * SEQ + qg) * AW + h * HD, causal, dest, PO, PML, lds_generic);
        }
        pos += c1 - c0;
    }
    }
    __syncthreads();
}
__device__ __forceinline__ void moba_combine_phase(Frame& F) {
    const bf16_t* PO = WSP(bf16_t, WS_PO); const f32x2* PML = WSP(f32x2, WS_PML); bf16_t* ATT = WSP(bf16_t, WS_ATT);
    for (size_t it = (size_t)F.bid * 512 + F.tid; it < (size_t)NB * NH * SEQ * 8; it += (size_t)F.G * 512) {
        const size_t r = it >> 3; const int ch = (int)(it & 7); const int bh = (int)(r / SEQ), qg = (int)(r % SEQ), b = bh >> 3, h = bh & 7;
        const f32x2 a0 = PML[r * 4 + 0], a1 = PML[r * 4 + 1], a2 = PML[r * 4 + 2], a3 = PML[r * 4 + 3];
        const float M = fmaxf(fmaxf(a0.x, a1.x), fmaxf(a2.x, a3.x));
        const float w0 = a0.y * __builtin_amdgcn_exp2f(a0.x - M), w1 = a1.y * __builtin_amdgcn_exp2f(a1.x - M), w2 = a2.y * __builtin_amdgcn_exp2f(a2.x - M), w3 = a3.y * __builtin_amdgcn_exp2f(a3.x - M);
        const float inv = 1.0f / (w0 + w1 + w2 + w3);
        float o[8] = {0.f, 0.f, 0.f, 0.f, 0.f, 0.f, 0.f, 0.f};
#define CMB(k, wk) if (wk > 0.f) { const u32x4 v = *(const u32x4*)(PO + (r * 4 + k) * 64 + ch * 8); o[0] += wk * bflo(v.x); o[1] += wk * bfhi(v.x); o[2] += wk * bflo(v.y); o[3] += wk * bfhi(v.y); o[4] += wk * bflo(v.z); o[5] += wk * bfhi(v.z); o[6] += wk * bflo(v.w); o[7] += wk * bfhi(v.w); }
        CMB(0, w0) CMB(1, w1) CMB(2, w2) CMB(3, w3)
#undef CMB
        u32x4 w; w.x = pk2(o[0] * inv, o[1] * inv); w.y = pk2(o[2] * inv, o[3] * inv); w.z = pk2(o[4] * inv, o[5] * inv); w.w = pk2(o[6] * inv, o[7] * inv);
        *(u32x4*)(ATT + ((size_t)b * SEQ + qg) * AW + h * HD + ch * 8) = w;
    }
}

__device__ __forceinline__ void phase_xattn_simple(Frame& F, bf16_t* Ob) {
    LAS unsigned* Ks = (LAS unsigned*)F.lds;
    LAS unsigned* Vs = (LAS unsigned*)(F.lds + 65536);
    const bf16_t *Qb = WSP(bf16_t, WS_XQ), *KV = WSP(bf16_t, WS_MKV);
    const int tl = F.tid >> 2, part = F.tid & 3;
    int lastbh = -1;
    for (int it = F.bid; it < NB * XH * (SEQ / 128); it += F.G) {
        const int bh = it / (SEQ / 128), ch = it % (SEQ / 128), b = bh / XH, h = bh % XH;
        if (bh != lastbh) { __syncthreads();
            for (int c = F.tid; c < 256 * 16; c += 512) { const int r = c >> 4, cc = c & 15;
                *(LAS u32x4*)(Ks + r * 64 + cc * 4) = *(const u32x4*)(KV + (size_t)(b * MEML + r) * (2 * XW) + h * XD + cc * 8);
                *(LAS u32x4*)(Vs + r * 64 + cc * 4) = *(const u32x4*)(KV + (size_t)(b * MEML + r) * (2 * XW) + XW + h * XD + cc * 8); }
            __syncthreads(); lastbh = bh; }
        const size_t row = (size_t)b * SEQ + ch * 128 + tl;
        float q[32];
        { const u32x4* qp = (const u32x4*)(Qb + row * XW + h * XD + part * 32);
#pragma unroll
          for (int c = 0; c < 4; ++c) { const u32x4 w = qp[c]; q[8 * c + 0] = bflo(w.x); q[8 * c + 1] = bfhi(w.x); q[8 * c + 2] = bflo(w.y); q[8 * c + 3] = bfhi(w.y); q[8 * c + 4] = bflo(w.z); q[8 * c + 5] = bfhi(w.z); q[8 * c + 6] = bflo(w.w); q[8 * c + 7] = bfhi(w.w); } }
        float mx = -3e38f, l = 0.f, o[32];
#pragma unroll
        for (int d = 0; d < 32; ++d) o[d] = 0.f;
        for (int kk = 0; kk < MEML; ++kk) { float s = 0.f;
#pragma unroll
            for (int c = 0; c < 4; ++c) { const u32x4 w = *(const LAS u32x4*)(Ks + kk * 64 + part * 16 + c * 4);
                s += q[8 * c + 0] * bflo(w.x) + q[8 * c + 1] * bfhi(w.x) + q[8 * c + 2] * bflo(w.y) + q[8 * c + 3] * bfhi(w.y) + q[8 * c + 4] * bflo(w.z) + q[8 * c + 5] * bfhi(w.z) + q[8 * c + 6] * bflo(w.w) + q[8 * c + 7] * bfhi(w.w); }
            s += __shfl_xor(s, 1); s += __shfl_xor(s, 2);
            const float mn = fmaxf(mx, s), corr = __builtin_amdgcn_exp2f(mx - mn), p = __builtin_amdgcn_exp2f(s - mn); mx = mn; l = l * corr + p;
#pragma unroll
            for (int c = 0; c < 4; ++c) { const u32x4 w = *(const LAS u32x4*)(Vs + kk * 64 + part * 16 + c * 4);
                o[8 * c + 0] = o[8 * c + 0] * corr + p * bflo(w.x); o[8 * c + 1] = o[8 * c + 1] * corr + p * bfhi(w.x); o[8 * c + 2] = o[8 * c + 2] * corr + p * bflo(w.y); o[8 * c + 3] = o[8 * c + 3] * corr + p * bfhi(w.y);
                o[8 * c + 4] = o[8 * c + 4] * corr + p * bflo(w.z); o[8 * c + 5] = o[8 * c + 5] * corr + p * bfhi(w.z); o[8 * c + 6] = o[8 * c + 6] * corr + p * bflo(w.w); o[8 * c + 7] = o[8 * c + 7] * corr + p * bfhi(w.w); } }
        const float il = 1.0f / l;
        u32x4* op = (u32x4*)(Ob + row * XW + h * XD + part * 32);
#pragma unroll
        for (int c = 0; c < 4; ++c) { u32x4 w; w.x = pk2(o[8 * c + 0] * il, o[8 * c + 1] * il); w.y = pk2(o[8 * c + 2] * il, o[8 * c + 3] * il); w.z = pk2(o[8 * c + 4] * il, o[8 * c + 5] * il); w.w = pk2(o[8 * c + 6] * il, o[8 * c + 7] * il); op[c] = w; }
    }
}

__device__ __forceinline__ void phase_router(Frame& F) {
    LAS float* wt = (LAS float*)F.lds;
    for (int c = F.tid; c < NE * DM; c += 512) { const int k = c >> 5, e = c & 31; wt[e * DM + k] = F.in[I_WROUTER][c] * F.in[I_GMOE][k]; }
    __syncthreads();
    const int gw = F.bid * 8 + F.wave, NGW = F.G * 8, lane = F.lane;
    const float* H = WSP(float, WS_H);
    unsigned* cnt = F.ctl + CW_CNT;
    for (int tk = gw; tk < T_; tk += NGW) {
        const f32x4* hp = (const f32x4*)(H + (size_t)tk * DM) + lane; f32x4 hv[4]; float ss = 0.f;
#pragma unroll
        for (int j = 0; j < 4; ++j) { hv[j] = hp[64 * j]; ss += (hv[j][0] * hv[j][0] + hv[j][1] * hv[j][1]) + (hv[j][2] * hv[j][2] + hv[j][3] * hv[j][3]); }
        const float rstd = 1.0f / sqrtf(wave_sum(ss) * (1.0f / DM) + RMS_EPS);
        float mylogit = 0.f;
#pragma unroll 4
        for (int e = 0; e < NE; ++e) { float a = 0.f;
#pragma unroll
            for (int j = 0; j < 4; ++j) { const f32x4 w = *(const LAS f32x4*)(wt + e * DM + 4 * lane + 256 * j); a += (hv[j][0] * w[0] + hv[j][1] * w[1]) + (hv[j][2] * w[2] + hv[j][3] * w[3]); }
            a = wave_sum(a);
            mylogit = (lane == e) ? a : mylogit; }
        mylogit = (lane < NE) ? (mylogit * rstd + F.in[I_BROUTER][lane & 31]) : -3e38f;
        float tv[4]; int ti[4]; float cur = mylogit;
#pragma unroll
        for (int s = 0; s < 4; ++s) { float bv = cur; int bi = lane;
#pragma unroll
            for (int o = 1; o < 64; o <<= 1) { const float ov = __shfl_xor(bv, o); const int oi = __shfl_xor(bi, o); if (ov > bv || (ov == bv && oi < bi)) { bv = ov; bi = oi; } }
            tv[s] = bv; ti[s] = bi; if (lane == bi) cur = -3e38f; }
        const float e1 = __expf(tv[1] - tv[0]), e2 = __expf(tv[2] - tv[0]), e3 = __expf(tv[3] - tv[0]); const float inv = 1.0f / (1.0f + e1 + e2 + e3);
        if (lane == 0) WSP(float, WS_RSTD2)[tk] = rstd;
        if (lane < 4) { const int ex = (lane == 0) ? ti[0] : (lane == 1) ? ti[1] : (lane == 2) ? ti[2] : ti[3]; const float gv = ((lane == 0) ? 1.0f : (lane == 1) ? e1 : (lane == 2) ? e2 : e3) * inv;
            WSP(float, WS_TKG)[(size_t)tk * 4 + lane] = gv;
            const unsigned rank = atomicAdd(&cnt[ex], 1u);
            WSP(int, WS_ROWLIST)[(size_t)ex * T_ + rank] = tk * 4 + lane; }
    }
}


constexpr int XA_VSTR = 520, XA_VT = 65536;
__device__ __forceinline__ bf16x8 pack8(const f32x16& s, int o) {
    u32x4 w; w.x = pg8::cvt_pk_bf16(s[o + 0], s[o + 1]); w.y = pg8::cvt_pk_bf16(s[o + 2], s[o + 3]); w.z = pg8::cvt_pk_bf16(s[o + 4], s[o + 5]); w.w = pg8::cvt_pk_bf16(s[o + 6], s[o + 7]);
    return __builtin_bit_cast(bf16x8, w);
}
__device__ __forceinline__ void phase_xattn(Frame& F) {
    LAS unsigned char* L = F.lds;
    const bf16_t *Qb = WSP(bf16_t, WS_XQ), *KV = WSP(bf16_t, WS_MKV); bf16_t* Ob = WSP(bf16_t, WS_XO);
    const int lane = F.lane, r32 = lane & 31, hi = lane >> 5, wid = F.wave;
    const int NU = NB * XH * (SEQ / 256), UPB = (NU + F.G - 1) / F.G;
    int lastbh = -1;
    for (int u = F.bid * UPB; u < NU && u < (F.bid + 1) * UPB; ++u) {
        const int bh = u >> 5, qb = u & 31, b = bh >> 2, h = bh & 3;
        if (bh != lastbh) {
            __syncthreads();
            for (int c = F.tid; c < 256 * 16; c += 512) { const int m = c >> 4, ch = c & 15; *(LAS u32x4*)(L + m * 256 + ((ch ^ (m & 15)) << 4)) = *(const u32x4*)(KV + (size_t)(b * MEML + m) * (2 * XW) + h * XD + ch * 8); }
            { const bf16_t* VTg = WSP(bf16_t, WS_MVT) + ((size_t)b * XW + h * XD) * MEML;
              for (int c = F.tid; c < 128 * 64; c += 512) { const int d = c >> 6, pc = c & 63; *(LAS u32x2*)(L + XA_VT + d * XA_VSTR + pc * 8) = *(const u32x2*)(VTg + (size_t)d * MEML + pc * 4); } }
            __syncthreads(); lastbh = bh; }
        const size_t row = (size_t)b * SEQ + qb * 256 + wid * 32 + r32;
        bf16x8 qf[8];
#pragma unroll
        for (int kd = 0; kd < 8; ++kd) qf[kd] = *(const bf16x8*)(Qb + row * XW + h * XD + 16 * kd + 8 * hi);
        f32x16 o[4];
#pragma unroll
        for (int dt = 0; dt < 4; ++dt)
#pragma unroll
            for (int r = 0; r < 16; ++r) o[dt][r] = 0.f;
        float mrun = -1e30f, lrun = 0.f;
#pragma unroll 1
        for (int c = 0; c < 4; ++c) {
            f32x16 s0, s1;
#pragma unroll
            for (int r = 0; r < 16; ++r) { s0[r] = 0.f; s1[r] = 0.f; }
            const int kv0 = c * 64 + r32, kv1 = kv0 + 32;
#pragma unroll
            for (int kd = 0; kd < 8; ++kd) { const int ch = 2 * kd + hi;
                const bf16x8 k0 = *(const LAS bf16x8*)(L + kv0 * 256 + ((ch ^ (kv0 & 15)) << 4)), k1 = *(const LAS bf16x8*)(L + kv1 * 256 + ((ch ^ (kv1 & 15)) << 4));
                s0 = __builtin_amdgcn_mfma_f32_32x32x16_bf16(k0, qf[kd], s0, 0, 0, 0); s1 = __builtin_amdgcn_mfma_f32_32x32x16_bf16(k1, qf[kd], s1, 0, 0, 0); }
            float mx = fmaxf(s0[0], s1[0]);
#pragma unroll
            for (int r = 1; r < 16; ++r) mx = fmaxf(mx, fmaxf(s0[r], s1[r]));
            mx = fmaxf(mx, __shfl_xor(mx, 32));
            const float mn = fmaxf(mrun, mx), sc = __builtin_amdgcn_exp2f(mrun - mn); mrun = mn;
            float ls = 0.f;
#pragma unroll
            for (int r = 0; r < 16; ++r) { s0[r] = __builtin_amdgcn_exp2f(s0[r] - mn); s1[r] = __builtin_amdgcn_exp2f(s1[r] - mn); ls += s0[r] + s1[r]; }
            ls += __shfl_xor(ls, 32); lrun = lrun * sc + ls;
#pragma unroll
            for (int dt = 0; dt < 4; ++dt)
#pragma unroll
                for (int r = 0; r < 16; ++r) o[dt][r] *= sc;
            bf16x8 pf[4]; pf[0] = pack8(s0, 0); pf[1] = pack8(s0, 8); pf[2] = pack8(s1, 0); pf[3] = pack8(s1, 8);
#pragma unroll
            for (int dt = 0; dt < 4; ++dt)
#pragma unroll
                for (int ks = 0; ks < 4; ++ks) { const LAS unsigned char* vp = L + XA_VT + (dt * 32 + r32) * XA_VSTR + (c * 64 + 16 * ks + 4 * hi) * 2;
                    const u32x2 lo = *(const LAS u32x2*)vp, hh = *(const LAS u32x2*)(vp + 16); u32x4 w; w.x = lo.x; w.y = lo.y; w.z = hh.x; w.w = hh.y;
                    o[dt] = __builtin_amdgcn_mfma_f32_32x32x16_bf16(__builtin_bit_cast(bf16x8, w), pf[ks], o[dt], 0, 0, 0); }
        }
        const float il = 1.0f / lrun;
        bf16_t* op = Ob + row * XW + h * XD + 4 * hi;
#pragma unroll
        for (int dt = 0; dt < 4; ++dt)
#pragma unroll
            for (int g4 = 0; g4 < 4; ++g4) { u32x2 w; w.x = pg8::cvt_pk_bf16(o[dt][4 * g4] * il, o[dt][4 * g4 + 1] * il); w.y = pg8::cvt_pk_bf16(o[dt][4 * g4 + 2] * il, o[dt][4 * g4 + 3] * il);
                *(u32x2*)(op + dt * 32 + 8 * g4) = w; }
    }
    __syncthreads();
}

constexpr int RT_WSTR = 1028, RT_LG = NE * RT_WSTR * 4  , RT_LCNT = RT_LG + 8 * 16 * 33 * 4  , RT_LBASE = RT_LCNT + 128, RT_RS = RT_LBASE + 128  ;
__device__ __forceinline__ void phase_router_mfma(Frame& F) {
    LAS float* wt = (LAS float*)F.lds;
    __syncthreads();
    for (int c = F.tid; c < NE * DM; c += 512) { const int k = c >> 5, e = c & 31; wt[e * RT_WSTR + k] = F.in[I_WROUTER][c] * F.in[I_GMOE][k]; }
    LAS unsigned* lcnt = (LAS unsigned*)(F.lds + RT_LCNT); LAS unsigned* lbase = (LAS unsigned*)(F.lds + RT_LBASE);
    const int lane = F.lane, wid = F.wave, row = lane & 15, kq = lane >> 4;
    LAS float* lg = (LAS float*)(F.lds + RT_LG) + wid * (16 * 33); LAS float* rsl = (LAS float*)(F.lds + RT_RS) + wid * 16;
    const bf16_t* HBp = WSP(bf16_t, WS_HB); bf16_t* N2 = WSP(bf16_t, WS_N2B); unsigned* cnt = F.ctl + CW_CNT;
    for (int chunk = F.bid; chunk < T_ / 128; chunk += F.G) {
        if (F.tid < 32) lcnt[F.tid] = 0u;
        __syncthreads();
        const int tok0 = chunk * 128 + wid * 16;
        f32x4 acc0 = {0.f, 0.f, 0.f, 0.f}, acc1 = {0.f, 0.f, 0.f, 0.f}; float ss = 0.f;
        const bf16_t* hp = HBp + (size_t)(tok0 + row) * DM + 8 * kq;
        const LAS float* w0 = wt + row * RT_WSTR + 8 * kq; const LAS float* w1 = w0 + 16 * RT_WSTR;
#pragma unroll 4
        for (int i = 0; i < 32; ++i) { const u32x4 hw = *(const u32x4*)(hp + 32 * i);
            const float a[8] = {bflo(hw.x), bfhi(hw.x), bflo(hw.y), bfhi(hw.y), bflo(hw.z), bfhi(hw.z), bflo(hw.w), bfhi(hw.w)};
            const f32x4 b00 = *(const LAS f32x4*)(w0 + 32 * i), b01 = *(const LAS f32x4*)(w0 + 32 * i + 4), b10 = *(const LAS f32x4*)(w1 + 32 * i), b11 = *(const LAS f32x4*)(w1 + 32 * i + 4);
#pragma unroll
            for (int e = 0; e < 8; ++e) ss += a[e] * a[e];
#pragma unroll
            for (int e = 0; e < 4; ++e) { acc0 = __builtin_amdgcn_mfma_f32_16x16x4f32(a[e], b00[e], acc0, 0, 0, 0); acc1 = __builtin_amdgcn_mfma_f32_16x16x4f32(a[e], b10[e], acc1, 0, 0, 0); }
#pragma unroll
            for (int e = 0; e < 4; ++e) { acc0 = __builtin_amdgcn_mfma_f32_16x16x4f32(a[4 + e], b01[e], acc0, 0, 0, 0); acc1 = __builtin_amdgcn_mfma_f32_16x16x4f32(a[4 + e], b11[e], acc1, 0, 0, 0); } }
        ss += __shfl_xor(ss, 16); ss += __shfl_xor(ss, 32);
        const float rstd = 1.0f / sqrtf(ss * (1.0f / DM) + RMS_EPS);
#pragma unroll
        for (int r = 0; r < 4; ++r) { lg[(4 * kq + r) * 33 + row] = acc0[r]; lg[(4 * kq + r) * 33 + 16 + row] = acc1[r]; }
        if (lane < 16) rsl[lane] = rstd;
        asm volatile("s_waitcnt lgkmcnt(0)" ::: "memory");
#pragma unroll 4
        for (int t = 0; t < 16; ++t) { const float rs = rsl[t]; const u32x4* src = (const u32x4*)(HBp + (size_t)(tok0 + t) * DM) + lane; u32x4* dst = (u32x4*)(N2 + (size_t)(tok0 + t) * DM) + lane;
#pragma unroll
            for (int hh = 0; hh < 2; ++hh) { const u32x4 w = src[64 * hh];
                if (MOE1_FP8) { int w0 = 0, w1 = 0;
                    w0 = __builtin_amdgcn_cvt_pk_fp8_f32(bflo(w.x) * rs, bfhi(w.x) * rs, w0, false); w0 = __builtin_amdgcn_cvt_pk_fp8_f32(bflo(w.y) * rs, bfhi(w.y) * rs, w0, true);
                    w1 = __builtin_amdgcn_cvt_pk_fp8_f32(bflo(w.z) * rs, bfhi(w.z) * rs, w1, false); w1 = __builtin_amdgcn_cvt_pk_fp8_f32(bflo(w.w) * rs, bfhi(w.w) * rs, w1, true);
                    ((u32x2*)((unsigned char*)N2 + (size_t)(tok0 + t) * DM))[lane + 64 * hh] = (u32x2){(unsigned)w0, (unsigned)w1}; }
                else { u32x4 o; o.x = pk2(bflo(w.x) * rs, bfhi(w.x) * rs); o.y = pk2(bflo(w.y) * rs, bfhi(w.y) * rs); o.z = pk2(bflo(w.z) * rs, bfhi(w.z) * rs); o.w = pk2(bflo(w.w) * rs, bfhi(w.w) * rs); dst[64 * hh] = o; } } }
        int ex[4] = {0, 0, 0, 0}; unsigned lrank[4] = {0u, 0u, 0u, 0u}; const int tk = tok0 + lane;
        if (lane < 16) {
            float v[32];
#pragma unroll
            for (int e = 0; e < 32; ++e) v[e] = lg[lane * 33 + e] * rstd + F.in[I_BROUTER][e];
            float tv[4];
#pragma unroll
            for (int s = 0; s < 4; ++s) { float bv = v[0]; int bi = 0;
#pragma unroll
                for (int e = 1; e < 32; ++e) if (v[e] > bv) { bv = v[e]; bi = e; }
#pragma unroll
                for (int e = 0; e < 32; ++e) v[e] = (e == bi) ? -3e38f : v[e];
                tv[s] = bv; ex[s] = bi; }
            const float e1 = __expf(tv[1] - tv[0]), e2 = __expf(tv[2] - tv[0]), e3 = __expf(tv[3] - tv[0]); const float inv = 1.0f / (1.0f + e1 + e2 + e3);
            *(f32x4*)(WSP(float, WS_TKG) + (size_t)tk * 4) = (f32x4){inv, e1 * inv, e2 * inv, e3 * inv};
#pragma unroll
            for (int s = 0; s < 4; ++s) lrank[s] = __hip_atomic_fetch_add(&lcnt[ex[s]], 1u, __ATOMIC_RELAXED, __HIP_MEMORY_SCOPE_WORKGROUP);
        }
        __syncthreads();
        if (F.tid < 32) lbase[F.tid] = atomicAdd(&cnt[F.tid], lcnt[F.tid]);
        __syncthreads();
        if (lane < 16) {
#pragma unroll
            for (int s = 0; s < 4; ++s) WSP(int, WS_ROWLIST)[(size_t)ex[s] * T_ + lbase[ex[s]] + lrank[s]] = tk * 4 + s; }
        __syncthreads();
    }
}

struct FinRegs { u32x2 hw[2][4]; u32x2 yw[2][4][4]; };
__device__ __forceinline__ void fin_load(const bf16_t* HBf, const bf16_t* Y, const int* INV, int tk, FinRegs& R, int lane) {
    int inv[2][4];
#pragma unroll
    for (int t = 0; t < 2; ++t)
#pragma unroll
        for (int s = 0; s < 4; ++s) inv[t][s] = __builtin_amdgcn_readfirstlane(INV[(size_t)(tk + t) * 4 + s]);
#pragma unroll
    for (int t = 0; t < 2; ++t) {
#pragma unroll
        for (int j = 0; j < 4; ++j) { R.hw[t][j] = ((const u32x2*)(HBf + (size_t)(tk + t) * DM))[lane + 64 * j];
#pragma unroll
            for (int s = 0; s < 4; ++s) { if (Y_FP8) { R.yw[t][s][j].x = ((const unsigned*)((const unsigned char*)Y + (size_t)inv[t][s] * DM))[lane + 64 * j]; R.yw[t][s][j].y = 0u; }
                else R.yw[t][s][j] = ((const u32x2*)(Y + (size_t)inv[t][s] * DM))[lane + 64 * j]; } } }
}
template <int FEXP> __device__ __forceinline__ void fin_finish(Frame& F, int tk, const FinRegs& R, const f32x4 (&gf)[4], int lane) {
#pragma unroll
    for (int t = 0; t < 2; ++t) { f32x4 hv[4]; float ss = 0.f;
#pragma unroll
        for (int j = 0; j < 4; ++j) { const u32x2 w = R.hw[t][j]; hv[j] = (f32x4){bflo(w.x), bfhi(w.x), bflo(w.y), bfhi(w.y)};
#pragma unroll
            for (int s = 0; s < 4; ++s) { const u32x2 y = R.yw[t][s][j];
                if (Y_FP8) { const float yi = 1.0f / (float)(1 << Y_SHIFT); hv[j][0] += __builtin_amdgcn_cvt_f32_fp8((int)y.x, 0) * yi; hv[j][1] += __builtin_amdgcn_cvt_f32_fp8((int)y.x, 1) * yi; hv[j][2] += __builtin_amdgcn_cvt_f32_fp8((int)y.x, 2) * yi; hv[j][3] += __builtin_amdgcn_cvt_f32_fp8((int)y.x, 3) * yi; }
                else { hv[j][0] += bflo(y.x); hv[j][1] += bfhi(y.x); hv[j][2] += bflo(y.y); hv[j][3] += bfhi(y.y); } }
            ss += (hv[j][0] * hv[j][0] + hv[j][1] * hv[j][1]) + (hv[j][2] * hv[j][2] + hv[j][3] * hv[j][3]); }
        float rstd = 1.0f / sqrtf(wave_sum(ss) * (1.0f / DM) + RMS_EPS);
#if DBG_STAGE
        { const float sd = __hip_atomic_load((float*)(F.ctl + CW_DBG), RLX_AGENT), sr = __hip_atomic_load((float*)(F.ctl + CW_DBG + 1), RLX_AGENT); rstd *= 1.0f + sqrtf(100.0f * sd / fmaxf(sr, 1e-30f)); }
#endif
        f32x4* op = (f32x4*)(((FEXP == 3) ? WSP(float, WS_PO) : F.out) + (size_t)(tk + t) * DM) + lane;
        if (FEXP == 1) { asm volatile("" :: "v"(hv[0][0] * rstd), "v"(hv[3][3] * rstd)); }
        else {
#pragma unroll
            for (int j = 0; j < 4; ++j) op[64 * j] = hv[j] * rstd * gf[j]; } }
}
template <int FEXP> __device__ __forceinline__ void phase_final_t(Frame& F) {
    const int gw = F.bid * 8 + F.wave, NGW = F.G * 8, lane = F.lane;
    const bf16_t* HBf = WSP(bf16_t, WS_HB); const bf16_t* Y = WSP(bf16_t, WS_Y); const int* INVp = WSP(int, WS_INV);
    f32x4 gf[4];
#pragma unroll
    for (int j = 0; j < 4; ++j) gf[j] = ((const f32x4*)F.in[I_GFINAL])[lane + 64 * j];
    FinRegs ra, rb; const int step = NGW * 2, t0 = gw * 2, n = (t0 < T_) ? (T_ - t0 + step - 1) / step : 0;
    if (n > 0) { fin_load(HBf, Y, INVp, t0, ra, lane); int i = 0;
        for (; i + 2 <= n; i += 2) {
            fin_load(HBf, Y, INVp, t0 + (i + 1) * step, rb, lane);
            fin_finish<FEXP>(F, t0 + i * step, ra, gf, lane);
            fin_load(HBf, Y, INVp, t0 + min(i + 2, n - 1) * step, ra, lane);
            fin_finish<FEXP>(F, t0 + (i + 1) * step, rb, gf, lane); }
        if (i < n) fin_finish<FEXP>(F, t0 + i * step, ra, gf, lane); }
}
__device__ __forceinline__ void phase_final(Frame& F) { phase_final_t<0>(F); }

__device__ __forceinline__ void dbg_compare(Frame& F, const bf16_t* A, const bf16_t* R, size_t n) {
    float sd = 0.f, sr = 0.f;
    for (size_t i = (size_t)F.bid * 512 + F.tid; i < n; i += (size_t)F.G * 512) { const float a = bf2f(A[i]), r = bf2f(R[i]); sd += (a - r) * (a - r); sr += r * r; }
    sd = wave_sum(sd); sr = wave_sum(sr);
    if (F.lane == 0) { atomicAdd((float*)(F.ctl + CW_DBG), sd); atomicAdd((float*)(F.ctl + CW_DBG + 1), sr); }
}
constexpr int N_PHASES = 15;
__global__ void __launch_bounds__(512, 2) mega_fwd(Args args) {
    extern __shared__ __attribute__((aligned(16))) unsigned char lds_raw[];
    Frame F;
    F.lds = (LAS unsigned char*)lds_raw; F.tid = threadIdx.x; F.lane = F.tid & 63; F.wave = __builtin_amdgcn_readfirstlane(F.tid >> 6); F.G = gridDim.x; F.bid = blockIdx.x;
#pragma unroll
    for (int i = 0; i < 28; ++i) F.in[i] = args.in[i];
    F.out = args.out; F.ws = args.ws; F.ctl = (unsigned*)(args.ws + WS_CTL);
    volatile LAS unsigned* MISC = (volatile LAS unsigned*)(F.lds + MISC_OFF);
    if (F.tid < 64) MISC[F.tid] = 0u;
    __syncthreads();
    const int lo = args.ph_lo, hi = args.ph_hi;
    XcdBarrier bar; bar.bar = F.ctl + CW_BAR; bar.x = 0; bar.st = nullptr;
    if (hi - lo > 1) bar = xcd_barrier_post(F.ctl + CW_BAR, MISC + 8);
#define IN(k) (lo <= (k) && (k) < hi)
#define SEAM(k) do { if (IN(k) && IN((k) + 1)) xcd_barrier(bar); } while (0)
    LAS unsigned char* ring = F.lds;
    const LAS int* gidx = (const LAS int*)(F.lds + GIDX_OFF);

    if (IN(0)) for (int rep_ = 0; rep_ <= ((REP_MASK >> 0) & 1) * REP_EXTRA; ++rep_) { if (rep_) xcd_barrier(bar);  phase_prologue(F); for (int tk = F.bid; tk < NG * 8; tk += F.G) p0_ssm_tables(F, tk); } SEAM(0);
    if (IN(1)) for (int rep_ = 0; rep_ <= ((REP_MASK >> 1) & 1) * REP_EXTRA; ++rep_) { if (rep_) xcd_barrier(bar);
        { pg8::Gemm g{WSP(bf16_t, WS_XB), WSP(bf16_t, WS_WIN), DM, 0}; pg8::PatchOrder S; S.init(T_ / 256, INW / 256, 8, F.G, F.bid);
          pg8::EpiInProj E{WSP(bf16_t, WS_Q), WSP(bf16_t, WS_K), WSP(bf16_t, WS_V), WSP(bf16_t, WS_U), WSP(bf16_t, WS_SGA), WSP(bf16_t, WS_SGB), WSP(float, WS_KM2)};
          pg8::gemm_phase<pg8::EpiInProj, pg8::PatchOrder, false>(ring, g, S, E, gidx, STG_TICKS);
#if NULL_EXP == 1
          { pg8::EpiNull EN; pg8::gemm_phase<pg8::EpiNull, pg8::PatchOrder, false>(ring, g, S, EN, gidx); pg8::gemm_phase<pg8::EpiNull, pg8::PatchOrder, false>(ring, g, S, EN, gidx); }
#elif NULL_EXP == 5
          { pg8::EpiStoreExp<false> EN{WSP(bf16_t, WS_N2B)}; pg8::gemm_phase<pg8::EpiStoreExp<false>, pg8::PatchOrder, false>(ring, g, S, EN, gidx); pg8::gemm_phase<pg8::EpiStoreExp<false>, pg8::PatchOrder, false>(ring, g, S, EN, gidx); }
#elif NULL_EXP == 6
          { pg8::EpiStoreExp<true> EN{WSP(bf16_t, WS_N2B)}; pg8::gemm_phase<pg8::EpiStoreExp<true>, pg8::PatchOrder, false>(ring, g, S, EN, gidx); pg8::gemm_phase<pg8::EpiStoreExp<true>, pg8::PatchOrder, false>(ring, g, S, EN, gidx); }
#elif NULL_EXP == 3
          { pg8::EpiInProjT<1> EN{E.Q, E.Kb, E.V, E.U, E.SGA, E.SGB, E.KM2}; pg8::gemm_phase<pg8::EpiInProjT<1>, pg8::PatchOrder, false>(ring, g, S, EN, gidx); pg8::gemm_phase<pg8::EpiInProjT<1>, pg8::PatchOrder, false>(ring, g, S, EN, gidx); }
#elif NULL_EXP == 4
          { pg8::EpiInProjT<2> EN{E.Q, E.Kb, E.V, E.U, E.SGA, E.SGB, E.KM2}; pg8::gemm_phase<pg8::EpiInProjT<2>, pg8::PatchOrder, false>(ring, g, S, EN, gidx); pg8::gemm_phase<pg8::EpiInProjT<2>, pg8::PatchOrder, false>(ring, g, S, EN, gidx); }
#endif
          }
        { pg8::Gemm g{WSP(bf16_t, WS_MN), WSP(bf16_t, WS_WXKV), DM, 0}; pg8::PatchOrder S; S.init(NB * MEML / 256, 2 * XW / 256, 4, F.G, F.bid);
          pg8::EpiMemKV E{WSP(bf16_t, WS_MKV), WSP(bf16_t, WS_MVT)};
          pg8::gemm_phase<pg8::EpiMemKV, pg8::PatchOrder, false>(ring, g, S, E, gidx); }
    } SEAM(1);
    if (IN(2)) for (int rep_ = 0; rep_ <= ((REP_MASK >> 2) & 1) * REP_EXTRA; ++rep_) { if (rep_) { xcd_barrier(bar); if (F.tid < 4) { for (int k_ = F.tid; k_ < 1024; k_ += 4) __hip_atomic_store(F.ctl + CW_MCNT + k_, 0u, RLX_AGENT); } __syncthreads(); xcd_barrier(bar); }
        for (int it = F.bid; it < NB * NG * 2; it += F.G) ssm_state_item(F, (it >> 1) / NG, (it >> 1) % NG, it & 1);
        for (int it = F.bid; it < NB * NH * NBLK; it += F.G) moba_route_item(F, it / NBLK, (NBLK - 1) - (it % NBLK));
    } SEAM(2);
    if (IN(3)) for (int rep_ = 0; rep_ <= ((REP_MASK >> 3) & 1) * REP_EXTRA; ++rep_) { if (rep_) xcd_barrier(bar);
        { int t_ = threadIdx.x; asm volatile("" : "+v"(t_)); F.tid = t_; F.lane = t_ & 63; F.wave = __builtin_amdgcn_readfirstlane(t_ >> 6); }
        { const int nsl = F.G >> 3, conv = (CONV_SLOTS > 0 && nsl > CONV_SLOTS && (F.G & 7) == 0) ? CONV_SLOTS : 0;
          if ((F.bid >> 3) >= nsl - conv) { __syncthreads(); convert_weights(F, 1, (((F.bid >> 3) - (nsl - conv)) * 8 + (F.bid & 7)) * 8 + F.wave, conv * 64); __syncthreads(); }
          moba_sparse_phase<0>(F, (char*)lds_raw, nsl); }
#if MOBA_EXP == 1
        moba_sparse_phase<1>(F, (char*)lds_raw, F.G >> 3); moba_sparse_phase<1>(F, (char*)lds_raw, F.G >> 3);
#endif
        { int t_ = threadIdx.x; asm volatile("" : "+v"(t_)); F.tid = t_; F.lane = t_ & 63; F.wave = __builtin_amdgcn_readfirstlane(t_ >> 6); }
        phase_ssm_out(F);
    } SEAM(3);
#if DBG_STAGE == 1 || DBG_STAGE == 2
    moba_combine_phase(F); xcd_barrier(bar);
#endif
#if DBG_STAGE == 1
    phase_ssm_simple(F, WSP(bf16_t, WS_MERGED)); xcd_barrier(bar); dbg_compare(F, WSP(bf16_t, WS_YB), WSP(bf16_t, WS_MERGED), (size_t)T_ * SW); xcd_barrier(bar);
#elif DBG_STAGE == 2
    phase_moba_simple(F, WSP(bf16_t, WS_MERGED)); xcd_barrier(bar); dbg_compare(F, WSP(bf16_t, WS_ATT), WSP(bf16_t, WS_MERGED), (size_t)T_ * AW); xcd_barrier(bar);
#endif
    if (IN(5)) for (int rep_ = 0; rep_ <= ((REP_MASK >> 5) & 1) * REP_EXTRA; ++rep_) { if (rep_) xcd_barrier(bar);
#if !(DBG_STAGE == 1 || DBG_STAGE == 2)
        moba_combine_phase(F);
#endif
        pg8::Gemm g{WSP(bf16_t, WS_YB), WSP(bf16_t, WS_WGLU), SW, 0};
        pg8::EpiGlu E{WSP(bf16_t, WS_SGB), WSP(bf16_t, WS_YB2S)};
        if (F.G == 256) { pg8::PairOrder S; S.init(F.bid, 0); pg8::gemm_phase<pg8::EpiGlu, pg8::PairOrder, false>(ring, g, S, E, gidx); }
        else { pg8::PatchOrder S; S.init(T_ / 256, 2 * DM / 256, 8, F.G, F.bid); pg8::gemm_phase<pg8::EpiGlu, pg8::PatchOrder, false>(ring, g, S, E, gidx); }
    } if (F.G != 256) SEAM(5);
    if (IN(6)) for (int rep_ = 0; rep_ <= ((REP_MASK >> 6) & 1) * REP_EXTRA; ++rep_) { if (rep_) xcd_barrier(bar);
        pg8::Gemm g{WSP(bf16_t, WS_ATT), WSP(bf16_t, WS_WPA), AW, 0};
        pg8::EpiMerge E{WSP(bf16_t, WS_SGA), WSP(bf16_t, WS_YB2S), WSP(bf16_t, WS_MERGED)};
        if (F.G == 256) { pg8::PairOrder S; S.init(F.bid, 1); pg8::gemm_phase<pg8::EpiMerge, pg8::PairOrder, false>(ring, g, S, E, gidx); }
        else { pg8::PatchOrder S; S.init(T_ / 256, DM / 256, 4, F.G, F.bid); pg8::gemm_phase<pg8::EpiMerge, pg8::PatchOrder, false>(ring, g, S, E, gidx); }
    } SEAM(6);
    if (IN(7)) for (int rep_ = 0; rep_ <= ((REP_MASK >> 7) & 1) * REP_EXTRA; ++rep_) { if (rep_) xcd_barrier(bar);
        pg8::Gemm g{WSP(bf16_t, WS_MERGED), WSP(bf16_t, WS_WOUT), DM, 0}; pg8::PatchOrder S; S.init(T_ / 256, DM / 256, 4, F.G, F.bid);
        pg8::EpiResidT<true> E{F.in[I_X], WSP(bf16_t, WS_HB), WSP(float, WS_SSQ1)};
        pg8::gemm_phase<pg8::EpiResidT<true>, pg8::PatchOrder, false>(ring, g, S, E, gidx);
    } SEAM(7);
    if (IN(8)) for (int rep_ = 0; rep_ <= ((REP_MASK >> 8) & 1) * REP_EXTRA; ++rep_) { if (rep_) xcd_barrier(bar);
        pg8::Gemm g{WSP(bf16_t, WS_HB), WSP(bf16_t, WS_WXQ), DM, 0}; pg8::PatchOrder S; S.init(T_ / 256, XW / 256, 2, F.G, F.bid);
        pg8::EpiXq E{WSP(float, WS_SSQ1), WSP(bf16_t, WS_XQ)};
        pg8::gemm_phase<pg8::EpiXq, pg8::PatchOrder, false>(ring, g, S, E, gidx);
    } SEAM(8);
    if (IN(9)) for (int rep_ = 0; rep_ <= ((REP_MASK >> 9) & 1) * REP_EXTRA; ++rep_) { if (rep_) xcd_barrier(bar);  phase_xattn(F); } SEAM(9);
#if DBG_STAGE == 3
    phase_xattn_simple(F, WSP(bf16_t, WS_MERGED)); xcd_barrier(bar); dbg_compare(F, WSP(bf16_t, WS_XO), WSP(bf16_t, WS_MERGED), (size_t)T_ * XW); xcd_barrier(bar);
#endif
    if (IN(10)) for (int rep_ = 0; rep_ <= ((REP_MASK >> 10) & 1) * REP_EXTRA; ++rep_) { if (rep_) xcd_barrier(bar);
        pg8::Gemm g{WSP(bf16_t, WS_XO), WSP(bf16_t, WS_WXO), XW, 0}; pg8::PatchOrder S; S.init(T_ / 256, DM / 256, 4, F.G, F.bid);
        pg8::EpiResidT<false> E{nullptr, WSP(bf16_t, WS_HB), nullptr};
        pg8::gemm_phase<pg8::EpiResidT<false>, pg8::PatchOrder, false>(ring, g, S, E, gidx);
    } SEAM(10);
    if (IN(11)) for (int rep_ = 0; rep_ <= ((REP_MASK >> 11) & 1) * REP_EXTRA; ++rep_) { if (rep_) xcd_barrier(bar);  phase_router_mfma(F);
#if OUT_TOUCH
        { const int gw = F.bid * 8 + F.wave, NGW = F.G * 8;
          for (int tk = gw * 2; tk < T_; tk += NGW * 2) { if (F.lane < 2) { const float v = __builtin_nontemporal_load(F.out + (size_t)(tk + F.lane) * DM); asm volatile("" :: "v"(v)); } } }
#endif
    } SEAM(11);
    if (IN(12) || IN(13)) {
        LAS int* pref = (LAS int*)(F.lds + MISC_OFF + 256);
        const unsigned* cnt = F.ctl + CW_CNT;
        __syncthreads();
        if (F.tid == 0) { int a = 0; for (int e = 0; e < NE; ++e) { pref[e] = a; a += ((int)__hip_atomic_load(cnt + e, RLX_AGENT) + 255) >> 8; } pref[NE] = a; }
        __syncthreads();
        const int MT = pref[NE];
        if (IN(12)) for (int rep_ = 0; rep_ <= ((REP_MASK >> 12) & 1) * REP_EXTRA; ++rep_) { if (rep_) xcd_barrier(bar);
            MoeOrder S; S.P.init(MT, 2 * DFF / 256, 8, F.G, F.bid); S.pref = pref; S.rev = 0;
            { LAS int* gw_ = (LAS int*)(F.lds + GIDX_OFF); pg8::Unit u;
              for (int i = 0; i < GIDX_UNITS && S.next(i, u); ++i) { const int ce = (int)__hip_atomic_load(cnt + u.e, RLX_AGENT);
                  if (F.tid < 256) { const int rank = u.mi * 256 + F.tid; int tokslot = 0; if (rank < ce) { tokslot = WSP(int, WS_ROWLIST)[(size_t)u.e * T_ + rank]; if (u.pn == 0) WSP(int, WS_INV)[tokslot] = u.pm * 256 + F.tid; }
                      gw_[i * 256 + F.tid] = tokslot >> 2; } } }
            __syncthreads();
            pg8::Gemm g{WSP(bf16_t, WS_N2B), WSP(bf16_t, WS_WGU), MOE1_FP8 ? DM / 2 : DM, MOE1_FP8 ? (size_t)2 * DFF * DM / 2 : (size_t)2 * DFF * DM};
            if (MOE1_FP8) g.scaleB = 0x01010101 * (127 - FP8_WSHIFT);
            pg8::EpiMoe1 E{F.in[I_BGU], WSP(bf16_t, WS_HID)};
            pg8::gemm_phase<pg8::EpiMoe1, MoeOrder, true, MOE1_FP8 != 0>(ring, g, S, E, gidx, STG_TICKS);
#if NULL_EXP == 2
            { pg8::EpiNull EN; pg8::gemm_phase<pg8::EpiNull, MoeOrder, true>(ring, g, S, EN, gidx); }
#endif
        }
        SEAM(12);
        if (IN(13)) for (int rep_ = 0; rep_ <= ((REP_MASK >> 13) & 1) * REP_EXTRA; ++rep_) { if (rep_) xcd_barrier(bar);
            MoeOrder S; S.P.init(MT, DM / 256, 4, F.G, F.bid); S.pref = pref; S.rev = 1;
            pg8::Gemm g{WSP(bf16_t, WS_HID), WSP(bf16_t, WS_WDN), MOE2_FP8 ? DFF / 2 : DFF, MOE2_FP8 ? (size_t)DM * DFF / 2 : (size_t)DM * DFF};
            if (MOE2_FP8) g.scaleB = 0x01010101 * (127 - FP8_WSHIFT);
            { LAS int* tD = (LAS int*)(F.lds + GIDX_OFF); LAS float* tG = (LAS float*)(F.lds + GIDX_OFF + 12 * 1024); pg8::Unit u;
              __syncthreads();
              for (int i = 0; i < 12 && S.next(i, u); ++i) { const int ce = (int)__hip_atomic_load(cnt + u.e, RLX_AGENT);
                  if (F.tid < 256) { const int rank = u.mi * 256 + F.tid; int d = -1; float gv = 0.f; if (rank < ce) { d = WSP(int, WS_ROWLIST)[(size_t)u.e * T_ + rank]; gv = WSP(float, WS_TKG)[d]; } tD[i * 256 + F.tid] = d; tG[i * 256 + F.tid] = gv; } }
              __syncthreads(); }
            pg8::EpiMoe2 E{F.in[I_BDN], (const LAS int*)(F.lds + GIDX_OFF), (const LAS float*)(F.lds + GIDX_OFF + 12 * 1024), WSP(bf16_t, WS_Y)};
            pg8::gemm_phase<pg8::EpiMoe2, MoeOrder, false, MOE2_FP8 != 0>(ring, g, S, E, gidx, STG_TICKS);
        }
    } SEAM(13);
#if BAR_EXP
    for (int k_ = 0; k_ < 20; ++k_) xcd_barrier(bar);
#endif
    if (IN(14)) for (int rep_ = 0; rep_ <= ((REP_MASK >> 14) & 1) * REP_EXTRA; ++rep_) { if (rep_) xcd_barrier(bar);  phase_final(F);
#if FINAL_EXP
        phase_final_t<FINAL_EXP>(F); phase_final_t<FINAL_EXP>(F);
#endif
    }
#undef IN
#undef SEAM
}

extern "C" void kernel_launch(void* const* d_in, const int* in_sizes, int n_in, void* d_out, int out_size, void* d_ws, size_t ws_size, hipStream_t stream) {
    static int grid = 0;
    if (grid == 0) {
        if (n_in != 28 || in_sizes[0] != T_ * DM || out_size != T_ * DM || ws_size < WS_END) { fprintf(stderr, "kernel_launch: unexpected shapes (n_in %d, in0 %d, out %d, ws %zu)\n", n_in, n_in > 0 ? in_sizes[0] : -1, out_size, ws_size); grid = -1; return; }
        int dev = 0, cus = 0;
        if (hipGetDevice(&dev) != hipSuccess || hipDeviceGetAttribute(&cus, hipDeviceAttributeMultiprocessorCount, dev) != hipSuccess) { grid = -1; return; }
        if (hipFuncSetAttribute((const void*)mega_fwd, hipFuncAttributeMaxDynamicSharedMemorySize, LDS_BYTES) != hipSuccess) { fprintf(stderr, "kernel_launch: hipFuncSetAttribute failed\n"); grid = -1; return; }
        (void)hipGetLastError();
        grid = cus;
    }
    if (grid < 0) return;
    (void)hipMemsetAsync((char*)d_ws + WS_CTL, 0, CTL_ZERO_BYTES, stream);
    Args a{};
    for (int i = 0; i < 28; ++i) a.in[i] = (const float*)d_in[i];
    a.out = (float*)d_out; a.ws = (unsigned char*)d_ws;
#if MK_N_LAUNCHES == 1
    a.ph_lo = 0; a.ph_hi = N_PHASES;
    hipLaunchKernelGGL(mega_fwd, dim3(grid), dim3(512), LDS_BYTES, stream, a);
#else
    for (int p = 0; p < N_PHASES; ++p) { a.ph_lo = p; a.ph_hi = p + 1; hipLaunchKernelGGL(mega_fwd, dim3(grid), dim3(512), LDS_BYTES, stream, a); }
#endif
}
```

```cpp
#include <hip/hip_runtime.h>
#include <hip/hip_bf16.h>
#include <cmath>
#include <cstdio>
#include <cstdint>

#ifndef MK_N_LAUNCHES
#define MK_N_LAUNCHES 1
#endif

#ifndef REP_EXTRA
#define REP_EXTRA 1
#endif
#ifndef NULL_EXP
#define NULL_EXP 0
#endif
#ifndef STG_TICKS
#define STG_TICKS 0
#endif
#ifndef MOBA_EXP
#define MOBA_EXP 0
#endif
#ifndef OUT_NT
#define OUT_NT 0
#endif
#ifndef OUT_TOUCH
#define OUT_TOUCH 0
#endif
#ifndef BAR_EXP
#define BAR_EXP 0
#endif
#ifndef FINAL_EXP
#define FINAL_EXP 0
#endif
#ifndef MOE1_FP8
#define MOE1_FP8 1
#endif
constexpr int FP8_WSHIFT = 7;
#ifndef MOE2_FP8
#define MOE2_FP8 1
#endif
#ifndef Y_FP8
#define Y_FP8 1
#endif
constexpr int Y_SHIFT = 3;
#ifndef CONV_SLOTS
#define CONV_SLOTS 14
#endif
#ifndef REP_MASK
#define REP_MASK 0
#endif
#ifndef DBG_STAGE
#define DBG_STAGE 0
#endif

#define GAS __attribute__((address_space(1)))
#define LAS __attribute__((address_space(3)))
typedef unsigned short bf16_t;
typedef short bf16x8 __attribute__((ext_vector_type(8)));
typedef float f32x4 __attribute__((ext_vector_type(4)));
typedef float f32x2 __attribute__((ext_vector_type(2)));
typedef float f32x16 __attribute__((ext_vector_type(16)));
typedef unsigned u32x4 __attribute__((ext_vector_type(4)));
typedef unsigned u32x2 __attribute__((ext_vector_type(2)));

constexpr int NB = 4, SEQ = 8192, DM = 1024, T_ = NB * SEQ;
constexpr int AW = 512, NH = 8, HD = 64, MBLK = 256, NBLK = SEQ / MBLK, MTOPK = 3;
constexpr int SW = 512, SGC = 16, NG = 32, SP = 64;
constexpr int INW = 4096;
constexpr int MEML = 256, XH = 4, XD = 128, XW = 512;
constexpr int NE = 32, ETOPK = 4, DFF = 1024;
constexpr float RMS_EPS = 1e-6f;
constexpr float LOG2E = 1.4426950408889634f;
constexpr float QSCALE = 0.125f * LOG2E;
constexpr float XSCALE = 0.08838834764831845f * LOG2E;
constexpr int HID_ROWS = ETOPK * T_ + NE * 256;

constexpr size_t MiB = 1u << 20;
constexpr size_t WS_WIN = 0 * MiB, WS_WGLU = 8 * MiB, WS_WPA = 10 * MiB, WS_WOUT = 11 * MiB, WS_WXQ = 13 * MiB, WS_WXKV = 14 * MiB, WS_WXO = 16 * MiB,
                 WS_WGU = 17 * MiB, WS_WDN = 145 * MiB;
constexpr size_t WS_CTL = 209 * MiB, CTL_ZERO_BYTES = 1 * MiB;
constexpr size_t WS_RSTD0 = 210 * MiB;
constexpr size_t WS_RSTD2 = WS_RSTD0 + 128 * 1024;
constexpr size_t WS_KMEAN = WS_RSTD2 + 128 * 1024;
constexpr size_t WS_KM2 = WS_KMEAN;
constexpr size_t WS_TKG = 224 * MiB;
constexpr size_t WS_SSQ1 = 211 * MiB;
constexpr size_t WS_SSQ2 = 213 * MiB;
constexpr size_t WS_ROWLIST = 215 * MiB;
constexpr size_t WS_MN = 219 * MiB;
constexpr size_t WS_MKV = 221 * MiB;
constexpr size_t WS_MVT = 223 * MiB;
constexpr size_t WS_WST = 225 * MiB;
constexpr size_t WS_GT = 233 * MiB;
constexpr size_t WS_KT = 241 * MiB;
constexpr size_t WS_LAML = 243 * MiB;
constexpr size_t WS_SST = 244 * MiB;
constexpr size_t WS_H = 256 * MiB;
constexpr size_t WS_N2B = 256 * MiB;
constexpr size_t WS_PO = 256 * MiB;
constexpr size_t WS_PML = 384 * MiB;
constexpr size_t WS_MLIST = 392 * MiB;
constexpr size_t WS_HB = 384 * MiB;
constexpr size_t WS_HID = 448 * MiB;
constexpr size_t WS_Y = 720 * MiB;
constexpr size_t WS_END = 992 * MiB;
constexpr size_t WS_INV = 224 * MiB + 512 * 1024;
constexpr size_t WS_XB = 448 * MiB, WS_Q = 512 * MiB, WS_K = 544 * MiB, WS_V = 576 * MiB, WS_U = 608 * MiB, WS_ATT = 640 * MiB, WS_YB = 672 * MiB;
constexpr size_t WS_SGA = 720 * MiB, WS_SGB = 784 * MiB, WS_YB2S = 848 * MiB, WS_MERGED = 912 * MiB;
constexpr size_t WS_XQ = 448 * MiB, WS_XO = 480 * MiB;
static_assert(WS_HID + (size_t)HID_ROWS * DFF * 2 <= WS_Y, "HID fits");
constexpr int CW_TMO = 0, CW_CNT = 64  , CW_DBG = 128  , CW_MCNT = 256  , CW_ACNT = 1536  , CW_BAR = 4096;

constexpr int RING_BYTES = 131072;
constexpr int GIDX_OFF = RING_BYTES, GIDX_UNITS = 24;
constexpr int MISC_OFF = GIDX_OFF + GIDX_UNITS * 1024;
constexpr int LDS_BYTES = 163840;

#define RLX_AGENT __ATOMIC_RELAXED, __HIP_MEMORY_SCOPE_AGENT
__device__ __forceinline__ unsigned f2bf(float f) { unsigned u = __builtin_bit_cast(unsigned, f); return (u + 0x7fffu + ((u >> 16) & 1u)) >> 16; }
__device__ __forceinline__ unsigned pk2(float lo, float hi) { return f2bf(lo) | (f2bf(hi) << 16); }
__device__ __forceinline__ float bf2f(unsigned short b) { return __builtin_bit_cast(float, (unsigned)b << 16); }
__device__ __forceinline__ float bflo(unsigned w) { return __builtin_bit_cast(float, w << 16); }
__device__ __forceinline__ float bfhi(unsigned w) { return __builtin_bit_cast(float, w & 0xffff0000u); }
__device__ __forceinline__ float ub0(unsigned w) { return (float)(w & 0xffu) * (1.0f / 255.0f); }
__device__ __forceinline__ float ub1(unsigned w) { return (float)((w >> 8) & 0xffu) * (1.0f / 255.0f); }
__device__ __forceinline__ float ub2(unsigned w) { return (float)((w >> 16) & 0xffu) * (1.0f / 255.0f); }
__device__ __forceinline__ float ub3(unsigned w) { return (float)(w >> 24) * (1.0f / 255.0f); }
__device__ __forceinline__ float wave_sum(float v) {
#pragma unroll
    for (int o = 1; o < 64; o <<= 1) v += __shfl_xor(v, o);
    return v;
}
__device__ __forceinline__ float fsigmoid(float x) { return __builtin_amdgcn_rcpf(1.0f + __builtin_amdgcn_exp2f(-x * LOG2E)); }
__device__ __forceinline__ float gelu_tanh(float x) {
    const float u = 0.7978845608028654f * (x + 0.044715f * x * x * x);
    return x * fsigmoid(2.0f * u);
}

namespace pg8 {
constexpr int BM = 256, BK = 64, HALF = 128, HTB = HALF * BK * 2, STAGE_BYTES = 8 * HTB;
__host__ __device__ __forceinline__ int lds_byte(int r, int c) { const int st = (r >> 4) * 2 + (c >> 5), rr = r & 15, cc = c & 31, ob = rr * 64 + cc * 2; return st * 1024 + (ob ^ (((ob >> 9) & 1) << 5)); }
__host__ __device__ __forceinline__ void stage_rc(int b, int& R, int& C) { const int st = b / 1024, sb = b % 1024, swz = sb ^ (((sb >> 9) & 1) << 5); R = (st >> 1) * 16 + swz / 64; C = (st & 1) * 32 + (swz % 64) / 2; }
__host__ __device__ __forceinline__ int perm32(int rho) { const int n = rho >> 4, i = rho & 15; return 8 * (i >> 2) + 4 * n + (i & 3); }

struct Unit { int pm, pn, e, mi, ui; };
struct Gemm { const bf16_t* A; const bf16_t* Bt; int K; size_t b_estride; int scaleA = 0x7f7f7f7f, scaleB = 0x7f7f7f7f; };
typedef int v8i __attribute__((ext_vector_type(8)));

struct PatchOrder {
    int nM, nN, PM, PN, x, j, ok;
    __device__ __forceinline__ void init(int nM_, int nN_, int PN_, int G, int c) { nM = nM_; nN = nN_; PN = PN_; PM = (G / 8) / PN_; x = c & 7; j = c >> 3; ok = ((G & 7) == 0) && (PM * PN == G / 8) && (nN % PN == 0); if (!ok) { x = c; j = G; } }
    __device__ __forceinline__ bool next(int i, Unit& u) const {
        if (!ok) { const long L = (long)i * j + x; if (L >= (long)nM * nN) return false; u.pm = (int)(L / nN); u.pn = (int)(L % nN); u.e = 0; u.mi = u.pm; u.ui = i; return true; }
        const int p = 8 * i + x, npn = nN / PN, pmb = p / npn, pnb = p % npn;
        u.pm = pmb * PM + (j % PM); u.pn = pnb * PN + (j / PM); u.e = 0; u.mi = u.pm; u.ui = i;
        return u.pm < nM;
    }
};

struct PairOrder {
    int pp, q, mode;
    __device__ __forceinline__ void init(int c, int mode_) { const int x = c & 7, k = c >> 3; q = k & 3; pp = 8 * x + (k >> 2); mode = mode_; }
    __device__ __forceinline__ bool next(int i, Unit& u) const {
        if (mode == 0) { if (i >= 4) return false; u.pm = 2 * pp + (i >> 1); u.pn = 2 * q + (i & 1); }
        else { if (i >= 2) return false; u.pm = 2 * pp + i; u.pn = q; }
        u.e = 0; u.mi = u.pm; u.ui = i; return true;
    }
};
struct OneUnit {
    int pm, pn, has;
    __device__ __forceinline__ bool next(int i, Unit& u) const { if (i != 0 || !has) return false; u.pm = pm; u.pn = pn; u.e = 0; u.mi = pm; u.ui = 0; return true; }
};
__device__ __forceinline__ unsigned cvt_pk_bf16(float lo, float hi) { unsigned r; asm volatile("v_cvt_pk_bf16_f32 %0, %1, %2" : "=v"(r) : "v"(lo), "v"(hi)); return r; }
#ifndef NT_STORES
#define NT_STORES 0
#endif
#ifndef WT_STORES
#define WT_STORES 0
#endif
__device__ __forceinline__ void st16(void* p, u32x4 v) {
#if WT_STORES
    asm volatile("global_store_dwordx4 %0, %1, off sc1\n\ts_nop 1" :: "v"(p), "v"(v) : "memory");
#elif NT_STORES
    __builtin_nontemporal_store(v, (u32x4*)p);
#else
    *(u32x4*)p = v;
#endif
}

template <class Epi, class Sched, bool GATHER, bool FP8 = false>
__device__ __forceinline__ void gemm_phase(LAS unsigned char* lds, const Gemm g, const Sched& S, const Epi& E, const LAS int* gidx, int stagger_ticks = 0) {
    if (stagger_ticks > 0) {
        const unsigned long long t0 = __builtin_amdgcn_s_memrealtime(); const unsigned long long dl = (unsigned long long)(stagger_ticks * ((blockIdx.x >> 3) & 3));
        while (__builtin_amdgcn_s_memrealtime() - t0 < dl) __builtin_amdgcn_s_sleep(8);
    }
    const int tid = threadIdx.x, wid = __builtin_amdgcn_readfirstlane(tid >> 6), lane = tid & 63, wr = wid >> 2, wc = wid & 3, fr = lane & 15, fq = lane >> 4;
    const int K = g.K, nt = K / BK;
    int Ra[2], Ca[2]; unsigned voffB[2];
#pragma unroll
    for (int i = 0; i < 2; ++i) { int R, C; stage_rc(tid * 16 + i * 8192, R, C); const int Rb = Epi::PERM ? ((R & ~31) + perm32(R & 31)) : R;
        Ra[i] = R; Ca[i] = C; voffB[i] = (unsigned)(Rb * K + C) * 2u; }
    const size_t kstep = (size_t)(BK * 2);
    const size_t hstep = (size_t)HALF * K * 2;
    const size_t tstep = 2 * hstep;
    const unsigned ldsw = (unsigned)wid * 1024u;
    const int aoff = lds_byte(wr * 64 + fr, fq * 8), boff = lds_byte(wc * 32 + fr, fq * 8);
#define PG8_SA(b, h) (((b) * 2 + (h)) * HTB)
#define PG8_SB(b, h) ((4 + (b) * 2 + (h)) * HTB)
#define PG8_STAGE(bufoff, gbase, voff) do { _Pragma("unroll") for (int _i = 0; _i < 2; ++_i) \
        __builtin_amdgcn_global_load_lds((const unsigned*)((const char*)(gbase) + (voff)[_i]), (LAS unsigned*)(lds + (bufoff) + ldsw + _i * 8192), 16, 0, 0); } while (0)
#define PG8_LDA_BF(dst, b, h) do { _Pragma("unroll") for (int m = 0; m < 4; ++m) _Pragma("unroll") for (int k = 0; k < 2; ++k) dst[m][k] = *(const LAS bf16x8*)(lds + PG8_SA(b, h) + aoff + m * 2048 + k * 1024); } while (0)
#define PG8_LDB_BF(dst, b, h) do { _Pragma("unroll") for (int n = 0; n < 2; ++n) _Pragma("unroll") for (int k = 0; k < 2; ++k) dst[n][k] = *(const LAS bf16x8*)(lds + PG8_SB(b, h) + boff + n * 2048 + k * 1024); } while (0)
#define PG8_LD8(dst, base_) do { const u32x4 lo_ = *(const LAS u32x4*)(base_), hi_ = *(const LAS u32x4*)((base_) + 1024); dst = (v8i){(int)lo_.x, (int)lo_.y, (int)lo_.z, (int)lo_.w, (int)hi_.x, (int)hi_.y, (int)hi_.z, (int)hi_.w}; } while (0)
#define PG8_LDA8(dst, b, h) do { _Pragma("unroll") for (int m = 0; m < 4; ++m) PG8_LD8(dst[m], lds + PG8_SA(b, h) + aoff + m * 2048); } while (0)
#define PG8_LDB8(dst, b, h) do { _Pragma("unroll") for (int n = 0; n < 2; ++n) PG8_LD8(dst[n], lds + PG8_SB(b, h) + boff + n * 2048); } while (0)
#define PG8_LDA(dst, b, h) do { if constexpr (FP8) PG8_LDA8(dst##8, b, h); else PG8_LDA_BF(dst, b, h); } while (0)
#define PG8_LDB(dst, b, h) do { if constexpr (FP8) PG8_LDB8(dst##8, b, h); else PG8_LDB_BF(dst, b, h); } while (0)
#define PG8_MMA_BF(ai, bj, At, Bt) do { __builtin_amdgcn_s_setprio(1); _Pragma("unroll") for (int m = 0; m < 4; ++m) _Pragma("unroll") for (int n = 0; n < 2; ++n) _Pragma("unroll") for (int k = 0; k < 2; ++k) \
        acc[ai][bj][m][n] = __builtin_amdgcn_mfma_f32_16x16x32_bf16(Bt[n][k], At[m][k], acc[ai][bj][m][n], 0, 0, 0); __builtin_amdgcn_s_setprio(0); } while (0)
#define PG8_MMA_F8(ai, bj, At, Bt) do { __builtin_amdgcn_s_setprio(1); _Pragma("unroll") for (int m = 0; m < 4; ++m) _Pragma("unroll") for (int n = 0; n < 2; ++n) \
        asm volatile("s_nop 1\n\tv_mfma_scale_f32_16x16x128_f8f6f4 %0, %1, %2, %0, %3, %4 op_sel_hi:[0,0,0]" : "+v"(acc[ai][bj][m][n]) : "v"(Bt[n]), "v"(At[m]), "v"(sclB), "v"(sclA)); \
        __builtin_amdgcn_s_setprio(0); } while (0)
#define PG8_MMA(ai, bj, At, Bt) do { if constexpr (FP8) PG8_MMA_F8(ai, bj, At##8, Bt##8); else PG8_MMA_BF(ai, bj, At, Bt); } while (0)
#define PG8_WAIT_V(n) asm volatile("s_waitcnt vmcnt(" #n ")" ::: "memory")
#define PG8_WAIT_L(n) asm volatile("s_waitcnt lgkmcnt(" #n ")" ::: "memory")
#define PG8_BAR __builtin_amdgcn_s_barrier()
#define PG8_SCHED __builtin_amdgcn_sched_barrier(0)
#define PG8_VOA(dst, u) do { _Pragma("unroll") for (int _h = 0; _h < 2; ++_h) _Pragma("unroll") for (int _i = 0; _i < 2; ++_i) { \
        const int _row = GATHER ? gidx[(u).ui * 256 + _h * HALF + Ra[_i]] : (_h * HALF + Ra[_i]); dst[_h][_i] = (unsigned)(_row * K + Ca[_i]) * 2u; } } while (0)
    Unit cur, nxt; int ui = 0;
    if (!S.next(0, cur)) return;
    f32x4 acc[2][2][4][2];
#pragma unroll
    for (int a = 0; a < 2; ++a)
#pragma unroll
        for (int b = 0; b < 2; ++b)
#pragma unroll
            for (int m = 0; m < 4; ++m)
#pragma unroll
                for (int n = 0; n < 2; ++n) acc[a][b][m][n] = (f32x4){0.f, 0.f, 0.f, 0.f};
    bf16x8 At[4][2], B0[2][2], B1[2][2]; v8i At8[4], B08[2], B18[2];
    unsigned voA[2][2];
    const int sclA = g.scaleA, sclB = g.scaleB;
    PG8_VOA(voA, cur);
    const char* cA = (const char*)g.A + (GATHER ? (size_t)0 : (size_t)cur.pm * tstep);
    const char* cB = (const char*)g.Bt + ((size_t)cur.e * g.b_estride) * 2 + (size_t)cur.pn * tstep;
    PG8_STAGE(PG8_SB(0, 0), cB, voffB); PG8_STAGE(PG8_SB(0, 1), cB + hstep, voffB); PG8_STAGE(PG8_SA(0, 0), cA, voA[0]); PG8_STAGE(PG8_SA(0, 1), cA, voA[1]);
    if (wr == 1) PG8_BAR;
    PG8_WAIT_V(2); PG8_BAR;
    PG8_STAGE(PG8_SB(1, 0), cB + kstep, voffB); PG8_STAGE(PG8_SA(1, 0), cA + kstep, voA[0]); PG8_STAGE(PG8_SB(1, 1), cB + hstep + kstep, voffB);
    PG8_WAIT_V(6); PG8_BAR;
    for (;;) {
        const bool has_next = S.next(ui + 1, nxt);
        const char* nA = cA; const char* nB = cB;
        if (has_next) { nA = (const char*)g.A + (GATHER ? (size_t)0 : (size_t)nxt.pm * tstep); nB = (const char*)g.Bt + ((size_t)nxt.e * g.b_estride) * 2 + (size_t)nxt.pn * tstep; }
#pragma unroll 1
        for (int t = 0; t < nt; t += 2) {
            const bool last = (t == nt - 2);
            const char* a1 = cA + (size_t)(t + 1) * kstep;
            const char* a2 = last ? nA : cA + (size_t)(t + 2) * kstep; const char* b2 = last ? nB : cB + (size_t)(t + 2) * kstep;
            const char* a3 = a2 + kstep; const char* b3 = b2 + kstep;
            unsigned vo2[2][2];
#pragma unroll
            for (int h = 0; h < 2; ++h)
#pragma unroll
                for (int i = 0; i < 2; ++i) vo2[h][i] = voA[h][i];
            if (GATHER && last && has_next) { PG8_VOA(vo2, nxt); }
            PG8_LDB(B0, 0, 0); PG8_LDB(B1, 0, 1); PG8_SCHED; PG8_LDA(At, 0, 0); PG8_STAGE(PG8_SA(1, 1), a1, voA[1]);
            PG8_WAIT_V(8); PG8_WAIT_L(0); PG8_BAR; PG8_MMA(0, 0, At, B0); PG8_MMA(0, 1, At, B1); PG8_BAR; PG8_SCHED;
            PG8_LDA(At, 0, 1); PG8_STAGE(PG8_SB(0, 0), b2, voffB); PG8_STAGE(PG8_SB(0, 1), b2 + hstep, voffB); PG8_STAGE(PG8_SA(0, 0), a2, vo2[0]);
            PG8_WAIT_V(8); PG8_WAIT_L(0); PG8_BAR; PG8_MMA(1, 0, At, B0); PG8_MMA(1, 1, At, B1); PG8_BAR; PG8_SCHED;
            PG8_LDB(B0, 1, 0); PG8_LDB(B1, 1, 1); PG8_SCHED; PG8_LDA(At, 1, 0); PG8_STAGE(PG8_SA(0, 1), a2, vo2[1]);
            PG8_WAIT_V(8); PG8_WAIT_L(0); PG8_BAR; PG8_MMA(0, 0, At, B0); PG8_MMA(0, 1, At, B1); PG8_BAR; PG8_SCHED;
            PG8_LDA(At, 1, 1); PG8_STAGE(PG8_SB(1, 0), b3, voffB); PG8_STAGE(PG8_SB(1, 1), b3 + hstep, voffB); PG8_STAGE(PG8_SA(1, 0), a3, vo2[0]);
            PG8_WAIT_V(8); PG8_WAIT_L(0); PG8_BAR; PG8_MMA(1, 0, At, B0); PG8_MMA(1, 1, At, B1); PG8_BAR; PG8_SCHED;
        }
        if (wr == 0) PG8_BAR;
        if constexpr (FP8) asm volatile("s_nop 15\n\ts_nop 15" ::: "memory");
        E(acc, cur, wr, wc, fr, fq);
        if (!has_next) break;
#pragma unroll
        for (int a = 0; a < 2; ++a)
#pragma unroll
            for (int b = 0; b < 2; ++b)
#pragma unroll
                for (int m = 0; m < 4; ++m)
#pragma unroll
                    for (int n = 0; n < 2; ++n) acc[a][b][m][n] = (f32x4){0.f, 0.f, 0.f, 0.f};
        cur = nxt; cA = nA; cB = nB; ++ui;
        if (GATHER) { PG8_VOA(voA, cur); }
        if (wr == 1) PG8_BAR;
    }
    PG8_WAIT_V(0);
    PG8_BAR;
#undef PG8_SA
#undef PG8_SB
#undef PG8_STAGE
#undef PG8_LDA
#undef PG8_LDA_BF
#undef PG8_LDA8
#undef PG8_LD8
#undef PG8_LDB
#undef PG8_LDB_BF
#undef PG8_LDB8
#undef PG8_MMA
#undef PG8_MMA_BF
#undef PG8_MMA_F8
#undef PG8_WAIT_V
#undef PG8_WAIT_L
#undef PG8_BAR
#undef PG8_SCHED
#undef PG8_VOA
}

typedef const f32x4 (&AccRef)[2][2][4][2];
#define EPI_ROWS for (int ai = 0; ai < 2; ++ai) _Pragma("unroll") for (int m = 0; m < 4; ++m)

template <int XMODE> struct EpiInProjT {
    static constexpr bool PERM = true;
    bf16_t *Q, *Kb, *V, *U, *SGA, *SGB; float* KM2;
    __device__ __forceinline__ void operator()(AccRef acc, const Unit& u, int wr, int wc, int fr, int fq) const {
        bf16_t* dst; int ld, colt; bool sig = false; float sc = 1.f;
        if (u.pn < 2) { dst = Q; ld = AW; colt = u.pn * 256; sc = QSCALE; }
        else if (u.pn < 4) { dst = Kb; ld = AW; colt = (u.pn - 2) * 256; }
        else if (u.pn < 6) { dst = V; ld = AW; colt = (u.pn - 4) * 256; }
        else if (u.pn < 8) { dst = U; ld = AW; colt = (u.pn - 6) * 256; }
        else if (u.pn < 12) { dst = SGA; ld = DM; colt = (u.pn - 8) * 256; sig = true; }
        else { dst = SGB; ld = DM; colt = (u.pn - 12) * 256; sig = true; }
        const int row0 = u.pm * BM + wr * 64 + fr, col0 = colt + wc * 32 + 8 * fq;
        const bool isk = (u.pn == 2 || u.pn == 3); f32x4 cs[2][2];
#pragma unroll
        for (int bj = 0; bj < 2; ++bj)
#pragma unroll
            for (int n = 0; n < 2; ++n) cs[bj][n] = (f32x4){0.f, 0.f, 0.f, 0.f};
#pragma unroll
        EPI_ROWS { const int row = row0 + ai * HALF + m * 16; const float rs = sc; bf16_t* rowp = dst + (size_t)row * ld + col0;
#pragma unroll
            for (int bj = 0; bj < 2; ++bj) { f32x4 v0 = acc[ai][bj][m][0] * rs, v1 = acc[ai][bj][m][1] * rs;
                cs[bj][0] += v0; cs[bj][1] += v1;
                if (sig) {
                    unsigned q[8];
#pragma unroll
                    for (int e = 0; e < 4; ++e) { q[e] = (unsigned)(fsigmoid(v0[e]) * 255.0f + 0.5f); q[4 + e] = (unsigned)(fsigmoid(v1[e]) * 255.0f + 0.5f); }
                    const unsigned g0 = q[0] | (q[1] << 8) | (q[2] << 16) | (q[3] << 24), g1 = q[4] | (q[5] << 8) | (q[6] << 16) | (q[7] << 24);
                    if (XMODE != 1) *(u32x2*)((unsigned char*)dst + (size_t)row * ld + col0 + bj * HALF) = (u32x2){g0, g1};
                    continue; }
                u32x4 w; w.x = cvt_pk_bf16(v0[0], v0[1]); w.y = cvt_pk_bf16(v0[2], v0[3]); w.z = cvt_pk_bf16(v1[0], v1[1]); w.w = cvt_pk_bf16(v1[2], v1[3]);
                if (XMODE == 1) { asm volatile("" :: "v"(w)); } else st16(rowp + bj * HALF, w); } }
        if (isk && XMODE == 0) {
#pragma unroll
            for (int bj = 0; bj < 2; ++bj)
#pragma unroll
                for (int n = 0; n < 2; ++n)
#pragma unroll
                    for (int e = 0; e < 4; ++e) { float v = cs[bj][n][e]; v += __shfl_xor(v, 1); v += __shfl_xor(v, 2); v += __shfl_xor(v, 4); v += __shfl_xor(v, 8); cs[bj][n][e] = v; }
            if (fr == 0) { const int b = u.pm / NBLK, j = u.pm % NBLK;
#pragma unroll
                for (int bj = 0; bj < 2; ++bj) { const int col = colt + bj * HALF + wc * 32 + 8 * fq, h = col >> 6, d = col & 63;
                    float* kp = KM2 + ((((size_t)wr * NB + b) * NH + h) * NBLK + j) * HD + d;
                    *(f32x4*)kp = cs[bj][0] * (1.0f / MBLK); *(f32x4*)(kp + 4) = cs[bj][1] * (1.0f / MBLK); } } }
    }
};
struct EpiNull {
    static constexpr bool PERM = true;
    __device__ __forceinline__ void operator()(AccRef acc, const Unit& u, int wr, int wc, int fr, int fq) const {
#pragma unroll
        EPI_ROWS {
#pragma unroll
            for (int bj = 0; bj < 2; ++bj) { asm volatile("" :: "v"(acc[ai][bj][m][0]), "v"(acc[ai][bj][m][1])); } }
    }
};
typedef EpiInProjT<0> EpiInProj;
template <bool FULL> struct EpiStoreExp {
    static constexpr bool PERM = true;
    bf16_t* O;
    __device__ __forceinline__ void operator()(AccRef acc, const Unit& u, int wr, int wc, int fr, int fq) const {
        const int row0 = u.pm * BM + wr * 64 + (FULL ? (fr & 7) : fr), col0 = (u.pn & 3) * BM + (FULL ? (wc * 64 + (fr >> 3) * 32 + 8 * fq) : (wc * 32 + 8 * fq));
#pragma unroll
        EPI_ROWS { bf16_t* rowp = O + (size_t)(row0 + ai * HALF + m * 16) * DM + col0;
#pragma unroll
            for (int bj = 0; bj < 2; ++bj) { const f32x4 v0 = acc[ai][bj][m][0], v1 = acc[ai][bj][m][1];
                u32x4 w; w.x = cvt_pk_bf16(v0[0], v0[1]); w.y = cvt_pk_bf16(v0[2], v0[3]); w.z = cvt_pk_bf16(v1[0], v1[1]); w.w = cvt_pk_bf16(v1[2], v1[3]);
                st16(rowp + (FULL ? (size_t)bj * 8 * DM : (size_t)bj * HALF), w); } }
    }
};
struct EpiStore {
    static constexpr bool PERM = true;
    bf16_t* O; int ld;
    __device__ __forceinline__ void operator()(AccRef acc, const Unit& u, int wr, int wc, int fr, int fq) const {
        const int row0 = u.pm * BM + wr * 64 + fr, col0 = u.pn * BM + wc * 32 + 8 * fq;
#pragma unroll
        EPI_ROWS { bf16_t* rowp = O + (size_t)(row0 + ai * HALF + m * 16) * ld + col0;
#pragma unroll
            for (int bj = 0; bj < 2; ++bj) { const f32x4 v0 = acc[ai][bj][m][0], v1 = acc[ai][bj][m][1];
                u32x4 w; w.x = cvt_pk_bf16(v0[0], v0[1]); w.y = cvt_pk_bf16(v0[2], v0[3]); w.z = cvt_pk_bf16(v1[0], v1[1]); w.w = cvt_pk_bf16(v1[2], v1[3]);
                st16(rowp + bj * HALF, w); } }
    }
};
struct EpiMemKV {
    static constexpr bool PERM = true;
    bf16_t* O; bf16_t* VT;
    __device__ __forceinline__ void operator()(AccRef acc, const Unit& u, int wr, int wc, int fr, int fq) const {
        const int rl0 = wr * 64 + fr, col0 = u.pn * BM + wc * 32 + 8 * fq;
#pragma unroll
        EPI_ROWS { const int rl = rl0 + ai * HALF + m * 16;
#pragma unroll
            for (int bj = 0; bj < 2; ++bj) { const f32x4 v0 = acc[ai][bj][m][0], v1 = acc[ai][bj][m][1]; const int col = col0 + bj * HALF;
                if (u.pn < 2) { u32x4 w; w.x = cvt_pk_bf16(v0[0], v0[1]); w.y = cvt_pk_bf16(v0[2], v0[3]); w.z = cvt_pk_bf16(v1[0], v1[1]); w.w = cvt_pk_bf16(v1[2], v1[3]);
                    st16(O + (size_t)(u.pm * BM + rl) * (2 * XW) + col, w); }
                else { bf16_t* vp = VT + ((size_t)u.pm * XW + (col - XW)) * MEML + rl;
#pragma unroll
                    for (int e = 0; e < 4; ++e) { vp[(size_t)e * MEML] = (bf16_t)f2bf(v0[e]); vp[(size_t)(4 + e) * MEML] = (bf16_t)f2bf(v1[e]); } } } }
    }
};
struct EpiGlu {
    static constexpr bool PERM = true;
    const bf16_t* SGB; bf16_t* O;
    __device__ __forceinline__ void operator()(AccRef acc, const Unit& u, int wr, int wc, int fr, int fq) const {
        const int row0 = u.pm * BM + wr * 64 + fr, col0 = u.pn * HALF + wc * 32 + 8 * fq;
#pragma unroll
        EPI_ROWS { const size_t off = (size_t)(row0 + ai * HALF + m * 16) * DM + col0; const u32x2 s = *(const u32x2*)((const unsigned char*)SGB + off);
            const f32x4 v0 = acc[ai][0][m][0], v1 = acc[ai][0][m][1], g0 = acc[ai][1][m][0], g1 = acc[ai][1][m][1];
            float o[8];
#pragma unroll
            for (int e = 0; e < 4; ++e) { o[e] = v0[e] * fsigmoid(g0[e]); o[4 + e] = v1[e] * fsigmoid(g1[e]); }
            o[0] *= ub0(s.x); o[1] *= ub1(s.x); o[2] *= ub2(s.x); o[3] *= ub3(s.x); o[4] *= ub0(s.y); o[5] *= ub1(s.y); o[6] *= ub2(s.y); o[7] *= ub3(s.y);
            u32x4 w; w.x = cvt_pk_bf16(o[0], o[1]); w.y = cvt_pk_bf16(o[2], o[3]); w.z = cvt_pk_bf16(o[4], o[5]); w.w = cvt_pk_bf16(o[6], o[7]);
            st16(O + off, w); }
    }
};
struct EpiMerge {
    static constexpr bool PERM = true;
    const bf16_t* SGA; const bf16_t* Y2; bf16_t* O;
    __device__ __forceinline__ void operator()(AccRef acc, const Unit& u, int wr, int wc, int fr, int fq) const {
        const int row0 = u.pm * BM + wr * 64 + fr, col0 = u.pn * BM + wc * 32 + 8 * fq;
#pragma unroll
        EPI_ROWS {
#pragma unroll
            for (int bj = 0; bj < 2; ++bj) { const size_t off = (size_t)(row0 + ai * HALF + m * 16) * DM + col0 + bj * HALF;
                const u32x2 s = *(const u32x2*)((const unsigned char*)SGA + off); const u32x4 y = *(const u32x4*)(Y2 + off); const f32x4 v0 = acc[ai][bj][m][0], v1 = acc[ai][bj][m][1];
                u32x4 w; w.x = cvt_pk_bf16(ub0(s.x) * v0[0] + bflo(y.x), ub1(s.x) * v0[1] + bfhi(y.x)); w.y = cvt_pk_bf16(ub2(s.x) * v0[2] + bflo(y.y), ub3(s.x) * v0[3] + bfhi(y.y));
                w.z = cvt_pk_bf16(ub0(s.y) * v1[0] + bflo(y.z), ub1(s.y) * v1[1] + bfhi(y.z)); w.w = cvt_pk_bf16(ub2(s.y) * v1[2] + bflo(y.w), ub3(s.y) * v1[3] + bfhi(y.w));
                st16(O + off, w); } }
    }
};
template <bool XBASE> struct EpiResidT {
    static constexpr bool PERM = true;
    const float* base; bf16_t* HB; float* SSQ;
    __device__ __forceinline__ void operator()(AccRef acc, const Unit& u, int wr, int wc, int fr, int fq) const {
        const int row0 = u.pm * BM + wr * 64 + fr, col0 = u.pn * BM + wc * 32 + 8 * fq;
#pragma unroll
        EPI_ROWS { const int row = row0 + ai * HALF + m * 16; const size_t off = (size_t)row * DM + col0; float ss = 0.f;
#pragma unroll
            for (int bj = 0; bj < 2; ++bj) { const size_t o2 = off + bj * HALF; f32x4 h0, h1;
                if (XBASE) { h0 = *(const f32x4*)(base + o2) + acc[ai][bj][m][0]; h1 = *(const f32x4*)(base + o2 + 4) + acc[ai][bj][m][1]; }
                else { const u32x4 w = *(const u32x4*)(HB + o2); h0 = (f32x4){bflo(w.x), bfhi(w.x), bflo(w.y), bfhi(w.y)} + acc[ai][bj][m][0]; h1 = (f32x4){bflo(w.z), bfhi(w.z), bflo(w.w), bfhi(w.w)} + acc[ai][bj][m][1]; }
                u32x4 o; o.x = cvt_pk_bf16(h0[0], h0[1]); o.y = cvt_pk_bf16(h0[2], h0[3]); o.z = cvt_pk_bf16(h1[0], h1[1]); o.w = cvt_pk_bf16(h1[2], h1[3]); st16(HB + o2, o);
                if (XBASE) ss += ((h0[0] * h0[0] + h0[1] * h0[1]) + (h0[2] * h0[2] + h0[3] * h0[3])) + ((h1[0] * h1[0] + h1[1] * h1[1]) + (h1[2] * h1[2] + h1[3] * h1[3])); }
            if (XBASE) { ss += __shfl_xor(ss, 16); ss += __shfl_xor(ss, 32); if (fq == 0) SSQ[(size_t)row * 16 + u.pn * 4 + wc] = ss; } }
    }
};
struct EpiXq {
    static constexpr bool PERM = true;
    const float* SSQ; bf16_t* O;
    __device__ __forceinline__ void operator()(AccRef acc, const Unit& u, int wr, int wc, int fr, int fq) const {
        const int row0 = u.pm * BM + wr * 64 + fr, col0 = u.pn * BM + wc * 32 + 8 * fq;
#pragma unroll
        EPI_ROWS { const int row = row0 + ai * HALF + m * 16; const f32x4* sp = (const f32x4*)(SSQ + (size_t)row * 16);
            const f32x4 a = sp[0] + sp[1] + sp[2] + sp[3]; const float rs = __builtin_amdgcn_rsqf(((a[0] + a[1]) + (a[2] + a[3])) * (1.0f / DM) + RMS_EPS) * XSCALE;
            bf16_t* rowp = O + (size_t)row * XW + col0;
#pragma unroll
            for (int bj = 0; bj < 2; ++bj) { const f32x4 v0 = acc[ai][bj][m][0] * rs, v1 = acc[ai][bj][m][1] * rs;
                u32x4 w; w.x = cvt_pk_bf16(v0[0], v0[1]); w.y = cvt_pk_bf16(v0[2], v0[3]); w.z = cvt_pk_bf16(v1[0], v1[1]); w.w = cvt_pk_bf16(v1[2], v1[3]);
                st16(rowp + bj * HALF, w); } }
    }
};
struct EpiMoe1 {
    static constexpr bool PERM = true;
    const float* bgu; bf16_t* HID;
    __device__ __forceinline__ void operator()(AccRef acc, const Unit& u, int wr, int wc, int fr, int fq) const {
        const int rl0 = wr * 64 + fr, col0 = u.pn * HALF + wc * 32 + 8 * fq; const float* bg = bgu + (size_t)u.e * (2 * DFF) + col0;
        const f32x4 bg0 = *(const f32x4*)(bg), bg1 = *(const f32x4*)(bg + 4), bu0 = *(const f32x4*)(bg + DFF), bu1 = *(const f32x4*)(bg + DFF + 4);
#pragma unroll
        EPI_ROWS { const int rl = rl0 + ai * HALF + m * 16;
            const f32x4 g0 = acc[ai][0][m][0] + bg0, g1 = acc[ai][0][m][1] + bg1, p0 = acc[ai][1][m][0] + bu0, p1 = acc[ai][1][m][1] + bu1;
            float o[8];
#pragma unroll
            for (int e = 0; e < 4; ++e) { const float ga = fminf(g0[e], 7.0f), gb = fminf(g1[e], 7.0f), ua = fminf(fmaxf(p0[e], -7.0f), 7.0f), ub = fminf(fmaxf(p1[e], -7.0f), 7.0f);
                o[e] = (ua + 1.0f) * ga * fsigmoid(1.702f * ga); o[4 + e] = (ub + 1.0f) * gb * fsigmoid(1.702f * gb); }
            if (MOE2_FP8) { int w0 = 0, w1 = 0;
                w0 = __builtin_amdgcn_cvt_pk_fp8_f32(o[0], o[1], w0, false); w0 = __builtin_amdgcn_cvt_pk_fp8_f32(o[2], o[3], w0, true); w1 = __builtin_amdgcn_cvt_pk_fp8_f32(o[4], o[5], w1, false); w1 = __builtin_amdgcn_cvt_pk_fp8_f32(o[6], o[7], w1, true);
                *(u32x2*)((unsigned char*)HID + (size_t)(u.pm * BM + rl) * DFF + col0) = (u32x2){(unsigned)w0, (unsigned)w1}; }
            else { u32x4 w; w.x = cvt_pk_bf16(o[0], o[1]); w.y = cvt_pk_bf16(o[2], o[3]); w.z = cvt_pk_bf16(o[4], o[5]); w.w = cvt_pk_bf16(o[6], o[7]);
                st16(HID + (size_t)(u.pm * BM + rl) * DFF + col0, w); } }
    }
};
struct EpiMoe2 {
    static constexpr bool PERM = true;
    const float* bdn; const LAS int* tabD; const LAS float* tabG; bf16_t* Y;
    __device__ __forceinline__ void operator()(AccRef acc, const Unit& u, int wr, int wc, int fr, int fq) const {
        const int rl0 = wr * 64 + fr, col0 = u.pn * BM + wc * 32 + 8 * fq; const float* bd = bdn + (size_t)u.e * DM + col0;
        f32x4 bv[2][2];
#pragma unroll
        for (int bj = 0; bj < 2; ++bj)
#pragma unroll
            for (int n = 0; n < 2; ++n) bv[bj][n] = *(const f32x4*)(bd + bj * HALF + 4 * n);
#pragma unroll
        EPI_ROWS { const int rl = rl0 + ai * HALF + m * 16; const int dest = tabD[u.ui * 256 + rl];
            if (dest >= 0) { const float gt = tabG[u.ui * 256 + rl]; bf16_t* rowp = Y + (size_t)(u.pm * BM + rl) * DM + col0;
#pragma unroll
                for (int bj = 0; bj < 2; ++bj) { const f32x4 v0 = (acc[ai][bj][m][0] + bv[bj][0]) * gt, v1 = (acc[ai][bj][m][1] + bv[bj][1]) * gt;
                    if (Y_FP8) { const float ys = (float)(1 << Y_SHIFT); int w0 = 0, w1 = 0;
                        w0 = __builtin_amdgcn_cvt_pk_fp8_f32(v0[0] * ys, v0[1] * ys, w0, false); w0 = __builtin_amdgcn_cvt_pk_fp8_f32(v0[2] * ys, v0[3] * ys, w0, true);
                        w1 = __builtin_amdgcn_cvt_pk_fp8_f32(v1[0] * ys, v1[1] * ys, w1, false); w1 = __builtin_amdgcn_cvt_pk_fp8_f32(v1[2] * ys, v1[3] * ys, w1, true);
                        *(u32x2*)((unsigned char*)Y + (size_t)(u.pm * BM + rl) * DM + col0 + bj * HALF) = (u32x2){(unsigned)w0, (unsigned)w1}; }
                    else { u32x4 w; w.x = cvt_pk_bf16(v0[0], v0[1]); w.y = cvt_pk_bf16(v0[2], v0[3]); w.z = cvt_pk_bf16(v1[0], v1[1]); w.w = cvt_pk_bf16(v1[2], v1[3]);
                        st16(rowp + bj * HALF, w); } } } }
    }
};
}

struct MoeOrder {
    pg8::PatchOrder P; const LAS int* pref; int rev;
    __device__ __forceinline__ bool next(int i, pg8::Unit& u) const {
        if (!P.next(i, u)) return false;
        if (rev) u.pm = P.nM - 1 - u.pm;
        int e = 0;
#pragma unroll 1
        for (int k = 1; k < NE; ++k) e += (pref[k] <= u.pm) ? 1 : 0;
        u.e = e; u.mi = u.pm - pref[e]; return true;
    }
};

namespace attn_body {
using bf16=__hip_bfloat16;
using bf16x8=__attribute__((ext_vector_type(8)))short;
using s16x4=__attribute__((ext_vector_type(4)))short;
using f32x16=__attribute__((ext_vector_type(16)))float;
using u32x4=__attribute__((ext_vector_type(4)))unsigned;
constexpr int BATCH=4,NHEAD=8,SEQ=8192,D=64,DM=NHEAD*D;
constexpr int NW=8,QBLK=32,QB=QBLK*NW,KVBLK=64,NQB=SEQ/QB;
constexpr int ATTN_PITCH=DM, ATTN_UNIT_ROWS=QB;
__device__ __forceinline__ int crow(int r,int hi){return (r&3)+8*(r>>2)+4*hi;}
#define SBAR() __builtin_amdgcn_sched_barrier(0)
__device__ __forceinline__ void cmask(f32x16&p0,f32x16&p1,int jb,int qrel,int hi){
  const float NEG=-INFINITY; int kb=64*jb+4*hi;
  #pragma unroll
  for(int r=0;r<16;++r){int kv=kb+(r&3)+8*(r>>2); if(kv>qrel)p0[r]=NEG; if(kv+32>qrel)p1[r]=NEG;}
}

constexpr int NSLOT=4, SLOTB=8192;
constexpr int LDS_K=0, LDS_V=NSLOT*SLOTB, LDS_WS=2*NSLOT*SLOTB, LDS_OST=LDS_WS+NW*64*4, LDS_KM=LDS_OST+NW*4096, LDS_SEL=LDS_KM+32*64*4, LDS_DST=LDS_SEL+1024, LDS_BYTES=LDS_DST+1024;
constexpr float C2=0.125f*1.4426950408889634f;
__device__ __forceinline__ void glds16(const void*gsrc,unsigned lds_dst){unsigned keep;
  asm volatile("s_mov_b32 %0, m0\n\ts_mov_b32 m0, %2\n\ts_nop 0\n\tglobal_load_lds_dwordx4 %1, off\n\ts_mov_b32 m0, %0":"=&s"(keep):"v"(gsrc),"s"(lds_dst):"memory");}
__device__ __forceinline__ float max3f(float a,float b,float c){float r;asm("v_max3_f32 %0, %1, %2, %3":"=v"(r):"v"(a),"v"(b),"v"(c));return r;}
__device__ __forceinline__ float max2f(float a,float b){float r;asm("v_max_f32_e32 %0, %1, %2":"=v"(r):"v"(a),"v"(b));return r;}
__device__ __forceinline__ float fadd_s(float a,float b){float r;asm("v_add_f32_e32 %0, %1, %2":"=v"(r):"v"(a),"v"(b));return r;}
__device__ __forceinline__ float fsub_s(float a,float b){float r;asm("v_sub_f32_e32 %0, %1, %2":"=v"(r):"v"(a),"v"(b));return r;}
typedef float f32x2_t __attribute__((ext_vector_type(2))); typedef __bf16 bf16x2_t __attribute__((ext_vector_type(2)));
__device__ __forceinline__ unsigned cvtpk_s(float lo,float hi){f32x2_t v={lo,hi};bf16x2_t b=__builtin_convertvector(v,bf16x2_t);return __builtin_bit_cast(unsigned,b);}
#define WAIT_BAR(N) asm volatile("s_waitcnt vmcnt(" #N ") lgkmcnt(0)\n\ts_barrier":::"memory")

__device__ __forceinline__ void qkt(f32x16&p0,f32x16&p1,const char*Kslot,const bf16x8*qr,const f32x16&negm,int r32,int hi){
  const char*kb=Kslot+hi*1024+r32*16;
  #pragma unroll
  for(int d0=0;d0<4;++d0){
    const bf16x8 b0=*reinterpret_cast<const bf16x8*>(kb+d0*2048);
    const bf16x8 b1=*reinterpret_cast<const bf16x8*>(kb+d0*2048+512);
    if(d0==0){p0=__builtin_amdgcn_mfma_f32_32x32x16_bf16(b0,qr[0],negm,0,0,0);p1=__builtin_amdgcn_mfma_f32_32x32x16_bf16(b1,qr[0],negm,0,0,0);}
    else{p0=__builtin_amdgcn_mfma_f32_32x32x16_bf16(b0,qr[d0],p0,0,0,0);p1=__builtin_amdgcn_mfma_f32_32x32x16_bf16(b1,qr[d0],p1,0,0,0);}}
}
typedef __attribute__((address_space(3))) const char* lds_cptr;
typedef short v4i16_t __attribute__((ext_vector_type(4)));
__device__ __forceinline__ void kload8(bf16x8*kf,lds_cptr kp){
  kf[0]=*(const __attribute__((address_space(3))) bf16x8*)(kp);      kf[1]=*(const __attribute__((address_space(3))) bf16x8*)(kp+512);
  kf[2]=*(const __attribute__((address_space(3))) bf16x8*)(kp+2048); kf[3]=*(const __attribute__((address_space(3))) bf16x8*)(kp+2560);
  kf[4]=*(const __attribute__((address_space(3))) bf16x8*)(kp+4096); kf[5]=*(const __attribute__((address_space(3))) bf16x8*)(kp+4608);
  kf[6]=*(const __attribute__((address_space(3))) bf16x8*)(kp+6144); kf[7]=*(const __attribute__((address_space(3))) bf16x8*)(kp+6656);
}
__device__ __forceinline__ void kload2(bf16x8*kf,lds_cptr kp,int j){ kf[2*j]=*(const __attribute__((address_space(3))) bf16x8*)(kp+j*2048); kf[2*j+1]=*(const __attribute__((address_space(3))) bf16x8*)(kp+j*2048+512); }
__device__ __forceinline__ s16x4 vtr(lds_cptr p){ return __builtin_bit_cast(s16x4,__builtin_amdgcn_ds_read_tr16_b64_v4i16((__attribute__((address_space(3))) v4i16_t*)p)); }
__device__ __forceinline__ float rowmax(const f32x16&p0,const f32x16&p1){
  float a=max3f(p0[0],p0[1],p1[0]),b=max3f(p0[2],p0[3],p1[1]);a=max3f(a,p1[2],p1[3]);
  #pragma unroll
  for(int r=4;r<16;r+=4){a=max3f(a,p0[r],p0[r+1]);b=max3f(b,p0[r+2],p0[r+3]);a=max3f(a,p1[r],p1[r+1]);b=max3f(b,p1[r+2],p1[r+3]);}
  const float m=max2f(a,b);
  auto rr=__builtin_amdgcn_permlane32_swap(__float_as_uint(m),__float_as_uint(m),false,false);
  return max2f(__uint_as_float(rr[0]),__uint_as_float(rr[1]));
}
__device__ __forceinline__ void pv(f32x16*o,int vb,bf16x8 pa0,bf16x8 pa1,bf16x8 pa2,bf16x8 pa3){
  #pragma unroll
  for(int d0=0;d0<2;++d0){s16x4 lo[4],hi[4];
    #pragma unroll
    for(int ks=0;ks<4;++ks){
      asm volatile("ds_read_b64_tr_b16 %0,%1 offset:%c2":"=&v"(lo[ks]):"v"(vb),"i"(d0*4096+ks*1024):"memory");
      asm volatile("ds_read_b64_tr_b16 %0,%1 offset:%c2":"=&v"(hi[ks]):"v"(vb),"i"(d0*4096+ks*1024+512):"memory");}
    asm volatile("s_waitcnt lgkmcnt(0)":::"memory");SBAR();
    #define PK(k) (bf16x8){lo[k][0],lo[k][1],lo[k][2],lo[k][3],hi[k][0],hi[k][1],hi[k][2],hi[k][3]}
    o[d0]=__builtin_amdgcn_mfma_f32_32x32x16_bf16(pa0,PK(0),o[d0],0,0,0);
    o[d0]=__builtin_amdgcn_mfma_f32_32x32x16_bf16(pa1,PK(1),o[d0],0,0,0);
    o[d0]=__builtin_amdgcn_mfma_f32_32x32x16_bf16(pa2,PK(2),o[d0],0,0,0);
    o[d0]=__builtin_amdgcn_mfma_f32_32x32x16_bf16(pa3,PK(3),o[d0],0,0,0);
    #undef PK
  }
}

#ifndef ATTN_STORE16
#define ATTN_STORE16(p,v) (*(u32x4*)(p)=(v))
#endif
template<int THRL> __device__ __forceinline__ void attn_unit(int b,int h,int qb,const bf16*Q,const bf16*__restrict__ K,const bf16*__restrict__ V,bf16*O,char*shm){
  const int tid=threadIdx.x,lane=tid&63,r32=lane&31,hi=lane>>5; const int wid=__builtin_amdgcn_readfirstlane(tid>>6);
  const long rowbase=(long)b*SEQ; const int q0=qb*QB;
  const bf16*Qw=Q+(rowbase+q0+wid*QBLK)*DM+h*D;
  const bf16*Kh=K+rowbase*DM+h*D,*Vh=V+rowbase*DM+h*D;
  const unsigned lds0=(unsigned)(uintptr_t)shm;
  float*wsf=(float*)(shm+LDS_WS)+wid*64;
  const bf16*ksrc=Kh+(long)lane*DM+wid*8;
  const bf16*vsrc=Vh+(long)(16*(wid&3)+(lane>>2))*DM+(wid>>2)*32+(lane&3)*8;
  const unsigned kdst=lds0+LDS_K+wid*1024, vdst=lds0+LDS_V+wid*1024;
  #define DMA_K(t,slot) glds16(ksrc+(long)(t)*KVBLK*DM,(unsigned)__builtin_amdgcn_readfirstlane(kdst+(slot)))
  #define DMA_V(t,slot) glds16(vsrc+(long)(t)*KVBLK*DM,(unsigned)__builtin_amdgcn_readfirstlane(vdst+(slot)))
  const int vb0=(int)(lds0+LDS_V)+((lane>>4)&1)*32+(lane&3)*8+(4*hi+((lane&15)>>2))*64;
  const char*Kbase=shm+LDS_K; bf16x8 kf[8];
  const lds_cptr shm3=(lds_cptr)shm; const lds_cptr kp0=shm3+LDS_K+hi*1024+r32*16; const lds_cptr vp0=shm3+LDS_V+((lane>>4)&1)*32+(lane&3)*8+(4*hi+((lane&15)>>2))*64;
  const int NT=(q0+QB)/KVBLK;
  DMA_K(0,0);DMA_V(0,0);DMA_K(1,SLOTB);
  bf16x8 qr[4];
  #pragma unroll
  for(int d0=0;d0<4;++d0)qr[d0]=*reinterpret_cast<const bf16x8*>(&Qw[(long)r32*DM+d0*16+hi*8]);
  { int lp_=lane; asm volatile("":"+v"(lp_)); const int r32p=lp_&31, hip=lp_>>5;
    unsigned sel=0u; const __attribute__((address_space(3))) float*km=(const __attribute__((address_space(3))) float*)((__attribute__((address_space(3))) const char*)shm+LDS_KM); float g0=-3e38f,g1=-3e38f,g2=-3e38f; int s0=-1,s1=-1,s2=-1;
    for(int j=0;j<qb;++j){ float g=0.f;
      #pragma unroll
      for(int d0=0;d0<4;++d0){
        #pragma unroll
        for(int e=0;e<8;++e)g+=__builtin_bit_cast(float,((unsigned)(unsigned short)qr[d0][e])<<16)*km[j*64+16*d0+8*hip+e];}
      g+=__shfl_xor(g,32);
      if(g>g0){g2=g1;s2=s1;g1=g0;s1=s0;g0=g;s0=j;}else if(g>g1){g2=g1;s2=s1;g1=g;s1=j;}else if(g>g2){g2=g;s2=j;} }
    if(s0>=0)sel|=1u<<s0; if(s1>=0)sel|=1u<<s1; if(s2>=0)sel|=1u<<s2;
    if(hip==0)((__attribute__((address_space(3))) unsigned*)((__attribute__((address_space(3))) char*)shm+LDS_SEL))[wid*32+r32p]=sel; asm volatile("s_waitcnt lgkmcnt(0)":::"memory"); }
  float mhat=0.f,l_reg=0.f;f32x16 o[2];o[0]=f32x16{};o[1]=f32x16{};f32x16 negm=f32x16{};asm volatile("":"+v"(negm));
  const int qrel=wid*QBLK+r32;
  #define BMASK(P0,P1,t) do{}while(0)
  #define CMASK(P0,P1,t) do{int jb_=(t)-(NT-4); if(jb_>=0)cmask(P0,P1,jb_,qrel,hi); else BMASK(P0,P1,t);}while(0)
  bool resc=false;
  #define START(P0,P1) do{ const float rm=rowmax(P0,P1); resc=false; \
    { const float dl=__builtin_fmaxf(rm,-64.f); mhat=fadd_s(mhat,dl); \
      _Pragma("unroll") for(int r=0;r<16;++r){P0[r]=fsub_s(P0[r],dl);P1[r]=fsub_s(P1[r],dl);} \
      _Pragma("unroll") for(int r=0;r<16;++r)negm[r]=-mhat; asm volatile("":"+v"(negm)); } \
    _Pragma("unroll") for(int r=0;r<16;++r)P0[r]=__builtin_amdgcn_exp2f(P0[r]); }while(0)
  #define RESC() do{ if(resc){ asm volatile("s_waitcnt lgkmcnt(0)":::"memory"); \
      _Pragma("unroll") for(int d_=0;d_<2;++d_) _Pragma("unroll") for(int r=0;r<16;++r)o[d_][r]*=wsf[crow(r,hi)]; } }while(0)
  f32x16 pA0,pA1,pB0,pB1;
  int sl_prev=0,sl_cur=0,sl_next=SLOTB;
  #define ROT() do{sl_prev=sl_cur;sl_cur=sl_next;sl_next=(sl_next==(NSLOT-1)*SLOTB)?0:sl_next+SLOTB;}while(0)
  DMA_K(2,2*SLOTB);
  WAIT_BAR(3);
  qkt(pA0,pA1,Kbase,qr,negm,r32,hi);asm volatile("s_nop 15\n\ts_nop 7":"+v"(pA0),"+v"(pA1));CMASK(pA0,pA1,0);
  START(pA0,pA1);
  _Pragma("unroll") for(int r=0;r<16;++r)pA1[r]=__builtin_amdgcn_exp2f(pA1[r]);
  WAIT_BAR(0);
  DMA_K(3,0);DMA_V(1,SLOTB);
  ROT();
  kload8(kf,kp0+sl_cur);
  WAIT_BAR(2);
  s16x4 vlo[8],vhi[8]; u32x4 pw0,pw1,pw2,pw3;
  #define PKW(P,B) (keep_?cvtpk_s(P[B],P[B+1]):0u)
  #define PAF(k) __builtin_bit_cast(bf16x8,pw##k)
  #define VFR(i) (bf16x8){vlo[i][0],vlo[i][1],vlo[i][2],vlo[i][3],vhi[i][0],vhi[i][1],vhi[i][2],vhi[i][3]}
  #define PIN(x) asm volatile("":"+v"(x))
  #define MX3(a,b,c) __builtin_fmaxf(__builtin_fmaxf((a),(b)),(c))
  #define GAPA(MF,A0,A1,A2,A3,W0,W1,PW) do{ MF; sacc+=A0; sacc+=A1; sacc+=A2; sacc+=A3; PIN(sacc); W0; W1; PIN(PW); SBAR(); }while(0)
  #define EX(v) __builtin_amdgcn_exp2f(v)
  #define GAPB(MF,X,B) do{ MF; X[B]=EX(X[B]); X[B+1]=EX(X[B+1]); X[B+2]=EX(X[B+2]); X[B+3]=EX(X[B+3]); PIN(X); SBAR(); }while(0)
  #define VRD(i) do{ vlo[i]=vtr(vp_+(((i)>>2)*4096+((i)&3)*1024)); vhi[i]=vtr(vp_+(((i)>>2)*4096+((i)&3)*1024+512)); }while(0)
  #define KRD(G,j) do{ if(G){ kload2(kf,kp0+sl_next,j); SBAR(); } }while(0)
  #define STEP(C0,C1,P0,P1,t,GK,GV,GL) do{ SBAR(); \
    int q_=qrel; asm volatile("":"+v"(q_)); const unsigned selw_=((const volatile __attribute__((address_space(3))) unsigned*)((__attribute__((address_space(3))) const char*)shm+LDS_SEL))[q_]; \
    const bool keep_=((t)-1>=NT-4)||((selw_>>(((t)-1)>>2))&1u); \
    const lds_cptr vp_=vp0+sl_prev; \
    VRD(0); SBAR(); float sacc=(P0[0]+P0[1]); \
    GAPA(C0=__builtin_amdgcn_mfma_f32_32x32x16_bf16(kf[0],qr[0],negm,0,0,0), P0[2],P0[3],P0[4],P0[5],     pw0[0]=PKW(P0,0), pw0[1]=PKW(P0,2), pw0); \
    VRD(4); SBAR(); GAPA(C1=__builtin_amdgcn_mfma_f32_32x32x16_bf16(kf[1],qr[0],negm,0,0,0), P0[6],P0[7],P0[8],P0[9],     pw0[2]=PKW(P0,4), pw0[3]=PKW(P0,6), pw0); \
    VRD(1); SBAR(); GAPA(C0=__builtin_amdgcn_mfma_f32_32x32x16_bf16(kf[2],qr[1],C0,0,0,0),   P0[10],P0[11],P0[12],P0[13], pw1[0]=PKW(P0,8), pw1[1]=PKW(P0,10), pw1); \
    VRD(5); SBAR(); GAPA(C1=__builtin_amdgcn_mfma_f32_32x32x16_bf16(kf[3],qr[1],C1,0,0,0),   P0[14],P0[15],P1[0],P1[1],   pw1[2]=PKW(P0,12),pw1[3]=PKW(P0,14), pw1); \
    VRD(2); SBAR(); GAPA(C0=__builtin_amdgcn_mfma_f32_32x32x16_bf16(kf[4],qr[2],C0,0,0,0),   P1[2],P1[3],P1[4],P1[5],     pw2[0]=PKW(P1,0), pw2[1]=PKW(P1,2), pw2); \
    VRD(6); SBAR(); GAPA(C1=__builtin_amdgcn_mfma_f32_32x32x16_bf16(kf[5],qr[2],C1,0,0,0),   P1[6],P1[7],P1[8],P1[9],     pw2[2]=PKW(P1,4), pw2[3]=PKW(P1,6), pw2); \
    VRD(3); SBAR(); GAPA(C0=__builtin_amdgcn_mfma_f32_32x32x16_bf16(kf[6],qr[3],C0,0,0,0),   P1[10],P1[11],P1[12],P1[13], pw3[0]=PKW(P1,8), pw3[1]=PKW(P1,10), pw3); \
    VRD(7); SBAR(); GAPA(C1=__builtin_amdgcn_mfma_f32_32x32x16_bf16(kf[7],qr[3],C1,0,0,0),   P1[14],P1[15],0.f,0.f,       pw3[2]=PKW(P1,12),pw3[3]=PKW(P1,14), pw3); \
    l_reg+=keep_?sacc:0.f; \
    if(GK){DMA_K((t)+3,sl_cur);} if(GV){DMA_V((t)+1,sl_next);} \
    CMASK(C0,C1,t); \
    { float a=MX3(C0[0],C0[1],C1[0]),b=MX3(C0[2],C0[3],C1[1]); a=MX3(a,C1[2],C1[3]); \
      _Pragma("unroll") for(int r=4;r<16;r+=4){a=MX3(a,C0[r],C0[r+1]);b=MX3(b,C0[r+2],C0[r+3]);a=MX3(a,C1[r],C1[r+1]);b=MX3(b,C1[r+2],C1[r+3]);} \
      float rm=__builtin_fmaxf(a,b); { auto rr=__builtin_amdgcn_permlane32_swap(__float_as_uint(rm),__float_as_uint(rm),false,false); rm=__builtin_fmaxf(__uint_as_float(rr[0]),__uint_as_float(rr[1])); } \
      resc=false; \
      if(__builtin_expect(__any(rm>(float)THRL),0)){ const float dl=__builtin_fmaxf(rm,0.f); mhat+=dl; \
        _Pragma("unroll") for(int r=0;r<16;++r){C0[r]-=dl;C1[r]-=dl;} \
        _Pragma("unroll") for(int r=0;r<16;++r)negm[r]=-mhat; asm volatile("":"+v"(negm)); \
        const float f=__builtin_amdgcn_exp2f(-dl); l_reg*=f; if(hi==0)wsf[r32]=f; resc=true; } } \
    SBAR(); \
    GAPB(o[0]=__builtin_amdgcn_mfma_f32_32x32x16_bf16(PAF(0),VFR(0),o[0],0,0,0), C0,0); \
    GAPB(o[1]=__builtin_amdgcn_mfma_f32_32x32x16_bf16(PAF(0),VFR(4),o[1],0,0,0), C0,4); \
    KRD(GL,0); GAPB(o[0]=__builtin_amdgcn_mfma_f32_32x32x16_bf16(PAF(1),VFR(1),o[0],0,0,0), C0,8); \
    KRD(GL,1); GAPB(o[1]=__builtin_amdgcn_mfma_f32_32x32x16_bf16(PAF(1),VFR(5),o[1],0,0,0), C0,12); \
    KRD(GL,2); GAPB(o[0]=__builtin_amdgcn_mfma_f32_32x32x16_bf16(PAF(2),VFR(2),o[0],0,0,0), C1,0); \
    KRD(GL,3); GAPB(o[1]=__builtin_amdgcn_mfma_f32_32x32x16_bf16(PAF(2),VFR(6),o[1],0,0,0), C1,4); \
    GAPB(o[0]=__builtin_amdgcn_mfma_f32_32x32x16_bf16(PAF(3),VFR(3),o[0],0,0,0), C1,8); \
    GAPB(o[1]=__builtin_amdgcn_mfma_f32_32x32x16_bf16(PAF(3),VFR(7),o[1],0,0,0), C1,12); \
    }while(0)
  int t=1;
  for(;t+5<NT;t+=2){
    STEP(pB0,pB1,pA0,pA1,t,true,true,true);     WAIT_BAR(2); RESC(); ROT();
    STEP(pA0,pA1,pB0,pB1,t+1,true,true,true);   WAIT_BAR(2); RESC(); ROT();
  }
  #define ENDW(tt) do{ if((tt)+3<NT){WAIT_BAR(2);} else if((tt)+2<NT){WAIT_BAR(1);} else {WAIT_BAR(0);} }while(0)
  for(;t+1<NT;t+=2){
    STEP(pB0,pB1,pA0,pA1,t,(t+3<NT),(t+1<NT),(t+1<NT));       ENDW(t);   RESC(); ROT();
    STEP(pA0,pA1,pB0,pB1,t+1,(t+4<NT),(t+2<NT),(t+2<NT));     ENDW(t+1); RESC(); ROT();
  }
  STEP(pB0,pB1,pA0,pA1,NT-1,false,false,false); RESC();
  { const bool keep_=true; float sacc=pB0[0]+pB0[1]; _Pragma("unroll") for(int r=2;r<16;++r)sacc+=pB0[r]; _Pragma("unroll") for(int r=0;r<16;++r)sacc+=pB1[r]; l_reg+=sacc;
    pw0=(u32x4){PKW(pB0,0),PKW(pB0,2),PKW(pB0,4),PKW(pB0,6)};pw1=(u32x4){PKW(pB0,8),PKW(pB0,10),PKW(pB0,12),PKW(pB0,14)};pw2=(u32x4){PKW(pB1,0),PKW(pB1,2),PKW(pB1,4),PKW(pB1,6)};pw3=(u32x4){PKW(pB1,8),PKW(pB1,10),PKW(pB1,12),PKW(pB1,14)};
    SBAR(); pv(o,vb0+sl_cur,PAF(0),PAF(1),PAF(2),PAF(3)); }
  #undef PKW
  #undef PAF
  #undef VFR
  #undef PIN
  #undef MX3
  #undef GAPA
  #undef GAPB
  #undef EX
  #undef VRD
  #undef KRD
  #undef STEP
  #undef ENDW
  {auto rr=__builtin_amdgcn_permlane32_swap(__float_as_uint(l_reg),__float_as_uint(l_reg),false,false);l_reg=__uint_as_float(rr[0])+__uint_as_float(rr[1]);}
  if(hi==0)wsf[32+r32]=l_reg;asm volatile("s_waitcnt lgkmcnt(0)":::"memory");
  float rli[16];
  #pragma unroll
  for(int r=0;r<16;++r)rli[r]=__builtin_amdgcn_rcpf(wsf[32+crow(r,hi)]);
  bf16*Ow=O+(rowbase+q0+wid*QBLK)*DM+h*D;
  { bf16*stg=(bf16*)(shm+LDS_OST)+wid*2048;
    #pragma unroll
    for(int r=0;r<16;++r){const int orow=crow(r,hi);
      #pragma unroll
      for(int d0=0;d0<2;++d0)stg[orow*64+d0*32+r32]=__float2bfloat16(o[d0][r]*rli[r]);}
    asm volatile("s_waitcnt lgkmcnt(0)":::"memory");
    #pragma unroll
    for(int i=0;i<4;++i){const int row=i*8+(lane>>3),ch=lane&7; const u32x4 v=*(const u32x4*)(stg+row*64+ch*8); ATTN_STORE16(Ow+(long)row*DM+ch*8,v);} }
  asm volatile("s_waitcnt lgkmcnt(0)\n\ts_barrier":::"memory");
  #undef DMA_K
  #undef DMA_V
  #undef CMASK
  #undef BMASK
  #undef START
  #undef RESC
  #undef ROT
}
template<int THRL> __device__ __forceinline__ void moba_unit4(const bf16*Qrow,const bf16*__restrict__ Kh,const bf16*__restrict__ Vh,bool causal,int dest,bf16*PO,float*PML,char*shm){
  int tid_=threadIdx.x; asm volatile("":"+v"(tid_)); const int tid=tid_,lane=tid&63,r32=lane&31,hi=lane>>5; const int wid=__builtin_amdgcn_readfirstlane(tid>>6);
  const unsigned lds0=(unsigned)(uintptr_t)shm;
  float*wsf=(float*)(shm+LDS_WS)+wid*64;
  const bf16*ksrc=Kh+(long)lane*DM+wid*8;
  const bf16*vsrc=Vh+(long)(16*(wid&3)+(lane>>2))*DM+(wid>>2)*32+(lane&3)*8;
  const unsigned kdst=lds0+LDS_K+wid*1024, vdst=lds0+LDS_V+wid*1024;
  #define DMA_K(t,slot) glds16(ksrc+(long)(t)*KVBLK*DM,(unsigned)__builtin_amdgcn_readfirstlane(kdst+(slot)))
  #define DMA_V(t,slot) glds16(vsrc+(long)(t)*KVBLK*DM,(unsigned)__builtin_amdgcn_readfirstlane(vdst+(slot)))
  const int vb0=(int)(lds0+LDS_V)+((lane>>4)&1)*32+(lane&3)*8+(4*hi+((lane&15)>>2))*64;
  const char*Kbase=shm+LDS_K; bf16x8 kf[8];
  const lds_cptr shm3=(lds_cptr)shm; const lds_cptr kp0=shm3+LDS_K+hi*1024+r32*16; const lds_cptr vp0=shm3+LDS_V+((lane>>4)&1)*32+(lane&3)*8+(4*hi+((lane&15)>>2))*64;
  constexpr int NT=4;
  DMA_K(0,0);DMA_V(0,0);DMA_K(1,SLOTB);
  bf16x8 qr[4];
  #pragma unroll
  for(int d0=0;d0<4;++d0)qr[d0]=*reinterpret_cast<const bf16x8*>(Qrow+d0*16+hi*8);
  float mhat=0.f,l_reg=0.f;f32x16 o[2];o[0]=f32x16{};o[1]=f32x16{};f32x16 negm=f32x16{};asm volatile("":"+v"(negm));
  const int qrel=wid*QBLK+r32;
  #define BMASK(P0,P1,t) do{}while(0)
  #define CMASK(P0,P1,t) do{ if(causal)cmask(P0,P1,(t),qrel,hi); }while(0)
  bool resc=false;
  #define START(P0,P1) do{ const float rm=rowmax(P0,P1); resc=false; \
    { const float dl=__builtin_fmaxf(rm,-64.f); mhat=fadd_s(mhat,dl); \
      _Pragma("unroll") for(int r=0;r<16;++r){P0[r]=fsub_s(P0[r],dl);P1[r]=fsub_s(P1[r],dl);} \
      _Pragma("unroll") for(int r=0;r<16;++r)negm[r]=-mhat; asm volatile("":"+v"(negm)); } \
    _Pragma("unroll") for(int r=0;r<16;++r)P0[r]=__builtin_amdgcn_exp2f(P0[r]); }while(0)
  #define RESC() do{ if(resc){ asm volatile("s_waitcnt lgkmcnt(0)":::"memory"); \
      _Pragma("unroll") for(int d_=0;d_<2;++d_) _Pragma("unroll") for(int r=0;r<16;++r)o[d_][r]*=wsf[crow(r,hi)]; } }while(0)
  f32x16 pA0,pA1,pB0,pB1;
  int sl_prev=0,sl_cur=0,sl_next=SLOTB;
  #define ROT() do{sl_prev=sl_cur;sl_cur=sl_next;sl_next=(sl_next==(NSLOT-1)*SLOTB)?0:sl_next+SLOTB;}while(0)
  DMA_K(2,2*SLOTB);
  WAIT_BAR(3);
  qkt(pA0,pA1,Kbase,qr,negm,r32,hi);asm volatile("s_nop 15\n\ts_nop 7":"+v"(pA0),"+v"(pA1));CMASK(pA0,pA1,0);
  START(pA0,pA1);
  _Pragma("unroll") for(int r=0;r<16;++r)pA1[r]=__builtin_amdgcn_exp2f(pA1[r]);
  WAIT_BAR(0);
  DMA_K(3,0);DMA_V(1,SLOTB);
  ROT();
  kload8(kf,kp0+sl_cur);
  WAIT_BAR(2);
  s16x4 vlo[8],vhi[8]; u32x4 pw0,pw1,pw2,pw3;
  #define PKW(P,B) (keep_?cvtpk_s(P[B],P[B+1]):0u)
  #define PAF(k) __builtin_bit_cast(bf16x8,pw##k)
  #define VFR(i) (bf16x8){vlo[i][0],vlo[i][1],vlo[i][2],vlo[i][3],vhi[i][0],vhi[i][1],vhi[i][2],vhi[i][3]}
  #define PIN(x) asm volatile("":"+v"(x))
  #define MX3(a,b,c) __builtin_fmaxf(__builtin_fmaxf((a),(b)),(c))
  #define GAPA(MF,A0,A1,A2,A3,W0,W1,PW) do{ MF; sacc+=A0; sacc+=A1; sacc+=A2; sacc+=A3; PIN(sacc); W0; W1; PIN(PW); SBAR(); }while(0)
  #define EX(v) __builtin_amdgcn_exp2f(v)
  #define GAPB(MF,X,B) do{ MF; X[B]=EX(X[B]); X[B+1]=EX(X[B+1]); X[B+2]=EX(X[B+2]); X[B+3]=EX(X[B+3]); PIN(X); SBAR(); }while(0)
  #define VRD(i) do{ vlo[i]=vtr(vp_+(((i)>>2)*4096+((i)&3)*1024)); vhi[i]=vtr(vp_+(((i)>>2)*4096+((i)&3)*1024+512)); }while(0)
  #define KRD(G,j) do{ if(G){ kload2(kf,kp0+sl_next,j); SBAR(); } }while(0)
  #define STEP(C0,C1,P0,P1,t,GK,GV,GL) do{ SBAR(); \
    const bool keep_=true; \
    const lds_cptr vp_=vp0+sl_prev; \
    VRD(0); SBAR(); float sacc=(P0[0]+P0[1]); \
    GAPA(C0=__builtin_amdgcn_mfma_f32_32x32x16_bf16(kf[0],qr[0],negm,0,0,0), P0[2],P0[3],P0[4],P0[5],     pw0[0]=PKW(P0,0), pw0[1]=PKW(P0,2), pw0); \
    VRD(4); SBAR(); GAPA(C1=__builtin_amdgcn_mfma_f32_32x32x16_bf16(kf[1],qr[0],negm,0,0,0), P0[6],P0[7],P0[8],P0[9],     pw0[2]=PKW(P0,4), pw0[3]=PKW(P0,6), pw0); \
    VRD(1); SBAR(); GAPA(C0=__builtin_amdgcn_mfma_f32_32x32x16_bf16(kf[2],qr[1],C0,0,0,0),   P0[10],P0[11],P0[12],P0[13], pw1[0]=PKW(P0,8), pw1[1]=PKW(P0,10), pw1); \
    VRD(5); SBAR(); GAPA(C1=__builtin_amdgcn_mfma_f32_32x32x16_bf16(kf[3],qr[1],C1,0,0,0),   P0[14],P0[15],P1[0],P1[1],   pw1[2]=PKW(P0,12),pw1[3]=PKW(P0,14), pw1); \
    VRD(2); SBAR(); GAPA(C0=__builtin_amdgcn_mfma_f32_32x32x16_bf16(kf[4],qr[2],C0,0,0,0),   P1[2],P1[3],P1[4],P1[5],     pw2[0]=PKW(P1,0), pw2[1]=PKW(P1,2), pw2); \
    VRD(6); SBAR(); GAPA(C1=__builtin_amdgcn_mfma_f32_32x32x16_bf16(kf[5],qr[2],C1,0,0,0),   P1[6],P1[7],P1[8],P1[9],     pw2[2]=PKW(P1,4), pw2[3]=PKW(P1,6), pw2); \
    VRD(3); SBAR(); GAPA(C0=__builtin_amdgcn_mfma_f32_32x32x16_bf16(kf[6],qr[3],C0,0,0,0),   P1[10],P1[11],P1[12],P1[13], pw3[0]=PKW(P1,8), pw3[1]=PKW(P1,10), pw3); \
    VRD(7); SBAR(); GAPA(C1=__builtin_amdgcn_mfma_f32_32x32x16_bf16(kf[7],qr[3],C1,0,0,0),   P1[14],P1[15],0.f,0.f,       pw3[2]=PKW(P1,12),pw3[3]=PKW(P1,14), pw3); \
    l_reg+=keep_?sacc:0.f; \
    if(GK){DMA_K((t)+3,sl_cur);} if(GV){DMA_V((t)+1,sl_next);} \
    CMASK(C0,C1,t); \
    { float a=MX3(C0[0],C0[1],C1[0]),b=MX3(C0[2],C0[3],C1[1]); a=MX3(a,C1[2],C1[3]); \
      _Pragma("unroll") for(int r=4;r<16;r+=4){a=MX3(a,C0[r],C0[r+1]);b=MX3(b,C0[r+2],C0[r+3]);a=MX3(a,C1[r],C1[r+1]);b=MX3(b,C1[r+2],C1[r+3]);} \
      float rm=__builtin_fmaxf(a,b); { auto rr=__builtin_amdgcn_permlane32_swap(__float_as_uint(rm),__float_as_uint(rm),false,false); rm=__builtin_fmaxf(__uint_as_float(rr[0]),__uint_as_float(rr[1])); } \
      resc=false; \
      if(__builtin_expect(__any(rm>(float)THRL),0)){ const float dl=__builtin_fmaxf(rm,0.f); mhat+=dl; \
        _Pragma("unroll") for(int r=0;r<16;++r){C0[r]-=dl;C1[r]-=dl;} \
        _Pragma("unroll") for(int r=0;r<16;++r)negm[r]=-mhat; asm volatile("":"+v"(negm)); \
        const float f=__builtin_amdgcn_exp2f(-dl); l_reg*=f; if(hi==0)wsf[r32]=f; resc=true; } } \
    SBAR(); \
    GAPB(o[0]=__builtin_amdgcn_mfma_f32_32x32x16_bf16(PAF(0),VFR(0),o[0],0,0,0), C0,0); \
    GAPB(o[1]=__builtin_amdgcn_mfma_f32_32x32x16_bf16(PAF(0),VFR(4),o[1],0,0,0), C0,4); \
    KRD(GL,0); GAPB(o[0]=__builtin_amdgcn_mfma_f32_32x32x16_bf16(PAF(1),VFR(1),o[0],0,0,0), C0,8); \
    KRD(GL,1); GAPB(o[1]=__builtin_amdgcn_mfma_f32_32x32x16_bf16(PAF(1),VFR(5),o[1],0,0,0), C0,12); \
    KRD(GL,2); GAPB(o[0]=__builtin_amdgcn_mfma_f32_32x32x16_bf16(PAF(2),VFR(2),o[0],0,0,0), C1,0); \
    KRD(GL,3); GAPB(o[1]=__builtin_amdgcn_mfma_f32_32x32x16_bf16(PAF(2),VFR(6),o[1],0,0,0), C1,4); \
    GAPB(o[0]=__builtin_amdgcn_mfma_f32_32x32x16_bf16(PAF(3),VFR(3),o[0],0,0,0), C1,8); \
    GAPB(o[1]=__builtin_amdgcn_mfma_f32_32x32x16_bf16(PAF(3),VFR(7),o[1],0,0,0), C1,12); \
    }while(0)
  int t=1;
  for(;t+5<NT;t+=2){
    STEP(pB0,pB1,pA0,pA1,t,true,true,true);     WAIT_BAR(2); RESC(); ROT();
    STEP(pA0,pA1,pB0,pB1,t+1,true,true,true);   WAIT_BAR(2); RESC(); ROT();
  }
  #define ENDW(tt) do{ if((tt)+3<NT){WAIT_BAR(2);} else if((tt)+2<NT){WAIT_BAR(1);} else {WAIT_BAR(0);} }while(0)
  for(;t+1<NT;t+=2){
    STEP(pB0,pB1,pA0,pA1,t,(t+3<NT),(t+1<NT),(t+1<NT));       ENDW(t);   RESC(); ROT();
    STEP(pA0,pA1,pB0,pB1,t+1,(t+4<NT),(t+2<NT),(t+2<NT));     ENDW(t+1); RESC(); ROT();
  }
  STEP(pB0,pB1,pA0,pA1,NT-1,false,false,false); RESC();
  { const bool keep_=true; float sacc=pB0[0]+pB0[1]; _Pragma("unroll") for(int r=2;r<16;++r)sacc+=pB0[r]; _Pragma("unroll") for(int r=0;r<16;++r)sacc+=pB1[r]; l_reg+=sacc;
    pw0=(u32x4){PKW(pB0,0),PKW(pB0,2),PKW(pB0,4),PKW(pB0,6)};pw1=(u32x4){PKW(pB0,8),PKW(pB0,10),PKW(pB0,12),PKW(pB0,14)};pw2=(u32x4){PKW(pB1,0),PKW(pB1,2),PKW(pB1,4),PKW(pB1,6)};pw3=(u32x4){PKW(pB1,8),PKW(pB1,10),PKW(pB1,12),PKW(pB1,14)};
    SBAR(); pv(o,vb0+sl_cur,PAF(0),PAF(1),PAF(2),PAF(3)); }
  #undef PKW
  #undef PAF
  #undef VFR
  #undef PIN
  #undef MX3
  #undef GAPA
  #undef GAPB
  #undef EX
  #undef VRD
  #undef KRD
  #undef STEP
  #undef ENDW
  {auto rr=__builtin_amdgcn_permlane32_swap(__float_as_uint(l_reg),__float_as_uint(l_reg),false,false);l_reg=__uint_as_float(rr[0])+__uint_as_float(rr[1]);}
  if(hi==0)wsf[32+r32]=l_reg;asm volatile("s_waitcnt lgkmcnt(0)":::"memory");
  float rli[16];
  #pragma unroll
  for(int r=0;r<16;++r)rli[r]=__builtin_amdgcn_rcpf(wsf[32+crow(r,hi)]);
  { bf16*stg=(bf16*)(shm+LDS_OST)+wid*2048;
    int*dtab=(int*)(shm+LDS_DST)+wid*32;
    if(hi==0){ dtab[r32]=dest; if(dest>=0){ PML[2*(long)dest]=mhat; PML[2*(long)dest+1]=l_reg; } }
    #pragma unroll
    for(int r=0;r<16;++r){const int orow=crow(r,hi);
      #pragma unroll
      for(int d0=0;d0<2;++d0)stg[orow*64+d0*32+r32]=__float2bfloat16(o[d0][r]*rli[r]);}
    asm volatile("s_waitcnt lgkmcnt(0)":::"memory");
    #pragma unroll
    for(int i=0;i<4;++i){const int row=i*8+(lane>>3),ch=lane&7; const int dr=dtab[row]; const u32x4 v=*(const u32x4*)(stg+row*64+ch*8); if(dr>=0)*(u32x4*)(PO+(long)dr*64+ch*8)=v;} }
  asm volatile("s_waitcnt lgkmcnt(0)\n\ts_barrier":::"memory");
  #undef DMA_K
  #undef DMA_V
  #undef CMASK
  #undef BMASK
  #undef START
  #undef RESC
  #undef ROT
}
template<int THRL> __device__ __forceinline__ void moba_chunk4(const bf16*Qrow,bool causal,int dest,bf16*PO,float*PML,char*shm){
  int tid_=threadIdx.x; asm volatile("":"+v"(tid_)); const int tid=tid_,lane=tid&63,r32=lane&31,hi=lane>>5; const int wid=__builtin_amdgcn_readfirstlane(tid>>6);
  const unsigned lds0=(unsigned)(uintptr_t)shm;
  float*wsf=(float*)(shm+LDS_WS)+wid*64;
  const int vb0=(int)(lds0+LDS_V)+((lane>>4)&1)*32+(lane&3)*8+(4*hi+((lane&15)>>2))*64;
  const char*Kbase=shm+LDS_K; bf16x8 kf[8];
  const lds_cptr shm3=(lds_cptr)shm; const lds_cptr kp0=shm3+LDS_K+hi*1024+r32*16; const lds_cptr vp0=shm3+LDS_V+((lane>>4)&1)*32+(lane&3)*8+(4*hi+((lane&15)>>2))*64;
  constexpr int NT=4;
  bf16x8 qr[4];
  #pragma unroll
  for(int d0=0;d0<4;++d0)qr[d0]=*reinterpret_cast<const bf16x8*>(Qrow+d0*16+hi*8);
  float mhat=0.f,l_reg=0.f;f32x16 o[2];o[0]=f32x16{};o[1]=f32x16{};f32x16 negm=f32x16{};asm volatile("":"+v"(negm));
  const int qrel=wid*QBLK+r32;
  #define BMASK(P0,P1,t) do{}while(0)
  #define CMASK(P0,P1,t) do{ if(causal)cmask(P0,P1,(t),qrel,hi); }while(0)
  bool resc=false;
  #define START(P0,P1) do{ const float rm=rowmax(P0,P1); resc=false; \
    { const float dl=__builtin_fmaxf(rm,-64.f); mhat=fadd_s(mhat,dl); \
      _Pragma("unroll") for(int r=0;r<16;++r){P0[r]=fsub_s(P0[r],dl);P1[r]=fsub_s(P1[r],dl);} \
      _Pragma("unroll") for(int r=0;r<16;++r)negm[r]=-mhat; asm volatile("":"+v"(negm)); } \
    _Pragma("unroll") for(int r=0;r<16;++r)P0[r]=__builtin_amdgcn_exp2f(P0[r]); }while(0)
  #define RESC() do{ if(resc){ asm volatile("s_waitcnt lgkmcnt(0)":::"memory"); \
      _Pragma("unroll") for(int d_=0;d_<2;++d_) _Pragma("unroll") for(int r=0;r<16;++r)o[d_][r]*=wsf[crow(r,hi)]; } }while(0)
  f32x16 pA0,pA1,pB0,pB1;
  int sl_prev=0,sl_cur=0,sl_next=SLOTB;
  #define ROT() do{sl_prev=sl_cur;sl_cur=sl_next;sl_next=(sl_next==(NSLOT-1)*SLOTB)?0:sl_next+SLOTB;}while(0)
  qkt(pA0,pA1,Kbase,qr,negm,r32,hi);asm volatile("s_nop 15\n\ts_nop 7":"+v"(pA0),"+v"(pA1));CMASK(pA0,pA1,0);
  START(pA0,pA1);
  _Pragma("unroll") for(int r=0;r<16;++r)pA1[r]=__builtin_amdgcn_exp2f(pA1[r]);
  ROT();
  kload8(kf,kp0+sl_cur);
  s16x4 vlo[8],vhi[8]; u32x4 pw0,pw1,pw2,pw3;
  #define PKW(P,B) (keep_?cvtpk_s(P[B],P[B+1]):0u)
  #define PAF(k) __builtin_bit_cast(bf16x8,pw##k)
  #define VFR(i) (bf16x8){vlo[i][0],vlo[i][1],vlo[i][2],vlo[i][3],vhi[i][0],vhi[i][1],vhi[i][2],vhi[i][3]}
  #define PIN(x) asm volatile("":"+v"(x))
  #define MX3(a,b,c) __builtin_fmaxf(__builtin_fmaxf((a),(b)),(c))
  #define GAPA(MF,A0,A1,A2,A3,W0,W1,PW) do{ MF; sacc+=A0; sacc+=A1; sacc+=A2; sacc+=A3; PIN(sacc); W0; W1; PIN(PW); SBAR(); }while(0)
  #define EX(v) __builtin_amdgcn_exp2f(v)
  #define GAPB(MF,X,B) do{ MF; X[B]=EX(X[B]); X[B+1]=EX(X[B+1]); X[B+2]=EX(X[B+2]); X[B+3]=EX(X[B+3]); PIN(X); SBAR(); }while(0)
  #define VRD(i) do{ vlo[i]=vtr(vp_+(((i)>>2)*4096+((i)&3)*1024)); vhi[i]=vtr(vp_+(((i)>>2)*4096+((i)&3)*1024+512)); }while(0)
  #define KRD(G,j) do{ if(G){ kload2(kf,kp0+sl_next,j); SBAR(); } }while(0)
  #define STEP(C0,C1,P0,P1,t,GK,GV,GL) do{ SBAR(); \
    const bool keep_=true; \
    const lds_cptr vp_=vp0+sl_prev; \
    VRD(0); SBAR(); float sacc=(P0[0]+P0[1]); \
    GAPA(C0=__builtin_amdgcn_mfma_f32_32x32x16_bf16(kf[0],qr[0],negm,0,0,0), P0[2],P0[3],P0[4],P0[5],     pw0[0]=PKW(P0,0), pw0[1]=PKW(P0,2), pw0); \
    VRD(4); SBAR(); GAPA(C1=__builtin_amdgcn_mfma_f32_32x32x16_bf16(kf[1],qr[0],negm,0,0,0), P0[6],P0[7],P0[8],P0[9],     pw0[2]=PKW(P0,4), pw0[3]=PKW(P0,6), pw0); \
    VRD(1); SBAR(); GAPA(C0=__builtin_amdgcn_mfma_f32_32x32x16_bf16(kf[2],qr[1],C0,0,0,0),   P0[10],P0[11],P0[12],P0[13], pw1[0]=PKW(P0,8), pw1[1]=PKW(P0,10), pw1); \
    VRD(5); SBAR(); GAPA(C1=__builtin_amdgcn_mfma_f32_32x32x16_bf16(kf[3],qr[1],C1,0,0,0),   P0[14],P0[15],P1[0],P1[1],   pw1[2]=PKW(P0,12),pw1[3]=PKW(P0,14), pw1); \
    VRD(2); SBAR(); GAPA(C0=__builtin_amdgcn_mfma_f32_32x32x16_bf16(kf[4],qr[2],C0,0,0,0),   P1[2],P1[3],P1[4],P1[5],     pw2[0]=PKW(P1,0), pw2[1]=PKW(P1,2), pw2); \
    VRD(6); SBAR(); GAPA(C1=__builtin_amdgcn_mfma_f32_32x32x16_bf16(kf[5],qr[2],C1,0,0,0),   P1[6],P1[7],P1[8],P1[9],     pw2[2]=PKW(P1,4), pw2[3]=PKW(P1,6), pw2); \
    VRD(3); SBAR(); GAPA(C0=__builtin_amdgcn_mfma_f32_32x32x16_bf16(kf[6],qr[3],C0,0,0,0),   P1[10],P1[11],P1[12],P1[13], pw3[0]=PKW(P1,8), pw3[1]=PKW(P1,10), pw3); \
    VRD(7); SBAR(); GAPA(C1=__builtin_amdgcn_mfma_f32_32x32x16_bf16(kf[7],qr[3],C1,0,0,0),   P1[14],P1[15],0.f,0.f,       pw3[2]=PKW(P1,12),pw3[3]=PKW(P1,14), pw3); \
    l_reg+=keep_?sacc:0.f; \
    CMASK(C0,C1,t); \
    { float a=MX3(C0[0],C0[1],C1[0]),b=MX3(C0[2],C0[3],C1[1]); a=MX3(a,C1[2],C1[3]); \
      _Pragma("unroll") for(int r=4;r<16;r+=4){a=MX3(a,C0[r],C0[r+1]);b=MX3(b,C0[r+2],C0[r+3]);a=MX3(a,C1[r],C1[r+1]);b=MX3(b,C1[r+2],C1[r+3]);} \
      float rm=__builtin_fmaxf(a,b); { auto rr=__builtin_amdgcn_permlane32_swap(__float_as_uint(rm),__float_as_uint(rm),false,false); rm=__builtin_fmaxf(__uint_as_float(rr[0]),__uint_as_float(rr[1])); } \
      resc=false; \
      if(__builtin_expect(__any(rm>(float)THRL),0)){ const float dl=__builtin_fmaxf(rm,0.f); mhat+=dl; \
        _Pragma("unroll") for(int r=0;r<16;++r){C0[r]-=dl;C1[r]-=dl;} \
        _Pragma("unroll") for(int r=0;r<16;++r)negm[r]=-mhat; asm volatile("":"+v"(negm)); \
        const float f=__builtin_amdgcn_exp2f(-dl); l_reg*=f; if(hi==0)wsf[r32]=f; resc=true; } } \
    SBAR(); \
    GAPB(o[0]=__builtin_amdgcn_mfma_f32_32x32x16_bf16(PAF(0),VFR(0),o[0],0,0,0), C0,0); \
    GAPB(o[1]=__builtin_amdgcn_mfma_f32_32x32x16_bf16(PAF(0),VFR(4),o[1],0,0,0), C0,4); \
    KRD(GL,0); GAPB(o[0]=__builtin_amdgcn_mfma_f32_32x32x16_bf16(PAF(1),VFR(1),o[0],0,0,0), C0,8); \
    KRD(GL,1); GAPB(o[1]=__builtin_amdgcn_mfma_f32_32x32x16_bf16(PAF(1),VFR(5),o[1],0,0,0), C0,12); \
    KRD(GL,2); GAPB(o[0]=__builtin_amdgcn_mfma_f32_32x32x16_bf16(PAF(2),VFR(2),o[0],0,0,0), C1,0); \
    KRD(GL,3); GAPB(o[1]=__builtin_amdgcn_mfma_f32_32x32x16_bf16(PAF(2),VFR(6),o[1],0,0,0), C1,4); \
    GAPB(o[0]=__builtin_amdgcn_mfma_f32_32x32x16_bf16(PAF(3),VFR(3),o[0],0,0,0), C1,8); \
    GAPB(o[1]=__builtin_amdgcn_mfma_f32_32x32x16_bf16(PAF(3),VFR(7),o[1],0,0,0), C1,12); \
    }while(0)
  int t=1;
  for(;t+5<NT;t+=2){
    STEP(pB0,pB1,pA0,pA1,t,true,true,true);      RESC(); ROT();
    STEP(pA0,pA1,pB0,pB1,t+1,true,true,true);    RESC(); ROT();
  }
  #define ENDW(tt) do{ if((tt)+3<NT){} else if((tt)+2<NT){} else {} }while(0)
  for(;t+1<NT;t+=2){
    STEP(pB0,pB1,pA0,pA1,t,(t+3<NT),(t+1<NT),(t+1<NT));       ENDW(t);   RESC(); ROT();
    STEP(pA0,pA1,pB0,pB1,t+1,(t+4<NT),(t+2<NT),(t+2<NT));     ENDW(t+1); RESC(); ROT();
  }
  STEP(pB0,pB1,pA0,pA1,NT-1,false,false,false); RESC();
  { const bool keep_=true; float sacc=pB0[0]+pB0[1]; _Pragma("unroll") for(int r=2;r<16;++r)sacc+=pB0[r]; _Pragma("unroll") for(int r=0;r<16;++r)sacc+=pB1[r]; l_reg+=sacc;
    pw0=(u32x4){PKW(pB0,0),PKW(pB0,2),PKW(pB0,4),PKW(pB0,6)};pw1=(u32x4){PKW(pB0,8),PKW(pB0,10),PKW(pB0,12),PKW(pB0,14)};pw2=(u32x4){PKW(pB1,0),PKW(pB1,2),PKW(pB1,4),PKW(pB1,6)};pw3=(u32x4){PKW(pB1,8),PKW(pB1,10),PKW(pB1,12),PKW(pB1,14)};
    SBAR(); pv(o,vb0+sl_cur,PAF(0),PAF(1),PAF(2),PAF(3)); }
  #undef PKW
  #undef PAF
  #undef VFR
  #undef PIN
  #undef MX3
  #undef GAPA
  #undef GAPB
  #undef EX
  #undef VRD
  #undef KRD
  #undef STEP
  #undef ENDW
  {auto rr=__builtin_amdgcn_permlane32_swap(__float_as_uint(l_reg),__float_as_uint(l_reg),false,false);l_reg=__uint_as_float(rr[0])+__uint_as_float(rr[1]);}
  if(hi==0)wsf[32+r32]=l_reg;asm volatile("s_waitcnt lgkmcnt(0)":::"memory");
  float rli[16];
  #pragma unroll
  for(int r=0;r<16;++r)rli[r]=__builtin_amdgcn_rcpf(wsf[32+crow(r,hi)]);
  { bf16*stg=(bf16*)(shm+LDS_OST)+wid*2048;
    int*dtab=(int*)(shm+LDS_DST)+wid*32;
    if(hi==0){ dtab[r32]=dest; if(dest>=0){ PML[2*(long)dest]=mhat; PML[2*(long)dest+1]=l_reg; } }
    #pragma unroll
    for(int r=0;r<16;++r){const int orow=crow(r,hi);
      #pragma unroll
      for(int d0=0;d0<2;++d0)stg[orow*64+d0*32+r32]=__float2bfloat16(o[d0][r]*rli[r]);}
    asm volatile("s_waitcnt lgkmcnt(0)":::"memory");
    #pragma unroll
    for(int i=0;i<4;++i){const int row=i*8+(lane>>3),ch=lane&7; const int dr=dtab[row]; const u32x4 v=*(const u32x4*)(stg+row*64+ch*8); if(dr>=0)*(u32x4*)(PO+(long)dr*64+ch*8)=v;} }
  asm volatile("s_waitcnt lgkmcnt(0)":::"memory");
  #undef CMASK
  #undef BMASK
  #undef START
  #undef RESC
  #undef ROT
}

__device__ __forceinline__ void moba_load_kv(const bf16*Kh,const bf16*Vh,char*shm){
  int tid_=threadIdx.x; asm volatile("":"+v"(tid_)); const int lane=tid_&63; const int wid=__builtin_amdgcn_readfirstlane(tid_>>6);
  const unsigned lds0=(unsigned)(uintptr_t)shm;
  const bf16*ksrc=Kh+(long)lane*DM+wid*8;
  const bf16*vsrc=Vh+(long)(16*(wid&3)+(lane>>2))*DM+(wid>>2)*32+(lane&3)*8;
  const unsigned kdst=lds0+LDS_K+wid*1024, vdst=lds0+LDS_V+wid*1024;
  #pragma unroll
  for(int t=0;t<4;++t){ glds16(ksrc+(long)t*KVBLK*DM,(unsigned)__builtin_amdgcn_readfirstlane(kdst+t*SLOTB)); glds16(vsrc+(long)t*KVBLK*DM,(unsigned)__builtin_amdgcn_readfirstlane(vdst+t*SLOTB)); }
  asm volatile("s_waitcnt vmcnt(0)":::"memory");
}
constexpr int ATTN_LDS_BYTES=LDS_BYTES;
struct AttnTensors { const bf16* Q; const bf16* K; const bf16* V; bf16* O; const float* KM; };
struct AttnUnit { int bh; int qb; };
struct StaticOrder {
  int vcu;
  __device__ __forceinline__ explicit StaticOrder(int grid,int block):vcu((block%8)*(grid/8)+block/8){}
  __device__ __forceinline__ bool next(int i,AttnUnit&u)const{ if(i>=4)return false; const int s=vcu&7; u.bh=vcu>>3; u.qb=(i==0)?s:(i==1)?15-s:(i==2)?16+s:31-s; return true; }
  __device__ __forceinline__ void a_ready(const AttnUnit&)const{}
  __device__ __forceinline__ void done(const AttnUnit&)const{}
};
template<class Sched,int THRL=8> __device__ __forceinline__ void attn_phase(char*lds,const AttnTensors&T,const Sched&S){
  AttnUnit u; int lastbh=-1;
  for(int i=0;S.next(i,u);++i){
    if(u.bh!=lastbh){ __syncthreads(); float*km=(float*)(lds+LDS_KM); int tx_=threadIdx.x; asm volatile("":"+v"(tx_)); for(int k=tx_;k<32*64;k+=512)km[k]=T.KM[(long)u.bh*32*64+k]+T.KM[(long)(BATCH*NHEAD+u.bh)*32*64+k]; asm volatile("s_waitcnt vmcnt(0) lgkmcnt(0)":::"memory"); __syncthreads(); lastbh=u.bh; }
    attn_unit<THRL>(u.bh/NHEAD,u.bh%NHEAD,u.qb,T.Q,T.K,T.V,T.O,lds); }
}
#undef SBAR
#undef WAIT_BAR
}

#define XB_TMO      128
#define XB_XCNT(j)  (256  + 64 * (j))
#define XB_XSUB(j)  (1280 + 64 * (j))
#define XB_XGEN(j)  (2304 + 64 * (j))
#define XB_TOP      3328
#define XB_TOPGEN   3392
#define XCD_BAR_WORDS 3456
#define XB_SPIN_CAP (1u << 20)
__device__ __forceinline__ unsigned xb_ld(unsigned* p)              { return __hip_atomic_load(p, __ATOMIC_RELAXED, __HIP_MEMORY_SCOPE_AGENT); }
__device__ __forceinline__ unsigned xb_add(unsigned* p, unsigned v) { return __hip_atomic_fetch_add(p, v, __ATOMIC_RELAXED, __HIP_MEMORY_SCOPE_AGENT); }
__device__ __forceinline__ unsigned xb_xcc_id() { return (unsigned)__builtin_amdgcn_s_getreg((3 << 11) | 20) & 0xFu; }
#define XB_SPIN(cond, bar) do { unsigned _sp = 0; while (cond) { __builtin_amdgcn_s_sleep(1); \
    if ((++_sp & 255u) == 0u) { if (xb_ld(&(bar)[XB_TMO])) break; if (_sp > XB_SPIN_CAP) { atomicAdd(&(bar)[XB_TMO], 1u); break; } } } } while (0)
struct XcdBarrier { unsigned* bar; unsigned x; volatile LAS unsigned* st; };
__device__ __forceinline__ XcdBarrier xcd_barrier_post(unsigned* bar, volatile LAS unsigned* st) {
    XcdBarrier b; b.bar = bar; b.x = xb_xcc_id(); b.st = st;
    if (threadIdx.x == 0) (void)xb_add(&bar[XB_XCNT(b.x)], 1u);
    return b;
}
__device__ __forceinline__ void xcd_barrier_complete(unsigned* bar, unsigned x, unsigned& nloc, unsigned& nx) {
    const unsigned G = gridDim.x * gridDim.y * gridDim.z;
    unsigned sum, cnt, mine, sp = 0u;
    for (;;) {
        sum = 0u; cnt = 0u; mine = 0u;
#pragma unroll
        for (unsigned j = 0; j < 16; ++j) { const unsigned c = xb_ld(&bar[XB_XCNT(j)]); sum += c; cnt += (c > 0u) ? 1u : 0u; mine = (j == x) ? c : mine; }
        if (sum == G) break;
        __builtin_amdgcn_s_sleep(1);
        if ((++sp & 255u) == 0u) { if (xb_ld(&bar[XB_TMO])) break; if (sp > XB_SPIN_CAP) { atomicAdd(&bar[XB_TMO], 1u); break; } }
    }
    nloc = mine > 0u ? mine : 1u; nx = cnt > 0u ? cnt : 1u;
}
__device__ __forceinline__ void xcd_barrier(const XcdBarrier& b) {
    asm volatile("s_waitcnt vmcnt(0)" ::: "memory");
    __syncthreads();
    if (threadIdx.x == 0) {
        unsigned* bar = b.bar;
        __builtin_amdgcn_s_waitcnt(0);
        unsigned nloc = b.st[0], nx = b.st[1];
        if (nloc == 0u) { xcd_barrier_complete(bar, b.x, nloc, nx); b.st[0] = nloc; b.st[1] = nx; }
        const unsigned old = xb_add(&bar[XB_XSUB(b.x)], 1u);
        const unsigned gen = old / nloc;
        if (old + 1u == (gen + 1u) * nloc) {
            __builtin_amdgcn_fence(__ATOMIC_RELEASE, "agent");
            asm volatile("s_waitcnt vmcnt(0)" ::: "memory");
            const unsigned og = xb_add(&bar[XB_TOP], 1u);
            const unsigned tg = og / nx;
            if (og + 1u == (tg + 1u) * nx) xb_add(&bar[XB_TOPGEN], 1u);
            else XB_SPIN(xb_ld(&bar[XB_TOPGEN]) == tg, bar);
            __builtin_amdgcn_fence(__ATOMIC_ACQUIRE, "agent");
            xb_add(&bar[XB_XGEN(b.x)], 1u);
            asm volatile("s_waitcnt vmcnt(0)" ::: "memory");
        } else {
            XB_SPIN(xb_ld(&bar[XB_XGEN(b.x)]) == gen, bar);
            __builtin_amdgcn_fence(__ATOMIC_ACQUIRE, "agent");
            asm volatile("s_waitcnt vmcnt(0)" ::: "memory");
        }
    }
    __syncthreads();
}

struct Args { const float* in[28]; float* out; unsigned char* ws; int ph_lo, ph_hi; };
enum { I_X = 0, I_MEM, I_GMIX, I_WIN, I_ARE, I_AIM, I_LOGDT, I_BRE, I_BIM, I_CRE, I_CIM, I_DSKIP, I_WGLU, I_WPA, I_WOUT, I_GXATTN, I_GMEM, I_WXQ, I_WXKV, I_WXO,
       I_GMOE, I_WROUTER, I_BROUTER, I_WGU, I_BGU, I_WDN, I_BDN, I_GFINAL };

struct TrDesc { const float* W; const float* gain; bf16_t* WT; int K, N, map, item; int fp8 = 0; };
__device__ __forceinline__ void tr_load(const TrDesc& d, f32x4 (&v)[16], float (&g)[16], int lane) {
    const int nblk = d.N / 64, kb = d.item / nblk, nb = d.item % nblk, k0 = 64 * kb, n0 = 64 * nb, q = lane & 15, kr = lane >> 4;
    const float* src = d.W + (size_t)(k0 + kr) * d.N + n0 + 4 * q;
#pragma unroll
    for (int j = 0; j < 16; ++j) v[j] = *(const f32x4*)(src + (size_t)(4 * j) * d.N);
#pragma unroll
    for (int j = 0; j < 16; ++j) g[j] = d.gain ? d.gain[k0 + kr + 4 * j] : 1.0f;
}
__device__ __forceinline__ void tr_finish(const TrDesc& d, const f32x4 (&v)[16], const float (&g)[16], LAS float* scr, int lane) {
    const int nblk = d.N / 64, kb = d.item / nblk, nb = d.item % nblk, k0 = 64 * kb, n0 = 64 * nb, q = lane & 15, kr = lane >> 4;
#pragma unroll
    for (int j = 0; j < 16; ++j) { const int kk = kr + 4 * j; *(LAS f32x4*)(scr + kk * 64 + 4 * (q ^ ((kk >> 3) & 7))) = v[j] * g[j]; }
    asm volatile("s_waitcnt lgkmcnt(0)" ::: "memory");
    const int c = lane & 7, nq = lane >> 3;
    const int nr0 = d.map ? (256 * ((n0 % 1024) / 128) + 128 * (n0 / 1024) + (n0 % 128)) : n0;
#pragma unroll
    for (int jj = 0; jj < 8; ++jj) { const int n = 8 * jj + nq; const LAS float* sp = scr + (8 * c) * 64 + (n ^ (4 * c));
        if (d.fp8) { const float sc = (float)(1 << FP8_WSHIFT); int w0 = 0, w1 = 0;
            w0 = __builtin_amdgcn_cvt_pk_fp8_f32(sp[0 * 64] * sc, sp[1 * 64] * sc, w0, false); w0 = __builtin_amdgcn_cvt_pk_fp8_f32(sp[2 * 64] * sc, sp[3 * 64] * sc, w0, true);
            w1 = __builtin_amdgcn_cvt_pk_fp8_f32(sp[4 * 64] * sc, sp[5 * 64] * sc, w1, false); w1 = __builtin_amdgcn_cvt_pk_fp8_f32(sp[6 * 64] * sc, sp[7 * 64] * sc, w1, true);
            *(u32x2*)((unsigned char*)d.WT + (size_t)(nr0 + n) * d.K + k0 + 8 * c) = (u32x2){(unsigned)w0, (unsigned)w1}; }
        else { u32x4 o; o.x = pk2(sp[0 * 64], sp[1 * 64]); o.y = pk2(sp[2 * 64], sp[3 * 64]); o.z = pk2(sp[4 * 64], sp[5 * 64]); o.w = pk2(sp[6 * 64], sp[7 * 64]);
            *(u32x4*)(d.WT + (size_t)(nr0 + n) * d.K + k0 + 8 * c) = o; } }
    asm volatile("s_waitcnt lgkmcnt(0)" ::: "memory");
}
template <int MODE>
__device__ __forceinline__ float rms_row_to_bf16(const float* xrow, const float* gain, bf16_t* orow, int lane) {
    const f32x4* xr = (const f32x4*)xrow + lane;
    f32x4 v[4]; float s = 0.f;
#pragma unroll
    for (int j = 0; j < 4; ++j) { v[j] = xr[64 * j]; s += (v[j][0] * v[j][0] + v[j][1] * v[j][1]) + (v[j][2] * v[j][2] + v[j][3] * v[j][3]); }
    const float rstd = 1.0f / sqrtf(wave_sum(s) * (1.0f / DM) + RMS_EPS);
    u32x2* o8 = (u32x2*)orow + lane;
#pragma unroll
    for (int j = 0; j < 4; ++j) { f32x4 w = v[j];
        if (MODE == 1) { const f32x4 g = ((const f32x4*)gain)[lane + 64 * j]; w = w * rstd * g; }
        u32x2 o; o.x = pk2(w[0], w[1]); o.y = pk2(w[2], w[3]); o8[64 * j] = o; }
    return rstd;
}

struct Frame {
    LAS unsigned char* lds; int tid, lane, wave, G, bid;
    const float* in[28]; float* out; unsigned char* ws; unsigned* ctl;
};
#define WSP(type, off) ((type*)(F.ws + (off)))

__device__ __forceinline__ TrDesc tr_decode(Frame& F, int it) {
    constexpr int I_IN = (DM / 64) * (INW / 64), I_GLU = (SW / 64) * (2 * DM / 64), I_PA = (AW / 64) * (DM / 64), I_OUT = (DM / 64) * (DM / 64), I_XQ = (DM / 64) * (XW / 64),
                  I_XKV = (DM / 64) * (2 * XW / 64), I_XO = (XW / 64) * (DM / 64), I_GU1 = (DM / 64) * (2 * DFF / 64), I_DN1 = (DFF / 64) * (DM / 64);
    int r = it;
    if (r < I_IN) return TrDesc{F.in[I_WIN], F.in[I_GMIX], WSP(bf16_t, WS_WIN), DM, INW, 0, r}; r -= I_IN;
    if (r < I_GLU) return TrDesc{F.in[I_WGLU], nullptr, WSP(bf16_t, WS_WGLU), SW, 2 * DM, 1, r}; r -= I_GLU;
    if (r < I_PA) return TrDesc{F.in[I_WPA], nullptr, WSP(bf16_t, WS_WPA), AW, DM, 0, r}; r -= I_PA;
    if (r < I_OUT) return TrDesc{F.in[I_WOUT], nullptr, WSP(bf16_t, WS_WOUT), DM, DM, 0, r}; r -= I_OUT;
    if (r < I_XQ) return TrDesc{F.in[I_WXQ], F.in[I_GXATTN], WSP(bf16_t, WS_WXQ), DM, XW, 0, r}; r -= I_XQ;
    if (r < I_XKV) return TrDesc{F.in[I_WXKV], nullptr, WSP(bf16_t, WS_WXKV), DM, 2 * XW, 0, r}; r -= I_XKV;
    if (r < I_XO) return TrDesc{F.in[I_WXO], nullptr, WSP(bf16_t, WS_WXO), XW, DM, 0, r}; r -= I_XO;
    const int e = r / (I_GU1 + I_DN1); r -= e * (I_GU1 + I_DN1);
    if (r < I_GU1) return TrDesc{F.in[I_WGU] + (size_t)e * DM * 2 * DFF, F.in[I_GMOE], (bf16_t*)(F.ws + WS_WGU + (MOE1_FP8 ? (size_t)e * 2 * DFF * DM : (size_t)e * 2 * DFF * DM * 2)), DM, 2 * DFF, 1, r, MOE1_FP8};
    return TrDesc{F.in[I_WDN] + (size_t)e * DFF * DM, nullptr, (bf16_t*)(F.ws + WS_WDN + (MOE2_FP8 ? (size_t)e * DM * DFF : (size_t)e * DM * DFF * 2)), DFF, DM, 0, r - I_GU1, MOE2_FP8};
}
__device__ __forceinline__ void xrow_load(const float* X, int m, f32x4 (&v)[4][4], int lane) {
#pragma unroll
    for (int r = 0; r < 4; ++r)
#pragma unroll
        for (int j = 0; j < 4; ++j) v[r][j] = ((const f32x4*)(X + (size_t)(m + r) * DM))[lane + 64 * j];
}
__device__ __forceinline__ void xrow_finish(bf16_t* XBp, int m, const f32x4 (&v)[4][4], int lane) {
    float ss[4];
#pragma unroll
    for (int r = 0; r < 4; ++r) { float s = 0.f;
#pragma unroll
        for (int j = 0; j < 4; ++j) s += (v[r][j][0] * v[r][j][0] + v[r][j][1] * v[r][j][1]) + (v[r][j][2] * v[r][j][2] + v[r][j][3] * v[r][j][3]);
        ss[r] = s; }
#pragma unroll
    for (int o = 1; o < 64; o <<= 1) {
#pragma unroll
        for (int r = 0; r < 4; ++r) ss[r] += __shfl_xor(ss[r], o); }
#pragma unroll
    for (int r = 0; r < 4; ++r) { u32x2* o8 = (u32x2*)(XBp + (size_t)(m + r) * DM) + lane;
        const float rs = 1.0f / sqrtf(ss[r] * (1.0f / DM) + RMS_EPS);
#pragma unroll
        for (int j = 0; j < 4; ++j) { u32x2 o; o.x = pk2(v[r][j][0] * rs, v[r][j][1] * rs); o.y = pk2(v[r][j][2] * rs, v[r][j][3] * rs); o8[64 * j] = o; } }
}
constexpr int TR_SMALL = (DM / 64) * (INW / 64) + (SW / 64) * (2 * DM / 64) + (AW / 64) * (DM / 64) + (DM / 64) * (DM / 64) + (DM / 64) * (XW / 64) + (DM / 64) * (2 * XW / 64) + (XW / 64) * (DM / 64);
constexpr int TR_ALL = TR_SMALL + NE * ((DM / 64) * (2 * DFF / 64) + (DFF / 64) * (DM / 64));
__device__ __forceinline__ void convert_weights(Frame& F, int which, int gw, int NGW) {
    LAS float* scr = (LAS float*)(F.lds + F.wave * 16384);
    const int lo = (which == 1) ? TR_SMALL : 0, hi = (which == 0) ? TR_SMALL : TR_ALL, first = lo + gw;
    f32x4 va[16], vb[16]; float ga[16], gb[16]; TrDesc da, db; const int n = (first < hi) ? (hi - first + NGW - 1) / NGW : 0;
    if (n > 0) { da = tr_decode(F, first); tr_load(da, va, ga, F.lane); int i = 0;
        for (; i + 2 <= n; i += 2) {
            db = tr_decode(F, first + (i + 1) * NGW); tr_load(db, vb, gb, F.lane);
            tr_finish(da, va, ga, scr, F.lane);
            da = tr_decode(F, first + min(i + 2, n - 1) * NGW); tr_load(da, va, ga, F.lane);
            tr_finish(db, vb, gb, scr, F.lane); }
        if (i < n) tr_finish(da, va, ga, scr, F.lane); }
}
__device__ __forceinline__ void phase_prologue(Frame& F) {
    LAS float* scr = (LAS float*)(F.lds + F.wave * 16384);
    const int gw = F.bid * 8 + F.wave, NGW = F.G * 8;
    { f32x4 va[4][4], vb[4][4]; const int step = NGW * 4, m0 = gw * 4, n = (m0 < T_) ? (T_ - m0 + step - 1) / step : 0;
      if (n > 0) { xrow_load(F.in[I_X], m0, va, F.lane); int i = 0;
          for (; i + 2 <= n; i += 2) {
              xrow_load(F.in[I_X], m0 + (i + 1) * step, vb, F.lane);
              xrow_finish(WSP(bf16_t, WS_XB), m0 + i * step, va, F.lane);
              xrow_load(F.in[I_X], m0 + min(i + 2, n - 1) * step, va, F.lane);
              xrow_finish(WSP(bf16_t, WS_XB), m0 + (i + 1) * step, vb, F.lane); }
          if (i < n) xrow_finish(WSP(bf16_t, WS_XB), m0 + i * step, va, F.lane); } }
    for (int m = gw; m < NB * MEML; m += NGW) (void)rms_row_to_bf16<1>(F.in[I_MEM] + (size_t)m * DM, F.in[I_GMEM], WSP(bf16_t, WS_MN) + (size_t)m * DM, F.lane);
    convert_weights(F, (CONV_SLOTS > 0 && (F.G >> 3) > CONV_SLOTS && (F.G & 7) == 0) ? 0 : 2, gw, NGW);
}

__device__ __forceinline__ void phase_kmean(Frame& F) {
    LAS float* red = (LAS float*)F.lds;
    const bf16_t* Kb = WSP(bf16_t, WS_K);
    for (int it = F.bid; it < NB * NH * NBLK; it += F.G) {
        const int j = it % NBLK, h = (it / NBLK) % NH, b = it / (NBLK * NH);
        const int col = F.tid & 63, rg = F.tid >> 6; float s = 0.f;
        const bf16_t* p = Kb + ((size_t)(b * SEQ + j * MBLK + rg * 32)) * AW + h * HD + col;
#pragma unroll 8
        for (int r = 0; r < 32; ++r) s += bf2f(p[(size_t)r * AW]);
        red[rg * 64 + col] = s;
        __syncthreads();
        if (F.tid < 64) { float t = 0.f;
#pragma unroll
            for (int k = 0; k < 8; ++k) t += red[k * 64 + F.tid];
            WSP(float, WS_KMEAN)[(size_t)it * HD + F.tid] = t * (1.0f / MBLK); }
        __syncthreads();
    }
}

__device__ __forceinline__ void phase_moba_simple(Frame& F, bf16_t* Ob) {
    LAS unsigned* Ks = (LAS unsigned*)F.lds;
    LAS unsigned* Vs = (LAS unsigned*)(F.lds + 32768);
    LAS float* km = (LAS float*)(F.lds + 65536);
    const bf16_t *Qb = WSP(bf16_t, WS_Q), *Kb = WSP(bf16_t, WS_K), *Vb = WSP(bf16_t, WS_V);
    const int ql = F.tid >> 1, half = F.tid & 1;
    for (int it = F.bid; it < NB * NH * NBLK; it += F.G) {
        const int iblk = (NBLK - 1) - (it % NBLK), h = (it / NBLK) % NH, b = it / (NBLK * NH);
        __syncthreads();
        for (int k = F.tid; k < NBLK * HD; k += 512) km[k] = WSP(float, WS_KMEAN)[(size_t)((b * NH + h) * NBLK) * HD + k] + WSP(float, WS_KMEAN)[(size_t)((NB * NH + b * NH + h) * NBLK) * HD + k];
        float q[32];
        { const u32x4* qp = (const u32x4*)(Qb + (size_t)(b * SEQ + iblk * MBLK + ql) * AW + h * HD + half * 32);
#pragma unroll
          for (int c = 0; c < 4; ++c) { const u32x4 w = qp[c]; q[8 * c + 0] = bflo(w.x); q[8 * c + 1] = bfhi(w.x); q[8 * c + 2] = bflo(w.y); q[8 * c + 3] = bfhi(w.y); q[8 * c + 4] = bflo(w.z); q[8 * c + 5] = bfhi(w.z); q[8 * c + 6] = bflo(w.w); q[8 * c + 7] = bfhi(w.w); } }
        __syncthreads();
        float g0 = -3e38f, g1 = -3e38f, g2 = -3e38f; int s0 = -1, s1 = -1, s2 = -1;
        for (int j = 0; j < iblk; ++j) { float g = 0.f;
#pragma unroll
            for (int d = 0; d < 32; ++d) g += q[d] * km[j * HD + half * 32 + d];
            g += __shfl_xor(g, 1);
            if (g > g0) { g2 = g1; s2 = s1; g1 = g0; s1 = s0; g0 = g; s0 = j; } else if (g > g1) { g2 = g1; s2 = s1; g1 = g; s1 = j; } else if (g > g2) { g2 = g; s2 = j; } }
        float mx = -3e38f, l = 0.f, o[32];
#pragma unroll
        for (int d = 0; d < 32; ++d) o[d] = 0.f;
        for (int jb = 0; jb <= iblk; ++jb) {
            __syncthreads();
            { const size_t rowb = (size_t)(b * SEQ + jb * MBLK);
              for (int c = F.tid; c < 256 * 8; c += 512) { const int r = c >> 3, ch = c & 7;
                  *(LAS u32x4*)(Ks + r * 32 + ch * 4) = *(const u32x4*)(Kb + (rowb + r) * AW + h * HD + ch * 8);
                  *(LAS u32x4*)(Vs + r * 32 + ch * 4) = *(const u32x4*)(Vb + (rowb + r) * AW + h * HD + ch * 8); } }
            __syncthreads();
            const bool need = (jb == iblk) || jb == s0 || jb == s1 || jb == s2;
            if (need) { const int kend = (jb == iblk) ? ql : 255;
                for (int kk = 0; kk <= kend; ++kk) { float s = 0.f;
#pragma unroll
                    for (int c = 0; c < 4; ++c) { const u32x4 w = *(const LAS u32x4*)(Ks + kk * 32 + half * 16 + c * 4);
                        s += q[8 * c + 0] * bflo(w.x) + q[8 * c + 1] * bfhi(w.x) + q[8 * c + 2] * bflo(w.y) + q[8 * c + 3] * bfhi(w.y) + q[8 * c + 4] * bflo(w.z) + q[8 * c + 5] * bfhi(w.z) + q[8 * c + 6] * bflo(w.w) + q[8 * c + 7] * bfhi(w.w); }
                    s += __shfl_xor(s, 1);
                    const float mn = fmaxf(mx, s), corr = __builtin_amdgcn_exp2f(mx - mn), p = __builtin_amdgcn_exp2f(s - mn); mx = mn; l = l * corr + p;
#pragma unroll
                    for (int c = 0; c < 4; ++c) { const u32x4 w = *(const LAS u32x4*)(Vs + kk * 32 + half * 16 + c * 4);
                        o[8 * c + 0] = o[8 * c + 0] * corr + p * bflo(w.x); o[8 * c + 1] = o[8 * c + 1] * corr + p * bfhi(w.x); o[8 * c + 2] = o[8 * c + 2] * corr + p * bflo(w.y); o[8 * c + 3] = o[8 * c + 3] * corr + p * bfhi(w.y);
                        o[8 * c + 4] = o[8 * c + 4] * corr + p * bflo(w.z); o[8 * c + 5] = o[8 * c + 5] * corr + p * bfhi(w.z); o[8 * c + 6] = o[8 * c + 6] * corr + p * bflo(w.w); o[8 * c + 7] = o[8 * c + 7] * corr + p * bfhi(w.w); } } }
        }
        const float il = 1.0f / l;
        u32x4* op = (u32x4*)(Ob + (size_t)(b * SEQ + iblk * MBLK + ql) * AW + h * HD + half * 32);
#pragma unroll
        for (int c = 0; c < 4; ++c) { u32x4 w; w.x = pk2(o[8 * c + 0] * il, o[8 * c + 1] * il); w.y = pk2(o[8 * c + 2] * il, o[8 * c + 3] * il); w.z = pk2(o[8 * c + 4] * il, o[8 * c + 5] * il); w.w = pk2(o[8 * c + 6] * il, o[8 * c + 7] * il); op[c] = w; }
    }
}

__device__ __forceinline__ void phase_ssm_simple(Frame& F, bf16_t* Yb) {
    const int gw = F.bid * 8 + F.wave, NGW = F.G * 8, p = F.lane;
    const bf16_t* Ub = WSP(bf16_t, WS_U);
    for (int it = gw; it < NB * NG; it += NGW) {
        const int g = it % NG, b = it / NG;
        const float are = fminf(F.in[I_ARE][g * SP + p], -1e-4f), aim = F.in[I_AIM][g * SP + p], dt = expf(F.in[I_LOGDT][g]);
        const float mag = expf(are * dt), ang = aim * dt; const float lr = mag * cosf(ang), li = mag * sinf(ang);
        const float nr = lr - 1.0f, ni = li, den = 1.0f / (are * are + aim * aim); const float fr_ = (nr * are + ni * aim) * den, fi_ = (ni * are - nr * aim) * den;
        float bbr[16], bbi[16], cr[16], ci[16], dsk[16];
#pragma unroll
        for (int c = 0; c < 16; ++c) { const float br = F.in[I_BRE][(size_t)(g * SP + p) * SGC + c], bi = F.in[I_BIM][(size_t)(g * SP + p) * SGC + c];
            bbr[c] = fr_ * br - fi_ * bi; bbi[c] = fr_ * bi + fi_ * br;
            cr[c] = F.in[I_CRE][(size_t)(g * SGC + c) * SP + p]; ci[c] = F.in[I_CIM][(size_t)(g * SGC + c) * SP + p]; dsk[c] = F.in[I_DSKIP][g * SGC + c]; }
        float xr = 0.f, xi = 0.f;
        const int csel = ((p >> 5) & 1) * 8 + ((p >> 4) & 1) * 4 + ((p >> 3) & 1) * 2 + ((p >> 2) & 1);
        float dmine = 0.f;
#pragma unroll
        for (int c = 0; c < 16; ++c) dmine = (c == csel) ? dsk[c] : dmine;
        for (int t = 0; t < SEQ; ++t) {
            const u32x4* up = (const u32x4*)(Ub + (size_t)(b * SEQ + t) * SW + g * SGC); const u32x4 w0 = up[0], w1 = up[1];
            float u[16]; u[0] = bflo(w0.x); u[1] = bfhi(w0.x); u[2] = bflo(w0.y); u[3] = bfhi(w0.y); u[4] = bflo(w0.z); u[5] = bfhi(w0.z); u[6] = bflo(w0.w); u[7] = bfhi(w0.w);
            u[8] = bflo(w1.x); u[9] = bfhi(w1.x); u[10] = bflo(w1.y); u[11] = bfhi(w1.y); u[12] = bflo(w1.z); u[13] = bfhi(w1.z); u[14] = bflo(w1.w); u[15] = bfhi(w1.w);
            float sr = 0.f, si = 0.f;
#pragma unroll
            for (int c = 0; c < 16; ++c) { sr += bbr[c] * u[c]; si += bbi[c] * u[c]; }
            const float nxr = lr * xr - li * xi + sr, nxi = lr * xi + li * xr + si; xr = nxr; xi = nxi;
            float y[16];
#pragma unroll
            for (int c = 0; c < 16; ++c) y[c] = cr[c] * xr - ci[c] * xi;
            float w8[8], w4[4], w2[2], w1_;
            { const bool hi = (p & 32) != 0;
#pragma unroll
              for (int i = 0; i < 8; ++i) { const float keep = hi ? y[i + 8] : y[i], send = hi ? y[i] : y[i + 8]; w8[i] = keep + __shfl_xor(send, 32); } }
            { const bool hi = (p & 16) != 0;
#pragma unroll
              for (int i = 0; i < 4; ++i) { const float keep = hi ? w8[i + 4] : w8[i], send = hi ? w8[i] : w8[i + 4]; w4[i] = keep + __shfl_xor(send, 16); } }
            { const bool hi = (p & 8) != 0;
#pragma unroll
              for (int i = 0; i < 2; ++i) { const float keep = hi ? w4[i + 2] : w4[i], send = hi ? w4[i] : w4[i + 2]; w2[i] = keep + __shfl_xor(send, 8); } }
            { const bool hi = (p & 4) != 0; const float keep = hi ? w2[1] : w2[0], send = hi ? w2[0] : w2[1]; w1_ = keep + __shfl_xor(send, 4); }
            w1_ += __shfl_xor(w1_, 2); w1_ += __shfl_xor(w1_, 1);
            float umine = 0.f;
#pragma unroll
            for (int c = 0; c < 16; ++c) umine = (c == csel) ? u[c] : umine;
            if ((p & 3) == 0) Yb[(size_t)(b * SEQ + t) * SW + g * SGC + csel] = (bf16_t)f2bf(gelu_tanh(w1_ + dmine * umine));
        }
    }
}


__device__ __forceinline__ void p0_ssm_tables(Frame& F, int task) {
    const int g = task >> 3, part = task & 7;
    LAS float* pwr = (LAS float*)F.lds; LAS float* pwi = pwr + 65 * 64; LAS float* bbr = pwi + 65 * 64; LAS float* bbi = bbr + 1024; LAS float* ccr = bbi + 1024; LAS float* cci = ccr + 1024;
    const float dt = expf(F.in[I_LOGDT][g]);
    __syncthreads();
    for (int i = F.tid; i < 65 * 64; i += 512) { const int k = i >> 6, p = i & 63; const float are = fminf(F.in[I_ARE][g * SP + p], -1e-4f), aim = F.in[I_AIM][g * SP + p];
        const float mag = expf(are * dt * (float)k); double a = (double)aim * (double)dt * (double)k; a -= 6.283185307179586 * rint(a * 0.15915494309189535); const float af = (float)a;
        pwr[i] = mag * cosf(af); pwi[i] = mag * sinf(af); }
    for (int i = F.tid; i < 1024; i += 512) { const int p = i >> 4, c = i & 15; const float are = fminf(F.in[I_ARE][g * SP + p], -1e-4f), aim = F.in[I_AIM][g * SP + p];
        const float mag = expf(are * dt); double a = (double)aim * (double)dt; a -= 6.283185307179586 * rint(a * 0.15915494309189535); const float af = (float)a;
        const float lr = mag * cosf(af), li = mag * sinf(af), nr = lr - 1.0f, ni = li, den = 1.0f / (are * are + aim * aim), fr_ = (nr * are + ni * aim) * den, fi_ = (ni * are - nr * aim) * den;
        const float br = F.in[I_BRE][(size_t)(g * SP + p) * SGC + c], bi = F.in[I_BIM][(size_t)(g * SP + p) * SGC + c];
        bbr[i] = fr_ * br - fi_ * bi; bbi[i] = fr_ * bi + fi_ * br; }
    for (int i = F.tid; i < 1024; i += 512) { ccr[i] = F.in[I_CRE][(size_t)g * 1024 + i]; cci[i] = F.in[I_CIM][(size_t)g * 1024 + i]; }
    __syncthreads();
    bf16_t* WST = WSP(bf16_t, WS_WST) + (size_t)g * 128 * 1024; bf16_t* GT = WSP(bf16_t, WS_GT) + (size_t)g * 1024 * 128; bf16_t* KT = WSP(bf16_t, WS_KT) + (size_t)g * 65 * 256;
    for (int j = 0; j < 32; ++j) { const int e = part * 16384 + j * 512 + F.tid; const int pp = e >> 10, k = e & 1023, s = k >> 4, c = k & 15, p = pp & 63;
        const float mr = pwr[(63 - s) * 64 + p], mi = pwi[(63 - s) * 64 + p], br = bbr[p * 16 + c], bi = bbi[p * 16 + c];
        WST[e] = (bf16_t)f2bf(pp < 64 ? (mr * br - mi * bi) : (mr * bi + mi * br)); }
    for (int j = 0; j < 32; ++j) { const int e = part * 16384 + j * 512 + F.tid; const int sc = e >> 7, pp = e & 127, s = sc >> 4, c = sc & 15, p = pp & 63;
        const float mr = pwr[(s + 1) * 64 + p], mi = pwi[(s + 1) * 64 + p], cr = ccr[c * 64 + p], ci = cci[c * 64 + p];
        GT[e] = (bf16_t)f2bf(pp < 64 ? (cr * mr - ci * mi) : -(cr * mi + ci * mr)); }
    for (int e = part * 2080 + F.tid; e < (part + 1) * 2080; e += 512) { const int tt = e >> 8, c = (e >> 4) & 15, c2 = e & 15; float acc = 0.f;
        if (tt > 0) { const int tau = tt - 1;
            for (int p = 0; p < 64; ++p) { const float mr = pwr[tau * 64 + p], mi = pwi[tau * 64 + p], cr = ccr[c * 64 + p], ci = cci[c * 64 + p]; const float zr = cr * mr - ci * mi, zi = cr * mi + ci * mr; acc += zr * bbr[p * 16 + c2] - zi * bbi[p * 16 + c2]; } }
        KT[e] = (bf16_t)f2bf(acc); }
    if (part == 0 && F.tid < 64) { WSP(f32x2, WS_LAML)[g * 64 + F.tid] = (f32x2){pwr[64 * 64 + F.tid], pwi[64 * 64 + F.tid]}; }
    __syncthreads();
}
__device__ __forceinline__ void ssm_state_item(Frame& F, int b, int g, int h) {
    const int w = F.wave, row = F.lane & 15, kg = F.lane >> 4;
    f32x4 acc[4];
#pragma unroll
    for (int c = 0; c < 4; ++c) acc[c] = (f32x4){0.f, 0.f, 0.f, 0.f};
    const bf16_t* Ub = WSP(bf16_t, WS_U) + ((size_t)b * SEQ + (size_t)(16 * w + row) * 64 + (kg >> 1)) * SW + g * SGC + 8 * (kg & 1);
    const bf16_t* Wb = WSP(bf16_t, WS_WST) + ((size_t)g * 128 + 32 * h + row) * 1024 + 8 * kg;
#pragma unroll 4
    for (int ks = 0; ks < 32; ++ks) {
        const bf16x8 a = *(const bf16x8*)(Ub + ((size_t)(2 * ks)) * SW);
        bf16x8 bq[4];
#pragma unroll
        for (int nt = 0; nt < 4; ++nt) bq[nt] = *(const bf16x8*)(Wb + (size_t)((nt & 1) * 16 + (nt >> 1) * 64) * 1024 + 32 * ks);
#pragma unroll
        for (int nt = 0; nt < 4; ++nt) acc[nt] = __builtin_amdgcn_mfma_f32_16x16x32_bf16(a, bq[nt], acc[nt], 0, 0, 0);
    }
    LAS float* X = (LAS float*)F.lds;
    __syncthreads();
#pragma unroll
    for (int nt = 0; nt < 4; ++nt)
#pragma unroll
        for (int r = 0; r < 4; ++r) X[(16 * w + 4 * kg + r) * 64 + (nt >> 1) * 32 + (nt & 1) * 16 + row] = acc[nt][r];
    __syncthreads();
    if (w == 0 && F.lane < 32) { const int p = 32 * h + F.lane; const f32x2 lam = WSP(f32x2, WS_LAML)[g * 64 + p]; float sr = 0.f, si = 0.f;
        bf16_t* SS = WSP(bf16_t, WS_SST) + ((size_t)(b * NG + g) * 128) * 128;
#pragma unroll 4
        for (int n = 0; n < 128; ++n) { SS[n * 128 + p] = (bf16_t)f2bf(sr); SS[n * 128 + 64 + p] = (bf16_t)f2bf(si);
            const float xr = X[n * 64 + F.lane], xi = X[n * 64 + 32 + F.lane]; const float nsr = lam.x * sr - lam.y * si + xr, nsi = lam.x * si + lam.y * sr + xi; sr = nsr; si = nsi; } }
    __syncthreads();
}
constexpr int SO_USTR = 2064, SO_KT = 32 * SO_USTR, SO_SS = SO_KT + 65 * 512, SO_SSTR = 272;
__device__ __forceinline__ void ssm_out_item(Frame& F, int b, int g, int rr) {
    LAS unsigned char* L = F.lds;
    const int w = F.wave, lane = F.lane, r32 = lane & 31, hi = lane >> 5, sp = r32 >> 4, cch = r32 & 15;
    __syncthreads();
    { const bf16_t* Ug = WSP(bf16_t, WS_U) + ((size_t)b * SEQ + (size_t)rr * 2048) * SW + g * SGC;
#pragma unroll
      for (int j = 0; j < 8; ++j) { const int c = F.tid + 512 * j, r = c >> 1, half = c & 1; *(LAS u32x4*)(L + (r >> 6) * SO_USTR + (r & 63) * 32 + half * 16) = *(const u32x4*)(Ug + (size_t)r * SW + half * 8); }
      const u32x4* Kg = (const u32x4*)(WSP(bf16_t, WS_KT) + (size_t)g * 65 * 256);
      for (int c = F.tid; c < 2080; c += 512) *(LAS u32x4*)(L + SO_KT + c * 16) = Kg[c];
      { const int c = F.tid, ch = c >> 4, pc = c & 15; *(LAS u32x4*)(L + SO_SS + ch * SO_SSTR + pc * 16) = *(const u32x4*)(WSP(bf16_t, WS_SST) + ((size_t)((b * NG + g) * 128 + rr * 32 + ch)) * 128 + pc * 8); } }
    const bf16_t* Gg = WSP(bf16_t, WS_GT) + ((size_t)g * 1024 + (2 * w + sp) * 16 + cch) * 128 + 8 * hi;
    bf16x8 gb[2][8];
#pragma unroll
    for (int k2 = 0; k2 < 8; ++k2) gb[0][k2] = *(const bf16x8*)(Gg + 16 * k2);
    __syncthreads();
    f32x16 acc[4];
#pragma unroll
    for (int a = 0; a < 4; ++a)
#pragma unroll
        for (int r = 0; r < 16; ++r) acc[a][r] = 0.f;
    const LAS unsigned char* Ua = L + r32 * SO_USTR + hi * 16;
    const LAS unsigned char* Kb_ = L + SO_KT + (2 * w + sp + 1) * 512 + cch * 32 + hi * 16;
#define SO_SEG(A0, LO, HI) for (int s1 = (LO); s1 < (HI); ++s1) { const bf16x8 av = *(const LAS bf16x8*)(Ua + s1 * 32); \
        _Pragma("unroll") for (int a = (A0); a < 4; ++a) { const bf16x8 bv = *(const LAS bf16x8*)(Kb_ + a * 8192 - s1 * 512); acc[a] = __builtin_amdgcn_mfma_f32_32x32x16_bf16(av, bv, acc[a], 0, 0, 0); } }
    SO_SEG(0, 0, 2 * w + 2)
    SO_SEG(1, 2 * w + 2, 2 * w + 18)
    SO_SEG(2, 2 * w + 18, 2 * w + 34)
    SO_SEG(3, 2 * w + 34, 2 * w + 50)
#undef SO_SEG
    bf16x8 sa[8];
#pragma unroll
    for (int k2 = 0; k2 < 8; ++k2) sa[k2] = *(const LAS bf16x8*)(L + SO_SS + r32 * SO_SSTR + k2 * 32 + hi * 16);
#pragma unroll
    for (int a = 0; a < 4; ++a) {
        if (a < 3) {
#pragma unroll
            for (int k2 = 0; k2 < 8; ++k2) gb[(a + 1) & 1][k2] = *(const bf16x8*)(Gg + (size_t)(a + 1) * (16 * 16 * 128) + 16 * k2); }
#pragma unroll
        for (int k2 = 0; k2 < 8; ++k2) acc[a] = __builtin_amdgcn_mfma_f32_32x32x16_bf16(sa[k2], gb[a & 1][k2], acc[a], 0, 0, 0);
    }
    __syncthreads();
    const float dsk = F.in[I_DSKIP][g * SGC + cch];
    { LAS unsigned char* yb = L + (4 * hi) * SO_USTR + (2 * w + sp) * 32 + cch * 2;
#pragma unroll
      for (int a = 0; a < 4; ++a)
#pragma unroll
          for (int r = 0; r < 16; ++r) { LAS unsigned short* p = (LAS unsigned short*)(yb + ((r & 3) + 8 * (r >> 2)) * SO_USTR + a * 512); const float u = bf2f(*p); *p = (unsigned short)f2bf(gelu_tanh(acc[a][r] + dsk * u)); } }
    __syncthreads();
    { bf16_t* Yg = WSP(bf16_t, WS_YB) + ((size_t)b * SEQ + (size_t)rr * 2048) * SW + g * SGC;
#pragma unroll 2
      for (int j = 0; j < 8; ++j) { const int c = F.tid + 512 * j, r = c >> 1, half = c & 1; *(u32x4*)(Yg + (size_t)r * SW + half * 8) = *(const LAS u32x4*)(L + (r >> 6) * SO_USTR + (r & 63) * 32 + half * 16); } }
}
__device__ __forceinline__ void phase_ssm_out(Frame& F) {
    for (int it = F.bid; it < NB * NG * 4; it += F.G) ssm_out_item(F, it >> 7, (it >> 2) & 31, it & 3);
    __syncthreads();
}


__device__ __forceinline__ void moba_route_item(Frame& F, int bh, int i) {
    LAS float* km = (LAS float*)F.lds;
    LAS unsigned* lc = (LAS unsigned*)(F.lds + 8192); LAS unsigned* lb = lc + 32;
    const int b = bh >> 3, h = bh & 7, ql = F.tid >> 1, half = F.tid & 1;
    __syncthreads();
    { const float* K0 = WSP(float, WS_KM2) + (size_t)bh * NBLK * HD; const float* K1 = K0 + (size_t)NB * NH * NBLK * HD;
      for (int k = F.tid; k < NBLK * HD; k += 512) km[k] = K0[k] + K1[k]; }
    if (F.tid < 32) lc[F.tid] = 0u;
    float q[32];
    { const u32x4* qp = (const u32x4*)(WSP(bf16_t, WS_Q) + (size_t)(b * SEQ + i * MBLK + ql) * AW + h * HD + half * 32);
#pragma unroll
      for (int c = 0; c < 4; ++c) { const u32x4 w = qp[c]; q[8 * c + 0] = bflo(w.x); q[8 * c + 1] = bfhi(w.x); q[8 * c + 2] = bflo(w.y); q[8 * c + 3] = bfhi(w.y); q[8 * c + 4] = bflo(w.z); q[8 * c + 5] = bfhi(w.z); q[8 * c + 6] = bflo(w.w); q[8 * c + 7] = bfhi(w.w); } }
    __syncthreads();
    float g0 = -3e38f, g1 = -3e38f, g2 = -3e38f; int s0 = -1, s1 = -1, s2 = -1;
    for (int j = 0; j < i; ++j) { float g = 0.f;
#pragma unroll
        for (int d = 0; d < 32; ++d) g += q[d] * km[j * HD + half * 32 + d];
        g += __shfl_xor(g, 1);
        if (g > g0) { g2 = g1; s2 = s1; g1 = g0; s1 = s0; g0 = g; s0 = j; } else if (g > g1) { g2 = g1; s2 = s1; g1 = g; s1 = j; } else if (g > g2) { g2 = g; s2 = j; } }
    unsigned r0 = 0u, r1 = 0u, r2 = 0u;
    if (half == 0) { if (s0 >= 0) r0 = __hip_atomic_fetch_add(&lc[s0], 1u, __ATOMIC_RELAXED, __HIP_MEMORY_SCOPE_WORKGROUP); if (s1 >= 0) r1 = __hip_atomic_fetch_add(&lc[s1], 1u, __ATOMIC_RELAXED, __HIP_MEMORY_SCOPE_WORKGROUP);
        if (s2 >= 0) r2 = __hip_atomic_fetch_add(&lc[s2], 1u, __ATOMIC_RELAXED, __HIP_MEMORY_SCOPE_WORKGROUP); }
    __syncthreads();
    if (F.tid < 32) { const unsigned n = lc[F.tid]; lb[F.tid] = n ? atomicAdd(F.ctl + CW_MCNT + bh * NBLK + F.tid, n) : 0u; }
    __syncthreads();
    if (half == 0) { unsigned short* ML = WSP(unsigned short, WS_MLIST) + (size_t)bh * NBLK * 8192; const unsigned e = (unsigned)(i * MBLK + ql) * 4u;
        f32x2* pml = WSP(f32x2, WS_PML) + ((size_t)bh * SEQ + i * MBLK + ql) * 4;
        if (s0 >= 0) ML[(size_t)s0 * 8192 + lb[s0] + r0] = (unsigned short)(e + 0u); else pml[0] = (f32x2){-1e30f, 0.f};
        if (s1 >= 0) ML[(size_t)s1 * 8192 + lb[s1] + r1] = (unsigned short)(e + 1u); else pml[1] = (f32x2){-1e30f, 0.f};
        if (s2 >= 0) ML[(size_t)s2 * 8192 + lb[s2] + r2] = (unsigned short)(e + 2u); else pml[2] = (f32x2){-1e30f, 0.f}; }
}
template <int EXPM> __device__ __forceinline__ void moba_sparse_phase(Frame& F, char* lds_generic, int nslots) {
    LAS unsigned* cl = (LAS unsigned*)(F.lds + attn_body::LDS_BYTES);
    LAS unsigned* pf = cl + 128;
    const int x = F.bid & 7;
    __syncthreads();
    if (F.tid < 128) cl[F.tid] = __hip_atomic_load(F.ctl + CW_MCNT + (x + 8 * (F.tid >> 5)) * NBLK + (F.tid & 31), RLX_AGENT);
    __syncthreads();
    if (F.tid == 0) { unsigned a = 0; for (int i = 0; i < 128; ++i) { pf[i] = a; a += 1u + ((cl[i] + 255u) >> 8); } pf[128] = a; }
    __syncthreads();
    const int total = (int)pf[128];
    LAS int* grab = (LAS int*)(pf + 132); unsigned* gctr = F.ctl + CW_ACNT + 64 * x;
    const attn_body::bf16* Qb = (const attn_body::bf16*)WSP(bf16_t, WS_Q); const attn_body::bf16* Kb = (const attn_body::bf16*)WSP(bf16_t, WS_K); const attn_body::bf16* Vb = (const attn_body::bf16*)WSP(bf16_t, WS_V);
    attn_body::bf16* PO = (attn_body::bf16*)WSP(bf16_t, WS_PO); float* PML = WSP(float, WS_PML);
    const int wid = F.wave;
    int L = 0;
    for (;;) {
    __syncthreads();
    if (F.tid == 0) { const int cur = (int)__hip_atomic_load(gctr, RLX_AGENT); int g = (total - cur) / (2 * nslots); g = g < 2 ? 2 : g; const int p = (int)__hip_atomic_fetch_add(gctr, (unsigned)g, RLX_AGENT); grab[0] = p; grab[1] = min(p + g, total); }
    __syncthreads();
    int pos = grab[0]; const int end = grab[1];
    if (pos >= total) break;
    while (pos < end) {
        while ((int)pf[L + 1] <= pos) ++L;
        const int m = L >> 5, j = L & 31, bh = x + 8 * m, b = bh >> 3, h = bh & 7, cnt = (int)cl[L];
        const int c0 = pos - (int)pf[L], c1 = min((int)pf[L + 1], end) - (int)pf[L];
        const size_t kvrow = (size_t)b * SEQ + (size_t)j * MBLK;
        __syncthreads();
        attn_body::moba_load_kv(Kb + kvrow * AW + h * HD, Vb + kvrow * AW + h * HD, lds_generic);
        __syncthreads();
        for (int c = c0; c < c1; ++c) {
            int l_ = F.lane; asm volatile("" : "+v"(l_)); const int r32 = l_ & 31;
            int qg, dest; bool causal;
            if (c == 0) { qg = j * MBLK + wid * 32 + r32; dest = (EXPM == 1) ? -1 : (bh * SEQ + qg) * 4 + 3; causal = true; }
            else { const int base = (c - 1) * 256 + wid * 32; if (base >= cnt) continue;
                const int idx = base + r32; causal = false;
                if (EXPM == 1) { qg = j * MBLK + wid * 32 + r32; dest = -1; }
                else if (idx < cnt) { const unsigned e = WSP(unsigned short, WS_MLIST)[((size_t)bh * NBLK + j) * 8192 + idx]; qg = (int)(e >> 2); dest = (bh * SEQ + qg) * 4 + (int)(e & 3u); }
                else { qg = j * MBLK + r32; dest = -1; } }
            attn_body::moba_chunk4<8>(Qb + ((size_t)b * SEQ + qg) * AW + h * HD, causal, dest, PO, PML, lds_generic);
        }
        pos += c1 - c0;
    }
    }
    __syncthreads();
}
__device__ __forceinline__ void moba_combine_phase(Frame& F) {
    const bf16_t* PO = WSP(bf16_t, WS_PO); const f32x2* PML = WSP(f32x2, WS_PML); bf16_t* ATT = WSP(bf16_t, WS_ATT);
    for (size_t it = (size_t)F.bid * 512 + F.tid; it < (size_t)NB * NH * SEQ * 8; it += (size_t)F.G * 512) {
        const size_t r = it >> 3; const int ch = (int)(it & 7); const int bh = (int)(r / SEQ), qg = (int)(r % SEQ), b = bh >> 3, h = bh & 7;
        const f32x2 a0 = PML[r * 4 + 0], a1 = PML[r * 4 + 1], a2 = PML[r * 4 + 2], a3 = PML[r * 4 + 3];
        const float M = fmaxf(fmaxf(a0.x, a1.x), fmaxf(a2.x, a3.x));
        const float w0 = a0.y * __builtin_amdgcn_exp2f(a0.x - M), w1 = a1.y * __builtin_amdgcn_exp2f(a1.x - M), w2 = a2.y * __builtin_amdgcn_exp2f(a2.x - M), w3 = a3.y * __builtin_amdgcn_exp2f(a3.x - M);
        const float inv = 1.0f / (w0 + w1 + w2 + w3);
        float o[8] = {0.f, 0.f, 0.f, 0.f, 0.f, 0.f, 0.f, 0.f};
#define CMB(k, wk) if (wk > 0.f) { const u32x4 v = *(const u32x4*)(PO + (r * 4 + k) * 64 + ch * 8); o[0] += wk * bflo(v.x); o[1] += wk * bfhi(v.x); o[2] += wk * bflo(v.y); o[3] += wk * bfhi(v.y); o[4] += wk * bflo(v.z); o[5] += wk * bfhi(v.z); o[6] += wk * bflo(v.w); o[7] += wk * bfhi(v.w); }
        CMB(0, w0) CMB(1, w1) CMB(2, w2) CMB(3, w3)
#undef CMB
        u32x4 w; w.x = pk2(o[0] * inv, o[1] * inv); w.y = pk2(o[2] * inv, o[3] * inv); w.z = pk2(o[4] * inv, o[5] * inv); w.w = pk2(o[6] * inv, o[7] * inv);
        *(u32x4*)(ATT + ((size_t)b * SEQ + qg) * AW + h * HD + ch * 8) = w;
    }
}

__device__ __forceinline__ void phase_xattn_simple(Frame& F, bf16_t* Ob) {
    LAS unsigned* Ks = (LAS unsigned*)F.lds;
    LAS unsigned* Vs = (LAS unsigned*)(F.lds + 65536);
    const bf16_t *Qb = WSP(bf16_t, WS_XQ), *KV = WSP(bf16_t, WS_MKV);
    const int tl = F.tid >> 2, part = F.tid & 3;
    int lastbh = -1;
    for (int it = F.bid; it < NB * XH * (SEQ / 128); it += F.G) {
        const int bh = it / (SEQ / 128), ch = it % (SEQ / 128), b = bh / XH, h = bh % XH;
        if (bh != lastbh) { __syncthreads();
            for (int c = F.tid; c < 256 * 16; c += 512) { const int r = c >> 4, cc = c & 15;
                *(LAS u32x4*)(Ks + r * 64 + cc * 4) = *(const u32x4*)(KV + (size_t)(b * MEML + r) * (2 * XW) + h * XD + cc * 8);
                *(LAS u32x4*)(Vs + r * 64 + cc * 4) = *(const u32x4*)(KV + (size_t)(b * MEML + r) * (2 * XW) + XW + h * XD + cc * 8); }
            __syncthreads(); lastbh = bh; }
        const size_t row = (size_t)b * SEQ + ch * 128 + tl;
        float q[32];
        { const u32x4* qp = (const u32x4*)(Qb + row * XW + h * XD + part * 32);
#pragma unroll
          for (int c = 0; c < 4; ++c) { const u32x4 w = qp[c]; q[8 * c + 0] = bflo(w.x); q[8 * c + 1] = bfhi(w.x); q[8 * c + 2] = bflo(w.y); q[8 * c + 3] = bfhi(w.y); q[8 * c + 4] = bflo(w.z); q[8 * c + 5] = bfhi(w.z); q[8 * c + 6] = bflo(w.w); q[8 * c + 7] = bfhi(w.w); } }
        float mx = -3e38f, l = 0.f, o[32];
#pragma unroll
        for (int d = 0; d < 32; ++d) o[d] = 0.f;
        for (int kk = 0; kk < MEML; ++kk) { float s = 0.f;
#pragma unroll
            for (int c = 0; c < 4; ++c) { const u32x4 w = *(const LAS u32x4*)(Ks + kk * 64 + part * 16 + c * 4);
                s += q[8 * c + 0] * bflo(w.x) + q[8 * c + 1] * bfhi(w.x) + q[8 * c + 2] * bflo(w.y) + q[8 * c + 3] * bfhi(w.y) + q[8 * c + 4] * bflo(w.z) + q[8 * c + 5] * bfhi(w.z) + q[8 * c + 6] * bflo(w.w) + q[8 * c + 7] * bfhi(w.w); }
            s += __shfl_xor(s, 1); s += __shfl_xor(s, 2);
            const float mn = fmaxf(mx, s), corr = __builtin_amdgcn_exp2f(mx - mn), p = __builtin_amdgcn_exp2f(s - mn); mx = mn; l = l * corr + p;
#pragma unroll
            for (int c = 0; c < 4; ++c) { const u32x4 w = *(const LAS u32x4*)(Vs + kk * 64 + part * 16 + c * 4);
                o[8 * c + 0] = o[8 * c + 0] * corr + p * bflo(w.x); o[8 * c + 1] = o[8 * c + 1] * corr + p * bfhi(w.x); o[8 * c + 2] = o[8 * c + 2] * corr + p * bflo(w.y); o[8 * c + 3] = o[8 * c + 3] * corr + p * bfhi(w.y);
                o[8 * c + 4] = o[8 * c + 4] * corr + p * bflo(w.z); o[8 * c + 5] = o[8 * c + 5] * corr + p * bfhi(w.z); o[8 * c + 6] = o[8 * c + 6] * corr + p * bflo(w.w); o[8 * c + 7] = o[8 * c + 7] * corr + p * bfhi(w.w); } }
        const float il = 1.0f / l;
        u32x4* op = (u32x4*)(Ob + row * XW + h * XD + part * 32);
#pragma unroll
        for (int c = 0; c < 4; ++c) { u32x4 w; w.x = pk2(o[8 * c + 0] * il, o[8 * c + 1] * il); w.y = pk2(o[8 * c + 2] * il, o[8 * c + 3] * il); w.z = pk2(o[8 * c + 4] * il, o[8 * c + 5] * il); w.w = pk2(o[8 * c + 6] * il, o[8 * c + 7] * il); op[c] = w; }
    }
}

__device__ __forceinline__ void phase_router(Frame& F) {
    LAS float* wt = (LAS float*)F.lds;
    for (int c = F.tid; c < NE * DM; c += 512) { const int k = c >> 5, e = c & 31; wt[e * DM + k] = F.in[I_WROUTER][c] * F.in[I_GMOE][k]; }
    __syncthreads();
    const int gw = F.bid * 8 + F.wave, NGW = F.G * 8, lane = F.lane;
    const float* H = WSP(float, WS_H);
    unsigned* cnt = F.ctl + CW_CNT;
    for (int tk = gw; tk < T_; tk += NGW) {
        const f32x4* hp = (const f32x4*)(H + (size_t)tk * DM) + lane; f32x4 hv[4]; float ss = 0.f;
#pragma unroll
        for (int j = 0; j < 4; ++j) { hv[j] = hp[64 * j]; ss += (hv[j][0] * hv[j][0] + hv[j][1] * hv[j][1]) + (hv[j][2] * hv[j][2] + hv[j][3] * hv[j][3]); }
        const float rstd = 1.0f / sqrtf(wave_sum(ss) * (1.0f / DM) + RMS_EPS);
        float mylogit = 0.f;
#pragma unroll 4
        for (int e = 0; e < NE; ++e) { float a = 0.f;
#pragma unroll
            for (int j = 0; j < 4; ++j) { const f32x4 w = *(const LAS f32x4*)(wt + e * DM + 4 * lane + 256 * j); a += (hv[j][0] * w[0] + hv[j][1] * w[1]) + (hv[j][2] * w[2] + hv[j][3] * w[3]); }
            a = wave_sum(a);
            mylogit = (lane == e) ? a : mylogit; }
        mylogit = (lane < NE) ? (mylogit * rstd + F.in[I_BROUTER][lane & 31]) : -3e38f;
        float tv[4]; int ti[4]; float cur = mylogit;
#pragma unroll
        for (int s = 0; s < 4; ++s) { float bv = cur; int bi = lane;
#pragma unroll
            for (int o = 1; o < 64; o <<= 1) { const float ov = __shfl_xor(bv, o); const int oi = __shfl_xor(bi, o); if (ov > bv || (ov == bv && oi < bi)) { bv = ov; bi = oi; } }
            tv[s] = bv; ti[s] = bi; if (lane == bi) cur = -3e38f; }
        const float e1 = __expf(tv[1] - tv[0]), e2 = __expf(tv[2] - tv[0]), e3 = __expf(tv[3] - tv[0]); const float inv = 1.0f / (1.0f + e1 + e2 + e3);
        if (lane == 0) WSP(float, WS_RSTD2)[tk] = rstd;
        if (lane < 4) { const int ex = (lane == 0) ? ti[0] : (lane == 1) ? ti[1] : (lane == 2) ? ti[2] : ti[3]; const float gv = ((lane == 0) ? 1.0f : (lane == 1) ? e1 : (lane == 2) ? e2 : e3) * inv;
            WSP(float, WS_TKG)[(size_t)tk * 4 + lane] = gv;
            const unsigned rank = atomicAdd(&cnt[ex], 1u);
            WSP(int, WS_ROWLIST)[(size_t)ex * T_ + rank] = tk * 4 + lane; }
    }
}


constexpr int XA_VSTR = 520, XA_VT = 65536;
__device__ __forceinline__ bf16x8 pack8(const f32x16& s, int o) {
    u32x4 w; w.x = pg8::cvt_pk_bf16(s[o + 0], s[o + 1]); w.y = pg8::cvt_pk_bf16(s[o + 2], s[o + 3]); w.z = pg8::cvt_pk_bf16(s[o + 4], s[o + 5]); w.w = pg8::cvt_pk_bf16(s[o + 6], s[o + 7]);
    return __builtin_bit_cast(bf16x8, w);
}
__device__ __forceinline__ void phase_xattn(Frame& F) {
    LAS unsigned char* L = F.lds;
    const bf16_t *Qb = WSP(bf16_t, WS_XQ), *KV = WSP(bf16_t, WS_MKV); bf16_t* Ob = WSP(bf16_t, WS_XO);
    const int lane = F.lane, r32 = lane & 31, hi = lane >> 5, wid = F.wave;
    const int NU = NB * XH * (SEQ / 256), UPB = (NU + F.G - 1) / F.G;
    int lastbh = -1;
    for (int u = F.bid * UPB; u < NU && u < (F.bid + 1) * UPB; ++u) {
        const int bh = u >> 5, qb = u & 31, b = bh >> 2, h = bh & 3;
        if (bh != lastbh) {
            __syncthreads();
            for (int c = F.tid; c < 256 * 16; c += 512) { const int m = c >> 4, ch = c & 15; *(LAS u32x4*)(L + m * 256 + ((ch ^ (m & 15)) << 4)) = *(const u32x4*)(KV + (size_t)(b * MEML + m) * (2 * XW) + h * XD + ch * 8); }
            { const bf16_t* VTg = WSP(bf16_t, WS_MVT) + ((size_t)b * XW + h * XD) * MEML;
              for (int c = F.tid; c < 128 * 64; c += 512) { const int d = c >> 6, pc = c & 63; *(LAS u32x2*)(L + XA_VT + d * XA_VSTR + pc * 8) = *(const u32x2*)(VTg + (size_t)d * MEML + pc * 4); } }
            __syncthreads(); lastbh = bh; }
        const size_t row = (size_t)b * SEQ + qb * 256 + wid * 32 + r32;
        bf16x8 qf[8];
#pragma unroll
        for (int kd = 0; kd < 8; ++kd) qf[kd] = *(const bf16x8*)(Qb + row * XW + h * XD + 16 * kd + 8 * hi);
        f32x16 o[4];
#pragma unroll
        for (int dt = 0; dt < 4; ++dt)
#pragma unroll
            for (int r = 0; r < 16; ++r) o[dt][r] = 0.f;
        float mrun = -1e30f, lrun = 0.f;
#pragma unroll 1
        for (int c = 0; c < 4; ++c) {
            f32x16 s0, s1;
#pragma unroll
            for (int r = 0; r < 16; ++r) { s0[r] = 0.f; s1[r] = 0.f; }
            const int kv0 = c * 64 + r32, kv1 = kv0 + 32;
#pragma unroll
            for (int kd = 0; kd < 8; ++kd) { const int ch = 2 * kd + hi;
                const bf16x8 k0 = *(const LAS bf16x8*)(L + kv0 * 256 + ((ch ^ (kv0 & 15)) << 4)), k1 = *(const LAS bf16x8*)(L + kv1 * 256 + ((ch ^ (kv1 & 15)) << 4));
                s0 = __builtin_amdgcn_mfma_f32_32x32x16_bf16(k0, qf[kd], s0, 0, 0, 0); s1 = __builtin_amdgcn_mfma_f32_32x32x16_bf16(k1, qf[kd], s1, 0, 0, 0); }
            float mx = fmaxf(s0[0], s1[0]);
#pragma unroll
            for (int r = 1; r < 16; ++r) mx = fmaxf(mx, fmaxf(s0[r], s1[r]));
            mx = fmaxf(mx, __shfl_xor(mx, 32));
            const float mn = fmaxf(mrun, mx), sc = __builtin_amdgcn_exp2f(mrun - mn); mrun = mn;
            float ls = 0.f;
#pragma unroll
            for (int r = 0; r < 16; ++r) { s0[r] = __builtin_amdgcn_exp2f(s0[r] - mn); s1[r] = __builtin_amdgcn_exp2f(s1[r] - mn); ls += s0[r] + s1[r]; }
            ls += __shfl_xor(ls, 32); lrun = lrun * sc + ls;
#pragma unroll
            for (int dt = 0; dt < 4; ++dt)
#pragma unroll
                for (int r = 0; r < 16; ++r) o[dt][r] *= sc;
            bf16x8 pf[4]; pf[0] = pack8(s0, 0); pf[1] = pack8(s0, 8); pf[2] = pack8(s1, 0); pf[3] = pack8(s1, 8);
#pragma unroll
            for (int dt = 0; dt < 4; ++dt)
#pragma unroll
                for (int ks = 0; ks < 4; ++ks) { const LAS unsigned char* vp = L + XA_VT + (dt * 32 + r32) * XA_VSTR + (c * 64 + 16 * ks + 4 * hi) * 2;
                    const u32x2 lo = *(const LAS u32x2*)vp, hh = *(const LAS u32x2*)(vp + 16); u32x4 w; w.x = lo.x; w.y = lo.y; w.z = hh.x; w.w = hh.y;
                    o[dt] = __builtin_amdgcn_mfma_f32_32x32x16_bf16(__builtin_bit_cast(bf16x8, w), pf[ks], o[dt], 0, 0, 0); }
        }
        const float il = 1.0f / lrun;
        bf16_t* op = Ob + row * XW + h * XD + 4 * hi;
#pragma unroll
        for (int dt = 0; dt < 4; ++dt)
#pragma unroll
            for (int g4 = 0; g4 < 4; ++g4) { u32x2 w; w.x = pg8::cvt_pk_bf16(o[dt][4 * g4] * il, o[dt][4 * g4 + 1] * il); w.y = pg8::cvt_pk_bf16(o[dt][4 * g4 + 2] * il, o[dt][4 * g4 + 3] * il);
                *(u32x2*)(op + dt * 32 + 8 * g4) = w; }
    }
    __syncthreads();
}

constexpr int RT_WSTR = 1028, RT_LG = NE * RT_WSTR * 4  , RT_LCNT = RT_LG + 8 * 16 * 33 * 4  , RT_LBASE = RT_LCNT + 128, RT_RS = RT_LBASE + 128  ;
__device__ __forceinline__ void phase_router_mfma(Frame& F) {
    LAS float* wt = (LAS float*)F.lds;
    __syncthreads();
    for (int c = F.tid; c < NE * DM; c += 512) { const int k = c >> 5, e = c & 31; wt[e * RT_WSTR + k] = F.in[I_WROUTER][c] * F.in[I_GMOE][k]; }
    LAS unsigned* lcnt = (LAS unsigned*)(F.lds + RT_LCNT); LAS unsigned* lbase = (LAS unsigned*)(F.lds + RT_LBASE);
    const int lane = F.lane, wid = F.wave, row = lane & 15, kq = lane >> 4;
    LAS float* lg = (LAS float*)(F.lds + RT_LG) + wid * (16 * 33); LAS float* rsl = (LAS float*)(F.lds + RT_RS) + wid * 16;
    const bf16_t* HBp = WSP(bf16_t, WS_HB); bf16_t* N2 = WSP(bf16_t, WS_N2B); unsigned* cnt = F.ctl + CW_CNT;
    for (int chunk = F.bid; chunk < T_ / 128; chunk += F.G) {
        if (F.tid < 32) lcnt[F.tid] = 0u;
        __syncthreads();
        const int tok0 = chunk * 128 + wid * 16;
        f32x4 acc0 = {0.f, 0.f, 0.f, 0.f}, acc1 = {0.f, 0.f, 0.f, 0.f}; float ss = 0.f;
        const bf16_t* hp = HBp + (size_t)(tok0 + row) * DM + 8 * kq;
        const LAS float* w0 = wt + row * RT_WSTR + 8 * kq; const LAS float* w1 = w0 + 16 * RT_WSTR;
#pragma unroll 4
        for (int i = 0; i < 32; ++i) { const u32x4 hw = *(const u32x4*)(hp + 32 * i);
            const float a[8] = {bflo(hw.x), bfhi(hw.x), bflo(hw.y), bfhi(hw.y), bflo(hw.z), bfhi(hw.z), bflo(hw.w), bfhi(hw.w)};
            const f32x4 b00 = *(const LAS f32x4*)(w0 + 32 * i), b01 = *(const LAS f32x4*)(w0 + 32 * i + 4), b10 = *(const LAS f32x4*)(w1 + 32 * i), b11 = *(const LAS f32x4*)(w1 + 32 * i + 4);
#pragma unroll
            for (int e = 0; e < 8; ++e) ss += a[e] * a[e];
#pragma unroll
            for (int e = 0; e < 4; ++e) { acc0 = __builtin_amdgcn_mfma_f32_16x16x4f32(a[e], b00[e], acc0, 0, 0, 0); acc1 = __builtin_amdgcn_mfma_f32_16x16x4f32(a[e], b10[e], acc1, 0, 0, 0); }
#pragma unroll
            for (int e = 0; e < 4; ++e) { acc0 = __builtin_amdgcn_mfma_f32_16x16x4f32(a[4 + e], b01[e], acc0, 0, 0, 0); acc1 = __builtin_amdgcn_mfma_f32_16x16x4f32(a[4 + e], b11[e], acc1, 0, 0, 0); } }
        ss += __shfl_xor(ss, 16); ss += __shfl_xor(ss, 32);
        const float rstd = 1.0f / sqrtf(ss * (1.0f / DM) + RMS_EPS);
#pragma unroll
        for (int r = 0; r < 4; ++r) { lg[(4 * kq + r) * 33 + row] = acc0[r]; lg[(4 * kq + r) * 33 + 16 + row] = acc1[r]; }
        if (lane < 16) rsl[lane] = rstd;
        asm volatile("s_waitcnt lgkmcnt(0)" ::: "memory");
#pragma unroll 4
        for (int t = 0; t < 16; ++t) { const float rs = rsl[t]; const u32x4* src = (const u32x4*)(HBp + (size_t)(tok0 + t) * DM) + lane; u32x4* dst = (u32x4*)(N2 + (size_t)(tok0 + t) * DM) + lane;
#pragma unroll
            for (int hh = 0; hh < 2; ++hh) { const u32x4 w = src[64 * hh];
                if (MOE1_FP8) { int w0 = 0, w1 = 0;
                    w0 = __builtin_amdgcn_cvt_pk_fp8_f32(bflo(w.x) * rs, bfhi(w.x) * rs, w0, false); w0 = __builtin_amdgcn_cvt_pk_fp8_f32(bflo(w.y) * rs, bfhi(w.y) * rs, w0, true);
                    w1 = __builtin_amdgcn_cvt_pk_fp8_f32(bflo(w.z) * rs, bfhi(w.z) * rs, w1, false); w1 = __builtin_amdgcn_cvt_pk_fp8_f32(bflo(w.w) * rs, bfhi(w.w) * rs, w1, true);
                    ((u32x2*)((unsigned char*)N2 + (size_t)(tok0 + t) * DM))[lane + 64 * hh] = (u32x2){(unsigned)w0, (unsigned)w1}; }
                else { u32x4 o; o.x = pk2(bflo(w.x) * rs, bfhi(w.x) * rs); o.y = pk2(bflo(w.y) * rs, bfhi(w.y) * rs); o.z = pk2(bflo(w.z) * rs, bfhi(w.z) * rs); o.w = pk2(bflo(w.w) * rs, bfhi(w.w) * rs); dst[64 * hh] = o; } } }
        int ex[4] = {0, 0, 0, 0}; unsigned lrank[4] = {0u, 0u, 0u, 0u}; const int tk = tok0 + lane;
        if (lane < 16) {
            float v[32];
#pragma unroll
            for (int e = 0; e < 32; ++e) v[e] = lg[lane * 33 + e] * rstd + F.in[I_BROUTER][e];
            float tv[4];
#pragma unroll
            for (int s = 0; s < 4; ++s) { float bv = v[0]; int bi = 0;
#pragma unroll
                for (int e = 1; e < 32; ++e) if (v[e] > bv) { bv = v[e]; bi = e; }
#pragma unroll
                for (int e = 0; e < 32; ++e) v[e] = (e == bi) ? -3e38f : v[e];
                tv[s] = bv; ex[s] = bi; }
            const float e1 = __expf(tv[1] - tv[0]), e2 = __expf(tv[2] - tv[0]), e3 = __expf(tv[3] - tv[0]); const float inv = 1.0f / (1.0f + e1 + e2 + e3);
            *(f32x4*)(WSP(float, WS_TKG) + (size_t)tk * 4) = (f32x4){inv, e1 * inv, e2 * inv, e3 * inv};
#pragma unroll
            for (int s = 0; s < 4; ++s) lrank[s] = __hip_atomic_fetch_add(&lcnt[ex[s]], 1u, __ATOMIC_RELAXED, __HIP_MEMORY_SCOPE_WORKGROUP);
        }
        __syncthreads();
        if (F.tid < 32) lbase[F.tid] = atomicAdd(&cnt[F.tid], lcnt[F.tid]);
        __syncthreads();
        if (lane < 16) {
#pragma unroll
            for (int s = 0; s < 4; ++s) WSP(int, WS_ROWLIST)[(size_t)ex[s] * T_ + lbase[ex[s]] + lrank[s]] = tk * 4 + s; }
        __syncthreads();
    }
}

struct FinRegs { u32x2 hw[2][4]; u32x2 yw[2][4][4]; };
__device__ __forceinline__ void fin_load(const bf16_t* HBf, const bf16_t* Y, const int* INV, int tk, FinRegs& R, int lane) {
    int inv[2][4];
#pragma unroll
    for (int t = 0; t < 2; ++t)
#pragma unroll
        for (int s = 0; s < 4; ++s) inv[t][s] = __builtin_amdgcn_readfirstlane(INV[(size_t)(tk + t) * 4 + s]);
#pragma unroll
    for (int t = 0; t < 2; ++t) {
#pragma unroll
        for (int j = 0; j < 4; ++j) { R.hw[t][j] = ((const u32x2*)(HBf + (size_t)(tk + t) * DM))[lane + 64 * j];
#pragma unroll
            for (int s = 0; s < 4; ++s) { if (Y_FP8) { R.yw[t][s][j].x = ((const unsigned*)((const unsigned char*)Y + (size_t)inv[t][s] * DM))[lane + 64 * j]; R.yw[t][s][j].y = 0u; }
                else R.yw[t][s][j] = ((const u32x2*)(Y + (size_t)inv[t][s] * DM))[lane + 64 * j]; } } }
}
template <int FEXP> __device__ __forceinline__ void fin_finish(Frame& F, int tk, const FinRegs& R, const f32x4 (&gf)[4], int lane) {
#pragma unroll
    for (int t = 0; t < 2; ++t) { f32x4 hv[4]; float ss = 0.f;
#pragma unroll
        for (int j = 0; j < 4; ++j) { const u32x2 w = R.hw[t][j]; hv[j] = (f32x4){bflo(w.x), bfhi(w.x), bflo(w.y), bfhi(w.y)};
#pragma unroll
            for (int s = 0; s < 4; ++s) { const u32x2 y = R.yw[t][s][j];
                if (Y_FP8) { const float yi = 1.0f / (float)(1 << Y_SHIFT); hv[j][0] += __builtin_amdgcn_cvt_f32_fp8((int)y.x, 0) * yi; hv[j][1] += __builtin_amdgcn_cvt_f32_fp8((int)y.x, 1) * yi; hv[j][2] += __builtin_amdgcn_cvt_f32_fp8((int)y.x, 2) * yi; hv[j][3] += __builtin_amdgcn_cvt_f32_fp8((int)y.x, 3) * yi; }
                else { hv[j][0] += bflo(y.x); hv[j][1] += bfhi(y.x); hv[j][2] += bflo(y.y); hv[j][3] += bfhi(y.y); } }
            ss += (hv[j][0] * hv[j][0] + hv[j][1] * hv[j][1]) + (hv[j][2] * hv[j][2] + hv[j][3] * hv[j][3]); }
        float rstd = 1.0f / sqrtf(wave_sum(ss) * (1.0f / DM) + RMS_EPS);
#if DBG_STAGE
        { const float sd = __hip_atomic_load((float*)(F.ctl + CW_DBG), RLX_AGENT), sr = __hip_atomic_load((float*)(F.ctl + CW_DBG + 1), RLX_AGENT); rstd *= 1.0f + sqrtf(100.0f * sd / fmaxf(sr, 1e-30f)); }
#endif
        f32x4* op = (f32x4*)(((FEXP == 3) ? WSP(float, WS_PO) : F.out) + (size_t)(tk + t) * DM) + lane;
        if (FEXP == 1) { asm volatile("" :: "v"(hv[0][0] * rstd), "v"(hv[3][3] * rstd)); }
        else {
#pragma unroll
            for (int j = 0; j < 4; ++j) op[64 * j] = hv[j] * rstd * gf[j]; } }
}
template <int FEXP> __device__ __forceinline__ void phase_final_t(Frame& F) {
    const int gw = F.bid * 8 + F.wave, NGW = F.G * 8, lane = F.lane;
    const bf16_t* HBf = WSP(bf16_t, WS_HB); const bf16_t* Y = WSP(bf16_t, WS_Y); const int* INVp = WSP(int, WS_INV);
    f32x4 gf[4];
#pragma unroll
    for (int j = 0; j < 4; ++j) gf[j] = ((const f32x4*)F.in[I_GFINAL])[lane + 64 * j];
    FinRegs ra, rb; const int step = NGW * 2, t0 = gw * 2, n = (t0 < T_) ? (T_ - t0 + step - 1) / step : 0;
    if (n > 0) { fin_load(HBf, Y, INVp, t0, ra, lane); int i = 0;
        for (; i + 2 <= n; i += 2) {
            fin_load(HBf, Y, INVp, t0 + (i + 1) * step, rb, lane);
            fin_finish<FEXP>(F, t0 + i * step, ra, gf, lane);
            fin_load(HBf, Y, INVp, t0 + min(i + 2, n - 1) * step, ra, lane);
            fin_finish<FEXP>(F, t0 + (i + 1) * step, rb, gf, lane); }
        if (i < n) fin_finish<FEXP>(F, t0 + i * step, ra, gf, lane); }
}
__device__ __forceinline__ void phase_final(Frame& F) { phase_final_t<0>(F); }

__device__ __forceinline__ void dbg_compare(Frame& F, const bf16_t* A, const bf16_t* R, size_t n) {
    float sd = 0.f, sr = 0.f;
    for (size_t i = (size_t)F.bid * 512 + F.tid; i < n; i += (size_t)F.G * 512) { const float a = bf2f(A[i]), r = bf2f(R[i]); sd += (a - r) * (a - r); sr += r * r; }
    sd = wave_sum(sd); sr = wave_sum(sr);
    if (F.lane == 0) { atomicAdd((float*)(F.ctl + CW_DBG), sd); atomicAdd((float*)(F.ctl + CW_DBG + 1), sr); }
}
constexpr int N_PHASES = 15;
__global__ void __launch_bounds__(512, 2) mega_fwd(Args args) {
    extern __shared__ __attribute__((aligned(16))) unsigned char lds_raw[];
    Frame F;
    F.lds = (LAS unsigned char*)lds_raw; F.tid = threadIdx.x; F.lane = F.tid & 63; F.wave = __builtin_amdgcn_readfirstlane(F.tid >> 6); F.G = gridDim.x; F.bid = blockIdx.x;
#pragma unroll
    for (int i = 0; i < 28; ++i) F.in[i] = args.in[i];
    F.out = args.out; F.ws = args.ws; F.ctl = (unsigned*)(args.ws + WS_CTL);
    volatile LAS unsigned* MISC = (volatile LAS unsigned*)(F.lds + MISC_OFF);
    if (F.tid < 64) MISC[F.tid] = 0u;
    __syncthreads();
    const int lo = args.ph_lo, hi = args.ph_hi;
    XcdBarrier bar; bar.bar = F.ctl + CW_BAR; bar.x = 0; bar.st = nullptr;
    if (hi - lo > 1) bar = xcd_barrier_post(F.ctl + CW_BAR, MISC + 8);
#define IN(k) (lo <= (k) && (k) < hi)
#define SEAM(k) do { if (IN(k) && IN((k) + 1)) xcd_barrier(bar); } while (0)
    LAS unsigned char* ring = F.lds;
    const LAS int* gidx = (const LAS int*)(F.lds + GIDX_OFF);

    if (IN(0)) for (int rep_ = 0; rep_ <= ((REP_MASK >> 0) & 1) * REP_EXTRA; ++rep_) { if (rep_) xcd_barrier(bar);  phase_prologue(F); for (int tk = F.bid; tk < NG * 8; tk += F.G) p0_ssm_tables(F, tk); } SEAM(0);
    if (IN(1)) for (int rep_ = 0; rep_ <= ((REP_MASK >> 1) & 1) * REP_EXTRA; ++rep_) { if (rep_) xcd_barrier(bar);
        { pg8::Gemm g{WSP(bf16_t, WS_XB), WSP(bf16_t, WS_WIN), DM, 0}; pg8::PatchOrder S; S.init(T_ / 256, INW / 256, 8, F.G, F.bid);
          pg8::EpiInProj E{WSP(bf16_t, WS_Q), WSP(bf16_t, WS_K), WSP(bf16_t, WS_V), WSP(bf16_t, WS_U), WSP(bf16_t, WS_SGA), WSP(bf16_t, WS_SGB), WSP(float, WS_KM2)};
          pg8::gemm_phase<pg8::EpiInProj, pg8::PatchOrder, false>(ring, g, S, E, gidx, STG_TICKS);
#if NULL_EXP == 1
          { pg8::EpiNull EN; pg8::gemm_phase<pg8::EpiNull, pg8::PatchOrder, false>(ring, g, S, EN, gidx); pg8::gemm_phase<pg8::EpiNull, pg8::PatchOrder, false>(ring, g, S, EN, gidx); }
#elif NULL_EXP == 5
          { pg8::EpiStoreExp<false> EN{WSP(bf16_t, WS_N2B)}; pg8::gemm_phase<pg8::EpiStoreExp<false>, pg8::PatchOrder, false>(ring, g, S, EN, gidx); pg8::gemm_phase<pg8::EpiStoreExp<false>, pg8::PatchOrder, false>(ring, g, S, EN, gidx); }
#elif NULL_EXP == 6
          { pg8::EpiStoreExp<true> EN{WSP(bf16_t, WS_N2B)}; pg8::gemm_phase<pg8::EpiStoreExp<true>, pg8::PatchOrder, false>(ring, g, S, EN, gidx); pg8::gemm_phase<pg8::EpiStoreExp<true>, pg8::PatchOrder, false>(ring, g, S, EN, gidx); }
#elif NULL_EXP == 3
          { pg8::EpiInProjT<1> EN{E.Q, E.Kb, E.V, E.U, E.SGA, E.SGB, E.KM2}; pg8::gemm_phase<pg8::EpiInProjT<1>, pg8::PatchOrder, false>(ring, g, S, EN, gidx); pg8::gemm_phase<pg8::EpiInProjT<1>, pg8::PatchOrder, false>(ring, g, S, EN, gidx); }
#elif NULL_EXP == 4
          { pg8::EpiInProjT<2> EN{E.Q, E.Kb, E.V, E.U, E.SGA, E.SGB, E.KM2}; pg8::gemm_phase<pg8::EpiInProjT<2>, pg8::PatchOrder, false>(ring, g, S, EN, gidx); pg8::gemm_phase<pg8::EpiInProjT<2>, pg8::PatchOrder, false>(ring, g, S, EN, gidx); }
#endif
          }
    } SEAM(1);
    if (IN(2)) for (int rep_ = 0; rep_ <= ((REP_MASK >> 2) & 1) * REP_EXTRA; ++rep_) { if (rep_) { xcd_barrier(bar); if (F.tid < 4) { for (int k_ = F.tid; k_ < 1024; k_ += 4) __hip_atomic_store(F.ctl + CW_MCNT + k_, 0u, RLX_AGENT); } __syncthreads(); xcd_barrier(bar); }
        for (int it = F.bid; it < NB * NG * 2; it += F.G) ssm_state_item(F, (it >> 1) / NG, (it >> 1) % NG, it & 1);
        for (int it = F.bid; it < NB * NH * NBLK; it += F.G) moba_route_item(F, it / NBLK, (NBLK - 1) - (it % NBLK));
    } SEAM(2);
    if (IN(3)) for (int rep_ = 0; rep_ <= ((REP_MASK >> 3) & 1) * REP_EXTRA; ++rep_) { if (rep_) xcd_barrier(bar);
        { int t_ = threadIdx.x; asm volatile("" : "+v"(t_)); F.tid = t_; F.lane = t_ & 63; F.wave = __builtin_amdgcn_readfirstlane(t_ >> 6); }
        { const int nsl = F.G >> 3, conv = (CONV_SLOTS > 0 && nsl > CONV_SLOTS && (F.G & 7) == 0) ? CONV_SLOTS : 0;
          { const int back = nsl - 1 - (F.bid >> 3), uidx = back * 8 + (F.bid & 7); pg8::OneUnit S1{uidx >> 2, uidx & 3, (back >= 0 && back < 2) ? 1 : 0};
            pg8::Gemm gk{WSP(bf16_t, WS_MN), WSP(bf16_t, WS_WXKV), DM, 0}; pg8::EpiMemKV Ek{WSP(bf16_t, WS_MKV), WSP(bf16_t, WS_MVT)};
            pg8::gemm_phase<pg8::EpiMemKV, pg8::OneUnit, false>(ring, gk, S1, Ek, gidx); __syncthreads(); }
          if ((F.bid >> 3) >= nsl - conv) { __syncthreads(); convert_weights(F, 1, (((F.bid >> 3) - (nsl - conv)) * 8 + (F.bid & 7)) * 8 + F.wave, conv * 64); __syncthreads(); }
          moba_sparse_phase<0>(F, (char*)lds_raw, nsl); }
#if MOBA_EXP == 1
        moba_sparse_phase<1>(F, (char*)lds_raw, F.G >> 3); moba_sparse_phase<1>(F, (char*)lds_raw, F.G >> 3);
#endif
        { int t_ = threadIdx.x; asm volatile("" : "+v"(t_)); F.tid = t_; F.lane = t_ & 63; F.wave = __builtin_amdgcn_readfirstlane(t_ >> 6); }
        phase_ssm_out(F);
    } SEAM(3);
#if DBG_STAGE == 1 || DBG_STAGE == 2
    moba_combine_phase(F); xcd_barrier(bar);
#endif
#if DBG_STAGE == 1
    phase_ssm_simple(F, WSP(bf16_t, WS_MERGED)); xcd_barrier(bar); dbg_compare(F, WSP(bf16_t, WS_YB), WSP(bf16_t, WS_MERGED), (size_t)T_ * SW); xcd_barrier(bar);
#elif DBG_STAGE == 2
    phase_moba_simple(F, WSP(bf16_t, WS_MERGED)); xcd_barrier(bar); dbg_compare(F, WSP(bf16_t, WS_ATT), WSP(bf16_t, WS_MERGED), (size_t)T_ * AW); xcd_barrier(bar);
#endif
    if (IN(5)) for (int rep_ = 0; rep_ <= ((REP_MASK >> 5) & 1) * REP_EXTRA; ++rep_) { if (rep_) xcd_barrier(bar);
#if !(DBG_STAGE == 1 || DBG_STAGE == 2)
        moba_combine_phase(F);
#endif
        pg8::Gemm g{WSP(bf16_t, WS_YB), WSP(bf16_t, WS_WGLU), SW, 0};
        pg8::EpiGlu E{WSP(bf16_t, WS_SGB), WSP(bf16_t, WS_YB2S)};
        if (F.G == 256) { pg8::PairOrder S; S.init(F.bid, 0); pg8::gemm_phase<pg8::EpiGlu, pg8::PairOrder, false>(ring, g, S, E, gidx); }
        else { pg8::PatchOrder S; S.init(T_ / 256, 2 * DM / 256, 8, F.G, F.bid); pg8::gemm_phase<pg8::EpiGlu, pg8::PatchOrder, false>(ring, g, S, E, gidx); }
    } if (F.G != 256) SEAM(5);
    if (IN(6)) for (int rep_ = 0; rep_ <= ((REP_MASK >> 6) & 1) * REP_EXTRA; ++rep_) { if (rep_) xcd_barrier(bar);
        pg8::Gemm g{WSP(bf16_t, WS_ATT), WSP(bf16_t, WS_WPA), AW, 0};
        pg8::EpiMerge E{WSP(bf16_t, WS_SGA), WSP(bf16_t, WS_YB2S), WSP(bf16_t, WS_MERGED)};
        if (F.G == 256) { pg8::PairOrder S; S.init(F.bid, 1); pg8::gemm_phase<pg8::EpiMerge, pg8::PairOrder, false>(ring, g, S, E, gidx); }
        else { pg8::PatchOrder S; S.init(T_ / 256, DM / 256, 4, F.G, F.bid); pg8::gemm_phase<pg8::EpiMerge, pg8::PatchOrder, false>(ring, g, S, E, gidx); }
    } SEAM(6);
    if (IN(7)) for (int rep_ = 0; rep_ <= ((REP_MASK >> 7) & 1) * REP_EXTRA; ++rep_) { if (rep_) xcd_barrier(bar);
        pg8::Gemm g{WSP(bf16_t, WS_MERGED), WSP(bf16_t, WS_WOUT), DM, 0}; pg8::PatchOrder S; S.init(T_ / 256, DM / 256, 4, F.G, F.bid);
        pg8::EpiResidT<true> E{F.in[I_X], WSP(bf16_t, WS_HB), WSP(float, WS_SSQ1)};
        pg8::gemm_phase<pg8::EpiResidT<true>, pg8::PatchOrder, false>(ring, g, S, E, gidx);
    } SEAM(7);
    if (IN(8)) for (int rep_ = 0; rep_ <= ((REP_MASK >> 8) & 1) * REP_EXTRA; ++rep_) { if (rep_) xcd_barrier(bar);
        pg8::Gemm g{WSP(bf16_t, WS_HB), WSP(bf16_t, WS_WXQ), DM, 0}; pg8::PatchOrder S; S.init(T_ / 256, XW / 256, 2, F.G, F.bid);
        pg8::EpiXq E{WSP(float, WS_SSQ1), WSP(bf16_t, WS_XQ)};
        pg8::gemm_phase<pg8::EpiXq, pg8::PatchOrder, false>(ring, g, S, E, gidx);
    } SEAM(8);
    if (IN(9)) for (int rep_ = 0; rep_ <= ((REP_MASK >> 9) & 1) * REP_EXTRA; ++rep_) { if (rep_) xcd_barrier(bar);  phase_xattn(F); } SEAM(9);
#if DBG_STAGE == 3
    phase_xattn_simple(F, WSP(bf16_t, WS_MERGED)); xcd_barrier(bar); dbg_compare(F, WSP(bf16_t, WS_XO), WSP(bf16_t, WS_MERGED), (size_t)T_ * XW); xcd_barrier(bar);
#endif
    if (IN(10)) for (int rep_ = 0; rep_ <= ((REP_MASK >> 10) & 1) * REP_EXTRA; ++rep_) { if (rep_) xcd_barrier(bar);
        pg8::Gemm g{WSP(bf16_t, WS_XO), WSP(bf16_t, WS_WXO), XW, 0}; pg8::PatchOrder S; S.init(T_ / 256, DM / 256, 4, F.G, F.bid);
        pg8::EpiResidT<false> E{nullptr, WSP(bf16_t, WS_HB), nullptr};
        pg8::gemm_phase<pg8::EpiResidT<false>, pg8::PatchOrder, false>(ring, g, S, E, gidx);
    } SEAM(10);
    if (IN(11)) for (int rep_ = 0; rep_ <= ((REP_MASK >> 11) & 1) * REP_EXTRA; ++rep_) { if (rep_) xcd_barrier(bar);  phase_router_mfma(F);
#if OUT_TOUCH
        { const int gw = F.bid * 8 + F.wave, NGW = F.G * 8;
          for (int tk = gw * 2; tk < T_; tk += NGW * 2) { if (F.lane < 2) { const float v = __builtin_nontemporal_load(F.out + (size_t)(tk + F.lane) * DM); asm volatile("" :: "v"(v)); } } }
#endif
    } SEAM(11);
    if (IN(12) || IN(13)) {
        LAS int* pref = (LAS int*)(F.lds + MISC_OFF + 256);
        const unsigned* cnt = F.ctl + CW_CNT;
        __syncthreads();
        if (F.tid == 0) { int a = 0; for (int e = 0; e < NE; ++e) { pref[e] = a; a += ((int)__hip_atomic_load(cnt + e, RLX_AGENT) + 255) >> 8; } pref[NE] = a; }
        __syncthreads();
        const int MT = pref[NE];
        if (IN(12)) for (int rep_ = 0; rep_ <= ((REP_MASK >> 12) & 1) * REP_EXTRA; ++rep_) { if (rep_) xcd_barrier(bar);
            MoeOrder S; S.P.init(MT, 2 * DFF / 256, 8, F.G, F.bid); S.pref = pref; S.rev = 0;
            { LAS int* gw_ = (LAS int*)(F.lds + GIDX_OFF); pg8::Unit u;
              for (int i = 0; i < GIDX_UNITS && S.next(i, u); ++i) { const int ce = (int)__hip_atomic_load(cnt + u.e, RLX_AGENT);
                  if (F.tid < 256) { const int rank = u.mi * 256 + F.tid; int tokslot = 0; if (rank < ce) { tokslot = WSP(int, WS_ROWLIST)[(size_t)u.e * T_ + rank]; if (u.pn == 0) WSP(int, WS_INV)[tokslot] = u.pm * 256 + F.tid; }
                      gw_[i * 256 + F.tid] = tokslot >> 2; } } }
            __syncthreads();
            pg8::Gemm g{WSP(bf16_t, WS_N2B), WSP(bf16_t, WS_WGU), MOE1_FP8 ? DM / 2 : DM, MOE1_FP8 ? (size_t)2 * DFF * DM / 2 : (size_t)2 * DFF * DM};
            if (MOE1_FP8) g.scaleB = 0x01010101 * (127 - FP8_WSHIFT);
            pg8::EpiMoe1 E{F.in[I_BGU], WSP(bf16_t, WS_HID)};
            pg8::gemm_phase<pg8::EpiMoe1, MoeOrder, true, MOE1_FP8 != 0>(ring, g, S, E, gidx, STG_TICKS);
#if NULL_EXP == 2
            { pg8::EpiNull EN; pg8::gemm_phase<pg8::EpiNull, MoeOrder, true>(ring, g, S, EN, gidx); }
#endif
        }
        SEAM(12);
        if (IN(13)) for (int rep_ = 0; rep_ <= ((REP_MASK >> 13) & 1) * REP_EXTRA; ++rep_) { if (rep_) xcd_barrier(bar);
            MoeOrder S; S.P.init(MT, DM / 256, 4, F.G, F.bid); S.pref = pref; S.rev = 1;
            pg8::Gemm g{WSP(bf16_t, WS_HID), WSP(bf16_t, WS_WDN), MOE2_FP8 ? DFF / 2 : DFF, MOE2_FP8 ? (size_t)DM * DFF / 2 : (size_t)DM * DFF};
            if (MOE2_FP8) g.scaleB = 0x01010101 * (127 - FP8_WSHIFT);
            { LAS int* tD = (LAS int*)(F.lds + GIDX_OFF); LAS float* tG = (LAS float*)(F.lds + GIDX_OFF + 12 * 1024); pg8::Unit u;
              __syncthreads();
              for (int i = 0; i < 12 && S.next(i, u); ++i) { const int ce = (int)__hip_atomic_load(cnt + u.e, RLX_AGENT);
                  if (F.tid < 256) { const int rank = u.mi * 256 + F.tid; int d = -1; float gv = 0.f; if (rank < ce) { d = WSP(int, WS_ROWLIST)[(size_t)u.e * T_ + rank]; gv = WSP(float, WS_TKG)[d]; } tD[i * 256 + F.tid] = d; tG[i * 256 + F.tid] = gv; } }
              __syncthreads(); }
            pg8::EpiMoe2 E{F.in[I_BDN], (const LAS int*)(F.lds + GIDX_OFF), (const LAS float*)(F.lds + GIDX_OFF + 12 * 1024), WSP(bf16_t, WS_Y)};
            pg8::gemm_phase<pg8::EpiMoe2, MoeOrder, false, MOE2_FP8 != 0>(ring, g, S, E, gidx, STG_TICKS);
        }
    } SEAM(13);
#if BAR_EXP
    for (int k_ = 0; k_ < 20; ++k_) xcd_barrier(bar);
#endif
    if (IN(14)) for (int rep_ = 0; rep_ <= ((REP_MASK >> 14) & 1) * REP_EXTRA; ++rep_) { if (rep_) xcd_barrier(bar);  phase_final(F);
#if FINAL_EXP
        phase_final_t<FINAL_EXP>(F); phase_final_t<FINAL_EXP>(F);
#endif
    }
#undef IN
#undef SEAM
}

extern "C" void kernel_launch(void* const* d_in, const int* in_sizes, int n_in, void* d_out, int out_size, void* d_ws, size_t ws_size, hipStream_t stream) {
    static int grid = 0;
    if (grid == 0) {
        if (n_in != 28 || in_sizes[0] != T_ * DM || out_size != T_ * DM || ws_size < WS_END) { fprintf(stderr, "kernel_launch: unexpected shapes (n_in %d, in0 %d, out %d, ws %zu)\n", n_in, n_in > 0 ? in_sizes[0] : -1, out_size, ws_size); grid = -1; return; }
        int dev = 0, cus = 0;
        if (hipGetDevice(&dev) != hipSuccess || hipDeviceGetAttribute(&cus, hipDeviceAttributeMultiprocessorCount, dev) != hipSuccess) { grid = -1; return; }
        if (hipFuncSetAttribute((const void*)mega_fwd, hipFuncAttributeMaxDynamicSharedMemorySize, LDS_BYTES) != hipSuccess) { fprintf(stderr, "kernel_launch: hipFuncSetAttribute failed\n"); grid = -1; return; }
        (void)hipGetLastError();
        grid = cus;
    }
    if (grid < 0) return;
    (void)hipMemsetAsync((char*)d_ws + WS_CTL, 0, CTL_ZERO_BYTES, stream);
    Args a{};
    for (int i = 0; i < 28; ++i) a.in[i] = (const float*)d_in[i];
    a.out = (float*)d_out; a.ws = (unsigned char*)d_ws;
#if MK_N_LAUNCHES == 1
    a.ph_lo = 0; a.ph_hi = N_PHASES;
    hipLaunchKernelGGL(mega_fwd, dim3(grid), dim3(512), LDS_BYTES, stream, a);
#else
    for (int p = 0; p < N_PHASES; ++p) { a.ph_lo = p; a.ph_hi = p + 1; hipLaunchKernelGGL(mega_fwd, dim3(grid), dim3(512), LDS_BYTES, stream, a); }
#endif
}
```
